# Optimizing an MI355X kernel written in HIP

```python
import jax, jax.numpy as jnp
from jax import lax
import numpy as np

D_MODEL = 1024
BATCH = 8
SEQ = 2048
DEPTH = 2
DEC_BATCH = 128
DEC_SEQ = 4
PAST_LEN = 16384
PAGE_SIZE = 128

W_MIX = 512
N_BRANCH = 4
RG_BLOCKS = 8
RG_BLOCK = W_MIX // RG_BLOCKS
RG_CONV = 4
RG_C = 8.0
CONF_CONV = 31
POOL_WINDOWS = (2, 4, 8, 16)
POOL_GROUPS = len(POOL_WINDOWS)
POOL_GW = W_MIX // POOL_GROUPS
POOL_BUF = max(POOL_WINDOWS) - 1
SC_CONV = 3
D_FF = -(-8 * D_MODEL // (3 * 256)) * 256
IN_COLS = 8 * W_MIX + N_BRANCH * D_MODEL
ALPHA = (2 * DEPTH) ** 0.25
BETA = (8 * DEPTH) ** -0.25
LN_EPS = 1e-5

kernel_name = "hybrid_rglru_conformer_pool_shortconv_decode_step"


def layer_norm(x, g, b):
    xf = x.astype(jnp.float32)
    mu = jnp.mean(xf, axis=-1, keepdims=True)
    var = jnp.mean(jnp.square(xf - mu), axis=-1, keepdims=True)
    y = (xf - mu) * lax.rsqrt(var + LN_EPS) * g.astype(jnp.float32) + b.astype(jnp.float32)
    return y.astype(x.dtype)


def causal_dwconv(buf, x, w):
    xp = jnp.concatenate([buf.astype(x.dtype), x], axis=1)
    y = lax.conv_general_dilated(xp, w[:, None, :].astype(x.dtype), window_strides=(1,), padding="VALID",
                                 dimension_numbers=("NWC", "WIO", "NWC"), feature_group_count=x.shape[-1])
    return y, xp[:, -(w.shape[0] - 1):]


def rg_lru(x, h0, w_a, b_a, w_x, b_x, lam):
    bsz, t = x.shape[0], x.shape[1]
    xb = x.reshape(bsz, t, RG_BLOCKS, RG_BLOCK)
    r = jax.nn.sigmoid(jnp.einsum('btnc,ncd->btnd', xb, w_a).reshape(bsz, t, W_MIX) + b_a)
    i = jax.nn.sigmoid(jnp.einsum('btnc,ncd->btnd', xb, w_x).reshape(bsz, t, W_MIX) + b_x)
    log_a = -RG_C * r.astype(jnp.float32) * jax.nn.softplus(-lam.astype(jnp.float32))
    a = jnp.exp(log_a)
    mult = jnp.sqrt(-jnp.expm1(2.0 * log_a))
    b = mult * (i * x).astype(jnp.float32)
    b = b.at[:, 0].add(a[:, 0] * h0.astype(jnp.float32))

    def combine(left, right):
        return (left[0] * right[0], right[0] * left[1] + right[1])

    _, h = lax.associative_scan(combine, (a, b), axis=1)
    return h.astype(x.dtype), h[:, -1].astype(x.dtype)


def pool_mixer(buf, c, start, pool_w, pool_scale):
    bsz, t = c.shape[0], c.shape[1]
    p = jnp.concatenate([buf.astype(c.dtype), c], axis=1).astype(jnp.float32)
    cs = jnp.concatenate([jnp.zeros_like(p[:, :1]), jnp.cumsum(p, axis=1)], axis=1)
    pos = start + jnp.arange(t)
    outs = []
    for g, w in enumerate(POOL_WINDOWS):
        sl = slice(g * POOL_GW, (g + 1) * POOL_GW)
        hi = cs[:, POOL_BUF + 1:POOL_BUF + 1 + t, sl]
        lo = cs[:, POOL_BUF + 1 - w:POOL_BUF + 1 - w + t, sl]
        cnt = jnp.minimum(w, pos + 1).astype(jnp.float32)[None, :, None]
        outs.append((hi - lo) / cnt - p[:, POOL_BUF:, sl])
    m = jnp.concatenate(outs, axis=-1).astype(c.dtype).reshape(bsz, t, POOL_GROUPS, POOL_GW)
    y = jnp.einsum('btgc,gcd->btgd', m, pool_w).reshape(bsz, t, W_MIX) * pool_scale
    return y, p[:, -POOL_BUF:].astype(c.dtype)


def run_layer(x, h0, rg_buf, cf_buf, pool_buf, sc_buf, start,
              w_in, rg_conv_w, rg_conv_b, rg_w_a, rg_b_a, rg_w_x, rg_b_x, rg_lambda,
              cf_conv_w, cf_conv_b, cf_ln_g, cf_ln_b, pool_w, pool_scale, sc_conv_w,
              w_branch, w_out, ln1_g, ln1_b, w_ff_gate, w_ff_up, w_ff_down, ln2_g, ln2_b):
    z = x @ w_in
    a_x, a_gate, b_val, b_gate, c_in, d_b, d_c, d_h, gates = jnp.split(
        z, [W_MIX * k for k in range(1, 9)], axis=-1)
    a_conv, rg_buf_new = causal_dwconv(rg_buf, a_x, rg_conv_w)
    a_h, h_new = rg_lru(a_conv + rg_conv_b, h0, rg_w_a, rg_b_a, rg_w_x, rg_b_x, rg_lambda)
    y_a = a_h * jax.nn.gelu(a_gate)
    glu = b_val * jax.nn.sigmoid(b_gate)
    b_conv, cf_buf_new = causal_dwconv(cf_buf, glu, cf_conv_w)
    y_b = jax.nn.silu(layer_norm(b_conv + cf_conv_b, cf_ln_g, cf_ln_b))
    y_c, pool_buf_new = pool_mixer(pool_buf, c_in, start, pool_w, pool_scale)
    sc_conv, sc_buf_new = causal_dwconv(sc_buf, d_c * d_h, sc_conv_w)
    y_d = d_b * sc_conv
    gate_parts = jnp.split(gates, N_BRANCH, axis=-1)
    branches = (y_a, y_b, y_c, y_d)
    merged = jax.nn.sigmoid(gate_parts[0]) * (branches[0] @ w_branch[0])
    for n in range(1, N_BRANCH):
        merged = merged + jax.nn.sigmoid(gate_parts[n]) * (branches[n] @ w_branch[n])
    x = layer_norm(ALPHA * x + merged @ w_out, ln1_g, ln1_b)
    f = (jax.nn.silu(x @ w_ff_gate) * (x @ w_ff_up)) @ w_ff_down
    x = layer_norm(ALPHA * x + f, ln2_g, ln2_b)
    return x, h_new, rg_buf_new, cf_buf_new, pool_buf_new, sc_buf_new


def setup_inputs(seed: int = 0) -> dict:
    key = jax.random.key(seed)
    ks = iter(jax.random.split(key, 40))
    nrm = lambda shape, s: jax.random.normal(next(ks), shape, jnp.float32) * s
    u = jax.random.uniform(next(ks), (DEPTH, W_MIX), jnp.float32, 0.9, 0.999)
    a_base = u ** (1.0 / RG_C)
    rg_lambda = jnp.log(a_base) - jnp.log1p(-a_base)
    return {
        "x_prompt": nrm((BATCH, SEQ, D_MODEL), 1.0),
        "x_sample": nrm((DEC_BATCH, DEC_SEQ, D_MODEL), 1.0),
        "state_rglru_h": nrm((DEPTH, DEC_BATCH, W_MIX), 0.5),
        "state_rglru_conv": nrm((DEPTH, DEC_BATCH, RG_CONV - 1, W_MIX), 1.0),
        "state_conformer_conv": nrm((DEPTH, DEC_BATCH, CONF_CONV - 1, W_MIX), 0.5),
        "state_pool": nrm((DEPTH, DEC_BATCH, POOL_BUF, W_MIX), 1.0),
        "state_shortconv": nrm((DEPTH, DEC_BATCH, SC_CONV - 1, W_MIX), 1.0),
        "w_in": nrm((DEPTH, D_MODEL, IN_COLS), D_MODEL ** -0.5),
        "rg_conv_w": nrm((DEPTH, RG_CONV, W_MIX), RG_CONV ** -0.5),
        "rg_conv_b": nrm((DEPTH, W_MIX), 0.01),
        "rg_w_a": nrm((DEPTH, RG_BLOCKS, RG_BLOCK, RG_BLOCK), RG_BLOCK ** -0.5),
        "rg_b_a": nrm((DEPTH, W_MIX), 0.01),
        "rg_w_x": nrm((DEPTH, RG_BLOCKS, RG_BLOCK, RG_BLOCK), RG_BLOCK ** -0.5),
        "rg_b_x": nrm((DEPTH, W_MIX), 0.01),
        "rg_lambda": rg_lambda,
        "cf_conv_w": nrm((DEPTH, CONF_CONV, W_MIX), CONF_CONV ** -0.5),
        "cf_conv_b": nrm((DEPTH, W_MIX), 0.01),
        "cf_ln_g": 1.0 + nrm((DEPTH, W_MIX), 0.02),
        "cf_ln_b": nrm((DEPTH, W_MIX), 0.02),
        "pool_w": nrm((DEPTH, POOL_GROUPS, POOL_GW, POOL_GW), POOL_GW ** -0.5),
        "pool_scale": 1.0 + nrm((DEPTH, W_MIX), 0.1),
        "sc_conv_w": nrm((DEPTH, SC_CONV, W_MIX), SC_CONV ** -0.5),
        "w_branch": nrm((DEPTH, N_BRANCH, W_MIX, D_MODEL), BETA * W_MIX ** -0.5),
        "w_out": nrm((DEPTH, D_MODEL, D_MODEL), BETA * D_MODEL ** -0.5),
        "ln1_g": 1.0 + nrm((DEPTH, D_MODEL), 0.02),
        "ln1_b": nrm((DEPTH, D_MODEL), 0.02),
        "w_ff_gate": nrm((DEPTH, D_MODEL, D_FF), D_MODEL ** -0.5),
        "w_ff_up": nrm((DEPTH, D_MODEL, D_FF), D_MODEL ** -0.5),
        "w_ff_down": nrm((DEPTH, D_FF, D_MODEL), BETA * D_FF ** -0.5),
        "ln2_g": 1.0 + nrm((DEPTH, D_MODEL), 0.02),
        "ln2_b": nrm((DEPTH, D_MODEL), 0.02),
    }


def reference(x_prompt, x_sample, state_rglru_h, state_rglru_conv, state_conformer_conv, state_pool,
              state_shortconv, w_in, rg_conv_w, rg_conv_b, rg_w_a, rg_b_a, rg_w_x, rg_b_x, rg_lambda,
              cf_conv_w, cf_conv_b, cf_ln_g, cf_ln_b, pool_w, pool_scale, sc_conv_w, w_branch, w_out,
              ln1_g, ln1_b, w_ff_gate, w_ff_up, w_ff_down, ln2_g, ln2_b):
    weights = (w_in, rg_conv_w, rg_conv_b, rg_w_a, rg_b_a, rg_w_x, rg_b_x, rg_lambda,
               cf_conv_w, cf_conv_b, cf_ln_g, cf_ln_b, pool_w, pool_scale, sc_conv_w,
               w_branch, w_out, ln1_g, ln1_b, w_ff_gate, w_ff_up, w_ff_down, ln2_g, ln2_b)
    bp = x_prompt.shape[0]
    dt = x_prompt.dtype
    yp, ys = x_prompt, x_sample
    p_new = [[] for _ in range(5)]
    s_new = [[] for _ in range(5)]
    for l in range(DEPTH):
        wl = [w[l] for w in weights]
        zero_states = (jnp.zeros((bp, W_MIX), dt),
                       jnp.zeros((bp, RG_CONV - 1, W_MIX), dt),
                       jnp.zeros((bp, CONF_CONV - 1, W_MIX), dt),
                       jnp.zeros((bp, POOL_BUF, W_MIX), dt),
                       jnp.zeros((bp, SC_CONV - 1, W_MIX), dt))
        outp = run_layer(yp, *zero_states, 0, *wl)
        outs = run_layer(ys, state_rglru_h[l], state_rglru_conv[l], state_conformer_conv[l],
                         state_pool[l], state_shortconv[l], PAST_LEN, *wl)
        yp, ys = outp[0], outs[0]
        for k in range(5):
            p_new[k].append(outp[k + 1])
            s_new[k].append(outs[k + 1])
    p_h, p_rgc, p_cf, p_pool, p_sc = [jnp.stack(v, axis=0) for v in p_new]
    s_h, s_rgc, s_cf, s_pool, s_sc = [jnp.stack(v, axis=0) for v in s_new]
    return (yp, ys, p_h, p_rgc, p_cf, p_pool, p_sc, s_h, s_rgc, s_cf, s_pool, s_sc)
```

```cpp
#include <hip/hip_runtime.h>
#include <cstdio>
#include <cstdint>

#ifndef MK_SPLIT
#define MK_SPLIT 0
#endif

constexpr int DM = 1024, WMIX = 512, NPB = 8, SEQ = 2048, NSB = 128, DSEQ = 4;
constexpr int MP = NPB * SEQ, MS = NSB * DSEQ, M = MP + MS;
constexpr int FF = 2816, INC = 8192, ZC = 3072, YC = 2048, GC = 4096;
constexpr float LN_EPS = 1e-5f, ALPHA = 1.41421356237f;
constexpr size_t O_Y = 0, O_PH = (size_t)M * DM, O_PRGC = O_PH + 8192, O_PCF = O_PRGC + 24576, O_PPOOL = O_PCF + 245760, O_PSC = O_PPOOL + 122880,
                 O_SH = O_PSC + 16384, O_SRGC = O_SH + 131072, O_SCF = O_SRGC + 393216, O_SPOOL = O_SCF + 3932160, O_SSC = O_SPOOL + 1966080, O_END = O_SSC + 262144;
static_assert(O_END == 24403968, "output map");

__device__ __forceinline__ int opqv(int v) { asm volatile("" : "+v"(v)); return v; }
__device__ __forceinline__ int lane_now() { int l; asm volatile("v_mbcnt_lo_u32_b32 %0, -1, 0\n\tv_mbcnt_hi_u32_b32 %0, -1, %0" : "=v"(l)); return l; }
__device__ __forceinline__ int opqs(int v) { asm volatile("" : "+s"(v)); return v; }
namespace pg8 {
#define PG8_LAS __attribute__((address_space(3)))
typedef unsigned short bf16_t;
typedef short bf16x8 __attribute__((ext_vector_type(8)));
typedef float f32x4 __attribute__((ext_vector_type(4)));
typedef float f32x2 __attribute__((ext_vector_type(2)));
typedef unsigned u32x4 __attribute__((ext_vector_type(4)));
typedef unsigned u32x2 __attribute__((ext_vector_type(2)));
typedef _Float16 f16x4 __attribute__((ext_vector_type(4)));
typedef _Float16 f16x8 __attribute__((ext_vector_type(8)));
constexpr int BM = 256, BK = 64, HALF = 128, HTB = HALF * BK * 2, STAGE_BYTES = 8 * HTB, NXCD = 8, WGM = 8;

__host__ __device__ __forceinline__ int lds_byte(int r, int c) { const int st = (r >> 4) * 2 + (c >> 5), rr = r & 15, cc = c & 31, ob = rr * 64 + cc * 2; return st * 1024 + (ob ^ (((ob >> 9) & 1) << 5)); }
__host__ __device__ __forceinline__ void stage_rc(int b, int& R, int& C) { const int st = b / 1024, sb = b % 1024, swz = sb ^ (((sb >> 9) & 1) << 5); R = (st >> 1) * 16 + swz / 64; C = (st & 1) * 32 + (swz % 64) / 2; }
__host__ __device__ __forceinline__ int perm32(int rho) { const int n = rho >> 4, i = rho & 15; return 8 * (i >> 2) + 4 * n + (i & 3); }

struct Unit { int pm, pn; };
struct Gemm { const bf16_t* A; const bf16_t* Bt; int M, N, K; };

struct StaticOrder {
    int nM, nN, nwg, G, c;
    __host__ __device__ void init(int M_, int N_, int G_, int c_) { nM = M_ / BM; nN = N_ / BM; nwg = nM * nN; G = G_; c = c_; }
    __host__ __device__ bool next(int i, Unit& u) const {
        const long L = (long)i * G + c; if (L >= nwg) return false;
        int wgid = (int)L; { const int q = nwg / NXCD, r = nwg % NXCD, xcd = wgid % NXCD, off = wgid / NXCD; wgid = (xcd < r ? xcd * (q + 1) : r * (q + 1) + (xcd - r) * q) + off; }
        const int nig = WGM * nN, gid = wgid / nig, fm = gid * WGM, gsz = (nM - fm) < WGM ? (nM - fm) : WGM;
        u.pm = fm + ((wgid % nig) % gsz); u.pn = (wgid % nig) / gsz; return true;
    }
};

__device__ __forceinline__ unsigned cvt_pk_bf16(float lo, float hi) { unsigned r; asm volatile("v_cvt_pk_bf16_f32 %0, %1, %2" : "=v"(r) : "v"(lo), "v"(hi)); return r; }
__device__ __forceinline__ float sigmoidf_fast(float x) { return __builtin_amdgcn_rcpf(1.0f + __builtin_amdgcn_exp2f(-1.44269504089f * x)); }
__device__ __forceinline__ float gelu_tanh(float x) { const float y = 1.5957691216057308f * (x + 0.044715f * x * x * x); return x * sigmoidf_fast(y); }

__device__ __forceinline__ float* state_ptr(float* out, int R, int keep, int layer, size_t p_off, size_t s_off) {
    if (R < MP) { const int b = R >> 11, j = (R & 2047) - (2048 - keep); return j < 0 ? nullptr : out + p_off + (size_t)((layer * 8 + b) * keep + j) * 512; }
    const int s = (R - MP) >> 2, j = (R & 3) + keep - 4; return j < 0 ? nullptr : out + s_off + (size_t)((layer * 128 + s) * keep + j) * 512;
}

struct EpiMix {
    static constexpr bool PERM = true, MIDK = false;
    bf16_t* Z; float* out; int layer;
    __device__ __forceinline__ void midk(f32x4 (&)[2][2][4][2], const Unit&, int, int, int, int, int) const {}
    __device__ __forceinline__ void operator()(f32x4 (&acc)[2][2][4][2], const Unit& u, int wr, int wc, int fr_, int fq_) const {
        const int lane_ = lane_now(), fr = lane_ & 15, fq = lane_ >> 4; (void)fr_; (void)fq_;
        const int pn = u.pn; int type, zcol, keep = 0, scol = 0; size_t poff = 0, soff = 0;
        if (pn < 2) { type = 0; zcol = 256 * pn; keep = 3; scol = zcol; poff = O_PRGC; soff = O_SRGC; }
        else if (pn < 4) { type = 1; zcol = 512 + 256 * (pn - 2); }
        else if (pn < 8) { type = 2; zcol = 1024 + 128 * (pn - 4); keep = 30; scol = 128 * (pn - 4); poff = O_PCF; soff = O_SCF; }
        else if (pn < 10) { type = 0; zcol = 1536 + 256 * (pn - 8); keep = 15; scol = 256 * (pn - 8); poff = O_PPOOL; soff = O_SPOOL; }
        else if (pn < 12) { type = 0; zcol = 2048 + 256 * (pn - 10); }
        else { type = 3; zcol = 2560 + 128 * (pn - 12); keep = 2; scol = 128 * (pn - 12); poff = O_PSC; soff = O_SSC; }
        const bool tail = keep != 0 && (u.pm >= 64 || (u.pm & 7) == 7);
        const int row0 = u.pm * BM + wr * 64 + fr, cl = wc * 32 + 8 * fq;
        if (type < 2) {
#pragma unroll
            for (int ai = 0; ai < 2; ++ai)
#pragma unroll
                for (int m = 0; m < 4; ++m) { const int R = row0 + ai * HALF + m * 16; bf16_t* rowp = Z + (size_t)R * ZC + zcol + cl;
                    float* sp = tail ? state_ptr(out, R, keep, layer, poff, soff) : nullptr;
#pragma unroll
                    for (int bj = 0; bj < 2; ++bj) { f32x4 v0 = acc[ai][bj][m][0], v1 = acc[ai][bj][m][1];
                        if (type == 1) { v0 = (f32x4){gelu_tanh(v0[0]), gelu_tanh(v0[1]), gelu_tanh(v0[2]), gelu_tanh(v0[3])}; v1 = (f32x4){gelu_tanh(v1[0]), gelu_tanh(v1[1]), gelu_tanh(v1[2]), gelu_tanh(v1[3])}; }
                        u32x4 w; w.x = cvt_pk_bf16(v0[0], v0[1]); w.y = cvt_pk_bf16(v0[2], v0[3]); w.z = cvt_pk_bf16(v1[0], v1[1]); w.w = cvt_pk_bf16(v1[2], v1[3]);
                        *(u32x4*)(rowp + bj * HALF) = w;
                        if (sp) { *(f32x4*)(sp + scol + cl + bj * HALF) = v0; *(f32x4*)(sp + scol + cl + bj * HALF + 4) = v1; } } }
        } else {
#pragma unroll
            for (int ai = 0; ai < 2; ++ai)
#pragma unroll
                for (int m = 0; m < 4; ++m) { const int R = row0 + ai * HALF + m * 16; bf16_t* rowp = Z + (size_t)R * ZC + zcol + cl;
                    float* sp = tail ? state_ptr(out, R, keep, layer, poff, soff) : nullptr;
                    f32x4 v0, v1; const f32x4 a0 = acc[ai][0][m][0], a1 = acc[ai][0][m][1], b0 = acc[ai][1][m][0], b1 = acc[ai][1][m][1];
                    if (type == 2) {
#pragma unroll
                        for (int i = 0; i < 4; ++i) { v0[i] = a0[i] * sigmoidf_fast(b0[i]); v1[i] = a1[i] * sigmoidf_fast(b1[i]); }
                    } else { v0 = a0 * b0; v1 = a1 * b1; }
                    u32x4 w; w.x = cvt_pk_bf16(v0[0], v0[1]); w.y = cvt_pk_bf16(v0[2], v0[3]); w.z = cvt_pk_bf16(v1[0], v1[1]); w.w = cvt_pk_bf16(v1[2], v1[3]);
                    *(u32x4*)rowp = w;
                    if (sp) { *(f32x4*)(sp + scol + cl) = v0; *(f32x4*)(sp + scol + cl + 4) = v1; } }
        }
    }
};

struct EpiGate {
    static constexpr bool PERM = true, MIDK = false;
    _Float16* G;
    __device__ __forceinline__ void midk(f32x4 (&)[2][2][4][2], const Unit&, int, int, int, int, int) const {}
    __device__ __forceinline__ void operator()(f32x4 (&acc)[2][2][4][2], const Unit& u, int wr, int wc, int fr_, int fq_) const {
        const int lane_ = lane_now(), fr = lane_ & 15, fq = lane_ >> 4; (void)fr_; (void)fq_;
        const int row0 = u.pm * BM + wr * 64 + fr, ch0 = 64 * u.pn + 16 * wc + 4 * fq;
#pragma unroll
        for (int ai = 0; ai < 2; ++ai)
#pragma unroll
            for (int m = 0; m < 4; ++m) { const int R = row0 + ai * HALF + m * 16; _Float16* gp = G + (size_t)R * GC + ch0;
                f16x4 r0, r1, r2, g3;
#pragma unroll
                for (int i = 0; i < 4; ++i) {
                    const float z0 = fminf(fmaxf(acc[ai][0][m][0][i], -40.f), 40.f), z1 = fminf(fmaxf(acc[ai][0][m][1][i], -40.f), 40.f);
                    const float z2 = fminf(fmaxf(acc[ai][1][m][0][i], -40.f), 40.f), z3 = fminf(fmaxf(acc[ai][1][m][1][i], -40.f), 40.f);
                    const float d0 = 1.f + __builtin_amdgcn_exp2f(-1.44269504089f * z0), d1 = 1.f + __builtin_amdgcn_exp2f(-1.44269504089f * z1);
                    const float d2 = 1.f + __builtin_amdgcn_exp2f(-1.44269504089f * z2), d3 = 1.f + __builtin_amdgcn_exp2f(-1.44269504089f * z3);
                    r0[i] = (_Float16)fminf(d1 * __builtin_amdgcn_rcpf(d0), 65504.f); r1[i] = (_Float16)fminf(d2 * __builtin_amdgcn_rcpf(d1), 65504.f);
                    r2[i] = (_Float16)fminf(d3 * __builtin_amdgcn_rcpf(d2), 65504.f); g3[i] = (_Float16)__builtin_amdgcn_rcpf(d3); }
                *(f16x4*)(gp) = r0; *(f16x4*)(gp + 1024) = r1; *(f16x4*)(gp + 2048) = r2; *(f16x4*)(gp + 3072) = g3; }
    }
};

struct EpiMerge {
    static constexpr bool PERM = false, MIDK = true;
    const _Float16* G; bf16_t* O;
    __device__ __forceinline__ void scale(f32x4 (&acc)[2][2][4][2], const Unit& u, int seg, int wr, int wc) const {
        const int lane_ = lane_now(), fr = lane_ & 15, fq = lane_ >> 4;
        const int row0 = u.pm * BM + wr * 64 + fr, c0 = 1024 * seg + 256 * u.pn + wc * 32 + 4 * fq;
#pragma unroll
        for (int ai = 0; ai < 2; ++ai)
#pragma unroll
            for (int m = 0; m < 4; ++m) { const _Float16* gp = G + (size_t)(row0 + ai * HALF + m * 16) * GC + c0;
#pragma unroll
                for (int bj = 0; bj < 2; ++bj)
#pragma unroll
                    for (int n = 0; n < 2; ++n) { const f16x4 f = *(const f16x4*)(gp + bj * HALF + n * 16);
                        acc[ai][bj][m][n] *= (f32x4){(float)f[0], (float)f[1], (float)f[2], (float)f[3]}; }
                asm volatile("" ::: "memory"); }
    }
    __device__ __forceinline__ void midk(f32x4 (&acc)[2][2][4][2], const Unit& u, int seg, int wr, int wc, int, int) const { scale(acc, u, seg, wr, wc); }
    __device__ __forceinline__ void operator()(f32x4 (&acc)[2][2][4][2], const Unit& u, int wr, int wc, int, int) const {
        scale(acc, u, 3, wr, wc);
        const int lane_ = lane_now(), fr = lane_ & 15, fq = lane_ >> 4;
        const int row0 = u.pm * BM + wr * 64 + fr, c0 = 256 * u.pn + wc * 32 + 4 * fq;
#pragma unroll
        for (int ai = 0; ai < 2; ++ai)
#pragma unroll
            for (int m = 0; m < 4; ++m) { bf16_t* rowp = O + (size_t)(row0 + ai * HALF + m * 16) * DM + c0;
#pragma unroll
                for (int bj = 0; bj < 2; ++bj)
#pragma unroll
                    for (int n = 0; n < 2; ++n) { const f32x4 v = acc[ai][bj][m][n]; u32x2 w; w.x = cvt_pk_bf16(v[0], v[1]); w.y = cvt_pk_bf16(v[2], v[3]); *(u32x2*)(rowp + bj * HALF + n * 16) = w; } }
    }
};

struct EpiRes {
    static constexpr bool PERM = false, MIDK = false;
    const float* baseP; const float* baseS; float* out;
    __device__ __forceinline__ void midk(f32x4 (&)[2][2][4][2], const Unit&, int, int, int, int, int) const {}
    __device__ __forceinline__ void operator()(f32x4 (&acc)[2][2][4][2], const Unit& u, int wr, int wc, int fr_, int fq_) const {
        const int lane_ = lane_now(), fr = lane_ & 15, fq = lane_ >> 4; (void)fr_; (void)fq_;
        const int row0 = u.pm * BM + wr * 64 + fr, c0 = 256 * u.pn + wc * 32 + 4 * fq;
#pragma unroll
        for (int ai = 0; ai < 2; ++ai)
#pragma unroll
            for (int m = 0; m < 4; ++m) { const int R = row0 + ai * HALF + m * 16;
                const float* bp = (R < MP ? baseP + (size_t)R * DM : baseS + (size_t)(R - MP) * DM) + c0; float* op = out + (size_t)R * DM + c0;
#pragma unroll
                for (int bj = 0; bj < 2; ++bj)
#pragma unroll
                    for (int n = 0; n < 2; ++n) { const f32x4 b = *(const f32x4*)(bp + bj * HALF + n * 16); *(f32x4*)(op + bj * HALF + n * 16) = b * ALPHA + acc[ai][bj][m][n]; }
                if (m & 1) asm volatile("" ::: "memory"); }
    }
};

struct EpiSwi {
    static constexpr bool PERM = true, MIDK = false;
    bf16_t* H;
    __device__ __forceinline__ void midk(f32x4 (&)[2][2][4][2], const Unit&, int, int, int, int, int) const {}
    __device__ __forceinline__ void operator()(f32x4 (&acc)[2][2][4][2], const Unit& u, int wr, int wc, int fr_, int fq_) const {
        const int lane_ = lane_now(), fr = lane_ & 15, fq = lane_ >> 4; (void)fr_; (void)fq_;
        const int row0 = u.pm * BM + wr * 64 + fr, c0 = 128 * u.pn + wc * 32 + 8 * fq;
#pragma unroll
        for (int ai = 0; ai < 2; ++ai)
#pragma unroll
            for (int m = 0; m < 4; ++m) { bf16_t* rowp = H + (size_t)(row0 + ai * HALF + m * 16) * FF + c0;
                const f32x4 g0 = acc[ai][0][m][0], g1 = acc[ai][0][m][1], u0 = acc[ai][1][m][0], u1 = acc[ai][1][m][1]; f32x4 v0, v1;
#pragma unroll
                for (int i = 0; i < 4; ++i) { v0[i] = g0[i] * sigmoidf_fast(g0[i]) * u0[i]; v1[i] = g1[i] * sigmoidf_fast(g1[i]) * u1[i]; }
                u32x4 w; w.x = cvt_pk_bf16(v0[0], v0[1]); w.y = cvt_pk_bf16(v0[2], v0[3]); w.z = cvt_pk_bf16(v1[0], v1[1]); w.w = cvt_pk_bf16(v1[2], v1[3]);
                *(u32x4*)rowp = w; }
    }
};

template <class Epi, class Sched, bool ALIGN_EPI>
__device__ __forceinline__ void gemm_phase(PG8_LAS unsigned char* lds, const Gemm g, const Sched& S, const Epi& E, int wave_id) {
    const int wid = opqs(wave_id), lane = lane_now(), tid = wid * 64 + lane, wr = wid >> 2, wc = wid & 3, fr = lane & 15, fq = lane >> 4;
    const int K = g.K, nt = K / BK, TSEG = Epi::MIDK ? 8 : nt;
    unsigned voffA[2], voffB[2];
#pragma unroll
    for (int i = 0; i < 2; ++i) { int R, C; stage_rc(tid * 16 + i * 8192, R, C); const int Rb = Epi::PERM ? ((R & ~31) + perm32(R & 31)) : R;
        voffA[i] = (unsigned)(R * K + C) * 2u; voffB[i] = (unsigned)(Rb * K + C) * 2u; }
    const size_t kstep = (size_t)(BK * 2);
    const size_t hstep = (size_t)HALF * K * 2;
    const size_t tstep = 2 * hstep;
    const unsigned ldsw = (unsigned)wid * 1024u;
    const int aoff = lds_byte(wr * 64 + fr, fq * 8), boff = lds_byte(wc * 32 + fr, fq * 8);
#define PG8_SA(b, h) (((b) * 2 + (h)) * HTB)
#define PG8_SB(b, h) ((4 + (b) * 2 + (h)) * HTB)
#define PG8_STAGE(bufoff, gbase, voff) do { _Pragma("unroll") for (int _i = 0; _i < 2; ++_i) \
        __builtin_amdgcn_global_load_lds((const unsigned*)((const char*)(gbase) + (voff)[_i]), (PG8_LAS unsigned*)(lds + (bufoff) + ldsw + _i * 8192), 16, 0, 0); } while (0)
#define PG8_LDA(dst, b, h) do { _Pragma("unroll") for (int m = 0; m < 4; ++m) _Pragma("unroll") for (int k = 0; k < 2; ++k) dst[m][k] = *(const PG8_LAS bf16x8*)(lds + PG8_SA(b, h) + aoff + m * 2048 + k * 1024); } while (0)
#define PG8_LDB(dst, b, h) do { _Pragma("unroll") for (int n = 0; n < 2; ++n) _Pragma("unroll") for (int k = 0; k < 2; ++k) dst[n][k] = *(const PG8_LAS bf16x8*)(lds + PG8_SB(b, h) + boff + n * 2048 + k * 1024); } while (0)
#define PG8_MMA(ai, bj, At, Bt) do { __builtin_amdgcn_s_setprio(1); _Pragma("unroll") for (int m = 0; m < 4; ++m) _Pragma("unroll") for (int n = 0; n < 2; ++n) _Pragma("unroll") for (int k = 0; k < 2; ++k) \
        acc[ai][bj][m][n] = __builtin_amdgcn_mfma_f32_16x16x32_bf16(Bt[n][k], At[m][k], acc[ai][bj][m][n], 0, 0, 0); __builtin_amdgcn_s_setprio(0); } while (0)
#define PG8_WAIT_V(n) asm volatile("s_waitcnt vmcnt(" #n ")" ::: "memory")
#define PG8_WAIT_L(n) asm volatile("s_waitcnt lgkmcnt(" #n ")" ::: "memory")
#define PG8_BAR __builtin_amdgcn_s_barrier()
#define PG8_SCHED __builtin_amdgcn_sched_barrier(0)
    Unit cur, nxt; int ui = 0;
    if (!S.next(0, cur)) return;
    f32x4 acc[2][2][4][2];
#pragma unroll
    for (int a = 0; a < 2; ++a)
#pragma unroll
        for (int b = 0; b < 2; ++b)
#pragma unroll
            for (int m = 0; m < 4; ++m)
#pragma unroll
                for (int n = 0; n < 2; ++n) acc[a][b][m][n] = (f32x4){0.f, 0.f, 0.f, 0.f};
    bf16x8 At[4][2], B0[2][2], B1[2][2];
    const char* cA = (const char*)g.A + (size_t)cur.pm * tstep; const char* cB = (const char*)g.Bt + (size_t)cur.pn * tstep;
    PG8_STAGE(PG8_SB(0, 0), cB, voffB); PG8_STAGE(PG8_SB(0, 1), cB + hstep, voffB); PG8_STAGE(PG8_SA(0, 0), cA, voffA); PG8_STAGE(PG8_SA(0, 1), cA + hstep, voffA);
    if (wr == 1) PG8_BAR;
    PG8_WAIT_V(2); PG8_BAR;
    PG8_STAGE(PG8_SB(1, 0), cB + kstep, voffB); PG8_STAGE(PG8_SA(1, 0), cA + kstep, voffA); PG8_STAGE(PG8_SB(1, 1), cB + hstep + kstep, voffB);
    PG8_WAIT_V(6); PG8_BAR;
    for (;;) {
        const bool has_next = S.next(ui + 1, nxt);
        const char* nA = has_next ? (const char*)g.A + (size_t)nxt.pm * tstep : cA; const char* nB = has_next ? (const char*)g.Bt + (size_t)nxt.pn * tstep : cB;
        for (int t0 = 0; t0 < nt; t0 += TSEG) {
        if constexpr (Epi::MIDK) { if (t0 != 0) { PG8_SCHED; E.midk(acc, cur, t0 / TSEG - 1, wr, wc, 0, 0); PG8_SCHED; } }
#pragma unroll 1
        for (int t = t0; t < t0 + TSEG; t += 2) {
            const bool last = (t == nt - 2);
            const char* a1 = cA + (size_t)(t + 1) * kstep;
            const char* a2 = last ? nA : cA + (size_t)(t + 2) * kstep; const char* b2 = last ? nB : cB + (size_t)(t + 2) * kstep;
            const char* a3 = a2 + kstep; const char* b3 = b2 + kstep;
            PG8_LDB(B0, 0, 0); PG8_LDB(B1, 0, 1); PG8_SCHED; PG8_LDA(At, 0, 0); PG8_STAGE(PG8_SA(1, 1), a1 + hstep, voffA);
            PG8_WAIT_V(8); PG8_WAIT_L(0); PG8_BAR; PG8_MMA(0, 0, At, B0); PG8_MMA(0, 1, At, B1); PG8_BAR; PG8_SCHED;
            PG8_LDA(At, 0, 1); PG8_STAGE(PG8_SB(0, 0), b2, voffB); PG8_STAGE(PG8_SB(0, 1), b2 + hstep, voffB); PG8_STAGE(PG8_SA(0, 0), a2, voffA);
            PG8_WAIT_V(8); PG8_WAIT_L(0); PG8_BAR; PG8_MMA(1, 0, At, B0); PG8_MMA(1, 1, At, B1); PG8_BAR; PG8_SCHED;
            PG8_LDB(B0, 1, 0); PG8_LDB(B1, 1, 1); PG8_SCHED; PG8_LDA(At, 1, 0); PG8_STAGE(PG8_SA(0, 1), a2 + hstep, voffA);
            PG8_WAIT_V(8); PG8_WAIT_L(0); PG8_BAR; PG8_MMA(0, 0, At, B0); PG8_MMA(0, 1, At, B1); PG8_BAR; PG8_SCHED;
            PG8_LDA(At, 1, 1); PG8_STAGE(PG8_SB(1, 0), b3, voffB); PG8_STAGE(PG8_SB(1, 1), b3 + hstep, voffB); PG8_STAGE(PG8_SA(1, 0), a3, voffA);
            PG8_WAIT_V(8); PG8_WAIT_L(0); PG8_BAR; PG8_MMA(1, 0, At, B0); PG8_MMA(1, 1, At, B1); PG8_BAR; PG8_SCHED;
        }
        }
        if constexpr (ALIGN_EPI) { if (wr == 0) PG8_BAR; }
        E(acc, cur, wr, wc, 0, 0);
        if (!has_next) break;
#pragma unroll
        for (int a = 0; a < 2; ++a)
#pragma unroll
            for (int b = 0; b < 2; ++b)
#pragma unroll
                for (int m = 0; m < 4; ++m)
#pragma unroll
                    for (int n = 0; n < 2; ++n) acc[a][b][m][n] = (f32x4){0.f, 0.f, 0.f, 0.f};
        cur = nxt; cA = nA; cB = nB; ++ui;
        if constexpr (ALIGN_EPI) { if (wr == 1) PG8_BAR; }
    }
    PG8_WAIT_V(0);
    if constexpr (!ALIGN_EPI) { if (wr == 0) PG8_BAR; }
    PG8_BAR;
#undef PG8_SA
#undef PG8_SB
#undef PG8_STAGE
#undef PG8_LDA
#undef PG8_LDB
#undef PG8_MMA
#undef PG8_WAIT_V
#undef PG8_WAIT_L
#undef PG8_BAR
#undef PG8_SCHED
}
}

constexpr int NWAVES = 8;
constexpr int NPHASE = 19;
constexpr size_t MiB = 1u << 20;
constexpr size_t WS_CTL = 0, CTL_ZERO_BYTES = 1 * MiB;
constexpr size_t WS_WA = 1 * MiB;
constexpr size_t WS_XB = 18 * MiB;
constexpr size_t WS_Y = 51 * MiB;
constexpr size_t WS_ZG = 117 * MiB;
constexpr size_t WS_BT3 = WS_WA, WS_BT4 = WS_WA + 4 * MiB, WS_BT5 = WS_ZG + 96 * MiB, WS_BT6 = WS_ZG + 108 * MiB;
constexpr size_t WS_END = 249 * MiB;
static_assert(WS_XB + (size_t)M * DM * 2 <= WS_Y && WS_Y + (size_t)M * YC * 2 <= WS_ZG && WS_ZG + (size_t)M * GC * 2 <= WS_END, "ws map");
static_assert((size_t)M * FF * 2 <= 96 * MiB && WS_BT5 + (size_t)2 * FF * DM * 2 <= WS_BT6 && WS_BT6 + (size_t)DM * FF * 2 <= WS_END, "ws map 2");
constexpr int CW_TMO = 0, CW_CODE = 1, CW_BAR = 4096;
constexpr int RING_OFF = 0, RING_BYTES = 131072;
constexpr int LDSCTL_OFF = RING_BYTES, MISC_OFF = LDSCTL_OFF + 320;
constexpr int LDS_BYTES = 147456;

#define GAS __attribute__((address_space(1)))
#define LAS __attribute__((address_space(3)))
typedef unsigned short bf16;
typedef unsigned v4u __attribute__((ext_vector_type(4)));
typedef unsigned v2u __attribute__((ext_vector_type(2)));
typedef float f32x4 __attribute__((ext_vector_type(4)));
typedef float f32x2 __attribute__((ext_vector_type(2)));
typedef short bf16x8 __attribute__((ext_vector_type(8)));
typedef GAS unsigned gu32;
#define RLX_AGENT __ATOMIC_RELAXED, __HIP_MEMORY_SCOPE_AGENT
#define LDS_WAIT() asm volatile("s_waitcnt lgkmcnt(0)" ::: "memory")
#define VM_WAIT() asm volatile("s_waitcnt vmcnt(0)" ::: "memory")
__device__ __forceinline__ unsigned pk2(float lo, float hi) { return pg8::cvt_pk_bf16(lo, hi); }
__device__ __forceinline__ float bflo(unsigned v) { return __uint_as_float(v << 16); }
__device__ __forceinline__ float bfhi(unsigned v) { return __uint_as_float(v & 0xffff0000u); }
__device__ __forceinline__ float bf1(unsigned short h) { return __uint_as_float((unsigned)h << 16); }
__device__ __forceinline__ unsigned short f2bf(float f) { return (unsigned short)(pg8::cvt_pk_bf16(f, 0.f) & 0xffffu); }

#define XB_TMO      128
#define XB_XCNT(j)  (256  + 64 * (j))
#define XB_XSUB(j)  (1280 + 64 * (j))
#define XB_XGEN(j)  (2304 + 64 * (j))
#define XB_TOP      3328
#define XB_TOPGEN   3392
#define XCD_BAR_WORDS 3456
#define XB_SPIN_CAP (1u << 18)
__device__ __forceinline__ unsigned xb_ld(unsigned* p)              { return __hip_atomic_load(p, __ATOMIC_RELAXED, __HIP_MEMORY_SCOPE_AGENT); }
__device__ __forceinline__ unsigned xb_add(unsigned* p, unsigned v) { return __hip_atomic_fetch_add(p, v, __ATOMIC_RELAXED, __HIP_MEMORY_SCOPE_AGENT); }
__device__ __forceinline__ unsigned xb_xcc_id() { return (unsigned)__builtin_amdgcn_s_getreg((3 << 11) | 20) & 0xFu; }
#define XB_SPIN(cond, bar) do { unsigned _sp = 0; while (cond) { __builtin_amdgcn_s_sleep(1); \
    if ((++_sp & 255u) == 0u) { if (xb_ld(&(bar)[XB_TMO])) break; if (_sp > XB_SPIN_CAP) { atomicAdd(&(bar)[XB_TMO], 1u); break; } } } } while (0)
struct XcdBarrier { unsigned* bar; unsigned x; volatile LAS unsigned* st; };
__device__ __forceinline__ XcdBarrier xcd_barrier_post(unsigned* bar, volatile LAS unsigned* st) {
    XcdBarrier b; b.bar = bar; b.x = xb_xcc_id(); b.st = st;
    if (threadIdx.x == 0) (void)xb_add(&bar[XB_XCNT(b.x)], 1u);
    return b;
}
__device__ __forceinline__ void xcd_barrier_complete(unsigned* bar, unsigned x, unsigned& nloc, unsigned& nx) {
    const unsigned G = gridDim.x * gridDim.y * gridDim.z;
    unsigned sum, cnt, mine, sp = 0u;
    for (;;) {
        sum = 0u; cnt = 0u; mine = 0u;
#pragma unroll
        for (unsigned j = 0; j < 16; ++j) { const unsigned c = xb_ld(&bar[XB_XCNT(j)]); sum += c; cnt += (c > 0u) ? 1u : 0u; mine = (j == x) ? c : mine; }
        if (sum == G) break;
        __builtin_amdgcn_s_sleep(1);
        if ((++sp & 255u) == 0u) { if (xb_ld(&bar[XB_TMO])) break; if (sp > XB_SPIN_CAP) { atomicAdd(&bar[XB_TMO], 1u); break; } }
    }
    nloc = mine > 0u ? mine : 1u; nx = cnt > 0u ? cnt : 1u;
}
__device__ __forceinline__ void xcd_barrier(const XcdBarrier& b) {
    asm volatile("s_waitcnt vmcnt(0)" ::: "memory");
    __syncthreads();
    if (threadIdx.x == 0) {
        unsigned* bar = b.bar;
        __builtin_amdgcn_s_waitcnt(0);
        unsigned nloc = b.st[0], nx = b.st[1];
        if (nloc == 0u) { xcd_barrier_complete(bar, b.x, nloc, nx); b.st[0] = nloc; b.st[1] = nx; }
        const unsigned old = xb_add(&bar[XB_XSUB(b.x)], 1u);
        const unsigned gen = old / nloc;
        if (old + 1u == (gen + 1u) * nloc) {
            __builtin_amdgcn_fence(__ATOMIC_RELEASE, "agent");
            asm volatile("s_waitcnt vmcnt(0)" ::: "memory");
            const unsigned og = xb_add(&bar[XB_TOP], 1u);
            const unsigned tg = og / nx;
            if (og + 1u == (tg + 1u) * nx) xb_add(&bar[XB_TOPGEN], 1u);
            else XB_SPIN(xb_ld(&bar[XB_TOPGEN]) == tg, bar);
            __builtin_amdgcn_fence(__ATOMIC_ACQUIRE, "agent");
            xb_add(&bar[XB_XGEN(b.x)], 1u);
            asm volatile("s_waitcnt vmcnt(0)" ::: "memory");
        } else {
            XB_SPIN(xb_ld(&bar[XB_XGEN(b.x)]) == gen, bar);
            __builtin_amdgcn_fence(__ATOMIC_ACQUIRE, "agent");
            asm volatile("s_waitcnt vmcnt(0)" ::: "memory");
        }
    }
    __syncthreads();
}

struct Frame {
    LAS unsigned char* lds;
    volatile LAS unsigned* MISC;
    gu32* ctl;
    int tid, lane, wave, G, bid;
    const float* const* in;
    float* out;
    unsigned char* ws;
};
enum { I_XP = 0, I_XS, I_SH, I_SRGC, I_SCF, I_SPOOL, I_SSC, I_WIN, I_RGCW, I_RGCB, I_RGWA, I_RGBA, I_RGWX, I_RGBX, I_LAM, I_CFW, I_CFB, I_CFG, I_CFBB, I_POOLW, I_POOLS, I_SCW,
       I_WBR, I_WOUT, I_LN1G, I_LN1B, I_WG, I_WU, I_WD, I_LN2G, I_LN2B };

__device__ __forceinline__ float shfl_idx(float v, int src_lane) { return __builtin_bit_cast(float, __builtin_amdgcn_ds_bpermute(src_lane << 2, __builtin_bit_cast(int, v))); }
__device__ __forceinline__ float wave_sum(float v, int lane) {
#pragma unroll
    for (int o = 1; o < 64; o <<= 1) v += shfl_idx(v, lane ^ o);
    return v;
}

enum { RM_ID = 0, RM_WIN = 1, RM_GU = 2 };
template <int MODE> __device__ __forceinline__ int rowmap(int s, int extra) {
    if (MODE == RM_ID) return s;
    if (MODE == RM_GU) return 256 * (s >> 7) + (s & 127) + extra;
    if (s < 1024) return s;
    if (s < 2048) { const int j = ((s - 1024) >> 7) & 3; return 1024 + 256 * j + (s >= 1536 ? 128 : 0) + (s & 127); }
    if (s < 3072) return s;
    if (s < 4096) { const int j = ((s - 3072) >> 7) & 3; return 3072 + 256 * j + (s >= 3584 ? 128 : 0) + (s & 127); }
    const int g = (s - 4096) >> 10, ch = s & 1023, pn = ch >> 6, chl = ch & 63, wc = chl >> 4, fq = (chl >> 2) & 3, i = chl & 3;
    return 4096 + 256 * pn + 128 * (g >> 1) + 32 * wc + 8 * fq + 4 * (g & 1) + i;
}
template <int MODE>
__device__ __forceinline__ void transpose_item(const float* W, int K, int N, bf16* WT, int dst_ld, int dst_koff, int extra, LAS float* scr, int item, int lane) {
    const int nblk = N / 32, kb = item / nblk, nb = item % nblk, k0 = 64 * kb, n0 = 32 * nb;
#pragma unroll 8
    for (int i = 0; i < 32; ++i) { const int kk = 2 * i + (lane >> 5); scr[kk * 33 + (lane & 31)] = W[(size_t)(k0 + kk) * N + n0 + (lane & 31)]; }
    LDS_WAIT(); asm volatile("" ::: "memory");
    const int c = lane & 7;
#pragma unroll
    for (int j = 0; j < 4; ++j) { const int n = (lane >> 3) + 8 * j; const LAS float* s = scr + (8 * c) * 33 + n;
        v4u o; o.x = pk2(s[0 * 33], s[1 * 33]); o.y = pk2(s[2 * 33], s[3 * 33]); o.z = pk2(s[4 * 33], s[5 * 33]); o.w = pk2(s[6 * 33], s[7 * 33]);
        *(GAS v4u*)(WT + (size_t)rowmap<MODE>(n0 + n, extra) * dst_ld + dst_koff + k0 + 8 * c) = o; }
    LDS_WAIT(); asm volatile("" ::: "memory");
}
template <int MODE>
__device__ __forceinline__ void convert_matrix(Frame& F, const float* W, int K, int N, bf16* WT, int dst_ld, int dst_koff, int extra) {
    LAS float* scr = (LAS float*)(F.lds + RING_OFF + F.wave * 16384);
    const int gw = F.bid * NWAVES + F.wave, NGW = F.G * NWAVES, nitems = (K / 64) * (N / 32);
    for (int it = gw; it < nitems; it += NGW) transpose_item<MODE>(W, K, N, WT, dst_ld, dst_koff, extra, scr, it, F.lane);
}
__device__ __forceinline__ void compose_pool(Frame& F, int layer, bf16* Bt3) {
    const float* pw = F.in[I_POOLW] + (size_t)layer * 4 * 128 * 128; const float* ps = F.in[I_POOLS] + layer * 512; const float* Wb2 = F.in[I_WBR] + ((size_t)layer * 4 + 2) * 512 * 1024;
    const int gw = F.bid * NWAVES + F.wave, NGW = F.G * NWAVES;
    for (int id = gw; id < 512; id += NGW) {
        const int g = __builtin_amdgcn_readfirstlane(id >> 7), c0 = __builtin_amdgcn_readfirstlane(8 * ((id >> 3) & 15)), d0 = 128 * (id & 7) + 2 * F.lane;
        f32x2 acc[8];
#pragma unroll
        for (int i = 0; i < 8; ++i) acc[i] = (f32x2){0.f, 0.f};
        for (int e = 0; e < 128; ++e) {
            const f32x2 wv = *(const f32x2*)(Wb2 + (size_t)(128 * g + e) * 1024 + d0); const float sc = ps[128 * g + e];
#pragma unroll
            for (int i = 0; i < 8; ++i) { const float p = pw[((size_t)g * 128 + c0 + i) * 128 + e] * sc; acc[i] += wv * p; }
        }
        v4u o0, o1;
        o0.x = pk2(acc[0].x, acc[1].x); o0.y = pk2(acc[2].x, acc[3].x); o0.z = pk2(acc[4].x, acc[5].x); o0.w = pk2(acc[6].x, acc[7].x);
        o1.x = pk2(acc[0].y, acc[1].y); o1.y = pk2(acc[2].y, acc[3].y); o1.z = pk2(acc[4].y, acc[5].y); o1.w = pk2(acc[6].y, acc[7].y);
        *(GAS v4u*)(Bt3 + (size_t)d0 * 2048 + 1024 + 128 * g + c0) = o0; *(GAS v4u*)(Bt3 + (size_t)(d0 + 1) * 2048 + 1024 + 128 * g + c0) = o1;
    }
}

__device__ __forceinline__ const float* xrow_in(Frame& F, int m) { return m < MP ? F.in[I_XP] + (size_t)m * DM : F.in[I_XS] + (size_t)(m - MP) * DM; }
__device__ __forceinline__ void x_to_bf16(Frame& F, bf16* XB) {
    const int gw = F.bid * NWAVES + F.wave, NGW = F.G * NWAVES;
    for (int m = gw; m < M; m += NGW) { const GAS f32x4* xr = (const GAS f32x4*)xrow_in(F, m) + F.lane; GAS v2u* o = (GAS v2u*)(XB + (size_t)m * DM) + F.lane;
#pragma unroll
        for (int j = 0; j < 4; ++j) { const f32x4 v = xr[64 * j]; o[64 * j] = (v2u){pk2(v.x, v.y), pk2(v.z, v.w)}; } }
}
__device__ __forceinline__ void ln_rows(Frame& F, float* V, const float* g, const float* b, bf16* XB) {
    const int gw = F.bid * NWAVES + F.wave, NGW = F.G * NWAVES;
    f32x4 gv[4], bv[4];
#pragma unroll
    for (int j = 0; j < 4; ++j) { gv[j] = ((const GAS f32x4*)g)[F.lane + 64 * j]; bv[j] = ((const GAS f32x4*)b)[F.lane + 64 * j]; }
    for (int m = gw; m < M; m += NGW) {
        GAS f32x4* xr = (GAS f32x4*)(V + (size_t)m * DM) + F.lane;
        f32x4 v[4]; float s = 0.f;
#pragma unroll
        for (int j = 0; j < 4; ++j) { v[j] = xr[64 * j]; s += (v[j].x + v[j].y) + (v[j].z + v[j].w); }
        const float mean = wave_sum(s, F.lane) * (1.f / DM); float s2 = 0.f;
#pragma unroll
        for (int j = 0; j < 4; ++j) { v[j] = v[j] - mean; s2 += (v[j].x * v[j].x + v[j].y * v[j].y) + (v[j].z * v[j].z + v[j].w * v[j].w); }
        const float rstd = 1.f / sqrtf(wave_sum(s2, F.lane) * (1.f / DM) + LN_EPS);
#pragma unroll
        for (int j = 0; j < 4; ++j) { v[j] = v[j] * rstd * gv[j] + bv[j]; xr[64 * j] = v[j]; }
        if (XB) { GAS v2u* o = (GAS v2u*)(XB + (size_t)m * DM) + F.lane;
#pragma unroll
            for (int j = 0; j < 4; ++j) o[64 * j] = (v2u){pk2(v[j].x, v[j].y), pk2(v[j].z, v[j].w)}; }
    }
}

__device__ __forceinline__ float softplusf_acc(float x) { return fmaxf(x, 0.f) + log1pf(__expf(-fabsf(x))); }
__device__ __forceinline__ float expm1_neg(float x) {
    const float p = x * (1.f + x * (0.5f + x * (1.f / 6.f + x * (1.f / 24.f + x * (1.f / 120.f + x * (1.f / 720.f + x * (1.f / 5040.f)))))));
    return x > -0.25f ? p : __expf(x) - 1.f;
}
constexpr int PATCH_STRIDE = 144;

struct ALane {
    const LAS float* tab;
    float cwD[4], cbD, ba, bx, ck;
    bf16x8 Ba0, Ba1, Bx0, Bx1;
};
constexpr int ATAB_OFF = 36864, ATAB_BYTES = 1280;
__device__ __forceinline__ void a_setup(Frame& F, int layer, int n, int q, ALane& L) {
    const int c = F.lane & 15, kg = F.lane >> 4, och = 64 * n + 16 * q + c;
    const float* cw = F.in[I_RGCW] + (size_t)layer * 4 * 512; const float* cb = F.in[I_RGCB] + layer * 512;
    LAS float* tab = (LAS float*)(F.lds + RING_OFF + ATAB_OFF + F.wave * ATAB_BYTES);
#pragma unroll
    for (int k = 0; k < 5; ++k) { const int idx = F.lane + 64 * k, tg = idx / 80, rem = idx - 80 * tg, j = rem >> 4, e = rem & 15, ch = 64 * n + (e < 8 ? 8 * tg + e : 32 + 8 * tg + (e - 8));
        tab[idx] = j < 4 ? cw[j * 512 + ch] : cb[ch]; }
    L.tab = tab + 80 * kg;
#pragma unroll
    for (int j = 0; j < 4; ++j) L.cwD[j] = cw[j * 512 + och];
    L.cbD = cb[och]; L.ba = F.in[I_RGBA][layer * 512 + och]; L.bx = F.in[I_RGBX][layer * 512 + och];
    L.ck = 8.0f * softplusf_acc(-F.in[I_LAM][layer * 512 + och]);
    const float* wa = F.in[I_RGWA] + ((size_t)layer * 8 + n) * 4096 + 16 * q + c; const float* wx = F.in[I_RGWX] + ((size_t)layer * 8 + n) * 4096 + 16 * q + c;
    unsigned a0[4], a1[4], x0[4], x1[4];
#pragma unroll
    for (int w = 0; w < 4; ++w) {
        a0[w] = pk2(wa[(8 * kg + 2 * w) * 64], wa[(8 * kg + 2 * w + 1) * 64]); a1[w] = pk2(wa[(32 + 8 * kg + 2 * w) * 64], wa[(32 + 8 * kg + 2 * w + 1) * 64]);
        x0[w] = pk2(wx[(8 * kg + 2 * w) * 64], wx[(8 * kg + 2 * w + 1) * 64]); x1[w] = pk2(wx[(32 + 8 * kg + 2 * w) * 64], wx[(32 + 8 * kg + 2 * w + 1) * 64]); }
    L.Ba0 = __builtin_bit_cast(bf16x8, (v4u){a0[0], a0[1], a0[2], a0[3]}); L.Ba1 = __builtin_bit_cast(bf16x8, (v4u){a1[0], a1[1], a1[2], a1[3]});
    L.Bx0 = __builtin_bit_cast(bf16x8, (v4u){x0[0], x0[1], x0[2], x0[3]}); L.Bx1 = __builtin_bit_cast(bf16x8, (v4u){x1[0], x1[1], x1[2], x1[3]});
    LDS_WAIT(); asm volatile("" ::: "memory");
}
__device__ __forceinline__ void a_block(const ALane& L, const LAS unsigned char* patch, int rowA0, int baseD, int q, int lane, float (&a)[4], float (&bb)[4]) {
    const int c = lane & 15, kg = lane >> 4;
    float x[16];
    { const f32x4 b0 = *(const LAS f32x4*)(L.tab + 64), b1 = *(const LAS f32x4*)(L.tab + 68), b2 = *(const LAS f32x4*)(L.tab + 72), b3 = *(const LAS f32x4*)(L.tab + 76);
#pragma unroll
      for (int e = 0; e < 4; ++e) { x[e] = b0[e]; x[4 + e] = b1[e]; x[8 + e] = b2[e]; x[12 + e] = b3[e]; } }
#pragma unroll
    for (int j = 0; j < 4; ++j) { const LAS unsigned char* rp = patch + (rowA0 + j) * PATCH_STRIDE + 16 * kg;
        const v4u v0 = *(const LAS v4u*)rp, v1 = *(const LAS v4u*)(rp + 64);
        const f32x4 t0 = *(const LAS f32x4*)(L.tab + 16 * j), t1 = *(const LAS f32x4*)(L.tab + 16 * j + 4), t2 = *(const LAS f32x4*)(L.tab + 16 * j + 8), t3 = *(const LAS f32x4*)(L.tab + 16 * j + 12);
#pragma unroll
        for (int w = 0; w < 2; ++w) { x[2 * w] += t0[2 * w] * bflo(v0[w]); x[2 * w + 1] += t0[2 * w + 1] * bfhi(v0[w]);
                                      x[4 + 2 * w] += t1[2 * w] * bflo(v0[2 + w]); x[5 + 2 * w] += t1[2 * w + 1] * bfhi(v0[2 + w]);
                                      x[8 + 2 * w] += t2[2 * w] * bflo(v1[w]); x[9 + 2 * w] += t2[2 * w + 1] * bfhi(v1[w]);
                                      x[12 + 2 * w] += t3[2 * w] * bflo(v1[2 + w]); x[13 + 2 * w] += t3[2 * w + 1] * bfhi(v1[2 + w]); } }
    const bf16x8 A0 = __builtin_bit_cast(bf16x8, (v4u){pk2(x[0], x[1]), pk2(x[2], x[3]), pk2(x[4], x[5]), pk2(x[6], x[7])});
    const bf16x8 A1 = __builtin_bit_cast(bf16x8, (v4u){pk2(x[8], x[9]), pk2(x[10], x[11]), pk2(x[12], x[13]), pk2(x[14], x[15])});
    f32x4 accR = (f32x4){0.f, 0.f, 0.f, 0.f}, accI = (f32x4){0.f, 0.f, 0.f, 0.f};
    accR = __builtin_amdgcn_mfma_f32_16x16x32_bf16(A0, L.Ba0, accR, 0, 0, 0); accR = __builtin_amdgcn_mfma_f32_16x16x32_bf16(A1, L.Ba1, accR, 0, 0, 0);
    accI = __builtin_amdgcn_mfma_f32_16x16x32_bf16(A0, L.Bx0, accI, 0, 0, 0); accI = __builtin_amdgcn_mfma_f32_16x16x32_bf16(A1, L.Bx1, accI, 0, 0, 0);
    float pv[7];
#pragma unroll
    for (int k = 0; k < 7; ++k) pv[k] = bf1(*(const LAS unsigned short*)(patch + (baseD + k) * PATCH_STRIDE + 2 * (16 * q + c)));
#pragma unroll
    for (int r = 0; r < 4; ++r) {
        const float xd = L.cbD + L.cwD[0] * pv[r] + L.cwD[1] * pv[r + 1] + L.cwD[2] * pv[r + 2] + L.cwD[3] * pv[r + 3];
        const float rr = pg8::sigmoidf_fast(accR[r] + L.ba), ii = pg8::sigmoidf_fast(accI[r] + L.bx);
        const float la = -L.ck * rr;
        a[r] = __expf(la); bb[r] = sqrtf(fmaxf(-expm1_neg(2.f * la), 0.f)) * (ii * xd);
    }
}
__device__ __forceinline__ void a_prompt_item(Frame& F, int layer, int item, const bf16* Z, bf16* Y) {
    const int b = item >> 5, n = (item >> 2) & 7, q = item & 3, lane = opqv(F.lane), w = F.wave, c = lane & 15, g = lane >> 4, och = 64 * n + 16 * q + c;
    ALane L; a_setup(F, layer, n, q, L);
    LAS unsigned char* patch = F.lds + RING_OFF + w * 4096;
    LAS f32x2* slots = (LAS f32x2*)(F.lds + RING_OFF + 32768);
    const bf16* Zb = Z + (size_t)b * SEQ * ZC;
    float hrun = 0.f;
    v4u pf[3];
    auto load_patch = [&](int tb) {
#pragma unroll
        for (int k = 0; k < 3; ++k) { const int ci = lane + 64 * k, pr = ci >> 3, cc = ci & 7, t = tb - 3 + pr;
            pf[k] = (ci < 152 && t >= 0) ? *(const GAS v4u*)(Zb + (size_t)t * ZC + 64 * n + 8 * cc) : (v4u){0u, 0u, 0u, 0u}; }
    };
    load_patch(16 * w);
    for (int it = 0; it < 16; ++it) {
        const int tb = 128 * it + 16 * w;
#pragma unroll
        for (int k = 0; k < 3; ++k) { const int ci = lane + 64 * k, pr = ci >> 3, cc = ci & 7; if (ci < 152) *(LAS v4u*)(patch + pr * PATCH_STRIDE + 16 * cc) = pf[k]; }
        if (it < 15) load_patch(tb + 128);
        unsigned short gav[4];
#pragma unroll
        for (int r = 0; r < 4; ++r) gav[r] = *(const GAS unsigned short*)(Zb + (size_t)(tb + 4 * g + r) * ZC + 512 + och);
        asm volatile("" ::: "memory");
        float a[4], bb[4];
        a_block(L, patch, lane & 15, 4 * g, q, lane, a, bb);
        float Ac[4], Bc[4]; Ac[0] = a[0]; Bc[0] = bb[0];
#pragma unroll
        for (int r = 1; r < 4; ++r) { Ac[r] = a[r] * Ac[r - 1]; Bc[r] = a[r] * Bc[r - 1] + bb[r]; }
        float IA = Ac[3], IB = Bc[3];
        { const float pa = shfl_idx(IA, lane - 16), pb = shfl_idx(IB, lane - 16); if (g >= 1) { IB = IA * pb + IB; IA = IA * pa; } }
        { const float pa = shfl_idx(IA, lane - 32), pb = shfl_idx(IB, lane - 32); if (g >= 2) { IB = IA * pb + IB; IA = IA * pa; } }
        float EA = shfl_idx(IA, lane - 16), EB = shfl_idx(IB, lane - 16); if (g == 0) { EA = 1.f; EB = 0.f; }
        const float WA = shfl_idx(IA, 48 + c), WB = shfl_idx(IB, 48 + c);
        if (lane < 16) slots[((it & 1) * 8 + w) * 16 + c] = (f32x2){WA, WB};
        __syncthreads();
        float hin = hrun, hw = 0.f;
#pragma unroll
        for (int ww = 0; ww < 8; ++ww) { const f32x2 s = slots[((it & 1) * 8 + ww) * 16 + c]; if (ww == w) hw = hin; hin = s.x * hin + s.y; }
        hrun = hin;
        const float hg = EA * hw + EB;
#pragma unroll
        for (int r = 0; r < 4; ++r) { const float h = Ac[r] * hg + Bc[r];
            *(GAS unsigned short*)(Y + (size_t)(b * SEQ + tb + 4 * g + r) * YC + och) = f2bf(h * bf1(gav[r]));
            if (r == 3 && it == 15 && w == 7 && g == 3) F.out[O_PH + (size_t)(layer * 8 + b) * 512 + och] = h; }
    }
}
__device__ __forceinline__ void a_sample_task(Frame& F, int layer, int task, const bf16* Z, bf16* Y) {
    const int blk = task >> 5, n = (task >> 2) & 7, q = task & 3, lane = opqv(F.lane), c = lane & 15, g = lane >> 4, och = 64 * n + 16 * q + c, s0 = 4 * blk;
    ALane L; a_setup(F, layer, n, q, L);
    LAS unsigned char* patch = F.lds + RING_OFF + F.wave * 4096;
#pragma unroll
    for (int k = 0; k < 4; ++k) { const int ci = lane + 64 * k; if (ci < 224) { const int pr = ci >> 3, cc = ci & 7, sq = pr / 7, tau = pr - 7 * sq - 3, seq = s0 + sq; v4u v;
            if (tau < 0) { const GAS f32x4* sp = (const GAS f32x4*)(F.in[I_SRGC] + ((size_t)(layer * 128 + seq) * 3 + (tau + 3)) * 512 + 64 * n + 8 * cc); const f32x4 f0 = sp[0], f1 = sp[1];
                v = (v4u){pk2(f0.x, f0.y), pk2(f0.z, f0.w), pk2(f1.x, f1.y), pk2(f1.z, f1.w)}; }
            else v = *(const GAS v4u*)(Z + (size_t)(MP + 4 * seq + tau) * ZC + 64 * n + 8 * cc);
            *(LAS v4u*)(patch + pr * PATCH_STRIDE + 16 * cc) = v; } }
    asm volatile("" ::: "memory");
    float a[4], bb[4];
    a_block(L, patch, 7 * ((lane & 15) >> 2) + (lane & 3), 7 * g, q, lane, a, bb);
    const int seq = s0 + g;
    float h = F.in[I_SH][(size_t)(layer * 128 + seq) * 512 + och];
#pragma unroll
    for (int r = 0; r < 4; ++r) { h = a[r] * h + bb[r]; const size_t row = (size_t)(MP + 4 * seq + r);
        *(GAS unsigned short*)(Y + row * YC + och) = f2bf(h * bf1(*(const GAS unsigned short*)(Z + row * ZC + 512 + och))); }
    F.out[O_SH + (size_t)(layer * 128 + seq) * 512 + och] = h;
}

__device__ __forceinline__ void ln_silu_row(const LAS float* xr, const float* g, const float* b, bf16* dst, int lane) {
    const f32x4 v0 = *(const LAS f32x4*)(xr + 4 * lane), v1 = *(const LAS f32x4*)(xr + 256 + 4 * lane);
    const float s = (v0.x + v0.y) + (v0.z + v0.w) + (v1.x + v1.y) + (v1.z + v1.w);
    const float mean = wave_sum(s, lane) * (1.f / 512.f);
    const f32x4 d0 = v0 - mean, d1 = v1 - mean;
    const float s2 = (d0.x * d0.x + d0.y * d0.y) + (d0.z * d0.z + d0.w * d0.w) + (d1.x * d1.x + d1.y * d1.y) + (d1.z * d1.z + d1.w * d1.w);
    const float rstd = 1.f / sqrtf(wave_sum(s2, lane) * (1.f / 512.f) + LN_EPS);
    const f32x4 g0 = *(const GAS f32x4*)(g + 4 * lane), g1 = *(const GAS f32x4*)(g + 256 + 4 * lane), b0 = *(const GAS f32x4*)(b + 4 * lane), b1 = *(const GAS f32x4*)(b + 256 + 4 * lane);
    f32x4 y0 = d0 * rstd * g0 + b0, y1 = d1 * rstd * g1 + b1;
#pragma unroll
    for (int i = 0; i < 4; ++i) { y0[i] = y0[i] * pg8::sigmoidf_fast(y0[i]); y1[i] = y1[i] * pg8::sigmoidf_fast(y1[i]); }
    *(GAS v2u*)(dst + 4 * lane) = (v2u){pk2(y0.x, y0.y), pk2(y0.z, y0.w)}; *(GAS v2u*)(dst + 256 + 4 * lane) = (v2u){pk2(y1.x, y1.y), pk2(y1.z, y1.w)};
}
__device__ __forceinline__ void b_prompt_item(Frame& F, int layer, int item, const bf16* Z, bf16* Y) {
    const int tidl = opqv(F.tid), b = item >> 5, t0 = 64 * (item & 31), p = tidl & 255, hh = tidl >> 8, ts = t0 + 32 * hh;
    const GAS unsigned* Zu = (const GAS unsigned*)(Z + (size_t)b * SEQ * ZC) + 512 + p;
    unsigned raw[62];
#pragma unroll
    for (int i = 0; i < 62; ++i) { const int t = ts - 30 + i; raw[i] = t >= 0 ? Zu[(size_t)t * (ZC / 2)] : 0u; }
    const float* cw = F.in[I_CFW] + (size_t)layer * 31 * 512 + 2 * p;
    f32x2 wj[31];
#pragma unroll
    for (int j = 0; j < 31; ++j) wj[j] = *(const GAS f32x2*)(cw + j * 512);
    const f32x2 bias = *(const GAS f32x2*)(F.in[I_CFB] + layer * 512 + 2 * p);
    f32x2 in[62];
#pragma unroll
    for (int i = 0; i < 62; ++i) in[i] = (f32x2){bflo(raw[i]), bfhi(raw[i])};
    LAS float* obuf = (LAS float*)(F.lds + RING_OFF);
#pragma unroll
    for (int i = 0; i < 32; ++i) { f32x2 o = bias;
#pragma unroll
        for (int j = 0; j < 31; ++j) o += wj[j] * in[i + j];
        *(LAS f32x2*)(obuf + (32 * hh + i) * 512 + 2 * p) = o; }
    __syncthreads();
    const float* lg = F.in[I_CFG] + layer * 512; const float* lb = F.in[I_CFBB] + layer * 512;
#pragma unroll 1
    for (int r = F.wave; r < 64; r += 8) ln_silu_row(obuf + r * 512, lg, lb, Y + (size_t)(b * SEQ + t0 + r) * YC + 512, F.lane);
}
__device__ __forceinline__ void cd_prompt_item(Frame& F, int layer, int item, const bf16* Z, bf16* Y) {
    const int tidl = opqv(F.tid), b = item >> 5, t0 = 64 * (item & 31), p = tidl & 255, hh = tidl >> 8;
    const bf16* Zb = Z + (size_t)b * SEQ * ZC;
    LAS unsigned* cbuf = (LAS unsigned*)(F.lds + RING_OFF);
    for (int ci = tidl; ci < 79 * 64; ci += 512) { const int pr = ci >> 6, cc = ci & 63, t = t0 - 15 + pr;
        const v4u v = t >= 0 ? *(const GAS v4u*)(Zb + (size_t)t * ZC + 1536 + 8 * cc) : (v4u){0u, 0u, 0u, 0u};
        *(LAS v4u*)(cbuf + pr * 256 + 4 * cc) = v; }
    __syncthreads();
    const int w = 2 << (p >> 6);
    const f32x2 w0 = *(const GAS f32x2*)(F.in[I_SCW] + (size_t)(layer * 3 + 0) * 512 + 2 * p), w1 = *(const GAS f32x2*)(F.in[I_SCW] + (size_t)(layer * 3 + 1) * 512 + 2 * p),
                w2 = *(const GAS f32x2*)(F.in[I_SCW] + (size_t)(layer * 3 + 2) * 512 + 2 * p);
    const GAS unsigned* Zu = (const GAS unsigned*)Zb + p;
    GAS unsigned* Yu = (GAS unsigned*)(Y + (size_t)b * SEQ * YC) + p;
    const int ts = t0 + 32 * hh;
    unsigned um2 = ts >= 2 ? Zu[(size_t)(ts - 2) * 1536 + 1280] : 0u, um1 = ts >= 1 ? Zu[(size_t)(ts - 1) * 1536 + 1280] : 0u;
#pragma unroll 4
    for (int i = 0; i < 32; ++i) { const int t = ts + i, rr = 15 + 32 * hh + i;
        f32x2 s = (f32x2){0.f, 0.f};
        for (int j = 0; j < w; ++j) { const unsigned v = cbuf[(rr - j) * 256 + p]; s += (f32x2){bflo(v), bfhi(v)}; }
        const unsigned cur = cbuf[rr * 256 + p]; const float cnt = (float)(t + 1 < w ? t + 1 : w);
        const f32x2 mm = s / cnt - (f32x2){bflo(cur), bfhi(cur)};
        Yu[(size_t)t * 1024 + 512] = pk2(mm.x, mm.y);
        const unsigned u0 = Zu[(size_t)t * 1536 + 1280], db = Zu[(size_t)t * 1536 + 1024];
        const f32x2 cv = w0 * (f32x2){bflo(um2), bfhi(um2)} + w1 * (f32x2){bflo(um1), bfhi(um1)} + w2 * (f32x2){bflo(u0), bfhi(u0)};
        const f32x2 yd = (f32x2){bflo(db), bfhi(db)} * cv;
        Yu[(size_t)t * 1024 + 768] = pk2(yd.x, yd.y);
        um2 = um1; um1 = u0; }
}
__device__ __forceinline__ void s_sample_item(Frame& F, int layer, int s, const bf16* Z, bf16* Y) {
    const int ch = opqv(F.tid); const size_t ls = (size_t)layer * 128 + s;
    const bf16* Zr = Z + (size_t)(MP + 4 * s) * ZC + ch; bf16* Yr = Y + (size_t)(MP + 4 * s) * YC + ch;
    LAS float* obuf = (LAS float*)(F.lds + RING_OFF);
    {
        const float* sp = F.in[I_SCF] + ls * 30 * 512 + ch; float* op = F.out + O_SCF + ls * 30 * 512 + ch; const float* wp = F.in[I_CFW] + (size_t)layer * 31 * 512 + ch;
        float x0 = sp[0], x1 = sp[512], x2 = sp[1024], x3 = sp[1536];
        const float bias = F.in[I_CFB][layer * 512 + ch]; float o0 = bias, o1 = bias, o2 = bias, o3 = bias;
#pragma unroll 2
        for (int j = 0; j < 31; ++j) { const float wv = wp[(size_t)j * 512];
            o0 += wv * x0; o1 += wv * x1; o2 += wv * x2; o3 += wv * x3;
            const int k = j + 4; float nx = 0.f;
            if (k < 30) { nx = sp[(size_t)k * 512]; op[(size_t)(k - 4) * 512] = nx; }
            else if (k < 34) nx = bf1(Zr[(size_t)(k - 30) * ZC + 1024]);
            x0 = x1; x1 = x2; x2 = x3; x3 = nx; }
        obuf[ch] = o0; obuf[512 + ch] = o1; obuf[1024 + ch] = o2; obuf[1536 + ch] = o3;
    }
    {
        const float* sp = F.in[I_SPOOL] + ls * 15 * 512 + ch; float* op = F.out + O_SPOOL + ls * 15 * 512 + ch;
        const int w = 2 << (ch >> 7); const float iw = 1.f / (float)w;
        float acc[4] = {0.f, 0.f, 0.f, 0.f}, tok[4] = {0.f, 0.f, 0.f, 0.f};
#pragma unroll 2
        for (int k = 0; k < 19; ++k) { float v;
            if (k < 15) { v = sp[(size_t)k * 512]; if (k >= 4) op[(size_t)(k - 4) * 512] = v; } else v = bf1(Zr[(size_t)(k - 15) * ZC + 1536]);
#pragma unroll
            for (int r = 0; r < 4; ++r) { if (k <= 15 + r && k > 15 + r - w) acc[r] += v; if (k == 15 + r) tok[r] = v; } }
#pragma unroll
        for (int r = 0; r < 4; ++r) Yr[(size_t)r * YC + 1024] = f2bf(acc[r] * iw - tok[r]);
    }
    {
        float u[6];
        u[0] = F.in[I_SSC][(ls * 2 + 0) * 512 + ch]; u[1] = F.in[I_SSC][(ls * 2 + 1) * 512 + ch];
#pragma unroll
        for (int r = 0; r < 4; ++r) u[2 + r] = bf1(Zr[(size_t)r * ZC + 2560]);
        const float w0 = F.in[I_SCW][(size_t)(layer * 3 + 0) * 512 + ch], w1 = F.in[I_SCW][(size_t)(layer * 3 + 1) * 512 + ch], w2 = F.in[I_SCW][(size_t)(layer * 3 + 2) * 512 + ch];
#pragma unroll
        for (int r = 0; r < 4; ++r) Yr[(size_t)r * YC + 1536] = f2bf(bf1(Zr[(size_t)r * ZC + 2048]) * (w0 * u[r] + w1 * u[r + 1] + w2 * u[r + 2]));
    }
    __syncthreads();
    if (F.wave < 4) ln_silu_row(obuf + F.wave * 512, F.in[I_CFG] + layer * 512, F.in[I_CFBB] + layer * 512, Y + (size_t)(MP + 4 * s + F.wave) * YC + 512, F.lane);
}

struct Args { const float* in[31]; float* out; unsigned char* ws; int ph_lo, ph_hi; };
__global__ void __launch_bounds__(NWAVES * 64, 2) hybrid_fwd(Args args) {
    extern __shared__ __attribute__((aligned(16))) unsigned char lds[];
    Frame F;
    F.lds = (LAS unsigned char*)lds;
    F.MISC = (volatile LAS unsigned*)(F.lds + MISC_OFF);
    const int wave0 = __builtin_amdgcn_readfirstlane((int)threadIdx.x >> 6);
    F.lane = lane_now(); F.wave = wave0; F.tid = F.wave * 64 + F.lane;
    F.G = gridDim.x; F.bid = blockIdx.x;
    F.ws = args.ws; F.out = args.out; F.ctl = (gu32*)(args.ws + WS_CTL);
    F.in = args.in;
    for (int u = F.tid; u < (LDS_BYTES - LDSCTL_OFF) / 4; u += NWAVES * 64) ((LAS unsigned*)(F.lds + LDSCTL_OFF))[u] = 0u;
    __syncthreads();
    XcdBarrier bar; bar.bar = (unsigned*)(F.ctl + CW_BAR); bar.x = 0; bar.st = nullptr;
    if (!MK_SPLIT) bar = xcd_barrier_post((unsigned*)(F.ctl + CW_BAR), F.MISC + 8);
    const int lo = args.ph_lo, hi = args.ph_hi;
#define IN(k) (lo <= (k) && (k) < hi)
#define REFRESH() do { F.lane = lane_now(); F.wave = opqs(wave0); F.tid = F.wave * 64 + F.lane; F.bid = opqs((int)blockIdx.x); } while (0)
#define SEAM(k) do { if (IN(k) && IN((k) + 1)) xcd_barrier(bar); } while (0)
    bf16* WA = (bf16*)(F.ws + WS_WA); bf16* XB = (bf16*)(F.ws + WS_XB); bf16* Y = (bf16*)(F.ws + WS_Y); bf16* Zm = (bf16*)(F.ws + WS_ZG); _Float16* Gb = (_Float16*)(F.ws + WS_ZG);
    bf16* Hb = (bf16*)(F.ws + WS_ZG); bf16* Bt3 = (bf16*)(F.ws + WS_BT3); bf16* Bt4 = (bf16*)(F.ws + WS_BT4); bf16* Bt5 = (bf16*)(F.ws + WS_BT5); bf16* Bt6 = (bf16*)(F.ws + WS_BT6);

    if (IN(0)) { REFRESH(); convert_matrix<RM_WIN>(F, F.in[I_WIN], DM, INC, WA, DM, 0, 0); REFRESH(); x_to_bf16(F, XB); }
    SEAM(0);

    for (int l = 0; l < 2; ++l) {
        const int pb = 1 + 9 * l;
        if (IN(pb + 0)) { pg8::Gemm g{XB, WA, M, 4096, DM}; pg8::StaticOrder S; S.init(M, 4096, F.G, F.bid); pg8::EpiMix E{Zm, F.out, l};
            pg8::gemm_phase<pg8::EpiMix, pg8::StaticOrder, true>(F.lds + RING_OFF, g, S, E, wave0); }
        SEAM(pb + 0);
        if (IN(pb + 1)) {
            __syncthreads(); REFRESH();
            for (int it = F.bid; it < 256; it += F.G) { a_prompt_item(F, l, it, Zm, Y); __syncthreads(); }
            REFRESH();
            for (int it = F.bid; it < 128; it += F.G) a_sample_task(F, l, 8 * it + F.wave, Zm, Y);
            __syncthreads(); REFRESH();
            for (int it = F.bid; it < 256; it += F.G) { b_prompt_item(F, l, it, Zm, Y); __syncthreads(); }
            REFRESH();
            for (int it = F.bid; it < 256; it += F.G) { cd_prompt_item(F, l, it, Zm, Y); __syncthreads(); }
            REFRESH();
            for (int it = F.bid; it < 128; it += F.G) { s_sample_item(F, l, it, Zm, Y); __syncthreads(); }
            REFRESH();
            const float* wbr = F.in[I_WBR] + (size_t)l * 4 * 512 * 1024;
            convert_matrix<RM_ID>(F, wbr, 512, 1024, Bt3, 2048, 0, 0);
            convert_matrix<RM_ID>(F, wbr + (size_t)512 * 1024, 512, 1024, Bt3, 2048, 512, 0);
            convert_matrix<RM_ID>(F, wbr + (size_t)3 * 512 * 1024, 512, 1024, Bt3, 2048, 1536, 0);
            REFRESH(); compose_pool(F, l, Bt3); REFRESH();
            convert_matrix<RM_ID>(F, F.in[I_WOUT] + (size_t)l * DM * DM, DM, DM, Bt4, DM, 0, 0);
        }
        SEAM(pb + 1);
        if (IN(pb + 2)) { pg8::Gemm g{XB, WA + (size_t)4096 * DM, M, 4096, DM}; pg8::StaticOrder S; S.init(M, 4096, F.G, F.bid); pg8::EpiGate E{Gb};
            pg8::gemm_phase<pg8::EpiGate, pg8::StaticOrder, true>(F.lds + RING_OFF, g, S, E, wave0); }
        SEAM(pb + 2);
        if (IN(pb + 3)) { pg8::Gemm g{Y, Bt3, M, DM, 2048}; pg8::StaticOrder S; S.init(M, DM, F.G, F.bid); pg8::EpiMerge E{Gb, XB};
            pg8::gemm_phase<pg8::EpiMerge, pg8::StaticOrder, true>(F.lds + RING_OFF, g, S, E, wave0); }
        SEAM(pb + 3);
        if (IN(pb + 4)) { pg8::Gemm g{XB, Bt4, M, DM, DM}; pg8::StaticOrder S; S.init(M, DM, F.G, F.bid);
            pg8::EpiRes E{l == 0 ? F.in[I_XP] : F.out, l == 0 ? F.in[I_XS] : F.out + (size_t)MP * DM, F.out};
            pg8::gemm_phase<pg8::EpiRes, pg8::StaticOrder, true>(F.lds + RING_OFF, g, S, E, wave0); }
        SEAM(pb + 4);
        if (IN(pb + 5)) {
            REFRESH();
            ln_rows(F, F.out, F.in[I_LN1G] + l * DM, F.in[I_LN1B] + l * DM, XB);
            REFRESH();
            convert_matrix<RM_GU>(F, F.in[I_WG] + (size_t)l * DM * FF, DM, FF, Bt5, DM, 0, 0);
            convert_matrix<RM_GU>(F, F.in[I_WU] + (size_t)l * DM * FF, DM, FF, Bt5, DM, 0, 128);
            convert_matrix<RM_ID>(F, F.in[I_WD] + (size_t)l * FF * DM, FF, DM, Bt6, FF, 0, 0);
        }
        SEAM(pb + 5);
        if (IN(pb + 6)) { pg8::Gemm g{XB, Bt5, M, 2 * FF, DM}; pg8::StaticOrder S; S.init(M, 2 * FF, F.G, F.bid); pg8::EpiSwi E{Hb};
            pg8::gemm_phase<pg8::EpiSwi, pg8::StaticOrder, true>(F.lds + RING_OFF, g, S, E, wave0); }
        SEAM(pb + 6);
        if (IN(pb + 7)) { pg8::Gemm g{Hb, Bt6, M, DM, FF}; pg8::StaticOrder S; S.init(M, DM, F.G, F.bid); pg8::EpiRes E{F.out, F.out + (size_t)MP * DM, F.out};
            pg8::gemm_phase<pg8::EpiRes, pg8::StaticOrder, true>(F.lds + RING_OFF, g, S, E, wave0); }
        SEAM(pb + 7);
        if (IN(pb + 8)) {
            REFRESH();
            ln_rows(F, F.out, F.in[I_LN2G] + l * DM, F.in[I_LN2B] + l * DM, l == 0 ? XB : nullptr);
            REFRESH();
            if (l == 0) convert_matrix<RM_WIN>(F, F.in[I_WIN] + (size_t)DM * INC, DM, INC, WA, DM, 0, 0);
        }
        if (l == 0) SEAM(pb + 8);
    }
#undef IN
#undef SEAM
#undef REFRESH
}

extern "C" void kernel_launch(void* const* d_in, const int* in_sizes, int n_in, void* d_out, int out_size, void* d_ws, size_t ws_size, hipStream_t stream) {
    static int grid = 0;
    if (grid == 0) {
        if (n_in != 31 || out_size != (int)O_END || ws_size < WS_END) { fprintf(stderr, "kernel_launch: unexpected sizes n_in %d out %d ws %zu\n", n_in, out_size, ws_size); grid = -1; return; }
        int dev = 0, cus = 0, per_cu = 0;
        if (hipGetDevice(&dev) != hipSuccess || hipDeviceGetAttribute(&cus, hipDeviceAttributeMultiprocessorCount, dev) != hipSuccess) { grid = -1; return; }
        if (hipFuncSetAttribute((const void*)hybrid_fwd, hipFuncAttributeMaxDynamicSharedMemorySize, LDS_BYTES) != hipSuccess) { fprintf(stderr, "kernel_launch: hipFuncSetAttribute failed\n"); grid = -1; return; }
        if (hipOccupancyMaxActiveBlocksPerMultiprocessor(&per_cu, (const void*)hybrid_fwd, NWAVES * 64, LDS_BYTES) != hipSuccess || per_cu < 1)
            fprintf(stderr, "kernel_launch: occupancy query reports %d workgroups per CU\n", per_cu);
        (void)hipGetLastError();
        grid = cus;
    }
    if (grid < 0) return;
    if (hipMemsetAsync((char*)d_ws + WS_CTL, 0, CTL_ZERO_BYTES, stream) != hipSuccess) { fprintf(stderr, "kernel_launch: memset failed\n"); return; }
    Args a{};
    for (int i = 0; i < 31; ++i) a.in[i] = (const float*)d_in[i];
    a.out = (float*)d_out; a.ws = (unsigned char*)d_ws;
#if MK_SPLIT
    for (int ph = 0; ph < NPHASE; ++ph) { a.ph_lo = ph; a.ph_hi = ph + 1; hipLaunchKernelGGL(hybrid_fwd, dim3(grid), dim3(NWAVES * 64), LDS_BYTES, stream, a); }
#else
    a.ph_lo = 0; a.ph_hi = NPHASE;
    hipLaunchKernelGGL(hybrid_fwd, dim3(grid), dim3(NWAVES * 64), LDS_BYTES, stream, a);
#endif
}
```

```cpp
#include <hip/hip_runtime.h>
#include <cstdio>
#include <cstdint>

#ifndef PROBE_REP
#define PROBE_REP 0
#endif
#define NREP(k) (1 + ((PROBE_REP >> (k)) & 1))
#ifndef PROBE2
#define PROBE2 0
#endif
#define NREP2(j) (1 + ((PROBE2 >> (j)) & 1))
#ifndef MK_SPLIT
#define MK_SPLIT 0
#endif

constexpr int DM = 1024, WMIX = 512, NPB = 8, SEQ = 2048, NSB = 128, DSEQ = 4;
constexpr int MP = NPB * SEQ, MS = NSB * DSEQ, M = MP + MS;
constexpr int FF = 2816, INC = 8192, ZC = 3072, YC = 2048, GC = 4096;
constexpr float LN_EPS = 1e-5f, ALPHA = 1.41421356237f;
constexpr size_t O_Y = 0, O_PH = (size_t)M * DM, O_PRGC = O_PH + 8192, O_PCF = O_PRGC + 24576, O_PPOOL = O_PCF + 245760, O_PSC = O_PPOOL + 122880,
                 O_SH = O_PSC + 16384, O_SRGC = O_SH + 131072, O_SCF = O_SRGC + 393216, O_SPOOL = O_SCF + 3932160, O_SSC = O_SPOOL + 1966080, O_END = O_SSC + 262144;
static_assert(O_END == 24403968, "output map");

__device__ __forceinline__ int opqv(int v) { asm volatile("" : "+v"(v)); return v; }
__device__ __forceinline__ int lane_now() { int l; asm volatile("v_mbcnt_lo_u32_b32 %0, -1, 0\n\tv_mbcnt_hi_u32_b32 %0, -1, %0" : "=v"(l)); return l; }
__device__ __forceinline__ int opqs(int v) { asm volatile("" : "+s"(v)); return v; }
namespace pg8 {
#define PG8_LAS __attribute__((address_space(3)))
typedef unsigned short bf16_t;
typedef short bf16x8 __attribute__((ext_vector_type(8)));
typedef float f32x4 __attribute__((ext_vector_type(4)));
typedef float f32x2 __attribute__((ext_vector_type(2)));
typedef unsigned u32x4 __attribute__((ext_vector_type(4)));
typedef unsigned u32x2 __attribute__((ext_vector_type(2)));
typedef _Float16 f16x4 __attribute__((ext_vector_type(4)));
typedef _Float16 f16x8 __attribute__((ext_vector_type(8)));
constexpr int BM = 256, BK = 64, HALF = 128, HTB = HALF * BK * 2, STAGE_BYTES = 8 * HTB, NXCD = 8, WGM = 8;

__host__ __device__ __forceinline__ int lds_byte(int r, int c) { const int st = (r >> 4) * 2 + (c >> 5), rr = r & 15, cc = c & 31, ob = rr * 64 + cc * 2; return st * 1024 + (ob ^ (((ob >> 9) & 1) << 5)); }
__host__ __device__ __forceinline__ void stage_rc(int b, int& R, int& C) { const int st = b / 1024, sb = b % 1024, swz = sb ^ (((sb >> 9) & 1) << 5); R = (st >> 1) * 16 + swz / 64; C = (st & 1) * 32 + (swz % 64) / 2; }
__host__ __device__ __forceinline__ int perm32(int rho) { const int n = rho >> 4, i = rho & 15; return 8 * (i >> 2) + 4 * n + (i & 3); }

struct Unit { int pm, pn; };
struct Gemm { const bf16_t* A; const bf16_t* Bt; int M, N, K; };

struct StaticOrder {
    int nM, nN, nwg, G, c;
    __host__ __device__ void init(int M_, int N_, int G_, int c_) { nM = M_ / BM; nN = N_ / BM; nwg = nM * nN; G = G_; c = c_; }
    __host__ __device__ bool next(int i, Unit& u) const {
        const long L = (long)i * G + c; if (L >= nwg) return false;
        int wgid = (int)L; { const int q = nwg / NXCD, r = nwg % NXCD, xcd = wgid % NXCD, off = wgid / NXCD; wgid = (xcd < r ? xcd * (q + 1) : r * (q + 1) + (xcd - r) * q) + off; }
        const int nig = WGM * nN, gid = wgid / nig, fm = gid * WGM, gsz = (nM - fm) < WGM ? (nM - fm) : WGM;
        u.pm = fm + ((wgid % nig) % gsz); u.pn = (wgid % nig) / gsz; return true;
    }
};

__device__ __forceinline__ unsigned cvt_pk_bf16(float lo, float hi) { unsigned r; asm volatile("v_cvt_pk_bf16_f32 %0, %1, %2" : "=v"(r) : "v"(lo), "v"(hi)); return r; }
__device__ __forceinline__ float sigmoidf_fast(float x) { return __builtin_amdgcn_rcpf(1.0f + __builtin_amdgcn_exp2f(-1.44269504089f * x)); }
__device__ __forceinline__ float gelu_tanh(float x) { const float y = 1.5957691216057308f * (x + 0.044715f * x * x * x); return x * sigmoidf_fast(y); }

__device__ __forceinline__ float* state_ptr(float* out, int R, int keep, int layer, size_t p_off, size_t s_off) {
    if (R < MP) { const int b = R >> 11, j = (R & 2047) - (2048 - keep); return j < 0 ? nullptr : out + p_off + (size_t)((layer * 8 + b) * keep + j) * 512; }
    const int s = (R - MP) >> 2, j = (R & 3) + keep - 4; return j < 0 ? nullptr : out + s_off + (size_t)((layer * 128 + s) * keep + j) * 512;
}

struct EpiMix {
    static constexpr bool PERM = true, MIDK = false;
    bf16_t* Z; float* out; int layer;
    __device__ __forceinline__ void midk(f32x4 (&)[2][2][4][2], const Unit&, int, int, int, int, int) const {}
    __device__ __forceinline__ void operator()(f32x4 (&acc)[2][2][4][2], const Unit& u, int wr, int wc, int fr_, int fq_) const {
        const int lane_ = lane_now(), fr = lane_ & 15, fq = lane_ >> 4; (void)fr_; (void)fq_;
        const int pn = u.pn; int type, zcol, keep = 0, scol = 0; size_t poff = 0, soff = 0;
        if (pn < 2) { type = 0; zcol = 256 * pn; keep = 3; scol = zcol; poff = O_PRGC; soff = O_SRGC; }
        else if (pn < 4) { type = 1; zcol = 512 + 256 * (pn - 2); }
        else if (pn < 8) { type = 2; zcol = 1024 + 128 * (pn - 4); keep = 30; scol = 128 * (pn - 4); poff = O_PCF; soff = O_SCF; }
        else if (pn < 10) { type = 0; zcol = 1536 + 256 * (pn - 8); keep = 15; scol = 256 * (pn - 8); poff = O_PPOOL; soff = O_SPOOL; }
        else if (pn < 12) { type = 0; zcol = 2048 + 256 * (pn - 10); }
        else { type = 3; zcol = 2560 + 128 * (pn - 12); keep = 2; scol = 128 * (pn - 12); poff = O_PSC; soff = O_SSC; }
        const bool tail = keep != 0 && (u.pm >= 64 || (u.pm & 7) == 7);
        const int row0 = u.pm * BM + wr * 64 + fr, cl = wc * 32 + 8 * fq;
        if (type < 2) {
#pragma unroll
            for (int ai = 0; ai < 2; ++ai)
#pragma unroll
                for (int m = 0; m < 4; ++m) { const int R = row0 + ai * HALF + m * 16; bf16_t* rowp = Z + (size_t)R * ZC + zcol + cl;
                    float* sp = tail ? state_ptr(out, R, keep, layer, poff, soff) : nullptr;
#pragma unroll
                    for (int bj = 0; bj < 2; ++bj) { f32x4 v0 = acc[ai][bj][m][0], v1 = acc[ai][bj][m][1];
                        if (type == 1) { v0 = (f32x4){gelu_tanh(v0[0]), gelu_tanh(v0[1]), gelu_tanh(v0[2]), gelu_tanh(v0[3])}; v1 = (f32x4){gelu_tanh(v1[0]), gelu_tanh(v1[1]), gelu_tanh(v1[2]), gelu_tanh(v1[3])}; }
                        u32x4 w; w.x = cvt_pk_bf16(v0[0], v0[1]); w.y = cvt_pk_bf16(v0[2], v0[3]); w.z = cvt_pk_bf16(v1[0], v1[1]); w.w = cvt_pk_bf16(v1[2], v1[3]);
                        *(u32x4*)(rowp + bj * HALF) = w;
                        if (sp) { *(f32x4*)(sp + scol + cl + bj * HALF) = v0; *(f32x4*)(sp + scol + cl + bj * HALF + 4) = v1; } } }
        } else {
#pragma unroll
            for (int ai = 0; ai < 2; ++ai)
#pragma unroll
                for (int m = 0; m < 4; ++m) { const int R = row0 + ai * HALF + m * 16; bf16_t* rowp = Z + (size_t)R * ZC + zcol + cl;
                    float* sp = tail ? state_ptr(out, R, keep, layer, poff, soff) : nullptr;
                    f32x4 v0, v1; const f32x4 a0 = acc[ai][0][m][0], a1 = acc[ai][0][m][1], b0 = acc[ai][1][m][0], b1 = acc[ai][1][m][1];
                    if (type == 2) {
#pragma unroll
                        for (int i = 0; i < 4; ++i) { v0[i] = a0[i] * sigmoidf_fast(b0[i]); v1[i] = a1[i] * sigmoidf_fast(b1[i]); }
                    } else { v0 = a0 * b0; v1 = a1 * b1; }
                    u32x4 w; w.x = cvt_pk_bf16(v0[0], v0[1]); w.y = cvt_pk_bf16(v0[2], v0[3]); w.z = cvt_pk_bf16(v1[0], v1[1]); w.w = cvt_pk_bf16(v1[2], v1[3]);
                    *(u32x4*)rowp = w;
                    if (sp) { *(f32x4*)(sp + scol + cl) = v0; *(f32x4*)(sp + scol + cl + 4) = v1; } }
        }
    }
};

struct EpiGate {
    static constexpr bool PERM = true, MIDK = false;
    _Float16* G;
    __device__ __forceinline__ void midk(f32x4 (&)[2][2][4][2], const Unit&, int, int, int, int, int) const {}
    __device__ __forceinline__ void operator()(f32x4 (&acc)[2][2][4][2], const Unit& u, int wr, int wc, int fr_, int fq_) const {
        const int lane_ = lane_now(), fr = lane_ & 15, fq = lane_ >> 4; (void)fr_; (void)fq_;
        const int row0 = u.pm * BM + wr * 64 + fr, ch0 = 64 * u.pn + 16 * wc + 4 * fq;
#pragma unroll
        for (int ai = 0; ai < 2; ++ai)
#pragma unroll
            for (int m = 0; m < 4; ++m) { const int R = row0 + ai * HALF + m * 16; _Float16* gp = G + (size_t)R * GC + ch0;
                f16x4 r0, r1, r2, g3;
#pragma unroll
                for (int i = 0; i < 4; ++i) {
                    const float z0 = fminf(fmaxf(acc[ai][0][m][0][i], -40.f), 40.f), z1 = fminf(fmaxf(acc[ai][0][m][1][i], -40.f), 40.f);
                    const float z2 = fminf(fmaxf(acc[ai][1][m][0][i], -40.f), 40.f), z3 = fminf(fmaxf(acc[ai][1][m][1][i], -40.f), 40.f);
                    const float d0 = 1.f + __builtin_amdgcn_exp2f(-1.44269504089f * z0), d1 = 1.f + __builtin_amdgcn_exp2f(-1.44269504089f * z1);
                    const float d2 = 1.f + __builtin_amdgcn_exp2f(-1.44269504089f * z2), d3 = 1.f + __builtin_amdgcn_exp2f(-1.44269504089f * z3);
                    r0[i] = (_Float16)fminf(d1 * __builtin_amdgcn_rcpf(d0), 65504.f); r1[i] = (_Float16)fminf(d2 * __builtin_amdgcn_rcpf(d1), 65504.f);
                    r2[i] = (_Float16)fminf(d3 * __builtin_amdgcn_rcpf(d2), 65504.f); g3[i] = (_Float16)__builtin_amdgcn_rcpf(d3); }
                *(f16x4*)(gp) = r0; *(f16x4*)(gp + 1024) = r1; *(f16x4*)(gp + 2048) = r2; *(f16x4*)(gp + 3072) = g3; }
    }
};

struct EpiMerge {
    static constexpr bool PERM = false, MIDK = true;
    const _Float16* G; bf16_t* O;
    __device__ __forceinline__ void scale(f32x4 (&acc)[2][2][4][2], const Unit& u, int seg, int wr, int wc) const {
        const int lane_ = lane_now(), fr = lane_ & 15, fq = lane_ >> 4;
        const int row0 = u.pm * BM + wr * 64 + fr, c0 = 1024 * seg + 256 * u.pn + wc * 32 + 4 * fq;
#pragma unroll
        for (int ai = 0; ai < 2; ++ai)
#pragma unroll
            for (int m = 0; m < 4; ++m) { const _Float16* gp = G + (size_t)(row0 + ai * HALF + m * 16) * GC + c0;
#pragma unroll
                for (int bj = 0; bj < 2; ++bj)
#pragma unroll
                    for (int n = 0; n < 2; ++n) { const f16x4 f = *(const f16x4*)(gp + bj * HALF + n * 16);
                        acc[ai][bj][m][n] *= (f32x4){(float)f[0], (float)f[1], (float)f[2], (float)f[3]}; }
                if (m == 3) asm volatile("" ::: "memory"); }
    }
    __device__ __forceinline__ void midk(f32x4 (&acc)[2][2][4][2], const Unit& u, int seg, int wr, int wc, int, int) const { scale(acc, u, seg, wr, wc); }
    __device__ __forceinline__ void operator()(f32x4 (&acc)[2][2][4][2], const Unit& u, int wr, int wc, int, int) const {
        scale(acc, u, 3, wr, wc);
        const int lane_ = lane_now(), fr = lane_ & 15, fq = lane_ >> 4;
        const int row0 = u.pm * BM + wr * 64 + fr, c0 = 256 * u.pn + wc * 32 + 4 * fq;
#pragma unroll
        for (int ai = 0; ai < 2; ++ai)
#pragma unroll
            for (int m = 0; m < 4; ++m) { bf16_t* rowp = O + (size_t)(row0 + ai * HALF + m * 16) * DM + c0;
#pragma unroll
                for (int bj = 0; bj < 2; ++bj)
#pragma unroll
                    for (int n = 0; n < 2; ++n) { const f32x4 v = acc[ai][bj][m][n]; u32x2 w; w.x = cvt_pk_bf16(v[0], v[1]); w.y = cvt_pk_bf16(v[2], v[3]); *(u32x2*)(rowp + bj * HALF + n * 16) = w; } }
    }
};

struct EpiRes {
    static constexpr bool PERM = false, MIDK = false;
    const float* baseP; const float* baseS; float* out;
    __device__ __forceinline__ void midk(f32x4 (&)[2][2][4][2], const Unit&, int, int, int, int, int) const {}
    __device__ __forceinline__ void operator()(f32x4 (&acc)[2][2][4][2], const Unit& u, int wr, int wc, int fr_, int fq_) const {
        const int lane_ = lane_now(), fr = lane_ & 15, fq = lane_ >> 4; (void)fr_; (void)fq_;
        const int row0 = u.pm * BM + wr * 64 + fr, c0 = 256 * u.pn + wc * 32 + 4 * fq;
#pragma unroll
        for (int ai = 0; ai < 2; ++ai)
#pragma unroll
            for (int m = 0; m < 4; ++m) { const int R = row0 + ai * HALF + m * 16;
                const float* bp = (R < MP ? baseP + (size_t)R * DM : baseS + (size_t)(R - MP) * DM) + c0; float* op = out + (size_t)R * DM + c0;
#pragma unroll
                for (int bj = 0; bj < 2; ++bj)
#pragma unroll
                    for (int n = 0; n < 2; ++n) { const f32x4 b = *(const f32x4*)(bp + bj * HALF + n * 16); *(f32x4*)(op + bj * HALF + n * 16) = b * ALPHA + acc[ai][bj][m][n]; }
                if (m & 1) asm volatile("" ::: "memory"); }
    }
};

struct EpiSwi {
    static constexpr bool PERM = true, MIDK = false;
    bf16_t* H;
    __device__ __forceinline__ void midk(f32x4 (&)[2][2][4][2], const Unit&, int, int, int, int, int) const {}
    __device__ __forceinline__ void operator()(f32x4 (&acc)[2][2][4][2], const Unit& u, int wr, int wc, int fr_, int fq_) const {
        const int lane_ = lane_now(), fr = lane_ & 15, fq = lane_ >> 4; (void)fr_; (void)fq_;
        const int row0 = u.pm * BM + wr * 64 + fr, c0 = 128 * u.pn + wc * 32 + 8 * fq;
#pragma unroll
        for (int ai = 0; ai < 2; ++ai)
#pragma unroll
            for (int m = 0; m < 4; ++m) { bf16_t* rowp = H + (size_t)(row0 + ai * HALF + m * 16) * FF + c0;
                const f32x4 g0 = acc[ai][0][m][0], g1 = acc[ai][0][m][1], u0 = acc[ai][1][m][0], u1 = acc[ai][1][m][1]; f32x4 v0, v1;
#pragma unroll
                for (int i = 0; i < 4; ++i) { v0[i] = g0[i] * sigmoidf_fast(g0[i]) * u0[i]; v1[i] = g1[i] * sigmoidf_fast(g1[i]) * u1[i]; }
                u32x4 w; w.x = cvt_pk_bf16(v0[0], v0[1]); w.y = cvt_pk_bf16(v0[2], v0[3]); w.z = cvt_pk_bf16(v1[0], v1[1]); w.w = cvt_pk_bf16(v1[2], v1[3]);
                *(u32x4*)rowp = w; }
    }
};

template <class Epi, class Sched, bool ALIGN_EPI>
__device__ __forceinline__ void gemm_phase(PG8_LAS unsigned char* lds, const Gemm g, const Sched& S, const Epi& E, int wave_id) {
    const int wid = opqs(wave_id), lane = lane_now(), tid = wid * 64 + lane, wr = wid >> 2, wc = wid & 3, fr = lane & 15, fq = lane >> 4;
    const int K = g.K, nt = K / BK, TSEG = Epi::MIDK ? 8 : nt;
    unsigned voffA[2], voffB[2];
#pragma unroll
    for (int i = 0; i < 2; ++i) { int R, C; stage_rc(tid * 16 + i * 8192, R, C); const int Rb = Epi::PERM ? ((R & ~31) + perm32(R & 31)) : R;
        voffA[i] = (unsigned)(R * K + C) * 2u; voffB[i] = (unsigned)(Rb * K + C) * 2u; }
    const size_t kstep = (size_t)(BK * 2);
    const size_t hstep = (size_t)HALF * K * 2;
    const size_t tstep = 2 * hstep;
    const unsigned ldsw = (unsigned)wid * 1024u;
    const int aoff = lds_byte(wr * 64 + fr, fq * 8), boff = lds_byte(wc * 32 + fr, fq * 8);
#define PG8_SA(b, h) (((b) * 2 + (h)) * HTB)
#define PG8_SB(b, h) ((4 + (b) * 2 + (h)) * HTB)
#define PG8_STAGE(bufoff, gbase, voff) do { _Pragma("unroll") for (int _i = 0; _i < 2; ++_i) \
        __builtin_amdgcn_global_load_lds((const unsigned*)((const char*)(gbase) + (voff)[_i]), (PG8_LAS unsigned*)(lds + (bufoff) + ldsw + _i * 8192), 16, 0, 0); } while (0)
#define PG8_LDA(dst, b, h) do { _Pragma("unroll") for (int m = 0; m < 4; ++m) _Pragma("unroll") for (int k = 0; k < 2; ++k) dst[m][k] = *(const PG8_LAS bf16x8*)(lds + PG8_SA(b, h) + aoff + m * 2048 + k * 1024); } while (0)
#define PG8_LDB(dst, b, h) do { _Pragma("unroll") for (int n = 0; n < 2; ++n) _Pragma("unroll") for (int k = 0; k < 2; ++k) dst[n][k] = *(const PG8_LAS bf16x8*)(lds + PG8_SB(b, h) + boff + n * 2048 + k * 1024); } while (0)
#define PG8_MMA(ai, bj, At, Bt) do { __builtin_amdgcn_s_setprio(1); _Pragma("unroll") for (int m = 0; m < 4; ++m) _Pragma("unroll") for (int n = 0; n < 2; ++n) _Pragma("unroll") for (int k = 0; k < 2; ++k) \
        acc[ai][bj][m][n] = __builtin_amdgcn_mfma_f32_16x16x32_bf16(Bt[n][k], At[m][k], acc[ai][bj][m][n], 0, 0, 0); __builtin_amdgcn_s_setprio(0); } while (0)
#define PG8_WAIT_V(n) asm volatile("s_waitcnt vmcnt(" #n ")" ::: "memory")
#define PG8_WAIT_L(n) asm volatile("s_waitcnt lgkmcnt(" #n ")" ::: "memory")
#define PG8_BAR __builtin_amdgcn_s_barrier()
#define PG8_SCHED __builtin_amdgcn_sched_barrier(0)
    Unit cur, nxt; int ui = 0;
    if (!S.next(0, cur)) return;
    f32x4 acc[2][2][4][2];
#pragma unroll
    for (int a = 0; a < 2; ++a)
#pragma unroll
        for (int b = 0; b < 2; ++b)
#pragma unroll
            for (int m = 0; m < 4; ++m)
#pragma unroll
                for (int n = 0; n < 2; ++n) acc[a][b][m][n] = (f32x4){0.f, 0.f, 0.f, 0.f};
    bf16x8 At[4][2], B0[2][2], B1[2][2];
    const char* cA = (const char*)g.A + (size_t)cur.pm * tstep; const char* cB = (const char*)g.Bt + (size_t)cur.pn * tstep;
    PG8_STAGE(PG8_SB(0, 0), cB, voffB); PG8_STAGE(PG8_SB(0, 1), cB + hstep, voffB); PG8_STAGE(PG8_SA(0, 0), cA, voffA); PG8_STAGE(PG8_SA(0, 1), cA + hstep, voffA);
    if (wr == 1) PG8_BAR;
    PG8_WAIT_V(2); PG8_BAR;
    PG8_STAGE(PG8_SB(1, 0), cB + kstep, voffB); PG8_STAGE(PG8_SA(1, 0), cA + kstep, voffA); PG8_STAGE(PG8_SB(1, 1), cB + hstep + kstep, voffB);
    PG8_WAIT_V(6); PG8_BAR;
    for (;;) {
        const bool has_next = S.next(ui + 1, nxt);
        const char* nA = has_next ? (const char*)g.A + (size_t)nxt.pm * tstep : cA; const char* nB = has_next ? (const char*)g.Bt + (size_t)nxt.pn * tstep : cB;
        for (int t0 = 0; t0 < nt; t0 += TSEG) {
        if constexpr (Epi::MIDK) { if (t0 != 0) { PG8_SCHED; E.midk(acc, cur, t0 / TSEG - 1, wr, wc, 0, 0); PG8_SCHED; } }
#pragma unroll 1
        for (int t = t0; t < t0 + TSEG; t += 2) {
            const bool last = (t == nt - 2);
            const char* a1 = cA + (size_t)(t + 1) * kstep;
            const char* a2 = last ? nA : cA + (size_t)(t + 2) * kstep; const char* b2 = last ? nB : cB + (size_t)(t + 2) * kstep;
            const char* a3 = a2 + kstep; const char* b3 = b2 + kstep;
            PG8_LDB(B0, 0, 0); PG8_LDB(B1, 0, 1); PG8_SCHED; PG8_LDA(At, 0, 0); PG8_STAGE(PG8_SA(1, 1), a1 + hstep, voffA);
            PG8_WAIT_V(8); PG8_WAIT_L(0); PG8_BAR; PG8_MMA(0, 0, At, B0); PG8_MMA(0, 1, At, B1); PG8_BAR; PG8_SCHED;
            PG8_LDA(At, 0, 1); PG8_STAGE(PG8_SB(0, 0), b2, voffB); PG8_STAGE(PG8_SB(0, 1), b2 + hstep, voffB); PG8_STAGE(PG8_SA(0, 0), a2, voffA);
            PG8_WAIT_V(8); PG8_WAIT_L(0); PG8_BAR; PG8_MMA(1, 0, At, B0); PG8_MMA(1, 1, At, B1); PG8_BAR; PG8_SCHED;
            PG8_LDB(B0, 1, 0); PG8_LDB(B1, 1, 1); PG8_SCHED; PG8_LDA(At, 1, 0); PG8_STAGE(PG8_SA(0, 1), a2 + hstep, voffA);
            PG8_WAIT_V(8); PG8_WAIT_L(0); PG8_BAR; PG8_MMA(0, 0, At, B0); PG8_MMA(0, 1, At, B1); PG8_BAR; PG8_SCHED;
            PG8_LDA(At, 1, 1); PG8_STAGE(PG8_SB(1, 0), b3, voffB); PG8_STAGE(PG8_SB(1, 1), b3 + hstep, voffB); PG8_STAGE(PG8_SA(1, 0), a3, voffA);
            PG8_WAIT_V(8); PG8_WAIT_L(0); PG8_BAR; PG8_MMA(1, 0, At, B0); PG8_MMA(1, 1, At, B1); PG8_BAR; PG8_SCHED;
        }
        }
        if constexpr (ALIGN_EPI) { if (wr == 0) PG8_BAR; }
        E(acc, cur, wr, wc, 0, 0);
        if (!has_next) break;
#pragma unroll
        for (int a = 0; a < 2; ++a)
#pragma unroll
            for (int b = 0; b < 2; ++b)
#pragma unroll
                for (int m = 0; m < 4; ++m)
#pragma unroll
                    for (int n = 0; n < 2; ++n) acc[a][b][m][n] = (f32x4){0.f, 0.f, 0.f, 0.f};
        cur = nxt; cA = nA; cB = nB; ++ui;
        if constexpr (ALIGN_EPI) { if (wr == 1) PG8_BAR; }
    }
    PG8_WAIT_V(0);
    if constexpr (!ALIGN_EPI) { if (wr == 0) PG8_BAR; }
    PG8_BAR;
#undef PG8_SA
#undef PG8_SB
#undef PG8_STAGE
#undef PG8_LDA
#undef PG8_LDB
#undef PG8_MMA
#undef PG8_WAIT_V
#undef PG8_WAIT_L
#undef PG8_BAR
#undef PG8_SCHED
}
}

constexpr int NWAVES = 8;
constexpr int NPHASE = 19;
constexpr size_t MiB = 1u << 20;
constexpr size_t WS_CTL = 0, CTL_ZERO_BYTES = 1 * MiB;
constexpr size_t WS_WA = 1 * MiB;
constexpr size_t WS_XB = 18 * MiB;
constexpr size_t WS_Y = 51 * MiB;
constexpr size_t WS_ZG = 117 * MiB;
constexpr size_t WS_BT3 = WS_WA, WS_BT4 = WS_WA + 4 * MiB, WS_BT5 = WS_ZG + 96 * MiB, WS_BT6 = WS_ZG + 108 * MiB;
constexpr size_t WS_END = 249 * MiB;
static_assert(WS_XB + (size_t)M * DM * 2 <= WS_Y && WS_Y + (size_t)M * YC * 2 <= WS_ZG && WS_ZG + (size_t)M * GC * 2 <= WS_END, "ws map");
static_assert((size_t)M * FF * 2 <= 96 * MiB && WS_BT5 + (size_t)2 * FF * DM * 2 <= WS_BT6 && WS_BT6 + (size_t)DM * FF * 2 <= WS_END, "ws map 2");
constexpr int CW_TMO = 0, CW_CODE = 1, CW_BAR = 4096;
constexpr int RING_OFF = 0, RING_BYTES = 131072;
constexpr int LDSCTL_OFF = RING_BYTES, MISC_OFF = LDSCTL_OFF + 320;
constexpr int LDS_BYTES = 147456;

#define GAS __attribute__((address_space(1)))
#define LAS __attribute__((address_space(3)))
typedef unsigned short bf16;
typedef unsigned v4u __attribute__((ext_vector_type(4)));
typedef unsigned v2u __attribute__((ext_vector_type(2)));
typedef float f32x4 __attribute__((ext_vector_type(4)));
typedef float f32x2 __attribute__((ext_vector_type(2)));
typedef short bf16x8 __attribute__((ext_vector_type(8)));
typedef GAS unsigned gu32;
#define RLX_AGENT __ATOMIC_RELAXED, __HIP_MEMORY_SCOPE_AGENT
#define LDS_WAIT() asm volatile("s_waitcnt lgkmcnt(0)" ::: "memory")
#define VM_WAIT() asm volatile("s_waitcnt vmcnt(0)" ::: "memory")
__device__ __forceinline__ unsigned pk2(float lo, float hi) { return pg8::cvt_pk_bf16(lo, hi); }
__device__ __forceinline__ float bflo(unsigned v) { return __uint_as_float(v << 16); }
__device__ __forceinline__ float bfhi(unsigned v) { return __uint_as_float(v & 0xffff0000u); }
__device__ __forceinline__ float bf1(unsigned short h) { return __uint_as_float((unsigned)h << 16); }
__device__ __forceinline__ unsigned short f2bf(float f) { return (unsigned short)(pg8::cvt_pk_bf16(f, 0.f) & 0xffffu); }

#define XB_TMO      128
#define XB_XCNT(j)  (256  + 64 * (j))
#define XB_XSUB(j)  (1280 + 64 * (j))
#define XB_XGEN(j)  (2304 + 64 * (j))
#define XB_TOP      3328
#define XB_TOPGEN   3392
#define XCD_BAR_WORDS 3456
#define XB_SPIN_CAP (1u << 18)
__device__ __forceinline__ unsigned xb_ld(unsigned* p)              { return __hip_atomic_load(p, __ATOMIC_RELAXED, __HIP_MEMORY_SCOPE_AGENT); }
__device__ __forceinline__ unsigned xb_add(unsigned* p, unsigned v) { return __hip_atomic_fetch_add(p, v, __ATOMIC_RELAXED, __HIP_MEMORY_SCOPE_AGENT); }
__device__ __forceinline__ unsigned xb_xcc_id() { return (unsigned)__builtin_amdgcn_s_getreg((3 << 11) | 20) & 0xFu; }
#define XB_SPIN(cond, bar) do { unsigned _sp = 0; while (cond) { __builtin_amdgcn_s_sleep(1); \
    if ((++_sp & 255u) == 0u) { if (xb_ld(&(bar)[XB_TMO])) break; if (_sp > XB_SPIN_CAP) { atomicAdd(&(bar)[XB_TMO], 1u); break; } } } } while (0)
struct XcdBarrier { unsigned* bar; unsigned x; volatile LAS unsigned* st; };
__device__ __forceinline__ XcdBarrier xcd_barrier_post(unsigned* bar, volatile LAS unsigned* st) {
    XcdBarrier b; b.bar = bar; b.x = xb_xcc_id(); b.st = st;
    if (threadIdx.x == 0) (void)xb_add(&bar[XB_XCNT(b.x)], 1u);
    return b;
}
__device__ __forceinline__ void xcd_barrier_complete(unsigned* bar, unsigned x, unsigned& nloc, unsigned& nx) {
    const unsigned G = gridDim.x * gridDim.y * gridDim.z;
    unsigned sum, cnt, mine, sp = 0u;
    for (;;) {
        sum = 0u; cnt = 0u; mine = 0u;
#pragma unroll
        for (unsigned j = 0; j < 16; ++j) { const unsigned c = xb_ld(&bar[XB_XCNT(j)]); sum += c; cnt += (c > 0u) ? 1u : 0u; mine = (j == x) ? c : mine; }
        if (sum == G) break;
        __builtin_amdgcn_s_sleep(1);
        if ((++sp & 255u) == 0u) { if (xb_ld(&bar[XB_TMO])) break; if (sp > XB_SPIN_CAP) { atomicAdd(&bar[XB_TMO], 1u); break; } }
    }
    nloc = mine > 0u ? mine : 1u; nx = cnt > 0u ? cnt : 1u;
}
__device__ __forceinline__ void xcd_barrier(const XcdBarrier& b) {
    asm volatile("s_waitcnt vmcnt(0)" ::: "memory");
    __syncthreads();
    if (threadIdx.x == 0) {
        unsigned* bar = b.bar;
        __builtin_amdgcn_s_waitcnt(0);
        unsigned nloc = b.st[0], nx = b.st[1];
        if (nloc == 0u) { xcd_barrier_complete(bar, b.x, nloc, nx); b.st[0] = nloc; b.st[1] = nx; }
        const unsigned old = xb_add(&bar[XB_XSUB(b.x)], 1u);
        const unsigned gen = old / nloc;
        if (old + 1u == (gen + 1u) * nloc) {
            __builtin_amdgcn_fence(__ATOMIC_RELEASE, "agent");
            asm volatile("s_waitcnt vmcnt(0)" ::: "memory");
            const unsigned og = xb_add(&bar[XB_TOP], 1u);
            const unsigned tg = og / nx;
            if (og + 1u == (tg + 1u) * nx) xb_add(&bar[XB_TOPGEN], 1u);
            else XB_SPIN(xb_ld(&bar[XB_TOPGEN]) == tg, bar);
            __builtin_amdgcn_fence(__ATOMIC_ACQUIRE, "agent");
            xb_add(&bar[XB_XGEN(b.x)], 1u);
            asm volatile("s_waitcnt vmcnt(0)" ::: "memory");
        } else {
            XB_SPIN(xb_ld(&bar[XB_XGEN(b.x)]) == gen, bar);
            __builtin_amdgcn_fence(__ATOMIC_ACQUIRE, "agent");
            asm volatile("s_waitcnt vmcnt(0)" ::: "memory");
        }
    }
    __syncthreads();
}

struct Frame {
    LAS unsigned char* lds;
    volatile LAS unsigned* MISC;
    gu32* ctl;
    int tid, lane, wave, G, bid;
    const float* const* in;
    float* out;
    unsigned char* ws;
};
enum { I_XP = 0, I_XS, I_SH, I_SRGC, I_SCF, I_SPOOL, I_SSC, I_WIN, I_RGCW, I_RGCB, I_RGWA, I_RGBA, I_RGWX, I_RGBX, I_LAM, I_CFW, I_CFB, I_CFG, I_CFBB, I_POOLW, I_POOLS, I_SCW,
       I_WBR, I_WOUT, I_LN1G, I_LN1B, I_WG, I_WU, I_WD, I_LN2G, I_LN2B };

__device__ __forceinline__ float shfl_idx(float v, int src_lane) { return __builtin_bit_cast(float, __builtin_amdgcn_ds_bpermute(src_lane << 2, __builtin_bit_cast(int, v))); }
__device__ __forceinline__ float wave_sum(float v, int lane) {
#pragma unroll
    for (int o = 1; o < 64; o <<= 1) v += shfl_idx(v, lane ^ o);
    return v;
}

enum { RM_ID = 0, RM_WIN = 1, RM_GU = 2 };
template <int MODE> __device__ __forceinline__ int rowmap(int s, int extra) {
    if (MODE == RM_ID) return s;
    if (MODE == RM_GU) return 256 * (s >> 7) + (s & 127) + extra;
    if (s < 1024) return s;
    if (s < 2048) { const int j = ((s - 1024) >> 7) & 3; return 1024 + 256 * j + (s >= 1536 ? 128 : 0) + (s & 127); }
    if (s < 3072) return s;
    if (s < 4096) { const int j = ((s - 3072) >> 7) & 3; return 3072 + 256 * j + (s >= 3584 ? 128 : 0) + (s & 127); }
    const int g = (s - 4096) >> 10, ch = s & 1023, pn = ch >> 6, chl = ch & 63, wc = chl >> 4, fq = (chl >> 2) & 3, i = chl & 3;
    return 4096 + 256 * pn + 128 * (g >> 1) + 32 * wc + 8 * fq + 4 * (g & 1) + i;
}
template <int MODE>
__device__ __forceinline__ void transpose_item(const float* W, int K, int N, bf16* WT, int dst_ld, int dst_koff, int extra, LAS float* scr, int item, int lane) {
    const int nblk = N / 32, kb = item / nblk, nb = item % nblk, k0 = 64 * kb, n0 = 32 * nb;
#pragma unroll 8
    for (int i = 0; i < 32; ++i) { const int kk = 2 * i + (lane >> 5); scr[kk * 33 + (lane & 31)] = W[(size_t)(k0 + kk) * N + n0 + (lane & 31)]; }
    LDS_WAIT(); asm volatile("" ::: "memory");
    const int c = lane & 7;
#pragma unroll
    for (int j = 0; j < 4; ++j) { const int n = (lane >> 3) + 8 * j; const LAS float* s = scr + (8 * c) * 33 + n;
        v4u o; o.x = pk2(s[0 * 33], s[1 * 33]); o.y = pk2(s[2 * 33], s[3 * 33]); o.z = pk2(s[4 * 33], s[5 * 33]); o.w = pk2(s[6 * 33], s[7 * 33]);
        *(GAS v4u*)(WT + (size_t)rowmap<MODE>(n0 + n, extra) * dst_ld + dst_koff + k0 + 8 * c) = o; }
    LDS_WAIT(); asm volatile("" ::: "memory");
}
template <int MODE>
__device__ __forceinline__ void convert_matrix(Frame& F, const float* W, int K, int N, bf16* WT, int dst_ld, int dst_koff, int extra) {
    LAS float* scr = (LAS float*)(F.lds + RING_OFF + F.wave * 16384);
    const int gw = F.bid * NWAVES + F.wave, NGW = F.G * NWAVES, nitems = (K / 64) * (N / 32);
    for (int it = gw; it < nitems; it += NGW) transpose_item<MODE>(W, K, N, WT, dst_ld, dst_koff, extra, scr, it, F.lane);
}
__device__ __forceinline__ void compose_pool(Frame& F, int layer, bf16* Bt3) {
    const float* pw = F.in[I_POOLW] + (size_t)layer * 4 * 128 * 128; const float* ps = F.in[I_POOLS] + layer * 512; const float* Wb2 = F.in[I_WBR] + ((size_t)layer * 4 + 2) * 512 * 1024;
    const int gw = F.bid * NWAVES + F.wave, NGW = F.G * NWAVES, lane = F.lane;
    LAS float* Pl = (LAS float*)(F.lds + RING_OFF + F.wave * 16384);
    for (int id = gw; id < 512; id += NGW) {
        const int g = __builtin_amdgcn_readfirstlane(id >> 7), c0 = __builtin_amdgcn_readfirstlane(8 * ((id >> 3) & 15)), d0 = 128 * (id & 7) + 2 * lane;
#pragma unroll
        for (int k = 0; k < 4; ++k) { const int idx4 = lane + 64 * k, i = idx4 >> 5, e4 = (idx4 & 31) * 4;
            const f32x4 pv = *(const GAS f32x4*)(pw + ((size_t)g * 128 + c0 + i) * 128 + e4), sv = *(const GAS f32x4*)(ps + 128 * g + e4);
            Pl[(e4 + 0) * 8 + i] = pv.x * sv.x; Pl[(e4 + 1) * 8 + i] = pv.y * sv.y; Pl[(e4 + 2) * 8 + i] = pv.z * sv.z; Pl[(e4 + 3) * 8 + i] = pv.w * sv.w; }
        LDS_WAIT(); asm volatile("" ::: "memory");
        f32x2 acc[8];
#pragma unroll
        for (int i = 0; i < 8; ++i) acc[i] = (f32x2){0.f, 0.f};
        const float* wrow = Wb2 + (size_t)(128 * g) * 1024 + d0;
#pragma unroll 1
        for (int e0 = 0; e0 < 128; e0 += 8) {
            f32x2 wv[8];
#pragma unroll
            for (int k = 0; k < 8; ++k) wv[k] = *(const GAS f32x2*)(wrow + (size_t)(e0 + k) * 1024);
#pragma unroll
            for (int k = 0; k < 8; ++k) { const f32x4 p0 = *(const LAS f32x4*)(Pl + (e0 + k) * 8), p1 = *(const LAS f32x4*)(Pl + (e0 + k) * 8 + 4);
#pragma unroll
                for (int i = 0; i < 4; ++i) { acc[i] += wv[k] * p0[i]; acc[4 + i] += wv[k] * p1[i]; } }
        }
        v4u o0, o1;
        o0.x = pk2(acc[0].x, acc[1].x); o0.y = pk2(acc[2].x, acc[3].x); o0.z = pk2(acc[4].x, acc[5].x); o0.w = pk2(acc[6].x, acc[7].x);
        o1.x = pk2(acc[0].y, acc[1].y); o1.y = pk2(acc[2].y, acc[3].y); o1.z = pk2(acc[4].y, acc[5].y); o1.w = pk2(acc[6].y, acc[7].y);
        *(GAS v4u*)(Bt3 + (size_t)d0 * 2048 + 1024 + 128 * g + c0) = o0; *(GAS v4u*)(Bt3 + (size_t)(d0 + 1) * 2048 + 1024 + 128 * g + c0) = o1;
        LDS_WAIT(); asm volatile("" ::: "memory");
    }
}

__device__ __forceinline__ const float* xrow_in(Frame& F, int m) { return m < MP ? F.in[I_XP] + (size_t)m * DM : F.in[I_XS] + (size_t)(m - MP) * DM; }
__device__ __forceinline__ void x_to_bf16(Frame& F, bf16* XB) {
    const int gw = F.bid * NWAVES + F.wave, NGW = F.G * NWAVES;
    for (int m = gw; m < M; m += NGW) { const GAS f32x4* xr = (const GAS f32x4*)xrow_in(F, m) + F.lane; GAS v2u* o = (GAS v2u*)(XB + (size_t)m * DM) + F.lane;
#pragma unroll
        for (int j = 0; j < 4; ++j) { const f32x4 v = xr[64 * j]; o[64 * j] = (v2u){pk2(v.x, v.y), pk2(v.z, v.w)}; } }
}
__device__ __forceinline__ void ln_rows(Frame& F, const float* V, float* O, const float* g, const float* b, bf16* XB) {
    const int gw = F.bid * NWAVES + F.wave, NGW = F.G * NWAVES;
    f32x4 gv[4], bv[4];
#pragma unroll
    for (int j = 0; j < 4; ++j) { gv[j] = ((const GAS f32x4*)g)[F.lane + 64 * j]; bv[j] = ((const GAS f32x4*)b)[F.lane + 64 * j]; }
    for (int m = gw; m < M; m += NGW) {
        const GAS f32x4* xr = (const GAS f32x4*)(V + (size_t)m * DM) + F.lane; GAS f32x4* orow = (GAS f32x4*)(O + (size_t)m * DM) + F.lane;
        f32x4 v[4]; float s = 0.f;
#pragma unroll
        for (int j = 0; j < 4; ++j) { v[j] = xr[64 * j]; s += (v[j].x + v[j].y) + (v[j].z + v[j].w); }
        const float mean = wave_sum(s, F.lane) * (1.f / DM); float s2 = 0.f;
#pragma unroll
        for (int j = 0; j < 4; ++j) { v[j] = v[j] - mean; s2 += (v[j].x * v[j].x + v[j].y * v[j].y) + (v[j].z * v[j].z + v[j].w * v[j].w); }
        const float rstd = 1.f / sqrtf(wave_sum(s2, F.lane) * (1.f / DM) + LN_EPS);
#pragma unroll
        for (int j = 0; j < 4; ++j) { v[j] = v[j] * rstd * gv[j] + bv[j]; orow[64 * j] = v[j]; }
        if (XB) { GAS v2u* o = (GAS v2u*)(XB + (size_t)m * DM) + F.lane;
#pragma unroll
            for (int j = 0; j < 4; ++j) o[64 * j] = (v2u){pk2(v[j].x, v[j].y), pk2(v[j].z, v[j].w)}; }
    }
}

__device__ __forceinline__ float softplusf_acc(float x) { return fmaxf(x, 0.f) + log1pf(__expf(-fabsf(x))); }
__device__ __forceinline__ float expm1_neg(float x) {
    const float p = x * (1.f + x * (0.5f + x * (1.f / 6.f + x * (1.f / 24.f + x * (1.f / 120.f + x * (1.f / 720.f + x * (1.f / 5040.f)))))));
    return x > -0.25f ? p : __expf(x) - 1.f;
}
constexpr int PATCH_STRIDE = 144;

struct ALane {
    const LAS float* tab;
    float cwD[4], cbD, ba, bx, ck;
    bf16x8 Ba0, Ba1, Bx0, Bx1;
};
constexpr int PATCH_BYTES = 5120, ASLOT_OFF = 8 * PATCH_BYTES, ATAB_OFF = ASLOT_OFF + 2048, ATAB_BYTES = 1280;
__device__ __forceinline__ void a_setup(Frame& F, int layer, int n, int q, ALane& L) {
    const int c = F.lane & 15, kg = F.lane >> 4, och = 64 * n + 16 * q + c;
    const float* cw = F.in[I_RGCW] + (size_t)layer * 4 * 512; const float* cb = F.in[I_RGCB] + layer * 512;
    LAS float* tab = (LAS float*)(F.lds + RING_OFF + ATAB_OFF + F.wave * ATAB_BYTES);
#pragma unroll
    for (int k = 0; k < 5; ++k) { const int idx = F.lane + 64 * k, tg = idx / 80, rem = idx - 80 * tg, j = rem >> 4, e = rem & 15, ch = 64 * n + (e < 8 ? 8 * tg + e : 32 + 8 * tg + (e - 8));
        tab[idx] = j < 4 ? cw[j * 512 + ch] : cb[ch]; }
    L.tab = tab + 80 * kg;
#pragma unroll
    for (int j = 0; j < 4; ++j) L.cwD[j] = cw[j * 512 + och];
    L.cbD = cb[och]; L.ba = F.in[I_RGBA][layer * 512 + och]; L.bx = F.in[I_RGBX][layer * 512 + och];
    L.ck = 8.0f * softplusf_acc(-F.in[I_LAM][layer * 512 + och]);
    const float* wa = F.in[I_RGWA] + ((size_t)layer * 8 + n) * 4096 + 16 * q + c; const float* wx = F.in[I_RGWX] + ((size_t)layer * 8 + n) * 4096 + 16 * q + c;
    unsigned a0[4], a1[4], x0[4], x1[4];
#pragma unroll
    for (int w = 0; w < 4; ++w) {
        a0[w] = pk2(wa[(8 * kg + 2 * w) * 64], wa[(8 * kg + 2 * w + 1) * 64]); a1[w] = pk2(wa[(32 + 8 * kg + 2 * w) * 64], wa[(32 + 8 * kg + 2 * w + 1) * 64]);
        x0[w] = pk2(wx[(8 * kg + 2 * w) * 64], wx[(8 * kg + 2 * w + 1) * 64]); x1[w] = pk2(wx[(32 + 8 * kg + 2 * w) * 64], wx[(32 + 8 * kg + 2 * w + 1) * 64]); }
    L.Ba0 = __builtin_bit_cast(bf16x8, (v4u){a0[0], a0[1], a0[2], a0[3]}); L.Ba1 = __builtin_bit_cast(bf16x8, (v4u){a1[0], a1[1], a1[2], a1[3]});
    L.Bx0 = __builtin_bit_cast(bf16x8, (v4u){x0[0], x0[1], x0[2], x0[3]}); L.Bx1 = __builtin_bit_cast(bf16x8, (v4u){x1[0], x1[1], x1[2], x1[3]});
    LDS_WAIT(); asm volatile("" ::: "memory");
}
__device__ __forceinline__ void a_block(const ALane& L, const LAS unsigned char* patch, int rowA0, int baseD, int q, int lane, float (&a)[4], float (&bb)[4]) {
    const int c = lane & 15, kg = lane >> 4;
    float x[16];
    { const f32x4 b0 = *(const LAS f32x4*)(L.tab + 64), b1 = *(const LAS f32x4*)(L.tab + 68), b2 = *(const LAS f32x4*)(L.tab + 72), b3 = *(const LAS f32x4*)(L.tab + 76);
#pragma unroll
      for (int e = 0; e < 4; ++e) { x[e] = b0[e]; x[4 + e] = b1[e]; x[8 + e] = b2[e]; x[12 + e] = b3[e]; } }
#pragma unroll
    for (int j = 0; j < 4; ++j) { const LAS unsigned char* rp = patch + (rowA0 + j) * PATCH_STRIDE + 16 * kg;
        const v4u v0 = *(const LAS v4u*)rp, v1 = *(const LAS v4u*)(rp + 64);
        const f32x4 t0 = *(const LAS f32x4*)(L.tab + 16 * j), t1 = *(const LAS f32x4*)(L.tab + 16 * j + 4), t2 = *(const LAS f32x4*)(L.tab + 16 * j + 8), t3 = *(const LAS f32x4*)(L.tab + 16 * j + 12);
#pragma unroll
        for (int w = 0; w < 2; ++w) { x[2 * w] += t0[2 * w] * bflo(v0[w]); x[2 * w + 1] += t0[2 * w + 1] * bfhi(v0[w]);
                                      x[4 + 2 * w] += t1[2 * w] * bflo(v0[2 + w]); x[5 + 2 * w] += t1[2 * w + 1] * bfhi(v0[2 + w]);
                                      x[8 + 2 * w] += t2[2 * w] * bflo(v1[w]); x[9 + 2 * w] += t2[2 * w + 1] * bfhi(v1[w]);
                                      x[12 + 2 * w] += t3[2 * w] * bflo(v1[2 + w]); x[13 + 2 * w] += t3[2 * w + 1] * bfhi(v1[2 + w]); } }
    const bf16x8 A0 = __builtin_bit_cast(bf16x8, (v4u){pk2(x[0], x[1]), pk2(x[2], x[3]), pk2(x[4], x[5]), pk2(x[6], x[7])});
    const bf16x8 A1 = __builtin_bit_cast(bf16x8, (v4u){pk2(x[8], x[9]), pk2(x[10], x[11]), pk2(x[12], x[13]), pk2(x[14], x[15])});
    f32x4 accR = (f32x4){0.f, 0.f, 0.f, 0.f}, accI = (f32x4){0.f, 0.f, 0.f, 0.f};
    accR = __builtin_amdgcn_mfma_f32_16x16x32_bf16(A0, L.Ba0, accR, 0, 0, 0); accR = __builtin_amdgcn_mfma_f32_16x16x32_bf16(A1, L.Ba1, accR, 0, 0, 0);
    accI = __builtin_amdgcn_mfma_f32_16x16x32_bf16(A0, L.Bx0, accI, 0, 0, 0); accI = __builtin_amdgcn_mfma_f32_16x16x32_bf16(A1, L.Bx1, accI, 0, 0, 0);
    float pv[7];
#pragma unroll
    for (int k = 0; k < 7; ++k) pv[k] = bf1(*(const LAS unsigned short*)(patch + (baseD + k) * PATCH_STRIDE + 2 * (16 * q + c)));
#pragma unroll
    for (int r = 0; r < 4; ++r) {
        const float xd = L.cbD + L.cwD[0] * pv[r] + L.cwD[1] * pv[r + 1] + L.cwD[2] * pv[r + 2] + L.cwD[3] * pv[r + 3];
        const float rr = pg8::sigmoidf_fast(accR[r] + L.ba), ii = pg8::sigmoidf_fast(accI[r] + L.bx);
        const float la = -L.ck * rr;
        a[r] = __expf(la); bb[r] = sqrtf(fmaxf(-expm1_neg(2.f * la), 0.f)) * (ii * xd);
    }
}
struct BlkScan { float Ac[4], Bc[4], EA, EB, WA, WB; };
__device__ __forceinline__ void blk_scan(const float (&a)[4], const float (&bb)[4], int lane, BlkScan& S) {
    const int c = lane & 15, g = lane >> 4;
    S.Ac[0] = a[0]; S.Bc[0] = bb[0];
#pragma unroll
    for (int r = 1; r < 4; ++r) { S.Ac[r] = a[r] * S.Ac[r - 1]; S.Bc[r] = a[r] * S.Bc[r - 1] + bb[r]; }
    float IA = S.Ac[3], IB = S.Bc[3];
    { const float pa = shfl_idx(IA, lane - 16), pb = shfl_idx(IB, lane - 16); if (g >= 1) { IB = IA * pb + IB; IA = IA * pa; } }
    { const float pa = shfl_idx(IA, lane - 32), pb = shfl_idx(IB, lane - 32); if (g >= 2) { IB = IA * pb + IB; IA = IA * pa; } }
    S.EA = shfl_idx(IA, lane - 16); S.EB = shfl_idx(IB, lane - 16); if (g == 0) { S.EA = 1.f; S.EB = 0.f; }
    S.WA = shfl_idx(IA, 48 + c); S.WB = shfl_idx(IB, 48 + c);
}
__device__ __forceinline__ void a_prompt_item(Frame& F, int layer, int item, const bf16* Z, bf16* Y) {
    const int b = item >> 5, n = (item >> 2) & 7, q = item & 3, lane = opqv(F.lane), w = F.wave, c = lane & 15, g = lane >> 4, och = 64 * n + 16 * q + c;
    ALane L; a_setup(F, layer, n, q, L);
    LAS unsigned char* patch = F.lds + RING_OFF + w * PATCH_BYTES;
    LAS f32x2* slots = (LAS f32x2*)(F.lds + RING_OFF + ASLOT_OFF);
    const bf16* Zb = Z + (size_t)b * SEQ * ZC;
    float hrun = 0.f;
    v4u pf[5];
    auto load_patch = [&](int tb) {
#pragma unroll
        for (int k = 0; k < 5; ++k) { const int ci = lane + 64 * k, pr = ci >> 3, cc = ci & 7, t = tb - 3 + pr;
            pf[k] = (ci < 280 && t >= 0) ? *(const GAS v4u*)(Zb + (size_t)t * ZC + 64 * n + 8 * cc) : (v4u){0u, 0u, 0u, 0u}; }
    };
    load_patch(32 * w);
    for (int it = 0; it < 8; ++it) {
        const int tb = 256 * it + 32 * w;
#pragma unroll
        for (int k = 0; k < 5; ++k) { const int ci = lane + 64 * k, pr = ci >> 3, cc = ci & 7; if (ci < 280) *(LAS v4u*)(patch + pr * PATCH_STRIDE + 16 * cc) = pf[k]; }
        if (it < 7) load_patch(tb + 256);
        unsigned short gav[8];
#pragma unroll
        for (int r = 0; r < 8; ++r) gav[r] = *(const GAS unsigned short*)(Zb + (size_t)(tb + 16 * (r >> 2) + 4 * g + (r & 3)) * ZC + 512 + och);
        asm volatile("" ::: "memory");
        float a0[4], b0[4], a1[4], b1[4];
        a_block(L, patch, lane & 15, 4 * g, q, lane, a0, b0);
        a_block(L, patch, 16 + (lane & 15), 16 + 4 * g, q, lane, a1, b1);
        BlkScan S0, S1; blk_scan(a0, b0, lane, S0); blk_scan(a1, b1, lane, S1);
        if (lane < 16) slots[((it & 1) * 8 + w) * 16 + c] = (f32x2){S0.WA * S1.WA, S1.WA * S0.WB + S1.WB};
        __syncthreads();
        float hin = hrun, hw = 0.f;
#pragma unroll
        for (int ww = 0; ww < 8; ++ww) { const f32x2 s = slots[((it & 1) * 8 + ww) * 16 + c]; if (ww == w) hw = hin; hin = s.x * hin + s.y; }
        hrun = hin;
        const float hg0 = S0.EA * hw + S0.EB, hw1 = S0.WA * hw + S0.WB, hg1 = S1.EA * hw1 + S1.EB;
#pragma unroll
        for (int r = 0; r < 4; ++r) { const float h = S0.Ac[r] * hg0 + S0.Bc[r];
            *(GAS unsigned short*)(Y + (size_t)(b * SEQ + tb + 4 * g + r) * YC + och) = f2bf(h * bf1(gav[r])); }
#pragma unroll
        for (int r = 0; r < 4; ++r) { const float h = S1.Ac[r] * hg1 + S1.Bc[r];
            *(GAS unsigned short*)(Y + (size_t)(b * SEQ + tb + 16 + 4 * g + r) * YC + och) = f2bf(h * bf1(gav[4 + r]));
            if (r == 3 && it == 7 && w == 7 && g == 3) F.out[O_PH + (size_t)(layer * 8 + b) * 512 + och] = h; }
    }
}
__device__ __forceinline__ void a_sample_task(Frame& F, int layer, int task, const bf16* Z, bf16* Y) {
    const int blk = task >> 5, n = (task >> 2) & 7, q = task & 3, lane = opqv(F.lane), c = lane & 15, g = lane >> 4, och = 64 * n + 16 * q + c, s0 = 4 * blk;
    ALane L; a_setup(F, layer, n, q, L);
    LAS unsigned char* patch = F.lds + RING_OFF + F.wave * PATCH_BYTES;
#pragma unroll
    for (int k = 0; k < 4; ++k) { const int ci = lane + 64 * k; if (ci < 224) { const int pr = ci >> 3, cc = ci & 7, sq = pr / 7, tau = pr - 7 * sq - 3, seq = s0 + sq; v4u v;
            if (tau < 0) { const GAS f32x4* sp = (const GAS f32x4*)(F.in[I_SRGC] + ((size_t)(layer * 128 + seq) * 3 + (tau + 3)) * 512 + 64 * n + 8 * cc); const f32x4 f0 = sp[0], f1 = sp[1];
                v = (v4u){pk2(f0.x, f0.y), pk2(f0.z, f0.w), pk2(f1.x, f1.y), pk2(f1.z, f1.w)}; }
            else v = *(const GAS v4u*)(Z + (size_t)(MP + 4 * seq + tau) * ZC + 64 * n + 8 * cc);
            *(LAS v4u*)(patch + pr * PATCH_STRIDE + 16 * cc) = v; } }
    asm volatile("" ::: "memory");
    float a[4], bb[4];
    a_block(L, patch, 7 * ((lane & 15) >> 2) + (lane & 3), 7 * g, q, lane, a, bb);
    const int seq = s0 + g;
    float h = F.in[I_SH][(size_t)(layer * 128 + seq) * 512 + och];
#pragma unroll
    for (int r = 0; r < 4; ++r) { h = a[r] * h + bb[r]; const size_t row = (size_t)(MP + 4 * seq + r);
        *(GAS unsigned short*)(Y + row * YC + och) = f2bf(h * bf1(*(const GAS unsigned short*)(Z + row * ZC + 512 + och))); }
    F.out[O_SH + (size_t)(layer * 128 + seq) * 512 + och] = h;
}

__device__ __forceinline__ void ln_silu_row(const LAS float* xr, const float* g, const float* b, bf16* dst, int lane) {
    const f32x4 v0 = *(const LAS f32x4*)(xr + 4 * lane), v1 = *(const LAS f32x4*)(xr + 256 + 4 * lane);
    const float s = (v0.x + v0.y) + (v0.z + v0.w) + (v1.x + v1.y) + (v1.z + v1.w);
    const float mean = wave_sum(s, lane) * (1.f / 512.f);
    const f32x4 d0 = v0 - mean, d1 = v1 - mean;
    const float s2 = (d0.x * d0.x + d0.y * d0.y) + (d0.z * d0.z + d0.w * d0.w) + (d1.x * d1.x + d1.y * d1.y) + (d1.z * d1.z + d1.w * d1.w);
    const float rstd = 1.f / sqrtf(wave_sum(s2, lane) * (1.f / 512.f) + LN_EPS);
    const f32x4 g0 = *(const GAS f32x4*)(g + 4 * lane), g1 = *(const GAS f32x4*)(g + 256 + 4 * lane), b0 = *(const GAS f32x4*)(b + 4 * lane), b1 = *(const GAS f32x4*)(b + 256 + 4 * lane);
    f32x4 y0 = d0 * rstd * g0 + b0, y1 = d1 * rstd * g1 + b1;
#pragma unroll
    for (int i = 0; i < 4; ++i) { y0[i] = y0[i] * pg8::sigmoidf_fast(y0[i]); y1[i] = y1[i] * pg8::sigmoidf_fast(y1[i]); }
    *(GAS v2u*)(dst + 4 * lane) = (v2u){pk2(y0.x, y0.y), pk2(y0.z, y0.w)}; *(GAS v2u*)(dst + 256 + 4 * lane) = (v2u){pk2(y1.x, y1.y), pk2(y1.z, y1.w)};
}
__device__ __forceinline__ void b_prompt_item(Frame& F, int layer, int item, const bf16* Z, bf16* Y) {
    const int tidl = opqv(F.tid), b = item >> 5, t0 = 64 * (item & 31), p = tidl & 255, hh = tidl >> 8, ts = t0 + 32 * hh;
    const GAS unsigned* Zu = (const GAS unsigned*)(Z + (size_t)b * SEQ * ZC) + 512 + p;
    unsigned raw[62];
#pragma unroll
    for (int i = 0; i < 62; ++i) { const int t = ts - 30 + i; raw[i] = t >= 0 ? Zu[(size_t)t * (ZC / 2)] : 0u; }
    const float* cw = F.in[I_CFW] + (size_t)layer * 31 * 512 + 2 * p;
    f32x2 wj[31];
#pragma unroll
    for (int j = 0; j < 31; ++j) wj[j] = *(const GAS f32x2*)(cw + j * 512);
    const f32x2 bias = *(const GAS f32x2*)(F.in[I_CFB] + layer * 512 + 2 * p);
    f32x2 in[62];
#pragma unroll
    for (int i = 0; i < 62; ++i) in[i] = (f32x2){bflo(raw[i]), bfhi(raw[i])};
    LAS float* obuf = (LAS float*)(F.lds + RING_OFF);
#pragma unroll
    for (int i = 0; i < 32; ++i) { f32x2 o = bias;
#pragma unroll
        for (int j = 0; j < 31; ++j) o += wj[j] * in[i + j];
        *(LAS f32x2*)(obuf + (32 * hh + i) * 512 + 2 * p) = o; }
    __syncthreads();
    const float* lg = F.in[I_CFG] + layer * 512; const float* lb = F.in[I_CFBB] + layer * 512;
#pragma unroll 1
    for (int r = F.wave; r < 64; r += 8) ln_silu_row(obuf + r * 512, lg, lb, Y + (size_t)(b * SEQ + t0 + r) * YC + 512, F.lane);
}
__device__ __forceinline__ void cd_prompt_item(Frame& F, int layer, int item, const bf16* Z, bf16* Y) {
    const int tidl = opqv(F.tid), b = item >> 5, t0 = 64 * (item & 31), p = tidl & 255, hh = tidl >> 8;
    const bf16* Zb = Z + (size_t)b * SEQ * ZC;
    LAS unsigned* cbuf = (LAS unsigned*)(F.lds + RING_OFF);
    for (int ci = tidl; ci < 79 * 64; ci += 512) { const int pr = ci >> 6, cc = ci & 63, t = t0 - 15 + pr;
        const v4u v = t >= 0 ? *(const GAS v4u*)(Zb + (size_t)t * ZC + 1536 + 8 * cc) : (v4u){0u, 0u, 0u, 0u};
        *(LAS v4u*)(cbuf + pr * 256 + 4 * cc) = v; }
    const int ts = t0 + 32 * hh;
    unsigned uu[34], dd[32];
#pragma unroll
    for (int i = 0; i < 34; ++i) { const int t = ts - 2 + i; uu[i] = t >= 0 ? ((const GAS unsigned*)(Zb + (size_t)t * ZC))[1280 + p] : 0u; }
#pragma unroll
    for (int i = 0; i < 32; ++i) dd[i] = ((const GAS unsigned*)(Zb + (size_t)(ts + i) * ZC))[1024 + p];
    const f32x2 w0 = ((const GAS f32x2*)(F.in[I_SCW] + (size_t)(layer * 3 + 0) * 512))[p], w1 = ((const GAS f32x2*)(F.in[I_SCW] + (size_t)(layer * 3 + 1) * 512))[p],
                w2 = ((const GAS f32x2*)(F.in[I_SCW] + (size_t)(layer * 3 + 2) * 512))[p];
    __syncthreads();
    const int w = 2 << (p >> 6), rr0 = 15 + 32 * hh;
    f32x2 s = (f32x2){0.f, 0.f};
    for (int j = 0; j < w; ++j) { const unsigned v = cbuf[(rr0 - j) * 256 + p]; s += (f32x2){bflo(v), bfhi(v)}; }
    GAS unsigned* Yu = (GAS unsigned*)(Y + (size_t)(b * SEQ + ts) * YC) + p;
#pragma unroll
    for (int i = 0; i < 32; ++i) { const int t = ts + i, rr = rr0 + i;
        const unsigned cur = cbuf[rr * 256 + p]; const f32x2 cf = (f32x2){bflo(cur), bfhi(cur)};
        if (i > 0) { const unsigned old = cbuf[(rr - w) * 256 + p]; s += cf - (f32x2){bflo(old), bfhi(old)}; }
        const float ic = __builtin_amdgcn_rcpf((float)(t + 1 < w ? t + 1 : w));
        const f32x2 mm = s * ic - cf;
        Yu[(size_t)i * 1024 + 512] = pk2(mm.x, mm.y);
        const f32x2 cv = w0 * (f32x2){bflo(uu[i]), bfhi(uu[i])} + w1 * (f32x2){bflo(uu[i + 1]), bfhi(uu[i + 1])} + w2 * (f32x2){bflo(uu[i + 2]), bfhi(uu[i + 2])};
        const f32x2 yd = (f32x2){bflo(dd[i]), bfhi(dd[i])} * cv;
        Yu[(size_t)i * 1024 + 768] = pk2(yd.x, yd.y); }
}
__device__ __forceinline__ void s_sample_item(Frame& F, int layer, int s, const bf16* Z, bf16* Y) {
    const int ch = opqv(F.tid); const size_t ls = (size_t)layer * 128 + s;
    const bf16* Zr = Z + (size_t)(MP + 4 * s) * ZC; bf16* Yr = Y + (size_t)(MP + 4 * s) * YC;
    LAS float* obuf = (LAS float*)(F.lds + RING_OFF);
    {
        float in[34], wv[31];
#pragma unroll
        for (int j = 0; j < 30; ++j) in[j] = (F.in[I_SCF] + (ls * 30 + j) * 512)[ch];
#pragma unroll
        for (int r = 0; r < 4; ++r) in[30 + r] = bf1((Zr + (size_t)r * ZC + 1024)[ch]);
#pragma unroll
        for (int j = 0; j < 31; ++j) wv[j] = (F.in[I_CFW] + ((size_t)layer * 31 + j) * 512)[ch];
        const float bias = (F.in[I_CFB] + layer * 512)[ch];
#pragma unroll
        for (int j = 0; j < 26; ++j) (F.out + O_SCF + (ls * 30 + j) * 512)[ch] = in[j + 4];
#pragma unroll
        for (int r = 0; r < 4; ++r) { float o = bias;
#pragma unroll
            for (int j = 0; j < 31; ++j) o += wv[j] * in[r + j];
            obuf[r * 512 + ch] = o; }
    }
    {
        float pb[19];
#pragma unroll
        for (int j = 0; j < 15; ++j) pb[j] = (F.in[I_SPOOL] + (ls * 15 + j) * 512)[ch];
#pragma unroll
        for (int r = 0; r < 4; ++r) pb[15 + r] = bf1((Zr + (size_t)r * ZC + 1536)[ch]);
#pragma unroll
        for (int j = 0; j < 11; ++j) (F.out + O_SPOOL + (ls * 15 + j) * 512)[ch] = pb[j + 4];
        const int gsel = ch >> 7;
#pragma unroll
        for (int r = 0; r < 4; ++r) { const int k = 15 + r;
            const float s2 = pb[k] + pb[k - 1], s4 = s2 + pb[k - 2] + pb[k - 3], s8 = s4 + (pb[k - 4] + pb[k - 5]) + (pb[k - 6] + pb[k - 7]);
            float s16 = s8;
#pragma unroll
            for (int j = 8; j < 16; ++j) s16 += pb[k - j];
            const float mv = (gsel == 0 ? s2 * 0.5f : gsel == 1 ? s4 * 0.25f : gsel == 2 ? s8 * 0.125f : s16 * 0.0625f) - pb[k];
            (Yr + (size_t)r * YC + 1024)[ch] = f2bf(mv); }
    }
    {
        float u[6];
        u[0] = (F.in[I_SSC] + (ls * 2 + 0) * 512)[ch]; u[1] = (F.in[I_SSC] + (ls * 2 + 1) * 512)[ch];
#pragma unroll
        for (int r = 0; r < 4; ++r) u[2 + r] = bf1((Zr + (size_t)r * ZC + 2560)[ch]);
        const float w0 = (F.in[I_SCW] + (size_t)(layer * 3 + 0) * 512)[ch], w1 = (F.in[I_SCW] + (size_t)(layer * 3 + 1) * 512)[ch], w2 = (F.in[I_SCW] + (size_t)(layer * 3 + 2) * 512)[ch];
#pragma unroll
        for (int r = 0; r < 4; ++r) (Yr + (size_t)r * YC + 1536)[ch] = f2bf(bf1((Zr + (size_t)r * ZC + 2048)[ch]) * (w0 * u[r] + w1 * u[r + 1] + w2 * u[r + 2]));
    }
    __syncthreads();
    if (F.wave < 4) ln_silu_row(obuf + F.wave * 512, F.in[I_CFG] + layer * 512, F.in[I_CFBB] + layer * 512, Yr + (size_t)F.wave * YC + 512, F.lane);
}

struct Args { const float* in[31]; float* out; unsigned char* ws; int ph_lo, ph_hi; };
__global__ void __launch_bounds__(NWAVES * 64, 2) hybrid_fwd(Args args) {
    extern __shared__ __attribute__((aligned(16))) unsigned char lds[];
    Frame F;
    F.lds = (LAS unsigned char*)lds;
    F.MISC = (volatile LAS unsigned*)(F.lds + MISC_OFF);
    const int wave0 = __builtin_amdgcn_readfirstlane((int)threadIdx.x >> 6);
    F.lane = lane_now(); F.wave = wave0; F.tid = F.wave * 64 + F.lane;
    F.G = gridDim.x; F.bid = blockIdx.x;
    F.ws = args.ws; F.out = args.out; F.ctl = (gu32*)(args.ws + WS_CTL);
    F.in = args.in;
    for (int u = F.tid; u < (LDS_BYTES - LDSCTL_OFF) / 4; u += NWAVES * 64) ((LAS unsigned*)(F.lds + LDSCTL_OFF))[u] = 0u;
    __syncthreads();
    XcdBarrier bar; bar.bar = (unsigned*)(F.ctl + CW_BAR); bar.x = 0; bar.st = nullptr;
    if (!MK_SPLIT) bar = xcd_barrier_post((unsigned*)(F.ctl + CW_BAR), F.MISC + 8);
    const int lo = args.ph_lo, hi = args.ph_hi;
#define IN(k) (lo <= (k) && (k) < hi)
#define REFRESH() do { F.lane = lane_now(); F.wave = opqs(wave0); F.tid = F.wave * 64 + F.lane; F.bid = opqs((int)blockIdx.x); } while (0)
#define SEAM(k) do { if (IN(k) && IN((k) + 1)) xcd_barrier(bar); } while (0)
    bf16* WA = (bf16*)(F.ws + WS_WA); bf16* XB = (bf16*)(F.ws + WS_XB); bf16* Y = (bf16*)(F.ws + WS_Y); bf16* Zm = (bf16*)(F.ws + WS_ZG); _Float16* Gb = (_Float16*)(F.ws + WS_ZG);
    bf16* Hb = (bf16*)(F.ws + WS_ZG); bf16* Bt3 = (bf16*)(F.ws + WS_BT3); bf16* Bt4 = (bf16*)(F.ws + WS_BT4); bf16* Bt5 = (bf16*)(F.ws + WS_BT5); bf16* Bt6 = (bf16*)(F.ws + WS_BT6);

    if (IN(0)) { REFRESH(); convert_matrix<RM_WIN>(F, F.in[I_WIN], DM, INC, WA, DM, 0, 0); REFRESH(); x_to_bf16(F, XB); }
    SEAM(0);

    for (int l = 0; l < 2; ++l) {
        const int pb = 1 + 9 * l;
        if (IN(pb + 0)) for (int rep = 0; rep < NREP(0); ++rep) { if (rep) xcd_barrier(bar); pg8::Gemm g{XB, WA, M, 4096, DM}; pg8::StaticOrder S; S.init(M, 4096, F.G, F.bid); pg8::EpiMix E{Zm, F.out, l};
            pg8::gemm_phase<pg8::EpiMix, pg8::StaticOrder, true>(F.lds + RING_OFF, g, S, E, wave0); }
        SEAM(pb + 0);
        if (IN(pb + 1)) for (int rep = 0; rep < NREP(1); ++rep) { if (rep) xcd_barrier(bar);
            __syncthreads(); REFRESH();
            for (int r2 = 0; r2 < NREP2(0); ++r2) for (int it = F.bid; it < 256; it += F.G) { a_prompt_item(F, l, it, Zm, Y); __syncthreads(); }
            REFRESH();
            for (int r2 = 0; r2 < NREP2(1); ++r2) for (int it = F.bid; it < 128; it += F.G) a_sample_task(F, l, 8 * it + F.wave, Zm, Y);
            __syncthreads(); REFRESH();
            for (int r2 = 0; r2 < NREP2(2); ++r2) for (int it = F.bid; it < 256; it += F.G) { b_prompt_item(F, l, it, Zm, Y); __syncthreads(); }
            REFRESH();
            for (int r2 = 0; r2 < NREP2(3); ++r2) for (int it = F.bid; it < 256; it += F.G) { cd_prompt_item(F, l, it, Zm, Y); __syncthreads(); }
            REFRESH();
            for (int r2 = 0; r2 < NREP2(4); ++r2) for (int it = F.bid; it < 128; it += F.G) { s_sample_item(F, l, it, Zm, Y); __syncthreads(); }
            REFRESH();
            const float* wbr = F.in[I_WBR] + (size_t)l * 4 * 512 * 1024;
            for (int r2 = 0; r2 < NREP2(5); ++r2) {
            convert_matrix<RM_ID>(F, wbr, 512, 1024, Bt3, 2048, 0, 0);
            convert_matrix<RM_ID>(F, wbr + (size_t)512 * 1024, 512, 1024, Bt3, 2048, 512, 0);
            convert_matrix<RM_ID>(F, wbr + (size_t)3 * 512 * 1024, 512, 1024, Bt3, 2048, 1536, 0);
            convert_matrix<RM_ID>(F, F.in[I_WOUT] + (size_t)l * DM * DM, DM, DM, Bt4, DM, 0, 0); }
            for (int r2 = 0; r2 < NREP2(6); ++r2) { REFRESH(); compose_pool(F, l, Bt3); REFRESH(); }
        }
        SEAM(pb + 1);
        if (IN(pb + 2)) for (int rep = 0; rep < NREP(2); ++rep) { if (rep) xcd_barrier(bar); pg8::Gemm g{XB, WA + (size_t)4096 * DM, M, 4096, DM}; pg8::StaticOrder S; S.init(M, 4096, F.G, F.bid); pg8::EpiGate E{Gb};
            pg8::gemm_phase<pg8::EpiGate, pg8::StaticOrder, true>(F.lds + RING_OFF, g, S, E, wave0); }
        SEAM(pb + 2);
        if (IN(pb + 3)) for (int rep = 0; rep < NREP(3); ++rep) { if (rep) xcd_barrier(bar); pg8::Gemm g{Y, Bt3, M, DM, 2048}; pg8::StaticOrder S; S.init(M, DM, F.G, F.bid); pg8::EpiMerge E{Gb, XB};
            pg8::gemm_phase<pg8::EpiMerge, pg8::StaticOrder, true>(F.lds + RING_OFF, g, S, E, wave0); }
        SEAM(pb + 3);
        if (IN(pb + 4)) for (int rep = 0; rep < NREP(4); ++rep) { if (rep) xcd_barrier(bar); pg8::Gemm g{XB, Bt4, M, DM, DM}; pg8::StaticOrder S; S.init(M, DM, F.G, F.bid);
            pg8::EpiRes E{l == 0 ? F.in[I_XP] : F.out, l == 0 ? F.in[I_XS] : F.out + (size_t)MP * DM, rep + 1 < NREP(4) ? (float*)(F.ws + WS_ZG) : F.out};
            pg8::gemm_phase<pg8::EpiRes, pg8::StaticOrder, true>(F.lds + RING_OFF, g, S, E, wave0); }
        SEAM(pb + 4);
        if (IN(pb + 5)) for (int rep = 0; rep < NREP(5); ++rep) { if (rep) xcd_barrier(bar);
            REFRESH();
            ln_rows(F, F.out, rep + 1 < NREP(5) ? (float*)(F.ws + WS_Y) : F.out, F.in[I_LN1G] + l * DM, F.in[I_LN1B] + l * DM, rep + 1 < NREP(5) ? nullptr : XB);
            REFRESH();
            convert_matrix<RM_GU>(F, F.in[I_WG] + (size_t)l * DM * FF, DM, FF, Bt5, DM, 0, 0);
            convert_matrix<RM_GU>(F, F.in[I_WU] + (size_t)l * DM * FF, DM, FF, Bt5, DM, 0, 128);
            convert_matrix<RM_ID>(F, F.in[I_WD] + (size_t)l * FF * DM, FF, DM, Bt6, FF, 0, 0);
        }
        SEAM(pb + 5);
        if (IN(pb + 6)) for (int rep = 0; rep < NREP(6); ++rep) { if (rep) xcd_barrier(bar); pg8::Gemm g{XB, Bt5, M, 2 * FF, DM}; pg8::StaticOrder S; S.init(M, 2 * FF, F.G, F.bid); pg8::EpiSwi E{Hb};
            pg8::gemm_phase<pg8::EpiSwi, pg8::StaticOrder, true>(F.lds + RING_OFF, g, S, E, wave0); }
        SEAM(pb + 6);
        if (IN(pb + 7)) for (int rep = 0; rep < NREP(7); ++rep) { if (rep) xcd_barrier(bar); pg8::Gemm g{Hb, Bt6, M, DM, FF}; pg8::StaticOrder S; S.init(M, DM, F.G, F.bid); pg8::EpiRes E{F.out, F.out + (size_t)MP * DM, rep + 1 < NREP(7) ? (float*)(F.ws + WS_Y) : F.out};
            pg8::gemm_phase<pg8::EpiRes, pg8::StaticOrder, true>(F.lds + RING_OFF, g, S, E, wave0); }
        SEAM(pb + 7);
        if (IN(pb + 8)) for (int rep = 0; rep < NREP(8); ++rep) { if (rep) xcd_barrier(bar);
            REFRESH();
            ln_rows(F, F.out, rep + 1 < NREP(8) ? (float*)(F.ws + WS_Y) : F.out, F.in[I_LN2G] + l * DM, F.in[I_LN2B] + l * DM, (l == 0 && rep + 1 == NREP(8)) ? XB : nullptr);
            REFRESH();
            if (l == 0) convert_matrix<RM_WIN>(F, F.in[I_WIN] + (size_t)DM * INC, DM, INC, WA, DM, 0, 0);
        }
        if (l == 0) SEAM(pb + 8);
    }
#undef IN
#undef SEAM
#undef REFRESH
}

extern "C" void kernel_launch(void* const* d_in, const int* in_sizes, int n_in, void* d_out, int out_size, void* d_ws, size_t ws_size, hipStream_t stream) {
    static int grid = 0;
    if (grid == 0) {
        if (n_in != 31 || out_size != (int)O_END || ws_size < WS_END) { fprintf(stderr, "kernel_launch: unexpected sizes n_in %d out %d ws %zu\n", n_in, out_size, ws_size); grid = -1; return; }
        int dev = 0, cus = 0, per_cu = 0;
        if (hipGetDevice(&dev) != hipSuccess || hipDeviceGetAttribute(&cus, hipDeviceAttributeMultiprocessorCount, dev) != hipSuccess) { grid = -1; return; }
        if (hipFuncSetAttribute((const void*)hybrid_fwd, hipFuncAttributeMaxDynamicSharedMemorySize, LDS_BYTES) != hipSuccess) { fprintf(stderr, "kernel_launch: hipFuncSetAttribute failed\n"); grid = -1; return; }
        if (hipOccupancyMaxActiveBlocksPerMultiprocessor(&per_cu, (const void*)hybrid_fwd, NWAVES * 64, LDS_BYTES) != hipSuccess || per_cu < 1)
            fprintf(stderr, "kernel_launch: occupancy query reports %d workgroups per CU\n", per_cu);
        (void)hipGetLastError();
        grid = cus;
    }
    if (grid < 0) return;
    if (hipMemsetAsync((char*)d_ws + WS_CTL, 0, CTL_ZERO_BYTES, stream) != hipSuccess) { fprintf(stderr, "kernel_launch: memset failed\n"); return; }
    Args a{};
    for (int i = 0; i < 31; ++i) a.in[i] = (const float*)d_in[i];
    a.out = (float*)d_out; a.ws = (unsigned char*)d_ws;
#if MK_SPLIT
    for (int ph = 0; ph < NPHASE; ++ph) { a.ph_lo = ph; a.ph_hi = ph + 1; hipLaunchKernelGGL(hybrid_fwd, dim3(grid), dim3(NWAVES * 64), LDS_BYTES, stream, a); }
#else
    a.ph_lo = 0; a.ph_hi = NPHASE;
    hipLaunchKernelGGL(hybrid_fwd, dim3(grid), dim3(NWAVES * 64), LDS_BYTES, stream, a);
#endif
}
```

```cpp
#include <hip/hip_runtime.h>
#include <cstdio>
#include <cstdint>

#ifndef PROBE_REP
#define PROBE_REP 0
#endif
#define NREP(k) (1 + ((PROBE_REP >> (k)) & 1))
#ifndef PROBE2
#define PROBE2 0
#endif
#define NREP2(j) (1 + ((PROBE2 >> (j)) & 1))
#ifndef MK_SPLIT
#define MK_SPLIT 0
#endif

constexpr int DM = 1024, WMIX = 512, NPB = 8, SEQ = 2048, NSB = 128, DSEQ = 4;
constexpr int MP = NPB * SEQ, MS = NSB * DSEQ, M = MP + MS;
constexpr int FF = 2816, INC = 8192, ZC = 3072, YC = 2048, GC = 4096;
constexpr float LN_EPS = 1e-5f, ALPHA = 1.41421356237f;
constexpr size_t O_Y = 0, O_PH = (size_t)M * DM, O_PRGC = O_PH + 8192, O_PCF = O_PRGC + 24576, O_PPOOL = O_PCF + 245760, O_PSC = O_PPOOL + 122880,
                 O_SH = O_PSC + 16384, O_SRGC = O_SH + 131072, O_SCF = O_SRGC + 393216, O_SPOOL = O_SCF + 3932160, O_SSC = O_SPOOL + 1966080, O_END = O_SSC + 262144;
static_assert(O_END == 24403968, "output map");

__device__ __forceinline__ int opqv(int v) { asm volatile("" : "+v"(v)); return v; }
__device__ __forceinline__ int lane_now() { int l; asm volatile("v_mbcnt_lo_u32_b32 %0, -1, 0\n\tv_mbcnt_hi_u32_b32 %0, -1, %0" : "=v"(l)); return l; }
__device__ __forceinline__ int opqs(int v) { asm volatile("" : "+s"(v)); return v; }
namespace pg8 {
#define PG8_LAS __attribute__((address_space(3)))
typedef unsigned short bf16_t;
typedef short bf16x8 __attribute__((ext_vector_type(8)));
typedef float f32x4 __attribute__((ext_vector_type(4)));
typedef float f32x2 __attribute__((ext_vector_type(2)));
typedef unsigned u32x4 __attribute__((ext_vector_type(4)));
typedef unsigned u32x2 __attribute__((ext_vector_type(2)));
typedef _Float16 f16x4 __attribute__((ext_vector_type(4)));
typedef _Float16 f16x8 __attribute__((ext_vector_type(8)));
constexpr int BM = 256, BK = 64, HALF = 128, HTB = HALF * BK * 2, STAGE_BYTES = 8 * HTB, NXCD = 8, WGM = 8;

__host__ __device__ __forceinline__ int lds_byte(int r, int c) { const int st = (r >> 4) * 2 + (c >> 5), rr = r & 15, cc = c & 31, ob = rr * 64 + cc * 2; return st * 1024 + (ob ^ (((ob >> 9) & 1) << 5)); }
__host__ __device__ __forceinline__ void stage_rc(int b, int& R, int& C) { const int st = b / 1024, sb = b % 1024, swz = sb ^ (((sb >> 9) & 1) << 5); R = (st >> 1) * 16 + swz / 64; C = (st & 1) * 32 + (swz % 64) / 2; }
__host__ __device__ __forceinline__ int perm32(int rho) { const int n = rho >> 4, i = rho & 15; return 8 * (i >> 2) + 4 * n + (i & 3); }

struct Unit { int pm, pn, nt, mode, aux; long offA, offB; };
struct Gemm { const bf16_t* A; const bf16_t* Bt; int lda, ldb; };

enum { SK_PLAIN = 0, SK_P3 = 1, SK_P4 = 2, SK_P6 = 3 };
struct UnitOrder {
    int kind, nN, nwgP, nS, ntP, G, c; long offA_s;
    __device__ __forceinline__ void init(int kind_, int N_, int K_, int G_, int c_, long offA_s_) { kind = kind_; nN = N_ / BM; nwgP = 64 * nN; ntP = K_ / BK; G = G_; c = c_; offA_s = offA_s_;
        nS = kind_ == SK_PLAIN ? 2 * nN : kind_ == SK_P3 ? 32 : kind_ == SK_P4 ? 64 : 88; }
    __device__ __forceinline__ bool next(int i, Unit& u, const Gemm& g) const {
        const long L = (long)i * G + c; const long ra = (long)BM * g.lda * 2, rb = (long)BM * g.ldb * 2;
        if (L < nwgP) {
            int wgid = (int)L; { const int q = nwgP / NXCD, xcd = wgid % NXCD, off = wgid / NXCD; wgid = xcd * q + off; }
            const int nig = WGM * nN; u.pm = (wgid / nig) * WGM + ((wgid % nig) % WGM); u.pn = (wgid % nig) / WGM;
            u.nt = ntP; u.mode = 0; u.aux = 0; u.offA = u.pm * ra; u.offB = u.pn * rb; return true; }
        const int s = (int)(L - nwgP); if (s >= nS) return false;
        if (kind == SK_PLAIN) { u.pm = 64 + (s & 1); u.pn = s >> 1; u.nt = ntP; u.mode = 0; u.aux = 0; u.offA = u.pm * ra; u.offB = u.pn * rb; }
        else if (kind == SK_P3) { const int n = s & 3, tile = s >> 2; u.pm = 64 + (tile & 1); u.pn = tile >> 1; u.nt = 8; u.mode = 1; u.aux = n; u.offA = u.pm * ra + 1024 * n; u.offB = u.pn * rb + 1024 * n; }
        else if (kind == SK_P4) { const int ch = s & 7, tile = s >> 3, n = ch >> 1, kin = (ch & 1) * 512; u.pm = 64 + (tile & 1); u.pn = tile >> 1; u.nt = 8; u.mode = 1; u.aux = ch;
            u.offA = offA_s + ((long)(n * 512 + (u.pm - 64) * 256) * 1024 + kin) * 2; u.offB = u.pn * rb + kin * 2; }
        else { const int ch = s % 11, tile = s / 11; u.pm = 64 + (tile & 1); u.pn = tile >> 1; u.nt = 4; u.mode = 1; u.aux = ch; u.offA = u.pm * ra + 512 * ch; u.offB = u.pn * rb + 512 * ch; }
        return true;
    }
};

__device__ __forceinline__ unsigned cvt_pk_bf16(float lo, float hi) { unsigned r; asm volatile("v_cvt_pk_bf16_f32 %0, %1, %2" : "=v"(r) : "v"(lo), "v"(hi)); return r; }
__device__ __forceinline__ float sigmoidf_fast(float x) { return __builtin_amdgcn_rcpf(1.0f + __builtin_amdgcn_exp2f(-1.44269504089f * x)); }
__device__ __forceinline__ float gelu_tanh(float x) { const float y = 1.5957691216057308f * (x + 0.044715f * x * x * x); return x * sigmoidf_fast(y); }

__device__ __forceinline__ float* state_ptr(float* out, int R, int keep, int layer, size_t p_off, size_t s_off) {
    if (R < MP) { const int b = R >> 11, j = (R & 2047) - (2048 - keep); return j < 0 ? nullptr : out + p_off + (size_t)((layer * 8 + b) * keep + j) * 512; }
    const int s = (R - MP) >> 2, j = (R & 3) + keep - 4; return j < 0 ? nullptr : out + s_off + (size_t)((layer * 128 + s) * keep + j) * 512;
}

struct EpiMix {
    static constexpr bool PERM = true, MIDK = false;
    bf16_t* Z; float* out; int layer;
    __device__ __forceinline__ void midk(f32x4 (&)[2][2][4][2], const Unit&, int, int, int, int, int) const {}
    __device__ __forceinline__ void operator()(f32x4 (&acc)[2][2][4][2], const Unit& u, int wr, int wc, int fr_, int fq_) const {
        const int lane_ = lane_now(), fr = lane_ & 15, fq = lane_ >> 4; (void)fr_; (void)fq_;
        const int pn = u.pn; int type, zcol, keep = 0, scol = 0; size_t poff = 0, soff = 0;
        if (pn < 2) { type = 0; zcol = 256 * pn; keep = 3; scol = zcol; poff = O_PRGC; soff = O_SRGC; }
        else if (pn < 4) { type = 1; zcol = 512 + 256 * (pn - 2); }
        else if (pn < 8) { type = 2; zcol = 1024 + 128 * (pn - 4); keep = 30; scol = 128 * (pn - 4); poff = O_PCF; soff = O_SCF; }
        else if (pn < 10) { type = 0; zcol = 1536 + 256 * (pn - 8); keep = 15; scol = 256 * (pn - 8); poff = O_PPOOL; soff = O_SPOOL; }
        else if (pn < 12) { type = 0; zcol = 2048 + 256 * (pn - 10); }
        else { type = 3; zcol = 2560 + 128 * (pn - 12); keep = 2; scol = 128 * (pn - 12); poff = O_PSC; soff = O_SSC; }
        const bool tail = keep != 0 && (u.pm >= 64 || (u.pm & 7) == 7);
        const int row0 = u.pm * BM + wr * 64 + fr, cl = wc * 32 + 8 * fq;
        if (type < 2) {
#pragma unroll
            for (int ai = 0; ai < 2; ++ai)
#pragma unroll
                for (int m = 0; m < 4; ++m) { const int R = row0 + ai * HALF + m * 16; bf16_t* rowp = Z + (size_t)R * ZC + zcol + cl;
                    float* sp = tail ? state_ptr(out, R, keep, layer, poff, soff) : nullptr;
#pragma unroll
                    for (int bj = 0; bj < 2; ++bj) { f32x4 v0 = acc[ai][bj][m][0], v1 = acc[ai][bj][m][1];
                        if (type == 1) { v0 = (f32x4){gelu_tanh(v0[0]), gelu_tanh(v0[1]), gelu_tanh(v0[2]), gelu_tanh(v0[3])}; v1 = (f32x4){gelu_tanh(v1[0]), gelu_tanh(v1[1]), gelu_tanh(v1[2]), gelu_tanh(v1[3])}; }
                        u32x4 w; w.x = cvt_pk_bf16(v0[0], v0[1]); w.y = cvt_pk_bf16(v0[2], v0[3]); w.z = cvt_pk_bf16(v1[0], v1[1]); w.w = cvt_pk_bf16(v1[2], v1[3]);
                        *(u32x4*)(rowp + bj * HALF) = w;
                        if (sp) { *(f32x4*)(sp + scol + cl + bj * HALF) = v0; *(f32x4*)(sp + scol + cl + bj * HALF + 4) = v1; } } }
        } else {
#pragma unroll
            for (int ai = 0; ai < 2; ++ai)
#pragma unroll
                for (int m = 0; m < 4; ++m) { const int R = row0 + ai * HALF + m * 16; bf16_t* rowp = Z + (size_t)R * ZC + zcol + cl;
                    float* sp = tail ? state_ptr(out, R, keep, layer, poff, soff) : nullptr;
                    f32x4 v0, v1; const f32x4 a0 = acc[ai][0][m][0], a1 = acc[ai][0][m][1], b0 = acc[ai][1][m][0], b1 = acc[ai][1][m][1];
                    if (type == 2) {
#pragma unroll
                        for (int i = 0; i < 4; ++i) { v0[i] = a0[i] * sigmoidf_fast(b0[i]); v1[i] = a1[i] * sigmoidf_fast(b1[i]); }
                    } else { v0 = a0 * b0; v1 = a1 * b1; }
                    u32x4 w; w.x = cvt_pk_bf16(v0[0], v0[1]); w.y = cvt_pk_bf16(v0[2], v0[3]); w.z = cvt_pk_bf16(v1[0], v1[1]); w.w = cvt_pk_bf16(v1[2], v1[3]);
                    *(u32x4*)rowp = w;
                    if (sp) { *(f32x4*)(sp + scol + cl) = v0; *(f32x4*)(sp + scol + cl + 4) = v1; } }
        }
    }
};

struct EpiGate {
    static constexpr bool PERM = true, MIDK = false;
    _Float16* G;
    __device__ __forceinline__ void midk(f32x4 (&)[2][2][4][2], const Unit&, int, int, int, int, int) const {}
    __device__ __forceinline__ void operator()(f32x4 (&acc)[2][2][4][2], const Unit& u, int wr, int wc, int fr_, int fq_) const {
        const int lane_ = lane_now(), fr = lane_ & 15, fq = lane_ >> 4; (void)fr_; (void)fq_;
        const int row0 = u.pm * BM + wr * 64 + fr, ch0 = 64 * u.pn + 16 * wc + 4 * fq; const bool plain = u.pm >= 64;
#pragma unroll
        for (int ai = 0; ai < 2; ++ai)
#pragma unroll
            for (int m = 0; m < 4; ++m) { const int R = row0 + ai * HALF + m * 16; _Float16* gp = G + (size_t)R * GC + ch0;
                f16x4 r0, r1, r2, g3;
#pragma unroll
                for (int i = 0; i < 4; ++i) {
                    const float z0 = fminf(fmaxf(acc[ai][0][m][0][i], -40.f), 40.f), z1 = fminf(fmaxf(acc[ai][0][m][1][i], -40.f), 40.f);
                    const float z2 = fminf(fmaxf(acc[ai][1][m][0][i], -40.f), 40.f), z3 = fminf(fmaxf(acc[ai][1][m][1][i], -40.f), 40.f);
                    const float d0 = 1.f + __builtin_amdgcn_exp2f(-1.44269504089f * z0), d1 = 1.f + __builtin_amdgcn_exp2f(-1.44269504089f * z1);
                    const float d2 = 1.f + __builtin_amdgcn_exp2f(-1.44269504089f * z2), d3 = 1.f + __builtin_amdgcn_exp2f(-1.44269504089f * z3);
                    const float i0 = __builtin_amdgcn_rcpf(d0), i1 = __builtin_amdgcn_rcpf(d1), i2 = __builtin_amdgcn_rcpf(d2), i3 = __builtin_amdgcn_rcpf(d3);
                    if (plain) { r0[i] = (_Float16)i0; r1[i] = (_Float16)i1; r2[i] = (_Float16)i2; }
                    else { r0[i] = (_Float16)fminf(d1 * i0, 65504.f); r1[i] = (_Float16)fminf(d2 * i1, 65504.f); r2[i] = (_Float16)fminf(d3 * i2, 65504.f); }
                    g3[i] = (_Float16)i3; }
                *(f16x4*)(gp) = r0; *(f16x4*)(gp + 1024) = r1; *(f16x4*)(gp + 2048) = r2; *(f16x4*)(gp + 3072) = g3; }
    }
};

struct EpiMerge {
    static constexpr bool PERM = false, MIDK = true;
    const _Float16* G; bf16_t* O; bf16_t* Os;
    __device__ __forceinline__ void scale(f32x4 (&acc)[2][2][4][2], const Unit& u, int seg, int wr, int wc) const {
        const int lane_ = lane_now(), fr = lane_ & 15, fq = lane_ >> 4;
        const int row0 = u.pm * BM + wr * 64 + fr, c0 = 1024 * seg + 256 * u.pn + wc * 32 + 4 * fq;
#pragma unroll
        for (int ai = 0; ai < 2; ++ai)
#pragma unroll
            for (int m = 0; m < 4; ++m) { const _Float16* gp = G + (size_t)(row0 + ai * HALF + m * 16) * GC + c0;
#pragma unroll
                for (int bj = 0; bj < 2; ++bj)
#pragma unroll
                    for (int n = 0; n < 2; ++n) { const f16x4 f = *(const f16x4*)(gp + bj * HALF + n * 16);
                        acc[ai][bj][m][n] *= (f32x4){(float)f[0], (float)f[1], (float)f[2], (float)f[3]}; }
                if (m == 3) asm volatile("" ::: "memory"); }
    }
    __device__ __forceinline__ void midk(f32x4 (&acc)[2][2][4][2], const Unit& u, int seg, int wr, int wc, int, int) const { scale(acc, u, seg, wr, wc); }
    __device__ __forceinline__ void operator()(f32x4 (&acc)[2][2][4][2], const Unit& u, int wr, int wc, int, int) const {
        scale(acc, u, u.mode ? u.aux : 3, wr, wc);
        const int lane_ = lane_now(), fr = lane_ & 15, fq = lane_ >> 4;
        const int row0 = (u.mode ? (u.pm - 64) * BM + 512 * u.aux : u.pm * BM) + wr * 64 + fr, c0 = 256 * u.pn + wc * 32 + 4 * fq;
        bf16_t* O = u.mode ? Os : this->O;
#pragma unroll
        for (int ai = 0; ai < 2; ++ai)
#pragma unroll
            for (int m = 0; m < 4; ++m) { bf16_t* rowp = O + (size_t)(row0 + ai * HALF + m * 16) * DM + c0;
#pragma unroll
                for (int bj = 0; bj < 2; ++bj)
#pragma unroll
                    for (int n = 0; n < 2; ++n) { const f32x4 v = acc[ai][bj][m][n]; u32x2 w; w.x = cvt_pk_bf16(v[0], v[1]); w.y = cvt_pk_bf16(v[2], v[3]); *(u32x2*)(rowp + bj * HALF + n * 16) = w; } }
    }
};

struct EpiRes {
    static constexpr bool PERM = false, MIDK = false;
    const float* baseP; const float* baseS; float* out; float* slab;
    __device__ __forceinline__ void midk(f32x4 (&)[2][2][4][2], const Unit&, int, int, int, int, int) const {}
    __device__ __forceinline__ void operator()(f32x4 (&acc)[2][2][4][2], const Unit& u, int wr, int wc, int fr_, int fq_) const {
        const int lane_ = lane_now(), fr = lane_ & 15, fq = lane_ >> 4; (void)fr_; (void)fq_;
        const int row0 = u.pm * BM + wr * 64 + fr, c0 = 256 * u.pn + wc * 32 + 4 * fq;
        if (u.mode) {
#pragma unroll
            for (int ai = 0; ai < 2; ++ai)
#pragma unroll
                for (int m = 0; m < 4; ++m) { float* op = slab + ((size_t)u.aux * 512 + (row0 - MP) + ai * HALF + m * 16) * DM + c0;
#pragma unroll
                    for (int bj = 0; bj < 2; ++bj)
#pragma unroll
                        for (int n = 0; n < 2; ++n) *(f32x4*)(op + bj * HALF + n * 16) = acc[ai][bj][m][n]; }
            return; }
#pragma unroll
        for (int ai = 0; ai < 2; ++ai)
#pragma unroll
            for (int m = 0; m < 4; ++m) { const int R = row0 + ai * HALF + m * 16;
                const float* bp = (R < MP ? baseP + (size_t)R * DM : baseS + (size_t)(R - MP) * DM) + c0; float* op = out + (size_t)R * DM + c0;
#pragma unroll
                for (int bj = 0; bj < 2; ++bj)
#pragma unroll
                    for (int n = 0; n < 2; ++n) { const f32x4 b = *(const f32x4*)(bp + bj * HALF + n * 16); *(f32x4*)(op + bj * HALF + n * 16) = b * ALPHA + acc[ai][bj][m][n]; }
                if (m & 1) asm volatile("" ::: "memory"); }
    }
};

struct EpiSwi {
    static constexpr bool PERM = true, MIDK = false;
    bf16_t* H;
    __device__ __forceinline__ void midk(f32x4 (&)[2][2][4][2], const Unit&, int, int, int, int, int) const {}
    __device__ __forceinline__ void operator()(f32x4 (&acc)[2][2][4][2], const Unit& u, int wr, int wc, int fr_, int fq_) const {
        const int lane_ = lane_now(), fr = lane_ & 15, fq = lane_ >> 4; (void)fr_; (void)fq_;
        const int row0 = u.pm * BM + wr * 64 + fr, c0 = 128 * u.pn + wc * 32 + 8 * fq;
#pragma unroll
        for (int ai = 0; ai < 2; ++ai)
#pragma unroll
            for (int m = 0; m < 4; ++m) { bf16_t* rowp = H + (size_t)(row0 + ai * HALF + m * 16) * FF + c0;
                const f32x4 g0 = acc[ai][0][m][0], g1 = acc[ai][0][m][1], u0 = acc[ai][1][m][0], u1 = acc[ai][1][m][1]; f32x4 v0, v1;
#pragma unroll
                for (int i = 0; i < 4; ++i) { v0[i] = g0[i] * sigmoidf_fast(g0[i]) * u0[i]; v1[i] = g1[i] * sigmoidf_fast(g1[i]) * u1[i]; }
                u32x4 w; w.x = cvt_pk_bf16(v0[0], v0[1]); w.y = cvt_pk_bf16(v0[2], v0[3]); w.z = cvt_pk_bf16(v1[0], v1[1]); w.w = cvt_pk_bf16(v1[2], v1[3]);
                *(u32x4*)rowp = w; }
    }
};

template <class Epi, class Sched, bool ALIGN_EPI>
__device__ __forceinline__ void gemm_phase(PG8_LAS unsigned char* lds, const Gemm g, const Sched& S, const Epi& E, int wave_id) {
    const int wid = opqs(wave_id), lane = lane_now(), tid = wid * 64 + lane, wr = wid >> 2, wc = wid & 3, fr = lane & 15, fq = lane >> 4;
    unsigned voffA[2], voffB[2];
#pragma unroll
    for (int i = 0; i < 2; ++i) { int R, C; stage_rc(tid * 16 + i * 8192, R, C); const int Rb = Epi::PERM ? ((R & ~31) + perm32(R & 31)) : R;
        voffA[i] = (unsigned)(R * g.lda + C) * 2u; voffB[i] = (unsigned)(Rb * g.ldb + C) * 2u; }
    const size_t kstep = (size_t)(BK * 2);
    const size_t hstepA = (size_t)HALF * g.lda * 2, hstepB = (size_t)HALF * g.ldb * 2;
    const unsigned ldsw = (unsigned)wid * 1024u;
    const int aoff = lds_byte(wr * 64 + fr, fq * 8), boff = lds_byte(wc * 32 + fr, fq * 8);
#define PG8_SA(b, h) (((b) * 2 + (h)) * HTB)
#define PG8_SB(b, h) ((4 + (b) * 2 + (h)) * HTB)
#define PG8_STAGE(bufoff, gbase, voff) do { _Pragma("unroll") for (int _i = 0; _i < 2; ++_i) \
        __builtin_amdgcn_global_load_lds((const unsigned*)((const char*)(gbase) + (voff)[_i]), (PG8_LAS unsigned*)(lds + (bufoff) + ldsw + _i * 8192), 16, 0, 0); } while (0)
#define PG8_LDA(dst, b, h) do { _Pragma("unroll") for (int m = 0; m < 4; ++m) _Pragma("unroll") for (int k = 0; k < 2; ++k) dst[m][k] = *(const PG8_LAS bf16x8*)(lds + PG8_SA(b, h) + aoff + m * 2048 + k * 1024); } while (0)
#define PG8_LDB(dst, b, h) do { _Pragma("unroll") for (int n = 0; n < 2; ++n) _Pragma("unroll") for (int k = 0; k < 2; ++k) dst[n][k] = *(const PG8_LAS bf16x8*)(lds + PG8_SB(b, h) + boff + n * 2048 + k * 1024); } while (0)
#define PG8_MMA(ai, bj, At, Bt) do { __builtin_amdgcn_s_setprio(1); _Pragma("unroll") for (int m = 0; m < 4; ++m) _Pragma("unroll") for (int n = 0; n < 2; ++n) _Pragma("unroll") for (int k = 0; k < 2; ++k) \
        acc[ai][bj][m][n] = __builtin_amdgcn_mfma_f32_16x16x32_bf16(Bt[n][k], At[m][k], acc[ai][bj][m][n], 0, 0, 0); __builtin_amdgcn_s_setprio(0); } while (0)
#define PG8_WAIT_V(n) asm volatile("s_waitcnt vmcnt(" #n ")" ::: "memory")
#define PG8_WAIT_L(n) asm volatile("s_waitcnt lgkmcnt(" #n ")" ::: "memory")
#define PG8_BAR __builtin_amdgcn_s_barrier()
#define PG8_SCHED __builtin_amdgcn_sched_barrier(0)
    Unit cur, nxt; int ui = 0;
    if (!S.next(0, cur, g)) return;
    f32x4 acc[2][2][4][2];
#pragma unroll
    for (int a = 0; a < 2; ++a)
#pragma unroll
        for (int b = 0; b < 2; ++b)
#pragma unroll
            for (int m = 0; m < 4; ++m)
#pragma unroll
                for (int n = 0; n < 2; ++n) acc[a][b][m][n] = (f32x4){0.f, 0.f, 0.f, 0.f};
    bf16x8 At[4][2], B0[2][2], B1[2][2];
    const char* cA = (const char*)g.A + cur.offA; const char* cB = (const char*)g.Bt + cur.offB;
    PG8_STAGE(PG8_SB(0, 0), cB, voffB); PG8_STAGE(PG8_SB(0, 1), cB + hstepB, voffB); PG8_STAGE(PG8_SA(0, 0), cA, voffA); PG8_STAGE(PG8_SA(0, 1), cA + hstepA, voffA);
    if (wr == 1) PG8_BAR;
    PG8_WAIT_V(2); PG8_BAR;
    PG8_STAGE(PG8_SB(1, 0), cB + kstep, voffB); PG8_STAGE(PG8_SA(1, 0), cA + kstep, voffA); PG8_STAGE(PG8_SB(1, 1), cB + hstepB + kstep, voffB);
    PG8_WAIT_V(6); PG8_BAR;
    for (;;) {
        const bool has_next = S.next(ui + 1, nxt, g);
        const char* nA = has_next ? (const char*)g.A + nxt.offA : cA; const char* nB = has_next ? (const char*)g.Bt + nxt.offB : cB;
        const int nt = cur.nt, TSEG = Epi::MIDK ? 8 : nt;
        for (int t0 = 0; t0 < nt; t0 += TSEG) {
        if constexpr (Epi::MIDK) { if (t0 != 0) { PG8_SCHED; E.midk(acc, cur, t0 / TSEG - 1, wr, wc, 0, 0); PG8_SCHED; } }
#pragma unroll 1
        for (int t = t0; t < t0 + TSEG; t += 2) {
            const bool last = (t == nt - 2);
            const char* a1 = cA + (size_t)(t + 1) * kstep;
            const char* a2 = last ? nA : cA + (size_t)(t + 2) * kstep; const char* b2 = last ? nB : cB + (size_t)(t + 2) * kstep;
            const char* a3 = a2 + kstep; const char* b3 = b2 + kstep;
            PG8_LDB(B0, 0, 0); PG8_LDB(B1, 0, 1); PG8_SCHED; PG8_LDA(At, 0, 0); PG8_STAGE(PG8_SA(1, 1), a1 + hstepA, voffA);
            PG8_WAIT_V(8); PG8_WAIT_L(0); PG8_BAR; PG8_MMA(0, 0, At, B0); PG8_MMA(0, 1, At, B1); PG8_BAR; PG8_SCHED;
            PG8_LDA(At, 0, 1); PG8_STAGE(PG8_SB(0, 0), b2, voffB); PG8_STAGE(PG8_SB(0, 1), b2 + hstepB, voffB); PG8_STAGE(PG8_SA(0, 0), a2, voffA);
            PG8_WAIT_V(8); PG8_WAIT_L(0); PG8_BAR; PG8_MMA(1, 0, At, B0); PG8_MMA(1, 1, At, B1); PG8_BAR; PG8_SCHED;
            PG8_LDB(B0, 1, 0); PG8_LDB(B1, 1, 1); PG8_SCHED; PG8_LDA(At, 1, 0); PG8_STAGE(PG8_SA(0, 1), a2 + hstepA, voffA);
            PG8_WAIT_V(8); PG8_WAIT_L(0); PG8_BAR; PG8_MMA(0, 0, At, B0); PG8_MMA(0, 1, At, B1); PG8_BAR; PG8_SCHED;
            PG8_LDA(At, 1, 1); PG8_STAGE(PG8_SB(1, 0), b3, voffB); PG8_STAGE(PG8_SB(1, 1), b3 + hstepB, voffB); PG8_STAGE(PG8_SA(1, 0), a3, voffA);
            PG8_WAIT_V(8); PG8_WAIT_L(0); PG8_BAR; PG8_MMA(1, 0, At, B0); PG8_MMA(1, 1, At, B1); PG8_BAR; PG8_SCHED;
        }
        }
        if constexpr (ALIGN_EPI) { if (wr == 0) PG8_BAR; }
        E(acc, cur, wr, wc, 0, 0);
        if (!has_next) break;
#pragma unroll
        for (int a = 0; a < 2; ++a)
#pragma unroll
            for (int b = 0; b < 2; ++b)
#pragma unroll
                for (int m = 0; m < 4; ++m)
#pragma unroll
                    for (int n = 0; n < 2; ++n) acc[a][b][m][n] = (f32x4){0.f, 0.f, 0.f, 0.f};
        cur = nxt; cA = nA; cB = nB; ++ui;
        if constexpr (ALIGN_EPI) { if (wr == 1) PG8_BAR; }
    }
    PG8_WAIT_V(0);
    if constexpr (!ALIGN_EPI) { if (wr == 0) PG8_BAR; }
    PG8_BAR;
#undef PG8_SA
#undef PG8_SB
#undef PG8_STAGE
#undef PG8_LDA
#undef PG8_LDB
#undef PG8_MMA
#undef PG8_WAIT_V
#undef PG8_WAIT_L
#undef PG8_BAR
#undef PG8_SCHED
}
}

constexpr int NWAVES = 8;
constexpr int NPHASE = 19;
constexpr size_t MiB = 1u << 20;
constexpr size_t WS_CTL = 0, CTL_ZERO_BYTES = 1 * MiB;
constexpr size_t WS_WA = 1 * MiB;
constexpr size_t WS_XB = 18 * MiB;
constexpr size_t WS_Y = 51 * MiB;
constexpr size_t WS_ZG = 117 * MiB;
constexpr size_t WS_BT3 = WS_WA, WS_BT4 = WS_WA + 4 * MiB, WS_BT5 = WS_ZG + 96 * MiB, WS_BT6 = WS_ZG + 108 * MiB;
constexpr size_t WS_MB4S = 249 * MiB;
constexpr size_t WS_SLAB = WS_Y;
constexpr size_t WS_END = 253 * MiB;
static_assert(WS_XB + (size_t)M * DM * 2 <= WS_Y && WS_Y + (size_t)M * YC * 2 <= WS_ZG && WS_ZG + (size_t)M * GC * 2 <= WS_MB4S && WS_SLAB + (size_t)11 * 512 * DM * 4 <= WS_ZG, "ws map");
static_assert((size_t)M * FF * 2 <= 96 * MiB && WS_BT5 + (size_t)2 * FF * DM * 2 <= WS_BT6 && WS_BT6 + (size_t)DM * FF * 2 <= WS_MB4S, "ws map 2");
constexpr int CW_TMO = 0, CW_CODE = 1, CW_BAR = 4096;
constexpr int RING_OFF = 0, RING_BYTES = 131072;
constexpr int LDSCTL_OFF = RING_BYTES, MISC_OFF = LDSCTL_OFF + 320;
constexpr int LDS_BYTES = 147456;

#define GAS __attribute__((address_space(1)))
#define LAS __attribute__((address_space(3)))
typedef unsigned short bf16;
typedef unsigned v4u __attribute__((ext_vector_type(4)));
typedef unsigned v2u __attribute__((ext_vector_type(2)));
typedef float f32x4 __attribute__((ext_vector_type(4)));
typedef float f32x2 __attribute__((ext_vector_type(2)));
typedef short bf16x8 __attribute__((ext_vector_type(8)));
typedef GAS unsigned gu32;
#define RLX_AGENT __ATOMIC_RELAXED, __HIP_MEMORY_SCOPE_AGENT
#define LDS_WAIT() asm volatile("s_waitcnt lgkmcnt(0)" ::: "memory")
#define VM_WAIT() asm volatile("s_waitcnt vmcnt(0)" ::: "memory")
__device__ __forceinline__ unsigned pk2(float lo, float hi) { return pg8::cvt_pk_bf16(lo, hi); }
__device__ __forceinline__ float bflo(unsigned v) { return __uint_as_float(v << 16); }
__device__ __forceinline__ float bfhi(unsigned v) { return __uint_as_float(v & 0xffff0000u); }
__device__ __forceinline__ float bf1(unsigned short h) { return __uint_as_float((unsigned)h << 16); }
__device__ __forceinline__ unsigned short f2bf(float f) { return (unsigned short)(pg8::cvt_pk_bf16(f, 0.f) & 0xffffu); }

#define XB_TMO      128
#define XB_XCNT(j)  (256  + 64 * (j))
#define XB_XSUB(j)  (1280 + 64 * (j))
#define XB_XGEN(j)  (2304 + 64 * (j))
#define XB_TOP      3328
#define XB_TOPGEN   3392
#define XCD_BAR_WORDS 3456
#define XB_SPIN_CAP (1u << 18)
__device__ __forceinline__ unsigned xb_ld(unsigned* p)              { return __hip_atomic_load(p, __ATOMIC_RELAXED, __HIP_MEMORY_SCOPE_AGENT); }
__device__ __forceinline__ unsigned xb_add(unsigned* p, unsigned v) { return __hip_atomic_fetch_add(p, v, __ATOMIC_RELAXED, __HIP_MEMORY_SCOPE_AGENT); }
__device__ __forceinline__ unsigned xb_xcc_id() { return (unsigned)__builtin_amdgcn_s_getreg((3 << 11) | 20) & 0xFu; }
#define XB_SPIN(cond, bar) do { unsigned _sp = 0; while (cond) { __builtin_amdgcn_s_sleep(1); \
    if ((++_sp & 255u) == 0u) { if (xb_ld(&(bar)[XB_TMO])) break; if (_sp > XB_SPIN_CAP) { atomicAdd(&(bar)[XB_TMO], 1u); break; } } } } while (0)
struct XcdBarrier { unsigned* bar; unsigned x; volatile LAS unsigned* st; };
__device__ __forceinline__ XcdBarrier xcd_barrier_post(unsigned* bar, volatile LAS unsigned* st) {
    XcdBarrier b; b.bar = bar; b.x = xb_xcc_id(); b.st = st;
    if (threadIdx.x == 0) (void)xb_add(&bar[XB_XCNT(b.x)], 1u);
    return b;
}
__device__ __forceinline__ void xcd_barrier_complete(unsigned* bar, unsigned x, unsigned& nloc, unsigned& nx) {
    const unsigned G = gridDim.x * gridDim.y * gridDim.z;
    unsigned sum, cnt, mine, sp = 0u;
    for (;;) {
        sum = 0u; cnt = 0u; mine = 0u;
#pragma unroll
        for (unsigned j = 0; j < 16; ++j) { const unsigned c = xb_ld(&bar[XB_XCNT(j)]); sum += c; cnt += (c > 0u) ? 1u : 0u; mine = (j == x) ? c : mine; }
        if (sum == G) break;
        __builtin_amdgcn_s_sleep(1);
        if ((++sp & 255u) == 0u) { if (xb_ld(&bar[XB_TMO])) break; if (sp > XB_SPIN_CAP) { atomicAdd(&bar[XB_TMO], 1u); break; } }
    }
    nloc = mine > 0u ? mine : 1u; nx = cnt > 0u ? cnt : 1u;
}
__device__ __forceinline__ void xcd_barrier(const XcdBarrier& b) {
    asm volatile("s_waitcnt vmcnt(0)" ::: "memory");
    __syncthreads();
    if (threadIdx.x == 0) {
        unsigned* bar = b.bar;
        __builtin_amdgcn_s_waitcnt(0);
        unsigned nloc = b.st[0], nx = b.st[1];
        if (nloc == 0u) { xcd_barrier_complete(bar, b.x, nloc, nx); b.st[0] = nloc; b.st[1] = nx; }
        const unsigned old = xb_add(&bar[XB_XSUB(b.x)], 1u);
        const unsigned gen = old / nloc;
        if (old + 1u == (gen + 1u) * nloc) {
            __builtin_amdgcn_fence(__ATOMIC_RELEASE, "agent");
            asm volatile("s_waitcnt vmcnt(0)" ::: "memory");
            const unsigned og = xb_add(&bar[XB_TOP], 1u);
            const unsigned tg = og / nx;
            if (og + 1u == (tg + 1u) * nx) xb_add(&bar[XB_TOPGEN], 1u);
            else XB_SPIN(xb_ld(&bar[XB_TOPGEN]) == tg, bar);
            __builtin_amdgcn_fence(__ATOMIC_ACQUIRE, "agent");
            xb_add(&bar[XB_XGEN(b.x)], 1u);
            asm volatile("s_waitcnt vmcnt(0)" ::: "memory");
        } else {
            XB_SPIN(xb_ld(&bar[XB_XGEN(b.x)]) == gen, bar);
            __builtin_amdgcn_fence(__ATOMIC_ACQUIRE, "agent");
            asm volatile("s_waitcnt vmcnt(0)" ::: "memory");
        }
    }
    __syncthreads();
}

struct Frame {
    LAS unsigned char* lds;
    volatile LAS unsigned* MISC;
    gu32* ctl;
    int tid, lane, wave, G, bid;
    const float* const* in;
    float* out;
    unsigned char* ws;
};
enum { I_XP = 0, I_XS, I_SH, I_SRGC, I_SCF, I_SPOOL, I_SSC, I_WIN, I_RGCW, I_RGCB, I_RGWA, I_RGBA, I_RGWX, I_RGBX, I_LAM, I_CFW, I_CFB, I_CFG, I_CFBB, I_POOLW, I_POOLS, I_SCW,
       I_WBR, I_WOUT, I_LN1G, I_LN1B, I_WG, I_WU, I_WD, I_LN2G, I_LN2B };

__device__ __forceinline__ float shfl_idx(float v, int src_lane) { return __builtin_bit_cast(float, __builtin_amdgcn_ds_bpermute(src_lane << 2, __builtin_bit_cast(int, v))); }
__device__ __forceinline__ float wave_sum(float v, int lane) {
#pragma unroll
    for (int o = 1; o < 64; o <<= 1) v += shfl_idx(v, lane ^ o);
    return v;
}

enum { RM_ID = 0, RM_WIN = 1, RM_GU = 2 };
template <int MODE> __device__ __forceinline__ int rowmap(int s, int extra) {
    if (MODE == RM_ID) return s;
    if (MODE == RM_GU) return 256 * (s >> 7) + (s & 127) + extra;
    if (s < 1024) return s;
    if (s < 2048) { const int j = ((s - 1024) >> 7) & 3; return 1024 + 256 * j + (s >= 1536 ? 128 : 0) + (s & 127); }
    if (s < 3072) return s;
    if (s < 4096) { const int j = ((s - 3072) >> 7) & 3; return 3072 + 256 * j + (s >= 3584 ? 128 : 0) + (s & 127); }
    const int g = (s - 4096) >> 10, ch = s & 1023, pn = ch >> 6, chl = ch & 63, wc = chl >> 4, fq = (chl >> 2) & 3, i = chl & 3;
    return 4096 + 256 * pn + 128 * (g >> 1) + 32 * wc + 8 * fq + 4 * (g & 1) + i;
}
template <int MODE>
__device__ __forceinline__ void transpose_item(const float* W, int K, int N, bf16* WT, int dst_ld, int dst_koff, int extra, LAS float* scr, int item, int lane) {
    const int nblk = N / 32, kb = item / nblk, nb = item % nblk, k0 = 64 * kb, n0 = 32 * nb;
#pragma unroll 8
    for (int i = 0; i < 32; ++i) { const int kk = 2 * i + (lane >> 5); scr[kk * 33 + (lane & 31)] = W[(size_t)(k0 + kk) * N + n0 + (lane & 31)]; }
    LDS_WAIT(); asm volatile("" ::: "memory");
    const int c = lane & 7;
#pragma unroll
    for (int j = 0; j < 4; ++j) { const int n = (lane >> 3) + 8 * j; const LAS float* s = scr + (8 * c) * 33 + n;
        v4u o; o.x = pk2(s[0 * 33], s[1 * 33]); o.y = pk2(s[2 * 33], s[3 * 33]); o.z = pk2(s[4 * 33], s[5 * 33]); o.w = pk2(s[6 * 33], s[7 * 33]);
        *(GAS v4u*)(WT + (size_t)rowmap<MODE>(n0 + n, extra) * dst_ld + dst_koff + k0 + 8 * c) = o; }
    LDS_WAIT(); asm volatile("" ::: "memory");
}
template <int MODE>
__device__ __forceinline__ void convert_matrix(Frame& F, const float* W, int K, int N, bf16* WT, int dst_ld, int dst_koff, int extra) {
    LAS float* scr = (LAS float*)(F.lds + RING_OFF + F.wave * 16384);
    const int gw = F.bid * NWAVES + F.wave, NGW = F.G * NWAVES, nitems = (K / 64) * (N / 32);
    for (int it = gw; it < nitems; it += NGW) transpose_item<MODE>(W, K, N, WT, dst_ld, dst_koff, extra, scr, it, F.lane);
}
__device__ __forceinline__ void compose_pool(Frame& F, int layer, bf16* Bt3) {
    const float* pw = F.in[I_POOLW] + (size_t)layer * 4 * 128 * 128; const float* ps = F.in[I_POOLS] + layer * 512; const float* Wb2 = F.in[I_WBR] + ((size_t)layer * 4 + 2) * 512 * 1024;
    const int gw = F.bid * NWAVES + F.wave, NGW = F.G * NWAVES, lane = F.lane;
    LAS float* Pl = (LAS float*)(F.lds + RING_OFF + F.wave * 16384);
    for (int id = gw; id < 512; id += NGW) {
        const int g = __builtin_amdgcn_readfirstlane(id >> 7), c0 = __builtin_amdgcn_readfirstlane(8 * ((id >> 3) & 15)), d0 = 128 * (id & 7) + 2 * lane;
#pragma unroll
        for (int k = 0; k < 4; ++k) { const int idx4 = lane + 64 * k, i = idx4 >> 5, e4 = (idx4 & 31) * 4;
            const f32x4 pv = *(const GAS f32x4*)(pw + ((size_t)g * 128 + c0 + i) * 128 + e4), sv = *(const GAS f32x4*)(ps + 128 * g + e4);
            Pl[(e4 + 0) * 8 + i] = pv.x * sv.x; Pl[(e4 + 1) * 8 + i] = pv.y * sv.y; Pl[(e4 + 2) * 8 + i] = pv.z * sv.z; Pl[(e4 + 3) * 8 + i] = pv.w * sv.w; }
        LDS_WAIT(); asm volatile("" ::: "memory");
        f32x2 acc[8];
#pragma unroll
        for (int i = 0; i < 8; ++i) acc[i] = (f32x2){0.f, 0.f};
        const float* wrow = Wb2 + (size_t)(128 * g) * 1024 + d0;
#pragma unroll 1
        for (int e0 = 0; e0 < 128; e0 += 8) {
            f32x2 wv[8];
#pragma unroll
            for (int k = 0; k < 8; ++k) wv[k] = *(const GAS f32x2*)(wrow + (size_t)(e0 + k) * 1024);
#pragma unroll
            for (int k = 0; k < 8; ++k) { const f32x4 p0 = *(const LAS f32x4*)(Pl + (e0 + k) * 8), p1 = *(const LAS f32x4*)(Pl + (e0 + k) * 8 + 4);
#pragma unroll
                for (int i = 0; i < 4; ++i) { acc[i] += wv[k] * p0[i]; acc[4 + i] += wv[k] * p1[i]; } }
        }
        v4u o0, o1;
        o0.x = pk2(acc[0].x, acc[1].x); o0.y = pk2(acc[2].x, acc[3].x); o0.z = pk2(acc[4].x, acc[5].x); o0.w = pk2(acc[6].x, acc[7].x);
        o1.x = pk2(acc[0].y, acc[1].y); o1.y = pk2(acc[2].y, acc[3].y); o1.z = pk2(acc[4].y, acc[5].y); o1.w = pk2(acc[6].y, acc[7].y);
        *(GAS v4u*)(Bt3 + (size_t)d0 * 2048 + 1024 + 128 * g + c0) = o0; *(GAS v4u*)(Bt3 + (size_t)(d0 + 1) * 2048 + 1024 + 128 * g + c0) = o1;
        LDS_WAIT(); asm volatile("" ::: "memory");
    }
}

__device__ __forceinline__ const float* xrow_in(Frame& F, int m) { return m < MP ? F.in[I_XP] + (size_t)m * DM : F.in[I_XS] + (size_t)(m - MP) * DM; }
__device__ __forceinline__ void x_to_bf16(Frame& F, bf16* XB) {
    const int gw = F.bid * NWAVES + F.wave, NGW = F.G * NWAVES;
    for (int m = gw; m < M; m += NGW) { const GAS f32x4* xr = (const GAS f32x4*)xrow_in(F, m) + F.lane; GAS v2u* o = (GAS v2u*)(XB + (size_t)m * DM) + F.lane;
#pragma unroll
        for (int j = 0; j < 4; ++j) { const f32x4 v = xr[64 * j]; o[64 * j] = (v2u){pk2(v.x, v.y), pk2(v.z, v.w)}; } }
}
__device__ __forceinline__ void ln_rows(Frame& F, const float* V, float* O, const float* g, const float* b, bf16* XB, const float* sbase, const float* slab, int nslab) {
    const int gw = F.bid * NWAVES + F.wave, NGW = F.G * NWAVES;
    f32x4 gv[4], bv[4];
#pragma unroll
    for (int j = 0; j < 4; ++j) { gv[j] = ((const GAS f32x4*)g)[F.lane + 64 * j]; bv[j] = ((const GAS f32x4*)b)[F.lane + 64 * j]; }
    for (int m = gw; m < M; m += NGW) {
        const GAS f32x4* xr = (const GAS f32x4*)(V + (size_t)m * DM) + F.lane; GAS f32x4* orow = (GAS f32x4*)(O + (size_t)m * DM) + F.lane;
        f32x4 v[4]; float s = 0.f;
#pragma unroll
        for (int j = 0; j < 4; ++j) v[j] = xr[64 * j];
        if (m >= MP) { const GAS f32x4* br = (const GAS f32x4*)(sbase + (size_t)(m - MP) * DM) + F.lane;
#pragma unroll
            for (int j = 0; j < 4; ++j) v[j] = br[64 * j] * ALPHA;
            for (int sl = 0; sl < nslab; ++sl) { const GAS f32x4* sr = (const GAS f32x4*)(slab + ((size_t)sl * 512 + (m - MP)) * DM) + F.lane;
#pragma unroll
                for (int j = 0; j < 4; ++j) v[j] += sr[64 * j]; } }
#pragma unroll
        for (int j = 0; j < 4; ++j) s += (v[j].x + v[j].y) + (v[j].z + v[j].w);
        const float mean = wave_sum(s, F.lane) * (1.f / DM); float s2 = 0.f;
#pragma unroll
        for (int j = 0; j < 4; ++j) { v[j] = v[j] - mean; s2 += (v[j].x * v[j].x + v[j].y * v[j].y) + (v[j].z * v[j].z + v[j].w * v[j].w); }
        const float rstd = 1.f / sqrtf(wave_sum(s2, F.lane) * (1.f / DM) + LN_EPS);
#pragma unroll
        for (int j = 0; j < 4; ++j) { v[j] = v[j] * rstd * gv[j] + bv[j]; orow[64 * j] = v[j]; }
        if (XB) { GAS v2u* o = (GAS v2u*)(XB + (size_t)m * DM) + F.lane;
#pragma unroll
            for (int j = 0; j < 4; ++j) o[64 * j] = (v2u){pk2(v[j].x, v[j].y), pk2(v[j].z, v[j].w)}; }
    }
}

__device__ __forceinline__ float softplusf_acc(float x) { return fmaxf(x, 0.f) + log1pf(__expf(-fabsf(x))); }
__device__ __forceinline__ float expm1_neg(float x) {
    const float p = x * (1.f + x * (0.5f + x * (1.f / 6.f + x * (1.f / 24.f + x * (1.f / 120.f + x * (1.f / 720.f + x * (1.f / 5040.f)))))));
    return x > -0.25f ? p : __expf(x) - 1.f;
}
constexpr int PATCH_STRIDE = 144;

struct ALane {
    const LAS float* tab;
    float cwD[4], cbD, ba, bx, ck;
    bf16x8 Ba0, Ba1, Bx0, Bx1;
};
constexpr int PATCH_BYTES = 5120, ASLOT_OFF = 8 * PATCH_BYTES, ATAB_OFF = ASLOT_OFF + 2048, ATAB_BYTES = 1280;
__device__ __forceinline__ void a_setup(Frame& F, int layer, int n, int q, ALane& L) {
    const int c = F.lane & 15, kg = F.lane >> 4, och = 64 * n + 16 * q + c;
    const float* cw = F.in[I_RGCW] + (size_t)layer * 4 * 512; const float* cb = F.in[I_RGCB] + layer * 512;
    LAS float* tab = (LAS float*)(F.lds + RING_OFF + ATAB_OFF + F.wave * ATAB_BYTES);
#pragma unroll
    for (int k = 0; k < 5; ++k) { const int idx = F.lane + 64 * k, tg = idx / 80, rem = idx - 80 * tg, j = rem >> 4, e = rem & 15, ch = 64 * n + (e < 8 ? 8 * tg + e : 32 + 8 * tg + (e - 8));
        tab[idx] = j < 4 ? cw[j * 512 + ch] : cb[ch]; }
    L.tab = tab + 80 * kg;
#pragma unroll
    for (int j = 0; j < 4; ++j) L.cwD[j] = cw[j * 512 + och];
    L.cbD = cb[och]; L.ba = F.in[I_RGBA][layer * 512 + och]; L.bx = F.in[I_RGBX][layer * 512 + och];
    L.ck = 8.0f * softplusf_acc(-F.in[I_LAM][layer * 512 + och]);
    const float* wa = F.in[I_RGWA] + ((size_t)layer * 8 + n) * 4096 + 16 * q + c; const float* wx = F.in[I_RGWX] + ((size_t)layer * 8 + n) * 4096 + 16 * q + c;
    unsigned a0[4], a1[4], x0[4], x1[4];
#pragma unroll
    for (int w = 0; w < 4; ++w) {
        a0[w] = pk2(wa[(8 * kg + 2 * w) * 64], wa[(8 * kg + 2 * w + 1) * 64]); a1[w] = pk2(wa[(32 + 8 * kg + 2 * w) * 64], wa[(32 + 8 * kg + 2 * w + 1) * 64]);
        x0[w] = pk2(wx[(8 * kg + 2 * w) * 64], wx[(8 * kg + 2 * w + 1) * 64]); x1[w] = pk2(wx[(32 + 8 * kg + 2 * w) * 64], wx[(32 + 8 * kg + 2 * w + 1) * 64]); }
    L.Ba0 = __builtin_bit_cast(bf16x8, (v4u){a0[0], a0[1], a0[2], a0[3]}); L.Ba1 = __builtin_bit_cast(bf16x8, (v4u){a1[0], a1[1], a1[2], a1[3]});
    L.Bx0 = __builtin_bit_cast(bf16x8, (v4u){x0[0], x0[1], x0[2], x0[3]}); L.Bx1 = __builtin_bit_cast(bf16x8, (v4u){x1[0], x1[1], x1[2], x1[3]});
    LDS_WAIT(); asm volatile("" ::: "memory");
}
__device__ __forceinline__ void a_block(const ALane& L, const LAS unsigned char* patch, int rowA0, int baseD, int q, int lane, float (&a)[4], float (&bb)[4]) {
    const int c = lane & 15, kg = lane >> 4;
    float x[16];
    { const f32x4 b0 = *(const LAS f32x4*)(L.tab + 64), b1 = *(const LAS f32x4*)(L.tab + 68), b2 = *(const LAS f32x4*)(L.tab + 72), b3 = *(const LAS f32x4*)(L.tab + 76);
#pragma unroll
      for (int e = 0; e < 4; ++e) { x[e] = b0[e]; x[4 + e] = b1[e]; x[8 + e] = b2[e]; x[12 + e] = b3[e]; } }
#pragma unroll
    for (int j = 0; j < 4; ++j) { const LAS unsigned char* rp = patch + (rowA0 + j) * PATCH_STRIDE + 16 * kg;
        const v4u v0 = *(const LAS v4u*)rp, v1 = *(const LAS v4u*)(rp + 64);
        const f32x4 t0 = *(const LAS f32x4*)(L.tab + 16 * j), t1 = *(const LAS f32x4*)(L.tab + 16 * j + 4), t2 = *(const LAS f32x4*)(L.tab + 16 * j + 8), t3 = *(const LAS f32x4*)(L.tab + 16 * j + 12);
#pragma unroll
        for (int w = 0; w < 2; ++w) { x[2 * w] += t0[2 * w] * bflo(v0[w]); x[2 * w + 1] += t0[2 * w + 1] * bfhi(v0[w]);
                                      x[4 + 2 * w] += t1[2 * w] * bflo(v0[2 + w]); x[5 + 2 * w] += t1[2 * w + 1] * bfhi(v0[2 + w]);
                                      x[8 + 2 * w] += t2[2 * w] * bflo(v1[w]); x[9 + 2 * w] += t2[2 * w + 1] * bfhi(v1[w]);
                                      x[12 + 2 * w] += t3[2 * w] * bflo(v1[2 + w]); x[13 + 2 * w] += t3[2 * w + 1] * bfhi(v1[2 + w]); } }
    const bf16x8 A0 = __builtin_bit_cast(bf16x8, (v4u){pk2(x[0], x[1]), pk2(x[2], x[3]), pk2(x[4], x[5]), pk2(x[6], x[7])});
    const bf16x8 A1 = __builtin_bit_cast(bf16x8, (v4u){pk2(x[8], x[9]), pk2(x[10], x[11]), pk2(x[12], x[13]), pk2(x[14], x[15])});
    f32x4 accR = (f32x4){0.f, 0.f, 0.f, 0.f}, accI = (f32x4){0.f, 0.f, 0.f, 0.f};
    accR = __builtin_amdgcn_mfma_f32_16x16x32_bf16(A0, L.Ba0, accR, 0, 0, 0); accR = __builtin_amdgcn_mfma_f32_16x16x32_bf16(A1, L.Ba1, accR, 0, 0, 0);
    accI = __builtin_amdgcn_mfma_f32_16x16x32_bf16(A0, L.Bx0, accI, 0, 0, 0); accI = __builtin_amdgcn_mfma_f32_16x16x32_bf16(A1, L.Bx1, accI, 0, 0, 0);
    float pv[7];
#pragma unroll
    for (int k = 0; k < 7; ++k) pv[k] = bf1(*(const LAS unsigned short*)(patch + (baseD + k) * PATCH_STRIDE + 2 * (16 * q + c)));
#pragma unroll
    for (int r = 0; r < 4; ++r) {
        const float xd = L.cbD + L.cwD[0] * pv[r] + L.cwD[1] * pv[r + 1] + L.cwD[2] * pv[r + 2] + L.cwD[3] * pv[r + 3];
        const float rr = pg8::sigmoidf_fast(accR[r] + L.ba), ii = pg8::sigmoidf_fast(accI[r] + L.bx);
        const float la = -L.ck * rr;
        a[r] = __expf(la); bb[r] = sqrtf(fmaxf(-expm1_neg(2.f * la), 0.f)) * (ii * xd);
    }
}
struct BlkScan { float Ac[4], Bc[4], EA, EB, WA, WB; };
__device__ __forceinline__ void blk_scan(const float (&a)[4], const float (&bb)[4], int lane, BlkScan& S) {
    const int c = lane & 15, g = lane >> 4;
    S.Ac[0] = a[0]; S.Bc[0] = bb[0];
#pragma unroll
    for (int r = 1; r < 4; ++r) { S.Ac[r] = a[r] * S.Ac[r - 1]; S.Bc[r] = a[r] * S.Bc[r - 1] + bb[r]; }
    float IA = S.Ac[3], IB = S.Bc[3];
    { const float pa = shfl_idx(IA, lane - 16), pb = shfl_idx(IB, lane - 16); if (g >= 1) { IB = IA * pb + IB; IA = IA * pa; } }
    { const float pa = shfl_idx(IA, lane - 32), pb = shfl_idx(IB, lane - 32); if (g >= 2) { IB = IA * pb + IB; IA = IA * pa; } }
    S.EA = shfl_idx(IA, lane - 16); S.EB = shfl_idx(IB, lane - 16); if (g == 0) { S.EA = 1.f; S.EB = 0.f; }
    S.WA = shfl_idx(IA, 48 + c); S.WB = shfl_idx(IB, 48 + c);
}
__device__ __forceinline__ void a_prompt_item(Frame& F, int layer, int item, const bf16* Z, bf16* Y) {
    const int b = item >> 5, n = (item >> 2) & 7, q = item & 3, lane = opqv(F.lane), w = F.wave, c = lane & 15, g = lane >> 4, och = 64 * n + 16 * q + c;
    ALane L; a_setup(F, layer, n, q, L);
    LAS unsigned char* patch = F.lds + RING_OFF + w * PATCH_BYTES;
    LAS f32x2* slots = (LAS f32x2*)(F.lds + RING_OFF + ASLOT_OFF);
    const bf16* Zb = Z + (size_t)b * SEQ * ZC;
    float hrun = 0.f;
    v4u pf[5];
    auto load_patch = [&](int tb) {
#pragma unroll
        for (int k = 0; k < 5; ++k) { const int ci = lane + 64 * k, pr = ci >> 3, cc = ci & 7, t = tb - 3 + pr;
            pf[k] = (ci < 280 && t >= 0) ? *(const GAS v4u*)(Zb + (size_t)t * ZC + 64 * n + 8 * cc) : (v4u){0u, 0u, 0u, 0u}; }
    };
    load_patch(32 * w);
    for (int it = 0; it < 8; ++it) {
        const int tb = 256 * it + 32 * w;
#pragma unroll
        for (int k = 0; k < 5; ++k) { const int ci = lane + 64 * k, pr = ci >> 3, cc = ci & 7; if (ci < 280) *(LAS v4u*)(patch + pr * PATCH_STRIDE + 16 * cc) = pf[k]; }
        if (it < 7) load_patch(tb + 256);
        unsigned short gav[8];
#pragma unroll
        for (int r = 0; r < 8; ++r) gav[r] = *(const GAS unsigned short*)(Zb + (size_t)(tb + 16 * (r >> 2) + 4 * g + (r & 3)) * ZC + 512 + och);
        asm volatile("" ::: "memory");
        float a0[4], b0[4], a1[4], b1[4];
        a_block(L, patch, lane & 15, 4 * g, q, lane, a0, b0);
        a_block(L, patch, 16 + (lane & 15), 16 + 4 * g, q, lane, a1, b1);
        BlkScan S0, S1; blk_scan(a0, b0, lane, S0); blk_scan(a1, b1, lane, S1);
        if (lane < 16) slots[((it & 1) * 8 + w) * 16 + c] = (f32x2){S0.WA * S1.WA, S1.WA * S0.WB + S1.WB};
        __syncthreads();
        float hin = hrun, hw = 0.f;
#pragma unroll
        for (int ww = 0; ww < 8; ++ww) { const f32x2 s = slots[((it & 1) * 8 + ww) * 16 + c]; if (ww == w) hw = hin; hin = s.x * hin + s.y; }
        hrun = hin;
        const float hg0 = S0.EA * hw + S0.EB, hw1 = S0.WA * hw + S0.WB, hg1 = S1.EA * hw1 + S1.EB;
#pragma unroll
        for (int r = 0; r < 4; ++r) { const float h = S0.Ac[r] * hg0 + S0.Bc[r];
            *(GAS unsigned short*)(Y + (size_t)(b * SEQ + tb + 4 * g + r) * YC + och) = f2bf(h * bf1(gav[r])); }
#pragma unroll
        for (int r = 0; r < 4; ++r) { const float h = S1.Ac[r] * hg1 + S1.Bc[r];
            *(GAS unsigned short*)(Y + (size_t)(b * SEQ + tb + 16 + 4 * g + r) * YC + och) = f2bf(h * bf1(gav[4 + r]));
            if (r == 3 && it == 7 && w == 7 && g == 3) F.out[O_PH + (size_t)(layer * 8 + b) * 512 + och] = h; }
    }
}
__device__ __forceinline__ void a_sample_task(Frame& F, int layer, int task, const bf16* Z, bf16* Y) {
    const int blk = task >> 5, n = (task >> 2) & 7, q = task & 3, lane = opqv(F.lane), c = lane & 15, g = lane >> 4, och = 64 * n + 16 * q + c, s0 = 4 * blk;
    ALane L; a_setup(F, layer, n, q, L);
    LAS unsigned char* patch = F.lds + RING_OFF + F.wave * PATCH_BYTES;
#pragma unroll
    for (int k = 0; k < 4; ++k) { const int ci = lane + 64 * k; if (ci < 224) { const int pr = ci >> 3, cc = ci & 7, sq = pr / 7, tau = pr - 7 * sq - 3, seq = s0 + sq; v4u v;
            if (tau < 0) { const GAS f32x4* sp = (const GAS f32x4*)(F.in[I_SRGC] + ((size_t)(layer * 128 + seq) * 3 + (tau + 3)) * 512 + 64 * n + 8 * cc); const f32x4 f0 = sp[0], f1 = sp[1];
                v = (v4u){pk2(f0.x, f0.y), pk2(f0.z, f0.w), pk2(f1.x, f1.y), pk2(f1.z, f1.w)}; }
            else v = *(const GAS v4u*)(Z + (size_t)(MP + 4 * seq + tau) * ZC + 64 * n + 8 * cc);
            *(LAS v4u*)(patch + pr * PATCH_STRIDE + 16 * cc) = v; } }
    asm volatile("" ::: "memory");
    float a[4], bb[4];
    a_block(L, patch, 7 * ((lane & 15) >> 2) + (lane & 3), 7 * g, q, lane, a, bb);
    const int seq = s0 + g;
    float h = F.in[I_SH][(size_t)(layer * 128 + seq) * 512 + och];
#pragma unroll
    for (int r = 0; r < 4; ++r) { h = a[r] * h + bb[r]; const size_t row = (size_t)(MP + 4 * seq + r);
        *(GAS unsigned short*)(Y + row * YC + och) = f2bf(h * bf1(*(const GAS unsigned short*)(Z + row * ZC + 512 + och))); }
    F.out[O_SH + (size_t)(layer * 128 + seq) * 512 + och] = h;
}

__device__ __forceinline__ void ln_silu_row(const LAS float* xr, const float* g, const float* b, bf16* dst, int lane) {
    const f32x4 v0 = *(const LAS f32x4*)(xr + 4 * lane), v1 = *(const LAS f32x4*)(xr + 256 + 4 * lane);
    const float s = (v0.x + v0.y) + (v0.z + v0.w) + (v1.x + v1.y) + (v1.z + v1.w);
    const float mean = wave_sum(s, lane) * (1.f / 512.f);
    const f32x4 d0 = v0 - mean, d1 = v1 - mean;
    const float s2 = (d0.x * d0.x + d0.y * d0.y) + (d0.z * d0.z + d0.w * d0.w) + (d1.x * d1.x + d1.y * d1.y) + (d1.z * d1.z + d1.w * d1.w);
    const float rstd = 1.f / sqrtf(wave_sum(s2, lane) * (1.f / 512.f) + LN_EPS);
    const f32x4 g0 = *(const GAS f32x4*)(g + 4 * lane), g1 = *(const GAS f32x4*)(g + 256 + 4 * lane), b0 = *(const GAS f32x4*)(b + 4 * lane), b1 = *(const GAS f32x4*)(b + 256 + 4 * lane);
    f32x4 y0 = d0 * rstd * g0 + b0, y1 = d1 * rstd * g1 + b1;
#pragma unroll
    for (int i = 0; i < 4; ++i) { y0[i] = y0[i] * pg8::sigmoidf_fast(y0[i]); y1[i] = y1[i] * pg8::sigmoidf_fast(y1[i]); }
    *(GAS v2u*)(dst + 4 * lane) = (v2u){pk2(y0.x, y0.y), pk2(y0.z, y0.w)}; *(GAS v2u*)(dst + 256 + 4 * lane) = (v2u){pk2(y1.x, y1.y), pk2(y1.z, y1.w)};
}
__device__ __forceinline__ void b_prompt_item(Frame& F, int layer, int item, const bf16* Z, bf16* Y) {
    const int tidl = opqv(F.tid), b = item >> 5, t0 = 64 * (item & 31), p = tidl & 255, hh = tidl >> 8, ts = t0 + 32 * hh;
    const GAS unsigned* Zu = (const GAS unsigned*)(Z + (size_t)b * SEQ * ZC) + 512 + p;
    unsigned raw[62];
#pragma unroll
    for (int i = 0; i < 62; ++i) { const int t = ts - 30 + i; raw[i] = t >= 0 ? Zu[(size_t)t * (ZC / 2)] : 0u; }
    const float* cw = F.in[I_CFW] + (size_t)layer * 31 * 512 + 2 * p;
    f32x2 wj[31];
#pragma unroll
    for (int j = 0; j < 31; ++j) wj[j] = *(const GAS f32x2*)(cw + j * 512);
    const f32x2 bias = *(const GAS f32x2*)(F.in[I_CFB] + layer * 512 + 2 * p);
    f32x2 in[62];
#pragma unroll
    for (int i = 0; i < 62; ++i) in[i] = (f32x2){bflo(raw[i]), bfhi(raw[i])};
    LAS float* obuf = (LAS float*)(F.lds + RING_OFF);
#pragma unroll
    for (int i = 0; i < 32; ++i) { f32x2 o = bias;
#pragma unroll
        for (int j = 0; j < 31; ++j) o += wj[j] * in[i + j];
        *(LAS f32x2*)(obuf + (32 * hh + i) * 512 + 2 * p) = o; }
    __syncthreads();
    const float* lg = F.in[I_CFG] + layer * 512; const float* lb = F.in[I_CFBB] + layer * 512;
#pragma unroll 1
    for (int r = F.wave; r < 64; r += 8) ln_silu_row(obuf + r * 512, lg, lb, Y + (size_t)(b * SEQ + t0 + r) * YC + 512, F.lane);
}
__device__ __forceinline__ void cd_prompt_item(Frame& F, int layer, int item, const bf16* Z, bf16* Y) {
    const int tidl = opqv(F.tid), b = item >> 5, t0 = 64 * (item & 31), p = tidl & 255, hh = tidl >> 8;
    const bf16* Zb = Z + (size_t)b * SEQ * ZC;
    LAS unsigned* cbuf = (LAS unsigned*)(F.lds + RING_OFF);
    for (int ci = tidl; ci < 79 * 64; ci += 512) { const int pr = ci >> 6, cc = ci & 63, t = t0 - 15 + pr;
        const v4u v = t >= 0 ? *(const GAS v4u*)(Zb + (size_t)t * ZC + 1536 + 8 * cc) : (v4u){0u, 0u, 0u, 0u};
        *(LAS v4u*)(cbuf + pr * 256 + 4 * cc) = v; }
    const int ts = t0 + 32 * hh;
    unsigned uu[34], dd[32];
#pragma unroll
    for (int i = 0; i < 34; ++i) { const int t = ts - 2 + i; uu[i] = t >= 0 ? ((const GAS unsigned*)(Zb + (size_t)t * ZC))[1280 + p] : 0u; }
#pragma unroll
    for (int i = 0; i < 32; ++i) dd[i] = ((const GAS unsigned*)(Zb + (size_t)(ts + i) * ZC))[1024 + p];
    const f32x2 w0 = ((const GAS f32x2*)(F.in[I_SCW] + (size_t)(layer * 3 + 0) * 512))[p], w1 = ((const GAS f32x2*)(F.in[I_SCW] + (size_t)(layer * 3 + 1) * 512))[p],
                w2 = ((const GAS f32x2*)(F.in[I_SCW] + (size_t)(layer * 3 + 2) * 512))[p];
    __syncthreads();
    const int w = 2 << (p >> 6), rr0 = 15 + 32 * hh;
    f32x2 s = (f32x2){0.f, 0.f};
    for (int j = 0; j < w; ++j) { const unsigned v = cbuf[(rr0 - j) * 256 + p]; s += (f32x2){bflo(v), bfhi(v)}; }
    GAS unsigned* Yu = (GAS unsigned*)(Y + (size_t)(b * SEQ + ts) * YC) + p;
#pragma unroll
    for (int i = 0; i < 32; ++i) { const int t = ts + i, rr = rr0 + i;
        const unsigned cur = cbuf[rr * 256 + p]; const f32x2 cf = (f32x2){bflo(cur), bfhi(cur)};
        if (i > 0) { const unsigned old = cbuf[(rr - w) * 256 + p]; s += cf - (f32x2){bflo(old), bfhi(old)}; }
        const float ic = __builtin_amdgcn_rcpf((float)(t + 1 < w ? t + 1 : w));
        const f32x2 mm = s * ic - cf;
        Yu[(size_t)i * 1024 + 512] = pk2(mm.x, mm.y);
        const f32x2 cv = w0 * (f32x2){bflo(uu[i]), bfhi(uu[i])} + w1 * (f32x2){bflo(uu[i + 1]), bfhi(uu[i + 1])} + w2 * (f32x2){bflo(uu[i + 2]), bfhi(uu[i + 2])};
        const f32x2 yd = (f32x2){bflo(dd[i]), bfhi(dd[i])} * cv;
        Yu[(size_t)i * 1024 + 768] = pk2(yd.x, yd.y); }
}
__device__ __forceinline__ void s_sample_item(Frame& F, int layer, int s, const bf16* Z, bf16* Y) {
    const int ch = opqv(F.tid); const size_t ls = (size_t)layer * 128 + s;
    const bf16* Zr = Z + (size_t)(MP + 4 * s) * ZC; bf16* Yr = Y + (size_t)(MP + 4 * s) * YC;
    LAS float* obuf = (LAS float*)(F.lds + RING_OFF);
    {
        float in[34], wv[31];
#pragma unroll
        for (int j = 0; j < 30; ++j) in[j] = (F.in[I_SCF] + (ls * 30 + j) * 512)[ch];
#pragma unroll
        for (int r = 0; r < 4; ++r) in[30 + r] = bf1((Zr + (size_t)r * ZC + 1024)[ch]);
#pragma unroll
        for (int j = 0; j < 31; ++j) wv[j] = (F.in[I_CFW] + ((size_t)layer * 31 + j) * 512)[ch];
        const float bias = (F.in[I_CFB] + layer * 512)[ch];
#pragma unroll
        for (int j = 0; j < 26; ++j) (F.out + O_SCF + (ls * 30 + j) * 512)[ch] = in[j + 4];
#pragma unroll
        for (int r = 0; r < 4; ++r) { float o = bias;
#pragma unroll
            for (int j = 0; j < 31; ++j) o += wv[j] * in[r + j];
            obuf[r * 512 + ch] = o; }
    }
    {
        float pb[19];
#pragma unroll
        for (int j = 0; j < 15; ++j) pb[j] = (F.in[I_SPOOL] + (ls * 15 + j) * 512)[ch];
#pragma unroll
        for (int r = 0; r < 4; ++r) pb[15 + r] = bf1((Zr + (size_t)r * ZC + 1536)[ch]);
#pragma unroll
        for (int j = 0; j < 11; ++j) (F.out + O_SPOOL + (ls * 15 + j) * 512)[ch] = pb[j + 4];
        const int gsel = ch >> 7;
#pragma unroll
        for (int r = 0; r < 4; ++r) { const int k = 15 + r;
            const float s2 = pb[k] + pb[k - 1], s4 = s2 + pb[k - 2] + pb[k - 3], s8 = s4 + (pb[k - 4] + pb[k - 5]) + (pb[k - 6] + pb[k - 7]);
            float s16 = s8;
#pragma unroll
            for (int j = 8; j < 16; ++j) s16 += pb[k - j];
            const float mv = (gsel == 0 ? s2 * 0.5f : gsel == 1 ? s4 * 0.25f : gsel == 2 ? s8 * 0.125f : s16 * 0.0625f) - pb[k];
            (Yr + (size_t)r * YC + 1024)[ch] = f2bf(mv); }
    }
    {
        float u[6];
        u[0] = (F.in[I_SSC] + (ls * 2 + 0) * 512)[ch]; u[1] = (F.in[I_SSC] + (ls * 2 + 1) * 512)[ch];
#pragma unroll
        for (int r = 0; r < 4; ++r) u[2 + r] = bf1((Zr + (size_t)r * ZC + 2560)[ch]);
        const float w0 = (F.in[I_SCW] + (size_t)(layer * 3 + 0) * 512)[ch], w1 = (F.in[I_SCW] + (size_t)(layer * 3 + 1) * 512)[ch], w2 = (F.in[I_SCW] + (size_t)(layer * 3 + 2) * 512)[ch];
#pragma unroll
        for (int r = 0; r < 4; ++r) (Yr + (size_t)r * YC + 1536)[ch] = f2bf(bf1((Zr + (size_t)r * ZC + 2048)[ch]) * (w0 * u[r] + w1 * u[r + 1] + w2 * u[r + 2]));
    }
    __syncthreads();
    if (F.wave < 4) ln_silu_row(obuf + F.wave * 512, F.in[I_CFG] + layer * 512, F.in[I_CFBB] + layer * 512, Yr + (size_t)F.wave * YC + 512, F.lane);
}

struct Args { const float* in[31]; float* out; unsigned char* ws; int ph_lo, ph_hi; };
__global__ void __launch_bounds__(NWAVES * 64, 2) hybrid_fwd(Args args) {
    extern __shared__ __attribute__((aligned(16))) unsigned char lds[];
    Frame F;
    F.lds = (LAS unsigned char*)lds;
    F.MISC = (volatile LAS unsigned*)(F.lds + MISC_OFF);
    const int wave0 = __builtin_amdgcn_readfirstlane((int)threadIdx.x >> 6);
    F.lane = lane_now(); F.wave = wave0; F.tid = F.wave * 64 + F.lane;
    F.G = gridDim.x; F.bid = blockIdx.x;
    F.ws = args.ws; F.out = args.out; F.ctl = (gu32*)(args.ws + WS_CTL);
    F.in = args.in;
    for (int u = F.tid; u < (LDS_BYTES - LDSCTL_OFF) / 4; u += NWAVES * 64) ((LAS unsigned*)(F.lds + LDSCTL_OFF))[u] = 0u;
    __syncthreads();
    XcdBarrier bar; bar.bar = (unsigned*)(F.ctl + CW_BAR); bar.x = 0; bar.st = nullptr;
    if (!MK_SPLIT) bar = xcd_barrier_post((unsigned*)(F.ctl + CW_BAR), F.MISC + 8);
    const int lo = args.ph_lo, hi = args.ph_hi;
#define IN(k) (lo <= (k) && (k) < hi)
#define REFRESH() do { F.lane = lane_now(); F.wave = opqs(wave0); F.tid = F.wave * 64 + F.lane; F.bid = opqs((int)blockIdx.x); } while (0)
#define SEAM(k) do { if (IN(k) && IN((k) + 1)) xcd_barrier(bar); } while (0)
    bf16* WA = (bf16*)(F.ws + WS_WA); bf16* XB = (bf16*)(F.ws + WS_XB); bf16* Y = (bf16*)(F.ws + WS_Y); bf16* Zm = (bf16*)(F.ws + WS_ZG); _Float16* Gb = (_Float16*)(F.ws + WS_ZG);
    bf16* Hb = (bf16*)(F.ws + WS_ZG); bf16* Bt3 = (bf16*)(F.ws + WS_BT3); bf16* Bt4 = (bf16*)(F.ws + WS_BT4); bf16* Bt5 = (bf16*)(F.ws + WS_BT5); bf16* Bt6 = (bf16*)(F.ws + WS_BT6);

    if (IN(0)) { REFRESH(); convert_matrix<RM_WIN>(F, F.in[I_WIN], DM, INC, WA, DM, 0, 0); REFRESH(); x_to_bf16(F, XB); }
    SEAM(0);

    for (int l = 0; l < 2; ++l) {
        const int pb = 1 + 9 * l;
        if (IN(pb + 0)) for (int rep = 0; rep < NREP(0); ++rep) { if (rep) xcd_barrier(bar); pg8::Gemm g{XB, WA, DM, DM}; pg8::UnitOrder S; S.init(pg8::SK_PLAIN, 4096, DM, F.G, F.bid, 0); pg8::EpiMix E{Zm, F.out, l};
            pg8::gemm_phase<pg8::EpiMix, pg8::UnitOrder, true>(F.lds + RING_OFF, g, S, E, wave0); }
        SEAM(pb + 0);
        if (IN(pb + 1)) for (int rep = 0; rep < NREP(1); ++rep) { if (rep) xcd_barrier(bar);
            __syncthreads(); REFRESH();
            for (int r2 = 0; r2 < NREP2(0); ++r2) for (int it = F.bid; it < 256; it += F.G) { a_prompt_item(F, l, it, Zm, Y); __syncthreads(); }
            REFRESH();
            for (int r2 = 0; r2 < NREP2(1); ++r2) for (int it = F.bid; it < 128; it += F.G) a_sample_task(F, l, 8 * it + F.wave, Zm, Y);
            __syncthreads(); REFRESH();
            for (int r2 = 0; r2 < NREP2(2); ++r2) for (int it = F.bid; it < 256; it += F.G) { b_prompt_item(F, l, it, Zm, Y); __syncthreads(); }
            REFRESH();
            for (int r2 = 0; r2 < NREP2(3); ++r2) for (int it = F.bid; it < 256; it += F.G) { cd_prompt_item(F, l, it, Zm, Y); __syncthreads(); }
            REFRESH();
            for (int r2 = 0; r2 < NREP2(4); ++r2) for (int it = F.bid; it < 128; it += F.G) { s_sample_item(F, l, it, Zm, Y); __syncthreads(); }
            REFRESH();
            const float* wbr = F.in[I_WBR] + (size_t)l * 4 * 512 * 1024;
            for (int r2 = 0; r2 < NREP2(5); ++r2) {
            convert_matrix<RM_ID>(F, wbr, 512, 1024, Bt3, 2048, 0, 0);
            convert_matrix<RM_ID>(F, wbr + (size_t)512 * 1024, 512, 1024, Bt3, 2048, 512, 0);
            convert_matrix<RM_ID>(F, wbr + (size_t)3 * 512 * 1024, 512, 1024, Bt3, 2048, 1536, 0);
            convert_matrix<RM_ID>(F, F.in[I_WOUT] + (size_t)l * DM * DM, DM, DM, Bt4, DM, 0, 0); }
            for (int r2 = 0; r2 < NREP2(6); ++r2) { REFRESH(); compose_pool(F, l, Bt3); REFRESH(); }
        }
        SEAM(pb + 1);
        if (IN(pb + 2)) for (int rep = 0; rep < NREP(2); ++rep) { if (rep) xcd_barrier(bar); pg8::Gemm g{XB, WA + (size_t)4096 * DM, DM, DM}; pg8::UnitOrder S; S.init(pg8::SK_PLAIN, 4096, DM, F.G, F.bid, 0); pg8::EpiGate E{Gb};
            pg8::gemm_phase<pg8::EpiGate, pg8::UnitOrder, true>(F.lds + RING_OFF, g, S, E, wave0); }
        SEAM(pb + 2);
        if (IN(pb + 3)) for (int rep = 0; rep < NREP(3); ++rep) { if (rep) xcd_barrier(bar); pg8::Gemm g{Y, Bt3, 2048, 2048}; pg8::UnitOrder S; S.init(pg8::SK_P3, DM, 2048, F.G, F.bid, 0); pg8::EpiMerge E{Gb, XB, (bf16*)(F.ws + WS_MB4S)};
            pg8::gemm_phase<pg8::EpiMerge, pg8::UnitOrder, true>(F.lds + RING_OFF, g, S, E, wave0); }
        SEAM(pb + 3);
        if (IN(pb + 4)) for (int rep = 0; rep < NREP(4); ++rep) { if (rep) xcd_barrier(bar); pg8::Gemm g{XB, Bt4, DM, DM}; pg8::UnitOrder S; S.init(pg8::SK_P4, DM, DM, F.G, F.bid, (long)(WS_MB4S - WS_XB));
            pg8::EpiRes E{l == 0 ? F.in[I_XP] : F.out, l == 0 ? F.in[I_XS] : F.out + (size_t)MP * DM, rep + 1 < NREP(4) ? (float*)(F.ws + WS_ZG) : F.out, (float*)(F.ws + WS_SLAB)};
            pg8::gemm_phase<pg8::EpiRes, pg8::UnitOrder, true>(F.lds + RING_OFF, g, S, E, wave0); }
        SEAM(pb + 4);
        if (IN(pb + 5)) for (int rep = 0; rep < NREP(5); ++rep) { if (rep) xcd_barrier(bar);
            REFRESH();
            ln_rows(F, F.out, rep + 1 < NREP(5) ? (float*)(F.ws + WS_Y) : F.out, F.in[I_LN1G] + l * DM, F.in[I_LN1B] + l * DM, rep + 1 < NREP(5) ? nullptr : XB, l == 0 ? F.in[I_XS] : F.out + (size_t)MP * DM, (const float*)(F.ws + WS_SLAB), 8);
            REFRESH();
            convert_matrix<RM_GU>(F, F.in[I_WG] + (size_t)l * DM * FF, DM, FF, Bt5, DM, 0, 0);
            convert_matrix<RM_GU>(F, F.in[I_WU] + (size_t)l * DM * FF, DM, FF, Bt5, DM, 0, 128);
            convert_matrix<RM_ID>(F, F.in[I_WD] + (size_t)l * FF * DM, FF, DM, Bt6, FF, 0, 0);
        }
        SEAM(pb + 5);
        if (IN(pb + 6)) for (int rep = 0; rep < NREP(6); ++rep) { if (rep) xcd_barrier(bar); pg8::Gemm g{XB, Bt5, DM, DM}; pg8::UnitOrder S; S.init(pg8::SK_PLAIN, 2 * FF, DM, F.G, F.bid, 0); pg8::EpiSwi E{Hb};
            pg8::gemm_phase<pg8::EpiSwi, pg8::UnitOrder, true>(F.lds + RING_OFF, g, S, E, wave0); }
        SEAM(pb + 6);
        if (IN(pb + 7)) for (int rep = 0; rep < NREP(7); ++rep) { if (rep) xcd_barrier(bar); pg8::Gemm g{Hb, Bt6, FF, FF}; pg8::UnitOrder S; S.init(pg8::SK_P6, DM, FF, F.G, F.bid, 0); pg8::EpiRes E{F.out, F.out + (size_t)MP * DM, F.out, (float*)(F.ws + WS_SLAB)};
            pg8::gemm_phase<pg8::EpiRes, pg8::UnitOrder, true>(F.lds + RING_OFF, g, S, E, wave0); }
        SEAM(pb + 7);
        if (IN(pb + 8)) for (int rep = 0; rep < NREP(8); ++rep) { if (rep) xcd_barrier(bar);
            REFRESH();
            ln_rows(F, F.out, rep + 1 < NREP(8) ? (float*)(F.ws + WS_Y) : F.out, F.in[I_LN2G] + l * DM, F.in[I_LN2B] + l * DM, (l == 0 && rep + 1 == NREP(8)) ? XB : nullptr, F.out + (size_t)MP * DM, (const float*)(F.ws + WS_SLAB), 11);
            REFRESH();
            if (l == 0) convert_matrix<RM_WIN>(F, F.in[I_WIN] + (size_t)DM * INC, DM, INC, WA, DM, 0, 0);
        }
        if (l == 0) SEAM(pb + 8);
    }
#undef IN
#undef SEAM
#undef REFRESH
}

extern "C" void kernel_launch(void* const* d_in, const int* in_sizes, int n_in, void* d_out, int out_size, void* d_ws, size_t ws_size, hipStream_t stream) {
    static int grid = 0;
    if (grid == 0) {
        if (n_in != 31 || out_size != (int)O_END || ws_size < WS_END) { fprintf(stderr, "kernel_launch: unexpected sizes n_in %d out %d ws %zu\n", n_in, out_size, ws_size); grid = -1; return; }
        int dev = 0, cus = 0, per_cu = 0;
        if (hipGetDevice(&dev) != hipSuccess || hipDeviceGetAttribute(&cus, hipDeviceAttributeMultiprocessorCount, dev) != hipSuccess) { grid = -1; return; }
        if (hipFuncSetAttribute((const void*)hybrid_fwd, hipFuncAttributeMaxDynamicSharedMemorySize, LDS_BYTES) != hipSuccess) { fprintf(stderr, "kernel_launch: hipFuncSetAttribute failed\n"); grid = -1; return; }
        if (hipOccupancyMaxActiveBlocksPerMultiprocessor(&per_cu, (const void*)hybrid_fwd, NWAVES * 64, LDS_BYTES) != hipSuccess || per_cu < 1)
            fprintf(stderr, "kernel_launch: occupancy query reports %d workgroups per CU\n", per_cu);
        (void)hipGetLastError();
        grid = cus;
    }
    if (grid < 0) return;
    if (hipMemsetAsync((char*)d_ws + WS_CTL, 0, CTL_ZERO_BYTES, stream) != hipSuccess) { fprintf(stderr, "kernel_launch: memset failed\n"); return; }
    Args a{};
    for (int i = 0; i < 31; ++i) a.in[i] = (const float*)d_in[i];
    a.out = (float*)d_out; a.ws = (unsigned char*)d_ws;
#if MK_SPLIT
    for (int ph = 0; ph < NPHASE; ++ph) { a.ph_lo = ph; a.ph_hi = ph + 1; hipLaunchKernelGGL(hybrid_fwd, dim3(grid), dim3(NWAVES * 64), LDS_BYTES, stream, a); }
#else
    a.ph_lo = 0; a.ph_hi = NPHASE;
    hipLaunchKernelGGL(hybrid_fwd, dim3(grid), dim3(NWAVES * 64), LDS_BYTES, stream, a);
#endif
}
```

```cpp
#include <hip/hip_runtime.h>
#include <cstdio>
#include <cstdint>

#ifndef PROBE_REP
#define PROBE_REP 0
#endif
#define NREP(k) (1 + ((PROBE_REP >> (k)) & 1))
#ifndef PROBE2
#define PROBE2 0
#endif
#define NREP2(j) (1 + ((PROBE2 >> (j)) & 1))
#ifndef MK_SPLIT
#define MK_SPLIT 0
#endif

constexpr int DM = 1024, WMIX = 512, NPB = 8, SEQ = 2048, NSB = 128, DSEQ = 4;
constexpr int MP = NPB * SEQ, MS = NSB * DSEQ, M = MP + MS;
constexpr int FF = 2816, INC = 8192, ZC = 3072, YC = 2048, GC = 4096;
constexpr float LN_EPS = 1e-5f, ALPHA = 1.41421356237f;
constexpr size_t O_Y = 0, O_PH = (size_t)M * DM, O_PRGC = O_PH + 8192, O_PCF = O_PRGC + 24576, O_PPOOL = O_PCF + 245760, O_PSC = O_PPOOL + 122880,
                 O_SH = O_PSC + 16384, O_SRGC = O_SH + 131072, O_SCF = O_SRGC + 393216, O_SPOOL = O_SCF + 3932160, O_SSC = O_SPOOL + 1966080, O_END = O_SSC + 262144;
static_assert(O_END == 24403968, "output map");

__device__ __forceinline__ int opqv(int v) { asm volatile("" : "+v"(v)); return v; }
__device__ __forceinline__ int lane_now() { int l; asm volatile("v_mbcnt_lo_u32_b32 %0, -1, 0\n\tv_mbcnt_hi_u32_b32 %0, -1, %0" : "=v"(l)); return l; }
__device__ __forceinline__ int opqs(int v) { asm volatile("" : "+s"(v)); return v; }
namespace pg8 {
#define PG8_LAS __attribute__((address_space(3)))
typedef unsigned short bf16_t;
typedef short bf16x8 __attribute__((ext_vector_type(8)));
typedef float f32x4 __attribute__((ext_vector_type(4)));
typedef float f32x2 __attribute__((ext_vector_type(2)));
typedef unsigned u32x4 __attribute__((ext_vector_type(4)));
typedef unsigned u32x2 __attribute__((ext_vector_type(2)));
typedef _Float16 f16x4 __attribute__((ext_vector_type(4)));
typedef _Float16 f16x8 __attribute__((ext_vector_type(8)));
constexpr int BM = 256, BK = 64, HALF = 128, HTB = HALF * BK * 2, STAGE_BYTES = 8 * HTB, NXCD = 8, WGM = 8;

__host__ __device__ __forceinline__ int lds_byte(int r, int c) { const int st = (r >> 4) * 2 + (c >> 5), rr = r & 15, cc = c & 31, ob = rr * 64 + cc * 2; return st * 1024 + (ob ^ (((ob >> 9) & 1) << 5)); }
__host__ __device__ __forceinline__ void stage_rc(int b, int& R, int& C) { const int st = b / 1024, sb = b % 1024, swz = sb ^ (((sb >> 9) & 1) << 5); R = (st >> 1) * 16 + swz / 64; C = (st & 1) * 32 + (swz % 64) / 2; }
__host__ __device__ __forceinline__ int perm32(int rho) { const int n = rho >> 4, i = rho & 15; return 8 * (i >> 2) + 4 * n + (i & 3); }

struct Unit { int pm, pn, nt, mode, aux; long offA, offB; };
struct Gemm { const bf16_t* A; const bf16_t* Bt; int lda, ldb; };

enum { SK_PLAIN = 0, SK_P3 = 1, SK_P4 = 2, SK_P6 = 3 };
struct UnitOrder {
    int kind, nN, nwgP, nS, ntP, G, c; long offA_s;
    __device__ __forceinline__ void init(int kind_, int N_, int K_, int G_, int c_, long offA_s_) { kind = kind_; nN = N_ / BM; nwgP = 64 * nN; ntP = K_ / BK; G = G_; c = c_; offA_s = offA_s_;
        nS = kind_ == SK_PLAIN ? 2 * nN : kind_ == SK_P3 ? 32 : kind_ == SK_P4 ? 64 : 88; }
    __device__ __forceinline__ bool next(int i, Unit& u, const Gemm& g) const {
        const long L = (long)i * G + c; const long ra = (long)BM * g.lda * 2, rb = (long)BM * g.ldb * 2;
        if (L < nwgP) {
            int wgid = (int)L; { const int q = nwgP / NXCD, xcd = wgid % NXCD, off = wgid / NXCD; wgid = xcd * q + off; }
            const int nig = WGM * nN; u.pm = (wgid / nig) * WGM + ((wgid % nig) % WGM); u.pn = (wgid % nig) / WGM;
            u.nt = ntP; u.mode = 0; u.aux = 0; u.offA = u.pm * ra; u.offB = u.pn * rb; return true; }
        const int s = (int)(L - nwgP); if (s >= nS) return false;
        if (kind == SK_PLAIN) { u.pm = 64 + (s & 1); u.pn = s >> 1; u.nt = ntP; u.mode = 0; u.aux = 0; u.offA = u.pm * ra; u.offB = u.pn * rb; }
        else if (kind == SK_P3) { const int n = s & 3, tile = s >> 2; u.pm = 64 + (tile & 1); u.pn = tile >> 1; u.nt = 8; u.mode = 1; u.aux = n; u.offA = u.pm * ra + 1024 * n; u.offB = u.pn * rb + 1024 * n; }
        else if (kind == SK_P4) { const int ch = s & 7, tile = s >> 3, n = ch >> 1, kin = (ch & 1) * 512; u.pm = 64 + (tile & 1); u.pn = tile >> 1; u.nt = 8; u.mode = 1; u.aux = ch;
            u.offA = offA_s + ((long)(n * 512 + (u.pm - 64) * 256) * 1024 + kin) * 2; u.offB = u.pn * rb + kin * 2; }
        else { const int ch = s % 11, tile = s / 11; u.pm = 64 + (tile & 1); u.pn = tile >> 1; u.nt = 4; u.mode = 1; u.aux = ch; u.offA = u.pm * ra + 512 * ch; u.offB = u.pn * rb + 512 * ch; }
        return true;
    }
};

__device__ __forceinline__ unsigned cvt_pk_bf16(float lo, float hi) { unsigned r; asm volatile("v_cvt_pk_bf16_f32 %0, %1, %2" : "=v"(r) : "v"(lo), "v"(hi)); return r; }
__device__ __forceinline__ float sigmoidf_fast(float x) { return __builtin_amdgcn_rcpf(1.0f + __builtin_amdgcn_exp2f(-1.44269504089f * x)); }
__device__ __forceinline__ float gelu_tanh(float x) { const float y = 1.5957691216057308f * (x + 0.044715f * x * x * x); return x * sigmoidf_fast(y); }

__device__ __forceinline__ float* state_ptr(float* out, int R, int keep, int layer, size_t p_off, size_t s_off) {
    if (R < MP) { const int b = R >> 11, j = (R & 2047) - (2048 - keep); return j < 0 ? nullptr : out + p_off + (size_t)((layer * 8 + b) * keep + j) * 512; }
    const int s = (R - MP) >> 2, j = (R & 3) + keep - 4; return j < 0 ? nullptr : out + s_off + (size_t)((layer * 128 + s) * keep + j) * 512;
}

struct EpiMix {
    static constexpr bool PERM = true, MIDK = false;
    bf16_t* Z; float* out; int layer;
    __device__ __forceinline__ void midk(f32x4 (&)[2][2][4][2], const Unit&, int, int, int, int, int) const {}
    __device__ __forceinline__ void operator()(f32x4 (&acc)[2][2][4][2], const Unit& u, int wr, int wc, int fr_, int fq_) const {
        const int lane_ = lane_now(), fr = lane_ & 15, fq = lane_ >> 4; (void)fr_; (void)fq_;
        const int pn = u.pn; int type, zcol, keep = 0, scol = 0; size_t poff = 0, soff = 0;
        if (pn < 2) { type = 0; zcol = 256 * pn; keep = 3; scol = zcol; poff = O_PRGC; soff = O_SRGC; }
        else if (pn < 4) { type = 1; zcol = 512 + 256 * (pn - 2); }
        else if (pn < 8) { type = 2; zcol = 1024 + 128 * (pn - 4); keep = 30; scol = 128 * (pn - 4); poff = O_PCF; soff = O_SCF; }
        else if (pn < 10) { type = 0; zcol = 1536 + 256 * (pn - 8); keep = 15; scol = 256 * (pn - 8); poff = O_PPOOL; soff = O_SPOOL; }
        else if (pn < 12) { type = 0; zcol = 2048 + 256 * (pn - 10); }
        else { type = 3; zcol = 2560 + 128 * (pn - 12); keep = 2; scol = 128 * (pn - 12); poff = O_PSC; soff = O_SSC; }
        const bool tail = keep != 0 && (u.pm >= 64 || (u.pm & 7) == 7);
        const int row0 = u.pm * BM + wr * 64 + fr, cl = wc * 32 + 8 * fq;
        if (type < 2) {
#pragma unroll
            for (int ai = 0; ai < 2; ++ai)
#pragma unroll
                for (int m = 0; m < 4; ++m) { const int R = row0 + ai * HALF + m * 16; bf16_t* rowp = Z + (size_t)R * ZC + zcol + cl;
                    float* sp = tail ? state_ptr(out, R, keep, layer, poff, soff) : nullptr;
#pragma unroll
                    for (int bj = 0; bj < 2; ++bj) { f32x4 v0 = acc[ai][bj][m][0], v1 = acc[ai][bj][m][1];
                        if (type == 1) { v0 = (f32x4){gelu_tanh(v0[0]), gelu_tanh(v0[1]), gelu_tanh(v0[2]), gelu_tanh(v0[3])}; v1 = (f32x4){gelu_tanh(v1[0]), gelu_tanh(v1[1]), gelu_tanh(v1[2]), gelu_tanh(v1[3])}; }
                        u32x4 w; w.x = cvt_pk_bf16(v0[0], v0[1]); w.y = cvt_pk_bf16(v0[2], v0[3]); w.z = cvt_pk_bf16(v1[0], v1[1]); w.w = cvt_pk_bf16(v1[2], v1[3]);
                        *(u32x4*)(rowp + bj * HALF) = w;
                        if (sp) { *(f32x4*)(sp + scol + cl + bj * HALF) = v0; *(f32x4*)(sp + scol + cl + bj * HALF + 4) = v1; } } }
        } else {
#pragma unroll
            for (int ai = 0; ai < 2; ++ai)
#pragma unroll
                for (int m = 0; m < 4; ++m) { const int R = row0 + ai * HALF + m * 16; bf16_t* rowp = Z + (size_t)R * ZC + zcol + cl;
                    float* sp = tail ? state_ptr(out, R, keep, layer, poff, soff) : nullptr;
                    f32x4 v0, v1; const f32x4 a0 = acc[ai][0][m][0], a1 = acc[ai][0][m][1], b0 = acc[ai][1][m][0], b1 = acc[ai][1][m][1];
                    if (type == 2) {
#pragma unroll
                        for (int i = 0; i < 4; ++i) { v0[i] = a0[i] * sigmoidf_fast(b0[i]); v1[i] = a1[i] * sigmoidf_fast(b1[i]); }
                    } else { v0 = a0 * b0; v1 = a1 * b1; }
                    u32x4 w; w.x = cvt_pk_bf16(v0[0], v0[1]); w.y = cvt_pk_bf16(v0[2], v0[3]); w.z = cvt_pk_bf16(v1[0], v1[1]); w.w = cvt_pk_bf16(v1[2], v1[3]);
                    *(u32x4*)rowp = w;
                    if (sp) { *(f32x4*)(sp + scol + cl) = v0; *(f32x4*)(sp + scol + cl + 4) = v1; } }
        }
    }
};

struct EpiGate {
    static constexpr bool PERM = true, MIDK = false;
    _Float16* G;
    __device__ __forceinline__ void midk(f32x4 (&)[2][2][4][2], const Unit&, int, int, int, int, int) const {}
    __device__ __forceinline__ void operator()(f32x4 (&acc)[2][2][4][2], const Unit& u, int wr, int wc, int fr_, int fq_) const {
        const int lane_ = lane_now(), fr = lane_ & 15, fq = lane_ >> 4; (void)fr_; (void)fq_;
        const int row0 = u.pm * BM + wr * 64 + fr, ch0 = 64 * u.pn + 16 * wc + 4 * fq; const bool plain = u.pm >= 64;
#pragma unroll
        for (int ai = 0; ai < 2; ++ai)
#pragma unroll
            for (int m = 0; m < 4; ++m) { const int R = row0 + ai * HALF + m * 16; _Float16* gp = G + (size_t)R * GC + ch0;
                f16x4 r0, r1, r2, g3;
#pragma unroll
                for (int i = 0; i < 4; ++i) {
                    const float z0 = fminf(fmaxf(acc[ai][0][m][0][i], -40.f), 40.f), z1 = fminf(fmaxf(acc[ai][0][m][1][i], -40.f), 40.f);
                    const float z2 = fminf(fmaxf(acc[ai][1][m][0][i], -40.f), 40.f), z3 = fminf(fmaxf(acc[ai][1][m][1][i], -40.f), 40.f);
                    const float d0 = 1.f + __builtin_amdgcn_exp2f(-1.44269504089f * z0), d1 = 1.f + __builtin_amdgcn_exp2f(-1.44269504089f * z1);
                    const float d2 = 1.f + __builtin_amdgcn_exp2f(-1.44269504089f * z2), d3 = 1.f + __builtin_amdgcn_exp2f(-1.44269504089f * z3);
                    const float i0 = __builtin_amdgcn_rcpf(d0), i1 = __builtin_amdgcn_rcpf(d1), i2 = __builtin_amdgcn_rcpf(d2), i3 = __builtin_amdgcn_rcpf(d3);
                    if (plain) { r0[i] = (_Float16)i0; r1[i] = (_Float16)i1; r2[i] = (_Float16)i2; }
                    else { r0[i] = (_Float16)fminf(d1 * i0, 65504.f); r1[i] = (_Float16)fminf(d2 * i1, 65504.f); r2[i] = (_Float16)fminf(d3 * i2, 65504.f); }
                    g3[i] = (_Float16)i3; }
                *(f16x4*)(gp) = r0; *(f16x4*)(gp + 1024) = r1; *(f16x4*)(gp + 2048) = r2; *(f16x4*)(gp + 3072) = g3; }
    }
};

struct EpiMerge {
    static constexpr bool PERM = false, MIDK = true;
    const _Float16* G; bf16_t* O; bf16_t* Os;
    __device__ __forceinline__ void scale(f32x4 (&acc)[2][2][4][2], const Unit& u, int seg, int wr, int wc) const {
        const int lane_ = lane_now(), fr = lane_ & 15, fq = lane_ >> 4;
        const int row0 = u.pm * BM + wr * 64 + fr, c0 = 1024 * seg + 256 * u.pn + wc * 32 + 4 * fq;
#pragma unroll
        for (int ai = 0; ai < 2; ++ai)
#pragma unroll
            for (int m = 0; m < 4; ++m) { const _Float16* gp = G + (size_t)(row0 + ai * HALF + m * 16) * GC + c0;
#pragma unroll
                for (int bj = 0; bj < 2; ++bj)
#pragma unroll
                    for (int n = 0; n < 2; ++n) { const f16x4 f = *(const f16x4*)(gp + bj * HALF + n * 16);
                        acc[ai][bj][m][n] *= (f32x4){(float)f[0], (float)f[1], (float)f[2], (float)f[3]}; } }
    }
    __device__ __forceinline__ void midk(f32x4 (&acc)[2][2][4][2], const Unit& u, int seg, int wr, int wc, int, int) const { scale(acc, u, seg, wr, wc); }
    __device__ __forceinline__ void operator()(f32x4 (&acc)[2][2][4][2], const Unit& u, int wr, int wc, int, int) const {
        scale(acc, u, u.mode ? u.aux : 3, wr, wc);
        const int lane_ = lane_now(), fr = lane_ & 15, fq = lane_ >> 4;
        const int row0 = (u.mode ? (u.pm - 64) * BM + 512 * u.aux : u.pm * BM) + wr * 64 + fr, c0 = 256 * u.pn + wc * 32 + 4 * fq;
        bf16_t* O = u.mode ? Os : this->O;
#pragma unroll
        for (int ai = 0; ai < 2; ++ai)
#pragma unroll
            for (int m = 0; m < 4; ++m) { bf16_t* rowp = O + (size_t)(row0 + ai * HALF + m * 16) * DM + c0;
#pragma unroll
                for (int bj = 0; bj < 2; ++bj)
#pragma unroll
                    for (int n = 0; n < 2; ++n) { const f32x4 v = acc[ai][bj][m][n]; u32x2 w; w.x = cvt_pk_bf16(v[0], v[1]); w.y = cvt_pk_bf16(v[2], v[3]); *(u32x2*)(rowp + bj * HALF + n * 16) = w; } }
    }
};

struct EpiRes {
    static constexpr bool PERM = false, MIDK = false;
    const float* baseP; const float* baseS; float* out; float* slab;
    __device__ __forceinline__ void midk(f32x4 (&)[2][2][4][2], const Unit&, int, int, int, int, int) const {}
    __device__ __forceinline__ void operator()(f32x4 (&acc)[2][2][4][2], const Unit& u, int wr, int wc, int fr_, int fq_) const {
        const int lane_ = lane_now(), fr = lane_ & 15, fq = lane_ >> 4; (void)fr_; (void)fq_;
        const int row0 = u.pm * BM + wr * 64 + fr, c0 = 256 * u.pn + wc * 32 + 4 * fq;
        if (u.mode) {
#pragma unroll
            for (int ai = 0; ai < 2; ++ai)
#pragma unroll
                for (int m = 0; m < 4; ++m) { float* op = slab + ((size_t)u.aux * 512 + (row0 - MP) + ai * HALF + m * 16) * DM + c0;
#pragma unroll
                    for (int bj = 0; bj < 2; ++bj)
#pragma unroll
                        for (int n = 0; n < 2; ++n) *(f32x4*)(op + bj * HALF + n * 16) = acc[ai][bj][m][n]; }
            return; }
#pragma unroll
        for (int ai = 0; ai < 2; ++ai)
#pragma unroll
            for (int m = 0; m < 4; ++m) { const int R = row0 + ai * HALF + m * 16;
                const float* bp = (R < MP ? baseP + (size_t)R * DM : baseS + (size_t)(R - MP) * DM) + c0; float* op = out + (size_t)R * DM + c0;
#pragma unroll
                for (int bj = 0; bj < 2; ++bj)
#pragma unroll
                    for (int n = 0; n < 2; ++n) { const f32x4 b = *(const f32x4*)(bp + bj * HALF + n * 16); *(f32x4*)(op + bj * HALF + n * 16) = b * ALPHA + acc[ai][bj][m][n]; }
                if (m & 1) asm volatile("" ::: "memory"); }
    }
};

struct EpiSwi {
    static constexpr bool PERM = true, MIDK = false;
    bf16_t* H;
    __device__ __forceinline__ void midk(f32x4 (&)[2][2][4][2], const Unit&, int, int, int, int, int) const {}
    __device__ __forceinline__ void operator()(f32x4 (&acc)[2][2][4][2], const Unit& u, int wr, int wc, int fr_, int fq_) const {
        const int lane_ = lane_now(), fr = lane_ & 15, fq = lane_ >> 4; (void)fr_; (void)fq_;
        const int row0 = u.pm * BM + wr * 64 + fr, c0 = 128 * u.pn + wc * 32 + 8 * fq;
#pragma unroll
        for (int ai = 0; ai < 2; ++ai)
#pragma unroll
            for (int m = 0; m < 4; ++m) { bf16_t* rowp = H + (size_t)(row0 + ai * HALF + m * 16) * FF + c0;
                const f32x4 g0 = acc[ai][0][m][0], g1 = acc[ai][0][m][1], u0 = acc[ai][1][m][0], u1 = acc[ai][1][m][1]; f32x4 v0, v1;
#pragma unroll
                for (int i = 0; i < 4; ++i) { v0[i] = g0[i] * sigmoidf_fast(g0[i]) * u0[i]; v1[i] = g1[i] * sigmoidf_fast(g1[i]) * u1[i]; }
                u32x4 w; w.x = cvt_pk_bf16(v0[0], v0[1]); w.y = cvt_pk_bf16(v0[2], v0[3]); w.z = cvt_pk_bf16(v1[0], v1[1]); w.w = cvt_pk_bf16(v1[2], v1[3]);
                *(u32x4*)rowp = w; }
    }
};

template <class Epi, class Sched, bool ALIGN_EPI>
__device__ __forceinline__ void gemm_phase(PG8_LAS unsigned char* lds, const Gemm g, const Sched& S, const Epi& E, int wave_id) {
    const int wid = opqs(wave_id), lane = lane_now(), tid = wid * 64 + lane, wr = wid >> 2, wc = wid & 3, fr = lane & 15, fq = lane >> 4;
    unsigned voffA[2], voffB[2];
#pragma unroll
    for (int i = 0; i < 2; ++i) { int R, C; stage_rc(tid * 16 + i * 8192, R, C); const int Rb = Epi::PERM ? ((R & ~31) + perm32(R & 31)) : R;
        voffA[i] = (unsigned)(R * g.lda + C) * 2u; voffB[i] = (unsigned)(Rb * g.ldb + C) * 2u; }
    const size_t kstep = (size_t)(BK * 2);
    const size_t hstepA = (size_t)HALF * g.lda * 2, hstepB = (size_t)HALF * g.ldb * 2;
    const unsigned ldsw = (unsigned)wid * 1024u;
    const int aoff = lds_byte(wr * 64 + fr, fq * 8), boff = lds_byte(wc * 32 + fr, fq * 8);
#define PG8_SA(b, h) (((b) * 2 + (h)) * HTB)
#define PG8_SB(b, h) ((4 + (b) * 2 + (h)) * HTB)
#define PG8_STAGE(bufoff, gbase, voff) do { _Pragma("unroll") for (int _i = 0; _i < 2; ++_i) \
        __builtin_amdgcn_global_load_lds((const unsigned*)((const char*)(gbase) + (voff)[_i]), (PG8_LAS unsigned*)(lds + (bufoff) + ldsw + _i * 8192), 16, 0, 0); } while (0)
#define PG8_LDA(dst, b, h) do { _Pragma("unroll") for (int m = 0; m < 4; ++m) _Pragma("unroll") for (int k = 0; k < 2; ++k) dst[m][k] = *(const PG8_LAS bf16x8*)(lds + PG8_SA(b, h) + aoff + m * 2048 + k * 1024); } while (0)
#define PG8_LDB(dst, b, h) do { _Pragma("unroll") for (int n = 0; n < 2; ++n) _Pragma("unroll") for (int k = 0; k < 2; ++k) dst[n][k] = *(const PG8_LAS bf16x8*)(lds + PG8_SB(b, h) + boff + n * 2048 + k * 1024); } while (0)
#define PG8_MMA(ai, bj, At, Bt) do { __builtin_amdgcn_s_setprio(1); _Pragma("unroll") for (int m = 0; m < 4; ++m) _Pragma("unroll") for (int n = 0; n < 2; ++n) _Pragma("unroll") for (int k = 0; k < 2; ++k) \
        acc[ai][bj][m][n] = __builtin_amdgcn_mfma_f32_16x16x32_bf16(Bt[n][k], At[m][k], acc[ai][bj][m][n], 0, 0, 0); __builtin_amdgcn_s_setprio(0); } while (0)
#define PG8_WAIT_V(n) asm volatile("s_waitcnt vmcnt(" #n ")" ::: "memory")
#define PG8_WAIT_L(n) asm volatile("s_waitcnt lgkmcnt(" #n ")" ::: "memory")
#define PG8_BAR __builtin_amdgcn_s_barrier()
#define PG8_SCHED __builtin_amdgcn_sched_barrier(0)
    Unit cur, nxt; int ui = 0;
    if (!S.next(0, cur, g)) return;
    f32x4 acc[2][2][4][2];
#pragma unroll
    for (int a = 0; a < 2; ++a)
#pragma unroll
        for (int b = 0; b < 2; ++b)
#pragma unroll
            for (int m = 0; m < 4; ++m)
#pragma unroll
                for (int n = 0; n < 2; ++n) acc[a][b][m][n] = (f32x4){0.f, 0.f, 0.f, 0.f};
    bf16x8 At[4][2], B0[2][2], B1[2][2];
    const char* cA = (const char*)g.A + cur.offA; const char* cB = (const char*)g.Bt + cur.offB;
    PG8_STAGE(PG8_SB(0, 0), cB, voffB); PG8_STAGE(PG8_SB(0, 1), cB + hstepB, voffB); PG8_STAGE(PG8_SA(0, 0), cA, voffA); PG8_STAGE(PG8_SA(0, 1), cA + hstepA, voffA);
    if (wr == 1) PG8_BAR;
    PG8_WAIT_V(2); PG8_BAR;
    PG8_STAGE(PG8_SB(1, 0), cB + kstep, voffB); PG8_STAGE(PG8_SA(1, 0), cA + kstep, voffA); PG8_STAGE(PG8_SB(1, 1), cB + hstepB + kstep, voffB);
    PG8_WAIT_V(6); PG8_BAR;
    for (;;) {
        const bool has_next = S.next(ui + 1, nxt, g);
        const char* nA = has_next ? (const char*)g.A + nxt.offA : cA; const char* nB = has_next ? (const char*)g.Bt + nxt.offB : cB;
        const int nt = cur.nt, TSEG = Epi::MIDK ? 8 : nt;
        for (int t0 = 0; t0 < nt; t0 += TSEG) {
        if constexpr (Epi::MIDK) { if (t0 != 0) { PG8_SCHED; E.midk(acc, cur, t0 / TSEG - 1, wr, wc, 0, 0); PG8_SCHED; } }
#pragma unroll 1
        for (int t = t0; t < t0 + TSEG; t += 2) {
            const bool last = (t == nt - 2);
            const char* a1 = cA + (size_t)(t + 1) * kstep;
            const char* a2 = last ? nA : cA + (size_t)(t + 2) * kstep; const char* b2 = last ? nB : cB + (size_t)(t + 2) * kstep;
            const char* a3 = a2 + kstep; const char* b3 = b2 + kstep;
            PG8_LDB(B0, 0, 0); PG8_LDB(B1, 0, 1); PG8_SCHED; PG8_LDA(At, 0, 0); PG8_STAGE(PG8_SA(1, 1), a1 + hstepA, voffA);
            PG8_WAIT_V(8); PG8_WAIT_L(0); PG8_BAR; PG8_MMA(0, 0, At, B0); PG8_MMA(0, 1, At, B1); PG8_BAR; PG8_SCHED;
            PG8_LDA(At, 0, 1); PG8_STAGE(PG8_SB(0, 0), b2, voffB); PG8_STAGE(PG8_SB(0, 1), b2 + hstepB, voffB); PG8_STAGE(PG8_SA(0, 0), a2, voffA);
            PG8_WAIT_V(8); PG8_WAIT_L(0); PG8_BAR; PG8_MMA(1, 0, At, B0); PG8_MMA(1, 1, At, B1); PG8_BAR; PG8_SCHED;
            PG8_LDB(B0, 1, 0); PG8_LDB(B1, 1, 1); PG8_SCHED; PG8_LDA(At, 1, 0); PG8_STAGE(PG8_SA(0, 1), a2 + hstepA, voffA);
            PG8_WAIT_V(8); PG8_WAIT_L(0); PG8_BAR; PG8_MMA(0, 0, At, B0); PG8_MMA(0, 1, At, B1); PG8_BAR; PG8_SCHED;
            PG8_LDA(At, 1, 1); PG8_STAGE(PG8_SB(1, 0), b3, voffB); PG8_STAGE(PG8_SB(1, 1), b3 + hstepB, voffB); PG8_STAGE(PG8_SA(1, 0), a3, voffA);
            PG8_WAIT_V(8); PG8_WAIT_L(0); PG8_BAR; PG8_MMA(1, 0, At, B0); PG8_MMA(1, 1, At, B1); PG8_BAR; PG8_SCHED;
        }
        }
        if constexpr (ALIGN_EPI) { if (wr == 0) PG8_BAR; }
        E(acc, cur, wr, wc, 0, 0);
        if (!has_next) break;
#pragma unroll
        for (int a = 0; a < 2; ++a)
#pragma unroll
            for (int b = 0; b < 2; ++b)
#pragma unroll
                for (int m = 0; m < 4; ++m)
#pragma unroll
                    for (int n = 0; n < 2; ++n) acc[a][b][m][n] = (f32x4){0.f, 0.f, 0.f, 0.f};
        cur = nxt; cA = nA; cB = nB; ++ui;
        if constexpr (ALIGN_EPI) { if (wr == 1) PG8_BAR; }
    }
    PG8_WAIT_V(0);
    if constexpr (!ALIGN_EPI) { if (wr == 0) PG8_BAR; }
    PG8_BAR;
#undef PG8_SA
#undef PG8_SB
#undef PG8_STAGE
#undef PG8_LDA
#undef PG8_LDB
#undef PG8_MMA
#undef PG8_WAIT_V
#undef PG8_WAIT_L
#undef PG8_BAR
#undef PG8_SCHED
}
}

constexpr int NWAVES = 8;
constexpr int NPHASE = 19;
constexpr size_t MiB = 1u << 20;
constexpr size_t WS_CTL = 0, CTL_ZERO_BYTES = 1 * MiB;
constexpr size_t WS_WA = 1 * MiB;
constexpr size_t WS_XB = 18 * MiB;
constexpr size_t WS_Y = 51 * MiB;
constexpr size_t WS_ZG = 117 * MiB;
constexpr size_t WS_BT3 = 249 * MiB, WS_BT4 = 253 * MiB, WS_BT5 = WS_ZG + 96 * MiB, WS_BT6 = WS_ZG + 108 * MiB;
constexpr size_t WS_MB4S = WS_WA + 8 * MiB;
constexpr size_t WS_SLAB = WS_Y;
constexpr size_t WS_END = 255 * MiB;
static_assert(WS_XB + (size_t)M * DM * 2 <= WS_Y && WS_Y + (size_t)M * YC * 2 <= WS_ZG && WS_ZG + (size_t)M * GC * 2 <= WS_BT3 && WS_SLAB + (size_t)11 * 512 * DM * 4 <= WS_ZG, "ws map");
static_assert((size_t)M * FF * 2 <= 96 * MiB && WS_BT5 + (size_t)2 * FF * DM * 2 <= WS_BT6 && WS_BT6 + (size_t)DM * FF * 2 <= WS_BT3, "ws map 2");
constexpr int CW_TMO = 0, CW_CODE = 1, CW_BAR = 4096;
constexpr int RING_OFF = 0, RING_BYTES = 131072;
constexpr int LDSCTL_OFF = RING_BYTES, MISC_OFF = LDSCTL_OFF + 320;
constexpr int LDS_BYTES = 147456;

#define GAS __attribute__((address_space(1)))
#define LAS __attribute__((address_space(3)))
typedef unsigned short bf16;
typedef unsigned v4u __attribute__((ext_vector_type(4)));
typedef unsigned v2u __attribute__((ext_vector_type(2)));
typedef float f32x4 __attribute__((ext_vector_type(4)));
typedef float f32x2 __attribute__((ext_vector_type(2)));
typedef short bf16x8 __attribute__((ext_vector_type(8)));
typedef GAS unsigned gu32;
#define RLX_AGENT __ATOMIC_RELAXED, __HIP_MEMORY_SCOPE_AGENT
#define LDS_WAIT() asm volatile("s_waitcnt lgkmcnt(0)" ::: "memory")
#define VM_WAIT() asm volatile("s_waitcnt vmcnt(0)" ::: "memory")
__device__ __forceinline__ unsigned pk2(float lo, float hi) { return pg8::cvt_pk_bf16(lo, hi); }
__device__ __forceinline__ float bflo(unsigned v) { return __uint_as_float(v << 16); }
__device__ __forceinline__ float bfhi(unsigned v) { return __uint_as_float(v & 0xffff0000u); }
__device__ __forceinline__ float bf1(unsigned short h) { return __uint_as_float((unsigned)h << 16); }
__device__ __forceinline__ unsigned short f2bf(float f) { return (unsigned short)(pg8::cvt_pk_bf16(f, 0.f) & 0xffffu); }

#define XB_TMO      128
#define XB_XCNT(j)  (256  + 64 * (j))
#define XB_XSUB(j)  (1280 + 64 * (j))
#define XB_XGEN(j)  (2304 + 64 * (j))
#define XB_TOP      3328
#define XB_TOPGEN   3392
#define XCD_BAR_WORDS 3456
#define XB_SPIN_CAP (1u << 18)
__device__ __forceinline__ unsigned xb_ld(unsigned* p)              { return __hip_atomic_load(p, __ATOMIC_RELAXED, __HIP_MEMORY_SCOPE_AGENT); }
__device__ __forceinline__ unsigned xb_add(unsigned* p, unsigned v) { return __hip_atomic_fetch_add(p, v, __ATOMIC_RELAXED, __HIP_MEMORY_SCOPE_AGENT); }
__device__ __forceinline__ unsigned xb_xcc_id() { return (unsigned)__builtin_amdgcn_s_getreg((3 << 11) | 20) & 0xFu; }
#define XB_SPIN(cond, bar) do { unsigned _sp = 0; while (cond) { __builtin_amdgcn_s_sleep(1); \
    if ((++_sp & 255u) == 0u) { if (xb_ld(&(bar)[XB_TMO])) break; if (_sp > XB_SPIN_CAP) { atomicAdd(&(bar)[XB_TMO], 1u); break; } } } } while (0)
struct XcdBarrier { unsigned* bar; unsigned x; volatile LAS unsigned* st; };
__device__ __forceinline__ XcdBarrier xcd_barrier_post(unsigned* bar, volatile LAS unsigned* st) {
    XcdBarrier b; b.bar = bar; b.x = xb_xcc_id(); b.st = st;
    if (threadIdx.x == 0) (void)xb_add(&bar[XB_XCNT(b.x)], 1u);
    return b;
}
__device__ __forceinline__ void xcd_barrier_complete(unsigned* bar, unsigned x, unsigned& nloc, unsigned& nx) {
    const unsigned G = gridDim.x * gridDim.y * gridDim.z;
    unsigned sum, cnt, mine, sp = 0u;
    for (;;) {
        sum = 0u; cnt = 0u; mine = 0u;
#pragma unroll
        for (unsigned j = 0; j < 16; ++j) { const unsigned c = xb_ld(&bar[XB_XCNT(j)]); sum += c; cnt += (c > 0u) ? 1u : 0u; mine = (j == x) ? c : mine; }
        if (sum == G) break;
        __builtin_amdgcn_s_sleep(1);
        if ((++sp & 255u) == 0u) { if (xb_ld(&bar[XB_TMO])) break; if (sp > XB_SPIN_CAP) { atomicAdd(&bar[XB_TMO], 1u); break; } }
    }
    nloc = mine > 0u ? mine : 1u; nx = cnt > 0u ? cnt : 1u;
}
__device__ __forceinline__ void xcd_barrier(const XcdBarrier& b) {
    asm volatile("s_waitcnt vmcnt(0)" ::: "memory");
    __syncthreads();
    if (threadIdx.x == 0) {
        unsigned* bar = b.bar;
        __builtin_amdgcn_s_waitcnt(0);
        unsigned nloc = b.st[0], nx = b.st[1];
        if (nloc == 0u) { xcd_barrier_complete(bar, b.x, nloc, nx); b.st[0] = nloc; b.st[1] = nx; }
        const unsigned old = xb_add(&bar[XB_XSUB(b.x)], 1u);
        const unsigned gen = old / nloc;
        if (old + 1u == (gen + 1u) * nloc) {
            __builtin_amdgcn_fence(__ATOMIC_RELEASE, "agent");
            asm volatile("s_waitcnt vmcnt(0)" ::: "memory");
            const unsigned og = xb_add(&bar[XB_TOP], 1u);
            const unsigned tg = og / nx;
            if (og + 1u == (tg + 1u) * nx) xb_add(&bar[XB_TOPGEN], 1u);
            else XB_SPIN(xb_ld(&bar[XB_TOPGEN]) == tg, bar);
            __builtin_amdgcn_fence(__ATOMIC_ACQUIRE, "agent");
            xb_add(&bar[XB_XGEN(b.x)], 1u);
            asm volatile("s_waitcnt vmcnt(0)" ::: "memory");
        } else {
            XB_SPIN(xb_ld(&bar[XB_XGEN(b.x)]) == gen, bar);
            __builtin_amdgcn_fence(__ATOMIC_ACQUIRE, "agent");
            asm volatile("s_waitcnt vmcnt(0)" ::: "memory");
        }
    }
    __syncthreads();
}

struct Frame {
    LAS unsigned char* lds;
    volatile LAS unsigned* MISC;
    gu32* ctl;
    int tid, lane, wave, G, bid;
    const float* const* in;
    float* out;
    unsigned char* ws;
};
enum { I_XP = 0, I_XS, I_SH, I_SRGC, I_SCF, I_SPOOL, I_SSC, I_WIN, I_RGCW, I_RGCB, I_RGWA, I_RGBA, I_RGWX, I_RGBX, I_LAM, I_CFW, I_CFB, I_CFG, I_CFBB, I_POOLW, I_POOLS, I_SCW,
       I_WBR, I_WOUT, I_LN1G, I_LN1B, I_WG, I_WU, I_WD, I_LN2G, I_LN2B };

__device__ __forceinline__ float shfl_idx(float v, int src_lane) { return __builtin_bit_cast(float, __builtin_amdgcn_ds_bpermute(src_lane << 2, __builtin_bit_cast(int, v))); }
__device__ __forceinline__ float wave_sum(float v, int lane) {
#pragma unroll
    for (int o = 1; o < 64; o <<= 1) v += shfl_idx(v, lane ^ o);
    return v;
}

enum { RM_ID = 0, RM_WIN = 1, RM_GU = 2 };
template <int MODE> __device__ __forceinline__ int rowmap(int s, int extra) {
    if (MODE == RM_ID) return s;
    if (MODE == RM_GU) return 256 * (s >> 7) + (s & 127) + extra;
    if (s < 1024) return s;
    if (s < 2048) { const int j = ((s - 1024) >> 7) & 3; return 1024 + 256 * j + (s >= 1536 ? 128 : 0) + (s & 127); }
    if (s < 3072) return s;
    if (s < 4096) { const int j = ((s - 3072) >> 7) & 3; return 3072 + 256 * j + (s >= 3584 ? 128 : 0) + (s & 127); }
    const int g = (s - 4096) >> 10, ch = s & 1023, pn = ch >> 6, chl = ch & 63, wc = chl >> 4, fq = (chl >> 2) & 3, i = chl & 3;
    return 4096 + 256 * pn + 128 * (g >> 1) + 32 * wc + 8 * fq + 4 * (g & 1) + i;
}
template <int MODE>
__device__ __forceinline__ void transpose_item(const float* W, int K, int N, bf16* WT, int dst_ld, int dst_koff, int extra, LAS float* scr, int item, int lane) {
    const int nblk = N / 32, kb = item / nblk, nb = item % nblk, k0 = 64 * kb, n0 = 32 * nb;
#pragma unroll 8
    for (int i = 0; i < 32; ++i) { const int kk = 2 * i + (lane >> 5); scr[kk * 33 + (lane & 31)] = W[(size_t)(k0 + kk) * N + n0 + (lane & 31)]; }
    LDS_WAIT(); asm volatile("" ::: "memory");
    const int c = lane & 7;
#pragma unroll
    for (int j = 0; j < 4; ++j) { const int n = (lane >> 3) + 8 * j; const LAS float* s = scr + (8 * c) * 33 + n;
        v4u o; o.x = pk2(s[0 * 33], s[1 * 33]); o.y = pk2(s[2 * 33], s[3 * 33]); o.z = pk2(s[4 * 33], s[5 * 33]); o.w = pk2(s[6 * 33], s[7 * 33]);
        *(GAS v4u*)(WT + (size_t)rowmap<MODE>(n0 + n, extra) * dst_ld + dst_koff + k0 + 8 * c) = o; }
    LDS_WAIT(); asm volatile("" ::: "memory");
}
template <int MODE>
__device__ __forceinline__ void convert_matrix(Frame& F, const float* W, int K, int N, bf16* WT, int dst_ld, int dst_koff, int extra, int gw, int NGW, int first = 0) {
    LAS float* scr = (LAS float*)(F.lds + RING_OFF + F.wave * 16384);
    const int nitems = (K / 64) * (N / 32);
    int it0 = gw - first; if (it0 < 0) it0 += ((-it0 + NGW - 1) / NGW) * NGW;
    for (int it = it0; it < nitems; it += NGW) transpose_item<MODE>(W, K, N, WT, dst_ld, dst_koff, extra, scr, it, F.lane);
}
__device__ __forceinline__ void compose_pool(Frame& F, int layer, bf16* Bt3, int gw, int NGW, int first = 0) {
    const float* pw = F.in[I_POOLW] + (size_t)layer * 4 * 128 * 128; const float* ps = F.in[I_POOLS] + layer * 512; const float* Wb2 = F.in[I_WBR] + ((size_t)layer * 4 + 2) * 512 * 1024;
    const int lane = F.lane;
    LAS float* Pl = (LAS float*)(F.lds + RING_OFF + F.wave * 16384);
    int id0 = gw - first; if (id0 < 0) id0 += ((-id0 + NGW - 1) / NGW) * NGW;
    for (int id = id0; id < 512; id += NGW) {
        const int g = __builtin_amdgcn_readfirstlane(id >> 7), c0 = __builtin_amdgcn_readfirstlane(8 * ((id >> 3) & 15)), d0 = 128 * (id & 7) + 2 * lane;
#pragma unroll
        for (int k = 0; k < 4; ++k) { const int idx4 = lane + 64 * k, i = idx4 >> 5, e4 = (idx4 & 31) * 4;
            const f32x4 pv = *(const GAS f32x4*)(pw + ((size_t)g * 128 + c0 + i) * 128 + e4), sv = *(const GAS f32x4*)(ps + 128 * g + e4);
            Pl[(e4 + 0) * 8 + i] = pv.x * sv.x; Pl[(e4 + 1) * 8 + i] = pv.y * sv.y; Pl[(e4 + 2) * 8 + i] = pv.z * sv.z; Pl[(e4 + 3) * 8 + i] = pv.w * sv.w; }
        LDS_WAIT(); asm volatile("" ::: "memory");
        f32x2 acc[8];
#pragma unroll
        for (int i = 0; i < 8; ++i) acc[i] = (f32x2){0.f, 0.f};
        const float* wrow = Wb2 + (size_t)(128 * g) * 1024 + d0;
#pragma unroll 1
        for (int e0 = 0; e0 < 128; e0 += 8) {
            f32x2 wv[8];
#pragma unroll
            for (int k = 0; k < 8; ++k) wv[k] = *(const GAS f32x2*)(wrow + (size_t)(e0 + k) * 1024);
#pragma unroll
            for (int k = 0; k < 8; ++k) { const f32x4 p0 = *(const LAS f32x4*)(Pl + (e0 + k) * 8), p1 = *(const LAS f32x4*)(Pl + (e0 + k) * 8 + 4);
#pragma unroll
                for (int i = 0; i < 4; ++i) { acc[i] += wv[k] * p0[i]; acc[4 + i] += wv[k] * p1[i]; } }
        }
        v4u o0, o1;
        o0.x = pk2(acc[0].x, acc[1].x); o0.y = pk2(acc[2].x, acc[3].x); o0.z = pk2(acc[4].x, acc[5].x); o0.w = pk2(acc[6].x, acc[7].x);
        o1.x = pk2(acc[0].y, acc[1].y); o1.y = pk2(acc[2].y, acc[3].y); o1.z = pk2(acc[4].y, acc[5].y); o1.w = pk2(acc[6].y, acc[7].y);
        *(GAS v4u*)(Bt3 + (size_t)d0 * 2048 + 1024 + 128 * g + c0) = o0; *(GAS v4u*)(Bt3 + (size_t)(d0 + 1) * 2048 + 1024 + 128 * g + c0) = o1;
        LDS_WAIT(); asm volatile("" ::: "memory");
    }
}

__device__ __forceinline__ const float* xrow_in(Frame& F, int m) { return m < MP ? F.in[I_XP] + (size_t)m * DM : F.in[I_XS] + (size_t)(m - MP) * DM; }
__device__ __forceinline__ void x_to_bf16(Frame& F, bf16* XB) {
    const int gw = F.bid * NWAVES + F.wave, NGW = F.G * NWAVES;
    for (int m = gw; m < M; m += NGW) { const GAS f32x4* xr = (const GAS f32x4*)xrow_in(F, m) + F.lane; GAS v2u* o = (GAS v2u*)(XB + (size_t)m * DM) + F.lane;
#pragma unroll
        for (int j = 0; j < 4; ++j) { const f32x4 v = xr[64 * j]; o[64 * j] = (v2u){pk2(v.x, v.y), pk2(v.z, v.w)}; } }
}
__device__ __forceinline__ void ln_rows(Frame& F, const float* V, float* O, const float* g, const float* b, bf16* XB, const float* sbase, const float* slab, int nslab) {
    const int gw = F.bid * NWAVES + F.wave, NGW = F.G * NWAVES;
    f32x4 gv[4], bv[4];
#pragma unroll
    for (int j = 0; j < 4; ++j) { gv[j] = ((const GAS f32x4*)g)[F.lane + 64 * j]; bv[j] = ((const GAS f32x4*)b)[F.lane + 64 * j]; }
    for (int m = gw; m < M; m += NGW) {
        const GAS f32x4* xr = (const GAS f32x4*)(V + (size_t)m * DM) + F.lane; GAS f32x4* orow = (GAS f32x4*)(O + (size_t)m * DM) + F.lane;
        f32x4 v[4]; float s = 0.f;
#pragma unroll
        for (int j = 0; j < 4; ++j) v[j] = xr[64 * j];
        if (m >= MP) { const GAS f32x4* br = (const GAS f32x4*)(sbase + (size_t)(m - MP) * DM) + F.lane;
#pragma unroll
            for (int j = 0; j < 4; ++j) v[j] = br[64 * j] * ALPHA;
            for (int sl = 0; sl < nslab; ++sl) { const GAS f32x4* sr = (const GAS f32x4*)(slab + ((size_t)sl * 512 + (m - MP)) * DM) + F.lane;
#pragma unroll
                for (int j = 0; j < 4; ++j) v[j] += sr[64 * j]; } }
#pragma unroll
        for (int j = 0; j < 4; ++j) s += (v[j].x + v[j].y) + (v[j].z + v[j].w);
        const float mean = wave_sum(s, F.lane) * (1.f / DM); float s2 = 0.f;
#pragma unroll
        for (int j = 0; j < 4; ++j) { v[j] = v[j] - mean; s2 += (v[j].x * v[j].x + v[j].y * v[j].y) + (v[j].z * v[j].z + v[j].w * v[j].w); }
        const float rstd = __builtin_amdgcn_rsqf(wave_sum(s2, F.lane) * (1.f / DM) + LN_EPS);
#pragma unroll
        for (int j = 0; j < 4; ++j) { v[j] = v[j] * rstd * gv[j] + bv[j]; orow[64 * j] = v[j]; }
        if (XB) { GAS v2u* o = (GAS v2u*)(XB + (size_t)m * DM) + F.lane;
#pragma unroll
            for (int j = 0; j < 4; ++j) o[64 * j] = (v2u){pk2(v[j].x, v[j].y), pk2(v[j].z, v[j].w)}; }
    }
}

__device__ __forceinline__ float softplusf_acc(float x) { return fmaxf(x, 0.f) + log1pf(__expf(-fabsf(x))); }
__device__ __forceinline__ float expm1_neg(float x) {
    const float p = x * (1.f + x * (0.5f + x * (1.f / 6.f + x * (1.f / 24.f + x * (1.f / 120.f + x * (1.f / 720.f + x * (1.f / 5040.f)))))));
    return x > -0.25f ? p : __expf(x) - 1.f;
}
constexpr int PATCH_STRIDE = 144;

struct ALane {
    const LAS float* tab;
    float cwD[4], cbD, ba, bx, ck;
    bf16x8 Ba0, Ba1, Bx0, Bx1;
};
constexpr int PATCH_BYTES = 5120, ASLOT_OFF = 8 * PATCH_BYTES, ATAB_OFF = ASLOT_OFF + 2048, ATAB_BYTES = 1280;
__device__ __forceinline__ void a_setup(Frame& F, int layer, int n, int q, ALane& L) {
    const int c = F.lane & 15, kg = F.lane >> 4, och = 64 * n + 16 * q + c;
    const float* cw = F.in[I_RGCW] + (size_t)layer * 4 * 512; const float* cb = F.in[I_RGCB] + layer * 512;
    LAS float* tab = (LAS float*)(F.lds + RING_OFF + ATAB_OFF + F.wave * ATAB_BYTES);
#pragma unroll
    for (int k = 0; k < 5; ++k) { const int idx = F.lane + 64 * k, tg = idx / 80, rem = idx - 80 * tg, j = rem >> 4, e = rem & 15, ch = 64 * n + (e < 8 ? 8 * tg + e : 32 + 8 * tg + (e - 8));
        tab[idx] = j < 4 ? cw[j * 512 + ch] : cb[ch]; }
    L.tab = tab + 80 * kg;
#pragma unroll
    for (int j = 0; j < 4; ++j) L.cwD[j] = cw[j * 512 + och];
    L.cbD = cb[och]; L.ba = F.in[I_RGBA][layer * 512 + och]; L.bx = F.in[I_RGBX][layer * 512 + och];
    L.ck = 8.0f * softplusf_acc(-F.in[I_LAM][layer * 512 + och]);
    const float* wa = F.in[I_RGWA] + ((size_t)layer * 8 + n) * 4096 + 16 * q + c; const float* wx = F.in[I_RGWX] + ((size_t)layer * 8 + n) * 4096 + 16 * q + c;
    unsigned a0[4], a1[4], x0[4], x1[4];
#pragma unroll
    for (int w = 0; w < 4; ++w) {
        a0[w] = pk2(wa[(8 * kg + 2 * w) * 64], wa[(8 * kg + 2 * w + 1) * 64]); a1[w] = pk2(wa[(32 + 8 * kg + 2 * w) * 64], wa[(32 + 8 * kg + 2 * w + 1) * 64]);
        x0[w] = pk2(wx[(8 * kg + 2 * w) * 64], wx[(8 * kg + 2 * w + 1) * 64]); x1[w] = pk2(wx[(32 + 8 * kg + 2 * w) * 64], wx[(32 + 8 * kg + 2 * w + 1) * 64]); }
    L.Ba0 = __builtin_bit_cast(bf16x8, (v4u){a0[0], a0[1], a0[2], a0[3]}); L.Ba1 = __builtin_bit_cast(bf16x8, (v4u){a1[0], a1[1], a1[2], a1[3]});
    L.Bx0 = __builtin_bit_cast(bf16x8, (v4u){x0[0], x0[1], x0[2], x0[3]}); L.Bx1 = __builtin_bit_cast(bf16x8, (v4u){x1[0], x1[1], x1[2], x1[3]});
    LDS_WAIT(); asm volatile("" ::: "memory");
}
__device__ __forceinline__ void a_block(const ALane& L, const LAS unsigned char* patch, int rowA0, int baseD, int q, int lane, float (&a)[4], float (&bb)[4]) {
    const int c = lane & 15, kg = lane >> 4;
    float x[16];
    { const f32x4 b0 = *(const LAS f32x4*)(L.tab + 64), b1 = *(const LAS f32x4*)(L.tab + 68), b2 = *(const LAS f32x4*)(L.tab + 72), b3 = *(const LAS f32x4*)(L.tab + 76);
#pragma unroll
      for (int e = 0; e < 4; ++e) { x[e] = b0[e]; x[4 + e] = b1[e]; x[8 + e] = b2[e]; x[12 + e] = b3[e]; } }
#pragma unroll
    for (int j = 0; j < 4; ++j) { const LAS unsigned char* rp = patch + (rowA0 + j) * PATCH_STRIDE + 16 * kg;
        const v4u v0 = *(const LAS v4u*)rp, v1 = *(const LAS v4u*)(rp + 64);
        const f32x4 t0 = *(const LAS f32x4*)(L.tab + 16 * j), t1 = *(const LAS f32x4*)(L.tab + 16 * j + 4), t2 = *(const LAS f32x4*)(L.tab + 16 * j + 8), t3 = *(const LAS f32x4*)(L.tab + 16 * j + 12);
#pragma unroll
        for (int w = 0; w < 2; ++w) { x[2 * w] = fmaf(t0[2 * w], bflo(v0[w]), x[2 * w]); x[2 * w + 1] = fmaf(t0[2 * w + 1], bfhi(v0[w]), x[2 * w + 1]);
                                      x[4 + 2 * w] = fmaf(t1[2 * w], bflo(v0[2 + w]), x[4 + 2 * w]); x[5 + 2 * w] = fmaf(t1[2 * w + 1], bfhi(v0[2 + w]), x[5 + 2 * w]);
                                      x[8 + 2 * w] = fmaf(t2[2 * w], bflo(v1[w]), x[8 + 2 * w]); x[9 + 2 * w] = fmaf(t2[2 * w + 1], bfhi(v1[w]), x[9 + 2 * w]);
                                      x[12 + 2 * w] = fmaf(t3[2 * w], bflo(v1[2 + w]), x[12 + 2 * w]); x[13 + 2 * w] = fmaf(t3[2 * w + 1], bfhi(v1[2 + w]), x[13 + 2 * w]); } }
    const bf16x8 A0 = __builtin_bit_cast(bf16x8, (v4u){pk2(x[0], x[1]), pk2(x[2], x[3]), pk2(x[4], x[5]), pk2(x[6], x[7])});
    const bf16x8 A1 = __builtin_bit_cast(bf16x8, (v4u){pk2(x[8], x[9]), pk2(x[10], x[11]), pk2(x[12], x[13]), pk2(x[14], x[15])});
    f32x4 accR = (f32x4){0.f, 0.f, 0.f, 0.f}, accI = (f32x4){0.f, 0.f, 0.f, 0.f};
    accR = __builtin_amdgcn_mfma_f32_16x16x32_bf16(A0, L.Ba0, accR, 0, 0, 0); accR = __builtin_amdgcn_mfma_f32_16x16x32_bf16(A1, L.Ba1, accR, 0, 0, 0);
    accI = __builtin_amdgcn_mfma_f32_16x16x32_bf16(A0, L.Bx0, accI, 0, 0, 0); accI = __builtin_amdgcn_mfma_f32_16x16x32_bf16(A1, L.Bx1, accI, 0, 0, 0);
    float pv[7];
#pragma unroll
    for (int k = 0; k < 7; ++k) pv[k] = bf1(*(const LAS unsigned short*)(patch + (baseD + k) * PATCH_STRIDE + 2 * (16 * q + c)));
#pragma unroll
    for (int r = 0; r < 4; ++r) {
        const float xd = L.cbD + L.cwD[0] * pv[r] + L.cwD[1] * pv[r + 1] + L.cwD[2] * pv[r + 2] + L.cwD[3] * pv[r + 3];
        const float rr = pg8::sigmoidf_fast(accR[r] + L.ba), ii = pg8::sigmoidf_fast(accI[r] + L.bx);
        const float la = -L.ck * rr;
        const float av = __builtin_amdgcn_exp2f(1.44269504089f * la);
        a[r] = av; bb[r] = __builtin_amdgcn_sqrtf(fmaxf(1.f - av * av, 0.f)) * (ii * xd);
    }
}
struct BlkScan { float Ac[4], Bc[4], EA, EB, WA, WB; };
__device__ __forceinline__ void blk_scan(const float (&a)[4], const float (&bb)[4], int lane, BlkScan& S) {
    const int c = lane & 15, g = lane >> 4;
    S.Ac[0] = a[0]; S.Bc[0] = bb[0];
#pragma unroll
    for (int r = 1; r < 4; ++r) { S.Ac[r] = a[r] * S.Ac[r - 1]; S.Bc[r] = a[r] * S.Bc[r - 1] + bb[r]; }
    float IA = S.Ac[3], IB = S.Bc[3];
    { const float pa = shfl_idx(IA, lane - 16), pb = shfl_idx(IB, lane - 16); if (g >= 1) { IB = IA * pb + IB; IA = IA * pa; } }
    { const float pa = shfl_idx(IA, lane - 32), pb = shfl_idx(IB, lane - 32); if (g >= 2) { IB = IA * pb + IB; IA = IA * pa; } }
    S.EA = shfl_idx(IA, lane - 16); S.EB = shfl_idx(IB, lane - 16); if (g == 0) { S.EA = 1.f; S.EB = 0.f; }
    S.WA = shfl_idx(IA, 48 + c); S.WB = shfl_idx(IB, 48 + c);
}
__device__ __forceinline__ void a_prompt_item(Frame& F, int layer, int item, const bf16* Z, bf16* Y) {
    const int b = item >> 5, n = (item >> 2) & 7, q = item & 3, lane = opqv(F.lane), w = F.wave, c = lane & 15, g = lane >> 4, och = 64 * n + 16 * q + c;
    ALane L; a_setup(F, layer, n, q, L);
    LAS unsigned char* patch = F.lds + RING_OFF + w * PATCH_BYTES;
    LAS f32x2* slots = (LAS f32x2*)(F.lds + RING_OFF + ASLOT_OFF);
    const bf16* Zb = Z + (size_t)b * SEQ * ZC;
    float hrun = 0.f;
    v4u pf[5];
    auto load_patch = [&](int tb) {
#pragma unroll
        for (int k = 0; k < 5; ++k) { const int ci = lane + 64 * k, pr = ci >> 3, cc = ci & 7, t = tb - 3 + pr;
            pf[k] = (ci < 280 && t >= 0) ? *(const GAS v4u*)(Zb + (size_t)t * ZC + 64 * n + 8 * cc) : (v4u){0u, 0u, 0u, 0u}; }
    };
    load_patch(32 * w);
    for (int it = 0; it < 8; ++it) {
        const int tb = 256 * it + 32 * w;
#pragma unroll
        for (int k = 0; k < 5; ++k) { const int ci = lane + 64 * k, pr = ci >> 3, cc = ci & 7; if (ci < 280) *(LAS v4u*)(patch + pr * PATCH_STRIDE + 16 * cc) = pf[k]; }
        if (it < 7) load_patch(tb + 256);
        unsigned short gav[8];
#pragma unroll
        for (int r = 0; r < 8; ++r) gav[r] = *(const GAS unsigned short*)(Zb + (size_t)(tb + 16 * (r >> 2) + 4 * g + (r & 3)) * ZC + 512 + och);
        asm volatile("" ::: "memory");
        float a0[4], b0[4], a1[4], b1[4];
        a_block(L, patch, lane & 15, 4 * g, q, lane, a0, b0);
        a_block(L, patch, 16 + (lane & 15), 16 + 4 * g, q, lane, a1, b1);
        BlkScan S0, S1; blk_scan(a0, b0, lane, S0); blk_scan(a1, b1, lane, S1);
        if (lane < 16) slots[((it & 1) * 8 + w) * 16 + c] = (f32x2){S0.WA * S1.WA, S1.WA * S0.WB + S1.WB};
        __syncthreads();
        float hin = hrun, hw = 0.f;
#pragma unroll
        for (int ww = 0; ww < 8; ++ww) { const f32x2 s = slots[((it & 1) * 8 + ww) * 16 + c]; if (ww == w) hw = hin; hin = s.x * hin + s.y; }
        hrun = hin;
        const float hg0 = S0.EA * hw + S0.EB, hw1 = S0.WA * hw + S0.WB, hg1 = S1.EA * hw1 + S1.EB;
#pragma unroll
        for (int r = 0; r < 4; ++r) { const float h = S0.Ac[r] * hg0 + S0.Bc[r];
            *(GAS unsigned short*)(Y + (size_t)(b * SEQ + tb + 4 * g + r) * YC + och) = f2bf(h * bf1(gav[r])); }
#pragma unroll
        for (int r = 0; r < 4; ++r) { const float h = S1.Ac[r] * hg1 + S1.Bc[r];
            *(GAS unsigned short*)(Y + (size_t)(b * SEQ + tb + 16 + 4 * g + r) * YC + och) = f2bf(h * bf1(gav[4 + r]));
            if (r == 3 && it == 7 && w == 7 && g == 3) F.out[O_PH + (size_t)(layer * 8 + b) * 512 + och] = h; }
    }
}
__device__ __forceinline__ void a_sample_task(Frame& F, int layer, int task, const bf16* Z, bf16* Y) {
    const int blk = task >> 5, n = (task >> 2) & 7, q = task & 3, lane = opqv(F.lane), c = lane & 15, g = lane >> 4, och = 64 * n + 16 * q + c, s0 = 4 * blk;
    ALane L; a_setup(F, layer, n, q, L);
    LAS unsigned char* patch = F.lds + RING_OFF + F.wave * PATCH_BYTES;
#pragma unroll
    for (int k = 0; k < 4; ++k) { const int ci = lane + 64 * k; if (ci < 224) { const int pr = ci >> 3, cc = ci & 7, sq = pr / 7, tau = pr - 7 * sq - 3, seq = s0 + sq; v4u v;
            if (tau < 0) { const GAS f32x4* sp = (const GAS f32x4*)(F.in[I_SRGC] + ((size_t)(layer * 128 + seq) * 3 + (tau + 3)) * 512 + 64 * n + 8 * cc); const f32x4 f0 = sp[0], f1 = sp[1];
                v = (v4u){pk2(f0.x, f0.y), pk2(f0.z, f0.w), pk2(f1.x, f1.y), pk2(f1.z, f1.w)}; }
            else v = *(const GAS v4u*)(Z + (size_t)(MP + 4 * seq + tau) * ZC + 64 * n + 8 * cc);
            *(LAS v4u*)(patch + pr * PATCH_STRIDE + 16 * cc) = v; } }
    asm volatile("" ::: "memory");
    float a[4], bb[4];
    a_block(L, patch, 7 * ((lane & 15) >> 2) + (lane & 3), 7 * g, q, lane, a, bb);
    const int seq = s0 + g;
    float h = F.in[I_SH][(size_t)(layer * 128 + seq) * 512 + och];
#pragma unroll
    for (int r = 0; r < 4; ++r) { h = a[r] * h + bb[r]; const size_t row = (size_t)(MP + 4 * seq + r);
        *(GAS unsigned short*)(Y + row * YC + och) = f2bf(h * bf1(*(const GAS unsigned short*)(Z + row * ZC + 512 + och))); }
    F.out[O_SH + (size_t)(layer * 128 + seq) * 512 + och] = h;
}

__device__ __forceinline__ void ln_silu_row(const LAS float* xr, const float* g, const float* b, bf16* dst, int lane) {
    const f32x4 v0 = *(const LAS f32x4*)(xr + 4 * lane), v1 = *(const LAS f32x4*)(xr + 256 + 4 * lane);
    const float s = (v0.x + v0.y) + (v0.z + v0.w) + (v1.x + v1.y) + (v1.z + v1.w);
    const float mean = wave_sum(s, lane) * (1.f / 512.f);
    const f32x4 d0 = v0 - mean, d1 = v1 - mean;
    const float s2 = (d0.x * d0.x + d0.y * d0.y) + (d0.z * d0.z + d0.w * d0.w) + (d1.x * d1.x + d1.y * d1.y) + (d1.z * d1.z + d1.w * d1.w);
    const float rstd = __builtin_amdgcn_rsqf(wave_sum(s2, lane) * (1.f / 512.f) + LN_EPS);
    const f32x4 g0 = *(const GAS f32x4*)(g + 4 * lane), g1 = *(const GAS f32x4*)(g + 256 + 4 * lane), b0 = *(const GAS f32x4*)(b + 4 * lane), b1 = *(const GAS f32x4*)(b + 256 + 4 * lane);
    f32x4 y0 = d0 * rstd * g0 + b0, y1 = d1 * rstd * g1 + b1;
#pragma unroll
    for (int i = 0; i < 4; ++i) { y0[i] = y0[i] * pg8::sigmoidf_fast(y0[i]); y1[i] = y1[i] * pg8::sigmoidf_fast(y1[i]); }
    *(GAS v2u*)(dst + 4 * lane) = (v2u){pk2(y0.x, y0.y), pk2(y0.z, y0.w)}; *(GAS v2u*)(dst + 256 + 4 * lane) = (v2u){pk2(y1.x, y1.y), pk2(y1.z, y1.w)};
}
__device__ __forceinline__ void b_prompt_item(Frame& F, int layer, int item, const bf16* Z, bf16* Y) {
    const int tidl = opqv(F.tid), b = item >> 5, t0 = 64 * (item & 31), p = tidl & 255, hh = tidl >> 8, ts = t0 + 32 * hh;
    const GAS unsigned* Zu = (const GAS unsigned*)(Z + (size_t)b * SEQ * ZC) + 512 + p;
    unsigned raw[62];
#pragma unroll
    for (int i = 0; i < 62; ++i) { const int t = ts - 30 + i; raw[i] = t >= 0 ? Zu[(size_t)t * (ZC / 2)] : 0u; }
    const float* cw = F.in[I_CFW] + (size_t)layer * 31 * 512 + 2 * p;
    f32x2 wj[31];
#pragma unroll
    for (int j = 0; j < 31; ++j) wj[j] = *(const GAS f32x2*)(cw + j * 512);
    const f32x2 bias = *(const GAS f32x2*)(F.in[I_CFB] + layer * 512 + 2 * p);
    f32x2 in[62];
#pragma unroll
    for (int i = 0; i < 62; ++i) in[i] = (f32x2){bflo(raw[i]), bfhi(raw[i])};
    LAS float* obuf = (LAS float*)(F.lds + RING_OFF);
#pragma unroll
    for (int i = 0; i < 32; ++i) { f32x2 o = bias;
#pragma unroll
        for (int j = 0; j < 31; ++j) o += wj[j] * in[i + j];
        *(LAS f32x2*)(obuf + (32 * hh + i) * 512 + 2 * p) = o; }
    __syncthreads();
    const float* lg = F.in[I_CFG] + layer * 512; const float* lb = F.in[I_CFBB] + layer * 512;
#pragma unroll 1
    for (int r = F.wave; r < 64; r += 8) ln_silu_row(obuf + r * 512, lg, lb, Y + (size_t)(b * SEQ + t0 + r) * YC + 512, F.lane);
}
__device__ __forceinline__ void cd_prompt_item(Frame& F, int layer, int item, const bf16* Z, bf16* Y) {
    const int tidl = opqv(F.tid), b = item >> 5, t0 = 64 * (item & 31), p = tidl & 255, hh = tidl >> 8;
    const bf16* Zb = Z + (size_t)b * SEQ * ZC;
    LAS unsigned* cbuf = (LAS unsigned*)(F.lds + RING_OFF);
    for (int ci = tidl; ci < 79 * 64; ci += 512) { const int pr = ci >> 6, cc = ci & 63, t = t0 - 15 + pr;
        const v4u v = t >= 0 ? *(const GAS v4u*)(Zb + (size_t)t * ZC + 1536 + 8 * cc) : (v4u){0u, 0u, 0u, 0u};
        *(LAS v4u*)(cbuf + pr * 256 + 4 * cc) = v; }
    const int ts = t0 + 32 * hh;
    unsigned uu[34], dd[32];
#pragma unroll
    for (int i = 0; i < 34; ++i) { const int t = ts - 2 + i; uu[i] = t >= 0 ? ((const GAS unsigned*)(Zb + (size_t)t * ZC))[1280 + p] : 0u; }
#pragma unroll
    for (int i = 0; i < 32; ++i) dd[i] = ((const GAS unsigned*)(Zb + (size_t)(ts + i) * ZC))[1024 + p];
    const f32x2 w0 = ((const GAS f32x2*)(F.in[I_SCW] + (size_t)(layer * 3 + 0) * 512))[p], w1 = ((const GAS f32x2*)(F.in[I_SCW] + (size_t)(layer * 3 + 1) * 512))[p],
                w2 = ((const GAS f32x2*)(F.in[I_SCW] + (size_t)(layer * 3 + 2) * 512))[p];
    __syncthreads();
    const int w = 2 << (p >> 6), rr0 = 15 + 32 * hh;
    f32x2 s = (f32x2){0.f, 0.f};
    for (int j = 0; j < w; ++j) { const unsigned v = cbuf[(rr0 - j) * 256 + p]; s += (f32x2){bflo(v), bfhi(v)}; }
    GAS unsigned* Yu = (GAS unsigned*)(Y + (size_t)(b * SEQ + ts) * YC) + p;
#pragma unroll
    for (int i = 0; i < 32; ++i) { const int t = ts + i, rr = rr0 + i;
        const unsigned cur = cbuf[rr * 256 + p]; const f32x2 cf = (f32x2){bflo(cur), bfhi(cur)};
        if (i > 0) { const unsigned old = cbuf[(rr - w) * 256 + p]; s += cf - (f32x2){bflo(old), bfhi(old)}; }
        const float ic = __builtin_amdgcn_rcpf((float)(t + 1 < w ? t + 1 : w));
        const f32x2 mm = s * ic - cf;
        Yu[(size_t)i * 1024 + 512] = pk2(mm.x, mm.y);
        const f32x2 cv = w0 * (f32x2){bflo(uu[i]), bfhi(uu[i])} + w1 * (f32x2){bflo(uu[i + 1]), bfhi(uu[i + 1])} + w2 * (f32x2){bflo(uu[i + 2]), bfhi(uu[i + 2])};
        const f32x2 yd = (f32x2){bflo(dd[i]), bfhi(dd[i])} * cv;
        Yu[(size_t)i * 1024 + 768] = pk2(yd.x, yd.y); }
}
__device__ __forceinline__ void s_sample_item(Frame& F, int layer, int s, const bf16* Z, bf16* Y) {
    const int ch = opqv(F.tid); const size_t ls = (size_t)layer * 128 + s;
    const bf16* Zr = Z + (size_t)(MP + 4 * s) * ZC; bf16* Yr = Y + (size_t)(MP + 4 * s) * YC;
    LAS float* obuf = (LAS float*)(F.lds + RING_OFF);
    {
        float in[34], wv[31];
#pragma unroll
        for (int j = 0; j < 30; ++j) in[j] = (F.in[I_SCF] + (ls * 30 + j) * 512)[ch];
#pragma unroll
        for (int r = 0; r < 4; ++r) in[30 + r] = bf1((Zr + (size_t)r * ZC + 1024)[ch]);
#pragma unroll
        for (int j = 0; j < 31; ++j) wv[j] = (F.in[I_CFW] + ((size_t)layer * 31 + j) * 512)[ch];
        const float bias = (F.in[I_CFB] + layer * 512)[ch];
#pragma unroll
        for (int j = 0; j < 26; ++j) (F.out + O_SCF + (ls * 30 + j) * 512)[ch] = in[j + 4];
#pragma unroll
        for (int r = 0; r < 4; ++r) { float o = bias;
#pragma unroll
            for (int j = 0; j < 31; ++j) o += wv[j] * in[r + j];
            obuf[r * 512 + ch] = o; }
    }
    {
        float pb[19];
#pragma unroll
        for (int j = 0; j < 15; ++j) pb[j] = (F.in[I_SPOOL] + (ls * 15 + j) * 512)[ch];
#pragma unroll
        for (int r = 0; r < 4; ++r) pb[15 + r] = bf1((Zr + (size_t)r * ZC + 1536)[ch]);
#pragma unroll
        for (int j = 0; j < 11; ++j) (F.out + O_SPOOL + (ls * 15 + j) * 512)[ch] = pb[j + 4];
        const int gsel = ch >> 7;
#pragma unroll
        for (int r = 0; r < 4; ++r) { const int k = 15 + r;
            const float s2 = pb[k] + pb[k - 1], s4 = s2 + pb[k - 2] + pb[k - 3], s8 = s4 + (pb[k - 4] + pb[k - 5]) + (pb[k - 6] + pb[k - 7]);
            float s16 = s8;
#pragma unroll
            for (int j = 8; j < 16; ++j) s16 += pb[k - j];
            const float mv = (gsel == 0 ? s2 * 0.5f : gsel == 1 ? s4 * 0.25f : gsel == 2 ? s8 * 0.125f : s16 * 0.0625f) - pb[k];
            (Yr + (size_t)r * YC + 1024)[ch] = f2bf(mv); }
    }
    {
        float u[6];
        u[0] = (F.in[I_SSC] + (ls * 2 + 0) * 512)[ch]; u[1] = (F.in[I_SSC] + (ls * 2 + 1) * 512)[ch];
#pragma unroll
        for (int r = 0; r < 4; ++r) u[2 + r] = bf1((Zr + (size_t)r * ZC + 2560)[ch]);
        const float w0 = (F.in[I_SCW] + (size_t)(layer * 3 + 0) * 512)[ch], w1 = (F.in[I_SCW] + (size_t)(layer * 3 + 1) * 512)[ch], w2 = (F.in[I_SCW] + (size_t)(layer * 3 + 2) * 512)[ch];
#pragma unroll
        for (int r = 0; r < 4; ++r) (Yr + (size_t)r * YC + 1536)[ch] = f2bf(bf1((Zr + (size_t)r * ZC + 2048)[ch]) * (w0 * u[r] + w1 * u[r + 1] + w2 * u[r + 2]));
    }
    __syncthreads();
    if (F.wave < 4) ln_silu_row(obuf + F.wave * 512, F.in[I_CFG] + layer * 512, F.in[I_CFBB] + layer * 512, Yr + (size_t)F.wave * YC + 512, F.lane);
}

struct Args { const float* in[31]; float* out; unsigned char* ws; int ph_lo, ph_hi; };
__global__ void __launch_bounds__(NWAVES * 64, 2) hybrid_fwd(Args args) {
    extern __shared__ __attribute__((aligned(16))) unsigned char lds[];
    Frame F;
    F.lds = (LAS unsigned char*)lds;
    F.MISC = (volatile LAS unsigned*)(F.lds + MISC_OFF);
    const int wave0 = __builtin_amdgcn_readfirstlane((int)threadIdx.x >> 6);
    F.lane = lane_now(); F.wave = wave0; F.tid = F.wave * 64 + F.lane;
    F.G = gridDim.x; F.bid = blockIdx.x;
    F.ws = args.ws; F.out = args.out; F.ctl = (gu32*)(args.ws + WS_CTL);
    F.in = args.in;
    for (int u = F.tid; u < (LDS_BYTES - LDSCTL_OFF) / 4; u += NWAVES * 64) ((LAS unsigned*)(F.lds + LDSCTL_OFF))[u] = 0u;
    __syncthreads();
    XcdBarrier bar; bar.bar = (unsigned*)(F.ctl + CW_BAR); bar.x = 0; bar.st = nullptr;
    if (!MK_SPLIT) bar = xcd_barrier_post((unsigned*)(F.ctl + CW_BAR), F.MISC + 8);
    const int lo = args.ph_lo, hi = args.ph_hi;
#define IN(k) (lo <= (k) && (k) < hi)
#define REFRESH() do { F.lane = lane_now(); F.wave = opqs(wave0); F.tid = F.wave * 64 + F.lane; F.bid = opqs((int)blockIdx.x); } while (0)
#define SEAM(k) do { if (IN(k) && IN((k) + 1)) xcd_barrier(bar); } while (0)
    bf16* WA = (bf16*)(F.ws + WS_WA); bf16* XB = (bf16*)(F.ws + WS_XB); bf16* Y = (bf16*)(F.ws + WS_Y); bf16* Zm = (bf16*)(F.ws + WS_ZG); _Float16* Gb = (_Float16*)(F.ws + WS_ZG);
    bf16* Hb = (bf16*)(F.ws + WS_ZG); bf16* Bt3 = (bf16*)(F.ws + WS_BT3); bf16* Bt4 = (bf16*)(F.ws + WS_BT4); bf16* Bt5 = (bf16*)(F.ws + WS_BT5); bf16* Bt6 = (bf16*)(F.ws + WS_BT6);

    if (IN(0)) { REFRESH(); convert_matrix<RM_WIN>(F, F.in[I_WIN], DM, INC, WA, DM, 0, 0, F.bid * NWAVES + F.wave, F.G * NWAVES); REFRESH(); x_to_bf16(F, XB); }
    SEAM(0);

    for (int l = 0; l < 2; ++l) {
        const int pb = 1 + 9 * l;
        if (IN(pb + 0)) for (int rep = 0; rep < NREP(0); ++rep) { if (rep) xcd_barrier(bar); pg8::Gemm g{XB, WA, DM, DM}; pg8::UnitOrder S; S.init(pg8::SK_PLAIN, 4096, DM, F.G, F.bid, 0); pg8::EpiMix E{Zm, F.out, l};
            pg8::gemm_phase<pg8::EpiMix, pg8::UnitOrder, true>(F.lds + RING_OFF, g, S, E, wave0);
            if (F.G == 256 && F.bid >= 32) {
                REFRESH(); const int gw = (F.bid - 32) * NWAVES + F.wave, NGW = 224 * NWAVES; const float* wbr = F.in[I_WBR] + (size_t)l * 4 * 512 * 1024;
                convert_matrix<RM_ID>(F, wbr, 512, 1024, Bt3, 2048, 0, 0, gw, NGW, 0);
                convert_matrix<RM_ID>(F, wbr + (size_t)512 * 1024, 512, 1024, Bt3, 2048, 512, 0, gw, NGW, 256);
                convert_matrix<RM_ID>(F, wbr + (size_t)3 * 512 * 1024, 512, 1024, Bt3, 2048, 1536, 0, gw, NGW, 512);
                convert_matrix<RM_ID>(F, F.in[I_WOUT] + (size_t)l * DM * DM, DM, DM, Bt4, DM, 0, 0, gw, NGW, 768);
                REFRESH(); compose_pool(F, l, Bt3, gw, NGW, 1280); } }
        SEAM(pb + 0);
        if (IN(pb + 1)) for (int rep = 0; rep < NREP(1); ++rep) { if (rep) xcd_barrier(bar);
            __syncthreads(); REFRESH();
            for (int r2 = 0; r2 < NREP2(0); ++r2) for (int it = F.bid; it < 256; it += F.G) { a_prompt_item(F, l, it, Zm, Y); __syncthreads(); }
            REFRESH();
            for (int r2 = 0; r2 < NREP2(1); ++r2) for (int it = F.bid; it < 128; it += F.G) a_sample_task(F, l, 8 * it + F.wave, Zm, Y);
            __syncthreads(); REFRESH();
            for (int r2 = 0; r2 < NREP2(2); ++r2) for (int it = F.bid; it < 256; it += F.G) { b_prompt_item(F, l, it, Zm, Y); __syncthreads(); }
            REFRESH();
            for (int r2 = 0; r2 < NREP2(3); ++r2) for (int it = F.bid; it < 256; it += F.G) { cd_prompt_item(F, l, it, Zm, Y); __syncthreads(); }
            REFRESH();
            for (int r2 = 0; r2 < NREP2(4); ++r2) for (int it = F.bid; it < 128; it += F.G) { s_sample_item(F, l, it, Zm, Y); __syncthreads(); }
            REFRESH();
            const float* wbr = F.in[I_WBR] + (size_t)l * 4 * 512 * 1024;
            if (F.G != 256) { const int gw = F.bid * NWAVES + F.wave, NGW = F.G * NWAVES;
                convert_matrix<RM_ID>(F, wbr, 512, 1024, Bt3, 2048, 0, 0, gw, NGW); convert_matrix<RM_ID>(F, wbr + (size_t)512 * 1024, 512, 1024, Bt3, 2048, 512, 0, gw, NGW);
                convert_matrix<RM_ID>(F, wbr + (size_t)3 * 512 * 1024, 512, 1024, Bt3, 2048, 1536, 0, gw, NGW); convert_matrix<RM_ID>(F, F.in[I_WOUT] + (size_t)l * DM * DM, DM, DM, Bt4, DM, 0, 0, gw, NGW);
                REFRESH(); compose_pool(F, l, Bt3, gw, NGW); }
        }
        SEAM(pb + 1);
        if (IN(pb + 2)) for (int rep = 0; rep < NREP(2); ++rep) { if (rep) xcd_barrier(bar); pg8::Gemm g{XB, WA + (size_t)4096 * DM, DM, DM}; pg8::UnitOrder S; S.init(pg8::SK_PLAIN, 4096, DM, F.G, F.bid, 0); pg8::EpiGate E{Gb};
            pg8::gemm_phase<pg8::EpiGate, pg8::UnitOrder, true>(F.lds + RING_OFF, g, S, E, wave0); }
        SEAM(pb + 2);
        if (IN(pb + 3)) for (int rep = 0; rep < NREP(3); ++rep) { if (rep) xcd_barrier(bar); pg8::Gemm g{Y, Bt3, 2048, 2048}; pg8::UnitOrder S; S.init(pg8::SK_P3, DM, 2048, F.G, F.bid, 0); pg8::EpiMerge E{Gb, XB, (bf16*)(F.ws + WS_MB4S)};
            pg8::gemm_phase<pg8::EpiMerge, pg8::UnitOrder, true>(F.lds + RING_OFF, g, S, E, wave0); }
        SEAM(pb + 3);
        if (IN(pb + 4)) for (int rep = 0; rep < NREP(4); ++rep) { if (rep) xcd_barrier(bar); pg8::Gemm g{XB, Bt4, DM, DM}; pg8::UnitOrder S; S.init(pg8::SK_P4, DM, DM, F.G, F.bid, (long)(WS_MB4S - WS_XB));
            pg8::EpiRes E{l == 0 ? F.in[I_XP] : F.out, l == 0 ? F.in[I_XS] : F.out + (size_t)MP * DM, rep + 1 < NREP(4) ? (float*)(F.ws + WS_ZG) : F.out, (float*)(F.ws + WS_SLAB)};
            pg8::gemm_phase<pg8::EpiRes, pg8::UnitOrder, true>(F.lds + RING_OFF, g, S, E, wave0);
            if (F.G == 256 && F.bid >= 64 && rep + 1 == NREP(4)) {
                REFRESH(); const int gw = (F.bid - 64) * NWAVES + F.wave, NGW = 192 * NWAVES;
                convert_matrix<RM_GU>(F, F.in[I_WG] + (size_t)l * DM * FF, DM, FF, Bt5, DM, 0, 0, gw, NGW, 0);
                convert_matrix<RM_GU>(F, F.in[I_WU] + (size_t)l * DM * FF, DM, FF, Bt5, DM, 0, 128, gw, NGW, 1408);
                convert_matrix<RM_ID>(F, F.in[I_WD] + (size_t)l * FF * DM, FF, DM, Bt6, FF, 0, 0, gw, NGW, 2816); } }
        SEAM(pb + 4);
        if (IN(pb + 5)) for (int rep = 0; rep < NREP(5); ++rep) { if (rep) xcd_barrier(bar);
            REFRESH();
            ln_rows(F, F.out, rep + 1 < NREP(5) ? (float*)(F.ws + WS_Y) : F.out, F.in[I_LN1G] + l * DM, F.in[I_LN1B] + l * DM, rep + 1 < NREP(5) ? nullptr : XB, l == 0 ? F.in[I_XS] : F.out + (size_t)MP * DM, (const float*)(F.ws + WS_SLAB), 8);
            REFRESH();
            if (F.G != 256) { const int gw = F.bid * NWAVES + F.wave, NGW = F.G * NWAVES;
                convert_matrix<RM_GU>(F, F.in[I_WG] + (size_t)l * DM * FF, DM, FF, Bt5, DM, 0, 0, gw, NGW); convert_matrix<RM_GU>(F, F.in[I_WU] + (size_t)l * DM * FF, DM, FF, Bt5, DM, 0, 128, gw, NGW);
                convert_matrix<RM_ID>(F, F.in[I_WD] + (size_t)l * FF * DM, FF, DM, Bt6, FF, 0, 0, gw, NGW); }
        }
        SEAM(pb + 5);
        if (IN(pb + 6)) for (int rep = 0; rep < NREP(6); ++rep) { if (rep) xcd_barrier(bar); pg8::Gemm g{XB, Bt5, DM, DM}; pg8::UnitOrder S; S.init(pg8::SK_PLAIN, 2 * FF, DM, F.G, F.bid, 0); pg8::EpiSwi E{Hb};
            pg8::gemm_phase<pg8::EpiSwi, pg8::UnitOrder, true>(F.lds + RING_OFF, g, S, E, wave0);
            if (F.G == 256 && F.bid >= 172 && l == 0 && rep + 1 == NREP(6)) {
                REFRESH(); convert_matrix<RM_WIN>(F, F.in[I_WIN] + (size_t)DM * INC, DM, INC, WA, DM, 0, 0, (F.bid - 172) * NWAVES + F.wave, 84 * NWAVES); } }
        SEAM(pb + 6);
        if (IN(pb + 7)) for (int rep = 0; rep < NREP(7); ++rep) { if (rep) xcd_barrier(bar); pg8::Gemm g{Hb, Bt6, FF, FF}; pg8::UnitOrder S; S.init(pg8::SK_P6, DM, FF, F.G, F.bid, 0); pg8::EpiRes E{F.out, F.out + (size_t)MP * DM, F.out, (float*)(F.ws + WS_SLAB)};
            pg8::gemm_phase<pg8::EpiRes, pg8::UnitOrder, true>(F.lds + RING_OFF, g, S, E, wave0); }
        SEAM(pb + 7);
        if (IN(pb + 8)) for (int rep = 0; rep < NREP(8); ++rep) { if (rep) xcd_barrier(bar);
            REFRESH();
            ln_rows(F, F.out, rep + 1 < NREP(8) ? (float*)(F.ws + WS_Y) : F.out, F.in[I_LN2G] + l * DM, F.in[I_LN2B] + l * DM, (l == 0 && rep + 1 == NREP(8)) ? XB : nullptr, F.out + (size_t)MP * DM, (const float*)(F.ws + WS_SLAB), 11);
            REFRESH();
            if (l == 0 && F.G != 256) convert_matrix<RM_WIN>(F, F.in[I_WIN] + (size_t)DM * INC, DM, INC, WA, DM, 0, 0, F.bid * NWAVES + F.wave, F.G * NWAVES);
        }
        if (l == 0) SEAM(pb + 8);
    }
#undef IN
#undef SEAM
#undef REFRESH
}

extern "C" void kernel_launch(void* const* d_in, const int* in_sizes, int n_in, void* d_out, int out_size, void* d_ws, size_t ws_size, hipStream_t stream) {
    static int grid = 0;
    if (grid == 0) {
        if (n_in != 31 || out_size != (int)O_END || ws_size < WS_END) { fprintf(stderr, "kernel_launch: unexpected sizes n_in %d out %d ws %zu\n", n_in, out_size, ws_size); grid = -1; return; }
        int dev = 0, cus = 0, per_cu = 0;
        if (hipGetDevice(&dev) != hipSuccess || hipDeviceGetAttribute(&cus, hipDeviceAttributeMultiprocessorCount, dev) != hipSuccess) { grid = -1; return; }
        if (hipFuncSetAttribute((const void*)hybrid_fwd, hipFuncAttributeMaxDynamicSharedMemorySize, LDS_BYTES) != hipSuccess) { fprintf(stderr, "kernel_launch: hipFuncSetAttribute failed\n"); grid = -1; return; }
        if (hipOccupancyMaxActiveBlocksPerMultiprocessor(&per_cu, (const void*)hybrid_fwd, NWAVES * 64, LDS_BYTES) != hipSuccess || per_cu < 1)
            fprintf(stderr, "kernel_launch: occupancy query reports %d workgroups per CU\n", per_cu);
        (void)hipGetLastError();
        grid = cus;
    }
    if (grid < 0) return;
    if (hipMemsetAsync((char*)d_ws + WS_CTL, 0, CTL_ZERO_BYTES, stream) != hipSuccess) { fprintf(stderr, "kernel_launch: memset failed\n"); return; }
    Args a{};
    for (int i = 0; i < 31; ++i) a.in[i] = (const float*)d_in[i];
    a.out = (float*)d_out; a.ws = (unsigned char*)d_ws;
#if MK_SPLIT
    for (int ph = 0; ph < NPHASE; ++ph) { a.ph_lo = ph; a.ph_hi = ph + 1; hipLaunchKernelGGL(hybrid_fwd, dim3(grid), dim3(NWAVES * 64), LDS_BYTES, stream, a); }
#else
    a.ph_lo = 0; a.ph_hi = NPHASE;
    hipLaunchKernelGGL(hybrid_fwd, dim3(grid), dim3(NWAVES * 64), LDS_BYTES, stream, a);
#endif
}
```

```cpp
#include <hip/hip_runtime.h>
#include <cstdio>
#include <cstdint>

#ifndef PROBE_REP
#define PROBE_REP 0
#endif
#define NREP(k) (1 + ((PROBE_REP >> (k)) & 1))
#ifndef PROBE2
#define PROBE2 0
#endif
#define NREP2(j) (1 + ((PROBE2 >> (j)) & 1))
#ifndef MK_SPLIT
#define MK_SPLIT 0
#endif

constexpr int DM = 1024, WMIX = 512, NPB = 8, SEQ = 2048, NSB = 128, DSEQ = 4;
constexpr int MP = NPB * SEQ, MS = NSB * DSEQ, M = MP + MS;
constexpr int FF = 2816, INC = 8192, ZC = 3072, YC = 2048, GC = 4096;
constexpr float LN_EPS = 1e-5f, ALPHA = 1.41421356237f;
constexpr size_t O_Y = 0, O_PH = (size_t)M * DM, O_PRGC = O_PH + 8192, O_PCF = O_PRGC + 24576, O_PPOOL = O_PCF + 245760, O_PSC = O_PPOOL + 122880,
                 O_SH = O_PSC + 16384, O_SRGC = O_SH + 131072, O_SCF = O_SRGC + 393216, O_SPOOL = O_SCF + 3932160, O_SSC = O_SPOOL + 1966080, O_END = O_SSC + 262144;
static_assert(O_END == 24403968, "output map");

__device__ __forceinline__ int opqv(int v) { asm volatile("" : "+v"(v)); return v; }
__device__ __forceinline__ int lane_now() { int l; asm volatile("v_mbcnt_lo_u32_b32 %0, -1, 0\n\tv_mbcnt_hi_u32_b32 %0, -1, %0" : "=v"(l)); return l; }
__device__ __forceinline__ int opqs(int v) { asm volatile("" : "+s"(v)); return v; }
namespace pg8 {
#define PG8_LAS __attribute__((address_space(3)))
typedef unsigned short bf16_t;
typedef short bf16x8 __attribute__((ext_vector_type(8)));
typedef float f32x4 __attribute__((ext_vector_type(4)));
typedef float f32x2 __attribute__((ext_vector_type(2)));
typedef unsigned u32x4 __attribute__((ext_vector_type(4)));
typedef unsigned u32x2 __attribute__((ext_vector_type(2)));
typedef _Float16 f16x4 __attribute__((ext_vector_type(4)));
typedef _Float16 f16x8 __attribute__((ext_vector_type(8)));
constexpr int BM = 256, BK = 64, HALF = 128, HTB = HALF * BK * 2, STAGE_BYTES = 8 * HTB, NXCD = 8, WGM = 8;

__host__ __device__ __forceinline__ int lds_byte(int r, int c) { const int st = (r >> 4) * 2 + (c >> 5), rr = r & 15, cc = c & 31, ob = rr * 64 + cc * 2; return st * 1024 + (ob ^ (((ob >> 9) & 1) << 5)); }
__host__ __device__ __forceinline__ void stage_rc(int b, int& R, int& C) { const int st = b / 1024, sb = b % 1024, swz = sb ^ (((sb >> 9) & 1) << 5); R = (st >> 1) * 16 + swz / 64; C = (st & 1) * 32 + (swz % 64) / 2; }
__host__ __device__ __forceinline__ int perm32(int rho) { const int n = rho >> 4, i = rho & 15; return 8 * (i >> 2) + 4 * n + (i & 3); }

struct Unit { int pm, pn, nt, mode, aux; long offA, offB; };
struct Gemm { const bf16_t* A; const bf16_t* Bt; int lda, ldb; };

enum { SK_PLAIN = 0, SK_P3 = 1, SK_P4 = 2, SK_P6 = 3 };
struct UnitOrder {
    int kind, nN, nwgP, nS, ntP, G, c; long offA_s;
    __device__ __forceinline__ void init(int kind_, int N_, int K_, int G_, int c_, long offA_s_, bool prompt = true, bool sample = true) { kind = kind_; nN = N_ / BM; nwgP = prompt ? 64 * nN : 0; ntP = K_ / BK; G = G_; c = c_; offA_s = offA_s_;
        nS = !sample ? 0 : kind_ == SK_PLAIN ? 2 * nN : kind_ == SK_P3 ? 32 : kind_ == SK_P4 ? 64 : 88; }
    __device__ __forceinline__ bool next(int i, Unit& u, const Gemm& g) const {
        const long L = (long)i * G + c; const long ra = (long)BM * g.lda * 2, rb = (long)BM * g.ldb * 2;
        if (L < nwgP) {
            int wgid = (int)L; { const int q = nwgP / NXCD, xcd = wgid % NXCD, off = wgid / NXCD; wgid = xcd * q + off; }
            const int nig = WGM * nN; u.pm = (wgid / nig) * WGM + ((wgid % nig) % WGM); u.pn = (wgid % nig) / WGM;
            u.nt = ntP; u.mode = 0; u.aux = 0; u.offA = u.pm * ra; u.offB = u.pn * rb; return true; }
        const int s = (int)(L - nwgP); if (s >= nS) return false;
        if (kind == SK_PLAIN) { u.pm = 64 + (s & 1); u.pn = s >> 1; u.nt = ntP; u.mode = 0; u.aux = 0; u.offA = u.pm * ra; u.offB = u.pn * rb; }
        else if (kind == SK_P3) { const int n = s & 3, tile = s >> 2; u.pm = 64 + (tile & 1); u.pn = tile >> 1; u.nt = 8; u.mode = 1; u.aux = n; u.offA = u.pm * ra + 1024 * n; u.offB = u.pn * rb + 1024 * n; }
        else if (kind == SK_P4) { const int ch = s & 7, tile = s >> 3, n = ch >> 1, kin = (ch & 1) * 512; u.pm = 64 + (tile & 1); u.pn = tile >> 1; u.nt = 8; u.mode = 1; u.aux = ch;
            u.offA = offA_s + ((long)(n * 512 + (u.pm - 64) * 256) * 1024 + kin) * 2; u.offB = u.pn * rb + kin * 2; }
        else { const int ch = s % 11, tile = s / 11; u.pm = 64 + (tile & 1); u.pn = tile >> 1; u.nt = 4; u.mode = 1; u.aux = ch; u.offA = u.pm * ra + 512 * ch; u.offB = u.pn * rb + 512 * ch; }
        return true;
    }
};

__device__ __forceinline__ unsigned cvt_pk_bf16(float lo, float hi) { unsigned r; asm volatile("v_cvt_pk_bf16_f32 %0, %1, %2" : "=v"(r) : "v"(lo), "v"(hi)); return r; }
__device__ __forceinline__ float sigmoidf_fast(float x) { return __builtin_amdgcn_rcpf(1.0f + __builtin_amdgcn_exp2f(-1.44269504089f * x)); }
__device__ __forceinline__ float gelu_tanh(float x) { const float t = x * x, y = x * fmaf(t, -0.10294324f, -2.3022082f); return x * __builtin_amdgcn_rcpf(1.0f + __builtin_amdgcn_exp2f(y)); }

__device__ __forceinline__ float* state_ptr(float* out, int R, int keep, int layer, size_t p_off, size_t s_off) {
    if (R < MP) { const int b = R >> 11, j = (R & 2047) - (2048 - keep); return j < 0 ? nullptr : out + p_off + (size_t)((layer * 8 + b) * keep + j) * 512; }
    const int s = (R - MP) >> 2, j = (R & 3) + keep - 4; return j < 0 ? nullptr : out + s_off + (size_t)((layer * 128 + s) * keep + j) * 512;
}

struct EpiMix {
    static constexpr bool PERM = true, MIDK = false;
    bf16_t* Z; float* out; int layer;
    __device__ __forceinline__ void midk(f32x4 (&)[2][2][4][2], const Unit&, int, int, int, int, int) const {}
    __device__ __forceinline__ void operator()(f32x4 (&acc)[2][2][4][2], const Unit& u, int wr, int wc, int fr_, int fq_) const {
        const int lane_ = lane_now(), fr = lane_ & 15, fq = lane_ >> 4; (void)fr_; (void)fq_;
        const int pn = u.pn; int type, zcol, keep = 0, scol = 0; size_t poff = 0, soff = 0;
        if (pn < 2) { type = 0; zcol = 256 * pn; keep = 3; scol = zcol; poff = O_PRGC; soff = O_SRGC; }
        else if (pn < 4) { type = 1; zcol = 512 + 256 * (pn - 2); }
        else if (pn < 8) { type = 2; zcol = 1024 + 128 * (pn - 4); keep = 30; scol = 128 * (pn - 4); poff = O_PCF; soff = O_SCF; }
        else if (pn < 10) { type = 0; zcol = 1536 + 256 * (pn - 8); keep = 15; scol = 256 * (pn - 8); poff = O_PPOOL; soff = O_SPOOL; }
        else if (pn < 12) { type = 0; zcol = 2048 + 256 * (pn - 10); }
        else { type = 3; zcol = 2560 + 128 * (pn - 12); keep = 2; scol = 128 * (pn - 12); poff = O_PSC; soff = O_SSC; }
        const bool tail = keep != 0 && (u.pm >= 64 || (u.pm & 7) == 7);
        const int row0 = u.pm * BM + wr * 64 + fr, cl = wc * 32 + 8 * fq;
        if (type < 2) {
#pragma unroll
            for (int ai = 0; ai < 2; ++ai)
#pragma unroll
                for (int m = 0; m < 4; ++m) { const int R = row0 + ai * HALF + m * 16; bf16_t* rowp = Z + (size_t)R * ZC + zcol + cl;
                    float* sp = tail ? state_ptr(out, R, keep, layer, poff, soff) : nullptr;
#pragma unroll
                    for (int bj = 0; bj < 2; ++bj) { f32x4 v0 = acc[ai][bj][m][0], v1 = acc[ai][bj][m][1];
                        if (type == 1) { v0 = (f32x4){gelu_tanh(v0[0]), gelu_tanh(v0[1]), gelu_tanh(v0[2]), gelu_tanh(v0[3])}; v1 = (f32x4){gelu_tanh(v1[0]), gelu_tanh(v1[1]), gelu_tanh(v1[2]), gelu_tanh(v1[3])}; }
                        u32x4 w; w.x = cvt_pk_bf16(v0[0], v0[1]); w.y = cvt_pk_bf16(v0[2], v0[3]); w.z = cvt_pk_bf16(v1[0], v1[1]); w.w = cvt_pk_bf16(v1[2], v1[3]);
                        *(u32x4*)(rowp + bj * HALF) = w;
                        if (sp) { *(f32x4*)(sp + scol + cl + bj * HALF) = v0; *(f32x4*)(sp + scol + cl + bj * HALF + 4) = v1; } } }
        } else {
#pragma unroll
            for (int ai = 0; ai < 2; ++ai)
#pragma unroll
                for (int m = 0; m < 4; ++m) { const int R = row0 + ai * HALF + m * 16; bf16_t* rowp = Z + (size_t)R * ZC + zcol + cl;
                    float* sp = tail ? state_ptr(out, R, keep, layer, poff, soff) : nullptr;
                    f32x4 v0, v1; const f32x4 a0 = acc[ai][0][m][0], a1 = acc[ai][0][m][1], b0 = acc[ai][1][m][0], b1 = acc[ai][1][m][1];
                    if (type == 2) {
#pragma unroll
                        for (int i = 0; i < 4; ++i) { v0[i] = a0[i] * sigmoidf_fast(b0[i]); v1[i] = a1[i] * sigmoidf_fast(b1[i]); }
                    } else { v0 = a0 * b0; v1 = a1 * b1; }
                    u32x4 w; w.x = cvt_pk_bf16(v0[0], v0[1]); w.y = cvt_pk_bf16(v0[2], v0[3]); w.z = cvt_pk_bf16(v1[0], v1[1]); w.w = cvt_pk_bf16(v1[2], v1[3]);
                    *(u32x4*)rowp = w;
                    if (sp) { *(f32x4*)(sp + scol + cl) = v0; *(f32x4*)(sp + scol + cl + 4) = v1; } }
        }
    }
};

struct EpiGate {
    static constexpr bool PERM = true, MIDK = false;
    _Float16* G;
    __device__ __forceinline__ void midk(f32x4 (&)[2][2][4][2], const Unit&, int, int, int, int, int) const {}
    __device__ __forceinline__ void operator()(f32x4 (&acc)[2][2][4][2], const Unit& u, int wr, int wc, int fr_, int fq_) const {
        const int lane_ = lane_now(), fr = lane_ & 15, fq = lane_ >> 4; (void)fr_; (void)fq_;
        const int row0 = u.pm * BM + wr * 64 + fr, ch0 = 64 * u.pn + 16 * wc + 4 * fq; const bool plain = u.pm >= 64;
#pragma unroll
        for (int ai = 0; ai < 2; ++ai)
#pragma unroll
            for (int m = 0; m < 4; ++m) { const int R = row0 + ai * HALF + m * 16; _Float16* gp = G + (size_t)R * GC + ch0;
                f16x4 r0, r1, r2, g3;
#pragma unroll
                for (int i = 0; i < 4; ++i) {
                    const float d0 = 1.f + __builtin_amdgcn_exp2f(__builtin_amdgcn_fmed3f(acc[ai][0][m][0][i], -15.f, 15.f)), d1 = 1.f + __builtin_amdgcn_exp2f(__builtin_amdgcn_fmed3f(acc[ai][0][m][1][i], -15.f, 15.f));
                    const float d2 = 1.f + __builtin_amdgcn_exp2f(__builtin_amdgcn_fmed3f(acc[ai][1][m][0][i], -15.f, 15.f)), d3 = 1.f + __builtin_amdgcn_exp2f(__builtin_amdgcn_fmed3f(acc[ai][1][m][1][i], -15.f, 15.f));
                    const float i0 = __builtin_amdgcn_rcpf(d0), i1 = __builtin_amdgcn_rcpf(d1), i2 = __builtin_amdgcn_rcpf(d2), i3 = __builtin_amdgcn_rcpf(d3);
                    if (plain) { r0[i] = (_Float16)i0; r1[i] = (_Float16)i1; r2[i] = (_Float16)i2; }
                    else { r0[i] = (_Float16)(d1 * i0); r1[i] = (_Float16)(d2 * i1); r2[i] = (_Float16)(d3 * i2); }
                    g3[i] = (_Float16)i3; }
                *(f16x4*)(gp) = r0; *(f16x4*)(gp + 1024) = r1; *(f16x4*)(gp + 2048) = r2; *(f16x4*)(gp + 3072) = g3; }
    }
};

struct EpiMerge {
    static constexpr bool PERM = false, MIDK = true;
    const _Float16* G; bf16_t* O; bf16_t* Os;
    __device__ __forceinline__ void scale(f32x4 (&acc)[2][2][4][2], const Unit& u, int seg, int wr, int wc) const {
        const int lane_ = lane_now(), fr = lane_ & 15, fq = lane_ >> 4;
        const int row0 = u.pm * BM + wr * 64 + fr, c0 = 1024 * seg + 256 * u.pn + wc * 32 + 4 * fq;
#pragma unroll
        for (int ai = 0; ai < 2; ++ai)
#pragma unroll
            for (int m = 0; m < 4; ++m) { const _Float16* gp = G + (size_t)(row0 + ai * HALF + m * 16) * GC + c0;
#pragma unroll
                for (int bj = 0; bj < 2; ++bj)
#pragma unroll
                    for (int n = 0; n < 2; ++n) { const f16x4 f = *(const f16x4*)(gp + bj * HALF + n * 16);
                        acc[ai][bj][m][n] *= (f32x4){(float)f[0], (float)f[1], (float)f[2], (float)f[3]}; } }
    }
    __device__ __forceinline__ void midk(f32x4 (&acc)[2][2][4][2], const Unit& u, int seg, int wr, int wc, int, int) const { scale(acc, u, seg, wr, wc); }
    __device__ __forceinline__ void operator()(f32x4 (&acc)[2][2][4][2], const Unit& u, int wr, int wc, int, int) const {
        scale(acc, u, u.mode ? u.aux : 3, wr, wc);
        const int lane_ = lane_now(), fr = lane_ & 15, fq = lane_ >> 4;
        const int row0 = (u.mode ? (u.pm - 64) * BM + 512 * u.aux : u.pm * BM) + wr * 64 + fr, c0 = 256 * u.pn + wc * 32 + 4 * fq;
        bf16_t* O = u.mode ? Os : this->O;
#pragma unroll
        for (int ai = 0; ai < 2; ++ai)
#pragma unroll
            for (int m = 0; m < 4; ++m) { bf16_t* rowp = O + (size_t)(row0 + ai * HALF + m * 16) * DM + c0;
#pragma unroll
                for (int bj = 0; bj < 2; ++bj)
#pragma unroll
                    for (int n = 0; n < 2; ++n) { const f32x4 v = acc[ai][bj][m][n]; u32x2 w; w.x = cvt_pk_bf16(v[0], v[1]); w.y = cvt_pk_bf16(v[2], v[3]); *(u32x2*)(rowp + bj * HALF + n * 16) = w; } }
    }
};

struct EpiRes {
    static constexpr bool PERM = false, MIDK = false;
    const float* baseP; const float* baseS; float* out; float* slab;
    __device__ __forceinline__ void midk(f32x4 (&)[2][2][4][2], const Unit&, int, int, int, int, int) const {}
    __device__ __forceinline__ void operator()(f32x4 (&acc)[2][2][4][2], const Unit& u, int wr, int wc, int fr_, int fq_) const {
        const int lane_ = lane_now(), fr = lane_ & 15, fq = lane_ >> 4; (void)fr_; (void)fq_;
        const int row0 = u.pm * BM + wr * 64 + fr, c0 = 256 * u.pn + wc * 32 + 4 * fq;
        if (u.mode) {
#pragma unroll
            for (int ai = 0; ai < 2; ++ai)
#pragma unroll
                for (int m = 0; m < 4; ++m) { float* op = slab + ((size_t)u.aux * 512 + (row0 - MP) + ai * HALF + m * 16) * DM + c0;
#pragma unroll
                    for (int bj = 0; bj < 2; ++bj)
#pragma unroll
                        for (int n = 0; n < 2; ++n) *(f32x4*)(op + bj * HALF + n * 16) = acc[ai][bj][m][n]; }
            return; }
#pragma unroll
        for (int ai = 0; ai < 2; ++ai)
#pragma unroll
            for (int m = 0; m < 4; ++m) { const int R = row0 + ai * HALF + m * 16;
                const float* bp = (R < MP ? baseP + (size_t)R * DM : baseS + (size_t)(R - MP) * DM) + c0; float* op = out + (size_t)R * DM + c0;
#pragma unroll
                for (int bj = 0; bj < 2; ++bj)
#pragma unroll
                    for (int n = 0; n < 2; ++n) { const f32x4 b = *(const f32x4*)(bp + bj * HALF + n * 16); *(f32x4*)(op + bj * HALF + n * 16) = b * ALPHA + acc[ai][bj][m][n]; }
                if (m & 1) asm volatile("" ::: "memory"); }
    }
};

struct EpiSwi {
    static constexpr bool PERM = true, MIDK = false;
    bf16_t* H;
    __device__ __forceinline__ void midk(f32x4 (&)[2][2][4][2], const Unit&, int, int, int, int, int) const {}
    __device__ __forceinline__ void operator()(f32x4 (&acc)[2][2][4][2], const Unit& u, int wr, int wc, int fr_, int fq_) const {
        const int lane_ = lane_now(), fr = lane_ & 15, fq = lane_ >> 4; (void)fr_; (void)fq_;
        const int row0 = u.pm * BM + wr * 64 + fr, c0 = 128 * u.pn + wc * 32 + 8 * fq;
#pragma unroll
        for (int ai = 0; ai < 2; ++ai)
#pragma unroll
            for (int m = 0; m < 4; ++m) { bf16_t* rowp = H + (size_t)(row0 + ai * HALF + m * 16) * FF + c0;
                const f32x4 g0 = acc[ai][0][m][0], g1 = acc[ai][0][m][1], u0 = acc[ai][1][m][0], u1 = acc[ai][1][m][1]; f32x4 v0, v1;
#pragma unroll
                for (int i = 0; i < 4; ++i) { v0[i] = g0[i] * sigmoidf_fast(g0[i]) * u0[i]; v1[i] = g1[i] * sigmoidf_fast(g1[i]) * u1[i]; }
                u32x4 w; w.x = cvt_pk_bf16(v0[0], v0[1]); w.y = cvt_pk_bf16(v0[2], v0[3]); w.z = cvt_pk_bf16(v1[0], v1[1]); w.w = cvt_pk_bf16(v1[2], v1[3]);
                *(u32x4*)rowp = w; }
    }
};

template <class Epi, class Sched, bool ALIGN_EPI>
__device__ __forceinline__ void gemm_phase(PG8_LAS unsigned char* lds, const Gemm g, const Sched& S, const Epi& E, int wave_id) {
    const int wid = opqs(wave_id), lane = lane_now(), tid = wid * 64 + lane, wr = wid >> 2, wc = wid & 3, fr = lane & 15, fq = lane >> 4;
    unsigned voffA[2], voffB[2];
#pragma unroll
    for (int i = 0; i < 2; ++i) { int R, C; stage_rc(tid * 16 + i * 8192, R, C); const int Rb = Epi::PERM ? ((R & ~31) + perm32(R & 31)) : R;
        voffA[i] = (unsigned)(R * g.lda + C) * 2u; voffB[i] = (unsigned)(Rb * g.ldb + C) * 2u; }
    const size_t kstep = (size_t)(BK * 2);
    const size_t hstepA = (size_t)HALF * g.lda * 2, hstepB = (size_t)HALF * g.ldb * 2;
    const unsigned ldsw = (unsigned)wid * 1024u;
    const int aoff = lds_byte(wr * 64 + fr, fq * 8), boff = lds_byte(wc * 32 + fr, fq * 8);
#define PG8_SA(b, h) (((b) * 2 + (h)) * HTB)
#define PG8_SB(b, h) ((4 + (b) * 2 + (h)) * HTB)
#define PG8_STAGE(bufoff, gbase, voff) do { _Pragma("unroll") for (int _i = 0; _i < 2; ++_i) \
        __builtin_amdgcn_global_load_lds((const unsigned*)((const char*)(gbase) + (voff)[_i]), (PG8_LAS unsigned*)(lds + (bufoff) + ldsw + _i * 8192), 16, 0, 0); } while (0)
#define PG8_LDA(dst, b, h) do { _Pragma("unroll") for (int m = 0; m < 4; ++m) _Pragma("unroll") for (int k = 0; k < 2; ++k) dst[m][k] = *(const PG8_LAS bf16x8*)(lds + PG8_SA(b, h) + aoff + m * 2048 + k * 1024); } while (0)
#define PG8_LDB(dst, b, h) do { _Pragma("unroll") for (int n = 0; n < 2; ++n) _Pragma("unroll") for (int k = 0; k < 2; ++k) dst[n][k] = *(const PG8_LAS bf16x8*)(lds + PG8_SB(b, h) + boff + n * 2048 + k * 1024); } while (0)
#define PG8_MMA(ai, bj, At, Bt) do { __builtin_amdgcn_s_setprio(1); _Pragma("unroll") for (int m = 0; m < 4; ++m) _Pragma("unroll") for (int n = 0; n < 2; ++n) _Pragma("unroll") for (int k = 0; k < 2; ++k) \
        acc[ai][bj][m][n] = __builtin_amdgcn_mfma_f32_16x16x32_bf16(Bt[n][k], At[m][k], acc[ai][bj][m][n], 0, 0, 0); __builtin_amdgcn_s_setprio(0); } while (0)
#define PG8_WAIT_V(n) asm volatile("s_waitcnt vmcnt(" #n ")" ::: "memory")
#define PG8_WAIT_L(n) asm volatile("s_waitcnt lgkmcnt(" #n ")" ::: "memory")
#define PG8_BAR __builtin_amdgcn_s_barrier()
#define PG8_SCHED __builtin_amdgcn_sched_barrier(0)
    Unit cur, nxt; int ui = 0;
    if (!S.next(0, cur, g)) return;
    f32x4 acc[2][2][4][2];
#pragma unroll
    for (int a = 0; a < 2; ++a)
#pragma unroll
        for (int b = 0; b < 2; ++b)
#pragma unroll
            for (int m = 0; m < 4; ++m)
#pragma unroll
                for (int n = 0; n < 2; ++n) acc[a][b][m][n] = (f32x4){0.f, 0.f, 0.f, 0.f};
    bf16x8 At[4][2], B0[2][2], B1[2][2];
    const char* cA = (const char*)g.A + cur.offA; const char* cB = (const char*)g.Bt + cur.offB;
    PG8_STAGE(PG8_SB(0, 0), cB, voffB); PG8_STAGE(PG8_SB(0, 1), cB + hstepB, voffB); PG8_STAGE(PG8_SA(0, 0), cA, voffA); PG8_STAGE(PG8_SA(0, 1), cA + hstepA, voffA);
    if (wr == 1) PG8_BAR;
    PG8_WAIT_V(2); PG8_BAR;
    PG8_STAGE(PG8_SB(1, 0), cB + kstep, voffB); PG8_STAGE(PG8_SA(1, 0), cA + kstep, voffA); PG8_STAGE(PG8_SB(1, 1), cB + hstepB + kstep, voffB);
    PG8_WAIT_V(6); PG8_BAR;
    for (;;) {
        const bool has_next = S.next(ui + 1, nxt, g);
        const char* nA = has_next ? (const char*)g.A + nxt.offA : cA; const char* nB = has_next ? (const char*)g.Bt + nxt.offB : cB;
        const int nt = cur.nt, TSEG = Epi::MIDK ? 8 : nt;
        for (int t0 = 0; t0 < nt; t0 += TSEG) {
        if constexpr (Epi::MIDK) { if (t0 != 0) { PG8_SCHED; E.midk(acc, cur, t0 / TSEG - 1, wr, wc, 0, 0); PG8_SCHED; } }
#pragma unroll 1
        for (int t = t0; t < t0 + TSEG; t += 2) {
            const bool last = (t == nt - 2);
            const char* a1 = cA + (size_t)(t + 1) * kstep;
            const char* a2 = last ? nA : cA + (size_t)(t + 2) * kstep; const char* b2 = last ? nB : cB + (size_t)(t + 2) * kstep;
            const char* a3 = a2 + kstep; const char* b3 = b2 + kstep;
            PG8_LDB(B0, 0, 0); PG8_LDB(B1, 0, 1); PG8_SCHED; PG8_LDA(At, 0, 0); PG8_STAGE(PG8_SA(1, 1), a1 + hstepA, voffA);
            PG8_WAIT_V(8); PG8_WAIT_L(0); PG8_BAR; PG8_MMA(0, 0, At, B0); PG8_MMA(0, 1, At, B1); PG8_BAR; PG8_SCHED;
            PG8_LDA(At, 0, 1); PG8_STAGE(PG8_SB(0, 0), b2, voffB); PG8_STAGE(PG8_SB(0, 1), b2 + hstepB, voffB); PG8_STAGE(PG8_SA(0, 0), a2, voffA);
            PG8_WAIT_V(8); PG8_WAIT_L(0); PG8_BAR; PG8_MMA(1, 0, At, B0); PG8_MMA(1, 1, At, B1); PG8_BAR; PG8_SCHED;
            PG8_LDB(B0, 1, 0); PG8_LDB(B1, 1, 1); PG8_SCHED; PG8_LDA(At, 1, 0); PG8_STAGE(PG8_SA(0, 1), a2 + hstepA, voffA);
            PG8_WAIT_V(8); PG8_WAIT_L(0); PG8_BAR; PG8_MMA(0, 0, At, B0); PG8_MMA(0, 1, At, B1); PG8_BAR; PG8_SCHED;
            PG8_LDA(At, 1, 1); PG8_STAGE(PG8_SB(1, 0), b3, voffB); PG8_STAGE(PG8_SB(1, 1), b3 + hstepB, voffB); PG8_STAGE(PG8_SA(1, 0), a3, voffA);
            PG8_WAIT_V(8); PG8_WAIT_L(0); PG8_BAR; PG8_MMA(1, 0, At, B0); PG8_MMA(1, 1, At, B1); PG8_BAR; PG8_SCHED;
        }
        }
        if constexpr (ALIGN_EPI) { if (wr == 0) PG8_BAR; }
        E(acc, cur, wr, wc, 0, 0);
        if (!has_next) break;
#pragma unroll
        for (int a = 0; a < 2; ++a)
#pragma unroll
            for (int b = 0; b < 2; ++b)
#pragma unroll
                for (int m = 0; m < 4; ++m)
#pragma unroll
                    for (int n = 0; n < 2; ++n) acc[a][b][m][n] = (f32x4){0.f, 0.f, 0.f, 0.f};
        cur = nxt; cA = nA; cB = nB; ++ui;
        if constexpr (ALIGN_EPI) { if (wr == 1) PG8_BAR; }
    }
    PG8_WAIT_V(0);
    if constexpr (!ALIGN_EPI) { if (wr == 0) PG8_BAR; }
    PG8_BAR;
#undef PG8_SA
#undef PG8_SB
#undef PG8_STAGE
#undef PG8_LDA
#undef PG8_LDB
#undef PG8_MMA
#undef PG8_WAIT_V
#undef PG8_WAIT_L
#undef PG8_BAR
#undef PG8_SCHED
}
}

constexpr int NWAVES = 8;
constexpr int NPHASE = 19;
constexpr size_t MiB = 1u << 20;
constexpr size_t WS_CTL = 0, CTL_ZERO_BYTES = 1 * MiB;
constexpr size_t WS_WA = 1 * MiB;
constexpr size_t WS_XB = 18 * MiB;
constexpr size_t WS_Y = 51 * MiB;
constexpr size_t WS_ZG = 117 * MiB;
constexpr size_t WS_BT3 = 249 * MiB, WS_BT4 = 253 * MiB, WS_BT5 = WS_ZG + 96 * MiB, WS_BT6 = WS_ZG + 108 * MiB;
constexpr size_t WS_MB4S = WS_WA + 8 * MiB;
constexpr size_t WS_SLAB = WS_Y;
constexpr size_t WS_END = 255 * MiB;
static_assert(WS_XB + (size_t)M * DM * 2 <= WS_Y && WS_Y + (size_t)M * YC * 2 <= WS_ZG && WS_ZG + (size_t)M * GC * 2 <= WS_BT3 && WS_SLAB + (size_t)11 * 512 * DM * 4 <= WS_ZG, "ws map");
static_assert((size_t)M * FF * 2 <= 96 * MiB && WS_BT5 + (size_t)2 * FF * DM * 2 <= WS_BT6 && WS_BT6 + (size_t)DM * FF * 2 <= WS_BT3, "ws map 2");
constexpr int CW_TMO = 0, CW_CODE = 1, CW_BAR = 4096;
constexpr int RING_OFF = 0, RING_BYTES = 131072;
constexpr int LDSCTL_OFF = RING_BYTES, MISC_OFF = LDSCTL_OFF + 320;
constexpr int LDS_BYTES = 147456;

#define GAS __attribute__((address_space(1)))
#define LAS __attribute__((address_space(3)))
typedef unsigned short bf16;
typedef unsigned v4u __attribute__((ext_vector_type(4)));
typedef unsigned v2u __attribute__((ext_vector_type(2)));
typedef float f32x4 __attribute__((ext_vector_type(4)));
typedef float f32x2 __attribute__((ext_vector_type(2)));
typedef short bf16x8 __attribute__((ext_vector_type(8)));
typedef GAS unsigned gu32;
#define RLX_AGENT __ATOMIC_RELAXED, __HIP_MEMORY_SCOPE_AGENT
#define LDS_WAIT() asm volatile("s_waitcnt lgkmcnt(0)" ::: "memory")
#define VM_WAIT() asm volatile("s_waitcnt vmcnt(0)" ::: "memory")
__device__ __forceinline__ unsigned pk2(float lo, float hi) { return pg8::cvt_pk_bf16(lo, hi); }
__device__ __forceinline__ float bflo(unsigned v) { return __uint_as_float(v << 16); }
__device__ __forceinline__ float bfhi(unsigned v) { return __uint_as_float(v & 0xffff0000u); }
__device__ __forceinline__ float bf1(unsigned short h) { return __uint_as_float((unsigned)h << 16); }
__device__ __forceinline__ unsigned short f2bf(float f) { return (unsigned short)(pg8::cvt_pk_bf16(f, 0.f) & 0xffffu); }

#define XB_TMO      128
#define XB_XCNT(j)  (256  + 64 * (j))
#define XB_XSUB(j)  (1280 + 64 * (j))
#define XB_XGEN(j)  (2304 + 64 * (j))
#define XB_TOP      3328
#define XB_TOPGEN   3392
#define XCD_BAR_WORDS 3456
#define XB_SPIN_CAP (1u << 18)
__device__ __forceinline__ unsigned xb_ld(unsigned* p)              { return __hip_atomic_load(p, __ATOMIC_RELAXED, __HIP_MEMORY_SCOPE_AGENT); }
__device__ __forceinline__ unsigned xb_add(unsigned* p, unsigned v) { return __hip_atomic_fetch_add(p, v, __ATOMIC_RELAXED, __HIP_MEMORY_SCOPE_AGENT); }
__device__ __forceinline__ unsigned xb_xcc_id() { return (unsigned)__builtin_amdgcn_s_getreg((3 << 11) | 20) & 0xFu; }
#define XB_SPIN(cond, bar) do { unsigned _sp = 0; while (cond) { __builtin_amdgcn_s_sleep(1); \
    if ((++_sp & 255u) == 0u) { if (xb_ld(&(bar)[XB_TMO])) break; if (_sp > XB_SPIN_CAP) { atomicAdd(&(bar)[XB_TMO], 1u); break; } } } } while (0)
struct XcdBarrier { unsigned* bar; unsigned x; volatile LAS unsigned* st; };
__device__ __forceinline__ XcdBarrier xcd_barrier_post(unsigned* bar, volatile LAS unsigned* st) {
    XcdBarrier b; b.bar = bar; b.x = xb_xcc_id(); b.st = st;
    if (threadIdx.x == 0) (void)xb_add(&bar[XB_XCNT(b.x)], 1u);
    return b;
}
__device__ __forceinline__ void xcd_barrier_complete(unsigned* bar, unsigned x, unsigned& nloc, unsigned& nx) {
    const unsigned G = gridDim.x * gridDim.y * gridDim.z;
    unsigned sum, cnt, mine, sp = 0u;
    for (;;) {
        sum = 0u; cnt = 0u; mine = 0u;
#pragma unroll
        for (unsigned j = 0; j < 16; ++j) { const unsigned c = xb_ld(&bar[XB_XCNT(j)]); sum += c; cnt += (c > 0u) ? 1u : 0u; mine = (j == x) ? c : mine; }
        if (sum == G) break;
        __builtin_amdgcn_s_sleep(1);
        if ((++sp & 255u) == 0u) { if (xb_ld(&bar[XB_TMO])) break; if (sp > XB_SPIN_CAP) { atomicAdd(&bar[XB_TMO], 1u); break; } }
    }
    nloc = mine > 0u ? mine : 1u; nx = cnt > 0u ? cnt : 1u;
}
__device__ __forceinline__ void xcd_barrier(const XcdBarrier& b) {
    asm volatile("s_waitcnt vmcnt(0)" ::: "memory");
    __syncthreads();
    if (threadIdx.x == 0) {
        unsigned* bar = b.bar;
        __builtin_amdgcn_s_waitcnt(0);
        unsigned nloc = b.st[0], nx = b.st[1];
        if (nloc == 0u) { xcd_barrier_complete(bar, b.x, nloc, nx); b.st[0] = nloc; b.st[1] = nx; }
        const unsigned old = xb_add(&bar[XB_XSUB(b.x)], 1u);
        const unsigned gen = old / nloc;
        if (old + 1u == (gen + 1u) * nloc) {
            __builtin_amdgcn_fence(__ATOMIC_RELEASE, "agent");
            asm volatile("s_waitcnt vmcnt(0)" ::: "memory");
            const unsigned og = xb_add(&bar[XB_TOP], 1u);
            const unsigned tg = og / nx;
            if (og + 1u == (tg + 1u) * nx) xb_add(&bar[XB_TOPGEN], 1u);
            else XB_SPIN(xb_ld(&bar[XB_TOPGEN]) == tg, bar);
            __builtin_amdgcn_fence(__ATOMIC_ACQUIRE, "agent");
            xb_add(&bar[XB_XGEN(b.x)], 1u);
            asm volatile("s_waitcnt vmcnt(0)" ::: "memory");
        } else {
            XB_SPIN(xb_ld(&bar[XB_XGEN(b.x)]) == gen, bar);
            __builtin_amdgcn_fence(__ATOMIC_ACQUIRE, "agent");
            asm volatile("s_waitcnt vmcnt(0)" ::: "memory");
        }
    }
    __syncthreads();
}

struct Frame {
    LAS unsigned char* lds;
    volatile LAS unsigned* MISC;
    gu32* ctl;
    int tid, lane, wave, G, bid;
    const float* const* in;
    float* out;
    unsigned char* ws;
};
enum { I_XP = 0, I_XS, I_SH, I_SRGC, I_SCF, I_SPOOL, I_SSC, I_WIN, I_RGCW, I_RGCB, I_RGWA, I_RGBA, I_RGWX, I_RGBX, I_LAM, I_CFW, I_CFB, I_CFG, I_CFBB, I_POOLW, I_POOLS, I_SCW,
       I_WBR, I_WOUT, I_LN1G, I_LN1B, I_WG, I_WU, I_WD, I_LN2G, I_LN2B };

__device__ __forceinline__ float shfl_idx(float v, int src_lane) { return __builtin_bit_cast(float, __builtin_amdgcn_ds_bpermute(src_lane << 2, __builtin_bit_cast(int, v))); }
__device__ __forceinline__ float wave_sum(float v, int lane) {
#pragma unroll
    for (int o = 1; o < 64; o <<= 1) v += shfl_idx(v, lane ^ o);
    return v;
}

enum { RM_ID = 0, RM_WIN = 1, RM_GU = 2 };
template <int MODE> __device__ __forceinline__ int rowmap(int s, int extra) {
    if (MODE == RM_ID) return s;
    if (MODE == RM_GU) return 256 * (s >> 7) + (s & 127) + extra;
    if (s < 1024) return s;
    if (s < 2048) { const int j = ((s - 1024) >> 7) & 3; return 1024 + 256 * j + (s >= 1536 ? 128 : 0) + (s & 127); }
    if (s < 3072) return s;
    if (s < 4096) { const int j = ((s - 3072) >> 7) & 3; return 3072 + 256 * j + (s >= 3584 ? 128 : 0) + (s & 127); }
    const int g = (s - 4096) >> 10, ch = s & 1023, pn = ch >> 6, chl = ch & 63, wc = chl >> 4, fq = (chl >> 2) & 3, i = chl & 3;
    return 4096 + 256 * pn + 128 * (g >> 1) + 32 * wc + 8 * fq + 4 * (g & 1) + i;
}
template <int MODE>
__device__ __forceinline__ void transpose_item(const float* W, int K, int N, bf16* WT, int dst_ld, int dst_koff, int extra, LAS float* scr, int item, int lane) {
    const int nblk = N / 32, kb = item / nblk, nb = item % nblk, k0 = 64 * kb, n0 = 32 * nb;
#pragma unroll 8
    for (int i = 0; i < 32; ++i) { const int kk = 2 * i + (lane >> 5); scr[kk * 33 + (lane & 31)] = W[(size_t)(k0 + kk) * N + n0 + (lane & 31)]; }
    LDS_WAIT(); asm volatile("" ::: "memory");
    const int c = lane & 7; const float sc = (MODE == RM_WIN && n0 >= 4096) ? -1.44269504089f : 1.0f;
#pragma unroll
    for (int j = 0; j < 4; ++j) { const int n = (lane >> 3) + 8 * j; const LAS float* s = scr + (8 * c) * 33 + n;
        v4u o; o.x = pk2(s[0 * 33] * sc, s[1 * 33] * sc); o.y = pk2(s[2 * 33] * sc, s[3 * 33] * sc); o.z = pk2(s[4 * 33] * sc, s[5 * 33] * sc); o.w = pk2(s[6 * 33] * sc, s[7 * 33] * sc);
        *(GAS v4u*)(WT + (size_t)rowmap<MODE>(n0 + n, extra) * dst_ld + dst_koff + k0 + 8 * c) = o; }
    LDS_WAIT(); asm volatile("" ::: "memory");
}
template <int MODE>
__device__ __forceinline__ void convert_matrix(Frame& F, const float* W, int K, int N, bf16* WT, int dst_ld, int dst_koff, int extra, int gw, int NGW, int first = 0) {
    LAS float* scr = (LAS float*)(F.lds + RING_OFF + F.wave * 16384);
    const int nitems = (K / 64) * (N / 32);
    int it0 = gw - first; if (it0 < 0) it0 += ((-it0 + NGW - 1) / NGW) * NGW;
    for (int it = it0; it < nitems; it += NGW) transpose_item<MODE>(W, K, N, WT, dst_ld, dst_koff, extra, scr, it, F.lane);
}
__device__ __forceinline__ void compose_pool(Frame& F, int layer, bf16* Bt3, int gw, int NGW, int first = 0) {
    const float* pw = F.in[I_POOLW] + (size_t)layer * 4 * 128 * 128; const float* ps = F.in[I_POOLS] + layer * 512; const float* Wb2 = F.in[I_WBR] + ((size_t)layer * 4 + 2) * 512 * 1024;
    const int lane = F.lane;
    LAS float* Pl = (LAS float*)(F.lds + RING_OFF + F.wave * 16384);
    int id0 = gw - first; if (id0 < 0) id0 += ((-id0 + NGW - 1) / NGW) * NGW;
    for (int id = id0; id < 512; id += NGW) {
        const int g = __builtin_amdgcn_readfirstlane(id >> 7), c0 = __builtin_amdgcn_readfirstlane(8 * ((id >> 3) & 15)), d0 = 128 * (id & 7) + 2 * lane;
#pragma unroll
        for (int k = 0; k < 4; ++k) { const int idx4 = lane + 64 * k, i = idx4 >> 5, e4 = (idx4 & 31) * 4;
            const f32x4 pv = *(const GAS f32x4*)(pw + ((size_t)g * 128 + c0 + i) * 128 + e4), sv = *(const GAS f32x4*)(ps + 128 * g + e4);
            Pl[(e4 + 0) * 8 + i] = pv.x * sv.x; Pl[(e4 + 1) * 8 + i] = pv.y * sv.y; Pl[(e4 + 2) * 8 + i] = pv.z * sv.z; Pl[(e4 + 3) * 8 + i] = pv.w * sv.w; }
        LDS_WAIT(); asm volatile("" ::: "memory");
        f32x2 acc[8];
#pragma unroll
        for (int i = 0; i < 8; ++i) acc[i] = (f32x2){0.f, 0.f};
        const float* wrow = Wb2 + (size_t)(128 * g) * 1024 + d0;
#pragma unroll 1
        for (int e0 = 0; e0 < 128; e0 += 8) {
            f32x2 wv[8];
#pragma unroll
            for (int k = 0; k < 8; ++k) wv[k] = *(const GAS f32x2*)(wrow + (size_t)(e0 + k) * 1024);
#pragma unroll
            for (int k = 0; k < 8; ++k) { const f32x4 p0 = *(const LAS f32x4*)(Pl + (e0 + k) * 8), p1 = *(const LAS f32x4*)(Pl + (e0 + k) * 8 + 4);
#pragma unroll
                for (int i = 0; i < 4; ++i) { acc[i] += wv[k] * p0[i]; acc[4 + i] += wv[k] * p1[i]; } }
        }
        v4u o0, o1;
        o0.x = pk2(acc[0].x, acc[1].x); o0.y = pk2(acc[2].x, acc[3].x); o0.z = pk2(acc[4].x, acc[5].x); o0.w = pk2(acc[6].x, acc[7].x);
        o1.x = pk2(acc[0].y, acc[1].y); o1.y = pk2(acc[2].y, acc[3].y); o1.z = pk2(acc[4].y, acc[5].y); o1.w = pk2(acc[6].y, acc[7].y);
        *(GAS v4u*)(Bt3 + (size_t)d0 * 2048 + 1024 + 128 * g + c0) = o0; *(GAS v4u*)(Bt3 + (size_t)(d0 + 1) * 2048 + 1024 + 128 * g + c0) = o1;
        LDS_WAIT(); asm volatile("" ::: "memory");
    }
}

__device__ __forceinline__ const float* xrow_in(Frame& F, int m) { return m < MP ? F.in[I_XP] + (size_t)m * DM : F.in[I_XS] + (size_t)(m - MP) * DM; }
__device__ __forceinline__ void x_to_bf16(Frame& F, bf16* XB) {
    const int gw = F.bid * NWAVES + F.wave, NGW = F.G * NWAVES;
    for (int m = gw; m < M; m += NGW) { const GAS f32x4* xr = (const GAS f32x4*)xrow_in(F, m) + F.lane; GAS v2u* o = (GAS v2u*)(XB + (size_t)m * DM) + F.lane;
#pragma unroll
        for (int j = 0; j < 4; ++j) { const f32x4 v = xr[64 * j]; o[64 * j] = (v2u){pk2(v.x, v.y), pk2(v.z, v.w)}; } }
}
__device__ __forceinline__ void ln_rows(Frame& F, const float* V, float* O, const float* g, const float* b, bf16* XB, const float* sbase, const float* slab, int nslab) {
    const int gw = F.bid * NWAVES + F.wave, NGW = F.G * NWAVES;
    f32x4 gv[4], bv[4];
#pragma unroll
    for (int j = 0; j < 4; ++j) { gv[j] = ((const GAS f32x4*)g)[F.lane + 64 * j]; bv[j] = ((const GAS f32x4*)b)[F.lane + 64 * j]; }
    for (int m = gw; m < M; m += NGW) {
        const GAS f32x4* xr = (const GAS f32x4*)(V + (size_t)m * DM) + F.lane; GAS f32x4* orow = (GAS f32x4*)(O + (size_t)m * DM) + F.lane;
        f32x4 v[4]; float s = 0.f;
#pragma unroll
        for (int j = 0; j < 4; ++j) v[j] = xr[64 * j];
        if (m >= MP) { const GAS f32x4* br = (const GAS f32x4*)(sbase + (size_t)(m - MP) * DM) + F.lane;
#pragma unroll
            for (int j = 0; j < 4; ++j) v[j] = br[64 * j] * ALPHA;
            for (int sl = 0; sl < nslab; ++sl) { const GAS f32x4* sr = (const GAS f32x4*)(slab + ((size_t)sl * 512 + (m - MP)) * DM) + F.lane;
#pragma unroll
                for (int j = 0; j < 4; ++j) v[j] += sr[64 * j]; } }
#pragma unroll
        for (int j = 0; j < 4; ++j) s += (v[j].x + v[j].y) + (v[j].z + v[j].w);
        const float mean = wave_sum(s, F.lane) * (1.f / DM); float s2 = 0.f;
#pragma unroll
        for (int j = 0; j < 4; ++j) { v[j] = v[j] - mean; s2 += (v[j].x * v[j].x + v[j].y * v[j].y) + (v[j].z * v[j].z + v[j].w * v[j].w); }
        const float rstd = __builtin_amdgcn_rsqf(wave_sum(s2, F.lane) * (1.f / DM) + LN_EPS);
#pragma unroll
        for (int j = 0; j < 4; ++j) { v[j] = v[j] * rstd * gv[j] + bv[j]; orow[64 * j] = v[j]; }
        if (XB) { GAS v2u* o = (GAS v2u*)(XB + (size_t)m * DM) + F.lane;
#pragma unroll
            for (int j = 0; j < 4; ++j) o[64 * j] = (v2u){pk2(v[j].x, v[j].y), pk2(v[j].z, v[j].w)}; }
    }
}

__device__ __forceinline__ float softplusf_acc(float x) { return fmaxf(x, 0.f) + log1pf(__expf(-fabsf(x))); }
__device__ __forceinline__ float expm1_neg(float x) {
    const float p = x * (1.f + x * (0.5f + x * (1.f / 6.f + x * (1.f / 24.f + x * (1.f / 120.f + x * (1.f / 720.f + x * (1.f / 5040.f)))))));
    return x > -0.25f ? p : __expf(x) - 1.f;
}
constexpr int PATCH_STRIDE = 144;

struct ALane {
    const LAS float* tab;
    float cwD[4], cbD, ba, bx, ck;
    bf16x8 Ba0, Ba1, Bx0, Bx1;
};
constexpr int PATCH_BYTES = 5120, ASLOT_OFF = 8 * PATCH_BYTES, ATAB_OFF = ASLOT_OFF + 2048, ATAB_BYTES = 1280;
__device__ __forceinline__ void a_setup(Frame& F, int layer, int n, int q, ALane& L) {
    const int c = F.lane & 15, kg = F.lane >> 4, och = 64 * n + 16 * q + c;
    const float* cw = F.in[I_RGCW] + (size_t)layer * 4 * 512; const float* cb = F.in[I_RGCB] + layer * 512;
    LAS float* tab = (LAS float*)(F.lds + RING_OFF + ATAB_OFF + F.wave * ATAB_BYTES);
#pragma unroll
    for (int k = 0; k < 5; ++k) { const int idx = F.lane + 64 * k, tg = idx / 80, rem = idx - 80 * tg, j = rem >> 4, e = rem & 15, ch = 64 * n + (e < 8 ? 8 * tg + e : 32 + 8 * tg + (e - 8));
        tab[idx] = j < 4 ? cw[j * 512 + ch] : cb[ch]; }
    L.tab = tab + 80 * kg;
#pragma unroll
    for (int j = 0; j < 4; ++j) L.cwD[j] = cw[j * 512 + och];
    L.cbD = cb[och]; L.ba = F.in[I_RGBA][layer * 512 + och]; L.bx = F.in[I_RGBX][layer * 512 + och];
    L.ck = 8.0f * softplusf_acc(-F.in[I_LAM][layer * 512 + och]);
    const float* wa = F.in[I_RGWA] + ((size_t)layer * 8 + n) * 4096 + 16 * q + c; const float* wx = F.in[I_RGWX] + ((size_t)layer * 8 + n) * 4096 + 16 * q + c;
    unsigned a0[4], a1[4], x0[4], x1[4];
#pragma unroll
    for (int w = 0; w < 4; ++w) {
        a0[w] = pk2(wa[(8 * kg + 2 * w) * 64], wa[(8 * kg + 2 * w + 1) * 64]); a1[w] = pk2(wa[(32 + 8 * kg + 2 * w) * 64], wa[(32 + 8 * kg + 2 * w + 1) * 64]);
        x0[w] = pk2(wx[(8 * kg + 2 * w) * 64], wx[(8 * kg + 2 * w + 1) * 64]); x1[w] = pk2(wx[(32 + 8 * kg + 2 * w) * 64], wx[(32 + 8 * kg + 2 * w + 1) * 64]); }
    L.Ba0 = __builtin_bit_cast(bf16x8, (v4u){a0[0], a0[1], a0[2], a0[3]}); L.Ba1 = __builtin_bit_cast(bf16x8, (v4u){a1[0], a1[1], a1[2], a1[3]});
    L.Bx0 = __builtin_bit_cast(bf16x8, (v4u){x0[0], x0[1], x0[2], x0[3]}); L.Bx1 = __builtin_bit_cast(bf16x8, (v4u){x1[0], x1[1], x1[2], x1[3]});
    LDS_WAIT(); asm volatile("" ::: "memory");
}
__device__ __forceinline__ void a_block(const ALane& L, const LAS unsigned char* patch, int rowA0, int baseD, int q, int lane, float (&a)[4], float (&bb)[4]) {
    const int c = lane & 15, kg = lane >> 4;
    float x[16];
    { const f32x4 b0 = *(const LAS f32x4*)(L.tab + 64), b1 = *(const LAS f32x4*)(L.tab + 68), b2 = *(const LAS f32x4*)(L.tab + 72), b3 = *(const LAS f32x4*)(L.tab + 76);
#pragma unroll
      for (int e = 0; e < 4; ++e) { x[e] = b0[e]; x[4 + e] = b1[e]; x[8 + e] = b2[e]; x[12 + e] = b3[e]; } }
#pragma unroll
    for (int j = 0; j < 4; ++j) { const LAS unsigned char* rp = patch + (rowA0 + j) * PATCH_STRIDE + 16 * kg;
        const v4u v0 = *(const LAS v4u*)rp, v1 = *(const LAS v4u*)(rp + 64);
        const f32x4 t0 = *(const LAS f32x4*)(L.tab + 16 * j), t1 = *(const LAS f32x4*)(L.tab + 16 * j + 4), t2 = *(const LAS f32x4*)(L.tab + 16 * j + 8), t3 = *(const LAS f32x4*)(L.tab + 16 * j + 12);
#pragma unroll
        for (int w = 0; w < 2; ++w) { x[2 * w] = fmaf(t0[2 * w], bflo(v0[w]), x[2 * w]); x[2 * w + 1] = fmaf(t0[2 * w + 1], bfhi(v0[w]), x[2 * w + 1]);
                                      x[4 + 2 * w] = fmaf(t1[2 * w], bflo(v0[2 + w]), x[4 + 2 * w]); x[5 + 2 * w] = fmaf(t1[2 * w + 1], bfhi(v0[2 + w]), x[5 + 2 * w]);
                                      x[8 + 2 * w] = fmaf(t2[2 * w], bflo(v1[w]), x[8 + 2 * w]); x[9 + 2 * w] = fmaf(t2[2 * w + 1], bfhi(v1[w]), x[9 + 2 * w]);
                                      x[12 + 2 * w] = fmaf(t3[2 * w], bflo(v1[2 + w]), x[12 + 2 * w]); x[13 + 2 * w] = fmaf(t3[2 * w + 1], bfhi(v1[2 + w]), x[13 + 2 * w]); } }
    const bf16x8 A0 = __builtin_bit_cast(bf16x8, (v4u){pk2(x[0], x[1]), pk2(x[2], x[3]), pk2(x[4], x[5]), pk2(x[6], x[7])});
    const bf16x8 A1 = __builtin_bit_cast(bf16x8, (v4u){pk2(x[8], x[9]), pk2(x[10], x[11]), pk2(x[12], x[13]), pk2(x[14], x[15])});
    f32x4 accR = (f32x4){0.f, 0.f, 0.f, 0.f}, accI = (f32x4){0.f, 0.f, 0.f, 0.f};
    accR = __builtin_amdgcn_mfma_f32_16x16x32_bf16(A0, L.Ba0, accR, 0, 0, 0); accR = __builtin_amdgcn_mfma_f32_16x16x32_bf16(A1, L.Ba1, accR, 0, 0, 0);
    accI = __builtin_amdgcn_mfma_f32_16x16x32_bf16(A0, L.Bx0, accI, 0, 0, 0); accI = __builtin_amdgcn_mfma_f32_16x16x32_bf16(A1, L.Bx1, accI, 0, 0, 0);
    float pv[7];
#pragma unroll
    for (int k = 0; k < 7; ++k) pv[k] = bf1(*(const LAS unsigned short*)(patch + (baseD + k) * PATCH_STRIDE + 2 * (16 * q + c)));
#pragma unroll
    for (int r = 0; r < 4; ++r) {
        const float xd = L.cbD + L.cwD[0] * pv[r] + L.cwD[1] * pv[r + 1] + L.cwD[2] * pv[r + 2] + L.cwD[3] * pv[r + 3];
        const float rr = pg8::sigmoidf_fast(accR[r] + L.ba), ii = pg8::sigmoidf_fast(accI[r] + L.bx);
        const float la = -L.ck * rr;
        const float av = __builtin_amdgcn_exp2f(1.44269504089f * la);
        a[r] = av; bb[r] = __builtin_amdgcn_sqrtf(fmaxf(1.f - av * av, 0.f)) * (ii * xd);
    }
}
struct BlkScan { float Ac[4], Bc[4], EA, EB, WA, WB; };
__device__ __forceinline__ void blk_scan(const float (&a)[4], const float (&bb)[4], int lane, BlkScan& S) {
    const int c = lane & 15, g = lane >> 4;
    S.Ac[0] = a[0]; S.Bc[0] = bb[0];
#pragma unroll
    for (int r = 1; r < 4; ++r) { S.Ac[r] = a[r] * S.Ac[r - 1]; S.Bc[r] = a[r] * S.Bc[r - 1] + bb[r]; }
    float IA = S.Ac[3], IB = S.Bc[3];
    { const float pa = shfl_idx(IA, lane - 16), pb = shfl_idx(IB, lane - 16); if (g >= 1) { IB = IA * pb + IB; IA = IA * pa; } }
    { const float pa = shfl_idx(IA, lane - 32), pb = shfl_idx(IB, lane - 32); if (g >= 2) { IB = IA * pb + IB; IA = IA * pa; } }
    S.EA = shfl_idx(IA, lane - 16); S.EB = shfl_idx(IB, lane - 16); if (g == 0) { S.EA = 1.f; S.EB = 0.f; }
    S.WA = shfl_idx(IA, 48 + c); S.WB = shfl_idx(IB, 48 + c);
}
__device__ __forceinline__ void a_prompt_item(Frame& F, int layer, int item, const bf16* Z, bf16* Y) {
    const int b = item >> 5, n = (item >> 2) & 7, q = item & 3, lane = opqv(F.lane), w = F.wave, c = lane & 15, g = lane >> 4, och = 64 * n + 16 * q + c;
    ALane L; a_setup(F, layer, n, q, L);
    LAS unsigned char* patch = F.lds + RING_OFF + w * PATCH_BYTES;
    LAS f32x2* slots = (LAS f32x2*)(F.lds + RING_OFF + ASLOT_OFF);
    const bf16* Zb = Z + (size_t)b * SEQ * ZC;
    float hrun = 0.f;
    v4u pf[5];
    auto load_patch = [&](int tb) {
#pragma unroll
        for (int k = 0; k < 5; ++k) { const int ci = lane + 64 * k, pr = ci >> 3, cc = ci & 7, t = tb - 3 + pr;
            pf[k] = (ci < 280 && t >= 0) ? *(const GAS v4u*)(Zb + (size_t)t * ZC + 64 * n + 8 * cc) : (v4u){0u, 0u, 0u, 0u}; }
    };
    load_patch(32 * w);
    for (int it = 0; it < 8; ++it) {
        const int tb = 256 * it + 32 * w;
#pragma unroll
        for (int k = 0; k < 5; ++k) { const int ci = lane + 64 * k, pr = ci >> 3, cc = ci & 7; if (ci < 280) *(LAS v4u*)(patch + pr * PATCH_STRIDE + 16 * cc) = pf[k]; }
        if (it < 7) load_patch(tb + 256);
        unsigned short gav[8];
#pragma unroll
        for (int r = 0; r < 8; ++r) gav[r] = *(const GAS unsigned short*)(Zb + (size_t)(tb + 16 * (r >> 2) + 4 * g + (r & 3)) * ZC + 512 + och);
        asm volatile("" ::: "memory");
        float a0[4], b0[4], a1[4], b1[4];
        a_block(L, patch, lane & 15, 4 * g, q, lane, a0, b0);
        a_block(L, patch, 16 + (lane & 15), 16 + 4 * g, q, lane, a1, b1);
        BlkScan S0, S1; blk_scan(a0, b0, lane, S0); blk_scan(a1, b1, lane, S1);
        if (lane < 16) slots[((it & 1) * 8 + w) * 16 + c] = (f32x2){S0.WA * S1.WA, S1.WA * S0.WB + S1.WB};
        __syncthreads();
        float hin = hrun, hw = 0.f;
#pragma unroll
        for (int ww = 0; ww < 8; ++ww) { const f32x2 s = slots[((it & 1) * 8 + ww) * 16 + c]; if (ww == w) hw = hin; hin = s.x * hin + s.y; }
        hrun = hin;
        const float hg0 = S0.EA * hw + S0.EB, hw1 = S0.WA * hw + S0.WB, hg1 = S1.EA * hw1 + S1.EB;
#pragma unroll
        for (int r = 0; r < 4; ++r) { const float h = S0.Ac[r] * hg0 + S0.Bc[r];
            *(GAS unsigned short*)(Y + (size_t)(b * SEQ + tb + 4 * g + r) * YC + och) = f2bf(h * bf1(gav[r])); }
#pragma unroll
        for (int r = 0; r < 4; ++r) { const float h = S1.Ac[r] * hg1 + S1.Bc[r];
            *(GAS unsigned short*)(Y + (size_t)(b * SEQ + tb + 16 + 4 * g + r) * YC + och) = f2bf(h * bf1(gav[4 + r]));
            if (r == 3 && it == 7 && w == 7 && g == 3) F.out[O_PH + (size_t)(layer * 8 + b) * 512 + och] = h; }
    }
}
__device__ __forceinline__ void a_sample_task(Frame& F, int layer, int task, const bf16* Z, bf16* Y) {
    const int blk = task >> 5, n = (task >> 2) & 7, q = task & 3, lane = opqv(F.lane), c = lane & 15, g = lane >> 4, och = 64 * n + 16 * q + c, s0 = 4 * blk;
    ALane L; a_setup(F, layer, n, q, L);
    LAS unsigned char* patch = F.lds + RING_OFF + F.wave * PATCH_BYTES;
#pragma unroll
    for (int k = 0; k < 4; ++k) { const int ci = lane + 64 * k; if (ci < 224) { const int pr = ci >> 3, cc = ci & 7, sq = pr / 7, tau = pr - 7 * sq - 3, seq = s0 + sq; v4u v;
            if (tau < 0) { const GAS f32x4* sp = (const GAS f32x4*)(F.in[I_SRGC] + ((size_t)(layer * 128 + seq) * 3 + (tau + 3)) * 512 + 64 * n + 8 * cc); const f32x4 f0 = sp[0], f1 = sp[1];
                v = (v4u){pk2(f0.x, f0.y), pk2(f0.z, f0.w), pk2(f1.x, f1.y), pk2(f1.z, f1.w)}; }
            else v = *(const GAS v4u*)(Z + (size_t)(MP + 4 * seq + tau) * ZC + 64 * n + 8 * cc);
            *(LAS v4u*)(patch + pr * PATCH_STRIDE + 16 * cc) = v; } }
    asm volatile("" ::: "memory");
    float a[4], bb[4];
    a_block(L, patch, 7 * ((lane & 15) >> 2) + (lane & 3), 7 * g, q, lane, a, bb);
    const int seq = s0 + g;
    float h = F.in[I_SH][(size_t)(layer * 128 + seq) * 512 + och];
#pragma unroll
    for (int r = 0; r < 4; ++r) { h = a[r] * h + bb[r]; const size_t row = (size_t)(MP + 4 * seq + r);
        *(GAS unsigned short*)(Y + row * YC + och) = f2bf(h * bf1(*(const GAS unsigned short*)(Z + row * ZC + 512 + och))); }
    F.out[O_SH + (size_t)(layer * 128 + seq) * 512 + och] = h;
}

__device__ __forceinline__ void ln_silu_row(const LAS float* xr, const float* g, const float* b, bf16* dst, int lane) {
    const f32x4 v0 = *(const LAS f32x4*)(xr + 4 * lane), v1 = *(const LAS f32x4*)(xr + 256 + 4 * lane);
    const float s = (v0.x + v0.y) + (v0.z + v0.w) + (v1.x + v1.y) + (v1.z + v1.w);
    const float mean = wave_sum(s, lane) * (1.f / 512.f);
    const f32x4 d0 = v0 - mean, d1 = v1 - mean;
    const float s2 = (d0.x * d0.x + d0.y * d0.y) + (d0.z * d0.z + d0.w * d0.w) + (d1.x * d1.x + d1.y * d1.y) + (d1.z * d1.z + d1.w * d1.w);
    const float rstd = __builtin_amdgcn_rsqf(wave_sum(s2, lane) * (1.f / 512.f) + LN_EPS);
    const f32x4 g0 = *(const GAS f32x4*)(g + 4 * lane), g1 = *(const GAS f32x4*)(g + 256 + 4 * lane), b0 = *(const GAS f32x4*)(b + 4 * lane), b1 = *(const GAS f32x4*)(b + 256 + 4 * lane);
    f32x4 y0 = d0 * rstd * g0 + b0, y1 = d1 * rstd * g1 + b1;
#pragma unroll
    for (int i = 0; i < 4; ++i) { y0[i] = y0[i] * pg8::sigmoidf_fast(y0[i]); y1[i] = y1[i] * pg8::sigmoidf_fast(y1[i]); }
    *(GAS v2u*)(dst + 4 * lane) = (v2u){pk2(y0.x, y0.y), pk2(y0.z, y0.w)}; *(GAS v2u*)(dst + 256 + 4 * lane) = (v2u){pk2(y1.x, y1.y), pk2(y1.z, y1.w)};
}
__device__ __forceinline__ void b_prompt_item(Frame& F, int layer, int item, const bf16* Z, bf16* Y) {
    const int tidl = opqv(F.tid), b = item >> 5, t0 = 64 * (item & 31), p = tidl & 255, hh = tidl >> 8, ts = t0 + 32 * hh;
    const GAS unsigned* Zu = (const GAS unsigned*)(Z + (size_t)b * SEQ * ZC) + 512 + p;
    unsigned raw[62];
#pragma unroll
    for (int i = 0; i < 62; ++i) { const int t = ts - 30 + i; raw[i] = t >= 0 ? Zu[(size_t)t * (ZC / 2)] : 0u; }
    const float* cw = F.in[I_CFW] + (size_t)layer * 31 * 512 + 2 * p;
    f32x2 wj[31];
#pragma unroll
    for (int j = 0; j < 31; ++j) wj[j] = *(const GAS f32x2*)(cw + j * 512);
    const f32x2 bias = *(const GAS f32x2*)(F.in[I_CFB] + layer * 512 + 2 * p);
    f32x2 in[62];
#pragma unroll
    for (int i = 0; i < 62; ++i) in[i] = (f32x2){bflo(raw[i]), bfhi(raw[i])};
    LAS float* obuf = (LAS float*)(F.lds + RING_OFF);
#pragma unroll
    for (int i = 0; i < 32; ++i) { f32x2 o = bias;
#pragma unroll
        for (int j = 0; j < 31; ++j) o += wj[j] * in[i + j];
        *(LAS f32x2*)(obuf + (32 * hh + i) * 512 + 2 * p) = o; }
    __syncthreads();
    const float* lg = F.in[I_CFG] + layer * 512; const float* lb = F.in[I_CFBB] + layer * 512;
#pragma unroll 1
    for (int r = F.wave; r < 64; r += 8) ln_silu_row(obuf + r * 512, lg, lb, Y + (size_t)(b * SEQ + t0 + r) * YC + 512, F.lane);
}
__device__ __forceinline__ void cd_prompt_item(Frame& F, int layer, int item, const bf16* Z, bf16* Y) {
    const int tidl = opqv(F.tid), b = item >> 5, t0 = 64 * (item & 31), p = tidl & 255, hh = tidl >> 8;
    const bf16* Zb = Z + (size_t)b * SEQ * ZC;
    LAS unsigned* cbuf = (LAS unsigned*)(F.lds + RING_OFF);
    for (int ci = tidl; ci < 79 * 64; ci += 512) { const int pr = ci >> 6, cc = ci & 63, t = t0 - 15 + pr;
        const v4u v = t >= 0 ? *(const GAS v4u*)(Zb + (size_t)t * ZC + 1536 + 8 * cc) : (v4u){0u, 0u, 0u, 0u};
        *(LAS v4u*)(cbuf + pr * 256 + 4 * cc) = v; }
    const int ts = t0 + 32 * hh;
    unsigned uu[34], dd[32];
#pragma unroll
    for (int i = 0; i < 34; ++i) { const int t = ts - 2 + i; uu[i] = t >= 0 ? ((const GAS unsigned*)(Zb + (size_t)t * ZC))[1280 + p] : 0u; }
#pragma unroll
    for (int i = 0; i < 32; ++i) dd[i] = ((const GAS unsigned*)(Zb + (size_t)(ts + i) * ZC))[1024 + p];
    const f32x2 w0 = ((const GAS f32x2*)(F.in[I_SCW] + (size_t)(layer * 3 + 0) * 512))[p], w1 = ((const GAS f32x2*)(F.in[I_SCW] + (size_t)(layer * 3 + 1) * 512))[p],
                w2 = ((const GAS f32x2*)(F.in[I_SCW] + (size_t)(layer * 3 + 2) * 512))[p];
    __syncthreads();
    const int w = 2 << (p >> 6), rr0 = 15 + 32 * hh;
    f32x2 s = (f32x2){0.f, 0.f};
    for (int j = 0; j < w; ++j) { const unsigned v = cbuf[(rr0 - j) * 256 + p]; s += (f32x2){bflo(v), bfhi(v)}; }
    GAS unsigned* Yu = (GAS unsigned*)(Y + (size_t)(b * SEQ + ts) * YC) + p;
#pragma unroll
    for (int i = 0; i < 32; ++i) { const int t = ts + i, rr = rr0 + i;
        const unsigned cur = cbuf[rr * 256 + p]; const f32x2 cf = (f32x2){bflo(cur), bfhi(cur)};
        if (i > 0) { const unsigned old = cbuf[(rr - w) * 256 + p]; s += cf - (f32x2){bflo(old), bfhi(old)}; }
        const float ic = __builtin_amdgcn_rcpf((float)(t + 1 < w ? t + 1 : w));
        const f32x2 mm = s * ic - cf;
        Yu[(size_t)i * 1024 + 512] = pk2(mm.x, mm.y);
        const f32x2 cv = w0 * (f32x2){bflo(uu[i]), bfhi(uu[i])} + w1 * (f32x2){bflo(uu[i + 1]), bfhi(uu[i + 1])} + w2 * (f32x2){bflo(uu[i + 2]), bfhi(uu[i + 2])};
        const f32x2 yd = (f32x2){bflo(dd[i]), bfhi(dd[i])} * cv;
        Yu[(size_t)i * 1024 + 768] = pk2(yd.x, yd.y); }
}
__device__ __forceinline__ void s_sample_item(Frame& F, int layer, int s, const bf16* Z, bf16* Y) {
    const int ch = opqv(F.tid); const size_t ls = (size_t)layer * 128 + s;
    const bf16* Zr = Z + (size_t)(MP + 4 * s) * ZC; bf16* Yr = Y + (size_t)(MP + 4 * s) * YC;
    LAS float* obuf = (LAS float*)(F.lds + RING_OFF);
    float in[34], wv[31], pb[19], u[6], dbv[4];
#pragma unroll
    for (int j = 0; j < 30; ++j) in[j] = (F.in[I_SCF] + (ls * 30 + j) * 512)[ch];
#pragma unroll
    for (int j = 0; j < 15; ++j) pb[j] = (F.in[I_SPOOL] + (ls * 15 + j) * 512)[ch];
    u[0] = (F.in[I_SSC] + (ls * 2 + 0) * 512)[ch]; u[1] = (F.in[I_SSC] + (ls * 2 + 1) * 512)[ch];
#pragma unroll
    for (int r = 0; r < 4; ++r) { in[30 + r] = bf1((Zr + (size_t)r * ZC + 1024)[ch]); pb[15 + r] = bf1((Zr + (size_t)r * ZC + 1536)[ch]); u[2 + r] = bf1((Zr + (size_t)r * ZC + 2560)[ch]); dbv[r] = bf1((Zr + (size_t)r * ZC + 2048)[ch]); }
#pragma unroll
    for (int j = 0; j < 31; ++j) wv[j] = (F.in[I_CFW] + ((size_t)layer * 31 + j) * 512)[ch];
    const float bias = (F.in[I_CFB] + layer * 512)[ch];
    const float w0 = (F.in[I_SCW] + (size_t)(layer * 3 + 0) * 512)[ch], w1 = (F.in[I_SCW] + (size_t)(layer * 3 + 1) * 512)[ch], w2 = (F.in[I_SCW] + (size_t)(layer * 3 + 2) * 512)[ch];
    asm volatile("" ::: "memory");
#pragma unroll
    for (int j = 0; j < 26; ++j) (F.out + O_SCF + (ls * 30 + j) * 512)[ch] = in[j + 4];
#pragma unroll
    for (int r = 0; r < 4; ++r) { float o = bias;
#pragma unroll
        for (int j = 0; j < 31; ++j) o += wv[j] * in[r + j];
        obuf[r * 512 + ch] = o; }
#pragma unroll
    for (int j = 0; j < 11; ++j) (F.out + O_SPOOL + (ls * 15 + j) * 512)[ch] = pb[j + 4];
    const int gsel = ch >> 7;
#pragma unroll
    for (int r = 0; r < 4; ++r) { const int k = 15 + r;
        const float s2 = pb[k] + pb[k - 1], s4 = s2 + pb[k - 2] + pb[k - 3], s8 = s4 + (pb[k - 4] + pb[k - 5]) + (pb[k - 6] + pb[k - 7]);
        float s16 = s8;
#pragma unroll
        for (int j = 8; j < 16; ++j) s16 += pb[k - j];
        const float mv = (gsel == 0 ? s2 * 0.5f : gsel == 1 ? s4 * 0.25f : gsel == 2 ? s8 * 0.125f : s16 * 0.0625f) - pb[k];
        (Yr + (size_t)r * YC + 1024)[ch] = f2bf(mv); }
#pragma unroll
    for (int r = 0; r < 4; ++r) (Yr + (size_t)r * YC + 1536)[ch] = f2bf(dbv[r] * (w0 * u[r] + w1 * u[r + 1] + w2 * u[r + 2]));
    __syncthreads();
    if (F.wave < 4) ln_silu_row(obuf + F.wave * 512, F.in[I_CFG] + layer * 512, F.in[I_CFBB] + layer * 512, Yr + (size_t)F.wave * YC + 512, F.lane);
}

struct Args { const float* in[31]; float* out; unsigned char* ws; int ph_lo, ph_hi; };
__global__ void __launch_bounds__(NWAVES * 64, 2) hybrid_fwd(Args args) {
    extern __shared__ __attribute__((aligned(16))) unsigned char lds[];
    Frame F;
    F.lds = (LAS unsigned char*)lds;
    F.MISC = (volatile LAS unsigned*)(F.lds + MISC_OFF);
    const int wave0 = __builtin_amdgcn_readfirstlane((int)threadIdx.x >> 6);
    F.lane = lane_now(); F.wave = wave0; F.tid = F.wave * 64 + F.lane;
    F.G = gridDim.x; F.bid = blockIdx.x;
    F.ws = args.ws; F.out = args.out; F.ctl = (gu32*)(args.ws + WS_CTL);
    F.in = args.in;
    for (int u = F.tid; u < (LDS_BYTES - LDSCTL_OFF) / 4; u += NWAVES * 64) ((LAS unsigned*)(F.lds + LDSCTL_OFF))[u] = 0u;
    __syncthreads();
    XcdBarrier bar; bar.bar = (unsigned*)(F.ctl + CW_BAR); bar.x = 0; bar.st = nullptr;
    if (!MK_SPLIT) bar = xcd_barrier_post((unsigned*)(F.ctl + CW_BAR), F.MISC + 8);
    const int lo = args.ph_lo, hi = args.ph_hi;
#define IN(k) (lo <= (k) && (k) < hi)
#define REFRESH() do { F.lane = lane_now(); F.wave = opqs(wave0); F.tid = F.wave * 64 + F.lane; F.bid = opqs((int)blockIdx.x); } while (0)
#define SEAM(k) do { if (IN(k) && IN((k) + 1)) xcd_barrier(bar); } while (0)
    bf16* WA = (bf16*)(F.ws + WS_WA); bf16* XB = (bf16*)(F.ws + WS_XB); bf16* Y = (bf16*)(F.ws + WS_Y); bf16* Zm = (bf16*)(F.ws + WS_ZG); _Float16* Gb = (_Float16*)(F.ws + WS_ZG);
    bf16* Hb = (bf16*)(F.ws + WS_ZG); bf16* Bt3 = (bf16*)(F.ws + WS_BT3); bf16* Bt4 = (bf16*)(F.ws + WS_BT4); bf16* Bt5 = (bf16*)(F.ws + WS_BT5); bf16* Bt6 = (bf16*)(F.ws + WS_BT6);

    if (IN(0)) { REFRESH(); convert_matrix<RM_WIN>(F, F.in[I_WIN], DM, INC, WA, DM, 0, 0, F.bid * NWAVES + F.wave, F.G * NWAVES); REFRESH(); x_to_bf16(F, XB); }
    SEAM(0);

    for (int l = 0; l < 2; ++l) {
        const int pb = 1 + 9 * l;
        if (IN(pb + 0)) for (int rep = 0; rep < NREP(0); ++rep) { if (rep) xcd_barrier(bar); pg8::Gemm g{XB, WA, DM, DM}; pg8::UnitOrder S; S.init(pg8::SK_PLAIN, 4096, DM, F.G, F.bid, 0); pg8::EpiMix E{Zm, F.out, l};
            pg8::gemm_phase<pg8::EpiMix, pg8::UnitOrder, true>(F.lds + RING_OFF, g, S, E, wave0);
            if (F.G == 256 && F.bid >= 32) {
                REFRESH(); const int gw = (F.bid - 32) * NWAVES + F.wave, NGW = 224 * NWAVES; const float* wbr = F.in[I_WBR] + (size_t)l * 4 * 512 * 1024;
                convert_matrix<RM_ID>(F, wbr, 512, 1024, Bt3, 2048, 0, 0, gw, NGW, 0);
                convert_matrix<RM_ID>(F, wbr + (size_t)512 * 1024, 512, 1024, Bt3, 2048, 512, 0, gw, NGW, 256);
                convert_matrix<RM_ID>(F, wbr + (size_t)3 * 512 * 1024, 512, 1024, Bt3, 2048, 1536, 0, gw, NGW, 512);
                convert_matrix<RM_ID>(F, F.in[I_WOUT] + (size_t)l * DM * DM, DM, DM, Bt4, DM, 0, 0, gw, NGW, 768);
                REFRESH(); compose_pool(F, l, Bt3, gw, NGW, 1280); } }
        SEAM(pb + 0);
        if (IN(pb + 1)) for (int rep = 0; rep < NREP(1); ++rep) { if (rep) xcd_barrier(bar);
            __syncthreads(); REFRESH();
            for (int r2 = 0; r2 < NREP2(0); ++r2) for (int it = F.bid; it < 256; it += F.G) { a_prompt_item(F, l, it, Zm, Y); __syncthreads(); }
            REFRESH();
            for (int r2 = 0; r2 < NREP2(1); ++r2) for (int it = (F.bid + 128) % F.G; it < 128; it += F.G) a_sample_task(F, l, 8 * it + F.wave, Zm, Y);
            __syncthreads(); REFRESH();
            for (int r2 = 0; r2 < NREP2(2); ++r2) for (int it = F.bid; it < 256; it += F.G) { b_prompt_item(F, l, it, Zm, Y); __syncthreads(); }
            REFRESH();
            for (int r2 = 0; r2 < NREP2(3); ++r2) for (int it = F.bid; it < 256; it += F.G) { cd_prompt_item(F, l, it, Zm, Y); __syncthreads(); }
            REFRESH();
            for (int r2 = 0; r2 < NREP2(4); ++r2) for (int it = F.bid; it < 128; it += F.G) { s_sample_item(F, l, it, Zm, Y); __syncthreads(); }
            if (F.G == 256 && F.bid >= 128 && F.bid < 160) {
                pg8::Gemm g{XB, WA + (size_t)4096 * DM, DM, DM}; pg8::UnitOrder S; S.init(pg8::SK_PLAIN, 4096, DM, 32, F.bid - 128, 0, false, true); pg8::EpiGate E{Gb};
                pg8::gemm_phase<pg8::EpiGate, pg8::UnitOrder, true>(F.lds + RING_OFF, g, S, E, wave0); }
            REFRESH();
            const float* wbr = F.in[I_WBR] + (size_t)l * 4 * 512 * 1024;
            if (F.G != 256) { const int gw = F.bid * NWAVES + F.wave, NGW = F.G * NWAVES;
                convert_matrix<RM_ID>(F, wbr, 512, 1024, Bt3, 2048, 0, 0, gw, NGW); convert_matrix<RM_ID>(F, wbr + (size_t)512 * 1024, 512, 1024, Bt3, 2048, 512, 0, gw, NGW);
                convert_matrix<RM_ID>(F, wbr + (size_t)3 * 512 * 1024, 512, 1024, Bt3, 2048, 1536, 0, gw, NGW); convert_matrix<RM_ID>(F, F.in[I_WOUT] + (size_t)l * DM * DM, DM, DM, Bt4, DM, 0, 0, gw, NGW);
                REFRESH(); compose_pool(F, l, Bt3, gw, NGW); }
        }
        SEAM(pb + 1);
        if (IN(pb + 2)) for (int rep = 0; rep < NREP(2); ++rep) { if (rep) xcd_barrier(bar); pg8::Gemm g{XB, WA + (size_t)4096 * DM, DM, DM}; pg8::UnitOrder S; S.init(pg8::SK_PLAIN, 4096, DM, F.G, F.bid, 0, true, F.G != 256); pg8::EpiGate E{Gb};
            pg8::gemm_phase<pg8::EpiGate, pg8::UnitOrder, true>(F.lds + RING_OFF, g, S, E, wave0); }
        SEAM(pb + 2);
        if (IN(pb + 3)) for (int rep = 0; rep < NREP(3); ++rep) { if (rep) xcd_barrier(bar); pg8::Gemm g{Y, Bt3, 2048, 2048}; pg8::UnitOrder S; S.init(pg8::SK_P3, DM, 2048, F.G, F.bid, 0); pg8::EpiMerge E{Gb, XB, (bf16*)(F.ws + WS_MB4S)};
            pg8::gemm_phase<pg8::EpiMerge, pg8::UnitOrder, true>(F.lds + RING_OFF, g, S, E, wave0); }
        SEAM(pb + 3);
        if (IN(pb + 4)) for (int rep = 0; rep < NREP(4); ++rep) { if (rep) xcd_barrier(bar); pg8::Gemm g{XB, Bt4, DM, DM}; pg8::UnitOrder S; S.init(pg8::SK_P4, DM, DM, F.G, F.bid, (long)(WS_MB4S - WS_XB));
            pg8::EpiRes E{l == 0 ? F.in[I_XP] : F.out, l == 0 ? F.in[I_XS] : F.out + (size_t)MP * DM, rep + 1 < NREP(4) ? (float*)(F.ws + WS_ZG) : F.out, (float*)(F.ws + WS_SLAB)};
            pg8::gemm_phase<pg8::EpiRes, pg8::UnitOrder, true>(F.lds + RING_OFF, g, S, E, wave0);
            if (F.G == 256 && F.bid >= 64 && rep + 1 == NREP(4)) {
                REFRESH(); const int gw = (F.bid - 64) * NWAVES + F.wave, NGW = 192 * NWAVES;
                convert_matrix<RM_GU>(F, F.in[I_WG] + (size_t)l * DM * FF, DM, FF, Bt5, DM, 0, 0, gw, NGW, 0);
                convert_matrix<RM_GU>(F, F.in[I_WU] + (size_t)l * DM * FF, DM, FF, Bt5, DM, 0, 128, gw, NGW, 1408);
                convert_matrix<RM_ID>(F, F.in[I_WD] + (size_t)l * FF * DM, FF, DM, Bt6, FF, 0, 0, gw, NGW, 2816); } }
        SEAM(pb + 4);
        if (IN(pb + 5)) for (int rep = 0; rep < NREP(5); ++rep) { if (rep) xcd_barrier(bar);
            REFRESH();
            ln_rows(F, F.out, rep + 1 < NREP(5) ? (float*)(F.ws + WS_Y) : F.out, F.in[I_LN1G] + l * DM, F.in[I_LN1B] + l * DM, rep + 1 < NREP(5) ? nullptr : XB, l == 0 ? F.in[I_XS] : F.out + (size_t)MP * DM, (const float*)(F.ws + WS_SLAB), 8);
            REFRESH();
            if (F.G != 256) { const int gw = F.bid * NWAVES + F.wave, NGW = F.G * NWAVES;
                convert_matrix<RM_GU>(F, F.in[I_WG] + (size_t)l * DM * FF, DM, FF, Bt5, DM, 0, 0, gw, NGW); convert_matrix<RM_GU>(F, F.in[I_WU] + (size_t)l * DM * FF, DM, FF, Bt5, DM, 0, 128, gw, NGW);
                convert_matrix<RM_ID>(F, F.in[I_WD] + (size_t)l * FF * DM, FF, DM, Bt6, FF, 0, 0, gw, NGW); }
        }
        SEAM(pb + 5);
        if (IN(pb + 6)) for (int rep = 0; rep < NREP(6); ++rep) { if (rep) xcd_barrier(bar); pg8::Gemm g{XB, Bt5, DM, DM}; pg8::UnitOrder S; S.init(pg8::SK_PLAIN, 2 * FF, DM, F.G, F.bid, 0); pg8::EpiSwi E{Hb};
            pg8::gemm_phase<pg8::EpiSwi, pg8::UnitOrder, true>(F.lds + RING_OFF, g, S, E, wave0);
            if (F.G == 256 && F.bid >= 172 && l == 0 && rep + 1 == NREP(6)) {
                REFRESH(); convert_matrix<RM_WIN>(F, F.in[I_WIN] + (size_t)DM * INC, DM, INC, WA, DM, 0, 0, (F.bid - 172) * NWAVES + F.wave, 84 * NWAVES); } }
        SEAM(pb + 6);
        if (IN(pb + 7)) for (int rep = 0; rep < NREP(7); ++rep) { if (rep) xcd_barrier(bar); pg8::Gemm g{Hb, Bt6, FF, FF}; pg8::UnitOrder S; S.init(pg8::SK_P6, DM, FF, F.G, F.bid, 0); pg8::EpiRes E{F.out, F.out + (size_t)MP * DM, F.out, (float*)(F.ws + WS_SLAB)};
            pg8::gemm_phase<pg8::EpiRes, pg8::UnitOrder, true>(F.lds + RING_OFF, g, S, E, wave0); }
        SEAM(pb + 7);
        if (IN(pb + 8)) for (int rep = 0; rep < NREP(8); ++rep) { if (rep) xcd_barrier(bar);
            REFRESH();
            ln_rows(F, F.out, rep + 1 < NREP(8) ? (float*)(F.ws + WS_Y) : F.out, F.in[I_LN2G] + l * DM, F.in[I_LN2B] + l * DM, (l == 0 && rep + 1 == NREP(8)) ? XB : nullptr, F.out + (size_t)MP * DM, (const float*)(F.ws + WS_SLAB), 11);
            REFRESH();
            if (l == 0 && F.G != 256) convert_matrix<RM_WIN>(F, F.in[I_WIN] + (size_t)DM * INC, DM, INC, WA, DM, 0, 0, F.bid * NWAVES + F.wave, F.G * NWAVES);
        }
        if (l == 0) SEAM(pb + 8);
    }
#undef IN
#undef SEAM
#undef REFRESH
}

extern "C" void kernel_launch(void* const* d_in, const int* in_sizes, int n_in, void* d_out, int out_size, void* d_ws, size_t ws_size, hipStream_t stream) {
    static int grid = 0;
    if (grid == 0) {
        if (n_in != 31 || out_size != (int)O_END || ws_size < WS_END) { fprintf(stderr, "kernel_launch: unexpected sizes n_in %d out %d ws %zu\n", n_in, out_size, ws_size); grid = -1; return; }
        int dev = 0, cus = 0, per_cu = 0;
        if (hipGetDevice(&dev) != hipSuccess || hipDeviceGetAttribute(&cus, hipDeviceAttributeMultiprocessorCount, dev) != hipSuccess) { grid = -1; return; }
        if (hipFuncSetAttribute((const void*)hybrid_fwd, hipFuncAttributeMaxDynamicSharedMemorySize, LDS_BYTES) != hipSuccess) { fprintf(stderr, "kernel_launch: hipFuncSetAttribute failed\n"); grid = -1; return; }
        if (hipOccupancyMaxActiveBlocksPerMultiprocessor(&per_cu, (const void*)hybrid_fwd, NWAVES * 64, LDS_BYTES) != hipSuccess || per_cu < 1)
            fprintf(stderr, "kernel_launch: occupancy query reports %d workgroups per CU\n", per_cu);
        (void)hipGetLastError();
        grid = cus;
    }
    if (grid < 0) return;
    if (hipMemsetAsync((char*)d_ws + WS_CTL, 0, CTL_ZERO_BYTES, stream) != hipSuccess) { fprintf(stderr, "kernel_launch: memset failed\n"); return; }
    Args a{};
    for (int i = 0; i < 31; ++i) a.in[i] = (const float*)d_in[i];
    a.out = (float*)d_out; a.ws = (unsigned char*)d_ws;
#if MK_SPLIT
    for (int ph = 0; ph < NPHASE; ++ph) { a.ph_lo = ph; a.ph_hi = ph + 1; hipLaunchKernelGGL(hybrid_fwd, dim3(grid), dim3(NWAVES * 64), LDS_BYTES, stream, a); }
#else
    a.ph_lo = 0; a.ph_hi = NPHASE;
    hipLaunchKernelGGL(hybrid_fwd, dim3(grid), dim3(NWAVES * 64), LDS_BYTES, stream, a);
#endif
}
```

```cpp
#include <hip/hip_runtime.h>
#include <cstdio>
#include <cstdint>

#ifndef PROBE_REP
#define PROBE_REP 0
#endif
#define NREP(k) (1 + ((PROBE_REP >> (k)) & 1))
#ifndef PROBE2
#define PROBE2 0
#endif
#define NREP2(j) (1 + ((PROBE2 >> (j)) & 1))
#ifndef MK_SPLIT
#define MK_SPLIT 0
#endif

constexpr int DM = 1024, WMIX = 512, NPB = 8, SEQ = 2048, NSB = 128, DSEQ = 4;
constexpr int MP = NPB * SEQ, MS = NSB * DSEQ, M = MP + MS;
constexpr int FF = 2816, INC = 8192, ZC = 3072, YC = 2048, GC = 4096;
constexpr float LN_EPS = 1e-5f, ALPHA = 1.41421356237f;
constexpr size_t O_Y = 0, O_PH = (size_t)M * DM, O_PRGC = O_PH + 8192, O_PCF = O_PRGC + 24576, O_PPOOL = O_PCF + 245760, O_PSC = O_PPOOL + 122880,
                 O_SH = O_PSC + 16384, O_SRGC = O_SH + 131072, O_SCF = O_SRGC + 393216, O_SPOOL = O_SCF + 3932160, O_SSC = O_SPOOL + 1966080, O_END = O_SSC + 262144;
static_assert(O_END == 24403968, "output map");

__device__ __forceinline__ int opqv(int v) { asm volatile("" : "+v"(v)); return v; }
__device__ __forceinline__ int lane_now() { int l; asm volatile("v_mbcnt_lo_u32_b32 %0, -1, 0\n\tv_mbcnt_hi_u32_b32 %0, -1, %0" : "=v"(l)); return l; }
__device__ __forceinline__ int opqs(int v) { asm volatile("" : "+s"(v)); return v; }
namespace pg8 {
#define PG8_LAS __attribute__((address_space(3)))
typedef unsigned short bf16_t;
typedef short bf16x8 __attribute__((ext_vector_type(8)));
typedef float f32x4 __attribute__((ext_vector_type(4)));
typedef float f32x2 __attribute__((ext_vector_type(2)));
typedef unsigned u32x4 __attribute__((ext_vector_type(4)));
typedef unsigned u32x2 __attribute__((ext_vector_type(2)));
typedef _Float16 f16x4 __attribute__((ext_vector_type(4)));
typedef _Float16 f16x8 __attribute__((ext_vector_type(8)));
constexpr int BM = 256, BK = 64, HALF = 128, HTB = HALF * BK * 2, STAGE_BYTES = 8 * HTB, NXCD = 8, WGM = 8;

__host__ __device__ __forceinline__ int lds_byte(int r, int c) { const int st = (r >> 4) * 2 + (c >> 5), rr = r & 15, cc = c & 31, ob = rr * 64 + cc * 2; return st * 1024 + (ob ^ (((ob >> 9) & 1) << 5)); }
__host__ __device__ __forceinline__ void stage_rc(int b, int& R, int& C) { const int st = b / 1024, sb = b % 1024, swz = sb ^ (((sb >> 9) & 1) << 5); R = (st >> 1) * 16 + swz / 64; C = (st & 1) * 32 + (swz % 64) / 2; }
__host__ __device__ __forceinline__ int perm32(int rho) { const int n = rho >> 4, i = rho & 15; return 8 * (i >> 2) + 4 * n + (i & 3); }

struct Unit { int pm, pn, nt, mode, aux; long offA, offB; };
struct Gemm { const bf16_t* A; const bf16_t* Bt; int lda, ldb; };

enum { SK_PLAIN = 0, SK_P3 = 1, SK_P4 = 2, SK_P6 = 3 };
struct UnitOrder {
    int kind, nN, nwgP, nS, ntP, G, c; long offA_s;
    __device__ __forceinline__ void init(int kind_, int N_, int K_, int G_, int c_, long offA_s_, bool prompt = true, bool sample = true) { kind = kind_; nN = N_ / BM; nwgP = prompt ? 64 * nN : 0; ntP = K_ / BK; G = G_; c = c_; offA_s = offA_s_;
        nS = !sample ? 0 : kind_ == SK_PLAIN ? 2 * nN : kind_ == SK_P3 ? 32 : kind_ == SK_P4 ? 64 : 88; }
    __device__ __forceinline__ bool next(int i, Unit& u, const Gemm& g) const {
        const long L = (long)i * G + c; const long ra = (long)BM * g.lda * 2, rb = (long)BM * g.ldb * 2;
        if (L < nwgP) {
            int wgid = (int)L; { const int q = nwgP / NXCD, xcd = wgid % NXCD, off = wgid / NXCD; wgid = xcd * q + off; }
            const int nig = WGM * nN; u.pm = (wgid / nig) * WGM + ((wgid % nig) % WGM); u.pn = (wgid % nig) / WGM;
            u.nt = ntP; u.mode = 0; u.aux = 0; u.offA = u.pm * ra; u.offB = u.pn * rb; return true; }
        const int s = (int)(L - nwgP); if (s >= nS) return false;
        if (kind == SK_PLAIN) { u.pm = 64 + (s & 1); u.pn = s >> 1; u.nt = ntP; u.mode = 0; u.aux = 0; u.offA = u.pm * ra; u.offB = u.pn * rb; }
        else if (kind == SK_P3) { const int n = s & 3, tile = s >> 2; u.pm = 64 + (tile & 1); u.pn = tile >> 1; u.nt = 8; u.mode = 1; u.aux = n; u.offA = u.pm * ra + 1024 * n; u.offB = u.pn * rb + 1024 * n; }
        else if (kind == SK_P4) { const int ch = s & 7, tile = s >> 3, n = ch >> 1, kin = (ch & 1) * 512; u.pm = 64 + (tile & 1); u.pn = tile >> 1; u.nt = 8; u.mode = 1; u.aux = ch;
            u.offA = offA_s + ((long)(n * 512 + (u.pm - 64) * 256) * 1024 + kin) * 2; u.offB = u.pn * rb + kin * 2; }
        else { const int ch = s % 11, tile = s / 11; u.pm = 64 + (tile & 1); u.pn = tile >> 1; u.nt = 4; u.mode = 1; u.aux = ch; u.offA = u.pm * ra + 512 * ch; u.offB = u.pn * rb + 512 * ch; }
        return true;
    }
};

__device__ __forceinline__ unsigned cvt_pk_bf16(float lo, float hi) { unsigned r; asm volatile("v_cvt_pk_bf16_f32 %0, %1, %2" : "=v"(r) : "v"(lo), "v"(hi)); return r; }
__device__ __forceinline__ float sigmoidf_fast(float x) { return __builtin_amdgcn_rcpf(1.0f + __builtin_amdgcn_exp2f(-1.44269504089f * x)); }
__device__ __forceinline__ float gelu_tanh(float x) { const float t = x * x, y = x * fmaf(t, -0.10294324f, -2.3022082f); return x * __builtin_amdgcn_rcpf(1.0f + __builtin_amdgcn_exp2f(y)); }

__device__ __forceinline__ float* state_ptr(float* out, int R, int keep, int layer, size_t p_off, size_t s_off) {
    if (R < MP) { const int b = R >> 11, j = (R & 2047) - (2048 - keep); return j < 0 ? nullptr : out + p_off + (size_t)((layer * 8 + b) * keep + j) * 512; }
    const int s = (R - MP) >> 2, j = (R & 3) + keep - 4; return j < 0 ? nullptr : out + s_off + (size_t)((layer * 128 + s) * keep + j) * 512;
}

struct EpiMix {
    static constexpr bool PERM = true, MIDK = false;
    bf16_t* Z; float* out; int layer;
    __device__ __forceinline__ void midk(f32x4 (&)[2][2][4][2], const Unit&, int, int, int, int, int) const {}
    __device__ __forceinline__ void operator()(f32x4 (&acc)[2][2][4][2], const Unit& u, int wr, int wc, int fr_, int fq_) const {
        const int lane_ = lane_now(), fr = lane_ & 15, fq = lane_ >> 4; (void)fr_; (void)fq_;
        const int pn = u.pn; int type, zcol, keep = 0, scol = 0; size_t poff = 0, soff = 0;
        if (pn < 2) { type = 0; zcol = 256 * pn; keep = 3; scol = zcol; poff = O_PRGC; soff = O_SRGC; }
        else if (pn < 4) { type = 1; zcol = 512 + 256 * (pn - 2); }
        else if (pn < 8) { type = 2; zcol = 1024 + 128 * (pn - 4); keep = 30; scol = 128 * (pn - 4); poff = O_PCF; soff = O_SCF; }
        else if (pn < 10) { type = 0; zcol = 1536 + 256 * (pn - 8); keep = 15; scol = 256 * (pn - 8); poff = O_PPOOL; soff = O_SPOOL; }
        else if (pn < 12) { type = 0; zcol = 2048 + 256 * (pn - 10); }
        else { type = 3; zcol = 2560 + 128 * (pn - 12); keep = 2; scol = 128 * (pn - 12); poff = O_PSC; soff = O_SSC; }
        const bool tail = keep != 0 && (u.pm >= 64 || (u.pm & 7) == 7);
        const int row0 = u.pm * BM + wr * 64 + fr, cl = wc * 32 + 8 * fq;
        if (type < 2) {
#pragma unroll
            for (int ai = 0; ai < 2; ++ai)
#pragma unroll
                for (int m = 0; m < 4; ++m) { const int R = row0 + ai * HALF + m * 16; bf16_t* rowp = Z + (size_t)R * ZC + zcol + cl;
                    float* sp = tail ? state_ptr(out, R, keep, layer, poff, soff) : nullptr;
#pragma unroll
                    for (int bj = 0; bj < 2; ++bj) { f32x4 v0 = acc[ai][bj][m][0], v1 = acc[ai][bj][m][1];
                        if (type == 1) { v0 = (f32x4){gelu_tanh(v0[0]), gelu_tanh(v0[1]), gelu_tanh(v0[2]), gelu_tanh(v0[3])}; v1 = (f32x4){gelu_tanh(v1[0]), gelu_tanh(v1[1]), gelu_tanh(v1[2]), gelu_tanh(v1[3])}; }
                        u32x4 w; w.x = cvt_pk_bf16(v0[0], v0[1]); w.y = cvt_pk_bf16(v0[2], v0[3]); w.z = cvt_pk_bf16(v1[0], v1[1]); w.w = cvt_pk_bf16(v1[2], v1[3]);
                        *(u32x4*)(rowp + bj * HALF) = w;
                        if (sp) { *(f32x4*)(sp + scol + cl + bj * HALF) = v0; *(f32x4*)(sp + scol + cl + bj * HALF + 4) = v1; } } }
        } else {
#pragma unroll
            for (int ai = 0; ai < 2; ++ai)
#pragma unroll
                for (int m = 0; m < 4; ++m) { const int R = row0 + ai * HALF + m * 16; bf16_t* rowp = Z + (size_t)R * ZC + zcol + cl;
                    float* sp = tail ? state_ptr(out, R, keep, layer, poff, soff) : nullptr;
                    f32x4 v0, v1; const f32x4 a0 = acc[ai][0][m][0], a1 = acc[ai][0][m][1], b0 = acc[ai][1][m][0], b1 = acc[ai][1][m][1];
                    if (type == 2) {
#pragma unroll
                        for (int i = 0; i < 4; ++i) { v0[i] = a0[i] * sigmoidf_fast(b0[i]); v1[i] = a1[i] * sigmoidf_fast(b1[i]); }
                    } else { v0 = a0 * b0; v1 = a1 * b1; }
                    u32x4 w; w.x = cvt_pk_bf16(v0[0], v0[1]); w.y = cvt_pk_bf16(v0[2], v0[3]); w.z = cvt_pk_bf16(v1[0], v1[1]); w.w = cvt_pk_bf16(v1[2], v1[3]);
                    *(u32x4*)rowp = w;
                    if (sp) { *(f32x4*)(sp + scol + cl) = v0; *(f32x4*)(sp + scol + cl + 4) = v1; } }
        }
    }
};

struct EpiGate {
    static constexpr bool PERM = true, MIDK = false;
    _Float16* G;
    __device__ __forceinline__ void midk(f32x4 (&)[2][2][4][2], const Unit&, int, int, int, int, int) const {}
    __device__ __forceinline__ void operator()(f32x4 (&acc)[2][2][4][2], const Unit& u, int wr, int wc, int fr_, int fq_) const {
        const int lane_ = lane_now(), fr = lane_ & 15, fq = lane_ >> 4; (void)fr_; (void)fq_;
        const int row0 = u.pm * BM + wr * 64 + fr, ch0 = 64 * u.pn + 16 * wc + 4 * fq; const bool plain = u.pm >= 64;
#pragma unroll
        for (int ai = 0; ai < 2; ++ai)
#pragma unroll
            for (int m = 0; m < 4; ++m) { const int R = row0 + ai * HALF + m * 16; _Float16* gp = G + (size_t)R * GC + ch0;
                f16x4 r0, r1, r2, g3;
#pragma unroll
                for (int i = 0; i < 4; ++i) {
                    const float d0 = 1.f + __builtin_amdgcn_exp2f(__builtin_amdgcn_fmed3f(acc[ai][0][m][0][i], -15.f, 15.f)), d1 = 1.f + __builtin_amdgcn_exp2f(__builtin_amdgcn_fmed3f(acc[ai][0][m][1][i], -15.f, 15.f));
                    const float d2 = 1.f + __builtin_amdgcn_exp2f(__builtin_amdgcn_fmed3f(acc[ai][1][m][0][i], -15.f, 15.f)), d3 = 1.f + __builtin_amdgcn_exp2f(__builtin_amdgcn_fmed3f(acc[ai][1][m][1][i], -15.f, 15.f));
                    const float i0 = __builtin_amdgcn_rcpf(d0), i1 = __builtin_amdgcn_rcpf(d1), i2 = __builtin_amdgcn_rcpf(d2), i3 = __builtin_amdgcn_rcpf(d3);
                    if (plain) { r0[i] = (_Float16)i0; r1[i] = (_Float16)i1; r2[i] = (_Float16)i2; }
                    else { r0[i] = (_Float16)(d1 * i0); r1[i] = (_Float16)(d2 * i1); r2[i] = (_Float16)(d3 * i2); }
                    g3[i] = (_Float16)i3; }
                *(f16x4*)(gp) = r0; *(f16x4*)(gp + 1024) = r1; *(f16x4*)(gp + 2048) = r2; *(f16x4*)(gp + 3072) = g3; }
    }
};

struct EpiMerge {
    static constexpr bool PERM = false, MIDK = true;
    const _Float16* G; bf16_t* O; bf16_t* Os;
    __device__ __forceinline__ void scale(f32x4 (&acc)[2][2][4][2], const Unit& u, int seg, int wr, int wc) const {
        const int lane_ = lane_now(), fr = lane_ & 15, fq = lane_ >> 4;
        const int row0 = u.pm * BM + wr * 64 + fr, c0 = 1024 * seg + 256 * u.pn + wc * 32 + 4 * fq;
#pragma unroll
        for (int ai = 0; ai < 2; ++ai)
#pragma unroll
            for (int m = 0; m < 4; ++m) { const _Float16* gp = G + (size_t)(row0 + ai * HALF + m * 16) * GC + c0;
#pragma unroll
                for (int bj = 0; bj < 2; ++bj)
#pragma unroll
                    for (int n = 0; n < 2; ++n) { const f16x4 f = *(const f16x4*)(gp + bj * HALF + n * 16);
                        acc[ai][bj][m][n] *= (f32x4){(float)f[0], (float)f[1], (float)f[2], (float)f[3]}; } }
    }
    __device__ __forceinline__ void midk(f32x4 (&acc)[2][2][4][2], const Unit& u, int seg, int wr, int wc, int, int) const { scale(acc, u, seg, wr, wc); }
    __device__ __forceinline__ void operator()(f32x4 (&acc)[2][2][4][2], const Unit& u, int wr, int wc, int, int) const {
        scale(acc, u, u.mode ? u.aux : 3, wr, wc);
        const int lane_ = lane_now(), fr = lane_ & 15, fq = lane_ >> 4;
        const int row0 = (u.mode ? (u.pm - 64) * BM + 512 * u.aux : u.pm * BM) + wr * 64 + fr, c0 = 256 * u.pn + wc * 32 + 4 * fq;
        bf16_t* O = u.mode ? Os : this->O;
#pragma unroll
        for (int ai = 0; ai < 2; ++ai)
#pragma unroll
            for (int m = 0; m < 4; ++m) { bf16_t* rowp = O + (size_t)(row0 + ai * HALF + m * 16) * DM + c0;
#pragma unroll
                for (int bj = 0; bj < 2; ++bj)
#pragma unroll
                    for (int n = 0; n < 2; ++n) { const f32x4 v = acc[ai][bj][m][n]; u32x2 w; w.x = cvt_pk_bf16(v[0], v[1]); w.y = cvt_pk_bf16(v[2], v[3]); *(u32x2*)(rowp + bj * HALF + n * 16) = w; } }
    }
};

struct EpiRes {
    static constexpr bool PERM = false, MIDK = false;
    const float* baseP; const float* baseS; float* out; float* slab;
    __device__ __forceinline__ void midk(f32x4 (&)[2][2][4][2], const Unit&, int, int, int, int, int) const {}
    __device__ __forceinline__ void operator()(f32x4 (&acc)[2][2][4][2], const Unit& u, int wr, int wc, int fr_, int fq_) const {
        const int lane_ = lane_now(), fr = lane_ & 15, fq = lane_ >> 4; (void)fr_; (void)fq_;
        const int row0 = u.pm * BM + wr * 64 + fr, c0 = 256 * u.pn + wc * 32 + 4 * fq;
        if (u.mode) {
#pragma unroll
            for (int ai = 0; ai < 2; ++ai)
#pragma unroll
                for (int m = 0; m < 4; ++m) { float* op = slab + ((size_t)u.aux * 512 + (row0 - MP) + ai * HALF + m * 16) * DM + c0;
#pragma unroll
                    for (int bj = 0; bj < 2; ++bj)
#pragma unroll
                        for (int n = 0; n < 2; ++n) *(f32x4*)(op + bj * HALF + n * 16) = acc[ai][bj][m][n]; }
            return; }
#pragma unroll
        for (int ai = 0; ai < 2; ++ai)
#pragma unroll
            for (int m = 0; m < 4; ++m) { const int R = row0 + ai * HALF + m * 16;
                const float* bp = (R < MP ? baseP + (size_t)R * DM : baseS + (size_t)(R - MP) * DM) + c0; float* op = out + (size_t)R * DM + c0;
#pragma unroll
                for (int bj = 0; bj < 2; ++bj)
#pragma unroll
                    for (int n = 0; n < 2; ++n) { const f32x4 b = *(const f32x4*)(bp + bj * HALF + n * 16); *(f32x4*)(op + bj * HALF + n * 16) = b * ALPHA + acc[ai][bj][m][n]; }
                if (m & 1) asm volatile("" ::: "memory"); }
    }
};

struct EpiSwi {
    static constexpr bool PERM = true, MIDK = false;
    bf16_t* H;
    __device__ __forceinline__ void midk(f32x4 (&)[2][2][4][2], const Unit&, int, int, int, int, int) const {}
    __device__ __forceinline__ void operator()(f32x4 (&acc)[2][2][4][2], const Unit& u, int wr, int wc, int fr_, int fq_) const {
        const int lane_ = lane_now(), fr = lane_ & 15, fq = lane_ >> 4; (void)fr_; (void)fq_;
        const int row0 = u.pm * BM + wr * 64 + fr, c0 = 128 * u.pn + wc * 32 + 8 * fq;
#pragma unroll
        for (int ai = 0; ai < 2; ++ai)
#pragma unroll
            for (int m = 0; m < 4; ++m) { bf16_t* rowp = H + (size_t)(row0 + ai * HALF + m * 16) * FF + c0;
                const f32x4 g0 = acc[ai][0][m][0], g1 = acc[ai][0][m][1], u0 = acc[ai][1][m][0], u1 = acc[ai][1][m][1]; f32x4 v0, v1;
#pragma unroll
                for (int i = 0; i < 4; ++i) { v0[i] = g0[i] * sigmoidf_fast(g0[i]) * u0[i]; v1[i] = g1[i] * sigmoidf_fast(g1[i]) * u1[i]; }
                u32x4 w; w.x = cvt_pk_bf16(v0[0], v0[1]); w.y = cvt_pk_bf16(v0[2], v0[3]); w.z = cvt_pk_bf16(v1[0], v1[1]); w.w = cvt_pk_bf16(v1[2], v1[3]);
                *(u32x4*)rowp = w; }
    }
};

template <class Epi, class Sched, bool ALIGN_EPI>
__device__ __forceinline__ void gemm_phase(PG8_LAS unsigned char* lds, const Gemm g, const Sched& S, const Epi& E, int wave_id) {
    const int wid = opqs(wave_id), lane = lane_now(), tid = wid * 64 + lane, wr = wid >> 2, wc = wid & 3, fr = lane & 15, fq = lane >> 4;
    unsigned voffA[2], voffB[2];
#pragma unroll
    for (int i = 0; i < 2; ++i) { int R, C; stage_rc(tid * 16 + i * 8192, R, C); const int Rb = Epi::PERM ? ((R & ~31) + perm32(R & 31)) : R;
        voffA[i] = (unsigned)(R * g.lda + C) * 2u; voffB[i] = (unsigned)(Rb * g.ldb + C) * 2u; }
    const size_t kstep = (size_t)(BK * 2);
    const size_t hstepA = (size_t)HALF * g.lda * 2, hstepB = (size_t)HALF * g.ldb * 2;
    const unsigned ldsw = (unsigned)wid * 1024u;
    const int aoff = lds_byte(wr * 64 + fr, fq * 8), boff = lds_byte(wc * 32 + fr, fq * 8);
#define PG8_SA(b, h) (((b) * 2 + (h)) * HTB)
#define PG8_SB(b, h) ((4 + (b) * 2 + (h)) * HTB)
#define PG8_STAGE(bufoff, gbase, voff) do { _Pragma("unroll") for (int _i = 0; _i < 2; ++_i) \
        __builtin_amdgcn_global_load_lds((const unsigned*)((const char*)(gbase) + (voff)[_i]), (PG8_LAS unsigned*)(lds + (bufoff) + ldsw + _i * 8192), 16, 0, 0); } while (0)
#define PG8_LDA(dst, b, h) do { _Pragma("unroll") for (int m = 0; m < 4; ++m) _Pragma("unroll") for (int k = 0; k < 2; ++k) dst[m][k] = *(const PG8_LAS bf16x8*)(lds + PG8_SA(b, h) + aoff + m * 2048 + k * 1024); } while (0)
#define PG8_LDB(dst, b, h) do { _Pragma("unroll") for (int n = 0; n < 2; ++n) _Pragma("unroll") for (int k = 0; k < 2; ++k) dst[n][k] = *(const PG8_LAS bf16x8*)(lds + PG8_SB(b, h) + boff + n * 2048 + k * 1024); } while (0)
#define PG8_MMA(ai, bj, At, Bt) do { __builtin_amdgcn_s_setprio(1); _Pragma("unroll") for (int m = 0; m < 4; ++m) _Pragma("unroll") for (int n = 0; n < 2; ++n) _Pragma("unroll") for (int k = 0; k < 2; ++k) \
        acc[ai][bj][m][n] = __builtin_amdgcn_mfma_f32_16x16x32_bf16(Bt[n][k], At[m][k], acc[ai][bj][m][n], 0, 0, 0); __builtin_amdgcn_s_setprio(0); } while (0)
#define PG8_WAIT_V(n) asm volatile("s_waitcnt vmcnt(" #n ")" ::: "memory")
#define PG8_WAIT_L(n) asm volatile("s_waitcnt lgkmcnt(" #n ")" ::: "memory")
#define PG8_BAR __builtin_amdgcn_s_barrier()
#define PG8_SCHED __builtin_amdgcn_sched_barrier(0)
    Unit cur, nxt; int ui = 0;
    if (!S.next(0, cur, g)) return;
    f32x4 acc[2][2][4][2];
#pragma unroll
    for (int a = 0; a < 2; ++a)
#pragma unroll
        for (int b = 0; b < 2; ++b)
#pragma unroll
            for (int m = 0; m < 4; ++m)
#pragma unroll
                for (int n = 0; n < 2; ++n) acc[a][b][m][n] = (f32x4){0.f, 0.f, 0.f, 0.f};
    bf16x8 At[4][2], B0[2][2], B1[2][2];
    const char* cA = (const char*)g.A + cur.offA; const char* cB = (const char*)g.Bt + cur.offB;
    PG8_STAGE(PG8_SB(0, 0), cB, voffB); PG8_STAGE(PG8_SB(0, 1), cB + hstepB, voffB); PG8_STAGE(PG8_SA(0, 0), cA, voffA); PG8_STAGE(PG8_SA(0, 1), cA + hstepA, voffA);
    if (wr == 1) PG8_BAR;
    PG8_WAIT_V(2); PG8_BAR;
    PG8_STAGE(PG8_SB(1, 0), cB + kstep, voffB); PG8_STAGE(PG8_SA(1, 0), cA + kstep, voffA); PG8_STAGE(PG8_SB(1, 1), cB + hstepB + kstep, voffB);
    PG8_WAIT_V(6); PG8_BAR;
    for (;;) {
        const bool has_next = S.next(ui + 1, nxt, g);
        const char* nA = has_next ? (const char*)g.A + nxt.offA : cA; const char* nB = has_next ? (const char*)g.Bt + nxt.offB : cB;
        const int nt = cur.nt, TSEG = Epi::MIDK ? 8 : nt;
        for (int t0 = 0; t0 < nt; t0 += TSEG) {
        if constexpr (Epi::MIDK) { if (t0 != 0) { PG8_SCHED; E.midk(acc, cur, t0 / TSEG - 1, wr, wc, 0, 0); PG8_SCHED; } }
#pragma unroll 1
        for (int t = t0; t < t0 + TSEG; t += 2) {
            const bool last = (t == nt - 2);
            const char* a1 = cA + (size_t)(t + 1) * kstep;
            const char* a2 = last ? nA : cA + (size_t)(t + 2) * kstep; const char* b2 = last ? nB : cB + (size_t)(t + 2) * kstep;
            const char* a3 = a2 + kstep; const char* b3 = b2 + kstep;
            PG8_LDB(B0, 0, 0); PG8_LDB(B1, 0, 1); PG8_SCHED; PG8_LDA(At, 0, 0); PG8_STAGE(PG8_SA(1, 1), a1 + hstepA, voffA);
            PG8_WAIT_V(8); PG8_WAIT_L(0); PG8_BAR; PG8_MMA(0, 0, At, B0); PG8_MMA(0, 1, At, B1); PG8_BAR; PG8_SCHED;
            PG8_LDA(At, 0, 1); PG8_STAGE(PG8_SB(0, 0), b2, voffB); PG8_STAGE(PG8_SB(0, 1), b2 + hstepB, voffB); PG8_STAGE(PG8_SA(0, 0), a2, voffA);
            PG8_WAIT_V(8); PG8_WAIT_L(0); PG8_BAR; PG8_MMA(1, 0, At, B0); PG8_MMA(1, 1, At, B1); PG8_BAR; PG8_SCHED;
            PG8_LDB(B0, 1, 0); PG8_LDB(B1, 1, 1); PG8_SCHED; PG8_LDA(At, 1, 0); PG8_STAGE(PG8_SA(0, 1), a2 + hstepA, voffA);
            PG8_WAIT_V(8); PG8_WAIT_L(0); PG8_BAR; PG8_MMA(0, 0, At, B0); PG8_MMA(0, 1, At, B1); PG8_BAR; PG8_SCHED;
            PG8_LDA(At, 1, 1); PG8_STAGE(PG8_SB(1, 0), b3, voffB); PG8_STAGE(PG8_SB(1, 1), b3 + hstepB, voffB); PG8_STAGE(PG8_SA(1, 0), a3, voffA);
            PG8_WAIT_V(8); PG8_WAIT_L(0); PG8_BAR; PG8_MMA(1, 0, At, B0); PG8_MMA(1, 1, At, B1); PG8_BAR; PG8_SCHED;
        }
        }
        if constexpr (ALIGN_EPI) { if (wr == 0) PG8_BAR; }
        E(acc, cur, wr, wc, 0, 0);
        if (!has_next) break;
#pragma unroll
        for (int a = 0; a < 2; ++a)
#pragma unroll
            for (int b = 0; b < 2; ++b)
#pragma unroll
                for (int m = 0; m < 4; ++m)
#pragma unroll
                    for (int n = 0; n < 2; ++n) acc[a][b][m][n] = (f32x4){0.f, 0.f, 0.f, 0.f};
        cur = nxt; cA = nA; cB = nB; ++ui;
        if constexpr (ALIGN_EPI) { if (wr == 1) PG8_BAR; }
    }
    PG8_WAIT_V(0);
    if constexpr (!ALIGN_EPI) { if (wr == 0) PG8_BAR; }
    PG8_BAR;
#undef PG8_SA
#undef PG8_SB
#undef PG8_STAGE
#undef PG8_LDA
#undef PG8_LDB
#undef PG8_MMA
#undef PG8_WAIT_V
#undef PG8_WAIT_L
#undef PG8_BAR
#undef PG8_SCHED
}
}

constexpr int NWAVES = 8;
constexpr int NPHASE = 19;
constexpr size_t MiB = 1u << 20;
constexpr size_t WS_CTL = 0, CTL_ZERO_BYTES = 1 * MiB;
constexpr size_t WS_WA = 1 * MiB;
constexpr size_t WS_XB = 18 * MiB;
constexpr size_t WS_Y = 51 * MiB;
constexpr size_t WS_ZG = 117 * MiB;
constexpr size_t WS_BT3 = 249 * MiB, WS_BT4 = 253 * MiB, WS_BT5 = WS_ZG + 96 * MiB, WS_BT6 = WS_ZG + 108 * MiB;
constexpr size_t WS_MB4S = WS_WA + 8 * MiB;
constexpr size_t WS_SLAB = WS_Y;
constexpr size_t WS_END = 255 * MiB;
static_assert(WS_XB + (size_t)M * DM * 2 <= WS_Y && WS_Y + (size_t)M * YC * 2 <= WS_ZG && WS_ZG + (size_t)M * GC * 2 <= WS_BT3 && WS_SLAB + (size_t)11 * 512 * DM * 4 <= WS_ZG, "ws map");
static_assert((size_t)M * FF * 2 <= 96 * MiB && WS_BT5 + (size_t)2 * FF * DM * 2 <= WS_BT6 && WS_BT6 + (size_t)DM * FF * 2 <= WS_BT3, "ws map 2");
constexpr int CW_TMO = 0, CW_CODE = 1, CW_BAR = 4096;
constexpr int RING_OFF = 0, RING_BYTES = 131072;
constexpr int LDSCTL_OFF = RING_BYTES, MISC_OFF = LDSCTL_OFF + 320;
constexpr int LDS_BYTES = 147456;

#define GAS __attribute__((address_space(1)))
#define LAS __attribute__((address_space(3)))
typedef unsigned short bf16;
typedef unsigned v4u __attribute__((ext_vector_type(4)));
typedef unsigned v2u __attribute__((ext_vector_type(2)));
typedef float f32x4 __attribute__((ext_vector_type(4)));
typedef float f32x2 __attribute__((ext_vector_type(2)));
typedef short bf16x8 __attribute__((ext_vector_type(8)));
typedef GAS unsigned gu32;
#define RLX_AGENT __ATOMIC_RELAXED, __HIP_MEMORY_SCOPE_AGENT
#define LDS_WAIT() asm volatile("s_waitcnt lgkmcnt(0)" ::: "memory")
#define VM_WAIT() asm volatile("s_waitcnt vmcnt(0)" ::: "memory")
__device__ __forceinline__ unsigned pk2(float lo, float hi) { return pg8::cvt_pk_bf16(lo, hi); }
__device__ __forceinline__ float bflo(unsigned v) { return __uint_as_float(v << 16); }
__device__ __forceinline__ float bfhi(unsigned v) { return __uint_as_float(v & 0xffff0000u); }
__device__ __forceinline__ float bf1(unsigned short h) { return __uint_as_float((unsigned)h << 16); }
__device__ __forceinline__ unsigned short f2bf(float f) { return (unsigned short)(pg8::cvt_pk_bf16(f, 0.f) & 0xffffu); }

#define XB_TMO      128
#define XB_XCNT(j)  (256  + 64 * (j))
#define XB_XSUB(j)  (1280 + 64 * (j))
#define XB_XGEN(j)  (2304 + 64 * (j))
#define XB_TOP      3328
#define XB_TOPGEN   3392
#define XCD_BAR_WORDS 3456
#define XB_SPIN_CAP (1u << 18)
__device__ __forceinline__ unsigned xb_ld(unsigned* p)              { return __hip_atomic_load(p, __ATOMIC_RELAXED, __HIP_MEMORY_SCOPE_AGENT); }
__device__ __forceinline__ unsigned xb_add(unsigned* p, unsigned v) { return __hip_atomic_fetch_add(p, v, __ATOMIC_RELAXED, __HIP_MEMORY_SCOPE_AGENT); }
__device__ __forceinline__ unsigned xb_xcc_id() { return (unsigned)__builtin_amdgcn_s_getreg((3 << 11) | 20) & 0xFu; }
#define XB_SPIN(cond, bar) do { unsigned _sp = 0; while (cond) { __builtin_amdgcn_s_sleep(1); \
    if ((++_sp & 255u) == 0u) { if (xb_ld(&(bar)[XB_TMO])) break; if (_sp > XB_SPIN_CAP) { atomicAdd(&(bar)[XB_TMO], 1u); break; } } } } while (0)
struct XcdBarrier { unsigned* bar; unsigned x; volatile LAS unsigned* st; };
__device__ __forceinline__ XcdBarrier xcd_barrier_post(unsigned* bar, volatile LAS unsigned* st) {
    XcdBarrier b; b.bar = bar; b.x = xb_xcc_id(); b.st = st;
    if (threadIdx.x == 0) (void)xb_add(&bar[XB_XCNT(b.x)], 1u);
    return b;
}
__device__ __forceinline__ void xcd_barrier_complete(unsigned* bar, unsigned x, unsigned& nloc, unsigned& nx) {
    const unsigned G = gridDim.x * gridDim.y * gridDim.z;
    unsigned sum, cnt, mine, sp = 0u;
    for (;;) {
        sum = 0u; cnt = 0u; mine = 0u;
#pragma unroll
        for (unsigned j = 0; j < 16; ++j) { const unsigned c = xb_ld(&bar[XB_XCNT(j)]); sum += c; cnt += (c > 0u) ? 1u : 0u; mine = (j == x) ? c : mine; }
        if (sum == G) break;
        __builtin_amdgcn_s_sleep(1);
        if ((++sp & 255u) == 0u) { if (xb_ld(&bar[XB_TMO])) break; if (sp > XB_SPIN_CAP) { atomicAdd(&bar[XB_TMO], 1u); break; } }
    }
    nloc = mine > 0u ? mine : 1u; nx = cnt > 0u ? cnt : 1u;
}
__device__ __forceinline__ void xcd_barrier(const XcdBarrier& b) {
    asm volatile("s_waitcnt vmcnt(0)" ::: "memory");
    __syncthreads();
    if (threadIdx.x == 0) {
        unsigned* bar = b.bar;
        __builtin_amdgcn_s_waitcnt(0);
        unsigned nloc = b.st[0], nx = b.st[1];
        if (nloc == 0u) { xcd_barrier_complete(bar, b.x, nloc, nx); b.st[0] = nloc; b.st[1] = nx; }
        const unsigned old = xb_add(&bar[XB_XSUB(b.x)], 1u);
        const unsigned gen = old / nloc;
        if (old + 1u == (gen + 1u) * nloc) {
            __builtin_amdgcn_fence(__ATOMIC_RELEASE, "agent");
            asm volatile("s_waitcnt vmcnt(0)" ::: "memory");
            const unsigned og = xb_add(&bar[XB_TOP], 1u);
            const unsigned tg = og / nx;
            if (og + 1u == (tg + 1u) * nx) xb_add(&bar[XB_TOPGEN], 1u);
            else XB_SPIN(xb_ld(&bar[XB_TOPGEN]) == tg, bar);
            __builtin_amdgcn_fence(__ATOMIC_ACQUIRE, "agent");
            xb_add(&bar[XB_XGEN(b.x)], 1u);
            asm volatile("s_waitcnt vmcnt(0)" ::: "memory");
        } else {
            XB_SPIN(xb_ld(&bar[XB_XGEN(b.x)]) == gen, bar);
            __builtin_amdgcn_fence(__ATOMIC_ACQUIRE, "agent");
            asm volatile("s_waitcnt vmcnt(0)" ::: "memory");
        }
    }
    __syncthreads();
}

struct Frame {
    LAS unsigned char* lds;
    volatile LAS unsigned* MISC;
    gu32* ctl;
    int tid, lane, wave, G, bid;
    const float* const* in;
    float* out;
    unsigned char* ws;
};
enum { I_XP = 0, I_XS, I_SH, I_SRGC, I_SCF, I_SPOOL, I_SSC, I_WIN, I_RGCW, I_RGCB, I_RGWA, I_RGBA, I_RGWX, I_RGBX, I_LAM, I_CFW, I_CFB, I_CFG, I_CFBB, I_POOLW, I_POOLS, I_SCW,
       I_WBR, I_WOUT, I_LN1G, I_LN1B, I_WG, I_WU, I_WD, I_LN2G, I_LN2B };

__device__ __forceinline__ float shfl_idx(float v, int src_lane) { return __builtin_bit_cast(float, __builtin_amdgcn_ds_bpermute(src_lane << 2, __builtin_bit_cast(int, v))); }
__device__ __forceinline__ float wave_sum(float v, int lane) {
#pragma unroll
    for (int o = 1; o < 64; o <<= 1) v += shfl_idx(v, lane ^ o);
    return v;
}

enum { RM_ID = 0, RM_WIN = 1, RM_GU = 2 };
template <int MODE> __device__ __forceinline__ int rowmap(int s, int extra) {
    if (MODE == RM_ID) return s;
    if (MODE == RM_GU) return 256 * (s >> 7) + (s & 127) + extra;
    if (s < 1024) return s;
    if (s < 2048) { const int j = ((s - 1024) >> 7) & 3; return 1024 + 256 * j + (s >= 1536 ? 128 : 0) + (s & 127); }
    if (s < 3072) return s;
    if (s < 4096) { const int j = ((s - 3072) >> 7) & 3; return 3072 + 256 * j + (s >= 3584 ? 128 : 0) + (s & 127); }
    const int g = (s - 4096) >> 10, ch = s & 1023, pn = ch >> 6, chl = ch & 63, wc = chl >> 4, fq = (chl >> 2) & 3, i = chl & 3;
    return 4096 + 256 * pn + 128 * (g >> 1) + 32 * wc + 8 * fq + 4 * (g & 1) + i;
}
template <int MODE>
__device__ __forceinline__ void transpose_item(const float* W, int K, int N, bf16* WT, int dst_ld, int dst_koff, int extra, LAS float* scr, int item, int lane) {
    const int nblk = N / 32, kb = item / nblk, nb = item % nblk, k0 = 64 * kb, n0 = 32 * nb;
#pragma unroll 8
    for (int i = 0; i < 32; ++i) { const int kk = 2 * i + (lane >> 5); scr[kk * 33 + (lane & 31)] = W[(size_t)(k0 + kk) * N + n0 + (lane & 31)]; }
    LDS_WAIT(); asm volatile("" ::: "memory");
    const int c = lane & 7; const float sc = (MODE == RM_WIN && n0 >= 4096) ? -1.44269504089f : 1.0f;
#pragma unroll
    for (int j = 0; j < 4; ++j) { const int n = (lane >> 3) + 8 * j; const LAS float* s = scr + (8 * c) * 33 + n;
        v4u o; o.x = pk2(s[0 * 33] * sc, s[1 * 33] * sc); o.y = pk2(s[2 * 33] * sc, s[3 * 33] * sc); o.z = pk2(s[4 * 33] * sc, s[5 * 33] * sc); o.w = pk2(s[6 * 33] * sc, s[7 * 33] * sc);
        *(GAS v4u*)(WT + (size_t)rowmap<MODE>(n0 + n, extra) * dst_ld + dst_koff + k0 + 8 * c) = o; }
    LDS_WAIT(); asm volatile("" ::: "memory");
}
template <int MODE>
__device__ __forceinline__ void convert_matrix(Frame& F, const float* W, int K, int N, bf16* WT, int dst_ld, int dst_koff, int extra, int gw, int NGW, int first = 0) {
    LAS float* scr = (LAS float*)(F.lds + RING_OFF + F.wave * 16384);
    const int nitems = (K / 64) * (N / 32);
    int it0 = gw - first; if (it0 < 0) it0 += ((-it0 + NGW - 1) / NGW) * NGW;
    for (int it = it0; it < nitems; it += NGW) transpose_item<MODE>(W, K, N, WT, dst_ld, dst_koff, extra, scr, it, F.lane);
}
__device__ __forceinline__ void compose_pool(Frame& F, int layer, bf16* Bt3, int gw, int NGW, int first = 0) {
    const float* pw = F.in[I_POOLW] + (size_t)layer * 4 * 128 * 128; const float* ps = F.in[I_POOLS] + layer * 512; const float* Wb2 = F.in[I_WBR] + ((size_t)layer * 4 + 2) * 512 * 1024;
    const int lane = F.lane;
    LAS float* Pl = (LAS float*)(F.lds + RING_OFF + F.wave * 16384);
    int id0 = gw - first; if (id0 < 0) id0 += ((-id0 + NGW - 1) / NGW) * NGW;
    for (int id = id0; id < 512; id += NGW) {
        const int g = __builtin_amdgcn_readfirstlane(id >> 7), c0 = __builtin_amdgcn_readfirstlane(8 * ((id >> 3) & 15)), d0 = 128 * (id & 7) + 2 * lane;
#pragma unroll
        for (int k = 0; k < 4; ++k) { const int idx4 = lane + 64 * k, i = idx4 >> 5, e4 = (idx4 & 31) * 4;
            const f32x4 pv = *(const GAS f32x4*)(pw + ((size_t)g * 128 + c0 + i) * 128 + e4), sv = *(const GAS f32x4*)(ps + 128 * g + e4);
            Pl[(e4 + 0) * 8 + i] = pv.x * sv.x; Pl[(e4 + 1) * 8 + i] = pv.y * sv.y; Pl[(e4 + 2) * 8 + i] = pv.z * sv.z; Pl[(e4 + 3) * 8 + i] = pv.w * sv.w; }
        LDS_WAIT(); asm volatile("" ::: "memory");
        f32x2 acc[8];
#pragma unroll
        for (int i = 0; i < 8; ++i) acc[i] = (f32x2){0.f, 0.f};
        const float* wrow = Wb2 + (size_t)(128 * g) * 1024 + d0;
#pragma unroll 1
        for (int e0 = 0; e0 < 128; e0 += 8) {
            f32x2 wv[8];
#pragma unroll
            for (int k = 0; k < 8; ++k) wv[k] = *(const GAS f32x2*)(wrow + (size_t)(e0 + k) * 1024);
#pragma unroll
            for (int k = 0; k < 8; ++k) { const f32x4 p0 = *(const LAS f32x4*)(Pl + (e0 + k) * 8), p1 = *(const LAS f32x4*)(Pl + (e0 + k) * 8 + 4);
#pragma unroll
                for (int i = 0; i < 4; ++i) { acc[i] += wv[k] * p0[i]; acc[4 + i] += wv[k] * p1[i]; } }
        }
        v4u o0, o1;
        o0.x = pk2(acc[0].x, acc[1].x); o0.y = pk2(acc[2].x, acc[3].x); o0.z = pk2(acc[4].x, acc[5].x); o0.w = pk2(acc[6].x, acc[7].x);
        o1.x = pk2(acc[0].y, acc[1].y); o1.y = pk2(acc[2].y, acc[3].y); o1.z = pk2(acc[4].y, acc[5].y); o1.w = pk2(acc[6].y, acc[7].y);
        *(GAS v4u*)(Bt3 + (size_t)d0 * 2048 + 1024 + 128 * g + c0) = o0; *(GAS v4u*)(Bt3 + (size_t)(d0 + 1) * 2048 + 1024 + 128 * g + c0) = o1;
        LDS_WAIT(); asm volatile("" ::: "memory");
    }
}

__device__ __forceinline__ const float* xrow_in(Frame& F, int m) { return m < MP ? F.in[I_XP] + (size_t)m * DM : F.in[I_XS] + (size_t)(m - MP) * DM; }
__device__ __forceinline__ void x_to_bf16(Frame& F, bf16* XB) {
    const int gw = F.bid * NWAVES + F.wave, NGW = F.G * NWAVES;
    for (int m = gw; m < M; m += NGW) { const GAS f32x4* xr = (const GAS f32x4*)xrow_in(F, m) + F.lane; GAS v2u* o = (GAS v2u*)(XB + (size_t)m * DM) + F.lane;
#pragma unroll
        for (int j = 0; j < 4; ++j) { const f32x4 v = xr[64 * j]; o[64 * j] = (v2u){pk2(v.x, v.y), pk2(v.z, v.w)}; } }
}
__device__ __forceinline__ void ln_rows(Frame& F, const float* V, float* O, const float* g, const float* b, bf16* XB, const float* sbase, const float* slab, int nslab) {
    const int gw = F.bid * NWAVES + F.wave, NGW = F.G * NWAVES;
    f32x4 gv[4], bv[4];
#pragma unroll
    for (int j = 0; j < 4; ++j) { gv[j] = ((const GAS f32x4*)g)[F.lane + 64 * j]; bv[j] = ((const GAS f32x4*)b)[F.lane + 64 * j]; }
    for (int m = gw; m < M; m += NGW) {
        const GAS f32x4* xr = (const GAS f32x4*)(V + (size_t)m * DM) + F.lane; GAS f32x4* orow = (GAS f32x4*)(O + (size_t)m * DM) + F.lane;
        f32x4 v[4]; float s = 0.f;
#pragma unroll
        for (int j = 0; j < 4; ++j) v[j] = xr[64 * j];
        if (m >= MP) { const GAS f32x4* br = (const GAS f32x4*)(sbase + (size_t)(m - MP) * DM) + F.lane;
#pragma unroll
            for (int j = 0; j < 4; ++j) v[j] = br[64 * j] * ALPHA;
            for (int sl = 0; sl < nslab; ++sl) { const GAS f32x4* sr = (const GAS f32x4*)(slab + ((size_t)sl * 512 + (m - MP)) * DM) + F.lane;
#pragma unroll
                for (int j = 0; j < 4; ++j) v[j] += sr[64 * j]; } }
#pragma unroll
        for (int j = 0; j < 4; ++j) s += (v[j].x + v[j].y) + (v[j].z + v[j].w);
        const float mean = wave_sum(s, F.lane) * (1.f / DM); float s2 = 0.f;
#pragma unroll
        for (int j = 0; j < 4; ++j) { v[j] = v[j] - mean; s2 += (v[j].x * v[j].x + v[j].y * v[j].y) + (v[j].z * v[j].z + v[j].w * v[j].w); }
        const float rstd = __builtin_amdgcn_rsqf(wave_sum(s2, F.lane) * (1.f / DM) + LN_EPS);
#pragma unroll
        for (int j = 0; j < 4; ++j) { v[j] = v[j] * rstd * gv[j] + bv[j]; orow[64 * j] = v[j]; }
        if (XB) { GAS v2u* o = (GAS v2u*)(XB + (size_t)m * DM) + F.lane;
#pragma unroll
            for (int j = 0; j < 4; ++j) o[64 * j] = (v2u){pk2(v[j].x, v[j].y), pk2(v[j].z, v[j].w)}; }
    }
}

__device__ __forceinline__ float softplusf_acc(float x) { return fmaxf(x, 0.f) + log1pf(__expf(-fabsf(x))); }
__device__ __forceinline__ float expm1_neg(float x) {
    const float p = x * (1.f + x * (0.5f + x * (1.f / 6.f + x * (1.f / 24.f + x * (1.f / 120.f + x * (1.f / 720.f + x * (1.f / 5040.f)))))));
    return x > -0.25f ? p : __expf(x) - 1.f;
}
constexpr int PATCH_STRIDE = 144;

struct ALane {
    const LAS float* tab;
    float cwD[4], cbD, ba, bx, ck;
    bf16x8 Ba0, Ba1, Bx0, Bx1;
};
constexpr int PATCH_BYTES = 5120, ASLOT_OFF = 8 * PATCH_BYTES, ATAB_OFF = ASLOT_OFF + 2048, ATAB_BYTES = 1280;
__device__ __forceinline__ void a_setup(Frame& F, int layer, int n, int q, ALane& L) {
    const int c = F.lane & 15, kg = F.lane >> 4, och = 64 * n + 16 * q + c;
    const float* cw = F.in[I_RGCW] + (size_t)layer * 4 * 512; const float* cb = F.in[I_RGCB] + layer * 512;
    LAS float* tab = (LAS float*)(F.lds + RING_OFF + ATAB_OFF + F.wave * ATAB_BYTES);
#pragma unroll
    for (int k = 0; k < 5; ++k) { const int idx = F.lane + 64 * k, tg = idx / 80, rem = idx - 80 * tg, j = rem >> 4, e = rem & 15, ch = 64 * n + (e < 8 ? 8 * tg + e : 32 + 8 * tg + (e - 8));
        tab[idx] = j < 4 ? cw[j * 512 + ch] : cb[ch]; }
    L.tab = tab + 80 * kg;
#pragma unroll
    for (int j = 0; j < 4; ++j) L.cwD[j] = cw[j * 512 + och];
    L.cbD = cb[och]; L.ba = F.in[I_RGBA][layer * 512 + och]; L.bx = F.in[I_RGBX][layer * 512 + och];
    L.ck = 8.0f * softplusf_acc(-F.in[I_LAM][layer * 512 + och]);
    const float* wa = F.in[I_RGWA] + ((size_t)layer * 8 + n) * 4096 + 16 * q + c; const float* wx = F.in[I_RGWX] + ((size_t)layer * 8 + n) * 4096 + 16 * q + c;
    unsigned a0[4], a1[4], x0[4], x1[4];
#pragma unroll
    for (int w = 0; w < 4; ++w) {
        a0[w] = pk2(wa[(8 * kg + 2 * w) * 64], wa[(8 * kg + 2 * w + 1) * 64]); a1[w] = pk2(wa[(32 + 8 * kg + 2 * w) * 64], wa[(32 + 8 * kg + 2 * w + 1) * 64]);
        x0[w] = pk2(wx[(8 * kg + 2 * w) * 64], wx[(8 * kg + 2 * w + 1) * 64]); x1[w] = pk2(wx[(32 + 8 * kg + 2 * w) * 64], wx[(32 + 8 * kg + 2 * w + 1) * 64]); }
    L.Ba0 = __builtin_bit_cast(bf16x8, (v4u){a0[0], a0[1], a0[2], a0[3]}); L.Ba1 = __builtin_bit_cast(bf16x8, (v4u){a1[0], a1[1], a1[2], a1[3]});
    L.Bx0 = __builtin_bit_cast(bf16x8, (v4u){x0[0], x0[1], x0[2], x0[3]}); L.Bx1 = __builtin_bit_cast(bf16x8, (v4u){x1[0], x1[1], x1[2], x1[3]});
    LDS_WAIT(); asm volatile("" ::: "memory");
}
__device__ __forceinline__ void a_block(const ALane& L, const LAS unsigned char* patch, int rowA0, int baseD, int q, int lane, float (&a)[4], float (&bb)[4]) {
    const int c = lane & 15, kg = lane >> 4;
    float x[16];
    { const f32x4 b0 = *(const LAS f32x4*)(L.tab + 64), b1 = *(const LAS f32x4*)(L.tab + 68), b2 = *(const LAS f32x4*)(L.tab + 72), b3 = *(const LAS f32x4*)(L.tab + 76);
#pragma unroll
      for (int e = 0; e < 4; ++e) { x[e] = b0[e]; x[4 + e] = b1[e]; x[8 + e] = b2[e]; x[12 + e] = b3[e]; } }
#pragma unroll
    for (int j = 0; j < 4; ++j) { const LAS unsigned char* rp = patch + (rowA0 + j) * PATCH_STRIDE + 16 * kg;
        const v4u v0 = *(const LAS v4u*)rp, v1 = *(const LAS v4u*)(rp + 64);
        const f32x4 t0 = *(const LAS f32x4*)(L.tab + 16 * j), t1 = *(const LAS f32x4*)(L.tab + 16 * j + 4), t2 = *(const LAS f32x4*)(L.tab + 16 * j + 8), t3 = *(const LAS f32x4*)(L.tab + 16 * j + 12);
#pragma unroll
        for (int w = 0; w < 2; ++w) { x[2 * w] = fmaf(t0[2 * w], bflo(v0[w]), x[2 * w]); x[2 * w + 1] = fmaf(t0[2 * w + 1], bfhi(v0[w]), x[2 * w + 1]);
                                      x[4 + 2 * w] = fmaf(t1[2 * w], bflo(v0[2 + w]), x[4 + 2 * w]); x[5 + 2 * w] = fmaf(t1[2 * w + 1], bfhi(v0[2 + w]), x[5 + 2 * w]);
                                      x[8 + 2 * w] = fmaf(t2[2 * w], bflo(v1[w]), x[8 + 2 * w]); x[9 + 2 * w] = fmaf(t2[2 * w + 1], bfhi(v1[w]), x[9 + 2 * w]);
                                      x[12 + 2 * w] = fmaf(t3[2 * w], bflo(v1[2 + w]), x[12 + 2 * w]); x[13 + 2 * w] = fmaf(t3[2 * w + 1], bfhi(v1[2 + w]), x[13 + 2 * w]); } }
    const bf16x8 A0 = __builtin_bit_cast(bf16x8, (v4u){pk2(x[0], x[1]), pk2(x[2], x[3]), pk2(x[4], x[5]), pk2(x[6], x[7])});
    const bf16x8 A1 = __builtin_bit_cast(bf16x8, (v4u){pk2(x[8], x[9]), pk2(x[10], x[11]), pk2(x[12], x[13]), pk2(x[14], x[15])});
    f32x4 accR = (f32x4){0.f, 0.f, 0.f, 0.f}, accI = (f32x4){0.f, 0.f, 0.f, 0.f};
    accR = __builtin_amdgcn_mfma_f32_16x16x32_bf16(A0, L.Ba0, accR, 0, 0, 0); accR = __builtin_amdgcn_mfma_f32_16x16x32_bf16(A1, L.Ba1, accR, 0, 0, 0);
    accI = __builtin_amdgcn_mfma_f32_16x16x32_bf16(A0, L.Bx0, accI, 0, 0, 0); accI = __builtin_amdgcn_mfma_f32_16x16x32_bf16(A1, L.Bx1, accI, 0, 0, 0);
    float pv[7];
#pragma unroll
    for (int k = 0; k < 7; ++k) pv[k] = bf1(*(const LAS unsigned short*)(patch + (baseD + k) * PATCH_STRIDE + 2 * (16 * q + c)));
#pragma unroll
    for (int r = 0; r < 4; ++r) {
        const float xd = L.cbD + L.cwD[0] * pv[r] + L.cwD[1] * pv[r + 1] + L.cwD[2] * pv[r + 2] + L.cwD[3] * pv[r + 3];
        const float rr = pg8::sigmoidf_fast(accR[r] + L.ba), ii = pg8::sigmoidf_fast(accI[r] + L.bx);
        const float la = -L.ck * rr;
        const float av = __builtin_amdgcn_exp2f(1.44269504089f * la);
        a[r] = av; bb[r] = __builtin_amdgcn_sqrtf(fmaxf(1.f - av * av, 0.f)) * (ii * xd);
    }
}
struct BlkScan { float Ac[4], Bc[4], EA, EB, WA, WB; };
__device__ __forceinline__ void blk_scan(const float (&a)[4], const float (&bb)[4], int lane, BlkScan& S) {
    const int c = lane & 15, g = lane >> 4;
    S.Ac[0] = a[0]; S.Bc[0] = bb[0];
#pragma unroll
    for (int r = 1; r < 4; ++r) { S.Ac[r] = a[r] * S.Ac[r - 1]; S.Bc[r] = a[r] * S.Bc[r - 1] + bb[r]; }
    float IA = S.Ac[3], IB = S.Bc[3];
    { const float pa = shfl_idx(IA, lane - 16), pb = shfl_idx(IB, lane - 16); if (g >= 1) { IB = IA * pb + IB; IA = IA * pa; } }
    { const float pa = shfl_idx(IA, lane - 32), pb = shfl_idx(IB, lane - 32); if (g >= 2) { IB = IA * pb + IB; IA = IA * pa; } }
    S.EA = shfl_idx(IA, lane - 16); S.EB = shfl_idx(IB, lane - 16); if (g == 0) { S.EA = 1.f; S.EB = 0.f; }
    S.WA = shfl_idx(IA, 48 + c); S.WB = shfl_idx(IB, 48 + c);
}
__device__ __forceinline__ void a_prompt_item(Frame& F, int layer, int item, const bf16* Z, bf16* Y) {
    const int b = item >> 5, n = (item >> 2) & 7, q = item & 3, lane = opqv(F.lane), w = F.wave, c = lane & 15, g = lane >> 4, och = 64 * n + 16 * q + c;
    ALane L; a_setup(F, layer, n, q, L);
    LAS unsigned char* patch = F.lds + RING_OFF + w * PATCH_BYTES;
    LAS f32x2* slots = (LAS f32x2*)(F.lds + RING_OFF + ASLOT_OFF);
    const bf16* Zb = Z + (size_t)b * SEQ * ZC;
    float hrun = 0.f;
    v4u pf[5];
    auto load_patch = [&](int tb) {
#pragma unroll
        for (int k = 0; k < 5; ++k) { const int ci = lane + 64 * k, pr = ci >> 3, cc = ci & 7, t = tb - 3 + pr;
            pf[k] = (ci < 280 && t >= 0) ? *(const GAS v4u*)(Zb + (size_t)t * ZC + 64 * n + 8 * cc) : (v4u){0u, 0u, 0u, 0u}; }
    };
    load_patch(32 * w);
    for (int it = 0; it < 8; ++it) {
        const int tb = 256 * it + 32 * w;
#pragma unroll
        for (int k = 0; k < 5; ++k) { const int ci = lane + 64 * k, pr = ci >> 3, cc = ci & 7; if (ci < 280) *(LAS v4u*)(patch + pr * PATCH_STRIDE + 16 * cc) = pf[k]; }
        if (it < 7) load_patch(tb + 256);
        unsigned short gav[8];
#pragma unroll
        for (int r = 0; r < 8; ++r) gav[r] = *(const GAS unsigned short*)(Zb + (size_t)(tb + 16 * (r >> 2) + 4 * g + (r & 3)) * ZC + 512 + och);
        asm volatile("" ::: "memory");
        float a0[4], b0[4], a1[4], b1[4];
        a_block(L, patch, lane & 15, 4 * g, q, lane, a0, b0);
        a_block(L, patch, 16 + (lane & 15), 16 + 4 * g, q, lane, a1, b1);
        BlkScan S0, S1; blk_scan(a0, b0, lane, S0); blk_scan(a1, b1, lane, S1);
        if (lane < 16) slots[((it & 1) * 8 + w) * 16 + c] = (f32x2){S0.WA * S1.WA, S1.WA * S0.WB + S1.WB};
        __syncthreads();
        float hin = hrun, hw = 0.f;
#pragma unroll
        for (int ww = 0; ww < 8; ++ww) { const f32x2 s = slots[((it & 1) * 8 + ww) * 16 + c]; if (ww == w) hw = hin; hin = s.x * hin + s.y; }
        hrun = hin;
        const float hg0 = S0.EA * hw + S0.EB, hw1 = S0.WA * hw + S0.WB, hg1 = S1.EA * hw1 + S1.EB;
#pragma unroll
        for (int r = 0; r < 4; ++r) { const float h = S0.Ac[r] * hg0 + S0.Bc[r];
            *(GAS unsigned short*)(Y + (size_t)(b * SEQ + tb + 4 * g + r) * YC + och) = f2bf(h * bf1(gav[r])); }
#pragma unroll
        for (int r = 0; r < 4; ++r) { const float h = S1.Ac[r] * hg1 + S1.Bc[r];
            *(GAS unsigned short*)(Y + (size_t)(b * SEQ + tb + 16 + 4 * g + r) * YC + och) = f2bf(h * bf1(gav[4 + r]));
            if (r == 3 && it == 7 && w == 7 && g == 3) F.out[O_PH + (size_t)(layer * 8 + b) * 512 + och] = h; }
    }
}
__device__ __forceinline__ void a_sample_task(Frame& F, int layer, int task, const bf16* Z, bf16* Y) {
    const int blk = task >> 5, n = (task >> 2) & 7, q = task & 3, lane = opqv(F.lane), c = lane & 15, g = lane >> 4, och = 64 * n + 16 * q + c, s0 = 4 * blk;
    ALane L; a_setup(F, layer, n, q, L);
    LAS unsigned char* patch = F.lds + RING_OFF + F.wave * PATCH_BYTES;
#pragma unroll
    for (int k = 0; k < 4; ++k) { const int ci = lane + 64 * k; if (ci < 224) { const int pr = ci >> 3, cc = ci & 7, sq = pr / 7, tau = pr - 7 * sq - 3, seq = s0 + sq; v4u v;
            if (tau < 0) { const GAS f32x4* sp = (const GAS f32x4*)(F.in[I_SRGC] + ((size_t)(layer * 128 + seq) * 3 + (tau + 3)) * 512 + 64 * n + 8 * cc); const f32x4 f0 = sp[0], f1 = sp[1];
                v = (v4u){pk2(f0.x, f0.y), pk2(f0.z, f0.w), pk2(f1.x, f1.y), pk2(f1.z, f1.w)}; }
            else v = *(const GAS v4u*)(Z + (size_t)(MP + 4 * seq + tau) * ZC + 64 * n + 8 * cc);
            *(LAS v4u*)(patch + pr * PATCH_STRIDE + 16 * cc) = v; } }
    asm volatile("" ::: "memory");
    float a[4], bb[4];
    a_block(L, patch, 7 * ((lane & 15) >> 2) + (lane & 3), 7 * g, q, lane, a, bb);
    const int seq = s0 + g;
    float h = F.in[I_SH][(size_t)(layer * 128 + seq) * 512 + och];
#pragma unroll
    for (int r = 0; r < 4; ++r) { h = a[r] * h + bb[r]; const size_t row = (size_t)(MP + 4 * seq + r);
        *(GAS unsigned short*)(Y + row * YC + och) = f2bf(h * bf1(*(const GAS unsigned short*)(Z + row * ZC + 512 + och))); }
    F.out[O_SH + (size_t)(layer * 128 + seq) * 512 + och] = h;
}

__device__ __forceinline__ void ln_silu_row(const LAS float* xr, const float* g, const float* b, bf16* dst, int lane) {
    const f32x4 v0 = *(const LAS f32x4*)(xr + 4 * lane), v1 = *(const LAS f32x4*)(xr + 256 + 4 * lane);
    const float s = (v0.x + v0.y) + (v0.z + v0.w) + (v1.x + v1.y) + (v1.z + v1.w);
    const float mean = wave_sum(s, lane) * (1.f / 512.f);
    const f32x4 d0 = v0 - mean, d1 = v1 - mean;
    const float s2 = (d0.x * d0.x + d0.y * d0.y) + (d0.z * d0.z + d0.w * d0.w) + (d1.x * d1.x + d1.y * d1.y) + (d1.z * d1.z + d1.w * d1.w);
    const float rstd = __builtin_amdgcn_rsqf(wave_sum(s2, lane) * (1.f / 512.f) + LN_EPS);
    const f32x4 g0 = *(const GAS f32x4*)(g + 4 * lane), g1 = *(const GAS f32x4*)(g + 256 + 4 * lane), b0 = *(const GAS f32x4*)(b + 4 * lane), b1 = *(const GAS f32x4*)(b + 256 + 4 * lane);
    f32x4 y0 = d0 * rstd * g0 + b0, y1 = d1 * rstd * g1 + b1;
#pragma unroll
    for (int i = 0; i < 4; ++i) { y0[i] = y0[i] * pg8::sigmoidf_fast(y0[i]); y1[i] = y1[i] * pg8::sigmoidf_fast(y1[i]); }
    *(GAS v2u*)(dst + 4 * lane) = (v2u){pk2(y0.x, y0.y), pk2(y0.z, y0.w)}; *(GAS v2u*)(dst + 256 + 4 * lane) = (v2u){pk2(y1.x, y1.y), pk2(y1.z, y1.w)};
}
__device__ __forceinline__ void b_prompt_item(Frame& F, int layer, int item, const bf16* Z, bf16* Y) {
    const int tidl = opqv(F.tid), b = item >> 5, t0 = 64 * (item & 31), p = tidl & 255, hh = tidl >> 8, ts = t0 + 32 * hh;
    const GAS unsigned* Zu = (const GAS unsigned*)(Z + (size_t)b * SEQ * ZC) + 512 + p;
    unsigned raw[62];
#pragma unroll
    for (int i = 0; i < 62; ++i) { const int t = ts - 30 + i; raw[i] = t >= 0 ? Zu[(size_t)t * (ZC / 2)] : 0u; }
    const float* cw = F.in[I_CFW] + (size_t)layer * 31 * 512 + 2 * p;
    f32x2 wj[31];
#pragma unroll
    for (int j = 0; j < 31; ++j) wj[j] = *(const GAS f32x2*)(cw + j * 512);
    const f32x2 bias = *(const GAS f32x2*)(F.in[I_CFB] + layer * 512 + 2 * p);
    f32x2 in[62];
#pragma unroll
    for (int i = 0; i < 62; ++i) in[i] = (f32x2){bflo(raw[i]), bfhi(raw[i])};
    LAS float* obuf = (LAS float*)(F.lds + RING_OFF);
#pragma unroll
    for (int i = 0; i < 32; ++i) { f32x2 o = bias;
#pragma unroll
        for (int j = 0; j < 31; ++j) o += wj[j] * in[i + j];
        *(LAS f32x2*)(obuf + (32 * hh + i) * 512 + 2 * p) = o; }
    __syncthreads();
    const float* lg = F.in[I_CFG] + layer * 512; const float* lb = F.in[I_CFBB] + layer * 512;
#pragma unroll 1
    for (int r = F.wave; r < 64; r += 8) ln_silu_row(obuf + r * 512, lg, lb, Y + (size_t)(b * SEQ + t0 + r) * YC + 512, F.lane);
}
__device__ __forceinline__ void cd_prompt_item(Frame& F, int layer, int item, const bf16* Z, bf16* Y) {
    const int tidl = opqv(F.tid), b = item >> 5, t0 = 64 * (item & 31), p = tidl & 255, hh = tidl >> 8;
    const bf16* Zb = Z + (size_t)b * SEQ * ZC;
    LAS unsigned* cbuf = (LAS unsigned*)(F.lds + RING_OFF);
    for (int ci = tidl; ci < 79 * 64; ci += 512) { const int pr = ci >> 6, cc = ci & 63, t = t0 - 15 + pr;
        const v4u v = t >= 0 ? *(const GAS v4u*)(Zb + (size_t)t * ZC + 1536 + 8 * cc) : (v4u){0u, 0u, 0u, 0u};
        *(LAS v4u*)(cbuf + pr * 256 + 4 * cc) = v; }
    const int ts = t0 + 32 * hh;
    unsigned uu[34], dd[32];
#pragma unroll
    for (int i = 0; i < 34; ++i) { const int t = ts - 2 + i; uu[i] = t >= 0 ? ((const GAS unsigned*)(Zb + (size_t)t * ZC))[1280 + p] : 0u; }
#pragma unroll
    for (int i = 0; i < 32; ++i) dd[i] = ((const GAS unsigned*)(Zb + (size_t)(ts + i) * ZC))[1024 + p];
    const f32x2 w0 = ((const GAS f32x2*)(F.in[I_SCW] + (size_t)(layer * 3 + 0) * 512))[p], w1 = ((const GAS f32x2*)(F.in[I_SCW] + (size_t)(layer * 3 + 1) * 512))[p],
                w2 = ((const GAS f32x2*)(F.in[I_SCW] + (size_t)(layer * 3 + 2) * 512))[p];
    __syncthreads();
    const int w = 2 << (p >> 6), rr0 = 15 + 32 * hh;
    f32x2 s = (f32x2){0.f, 0.f};
    for (int j = 0; j < w; ++j) { const unsigned v = cbuf[(rr0 - j) * 256 + p]; s += (f32x2){bflo(v), bfhi(v)}; }
    GAS unsigned* Yu = (GAS unsigned*)(Y + (size_t)(b * SEQ + ts) * YC) + p;
#pragma unroll
    for (int i = 0; i < 32; ++i) { const int t = ts + i, rr = rr0 + i;
        const unsigned cur = cbuf[rr * 256 + p]; const f32x2 cf = (f32x2){bflo(cur), bfhi(cur)};
        if (i > 0) { const unsigned old = cbuf[(rr - w) * 256 + p]; s += cf - (f32x2){bflo(old), bfhi(old)}; }
        const float ic = __builtin_amdgcn_rcpf((float)(t + 1 < w ? t + 1 : w));
        const f32x2 mm = s * ic - cf;
        Yu[(size_t)i * 1024 + 512] = pk2(mm.x, mm.y);
        const f32x2 cv = w0 * (f32x2){bflo(uu[i]), bfhi(uu[i])} + w1 * (f32x2){bflo(uu[i + 1]), bfhi(uu[i + 1])} + w2 * (f32x2){bflo(uu[i + 2]), bfhi(uu[i + 2])};
        const f32x2 yd = (f32x2){bflo(dd[i]), bfhi(dd[i])} * cv;
        Yu[(size_t)i * 1024 + 768] = pk2(yd.x, yd.y); }
}
__device__ __forceinline__ void s_sample_item(Frame& F, int layer, int s, const bf16* Z, bf16* Y) {
    const int ch = opqv(F.tid); const size_t ls = (size_t)layer * 128 + s;
    const bf16* Zr = Z + (size_t)(MP + 4 * s) * ZC; bf16* Yr = Y + (size_t)(MP + 4 * s) * YC;
    LAS float* obuf = (LAS float*)(F.lds + RING_OFF);
    float in[34], wv[31], pb[19], u[6], dbv[4];
#pragma unroll
    for (int j = 0; j < 30; ++j) in[j] = (F.in[I_SCF] + (ls * 30 + j) * 512)[ch];
#pragma unroll
    for (int j = 0; j < 15; ++j) pb[j] = (F.in[I_SPOOL] + (ls * 15 + j) * 512)[ch];
    u[0] = (F.in[I_SSC] + (ls * 2 + 0) * 512)[ch]; u[1] = (F.in[I_SSC] + (ls * 2 + 1) * 512)[ch];
#pragma unroll
    for (int r = 0; r < 4; ++r) { in[30 + r] = bf1((Zr + (size_t)r * ZC + 1024)[ch]); pb[15 + r] = bf1((Zr + (size_t)r * ZC + 1536)[ch]); u[2 + r] = bf1((Zr + (size_t)r * ZC + 2560)[ch]); dbv[r] = bf1((Zr + (size_t)r * ZC + 2048)[ch]); }
#pragma unroll
    for (int j = 0; j < 31; ++j) wv[j] = (F.in[I_CFW] + ((size_t)layer * 31 + j) * 512)[ch];
    const float bias = (F.in[I_CFB] + layer * 512)[ch];
    const float w0 = (F.in[I_SCW] + (size_t)(layer * 3 + 0) * 512)[ch], w1 = (F.in[I_SCW] + (size_t)(layer * 3 + 1) * 512)[ch], w2 = (F.in[I_SCW] + (size_t)(layer * 3 + 2) * 512)[ch];
    asm volatile("" ::: "memory");
#pragma unroll
    for (int j = 0; j < 26; ++j) (F.out + O_SCF + (ls * 30 + j) * 512)[ch] = in[j + 4];
#pragma unroll
    for (int r = 0; r < 4; ++r) { float o = bias;
#pragma unroll
        for (int j = 0; j < 31; ++j) o += wv[j] * in[r + j];
        obuf[r * 512 + ch] = o; }
#pragma unroll
    for (int j = 0; j < 11; ++j) (F.out + O_SPOOL + (ls * 15 + j) * 512)[ch] = pb[j + 4];
    const int gsel = ch >> 7;
#pragma unroll
    for (int r = 0; r < 4; ++r) { const int k = 15 + r;
        const float s2 = pb[k] + pb[k - 1], s4 = s2 + pb[k - 2] + pb[k - 3], s8 = s4 + (pb[k - 4] + pb[k - 5]) + (pb[k - 6] + pb[k - 7]);
        float s16 = s8;
#pragma unroll
        for (int j = 8; j < 16; ++j) s16 += pb[k - j];
        const float mv = (gsel == 0 ? s2 * 0.5f : gsel == 1 ? s4 * 0.25f : gsel == 2 ? s8 * 0.125f : s16 * 0.0625f) - pb[k];
        (Yr + (size_t)r * YC + 1024)[ch] = f2bf(mv); }
#pragma unroll
    for (int r = 0; r < 4; ++r) (Yr + (size_t)r * YC + 1536)[ch] = f2bf(dbv[r] * (w0 * u[r] + w1 * u[r + 1] + w2 * u[r + 2]));
    __syncthreads();
    if (F.wave < 4) ln_silu_row(obuf + F.wave * 512, F.in[I_CFG] + layer * 512, F.in[I_CFBB] + layer * 512, Yr + (size_t)F.wave * YC + 512, F.lane);
}

struct Args { const float* in[31]; float* out; unsigned char* ws; int ph_lo, ph_hi; };
__global__ void __launch_bounds__(NWAVES * 64, 2) hybrid_fwd(Args args) {
    extern __shared__ __attribute__((aligned(16))) unsigned char lds[];
    Frame F;
    F.lds = (LAS unsigned char*)lds;
    F.MISC = (volatile LAS unsigned*)(F.lds + MISC_OFF);
    const int wave0 = __builtin_amdgcn_readfirstlane((int)threadIdx.x >> 6);
    F.lane = lane_now(); F.wave = wave0; F.tid = F.wave * 64 + F.lane;
    F.G = gridDim.x; F.bid = blockIdx.x;
    F.ws = args.ws; F.out = args.out; F.ctl = (gu32*)(args.ws + WS_CTL);
    F.in = args.in;
    for (int u = F.tid; u < (LDS_BYTES - LDSCTL_OFF) / 4; u += NWAVES * 64) ((LAS unsigned*)(F.lds + LDSCTL_OFF))[u] = 0u;
    __syncthreads();
    XcdBarrier bar; bar.bar = (unsigned*)(F.ctl + CW_BAR); bar.x = 0; bar.st = nullptr;
    if (!MK_SPLIT) bar = xcd_barrier_post((unsigned*)(F.ctl + CW_BAR), F.MISC + 8);
    const int lo = args.ph_lo, hi = args.ph_hi;
#define IN(k) (lo <= (k) && (k) < hi)
#define REFRESH() do { F.lane = lane_now(); F.wave = opqs(wave0); F.tid = F.wave * 64 + F.lane; F.bid = opqs((int)blockIdx.x); } while (0)
#define SEAM(k) do { if (IN(k) && IN((k) + 1)) xcd_barrier(bar); } while (0)
    bf16* WA = (bf16*)(F.ws + WS_WA); bf16* XB = (bf16*)(F.ws + WS_XB); bf16* Y = (bf16*)(F.ws + WS_Y); bf16* Zm = (bf16*)(F.ws + WS_ZG); _Float16* Gb = (_Float16*)(F.ws + WS_ZG);
    bf16* Hb = (bf16*)(F.ws + WS_ZG); bf16* Bt3 = (bf16*)(F.ws + WS_BT3); bf16* Bt4 = (bf16*)(F.ws + WS_BT4); bf16* Bt5 = (bf16*)(F.ws + WS_BT5); bf16* Bt6 = (bf16*)(F.ws + WS_BT6);

    if (IN(0)) { REFRESH(); convert_matrix<RM_WIN>(F, F.in[I_WIN], DM, INC, WA, DM, 0, 0, F.bid * NWAVES + F.wave, F.G * NWAVES); REFRESH(); x_to_bf16(F, XB); }
    SEAM(0);

    for (int l = 0; l < 2; ++l) {
        const int pb = 1 + 9 * l;
        if (IN(pb + 0)) for (int rep = 0; rep < NREP(0); ++rep) { if (rep) xcd_barrier(bar); pg8::Gemm g{XB, WA, DM, DM}; pg8::UnitOrder S; S.init(pg8::SK_PLAIN, 4096, DM, F.G, F.bid, 0); pg8::EpiMix E{Zm, F.out, l};
            pg8::gemm_phase<pg8::EpiMix, pg8::UnitOrder, true>(F.lds + RING_OFF, g, S, E, wave0);
            if (F.G == 256 && F.bid >= 32) {
                REFRESH(); const int gw = (F.bid - 32) * NWAVES + F.wave, NGW = 224 * NWAVES; const float* wbr = F.in[I_WBR] + (size_t)l * 4 * 512 * 1024;
                convert_matrix<RM_ID>(F, wbr, 512, 1024, Bt3, 2048, 0, 0, gw, NGW, 0);
                convert_matrix<RM_ID>(F, wbr + (size_t)512 * 1024, 512, 1024, Bt3, 2048, 512, 0, gw, NGW, 256);
                convert_matrix<RM_ID>(F, wbr + (size_t)3 * 512 * 1024, 512, 1024, Bt3, 2048, 1536, 0, gw, NGW, 512);
                convert_matrix<RM_ID>(F, F.in[I_WOUT] + (size_t)l * DM * DM, DM, DM, Bt4, DM, 0, 0, gw, NGW, 768);
                REFRESH(); compose_pool(F, l, Bt3, gw, NGW, 1280); } }
        SEAM(pb + 0);
        if (IN(pb + 1)) for (int rep = 0; rep < NREP(1); ++rep) { if (rep) xcd_barrier(bar);
            __syncthreads(); REFRESH();
            for (int r2 = 0; r2 < NREP2(0); ++r2) for (int it = F.bid; it < 256; it += F.G) { a_prompt_item(F, l, it, Zm, Y); __syncthreads(); }
            REFRESH();
            for (int r2 = 0; r2 < NREP2(1); ++r2) for (int it = (F.bid + 128) % F.G; it < 128; it += F.G) a_sample_task(F, l, 8 * it + F.wave, Zm, Y);
            __syncthreads(); REFRESH();
            const bool rebal = F.G == 256, gemm_wg = rebal && F.bid >= 128 && F.bid < 160;
            for (int r2 = 0; r2 < NREP2(2); ++r2) { if (!gemm_wg) for (int it = F.bid; it < 256; it += F.G) { b_prompt_item(F, l, it, Zm, Y); __syncthreads(); }
                if (rebal && F.bid >= 160 && F.bid < 192) { b_prompt_item(F, l, F.bid - 32, Zm, Y); __syncthreads(); } }
            REFRESH();
            for (int r2 = 0; r2 < NREP2(3); ++r2) { if (!gemm_wg) for (int it = F.bid; it < 256; it += F.G) { cd_prompt_item(F, l, it, Zm, Y); __syncthreads(); }
                if (rebal && F.bid >= 192 && F.bid < 224) { cd_prompt_item(F, l, F.bid - 64, Zm, Y); __syncthreads(); } }
            REFRESH();
            for (int r2 = 0; r2 < NREP2(4); ++r2) for (int it = F.bid; it < 128; it += F.G) { s_sample_item(F, l, it, Zm, Y); __syncthreads(); }
            if (F.G == 256 && F.bid >= 128 && F.bid < 160) {
                pg8::Gemm g{XB, WA + (size_t)4096 * DM, DM, DM}; pg8::UnitOrder S; S.init(pg8::SK_PLAIN, 4096, DM, 32, F.bid - 128, 0, false, true); pg8::EpiGate E{Gb};
                pg8::gemm_phase<pg8::EpiGate, pg8::UnitOrder, true>(F.lds + RING_OFF, g, S, E, wave0); }
            REFRESH();
            const float* wbr = F.in[I_WBR] + (size_t)l * 4 * 512 * 1024;
            if (F.G != 256) { const int gw = F.bid * NWAVES + F.wave, NGW = F.G * NWAVES;
                convert_matrix<RM_ID>(F, wbr, 512, 1024, Bt3, 2048, 0, 0, gw, NGW); convert_matrix<RM_ID>(F, wbr + (size_t)512 * 1024, 512, 1024, Bt3, 2048, 512, 0, gw, NGW);
                convert_matrix<RM_ID>(F, wbr + (size_t)3 * 512 * 1024, 512, 1024, Bt3, 2048, 1536, 0, gw, NGW); convert_matrix<RM_ID>(F, F.in[I_WOUT] + (size_t)l * DM * DM, DM, DM, Bt4, DM, 0, 0, gw, NGW);
                REFRESH(); compose_pool(F, l, Bt3, gw, NGW); }
        }
        SEAM(pb + 1);
        if (IN(pb + 2)) for (int rep = 0; rep < NREP(2); ++rep) { if (rep) xcd_barrier(bar); pg8::Gemm g{XB, WA + (size_t)4096 * DM, DM, DM}; pg8::UnitOrder S; S.init(pg8::SK_PLAIN, 4096, DM, F.G, F.bid, 0, true, F.G != 256); pg8::EpiGate E{Gb};
            pg8::gemm_phase<pg8::EpiGate, pg8::UnitOrder, true>(F.lds + RING_OFF, g, S, E, wave0); }
        SEAM(pb + 2);
        if (IN(pb + 3)) for (int rep = 0; rep < NREP(3); ++rep) { if (rep) xcd_barrier(bar); pg8::Gemm g{Y, Bt3, 2048, 2048}; pg8::UnitOrder S; S.init(pg8::SK_P3, DM, 2048, F.G, F.bid, 0); pg8::EpiMerge E{Gb, XB, (bf16*)(F.ws + WS_MB4S)};
            pg8::gemm_phase<pg8::EpiMerge, pg8::UnitOrder, true>(F.lds + RING_OFF, g, S, E, wave0); }
        SEAM(pb + 3);
        if (IN(pb + 4)) for (int rep = 0; rep < NREP(4); ++rep) { if (rep) xcd_barrier(bar); pg8::Gemm g{XB, Bt4, DM, DM}; pg8::UnitOrder S; S.init(pg8::SK_P4, DM, DM, F.G, F.bid, (long)(WS_MB4S - WS_XB));
            pg8::EpiRes E{l == 0 ? F.in[I_XP] : F.out, l == 0 ? F.in[I_XS] : F.out + (size_t)MP * DM, rep + 1 < NREP(4) ? (float*)(F.ws + WS_ZG) : F.out, (float*)(F.ws + WS_SLAB)};
            pg8::gemm_phase<pg8::EpiRes, pg8::UnitOrder, true>(F.lds + RING_OFF, g, S, E, wave0);
            if (F.G == 256 && F.bid >= 64 && rep + 1 == NREP(4)) {
                REFRESH(); const int gw = (F.bid - 64) * NWAVES + F.wave, NGW = 192 * NWAVES;
                convert_matrix<RM_GU>(F, F.in[I_WG] + (size_t)l * DM * FF, DM, FF, Bt5, DM, 0, 0, gw, NGW, 0);
                convert_matrix<RM_GU>(F, F.in[I_WU] + (size_t)l * DM * FF, DM, FF, Bt5, DM, 0, 128, gw, NGW, 1408);
                convert_matrix<RM_ID>(F, F.in[I_WD] + (size_t)l * FF * DM, FF, DM, Bt6, FF, 0, 0, gw, NGW, 2816); } }
        SEAM(pb + 4);
        if (IN(pb + 5)) for (int rep = 0; rep < NREP(5); ++rep) { if (rep) xcd_barrier(bar);
            REFRESH();
            ln_rows(F, F.out, rep + 1 < NREP(5) ? (float*)(F.ws + WS_Y) : F.out, F.in[I_LN1G] + l * DM, F.in[I_LN1B] + l * DM, rep + 1 < NREP(5) ? nullptr : XB, l == 0 ? F.in[I_XS] : F.out + (size_t)MP * DM, (const float*)(F.ws + WS_SLAB), 8);
            REFRESH();
            if (F.G != 256) { const int gw = F.bid * NWAVES + F.wave, NGW = F.G * NWAVES;
                convert_matrix<RM_GU>(F, F.in[I_WG] + (size_t)l * DM * FF, DM, FF, Bt5, DM, 0, 0, gw, NGW); convert_matrix<RM_GU>(F, F.in[I_WU] + (size_t)l * DM * FF, DM, FF, Bt5, DM, 0, 128, gw, NGW);
                convert_matrix<RM_ID>(F, F.in[I_WD] + (size_t)l * FF * DM, FF, DM, Bt6, FF, 0, 0, gw, NGW); }
        }
        SEAM(pb + 5);
        if (IN(pb + 6)) for (int rep = 0; rep < NREP(6); ++rep) { if (rep) xcd_barrier(bar); pg8::Gemm g{XB, Bt5, DM, DM}; pg8::UnitOrder S; S.init(pg8::SK_PLAIN, 2 * FF, DM, F.G, F.bid, 0); pg8::EpiSwi E{Hb};
            pg8::gemm_phase<pg8::EpiSwi, pg8::UnitOrder, true>(F.lds + RING_OFF, g, S, E, wave0);
            if (F.G == 256 && F.bid >= 172 && l == 0 && rep + 1 == NREP(6)) {
                REFRESH(); convert_matrix<RM_WIN>(F, F.in[I_WIN] + (size_t)DM * INC, DM, INC, WA, DM, 0, 0, (F.bid - 172) * NWAVES + F.wave, 84 * NWAVES); } }
        SEAM(pb + 6);
        if (IN(pb + 7)) for (int rep = 0; rep < NREP(7); ++rep) { if (rep) xcd_barrier(bar); pg8::Gemm g{Hb, Bt6, FF, FF}; pg8::UnitOrder S; S.init(pg8::SK_P6, DM, FF, F.G, F.bid, 0); pg8::EpiRes E{F.out, F.out + (size_t)MP * DM, F.out, (float*)(F.ws + WS_SLAB)};
            pg8::gemm_phase<pg8::EpiRes, pg8::UnitOrder, true>(F.lds + RING_OFF, g, S, E, wave0); }
        SEAM(pb + 7);
        if (IN(pb + 8)) for (int rep = 0; rep < NREP(8); ++rep) { if (rep) xcd_barrier(bar);
            REFRESH();
            ln_rows(F, F.out, rep + 1 < NREP(8) ? (float*)(F.ws + WS_Y) : F.out, F.in[I_LN2G] + l * DM, F.in[I_LN2B] + l * DM, (l == 0 && rep + 1 == NREP(8)) ? XB : nullptr, F.out + (size_t)MP * DM, (const float*)(F.ws + WS_SLAB), 11);
            REFRESH();
            if (l == 0 && F.G != 256) convert_matrix<RM_WIN>(F, F.in[I_WIN] + (size_t)DM * INC, DM, INC, WA, DM, 0, 0, F.bid * NWAVES + F.wave, F.G * NWAVES);
        }
        if (l == 0) SEAM(pb + 8);
    }
#undef IN
#undef SEAM
#undef REFRESH
}

extern "C" void kernel_launch(void* const* d_in, const int* in_sizes, int n_in, void* d_out, int out_size, void* d_ws, size_t ws_size, hipStream_t stream) {
    static int grid = 0;
    if (grid == 0) {
        if (n_in != 31 || out_size != (int)O_END || ws_size < WS_END) { fprintf(stderr, "kernel_launch: unexpected sizes n_in %d out %d ws %zu\n", n_in, out_size, ws_size); grid = -1; return; }
        int dev = 0, cus = 0, per_cu = 0;
        if (hipGetDevice(&dev) != hipSuccess || hipDeviceGetAttribute(&cus, hipDeviceAttributeMultiprocessorCount, dev) != hipSuccess) { grid = -1; return; }
        if (hipFuncSetAttribute((const void*)hybrid_fwd, hipFuncAttributeMaxDynamicSharedMemorySize, LDS_BYTES) != hipSuccess) { fprintf(stderr, "kernel_launch: hipFuncSetAttribute failed\n"); grid = -1; return; }
        if (hipOccupancyMaxActiveBlocksPerMultiprocessor(&per_cu, (const void*)hybrid_fwd, NWAVES * 64, LDS_BYTES) != hipSuccess || per_cu < 1)
            fprintf(stderr, "kernel_launch: occupancy query reports %d workgroups per CU\n", per_cu);
        (void)hipGetLastError();
        grid = cus;
    }
    if (grid < 0) return;
    if (hipMemsetAsync((char*)d_ws + WS_CTL, 0, CTL_ZERO_BYTES, stream) != hipSuccess) { fprintf(stderr, "kernel_launch: memset failed\n"); return; }
    Args a{};
    for (int i = 0; i < 31; ++i) a.in[i] = (const float*)d_in[i];
    a.out = (float*)d_out; a.ws = (unsigned char*)d_ws;
#if MK_SPLIT
    for (int ph = 0; ph < NPHASE; ++ph) { a.ph_lo = ph; a.ph_hi = ph + 1; hipLaunchKernelGGL(hybrid_fwd, dim3(grid), dim3(NWAVES * 64), LDS_BYTES, stream, a); }
#else
    a.ph_lo = 0; a.ph_hi = NPHASE;
    hipLaunchKernelGGL(hybrid_fwd, dim3(grid), dim3(NWAVES * 64), LDS_BYTES, stream, a);
#endif
}
```

```cpp
#include <hip/hip_runtime.h>
#include <cstdio>
#include <cstdint>

#ifndef PROBE_REP
#define PROBE_REP 0
#endif
#define NREP(k) (1 + ((PROBE_REP >> (k)) & 1))
#ifndef PROBE2
#define PROBE2 0
#endif
#define NREP2(j) (1 + ((PROBE2 >> (j)) & 1))
#ifndef MK_SPLIT
#define MK_SPLIT 0
#endif

constexpr int DM = 1024, WMIX = 512, NPB = 8, SEQ = 2048, NSB = 128, DSEQ = 4;
constexpr int MP = NPB * SEQ, MS = NSB * DSEQ, M = MP + MS;
constexpr int FF = 2816, INC = 8192, ZC = 3072, YC = 2048, GC = 4096;
constexpr float LN_EPS = 1e-5f, ALPHA = 1.41421356237f;
constexpr size_t O_Y = 0, O_PH = (size_t)M * DM, O_PRGC = O_PH + 8192, O_PCF = O_PRGC + 24576, O_PPOOL = O_PCF + 245760, O_PSC = O_PPOOL + 122880,
                 O_SH = O_PSC + 16384, O_SRGC = O_SH + 131072, O_SCF = O_SRGC + 393216, O_SPOOL = O_SCF + 3932160, O_SSC = O_SPOOL + 1966080, O_END = O_SSC + 262144;
static_assert(O_END == 24403968, "output map");

__device__ __forceinline__ int opqv(int v) { asm volatile("" : "+v"(v)); return v; }
__device__ __forceinline__ int lane_now() { int l; asm volatile("v_mbcnt_lo_u32_b32 %0, -1, 0\n\tv_mbcnt_hi_u32_b32 %0, -1, %0" : "=v"(l)); return l; }
__device__ __forceinline__ int opqs(int v) { asm volatile("" : "+s"(v)); return v; }
namespace pg8 {
#define PG8_LAS __attribute__((address_space(3)))
typedef unsigned short bf16_t;
typedef short bf16x8 __attribute__((ext_vector_type(8)));
typedef float f32x4 __attribute__((ext_vector_type(4)));
typedef float f32x2 __attribute__((ext_vector_type(2)));
typedef unsigned u32x4 __attribute__((ext_vector_type(4)));
typedef unsigned u32x2 __attribute__((ext_vector_type(2)));
typedef _Float16 f16x4 __attribute__((ext_vector_type(4)));
typedef _Float16 f16x8 __attribute__((ext_vector_type(8)));
constexpr int BM = 256, BK = 64, HALF = 128, HTB = HALF * BK * 2, STAGE_BYTES = 8 * HTB, NXCD = 8, WGM = 8;

__host__ __device__ __forceinline__ int lds_byte(int r, int c) { const int st = (r >> 4) * 2 + (c >> 5), rr = r & 15, cc = c & 31, ob = rr * 64 + cc * 2; return st * 1024 + (ob ^ (((ob >> 9) & 1) << 5)); }
__host__ __device__ __forceinline__ void stage_rc(int b, int& R, int& C) { const int st = b / 1024, sb = b % 1024, swz = sb ^ (((sb >> 9) & 1) << 5); R = (st >> 1) * 16 + swz / 64; C = (st & 1) * 32 + (swz % 64) / 2; }
__host__ __device__ __forceinline__ int perm32(int rho) { const int n = rho >> 4, i = rho & 15; return 8 * (i >> 2) + 4 * n + (i & 3); }

struct Unit { int pm, pn, nt, mode, aux; long offA, offB; };
struct Gemm { const bf16_t* A; const bf16_t* Bt; int lda, ldb; };

enum { SK_PLAIN = 0, SK_P3 = 1, SK_P4 = 2, SK_P6 = 3 };
struct UnitOrder {
    int kind, nN, nwgP, nS, ntP, G, c; long offA_s;
    __device__ __forceinline__ void init(int kind_, int N_, int K_, int G_, int c_, long offA_s_, bool prompt = true, bool sample = true) { kind = kind_; nN = N_ / BM; nwgP = prompt ? 64 * nN : 0; ntP = K_ / BK; G = G_; c = c_; offA_s = offA_s_;
        nS = !sample ? 0 : kind_ == SK_PLAIN ? 2 * nN : kind_ == SK_P3 ? 32 : kind_ == SK_P4 ? 64 : 88; }
    __device__ __forceinline__ bool next(int i, Unit& u, const Gemm& g) const {
        const long L = (long)i * G + c; const long ra = (long)BM * g.lda * 2, rb = (long)BM * g.ldb * 2;
        if (L < nwgP) {
            int wgid = (int)L; { const int q = nwgP / NXCD, xcd = wgid % NXCD, off = wgid / NXCD; wgid = xcd * q + off; }
            const int nig = WGM * nN; u.pm = (wgid / nig) * WGM + ((wgid % nig) % WGM); u.pn = (wgid % nig) / WGM;
            u.nt = ntP; u.mode = 0; u.aux = 0; u.offA = u.pm * ra; u.offB = u.pn * rb; return true; }
        const int s = (int)(L - nwgP); if (s >= nS) return false;
        if (kind == SK_PLAIN) { u.pm = 64 + (s & 1); u.pn = s >> 1; u.nt = ntP; u.mode = 0; u.aux = 0; u.offA = u.pm * ra; u.offB = u.pn * rb; }
        else if (kind == SK_P3) { const int n = s & 3, tile = s >> 2; u.pm = 64 + (tile & 1); u.pn = tile >> 1; u.nt = 8; u.mode = 1; u.aux = n; u.offA = u.pm * ra + 1024 * n; u.offB = u.pn * rb + 1024 * n; }
        else if (kind == SK_P4) { const int ch = s & 7, tile = s >> 3, n = ch >> 1, kin = (ch & 1) * 512; u.pm = 64 + (tile & 1); u.pn = tile >> 1; u.nt = 8; u.mode = 1; u.aux = ch;
            u.offA = offA_s + ((long)(n * 512 + (u.pm - 64) * 256) * 1024 + kin) * 2; u.offB = u.pn * rb + kin * 2; }
        else { const int ch = s % 11, tile = s / 11; u.pm = 64 + (tile & 1); u.pn = tile >> 1; u.nt = 4; u.mode = 1; u.aux = ch; u.offA = u.pm * ra + 512 * ch; u.offB = u.pn * rb + 512 * ch; }
        return true;
    }
};

__device__ __forceinline__ unsigned cvt_pk_bf16(float lo, float hi) { unsigned r; asm volatile("v_cvt_pk_bf16_f32 %0, %1, %2" : "=v"(r) : "v"(lo), "v"(hi)); return r; }
__device__ __forceinline__ float sigmoidf_fast(float x) { return __builtin_amdgcn_rcpf(1.0f + __builtin_amdgcn_exp2f(-1.44269504089f * x)); }
__device__ __forceinline__ float gelu_tanh(float x) { const float t = x * x, y = x * fmaf(t, -0.10294324f, -2.3022082f); return x * __builtin_amdgcn_rcpf(1.0f + __builtin_amdgcn_exp2f(y)); }

__device__ __forceinline__ void acc_zero(f32x4 (&acc)[2][2][4][2]) {
#pragma unroll
    for (int a = 0; a < 2; ++a)
#pragma unroll
        for (int b = 0; b < 2; ++b)
#pragma unroll
            for (int m = 0; m < 4; ++m)
#pragma unroll
                for (int n = 0; n < 2; ++n) acc[a][b][m][n] = (f32x4){0.f, 0.f, 0.f, 0.f};
}
__device__ __forceinline__ float* state_ptr(float* out, int R, int keep, int layer, size_t p_off, size_t s_off) {
    if (R < MP) { const int b = R >> 11, j = (R & 2047) - (2048 - keep); return j < 0 ? nullptr : out + p_off + (size_t)((layer * 8 + b) * keep + j) * 512; }
    const int s = (R - MP) >> 2, j = (R & 3) + keep - 4; return j < 0 ? nullptr : out + s_off + (size_t)((layer * 128 + s) * keep + j) * 512;
}

struct EpiMix {
    static constexpr bool PERM = true, MIDK = false;
    __device__ __forceinline__ void init(f32x4 (&acc)[2][2][4][2], const Unit&, int, int) const { acc_zero(acc); }
    bf16_t* Z; float* out; int layer;
    __device__ __forceinline__ void midk(f32x4 (&)[2][2][4][2], const Unit&, int, int, int, int, int) const {}
    __device__ __forceinline__ void operator()(f32x4 (&acc)[2][2][4][2], const Unit& u, int wr, int wc, int fr_, int fq_) const {
        const int lane_ = lane_now(), fr = lane_ & 15, fq = lane_ >> 4; (void)fr_; (void)fq_;
        const int pn = u.pn; int type, zcol, keep = 0, scol = 0; size_t poff = 0, soff = 0;
        if (pn < 2) { type = 0; zcol = 256 * pn; keep = 3; scol = zcol; poff = O_PRGC; soff = O_SRGC; }
        else if (pn < 4) { type = 1; zcol = 512 + 256 * (pn - 2); }
        else if (pn < 8) { type = 2; zcol = 1024 + 128 * (pn - 4); keep = 30; scol = 128 * (pn - 4); poff = O_PCF; soff = O_SCF; }
        else if (pn < 10) { type = 0; zcol = 1536 + 256 * (pn - 8); keep = 15; scol = 256 * (pn - 8); poff = O_PPOOL; soff = O_SPOOL; }
        else if (pn < 12) { type = 0; zcol = 2048 + 256 * (pn - 10); }
        else { type = 3; zcol = 2560 + 128 * (pn - 12); keep = 2; scol = 128 * (pn - 12); poff = O_PSC; soff = O_SSC; }
        const bool tail = keep != 0 && (u.pm >= 64 || (u.pm & 7) == 7);
        const int row0 = u.pm * BM + wr * 64 + fr, cl = wc * 32 + 8 * fq;
        if (type < 2) {
#pragma unroll
            for (int ai = 0; ai < 2; ++ai)
#pragma unroll
                for (int m = 0; m < 4; ++m) { const int R = row0 + ai * HALF + m * 16; bf16_t* rowp = Z + (size_t)R * ZC + zcol + cl;
                    float* sp = tail ? state_ptr(out, R, keep, layer, poff, soff) : nullptr;
#pragma unroll
                    for (int bj = 0; bj < 2; ++bj) { f32x4 v0 = acc[ai][bj][m][0], v1 = acc[ai][bj][m][1];
                        if (type == 1) { v0 = (f32x4){gelu_tanh(v0[0]), gelu_tanh(v0[1]), gelu_tanh(v0[2]), gelu_tanh(v0[3])}; v1 = (f32x4){gelu_tanh(v1[0]), gelu_tanh(v1[1]), gelu_tanh(v1[2]), gelu_tanh(v1[3])}; }
                        u32x4 w; w.x = cvt_pk_bf16(v0[0], v0[1]); w.y = cvt_pk_bf16(v0[2], v0[3]); w.z = cvt_pk_bf16(v1[0], v1[1]); w.w = cvt_pk_bf16(v1[2], v1[3]);
                        *(u32x4*)(rowp + bj * HALF) = w;
                        if (sp) { *(f32x4*)(sp + scol + cl + bj * HALF) = v0; *(f32x4*)(sp + scol + cl + bj * HALF + 4) = v1; } } }
        } else {
#pragma unroll
            for (int ai = 0; ai < 2; ++ai)
#pragma unroll
                for (int m = 0; m < 4; ++m) { const int R = row0 + ai * HALF + m * 16; bf16_t* rowp = Z + (size_t)R * ZC + zcol + cl;
                    float* sp = tail ? state_ptr(out, R, keep, layer, poff, soff) : nullptr;
                    f32x4 v0, v1; const f32x4 a0 = acc[ai][0][m][0], a1 = acc[ai][0][m][1], b0 = acc[ai][1][m][0], b1 = acc[ai][1][m][1];
                    if (type == 2) {
#pragma unroll
                        for (int i = 0; i < 4; ++i) { v0[i] = a0[i] * sigmoidf_fast(b0[i]); v1[i] = a1[i] * sigmoidf_fast(b1[i]); }
                    } else { v0 = a0 * b0; v1 = a1 * b1; }
                    u32x4 w; w.x = cvt_pk_bf16(v0[0], v0[1]); w.y = cvt_pk_bf16(v0[2], v0[3]); w.z = cvt_pk_bf16(v1[0], v1[1]); w.w = cvt_pk_bf16(v1[2], v1[3]);
                    *(u32x4*)rowp = w;
                    if (sp) { *(f32x4*)(sp + scol + cl) = v0; *(f32x4*)(sp + scol + cl + 4) = v1; } }
        }
    }
};

struct EpiGate {
    static constexpr bool PERM = true, MIDK = false;
    __device__ __forceinline__ void init(f32x4 (&acc)[2][2][4][2], const Unit&, int, int) const { acc_zero(acc); }
    _Float16* G;
    __device__ __forceinline__ void midk(f32x4 (&)[2][2][4][2], const Unit&, int, int, int, int, int) const {}
    __device__ __forceinline__ void operator()(f32x4 (&acc)[2][2][4][2], const Unit& u, int wr, int wc, int fr_, int fq_) const {
        const int lane_ = lane_now(), fr = lane_ & 15, fq = lane_ >> 4; (void)fr_; (void)fq_;
        const int row0 = u.pm * BM + wr * 64 + fr, ch0 = 64 * u.pn + 16 * wc + 4 * fq; const bool plain = u.pm >= 64;
#pragma unroll
        for (int ai = 0; ai < 2; ++ai)
#pragma unroll
            for (int m = 0; m < 4; ++m) { const int R = row0 + ai * HALF + m * 16; _Float16* gp = G + (size_t)R * GC + ch0;
                f16x4 r0, r1, r2, g3;
#pragma unroll
                for (int i = 0; i < 4; ++i) {
                    const float d0 = 1.f + __builtin_amdgcn_exp2f(__builtin_amdgcn_fmed3f(acc[ai][0][m][0][i], -15.f, 15.f)), d1 = 1.f + __builtin_amdgcn_exp2f(__builtin_amdgcn_fmed3f(acc[ai][0][m][1][i], -15.f, 15.f));
                    const float d2 = 1.f + __builtin_amdgcn_exp2f(__builtin_amdgcn_fmed3f(acc[ai][1][m][0][i], -15.f, 15.f)), d3 = 1.f + __builtin_amdgcn_exp2f(__builtin_amdgcn_fmed3f(acc[ai][1][m][1][i], -15.f, 15.f));
                    const float i0 = __builtin_amdgcn_rcpf(d0), i1 = __builtin_amdgcn_rcpf(d1), i2 = __builtin_amdgcn_rcpf(d2), i3 = __builtin_amdgcn_rcpf(d3);
                    if (plain) { r0[i] = (_Float16)i0; r1[i] = (_Float16)i1; r2[i] = (_Float16)i2; }
                    else { r0[i] = (_Float16)(d1 * i0); r1[i] = (_Float16)(d2 * i1); r2[i] = (_Float16)(d3 * i2); }
                    g3[i] = (_Float16)i3; }
                *(f16x4*)(gp) = r0; *(f16x4*)(gp + 1024) = r1; *(f16x4*)(gp + 2048) = r2; *(f16x4*)(gp + 3072) = g3; }
    }
};

struct EpiMerge {
    static constexpr bool PERM = false, MIDK = true;
    __device__ __forceinline__ void init(f32x4 (&acc)[2][2][4][2], const Unit&, int, int) const { acc_zero(acc); }
    const _Float16* G; bf16_t* O; bf16_t* Os;
    __device__ __forceinline__ void scale(f32x4 (&acc)[2][2][4][2], const Unit& u, int seg, int wr, int wc) const {
        const int lane_ = lane_now(), fr = lane_ & 15, fq = lane_ >> 4;
        const int row0 = u.pm * BM + wr * 64 + fr, c0 = 1024 * seg + 256 * u.pn + wc * 32 + 4 * fq;
#pragma unroll
        for (int ai = 0; ai < 2; ++ai)
#pragma unroll
            for (int m = 0; m < 4; ++m) { const _Float16* gp = G + (size_t)(row0 + ai * HALF + m * 16) * GC + c0;
#pragma unroll
                for (int bj = 0; bj < 2; ++bj)
#pragma unroll
                    for (int n = 0; n < 2; ++n) { const f16x4 f = *(const f16x4*)(gp + bj * HALF + n * 16);
                        acc[ai][bj][m][n] *= (f32x4){(float)f[0], (float)f[1], (float)f[2], (float)f[3]}; } }
    }
    __device__ __forceinline__ void midk(f32x4 (&acc)[2][2][4][2], const Unit& u, int seg, int wr, int wc, int, int) const { scale(acc, u, seg, wr, wc); }
    __device__ __forceinline__ void operator()(f32x4 (&acc)[2][2][4][2], const Unit& u, int wr, int wc, int, int) const {
        scale(acc, u, u.mode ? u.aux : 3, wr, wc);
        const int lane_ = lane_now(), fr = lane_ & 15, fq = lane_ >> 4;
        const int row0 = (u.mode ? (u.pm - 64) * BM + 512 * u.aux : u.pm * BM) + wr * 64 + fr, c0 = 256 * u.pn + wc * 32 + 4 * fq;
        bf16_t* O = u.mode ? Os : this->O;
#pragma unroll
        for (int ai = 0; ai < 2; ++ai)
#pragma unroll
            for (int m = 0; m < 4; ++m) { bf16_t* rowp = O + (size_t)(row0 + ai * HALF + m * 16) * DM + c0;
#pragma unroll
                for (int bj = 0; bj < 2; ++bj)
#pragma unroll
                    for (int n = 0; n < 2; ++n) { const f32x4 v = acc[ai][bj][m][n]; u32x2 w; w.x = cvt_pk_bf16(v[0], v[1]); w.y = cvt_pk_bf16(v[2], v[3]); *(u32x2*)(rowp + bj * HALF + n * 16) = w; } }
    }
};

struct PanelStats {
    unsigned* xbuf;
    unsigned* cnt;
    __device__ __forceinline__ void run(const f32x4 (&v)[2][2][4][2], const Unit& u, int wr, int wc, PG8_LAS unsigned char* lds, int wid) const {
        const int lane = lane_now(), fr = lane & 15, fq = lane >> 4;
        PG8_LAS f32x2* P = (PG8_LAS f32x2*)lds;
        PG8_LAS f32x2* S = (PG8_LAS f32x2*)(lds + 8192);
#pragma unroll
        for (int ai = 0; ai < 2; ++ai)
#pragma unroll
            for (int m = 0; m < 4; ++m) {
                float s = 0.f;
#pragma unroll
                for (int bj = 0; bj < 2; ++bj)
#pragma unroll
                    for (int n = 0; n < 2; ++n) { const f32x4 x = v[ai][bj][m][n]; s += (x[0] + x[1]) + (x[2] + x[3]); }
                s += __builtin_bit_cast(float, __builtin_amdgcn_ds_bpermute((lane ^ 16) << 2, __builtin_bit_cast(int, s))); s += __builtin_bit_cast(float, __builtin_amdgcn_ds_bpermute((lane ^ 32) << 2, __builtin_bit_cast(int, s)));
                const float mw = s * (1.0f / 64.0f); float q = 0.f;
#pragma unroll
                for (int bj = 0; bj < 2; ++bj)
#pragma unroll
                    for (int n = 0; n < 2; ++n) { const f32x4 d = v[ai][bj][m][n] - mw; q += (d[0] * d[0] + d[1] * d[1]) + (d[2] * d[2] + d[3] * d[3]); }
                q += __builtin_bit_cast(float, __builtin_amdgcn_ds_bpermute((lane ^ 16) << 2, __builtin_bit_cast(int, q))); q += __builtin_bit_cast(float, __builtin_amdgcn_ds_bpermute((lane ^ 32) << 2, __builtin_bit_cast(int, q)));
                if (fq == 0) P[(ai * HALF + wr * 64 + m * 16 + fr) * 4 + wc] = (f32x2){mw, q};
            }
        asm volatile("s_waitcnt lgkmcnt(0)" ::: "memory"); __builtin_amdgcn_s_barrier(); asm volatile("" ::: "memory");
        const int row = wid * 32 + (lane & 31);
        if (lane < 32) {
            const f32x2 a = P[row * 4 + 0], b = P[row * 4 + 1], c = P[row * 4 + 2], d = P[row * 4 + 3];
            const float mt = (a.x + b.x + c.x + d.x) * 0.25f;
            const float da = a.x - mt, db = b.x - mt, dc = c.x - mt, dd = d.x - mt;
            const float m2 = (a.y + b.y) + (c.y + d.y) + 64.0f * ((da * da + db * db) + (dc * dc + dd * dd));
            unsigned long long* slot = (unsigned long long*)xbuf + ((size_t)(u.pm * BM + row) * 4 + u.pn);
            __hip_atomic_store(slot, ((unsigned long long)__float_as_uint(m2) << 32) | __float_as_uint(mt), __ATOMIC_RELAXED, __HIP_MEMORY_SCOPE_AGENT);
        }
        asm volatile("s_waitcnt vmcnt(0)" ::: "memory");
        if (lane == 0) __hip_atomic_fetch_add(cnt + 64 * u.pm, 1u, __ATOMIC_RELAXED, __HIP_MEMORY_SCOPE_AGENT);
        if (wid == 0) {
            unsigned spins = 0;
            while ((unsigned)__builtin_amdgcn_readfirstlane(__hip_atomic_load(cnt + 64 * u.pm, __ATOMIC_RELAXED, __HIP_MEMORY_SCOPE_AGENT)) < 32u) { __builtin_amdgcn_s_sleep(2); if (++spins > (1u << 20)) break; }
            __builtin_amdgcn_fence(__ATOMIC_ACQUIRE, "agent");
        }
        asm volatile("s_waitcnt vmcnt(0) lgkmcnt(0)" ::: "memory"); __builtin_amdgcn_s_barrier(); asm volatile("" ::: "memory");
        if (lane < 32) {
            const unsigned long long* slot = (const unsigned long long*)xbuf + (size_t)(u.pm * BM + row) * 4; float mt[4], m2[4]; float ms = 0.f;
#pragma unroll
            for (int t = 0; t < 4; ++t) { const unsigned long long w = __hip_atomic_load(slot + t, __ATOMIC_RELAXED, __HIP_MEMORY_SCOPE_AGENT); mt[t] = __uint_as_float((unsigned)w); m2[t] = __uint_as_float((unsigned)(w >> 32)); ms += mt[t]; }
            const float mean = ms * 0.25f; float q = 0.f;
#pragma unroll
            for (int t = 0; t < 4; ++t) { const float dm = mt[t] - mean; q += m2[t] + 256.0f * dm * dm; }
            S[row] = (f32x2){mean, __builtin_amdgcn_rsqf(q * (1.0f / 1024.0f) + LN_EPS)};
        }
        asm volatile("s_waitcnt lgkmcnt(0)" ::: "memory"); __builtin_amdgcn_s_barrier(); asm volatile("" ::: "memory");
    }
};
struct EpiRes {
    static constexpr bool PERM = false, MIDK = false;
    __device__ __forceinline__ void init(f32x4 (&acc)[2][2][4][2], const Unit& u, int wr, int wc) const {
        if (u.mode) { acc_zero(acc); return; }
        const int lane_ = lane_now(), fr = lane_ & 15, fq = lane_ >> 4;
        const float* bp0 = baseP + (size_t)(u.pm * BM + wr * 64 + fr) * DM + 256 * u.pn + wc * 32 + 4 * fq;
#pragma unroll
        for (int ai = 0; ai < 2; ++ai)
#pragma unroll
            for (int m = 0; m < 4; ++m)
#pragma unroll
                for (int bj = 0; bj < 2; ++bj)
#pragma unroll
                    for (int n = 0; n < 2; ++n) acc[ai][bj][m][n] = *(const f32x4*)(bp0 + (size_t)(ai * HALF + m * 16) * DM + bj * HALF + n * 16) * ALPHA;
    }
    const float* baseP; float* out; bf16_t* xb; const float* lng; const float* lnb; float* slab; PanelStats st; PG8_LAS unsigned char* xlds; int wid;
    __device__ __forceinline__ void midk(f32x4 (&)[2][2][4][2], const Unit&, int, int, int, int, int) const {}
    __device__ __forceinline__ void operator()(f32x4 (&acc)[2][2][4][2], const Unit& u, int wr, int wc, int fr_, int fq_) const {
        const int lane_ = lane_now(), fr = lane_ & 15, fq = lane_ >> 4; (void)fr_; (void)fq_;
        const int row0 = u.pm * BM + wr * 64 + fr, c0 = 256 * u.pn + wc * 32 + 4 * fq;
        if (u.mode) {
#pragma unroll
            for (int ai = 0; ai < 2; ++ai)
#pragma unroll
                for (int m = 0; m < 4; ++m) { float* op = slab + ((size_t)u.aux * 512 + (row0 - MP) + ai * HALF + m * 16) * DM + c0;
#pragma unroll
                    for (int bj = 0; bj < 2; ++bj)
#pragma unroll
                        for (int n = 0; n < 2; ++n) *(f32x4*)(op + bj * HALF + n * 16) = acc[ai][bj][m][n]; }
            return; }
        st.run(acc, u, wr, wc, xlds, wid);
        const PG8_LAS f32x2* S = (const PG8_LAS f32x2*)(xlds + 8192);
#pragma unroll
        for (int bj = 0; bj < 2; ++bj)
#pragma unroll
            for (int n = 0; n < 2; ++n) { const int cc = c0 + bj * HALF + n * 16; const f32x4 gv = *(const f32x4*)(lng + cc), bv = *(const f32x4*)(lnb + cc);
#pragma unroll
                for (int ai = 0; ai < 2; ++ai)
#pragma unroll
                    for (int m = 0; m < 4; ++m) { const int r = ai * HALF + wr * 64 + m * 16 + fr; const f32x2 sr = S[r]; const size_t off = (size_t)(u.pm * BM + r) * DM + cc;
                        const f32x4 o = (acc[ai][bj][m][n] - sr.x) * sr.y * gv + bv; *(f32x4*)(out + off) = o;
                        if (xb) { u32x2 w; w.x = cvt_pk_bf16(o[0], o[1]); w.y = cvt_pk_bf16(o[2], o[3]); *(u32x2*)(xb + off) = w; }
                        if (m & 1) asm volatile("" ::: "memory"); } }
    }
};

struct EpiSwi {
    static constexpr bool PERM = true, MIDK = false;
    __device__ __forceinline__ void init(f32x4 (&acc)[2][2][4][2], const Unit&, int, int) const { acc_zero(acc); }
    bf16_t* H;
    __device__ __forceinline__ void midk(f32x4 (&)[2][2][4][2], const Unit&, int, int, int, int, int) const {}
    __device__ __forceinline__ void operator()(f32x4 (&acc)[2][2][4][2], const Unit& u, int wr, int wc, int fr_, int fq_) const {
        const int lane_ = lane_now(), fr = lane_ & 15, fq = lane_ >> 4; (void)fr_; (void)fq_;
        const int row0 = u.pm * BM + wr * 64 + fr, c0 = 128 * u.pn + wc * 32 + 8 * fq;
#pragma unroll
        for (int ai = 0; ai < 2; ++ai)
#pragma unroll
            for (int m = 0; m < 4; ++m) { bf16_t* rowp = H + (size_t)(row0 + ai * HALF + m * 16) * FF + c0;
                const f32x4 g0 = acc[ai][0][m][0], g1 = acc[ai][0][m][1], u0 = acc[ai][1][m][0], u1 = acc[ai][1][m][1]; f32x4 v0, v1;
#pragma unroll
                for (int i = 0; i < 4; ++i) { v0[i] = g0[i] * sigmoidf_fast(g0[i]) * u0[i]; v1[i] = g1[i] * sigmoidf_fast(g1[i]) * u1[i]; }
                u32x4 w; w.x = cvt_pk_bf16(v0[0], v0[1]); w.y = cvt_pk_bf16(v0[2], v0[3]); w.z = cvt_pk_bf16(v1[0], v1[1]); w.w = cvt_pk_bf16(v1[2], v1[3]);
                *(u32x4*)rowp = w; }
    }
};

template <class Epi, class Sched, bool ALIGN_EPI>
__device__ __forceinline__ void gemm_phase(PG8_LAS unsigned char* lds, const Gemm g, const Sched& S, const Epi& E, int wave_id) {
    const int wid = opqs(wave_id), lane = lane_now(), tid = wid * 64 + lane, wr = wid >> 2, wc = wid & 3, fr = lane & 15, fq = lane >> 4;
    unsigned voffA[2], voffB[2];
#pragma unroll
    for (int i = 0; i < 2; ++i) { int R, C; stage_rc(tid * 16 + i * 8192, R, C); const int Rb = Epi::PERM ? ((R & ~31) + perm32(R & 31)) : R;
        voffA[i] = (unsigned)(R * g.lda + C) * 2u; voffB[i] = (unsigned)(Rb * g.ldb + C) * 2u; }
    const size_t kstep = (size_t)(BK * 2);
    const size_t hstepA = (size_t)HALF * g.lda * 2, hstepB = (size_t)HALF * g.ldb * 2;
    const unsigned ldsw = (unsigned)wid * 1024u;
    const int aoff = lds_byte(wr * 64 + fr, fq * 8), boff = lds_byte(wc * 32 + fr, fq * 8);
#define PG8_SA(b, h) (((b) * 2 + (h)) * HTB)
#define PG8_SB(b, h) ((4 + (b) * 2 + (h)) * HTB)
#define PG8_STAGE(bufoff, gbase, voff) do { _Pragma("unroll") for (int _i = 0; _i < 2; ++_i) \
        __builtin_amdgcn_global_load_lds((const unsigned*)((const char*)(gbase) + (voff)[_i]), (PG8_LAS unsigned*)(lds + (bufoff) + ldsw + _i * 8192), 16, 0, 0); } while (0)
#define PG8_LDA(dst, b, h) do { _Pragma("unroll") for (int m = 0; m < 4; ++m) _Pragma("unroll") for (int k = 0; k < 2; ++k) dst[m][k] = *(const PG8_LAS bf16x8*)(lds + PG8_SA(b, h) + aoff + m * 2048 + k * 1024); } while (0)
#define PG8_LDB(dst, b, h) do { _Pragma("unroll") for (int n = 0; n < 2; ++n) _Pragma("unroll") for (int k = 0; k < 2; ++k) dst[n][k] = *(const PG8_LAS bf16x8*)(lds + PG8_SB(b, h) + boff + n * 2048 + k * 1024); } while (0)
#define PG8_MMA(ai, bj, At, Bt) do { __builtin_amdgcn_s_setprio(1); _Pragma("unroll") for (int m = 0; m < 4; ++m) _Pragma("unroll") for (int n = 0; n < 2; ++n) _Pragma("unroll") for (int k = 0; k < 2; ++k) \
        acc[ai][bj][m][n] = __builtin_amdgcn_mfma_f32_16x16x32_bf16(Bt[n][k], At[m][k], acc[ai][bj][m][n], 0, 0, 0); __builtin_amdgcn_s_setprio(0); } while (0)
#define PG8_WAIT_V(n) asm volatile("s_waitcnt vmcnt(" #n ")" ::: "memory")
#define PG8_WAIT_L(n) asm volatile("s_waitcnt lgkmcnt(" #n ")" ::: "memory")
#define PG8_BAR __builtin_amdgcn_s_barrier()
#define PG8_SCHED __builtin_amdgcn_sched_barrier(0)
    Unit cur, nxt; int ui = 0;
    if (!S.next(0, cur, g)) return;
    f32x4 acc[2][2][4][2];
    E.init(acc, cur, wr, wc);
    bf16x8 At[4][2], B0[2][2], B1[2][2];
    const char* cA = (const char*)g.A + cur.offA; const char* cB = (const char*)g.Bt + cur.offB;
    PG8_STAGE(PG8_SB(0, 0), cB, voffB); PG8_STAGE(PG8_SB(0, 1), cB + hstepB, voffB); PG8_STAGE(PG8_SA(0, 0), cA, voffA); PG8_STAGE(PG8_SA(0, 1), cA + hstepA, voffA);
    if (wr == 1) PG8_BAR;
    PG8_WAIT_V(2); PG8_BAR;
    PG8_STAGE(PG8_SB(1, 0), cB + kstep, voffB); PG8_STAGE(PG8_SA(1, 0), cA + kstep, voffA); PG8_STAGE(PG8_SB(1, 1), cB + hstepB + kstep, voffB);
    PG8_WAIT_V(6); PG8_BAR;
    for (;;) {
        const bool has_next = S.next(ui + 1, nxt, g);
        const char* nA = has_next ? (const char*)g.A + nxt.offA : cA; const char* nB = has_next ? (const char*)g.Bt + nxt.offB : cB;
        const int nt = cur.nt, TSEG = Epi::MIDK ? 8 : nt;
        for (int t0 = 0; t0 < nt; t0 += TSEG) {
        if constexpr (Epi::MIDK) { if (t0 != 0) { PG8_SCHED; E.midk(acc, cur, t0 / TSEG - 1, wr, wc, 0, 0); PG8_SCHED; } }
#pragma unroll 1
        for (int t = t0; t < t0 + TSEG; t += 2) {
            const bool last = (t == nt - 2);
            const char* a1 = cA + (size_t)(t + 1) * kstep;
            const char* a2 = last ? nA : cA + (size_t)(t + 2) * kstep; const char* b2 = last ? nB : cB + (size_t)(t + 2) * kstep;
            const char* a3 = a2 + kstep; const char* b3 = b2 + kstep;
            PG8_LDB(B0, 0, 0); PG8_LDB(B1, 0, 1); PG8_SCHED; PG8_LDA(At, 0, 0); PG8_STAGE(PG8_SA(1, 1), a1 + hstepA, voffA);
            PG8_WAIT_V(8); PG8_WAIT_L(0); PG8_BAR; PG8_MMA(0, 0, At, B0); PG8_MMA(0, 1, At, B1); PG8_BAR; PG8_SCHED;
            PG8_LDA(At, 0, 1); PG8_STAGE(PG8_SB(0, 0), b2, voffB); PG8_STAGE(PG8_SB(0, 1), b2 + hstepB, voffB); PG8_STAGE(PG8_SA(0, 0), a2, voffA);
            PG8_WAIT_V(8); PG8_WAIT_L(0); PG8_BAR; PG8_MMA(1, 0, At, B0); PG8_MMA(1, 1, At, B1); PG8_BAR; PG8_SCHED;
            PG8_LDB(B0, 1, 0); PG8_LDB(B1, 1, 1); PG8_SCHED; PG8_LDA(At, 1, 0); PG8_STAGE(PG8_SA(0, 1), a2 + hstepA, voffA);
            PG8_WAIT_V(8); PG8_WAIT_L(0); PG8_BAR; PG8_MMA(0, 0, At, B0); PG8_MMA(0, 1, At, B1); PG8_BAR; PG8_SCHED;
            PG8_LDA(At, 1, 1); PG8_STAGE(PG8_SB(1, 0), b3, voffB); PG8_STAGE(PG8_SB(1, 1), b3 + hstepB, voffB); PG8_STAGE(PG8_SA(1, 0), a3, voffA);
            PG8_WAIT_V(8); PG8_WAIT_L(0); PG8_BAR; PG8_MMA(1, 0, At, B0); PG8_MMA(1, 1, At, B1); PG8_BAR; PG8_SCHED;
        }
        }
        if constexpr (ALIGN_EPI) { if (wr == 0) PG8_BAR; }
        E(acc, cur, wr, wc, 0, 0);
        if (!has_next) break;
        cur = nxt; cA = nA; cB = nB; ++ui;
        E.init(acc, cur, wr, wc);
        if constexpr (ALIGN_EPI) { if (wr == 1) PG8_BAR; }
    }
    PG8_WAIT_V(0);
    if constexpr (!ALIGN_EPI) { if (wr == 0) PG8_BAR; }
    PG8_BAR;
#undef PG8_SA
#undef PG8_SB
#undef PG8_STAGE
#undef PG8_LDA
#undef PG8_LDB
#undef PG8_MMA
#undef PG8_WAIT_V
#undef PG8_WAIT_L
#undef PG8_BAR
#undef PG8_SCHED
}
}

constexpr int NWAVES = 8;
constexpr int NPHASE = 19;
constexpr size_t MiB = 1u << 20;
constexpr size_t WS_CTL = 0, CTL_ZERO_BYTES = 1 * MiB;
constexpr size_t WS_WA = 1 * MiB;
constexpr size_t WS_XB = 18 * MiB;
constexpr size_t WS_Y = 51 * MiB;
constexpr size_t WS_ZG = 117 * MiB;
constexpr size_t WS_BT3 = 249 * MiB, WS_BT4 = 253 * MiB, WS_BT5 = WS_ZG + 96 * MiB, WS_BT6 = WS_ZG + 108 * MiB;
constexpr size_t WS_MB4S = WS_WA + 8 * MiB;
constexpr size_t WS_SLAB = WS_Y;
constexpr size_t WS_END = 255 * MiB;
static_assert(WS_XB + (size_t)M * DM * 2 <= WS_Y && WS_Y + (size_t)M * YC * 2 <= WS_ZG && WS_ZG + (size_t)M * GC * 2 <= WS_BT3 && WS_SLAB + (size_t)11 * 512 * DM * 4 <= WS_ZG, "ws map");
static_assert((size_t)M * FF * 2 <= 96 * MiB && WS_BT5 + (size_t)2 * FF * DM * 2 <= WS_BT6 && WS_BT6 + (size_t)DM * FF * 2 <= WS_BT3, "ws map 2");
constexpr int CW_TMO = 0, CW_CODE = 1, CW_BAR = 4096, CW_SEAM = 16384, SEAM_BANK = 8192;
constexpr size_t WS_XCH = WS_Y + 32 * MiB;
constexpr int XLDS_OFF = 131072 + 1024;
constexpr int RING_OFF = 0, RING_BYTES = 131072;
constexpr int LDSCTL_OFF = RING_BYTES, MISC_OFF = LDSCTL_OFF + 320;
constexpr int LDS_BYTES = 147456;

#define GAS __attribute__((address_space(1)))
#define LAS __attribute__((address_space(3)))
typedef unsigned short bf16;
typedef unsigned v4u __attribute__((ext_vector_type(4)));
typedef unsigned v2u __attribute__((ext_vector_type(2)));
typedef float f32x4 __attribute__((ext_vector_type(4)));
typedef float f32x2 __attribute__((ext_vector_type(2)));
typedef short bf16x8 __attribute__((ext_vector_type(8)));
typedef GAS unsigned gu32;
#define RLX_AGENT __ATOMIC_RELAXED, __HIP_MEMORY_SCOPE_AGENT
#define LDS_WAIT() asm volatile("s_waitcnt lgkmcnt(0)" ::: "memory")
#define VM_WAIT() asm volatile("s_waitcnt vmcnt(0)" ::: "memory")
__device__ __forceinline__ unsigned pk2(float lo, float hi) { return pg8::cvt_pk_bf16(lo, hi); }
__device__ __forceinline__ float bflo(unsigned v) { return __uint_as_float(v << 16); }
__device__ __forceinline__ float bfhi(unsigned v) { return __uint_as_float(v & 0xffff0000u); }
__device__ __forceinline__ float bf1(unsigned short h) { return __uint_as_float((unsigned)h << 16); }
__device__ __forceinline__ unsigned short f2bf(float f) { return (unsigned short)(pg8::cvt_pk_bf16(f, 0.f) & 0xffffu); }

#define XB_TMO      128
#define XB_XCNT(j)  (256  + 64 * (j))
#define XB_XSUB(j)  (1280 + 64 * (j))
#define XB_XGEN(j)  (2304 + 64 * (j))
#define XB_TOP      3328
#define XB_TOPGEN   3392
#define XCD_BAR_WORDS 3456
#define XB_SPIN_CAP (1u << 18)
__device__ __forceinline__ unsigned xb_ld(unsigned* p)              { return __hip_atomic_load(p, __ATOMIC_RELAXED, __HIP_MEMORY_SCOPE_AGENT); }
__device__ __forceinline__ unsigned xb_add(unsigned* p, unsigned v) { return __hip_atomic_fetch_add(p, v, __ATOMIC_RELAXED, __HIP_MEMORY_SCOPE_AGENT); }
__device__ __forceinline__ unsigned xb_xcc_id() { return (unsigned)__builtin_amdgcn_s_getreg((3 << 11) | 20) & 0xFu; }
#define XB_SPIN(cond, bar) do { unsigned _sp = 0; while (cond) { __builtin_amdgcn_s_sleep(1); \
    if ((++_sp & 255u) == 0u) { if (xb_ld(&(bar)[XB_TMO])) break; if (_sp > XB_SPIN_CAP) { atomicAdd(&(bar)[XB_TMO], 1u); break; } } } } while (0)
struct XcdBarrier { unsigned* bar; unsigned x; volatile LAS unsigned* st; };
__device__ __forceinline__ XcdBarrier xcd_barrier_post(unsigned* bar, volatile LAS unsigned* st) {
    XcdBarrier b; b.bar = bar; b.x = xb_xcc_id(); b.st = st;
    if (threadIdx.x == 0) (void)xb_add(&bar[XB_XCNT(b.x)], 1u);
    return b;
}
__device__ __forceinline__ void xcd_barrier_complete(unsigned* bar, unsigned x, unsigned& nloc, unsigned& nx) {
    const unsigned G = gridDim.x * gridDim.y * gridDim.z;
    unsigned sum, cnt, mine, sp = 0u;
    for (;;) {
        sum = 0u; cnt = 0u; mine = 0u;
#pragma unroll
        for (unsigned j = 0; j < 16; ++j) { const unsigned c = xb_ld(&bar[XB_XCNT(j)]); sum += c; cnt += (c > 0u) ? 1u : 0u; mine = (j == x) ? c : mine; }
        if (sum == G) break;
        __builtin_amdgcn_s_sleep(1);
        if ((++sp & 255u) == 0u) { if (xb_ld(&bar[XB_TMO])) break; if (sp > XB_SPIN_CAP) { atomicAdd(&bar[XB_TMO], 1u); break; } }
    }
    nloc = mine > 0u ? mine : 1u; nx = cnt > 0u ? cnt : 1u;
}
__device__ __forceinline__ void xcd_barrier(const XcdBarrier& b) {
    asm volatile("s_waitcnt vmcnt(0)" ::: "memory");
    __syncthreads();
    if (threadIdx.x == 0) {
        unsigned* bar = b.bar;
        __builtin_amdgcn_s_waitcnt(0);
        unsigned nloc = b.st[0], nx = b.st[1];
        if (nloc == 0u) { xcd_barrier_complete(bar, b.x, nloc, nx); b.st[0] = nloc; b.st[1] = nx; }
        const unsigned old = xb_add(&bar[XB_XSUB(b.x)], 1u);
        const unsigned gen = old / nloc;
        if (old + 1u == (gen + 1u) * nloc) {
            __builtin_amdgcn_fence(__ATOMIC_RELEASE, "agent");
            asm volatile("s_waitcnt vmcnt(0)" ::: "memory");
            const unsigned og = xb_add(&bar[XB_TOP], 1u);
            const unsigned tg = og / nx;
            if (og + 1u == (tg + 1u) * nx) xb_add(&bar[XB_TOPGEN], 1u);
            else XB_SPIN(xb_ld(&bar[XB_TOPGEN]) == tg, bar);
            __builtin_amdgcn_fence(__ATOMIC_ACQUIRE, "agent");
            xb_add(&bar[XB_XGEN(b.x)], 1u);
            asm volatile("s_waitcnt vmcnt(0)" ::: "memory");
        } else {
            XB_SPIN(xb_ld(&bar[XB_XGEN(b.x)]) == gen, bar);
            __builtin_amdgcn_fence(__ATOMIC_ACQUIRE, "agent");
            asm volatile("s_waitcnt vmcnt(0)" ::: "memory");
        }
    }
    __syncthreads();
}

struct Frame {
    LAS unsigned char* lds;
    volatile LAS unsigned* MISC;
    gu32* ctl;
    int tid, lane, wave, G, bid;
    const float* const* in;
    float* out;
    unsigned char* ws;
};
enum { I_XP = 0, I_XS, I_SH, I_SRGC, I_SCF, I_SPOOL, I_SSC, I_WIN, I_RGCW, I_RGCB, I_RGWA, I_RGBA, I_RGWX, I_RGBX, I_LAM, I_CFW, I_CFB, I_CFG, I_CFBB, I_POOLW, I_POOLS, I_SCW,
       I_WBR, I_WOUT, I_LN1G, I_LN1B, I_WG, I_WU, I_WD, I_LN2G, I_LN2B };

__device__ __forceinline__ float shfl_idx(float v, int src_lane) { return __builtin_bit_cast(float, __builtin_amdgcn_ds_bpermute(src_lane << 2, __builtin_bit_cast(int, v))); }
__device__ __forceinline__ float wave_sum(float v, int lane) {
#pragma unroll
    for (int o = 1; o < 64; o <<= 1) v += shfl_idx(v, lane ^ o);
    return v;
}

enum { RM_ID = 0, RM_WIN = 1, RM_GU = 2 };
template <int MODE> __device__ __forceinline__ int rowmap(int s, int extra) {
    if (MODE == RM_ID) return s;
    if (MODE == RM_GU) return 256 * (s >> 7) + (s & 127) + extra;
    if (s < 1024) return s;
    if (s < 2048) { const int j = ((s - 1024) >> 7) & 3; return 1024 + 256 * j + (s >= 1536 ? 128 : 0) + (s & 127); }
    if (s < 3072) return s;
    if (s < 4096) { const int j = ((s - 3072) >> 7) & 3; return 3072 + 256 * j + (s >= 3584 ? 128 : 0) + (s & 127); }
    const int g = (s - 4096) >> 10, ch = s & 1023, pn = ch >> 6, chl = ch & 63, wc = chl >> 4, fq = (chl >> 2) & 3, i = chl & 3;
    return 4096 + 256 * pn + 128 * (g >> 1) + 32 * wc + 8 * fq + 4 * (g & 1) + i;
}
template <int MODE>
__device__ __forceinline__ void transpose_item(const float* W, int K, int N, bf16* WT, int dst_ld, int dst_koff, int extra, LAS float* scr, int item, int lane) {
    const int nblk = N / 32, kb = item / nblk, nb = item % nblk, k0 = 64 * kb, n0 = 32 * nb;
#pragma unroll 8
    for (int i = 0; i < 32; ++i) { const int kk = 2 * i + (lane >> 5); scr[kk * 33 + (lane & 31)] = W[(size_t)(k0 + kk) * N + n0 + (lane & 31)]; }
    LDS_WAIT(); asm volatile("" ::: "memory");
    const int c = lane & 7; const float sc = (MODE == RM_WIN && n0 >= 4096) ? -1.44269504089f : 1.0f;
#pragma unroll
    for (int j = 0; j < 4; ++j) { const int n = (lane >> 3) + 8 * j; const LAS float* s = scr + (8 * c) * 33 + n;
        v4u o; o.x = pk2(s[0 * 33] * sc, s[1 * 33] * sc); o.y = pk2(s[2 * 33] * sc, s[3 * 33] * sc); o.z = pk2(s[4 * 33] * sc, s[5 * 33] * sc); o.w = pk2(s[6 * 33] * sc, s[7 * 33] * sc);
        *(GAS v4u*)(WT + (size_t)rowmap<MODE>(n0 + n, extra) * dst_ld + dst_koff + k0 + 8 * c) = o; }
    LDS_WAIT(); asm volatile("" ::: "memory");
}
template <int MODE>
__device__ __forceinline__ void convert_matrix(Frame& F, const float* W, int K, int N, bf16* WT, int dst_ld, int dst_koff, int extra, int gw, int NGW, int first = 0) {
    LAS float* scr = (LAS float*)(F.lds + RING_OFF + F.wave * 16384);
    const int nitems = (K / 64) * (N / 32);
    int it0 = gw - first; if (it0 < 0) it0 += ((-it0 + NGW - 1) / NGW) * NGW;
    for (int it = it0; it < nitems; it += NGW) transpose_item<MODE>(W, K, N, WT, dst_ld, dst_koff, extra, scr, it, F.lane);
}
__device__ __forceinline__ void compose_pool(Frame& F, int layer, bf16* Bt3, int gw, int NGW, int first = 0) {
    const float* pw = F.in[I_POOLW] + (size_t)layer * 4 * 128 * 128; const float* ps = F.in[I_POOLS] + layer * 512; const float* Wb2 = F.in[I_WBR] + ((size_t)layer * 4 + 2) * 512 * 1024;
    const int lane = F.lane;
    LAS float* Pl = (LAS float*)(F.lds + RING_OFF + F.wave * 16384);
    int id0 = gw - first; if (id0 < 0) id0 += ((-id0 + NGW - 1) / NGW) * NGW;
    for (int id = id0; id < 512; id += NGW) {
        const int g = __builtin_amdgcn_readfirstlane(id >> 7), c0 = __builtin_amdgcn_readfirstlane(8 * ((id >> 3) & 15)), d0 = 128 * (id & 7) + 2 * lane;
#pragma unroll
        for (int k = 0; k < 4; ++k) { const int idx4 = lane + 64 * k, i = idx4 >> 5, e4 = (idx4 & 31) * 4;
            const f32x4 pv = *(const GAS f32x4*)(pw + ((size_t)g * 128 + c0 + i) * 128 + e4), sv = *(const GAS f32x4*)(ps + 128 * g + e4);
            Pl[(e4 + 0) * 8 + i] = pv.x * sv.x; Pl[(e4 + 1) * 8 + i] = pv.y * sv.y; Pl[(e4 + 2) * 8 + i] = pv.z * sv.z; Pl[(e4 + 3) * 8 + i] = pv.w * sv.w; }
        LDS_WAIT(); asm volatile("" ::: "memory");
        f32x2 acc[8];
#pragma unroll
        for (int i = 0; i < 8; ++i) acc[i] = (f32x2){0.f, 0.f};
        const float* wrow = Wb2 + (size_t)(128 * g) * 1024 + d0;
#pragma unroll 1
        for (int e0 = 0; e0 < 128; e0 += 8) {
            f32x2 wv[8];
#pragma unroll
            for (int k = 0; k < 8; ++k) wv[k] = *(const GAS f32x2*)(wrow + (size_t)(e0 + k) * 1024);
#pragma unroll
            for (int k = 0; k < 8; ++k) { const f32x4 p0 = *(const LAS f32x4*)(Pl + (e0 + k) * 8), p1 = *(const LAS f32x4*)(Pl + (e0 + k) * 8 + 4);
#pragma unroll
                for (int i = 0; i < 4; ++i) { acc[i] += wv[k] * p0[i]; acc[4 + i] += wv[k] * p1[i]; } }
        }
        v4u o0, o1;
        o0.x = pk2(acc[0].x, acc[1].x); o0.y = pk2(acc[2].x, acc[3].x); o0.z = pk2(acc[4].x, acc[5].x); o0.w = pk2(acc[6].x, acc[7].x);
        o1.x = pk2(acc[0].y, acc[1].y); o1.y = pk2(acc[2].y, acc[3].y); o1.z = pk2(acc[4].y, acc[5].y); o1.w = pk2(acc[6].y, acc[7].y);
        *(GAS v4u*)(Bt3 + (size_t)d0 * 2048 + 1024 + 128 * g + c0) = o0; *(GAS v4u*)(Bt3 + (size_t)(d0 + 1) * 2048 + 1024 + 128 * g + c0) = o1;
        LDS_WAIT(); asm volatile("" ::: "memory");
    }
}

__device__ __forceinline__ const float* xrow_in(Frame& F, int m) { return m < MP ? F.in[I_XP] + (size_t)m * DM : F.in[I_XS] + (size_t)(m - MP) * DM; }
__device__ __forceinline__ void x_to_bf16(Frame& F, bf16* XB) {
    const int gw = F.bid * NWAVES + F.wave, NGW = F.G * NWAVES;
    for (int m = gw; m < M; m += NGW) { const GAS f32x4* xr = (const GAS f32x4*)xrow_in(F, m) + F.lane; GAS v2u* o = (GAS v2u*)(XB + (size_t)m * DM) + F.lane;
#pragma unroll
        for (int j = 0; j < 4; ++j) { const f32x4 v = xr[64 * j]; o[64 * j] = (v2u){pk2(v.x, v.y), pk2(v.z, v.w)}; } }
}
__device__ __forceinline__ void ln_rows(Frame& F, const float* V, float* O, const float* g, const float* b, bf16* XB, const float* sbase, const float* slab, int nslab) {
    const int gw = F.bid * NWAVES + F.wave, NGW = F.G * NWAVES;
    f32x4 gv[4], bv[4];
#pragma unroll
    for (int j = 0; j < 4; ++j) { gv[j] = ((const GAS f32x4*)g)[F.lane + 64 * j]; bv[j] = ((const GAS f32x4*)b)[F.lane + 64 * j]; }
    for (int m = MP + gw; m < M; m += NGW) {
        const GAS f32x4* xr = (const GAS f32x4*)(V + (size_t)m * DM) + F.lane; GAS f32x4* orow = (GAS f32x4*)(O + (size_t)m * DM) + F.lane;
        f32x4 v[4]; float s = 0.f;
#pragma unroll
        for (int j = 0; j < 4; ++j) v[j] = xr[64 * j];
        if (m >= MP) { const GAS f32x4* br = (const GAS f32x4*)(sbase + (size_t)(m - MP) * DM) + F.lane;
#pragma unroll
            for (int j = 0; j < 4; ++j) v[j] = br[64 * j] * ALPHA;
            for (int sl = 0; sl < nslab; ++sl) { const GAS f32x4* sr = (const GAS f32x4*)(slab + ((size_t)sl * 512 + (m - MP)) * DM) + F.lane;
#pragma unroll
                for (int j = 0; j < 4; ++j) v[j] += sr[64 * j]; } }
#pragma unroll
        for (int j = 0; j < 4; ++j) s += (v[j].x + v[j].y) + (v[j].z + v[j].w);
        const float mean = wave_sum(s, F.lane) * (1.f / DM); float s2 = 0.f;
#pragma unroll
        for (int j = 0; j < 4; ++j) { v[j] = v[j] - mean; s2 += (v[j].x * v[j].x + v[j].y * v[j].y) + (v[j].z * v[j].z + v[j].w * v[j].w); }
        const float rstd = __builtin_amdgcn_rsqf(wave_sum(s2, F.lane) * (1.f / DM) + LN_EPS);
#pragma unroll
        for (int j = 0; j < 4; ++j) { v[j] = v[j] * rstd * gv[j] + bv[j]; orow[64 * j] = v[j]; }
        if (XB) { GAS v2u* o = (GAS v2u*)(XB + (size_t)m * DM) + F.lane;
#pragma unroll
            for (int j = 0; j < 4; ++j) o[64 * j] = (v2u){pk2(v[j].x, v[j].y), pk2(v[j].z, v[j].w)}; }
    }
}

__device__ __forceinline__ float softplusf_acc(float x) { return fmaxf(x, 0.f) + log1pf(__expf(-fabsf(x))); }
__device__ __forceinline__ float expm1_neg(float x) {
    const float p = x * (1.f + x * (0.5f + x * (1.f / 6.f + x * (1.f / 24.f + x * (1.f / 120.f + x * (1.f / 720.f + x * (1.f / 5040.f)))))));
    return x > -0.25f ? p : __expf(x) - 1.f;
}
constexpr int PATCH_STRIDE = 144;

struct ALane {
    const LAS float* tab;
    float cwD[4], cbD, ba, bx, ck;
    bf16x8 Ba0, Ba1, Bx0, Bx1;
};
constexpr int PATCH_BYTES = 5120, ASLOT_OFF = 8 * PATCH_BYTES, ATAB_OFF = ASLOT_OFF + 2048, ATAB_BYTES = 1280;
__device__ __forceinline__ void a_setup(Frame& F, int layer, int n, int q, ALane& L) {
    const int c = F.lane & 15, kg = F.lane >> 4, och = 64 * n + 16 * q + c;
    const float* cw = F.in[I_RGCW] + (size_t)layer * 4 * 512; const float* cb = F.in[I_RGCB] + layer * 512;
    LAS float* tab = (LAS float*)(F.lds + RING_OFF + ATAB_OFF + F.wave * ATAB_BYTES);
#pragma unroll
    for (int k = 0; k < 5; ++k) { const int idx = F.lane + 64 * k, tg = idx / 80, rem = idx - 80 * tg, j = rem >> 4, e = rem & 15, ch = 64 * n + (e < 8 ? 8 * tg + e : 32 + 8 * tg + (e - 8));
        tab[idx] = j < 4 ? cw[j * 512 + ch] : cb[ch]; }
    L.tab = tab + 80 * kg;
#pragma unroll
    for (int j = 0; j < 4; ++j) L.cwD[j] = cw[j * 512 + och];
    L.cbD = cb[och]; L.ba = F.in[I_RGBA][layer * 512 + och]; L.bx = F.in[I_RGBX][layer * 512 + och];
    L.ck = 8.0f * softplusf_acc(-F.in[I_LAM][layer * 512 + och]);
    const float* wa = F.in[I_RGWA] + ((size_t)layer * 8 + n) * 4096 + 16 * q + c; const float* wx = F.in[I_RGWX] + ((size_t)layer * 8 + n) * 4096 + 16 * q + c;
    unsigned a0[4], a1[4], x0[4], x1[4];
#pragma unroll
    for (int w = 0; w < 4; ++w) {
        a0[w] = pk2(wa[(8 * kg + 2 * w) * 64], wa[(8 * kg + 2 * w + 1) * 64]); a1[w] = pk2(wa[(32 + 8 * kg + 2 * w) * 64], wa[(32 + 8 * kg + 2 * w + 1) * 64]);
        x0[w] = pk2(wx[(8 * kg + 2 * w) * 64], wx[(8 * kg + 2 * w + 1) * 64]); x1[w] = pk2(wx[(32 + 8 * kg + 2 * w) * 64], wx[(32 + 8 * kg + 2 * w + 1) * 64]); }
    L.Ba0 = __builtin_bit_cast(bf16x8, (v4u){a0[0], a0[1], a0[2], a0[3]}); L.Ba1 = __builtin_bit_cast(bf16x8, (v4u){a1[0], a1[1], a1[2], a1[3]});
    L.Bx0 = __builtin_bit_cast(bf16x8, (v4u){x0[0], x0[1], x0[2], x0[3]}); L.Bx1 = __builtin_bit_cast(bf16x8, (v4u){x1[0], x1[1], x1[2], x1[3]});
    LDS_WAIT(); asm volatile("" ::: "memory");
}
__device__ __forceinline__ void a_block(const ALane& L, const LAS unsigned char* patch, int rowA0, int baseD, int q, int lane, float (&a)[4], float (&bb)[4]) {
    const int c = lane & 15, kg = lane >> 4;
    float x[16];
    { const f32x4 b0 = *(const LAS f32x4*)(L.tab + 64), b1 = *(const LAS f32x4*)(L.tab + 68), b2 = *(const LAS f32x4*)(L.tab + 72), b3 = *(const LAS f32x4*)(L.tab + 76);
#pragma unroll
      for (int e = 0; e < 4; ++e) { x[e] = b0[e]; x[4 + e] = b1[e]; x[8 + e] = b2[e]; x[12 + e] = b3[e]; } }
#pragma unroll
    for (int j = 0; j < 4; ++j) { const LAS unsigned char* rp = patch + (rowA0 + j) * PATCH_STRIDE + 16 * kg;
        const v4u v0 = *(const LAS v4u*)rp, v1 = *(const LAS v4u*)(rp + 64);
        const f32x4 t0 = *(const LAS f32x4*)(L.tab + 16 * j), t1 = *(const LAS f32x4*)(L.tab + 16 * j + 4), t2 = *(const LAS f32x4*)(L.tab + 16 * j + 8), t3 = *(const LAS f32x4*)(L.tab + 16 * j + 12);
#pragma unroll
        for (int w = 0; w < 2; ++w) { x[2 * w] = fmaf(t0[2 * w], bflo(v0[w]), x[2 * w]); x[2 * w + 1] = fmaf(t0[2 * w + 1], bfhi(v0[w]), x[2 * w + 1]);
                                      x[4 + 2 * w] = fmaf(t1[2 * w], bflo(v0[2 + w]), x[4 + 2 * w]); x[5 + 2 * w] = fmaf(t1[2 * w + 1], bfhi(v0[2 + w]), x[5 + 2 * w]);
                                      x[8 + 2 * w] = fmaf(t2[2 * w], bflo(v1[w]), x[8 + 2 * w]); x[9 + 2 * w] = fmaf(t2[2 * w + 1], bfhi(v1[w]), x[9 + 2 * w]);
                                      x[12 + 2 * w] = fmaf(t3[2 * w], bflo(v1[2 + w]), x[12 + 2 * w]); x[13 + 2 * w] = fmaf(t3[2 * w + 1], bfhi(v1[2 + w]), x[13 + 2 * w]); } }
    const bf16x8 A0 = __builtin_bit_cast(bf16x8, (v4u){pk2(x[0], x[1]), pk2(x[2], x[3]), pk2(x[4], x[5]), pk2(x[6], x[7])});
    const bf16x8 A1 = __builtin_bit_cast(bf16x8, (v4u){pk2(x[8], x[9]), pk2(x[10], x[11]), pk2(x[12], x[13]), pk2(x[14], x[15])});
    f32x4 accR = (f32x4){0.f, 0.f, 0.f, 0.f}, accI = (f32x4){0.f, 0.f, 0.f, 0.f};
    accR = __builtin_amdgcn_mfma_f32_16x16x32_bf16(A0, L.Ba0, accR, 0, 0, 0); accR = __builtin_amdgcn_mfma_f32_16x16x32_bf16(A1, L.Ba1, accR, 0, 0, 0);
    accI = __builtin_amdgcn_mfma_f32_16x16x32_bf16(A0, L.Bx0, accI, 0, 0, 0); accI = __builtin_amdgcn_mfma_f32_16x16x32_bf16(A1, L.Bx1, accI, 0, 0, 0);
    float pv[7];
#pragma unroll
    for (int k = 0; k < 7; ++k) pv[k] = bf1(*(const LAS unsigned short*)(patch + (baseD + k) * PATCH_STRIDE + 2 * (16 * q + c)));
#pragma unroll
    for (int r = 0; r < 4; ++r) {
        const float xd = L.cbD + L.cwD[0] * pv[r] + L.cwD[1] * pv[r + 1] + L.cwD[2] * pv[r + 2] + L.cwD[3] * pv[r + 3];
        const float rr = pg8::sigmoidf_fast(accR[r] + L.ba), ii = pg8::sigmoidf_fast(accI[r] + L.bx);
        const float la = -L.ck * rr;
        const float av = __builtin_amdgcn_exp2f(1.44269504089f * la);
        a[r] = av; bb[r] = __builtin_amdgcn_sqrtf(fmaxf(1.f - av * av, 0.f)) * (ii * xd);
    }
}
struct BlkScan { float Ac[4], Bc[4], EA, EB, WA, WB; };
__device__ __forceinline__ void blk_scan(const float (&a)[4], const float (&bb)[4], int lane, BlkScan& S) {
    const int c = lane & 15, g = lane >> 4;
    S.Ac[0] = a[0]; S.Bc[0] = bb[0];
#pragma unroll
    for (int r = 1; r < 4; ++r) { S.Ac[r] = a[r] * S.Ac[r - 1]; S.Bc[r] = a[r] * S.Bc[r - 1] + bb[r]; }
    float IA = S.Ac[3], IB = S.Bc[3];
    { const float pa = shfl_idx(IA, lane - 16), pb = shfl_idx(IB, lane - 16); if (g >= 1) { IB = IA * pb + IB; IA = IA * pa; } }
    { const float pa = shfl_idx(IA, lane - 32), pb = shfl_idx(IB, lane - 32); if (g >= 2) { IB = IA * pb + IB; IA = IA * pa; } }
    S.EA = shfl_idx(IA, lane - 16); S.EB = shfl_idx(IB, lane - 16); if (g == 0) { S.EA = 1.f; S.EB = 0.f; }
    S.WA = shfl_idx(IA, 48 + c); S.WB = shfl_idx(IB, 48 + c);
}
__device__ __forceinline__ void a_prompt_item(Frame& F, int layer, int item, const bf16* Z, bf16* Y) {
    const int b = item >> 5, n = (item >> 2) & 7, q = item & 3, lane = opqv(F.lane), w = F.wave, c = lane & 15, g = lane >> 4, och = 64 * n + 16 * q + c;
    ALane L; a_setup(F, layer, n, q, L);
    LAS unsigned char* patch = F.lds + RING_OFF + w * PATCH_BYTES;
    LAS f32x2* slots = (LAS f32x2*)(F.lds + RING_OFF + ASLOT_OFF);
    const bf16* Zb = Z + (size_t)b * SEQ * ZC;
    float hrun = 0.f;
    v4u pf[5];
    auto load_patch = [&](int tb) {
#pragma unroll
        for (int k = 0; k < 5; ++k) { const int ci = lane + 64 * k, pr = ci >> 3, cc = ci & 7, t = tb - 3 + pr;
            pf[k] = (ci < 280 && t >= 0) ? *(const GAS v4u*)(Zb + (size_t)t * ZC + 64 * n + 8 * cc) : (v4u){0u, 0u, 0u, 0u}; }
    };
    load_patch(32 * w);
    for (int it = 0; it < 8; ++it) {
        const int tb = 256 * it + 32 * w;
#pragma unroll
        for (int k = 0; k < 5; ++k) { const int ci = lane + 64 * k, pr = ci >> 3, cc = ci & 7; if (ci < 280) *(LAS v4u*)(patch + pr * PATCH_STRIDE + 16 * cc) = pf[k]; }
        if (it < 7) load_patch(tb + 256);
        unsigned short gav[8];
#pragma unroll
        for (int r = 0; r < 8; ++r) gav[r] = *(const GAS unsigned short*)(Zb + (size_t)(tb + 16 * (r >> 2) + 4 * g + (r & 3)) * ZC + 512 + och);
        asm volatile("" ::: "memory");
        float a0[4], b0[4], a1[4], b1[4];
        a_block(L, patch, lane & 15, 4 * g, q, lane, a0, b0);
        a_block(L, patch, 16 + (lane & 15), 16 + 4 * g, q, lane, a1, b1);
        BlkScan S0, S1; blk_scan(a0, b0, lane, S0); blk_scan(a1, b1, lane, S1);
        if (lane < 16) slots[((it & 1) * 8 + w) * 16 + c] = (f32x2){S0.WA * S1.WA, S1.WA * S0.WB + S1.WB};
        __syncthreads();
        float hin = hrun, hw = 0.f;
#pragma unroll
        for (int ww = 0; ww < 8; ++ww) { const f32x2 s = slots[((it & 1) * 8 + ww) * 16 + c]; if (ww == w) hw = hin; hin = s.x * hin + s.y; }
        hrun = hin;
        const float hg0 = S0.EA * hw + S0.EB, hw1 = S0.WA * hw + S0.WB, hg1 = S1.EA * hw1 + S1.EB;
#pragma unroll
        for (int r = 0; r < 4; ++r) { const float h = S0.Ac[r] * hg0 + S0.Bc[r];
            *(GAS unsigned short*)(Y + (size_t)(b * SEQ + tb + 4 * g + r) * YC + och) = f2bf(h * bf1(gav[r])); }
#pragma unroll
        for (int r = 0; r < 4; ++r) { const float h = S1.Ac[r] * hg1 + S1.Bc[r];
            *(GAS unsigned short*)(Y + (size_t)(b * SEQ + tb + 16 + 4 * g + r) * YC + och) = f2bf(h * bf1(gav[4 + r]));
            if (r == 3 && it == 7 && w == 7 && g == 3) F.out[O_PH + (size_t)(layer * 8 + b) * 512 + och] = h; }
    }
}
__device__ __forceinline__ void a_sample_task(Frame& F, int layer, int task, const bf16* Z, bf16* Y) {
    const int blk = task >> 5, n = (task >> 2) & 7, q = task & 3, lane = opqv(F.lane), c = lane & 15, g = lane >> 4, och = 64 * n + 16 * q + c, s0 = 4 * blk;
    ALane L; a_setup(F, layer, n, q, L);
    LAS unsigned char* patch = F.lds + RING_OFF + F.wave * PATCH_BYTES;
#pragma unroll
    for (int k = 0; k < 4; ++k) { const int ci = lane + 64 * k; if (ci < 224) { const int pr = ci >> 3, cc = ci & 7, sq = pr / 7, tau = pr - 7 * sq - 3, seq = s0 + sq; v4u v;
            if (tau < 0) { const GAS f32x4* sp = (const GAS f32x4*)(F.in[I_SRGC] + ((size_t)(layer * 128 + seq) * 3 + (tau + 3)) * 512 + 64 * n + 8 * cc); const f32x4 f0 = sp[0], f1 = sp[1];
                v = (v4u){pk2(f0.x, f0.y), pk2(f0.z, f0.w), pk2(f1.x, f1.y), pk2(f1.z, f1.w)}; }
            else v = *(const GAS v4u*)(Z + (size_t)(MP + 4 * seq + tau) * ZC + 64 * n + 8 * cc);
            *(LAS v4u*)(patch + pr * PATCH_STRIDE + 16 * cc) = v; } }
    asm volatile("" ::: "memory");
    float a[4], bb[4];
    a_block(L, patch, 7 * ((lane & 15) >> 2) + (lane & 3), 7 * g, q, lane, a, bb);
    const int seq = s0 + g;
    float h = F.in[I_SH][(size_t)(layer * 128 + seq) * 512 + och];
#pragma unroll
    for (int r = 0; r < 4; ++r) { h = a[r] * h + bb[r]; const size_t row = (size_t)(MP + 4 * seq + r);
        *(GAS unsigned short*)(Y + row * YC + och) = f2bf(h * bf1(*(const GAS unsigned short*)(Z + row * ZC + 512 + och))); }
    F.out[O_SH + (size_t)(layer * 128 + seq) * 512 + och] = h;
}

__device__ __forceinline__ void ln_silu_row(const LAS float* xr, const float* g, const float* b, bf16* dst, int lane) {
    const f32x4 v0 = *(const LAS f32x4*)(xr + 4 * lane), v1 = *(const LAS f32x4*)(xr + 256 + 4 * lane);
    const float s = (v0.x + v0.y) + (v0.z + v0.w) + (v1.x + v1.y) + (v1.z + v1.w);
    const float mean = wave_sum(s, lane) * (1.f / 512.f);
    const f32x4 d0 = v0 - mean, d1 = v1 - mean;
    const float s2 = (d0.x * d0.x + d0.y * d0.y) + (d0.z * d0.z + d0.w * d0.w) + (d1.x * d1.x + d1.y * d1.y) + (d1.z * d1.z + d1.w * d1.w);
    const float rstd = __builtin_amdgcn_rsqf(wave_sum(s2, lane) * (1.f / 512.f) + LN_EPS);
    const f32x4 g0 = *(const GAS f32x4*)(g + 4 * lane), g1 = *(const GAS f32x4*)(g + 256 + 4 * lane), b0 = *(const GAS f32x4*)(b + 4 * lane), b1 = *(const GAS f32x4*)(b + 256 + 4 * lane);
    f32x4 y0 = d0 * rstd * g0 + b0, y1 = d1 * rstd * g1 + b1;
#pragma unroll
    for (int i = 0; i < 4; ++i) { y0[i] = y0[i] * pg8::sigmoidf_fast(y0[i]); y1[i] = y1[i] * pg8::sigmoidf_fast(y1[i]); }
    *(GAS v2u*)(dst + 4 * lane) = (v2u){pk2(y0.x, y0.y), pk2(y0.z, y0.w)}; *(GAS v2u*)(dst + 256 + 4 * lane) = (v2u){pk2(y1.x, y1.y), pk2(y1.z, y1.w)};
}
__device__ __forceinline__ void b_prompt_item(Frame& F, int layer, int item, const bf16* Z, bf16* Y) {
    const int tidl = opqv(F.tid), b = item >> 5, t0 = 64 * (item & 31), p = tidl & 255, hh = tidl >> 8, ts = t0 + 32 * hh;
    const GAS unsigned* Zu = (const GAS unsigned*)(Z + (size_t)b * SEQ * ZC) + 512 + p;
    unsigned raw[62];
#pragma unroll
    for (int i = 0; i < 62; ++i) { const int t = ts - 30 + i; raw[i] = t >= 0 ? Zu[(size_t)t * (ZC / 2)] : 0u; }
    const float* cw = F.in[I_CFW] + (size_t)layer * 31 * 512 + 2 * p;
    f32x2 wj[31];
#pragma unroll
    for (int j = 0; j < 31; ++j) wj[j] = *(const GAS f32x2*)(cw + j * 512);
    const f32x2 bias = *(const GAS f32x2*)(F.in[I_CFB] + layer * 512 + 2 * p);
    f32x2 in[62];
#pragma unroll
    for (int i = 0; i < 62; ++i) in[i] = (f32x2){bflo(raw[i]), bfhi(raw[i])};
    LAS float* obuf = (LAS float*)(F.lds + RING_OFF);
#pragma unroll
    for (int i = 0; i < 32; ++i) { f32x2 o = bias;
#pragma unroll
        for (int j = 0; j < 31; ++j) o += wj[j] * in[i + j];
        *(LAS f32x2*)(obuf + (32 * hh + i) * 512 + 2 * p) = o; }
    __syncthreads();
    const float* lg = F.in[I_CFG] + layer * 512; const float* lb = F.in[I_CFBB] + layer * 512;
#pragma unroll 1
    for (int r = F.wave; r < 64; r += 8) ln_silu_row(obuf + r * 512, lg, lb, Y + (size_t)(b * SEQ + t0 + r) * YC + 512, F.lane);
}
__device__ __forceinline__ void cd_prompt_item(Frame& F, int layer, int item, const bf16* Z, bf16* Y) {
    const int tidl = opqv(F.tid), b = item >> 5, t0 = 64 * (item & 31), p = tidl & 255, hh = tidl >> 8;
    const bf16* Zb = Z + (size_t)b * SEQ * ZC;
    LAS unsigned* cbuf = (LAS unsigned*)(F.lds + RING_OFF);
    for (int ci = tidl; ci < 79 * 64; ci += 512) { const int pr = ci >> 6, cc = ci & 63, t = t0 - 15 + pr;
        const v4u v = t >= 0 ? *(const GAS v4u*)(Zb + (size_t)t * ZC + 1536 + 8 * cc) : (v4u){0u, 0u, 0u, 0u};
        *(LAS v4u*)(cbuf + pr * 256 + 4 * cc) = v; }
    const int ts = t0 + 32 * hh;
    unsigned uu[34], dd[32];
#pragma unroll
    for (int i = 0; i < 34; ++i) { const int t = ts - 2 + i; uu[i] = t >= 0 ? ((const GAS unsigned*)(Zb + (size_t)t * ZC))[1280 + p] : 0u; }
#pragma unroll
    for (int i = 0; i < 32; ++i) dd[i] = ((const GAS unsigned*)(Zb + (size_t)(ts + i) * ZC))[1024 + p];
    const f32x2 w0 = ((const GAS f32x2*)(F.in[I_SCW] + (size_t)(layer * 3 + 0) * 512))[p], w1 = ((const GAS f32x2*)(F.in[I_SCW] + (size_t)(layer * 3 + 1) * 512))[p],
                w2 = ((const GAS f32x2*)(F.in[I_SCW] + (size_t)(layer * 3 + 2) * 512))[p];
    __syncthreads();
    const int w = 2 << (p >> 6), rr0 = 15 + 32 * hh;
    f32x2 s = (f32x2){0.f, 0.f};
    for (int j = 0; j < w; ++j) { const unsigned v = cbuf[(rr0 - j) * 256 + p]; s += (f32x2){bflo(v), bfhi(v)}; }
    GAS unsigned* Yu = (GAS unsigned*)(Y + (size_t)(b * SEQ + ts) * YC) + p;
#pragma unroll
    for (int i = 0; i < 32; ++i) { const int t = ts + i, rr = rr0 + i;
        const unsigned cur = cbuf[rr * 256 + p]; const f32x2 cf = (f32x2){bflo(cur), bfhi(cur)};
        if (i > 0) { const unsigned old = cbuf[(rr - w) * 256 + p]; s += cf - (f32x2){bflo(old), bfhi(old)}; }
        const float ic = __builtin_amdgcn_rcpf((float)(t + 1 < w ? t + 1 : w));
        const f32x2 mm = s * ic - cf;
        Yu[(size_t)i * 1024 + 512] = pk2(mm.x, mm.y);
        const f32x2 cv = w0 * (f32x2){bflo(uu[i]), bfhi(uu[i])} + w1 * (f32x2){bflo(uu[i + 1]), bfhi(uu[i + 1])} + w2 * (f32x2){bflo(uu[i + 2]), bfhi(uu[i + 2])};
        const f32x2 yd = (f32x2){bflo(dd[i]), bfhi(dd[i])} * cv;
        Yu[(size_t)i * 1024 + 768] = pk2(yd.x, yd.y); }
}
__device__ __forceinline__ void s_sample_item(Frame& F, int layer, int s, const bf16* Z, bf16* Y) {
    const int ch = opqv(F.tid); const size_t ls = (size_t)layer * 128 + s;
    const bf16* Zr = Z + (size_t)(MP + 4 * s) * ZC; bf16* Yr = Y + (size_t)(MP + 4 * s) * YC;
    LAS float* obuf = (LAS float*)(F.lds + RING_OFF);
    float in[34], wv[31], pb[19], u[6], dbv[4];
#pragma unroll
    for (int j = 0; j < 30; ++j) in[j] = (F.in[I_SCF] + (ls * 30 + j) * 512)[ch];
#pragma unroll
    for (int j = 0; j < 15; ++j) pb[j] = (F.in[I_SPOOL] + (ls * 15 + j) * 512)[ch];
    u[0] = (F.in[I_SSC] + (ls * 2 + 0) * 512)[ch]; u[1] = (F.in[I_SSC] + (ls * 2 + 1) * 512)[ch];
#pragma unroll
    for (int r = 0; r < 4; ++r) { in[30 + r] = bf1((Zr + (size_t)r * ZC + 1024)[ch]); pb[15 + r] = bf1((Zr + (size_t)r * ZC + 1536)[ch]); u[2 + r] = bf1((Zr + (size_t)r * ZC + 2560)[ch]); dbv[r] = bf1((Zr + (size_t)r * ZC + 2048)[ch]); }
#pragma unroll
    for (int j = 0; j < 31; ++j) wv[j] = (F.in[I_CFW] + ((size_t)layer * 31 + j) * 512)[ch];
    const float bias = (F.in[I_CFB] + layer * 512)[ch];
    const float w0 = (F.in[I_SCW] + (size_t)(layer * 3 + 0) * 512)[ch], w1 = (F.in[I_SCW] + (size_t)(layer * 3 + 1) * 512)[ch], w2 = (F.in[I_SCW] + (size_t)(layer * 3 + 2) * 512)[ch];
    asm volatile("" ::: "memory");
#pragma unroll
    for (int j = 0; j < 26; ++j) (F.out + O_SCF + (ls * 30 + j) * 512)[ch] = in[j + 4];
#pragma unroll
    for (int r = 0; r < 4; ++r) { float o = bias;
#pragma unroll
        for (int j = 0; j < 31; ++j) o += wv[j] * in[r + j];
        obuf[r * 512 + ch] = o; }
#pragma unroll
    for (int j = 0; j < 11; ++j) (F.out + O_SPOOL + (ls * 15 + j) * 512)[ch] = pb[j + 4];
    const int gsel = ch >> 7;
#pragma unroll
    for (int r = 0; r < 4; ++r) { const int k = 15 + r;
        const float s2 = pb[k] + pb[k - 1], s4 = s2 + pb[k - 2] + pb[k - 3], s8 = s4 + (pb[k - 4] + pb[k - 5]) + (pb[k - 6] + pb[k - 7]);
        float s16 = s8;
#pragma unroll
        for (int j = 8; j < 16; ++j) s16 += pb[k - j];
        const float mv = (gsel == 0 ? s2 * 0.5f : gsel == 1 ? s4 * 0.25f : gsel == 2 ? s8 * 0.125f : s16 * 0.0625f) - pb[k];
        (Yr + (size_t)r * YC + 1024)[ch] = f2bf(mv); }
#pragma unroll
    for (int r = 0; r < 4; ++r) (Yr + (size_t)r * YC + 1536)[ch] = f2bf(dbv[r] * (w0 * u[r] + w1 * u[r + 1] + w2 * u[r + 2]));
    __syncthreads();
    if (F.wave < 4) ln_silu_row(obuf + F.wave * 512, F.in[I_CFG] + layer * 512, F.in[I_CFBB] + layer * 512, Yr + (size_t)F.wave * YC + 512, F.lane);
}

struct Args { const float* in[31]; float* out; unsigned char* ws; int ph_lo, ph_hi; };
__global__ void __launch_bounds__(NWAVES * 64, 2) hybrid_fwd(Args args) {
    extern __shared__ __attribute__((aligned(16))) unsigned char lds[];
    Frame F;
    F.lds = (LAS unsigned char*)lds;
    F.MISC = (volatile LAS unsigned*)(F.lds + MISC_OFF);
    const int wave0 = __builtin_amdgcn_readfirstlane((int)threadIdx.x >> 6);
    F.lane = lane_now(); F.wave = wave0; F.tid = F.wave * 64 + F.lane;
    F.G = gridDim.x; F.bid = blockIdx.x;
    F.ws = args.ws; F.out = args.out; F.ctl = (gu32*)(args.ws + WS_CTL);
    F.in = args.in;
    for (int u = F.tid; u < (LDS_BYTES - LDSCTL_OFF) / 4; u += NWAVES * 64) ((LAS unsigned*)(F.lds + LDSCTL_OFF))[u] = 0u;
    __syncthreads();
    XcdBarrier bar; bar.bar = (unsigned*)(F.ctl + CW_BAR); bar.x = 0; bar.st = nullptr;
    if (!MK_SPLIT) bar = xcd_barrier_post((unsigned*)(F.ctl + CW_BAR), F.MISC + 8);
    const int lo = args.ph_lo, hi = args.ph_hi;
#define IN(k) (lo <= (k) && (k) < hi)
#define REFRESH() do { F.lane = lane_now(); F.wave = opqs(wave0); F.tid = F.wave * 64 + F.lane; F.bid = opqs((int)blockIdx.x); } while (0)
#define SEAM(k) do { if (IN(k) && IN((k) + 1)) xcd_barrier(bar); } while (0)
    bf16* WA = (bf16*)(F.ws + WS_WA); bf16* XB = (bf16*)(F.ws + WS_XB); bf16* Y = (bf16*)(F.ws + WS_Y); bf16* Zm = (bf16*)(F.ws + WS_ZG); _Float16* Gb = (_Float16*)(F.ws + WS_ZG);
    bf16* Hb = (bf16*)(F.ws + WS_ZG); bf16* Bt3 = (bf16*)(F.ws + WS_BT3); bf16* Bt4 = (bf16*)(F.ws + WS_BT4); bf16* Bt5 = (bf16*)(F.ws + WS_BT5); bf16* Bt6 = (bf16*)(F.ws + WS_BT6);

    if (IN(0)) { REFRESH(); convert_matrix<RM_WIN>(F, F.in[I_WIN], DM, INC, WA, DM, 0, 0, F.bid * NWAVES + F.wave, F.G * NWAVES); REFRESH(); x_to_bf16(F, XB); }
    SEAM(0);

    for (int l = 0; l < 2; ++l) {
        const int pb = 1 + 9 * l;
        if (IN(pb + 0)) for (int rep = 0; rep < NREP(0); ++rep) { if (rep) xcd_barrier(bar); pg8::Gemm g{XB, WA, DM, DM}; pg8::UnitOrder S; S.init(pg8::SK_PLAIN, 4096, DM, F.G, F.bid, 0); pg8::EpiMix E{Zm, F.out, l};
            pg8::gemm_phase<pg8::EpiMix, pg8::UnitOrder, true>(F.lds + RING_OFF, g, S, E, wave0);
            if (F.G == 256 && F.bid >= 32) {
                REFRESH(); const int gw = (F.bid - 32) * NWAVES + F.wave, NGW = 224 * NWAVES; const float* wbr = F.in[I_WBR] + (size_t)l * 4 * 512 * 1024;
                convert_matrix<RM_ID>(F, wbr, 512, 1024, Bt3, 2048, 0, 0, gw, NGW, 0);
                convert_matrix<RM_ID>(F, wbr + (size_t)512 * 1024, 512, 1024, Bt3, 2048, 512, 0, gw, NGW, 256);
                convert_matrix<RM_ID>(F, wbr + (size_t)3 * 512 * 1024, 512, 1024, Bt3, 2048, 1536, 0, gw, NGW, 512);
                convert_matrix<RM_ID>(F, F.in[I_WOUT] + (size_t)l * DM * DM, DM, DM, Bt4, DM, 0, 0, gw, NGW, 768);
                REFRESH(); compose_pool(F, l, Bt3, gw, NGW, 1280); } }
        SEAM(pb + 0);
        if (IN(pb + 1)) for (int rep = 0; rep < NREP(1); ++rep) { if (rep) xcd_barrier(bar);
            __syncthreads(); REFRESH();
            for (int r2 = 0; r2 < NREP2(0); ++r2) for (int it = F.bid; it < 256; it += F.G) { a_prompt_item(F, l, it, Zm, Y); __syncthreads(); }
            REFRESH();
            for (int r2 = 0; r2 < NREP2(1); ++r2) for (int it = (F.bid + 128) % F.G; it < 128; it += F.G) a_sample_task(F, l, 8 * it + F.wave, Zm, Y);
            __syncthreads(); REFRESH();
            const bool rebal = F.G == 256, gemm_wg = rebal && F.bid >= 128 && F.bid < 160;
            for (int r2 = 0; r2 < NREP2(2); ++r2) { if (!gemm_wg) for (int it = F.bid; it < 256; it += F.G) { b_prompt_item(F, l, it, Zm, Y); __syncthreads(); }
                if (rebal && F.bid >= 160 && F.bid < 192) { b_prompt_item(F, l, F.bid - 32, Zm, Y); __syncthreads(); } }
            REFRESH();
            for (int r2 = 0; r2 < NREP2(3); ++r2) { if (!gemm_wg) for (int it = F.bid; it < 256; it += F.G) { cd_prompt_item(F, l, it, Zm, Y); __syncthreads(); }
                if (rebal && F.bid >= 192 && F.bid < 224) { cd_prompt_item(F, l, F.bid - 64, Zm, Y); __syncthreads(); } }
            REFRESH();
            for (int r2 = 0; r2 < NREP2(4); ++r2) for (int it = F.bid; it < 128; it += F.G) { s_sample_item(F, l, it, Zm, Y); __syncthreads(); }
            if (F.G == 256 && F.bid >= 128 && F.bid < 160) {
                pg8::Gemm g{XB, WA + (size_t)4096 * DM, DM, DM}; pg8::UnitOrder S; S.init(pg8::SK_PLAIN, 4096, DM, 32, F.bid - 128, 0, false, true); pg8::EpiGate E{Gb};
                pg8::gemm_phase<pg8::EpiGate, pg8::UnitOrder, true>(F.lds + RING_OFF, g, S, E, wave0); }
            REFRESH();
            const float* wbr = F.in[I_WBR] + (size_t)l * 4 * 512 * 1024;
            if (F.G != 256) { const int gw = F.bid * NWAVES + F.wave, NGW = F.G * NWAVES;
                convert_matrix<RM_ID>(F, wbr, 512, 1024, Bt3, 2048, 0, 0, gw, NGW); convert_matrix<RM_ID>(F, wbr + (size_t)512 * 1024, 512, 1024, Bt3, 2048, 512, 0, gw, NGW);
                convert_matrix<RM_ID>(F, wbr + (size_t)3 * 512 * 1024, 512, 1024, Bt3, 2048, 1536, 0, gw, NGW); convert_matrix<RM_ID>(F, F.in[I_WOUT] + (size_t)l * DM * DM, DM, DM, Bt4, DM, 0, 0, gw, NGW);
                REFRESH(); compose_pool(F, l, Bt3, gw, NGW); }
        }
        SEAM(pb + 1);
        if (IN(pb + 2)) for (int rep = 0; rep < NREP(2); ++rep) { if (rep) xcd_barrier(bar); pg8::Gemm g{XB, WA + (size_t)4096 * DM, DM, DM}; pg8::UnitOrder S; S.init(pg8::SK_PLAIN, 4096, DM, F.G, F.bid, 0, true, F.G != 256); pg8::EpiGate E{Gb};
            pg8::gemm_phase<pg8::EpiGate, pg8::UnitOrder, true>(F.lds + RING_OFF, g, S, E, wave0); }
        SEAM(pb + 2);
        if (IN(pb + 3)) for (int rep = 0; rep < NREP(3); ++rep) { if (rep) xcd_barrier(bar); pg8::Gemm g{Y, Bt3, 2048, 2048}; pg8::UnitOrder S; S.init(pg8::SK_P3, DM, 2048, F.G, F.bid, 0); pg8::EpiMerge E{Gb, XB, (bf16*)(F.ws + WS_MB4S)};
            pg8::gemm_phase<pg8::EpiMerge, pg8::UnitOrder, true>(F.lds + RING_OFF, g, S, E, wave0); }
        SEAM(pb + 3);
        if (IN(pb + 4)) for (int rep = 0; rep < 1; ++rep) { pg8::Gemm g{XB, Bt4, DM, DM}; pg8::UnitOrder S; S.init(pg8::SK_P4, DM, DM, F.G, F.bid, (long)(WS_MB4S - WS_XB));
            pg8::EpiRes E{l == 0 ? F.in[I_XP] : F.out, F.out, XB, F.in[I_LN1G] + l * DM, F.in[I_LN1B] + l * DM, (float*)(F.ws + WS_SLAB),
                          pg8::PanelStats{(unsigned*)(F.ws + WS_XCH + (size_t)(2 * l) * 512 * 1024), (unsigned*)(F.ctl + CW_SEAM + (2 * l) * SEAM_BANK)}, F.lds + XLDS_OFF, wave0};
            pg8::gemm_phase<pg8::EpiRes, pg8::UnitOrder, true>(F.lds + RING_OFF, g, S, E, wave0);
            if (F.G == 256 && F.bid >= 64) {
                REFRESH(); const int gw = (F.bid - 64) * NWAVES + F.wave, NGW = 192 * NWAVES;
                convert_matrix<RM_GU>(F, F.in[I_WG] + (size_t)l * DM * FF, DM, FF, Bt5, DM, 0, 0, gw, NGW, 0);
                convert_matrix<RM_GU>(F, F.in[I_WU] + (size_t)l * DM * FF, DM, FF, Bt5, DM, 0, 128, gw, NGW, 1408);
                convert_matrix<RM_ID>(F, F.in[I_WD] + (size_t)l * FF * DM, FF, DM, Bt6, FF, 0, 0, gw, NGW, 2816); } }
        SEAM(pb + 4);
        if (IN(pb + 5)) for (int rep = 0; rep < NREP(5); ++rep) { if (rep) xcd_barrier(bar);
            REFRESH();
            ln_rows(F, F.out, rep + 1 < NREP(5) ? (float*)(F.ws + WS_Y) : F.out, F.in[I_LN1G] + l * DM, F.in[I_LN1B] + l * DM, rep + 1 < NREP(5) ? nullptr : XB, l == 0 ? F.in[I_XS] : F.out + (size_t)MP * DM, (const float*)(F.ws + WS_SLAB), 8);
            REFRESH();
            if (F.G != 256) { const int gw = F.bid * NWAVES + F.wave, NGW = F.G * NWAVES;
                convert_matrix<RM_GU>(F, F.in[I_WG] + (size_t)l * DM * FF, DM, FF, Bt5, DM, 0, 0, gw, NGW); convert_matrix<RM_GU>(F, F.in[I_WU] + (size_t)l * DM * FF, DM, FF, Bt5, DM, 0, 128, gw, NGW);
                convert_matrix<RM_ID>(F, F.in[I_WD] + (size_t)l * FF * DM, FF, DM, Bt6, FF, 0, 0, gw, NGW); }
        }
        SEAM(pb + 5);
        if (IN(pb + 6)) for (int rep = 0; rep < NREP(6); ++rep) { if (rep) xcd_barrier(bar); pg8::Gemm g{XB, Bt5, DM, DM}; pg8::UnitOrder S; S.init(pg8::SK_PLAIN, 2 * FF, DM, F.G, F.bid, 0); pg8::EpiSwi E{Hb};
            pg8::gemm_phase<pg8::EpiSwi, pg8::UnitOrder, true>(F.lds + RING_OFF, g, S, E, wave0);
            if (F.G == 256 && F.bid >= 172 && l == 0 && rep + 1 == NREP(6)) {
                REFRESH(); convert_matrix<RM_WIN>(F, F.in[I_WIN] + (size_t)DM * INC, DM, INC, WA, DM, 0, 0, (F.bid - 172) * NWAVES + F.wave, 84 * NWAVES); } }
        SEAM(pb + 6);
        if (IN(pb + 7)) for (int rep = 0; rep < 1; ++rep) { pg8::Gemm g{Hb, Bt6, FF, FF}; pg8::UnitOrder S; S.init(pg8::SK_P6, DM, FF, F.G, F.bid, 0); pg8::EpiRes E{F.out, F.out, l == 0 ? XB : nullptr, F.in[I_LN2G] + l * DM, F.in[I_LN2B] + l * DM, (float*)(F.ws + WS_SLAB),
                          pg8::PanelStats{(unsigned*)(F.ws + WS_XCH + (size_t)(2 * l + 1) * 512 * 1024), (unsigned*)(F.ctl + CW_SEAM + (2 * l + 1) * SEAM_BANK)}, F.lds + XLDS_OFF, wave0};
            pg8::gemm_phase<pg8::EpiRes, pg8::UnitOrder, true>(F.lds + RING_OFF, g, S, E, wave0); }
        SEAM(pb + 7);
        if (IN(pb + 8)) for (int rep = 0; rep < NREP(8); ++rep) { if (rep) xcd_barrier(bar);
            REFRESH();
            ln_rows(F, F.out, rep + 1 < NREP(8) ? (float*)(F.ws + WS_Y) : F.out, F.in[I_LN2G] + l * DM, F.in[I_LN2B] + l * DM, (l == 0 && rep + 1 == NREP(8)) ? XB : nullptr, F.out + (size_t)MP * DM, (const float*)(F.ws + WS_SLAB), 11);
            REFRESH();
            if (l == 0 && F.G != 256) convert_matrix<RM_WIN>(F, F.in[I_WIN] + (size_t)DM * INC, DM, INC, WA, DM, 0, 0, F.bid * NWAVES + F.wave, F.G * NWAVES);
        }
        if (l == 0) SEAM(pb + 8);
    }
#undef IN
#undef SEAM
#undef REFRESH
}

extern "C" void kernel_launch(void* const* d_in, const int* in_sizes, int n_in, void* d_out, int out_size, void* d_ws, size_t ws_size, hipStream_t stream) {
    static int grid = 0;
    if (grid == 0) {
        if (n_in != 31 || out_size != (int)O_END || ws_size < WS_END) { fprintf(stderr, "kernel_launch: unexpected sizes n_in %d out %d ws %zu\n", n_in, out_size, ws_size); grid = -1; return; }
        int dev = 0, cus = 0, per_cu = 0;
        if (hipGetDevice(&dev) != hipSuccess || hipDeviceGetAttribute(&cus, hipDeviceAttributeMultiprocessorCount, dev) != hipSuccess) { grid = -1; return; }
        if (hipFuncSetAttribute((const void*)hybrid_fwd, hipFuncAttributeMaxDynamicSharedMemorySize, LDS_BYTES) != hipSuccess) { fprintf(stderr, "kernel_launch: hipFuncSetAttribute failed\n"); grid = -1; return; }
        if (hipOccupancyMaxActiveBlocksPerMultiprocessor(&per_cu, (const void*)hybrid_fwd, NWAVES * 64, LDS_BYTES) != hipSuccess || per_cu < 1)
            fprintf(stderr, "kernel_launch: occupancy query reports %d workgroups per CU\n", per_cu);
        (void)hipGetLastError();
        grid = cus;
    }
    if (grid < 0) return;
    if (hipMemsetAsync((char*)d_ws + WS_CTL, 0, CTL_ZERO_BYTES, stream) != hipSuccess) { fprintf(stderr, "kernel_launch: memset failed\n"); return; }
    Args a{};
    for (int i = 0; i < 31; ++i) a.in[i] = (const float*)d_in[i];
    a.out = (float*)d_out; a.ws = (unsigned char*)d_ws;
#if MK_SPLIT
    for (int ph = 0; ph < NPHASE; ++ph) { a.ph_lo = ph; a.ph_hi = ph + 1; hipLaunchKernelGGL(hybrid_fwd, dim3(grid), dim3(NWAVES * 64), LDS_BYTES, stream, a); }
#else
    a.ph_lo = 0; a.ph_hi = NPHASE;
    hipLaunchKernelGGL(hybrid_fwd, dim3(grid), dim3(NWAVES * 64), LDS_BYTES, stream, a);
#endif
}
```

```cpp
#include <hip/hip_runtime.h>
#include <cstdio>
#include <cstdint>

#ifndef PROBE_REP
#define PROBE_REP 0
#endif
#define NREP(k) (1 + ((PROBE_REP >> (k)) & 1))
#ifndef PROBE2
#define PROBE2 0
#endif
#define NREP2(j) (1 + ((PROBE2 >> (j)) & 1))
#ifndef MK_SPLIT
#define MK_SPLIT 0
#endif

constexpr int DM = 1024, WMIX = 512, NPB = 8, SEQ = 2048, NSB = 128, DSEQ = 4;
constexpr int MP = NPB * SEQ, MS = NSB * DSEQ, M = MP + MS;
constexpr int FF = 2816, INC = 8192, ZC = 3072, YC = 2048, GC = 4096;
constexpr float LN_EPS = 1e-5f, ALPHA = 1.41421356237f;
constexpr size_t O_Y = 0, O_PH = (size_t)M * DM, O_PRGC = O_PH + 8192, O_PCF = O_PRGC + 24576, O_PPOOL = O_PCF + 245760, O_PSC = O_PPOOL + 122880,
                 O_SH = O_PSC + 16384, O_SRGC = O_SH + 131072, O_SCF = O_SRGC + 393216, O_SPOOL = O_SCF + 3932160, O_SSC = O_SPOOL + 1966080, O_END = O_SSC + 262144;
static_assert(O_END == 24403968, "output map");

__device__ __forceinline__ int opqv(int v) { asm volatile("" : "+v"(v)); return v; }
__device__ __forceinline__ int lane_now() { int l; asm volatile("v_mbcnt_lo_u32_b32 %0, -1, 0\n\tv_mbcnt_hi_u32_b32 %0, -1, %0" : "=v"(l)); return l; }
__device__ __forceinline__ int opqs(int v) { asm volatile("" : "+s"(v)); return v; }
namespace pg8 {
#define PG8_LAS __attribute__((address_space(3)))
typedef unsigned short bf16_t;
typedef short bf16x8 __attribute__((ext_vector_type(8)));
typedef float f32x4 __attribute__((ext_vector_type(4)));
typedef float f32x2 __attribute__((ext_vector_type(2)));
typedef unsigned u32x4 __attribute__((ext_vector_type(4)));
typedef unsigned u32x2 __attribute__((ext_vector_type(2)));
typedef _Float16 f16x4 __attribute__((ext_vector_type(4)));
typedef _Float16 f16x8 __attribute__((ext_vector_type(8)));
constexpr int BM = 256, BK = 64, HALF = 128, HTB = HALF * BK * 2, STAGE_BYTES = 8 * HTB, NXCD = 8, WGM = 8;

__host__ __device__ __forceinline__ int lds_byte(int r, int c) { const int st = (r >> 4) * 2 + (c >> 5), rr = r & 15, cc = c & 31, ob = rr * 64 + cc * 2; return st * 1024 + (ob ^ (((ob >> 9) & 1) << 5)); }
__host__ __device__ __forceinline__ void stage_rc(int b, int& R, int& C) { const int st = b / 1024, sb = b % 1024, swz = sb ^ (((sb >> 9) & 1) << 5); R = (st >> 1) * 16 + swz / 64; C = (st & 1) * 32 + (swz % 64) / 2; }
__host__ __device__ __forceinline__ int perm32(int rho) { const int n = rho >> 4, i = rho & 15; return 8 * (i >> 2) + 4 * n + (i & 3); }

struct Unit { int pm, pn, nt, mode, aux; long offA, offB; };
struct Gemm { const bf16_t* A; const bf16_t* Bt; int lda, ldb; };

enum { SK_PLAIN = 0, SK_P3 = 1, SK_P4 = 2, SK_P6 = 3 };
struct UnitOrder {
    int kind, nN, nwgP, nS, ntP, G, c; long offA_s;
    __device__ __forceinline__ void init(int kind_, int N_, int K_, int G_, int c_, long offA_s_, bool prompt = true, bool sample = true) { kind = kind_; nN = N_ / BM; nwgP = prompt ? 64 * nN : 0; ntP = K_ / BK; G = G_; c = c_; offA_s = offA_s_;
        nS = !sample ? 0 : kind_ == SK_PLAIN ? 2 * nN : kind_ == SK_P3 ? 32 : kind_ == SK_P4 ? 64 : 88; }
    __device__ __forceinline__ bool next(int i, Unit& u, const Gemm& g) const {
        const long L = (long)i * G + c; const long ra = (long)BM * g.lda * 2, rb = (long)BM * g.ldb * 2;
        if (L < nwgP) {
            int wgid = (int)L; { const int q = nwgP / NXCD, xcd = wgid % NXCD, off = wgid / NXCD; wgid = xcd * q + off; }
            const int nig = WGM * nN; u.pm = (wgid / nig) * WGM + ((wgid % nig) % WGM); u.pn = (wgid % nig) / WGM;
            u.nt = ntP; u.mode = 0; u.aux = 0; u.offA = u.pm * ra; u.offB = u.pn * rb; return true; }
        const int s = (int)(L - nwgP); if (s >= nS) return false;
        if (kind == SK_PLAIN) { u.pm = 64 + (s & 1); u.pn = s >> 1; u.nt = ntP; u.mode = 0; u.aux = 0; u.offA = u.pm * ra; u.offB = u.pn * rb; }
        else if (kind == SK_P3) { const int n = s & 3, tile = s >> 2; u.pm = 64 + (tile & 1); u.pn = tile >> 1; u.nt = 8; u.mode = 1; u.aux = n; u.offA = u.pm * ra + 1024 * n; u.offB = u.pn * rb + 1024 * n; }
        else if (kind == SK_P4) { const int ch = s & 7, tile = s >> 3, n = ch >> 1, kin = (ch & 1) * 512; u.pm = 64 + (tile & 1); u.pn = tile >> 1; u.nt = 8; u.mode = 1; u.aux = ch;
            u.offA = offA_s + ((long)(n * 512 + (u.pm - 64) * 256) * 1024 + kin) * 2; u.offB = u.pn * rb + kin * 2; }
        else { const int ch = s % 11, tile = s / 11; u.pm = 64 + (tile & 1); u.pn = tile >> 1; u.nt = 4; u.mode = 1; u.aux = ch; u.offA = u.pm * ra + 512 * ch; u.offB = u.pn * rb + 512 * ch; }
        return true;
    }
};

__device__ __forceinline__ unsigned cvt_pk_bf16(float lo, float hi) { unsigned r; asm volatile("v_cvt_pk_bf16_f32 %0, %1, %2" : "=v"(r) : "v"(lo), "v"(hi)); return r; }
__device__ __forceinline__ float sigmoidf_fast(float x) { return __builtin_amdgcn_rcpf(1.0f + __builtin_amdgcn_exp2f(-1.44269504089f * x)); }
__device__ __forceinline__ float gelu_tanh(float x) { const float t = x * x, y = x * fmaf(t, -0.10294324f, -2.3022082f); return x * __builtin_amdgcn_rcpf(1.0f + __builtin_amdgcn_exp2f(y)); }

__device__ __forceinline__ void acc_zero(f32x4 (&acc)[2][2][4][2]) {
#pragma unroll
    for (int a = 0; a < 2; ++a)
#pragma unroll
        for (int b = 0; b < 2; ++b)
#pragma unroll
            for (int m = 0; m < 4; ++m)
#pragma unroll
                for (int n = 0; n < 2; ++n) acc[a][b][m][n] = (f32x4){0.f, 0.f, 0.f, 0.f};
}
__device__ __forceinline__ float* state_ptr(float* out, int R, int keep, int layer, size_t p_off, size_t s_off) {
    if (R < MP) { const int b = R >> 11, j = (R & 2047) - (2048 - keep); return j < 0 ? nullptr : out + p_off + (size_t)((layer * 8 + b) * keep + j) * 512; }
    const int s = (R - MP) >> 2, j = (R & 3) + keep - 4; return j < 0 ? nullptr : out + s_off + (size_t)((layer * 128 + s) * keep + j) * 512;
}

struct EpiMix {
    static constexpr bool PERM = true, MIDK = false;
    __device__ __forceinline__ void init(f32x4 (&acc)[2][2][4][2], const Unit&, int, int) const { acc_zero(acc); }
    bf16_t* Z; float* out; int layer;
    __device__ __forceinline__ void midk(f32x4 (&)[2][2][4][2], const Unit&, int, int, int, int, int) const {}
    __device__ __forceinline__ void operator()(f32x4 (&acc)[2][2][4][2], const Unit& u, int wr, int wc, int fr_, int fq_) const {
        const int lane_ = lane_now(), fr = lane_ & 15, fq = lane_ >> 4; (void)fr_; (void)fq_;
        const int pn = u.pn; int type, zcol, keep = 0, scol = 0; size_t poff = 0, soff = 0;
        if (pn < 2) { type = 0; zcol = 256 * pn; keep = 3; scol = zcol; poff = O_PRGC; soff = O_SRGC; }
        else if (pn < 4) { type = 1; zcol = 512 + 256 * (pn - 2); }
        else if (pn < 8) { type = 2; zcol = 1024 + 128 * (pn - 4); keep = 30; scol = 128 * (pn - 4); poff = O_PCF; soff = O_SCF; }
        else if (pn < 10) { type = 0; zcol = 1536 + 256 * (pn - 8); keep = 15; scol = 256 * (pn - 8); poff = O_PPOOL; soff = O_SPOOL; }
        else if (pn < 12) { type = 0; zcol = 2048 + 256 * (pn - 10); }
        else { type = 3; zcol = 2560 + 128 * (pn - 12); keep = 2; scol = 128 * (pn - 12); poff = O_PSC; soff = O_SSC; }
        const bool tail = keep != 0 && (u.pm >= 64 || (u.pm & 7) == 7);
        const int row0 = u.pm * BM + wr * 64 + fr, cl = wc * 32 + 8 * fq;
        if (type < 2) {
#pragma unroll
            for (int ai = 0; ai < 2; ++ai)
#pragma unroll
                for (int m = 0; m < 4; ++m) { const int R = row0 + ai * HALF + m * 16; bf16_t* rowp = Z + (size_t)R * ZC + zcol + cl;
                    float* sp = tail ? state_ptr(out, R, keep, layer, poff, soff) : nullptr;
#pragma unroll
                    for (int bj = 0; bj < 2; ++bj) { f32x4 v0 = acc[ai][bj][m][0], v1 = acc[ai][bj][m][1];
                        if (type == 1) { v0 = (f32x4){gelu_tanh(v0[0]), gelu_tanh(v0[1]), gelu_tanh(v0[2]), gelu_tanh(v0[3])}; v1 = (f32x4){gelu_tanh(v1[0]), gelu_tanh(v1[1]), gelu_tanh(v1[2]), gelu_tanh(v1[3])}; }
                        u32x4 w; w.x = cvt_pk_bf16(v0[0], v0[1]); w.y = cvt_pk_bf16(v0[2], v0[3]); w.z = cvt_pk_bf16(v1[0], v1[1]); w.w = cvt_pk_bf16(v1[2], v1[3]);
                        *(u32x4*)(rowp + bj * HALF) = w;
                        if (sp) { *(f32x4*)(sp + scol + cl + bj * HALF) = v0; *(f32x4*)(sp + scol + cl + bj * HALF + 4) = v1; } } }
        } else {
#pragma unroll
            for (int ai = 0; ai < 2; ++ai)
#pragma unroll
                for (int m = 0; m < 4; ++m) { const int R = row0 + ai * HALF + m * 16; bf16_t* rowp = Z + (size_t)R * ZC + zcol + cl;
                    float* sp = tail ? state_ptr(out, R, keep, layer, poff, soff) : nullptr;
                    f32x4 v0, v1; const f32x4 a0 = acc[ai][0][m][0], a1 = acc[ai][0][m][1], b0 = acc[ai][1][m][0], b1 = acc[ai][1][m][1];
                    if (type == 2) {
#pragma unroll
                        for (int i = 0; i < 4; ++i) { v0[i] = a0[i] * sigmoidf_fast(b0[i]); v1[i] = a1[i] * sigmoidf_fast(b1[i]); }
                    } else { v0 = a0 * b0; v1 = a1 * b1; }
                    u32x4 w; w.x = cvt_pk_bf16(v0[0], v0[1]); w.y = cvt_pk_bf16(v0[2], v0[3]); w.z = cvt_pk_bf16(v1[0], v1[1]); w.w = cvt_pk_bf16(v1[2], v1[3]);
                    *(u32x4*)rowp = w;
                    if (sp) { *(f32x4*)(sp + scol + cl) = v0; *(f32x4*)(sp + scol + cl + 4) = v1; } }
        }
    }
};

struct EpiGate {
    static constexpr bool PERM = true, MIDK = false;
    __device__ __forceinline__ void init(f32x4 (&acc)[2][2][4][2], const Unit&, int, int) const { acc_zero(acc); }
    _Float16* G;
    __device__ __forceinline__ void midk(f32x4 (&)[2][2][4][2], const Unit&, int, int, int, int, int) const {}
    __device__ __forceinline__ void operator()(f32x4 (&acc)[2][2][4][2], const Unit& u, int wr, int wc, int fr_, int fq_) const {
        const int lane_ = lane_now(), fr = lane_ & 15, fq = lane_ >> 4; (void)fr_; (void)fq_;
        const int row0 = u.pm * BM + wr * 64 + fr, ch0 = 64 * u.pn + 16 * wc + 4 * fq; const bool plain = u.pm >= 64;
#pragma unroll
        for (int ai = 0; ai < 2; ++ai)
#pragma unroll
            for (int m = 0; m < 4; ++m) { const int R = row0 + ai * HALF + m * 16; _Float16* gp = G + (size_t)R * GC + ch0;
                f16x4 r0, r1, r2, g3;
#pragma unroll
                for (int i = 0; i < 4; ++i) {
                    const float d0 = 1.f + __builtin_amdgcn_exp2f(__builtin_amdgcn_fmed3f(acc[ai][0][m][0][i], -15.f, 15.f)), d1 = 1.f + __builtin_amdgcn_exp2f(__builtin_amdgcn_fmed3f(acc[ai][0][m][1][i], -15.f, 15.f));
                    const float d2 = 1.f + __builtin_amdgcn_exp2f(__builtin_amdgcn_fmed3f(acc[ai][1][m][0][i], -15.f, 15.f)), d3 = 1.f + __builtin_amdgcn_exp2f(__builtin_amdgcn_fmed3f(acc[ai][1][m][1][i], -15.f, 15.f));
                    const float i0 = __builtin_amdgcn_rcpf(d0), i1 = __builtin_amdgcn_rcpf(d1), i2 = __builtin_amdgcn_rcpf(d2), i3 = __builtin_amdgcn_rcpf(d3);
                    if (plain) { r0[i] = (_Float16)i0; r1[i] = (_Float16)i1; r2[i] = (_Float16)i2; }
                    else { r0[i] = (_Float16)(d1 * i0); r1[i] = (_Float16)(d2 * i1); r2[i] = (_Float16)(d3 * i2); }
                    g3[i] = (_Float16)i3; }
                *(f16x4*)(gp) = r0; *(f16x4*)(gp + 1024) = r1; *(f16x4*)(gp + 2048) = r2; *(f16x4*)(gp + 3072) = g3; }
    }
};

struct EpiMerge {
    static constexpr bool PERM = false, MIDK = true;
    __device__ __forceinline__ void init(f32x4 (&acc)[2][2][4][2], const Unit&, int, int) const { acc_zero(acc); }
    const _Float16* G; bf16_t* O; bf16_t* Os;
    __device__ __forceinline__ void scale(f32x4 (&acc)[2][2][4][2], const Unit& u, int seg, int wr, int wc) const {
        const int lane_ = lane_now(), fr = lane_ & 15, fq = lane_ >> 4;
        const int row0 = u.pm * BM + wr * 64 + fr, c0 = 1024 * seg + 256 * u.pn + wc * 32 + 4 * fq;
#pragma unroll
        for (int ai = 0; ai < 2; ++ai)
#pragma unroll
            for (int m = 0; m < 4; ++m) { const _Float16* gp = G + (size_t)(row0 + ai * HALF + m * 16) * GC + c0;
#pragma unroll
                for (int bj = 0; bj < 2; ++bj)
#pragma unroll
                    for (int n = 0; n < 2; ++n) { const f16x4 f = *(const f16x4*)(gp + bj * HALF + n * 16);
                        acc[ai][bj][m][n] *= (f32x4){(float)f[0], (float)f[1], (float)f[2], (float)f[3]}; } }
    }
    __device__ __forceinline__ void midk(f32x4 (&acc)[2][2][4][2], const Unit& u, int seg, int wr, int wc, int, int) const { scale(acc, u, seg, wr, wc); }
    __device__ __forceinline__ void operator()(f32x4 (&acc)[2][2][4][2], const Unit& u, int wr, int wc, int, int) const {
        scale(acc, u, u.mode ? u.aux : 3, wr, wc);
        const int lane_ = lane_now(), fr = lane_ & 15, fq = lane_ >> 4;
        const int row0 = (u.mode ? (u.pm - 64) * BM + 512 * u.aux : u.pm * BM) + wr * 64 + fr, c0 = 256 * u.pn + wc * 32 + 4 * fq;
        bf16_t* O = u.mode ? Os : this->O;
#pragma unroll
        for (int ai = 0; ai < 2; ++ai)
#pragma unroll
            for (int m = 0; m < 4; ++m) { bf16_t* rowp = O + (size_t)(row0 + ai * HALF + m * 16) * DM + c0;
#pragma unroll
                for (int bj = 0; bj < 2; ++bj)
#pragma unroll
                    for (int n = 0; n < 2; ++n) { const f32x4 v = acc[ai][bj][m][n]; u32x2 w; w.x = cvt_pk_bf16(v[0], v[1]); w.y = cvt_pk_bf16(v[2], v[3]); *(u32x2*)(rowp + bj * HALF + n * 16) = w; } }
    }
};

struct PanelStats {
    unsigned* xbuf;
    unsigned* cnt;
    __device__ __forceinline__ void run(const f32x4 (&v)[2][2][4][2], const Unit& u, int wr, int wc, PG8_LAS unsigned char* lds, int wid) const {
        const int lane = lane_now(), fr = lane & 15, fq = lane >> 4;
        PG8_LAS f32x2* P = (PG8_LAS f32x2*)lds;
        PG8_LAS f32x2* S = (PG8_LAS f32x2*)(lds + 8192);
#pragma unroll
        for (int ai = 0; ai < 2; ++ai)
#pragma unroll
            for (int m = 0; m < 4; ++m) {
                float s = 0.f;
#pragma unroll
                for (int bj = 0; bj < 2; ++bj)
#pragma unroll
                    for (int n = 0; n < 2; ++n) { const f32x4 x = v[ai][bj][m][n]; s += (x[0] + x[1]) + (x[2] + x[3]); }
                s += __builtin_bit_cast(float, __builtin_amdgcn_ds_bpermute((lane ^ 16) << 2, __builtin_bit_cast(int, s))); s += __builtin_bit_cast(float, __builtin_amdgcn_ds_bpermute((lane ^ 32) << 2, __builtin_bit_cast(int, s)));
                const float mw = s * (1.0f / 64.0f); float q = 0.f;
#pragma unroll
                for (int bj = 0; bj < 2; ++bj)
#pragma unroll
                    for (int n = 0; n < 2; ++n) { const f32x4 d = v[ai][bj][m][n] - mw; q += (d[0] * d[0] + d[1] * d[1]) + (d[2] * d[2] + d[3] * d[3]); }
                q += __builtin_bit_cast(float, __builtin_amdgcn_ds_bpermute((lane ^ 16) << 2, __builtin_bit_cast(int, q))); q += __builtin_bit_cast(float, __builtin_amdgcn_ds_bpermute((lane ^ 32) << 2, __builtin_bit_cast(int, q)));
                if (fq == 0) P[(ai * HALF + wr * 64 + m * 16 + fr) * 4 + wc] = (f32x2){mw, q};
            }
        asm volatile("s_waitcnt lgkmcnt(0)" ::: "memory"); __builtin_amdgcn_s_barrier(); asm volatile("" ::: "memory");
        const int row = wid * 32 + (lane & 31);
        if (lane < 32) {
            const f32x2 a = P[row * 4 + 0], b = P[row * 4 + 1], c = P[row * 4 + 2], d = P[row * 4 + 3];
            const float mt = (a.x + b.x + c.x + d.x) * 0.25f;
            const float da = a.x - mt, db = b.x - mt, dc = c.x - mt, dd = d.x - mt;
            const float m2 = (a.y + b.y) + (c.y + d.y) + 64.0f * ((da * da + db * db) + (dc * dc + dd * dd));
            unsigned long long* slot = (unsigned long long*)xbuf + ((size_t)(u.pm * BM + row) * 4 + u.pn);
            __hip_atomic_store(slot, ((unsigned long long)__float_as_uint(m2) << 32) | __float_as_uint(mt), __ATOMIC_RELAXED, __HIP_MEMORY_SCOPE_AGENT);
        }
        asm volatile("s_waitcnt vmcnt(0)" ::: "memory");
        if (lane == 0) __hip_atomic_fetch_add(cnt + 64 * u.pm, 1u, __ATOMIC_RELAXED, __HIP_MEMORY_SCOPE_AGENT);
        if (wid == 0) {
            unsigned spins = 0;
            while ((unsigned)__builtin_amdgcn_readfirstlane(__hip_atomic_load(cnt + 64 * u.pm, __ATOMIC_RELAXED, __HIP_MEMORY_SCOPE_AGENT)) < 32u) { __builtin_amdgcn_s_sleep(2); if (++spins > (1u << 20)) break; }
            __builtin_amdgcn_fence(__ATOMIC_ACQUIRE, "agent");
        }
        asm volatile("s_waitcnt vmcnt(0) lgkmcnt(0)" ::: "memory"); __builtin_amdgcn_s_barrier(); asm volatile("" ::: "memory");
        if (lane < 32) {
            const unsigned long long* slot = (const unsigned long long*)xbuf + (size_t)(u.pm * BM + row) * 4; float mt[4], m2[4]; float ms = 0.f;
#pragma unroll
            for (int t = 0; t < 4; ++t) { const unsigned long long w = __hip_atomic_load(slot + t, __ATOMIC_RELAXED, __HIP_MEMORY_SCOPE_AGENT); mt[t] = __uint_as_float((unsigned)w); m2[t] = __uint_as_float((unsigned)(w >> 32)); ms += mt[t]; }
            const float mean = ms * 0.25f; float q = 0.f;
#pragma unroll
            for (int t = 0; t < 4; ++t) { const float dm = mt[t] - mean; q += m2[t] + 256.0f * dm * dm; }
            S[row] = (f32x2){mean, __builtin_amdgcn_rsqf(q * (1.0f / 1024.0f) + LN_EPS)};
        }
        asm volatile("s_waitcnt lgkmcnt(0)" ::: "memory"); __builtin_amdgcn_s_barrier(); asm volatile("" ::: "memory");
    }
};
struct EpiRes {
    static constexpr bool PERM = false, MIDK = false;
    __device__ __forceinline__ void init(f32x4 (&acc)[2][2][4][2], const Unit& u, int wr, int wc) const {
        if (u.mode) { acc_zero(acc); return; }
        const int lane_ = lane_now(), fr = lane_ & 15, fq = lane_ >> 4;
        const float* bp0 = baseP + (size_t)(u.pm * BM + wr * 64 + fr) * DM + 256 * u.pn + wc * 32 + 4 * fq;
#pragma unroll
        for (int ai = 0; ai < 2; ++ai)
#pragma unroll
            for (int m = 0; m < 4; ++m)
#pragma unroll
                for (int bj = 0; bj < 2; ++bj)
#pragma unroll
                    for (int n = 0; n < 2; ++n) acc[ai][bj][m][n] = *(const f32x4*)(bp0 + (size_t)(ai * HALF + m * 16) * DM + bj * HALF + n * 16) * ALPHA;
    }
    const float* baseP; float* out; bf16_t* xb; const float* lng; const float* lnb; float* slab; PanelStats st; PG8_LAS unsigned char* xlds; int wid;
    __device__ __forceinline__ void midk(f32x4 (&)[2][2][4][2], const Unit&, int, int, int, int, int) const {}
    __device__ __forceinline__ void operator()(f32x4 (&acc)[2][2][4][2], const Unit& u, int wr, int wc, int fr_, int fq_) const {
        const int lane_ = lane_now(), fr = lane_ & 15, fq = lane_ >> 4; (void)fr_; (void)fq_;
        const int row0 = u.pm * BM + wr * 64 + fr, c0 = 256 * u.pn + wc * 32 + 4 * fq;
        if (u.mode) {
#pragma unroll
            for (int ai = 0; ai < 2; ++ai)
#pragma unroll
                for (int m = 0; m < 4; ++m) { float* op = slab + ((size_t)u.aux * 512 + (row0 - MP) + ai * HALF + m * 16) * DM + c0;
#pragma unroll
                    for (int bj = 0; bj < 2; ++bj)
#pragma unroll
                        for (int n = 0; n < 2; ++n) *(f32x4*)(op + bj * HALF + n * 16) = acc[ai][bj][m][n]; }
            return; }
        st.run(acc, u, wr, wc, xlds, wid);
        const PG8_LAS f32x2* S = (const PG8_LAS f32x2*)(xlds + 8192);
#pragma unroll
        for (int bj = 0; bj < 2; ++bj)
#pragma unroll
            for (int n = 0; n < 2; ++n) { const int cc = c0 + bj * HALF + n * 16; const f32x4 gv = *(const f32x4*)(lng + cc), bv = *(const f32x4*)(lnb + cc);
#pragma unroll
                for (int ai = 0; ai < 2; ++ai)
#pragma unroll
                    for (int m = 0; m < 4; ++m) { const int r = ai * HALF + wr * 64 + m * 16 + fr; const f32x2 sr = S[r]; const size_t off = (size_t)(u.pm * BM + r) * DM + cc;
                        const f32x4 o = (acc[ai][bj][m][n] - sr.x) * sr.y * gv + bv; *(f32x4*)(out + off) = o;
                        if (xb) { u32x2 w; w.x = cvt_pk_bf16(o[0], o[1]); w.y = cvt_pk_bf16(o[2], o[3]); *(u32x2*)(xb + off) = w; }
                        if (m & 1) asm volatile("" ::: "memory"); } }
    }
};

struct EpiSwi {
    static constexpr bool PERM = true, MIDK = false;
    __device__ __forceinline__ void init(f32x4 (&acc)[2][2][4][2], const Unit&, int, int) const { acc_zero(acc); }
    bf16_t* H;
    __device__ __forceinline__ void midk(f32x4 (&)[2][2][4][2], const Unit&, int, int, int, int, int) const {}
    __device__ __forceinline__ void operator()(f32x4 (&acc)[2][2][4][2], const Unit& u, int wr, int wc, int fr_, int fq_) const {
        const int lane_ = lane_now(), fr = lane_ & 15, fq = lane_ >> 4; (void)fr_; (void)fq_;
        const int row0 = u.pm * BM + wr * 64 + fr, c0 = 128 * u.pn + wc * 32 + 8 * fq;
#pragma unroll
        for (int ai = 0; ai < 2; ++ai)
#pragma unroll
            for (int m = 0; m < 4; ++m) { bf16_t* rowp = H + (size_t)(row0 + ai * HALF + m * 16) * FF + c0;
                const f32x4 g0 = acc[ai][0][m][0], g1 = acc[ai][0][m][1], u0 = acc[ai][1][m][0], u1 = acc[ai][1][m][1]; f32x4 v0, v1;
#pragma unroll
                for (int i = 0; i < 4; ++i) { v0[i] = g0[i] * sigmoidf_fast(g0[i]) * u0[i]; v1[i] = g1[i] * sigmoidf_fast(g1[i]) * u1[i]; }
                u32x4 w; w.x = cvt_pk_bf16(v0[0], v0[1]); w.y = cvt_pk_bf16(v0[2], v0[3]); w.z = cvt_pk_bf16(v1[0], v1[1]); w.w = cvt_pk_bf16(v1[2], v1[3]);
                *(u32x4*)rowp = w; }
    }
};

template <class Epi, class Sched, bool ALIGN_EPI>
__device__ __forceinline__ void gemm_phase(PG8_LAS unsigned char* lds, const Gemm g, const Sched& S, const Epi& E, int wave_id) {
    const int wid = opqs(wave_id), lane = lane_now(), tid = wid * 64 + lane, wr = wid >> 2, wc = wid & 3, fr = lane & 15, fq = lane >> 4;
    unsigned voffA[2], voffB[2];
#pragma unroll
    for (int i = 0; i < 2; ++i) { int R, C; stage_rc(tid * 16 + i * 8192, R, C); const int Rb = Epi::PERM ? ((R & ~31) + perm32(R & 31)) : R;
        voffA[i] = (unsigned)(R * g.lda + C) * 2u; voffB[i] = (unsigned)(Rb * g.ldb + C) * 2u; }
    const size_t kstep = (size_t)(BK * 2);
    const size_t hstepA = (size_t)HALF * g.lda * 2, hstepB = (size_t)HALF * g.ldb * 2;
    const unsigned ldsw = (unsigned)wid * 1024u;
    const int aoff = lds_byte(wr * 64 + fr, fq * 8), boff = lds_byte(wc * 32 + fr, fq * 8);
#define PG8_SA(b, h) (((b) * 2 + (h)) * HTB)
#define PG8_SB(b, h) ((4 + (b) * 2 + (h)) * HTB)
#define PG8_STAGE(bufoff, gbase, voff) do { _Pragma("unroll") for (int _i = 0; _i < 2; ++_i) \
        __builtin_amdgcn_global_load_lds((const unsigned*)((const char*)(gbase) + (voff)[_i]), (PG8_LAS unsigned*)(lds + (bufoff) + ldsw + _i * 8192), 16, 0, 0); } while (0)
#define PG8_LDA(dst, b, h) do { _Pragma("unroll") for (int m = 0; m < 4; ++m) _Pragma("unroll") for (int k = 0; k < 2; ++k) dst[m][k] = *(const PG8_LAS bf16x8*)(lds + PG8_SA(b, h) + aoff + m * 2048 + k * 1024); } while (0)
#define PG8_LDB(dst, b, h) do { _Pragma("unroll") for (int n = 0; n < 2; ++n) _Pragma("unroll") for (int k = 0; k < 2; ++k) dst[n][k] = *(const PG8_LAS bf16x8*)(lds + PG8_SB(b, h) + boff + n * 2048 + k * 1024); } while (0)
#define PG8_MMA(ai, bj, At, Bt) do { __builtin_amdgcn_s_setprio(1); _Pragma("unroll") for (int m = 0; m < 4; ++m) _Pragma("unroll") for (int n = 0; n < 2; ++n) _Pragma("unroll") for (int k = 0; k < 2; ++k) \
        acc[ai][bj][m][n] = __builtin_amdgcn_mfma_f32_16x16x32_bf16(Bt[n][k], At[m][k], acc[ai][bj][m][n], 0, 0, 0); __builtin_amdgcn_s_setprio(0); } while (0)
#define PG8_WAIT_V(n) asm volatile("s_waitcnt vmcnt(" #n ")" ::: "memory")
#define PG8_WAIT_L(n) asm volatile("s_waitcnt lgkmcnt(" #n ")" ::: "memory")
#define PG8_BAR __builtin_amdgcn_s_barrier()
#define PG8_SCHED __builtin_amdgcn_sched_barrier(0)
    Unit cur, nxt; int ui = 0;
    if (!S.next(0, cur, g)) return;
    f32x4 acc[2][2][4][2];
    E.init(acc, cur, wr, wc);
    bf16x8 At[4][2], B0[2][2], B1[2][2];
    const char* cA = (const char*)g.A + cur.offA; const char* cB = (const char*)g.Bt + cur.offB;
    PG8_STAGE(PG8_SB(0, 0), cB, voffB); PG8_STAGE(PG8_SB(0, 1), cB + hstepB, voffB); PG8_STAGE(PG8_SA(0, 0), cA, voffA); PG8_STAGE(PG8_SA(0, 1), cA + hstepA, voffA);
    if (wr == 1) PG8_BAR;
    PG8_WAIT_V(2); PG8_BAR;
    PG8_STAGE(PG8_SB(1, 0), cB + kstep, voffB); PG8_STAGE(PG8_SA(1, 0), cA + kstep, voffA); PG8_STAGE(PG8_SB(1, 1), cB + hstepB + kstep, voffB);
    PG8_WAIT_V(6); PG8_BAR;
    for (;;) {
        const bool has_next = S.next(ui + 1, nxt, g);
        const char* nA = has_next ? (const char*)g.A + nxt.offA : cA; const char* nB = has_next ? (const char*)g.Bt + nxt.offB : cB;
        const int nt = cur.nt, TSEG = Epi::MIDK ? 8 : nt;
        for (int t0 = 0; t0 < nt; t0 += TSEG) {
        if constexpr (Epi::MIDK) { if (t0 != 0) { PG8_SCHED; E.midk(acc, cur, t0 / TSEG - 1, wr, wc, 0, 0); PG8_SCHED; } }
#pragma unroll 1
        for (int t = t0; t < t0 + TSEG; t += 2) {
            const bool last = (t == nt - 2);
            const char* a1 = cA + (size_t)(t + 1) * kstep;
            const char* a2 = last ? nA : cA + (size_t)(t + 2) * kstep; const char* b2 = last ? nB : cB + (size_t)(t + 2) * kstep;
            const char* a3 = a2 + kstep; const char* b3 = b2 + kstep;
            PG8_LDB(B0, 0, 0); PG8_LDB(B1, 0, 1); PG8_SCHED; PG8_LDA(At, 0, 0); PG8_STAGE(PG8_SA(1, 1), a1 + hstepA, voffA);
            PG8_WAIT_V(8); PG8_WAIT_L(0); PG8_BAR; PG8_MMA(0, 0, At, B0); PG8_MMA(0, 1, At, B1); PG8_BAR; PG8_SCHED;
            PG8_LDA(At, 0, 1); PG8_STAGE(PG8_SB(0, 0), b2, voffB); PG8_STAGE(PG8_SB(0, 1), b2 + hstepB, voffB); PG8_STAGE(PG8_SA(0, 0), a2, voffA);
            PG8_WAIT_V(8); PG8_WAIT_L(0); PG8_BAR; PG8_MMA(1, 0, At, B0); PG8_MMA(1, 1, At, B1); PG8_BAR; PG8_SCHED;
            PG8_LDB(B0, 1, 0); PG8_LDB(B1, 1, 1); PG8_SCHED; PG8_LDA(At, 1, 0); PG8_STAGE(PG8_SA(0, 1), a2 + hstepA, voffA);
            PG8_WAIT_V(8); PG8_WAIT_L(0); PG8_BAR; PG8_MMA(0, 0, At, B0); PG8_MMA(0, 1, At, B1); PG8_BAR; PG8_SCHED;
            PG8_LDA(At, 1, 1); PG8_STAGE(PG8_SB(1, 0), b3, voffB); PG8_STAGE(PG8_SB(1, 1), b3 + hstepB, voffB); PG8_STAGE(PG8_SA(1, 0), a3, voffA);
            PG8_WAIT_V(8); PG8_WAIT_L(0); PG8_BAR; PG8_MMA(1, 0, At, B0); PG8_MMA(1, 1, At, B1); PG8_BAR; PG8_SCHED;
        }
        }
        if constexpr (ALIGN_EPI) { if (wr == 0) PG8_BAR; }
        E(acc, cur, wr, wc, 0, 0);
        if (!has_next) break;
        cur = nxt; cA = nA; cB = nB; ++ui;
        E.init(acc, cur, wr, wc);
        if constexpr (ALIGN_EPI) { if (wr == 1) PG8_BAR; }
    }
    PG8_WAIT_V(0);
    if constexpr (!ALIGN_EPI) { if (wr == 0) PG8_BAR; }
    PG8_BAR;
#undef PG8_SA
#undef PG8_SB
#undef PG8_STAGE
#undef PG8_LDA
#undef PG8_LDB
#undef PG8_MMA
#undef PG8_WAIT_V
#undef PG8_WAIT_L
#undef PG8_BAR
#undef PG8_SCHED
}
}

constexpr int NWAVES = 8;
constexpr int NPHASE = 19;
constexpr size_t MiB = 1u << 20;
constexpr size_t WS_CTL = 0, CTL_ZERO_BYTES = 1 * MiB;
constexpr size_t WS_WA = 1 * MiB;
constexpr size_t WS_XB = 18 * MiB;
constexpr size_t WS_Y = 51 * MiB;
constexpr size_t WS_ZG = 117 * MiB;
constexpr size_t WS_BT3 = 249 * MiB, WS_BT4 = 253 * MiB, WS_BT5 = WS_ZG + 96 * MiB, WS_BT6 = WS_ZG + 108 * MiB;
constexpr size_t WS_MB4S = WS_WA + 8 * MiB;
constexpr size_t WS_SLAB = WS_Y;
constexpr size_t WS_END = 255 * MiB;
static_assert(WS_XB + (size_t)M * DM * 2 <= WS_Y && WS_Y + (size_t)M * YC * 2 <= WS_ZG && WS_ZG + (size_t)M * GC * 2 <= WS_BT3 && WS_SLAB + (size_t)11 * 512 * DM * 4 <= WS_ZG, "ws map");
static_assert((size_t)M * FF * 2 <= 96 * MiB && WS_BT5 + (size_t)2 * FF * DM * 2 <= WS_BT6 && WS_BT6 + (size_t)DM * FF * 2 <= WS_BT3, "ws map 2");
constexpr int CW_TMO = 0, CW_CODE = 1, CW_BAR = 4096, CW_SEAM = 16384, SEAM_BANK = 8192;
constexpr size_t WS_XCH = WS_Y + 32 * MiB;
constexpr int XLDS_OFF = 131072 + 1024;
constexpr int RING_OFF = 0, RING_BYTES = 131072;
constexpr int LDSCTL_OFF = RING_BYTES, MISC_OFF = LDSCTL_OFF + 320;
constexpr int LDS_BYTES = 147456;

#define GAS __attribute__((address_space(1)))
#define LAS __attribute__((address_space(3)))
typedef unsigned short bf16;
typedef unsigned v4u __attribute__((ext_vector_type(4)));
typedef unsigned v2u __attribute__((ext_vector_type(2)));
typedef float f32x4 __attribute__((ext_vector_type(4)));
typedef float f32x2 __attribute__((ext_vector_type(2)));
typedef short bf16x8 __attribute__((ext_vector_type(8)));
typedef GAS unsigned gu32;
#define RLX_AGENT __ATOMIC_RELAXED, __HIP_MEMORY_SCOPE_AGENT
#define LDS_WAIT() asm volatile("s_waitcnt lgkmcnt(0)" ::: "memory")
#define VM_WAIT() asm volatile("s_waitcnt vmcnt(0)" ::: "memory")
__device__ __forceinline__ unsigned pk2(float lo, float hi) { return pg8::cvt_pk_bf16(lo, hi); }
__device__ __forceinline__ float bflo(unsigned v) { return __uint_as_float(v << 16); }
__device__ __forceinline__ float bfhi(unsigned v) { return __uint_as_float(v & 0xffff0000u); }
__device__ __forceinline__ float bf1(unsigned short h) { return __uint_as_float((unsigned)h << 16); }
__device__ __forceinline__ unsigned short f2bf(float f) { return (unsigned short)(pg8::cvt_pk_bf16(f, 0.f) & 0xffffu); }

#define XB_TMO      128
#define XB_XCNT(j)  (256  + 64 * (j))
#define XB_XSUB(j)  (1280 + 64 * (j))
#define XB_XGEN(j)  (2304 + 64 * (j))
#define XB_TOP      3328
#define XB_TOPGEN   3392
#define XCD_BAR_WORDS 3456
#define XB_SPIN_CAP (1u << 18)
__device__ __forceinline__ unsigned xb_ld(unsigned* p)              { return __hip_atomic_load(p, __ATOMIC_RELAXED, __HIP_MEMORY_SCOPE_AGENT); }
__device__ __forceinline__ unsigned xb_add(unsigned* p, unsigned v) { return __hip_atomic_fetch_add(p, v, __ATOMIC_RELAXED, __HIP_MEMORY_SCOPE_AGENT); }
__device__ __forceinline__ unsigned xb_xcc_id() { return (unsigned)__builtin_amdgcn_s_getreg((3 << 11) | 20) & 0xFu; }
#define XB_SPIN(cond, bar) do { unsigned _sp = 0; while (cond) { __builtin_amdgcn_s_sleep(1); \
    if ((++_sp & 255u) == 0u) { if (xb_ld(&(bar)[XB_TMO])) break; if (_sp > XB_SPIN_CAP) { atomicAdd(&(bar)[XB_TMO], 1u); break; } } } } while (0)
struct XcdBarrier { unsigned* bar; unsigned x; volatile LAS unsigned* st; };
__device__ __forceinline__ XcdBarrier xcd_barrier_post(unsigned* bar, volatile LAS unsigned* st) {
    XcdBarrier b; b.bar = bar; b.x = xb_xcc_id(); b.st = st;
    if (threadIdx.x == 0) (void)xb_add(&bar[XB_XCNT(b.x)], 1u);
    return b;
}
__device__ __forceinline__ void xcd_barrier_complete(unsigned* bar, unsigned x, unsigned& nloc, unsigned& nx) {
    const unsigned G = gridDim.x * gridDim.y * gridDim.z;
    unsigned sum, cnt, mine, sp = 0u;
    for (;;) {
        sum = 0u; cnt = 0u; mine = 0u;
#pragma unroll
        for (unsigned j = 0; j < 16; ++j) { const unsigned c = xb_ld(&bar[XB_XCNT(j)]); sum += c; cnt += (c > 0u) ? 1u : 0u; mine = (j == x) ? c : mine; }
        if (sum == G) break;
        __builtin_amdgcn_s_sleep(1);
        if ((++sp & 255u) == 0u) { if (xb_ld(&bar[XB_TMO])) break; if (sp > XB_SPIN_CAP) { atomicAdd(&bar[XB_TMO], 1u); break; } }
    }
    nloc = mine > 0u ? mine : 1u; nx = cnt > 0u ? cnt : 1u;
}
__device__ __forceinline__ void xcd_barrier(const XcdBarrier& b) {
    asm volatile("s_waitcnt vmcnt(0)" ::: "memory");
    __syncthreads();
    if (threadIdx.x == 0) {
        unsigned* bar = b.bar;
        __builtin_amdgcn_s_waitcnt(0);
        unsigned nloc = b.st[0], nx = b.st[1];
        if (nloc == 0u) { xcd_barrier_complete(bar, b.x, nloc, nx); b.st[0] = nloc; b.st[1] = nx; }
        const unsigned old = xb_add(&bar[XB_XSUB(b.x)], 1u);
        const unsigned gen = old / nloc;
        if (old + 1u == (gen + 1u) * nloc) {
            __builtin_amdgcn_fence(__ATOMIC_RELEASE, "agent");
            asm volatile("s_waitcnt vmcnt(0)" ::: "memory");
            const unsigned og = xb_add(&bar[XB_TOP], 1u);
            const unsigned tg = og / nx;
            if (og + 1u == (tg + 1u) * nx) xb_add(&bar[XB_TOPGEN], 1u);
            else XB_SPIN(xb_ld(&bar[XB_TOPGEN]) == tg, bar);
            __builtin_amdgcn_fence(__ATOMIC_ACQUIRE, "agent");
            xb_add(&bar[XB_XGEN(b.x)], 1u);
            asm volatile("s_waitcnt vmcnt(0)" ::: "memory");
        } else {
            XB_SPIN(xb_ld(&bar[XB_XGEN(b.x)]) == gen, bar);
            __builtin_amdgcn_fence(__ATOMIC_ACQUIRE, "agent");
            asm volatile("s_waitcnt vmcnt(0)" ::: "memory");
        }
    }
    __syncthreads();
}

struct Frame {
    LAS unsigned char* lds;
    volatile LAS unsigned* MISC;
    gu32* ctl;
    int tid, lane, wave, G, bid;
    const float* const* in;
    float* out;
    unsigned char* ws;
};
enum { I_XP = 0, I_XS, I_SH, I_SRGC, I_SCF, I_SPOOL, I_SSC, I_WIN, I_RGCW, I_RGCB, I_RGWA, I_RGBA, I_RGWX, I_RGBX, I_LAM, I_CFW, I_CFB, I_CFG, I_CFBB, I_POOLW, I_POOLS, I_SCW,
       I_WBR, I_WOUT, I_LN1G, I_LN1B, I_WG, I_WU, I_WD, I_LN2G, I_LN2B };

__device__ __forceinline__ float shfl_idx(float v, int src_lane) { return __builtin_bit_cast(float, __builtin_amdgcn_ds_bpermute(src_lane << 2, __builtin_bit_cast(int, v))); }
__device__ __forceinline__ float wave_sum(float v, int lane) {
#pragma unroll
    for (int o = 1; o < 64; o <<= 1) v += shfl_idx(v, lane ^ o);
    return v;
}

enum { RM_ID = 0, RM_WIN = 1, RM_GU = 2 };
template <int MODE> __device__ __forceinline__ int rowmap(int s, int extra) {
    if (MODE == RM_ID) return s;
    if (MODE == RM_GU) return 256 * (s >> 7) + (s & 127) + extra;
    if (s < 1024) return s;
    if (s < 2048) { const int j = ((s - 1024) >> 7) & 3; return 1024 + 256 * j + (s >= 1536 ? 128 : 0) + (s & 127); }
    if (s < 3072) return s;
    if (s < 4096) { const int j = ((s - 3072) >> 7) & 3; return 3072 + 256 * j + (s >= 3584 ? 128 : 0) + (s & 127); }
    const int g = (s - 4096) >> 10, ch = s & 1023, pn = ch >> 6, chl = ch & 63, wc = chl >> 4, fq = (chl >> 2) & 3, i = chl & 3;
    return 4096 + 256 * pn + 128 * (g >> 1) + 32 * wc + 8 * fq + 4 * (g & 1) + i;
}
template <int MODE>
__device__ __forceinline__ void transpose_item(const float* W, int K, int N, bf16* WT, int dst_ld, int dst_koff, int extra, LAS float* scr, int item, int lane) {
    const int nblk = N / 32, kb = item / nblk, nb = item % nblk, k0 = 64 * kb, n0 = 32 * nb;
#pragma unroll 8
    for (int i = 0; i < 32; ++i) { const int kk = 2 * i + (lane >> 5); scr[kk * 33 + (lane & 31)] = W[(size_t)(k0 + kk) * N + n0 + (lane & 31)]; }
    LDS_WAIT(); asm volatile("" ::: "memory");
    const int c = lane & 7; const float sc = (MODE == RM_WIN && n0 >= 4096) ? -1.44269504089f : 1.0f;
#pragma unroll
    for (int j = 0; j < 4; ++j) { const int n = (lane >> 3) + 8 * j; const LAS float* s = scr + (8 * c) * 33 + n;
        v4u o; o.x = pk2(s[0 * 33] * sc, s[1 * 33] * sc); o.y = pk2(s[2 * 33] * sc, s[3 * 33] * sc); o.z = pk2(s[4 * 33] * sc, s[5 * 33] * sc); o.w = pk2(s[6 * 33] * sc, s[7 * 33] * sc);
        *(GAS v4u*)(WT + (size_t)rowmap<MODE>(n0 + n, extra) * dst_ld + dst_koff + k0 + 8 * c) = o; }
    LDS_WAIT(); asm volatile("" ::: "memory");
}
template <int MODE>
__device__ __forceinline__ void convert_matrix(Frame& F, const float* W, int K, int N, bf16* WT, int dst_ld, int dst_koff, int extra, int gw, int NGW, int first = 0) {
    LAS float* scr = (LAS float*)(F.lds + RING_OFF + F.wave * 16384);
    const int nitems = (K / 64) * (N / 32);
    int it0 = gw - first; if (it0 < 0) it0 += ((-it0 + NGW - 1) / NGW) * NGW;
    for (int it = it0; it < nitems; it += NGW) transpose_item<MODE>(W, K, N, WT, dst_ld, dst_koff, extra, scr, it, F.lane);
}
__device__ __forceinline__ void compose_pool(Frame& F, int layer, bf16* Bt3, int gw, int NGW, int first = 0) {
    const float* pw = F.in[I_POOLW] + (size_t)layer * 4 * 128 * 128; const float* ps = F.in[I_POOLS] + layer * 512; const float* Wb2 = F.in[I_WBR] + ((size_t)layer * 4 + 2) * 512 * 1024;
    const int lane = F.lane;
    LAS float* Pl = (LAS float*)(F.lds + RING_OFF + F.wave * 16384);
    int id0 = gw - first; if (id0 < 0) id0 += ((-id0 + NGW - 1) / NGW) * NGW;
    for (int id = id0; id < 512; id += NGW) {
        const int g = __builtin_amdgcn_readfirstlane(id >> 7), c0 = __builtin_amdgcn_readfirstlane(8 * ((id >> 3) & 15)), d0 = 128 * (id & 7) + 2 * lane;
#pragma unroll
        for (int k = 0; k < 4; ++k) { const int idx4 = lane + 64 * k, i = idx4 >> 5, e4 = (idx4 & 31) * 4;
            const f32x4 pv = *(const GAS f32x4*)(pw + ((size_t)g * 128 + c0 + i) * 128 + e4), sv = *(const GAS f32x4*)(ps + 128 * g + e4);
            Pl[(e4 + 0) * 8 + i] = pv.x * sv.x; Pl[(e4 + 1) * 8 + i] = pv.y * sv.y; Pl[(e4 + 2) * 8 + i] = pv.z * sv.z; Pl[(e4 + 3) * 8 + i] = pv.w * sv.w; }
        LDS_WAIT(); asm volatile("" ::: "memory");
        f32x2 acc[8];
#pragma unroll
        for (int i = 0; i < 8; ++i) acc[i] = (f32x2){0.f, 0.f};
        const float* wrow = Wb2 + (size_t)(128 * g) * 1024 + d0;
#pragma unroll 1
        for (int e0 = 0; e0 < 128; e0 += 8) {
            f32x2 wv[8];
#pragma unroll
            for (int k = 0; k < 8; ++k) wv[k] = *(const GAS f32x2*)(wrow + (size_t)(e0 + k) * 1024);
#pragma unroll
            for (int k = 0; k < 8; ++k) { const f32x4 p0 = *(const LAS f32x4*)(Pl + (e0 + k) * 8), p1 = *(const LAS f32x4*)(Pl + (e0 + k) * 8 + 4);
#pragma unroll
                for (int i = 0; i < 4; ++i) { acc[i] += wv[k] * p0[i]; acc[4 + i] += wv[k] * p1[i]; } }
        }
        v4u o0, o1;
        o0.x = pk2(acc[0].x, acc[1].x); o0.y = pk2(acc[2].x, acc[3].x); o0.z = pk2(acc[4].x, acc[5].x); o0.w = pk2(acc[6].x, acc[7].x);
        o1.x = pk2(acc[0].y, acc[1].y); o1.y = pk2(acc[2].y, acc[3].y); o1.z = pk2(acc[4].y, acc[5].y); o1.w = pk2(acc[6].y, acc[7].y);
        *(GAS v4u*)(Bt3 + (size_t)d0 * 2048 + 1024 + 128 * g + c0) = o0; *(GAS v4u*)(Bt3 + (size_t)(d0 + 1) * 2048 + 1024 + 128 * g + c0) = o1;
        LDS_WAIT(); asm volatile("" ::: "memory");
    }
}

__device__ __forceinline__ const float* xrow_in(Frame& F, int m) { return m < MP ? F.in[I_XP] + (size_t)m * DM : F.in[I_XS] + (size_t)(m - MP) * DM; }
__device__ __forceinline__ void x_to_bf16(Frame& F, bf16* XB) {
    const int gw = F.bid * NWAVES + F.wave, NGW = F.G * NWAVES;
    for (int m0 = 4 * gw; m0 < M; m0 += 4 * NGW) {
        f32x4 v[4][4];
#pragma unroll
        for (int k = 0; k < 4; ++k) { const GAS f32x4* xr = (const GAS f32x4*)xrow_in(F, m0 + k) + F.lane;
#pragma unroll
            for (int j = 0; j < 4; ++j) v[k][j] = xr[64 * j]; }
#pragma unroll
        for (int k = 0; k < 4; ++k) { GAS v2u* o = (GAS v2u*)(XB + (size_t)(m0 + k) * DM) + F.lane;
#pragma unroll
            for (int j = 0; j < 4; ++j) o[64 * j] = (v2u){pk2(v[k][j].x, v[k][j].y), pk2(v[k][j].z, v[k][j].w)}; } }
}
__device__ __forceinline__ void ln_rows(Frame& F, const float* V, float* O, const float* g, const float* b, bf16* XB, const float* sbase, const float* slab, int nslab) {
    const int gw = F.bid * NWAVES + F.wave, NGW = F.G * NWAVES;
    f32x4 gv[4], bv[4];
#pragma unroll
    for (int j = 0; j < 4; ++j) { gv[j] = ((const GAS f32x4*)g)[F.lane + 64 * j]; bv[j] = ((const GAS f32x4*)b)[F.lane + 64 * j]; }
    for (int m = MP + gw; m < M; m += NGW) {
        const GAS f32x4* xr = (const GAS f32x4*)(V + (size_t)m * DM) + F.lane; GAS f32x4* orow = (GAS f32x4*)(O + (size_t)m * DM) + F.lane;
        f32x4 v[4]; float s = 0.f;
#pragma unroll
        for (int j = 0; j < 4; ++j) v[j] = xr[64 * j];
        if (m >= MP) { const GAS f32x4* br = (const GAS f32x4*)(sbase + (size_t)(m - MP) * DM) + F.lane;
#pragma unroll
            for (int j = 0; j < 4; ++j) v[j] = br[64 * j] * ALPHA;
            for (int sl = 0; sl < nslab; ++sl) { const GAS f32x4* sr = (const GAS f32x4*)(slab + ((size_t)sl * 512 + (m - MP)) * DM) + F.lane;
#pragma unroll
                for (int j = 0; j < 4; ++j) v[j] += sr[64 * j]; } }
#pragma unroll
        for (int j = 0; j < 4; ++j) s += (v[j].x + v[j].y) + (v[j].z + v[j].w);
        const float mean = wave_sum(s, F.lane) * (1.f / DM); float s2 = 0.f;
#pragma unroll
        for (int j = 0; j < 4; ++j) { v[j] = v[j] - mean; s2 += (v[j].x * v[j].x + v[j].y * v[j].y) + (v[j].z * v[j].z + v[j].w * v[j].w); }
        const float rstd = __builtin_amdgcn_rsqf(wave_sum(s2, F.lane) * (1.f / DM) + LN_EPS);
#pragma unroll
        for (int j = 0; j < 4; ++j) { v[j] = v[j] * rstd * gv[j] + bv[j]; orow[64 * j] = v[j]; }
        if (XB) { GAS v2u* o = (GAS v2u*)(XB + (size_t)m * DM) + F.lane;
#pragma unroll
            for (int j = 0; j < 4; ++j) o[64 * j] = (v2u){pk2(v[j].x, v[j].y), pk2(v[j].z, v[j].w)}; }
    }
}

__device__ __forceinline__ float softplusf_acc(float x) { return fmaxf(x, 0.f) + log1pf(__expf(-fabsf(x))); }
__device__ __forceinline__ float expm1_neg(float x) {
    const float p = x * (1.f + x * (0.5f + x * (1.f / 6.f + x * (1.f / 24.f + x * (1.f / 120.f + x * (1.f / 720.f + x * (1.f / 5040.f)))))));
    return x > -0.25f ? p : __expf(x) - 1.f;
}
constexpr int PATCH_STRIDE = 144;

struct ALane {
    float cwD[4], cbD, ba, bx, ck;
    bf16x8 Ba[4][2], Bx[4][2];
};
constexpr int PATCH_BYTES = 5120, ASLOT_OFF = 8 * PATCH_BYTES;
__device__ __forceinline__ void a_setup(Frame& F, int layer, int n, int q, ALane& L) {
    const int c = F.lane & 15, kg = F.lane >> 4, och = 64 * n + 16 * q + c;
    const float* cw = F.in[I_RGCW] + (size_t)layer * 4 * 512 + 64 * n; const float* cb = F.in[I_RGCB] + layer * 512 + 64 * n;
#pragma unroll
    for (int j = 0; j < 4; ++j) L.cwD[j] = cw[j * 512 + 16 * q + c];
    L.cbD = cb[16 * q + c];
    L.ck = 8.0f * softplusf_acc(-F.in[I_LAM][layer * 512 + och]);
    const float* wa = F.in[I_RGWA] + ((size_t)layer * 8 + n) * 4096 + 16 * q + c; const float* wx = F.in[I_RGWX] + ((size_t)layer * 8 + n) * 4096 + 16 * q + c;
    float wav[16], wxv[16], cbv[16];
#pragma unroll
    for (int e = 0; e < 16; ++e) { const int k = (e < 8 ? 8 * kg + e : 32 + 8 * kg + (e - 8)); wav[e] = wa[k * 64]; wxv[e] = wx[k * 64]; cbv[e] = cb[k]; }
#pragma unroll
    for (int j = 0; j < 4; ++j) { float t[16];
#pragma unroll
        for (int e = 0; e < 16; ++e) t[e] = cw[j * 512 + (e < 8 ? 8 * kg + e : 32 + 8 * kg + (e - 8))];
        L.Ba[j][0] = __builtin_bit_cast(bf16x8, (v4u){pk2(wav[0] * t[0], wav[1] * t[1]), pk2(wav[2] * t[2], wav[3] * t[3]), pk2(wav[4] * t[4], wav[5] * t[5]), pk2(wav[6] * t[6], wav[7] * t[7])});
        L.Ba[j][1] = __builtin_bit_cast(bf16x8, (v4u){pk2(wav[8] * t[8], wav[9] * t[9]), pk2(wav[10] * t[10], wav[11] * t[11]), pk2(wav[12] * t[12], wav[13] * t[13]), pk2(wav[14] * t[14], wav[15] * t[15])});
        L.Bx[j][0] = __builtin_bit_cast(bf16x8, (v4u){pk2(wxv[0] * t[0], wxv[1] * t[1]), pk2(wxv[2] * t[2], wxv[3] * t[3]), pk2(wxv[4] * t[4], wxv[5] * t[5]), pk2(wxv[6] * t[6], wxv[7] * t[7])});
        L.Bx[j][1] = __builtin_bit_cast(bf16x8, (v4u){pk2(wxv[8] * t[8], wxv[9] * t[9]), pk2(wxv[10] * t[10], wxv[11] * t[11]), pk2(wxv[12] * t[12], wxv[13] * t[13]), pk2(wxv[14] * t[14], wxv[15] * t[15])}); }
    float sa = 0.f, sx = 0.f;
#pragma unroll
    for (int e = 0; e < 16; ++e) { sa = fmaf(cbv[e], wav[e], sa); sx = fmaf(cbv[e], wxv[e], sx); }
    sa += shfl_idx(sa, F.lane ^ 16); sa += shfl_idx(sa, F.lane ^ 32); sx += shfl_idx(sx, F.lane ^ 16); sx += shfl_idx(sx, F.lane ^ 32);
    L.ba = F.in[I_RGBA][layer * 512 + och] + sa; L.bx = F.in[I_RGBX][layer * 512 + och] + sx;
}
__device__ __forceinline__ void a_block(const ALane& L, const LAS unsigned char* patch, int rowA0, int baseD, int q, int lane, float (&a)[4], float (&bb)[4]) {
    const int c = lane & 15, kg = lane >> 4;
    f32x4 accR = (f32x4){0.f, 0.f, 0.f, 0.f}, accI = (f32x4){0.f, 0.f, 0.f, 0.f};
#pragma unroll
    for (int j = 0; j < 4; ++j) { const LAS unsigned char* rp = patch + (rowA0 + j) * PATCH_STRIDE + 16 * kg;
        const bf16x8 A0 = *(const LAS bf16x8*)rp, A1 = *(const LAS bf16x8*)(rp + 64);
        accR = __builtin_amdgcn_mfma_f32_16x16x32_bf16(A0, L.Ba[j][0], accR, 0, 0, 0); accR = __builtin_amdgcn_mfma_f32_16x16x32_bf16(A1, L.Ba[j][1], accR, 0, 0, 0);
        accI = __builtin_amdgcn_mfma_f32_16x16x32_bf16(A0, L.Bx[j][0], accI, 0, 0, 0); accI = __builtin_amdgcn_mfma_f32_16x16x32_bf16(A1, L.Bx[j][1], accI, 0, 0, 0); }
    float pv[7];
#pragma unroll
    for (int k = 0; k < 7; ++k) pv[k] = bf1(*(const LAS unsigned short*)(patch + (baseD + k) * PATCH_STRIDE + 2 * (16 * q + c)));
#pragma unroll
    for (int r = 0; r < 4; ++r) {
        const float xd = L.cbD + L.cwD[0] * pv[r] + L.cwD[1] * pv[r + 1] + L.cwD[2] * pv[r + 2] + L.cwD[3] * pv[r + 3];
        const float rr = pg8::sigmoidf_fast(accR[r] + L.ba), ii = pg8::sigmoidf_fast(accI[r] + L.bx);
        const float la = -L.ck * rr;
        const float av = __builtin_amdgcn_exp2f(1.44269504089f * la);
        a[r] = av; bb[r] = __builtin_amdgcn_sqrtf(fmaxf(1.f - av * av, 0.f)) * (ii * xd);
    }
}
struct BlkScan { float Ac[4], Bc[4], EA, EB, WA, WB; };
__device__ __forceinline__ void blk_scan(const float (&a)[4], const float (&bb)[4], int lane, BlkScan& S) {
    const int c = lane & 15, g = lane >> 4;
    S.Ac[0] = a[0]; S.Bc[0] = bb[0];
#pragma unroll
    for (int r = 1; r < 4; ++r) { S.Ac[r] = a[r] * S.Ac[r - 1]; S.Bc[r] = a[r] * S.Bc[r - 1] + bb[r]; }
    float IA = S.Ac[3], IB = S.Bc[3];
    { const float pa = shfl_idx(IA, lane - 16), pb = shfl_idx(IB, lane - 16); if (g >= 1) { IB = IA * pb + IB; IA = IA * pa; } }
    { const float pa = shfl_idx(IA, lane - 32), pb = shfl_idx(IB, lane - 32); if (g >= 2) { IB = IA * pb + IB; IA = IA * pa; } }
    S.EA = shfl_idx(IA, lane - 16); S.EB = shfl_idx(IB, lane - 16); if (g == 0) { S.EA = 1.f; S.EB = 0.f; }
    S.WA = shfl_idx(IA, 48 + c); S.WB = shfl_idx(IB, 48 + c);
}
__device__ __forceinline__ void a_prompt_item(Frame& F, int layer, int item, const bf16* Z, bf16* Y) {
    const int b = item >> 5, n = (item >> 2) & 7, q = item & 3, lane = opqv(F.lane), w = F.wave, c = lane & 15, g = lane >> 4, och = 64 * n + 16 * q + c;
    ALane L; a_setup(F, layer, n, q, L);
    LAS unsigned char* patch = F.lds + RING_OFF + w * PATCH_BYTES;
    LAS f32x2* slots = (LAS f32x2*)(F.lds + RING_OFF + ASLOT_OFF);
    const bf16* Zb = Z + (size_t)b * SEQ * ZC;
    float hrun = 0.f;
    v4u pf[5];
    auto load_patch = [&](int tb) {
#pragma unroll
        for (int k = 0; k < 5; ++k) { const int ci = lane + 64 * k, pr = ci >> 3, cc = ci & 7, t = tb - 3 + pr;
            pf[k] = (ci < 280 && t >= 0) ? *(const GAS v4u*)(Zb + (size_t)t * ZC + 64 * n + 8 * cc) : (v4u){0u, 0u, 0u, 0u}; }
    };
    load_patch(32 * w);
    for (int it = 0; it < 8; ++it) {
        const int tb = 256 * it + 32 * w;
#pragma unroll
        for (int k = 0; k < 5; ++k) { const int ci = lane + 64 * k, pr = ci >> 3, cc = ci & 7; if (ci < 280) *(LAS v4u*)(patch + pr * PATCH_STRIDE + 16 * cc) = pf[k]; }
        if (it < 7) load_patch(tb + 256);
        unsigned short gav[8];
#pragma unroll
        for (int r = 0; r < 8; ++r) gav[r] = *(const GAS unsigned short*)(Zb + (size_t)(tb + 16 * (r >> 2) + 4 * g + (r & 3)) * ZC + 512 + och);
        asm volatile("" ::: "memory");
        float a0[4], b0[4], a1[4], b1[4];
        a_block(L, patch, lane & 15, 4 * g, q, lane, a0, b0);
        a_block(L, patch, 16 + (lane & 15), 16 + 4 * g, q, lane, a1, b1);
        BlkScan S0, S1; blk_scan(a0, b0, lane, S0); blk_scan(a1, b1, lane, S1);
        if (lane < 16) slots[((it & 1) * 8 + w) * 16 + c] = (f32x2){S0.WA * S1.WA, S1.WA * S0.WB + S1.WB};
        __syncthreads();
        float hin = hrun, hw = 0.f;
#pragma unroll
        for (int ww = 0; ww < 8; ++ww) { const f32x2 s = slots[((it & 1) * 8 + ww) * 16 + c]; if (ww == w) hw = hin; hin = s.x * hin + s.y; }
        hrun = hin;
        const float hg0 = S0.EA * hw + S0.EB, hw1 = S0.WA * hw + S0.WB, hg1 = S1.EA * hw1 + S1.EB;
#pragma unroll
        for (int r = 0; r < 4; ++r) { const float h = S0.Ac[r] * hg0 + S0.Bc[r];
            *(GAS unsigned short*)(Y + (size_t)(b * SEQ + tb + 4 * g + r) * YC + och) = f2bf(h * bf1(gav[r])); }
#pragma unroll
        for (int r = 0; r < 4; ++r) { const float h = S1.Ac[r] * hg1 + S1.Bc[r];
            *(GAS unsigned short*)(Y + (size_t)(b * SEQ + tb + 16 + 4 * g + r) * YC + och) = f2bf(h * bf1(gav[4 + r]));
            if (r == 3 && it == 7 && w == 7 && g == 3) F.out[O_PH + (size_t)(layer * 8 + b) * 512 + och] = h; }
    }
}
__device__ __forceinline__ void a_sample_task(Frame& F, int layer, int task, const bf16* Z, bf16* Y) {
    const int blk = task >> 5, n = (task >> 2) & 7, q = task & 3, lane = opqv(F.lane), c = lane & 15, g = lane >> 4, och = 64 * n + 16 * q + c, s0 = 4 * blk;
    ALane L; a_setup(F, layer, n, q, L);
    LAS unsigned char* patch = F.lds + RING_OFF + F.wave * PATCH_BYTES;
#pragma unroll
    for (int k = 0; k < 4; ++k) { const int ci = lane + 64 * k; if (ci < 224) { const int pr = ci >> 3, cc = ci & 7, sq = pr / 7, tau = pr - 7 * sq - 3, seq = s0 + sq; v4u v;
            if (tau < 0) { const GAS f32x4* sp = (const GAS f32x4*)(F.in[I_SRGC] + ((size_t)(layer * 128 + seq) * 3 + (tau + 3)) * 512 + 64 * n + 8 * cc); const f32x4 f0 = sp[0], f1 = sp[1];
                v = (v4u){pk2(f0.x, f0.y), pk2(f0.z, f0.w), pk2(f1.x, f1.y), pk2(f1.z, f1.w)}; }
            else v = *(const GAS v4u*)(Z + (size_t)(MP + 4 * seq + tau) * ZC + 64 * n + 8 * cc);
            *(LAS v4u*)(patch + pr * PATCH_STRIDE + 16 * cc) = v; } }
    asm volatile("" ::: "memory");
    float a[4], bb[4];
    a_block(L, patch, 7 * ((lane & 15) >> 2) + (lane & 3), 7 * g, q, lane, a, bb);
    const int seq = s0 + g;
    float h = F.in[I_SH][(size_t)(layer * 128 + seq) * 512 + och];
#pragma unroll
    for (int r = 0; r < 4; ++r) { h = a[r] * h + bb[r]; const size_t row = (size_t)(MP + 4 * seq + r);
        *(GAS unsigned short*)(Y + row * YC + och) = f2bf(h * bf1(*(const GAS unsigned short*)(Z + row * ZC + 512 + och))); }
    F.out[O_SH + (size_t)(layer * 128 + seq) * 512 + och] = h;
}

__device__ __forceinline__ void ln_silu_row(const LAS float* xr, const float* g, const float* b, bf16* dst, int lane) {
    const f32x4 v0 = *(const LAS f32x4*)(xr + 4 * lane), v1 = *(const LAS f32x4*)(xr + 256 + 4 * lane);
    const float s = (v0.x + v0.y) + (v0.z + v0.w) + (v1.x + v1.y) + (v1.z + v1.w);
    const float mean = wave_sum(s, lane) * (1.f / 512.f);
    const f32x4 d0 = v0 - mean, d1 = v1 - mean;
    const float s2 = (d0.x * d0.x + d0.y * d0.y) + (d0.z * d0.z + d0.w * d0.w) + (d1.x * d1.x + d1.y * d1.y) + (d1.z * d1.z + d1.w * d1.w);
    const float rstd = __builtin_amdgcn_rsqf(wave_sum(s2, lane) * (1.f / 512.f) + LN_EPS);
    const f32x4 g0 = *(const GAS f32x4*)(g + 4 * lane), g1 = *(const GAS f32x4*)(g + 256 + 4 * lane), b0 = *(const GAS f32x4*)(b + 4 * lane), b1 = *(const GAS f32x4*)(b + 256 + 4 * lane);
    f32x4 y0 = d0 * rstd * g0 + b0, y1 = d1 * rstd * g1 + b1;
#pragma unroll
    for (int i = 0; i < 4; ++i) { y0[i] = y0[i] * pg8::sigmoidf_fast(y0[i]); y1[i] = y1[i] * pg8::sigmoidf_fast(y1[i]); }
    *(GAS v2u*)(dst + 4 * lane) = (v2u){pk2(y0.x, y0.y), pk2(y0.z, y0.w)}; *(GAS v2u*)(dst + 256 + 4 * lane) = (v2u){pk2(y1.x, y1.y), pk2(y1.z, y1.w)};
}
__device__ __forceinline__ void ln_silu_rows4(const LAS float* xr, int rstride, const float* g, const float* b, bf16* dst, size_t dstride, int lane) {
    f32x4 v0[4], v1[4]; float s[4], s2[4];
#pragma unroll
    for (int k = 0; k < 4; ++k) { v0[k] = *(const LAS f32x4*)(xr + k * rstride + 4 * lane); v1[k] = *(const LAS f32x4*)(xr + k * rstride + 256 + 4 * lane);
        s[k] = (v0[k].x + v0[k].y) + (v0[k].z + v0[k].w) + (v1[k].x + v1[k].y) + (v1[k].z + v1[k].w); }
#pragma unroll
    for (int o = 1; o < 64; o <<= 1) {
#pragma unroll
        for (int k = 0; k < 4; ++k) s[k] += shfl_idx(s[k], lane ^ o); }
#pragma unroll
    for (int k = 0; k < 4; ++k) { const float mean = s[k] * (1.f / 512.f); v0[k] = v0[k] - mean; v1[k] = v1[k] - mean;
        s2[k] = (v0[k].x * v0[k].x + v0[k].y * v0[k].y) + (v0[k].z * v0[k].z + v0[k].w * v0[k].w) + (v1[k].x * v1[k].x + v1[k].y * v1[k].y) + (v1[k].z * v1[k].z + v1[k].w * v1[k].w); }
#pragma unroll
    for (int o = 1; o < 64; o <<= 1) {
#pragma unroll
        for (int k = 0; k < 4; ++k) s2[k] += shfl_idx(s2[k], lane ^ o); }
    const f32x4 g0 = *(const GAS f32x4*)(g + 4 * lane), g1 = *(const GAS f32x4*)(g + 256 + 4 * lane), b0 = *(const GAS f32x4*)(b + 4 * lane), b1 = *(const GAS f32x4*)(b + 256 + 4 * lane);
#pragma unroll
    for (int k = 0; k < 4; ++k) { const float rstd = __builtin_amdgcn_rsqf(s2[k] * (1.f / 512.f) + LN_EPS);
        f32x4 y0 = v0[k] * rstd * g0 + b0, y1 = v1[k] * rstd * g1 + b1;
#pragma unroll
        for (int i = 0; i < 4; ++i) { y0[i] = y0[i] * pg8::sigmoidf_fast(y0[i]); y1[i] = y1[i] * pg8::sigmoidf_fast(y1[i]); }
        bf16* d = dst + (size_t)k * dstride;
        *(GAS v2u*)(d + 4 * lane) = (v2u){pk2(y0.x, y0.y), pk2(y0.z, y0.w)}; *(GAS v2u*)(d + 256 + 4 * lane) = (v2u){pk2(y1.x, y1.y), pk2(y1.z, y1.w)}; }
}
__device__ __forceinline__ void b_prompt_item(Frame& F, int layer, int item, const bf16* Z, bf16* Y) {
    const int tidl = opqv(F.tid), b = item >> 5, t0 = 64 * (item & 31), p = tidl & 255, hh = tidl >> 8, ts = t0 + 32 * hh;
    const GAS unsigned* Zu = (const GAS unsigned*)(Z + (size_t)b * SEQ * ZC) + 512 + p;
    unsigned raw[62];
#pragma unroll
    for (int i = 0; i < 62; ++i) { const int t = ts - 30 + i; raw[i] = t >= 0 ? Zu[(size_t)t * (ZC / 2)] : 0u; }
    const float* cw = F.in[I_CFW] + (size_t)layer * 31 * 512 + 2 * p;
    f32x2 wj[31];
#pragma unroll
    for (int j = 0; j < 31; ++j) wj[j] = *(const GAS f32x2*)(cw + j * 512);
    const f32x2 bias = *(const GAS f32x2*)(F.in[I_CFB] + layer * 512 + 2 * p);
    f32x2 in[62];
#pragma unroll
    for (int i = 0; i < 62; ++i) in[i] = (f32x2){bflo(raw[i]), bfhi(raw[i])};
    LAS float* obuf = (LAS float*)(F.lds + RING_OFF);
#pragma unroll
    for (int i = 0; i < 32; ++i) { f32x2 o = bias;
#pragma unroll
        for (int j = 0; j < 31; ++j) o += wj[j] * in[i + j];
        *(LAS f32x2*)(obuf + (32 * hh + i) * 512 + 2 * p) = o; }
    __syncthreads();
    const float* lg = F.in[I_CFG] + layer * 512; const float* lb = F.in[I_CFBB] + layer * 512;
#pragma unroll 1
    for (int r = 8 * F.wave; r < 8 * F.wave + 8; r += 4) ln_silu_rows4(obuf + r * 512, 512, lg, lb, Y + (size_t)(b * SEQ + t0 + r) * YC + 512, YC, F.lane);
}
__device__ __forceinline__ void cd_prompt_item(Frame& F, int layer, int item, const bf16* Z, bf16* Y) {
    const int tidl = opqv(F.tid), b = item >> 5, t0 = 64 * (item & 31), p = tidl & 255, hh = tidl >> 8;
    const bf16* Zb = Z + (size_t)b * SEQ * ZC;
    LAS unsigned* cbuf = (LAS unsigned*)(F.lds + RING_OFF);
    { v4u tmp[10];
#pragma unroll
      for (int k = 0; k < 10; ++k) { const int ci = tidl + 512 * k, pr = ci >> 6, cc = ci & 63, t = t0 - 15 + pr;
          tmp[k] = (ci < 79 * 64 && t >= 0) ? *(const GAS v4u*)(Zb + (size_t)t * ZC + 1536 + 8 * cc) : (v4u){0u, 0u, 0u, 0u}; }
#pragma unroll
      for (int k = 0; k < 10; ++k) { const int ci = tidl + 512 * k, pr = ci >> 6, cc = ci & 63; if (ci < 79 * 64) *(LAS v4u*)(cbuf + pr * 256 + 4 * cc) = tmp[k]; } }
    const int ts = t0 + 32 * hh;
    unsigned uu[34], dd[32];
#pragma unroll
    for (int i = 0; i < 34; ++i) { const int t = ts - 2 + i; uu[i] = t >= 0 ? ((const GAS unsigned*)(Zb + (size_t)t * ZC))[1280 + p] : 0u; }
#pragma unroll
    for (int i = 0; i < 32; ++i) dd[i] = ((const GAS unsigned*)(Zb + (size_t)(ts + i) * ZC))[1024 + p];
    const f32x2 w0 = ((const GAS f32x2*)(F.in[I_SCW] + (size_t)(layer * 3 + 0) * 512))[p], w1 = ((const GAS f32x2*)(F.in[I_SCW] + (size_t)(layer * 3 + 1) * 512))[p],
                w2 = ((const GAS f32x2*)(F.in[I_SCW] + (size_t)(layer * 3 + 2) * 512))[p];
    __syncthreads();
    const int w = 2 << (p >> 6), rr0 = 15 + 32 * hh;
    f32x2 s = (f32x2){0.f, 0.f};
    for (int j = 0; j < w; ++j) { const unsigned v = cbuf[(rr0 - j) * 256 + p]; s += (f32x2){bflo(v), bfhi(v)}; }
    GAS unsigned* Yu = (GAS unsigned*)(Y + (size_t)(b * SEQ + ts) * YC) + p;
#pragma unroll
    for (int i = 0; i < 32; ++i) { const int t = ts + i, rr = rr0 + i;
        const unsigned cur = cbuf[rr * 256 + p]; const f32x2 cf = (f32x2){bflo(cur), bfhi(cur)};
        if (i > 0) { const unsigned old = cbuf[(rr - w) * 256 + p]; s += cf - (f32x2){bflo(old), bfhi(old)}; }
        const float ic = __builtin_amdgcn_rcpf((float)(t + 1 < w ? t + 1 : w));
        const f32x2 mm = s * ic - cf;
        Yu[(size_t)i * 1024 + 512] = pk2(mm.x, mm.y);
        const f32x2 cv = w0 * (f32x2){bflo(uu[i]), bfhi(uu[i])} + w1 * (f32x2){bflo(uu[i + 1]), bfhi(uu[i + 1])} + w2 * (f32x2){bflo(uu[i + 2]), bfhi(uu[i + 2])};
        const f32x2 yd = (f32x2){bflo(dd[i]), bfhi(dd[i])} * cv;
        Yu[(size_t)i * 1024 + 768] = pk2(yd.x, yd.y); }
}
__device__ __forceinline__ void s_sample_item(Frame& F, int layer, int s, const bf16* Z, bf16* Y) {
    const int ch = opqv(F.tid); const size_t ls = (size_t)layer * 128 + s;
    const bf16* Zr = Z + (size_t)(MP + 4 * s) * ZC; bf16* Yr = Y + (size_t)(MP + 4 * s) * YC;
    LAS float* obuf = (LAS float*)(F.lds + RING_OFF);
    float in[34], wv[31], pb[19], u[6], dbv[4];
#pragma unroll
    for (int j = 0; j < 30; ++j) in[j] = (F.in[I_SCF] + (ls * 30 + j) * 512)[ch];
#pragma unroll
    for (int j = 0; j < 15; ++j) pb[j] = (F.in[I_SPOOL] + (ls * 15 + j) * 512)[ch];
    u[0] = (F.in[I_SSC] + (ls * 2 + 0) * 512)[ch]; u[1] = (F.in[I_SSC] + (ls * 2 + 1) * 512)[ch];
#pragma unroll
    for (int r = 0; r < 4; ++r) { in[30 + r] = bf1((Zr + (size_t)r * ZC + 1024)[ch]); pb[15 + r] = bf1((Zr + (size_t)r * ZC + 1536)[ch]); u[2 + r] = bf1((Zr + (size_t)r * ZC + 2560)[ch]); dbv[r] = bf1((Zr + (size_t)r * ZC + 2048)[ch]); }
#pragma unroll
    for (int j = 0; j < 31; ++j) wv[j] = (F.in[I_CFW] + ((size_t)layer * 31 + j) * 512)[ch];
    const float bias = (F.in[I_CFB] + layer * 512)[ch];
    const float w0 = (F.in[I_SCW] + (size_t)(layer * 3 + 0) * 512)[ch], w1 = (F.in[I_SCW] + (size_t)(layer * 3 + 1) * 512)[ch], w2 = (F.in[I_SCW] + (size_t)(layer * 3 + 2) * 512)[ch];
    asm volatile("" ::: "memory");
#pragma unroll
    for (int j = 0; j < 26; ++j) (F.out + O_SCF + (ls * 30 + j) * 512)[ch] = in[j + 4];
#pragma unroll
    for (int r = 0; r < 4; ++r) { float o = bias;
#pragma unroll
        for (int j = 0; j < 31; ++j) o += wv[j] * in[r + j];
        obuf[r * 512 + ch] = o; }
#pragma unroll
    for (int j = 0; j < 11; ++j) (F.out + O_SPOOL + (ls * 15 + j) * 512)[ch] = pb[j + 4];
    const int gsel = ch >> 7;
#pragma unroll
    for (int r = 0; r < 4; ++r) { const int k = 15 + r;
        const float s2 = pb[k] + pb[k - 1], s4 = s2 + pb[k - 2] + pb[k - 3], s8 = s4 + (pb[k - 4] + pb[k - 5]) + (pb[k - 6] + pb[k - 7]);
        float s16 = s8;
#pragma unroll
        for (int j = 8; j < 16; ++j) s16 += pb[k - j];
        const float mv = (gsel == 0 ? s2 * 0.5f : gsel == 1 ? s4 * 0.25f : gsel == 2 ? s8 * 0.125f : s16 * 0.0625f) - pb[k];
        (Yr + (size_t)r * YC + 1024)[ch] = f2bf(mv); }
#pragma unroll
    for (int r = 0; r < 4; ++r) (Yr + (size_t)r * YC + 1536)[ch] = f2bf(dbv[r] * (w0 * u[r] + w1 * u[r + 1] + w2 * u[r + 2]));
    __syncthreads();
    if (F.wave < 4) ln_silu_row(obuf + F.wave * 512, F.in[I_CFG] + layer * 512, F.in[I_CFBB] + layer * 512, Yr + (size_t)F.wave * YC + 512, F.lane);
}

struct Args { const float* in[31]; float* out; unsigned char* ws; int ph_lo, ph_hi; };
__global__ void __launch_bounds__(NWAVES * 64, 2) hybrid_fwd(Args args) {
    extern __shared__ __attribute__((aligned(16))) unsigned char lds[];
    Frame F;
    F.lds = (LAS unsigned char*)lds;
    F.MISC = (volatile LAS unsigned*)(F.lds + MISC_OFF);
    const int wave0 = __builtin_amdgcn_readfirstlane((int)threadIdx.x >> 6);
    F.lane = lane_now(); F.wave = wave0; F.tid = F.wave * 64 + F.lane;
    F.G = gridDim.x; F.bid = blockIdx.x;
    F.ws = args.ws; F.out = args.out; F.ctl = (gu32*)(args.ws + WS_CTL);
    F.in = args.in;
    for (int u = F.tid; u < (LDS_BYTES - LDSCTL_OFF) / 4; u += NWAVES * 64) ((LAS unsigned*)(F.lds + LDSCTL_OFF))[u] = 0u;
    __syncthreads();
    XcdBarrier bar; bar.bar = (unsigned*)(F.ctl + CW_BAR); bar.x = 0; bar.st = nullptr;
    if (!MK_SPLIT) bar = xcd_barrier_post((unsigned*)(F.ctl + CW_BAR), F.MISC + 8);
    const int lo = args.ph_lo, hi = args.ph_hi;
#define IN(k) (lo <= (k) && (k) < hi)
#define REFRESH() do { F.lane = lane_now(); F.wave = opqs(wave0); F.tid = F.wave * 64 + F.lane; F.bid = opqs((int)blockIdx.x); } while (0)
#define SEAM(k) do { if (IN(k) && IN((k) + 1)) xcd_barrier(bar); } while (0)
    bf16* WA = (bf16*)(F.ws + WS_WA); bf16* XB = (bf16*)(F.ws + WS_XB); bf16* Y = (bf16*)(F.ws + WS_Y); bf16* Zm = (bf16*)(F.ws + WS_ZG); _Float16* Gb = (_Float16*)(F.ws + WS_ZG);
    bf16* Hb = (bf16*)(F.ws + WS_ZG); bf16* Bt3 = (bf16*)(F.ws + WS_BT3); bf16* Bt4 = (bf16*)(F.ws + WS_BT4); bf16* Bt5 = (bf16*)(F.ws + WS_BT5); bf16* Bt6 = (bf16*)(F.ws + WS_BT6);

    if (IN(0)) { REFRESH(); convert_matrix<RM_WIN>(F, F.in[I_WIN], DM, INC, WA, DM, 0, 0, F.bid * NWAVES + F.wave, F.G * NWAVES); REFRESH(); x_to_bf16(F, XB); }
    SEAM(0);

    for (int l = 0; l < 2; ++l) {
        const int pb = 1 + 9 * l;
        if (IN(pb + 0)) for (int rep = 0; rep < NREP(0); ++rep) { if (rep) xcd_barrier(bar); pg8::Gemm g{XB, WA, DM, DM}; pg8::UnitOrder S; S.init(pg8::SK_PLAIN, 4096, DM, F.G, F.bid, 0); pg8::EpiMix E{Zm, F.out, l};
            pg8::gemm_phase<pg8::EpiMix, pg8::UnitOrder, true>(F.lds + RING_OFF, g, S, E, wave0);
            if (F.G == 256 && F.bid >= 32) {
                REFRESH(); const int gw = (F.bid - 32) * NWAVES + F.wave, NGW = 224 * NWAVES; const float* wbr = F.in[I_WBR] + (size_t)l * 4 * 512 * 1024;
                convert_matrix<RM_ID>(F, wbr, 512, 1024, Bt3, 2048, 0, 0, gw, NGW, 0);
                convert_matrix<RM_ID>(F, wbr + (size_t)512 * 1024, 512, 1024, Bt3, 2048, 512, 0, gw, NGW, 256);
                convert_matrix<RM_ID>(F, wbr + (size_t)3 * 512 * 1024, 512, 1024, Bt3, 2048, 1536, 0, gw, NGW, 512);
                convert_matrix<RM_ID>(F, F.in[I_WOUT] + (size_t)l * DM * DM, DM, DM, Bt4, DM, 0, 0, gw, NGW, 768);
                REFRESH(); compose_pool(F, l, Bt3, gw, NGW, 1280); } }
        SEAM(pb + 0);
        if (IN(pb + 1)) for (int rep = 0; rep < NREP(1); ++rep) { if (rep) xcd_barrier(bar);
            __syncthreads(); REFRESH();
            for (int r2 = 0; r2 < NREP2(0); ++r2) for (int it = F.bid; it < 256; it += F.G) { a_prompt_item(F, l, it, Zm, Y); __syncthreads(); }
            REFRESH();
            for (int r2 = 0; r2 < NREP2(1); ++r2) for (int it = (F.bid + 128) % F.G; it < 128; it += F.G) a_sample_task(F, l, 8 * it + F.wave, Zm, Y);
            __syncthreads(); REFRESH();
            const bool rebal = F.G == 256, gemm_wg = rebal && F.bid >= 128 && F.bid < 160;
            for (int r2 = 0; r2 < NREP2(2); ++r2) { if (!gemm_wg) for (int it = F.bid; it < 256; it += F.G) { b_prompt_item(F, l, it, Zm, Y); __syncthreads(); }
                if (rebal && F.bid >= 160 && F.bid < 192) { b_prompt_item(F, l, F.bid - 32, Zm, Y); __syncthreads(); } }
            REFRESH();
            for (int r2 = 0; r2 < NREP2(3); ++r2) { if (!gemm_wg) for (int it = F.bid; it < 256; it += F.G) { cd_prompt_item(F, l, it, Zm, Y); __syncthreads(); }
                if (rebal && F.bid >= 192 && F.bid < 224) { cd_prompt_item(F, l, F.bid - 64, Zm, Y); __syncthreads(); } }
            REFRESH();
            for (int r2 = 0; r2 < NREP2(4); ++r2) for (int it = F.bid; it < 128; it += F.G) { s_sample_item(F, l, it, Zm, Y); __syncthreads(); }
            if (F.G == 256 && F.bid >= 128 && F.bid < 160) {
                pg8::Gemm g{XB, WA + (size_t)4096 * DM, DM, DM}; pg8::UnitOrder S; S.init(pg8::SK_PLAIN, 4096, DM, 32, F.bid - 128, 0, false, true); pg8::EpiGate E{Gb};
                pg8::gemm_phase<pg8::EpiGate, pg8::UnitOrder, true>(F.lds + RING_OFF, g, S, E, wave0); }
            REFRESH();
            const float* wbr = F.in[I_WBR] + (size_t)l * 4 * 512 * 1024;
            if (F.G != 256) { const int gw = F.bid * NWAVES + F.wave, NGW = F.G * NWAVES;
                convert_matrix<RM_ID>(F, wbr, 512, 1024, Bt3, 2048, 0, 0, gw, NGW); convert_matrix<RM_ID>(F, wbr + (size_t)512 * 1024, 512, 1024, Bt3, 2048, 512, 0, gw, NGW);
                convert_matrix<RM_ID>(F, wbr + (size_t)3 * 512 * 1024, 512, 1024, Bt3, 2048, 1536, 0, gw, NGW); convert_matrix<RM_ID>(F, F.in[I_WOUT] + (size_t)l * DM * DM, DM, DM, Bt4, DM, 0, 0, gw, NGW);
                REFRESH(); compose_pool(F, l, Bt3, gw, NGW); }
        }
        SEAM(pb + 1);
        if (IN(pb + 2)) for (int rep = 0; rep < NREP(2); ++rep) { if (rep) xcd_barrier(bar); pg8::Gemm g{XB, WA + (size_t)4096 * DM, DM, DM}; pg8::UnitOrder S; S.init(pg8::SK_PLAIN, 4096, DM, F.G, F.bid, 0, true, F.G != 256); pg8::EpiGate E{Gb};
            pg8::gemm_phase<pg8::EpiGate, pg8::UnitOrder, true>(F.lds + RING_OFF, g, S, E, wave0); }
        SEAM(pb + 2);
        if (IN(pb + 3)) for (int rep = 0; rep < NREP(3); ++rep) { if (rep) xcd_barrier(bar); pg8::Gemm g{Y, Bt3, 2048, 2048}; pg8::UnitOrder S; S.init(pg8::SK_P3, DM, 2048, F.G, F.bid, 0); pg8::EpiMerge E{Gb, XB, (bf16*)(F.ws + WS_MB4S)};
            pg8::gemm_phase<pg8::EpiMerge, pg8::UnitOrder, true>(F.lds + RING_OFF, g, S, E, wave0); }
        SEAM(pb + 3);
        if (IN(pb + 4)) for (int rep = 0; rep < 1; ++rep) { pg8::Gemm g{XB, Bt4, DM, DM}; pg8::UnitOrder S; S.init(pg8::SK_P4, DM, DM, F.G, F.bid, (long)(WS_MB4S - WS_XB));
            pg8::EpiRes E{l == 0 ? F.in[I_XP] : F.out, F.out, XB, F.in[I_LN1G] + l * DM, F.in[I_LN1B] + l * DM, (float*)(F.ws + WS_SLAB),
                          pg8::PanelStats{(unsigned*)(F.ws + WS_XCH + (size_t)(2 * l) * 512 * 1024), (unsigned*)(F.ctl + CW_SEAM + (2 * l) * SEAM_BANK)}, F.lds + XLDS_OFF, wave0};
            pg8::gemm_phase<pg8::EpiRes, pg8::UnitOrder, true>(F.lds + RING_OFF, g, S, E, wave0);
            if (F.G == 256 && F.bid >= 64) {
                REFRESH(); const int gw = (F.bid - 64) * NWAVES + F.wave, NGW = 192 * NWAVES;
                convert_matrix<RM_GU>(F, F.in[I_WG] + (size_t)l * DM * FF, DM, FF, Bt5, DM, 0, 0, gw, NGW, 0);
                convert_matrix<RM_GU>(F, F.in[I_WU] + (size_t)l * DM * FF, DM, FF, Bt5, DM, 0, 128, gw, NGW, 1408);
                convert_matrix<RM_ID>(F, F.in[I_WD] + (size_t)l * FF * DM, FF, DM, Bt6, FF, 0, 0, gw, NGW, 2816); } }
        SEAM(pb + 4);
        if (IN(pb + 5)) for (int rep = 0; rep < NREP(5); ++rep) { if (rep) xcd_barrier(bar);
            REFRESH();
            ln_rows(F, F.out, rep + 1 < NREP(5) ? (float*)(F.ws + WS_Y) : F.out, F.in[I_LN1G] + l * DM, F.in[I_LN1B] + l * DM, rep + 1 < NREP(5) ? nullptr : XB, l == 0 ? F.in[I_XS] : F.out + (size_t)MP * DM, (const float*)(F.ws + WS_SLAB), 8);
            REFRESH();
            if (F.G != 256) { const int gw = F.bid * NWAVES + F.wave, NGW = F.G * NWAVES;
                convert_matrix<RM_GU>(F, F.in[I_WG] + (size_t)l * DM * FF, DM, FF, Bt5, DM, 0, 0, gw, NGW); convert_matrix<RM_GU>(F, F.in[I_WU] + (size_t)l * DM * FF, DM, FF, Bt5, DM, 0, 128, gw, NGW);
                convert_matrix<RM_ID>(F, F.in[I_WD] + (size_t)l * FF * DM, FF, DM, Bt6, FF, 0, 0, gw, NGW); }
        }
        SEAM(pb + 5);
        if (IN(pb + 6)) for (int rep = 0; rep < NREP(6); ++rep) { if (rep) xcd_barrier(bar); pg8::Gemm g{XB, Bt5, DM, DM}; pg8::UnitOrder S; S.init(pg8::SK_PLAIN, 2 * FF, DM, F.G, F.bid, 0); pg8::EpiSwi E{Hb};
            pg8::gemm_phase<pg8::EpiSwi, pg8::UnitOrder, true>(F.lds + RING_OFF, g, S, E, wave0);
            if (F.G == 256 && F.bid >= 172 && l == 0 && rep + 1 == NREP(6)) {
                REFRESH(); convert_matrix<RM_WIN>(F, F.in[I_WIN] + (size_t)DM * INC, DM, INC, WA, DM, 0, 0, (F.bid - 172) * NWAVES + F.wave, 84 * NWAVES); } }
        SEAM(pb + 6);
        if (IN(pb + 7)) for (int rep = 0; rep < 1; ++rep) { pg8::Gemm g{Hb, Bt6, FF, FF}; pg8::UnitOrder S; S.init(pg8::SK_P6, DM, FF, F.G, F.bid, 0); pg8::EpiRes E{F.out, F.out, l == 0 ? XB : nullptr, F.in[I_LN2G] + l * DM, F.in[I_LN2B] + l * DM, (float*)(F.ws + WS_SLAB),
                          pg8::PanelStats{(unsigned*)(F.ws + WS_XCH + (size_t)(2 * l + 1) * 512 * 1024), (unsigned*)(F.ctl + CW_SEAM + (2 * l + 1) * SEAM_BANK)}, F.lds + XLDS_OFF, wave0};
            pg8::gemm_phase<pg8::EpiRes, pg8::UnitOrder, true>(F.lds + RING_OFF, g, S, E, wave0); }
        SEAM(pb + 7);
        if (IN(pb + 8)) for (int rep = 0; rep < NREP(8); ++rep) { if (rep) xcd_barrier(bar);
            REFRESH();
            ln_rows(F, F.out, rep + 1 < NREP(8) ? (float*)(F.ws + WS_Y) : F.out, F.in[I_LN2G] + l * DM, F.in[I_LN2B] + l * DM, (l == 0 && rep + 1 == NREP(8)) ? XB : nullptr, F.out + (size_t)MP * DM, (const float*)(F.ws + WS_SLAB), 11);
            REFRESH();
            if (l == 0 && F.G != 256) convert_matrix<RM_WIN>(F, F.in[I_WIN] + (size_t)DM * INC, DM, INC, WA, DM, 0, 0, F.bid * NWAVES + F.wave, F.G * NWAVES);
        }
        if (l == 0) SEAM(pb + 8);
    }
#undef IN
#undef SEAM
#undef REFRESH
}

extern "C" void kernel_launch(void* const* d_in, const int* in_sizes, int n_in, void* d_out, int out_size, void* d_ws, size_t ws_size, hipStream_t stream) {
    static int grid = 0;
    if (grid == 0) {
        if (n_in != 31 || out_size != (int)O_END || ws_size < WS_END) { fprintf(stderr, "kernel_launch: unexpected sizes n_in %d out %d ws %zu\n", n_in, out_size, ws_size); grid = -1; return; }
        int dev = 0, cus = 0, per_cu = 0;
        if (hipGetDevice(&dev) != hipSuccess || hipDeviceGetAttribute(&cus, hipDeviceAttributeMultiprocessorCount, dev) != hipSuccess) { grid = -1; return; }
        if (hipFuncSetAttribute((const void*)hybrid_fwd, hipFuncAttributeMaxDynamicSharedMemorySize, LDS_BYTES) != hipSuccess) { fprintf(stderr, "kernel_launch: hipFuncSetAttribute failed\n"); grid = -1; return; }
        if (hipOccupancyMaxActiveBlocksPerMultiprocessor(&per_cu, (const void*)hybrid_fwd, NWAVES * 64, LDS_BYTES) != hipSuccess || per_cu < 1)
            fprintf(stderr, "kernel_launch: occupancy query reports %d workgroups per CU\n", per_cu);
        (void)hipGetLastError();
        grid = cus;
    }
    if (grid < 0) return;
    if (hipMemsetAsync((char*)d_ws + WS_CTL, 0, CTL_ZERO_BYTES, stream) != hipSuccess) { fprintf(stderr, "kernel_launch: memset failed\n"); return; }
    Args a{};
    for (int i = 0; i < 31; ++i) a.in[i] = (const float*)d_in[i];
    a.out = (float*)d_out; a.ws = (unsigned char*)d_ws;
#if MK_SPLIT
    for (int ph = 0; ph < NPHASE; ++ph) { a.ph_lo = ph; a.ph_hi = ph + 1; hipLaunchKernelGGL(hybrid_fwd, dim3(grid), dim3(NWAVES * 64), LDS_BYTES, stream, a); }
#else
    a.ph_lo = 0; a.ph_hi = NPHASE;
    hipLaunchKernelGGL(hybrid_fwd, dim3(grid), dim3(NWAVES * 64), LDS_BYTES, stream, a);
#endif
}
```

```cpp
#include <hip/hip_runtime.h>
#include <cstdio>
#include <cstdint>

#ifndef PROBE_REP
#define PROBE_REP 0
#endif
#define NREP(k) (1 + ((PROBE_REP >> (k)) & 1))
#ifndef PROBE2
#define PROBE2 0
#endif
#define NREP2(j) (1 + ((PROBE2 >> (j)) & 1))
#ifndef MK_SPLIT
#define MK_SPLIT 0
#endif

constexpr int DM = 1024, WMIX = 512, NPB = 8, SEQ = 2048, NSB = 128, DSEQ = 4;
constexpr int MP = NPB * SEQ, MS = NSB * DSEQ, M = MP + MS;
constexpr int FF = 2816, INC = 8192, ZC = 3072, YC = 2048, GC = 4096;
constexpr float LN_EPS = 1e-5f, ALPHA = 1.41421356237f;
constexpr size_t O_Y = 0, O_PH = (size_t)M * DM, O_PRGC = O_PH + 8192, O_PCF = O_PRGC + 24576, O_PPOOL = O_PCF + 245760, O_PSC = O_PPOOL + 122880,
                 O_SH = O_PSC + 16384, O_SRGC = O_SH + 131072, O_SCF = O_SRGC + 393216, O_SPOOL = O_SCF + 3932160, O_SSC = O_SPOOL + 1966080, O_END = O_SSC + 262144;
static_assert(O_END == 24403968, "output map");

__device__ __forceinline__ int opqv(int v) { asm volatile("" : "+v"(v)); return v; }
__device__ __forceinline__ int lane_now() { int l; asm volatile("v_mbcnt_lo_u32_b32 %0, -1, 0\n\tv_mbcnt_hi_u32_b32 %0, -1, %0" : "=v"(l)); return l; }
__device__ __forceinline__ int opqs(int v) { asm volatile("" : "+s"(v)); return v; }
namespace pg8 {
#define PG8_LAS __attribute__((address_space(3)))
typedef unsigned short bf16_t;
typedef short bf16x8 __attribute__((ext_vector_type(8)));
typedef float f32x4 __attribute__((ext_vector_type(4)));
typedef float f32x2 __attribute__((ext_vector_type(2)));
typedef unsigned u32x4 __attribute__((ext_vector_type(4)));
typedef unsigned u32x2 __attribute__((ext_vector_type(2)));
typedef _Float16 f16x4 __attribute__((ext_vector_type(4)));
typedef _Float16 f16x8 __attribute__((ext_vector_type(8)));
constexpr int BM = 256, BK = 64, HALF = 128, HTB = HALF * BK * 2, STAGE_BYTES = 8 * HTB, NXCD = 8, WGM = 8;

__host__ __device__ __forceinline__ int lds_byte(int r, int c) { const int st = (r >> 4) * 2 + (c >> 5), rr = r & 15, cc = c & 31, ob = rr * 64 + cc * 2; return st * 1024 + (ob ^ (((ob >> 9) & 1) << 5)); }
__host__ __device__ __forceinline__ void stage_rc(int b, int& R, int& C) { const int st = b / 1024, sb = b % 1024, swz = sb ^ (((sb >> 9) & 1) << 5); R = (st >> 1) * 16 + swz / 64; C = (st & 1) * 32 + (swz % 64) / 2; }
__host__ __device__ __forceinline__ int perm32(int rho) { const int n = rho >> 4, i = rho & 15; return 8 * (i >> 2) + 4 * n + (i & 3); }

struct Unit { int pm, pn, nt, mode, aux; long offA, offB; };
struct Gemm { const bf16_t* A; const bf16_t* Bt; int lda, ldb; };

enum { SK_PLAIN = 0, SK_P3 = 1, SK_P4 = 2, SK_P6 = 3 };
struct UnitOrder {
    int kind, nN, nwgP, nS, ntP, G, c; long offA_s;
    __device__ __forceinline__ void init(int kind_, int N_, int K_, int G_, int c_, long offA_s_, bool prompt = true, bool sample = true) { kind = kind_; nN = N_ / BM; nwgP = prompt ? 64 * nN : 0; ntP = K_ / BK; G = G_; c = c_; offA_s = offA_s_;
        nS = !sample ? 0 : kind_ == SK_PLAIN ? 2 * nN : kind_ == SK_P3 ? 32 : kind_ == SK_P4 ? 64 : 88; }
    __device__ __forceinline__ bool next(int i, Unit& u, const Gemm& g) const {
        const long L = (long)i * G + c; const long ra = (long)BM * g.lda * 2, rb = (long)BM * g.ldb * 2;
        if (L < nwgP) {
            int wgid = (int)L; { const int q = nwgP / NXCD, xcd = wgid % NXCD, off = wgid / NXCD; wgid = xcd * q + off; }
            const int nig = WGM * nN; u.pm = (wgid / nig) * WGM + ((wgid % nig) % WGM); u.pn = (wgid % nig) / WGM;
            u.nt = ntP; u.mode = 0; u.aux = 0; u.offA = u.pm * ra; u.offB = u.pn * rb; return true; }
        const int s = (int)(L - nwgP); if (s >= nS) return false;
        if (kind == SK_PLAIN) { u.pm = 64 + (s & 1); u.pn = s >> 1; u.nt = ntP; u.mode = 0; u.aux = 0; u.offA = u.pm * ra; u.offB = u.pn * rb; }
        else if (kind == SK_P3) { const int n = s & 3, tile = s >> 2; u.pm = 64 + (tile & 1); u.pn = tile >> 1; u.nt = 8; u.mode = 1; u.aux = n; u.offA = u.pm * ra + 1024 * n; u.offB = u.pn * rb + 1024 * n; }
        else if (kind == SK_P4) { const int ch = s & 7, tile = s >> 3, n = ch >> 1, kin = (ch & 1) * 512; u.pm = 64 + (tile & 1); u.pn = tile >> 1; u.nt = 8; u.mode = 1; u.aux = ch;
            u.offA = offA_s + ((long)(n * 512 + (u.pm - 64) * 256) * 1024 + kin) * 2; u.offB = u.pn * rb + kin * 2; }
        else { const int ch = s % 11, tile = s / 11; u.pm = 64 + (tile & 1); u.pn = tile >> 1; u.nt = 4; u.mode = 1; u.aux = ch; u.offA = u.pm * ra + 512 * ch; u.offB = u.pn * rb + 512 * ch; }
        return true;
    }
};

__device__ __forceinline__ unsigned cvt_pk_bf16(float lo, float hi) { unsigned r; asm volatile("v_cvt_pk_bf16_f32 %0, %1, %2" : "=v"(r) : "v"(lo), "v"(hi)); return r; }
__device__ __forceinline__ float sigmoidf_fast(float x) { return __builtin_amdgcn_rcpf(1.0f + __builtin_amdgcn_exp2f(-1.44269504089f * x)); }
__device__ __forceinline__ float gelu_tanh(float x) { const float t = x * x, y = x * fmaf(t, -0.10294324f, -2.3022082f); return x * __builtin_amdgcn_rcpf(1.0f + __builtin_amdgcn_exp2f(y)); }

__device__ __forceinline__ void acc_zero(f32x4 (&acc)[2][2][4][2]) {
#pragma unroll
    for (int a = 0; a < 2; ++a)
#pragma unroll
        for (int b = 0; b < 2; ++b)
#pragma unroll
            for (int m = 0; m < 4; ++m)
#pragma unroll
                for (int n = 0; n < 2; ++n) acc[a][b][m][n] = (f32x4){0.f, 0.f, 0.f, 0.f};
}
__device__ __forceinline__ float* state_ptr(float* out, int R, int keep, int layer, size_t p_off, size_t s_off) {
    if (R < MP) { const int b = R >> 11, j = (R & 2047) - (2048 - keep); return j < 0 ? nullptr : out + p_off + (size_t)((layer * 8 + b) * keep + j) * 512; }
    const int s = (R - MP) >> 2, j = (R & 3) + keep - 4; return j < 0 ? nullptr : out + s_off + (size_t)((layer * 128 + s) * keep + j) * 512;
}

struct EpiMix {
    static constexpr bool PERM = true, MIDK = false;
    __device__ __forceinline__ void init(f32x4 (&acc)[2][2][4][2], const Unit&, int, int) const { acc_zero(acc); }
    bf16_t* Z; float* out; int layer;
    __device__ __forceinline__ void midk(f32x4 (&)[2][2][4][2], const Unit&, int, int, int, int, int) const {}
    __device__ __forceinline__ void operator()(f32x4 (&acc)[2][2][4][2], const Unit& u, int wr, int wc, int fr_, int fq_) const {
        const int lane_ = lane_now(), fr = lane_ & 15, fq = lane_ >> 4; (void)fr_; (void)fq_;
        const int pn = u.pn; int type, zcol, keep = 0, scol = 0; size_t poff = 0, soff = 0;
        if (pn < 2) { type = 0; zcol = 256 * pn; keep = 3; scol = zcol; poff = O_PRGC; soff = O_SRGC; }
        else if (pn < 4) { type = 1; zcol = 512 + 256 * (pn - 2); }
        else if (pn < 8) { type = 2; zcol = 1024 + 128 * (pn - 4); keep = 30; scol = 128 * (pn - 4); poff = O_PCF; soff = O_SCF; }
        else if (pn < 10) { type = 0; zcol = 1536 + 256 * (pn - 8); keep = 15; scol = 256 * (pn - 8); poff = O_PPOOL; soff = O_SPOOL; }
        else if (pn < 12) { type = 0; zcol = 2048 + 256 * (pn - 10); }
        else { type = 3; zcol = 2560 + 128 * (pn - 12); keep = 2; scol = 128 * (pn - 12); poff = O_PSC; soff = O_SSC; }
        const bool tail = keep != 0 && (u.pm >= 64 || (u.pm & 7) == 7);
        const int row0 = u.pm * BM + wr * 64 + fr, cl = wc * 32 + 8 * fq;
        if (type < 2) {
#pragma unroll
            for (int ai = 0; ai < 2; ++ai)
#pragma unroll
                for (int m = 0; m < 4; ++m) { const int R = row0 + ai * HALF + m * 16; bf16_t* rowp = Z + (size_t)R * ZC + zcol + cl;
                    float* sp = tail ? state_ptr(out, R, keep, layer, poff, soff) : nullptr;
#pragma unroll
                    for (int bj = 0; bj < 2; ++bj) { f32x4 v0 = acc[ai][bj][m][0], v1 = acc[ai][bj][m][1];
                        if (type == 1) { v0 = (f32x4){gelu_tanh(v0[0]), gelu_tanh(v0[1]), gelu_tanh(v0[2]), gelu_tanh(v0[3])}; v1 = (f32x4){gelu_tanh(v1[0]), gelu_tanh(v1[1]), gelu_tanh(v1[2]), gelu_tanh(v1[3])}; }
                        u32x4 w; w.x = cvt_pk_bf16(v0[0], v0[1]); w.y = cvt_pk_bf16(v0[2], v0[3]); w.z = cvt_pk_bf16(v1[0], v1[1]); w.w = cvt_pk_bf16(v1[2], v1[3]);
                        *(u32x4*)(rowp + bj * HALF) = w;
                        if (sp) { *(f32x4*)(sp + scol + cl + bj * HALF) = v0; *(f32x4*)(sp + scol + cl + bj * HALF + 4) = v1; } } }
        } else {
#pragma unroll
            for (int ai = 0; ai < 2; ++ai)
#pragma unroll
                for (int m = 0; m < 4; ++m) { const int R = row0 + ai * HALF + m * 16; bf16_t* rowp = Z + (size_t)R * ZC + zcol + cl;
                    float* sp = tail ? state_ptr(out, R, keep, layer, poff, soff) : nullptr;
                    f32x4 v0, v1; const f32x4 a0 = acc[ai][0][m][0], a1 = acc[ai][0][m][1], b0 = acc[ai][1][m][0], b1 = acc[ai][1][m][1];
                    if (type == 2) {
#pragma unroll
                        for (int i = 0; i < 4; ++i) { v0[i] = a0[i] * sigmoidf_fast(b0[i]); v1[i] = a1[i] * sigmoidf_fast(b1[i]); }
                    } else { v0 = a0 * b0; v1 = a1 * b1; }
                    u32x4 w; w.x = cvt_pk_bf16(v0[0], v0[1]); w.y = cvt_pk_bf16(v0[2], v0[3]); w.z = cvt_pk_bf16(v1[0], v1[1]); w.w = cvt_pk_bf16(v1[2], v1[3]);
                    *(u32x4*)rowp = w;
                    if (sp) { *(f32x4*)(sp + scol + cl) = v0; *(f32x4*)(sp + scol + cl + 4) = v1; } }
        }
    }
};

struct EpiGate {
    static constexpr bool PERM = true, MIDK = false;
    __device__ __forceinline__ void init(f32x4 (&acc)[2][2][4][2], const Unit&, int, int) const { acc_zero(acc); }
    _Float16* G;
    __device__ __forceinline__ void midk(f32x4 (&)[2][2][4][2], const Unit&, int, int, int, int, int) const {}
    __device__ __forceinline__ void operator()(f32x4 (&acc)[2][2][4][2], const Unit& u, int wr, int wc, int fr_, int fq_) const {
        const int lane_ = lane_now(), fr = lane_ & 15, fq = lane_ >> 4; (void)fr_; (void)fq_;
        const int row0 = u.pm * BM + wr * 64 + fr, ch0 = 64 * u.pn + 16 * wc + 4 * fq; const bool plain = u.pm >= 64;
#pragma unroll
        for (int ai = 0; ai < 2; ++ai)
#pragma unroll
            for (int m = 0; m < 4; ++m) { const int R = row0 + ai * HALF + m * 16; _Float16* gp = G + (size_t)R * GC + ch0;
                f16x4 r0, r1, r2, g3;
#pragma unroll
                for (int i = 0; i < 4; ++i) {
                    const float d0 = 1.f + __builtin_amdgcn_exp2f(__builtin_amdgcn_fmed3f(acc[ai][0][m][0][i], -15.f, 15.f)), d1 = 1.f + __builtin_amdgcn_exp2f(__builtin_amdgcn_fmed3f(acc[ai][0][m][1][i], -15.f, 15.f));
                    const float d2 = 1.f + __builtin_amdgcn_exp2f(__builtin_amdgcn_fmed3f(acc[ai][1][m][0][i], -15.f, 15.f)), d3 = 1.f + __builtin_amdgcn_exp2f(__builtin_amdgcn_fmed3f(acc[ai][1][m][1][i], -15.f, 15.f));
                    const float i0 = __builtin_amdgcn_rcpf(d0), i1 = __builtin_amdgcn_rcpf(d1), i2 = __builtin_amdgcn_rcpf(d2), i3 = __builtin_amdgcn_rcpf(d3);
                    if (plain) { r0[i] = (_Float16)i0; r1[i] = (_Float16)i1; r2[i] = (_Float16)i2; }
                    else { r0[i] = (_Float16)(d1 * i0); r1[i] = (_Float16)(d2 * i1); r2[i] = (_Float16)(d3 * i2); }
                    g3[i] = (_Float16)i3; }
                *(f16x4*)(gp) = r0; *(f16x4*)(gp + 1024) = r1; *(f16x4*)(gp + 2048) = r2; *(f16x4*)(gp + 3072) = g3; }
    }
};

struct EpiMerge {
    static constexpr bool PERM = true, MIDK = true;
    __device__ __forceinline__ void init(f32x4 (&acc)[2][2][4][2], const Unit&, int, int) const { acc_zero(acc); }
    const _Float16* G; bf16_t* O; bf16_t* Os;
    __device__ __forceinline__ void scale(f32x4 (&acc)[2][2][4][2], const Unit& u, int seg, int wr, int wc) const {
        const int lane_ = lane_now(), fr = lane_ & 15, fq = lane_ >> 4;
        const int row0 = u.pm * BM + wr * 64 + fr, c0 = 1024 * seg + 256 * u.pn + wc * 32 + 8 * fq;
#pragma unroll
        for (int ai = 0; ai < 2; ++ai)
#pragma unroll
            for (int m = 0; m < 4; ++m) { const _Float16* gp = G + (size_t)(row0 + ai * HALF + m * 16) * GC + c0;
#pragma unroll
                for (int bj = 0; bj < 2; ++bj) { const f16x8 f = *(const f16x8*)(gp + bj * HALF);
                    acc[ai][bj][m][0] *= (f32x4){(float)f[0], (float)f[1], (float)f[2], (float)f[3]}; acc[ai][bj][m][1] *= (f32x4){(float)f[4], (float)f[5], (float)f[6], (float)f[7]}; } }
    }
    __device__ __forceinline__ void midk(f32x4 (&acc)[2][2][4][2], const Unit& u, int seg, int wr, int wc, int, int) const { scale(acc, u, seg, wr, wc); }
    __device__ __forceinline__ void operator()(f32x4 (&acc)[2][2][4][2], const Unit& u, int wr, int wc, int, int) const {
        scale(acc, u, u.mode ? u.aux : 3, wr, wc);
        const int lane_ = lane_now(), fr = lane_ & 15, fq = lane_ >> 4;
        const int row0 = (u.mode ? (u.pm - 64) * BM + 512 * u.aux : u.pm * BM) + wr * 64 + fr, c0 = 256 * u.pn + wc * 32 + 8 * fq;
        bf16_t* O = u.mode ? Os : this->O;
#pragma unroll
        for (int ai = 0; ai < 2; ++ai)
#pragma unroll
            for (int m = 0; m < 4; ++m) { bf16_t* rowp = O + (size_t)(row0 + ai * HALF + m * 16) * DM + c0;
#pragma unroll
                for (int bj = 0; bj < 2; ++bj) { const f32x4 v0 = acc[ai][bj][m][0], v1 = acc[ai][bj][m][1];
                    u32x4 w; w.x = cvt_pk_bf16(v0[0], v0[1]); w.y = cvt_pk_bf16(v0[2], v0[3]); w.z = cvt_pk_bf16(v1[0], v1[1]); w.w = cvt_pk_bf16(v1[2], v1[3]); *(u32x4*)(rowp + bj * HALF) = w; } }
    }
};

struct PanelStats {
    unsigned* xbuf;
    unsigned* cnt;
    __device__ __forceinline__ void run(const f32x4 (&v)[2][2][4][2], const Unit& u, int wr, int wc, PG8_LAS unsigned char* lds, int wid) const {
        const int lane = lane_now(), fr = lane & 15, fq = lane >> 4;
        PG8_LAS f32x2* P = (PG8_LAS f32x2*)lds;
        PG8_LAS f32x2* S = (PG8_LAS f32x2*)(lds + 8192);
#pragma unroll
        for (int ai = 0; ai < 2; ++ai)
#pragma unroll
            for (int m = 0; m < 4; ++m) {
                float s = 0.f;
#pragma unroll
                for (int bj = 0; bj < 2; ++bj)
#pragma unroll
                    for (int n = 0; n < 2; ++n) { const f32x4 x = v[ai][bj][m][n]; s += (x[0] + x[1]) + (x[2] + x[3]); }
                s += __builtin_bit_cast(float, __builtin_amdgcn_ds_bpermute((lane ^ 16) << 2, __builtin_bit_cast(int, s))); s += __builtin_bit_cast(float, __builtin_amdgcn_ds_bpermute((lane ^ 32) << 2, __builtin_bit_cast(int, s)));
                const float mw = s * (1.0f / 64.0f); float q = 0.f;
#pragma unroll
                for (int bj = 0; bj < 2; ++bj)
#pragma unroll
                    for (int n = 0; n < 2; ++n) { const f32x4 d = v[ai][bj][m][n] - mw; q += (d[0] * d[0] + d[1] * d[1]) + (d[2] * d[2] + d[3] * d[3]); }
                q += __builtin_bit_cast(float, __builtin_amdgcn_ds_bpermute((lane ^ 16) << 2, __builtin_bit_cast(int, q))); q += __builtin_bit_cast(float, __builtin_amdgcn_ds_bpermute((lane ^ 32) << 2, __builtin_bit_cast(int, q)));
                if (fq == 0) P[(ai * HALF + wr * 64 + m * 16 + fr) * 4 + wc] = (f32x2){mw, q};
            }
        asm volatile("s_waitcnt lgkmcnt(0)" ::: "memory"); __builtin_amdgcn_s_barrier(); asm volatile("" ::: "memory");
        const int row = wid * 32 + (lane & 31);
        if (lane < 32) {
            const f32x2 a = P[row * 4 + 0], b = P[row * 4 + 1], c = P[row * 4 + 2], d = P[row * 4 + 3];
            const float mt = (a.x + b.x + c.x + d.x) * 0.25f;
            const float da = a.x - mt, db = b.x - mt, dc = c.x - mt, dd = d.x - mt;
            const float m2 = (a.y + b.y) + (c.y + d.y) + 64.0f * ((da * da + db * db) + (dc * dc + dd * dd));
            unsigned long long* slot = (unsigned long long*)xbuf + ((size_t)(u.pm * BM + row) * 4 + u.pn);
            __hip_atomic_store(slot, ((unsigned long long)__float_as_uint(m2) << 32) | __float_as_uint(mt), __ATOMIC_RELAXED, __HIP_MEMORY_SCOPE_AGENT);
        }
        asm volatile("s_waitcnt vmcnt(0)" ::: "memory");
        if (lane == 0) __hip_atomic_fetch_add(cnt + 64 * u.pm, 1u, __ATOMIC_RELAXED, __HIP_MEMORY_SCOPE_AGENT);
        if (wid == 0) {
            unsigned spins = 0;
            while ((unsigned)__builtin_amdgcn_readfirstlane(__hip_atomic_load(cnt + 64 * u.pm, __ATOMIC_RELAXED, __HIP_MEMORY_SCOPE_AGENT)) < 32u) { __builtin_amdgcn_s_sleep(2); if (++spins > (1u << 20)) break; }
            __builtin_amdgcn_fence(__ATOMIC_ACQUIRE, "agent");
        }
        asm volatile("s_waitcnt vmcnt(0) lgkmcnt(0)" ::: "memory"); __builtin_amdgcn_s_barrier(); asm volatile("" ::: "memory");
        if (lane < 32) {
            const unsigned long long* slot = (const unsigned long long*)xbuf + (size_t)(u.pm * BM + row) * 4; float mt[4], m2[4]; float ms = 0.f;
#pragma unroll
            for (int t = 0; t < 4; ++t) { const unsigned long long w = __hip_atomic_load(slot + t, __ATOMIC_RELAXED, __HIP_MEMORY_SCOPE_AGENT); mt[t] = __uint_as_float((unsigned)w); m2[t] = __uint_as_float((unsigned)(w >> 32)); ms += mt[t]; }
            const float mean = ms * 0.25f; float q = 0.f;
#pragma unroll
            for (int t = 0; t < 4; ++t) { const float dm = mt[t] - mean; q += m2[t] + 256.0f * dm * dm; }
            S[row] = (f32x2){mean, __builtin_amdgcn_rsqf(q * (1.0f / 1024.0f) + LN_EPS)};
        }
        asm volatile("s_waitcnt lgkmcnt(0)" ::: "memory"); __builtin_amdgcn_s_barrier(); asm volatile("" ::: "memory");
    }
};
struct EpiRes {
    static constexpr bool PERM = false, MIDK = false;
    __device__ __forceinline__ void init(f32x4 (&acc)[2][2][4][2], const Unit& u, int wr, int wc) const {
        if (u.mode) { acc_zero(acc); return; }
        const int lane_ = lane_now(), fr = lane_ & 15, fq = lane_ >> 4;
        const float* bp0 = baseP + (size_t)(u.pm * BM + wr * 64 + fr) * DM + 256 * u.pn + wc * 32 + 4 * fq;
#pragma unroll
        for (int ai = 0; ai < 2; ++ai)
#pragma unroll
            for (int m = 0; m < 4; ++m)
#pragma unroll
                for (int bj = 0; bj < 2; ++bj)
#pragma unroll
                    for (int n = 0; n < 2; ++n) acc[ai][bj][m][n] = *(const f32x4*)(bp0 + (size_t)(ai * HALF + m * 16) * DM + bj * HALF + n * 16) * ALPHA;
    }
    const float* baseP; float* out; bf16_t* xb; const float* lng; const float* lnb; float* slab; PanelStats st; PG8_LAS unsigned char* xlds; int wid;
    __device__ __forceinline__ void midk(f32x4 (&)[2][2][4][2], const Unit&, int, int, int, int, int) const {}
    __device__ __forceinline__ void operator()(f32x4 (&acc)[2][2][4][2], const Unit& u, int wr, int wc, int fr_, int fq_) const {
        const int lane_ = lane_now(), fr = lane_ & 15, fq = lane_ >> 4; (void)fr_; (void)fq_;
        const int row0 = u.pm * BM + wr * 64 + fr, c0 = 256 * u.pn + wc * 32 + 4 * fq;
        if (u.mode) {
#pragma unroll
            for (int ai = 0; ai < 2; ++ai)
#pragma unroll
                for (int m = 0; m < 4; ++m) { float* op = slab + ((size_t)u.aux * 512 + (row0 - MP) + ai * HALF + m * 16) * DM + c0;
#pragma unroll
                    for (int bj = 0; bj < 2; ++bj)
#pragma unroll
                        for (int n = 0; n < 2; ++n) *(f32x4*)(op + bj * HALF + n * 16) = acc[ai][bj][m][n]; }
            return; }
        st.run(acc, u, wr, wc, xlds, wid);
        const PG8_LAS f32x2* S = (const PG8_LAS f32x2*)(xlds + 8192);
#pragma unroll
        for (int bj = 0; bj < 2; ++bj)
#pragma unroll
            for (int n = 0; n < 2; ++n) { const int cc = c0 + bj * HALF + n * 16; const f32x4 gv = *(const f32x4*)(lng + cc), bv = *(const f32x4*)(lnb + cc);
#pragma unroll
                for (int ai = 0; ai < 2; ++ai)
#pragma unroll
                    for (int m = 0; m < 4; ++m) { const int r = ai * HALF + wr * 64 + m * 16 + fr; const f32x2 sr = S[r]; const size_t off = (size_t)(u.pm * BM + r) * DM + cc;
                        const f32x4 o = (acc[ai][bj][m][n] - sr.x) * sr.y * gv + bv; *(f32x4*)(out + off) = o;
                        if (xb) { u32x2 w; w.x = cvt_pk_bf16(o[0], o[1]); w.y = cvt_pk_bf16(o[2], o[3]); *(u32x2*)(xb + off) = w; }
                        if (m & 1) asm volatile("" ::: "memory"); } }
    }
};

struct EpiSwi {
    static constexpr bool PERM = true, MIDK = false;
    __device__ __forceinline__ void init(f32x4 (&acc)[2][2][4][2], const Unit&, int, int) const { acc_zero(acc); }
    bf16_t* H;
    __device__ __forceinline__ void midk(f32x4 (&)[2][2][4][2], const Unit&, int, int, int, int, int) const {}
    __device__ __forceinline__ void operator()(f32x4 (&acc)[2][2][4][2], const Unit& u, int wr, int wc, int fr_, int fq_) const {
        const int lane_ = lane_now(), fr = lane_ & 15, fq = lane_ >> 4; (void)fr_; (void)fq_;
        const int row0 = u.pm * BM + wr * 64 + fr, c0 = 128 * u.pn + wc * 32 + 8 * fq;
#pragma unroll
        for (int ai = 0; ai < 2; ++ai)
#pragma unroll
            for (int m = 0; m < 4; ++m) { bf16_t* rowp = H + (size_t)(row0 + ai * HALF + m * 16) * FF + c0;
                const f32x4 g0 = acc[ai][0][m][0], g1 = acc[ai][0][m][1], u0 = acc[ai][1][m][0], u1 = acc[ai][1][m][1]; f32x4 v0, v1;
#pragma unroll
                for (int i = 0; i < 4; ++i) { v0[i] = g0[i] * sigmoidf_fast(g0[i]) * u0[i]; v1[i] = g1[i] * sigmoidf_fast(g1[i]) * u1[i]; }
                u32x4 w; w.x = cvt_pk_bf16(v0[0], v0[1]); w.y = cvt_pk_bf16(v0[2], v0[3]); w.z = cvt_pk_bf16(v1[0], v1[1]); w.w = cvt_pk_bf16(v1[2], v1[3]);
                *(u32x4*)rowp = w; }
    }
};

template <class Epi, class Sched, bool ALIGN_EPI>
__device__ __forceinline__ void gemm_phase(PG8_LAS unsigned char* lds, const Gemm g, const Sched& S, const Epi& E, int wave_id) {
    const int wid = opqs(wave_id), lane = lane_now(), tid = wid * 64 + lane, wr = wid >> 2, wc = wid & 3, fr = lane & 15, fq = lane >> 4;
    unsigned voffA[2], voffB[2];
#pragma unroll
    for (int i = 0; i < 2; ++i) { int R, C; stage_rc(tid * 16 + i * 8192, R, C); const int Rb = Epi::PERM ? ((R & ~31) + perm32(R & 31)) : R;
        voffA[i] = (unsigned)(R * g.lda + C) * 2u; voffB[i] = (unsigned)(Rb * g.ldb + C) * 2u; }
    const size_t kstep = (size_t)(BK * 2);
    const size_t hstepA = (size_t)HALF * g.lda * 2, hstepB = (size_t)HALF * g.ldb * 2;
    const unsigned ldsw = (unsigned)wid * 1024u;
    const int aoff = lds_byte(wr * 64 + fr, fq * 8), boff = lds_byte(wc * 32 + fr, fq * 8);
#define PG8_SA(b, h) (((b) * 2 + (h)) * HTB)
#define PG8_SB(b, h) ((4 + (b) * 2 + (h)) * HTB)
#define PG8_STAGE(bufoff, gbase, voff) do { _Pragma("unroll") for (int _i = 0; _i < 2; ++_i) \
        __builtin_amdgcn_global_load_lds((const unsigned*)((const char*)(gbase) + (voff)[_i]), (PG8_LAS unsigned*)(lds + (bufoff) + ldsw + _i * 8192), 16, 0, 0); } while (0)
#define PG8_LDA(dst, b, h) do { _Pragma("unroll") for (int m = 0; m < 4; ++m) _Pragma("unroll") for (int k = 0; k < 2; ++k) dst[m][k] = *(const PG8_LAS bf16x8*)(lds + PG8_SA(b, h) + aoff + m * 2048 + k * 1024); } while (0)
#define PG8_LDB(dst, b, h) do { _Pragma("unroll") for (int n = 0; n < 2; ++n) _Pragma("unroll") for (int k = 0; k < 2; ++k) dst[n][k] = *(const PG8_LAS bf16x8*)(lds + PG8_SB(b, h) + boff + n * 2048 + k * 1024); } while (0)
#define PG8_MMA(ai, bj, At, Bt) do { __builtin_amdgcn_s_setprio(1); _Pragma("unroll") for (int m = 0; m < 4; ++m) _Pragma("unroll") for (int n = 0; n < 2; ++n) _Pragma("unroll") for (int k = 0; k < 2; ++k) \
        acc[ai][bj][m][n] = __builtin_amdgcn_mfma_f32_16x16x32_bf16(Bt[n][k], At[m][k], acc[ai][bj][m][n], 0, 0, 0); __builtin_amdgcn_s_setprio(0); } while (0)
#define PG8_WAIT_V(n) asm volatile("s_waitcnt vmcnt(" #n ")" ::: "memory")
#define PG8_WAIT_L(n) asm volatile("s_waitcnt lgkmcnt(" #n ")" ::: "memory")
#define PG8_BAR __builtin_amdgcn_s_barrier()
#define PG8_SCHED __builtin_amdgcn_sched_barrier(0)
    Unit cur, nxt; int ui = 0;
    if (!S.next(0, cur, g)) return;
    f32x4 acc[2][2][4][2];
    E.init(acc, cur, wr, wc);
    bf16x8 At[4][2], B0[2][2], B1[2][2];
    const char* cA = (const char*)g.A + cur.offA; const char* cB = (const char*)g.Bt + cur.offB;
    PG8_STAGE(PG8_SB(0, 0), cB, voffB); PG8_STAGE(PG8_SB(0, 1), cB + hstepB, voffB); PG8_STAGE(PG8_SA(0, 0), cA, voffA); PG8_STAGE(PG8_SA(0, 1), cA + hstepA, voffA);
    if (wr == 1) PG8_BAR;
    PG8_WAIT_V(2); PG8_BAR;
    PG8_STAGE(PG8_SB(1, 0), cB + kstep, voffB); PG8_STAGE(PG8_SA(1, 0), cA + kstep, voffA); PG8_STAGE(PG8_SB(1, 1), cB + hstepB + kstep, voffB);
    PG8_WAIT_V(6); PG8_BAR;
    for (;;) {
        const bool has_next = S.next(ui + 1, nxt, g);
        const char* nA = has_next ? (const char*)g.A + nxt.offA : cA; const char* nB = has_next ? (const char*)g.Bt + nxt.offB : cB;
        const int nt = cur.nt, TSEG = Epi::MIDK ? 8 : nt;
        for (int t0 = 0; t0 < nt; t0 += TSEG) {
        if constexpr (Epi::MIDK) { if (t0 != 0) { PG8_SCHED; E.midk(acc, cur, t0 / TSEG - 1, wr, wc, 0, 0); PG8_SCHED; } }
#pragma unroll 1
        for (int t = t0; t < t0 + TSEG; t += 2) {
            const bool last = (t == nt - 2);
            const char* a1 = cA + (size_t)(t + 1) * kstep;
            const char* a2 = last ? nA : cA + (size_t)(t + 2) * kstep; const char* b2 = last ? nB : cB + (size_t)(t + 2) * kstep;
            const char* a3 = a2 + kstep; const char* b3 = b2 + kstep;
            PG8_LDB(B0, 0, 0); PG8_LDB(B1, 0, 1); PG8_SCHED; PG8_LDA(At, 0, 0); PG8_STAGE(PG8_SA(1, 1), a1 + hstepA, voffA);
            PG8_WAIT_V(8); PG8_WAIT_L(0); PG8_BAR; PG8_MMA(0, 0, At, B0); PG8_MMA(0, 1, At, B1); PG8_BAR; PG8_SCHED;
            PG8_LDA(At, 0, 1); PG8_STAGE(PG8_SB(0, 0), b2, voffB); PG8_STAGE(PG8_SB(0, 1), b2 + hstepB, voffB); PG8_STAGE(PG8_SA(0, 0), a2, voffA);
            PG8_WAIT_V(8); PG8_WAIT_L(0); PG8_BAR; PG8_MMA(1, 0, At, B0); PG8_MMA(1, 1, At, B1); PG8_BAR; PG8_SCHED;
            PG8_LDB(B0, 1, 0); PG8_LDB(B1, 1, 1); PG8_SCHED; PG8_LDA(At, 1, 0); PG8_STAGE(PG8_SA(0, 1), a2 + hstepA, voffA);
            PG8_WAIT_V(8); PG8_WAIT_L(0); PG8_BAR; PG8_MMA(0, 0, At, B0); PG8_MMA(0, 1, At, B1); PG8_BAR; PG8_SCHED;
            PG8_LDA(At, 1, 1); PG8_STAGE(PG8_SB(1, 0), b3, voffB); PG8_STAGE(PG8_SB(1, 1), b3 + hstepB, voffB); PG8_STAGE(PG8_SA(1, 0), a3, voffA);
            PG8_WAIT_V(8); PG8_WAIT_L(0); PG8_BAR; PG8_MMA(1, 0, At, B0); PG8_MMA(1, 1, At, B1); PG8_BAR; PG8_SCHED;
        }
        }
        if constexpr (ALIGN_EPI) { if (wr == 0) PG8_BAR; }
        E(acc, cur, wr, wc, 0, 0);
        if (!has_next) break;
        cur = nxt; cA = nA; cB = nB; ++ui;
        E.init(acc, cur, wr, wc);
        if constexpr (ALIGN_EPI) { if (wr == 1) PG8_BAR; }
    }
    PG8_WAIT_V(0);
    if constexpr (!ALIGN_EPI) { if (wr == 0) PG8_BAR; }
    PG8_BAR;
#undef PG8_SA
#undef PG8_SB
#undef PG8_STAGE
#undef PG8_LDA
#undef PG8_LDB
#undef PG8_MMA
#undef PG8_WAIT_V
#undef PG8_WAIT_L
#undef PG8_BAR
#undef PG8_SCHED
}
}

constexpr int NWAVES = 8;
constexpr int NPHASE = 19;
constexpr size_t MiB = 1u << 20;
constexpr size_t WS_CTL = 0, CTL_ZERO_BYTES = 1 * MiB;
constexpr size_t WS_WA = 1 * MiB;
constexpr size_t WS_XB = 18 * MiB;
constexpr size_t WS_Y = 51 * MiB;
constexpr size_t WS_ZG = 117 * MiB;
constexpr size_t WS_BT3 = 249 * MiB, WS_BT4 = 253 * MiB, WS_BT5 = WS_ZG + 96 * MiB, WS_BT6 = WS_ZG + 108 * MiB;
constexpr size_t WS_MB4S = WS_WA + 8 * MiB;
constexpr size_t WS_SLAB = WS_Y;
constexpr size_t WS_END = 255 * MiB;
static_assert(WS_XB + (size_t)M * DM * 2 <= WS_Y && WS_Y + (size_t)M * YC * 2 <= WS_ZG && WS_ZG + (size_t)M * GC * 2 <= WS_BT3 && WS_SLAB + (size_t)11 * 512 * DM * 4 <= WS_ZG, "ws map");
static_assert((size_t)M * FF * 2 <= 96 * MiB && WS_BT5 + (size_t)2 * FF * DM * 2 <= WS_BT6 && WS_BT6 + (size_t)DM * FF * 2 <= WS_BT3, "ws map 2");
constexpr int CW_TMO = 0, CW_CODE = 1, CW_BAR = 4096, CW_SEAM = 16384, SEAM_BANK = 8192;
constexpr size_t WS_XCH = WS_Y + 32 * MiB;
constexpr int XLDS_OFF = 131072 + 1024;
constexpr int RING_OFF = 0, RING_BYTES = 131072;
constexpr int LDSCTL_OFF = RING_BYTES, MISC_OFF = LDSCTL_OFF + 320;
constexpr int LDS_BYTES = 147456;

#define GAS __attribute__((address_space(1)))
#define LAS __attribute__((address_space(3)))
typedef unsigned short bf16;
typedef unsigned v4u __attribute__((ext_vector_type(4)));
typedef unsigned v2u __attribute__((ext_vector_type(2)));
typedef float f32x4 __attribute__((ext_vector_type(4)));
typedef float f32x2 __attribute__((ext_vector_type(2)));
typedef short bf16x8 __attribute__((ext_vector_type(8)));
typedef GAS unsigned gu32;
#define RLX_AGENT __ATOMIC_RELAXED, __HIP_MEMORY_SCOPE_AGENT
#define LDS_WAIT() asm volatile("s_waitcnt lgkmcnt(0)" ::: "memory")
#define VM_WAIT() asm volatile("s_waitcnt vmcnt(0)" ::: "memory")
__device__ __forceinline__ unsigned pk2(float lo, float hi) { return pg8::cvt_pk_bf16(lo, hi); }
__device__ __forceinline__ float bflo(unsigned v) { return __uint_as_float(v << 16); }
__device__ __forceinline__ float bfhi(unsigned v) { return __uint_as_float(v & 0xffff0000u); }
__device__ __forceinline__ float bf1(unsigned short h) { return __uint_as_float((unsigned)h << 16); }
__device__ __forceinline__ unsigned short f2bf(float f) { return (unsigned short)(pg8::cvt_pk_bf16(f, 0.f) & 0xffffu); }

#define XB_TMO      128
#define XB_XCNT(j)  (256  + 64 * (j))
#define XB_XSUB(j)  (1280 + 64 * (j))
#define XB_XGEN(j)  (2304 + 64 * (j))
#define XB_TOP      3328
#define XB_TOPGEN   3392
#define XCD_BAR_WORDS 3456
#define XB_SPIN_CAP (1u << 18)
__device__ __forceinline__ unsigned xb_ld(unsigned* p)              { return __hip_atomic_load(p, __ATOMIC_RELAXED, __HIP_MEMORY_SCOPE_AGENT); }
__device__ __forceinline__ unsigned xb_add(unsigned* p, unsigned v) { return __hip_atomic_fetch_add(p, v, __ATOMIC_RELAXED, __HIP_MEMORY_SCOPE_AGENT); }
__device__ __forceinline__ unsigned xb_xcc_id() { return (unsigned)__builtin_amdgcn_s_getreg((3 << 11) | 20) & 0xFu; }
#define XB_SPIN(cond, bar) do { unsigned _sp = 0; while (cond) { __builtin_amdgcn_s_sleep(1); \
    if ((++_sp & 255u) == 0u) { if (xb_ld(&(bar)[XB_TMO])) break; if (_sp > XB_SPIN_CAP) { atomicAdd(&(bar)[XB_TMO], 1u); break; } } } } while (0)
struct XcdBarrier { unsigned* bar; unsigned x; volatile LAS unsigned* st; };
__device__ __forceinline__ XcdBarrier xcd_barrier_post(unsigned* bar, volatile LAS unsigned* st) {
    XcdBarrier b; b.bar = bar; b.x = xb_xcc_id(); b.st = st;
    if (threadIdx.x == 0) (void)xb_add(&bar[XB_XCNT(b.x)], 1u);
    return b;
}
__device__ __forceinline__ void xcd_barrier_complete(unsigned* bar, unsigned x, unsigned& nloc, unsigned& nx) {
    const unsigned G = gridDim.x * gridDim.y * gridDim.z;
    unsigned sum, cnt, mine, sp = 0u;
    for (;;) {
        sum = 0u; cnt = 0u; mine = 0u;
#pragma unroll
        for (unsigned j = 0; j < 16; ++j) { const unsigned c = xb_ld(&bar[XB_XCNT(j)]); sum += c; cnt += (c > 0u) ? 1u : 0u; mine = (j == x) ? c : mine; }
        if (sum == G) break;
        __builtin_amdgcn_s_sleep(1);
        if ((++sp & 255u) == 0u) { if (xb_ld(&bar[XB_TMO])) break; if (sp > XB_SPIN_CAP) { atomicAdd(&bar[XB_TMO], 1u); break; } }
    }
    nloc = mine > 0u ? mine : 1u; nx = cnt > 0u ? cnt : 1u;
}
__device__ __forceinline__ void xcd_barrier(const XcdBarrier& b) {
    asm volatile("s_waitcnt vmcnt(0)" ::: "memory");
    __syncthreads();
    if (threadIdx.x == 0) {
        unsigned* bar = b.bar;
        __builtin_amdgcn_s_waitcnt(0);
        unsigned nloc = b.st[0], nx = b.st[1];
        if (nloc == 0u) { xcd_barrier_complete(bar, b.x, nloc, nx); b.st[0] = nloc; b.st[1] = nx; }
        const unsigned old = xb_add(&bar[XB_XSUB(b.x)], 1u);
        const unsigned gen = old / nloc;
        if (old + 1u == (gen + 1u) * nloc) {
            __builtin_amdgcn_fence(__ATOMIC_RELEASE, "agent");
            asm volatile("s_waitcnt vmcnt(0)" ::: "memory");
            const unsigned og = xb_add(&bar[XB_TOP], 1u);
            const unsigned tg = og / nx;
            if (og + 1u == (tg + 1u) * nx) xb_add(&bar[XB_TOPGEN], 1u);
            else XB_SPIN(xb_ld(&bar[XB_TOPGEN]) == tg, bar);
            __builtin_amdgcn_fence(__ATOMIC_ACQUIRE, "agent");
            xb_add(&bar[XB_XGEN(b.x)], 1u);
            asm volatile("s_waitcnt vmcnt(0)" ::: "memory");
        } else {
            XB_SPIN(xb_ld(&bar[XB_XGEN(b.x)]) == gen, bar);
            __builtin_amdgcn_fence(__ATOMIC_ACQUIRE, "agent");
            asm volatile("s_waitcnt vmcnt(0)" ::: "memory");
        }
    }
    __syncthreads();
}

struct Frame {
    LAS unsigned char* lds;
    volatile LAS unsigned* MISC;
    gu32* ctl;
    int tid, lane, wave, G, bid;
    const float* const* in;
    float* out;
    unsigned char* ws;
};
enum { I_XP = 0, I_XS, I_SH, I_SRGC, I_SCF, I_SPOOL, I_SSC, I_WIN, I_RGCW, I_RGCB, I_RGWA, I_RGBA, I_RGWX, I_RGBX, I_LAM, I_CFW, I_CFB, I_CFG, I_CFBB, I_POOLW, I_POOLS, I_SCW,
       I_WBR, I_WOUT, I_LN1G, I_LN1B, I_WG, I_WU, I_WD, I_LN2G, I_LN2B };

__device__ __forceinline__ float shfl_idx(float v, int src_lane) { return __builtin_bit_cast(float, __builtin_amdgcn_ds_bpermute(src_lane << 2, __builtin_bit_cast(int, v))); }
__device__ __forceinline__ float wave_sum(float v, int lane) {
#pragma unroll
    for (int o = 1; o < 64; o <<= 1) v += shfl_idx(v, lane ^ o);
    return v;
}

enum { RM_ID = 0, RM_WIN = 1, RM_GU = 2 };
template <int MODE> __device__ __forceinline__ int rowmap(int s, int extra) {
    if (MODE == RM_ID) return s;
    if (MODE == RM_GU) return 256 * (s >> 7) + (s & 127) + extra;
    if (s < 1024) return s;
    if (s < 2048) { const int j = ((s - 1024) >> 7) & 3; return 1024 + 256 * j + (s >= 1536 ? 128 : 0) + (s & 127); }
    if (s < 3072) return s;
    if (s < 4096) { const int j = ((s - 3072) >> 7) & 3; return 3072 + 256 * j + (s >= 3584 ? 128 : 0) + (s & 127); }
    const int g = (s - 4096) >> 10, ch = s & 1023, pn = ch >> 6, chl = ch & 63, wc = chl >> 4, fq = (chl >> 2) & 3, i = chl & 3;
    return 4096 + 256 * pn + 128 * (g >> 1) + 32 * wc + 8 * fq + 4 * (g & 1) + i;
}
template <int MODE>
__device__ __forceinline__ void transpose_item(const float* W, int K, int N, bf16* WT, int dst_ld, int dst_koff, int extra, LAS float* scr, int item, int lane) {
    const int nblk = N / 32, kb = item / nblk, nb = item % nblk, k0 = 64 * kb, n0 = 32 * nb;
#pragma unroll 8
    for (int i = 0; i < 32; ++i) { const int kk = 2 * i + (lane >> 5); scr[kk * 33 + (lane & 31)] = W[(size_t)(k0 + kk) * N + n0 + (lane & 31)]; }
    LDS_WAIT(); asm volatile("" ::: "memory");
    const int c = lane & 7; const float sc = (MODE == RM_WIN && n0 >= 4096) ? -1.44269504089f : 1.0f;
#pragma unroll
    for (int j = 0; j < 4; ++j) { const int n = (lane >> 3) + 8 * j; const LAS float* s = scr + (8 * c) * 33 + n;
        v4u o; o.x = pk2(s[0 * 33] * sc, s[1 * 33] * sc); o.y = pk2(s[2 * 33] * sc, s[3 * 33] * sc); o.z = pk2(s[4 * 33] * sc, s[5 * 33] * sc); o.w = pk2(s[6 * 33] * sc, s[7 * 33] * sc);
        *(GAS v4u*)(WT + (size_t)rowmap<MODE>(n0 + n, extra) * dst_ld + dst_koff + k0 + 8 * c) = o; }
    LDS_WAIT(); asm volatile("" ::: "memory");
}
template <int MODE>
__device__ __forceinline__ void convert_matrix(Frame& F, const float* W, int K, int N, bf16* WT, int dst_ld, int dst_koff, int extra, int gw, int NGW, int first = 0) {
    LAS float* scr = (LAS float*)(F.lds + RING_OFF + F.wave * 16384);
    const int nitems = (K / 64) * (N / 32);
    int it0 = gw - first; if (it0 < 0) it0 += ((-it0 + NGW - 1) / NGW) * NGW;
    for (int it = it0; it < nitems; it += NGW) transpose_item<MODE>(W, K, N, WT, dst_ld, dst_koff, extra, scr, it, F.lane);
}
__device__ __forceinline__ void compose_pool(Frame& F, int layer, bf16* Bt3, int gw, int NGW, int first = 0) {
    const float* pw = F.in[I_POOLW] + (size_t)layer * 4 * 128 * 128; const float* ps = F.in[I_POOLS] + layer * 512; const float* Wb2 = F.in[I_WBR] + ((size_t)layer * 4 + 2) * 512 * 1024;
    const int lane = F.lane;
    LAS float* Pl = (LAS float*)(F.lds + RING_OFF + F.wave * 16384);
    int id0 = gw - first; if (id0 < 0) id0 += ((-id0 + NGW - 1) / NGW) * NGW;
    for (int id = id0; id < 512; id += NGW) {
        const int g = __builtin_amdgcn_readfirstlane(id >> 7), c0 = __builtin_amdgcn_readfirstlane(8 * ((id >> 3) & 15)), d0 = 128 * (id & 7) + 2 * lane;
#pragma unroll
        for (int k = 0; k < 4; ++k) { const int idx4 = lane + 64 * k, i = idx4 >> 5, e4 = (idx4 & 31) * 4;
            const f32x4 pv = *(const GAS f32x4*)(pw + ((size_t)g * 128 + c0 + i) * 128 + e4), sv = *(const GAS f32x4*)(ps + 128 * g + e4);
            Pl[(e4 + 0) * 8 + i] = pv.x * sv.x; Pl[(e4 + 1) * 8 + i] = pv.y * sv.y; Pl[(e4 + 2) * 8 + i] = pv.z * sv.z; Pl[(e4 + 3) * 8 + i] = pv.w * sv.w; }
        LDS_WAIT(); asm volatile("" ::: "memory");
        f32x2 acc[8];
#pragma unroll
        for (int i = 0; i < 8; ++i) acc[i] = (f32x2){0.f, 0.f};
        const float* wrow = Wb2 + (size_t)(128 * g) * 1024 + d0;
#pragma unroll 1
        for (int e0 = 0; e0 < 128; e0 += 8) {
            f32x2 wv[8];
#pragma unroll
            for (int k = 0; k < 8; ++k) wv[k] = *(const GAS f32x2*)(wrow + (size_t)(e0 + k) * 1024);
#pragma unroll
            for (int k = 0; k < 8; ++k) { const f32x4 p0 = *(const LAS f32x4*)(Pl + (e0 + k) * 8), p1 = *(const LAS f32x4*)(Pl + (e0 + k) * 8 + 4);
#pragma unroll
                for (int i = 0; i < 4; ++i) { acc[i] += wv[k] * p0[i]; acc[4 + i] += wv[k] * p1[i]; } }
        }
        v4u o0, o1;
        o0.x = pk2(acc[0].x, acc[1].x); o0.y = pk2(acc[2].x, acc[3].x); o0.z = pk2(acc[4].x, acc[5].x); o0.w = pk2(acc[6].x, acc[7].x);
        o1.x = pk2(acc[0].y, acc[1].y); o1.y = pk2(acc[2].y, acc[3].y); o1.z = pk2(acc[4].y, acc[5].y); o1.w = pk2(acc[6].y, acc[7].y);
        *(GAS v4u*)(Bt3 + (size_t)d0 * 2048 + 1024 + 128 * g + c0) = o0; *(GAS v4u*)(Bt3 + (size_t)(d0 + 1) * 2048 + 1024 + 128 * g + c0) = o1;
        LDS_WAIT(); asm volatile("" ::: "memory");
    }
}

__device__ __forceinline__ const float* xrow_in(Frame& F, int m) { return m < MP ? F.in[I_XP] + (size_t)m * DM : F.in[I_XS] + (size_t)(m - MP) * DM; }
__device__ __forceinline__ void x_to_bf16(Frame& F, bf16* XB) {
    const int gw = F.bid * NWAVES + F.wave, NGW = F.G * NWAVES;
    for (int m0 = 4 * gw; m0 < M; m0 += 4 * NGW) {
        f32x4 v[4][4];
#pragma unroll
        for (int k = 0; k < 4; ++k) { const GAS f32x4* xr = (const GAS f32x4*)xrow_in(F, m0 + k) + F.lane;
#pragma unroll
            for (int j = 0; j < 4; ++j) v[k][j] = xr[64 * j]; }
#pragma unroll
        for (int k = 0; k < 4; ++k) { GAS v2u* o = (GAS v2u*)(XB + (size_t)(m0 + k) * DM) + F.lane;
#pragma unroll
            for (int j = 0; j < 4; ++j) o[64 * j] = (v2u){pk2(v[k][j].x, v[k][j].y), pk2(v[k][j].z, v[k][j].w)}; } }
}
__device__ __forceinline__ void ln_rows(Frame& F, const float* V, float* O, const float* g, const float* b, bf16* XB, const float* sbase, const float* slab, int nslab) {
    const int gw = F.bid * NWAVES + F.wave, NGW = F.G * NWAVES;
    f32x4 gv[4], bv[4];
#pragma unroll
    for (int j = 0; j < 4; ++j) { gv[j] = ((const GAS f32x4*)g)[F.lane + 64 * j]; bv[j] = ((const GAS f32x4*)b)[F.lane + 64 * j]; }
    for (int m = MP + gw; m < M; m += NGW) {
        const GAS f32x4* xr = (const GAS f32x4*)(V + (size_t)m * DM) + F.lane; GAS f32x4* orow = (GAS f32x4*)(O + (size_t)m * DM) + F.lane;
        f32x4 v[4]; float s = 0.f;
#pragma unroll
        for (int j = 0; j < 4; ++j) v[j] = xr[64 * j];
        if (m >= MP) { const GAS f32x4* br = (const GAS f32x4*)(sbase + (size_t)(m - MP) * DM) + F.lane;
#pragma unroll
            for (int j = 0; j < 4; ++j) v[j] = br[64 * j] * ALPHA;
            for (int sl = 0; sl < nslab; ++sl) { const GAS f32x4* sr = (const GAS f32x4*)(slab + ((size_t)sl * 512 + (m - MP)) * DM) + F.lane;
#pragma unroll
                for (int j = 0; j < 4; ++j) v[j] += sr[64 * j]; } }
#pragma unroll
        for (int j = 0; j < 4; ++j) s += (v[j].x + v[j].y) + (v[j].z + v[j].w);
        const float mean = wave_sum(s, F.lane) * (1.f / DM); float s2 = 0.f;
#pragma unroll
        for (int j = 0; j < 4; ++j) { v[j] = v[j] - mean; s2 += (v[j].x * v[j].x + v[j].y * v[j].y) + (v[j].z * v[j].z + v[j].w * v[j].w); }
        const float rstd = __builtin_amdgcn_rsqf(wave_sum(s2, F.lane) * (1.f / DM) + LN_EPS);
#pragma unroll
        for (int j = 0; j < 4; ++j) { v[j] = v[j] * rstd * gv[j] + bv[j]; orow[64 * j] = v[j]; }
        if (XB) { GAS v2u* o = (GAS v2u*)(XB + (size_t)m * DM) + F.lane;
#pragma unroll
            for (int j = 0; j < 4; ++j) o[64 * j] = (v2u){pk2(v[j].x, v[j].y), pk2(v[j].z, v[j].w)}; }
    }
}

__device__ __forceinline__ float softplusf_acc(float x) { return fmaxf(x, 0.f) + log1pf(__expf(-fabsf(x))); }
__device__ __forceinline__ float expm1_neg(float x) {
    const float p = x * (1.f + x * (0.5f + x * (1.f / 6.f + x * (1.f / 24.f + x * (1.f / 120.f + x * (1.f / 720.f + x * (1.f / 5040.f)))))));
    return x > -0.25f ? p : __expf(x) - 1.f;
}
constexpr int PATCH_STRIDE = 144;

struct ALane {
    float cwD[4], cbD, ba, bx, ck;
    bf16x8 Ba[4][2], Bx[4][2];
};
constexpr int PATCH_BYTES = 5120, ASLOT_OFF = 8 * PATCH_BYTES;
__device__ __forceinline__ void a_setup(Frame& F, int layer, int n, int q, ALane& L) {
    const int c = F.lane & 15, kg = F.lane >> 4, och = 64 * n + 16 * q + c;
    const float* cw = F.in[I_RGCW] + (size_t)layer * 4 * 512 + 64 * n; const float* cb = F.in[I_RGCB] + layer * 512 + 64 * n;
#pragma unroll
    for (int j = 0; j < 4; ++j) L.cwD[j] = cw[j * 512 + 16 * q + c];
    L.cbD = cb[16 * q + c];
    L.ck = 8.0f * softplusf_acc(-F.in[I_LAM][layer * 512 + och]);
    const float* wa = F.in[I_RGWA] + ((size_t)layer * 8 + n) * 4096 + 16 * q + c; const float* wx = F.in[I_RGWX] + ((size_t)layer * 8 + n) * 4096 + 16 * q + c;
    float wav[16], wxv[16], cbv[16];
#pragma unroll
    for (int e = 0; e < 16; ++e) { const int k = (e < 8 ? 8 * kg + e : 32 + 8 * kg + (e - 8)); wav[e] = wa[k * 64]; wxv[e] = wx[k * 64]; cbv[e] = cb[k]; }
#pragma unroll
    for (int j = 0; j < 4; ++j) { float t[16];
#pragma unroll
        for (int e = 0; e < 16; ++e) t[e] = cw[j * 512 + (e < 8 ? 8 * kg + e : 32 + 8 * kg + (e - 8))];
        L.Ba[j][0] = __builtin_bit_cast(bf16x8, (v4u){pk2(wav[0] * t[0], wav[1] * t[1]), pk2(wav[2] * t[2], wav[3] * t[3]), pk2(wav[4] * t[4], wav[5] * t[5]), pk2(wav[6] * t[6], wav[7] * t[7])});
        L.Ba[j][1] = __builtin_bit_cast(bf16x8, (v4u){pk2(wav[8] * t[8], wav[9] * t[9]), pk2(wav[10] * t[10], wav[11] * t[11]), pk2(wav[12] * t[12], wav[13] * t[13]), pk2(wav[14] * t[14], wav[15] * t[15])});
        L.Bx[j][0] = __builtin_bit_cast(bf16x8, (v4u){pk2(wxv[0] * t[0], wxv[1] * t[1]), pk2(wxv[2] * t[2], wxv[3] * t[3]), pk2(wxv[4] * t[4], wxv[5] * t[5]), pk2(wxv[6] * t[6], wxv[7] * t[7])});
        L.Bx[j][1] = __builtin_bit_cast(bf16x8, (v4u){pk2(wxv[8] * t[8], wxv[9] * t[9]), pk2(wxv[10] * t[10], wxv[11] * t[11]), pk2(wxv[12] * t[12], wxv[13] * t[13]), pk2(wxv[14] * t[14], wxv[15] * t[15])}); }
    float sa = 0.f, sx = 0.f;
#pragma unroll
    for (int e = 0; e < 16; ++e) { sa = fmaf(cbv[e], wav[e], sa); sx = fmaf(cbv[e], wxv[e], sx); }
    sa += shfl_idx(sa, F.lane ^ 16); sa += shfl_idx(sa, F.lane ^ 32); sx += shfl_idx(sx, F.lane ^ 16); sx += shfl_idx(sx, F.lane ^ 32);
    L.ba = F.in[I_RGBA][layer * 512 + och] + sa; L.bx = F.in[I_RGBX][layer * 512 + och] + sx;
}
__device__ __forceinline__ void a_block(const ALane& L, const LAS unsigned char* patch, int rowA0, int baseD, int q, int lane, float (&a)[4], float (&bb)[4]) {
    const int c = lane & 15, kg = lane >> 4;
    f32x4 accR = (f32x4){0.f, 0.f, 0.f, 0.f}, accI = (f32x4){0.f, 0.f, 0.f, 0.f};
#pragma unroll
    for (int j = 0; j < 4; ++j) { const LAS unsigned char* rp = patch + (rowA0 + j) * PATCH_STRIDE + 16 * kg;
        const bf16x8 A0 = *(const LAS bf16x8*)rp, A1 = *(const LAS bf16x8*)(rp + 64);
        accR = __builtin_amdgcn_mfma_f32_16x16x32_bf16(A0, L.Ba[j][0], accR, 0, 0, 0); accR = __builtin_amdgcn_mfma_f32_16x16x32_bf16(A1, L.Ba[j][1], accR, 0, 0, 0);
        accI = __builtin_amdgcn_mfma_f32_16x16x32_bf16(A0, L.Bx[j][0], accI, 0, 0, 0); accI = __builtin_amdgcn_mfma_f32_16x16x32_bf16(A1, L.Bx[j][1], accI, 0, 0, 0); }
    float pv[7];
#pragma unroll
    for (int k = 0; k < 7; ++k) pv[k] = bf1(*(const LAS unsigned short*)(patch + (baseD + k) * PATCH_STRIDE + 2 * (16 * q + c)));
#pragma unroll
    for (int r = 0; r < 4; ++r) {
        const float xd = L.cbD + L.cwD[0] * pv[r] + L.cwD[1] * pv[r + 1] + L.cwD[2] * pv[r + 2] + L.cwD[3] * pv[r + 3];
        const float rr = pg8::sigmoidf_fast(accR[r] + L.ba), ii = pg8::sigmoidf_fast(accI[r] + L.bx);
        const float la = -L.ck * rr;
        const float av = __builtin_amdgcn_exp2f(1.44269504089f * la);
        a[r] = av; bb[r] = __builtin_amdgcn_sqrtf(fmaxf(1.f - av * av, 0.f)) * (ii * xd);
    }
}
struct BlkScan { float Ac[4], Bc[4], EA, EB, WA, WB; };
__device__ __forceinline__ void blk_scan(const float (&a)[4], const float (&bb)[4], int lane, BlkScan& S) {
    const int c = lane & 15, g = lane >> 4;
    S.Ac[0] = a[0]; S.Bc[0] = bb[0];
#pragma unroll
    for (int r = 1; r < 4; ++r) { S.Ac[r] = a[r] * S.Ac[r - 1]; S.Bc[r] = a[r] * S.Bc[r - 1] + bb[r]; }
    float IA = S.Ac[3], IB = S.Bc[3];
    { const float pa = shfl_idx(IA, lane - 16), pb = shfl_idx(IB, lane - 16); if (g >= 1) { IB = IA * pb + IB; IA = IA * pa; } }
    { const float pa = shfl_idx(IA, lane - 32), pb = shfl_idx(IB, lane - 32); if (g >= 2) { IB = IA * pb + IB; IA = IA * pa; } }
    S.EA = shfl_idx(IA, lane - 16); S.EB = shfl_idx(IB, lane - 16); if (g == 0) { S.EA = 1.f; S.EB = 0.f; }
    S.WA = shfl_idx(IA, 48 + c); S.WB = shfl_idx(IB, 48 + c);
}
__device__ __forceinline__ void a_prompt_item(Frame& F, int layer, int item, const bf16* Z, bf16* Y) {
    const int b = item >> 5, n = (item >> 2) & 7, q = item & 3, lane = opqv(F.lane), w = F.wave, c = lane & 15, g = lane >> 4, och = 64 * n + 16 * q + c;
    ALane L; a_setup(F, layer, n, q, L);
    LAS unsigned char* patch = F.lds + RING_OFF + w * PATCH_BYTES;
    LAS f32x2* slots = (LAS f32x2*)(F.lds + RING_OFF + ASLOT_OFF);
    const bf16* Zb = Z + (size_t)b * SEQ * ZC;
    float hrun = 0.f;
    v4u pf[5];
    auto load_patch = [&](int tb) {
#pragma unroll
        for (int k = 0; k < 5; ++k) { const int ci = lane + 64 * k, pr = ci >> 3, cc = ci & 7, t = tb - 3 + pr;
            pf[k] = (ci < 280 && t >= 0) ? *(const GAS v4u*)(Zb + (size_t)t * ZC + 64 * n + 8 * cc) : (v4u){0u, 0u, 0u, 0u}; }
    };
    load_patch(32 * w);
    for (int it = 0; it < 8; ++it) {
        const int tb = 256 * it + 32 * w;
#pragma unroll
        for (int k = 0; k < 5; ++k) { const int ci = lane + 64 * k, pr = ci >> 3, cc = ci & 7; if (ci < 280) *(LAS v4u*)(patch + pr * PATCH_STRIDE + 16 * cc) = pf[k]; }
        if (it < 7) load_patch(tb + 256);
        unsigned short gav[8];
#pragma unroll
        for (int r = 0; r < 8; ++r) gav[r] = *(const GAS unsigned short*)(Zb + (size_t)(tb + 16 * (r >> 2) + 4 * g + (r & 3)) * ZC + 512 + och);
        asm volatile("" ::: "memory");
        float a0[4], b0[4], a1[4], b1[4];
        a_block(L, patch, lane & 15, 4 * g, q, lane, a0, b0);
        a_block(L, patch, 16 + (lane & 15), 16 + 4 * g, q, lane, a1, b1);
        BlkScan S0, S1; blk_scan(a0, b0, lane, S0); blk_scan(a1, b1, lane, S1);
        if (lane < 16) slots[((it & 1) * 8 + w) * 16 + c] = (f32x2){S0.WA * S1.WA, S1.WA * S0.WB + S1.WB};
        __syncthreads();
        float hin = hrun, hw = 0.f;
#pragma unroll
        for (int ww = 0; ww < 8; ++ww) { const f32x2 s = slots[((it & 1) * 8 + ww) * 16 + c]; if (ww == w) hw = hin; hin = s.x * hin + s.y; }
        hrun = hin;
        const float hg0 = S0.EA * hw + S0.EB, hw1 = S0.WA * hw + S0.WB, hg1 = S1.EA * hw1 + S1.EB;
#pragma unroll
        for (int r = 0; r < 4; ++r) { const float h = S0.Ac[r] * hg0 + S0.Bc[r];
            *(GAS unsigned short*)(Y + (size_t)(b * SEQ + tb + 4 * g + r) * YC + och) = f2bf(h * bf1(gav[r])); }
#pragma unroll
        for (int r = 0; r < 4; ++r) { const float h = S1.Ac[r] * hg1 + S1.Bc[r];
            *(GAS unsigned short*)(Y + (size_t)(b * SEQ + tb + 16 + 4 * g + r) * YC + och) = f2bf(h * bf1(gav[4 + r]));
            if (r == 3 && it == 7 && w == 7 && g == 3) F.out[O_PH + (size_t)(layer * 8 + b) * 512 + och] = h; }
    }
}
__device__ __forceinline__ void a_sample_task(Frame& F, int layer, int task, const bf16* Z, bf16* Y) {
    const int blk = task >> 5, n = (task >> 2) & 7, q = task & 3, lane = opqv(F.lane), c = lane & 15, g = lane >> 4, och = 64 * n + 16 * q + c, s0 = 4 * blk;
    ALane L; a_setup(F, layer, n, q, L);
    LAS unsigned char* patch = F.lds + RING_OFF + F.wave * PATCH_BYTES;
#pragma unroll
    for (int k = 0; k < 4; ++k) { const int ci = lane + 64 * k; if (ci < 224) { const int pr = ci >> 3, cc = ci & 7, sq = pr / 7, tau = pr - 7 * sq - 3, seq = s0 + sq; v4u v;
            if (tau < 0) { const GAS f32x4* sp = (const GAS f32x4*)(F.in[I_SRGC] + ((size_t)(layer * 128 + seq) * 3 + (tau + 3)) * 512 + 64 * n + 8 * cc); const f32x4 f0 = sp[0], f1 = sp[1];
                v = (v4u){pk2(f0.x, f0.y), pk2(f0.z, f0.w), pk2(f1.x, f1.y), pk2(f1.z, f1.w)}; }
            else v = *(const GAS v4u*)(Z + (size_t)(MP + 4 * seq + tau) * ZC + 64 * n + 8 * cc);
            *(LAS v4u*)(patch + pr * PATCH_STRIDE + 16 * cc) = v; } }
    asm volatile("" ::: "memory");
    float a[4], bb[4];
    a_block(L, patch, 7 * ((lane & 15) >> 2) + (lane & 3), 7 * g, q, lane, a, bb);
    const int seq = s0 + g;
    float h = F.in[I_SH][(size_t)(layer * 128 + seq) * 512 + och];
#pragma unroll
    for (int r = 0; r < 4; ++r) { h = a[r] * h + bb[r]; const size_t row = (size_t)(MP + 4 * seq + r);
        *(GAS unsigned short*)(Y + row * YC + och) = f2bf(h * bf1(*(const GAS unsigned short*)(Z + row * ZC + 512 + och))); }
    F.out[O_SH + (size_t)(layer * 128 + seq) * 512 + och] = h;
}

__device__ __forceinline__ void ln_silu_row(const LAS float* xr, const float* g, const float* b, bf16* dst, int lane) {
    const f32x4 v0 = *(const LAS f32x4*)(xr + 4 * lane), v1 = *(const LAS f32x4*)(xr + 256 + 4 * lane);
    const float s = (v0.x + v0.y) + (v0.z + v0.w) + (v1.x + v1.y) + (v1.z + v1.w);
    const float mean = wave_sum(s, lane) * (1.f / 512.f);
    const f32x4 d0 = v0 - mean, d1 = v1 - mean;
    const float s2 = (d0.x * d0.x + d0.y * d0.y) + (d0.z * d0.z + d0.w * d0.w) + (d1.x * d1.x + d1.y * d1.y) + (d1.z * d1.z + d1.w * d1.w);
    const float rstd = __builtin_amdgcn_rsqf(wave_sum(s2, lane) * (1.f / 512.f) + LN_EPS);
    const f32x4 g0 = *(const GAS f32x4*)(g + 4 * lane), g1 = *(const GAS f32x4*)(g + 256 + 4 * lane), b0 = *(const GAS f32x4*)(b + 4 * lane), b1 = *(const GAS f32x4*)(b + 256 + 4 * lane);
    f32x4 y0 = d0 * rstd * g0 + b0, y1 = d1 * rstd * g1 + b1;
#pragma unroll
    for (int i = 0; i < 4; ++i) { y0[i] = y0[i] * pg8::sigmoidf_fast(y0[i]); y1[i] = y1[i] * pg8::sigmoidf_fast(y1[i]); }
    *(GAS v2u*)(dst + 4 * lane) = (v2u){pk2(y0.x, y0.y), pk2(y0.z, y0.w)}; *(GAS v2u*)(dst + 256 + 4 * lane) = (v2u){pk2(y1.x, y1.y), pk2(y1.z, y1.w)};
}
__device__ __forceinline__ void ln_silu_rows4(const LAS float* xr, int rstride, const float* g, const float* b, bf16* dst, size_t dstride, int lane) {
    f32x4 v0[4], v1[4]; float s[4], s2[4];
#pragma unroll
    for (int k = 0; k < 4; ++k) { v0[k] = *(const LAS f32x4*)(xr + k * rstride + 4 * lane); v1[k] = *(const LAS f32x4*)(xr + k * rstride + 256 + 4 * lane);
        s[k] = (v0[k].x + v0[k].y) + (v0[k].z + v0[k].w) + (v1[k].x + v1[k].y) + (v1[k].z + v1[k].w); }
#pragma unroll
    for (int o = 1; o < 64; o <<= 1) {
#pragma unroll
        for (int k = 0; k < 4; ++k) s[k] += shfl_idx(s[k], lane ^ o); }
#pragma unroll
    for (int k = 0; k < 4; ++k) { const float mean = s[k] * (1.f / 512.f); v0[k] = v0[k] - mean; v1[k] = v1[k] - mean;
        s2[k] = (v0[k].x * v0[k].x + v0[k].y * v0[k].y) + (v0[k].z * v0[k].z + v0[k].w * v0[k].w) + (v1[k].x * v1[k].x + v1[k].y * v1[k].y) + (v1[k].z * v1[k].z + v1[k].w * v1[k].w); }
#pragma unroll
    for (int o = 1; o < 64; o <<= 1) {
#pragma unroll
        for (int k = 0; k < 4; ++k) s2[k] += shfl_idx(s2[k], lane ^ o); }
    const f32x4 g0 = *(const GAS f32x4*)(g + 4 * lane), g1 = *(const GAS f32x4*)(g + 256 + 4 * lane), b0 = *(const GAS f32x4*)(b + 4 * lane), b1 = *(const GAS f32x4*)(b + 256 + 4 * lane);
#pragma unroll
    for (int k = 0; k < 4; ++k) { const float rstd = __builtin_amdgcn_rsqf(s2[k] * (1.f / 512.f) + LN_EPS);
        f32x4 y0 = v0[k] * rstd * g0 + b0, y1 = v1[k] * rstd * g1 + b1;
#pragma unroll
        for (int i = 0; i < 4; ++i) { y0[i] = y0[i] * pg8::sigmoidf_fast(y0[i]); y1[i] = y1[i] * pg8::sigmoidf_fast(y1[i]); }
        bf16* d = dst + (size_t)k * dstride;
        *(GAS v2u*)(d + 4 * lane) = (v2u){pk2(y0.x, y0.y), pk2(y0.z, y0.w)}; *(GAS v2u*)(d + 256 + 4 * lane) = (v2u){pk2(y1.x, y1.y), pk2(y1.z, y1.w)}; }
}
__device__ __forceinline__ void b_prompt_item(Frame& F, int layer, int item, const bf16* Z, bf16* Y) {
    const int tidl = opqv(F.tid), b = item >> 5, t0 = 64 * (item & 31), p = tidl & 255, hh = tidl >> 8, ts = t0 + 32 * hh;
    const GAS unsigned* Zu = (const GAS unsigned*)(Z + (size_t)b * SEQ * ZC) + 512 + p;
    unsigned raw[62];
#pragma unroll
    for (int i = 0; i < 62; ++i) { const int t = ts - 30 + i; raw[i] = t >= 0 ? Zu[(size_t)t * (ZC / 2)] : 0u; }
    const float* cw = F.in[I_CFW] + (size_t)layer * 31 * 512 + 2 * p;
    f32x2 wj[31];
#pragma unroll
    for (int j = 0; j < 31; ++j) wj[j] = *(const GAS f32x2*)(cw + j * 512);
    const f32x2 bias = *(const GAS f32x2*)(F.in[I_CFB] + layer * 512 + 2 * p);
    f32x2 in[62];
#pragma unroll
    for (int i = 0; i < 62; ++i) in[i] = (f32x2){bflo(raw[i]), bfhi(raw[i])};
    LAS float* obuf = (LAS float*)(F.lds + RING_OFF);
#pragma unroll
    for (int i = 0; i < 32; ++i) { f32x2 o = bias;
#pragma unroll
        for (int j = 0; j < 31; ++j) o += wj[j] * in[i + j];
        *(LAS f32x2*)(obuf + (32 * hh + i) * 512 + 2 * p) = o; }
    __syncthreads();
    const float* lg = F.in[I_CFG] + layer * 512; const float* lb = F.in[I_CFBB] + layer * 512;
#pragma unroll 1
    for (int r = 8 * F.wave; r < 8 * F.wave + 8; r += 4) ln_silu_rows4(obuf + r * 512, 512, lg, lb, Y + (size_t)(b * SEQ + t0 + r) * YC + 512, YC, F.lane);
}
__device__ __forceinline__ void cd_prompt_item(Frame& F, int layer, int item, const bf16* Z, bf16* Y) {
    const int tidl = opqv(F.tid), b = item >> 5, t0 = 64 * (item & 31), p = tidl & 255, hh = tidl >> 8;
    const bf16* Zb = Z + (size_t)b * SEQ * ZC;
    LAS unsigned* cbuf = (LAS unsigned*)(F.lds + RING_OFF);
    { v4u tmp[10];
#pragma unroll
      for (int k = 0; k < 10; ++k) { const int ci = tidl + 512 * k, pr = ci >> 6, cc = ci & 63, t = t0 - 15 + pr;
          tmp[k] = (ci < 79 * 64 && t >= 0) ? *(const GAS v4u*)(Zb + (size_t)t * ZC + 1536 + 8 * cc) : (v4u){0u, 0u, 0u, 0u}; }
#pragma unroll
      for (int k = 0; k < 10; ++k) { const int ci = tidl + 512 * k, pr = ci >> 6, cc = ci & 63; if (ci < 79 * 64) *(LAS v4u*)(cbuf + pr * 256 + 4 * cc) = tmp[k]; } }
    const int ts = t0 + 32 * hh;
    unsigned uu[34], dd[32];
#pragma unroll
    for (int i = 0; i < 34; ++i) { const int t = ts - 2 + i; uu[i] = t >= 0 ? ((const GAS unsigned*)(Zb + (size_t)t * ZC))[1280 + p] : 0u; }
#pragma unroll
    for (int i = 0; i < 32; ++i) dd[i] = ((const GAS unsigned*)(Zb + (size_t)(ts + i) * ZC))[1024 + p];
    const f32x2 w0 = ((const GAS f32x2*)(F.in[I_SCW] + (size_t)(layer * 3 + 0) * 512))[p], w1 = ((const GAS f32x2*)(F.in[I_SCW] + (size_t)(layer * 3 + 1) * 512))[p],
                w2 = ((const GAS f32x2*)(F.in[I_SCW] + (size_t)(layer * 3 + 2) * 512))[p];
    __syncthreads();
    const int w = 2 << (p >> 6), rr0 = 15 + 32 * hh;
    f32x2 s = (f32x2){0.f, 0.f};
    for (int j = 0; j < w; ++j) { const unsigned v = cbuf[(rr0 - j) * 256 + p]; s += (f32x2){bflo(v), bfhi(v)}; }
    GAS unsigned* Yu = (GAS unsigned*)(Y + (size_t)(b * SEQ + ts) * YC) + p;
#pragma unroll
    for (int i = 0; i < 32; ++i) { const int t = ts + i, rr = rr0 + i;
        const unsigned cur = cbuf[rr * 256 + p]; const f32x2 cf = (f32x2){bflo(cur), bfhi(cur)};
        if (i > 0) { const unsigned old = cbuf[(rr - w) * 256 + p]; s += cf - (f32x2){bflo(old), bfhi(old)}; }
        const float ic = __builtin_amdgcn_rcpf((float)(t + 1 < w ? t + 1 : w));
        const f32x2 mm = s * ic - cf;
        Yu[(size_t)i * 1024 + 512] = pk2(mm.x, mm.y);
        const f32x2 cv = w0 * (f32x2){bflo(uu[i]), bfhi(uu[i])} + w1 * (f32x2){bflo(uu[i + 1]), bfhi(uu[i + 1])} + w2 * (f32x2){bflo(uu[i + 2]), bfhi(uu[i + 2])};
        const f32x2 yd = (f32x2){bflo(dd[i]), bfhi(dd[i])} * cv;
        Yu[(size_t)i * 1024 + 768] = pk2(yd.x, yd.y); }
}
__device__ __forceinline__ void s_sample_item(Frame& F, int layer, int s, const bf16* Z, bf16* Y) {
    const int ch = opqv(F.tid); const size_t ls = (size_t)layer * 128 + s;
    const bf16* Zr = Z + (size_t)(MP + 4 * s) * ZC; bf16* Yr = Y + (size_t)(MP + 4 * s) * YC;
    LAS float* obuf = (LAS float*)(F.lds + RING_OFF);
    float in[34], wv[31], pb[19], u[6], dbv[4];
#pragma unroll
    for (int j = 0; j < 30; ++j) in[j] = (F.in[I_SCF] + (ls * 30 + j) * 512)[ch];
#pragma unroll
    for (int j = 0; j < 15; ++j) pb[j] = (F.in[I_SPOOL] + (ls * 15 + j) * 512)[ch];
    u[0] = (F.in[I_SSC] + (ls * 2 + 0) * 512)[ch]; u[1] = (F.in[I_SSC] + (ls * 2 + 1) * 512)[ch];
#pragma unroll
    for (int r = 0; r < 4; ++r) { in[30 + r] = bf1((Zr + (size_t)r * ZC + 1024)[ch]); pb[15 + r] = bf1((Zr + (size_t)r * ZC + 1536)[ch]); u[2 + r] = bf1((Zr + (size_t)r * ZC + 2560)[ch]); dbv[r] = bf1((Zr + (size_t)r * ZC + 2048)[ch]); }
#pragma unroll
    for (int j = 0; j < 31; ++j) wv[j] = (F.in[I_CFW] + ((size_t)layer * 31 + j) * 512)[ch];
    const float bias = (F.in[I_CFB] + layer * 512)[ch];
    const float w0 = (F.in[I_SCW] + (size_t)(layer * 3 + 0) * 512)[ch], w1 = (F.in[I_SCW] + (size_t)(layer * 3 + 1) * 512)[ch], w2 = (F.in[I_SCW] + (size_t)(layer * 3 + 2) * 512)[ch];
    asm volatile("" ::: "memory");
#pragma unroll
    for (int j = 0; j < 26; ++j) (F.out + O_SCF + (ls * 30 + j) * 512)[ch] = in[j + 4];
#pragma unroll
    for (int r = 0; r < 4; ++r) { float o = bias;
#pragma unroll
        for (int j = 0; j < 31; ++j) o += wv[j] * in[r + j];
        obuf[r * 512 + ch] = o; }
#pragma unroll
    for (int j = 0; j < 11; ++j) (F.out + O_SPOOL + (ls * 15 + j) * 512)[ch] = pb[j + 4];
    const int gsel = ch >> 7;
#pragma unroll
    for (int r = 0; r < 4; ++r) { const int k = 15 + r;
        const float s2 = pb[k] + pb[k - 1], s4 = s2 + pb[k - 2] + pb[k - 3], s8 = s4 + (pb[k - 4] + pb[k - 5]) + (pb[k - 6] + pb[k - 7]);
        float s16 = s8;
#pragma unroll
        for (int j = 8; j < 16; ++j) s16 += pb[k - j];
        const float mv = (gsel == 0 ? s2 * 0.5f : gsel == 1 ? s4 * 0.25f : gsel == 2 ? s8 * 0.125f : s16 * 0.0625f) - pb[k];
        (Yr + (size_t)r * YC + 1024)[ch] = f2bf(mv); }
#pragma unroll
    for (int r = 0; r < 4; ++r) (Yr + (size_t)r * YC + 1536)[ch] = f2bf(dbv[r] * (w0 * u[r] + w1 * u[r + 1] + w2 * u[r + 2]));
    __syncthreads();
    if (F.wave < 4) ln_silu_row(obuf + F.wave * 512, F.in[I_CFG] + layer * 512, F.in[I_CFBB] + layer * 512, Yr + (size_t)F.wave * YC + 512, F.lane);
}

struct Args { const float* in[31]; float* out; unsigned char* ws; int ph_lo, ph_hi; };
__global__ void __launch_bounds__(NWAVES * 64, 2) hybrid_fwd(Args args) {
    extern __shared__ __attribute__((aligned(16))) unsigned char lds[];
    Frame F;
    F.lds = (LAS unsigned char*)lds;
    F.MISC = (volatile LAS unsigned*)(F.lds + MISC_OFF);
    const int wave0 = __builtin_amdgcn_readfirstlane((int)threadIdx.x >> 6);
    F.lane = lane_now(); F.wave = wave0; F.tid = F.wave * 64 + F.lane;
    F.G = gridDim.x; F.bid = blockIdx.x;
    F.ws = args.ws; F.out = args.out; F.ctl = (gu32*)(args.ws + WS_CTL);
    F.in = args.in;
    for (int u = F.tid; u < (LDS_BYTES - LDSCTL_OFF) / 4; u += NWAVES * 64) ((LAS unsigned*)(F.lds + LDSCTL_OFF))[u] = 0u;
    __syncthreads();
    XcdBarrier bar; bar.bar = (unsigned*)(F.ctl + CW_BAR); bar.x = 0; bar.st = nullptr;
    if (!MK_SPLIT) bar = xcd_barrier_post((unsigned*)(F.ctl + CW_BAR), F.MISC + 8);
    const int lo = args.ph_lo, hi = args.ph_hi;
#define IN(k) (lo <= (k) && (k) < hi)
#define REFRESH() do { F.lane = lane_now(); F.wave = opqs(wave0); F.tid = F.wave * 64 + F.lane; F.bid = opqs((int)blockIdx.x); } while (0)
#define SEAM(k) do { if (IN(k) && IN((k) + 1)) xcd_barrier(bar); } while (0)
    bf16* WA = (bf16*)(F.ws + WS_WA); bf16* XB = (bf16*)(F.ws + WS_XB); bf16* Y = (bf16*)(F.ws + WS_Y); bf16* Zm = (bf16*)(F.ws + WS_ZG); _Float16* Gb = (_Float16*)(F.ws + WS_ZG);
    bf16* Hb = (bf16*)(F.ws + WS_ZG); bf16* Bt3 = (bf16*)(F.ws + WS_BT3); bf16* Bt4 = (bf16*)(F.ws + WS_BT4); bf16* Bt5 = (bf16*)(F.ws + WS_BT5); bf16* Bt6 = (bf16*)(F.ws + WS_BT6);

    if (IN(0)) { REFRESH(); convert_matrix<RM_WIN>(F, F.in[I_WIN], DM, INC, WA, DM, 0, 0, F.bid * NWAVES + F.wave, F.G * NWAVES); REFRESH(); x_to_bf16(F, XB); }
    SEAM(0);

    for (int l = 0; l < 2; ++l) {
        const int pb = 1 + 9 * l;
        if (IN(pb + 0)) for (int rep = 0; rep < NREP(0); ++rep) { if (rep) xcd_barrier(bar); pg8::Gemm g{XB, WA, DM, DM}; pg8::UnitOrder S; S.init(pg8::SK_PLAIN, 4096, DM, F.G, F.bid, 0); pg8::EpiMix E{Zm, F.out, l};
            pg8::gemm_phase<pg8::EpiMix, pg8::UnitOrder, true>(F.lds + RING_OFF, g, S, E, wave0);
            if (F.G == 256 && F.bid >= 32) {
                REFRESH(); const int gw = (F.bid - 32) * NWAVES + F.wave, NGW = 224 * NWAVES; const float* wbr = F.in[I_WBR] + (size_t)l * 4 * 512 * 1024;
                convert_matrix<RM_ID>(F, wbr, 512, 1024, Bt3, 2048, 0, 0, gw, NGW, 0);
                convert_matrix<RM_ID>(F, wbr + (size_t)512 * 1024, 512, 1024, Bt3, 2048, 512, 0, gw, NGW, 256);
                convert_matrix<RM_ID>(F, wbr + (size_t)3 * 512 * 1024, 512, 1024, Bt3, 2048, 1536, 0, gw, NGW, 512);
                convert_matrix<RM_ID>(F, F.in[I_WOUT] + (size_t)l * DM * DM, DM, DM, Bt4, DM, 0, 0, gw, NGW, 768);
                REFRESH(); compose_pool(F, l, Bt3, gw, NGW, 1280); } }
        SEAM(pb + 0);
        if (IN(pb + 1)) for (int rep = 0; rep < NREP(1); ++rep) { if (rep) xcd_barrier(bar);
            __syncthreads(); REFRESH();
            for (int r2 = 0; r2 < NREP2(0); ++r2) for (int it = F.bid; it < 256; it += F.G) { a_prompt_item(F, l, it, Zm, Y); __syncthreads(); }
            REFRESH();
            for (int r2 = 0; r2 < NREP2(1); ++r2) for (int it = (F.bid + 128) % F.G; it < 128; it += F.G) a_sample_task(F, l, 8 * it + F.wave, Zm, Y);
            __syncthreads(); REFRESH();
            const bool rebal = F.G == 256, gemm_wg = rebal && F.bid >= 128 && F.bid < 160;
            for (int r2 = 0; r2 < NREP2(2); ++r2) { if (!gemm_wg) for (int it = F.bid; it < 256; it += F.G) { b_prompt_item(F, l, it, Zm, Y); __syncthreads(); }
                if (rebal && F.bid >= 160 && F.bid < 192) { b_prompt_item(F, l, F.bid - 32, Zm, Y); __syncthreads(); } }
            REFRESH();
            for (int r2 = 0; r2 < NREP2(3); ++r2) { if (!gemm_wg) for (int it = F.bid; it < 256; it += F.G) { cd_prompt_item(F, l, it, Zm, Y); __syncthreads(); }
                if (rebal && F.bid >= 192 && F.bid < 224) { cd_prompt_item(F, l, F.bid - 64, Zm, Y); __syncthreads(); } }
            REFRESH();
            for (int r2 = 0; r2 < NREP2(4); ++r2) for (int it = F.bid; it < 128; it += F.G) { s_sample_item(F, l, it, Zm, Y); __syncthreads(); }
            if (F.G == 256 && F.bid >= 128 && F.bid < 160) {
                pg8::Gemm g{XB, WA + (size_t)4096 * DM, DM, DM}; pg8::UnitOrder S; S.init(pg8::SK_PLAIN, 4096, DM, 32, F.bid - 128, 0, false, true); pg8::EpiGate E{Gb};
                pg8::gemm_phase<pg8::EpiGate, pg8::UnitOrder, true>(F.lds + RING_OFF, g, S, E, wave0); }
            REFRESH();
            const float* wbr = F.in[I_WBR] + (size_t)l * 4 * 512 * 1024;
            if (F.G != 256) { const int gw = F.bid * NWAVES + F.wave, NGW = F.G * NWAVES;
                convert_matrix<RM_ID>(F, wbr, 512, 1024, Bt3, 2048, 0, 0, gw, NGW); convert_matrix<RM_ID>(F, wbr + (size_t)512 * 1024, 512, 1024, Bt3, 2048, 512, 0, gw, NGW);
                convert_matrix<RM_ID>(F, wbr + (size_t)3 * 512 * 1024, 512, 1024, Bt3, 2048, 1536, 0, gw, NGW); convert_matrix<RM_ID>(F, F.in[I_WOUT] + (size_t)l * DM * DM, DM, DM, Bt4, DM, 0, 0, gw, NGW);
                REFRESH(); compose_pool(F, l, Bt3, gw, NGW); }
        }
        SEAM(pb + 1);
        if (IN(pb + 2)) for (int rep = 0; rep < NREP(2); ++rep) { if (rep) xcd_barrier(bar); pg8::Gemm g{XB, WA + (size_t)4096 * DM, DM, DM}; pg8::UnitOrder S; S.init(pg8::SK_PLAIN, 4096, DM, F.G, F.bid, 0, true, F.G != 256); pg8::EpiGate E{Gb};
            pg8::gemm_phase<pg8::EpiGate, pg8::UnitOrder, true>(F.lds + RING_OFF, g, S, E, wave0); }
        SEAM(pb + 2);
        if (IN(pb + 3)) for (int rep = 0; rep < NREP(3); ++rep) { if (rep) xcd_barrier(bar); pg8::Gemm g{Y, Bt3, 2048, 2048}; pg8::UnitOrder S; S.init(pg8::SK_P3, DM, 2048, F.G, F.bid, 0); pg8::EpiMerge E{Gb, XB, (bf16*)(F.ws + WS_MB4S)};
            pg8::gemm_phase<pg8::EpiMerge, pg8::UnitOrder, true>(F.lds + RING_OFF, g, S, E, wave0); }
        SEAM(pb + 3);
        if (IN(pb + 4)) for (int rep = 0; rep < 1; ++rep) { pg8::Gemm g{XB, Bt4, DM, DM}; pg8::UnitOrder S; S.init(pg8::SK_P4, DM, DM, F.G, F.bid, (long)(WS_MB4S - WS_XB));
            pg8::EpiRes E{l == 0 ? F.in[I_XP] : F.out, F.out, XB, F.in[I_LN1G] + l * DM, F.in[I_LN1B] + l * DM, (float*)(F.ws + WS_SLAB),
                          pg8::PanelStats{(unsigned*)(F.ws + WS_XCH + (size_t)(2 * l) * 512 * 1024), (unsigned*)(F.ctl + CW_SEAM + (2 * l) * SEAM_BANK)}, F.lds + XLDS_OFF, wave0};
            pg8::gemm_phase<pg8::EpiRes, pg8::UnitOrder, true>(F.lds + RING_OFF, g, S, E, wave0);
            if (F.G == 256 && F.bid >= 64) {
                REFRESH(); const int gw = (F.bid - 64) * NWAVES + F.wave, NGW = 192 * NWAVES;
                convert_matrix<RM_GU>(F, F.in[I_WG] + (size_t)l * DM * FF, DM, FF, Bt5, DM, 0, 0, gw, NGW, 0);
                convert_matrix<RM_GU>(F, F.in[I_WU] + (size_t)l * DM * FF, DM, FF, Bt5, DM, 0, 128, gw, NGW, 1408);
            } }
        SEAM(pb + 4);
        if (IN(pb + 5)) for (int rep = 0; rep < NREP(5); ++rep) { if (rep) xcd_barrier(bar);
            REFRESH();
            ln_rows(F, F.out, rep + 1 < NREP(5) ? (float*)(F.ws + WS_Y) : F.out, F.in[I_LN1G] + l * DM, F.in[I_LN1B] + l * DM, rep + 1 < NREP(5) ? nullptr : XB, l == 0 ? F.in[I_XS] : F.out + (size_t)MP * DM, (const float*)(F.ws + WS_SLAB), 8);
            REFRESH();
            if (F.G != 256) { const int gw = F.bid * NWAVES + F.wave, NGW = F.G * NWAVES;
                convert_matrix<RM_GU>(F, F.in[I_WG] + (size_t)l * DM * FF, DM, FF, Bt5, DM, 0, 0, gw, NGW); convert_matrix<RM_GU>(F, F.in[I_WU] + (size_t)l * DM * FF, DM, FF, Bt5, DM, 0, 128, gw, NGW);
                convert_matrix<RM_ID>(F, F.in[I_WD] + (size_t)l * FF * DM, FF, DM, Bt6, FF, 0, 0, gw, NGW); }
        }
        SEAM(pb + 5);
        if (IN(pb + 6)) for (int rep = 0; rep < NREP(6); ++rep) { if (rep) xcd_barrier(bar); pg8::Gemm g{XB, Bt5, DM, DM}; pg8::UnitOrder S; S.init(pg8::SK_PLAIN, 2 * FF, DM, F.G, F.bid, 0); pg8::EpiSwi E{Hb};
            pg8::gemm_phase<pg8::EpiSwi, pg8::UnitOrder, true>(F.lds + RING_OFF, g, S, E, wave0);
            if (F.G == 256 && F.bid >= 172 && rep + 1 == NREP(6)) {
                REFRESH(); const int gw = (F.bid - 172) * NWAVES + F.wave, NGW = 84 * NWAVES;
                convert_matrix<RM_ID>(F, F.in[I_WD] + (size_t)l * FF * DM, FF, DM, Bt6, FF, 0, 0, gw, NGW, 0);
                if (l == 0) convert_matrix<RM_WIN>(F, F.in[I_WIN] + (size_t)DM * INC, DM, INC, WA, DM, 0, 0, gw, NGW, 1408); } }
        SEAM(pb + 6);
        if (IN(pb + 7)) for (int rep = 0; rep < 1; ++rep) { pg8::Gemm g{Hb, Bt6, FF, FF}; pg8::UnitOrder S; S.init(pg8::SK_P6, DM, FF, F.G, F.bid, 0); pg8::EpiRes E{F.out, F.out, l == 0 ? XB : nullptr, F.in[I_LN2G] + l * DM, F.in[I_LN2B] + l * DM, (float*)(F.ws + WS_SLAB),
                          pg8::PanelStats{(unsigned*)(F.ws + WS_XCH + (size_t)(2 * l + 1) * 512 * 1024), (unsigned*)(F.ctl + CW_SEAM + (2 * l + 1) * SEAM_BANK)}, F.lds + XLDS_OFF, wave0};
            pg8::gemm_phase<pg8::EpiRes, pg8::UnitOrder, true>(F.lds + RING_OFF, g, S, E, wave0); }
        SEAM(pb + 7);
        if (IN(pb + 8)) for (int rep = 0; rep < NREP(8); ++rep) { if (rep) xcd_barrier(bar);
            REFRESH();
            ln_rows(F, F.out, rep + 1 < NREP(8) ? (float*)(F.ws + WS_Y) : F.out, F.in[I_LN2G] + l * DM, F.in[I_LN2B] + l * DM, (l == 0 && rep + 1 == NREP(8)) ? XB : nullptr, F.out + (size_t)MP * DM, (const float*)(F.ws + WS_SLAB), 11);
            REFRESH();
            if (l == 0 && F.G != 256) convert_matrix<RM_WIN>(F, F.in[I_WIN] + (size_t)DM * INC, DM, INC, WA, DM, 0, 0, F.bid * NWAVES + F.wave, F.G * NWAVES);
        }
        if (l == 0) SEAM(pb + 8);
    }
#undef IN
#undef SEAM
#undef REFRESH
}

extern "C" void kernel_launch(void* const* d_in, const int* in_sizes, int n_in, void* d_out, int out_size, void* d_ws, size_t ws_size, hipStream_t stream) {
    static int grid = 0;
    if (grid == 0) {
        if (n_in != 31 || out_size != (int)O_END || ws_size < WS_END) { fprintf(stderr, "kernel_launch: unexpected sizes n_in %d out %d ws %zu\n", n_in, out_size, ws_size); grid = -1; return; }
        int dev = 0, cus = 0, per_cu = 0;
        if (hipGetDevice(&dev) != hipSuccess || hipDeviceGetAttribute(&cus, hipDeviceAttributeMultiprocessorCount, dev) != hipSuccess) { grid = -1; return; }
        if (hipFuncSetAttribute((const void*)hybrid_fwd, hipFuncAttributeMaxDynamicSharedMemorySize, LDS_BYTES) != hipSuccess) { fprintf(stderr, "kernel_launch: hipFuncSetAttribute failed\n"); grid = -1; return; }
        if (hipOccupancyMaxActiveBlocksPerMultiprocessor(&per_cu, (const void*)hybrid_fwd, NWAVES * 64, LDS_BYTES) != hipSuccess || per_cu < 1)
            fprintf(stderr, "kernel_launch: occupancy query reports %d workgroups per CU\n", per_cu);
        (void)hipGetLastError();
        grid = cus;
    }
    if (grid < 0) return;
    if (hipMemsetAsync((char*)d_ws + WS_CTL, 0, CTL_ZERO_BYTES, stream) != hipSuccess) { fprintf(stderr, "kernel_launch: memset failed\n"); return; }
    Args a{};
    for (int i = 0; i < 31; ++i) a.in[i] = (const float*)d_in[i];
    a.out = (float*)d_out; a.ws = (unsigned char*)d_ws;
#if MK_SPLIT
    for (int ph = 0; ph < NPHASE; ++ph) { a.ph_lo = ph; a.ph_hi = ph + 1; hipLaunchKernelGGL(hybrid_fwd, dim3(grid), dim3(NWAVES * 64), LDS_BYTES, stream, a); }
#else
    a.ph_lo = 0; a.ph_hi = NPHASE;
    hipLaunchKernelGGL(hybrid_fwd, dim3(grid), dim3(NWAVES * 64), LDS_BYTES, stream, a);
#endif
}
```

```cpp
#include <hip/hip_runtime.h>
#include <cstdio>
#include <cstdint>

#ifndef PROBE_REP
#define PROBE_REP 0
#endif
#define NREP(k) (1 + ((PROBE_REP >> (k)) & 1))
#ifndef PROBE2
#define PROBE2 0
#endif
#define NREP2(j) (1 + ((PROBE2 >> (j)) & 1))
#ifndef MK_SPLIT
#define MK_SPLIT 0
#endif

constexpr int DM = 1024, WMIX = 512, NPB = 8, SEQ = 2048, NSB = 128, DSEQ = 4;
constexpr int MP = NPB * SEQ, MS = NSB * DSEQ, M = MP + MS;
constexpr int FF = 2816, INC = 8192, ZC = 3072, YC = 2048, GC = 4096;
constexpr float LN_EPS = 1e-5f, ALPHA = 1.41421356237f;
constexpr size_t O_Y = 0, O_PH = (size_t)M * DM, O_PRGC = O_PH + 8192, O_PCF = O_PRGC + 24576, O_PPOOL = O_PCF + 245760, O_PSC = O_PPOOL + 122880,
                 O_SH = O_PSC + 16384, O_SRGC = O_SH + 131072, O_SCF = O_SRGC + 393216, O_SPOOL = O_SCF + 3932160, O_SSC = O_SPOOL + 1966080, O_END = O_SSC + 262144;
static_assert(O_END == 24403968, "output map");

__device__ __forceinline__ int opqv(int v) { asm volatile("" : "+v"(v)); return v; }
__device__ __forceinline__ int lane_now() { int l; asm volatile("v_mbcnt_lo_u32_b32 %0, -1, 0\n\tv_mbcnt_hi_u32_b32 %0, -1, %0" : "=v"(l)); return l; }
__device__ __forceinline__ int opqs(int v) { asm volatile("" : "+s"(v)); return v; }
namespace pg8 {
#define PG8_LAS __attribute__((address_space(3)))
typedef unsigned short bf16_t;
typedef short bf16x8 __attribute__((ext_vector_type(8)));
typedef float f32x4 __attribute__((ext_vector_type(4)));
typedef float f32x2 __attribute__((ext_vector_type(2)));
typedef unsigned u32x4 __attribute__((ext_vector_type(4)));
typedef unsigned u32x2 __attribute__((ext_vector_type(2)));
typedef _Float16 f16x4 __attribute__((ext_vector_type(4)));
typedef _Float16 f16x8 __attribute__((ext_vector_type(8)));
constexpr int BM = 256, BK = 64, HALF = 128, HTB = HALF * BK * 2, STAGE_BYTES = 8 * HTB, NXCD = 8, WGM = 8;

__host__ __device__ __forceinline__ int lds_byte(int r, int c) { const int st = (r >> 4) * 2 + (c >> 5), rr = r & 15, cc = c & 31, ob = rr * 64 + cc * 2; return st * 1024 + (ob ^ (((ob >> 9) & 1) << 5)); }
__host__ __device__ __forceinline__ void stage_rc(int b, int& R, int& C) { const int st = b / 1024, sb = b % 1024, swz = sb ^ (((sb >> 9) & 1) << 5); R = (st >> 1) * 16 + swz / 64; C = (st & 1) * 32 + (swz % 64) / 2; }
__host__ __device__ __forceinline__ int perm32(int rho) { const int n = rho >> 4, i = rho & 15; return 8 * (i >> 2) + 4 * n + (i & 3); }

struct Unit { int pm, pn, nt, mode, aux; long offA, offB; };
struct Gemm { const bf16_t* A; const bf16_t* Bt; int lda, ldb; };

enum { SK_PLAIN = 0, SK_P3 = 1, SK_P4 = 2, SK_P6 = 3 };
struct UnitOrder {
    int kind, nN, nwgP, nS, ntP, G, c; long offA_s;
    __device__ __forceinline__ void init(int kind_, int N_, int K_, int G_, int c_, long offA_s_, bool prompt = true, bool sample = true) { kind = kind_; nN = N_ / BM; nwgP = prompt ? 64 * nN : 0; ntP = K_ / BK; G = G_; c = c_; offA_s = offA_s_;
        nS = !sample ? 0 : kind_ == SK_PLAIN ? 2 * nN : kind_ == SK_P3 ? 32 : kind_ == SK_P4 ? 64 : 88; }
    __device__ __forceinline__ bool next(int i, Unit& u, const Gemm& g) const {
        const long L = (long)i * G + c; const long ra = (long)BM * g.lda * 2, rb = (long)BM * g.ldb * 2;
        if (L < nwgP) {
            int wgid = (int)L; { const int q = nwgP / NXCD, xcd = wgid % NXCD, off = wgid / NXCD; wgid = xcd * q + off; }
            const int nig = WGM * nN; u.pm = (wgid / nig) * WGM + ((wgid % nig) % WGM); u.pn = (wgid % nig) / WGM;
            u.nt = ntP; u.mode = 0; u.aux = 0; u.offA = u.pm * ra; u.offB = u.pn * rb; return true; }
        const int s = (int)(L - nwgP); if (s >= nS) return false;
        if (kind == SK_PLAIN) { u.pm = 64 + (s & 1); u.pn = s >> 1; u.nt = ntP; u.mode = 0; u.aux = 0; u.offA = u.pm * ra; u.offB = u.pn * rb; }
        else if (kind == SK_P3) { const int n = s & 3, tile = s >> 2; u.pm = 64 + (tile & 1); u.pn = tile >> 1; u.nt = 8; u.mode = 1; u.aux = n; u.offA = u.pm * ra + 1024 * n; u.offB = u.pn * rb + 1024 * n; }
        else if (kind == SK_P4) { const int ch = s & 7, tile = s >> 3, n = ch >> 1, kin = (ch & 1) * 512; u.pm = 64 + (tile & 1); u.pn = tile >> 1; u.nt = 8; u.mode = 1; u.aux = ch;
            u.offA = offA_s + ((long)(n * 512 + (u.pm - 64) * 256) * 1024 + kin) * 2; u.offB = u.pn * rb + kin * 2; }
        else { const int ch = s % 11, tile = s / 11; u.pm = 64 + (tile & 1); u.pn = tile >> 1; u.nt = 4; u.mode = 1; u.aux = ch; u.offA = u.pm * ra + 512 * ch; u.offB = u.pn * rb + 512 * ch; }
        return true;
    }
};

__device__ __forceinline__ unsigned cvt_pk_bf16(float lo, float hi) { unsigned r; asm volatile("v_cvt_pk_bf16_f32 %0, %1, %2" : "=v"(r) : "v"(lo), "v"(hi)); return r; }
__device__ __forceinline__ float sigmoidf_fast(float x) { return __builtin_amdgcn_rcpf(1.0f + __builtin_amdgcn_exp2f(-1.44269504089f * x)); }
__device__ __forceinline__ float gelu_tanh(float x) { const float t = x * x, y = x * fmaf(t, -0.10294324f, -2.3022082f); return x * __builtin_amdgcn_rcpf(1.0f + __builtin_amdgcn_exp2f(y)); }

__device__ __forceinline__ void acc_zero(f32x4 (&acc)[2][2][4][2]) {
#pragma unroll
    for (int a = 0; a < 2; ++a)
#pragma unroll
        for (int b = 0; b < 2; ++b)
#pragma unroll
            for (int m = 0; m < 4; ++m)
#pragma unroll
                for (int n = 0; n < 2; ++n) acc[a][b][m][n] = (f32x4){0.f, 0.f, 0.f, 0.f};
}
__device__ __forceinline__ float* state_ptr(float* out, int R, int keep, int layer, size_t p_off, size_t s_off) {
    if (R < MP) { const int b = R >> 11, j = (R & 2047) - (2048 - keep); return j < 0 ? nullptr : out + p_off + (size_t)((layer * 8 + b) * keep + j) * 512; }
    const int s = (R - MP) >> 2, j = (R & 3) + keep - 4; return j < 0 ? nullptr : out + s_off + (size_t)((layer * 128 + s) * keep + j) * 512;
}

struct EpiMix {
    static constexpr bool PERM = true, MIDK = false;
    __device__ __forceinline__ void init(f32x4 (&acc)[2][2][4][2], const Unit&, int, int) const { acc_zero(acc); }
    bf16_t* Z; float* out; int layer;
    __device__ __forceinline__ void midk(f32x4 (&)[2][2][4][2], const Unit&, int, int, int, int, int) const {}
    __device__ __forceinline__ void operator()(f32x4 (&acc)[2][2][4][2], const Unit& u, int wr, int wc, int fr_, int fq_) const {
        const int lane_ = lane_now(), fr = lane_ & 15, fq = lane_ >> 4; (void)fr_; (void)fq_;
        const int pn = u.pn; int type, zcol, keep = 0, scol = 0; size_t poff = 0, soff = 0;
        if (pn < 2) { type = 0; zcol = 256 * pn; keep = 3; scol = zcol; poff = O_PRGC; soff = O_SRGC; }
        else if (pn < 4) { type = 1; zcol = 512 + 256 * (pn - 2); }
        else if (pn < 8) { type = 2; zcol = 1024 + 128 * (pn - 4); keep = 30; scol = 128 * (pn - 4); poff = O_PCF; soff = O_SCF; }
        else if (pn < 10) { type = 0; zcol = 1536 + 256 * (pn - 8); keep = 15; scol = 256 * (pn - 8); poff = O_PPOOL; soff = O_SPOOL; }
        else if (pn < 12) { type = 0; zcol = 2048 + 256 * (pn - 10); }
        else { type = 3; zcol = 2560 + 128 * (pn - 12); keep = 2; scol = 128 * (pn - 12); poff = O_PSC; soff = O_SSC; }
        const bool tail = keep != 0 && (u.pm >= 64 || (u.pm & 7) == 7);
        const int row0 = u.pm * BM + wr * 64 + fr, cl = wc * 32 + 8 * fq;
        if (type < 2) {
#pragma unroll
            for (int ai = 0; ai < 2; ++ai)
#pragma unroll
                for (int m = 0; m < 4; ++m) { const int R = row0 + ai * HALF + m * 16; bf16_t* rowp = Z + (size_t)R * ZC + zcol + cl;
                    float* sp = tail ? state_ptr(out, R, keep, layer, poff, soff) : nullptr;
#pragma unroll
                    for (int bj = 0; bj < 2; ++bj) { f32x4 v0 = acc[ai][bj][m][0], v1 = acc[ai][bj][m][1];
                        if (type == 1) { v0 = (f32x4){gelu_tanh(v0[0]), gelu_tanh(v0[1]), gelu_tanh(v0[2]), gelu_tanh(v0[3])}; v1 = (f32x4){gelu_tanh(v1[0]), gelu_tanh(v1[1]), gelu_tanh(v1[2]), gelu_tanh(v1[3])}; }
                        u32x4 w; w.x = cvt_pk_bf16(v0[0], v0[1]); w.y = cvt_pk_bf16(v0[2], v0[3]); w.z = cvt_pk_bf16(v1[0], v1[1]); w.w = cvt_pk_bf16(v1[2], v1[3]);
                        *(u32x4*)(rowp + bj * HALF) = w;
                        if (sp) { *(f32x4*)(sp + scol + cl + bj * HALF) = v0; *(f32x4*)(sp + scol + cl + bj * HALF + 4) = v1; } } }
        } else {
#pragma unroll
            for (int ai = 0; ai < 2; ++ai)
#pragma unroll
                for (int m = 0; m < 4; ++m) { const int R = row0 + ai * HALF + m * 16; bf16_t* rowp = Z + (size_t)R * ZC + zcol + cl;
                    float* sp = tail ? state_ptr(out, R, keep, layer, poff, soff) : nullptr;
                    f32x4 v0, v1; const f32x4 a0 = acc[ai][0][m][0], a1 = acc[ai][0][m][1], b0 = acc[ai][1][m][0], b1 = acc[ai][1][m][1];
                    if (type == 2) {
#pragma unroll
                        for (int i = 0; i < 4; ++i) { v0[i] = a0[i] * sigmoidf_fast(b0[i]); v1[i] = a1[i] * sigmoidf_fast(b1[i]); }
                    } else { v0 = a0 * b0; v1 = a1 * b1; }
                    u32x4 w; w.x = cvt_pk_bf16(v0[0], v0[1]); w.y = cvt_pk_bf16(v0[2], v0[3]); w.z = cvt_pk_bf16(v1[0], v1[1]); w.w = cvt_pk_bf16(v1[2], v1[3]);
                    *(u32x4*)rowp = w;
                    if (sp) { *(f32x4*)(sp + scol + cl) = v0; *(f32x4*)(sp + scol + cl + 4) = v1; } }
        }
    }
};

struct EpiGate {
    static constexpr bool PERM = true, MIDK = false;
    __device__ __forceinline__ void init(f32x4 (&acc)[2][2][4][2], const Unit&, int, int) const { acc_zero(acc); }
    _Float16* G;
    __device__ __forceinline__ void midk(f32x4 (&)[2][2][4][2], const Unit&, int, int, int, int, int) const {}
    __device__ __forceinline__ void operator()(f32x4 (&acc)[2][2][4][2], const Unit& u, int wr, int wc, int fr_, int fq_) const {
        const int lane_ = lane_now(), fr = lane_ & 15, fq = lane_ >> 4; (void)fr_; (void)fq_;
        const int row0 = u.pm * BM + wr * 64 + fr, ch0 = 64 * u.pn + 16 * wc + 4 * fq; const bool plain = u.pm >= 64;
#pragma unroll
        for (int ai = 0; ai < 2; ++ai)
#pragma unroll
            for (int m = 0; m < 4; ++m) { const int R = row0 + ai * HALF + m * 16; _Float16* gp = G + (size_t)R * GC + ch0;
                f16x4 r0, r1, r2, g3;
#pragma unroll
                for (int i = 0; i < 4; ++i) {
                    const float d0 = 1.f + __builtin_amdgcn_exp2f(__builtin_amdgcn_fmed3f(acc[ai][0][m][0][i], -15.f, 15.f)), d1 = 1.f + __builtin_amdgcn_exp2f(__builtin_amdgcn_fmed3f(acc[ai][0][m][1][i], -15.f, 15.f));
                    const float d2 = 1.f + __builtin_amdgcn_exp2f(__builtin_amdgcn_fmed3f(acc[ai][1][m][0][i], -15.f, 15.f)), d3 = 1.f + __builtin_amdgcn_exp2f(__builtin_amdgcn_fmed3f(acc[ai][1][m][1][i], -15.f, 15.f));
                    const float i0 = __builtin_amdgcn_rcpf(d0), i1 = __builtin_amdgcn_rcpf(d1), i2 = __builtin_amdgcn_rcpf(d2), i3 = __builtin_amdgcn_rcpf(d3);
                    if (plain) { r0[i] = (_Float16)i0; r1[i] = (_Float16)i1; r2[i] = (_Float16)i2; }
                    else { r0[i] = (_Float16)(d1 * i0); r1[i] = (_Float16)(d2 * i1); r2[i] = (_Float16)(d3 * i2); }
                    g3[i] = (_Float16)i3; }
                *(f16x4*)(gp) = r0; *(f16x4*)(gp + 1024) = r1; *(f16x4*)(gp + 2048) = r2; *(f16x4*)(gp + 3072) = g3; }
    }
};

struct EpiMerge {
    static constexpr bool PERM = true, MIDK = true;
    __device__ __forceinline__ void init(f32x4 (&acc)[2][2][4][2], const Unit&, int, int) const { acc_zero(acc); }
    const _Float16* G; bf16_t* O; bf16_t* Os;
    __device__ __forceinline__ void scale(f32x4 (&acc)[2][2][4][2], const Unit& u, int seg, int wr, int wc) const {
        const int lane_ = lane_now(), fr = lane_ & 15, fq = lane_ >> 4;
        const int row0 = u.pm * BM + wr * 64 + fr, c0 = 1024 * seg + 256 * u.pn + wc * 32 + 8 * fq;
#pragma unroll
        for (int ai = 0; ai < 2; ++ai)
#pragma unroll
            for (int m = 0; m < 4; ++m) { const _Float16* gp = G + (size_t)(row0 + ai * HALF + m * 16) * GC + c0;
#pragma unroll
                for (int bj = 0; bj < 2; ++bj) { const f16x8 f = *(const f16x8*)(gp + bj * HALF);
                    acc[ai][bj][m][0] *= (f32x4){(float)f[0], (float)f[1], (float)f[2], (float)f[3]}; acc[ai][bj][m][1] *= (f32x4){(float)f[4], (float)f[5], (float)f[6], (float)f[7]}; } }
    }
    __device__ __forceinline__ void midk(f32x4 (&acc)[2][2][4][2], const Unit& u, int seg, int wr, int wc, int, int) const { scale(acc, u, seg, wr, wc); }
    __device__ __forceinline__ void operator()(f32x4 (&acc)[2][2][4][2], const Unit& u, int wr, int wc, int, int) const {
        scale(acc, u, u.mode ? u.aux : 3, wr, wc);
        const int lane_ = lane_now(), fr = lane_ & 15, fq = lane_ >> 4;
        const int row0 = (u.mode ? (u.pm - 64) * BM + 512 * u.aux : u.pm * BM) + wr * 64 + fr, c0 = 256 * u.pn + wc * 32 + 8 * fq;
        bf16_t* O = u.mode ? Os : this->O;
#pragma unroll
        for (int ai = 0; ai < 2; ++ai)
#pragma unroll
            for (int m = 0; m < 4; ++m) { bf16_t* rowp = O + (size_t)(row0 + ai * HALF + m * 16) * DM + c0;
#pragma unroll
                for (int bj = 0; bj < 2; ++bj) { const f32x4 v0 = acc[ai][bj][m][0], v1 = acc[ai][bj][m][1];
                    u32x4 w; w.x = cvt_pk_bf16(v0[0], v0[1]); w.y = cvt_pk_bf16(v0[2], v0[3]); w.z = cvt_pk_bf16(v1[0], v1[1]); w.w = cvt_pk_bf16(v1[2], v1[3]); *(u32x4*)(rowp + bj * HALF) = w; } }
    }
};

struct PanelStats {
    unsigned* xbuf;
    unsigned* cnt;
    __device__ __forceinline__ void run(const f32x4 (&v)[2][2][4][2], const Unit& u, int wr, int wc, PG8_LAS unsigned char* lds, int wid) const {
        const int lane = lane_now(), fr = lane & 15, fq = lane >> 4;
        PG8_LAS f32x2* P = (PG8_LAS f32x2*)lds;
        PG8_LAS f32x2* S = (PG8_LAS f32x2*)(lds + 8192);
#pragma unroll
        for (int ai = 0; ai < 2; ++ai)
#pragma unroll
            for (int m = 0; m < 4; ++m) {
                float s = 0.f;
#pragma unroll
                for (int bj = 0; bj < 2; ++bj)
#pragma unroll
                    for (int n = 0; n < 2; ++n) { const f32x4 x = v[ai][bj][m][n]; s += (x[0] + x[1]) + (x[2] + x[3]); }
                s += __builtin_bit_cast(float, __builtin_amdgcn_ds_bpermute((lane ^ 16) << 2, __builtin_bit_cast(int, s))); s += __builtin_bit_cast(float, __builtin_amdgcn_ds_bpermute((lane ^ 32) << 2, __builtin_bit_cast(int, s)));
                const float mw = s * (1.0f / 64.0f); float q = 0.f;
#pragma unroll
                for (int bj = 0; bj < 2; ++bj)
#pragma unroll
                    for (int n = 0; n < 2; ++n) { const f32x4 d = v[ai][bj][m][n] - mw; q += (d[0] * d[0] + d[1] * d[1]) + (d[2] * d[2] + d[3] * d[3]); }
                q += __builtin_bit_cast(float, __builtin_amdgcn_ds_bpermute((lane ^ 16) << 2, __builtin_bit_cast(int, q))); q += __builtin_bit_cast(float, __builtin_amdgcn_ds_bpermute((lane ^ 32) << 2, __builtin_bit_cast(int, q)));
                if (fq == 0) P[(ai * HALF + wr * 64 + m * 16 + fr) * 4 + wc] = (f32x2){mw, q};
            }
        asm volatile("s_waitcnt lgkmcnt(0)" ::: "memory"); __builtin_amdgcn_s_barrier(); asm volatile("" ::: "memory");
        const int row = wid * 32 + (lane & 31);
        if (lane < 32) {
            const f32x2 a = P[row * 4 + 0], b = P[row * 4 + 1], c = P[row * 4 + 2], d = P[row * 4 + 3];
            const float mt = (a.x + b.x + c.x + d.x) * 0.25f;
            const float da = a.x - mt, db = b.x - mt, dc = c.x - mt, dd = d.x - mt;
            const float m2 = (a.y + b.y) + (c.y + d.y) + 64.0f * ((da * da + db * db) + (dc * dc + dd * dd));
            unsigned long long* slot = (unsigned long long*)xbuf + ((size_t)(u.pm * BM + row) * 4 + u.pn);
            __hip_atomic_store(slot, ((unsigned long long)__float_as_uint(m2) << 32) | __float_as_uint(mt), __ATOMIC_RELAXED, __HIP_MEMORY_SCOPE_AGENT);
        }
        asm volatile("s_waitcnt vmcnt(0)" ::: "memory");
        if (lane == 0) __hip_atomic_fetch_add(cnt + 64 * u.pm, 1u, __ATOMIC_RELAXED, __HIP_MEMORY_SCOPE_AGENT);
        if (wid == 0) {
            unsigned spins = 0;
            while ((unsigned)__builtin_amdgcn_readfirstlane(__hip_atomic_load(cnt + 64 * u.pm, __ATOMIC_RELAXED, __HIP_MEMORY_SCOPE_AGENT)) < 32u) { __builtin_amdgcn_s_sleep(2); if (++spins > (1u << 20)) break; }
            __builtin_amdgcn_fence(__ATOMIC_ACQUIRE, "agent");
        }
        asm volatile("s_waitcnt vmcnt(0) lgkmcnt(0)" ::: "memory"); __builtin_amdgcn_s_barrier(); asm volatile("" ::: "memory");
        if (lane < 32) {
            const unsigned long long* slot = (const unsigned long long*)xbuf + (size_t)(u.pm * BM + row) * 4; float mt[4], m2[4]; float ms = 0.f;
#pragma unroll
            for (int t = 0; t < 4; ++t) { const unsigned long long w = __hip_atomic_load(slot + t, __ATOMIC_RELAXED, __HIP_MEMORY_SCOPE_AGENT); mt[t] = __uint_as_float((unsigned)w); m2[t] = __uint_as_float((unsigned)(w >> 32)); ms += mt[t]; }
            const float mean = ms * 0.25f; float q = 0.f;
#pragma unroll
            for (int t = 0; t < 4; ++t) { const float dm = mt[t] - mean; q += m2[t] + 256.0f * dm * dm; }
            S[row] = (f32x2){mean, __builtin_amdgcn_rsqf(q * (1.0f / 1024.0f) + LN_EPS)};
        }
        asm volatile("s_waitcnt lgkmcnt(0)" ::: "memory"); __builtin_amdgcn_s_barrier(); asm volatile("" ::: "memory");
    }
};
struct EpiRes {
    static constexpr bool PERM = false, MIDK = false;
    __device__ __forceinline__ void init(f32x4 (&acc)[2][2][4][2], const Unit& u, int wr, int wc) const {
        if (u.mode) { acc_zero(acc); return; }
        const int lane_ = lane_now(), fr = lane_ & 15, fq = lane_ >> 4;
        const float* bp0 = baseP + (size_t)(u.pm * BM + wr * 64 + fr) * DM + 256 * u.pn + wc * 32 + 4 * fq;
#pragma unroll
        for (int ai = 0; ai < 2; ++ai)
#pragma unroll
            for (int m = 0; m < 4; ++m)
#pragma unroll
                for (int bj = 0; bj < 2; ++bj)
#pragma unroll
                    for (int n = 0; n < 2; ++n) acc[ai][bj][m][n] = *(const f32x4*)(bp0 + (size_t)(ai * HALF + m * 16) * DM + bj * HALF + n * 16) * ALPHA;
    }
    const float* baseP; float* out; bf16_t* xb; const float* lng; const float* lnb; float* slab; PanelStats st; PG8_LAS unsigned char* xlds; int wid;
    __device__ __forceinline__ void midk(f32x4 (&)[2][2][4][2], const Unit&, int, int, int, int, int) const {}
    __device__ __forceinline__ void operator()(f32x4 (&acc)[2][2][4][2], const Unit& u, int wr, int wc, int fr_, int fq_) const {
        const int lane_ = lane_now(), fr = lane_ & 15, fq = lane_ >> 4; (void)fr_; (void)fq_;
        const int row0 = u.pm * BM + wr * 64 + fr, c0 = 256 * u.pn + wc * 32 + 4 * fq;
        if (u.mode) {
#pragma unroll
            for (int ai = 0; ai < 2; ++ai)
#pragma unroll
                for (int m = 0; m < 4; ++m) { float* op = slab + ((size_t)u.aux * 512 + (row0 - MP) + ai * HALF + m * 16) * DM + c0;
#pragma unroll
                    for (int bj = 0; bj < 2; ++bj)
#pragma unroll
                        for (int n = 0; n < 2; ++n) *(f32x4*)(op + bj * HALF + n * 16) = acc[ai][bj][m][n]; }
            return; }
        st.run(acc, u, wr, wc, xlds, wid);
        const PG8_LAS f32x2* S = (const PG8_LAS f32x2*)(xlds + 8192);
#pragma unroll
        for (int bj = 0; bj < 2; ++bj)
#pragma unroll
            for (int n = 0; n < 2; ++n) { const int cc = c0 + bj * HALF + n * 16; const f32x4 gv = *(const f32x4*)(lng + cc), bv = *(const f32x4*)(lnb + cc);
#pragma unroll
                for (int ai = 0; ai < 2; ++ai)
#pragma unroll
                    for (int m = 0; m < 4; ++m) { const int r = ai * HALF + wr * 64 + m * 16 + fr; const f32x2 sr = S[r]; const size_t off = (size_t)(u.pm * BM + r) * DM + cc;
                        const f32x4 o = (acc[ai][bj][m][n] - sr.x) * sr.y * gv + bv; *(f32x4*)(out + off) = o;
                        if (xb) { u32x2 w; w.x = cvt_pk_bf16(o[0], o[1]); w.y = cvt_pk_bf16(o[2], o[3]); *(u32x2*)(xb + off) = w; }
                        if (m & 1) asm volatile("" ::: "memory"); } }
    }
};

struct EpiSwi {
    static constexpr bool PERM = true, MIDK = false;
    __device__ __forceinline__ void init(f32x4 (&acc)[2][2][4][2], const Unit&, int, int) const { acc_zero(acc); }
    bf16_t* H;
    __device__ __forceinline__ void midk(f32x4 (&)[2][2][4][2], const Unit&, int, int, int, int, int) const {}
    __device__ __forceinline__ void operator()(f32x4 (&acc)[2][2][4][2], const Unit& u, int wr, int wc, int fr_, int fq_) const {
        const int lane_ = lane_now(), fr = lane_ & 15, fq = lane_ >> 4; (void)fr_; (void)fq_;
        const int row0 = u.pm * BM + wr * 64 + fr, c0 = 128 * u.pn + wc * 32 + 8 * fq;
#pragma unroll
        for (int ai = 0; ai < 2; ++ai)
#pragma unroll
            for (int m = 0; m < 4; ++m) { bf16_t* rowp = H + (size_t)(row0 + ai * HALF + m * 16) * FF + c0;
                const f32x4 g0 = acc[ai][0][m][0], g1 = acc[ai][0][m][1], u0 = acc[ai][1][m][0], u1 = acc[ai][1][m][1]; f32x4 v0, v1;
#pragma unroll
                for (int i = 0; i < 4; ++i) { v0[i] = g0[i] * sigmoidf_fast(g0[i]) * u0[i]; v1[i] = g1[i] * sigmoidf_fast(g1[i]) * u1[i]; }
                u32x4 w; w.x = cvt_pk_bf16(v0[0], v0[1]); w.y = cvt_pk_bf16(v0[2], v0[3]); w.z = cvt_pk_bf16(v1[0], v1[1]); w.w = cvt_pk_bf16(v1[2], v1[3]);
                *(u32x4*)rowp = w; }
    }
};

template <class Epi, class Sched, bool ALIGN_EPI>
__device__ __forceinline__ void gemm_phase(PG8_LAS unsigned char* lds, const Gemm g, const Sched& S, const Epi& E, int wave_id) {
    const int wid = opqs(wave_id), lane = lane_now(), tid = wid * 64 + lane, wr = wid >> 2, wc = wid & 3, fr = lane & 15, fq = lane >> 4;
    unsigned voffA[2], voffB[2];
#pragma unroll
    for (int i = 0; i < 2; ++i) { int R, C; stage_rc(tid * 16 + i * 8192, R, C); const int Rb = Epi::PERM ? ((R & ~31) + perm32(R & 31)) : R;
        voffA[i] = (unsigned)(R * g.lda + C) * 2u; voffB[i] = (unsigned)(Rb * g.ldb + C) * 2u; }
    const size_t kstep = (size_t)(BK * 2);
    const size_t hstepA = (size_t)HALF * g.lda * 2, hstepB = (size_t)HALF * g.ldb * 2;
    const unsigned ldsw = (unsigned)wid * 1024u;
    const int aoff = lds_byte(wr * 64 + fr, fq * 8), boff = lds_byte(wc * 32 + fr, fq * 8);
#define PG8_SA(b, h) (((b) * 2 + (h)) * HTB)
#define PG8_SB(b, h) ((4 + (b) * 2 + (h)) * HTB)
#define PG8_STAGE(bufoff, gbase, voff) do { _Pragma("unroll") for (int _i = 0; _i < 2; ++_i) \
        __builtin_amdgcn_global_load_lds((const unsigned*)((const char*)(gbase) + (voff)[_i]), (PG8_LAS unsigned*)(lds + (bufoff) + ldsw + _i * 8192), 16, 0, 0); } while (0)
#define PG8_LDA(dst, b, h) do { _Pragma("unroll") for (int m = 0; m < 4; ++m) _Pragma("unroll") for (int k = 0; k < 2; ++k) dst[m][k] = *(const PG8_LAS bf16x8*)(lds + PG8_SA(b, h) + aoff + m * 2048 + k * 1024); } while (0)
#define PG8_LDB(dst, b, h) do { _Pragma("unroll") for (int n = 0; n < 2; ++n) _Pragma("unroll") for (int k = 0; k < 2; ++k) dst[n][k] = *(const PG8_LAS bf16x8*)(lds + PG8_SB(b, h) + boff + n * 2048 + k * 1024); } while (0)
#define PG8_MMA(ai, bj, At, Bt) do { __builtin_amdgcn_s_setprio(1); _Pragma("unroll") for (int m = 0; m < 4; ++m) _Pragma("unroll") for (int n = 0; n < 2; ++n) _Pragma("unroll") for (int k = 0; k < 2; ++k) \
        acc[ai][bj][m][n] = __builtin_amdgcn_mfma_f32_16x16x32_bf16(Bt[n][k], At[m][k], acc[ai][bj][m][n], 0, 0, 0); __builtin_amdgcn_s_setprio(0); } while (0)
#define PG8_WAIT_V(n) asm volatile("s_waitcnt vmcnt(" #n ")" ::: "memory")
#define PG8_WAIT_L(n) asm volatile("s_waitcnt lgkmcnt(" #n ")" ::: "memory")
#define PG8_BAR __builtin_amdgcn_s_barrier()
#define PG8_SCHED __builtin_amdgcn_sched_barrier(0)
    Unit cur, nxt; int ui = 0;
    if (!S.next(0, cur, g)) return;
    f32x4 acc[2][2][4][2];
    E.init(acc, cur, wr, wc);
    bf16x8 At[4][2], B0[2][2], B1[2][2];
    const char* cA = (const char*)g.A + cur.offA; const char* cB = (const char*)g.Bt + cur.offB;
    PG8_STAGE(PG8_SB(0, 0), cB, voffB); PG8_STAGE(PG8_SB(0, 1), cB + hstepB, voffB); PG8_STAGE(PG8_SA(0, 0), cA, voffA); PG8_STAGE(PG8_SA(0, 1), cA + hstepA, voffA);
    if (wr == 1) PG8_BAR;
    PG8_WAIT_V(2); PG8_BAR;
    PG8_STAGE(PG8_SB(1, 0), cB + kstep, voffB); PG8_STAGE(PG8_SA(1, 0), cA + kstep, voffA); PG8_STAGE(PG8_SB(1, 1), cB + hstepB + kstep, voffB);
    PG8_WAIT_V(6); PG8_BAR;
    for (;;) {
        const bool has_next = S.next(ui + 1, nxt, g);
        const char* nA = has_next ? (const char*)g.A + nxt.offA : cA; const char* nB = has_next ? (const char*)g.Bt + nxt.offB : cB;
        const int nt = cur.nt, TSEG = Epi::MIDK ? 8 : nt;
        for (int t0 = 0; t0 < nt; t0 += TSEG) {
        if constexpr (Epi::MIDK) { if (t0 != 0) { PG8_SCHED; E.midk(acc, cur, t0 / TSEG - 1, wr, wc, 0, 0); PG8_SCHED; } }
#pragma unroll 1
        for (int t = t0; t < t0 + TSEG; t += 2) {
            const bool last = (t == nt - 2);
            const char* a1 = cA + (size_t)(t + 1) * kstep;
            const char* a2 = last ? nA : cA + (size_t)(t + 2) * kstep; const char* b2 = last ? nB : cB + (size_t)(t + 2) * kstep;
            const char* a3 = a2 + kstep; const char* b3 = b2 + kstep;
            PG8_LDB(B0, 0, 0); PG8_LDB(B1, 0, 1); PG8_SCHED; PG8_LDA(At, 0, 0); PG8_STAGE(PG8_SA(1, 1), a1 + hstepA, voffA);
            PG8_WAIT_V(8); PG8_WAIT_L(0); PG8_BAR; PG8_MMA(0, 0, At, B0); PG8_MMA(0, 1, At, B1); PG8_BAR; PG8_SCHED;
            PG8_LDA(At, 0, 1); PG8_STAGE(PG8_SB(0, 0), b2, voffB); PG8_STAGE(PG8_SB(0, 1), b2 + hstepB, voffB); PG8_STAGE(PG8_SA(0, 0), a2, voffA);
            PG8_WAIT_V(8); PG8_WAIT_L(0); PG8_BAR; PG8_MMA(1, 0, At, B0); PG8_MMA(1, 1, At, B1); PG8_BAR; PG8_SCHED;
            PG8_LDB(B0, 1, 0); PG8_LDB(B1, 1, 1); PG8_SCHED; PG8_LDA(At, 1, 0); PG8_STAGE(PG8_SA(0, 1), a2 + hstepA, voffA);
            PG8_WAIT_V(8); PG8_WAIT_L(0); PG8_BAR; PG8_MMA(0, 0, At, B0); PG8_MMA(0, 1, At, B1); PG8_BAR; PG8_SCHED;
            PG8_LDA(At, 1, 1); PG8_STAGE(PG8_SB(1, 0), b3, voffB); PG8_STAGE(PG8_SB(1, 1), b3 + hstepB, voffB); PG8_STAGE(PG8_SA(1, 0), a3, voffA);
            PG8_WAIT_V(8); PG8_WAIT_L(0); PG8_BAR; PG8_MMA(1, 0, At, B0); PG8_MMA(1, 1, At, B1); PG8_BAR; PG8_SCHED;
        }
        }
        if constexpr (ALIGN_EPI) { if (wr == 0) PG8_BAR; }
        E(acc, cur, wr, wc, 0, 0);
        if (!has_next) break;
        cur = nxt; cA = nA; cB = nB; ++ui;
        E.init(acc, cur, wr, wc);
        if constexpr (ALIGN_EPI) { if (wr == 1) PG8_BAR; }
    }
    PG8_WAIT_V(0);
    if constexpr (!ALIGN_EPI) { if (wr == 0) PG8_BAR; }
    PG8_BAR;
#undef PG8_SA
#undef PG8_SB
#undef PG8_STAGE
#undef PG8_LDA
#undef PG8_LDB
#undef PG8_MMA
#undef PG8_WAIT_V
#undef PG8_WAIT_L
#undef PG8_BAR
#undef PG8_SCHED
}
}

constexpr int NWAVES = 8;
constexpr int NPHASE = 19;
constexpr size_t MiB = 1u << 20;
constexpr size_t WS_CTL = 0, CTL_ZERO_BYTES = 1 * MiB;
constexpr size_t WS_WA = 1 * MiB;
constexpr size_t WS_XB = 18 * MiB;
constexpr size_t WS_Y = 51 * MiB;
constexpr size_t WS_ZG = 117 * MiB;
constexpr size_t WS_BT3 = 249 * MiB, WS_BT4 = 253 * MiB, WS_BT5 = WS_ZG + 96 * MiB, WS_BT6 = WS_ZG + 108 * MiB;
constexpr size_t WS_MB4S = WS_WA + 8 * MiB;
constexpr size_t WS_SLAB = WS_Y;
constexpr size_t WS_END = 255 * MiB;
static_assert(WS_XB + (size_t)M * DM * 2 <= WS_Y && WS_Y + (size_t)M * YC * 2 <= WS_ZG && WS_ZG + (size_t)M * GC * 2 <= WS_BT3 && WS_SLAB + (size_t)11 * 512 * DM * 4 <= WS_ZG, "ws map");
static_assert((size_t)M * FF * 2 <= 96 * MiB && WS_BT5 + (size_t)2 * FF * DM * 2 <= WS_BT6 && WS_BT6 + (size_t)DM * FF * 2 <= WS_BT3, "ws map 2");
constexpr int CW_TMO = 0, CW_CODE = 1, CW_BAR = 4096, CW_SEAM = 16384, SEAM_BANK = 8192;
constexpr size_t WS_XCH = WS_Y + 32 * MiB;
constexpr int XLDS_OFF = 131072 + 1024;
constexpr int RING_OFF = 0, RING_BYTES = 131072;
constexpr int LDSCTL_OFF = RING_BYTES, MISC_OFF = LDSCTL_OFF + 320;
constexpr int LDS_BYTES = 147456;

#define GAS __attribute__((address_space(1)))
#define LAS __attribute__((address_space(3)))
typedef unsigned short bf16;
typedef unsigned v4u __attribute__((ext_vector_type(4)));
typedef unsigned v2u __attribute__((ext_vector_type(2)));
typedef float f32x4 __attribute__((ext_vector_type(4)));
typedef float f32x2 __attribute__((ext_vector_type(2)));
typedef short bf16x8 __attribute__((ext_vector_type(8)));
typedef GAS unsigned gu32;
#define RLX_AGENT __ATOMIC_RELAXED, __HIP_MEMORY_SCOPE_AGENT
#define LDS_WAIT() asm volatile("s_waitcnt lgkmcnt(0)" ::: "memory")
#define VM_WAIT() asm volatile("s_waitcnt vmcnt(0)" ::: "memory")
__device__ __forceinline__ unsigned pk2(float lo, float hi) { return pg8::cvt_pk_bf16(lo, hi); }
__device__ __forceinline__ float bflo(unsigned v) { return __uint_as_float(v << 16); }
__device__ __forceinline__ float bfhi(unsigned v) { return __uint_as_float(v & 0xffff0000u); }
__device__ __forceinline__ float bf1(unsigned short h) { return __uint_as_float((unsigned)h << 16); }
__device__ __forceinline__ unsigned short f2bf(float f) { return (unsigned short)(pg8::cvt_pk_bf16(f, 0.f) & 0xffffu); }

#define XB_TMO      128
#define XB_XCNT(j)  (256  + 64 * (j))
#define XB_XSUB(j)  (1280 + 64 * (j))
#define XB_XGEN(j)  (2304 + 64 * (j))
#define XB_TOP      3328
#define XB_TOPGEN   3392
#define XCD_BAR_WORDS 3456
#define XB_SPIN_CAP (1u << 18)
__device__ __forceinline__ unsigned xb_ld(unsigned* p)              { return __hip_atomic_load(p, __ATOMIC_RELAXED, __HIP_MEMORY_SCOPE_AGENT); }
__device__ __forceinline__ unsigned xb_add(unsigned* p, unsigned v) { return __hip_atomic_fetch_add(p, v, __ATOMIC_RELAXED, __HIP_MEMORY_SCOPE_AGENT); }
__device__ __forceinline__ unsigned xb_xcc_id() { return (unsigned)__builtin_amdgcn_s_getreg((3 << 11) | 20) & 0xFu; }
#define XB_SPIN(cond, bar) do { unsigned _sp = 0; while (cond) { __builtin_amdgcn_s_sleep(1); \
    if ((++_sp & 255u) == 0u) { if (xb_ld(&(bar)[XB_TMO])) break; if (_sp > XB_SPIN_CAP) { atomicAdd(&(bar)[XB_TMO], 1u); break; } } } } while (0)
struct XcdBarrier { unsigned* bar; unsigned x; volatile LAS unsigned* st; };
__device__ __forceinline__ XcdBarrier xcd_barrier_post(unsigned* bar, volatile LAS unsigned* st) {
    XcdBarrier b; b.bar = bar; b.x = xb_xcc_id(); b.st = st;
    if (threadIdx.x == 0) (void)xb_add(&bar[XB_XCNT(b.x)], 1u);
    return b;
}
__device__ __forceinline__ void xcd_barrier_complete(unsigned* bar, unsigned x, unsigned& nloc, unsigned& nx) {
    const unsigned G = gridDim.x * gridDim.y * gridDim.z;
    unsigned sum, cnt, mine, sp = 0u;
    for (;;) {
        sum = 0u; cnt = 0u; mine = 0u;
#pragma unroll
        for (unsigned j = 0; j < 16; ++j) { const unsigned c = xb_ld(&bar[XB_XCNT(j)]); sum += c; cnt += (c > 0u) ? 1u : 0u; mine = (j == x) ? c : mine; }
        if (sum == G) break;
        __builtin_amdgcn_s_sleep(1);
        if ((++sp & 255u) == 0u) { if (xb_ld(&bar[XB_TMO])) break; if (sp > XB_SPIN_CAP) { atomicAdd(&bar[XB_TMO], 1u); break; } }
    }
    nloc = mine > 0u ? mine : 1u; nx = cnt > 0u ? cnt : 1u;
}
__device__ __forceinline__ void xcd_barrier(const XcdBarrier& b) {
    asm volatile("s_waitcnt vmcnt(0)" ::: "memory");
    __syncthreads();
    if (threadIdx.x == 0) {
        unsigned* bar = b.bar;
        __builtin_amdgcn_s_waitcnt(0);
        unsigned nloc = b.st[0], nx = b.st[1];
        if (nloc == 0u) { xcd_barrier_complete(bar, b.x, nloc, nx); b.st[0] = nloc; b.st[1] = nx; }
        const unsigned old = xb_add(&bar[XB_XSUB(b.x)], 1u);
        const unsigned gen = old / nloc;
        if (old + 1u == (gen + 1u) * nloc) {
            __builtin_amdgcn_fence(__ATOMIC_RELEASE, "agent");
            asm volatile("s_waitcnt vmcnt(0)" ::: "memory");
            const unsigned og = xb_add(&bar[XB_TOP], 1u);
            const unsigned tg = og / nx;
            if (og + 1u == (tg + 1u) * nx) xb_add(&bar[XB_TOPGEN], 1u);
            else XB_SPIN(xb_ld(&bar[XB_TOPGEN]) == tg, bar);
            __builtin_amdgcn_fence(__ATOMIC_ACQUIRE, "agent");
            xb_add(&bar[XB_XGEN(b.x)], 1u);
            asm volatile("s_waitcnt vmcnt(0)" ::: "memory");
        } else {
            XB_SPIN(xb_ld(&bar[XB_XGEN(b.x)]) == gen, bar);
            __builtin_amdgcn_fence(__ATOMIC_ACQUIRE, "agent");
            asm volatile("s_waitcnt vmcnt(0)" ::: "memory");
        }
    }
    __syncthreads();
}

struct Frame {
    LAS unsigned char* lds;
    volatile LAS unsigned* MISC;
    gu32* ctl;
    int tid, lane, wave, G, bid;
    const float* const* in;
    float* out;
    unsigned char* ws;
};
enum { I_XP = 0, I_XS, I_SH, I_SRGC, I_SCF, I_SPOOL, I_SSC, I_WIN, I_RGCW, I_RGCB, I_RGWA, I_RGBA, I_RGWX, I_RGBX, I_LAM, I_CFW, I_CFB, I_CFG, I_CFBB, I_POOLW, I_POOLS, I_SCW,
       I_WBR, I_WOUT, I_LN1G, I_LN1B, I_WG, I_WU, I_WD, I_LN2G, I_LN2B };

__device__ __forceinline__ float shfl_idx(float v, int src_lane) { return __builtin_bit_cast(float, __builtin_amdgcn_ds_bpermute(src_lane << 2, __builtin_bit_cast(int, v))); }
__device__ __forceinline__ float wave_sum(float v, int lane) {
#pragma unroll
    for (int o = 1; o < 64; o <<= 1) v += shfl_idx(v, lane ^ o);
    return v;
}

enum { RM_ID = 0, RM_WIN = 1, RM_GU = 2 };
template <int MODE> __device__ __forceinline__ int rowmap(int s, int extra) {
    if (MODE == RM_ID) return s;
    if (MODE == RM_GU) return 256 * (s >> 7) + (s & 127) + extra;
    if (s < 1024) return s;
    if (s < 2048) { const int j = ((s - 1024) >> 7) & 3; return 1024 + 256 * j + (s >= 1536 ? 128 : 0) + (s & 127); }
    if (s < 3072) return s;
    if (s < 4096) { const int j = ((s - 3072) >> 7) & 3; return 3072 + 256 * j + (s >= 3584 ? 128 : 0) + (s & 127); }
    const int g = (s - 4096) >> 10, ch = s & 1023, pn = ch >> 6, chl = ch & 63, wc = chl >> 4, fq = (chl >> 2) & 3, i = chl & 3;
    return 4096 + 256 * pn + 128 * (g >> 1) + 32 * wc + 8 * fq + 4 * (g & 1) + i;
}
template <int MODE>
__device__ __forceinline__ void transpose_item(const float* W, int K, int N, bf16* WT, int dst_ld, int dst_koff, int extra, LAS float* scr, int item, int lane, int nb0, int nnb) {
    const int kb = item / nnb, nb = nb0 + item % nnb, k0 = 64 * kb, n0 = 32 * nb;
#pragma unroll 8
    for (int i = 0; i < 32; ++i) { const int kk = 2 * i + (lane >> 5); scr[kk * 33 + (lane & 31)] = W[(size_t)(k0 + kk) * N + n0 + (lane & 31)]; }
    LDS_WAIT(); asm volatile("" ::: "memory");
    const int c = lane & 7; const float sc = (MODE == RM_WIN && n0 >= 4096) ? -1.44269504089f : 1.0f;
#pragma unroll
    for (int j = 0; j < 4; ++j) { const int n = (lane >> 3) + 8 * j; const LAS float* s = scr + (8 * c) * 33 + n;
        v4u o; o.x = pk2(s[0 * 33] * sc, s[1 * 33] * sc); o.y = pk2(s[2 * 33] * sc, s[3 * 33] * sc); o.z = pk2(s[4 * 33] * sc, s[5 * 33] * sc); o.w = pk2(s[6 * 33] * sc, s[7 * 33] * sc);
        *(GAS v4u*)(WT + (size_t)rowmap<MODE>(n0 + n, extra) * dst_ld + dst_koff + k0 + 8 * c) = o; }
    LDS_WAIT(); asm volatile("" ::: "memory");
}
template <int MODE>
__device__ __forceinline__ void convert_matrix(Frame& F, const float* W, int K, int N, bf16* WT, int dst_ld, int dst_koff, int extra, int gw, int NGW, int first = 0, int nb0 = 0, int nnb = 0) {
    LAS float* scr = (LAS float*)(F.lds + RING_OFF + F.wave * 16384);
    if (nnb == 0) nnb = N / 32;
    const int nitems = (K / 64) * nnb;
    int it0 = gw - first; if (it0 < 0) it0 += ((-it0 + NGW - 1) / NGW) * NGW;
    for (int it = it0; it < nitems; it += NGW) transpose_item<MODE>(W, K, N, WT, dst_ld, dst_koff, extra, scr, it, F.lane, nb0, nnb);
}
__device__ __forceinline__ void compose_pool(Frame& F, int layer, bf16* Bt3, int gw, int NGW, int first = 0) {
    const float* pw = F.in[I_POOLW] + (size_t)layer * 4 * 128 * 128; const float* ps = F.in[I_POOLS] + layer * 512; const float* Wb2 = F.in[I_WBR] + ((size_t)layer * 4 + 2) * 512 * 1024;
    const int lane = F.lane;
    LAS float* Pl = (LAS float*)(F.lds + RING_OFF + F.wave * 16384);
    int id0 = gw - first; if (id0 < 0) id0 += ((-id0 + NGW - 1) / NGW) * NGW;
    for (int id = id0; id < 512; id += NGW) {
        const int g = __builtin_amdgcn_readfirstlane(id >> 7), c0 = __builtin_amdgcn_readfirstlane(8 * ((id >> 3) & 15)), d0 = 128 * (id & 7) + 2 * lane;
#pragma unroll
        for (int k = 0; k < 4; ++k) { const int idx4 = lane + 64 * k, i = idx4 >> 5, e4 = (idx4 & 31) * 4;
            const f32x4 pv = *(const GAS f32x4*)(pw + ((size_t)g * 128 + c0 + i) * 128 + e4), sv = *(const GAS f32x4*)(ps + 128 * g + e4);
            Pl[(e4 + 0) * 8 + i] = pv.x * sv.x; Pl[(e4 + 1) * 8 + i] = pv.y * sv.y; Pl[(e4 + 2) * 8 + i] = pv.z * sv.z; Pl[(e4 + 3) * 8 + i] = pv.w * sv.w; }
        LDS_WAIT(); asm volatile("" ::: "memory");
        f32x2 acc[8];
#pragma unroll
        for (int i = 0; i < 8; ++i) acc[i] = (f32x2){0.f, 0.f};
        const float* wrow = Wb2 + (size_t)(128 * g) * 1024 + d0;
#pragma unroll 1
        for (int e0 = 0; e0 < 128; e0 += 8) {
            f32x2 wv[8];
#pragma unroll
            for (int k = 0; k < 8; ++k) wv[k] = *(const GAS f32x2*)(wrow + (size_t)(e0 + k) * 1024);
#pragma unroll
            for (int k = 0; k < 8; ++k) { const f32x4 p0 = *(const LAS f32x4*)(Pl + (e0 + k) * 8), p1 = *(const LAS f32x4*)(Pl + (e0 + k) * 8 + 4);
#pragma unroll
                for (int i = 0; i < 4; ++i) { acc[i] += wv[k] * p0[i]; acc[4 + i] += wv[k] * p1[i]; } }
        }
        v4u o0, o1;
        o0.x = pk2(acc[0].x, acc[1].x); o0.y = pk2(acc[2].x, acc[3].x); o0.z = pk2(acc[4].x, acc[5].x); o0.w = pk2(acc[6].x, acc[7].x);
        o1.x = pk2(acc[0].y, acc[1].y); o1.y = pk2(acc[2].y, acc[3].y); o1.z = pk2(acc[4].y, acc[5].y); o1.w = pk2(acc[6].y, acc[7].y);
        *(GAS v4u*)(Bt3 + (size_t)d0 * 2048 + 1024 + 128 * g + c0) = o0; *(GAS v4u*)(Bt3 + (size_t)(d0 + 1) * 2048 + 1024 + 128 * g + c0) = o1;
        LDS_WAIT(); asm volatile("" ::: "memory");
    }
}

__device__ __forceinline__ const float* xrow_in(Frame& F, int m) { return m < MP ? F.in[I_XP] + (size_t)m * DM : F.in[I_XS] + (size_t)(m - MP) * DM; }
__device__ __forceinline__ void x_to_bf16(Frame& F, bf16* XB) {
    const int gw = F.bid * NWAVES + F.wave, NGW = F.G * NWAVES;
    for (int m0 = 4 * gw; m0 < M; m0 += 4 * NGW) {
        f32x4 v[4][4];
#pragma unroll
        for (int k = 0; k < 4; ++k) { const GAS f32x4* xr = (const GAS f32x4*)xrow_in(F, m0 + k) + F.lane;
#pragma unroll
            for (int j = 0; j < 4; ++j) v[k][j] = xr[64 * j]; }
#pragma unroll
        for (int k = 0; k < 4; ++k) { GAS v2u* o = (GAS v2u*)(XB + (size_t)(m0 + k) * DM) + F.lane;
#pragma unroll
            for (int j = 0; j < 4; ++j) o[64 * j] = (v2u){pk2(v[k][j].x, v[k][j].y), pk2(v[k][j].z, v[k][j].w)}; } }
}
__device__ __forceinline__ void ln_rows(Frame& F, const float* V, float* O, const float* g, const float* b, bf16* XB, const float* sbase, const float* slab, int nslab) {
    const int gw = F.bid * NWAVES + F.wave, NGW = F.G * NWAVES;
    f32x4 gv[4], bv[4];
#pragma unroll
    for (int j = 0; j < 4; ++j) { gv[j] = ((const GAS f32x4*)g)[F.lane + 64 * j]; bv[j] = ((const GAS f32x4*)b)[F.lane + 64 * j]; }
    for (int m = MP + gw; m < M; m += NGW) {
        const GAS f32x4* xr = (const GAS f32x4*)(V + (size_t)m * DM) + F.lane; GAS f32x4* orow = (GAS f32x4*)(O + (size_t)m * DM) + F.lane;
        f32x4 v[4]; float s = 0.f;
#pragma unroll
        for (int j = 0; j < 4; ++j) v[j] = xr[64 * j];
        if (m >= MP) { const GAS f32x4* br = (const GAS f32x4*)(sbase + (size_t)(m - MP) * DM) + F.lane;
#pragma unroll
            for (int j = 0; j < 4; ++j) v[j] = br[64 * j] * ALPHA;
            for (int sl = 0; sl < nslab; ++sl) { const GAS f32x4* sr = (const GAS f32x4*)(slab + ((size_t)sl * 512 + (m - MP)) * DM) + F.lane;
#pragma unroll
                for (int j = 0; j < 4; ++j) v[j] += sr[64 * j]; } }
#pragma unroll
        for (int j = 0; j < 4; ++j) s += (v[j].x + v[j].y) + (v[j].z + v[j].w);
        const float mean = wave_sum(s, F.lane) * (1.f / DM); float s2 = 0.f;
#pragma unroll
        for (int j = 0; j < 4; ++j) { v[j] = v[j] - mean; s2 += (v[j].x * v[j].x + v[j].y * v[j].y) + (v[j].z * v[j].z + v[j].w * v[j].w); }
        const float rstd = __builtin_amdgcn_rsqf(wave_sum(s2, F.lane) * (1.f / DM) + LN_EPS);
#pragma unroll
        for (int j = 0; j < 4; ++j) { v[j] = v[j] * rstd * gv[j] + bv[j]; orow[64 * j] = v[j]; }
        if (XB) { GAS v2u* o = (GAS v2u*)(XB + (size_t)m * DM) + F.lane;
#pragma unroll
            for (int j = 0; j < 4; ++j) o[64 * j] = (v2u){pk2(v[j].x, v[j].y), pk2(v[j].z, v[j].w)}; }
    }
}

__device__ __forceinline__ float softplusf_acc(float x) { return fmaxf(x, 0.f) + log1pf(__expf(-fabsf(x))); }
__device__ __forceinline__ float expm1_neg(float x) {
    const float p = x * (1.f + x * (0.5f + x * (1.f / 6.f + x * (1.f / 24.f + x * (1.f / 120.f + x * (1.f / 720.f + x * (1.f / 5040.f)))))));
    return x > -0.25f ? p : __expf(x) - 1.f;
}
constexpr int PATCH_STRIDE = 144;

struct ALane {
    float cwD[4], cbD, ba, bx, ck;
    bf16x8 Ba[4][2], Bx[4][2];
};
constexpr int PATCH_BYTES = 5120, ASLOT_OFF = 8 * PATCH_BYTES;
__device__ __forceinline__ void a_setup(Frame& F, int layer, int n, int q, ALane& L) {
    const int c = F.lane & 15, kg = F.lane >> 4, och = 64 * n + 16 * q + c;
    const float* cw = F.in[I_RGCW] + (size_t)layer * 4 * 512 + 64 * n; const float* cb = F.in[I_RGCB] + layer * 512 + 64 * n;
#pragma unroll
    for (int j = 0; j < 4; ++j) L.cwD[j] = cw[j * 512 + 16 * q + c];
    L.cbD = cb[16 * q + c];
    L.ck = 8.0f * softplusf_acc(-F.in[I_LAM][layer * 512 + och]);
    const float* wa = F.in[I_RGWA] + ((size_t)layer * 8 + n) * 4096 + 16 * q + c; const float* wx = F.in[I_RGWX] + ((size_t)layer * 8 + n) * 4096 + 16 * q + c;
    float wav[16], wxv[16], cbv[16];
#pragma unroll
    for (int e = 0; e < 16; ++e) { const int k = (e < 8 ? 8 * kg + e : 32 + 8 * kg + (e - 8)); wav[e] = wa[k * 64]; wxv[e] = wx[k * 64]; cbv[e] = cb[k]; }
#pragma unroll
    for (int j = 0; j < 4; ++j) { float t[16];
#pragma unroll
        for (int e = 0; e < 16; ++e) t[e] = cw[j * 512 + (e < 8 ? 8 * kg + e : 32 + 8 * kg + (e - 8))];
        L.Ba[j][0] = __builtin_bit_cast(bf16x8, (v4u){pk2(wav[0] * t[0], wav[1] * t[1]), pk2(wav[2] * t[2], wav[3] * t[3]), pk2(wav[4] * t[4], wav[5] * t[5]), pk2(wav[6] * t[6], wav[7] * t[7])});
        L.Ba[j][1] = __builtin_bit_cast(bf16x8, (v4u){pk2(wav[8] * t[8], wav[9] * t[9]), pk2(wav[10] * t[10], wav[11] * t[11]), pk2(wav[12] * t[12], wav[13] * t[13]), pk2(wav[14] * t[14], wav[15] * t[15])});
        L.Bx[j][0] = __builtin_bit_cast(bf16x8, (v4u){pk2(wxv[0] * t[0], wxv[1] * t[1]), pk2(wxv[2] * t[2], wxv[3] * t[3]), pk2(wxv[4] * t[4], wxv[5] * t[5]), pk2(wxv[6] * t[6], wxv[7] * t[7])});
        L.Bx[j][1] = __builtin_bit_cast(bf16x8, (v4u){pk2(wxv[8] * t[8], wxv[9] * t[9]), pk2(wxv[10] * t[10], wxv[11] * t[11]), pk2(wxv[12] * t[12], wxv[13] * t[13]), pk2(wxv[14] * t[14], wxv[15] * t[15])}); }
    float sa = 0.f, sx = 0.f;
#pragma unroll
    for (int e = 0; e < 16; ++e) { sa = fmaf(cbv[e], wav[e], sa); sx = fmaf(cbv[e], wxv[e], sx); }
    sa += shfl_idx(sa, F.lane ^ 16); sa += shfl_idx(sa, F.lane ^ 32); sx += shfl_idx(sx, F.lane ^ 16); sx += shfl_idx(sx, F.lane ^ 32);
    L.ba = F.in[I_RGBA][layer * 512 + och] + sa; L.bx = F.in[I_RGBX][layer * 512 + och] + sx;
}
__device__ __forceinline__ void a_block(const ALane& L, const LAS unsigned char* patch, int rowA0, int baseD, int q, int lane, float (&a)[4], float (&bb)[4]) {
    const int c = lane & 15, kg = lane >> 4;
    f32x4 accR = (f32x4){0.f, 0.f, 0.f, 0.f}, accI = (f32x4){0.f, 0.f, 0.f, 0.f};
#pragma unroll
    for (int j = 0; j < 4; ++j) { const LAS unsigned char* rp = patch + (rowA0 + j) * PATCH_STRIDE + 16 * kg;
        const bf16x8 A0 = *(const LAS bf16x8*)rp, A1 = *(const LAS bf16x8*)(rp + 64);
        accR = __builtin_amdgcn_mfma_f32_16x16x32_bf16(A0, L.Ba[j][0], accR, 0, 0, 0); accR = __builtin_amdgcn_mfma_f32_16x16x32_bf16(A1, L.Ba[j][1], accR, 0, 0, 0);
        accI = __builtin_amdgcn_mfma_f32_16x16x32_bf16(A0, L.Bx[j][0], accI, 0, 0, 0); accI = __builtin_amdgcn_mfma_f32_16x16x32_bf16(A1, L.Bx[j][1], accI, 0, 0, 0); }
    float pv[7];
#pragma unroll
    for (int k = 0; k < 7; ++k) pv[k] = bf1(*(const LAS unsigned short*)(patch + (baseD + k) * PATCH_STRIDE + 2 * (16 * q + c)));
#pragma unroll
    for (int r = 0; r < 4; ++r) {
        const float xd = L.cbD + L.cwD[0] * pv[r] + L.cwD[1] * pv[r + 1] + L.cwD[2] * pv[r + 2] + L.cwD[3] * pv[r + 3];
        const float rr = pg8::sigmoidf_fast(accR[r] + L.ba), ii = pg8::sigmoidf_fast(accI[r] + L.bx);
        const float la = -L.ck * rr;
        const float av = __builtin_amdgcn_exp2f(1.44269504089f * la);
        a[r] = av; bb[r] = __builtin_amdgcn_sqrtf(fmaxf(1.f - av * av, 0.f)) * (ii * xd);
    }
}
struct BlkScan { float Ac[4], Bc[4], EA, EB, WA, WB; };
__device__ __forceinline__ void blk_scan(const float (&a)[4], const float (&bb)[4], int lane, BlkScan& S) {
    const int c = lane & 15, g = lane >> 4;
    S.Ac[0] = a[0]; S.Bc[0] = bb[0];
#pragma unroll
    for (int r = 1; r < 4; ++r) { S.Ac[r] = a[r] * S.Ac[r - 1]; S.Bc[r] = a[r] * S.Bc[r - 1] + bb[r]; }
    float IA = S.Ac[3], IB = S.Bc[3];
    { const float pa = shfl_idx(IA, lane - 16), pb = shfl_idx(IB, lane - 16); if (g >= 1) { IB = IA * pb + IB; IA = IA * pa; } }
    { const float pa = shfl_idx(IA, lane - 32), pb = shfl_idx(IB, lane - 32); if (g >= 2) { IB = IA * pb + IB; IA = IA * pa; } }
    S.EA = shfl_idx(IA, lane - 16); S.EB = shfl_idx(IB, lane - 16); if (g == 0) { S.EA = 1.f; S.EB = 0.f; }
    S.WA = shfl_idx(IA, 48 + c); S.WB = shfl_idx(IB, 48 + c);
}
__device__ __forceinline__ void a_prompt_item(Frame& F, int layer, int item, const bf16* Z, bf16* Y) {
    const int b = item >> 5, n = (item >> 2) & 7, q = item & 3, lane = opqv(F.lane), w = F.wave, c = lane & 15, g = lane >> 4, och = 64 * n + 16 * q + c;
    ALane L; a_setup(F, layer, n, q, L);
    LAS unsigned char* patch = F.lds + RING_OFF + w * PATCH_BYTES;
    LAS f32x2* slots = (LAS f32x2*)(F.lds + RING_OFF + ASLOT_OFF);
    const bf16* Zb = Z + (size_t)b * SEQ * ZC;
    float hrun = 0.f;
    v4u pf[5];
    auto load_patch = [&](int tb) {
#pragma unroll
        for (int k = 0; k < 5; ++k) { const int ci = lane + 64 * k, pr = ci >> 3, cc = ci & 7, t = tb - 3 + pr;
            pf[k] = (ci < 280 && t >= 0) ? *(const GAS v4u*)(Zb + (size_t)t * ZC + 64 * n + 8 * cc) : (v4u){0u, 0u, 0u, 0u}; }
    };
    load_patch(32 * w);
    for (int it = 0; it < 8; ++it) {
        const int tb = 256 * it + 32 * w;
#pragma unroll
        for (int k = 0; k < 5; ++k) { const int ci = lane + 64 * k, pr = ci >> 3, cc = ci & 7; if (ci < 280) *(LAS v4u*)(patch + pr * PATCH_STRIDE + 16 * cc) = pf[k]; }
        if (it < 7) load_patch(tb + 256);
        unsigned short gav[8];
#pragma unroll
        for (int r = 0; r < 8; ++r) gav[r] = *(const GAS unsigned short*)(Zb + (size_t)(tb + 16 * (r >> 2) + 4 * g + (r & 3)) * ZC + 512 + och);
        asm volatile("" ::: "memory");
        float a0[4], b0[4], a1[4], b1[4];
        a_block(L, patch, lane & 15, 4 * g, q, lane, a0, b0);
        a_block(L, patch, 16 + (lane & 15), 16 + 4 * g, q, lane, a1, b1);
        BlkScan S0, S1; blk_scan(a0, b0, lane, S0); blk_scan(a1, b1, lane, S1);
        if (lane < 16) slots[((it & 1) * 8 + w) * 16 + c] = (f32x2){S0.WA * S1.WA, S1.WA * S0.WB + S1.WB};
        __syncthreads();
        float hin = hrun, hw = 0.f;
#pragma unroll
        for (int ww = 0; ww < 8; ++ww) { const f32x2 s = slots[((it & 1) * 8 + ww) * 16 + c]; if (ww == w) hw = hin; hin = s.x * hin + s.y; }
        hrun = hin;
        const float hg0 = S0.EA * hw + S0.EB, hw1 = S0.WA * hw + S0.WB, hg1 = S1.EA * hw1 + S1.EB;
#pragma unroll
        for (int r = 0; r < 4; ++r) { const float h = S0.Ac[r] * hg0 + S0.Bc[r];
            *(GAS unsigned short*)(Y + (size_t)(b * SEQ + tb + 4 * g + r) * YC + och) = f2bf(h * bf1(gav[r])); }
#pragma unroll
        for (int r = 0; r < 4; ++r) { const float h = S1.Ac[r] * hg1 + S1.Bc[r];
            *(GAS unsigned short*)(Y + (size_t)(b * SEQ + tb + 16 + 4 * g + r) * YC + och) = f2bf(h * bf1(gav[4 + r]));
            if (r == 3 && it == 7 && w == 7 && g == 3) F.out[O_PH + (size_t)(layer * 8 + b) * 512 + och] = h; }
    }
}
__device__ __forceinline__ void a_sample_task(Frame& F, int layer, int task, const bf16* Z, bf16* Y) {
    const int blk = task >> 5, n = (task >> 2) & 7, q = task & 3, lane = opqv(F.lane), c = lane & 15, g = lane >> 4, och = 64 * n + 16 * q + c, s0 = 4 * blk;
    ALane L; a_setup(F, layer, n, q, L);
    LAS unsigned char* patch = F.lds + RING_OFF + F.wave * PATCH_BYTES;
#pragma unroll
    for (int k = 0; k < 4; ++k) { const int ci = lane + 64 * k; if (ci < 224) { const int pr = ci >> 3, cc = ci & 7, sq = pr / 7, tau = pr - 7 * sq - 3, seq = s0 + sq; v4u v;
            if (tau < 0) { const GAS f32x4* sp = (const GAS f32x4*)(F.in[I_SRGC] + ((size_t)(layer * 128 + seq) * 3 + (tau + 3)) * 512 + 64 * n + 8 * cc); const f32x4 f0 = sp[0], f1 = sp[1];
                v = (v4u){pk2(f0.x, f0.y), pk2(f0.z, f0.w), pk2(f1.x, f1.y), pk2(f1.z, f1.w)}; }
            else v = *(const GAS v4u*)(Z + (size_t)(MP + 4 * seq + tau) * ZC + 64 * n + 8 * cc);
            *(LAS v4u*)(patch + pr * PATCH_STRIDE + 16 * cc) = v; } }
    asm volatile("" ::: "memory");
    float a[4], bb[4];
    a_block(L, patch, 7 * ((lane & 15) >> 2) + (lane & 3), 7 * g, q, lane, a, bb);
    const int seq = s0 + g;
    float h = F.in[I_SH][(size_t)(layer * 128 + seq) * 512 + och];
#pragma unroll
    for (int r = 0; r < 4; ++r) { h = a[r] * h + bb[r]; const size_t row = (size_t)(MP + 4 * seq + r);
        *(GAS unsigned short*)(Y + row * YC + och) = f2bf(h * bf1(*(const GAS unsigned short*)(Z + row * ZC + 512 + och))); }
    F.out[O_SH + (size_t)(layer * 128 + seq) * 512 + och] = h;
}

__device__ __forceinline__ void ln_silu_row(const LAS float* xr, const float* g, const float* b, bf16* dst, int lane) {
    const f32x4 v0 = *(const LAS f32x4*)(xr + 4 * lane), v1 = *(const LAS f32x4*)(xr + 256 + 4 * lane);
    const float s = (v0.x + v0.y) + (v0.z + v0.w) + (v1.x + v1.y) + (v1.z + v1.w);
    const float mean = wave_sum(s, lane) * (1.f / 512.f);
    const f32x4 d0 = v0 - mean, d1 = v1 - mean;
    const float s2 = (d0.x * d0.x + d0.y * d0.y) + (d0.z * d0.z + d0.w * d0.w) + (d1.x * d1.x + d1.y * d1.y) + (d1.z * d1.z + d1.w * d1.w);
    const float rstd = __builtin_amdgcn_rsqf(wave_sum(s2, lane) * (1.f / 512.f) + LN_EPS);
    const f32x4 g0 = *(const GAS f32x4*)(g + 4 * lane), g1 = *(const GAS f32x4*)(g + 256 + 4 * lane), b0 = *(const GAS f32x4*)(b + 4 * lane), b1 = *(const GAS f32x4*)(b + 256 + 4 * lane);
    f32x4 y0 = d0 * rstd * g0 + b0, y1 = d1 * rstd * g1 + b1;
#pragma unroll
    for (int i = 0; i < 4; ++i) { y0[i] = y0[i] * pg8::sigmoidf_fast(y0[i]); y1[i] = y1[i] * pg8::sigmoidf_fast(y1[i]); }
    *(GAS v2u*)(dst + 4 * lane) = (v2u){pk2(y0.x, y0.y), pk2(y0.z, y0.w)}; *(GAS v2u*)(dst + 256 + 4 * lane) = (v2u){pk2(y1.x, y1.y), pk2(y1.z, y1.w)};
}
__device__ __forceinline__ void ln_silu_rows4(const LAS float* xr, int rstride, const float* g, const float* b, bf16* dst, size_t dstride, int lane) {
    f32x4 v0[4], v1[4]; float s[4], s2[4];
#pragma unroll
    for (int k = 0; k < 4; ++k) { v0[k] = *(const LAS f32x4*)(xr + k * rstride + 4 * lane); v1[k] = *(const LAS f32x4*)(xr + k * rstride + 256 + 4 * lane);
        s[k] = (v0[k].x + v0[k].y) + (v0[k].z + v0[k].w) + (v1[k].x + v1[k].y) + (v1[k].z + v1[k].w); }
#pragma unroll
    for (int o = 1; o < 64; o <<= 1) {
#pragma unroll
        for (int k = 0; k < 4; ++k) s[k] += shfl_idx(s[k], lane ^ o); }
#pragma unroll
    for (int k = 0; k < 4; ++k) { const float mean = s[k] * (1.f / 512.f); v0[k] = v0[k] - mean; v1[k] = v1[k] - mean;
        s2[k] = (v0[k].x * v0[k].x + v0[k].y * v0[k].y) + (v0[k].z * v0[k].z + v0[k].w * v0[k].w) + (v1[k].x * v1[k].x + v1[k].y * v1[k].y) + (v1[k].z * v1[k].z + v1[k].w * v1[k].w); }
#pragma unroll
    for (int o = 1; o < 64; o <<= 1) {
#pragma unroll
        for (int k = 0; k < 4; ++k) s2[k] += shfl_idx(s2[k], lane ^ o); }
    const f32x4 g0 = *(const GAS f32x4*)(g + 4 * lane), g1 = *(const GAS f32x4*)(g + 256 + 4 * lane), b0 = *(const GAS f32x4*)(b + 4 * lane), b1 = *(const GAS f32x4*)(b + 256 + 4 * lane);
#pragma unroll
    for (int k = 0; k < 4; ++k) { const float rstd = __builtin_amdgcn_rsqf(s2[k] * (1.f / 512.f) + LN_EPS);
        f32x4 y0 = v0[k] * rstd * g0 + b0, y1 = v1[k] * rstd * g1 + b1;
#pragma unroll
        for (int i = 0; i < 4; ++i) { y0[i] = y0[i] * pg8::sigmoidf_fast(y0[i]); y1[i] = y1[i] * pg8::sigmoidf_fast(y1[i]); }
        bf16* d = dst + (size_t)k * dstride;
        *(GAS v2u*)(d + 4 * lane) = (v2u){pk2(y0.x, y0.y), pk2(y0.z, y0.w)}; *(GAS v2u*)(d + 256 + 4 * lane) = (v2u){pk2(y1.x, y1.y), pk2(y1.z, y1.w)}; }
}
__device__ __forceinline__ void b_prompt_item(Frame& F, int layer, int item, const bf16* Z, bf16* Y) {
    const int tidl = opqv(F.tid), b = item >> 5, t0 = 64 * (item & 31), p = tidl & 255, hh = tidl >> 8, ts = t0 + 32 * hh;
    const GAS unsigned* Zu = (const GAS unsigned*)(Z + (size_t)b * SEQ * ZC) + 512 + p;
    unsigned raw[62];
#pragma unroll
    for (int i = 0; i < 62; ++i) { const int t = ts - 30 + i; raw[i] = t >= 0 ? Zu[(size_t)t * (ZC / 2)] : 0u; }
    const float* cw = F.in[I_CFW] + (size_t)layer * 31 * 512 + 2 * p;
    f32x2 wj[31];
#pragma unroll
    for (int j = 0; j < 31; ++j) wj[j] = *(const GAS f32x2*)(cw + j * 512);
    const f32x2 bias = *(const GAS f32x2*)(F.in[I_CFB] + layer * 512 + 2 * p);
    f32x2 in[62];
#pragma unroll
    for (int i = 0; i < 62; ++i) in[i] = (f32x2){bflo(raw[i]), bfhi(raw[i])};
    LAS float* obuf = (LAS float*)(F.lds + RING_OFF);
#pragma unroll
    for (int i = 0; i < 32; ++i) { f32x2 o = bias;
#pragma unroll
        for (int j = 0; j < 31; ++j) o += wj[j] * in[i + j];
        *(LAS f32x2*)(obuf + (32 * hh + i) * 512 + 2 * p) = o; }
    __syncthreads();
    const float* lg = F.in[I_CFG] + layer * 512; const float* lb = F.in[I_CFBB] + layer * 512;
#pragma unroll 1
    for (int r = 8 * F.wave; r < 8 * F.wave + 8; r += 4) ln_silu_rows4(obuf + r * 512, 512, lg, lb, Y + (size_t)(b * SEQ + t0 + r) * YC + 512, YC, F.lane);
}
__device__ __forceinline__ void cd_prompt_item(Frame& F, int layer, int item, const bf16* Z, bf16* Y) {
    const int tidl = opqv(F.tid), b = item >> 5, t0 = 64 * (item & 31), p = tidl & 255, hh = tidl >> 8;
    const bf16* Zb = Z + (size_t)b * SEQ * ZC;
    LAS unsigned* cbuf = (LAS unsigned*)(F.lds + RING_OFF);
    { v4u tmp[10];
#pragma unroll
      for (int k = 0; k < 10; ++k) { const int ci = tidl + 512 * k, pr = ci >> 6, cc = ci & 63, t = t0 - 15 + pr;
          tmp[k] = (ci < 79 * 64 && t >= 0) ? *(const GAS v4u*)(Zb + (size_t)t * ZC + 1536 + 8 * cc) : (v4u){0u, 0u, 0u, 0u}; }
#pragma unroll
      for (int k = 0; k < 10; ++k) { const int ci = tidl + 512 * k, pr = ci >> 6, cc = ci & 63; if (ci < 79 * 64) *(LAS v4u*)(cbuf + pr * 256 + 4 * cc) = tmp[k]; } }
    const int ts = t0 + 32 * hh;
    unsigned uu[34], dd[32];
#pragma unroll
    for (int i = 0; i < 34; ++i) { const int t = ts - 2 + i; uu[i] = t >= 0 ? ((const GAS unsigned*)(Zb + (size_t)t * ZC))[1280 + p] : 0u; }
#pragma unroll
    for (int i = 0; i < 32; ++i) dd[i] = ((const GAS unsigned*)(Zb + (size_t)(ts + i) * ZC))[1024 + p];
    const f32x2 w0 = ((const GAS f32x2*)(F.in[I_SCW] + (size_t)(layer * 3 + 0) * 512))[p], w1 = ((const GAS f32x2*)(F.in[I_SCW] + (size_t)(layer * 3 + 1) * 512))[p],
                w2 = ((const GAS f32x2*)(F.in[I_SCW] + (size_t)(layer * 3 + 2) * 512))[p];
    __syncthreads();
    const int w = 2 << (p >> 6), rr0 = 15 + 32 * hh;
    f32x2 s = (f32x2){0.f, 0.f};
    for (int j = 0; j < w; ++j) { const unsigned v = cbuf[(rr0 - j) * 256 + p]; s += (f32x2){bflo(v), bfhi(v)}; }
    GAS unsigned* Yu = (GAS unsigned*)(Y + (size_t)(b * SEQ + ts) * YC) + p;
#pragma unroll
    for (int i = 0; i < 32; ++i) { const int t = ts + i, rr = rr0 + i;
        const unsigned cur = cbuf[rr * 256 + p]; const f32x2 cf = (f32x2){bflo(cur), bfhi(cur)};
        if (i > 0) { const unsigned old = cbuf[(rr - w) * 256 + p]; s += cf - (f32x2){bflo(old), bfhi(old)}; }
        const float ic = __builtin_amdgcn_rcpf((float)(t + 1 < w ? t + 1 : w));
        const f32x2 mm = s * ic - cf;
        Yu[(size_t)i * 1024 + 512] = pk2(mm.x, mm.y);
        const f32x2 cv = w0 * (f32x2){bflo(uu[i]), bfhi(uu[i])} + w1 * (f32x2){bflo(uu[i + 1]), bfhi(uu[i + 1])} + w2 * (f32x2){bflo(uu[i + 2]), bfhi(uu[i + 2])};
        const f32x2 yd = (f32x2){bflo(dd[i]), bfhi(dd[i])} * cv;
        Yu[(size_t)i * 1024 + 768] = pk2(yd.x, yd.y); }
}
__device__ __forceinline__ void s_sample_item(Frame& F, int layer, int s, const bf16* Z, bf16* Y) {
    const int ch = opqv(F.tid); const size_t ls = (size_t)layer * 128 + s;
    const bf16* Zr = Z + (size_t)(MP + 4 * s) * ZC; bf16* Yr = Y + (size_t)(MP + 4 * s) * YC;
    LAS float* obuf = (LAS float*)(F.lds + RING_OFF);
    float in[34], wv[31], pb[19], u[6], dbv[4];
#pragma unroll
    for (int j = 0; j < 30; ++j) in[j] = (F.in[I_SCF] + (ls * 30 + j) * 512)[ch];
#pragma unroll
    for (int j = 0; j < 15; ++j) pb[j] = (F.in[I_SPOOL] + (ls * 15 + j) * 512)[ch];
    u[0] = (F.in[I_SSC] + (ls * 2 + 0) * 512)[ch]; u[1] = (F.in[I_SSC] + (ls * 2 + 1) * 512)[ch];
#pragma unroll
    for (int r = 0; r < 4; ++r) { in[30 + r] = bf1((Zr + (size_t)r * ZC + 1024)[ch]); pb[15 + r] = bf1((Zr + (size_t)r * ZC + 1536)[ch]); u[2 + r] = bf1((Zr + (size_t)r * ZC + 2560)[ch]); dbv[r] = bf1((Zr + (size_t)r * ZC + 2048)[ch]); }
#pragma unroll
    for (int j = 0; j < 31; ++j) wv[j] = (F.in[I_CFW] + ((size_t)layer * 31 + j) * 512)[ch];
    const float bias = (F.in[I_CFB] + layer * 512)[ch];
    const float w0 = (F.in[I_SCW] + (size_t)(layer * 3 + 0) * 512)[ch], w1 = (F.in[I_SCW] + (size_t)(layer * 3 + 1) * 512)[ch], w2 = (F.in[I_SCW] + (size_t)(layer * 3 + 2) * 512)[ch];
    asm volatile("" ::: "memory");
#pragma unroll
    for (int j = 0; j < 26; ++j) (F.out + O_SCF + (ls * 30 + j) * 512)[ch] = in[j + 4];
#pragma unroll
    for (int r = 0; r < 4; ++r) { float o = bias;
#pragma unroll
        for (int j = 0; j < 31; ++j) o += wv[j] * in[r + j];
        obuf[r * 512 + ch] = o; }
#pragma unroll
    for (int j = 0; j < 11; ++j) (F.out + O_SPOOL + (ls * 15 + j) * 512)[ch] = pb[j + 4];
    const int gsel = ch >> 7;
#pragma unroll
    for (int r = 0; r < 4; ++r) { const int k = 15 + r;
        const float s2 = pb[k] + pb[k - 1], s4 = s2 + pb[k - 2] + pb[k - 3], s8 = s4 + (pb[k - 4] + pb[k - 5]) + (pb[k - 6] + pb[k - 7]);
        float s16 = s8;
#pragma unroll
        for (int j = 8; j < 16; ++j) s16 += pb[k - j];
        const float mv = (gsel == 0 ? s2 * 0.5f : gsel == 1 ? s4 * 0.25f : gsel == 2 ? s8 * 0.125f : s16 * 0.0625f) - pb[k];
        (Yr + (size_t)r * YC + 1024)[ch] = f2bf(mv); }
#pragma unroll
    for (int r = 0; r < 4; ++r) (Yr + (size_t)r * YC + 1536)[ch] = f2bf(dbv[r] * (w0 * u[r] + w1 * u[r + 1] + w2 * u[r + 2]));
    __syncthreads();
    if (F.wave < 4) ln_silu_row(obuf + F.wave * 512, F.in[I_CFG] + layer * 512, F.in[I_CFBB] + layer * 512, Yr + (size_t)F.wave * YC + 512, F.lane);
}

struct Args { const float* in[31]; float* out; unsigned char* ws; int ph_lo, ph_hi; };
__global__ void __launch_bounds__(NWAVES * 64, 2) hybrid_fwd(Args args) {
    extern __shared__ __attribute__((aligned(16))) unsigned char lds[];
    Frame F;
    F.lds = (LAS unsigned char*)lds;
    F.MISC = (volatile LAS unsigned*)(F.lds + MISC_OFF);
    const int wave0 = __builtin_amdgcn_readfirstlane((int)threadIdx.x >> 6);
    F.lane = lane_now(); F.wave = wave0; F.tid = F.wave * 64 + F.lane;
    F.G = gridDim.x; F.bid = blockIdx.x;
    F.ws = args.ws; F.out = args.out; F.ctl = (gu32*)(args.ws + WS_CTL);
    F.in = args.in;
    for (int u = F.tid; u < (LDS_BYTES - LDSCTL_OFF) / 4; u += NWAVES * 64) ((LAS unsigned*)(F.lds + LDSCTL_OFF))[u] = 0u;
    __syncthreads();
    XcdBarrier bar; bar.bar = (unsigned*)(F.ctl + CW_BAR); bar.x = 0; bar.st = nullptr;
    if (!MK_SPLIT) bar = xcd_barrier_post((unsigned*)(F.ctl + CW_BAR), F.MISC + 8);
    const int lo = args.ph_lo, hi = args.ph_hi;
#define IN(k) (lo <= (k) && (k) < hi)
#define REFRESH() do { F.lane = lane_now(); F.wave = opqs(wave0); F.tid = F.wave * 64 + F.lane; F.bid = opqs((int)blockIdx.x); } while (0)
#define SEAM(k) do { if (IN(k) && IN((k) + 1)) xcd_barrier(bar); } while (0)
    bf16* WA = (bf16*)(F.ws + WS_WA); bf16* XB = (bf16*)(F.ws + WS_XB); bf16* Y = (bf16*)(F.ws + WS_Y); bf16* Zm = (bf16*)(F.ws + WS_ZG); _Float16* Gb = (_Float16*)(F.ws + WS_ZG);
    bf16* Hb = (bf16*)(F.ws + WS_ZG); bf16* Bt3 = (bf16*)(F.ws + WS_BT3); bf16* Bt4 = (bf16*)(F.ws + WS_BT4); bf16* Bt5 = (bf16*)(F.ws + WS_BT5); bf16* Bt6 = (bf16*)(F.ws + WS_BT6);

    if (IN(0)) { REFRESH(); convert_matrix<RM_WIN>(F, F.in[I_WIN], DM, INC, WA, DM, 0, 0, F.bid * NWAVES + F.wave, F.G * NWAVES, 0, 0, F.G == 256 ? 128 : 0); REFRESH(); x_to_bf16(F, XB); }
    SEAM(0);

    for (int l = 0; l < 2; ++l) {
        const int pb = 1 + 9 * l;
        if (IN(pb + 0)) for (int rep = 0; rep < NREP(0); ++rep) { if (rep) xcd_barrier(bar); pg8::Gemm g{XB, WA, DM, DM}; pg8::UnitOrder S; S.init(pg8::SK_PLAIN, 4096, DM, F.G, F.bid, 0); pg8::EpiMix E{Zm, F.out, l};
            pg8::gemm_phase<pg8::EpiMix, pg8::UnitOrder, true>(F.lds + RING_OFF, g, S, E, wave0);
            if (F.G == 256 && F.bid >= 32) {
                REFRESH(); const int gw = (F.bid - 32) * NWAVES + F.wave, NGW = 224 * NWAVES; const float* wbr = F.in[I_WBR] + (size_t)l * 4 * 512 * 1024;
                convert_matrix<RM_ID>(F, wbr, 512, 1024, Bt3, 2048, 0, 0, gw, NGW, 0);
                convert_matrix<RM_ID>(F, wbr + (size_t)512 * 1024, 512, 1024, Bt3, 2048, 512, 0, gw, NGW, 256);
                convert_matrix<RM_ID>(F, wbr + (size_t)3 * 512 * 1024, 512, 1024, Bt3, 2048, 1536, 0, gw, NGW, 512);
                convert_matrix<RM_ID>(F, F.in[I_WOUT] + (size_t)l * DM * DM, DM, DM, Bt4, DM, 0, 0, gw, NGW, 768);
                REFRESH(); compose_pool(F, l, Bt3, gw, NGW, 1280);
                REFRESH(); convert_matrix<RM_WIN>(F, F.in[I_WIN] + (size_t)l * DM * INC, DM, INC, WA, DM, 0, 0, gw, NGW, 0, 128, 128); } }
        SEAM(pb + 0);
        if (IN(pb + 1)) for (int rep = 0; rep < NREP(1); ++rep) { if (rep) xcd_barrier(bar);
            __syncthreads(); REFRESH();
            for (int r2 = 0; r2 < NREP2(0); ++r2) for (int it = F.bid; it < 256; it += F.G) { a_prompt_item(F, l, it, Zm, Y); __syncthreads(); }
            REFRESH();
            for (int r2 = 0; r2 < NREP2(1); ++r2) for (int it = (F.bid + 128) % F.G; it < 128; it += F.G) a_sample_task(F, l, 8 * it + F.wave, Zm, Y);
            __syncthreads(); REFRESH();
            const bool rebal = F.G == 256, gemm_wg = rebal && F.bid >= 128 && F.bid < 160;
            for (int r2 = 0; r2 < NREP2(2); ++r2) { if (!gemm_wg) for (int it = F.bid; it < 256; it += F.G) { b_prompt_item(F, l, it, Zm, Y); __syncthreads(); }
                if (rebal && F.bid >= 160 && F.bid < 192) { b_prompt_item(F, l, F.bid - 32, Zm, Y); __syncthreads(); } }
            REFRESH();
            for (int r2 = 0; r2 < NREP2(3); ++r2) { if (!gemm_wg) for (int it = F.bid; it < 256; it += F.G) { cd_prompt_item(F, l, it, Zm, Y); __syncthreads(); }
                if (rebal && F.bid >= 192 && F.bid < 224) { cd_prompt_item(F, l, F.bid - 64, Zm, Y); __syncthreads(); } }
            REFRESH();
            for (int r2 = 0; r2 < NREP2(4); ++r2) for (int it = F.bid; it < 128; it += F.G) { s_sample_item(F, l, it, Zm, Y); __syncthreads(); }
            if (F.G == 256 && F.bid >= 128 && F.bid < 160) {
                pg8::Gemm g{XB, WA + (size_t)4096 * DM, DM, DM}; pg8::UnitOrder S; S.init(pg8::SK_PLAIN, 4096, DM, 32, F.bid - 128, 0, false, true); pg8::EpiGate E{Gb};
                pg8::gemm_phase<pg8::EpiGate, pg8::UnitOrder, true>(F.lds + RING_OFF, g, S, E, wave0); }
            REFRESH();
            const float* wbr = F.in[I_WBR] + (size_t)l * 4 * 512 * 1024;
            if (F.G != 256) { const int gw = F.bid * NWAVES + F.wave, NGW = F.G * NWAVES;
                convert_matrix<RM_ID>(F, wbr, 512, 1024, Bt3, 2048, 0, 0, gw, NGW); convert_matrix<RM_ID>(F, wbr + (size_t)512 * 1024, 512, 1024, Bt3, 2048, 512, 0, gw, NGW);
                convert_matrix<RM_ID>(F, wbr + (size_t)3 * 512 * 1024, 512, 1024, Bt3, 2048, 1536, 0, gw, NGW); convert_matrix<RM_ID>(F, F.in[I_WOUT] + (size_t)l * DM * DM, DM, DM, Bt4, DM, 0, 0, gw, NGW);
                REFRESH(); compose_pool(F, l, Bt3, gw, NGW); }
        }
        SEAM(pb + 1);
        if (IN(pb + 2)) for (int rep = 0; rep < NREP(2); ++rep) { if (rep) xcd_barrier(bar); pg8::Gemm g{XB, WA + (size_t)4096 * DM, DM, DM}; pg8::UnitOrder S; S.init(pg8::SK_PLAIN, 4096, DM, F.G, F.bid, 0, true, F.G != 256); pg8::EpiGate E{Gb};
            pg8::gemm_phase<pg8::EpiGate, pg8::UnitOrder, true>(F.lds + RING_OFF, g, S, E, wave0); }
        SEAM(pb + 2);
        if (IN(pb + 3)) for (int rep = 0; rep < NREP(3); ++rep) { if (rep) xcd_barrier(bar); pg8::Gemm g{Y, Bt3, 2048, 2048}; pg8::UnitOrder S; S.init(pg8::SK_P3, DM, 2048, F.G, F.bid, 0); pg8::EpiMerge E{Gb, XB, (bf16*)(F.ws + WS_MB4S)};
            pg8::gemm_phase<pg8::EpiMerge, pg8::UnitOrder, true>(F.lds + RING_OFF, g, S, E, wave0); }
        SEAM(pb + 3);
        if (IN(pb + 4)) for (int rep = 0; rep < 1; ++rep) { pg8::Gemm g{XB, Bt4, DM, DM}; pg8::UnitOrder S; S.init(pg8::SK_P4, DM, DM, F.G, F.bid, (long)(WS_MB4S - WS_XB));
            pg8::EpiRes E{l == 0 ? F.in[I_XP] : F.out, F.out, XB, F.in[I_LN1G] + l * DM, F.in[I_LN1B] + l * DM, (float*)(F.ws + WS_SLAB),
                          pg8::PanelStats{(unsigned*)(F.ws + WS_XCH + (size_t)(2 * l) * 512 * 1024), (unsigned*)(F.ctl + CW_SEAM + (2 * l) * SEAM_BANK)}, F.lds + XLDS_OFF, wave0};
            pg8::gemm_phase<pg8::EpiRes, pg8::UnitOrder, true>(F.lds + RING_OFF, g, S, E, wave0);
            if (F.G == 256 && F.bid >= 64) {
                REFRESH(); const int gw = (F.bid - 64) * NWAVES + F.wave, NGW = 192 * NWAVES;
                convert_matrix<RM_GU>(F, F.in[I_WG] + (size_t)l * DM * FF, DM, FF, Bt5, DM, 0, 0, gw, NGW, 0);
                convert_matrix<RM_GU>(F, F.in[I_WU] + (size_t)l * DM * FF, DM, FF, Bt5, DM, 0, 128, gw, NGW, 1408);
            } }
        SEAM(pb + 4);
        if (IN(pb + 5)) for (int rep = 0; rep < NREP(5); ++rep) { if (rep) xcd_barrier(bar);
            REFRESH();
            ln_rows(F, F.out, rep + 1 < NREP(5) ? (float*)(F.ws + WS_Y) : F.out, F.in[I_LN1G] + l * DM, F.in[I_LN1B] + l * DM, rep + 1 < NREP(5) ? nullptr : XB, l == 0 ? F.in[I_XS] : F.out + (size_t)MP * DM, (const float*)(F.ws + WS_SLAB), 8);
            REFRESH();
            if (F.G != 256) { const int gw = F.bid * NWAVES + F.wave, NGW = F.G * NWAVES;
                convert_matrix<RM_GU>(F, F.in[I_WG] + (size_t)l * DM * FF, DM, FF, Bt5, DM, 0, 0, gw, NGW); convert_matrix<RM_GU>(F, F.in[I_WU] + (size_t)l * DM * FF, DM, FF, Bt5, DM, 0, 128, gw, NGW);
                convert_matrix<RM_ID>(F, F.in[I_WD] + (size_t)l * FF * DM, FF, DM, Bt6, FF, 0, 0, gw, NGW); }
        }
        SEAM(pb + 5);
        if (IN(pb + 6)) for (int rep = 0; rep < NREP(6); ++rep) { if (rep) xcd_barrier(bar); pg8::Gemm g{XB, Bt5, DM, DM}; pg8::UnitOrder S; S.init(pg8::SK_PLAIN, 2 * FF, DM, F.G, F.bid, 0); pg8::EpiSwi E{Hb};
            pg8::gemm_phase<pg8::EpiSwi, pg8::UnitOrder, true>(F.lds + RING_OFF, g, S, E, wave0);
            if (F.G == 256 && F.bid >= 172 && rep + 1 == NREP(6)) {
                REFRESH(); const int gw = (F.bid - 172) * NWAVES + F.wave, NGW = 84 * NWAVES;
                convert_matrix<RM_ID>(F, F.in[I_WD] + (size_t)l * FF * DM, FF, DM, Bt6, FF, 0, 0, gw, NGW, 0);
                if (l == 0) convert_matrix<RM_WIN>(F, F.in[I_WIN] + (size_t)DM * INC, DM, INC, WA, DM, 0, 0, gw, NGW, 1408, 0, 128); } }
        SEAM(pb + 6);
        if (IN(pb + 7)) for (int rep = 0; rep < 1; ++rep) { pg8::Gemm g{Hb, Bt6, FF, FF}; pg8::UnitOrder S; S.init(pg8::SK_P6, DM, FF, F.G, F.bid, 0); pg8::EpiRes E{F.out, F.out, l == 0 ? XB : nullptr, F.in[I_LN2G] + l * DM, F.in[I_LN2B] + l * DM, (float*)(F.ws + WS_SLAB),
                          pg8::PanelStats{(unsigned*)(F.ws + WS_XCH + (size_t)(2 * l + 1) * 512 * 1024), (unsigned*)(F.ctl + CW_SEAM + (2 * l + 1) * SEAM_BANK)}, F.lds + XLDS_OFF, wave0};
            pg8::gemm_phase<pg8::EpiRes, pg8::UnitOrder, true>(F.lds + RING_OFF, g, S, E, wave0); }
        SEAM(pb + 7);
        if (IN(pb + 8)) for (int rep = 0; rep < NREP(8); ++rep) { if (rep) xcd_barrier(bar);
            REFRESH();
            ln_rows(F, F.out, rep + 1 < NREP(8) ? (float*)(F.ws + WS_Y) : F.out, F.in[I_LN2G] + l * DM, F.in[I_LN2B] + l * DM, (l == 0 && rep + 1 == NREP(8)) ? XB : nullptr, F.out + (size_t)MP * DM, (const float*)(F.ws + WS_SLAB), 11);
            REFRESH();
            if (l == 0 && F.G != 256) convert_matrix<RM_WIN>(F, F.in[I_WIN] + (size_t)DM * INC, DM, INC, WA, DM, 0, 0, F.bid * NWAVES + F.wave, F.G * NWAVES);
        }
        if (l == 0) SEAM(pb + 8);
    }
#undef IN
#undef SEAM
#undef REFRESH
}

extern "C" void kernel_launch(void* const* d_in, const int* in_sizes, int n_in, void* d_out, int out_size, void* d_ws, size_t ws_size, hipStream_t stream) {
    static int grid = 0;
    if (grid == 0) {
        if (n_in != 31 || out_size != (int)O_END || ws_size < WS_END) { fprintf(stderr, "kernel_launch: unexpected sizes n_in %d out %d ws %zu\n", n_in, out_size, ws_size); grid = -1; return; }
        int dev = 0, cus = 0, per_cu = 0;
        if (hipGetDevice(&dev) != hipSuccess || hipDeviceGetAttribute(&cus, hipDeviceAttributeMultiprocessorCount, dev) != hipSuccess) { grid = -1; return; }
        if (hipFuncSetAttribute((const void*)hybrid_fwd, hipFuncAttributeMaxDynamicSharedMemorySize, LDS_BYTES) != hipSuccess) { fprintf(stderr, "kernel_launch: hipFuncSetAttribute failed\n"); grid = -1; return; }
        if (hipOccupancyMaxActiveBlocksPerMultiprocessor(&per_cu, (const void*)hybrid_fwd, NWAVES * 64, LDS_BYTES) != hipSuccess || per_cu < 1)
            fprintf(stderr, "kernel_launch: occupancy query reports %d workgroups per CU\n", per_cu);
        (void)hipGetLastError();
        grid = cus;
    }
    if (grid < 0) return;
    if (hipMemsetAsync((char*)d_ws + WS_CTL, 0, CTL_ZERO_BYTES, stream) != hipSuccess) { fprintf(stderr, "kernel_launch: memset failed\n"); return; }
    Args a{};
    for (int i = 0; i < 31; ++i) a.in[i] = (const float*)d_in[i];
    a.out = (float*)d_out; a.ws = (unsigned char*)d_ws;
#if MK_SPLIT
    for (int ph = 0; ph < NPHASE; ++ph) { a.ph_lo = ph; a.ph_hi = ph + 1; hipLaunchKernelGGL(hybrid_fwd, dim3(grid), dim3(NWAVES * 64), LDS_BYTES, stream, a); }
#else
    a.ph_lo = 0; a.ph_hi = NPHASE;
    hipLaunchKernelGGL(hybrid_fwd, dim3(grid), dim3(NWAVES * 64), LDS_BYTES, stream, a);
#endif
}
```

```cpp
#include <hip/hip_runtime.h>
#include <cstdio>
#include <cstdint>

#ifndef PROBE_REP
#define PROBE_REP 0
#endif
#define NREP(k) (1 + ((PROBE_REP >> (k)) & 1))
#ifndef PROBE2
#define PROBE2 0
#endif
#define NREP2(j) (1 + ((PROBE2 >> (j)) & 1))
#ifndef MK_SPLIT
#define MK_SPLIT 0
#endif

constexpr int DM = 1024, WMIX = 512, NPB = 8, SEQ = 2048, NSB = 128, DSEQ = 4;
constexpr int MP = NPB * SEQ, MS = NSB * DSEQ, M = MP + MS;
constexpr int FF = 2816, INC = 8192, ZC = 3072, YC = 2048, GC = 4096;
constexpr float LN_EPS = 1e-5f, ALPHA = 1.41421356237f;
constexpr size_t O_Y = 0, O_PH = (size_t)M * DM, O_PRGC = O_PH + 8192, O_PCF = O_PRGC + 24576, O_PPOOL = O_PCF + 245760, O_PSC = O_PPOOL + 122880,
                 O_SH = O_PSC + 16384, O_SRGC = O_SH + 131072, O_SCF = O_SRGC + 393216, O_SPOOL = O_SCF + 3932160, O_SSC = O_SPOOL + 1966080, O_END = O_SSC + 262144;
static_assert(O_END == 24403968, "output map");

__device__ __forceinline__ int opqv(int v) { asm volatile("" : "+v"(v)); return v; }
__device__ __forceinline__ int lane_now() { int l; asm volatile("v_mbcnt_lo_u32_b32 %0, -1, 0\n\tv_mbcnt_hi_u32_b32 %0, -1, %0" : "=v"(l)); return l; }
__device__ __forceinline__ int opqs(int v) { asm volatile("" : "+s"(v)); return v; }
namespace pg8 {
#define PG8_LAS __attribute__((address_space(3)))
typedef unsigned short bf16_t;
typedef short bf16x8 __attribute__((ext_vector_type(8)));
typedef float f32x4 __attribute__((ext_vector_type(4)));
typedef float f32x2 __attribute__((ext_vector_type(2)));
typedef unsigned u32x4 __attribute__((ext_vector_type(4)));
typedef unsigned u32x2 __attribute__((ext_vector_type(2)));
typedef _Float16 f16x4 __attribute__((ext_vector_type(4)));
typedef _Float16 f16x8 __attribute__((ext_vector_type(8)));
constexpr int BM = 256, BK = 64, HALF = 128, HTB = HALF * BK * 2, STAGE_BYTES = 8 * HTB, NXCD = 8, WGM = 8;

__host__ __device__ __forceinline__ int lds_byte(int r, int c) { const int st = (r >> 4) * 2 + (c >> 5), rr = r & 15, cc = c & 31, ob = rr * 64 + cc * 2; return st * 1024 + (ob ^ (((ob >> 9) & 1) << 5)); }
__host__ __device__ __forceinline__ void stage_rc(int b, int& R, int& C) { const int st = b / 1024, sb = b % 1024, swz = sb ^ (((sb >> 9) & 1) << 5); R = (st >> 1) * 16 + swz / 64; C = (st & 1) * 32 + (swz % 64) / 2; }
__host__ __device__ __forceinline__ int perm32(int rho) { const int n = rho >> 4, i = rho & 15; return 8 * (i >> 2) + 4 * n + (i & 3); }

struct Unit { int pm, pn, nt, mode, aux; long offA, offB; };
struct Gemm { const bf16_t* A; const bf16_t* Bt; int lda, ldb; };

enum { SK_PLAIN = 0, SK_P3 = 1, SK_P4 = 2, SK_P6 = 3 };
struct UnitOrder {
    int kind, nN, nwgP, nS, ntP, G, c; long offA_s;
    __device__ __forceinline__ void init(int kind_, int N_, int K_, int G_, int c_, long offA_s_, bool prompt = true, bool sample = true) { kind = kind_; nN = N_ / BM; nwgP = prompt ? 64 * nN : 0; ntP = K_ / BK; G = G_; c = c_; offA_s = offA_s_;
        nS = !sample ? 0 : kind_ == SK_PLAIN ? 2 * nN : kind_ == SK_P3 ? 32 : kind_ == SK_P4 ? 128 : 88; }
    __device__ __forceinline__ bool next(int i, Unit& u, const Gemm& g) const {
        const long L = (long)i * G + c; const long ra = (long)BM * g.lda * 2, rb = (long)BM * g.ldb * 2;
        if (L < nwgP) {
            int wgid = (int)L; { const int q = nwgP / NXCD, xcd = wgid % NXCD, off = wgid / NXCD; wgid = xcd * q + off; }
            const int nig = WGM * nN; u.pm = (wgid / nig) * WGM + ((wgid % nig) % WGM); u.pn = (wgid % nig) / WGM;
            u.nt = ntP; u.mode = 0; u.aux = 0; u.offA = u.pm * ra; u.offB = u.pn * rb; return true; }
        const int s = (int)(L - nwgP); if (s >= nS) return false;
        if (kind == SK_PLAIN) { u.pm = 64 + (s & 1); u.pn = s >> 1; u.nt = ntP; u.mode = 0; u.aux = 0; u.offA = u.pm * ra; u.offB = u.pn * rb; }
        else if (kind == SK_P3) { const int n = s & 3, tile = s >> 2; u.pm = 64 + (tile & 1); u.pn = tile >> 1; u.nt = 8; u.mode = 1; u.aux = n; u.offA = u.pm * ra + 1024 * n; u.offB = u.pn * rb + 1024 * n; }
        else if (kind == SK_P4) { const int ch = s & 15, tile = s >> 4, n = ch >> 2, kin = (ch & 3) * 256; u.pm = 64 + (tile & 1); u.pn = tile >> 1; u.nt = 4; u.mode = 1; u.aux = ch;
            u.offA = offA_s + ((long)(n * 512 + (u.pm - 64) * 256) * 1024 + kin) * 2; u.offB = u.pn * rb + kin * 2; }
        else { const int ch = s % 11, tile = s / 11; u.pm = 64 + (tile & 1); u.pn = tile >> 1; u.nt = 4; u.mode = 1; u.aux = ch; u.offA = u.pm * ra + 512 * ch; u.offB = u.pn * rb + 512 * ch; }
        return true;
    }
};

__device__ __forceinline__ unsigned cvt_pk_bf16(float lo, float hi) { unsigned r; asm volatile("v_cvt_pk_bf16_f32 %0, %1, %2" : "=v"(r) : "v"(lo), "v"(hi)); return r; }
__device__ __forceinline__ float sigmoidf_fast(float x) { return __builtin_amdgcn_rcpf(1.0f + __builtin_amdgcn_exp2f(-1.44269504089f * x)); }
__device__ __forceinline__ float gelu_tanh(float x) { const float t = x * x, y = x * fmaf(t, -0.10294324f, -2.3022082f); return x * __builtin_amdgcn_rcpf(1.0f + __builtin_amdgcn_exp2f(y)); }

__device__ __forceinline__ void acc_zero(f32x4 (&acc)[2][2][4][2]) {
#pragma unroll
    for (int a = 0; a < 2; ++a)
#pragma unroll
        for (int b = 0; b < 2; ++b)
#pragma unroll
            for (int m = 0; m < 4; ++m)
#pragma unroll
                for (int n = 0; n < 2; ++n) acc[a][b][m][n] = (f32x4){0.f, 0.f, 0.f, 0.f};
}
__device__ __forceinline__ float* state_ptr(float* out, int R, int keep, int layer, size_t p_off, size_t s_off) {
    if (R < MP) { const int b = R >> 11, j = (R & 2047) - (2048 - keep); return j < 0 ? nullptr : out + p_off + (size_t)((layer * 8 + b) * keep + j) * 512; }
    const int s = (R - MP) >> 2, j = (R & 3) + keep - 4; return j < 0 ? nullptr : out + s_off + (size_t)((layer * 128 + s) * keep + j) * 512;
}

struct EpiMix {
    static constexpr bool PERM = true, MIDK = false;
    __device__ __forceinline__ void init(f32x4 (&acc)[2][2][4][2], const Unit&, int, int) const { acc_zero(acc); }
    bf16_t* Z; float* out; int layer;
    __device__ __forceinline__ void midk(f32x4 (&)[2][2][4][2], const Unit&, int, int, int, int, int) const {}
    __device__ __forceinline__ void operator()(f32x4 (&acc)[2][2][4][2], const Unit& u, int wr, int wc, int fr_, int fq_) const {
        const int lane_ = lane_now(), fr = lane_ & 15, fq = lane_ >> 4; (void)fr_; (void)fq_;
        const int pn = u.pn; int type, zcol, keep = 0, scol = 0; size_t poff = 0, soff = 0;
        if (pn < 2) { type = 0; zcol = 256 * pn; keep = 3; scol = zcol; poff = O_PRGC; soff = O_SRGC; }
        else if (pn < 4) { type = 1; zcol = 512 + 256 * (pn - 2); }
        else if (pn < 8) { type = 2; zcol = 1024 + 128 * (pn - 4); keep = 30; scol = 128 * (pn - 4); poff = O_PCF; soff = O_SCF; }
        else if (pn < 10) { type = 0; zcol = 1536 + 256 * (pn - 8); keep = 15; scol = 256 * (pn - 8); poff = O_PPOOL; soff = O_SPOOL; }
        else if (pn < 12) { type = 0; zcol = 2048 + 256 * (pn - 10); }
        else { type = 3; zcol = 2560 + 128 * (pn - 12); keep = 2; scol = 128 * (pn - 12); poff = O_PSC; soff = O_SSC; }
        const bool tail = keep != 0 && (u.pm >= 64 || (u.pm & 7) == 7);
        const int row0 = u.pm * BM + wr * 64 + fr, cl = wc * 32 + 8 * fq;
        if (type < 2) {
#pragma unroll
            for (int ai = 0; ai < 2; ++ai)
#pragma unroll
                for (int m = 0; m < 4; ++m) { const int R = row0 + ai * HALF + m * 16; bf16_t* rowp = Z + (size_t)R * ZC + zcol + cl;
                    float* sp = tail ? state_ptr(out, R, keep, layer, poff, soff) : nullptr;
#pragma unroll
                    for (int bj = 0; bj < 2; ++bj) { f32x4 v0 = acc[ai][bj][m][0], v1 = acc[ai][bj][m][1];
                        if (type == 1) { v0 = (f32x4){gelu_tanh(v0[0]), gelu_tanh(v0[1]), gelu_tanh(v0[2]), gelu_tanh(v0[3])}; v1 = (f32x4){gelu_tanh(v1[0]), gelu_tanh(v1[1]), gelu_tanh(v1[2]), gelu_tanh(v1[3])}; }
                        u32x4 w; w.x = cvt_pk_bf16(v0[0], v0[1]); w.y = cvt_pk_bf16(v0[2], v0[3]); w.z = cvt_pk_bf16(v1[0], v1[1]); w.w = cvt_pk_bf16(v1[2], v1[3]);
                        *(u32x4*)(rowp + bj * HALF) = w;
                        if (sp) { *(f32x4*)(sp + scol + cl + bj * HALF) = v0; *(f32x4*)(sp + scol + cl + bj * HALF + 4) = v1; } } }
        } else {
#pragma unroll
            for (int ai = 0; ai < 2; ++ai)
#pragma unroll
                for (int m = 0; m < 4; ++m) { const int R = row0 + ai * HALF + m * 16; bf16_t* rowp = Z + (size_t)R * ZC + zcol + cl;
                    float* sp = tail ? state_ptr(out, R, keep, layer, poff, soff) : nullptr;
                    f32x4 v0, v1; const f32x4 a0 = acc[ai][0][m][0], a1 = acc[ai][0][m][1], b0 = acc[ai][1][m][0], b1 = acc[ai][1][m][1];
                    if (type == 2) {
#pragma unroll
                        for (int i = 0; i < 4; ++i) { v0[i] = a0[i] * sigmoidf_fast(b0[i]); v1[i] = a1[i] * sigmoidf_fast(b1[i]); }
                    } else { v0 = a0 * b0; v1 = a1 * b1; }
                    u32x4 w; w.x = cvt_pk_bf16(v0[0], v0[1]); w.y = cvt_pk_bf16(v0[2], v0[3]); w.z = cvt_pk_bf16(v1[0], v1[1]); w.w = cvt_pk_bf16(v1[2], v1[3]);
                    *(u32x4*)rowp = w;
                    if (sp) { *(f32x4*)(sp + scol + cl) = v0; *(f32x4*)(sp + scol + cl + 4) = v1; } }
        }
    }
};

struct EpiGate {
    static constexpr bool PERM = true, MIDK = false;
    __device__ __forceinline__ void init(f32x4 (&acc)[2][2][4][2], const Unit&, int, int) const { acc_zero(acc); }
    _Float16* G;
    __device__ __forceinline__ void midk(f32x4 (&)[2][2][4][2], const Unit&, int, int, int, int, int) const {}
    __device__ __forceinline__ void operator()(f32x4 (&acc)[2][2][4][2], const Unit& u, int wr, int wc, int fr_, int fq_) const {
        const int lane_ = lane_now(), fr = lane_ & 15, fq = lane_ >> 4; (void)fr_; (void)fq_;
        const int row0 = u.pm * BM + wr * 64 + fr, ch0 = 64 * u.pn + 16 * wc + 4 * fq; const bool plain = u.pm >= 64;
#pragma unroll
        for (int ai = 0; ai < 2; ++ai)
#pragma unroll
            for (int m = 0; m < 4; ++m) { const int R = row0 + ai * HALF + m * 16; _Float16* gp = G + (size_t)R * GC + ch0;
                f16x4 r0, r1, r2, g3;
#pragma unroll
                for (int i = 0; i < 4; ++i) {
                    const float d0 = 1.f + __builtin_amdgcn_exp2f(__builtin_amdgcn_fmed3f(acc[ai][0][m][0][i], -15.f, 15.f)), d1 = 1.f + __builtin_amdgcn_exp2f(__builtin_amdgcn_fmed3f(acc[ai][0][m][1][i], -15.f, 15.f));
                    const float d2 = 1.f + __builtin_amdgcn_exp2f(__builtin_amdgcn_fmed3f(acc[ai][1][m][0][i], -15.f, 15.f)), d3 = 1.f + __builtin_amdgcn_exp2f(__builtin_amdgcn_fmed3f(acc[ai][1][m][1][i], -15.f, 15.f));
                    const float i0 = __builtin_amdgcn_rcpf(d0), i1 = __builtin_amdgcn_rcpf(d1), i2 = __builtin_amdgcn_rcpf(d2), i3 = __builtin_amdgcn_rcpf(d3);
                    if (plain) { r0[i] = (_Float16)i0; r1[i] = (_Float16)i1; r2[i] = (_Float16)i2; }
                    else { r0[i] = (_Float16)(d1 * i0); r1[i] = (_Float16)(d2 * i1); r2[i] = (_Float16)(d3 * i2); }
                    g3[i] = (_Float16)i3; }
                *(f16x4*)(gp) = r0; *(f16x4*)(gp + 1024) = r1; *(f16x4*)(gp + 2048) = r2; *(f16x4*)(gp + 3072) = g3; }
    }
};

struct EpiMerge {
    static constexpr bool PERM = true, MIDK = true;
    __device__ __forceinline__ void init(f32x4 (&acc)[2][2][4][2], const Unit&, int, int) const { acc_zero(acc); }
    const _Float16* G; bf16_t* O; bf16_t* Os;
    __device__ __forceinline__ void scale(f32x4 (&acc)[2][2][4][2], const Unit& u, int seg, int wr, int wc) const {
        const int lane_ = lane_now(), fr = lane_ & 15, fq = lane_ >> 4;
        const int row0 = u.pm * BM + wr * 64 + fr, c0 = 1024 * seg + 256 * u.pn + wc * 32 + 8 * fq;
#pragma unroll
        for (int ai = 0; ai < 2; ++ai)
#pragma unroll
            for (int m = 0; m < 4; ++m) { const _Float16* gp = G + (size_t)(row0 + ai * HALF + m * 16) * GC + c0;
#pragma unroll
                for (int bj = 0; bj < 2; ++bj) { const f16x8 f = *(const f16x8*)(gp + bj * HALF);
                    acc[ai][bj][m][0] *= (f32x4){(float)f[0], (float)f[1], (float)f[2], (float)f[3]}; acc[ai][bj][m][1] *= (f32x4){(float)f[4], (float)f[5], (float)f[6], (float)f[7]}; } }
    }
    __device__ __forceinline__ void midk(f32x4 (&acc)[2][2][4][2], const Unit& u, int seg, int wr, int wc, int, int) const { scale(acc, u, seg, wr, wc); }
    __device__ __forceinline__ void operator()(f32x4 (&acc)[2][2][4][2], const Unit& u, int wr, int wc, int, int) const {
        scale(acc, u, u.mode ? u.aux : 3, wr, wc);
        const int lane_ = lane_now(), fr = lane_ & 15, fq = lane_ >> 4;
        const int row0 = (u.mode ? (u.pm - 64) * BM + 512 * u.aux : u.pm * BM) + wr * 64 + fr, c0 = 256 * u.pn + wc * 32 + 8 * fq;
        bf16_t* O = u.mode ? Os : this->O;
#pragma unroll
        for (int ai = 0; ai < 2; ++ai)
#pragma unroll
            for (int m = 0; m < 4; ++m) { bf16_t* rowp = O + (size_t)(row0 + ai * HALF + m * 16) * DM + c0;
#pragma unroll
                for (int bj = 0; bj < 2; ++bj) { const f32x4 v0 = acc[ai][bj][m][0], v1 = acc[ai][bj][m][1];
                    u32x4 w; w.x = cvt_pk_bf16(v0[0], v0[1]); w.y = cvt_pk_bf16(v0[2], v0[3]); w.z = cvt_pk_bf16(v1[0], v1[1]); w.w = cvt_pk_bf16(v1[2], v1[3]); *(u32x4*)(rowp + bj * HALF) = w; } }
    }
};

struct PanelStats {
    unsigned* xbuf;
    unsigned* cnt;
    __device__ __forceinline__ void run(const f32x4 (&v)[2][2][4][2], const Unit& u, int wr, int wc, PG8_LAS unsigned char* lds, int wid) const {
        const int lane = lane_now(), fr = lane & 15, fq = lane >> 4;
        PG8_LAS f32x2* P = (PG8_LAS f32x2*)lds;
        PG8_LAS f32x2* S = (PG8_LAS f32x2*)(lds + 8192);
#pragma unroll
        for (int ai = 0; ai < 2; ++ai)
#pragma unroll
            for (int m = 0; m < 4; ++m) {
                float s = 0.f;
#pragma unroll
                for (int bj = 0; bj < 2; ++bj)
#pragma unroll
                    for (int n = 0; n < 2; ++n) { const f32x4 x = v[ai][bj][m][n]; s += (x[0] + x[1]) + (x[2] + x[3]); }
                s += __builtin_bit_cast(float, __builtin_amdgcn_ds_bpermute((lane ^ 16) << 2, __builtin_bit_cast(int, s))); s += __builtin_bit_cast(float, __builtin_amdgcn_ds_bpermute((lane ^ 32) << 2, __builtin_bit_cast(int, s)));
                const float mw = s * (1.0f / 64.0f); float q = 0.f;
#pragma unroll
                for (int bj = 0; bj < 2; ++bj)
#pragma unroll
                    for (int n = 0; n < 2; ++n) { const f32x4 d = v[ai][bj][m][n] - mw; q += (d[0] * d[0] + d[1] * d[1]) + (d[2] * d[2] + d[3] * d[3]); }
                q += __builtin_bit_cast(float, __builtin_amdgcn_ds_bpermute((lane ^ 16) << 2, __builtin_bit_cast(int, q))); q += __builtin_bit_cast(float, __builtin_amdgcn_ds_bpermute((lane ^ 32) << 2, __builtin_bit_cast(int, q)));
                if (fq == 0) P[(ai * HALF + wr * 64 + m * 16 + fr) * 4 + wc] = (f32x2){mw, q};
            }
        asm volatile("s_waitcnt lgkmcnt(0)" ::: "memory"); __builtin_amdgcn_s_barrier(); asm volatile("" ::: "memory");
        const int row = wid * 32 + (lane & 31);
        if (lane < 32) {
            const f32x2 a = P[row * 4 + 0], b = P[row * 4 + 1], c = P[row * 4 + 2], d = P[row * 4 + 3];
            const float mt = (a.x + b.x + c.x + d.x) * 0.25f;
            const float da = a.x - mt, db = b.x - mt, dc = c.x - mt, dd = d.x - mt;
            const float m2 = (a.y + b.y) + (c.y + d.y) + 64.0f * ((da * da + db * db) + (dc * dc + dd * dd));
            unsigned long long* slot = (unsigned long long*)xbuf + ((size_t)(u.pm * BM + row) * 4 + u.pn);
            __hip_atomic_store(slot, ((unsigned long long)__float_as_uint(m2) << 32) | __float_as_uint(mt), __ATOMIC_RELAXED, __HIP_MEMORY_SCOPE_AGENT);
        }
        asm volatile("s_waitcnt vmcnt(0)" ::: "memory");
        if (lane == 0) __hip_atomic_fetch_add(cnt + 64 * u.pm, 1u, __ATOMIC_RELAXED, __HIP_MEMORY_SCOPE_AGENT);
        if (wid == 0) {
            unsigned spins = 0;
            while ((unsigned)__builtin_amdgcn_readfirstlane(__hip_atomic_load(cnt + 64 * u.pm, __ATOMIC_RELAXED, __HIP_MEMORY_SCOPE_AGENT)) < 32u) { __builtin_amdgcn_s_sleep(2); if (++spins > (1u << 20)) break; }
            __builtin_amdgcn_fence(__ATOMIC_ACQUIRE, "agent");
        }
        asm volatile("s_waitcnt vmcnt(0) lgkmcnt(0)" ::: "memory"); __builtin_amdgcn_s_barrier(); asm volatile("" ::: "memory");
        if (lane < 32) {
            const unsigned long long* slot = (const unsigned long long*)xbuf + (size_t)(u.pm * BM + row) * 4; float mt[4], m2[4]; float ms = 0.f;
#pragma unroll
            for (int t = 0; t < 4; ++t) { const unsigned long long w = __hip_atomic_load(slot + t, __ATOMIC_RELAXED, __HIP_MEMORY_SCOPE_AGENT); mt[t] = __uint_as_float((unsigned)w); m2[t] = __uint_as_float((unsigned)(w >> 32)); ms += mt[t]; }
            const float mean = ms * 0.25f; float q = 0.f;
#pragma unroll
            for (int t = 0; t < 4; ++t) { const float dm = mt[t] - mean; q += m2[t] + 256.0f * dm * dm; }
            S[row] = (f32x2){mean, __builtin_amdgcn_rsqf(q * (1.0f / 1024.0f) + LN_EPS)};
        }
        asm volatile("s_waitcnt lgkmcnt(0)" ::: "memory"); __builtin_amdgcn_s_barrier(); asm volatile("" ::: "memory");
    }
};
struct EpiRes {
    static constexpr bool PERM = false, MIDK = false;
    __device__ __forceinline__ void init(f32x4 (&acc)[2][2][4][2], const Unit& u, int wr, int wc) const {
        if (u.mode) { acc_zero(acc); return; }
        const int lane_ = lane_now(), fr = lane_ & 15, fq = lane_ >> 4;
        const float* bp0 = baseP + (size_t)(u.pm * BM + wr * 64 + fr) * DM + 256 * u.pn + wc * 32 + 4 * fq;
#pragma unroll
        for (int ai = 0; ai < 2; ++ai)
#pragma unroll
            for (int m = 0; m < 4; ++m)
#pragma unroll
                for (int bj = 0; bj < 2; ++bj)
#pragma unroll
                    for (int n = 0; n < 2; ++n) acc[ai][bj][m][n] = *(const f32x4*)(bp0 + (size_t)(ai * HALF + m * 16) * DM + bj * HALF + n * 16) * ALPHA;
    }
    const float* baseP; float* out; bf16_t* xb; const float* lng; const float* lnb; float* slab; PanelStats st; PG8_LAS unsigned char* xlds; int wid;
    __device__ __forceinline__ void midk(f32x4 (&)[2][2][4][2], const Unit&, int, int, int, int, int) const {}
    __device__ __forceinline__ void operator()(f32x4 (&acc)[2][2][4][2], const Unit& u, int wr, int wc, int fr_, int fq_) const {
        const int lane_ = lane_now(), fr = lane_ & 15, fq = lane_ >> 4; (void)fr_; (void)fq_;
        const int row0 = u.pm * BM + wr * 64 + fr, c0 = 256 * u.pn + wc * 32 + 4 * fq;
        if (u.mode) {
#pragma unroll
            for (int ai = 0; ai < 2; ++ai)
#pragma unroll
                for (int m = 0; m < 4; ++m) { float* op = slab + ((size_t)u.aux * 512 + (row0 - MP) + ai * HALF + m * 16) * DM + c0;
#pragma unroll
                    for (int bj = 0; bj < 2; ++bj)
#pragma unroll
                        for (int n = 0; n < 2; ++n) *(f32x4*)(op + bj * HALF + n * 16) = acc[ai][bj][m][n]; }
            return; }
        st.run(acc, u, wr, wc, xlds, wid);
        const PG8_LAS f32x2* S = (const PG8_LAS f32x2*)(xlds + 8192);
#pragma unroll
        for (int bj = 0; bj < 2; ++bj)
#pragma unroll
            for (int n = 0; n < 2; ++n) { const int cc = c0 + bj * HALF + n * 16; const f32x4 gv = *(const f32x4*)(lng + cc), bv = *(const f32x4*)(lnb + cc);
#pragma unroll
                for (int ai = 0; ai < 2; ++ai)
#pragma unroll
                    for (int m = 0; m < 4; ++m) { const int r = ai * HALF + wr * 64 + m * 16 + fr; const f32x2 sr = S[r]; const size_t off = (size_t)(u.pm * BM + r) * DM + cc;
                        const f32x4 o = (acc[ai][bj][m][n] - sr.x) * sr.y * gv + bv; *(f32x4*)(out + off) = o;
                        if (xb) { u32x2 w; w.x = cvt_pk_bf16(o[0], o[1]); w.y = cvt_pk_bf16(o[2], o[3]); *(u32x2*)(xb + off) = w; }
                        if (m & 1) asm volatile("" ::: "memory"); } }
    }
};

struct EpiSwi {
    static constexpr bool PERM = true, MIDK = false;
    __device__ __forceinline__ void init(f32x4 (&acc)[2][2][4][2], const Unit&, int, int) const { acc_zero(acc); }
    bf16_t* H;
    __device__ __forceinline__ void midk(f32x4 (&)[2][2][4][2], const Unit&, int, int, int, int, int) const {}
    __device__ __forceinline__ void operator()(f32x4 (&acc)[2][2][4][2], const Unit& u, int wr, int wc, int fr_, int fq_) const {
        const int lane_ = lane_now(), fr = lane_ & 15, fq = lane_ >> 4; (void)fr_; (void)fq_;
        const int row0 = u.pm * BM + wr * 64 + fr, c0 = 128 * u.pn + wc * 32 + 8 * fq;
#pragma unroll
        for (int ai = 0; ai < 2; ++ai)
#pragma unroll
            for (int m = 0; m < 4; ++m) { bf16_t* rowp = H + (size_t)(row0 + ai * HALF + m * 16) * FF + c0;
                const f32x4 g0 = acc[ai][0][m][0], g1 = acc[ai][0][m][1], u0 = acc[ai][1][m][0], u1 = acc[ai][1][m][1]; f32x4 v0, v1;
#pragma unroll
                for (int i = 0; i < 4; ++i) { v0[i] = g0[i] * sigmoidf_fast(g0[i]) * u0[i]; v1[i] = g1[i] * sigmoidf_fast(g1[i]) * u1[i]; }
                u32x4 w; w.x = cvt_pk_bf16(v0[0], v0[1]); w.y = cvt_pk_bf16(v0[2], v0[3]); w.z = cvt_pk_bf16(v1[0], v1[1]); w.w = cvt_pk_bf16(v1[2], v1[3]);
                *(u32x4*)rowp = w; }
    }
};

template <class Epi, class Sched, bool ALIGN_EPI>
__device__ __forceinline__ void gemm_phase(PG8_LAS unsigned char* lds, const Gemm g, const Sched& S, const Epi& E, int wave_id) {
    const int wid = opqs(wave_id), lane = lane_now(), tid = wid * 64 + lane, wr = wid >> 2, wc = wid & 3, fr = lane & 15, fq = lane >> 4;
    unsigned voffA[2], voffB[2];
#pragma unroll
    for (int i = 0; i < 2; ++i) { int R, C; stage_rc(tid * 16 + i * 8192, R, C); const int Rb = Epi::PERM ? ((R & ~31) + perm32(R & 31)) : R;
        voffA[i] = (unsigned)(R * g.lda + C) * 2u; voffB[i] = (unsigned)(Rb * g.ldb + C) * 2u; }
    const size_t kstep = (size_t)(BK * 2);
    const size_t hstepA = (size_t)HALF * g.lda * 2, hstepB = (size_t)HALF * g.ldb * 2;
    const unsigned ldsw = (unsigned)wid * 1024u;
    const int aoff = lds_byte(wr * 64 + fr, fq * 8), boff = lds_byte(wc * 32 + fr, fq * 8);
#define PG8_SA(b, h) (((b) * 2 + (h)) * HTB)
#define PG8_SB(b, h) ((4 + (b) * 2 + (h)) * HTB)
#define PG8_STAGE(bufoff, gbase, voff) do { _Pragma("unroll") for (int _i = 0; _i < 2; ++_i) \
        __builtin_amdgcn_global_load_lds((const unsigned*)((const char*)(gbase) + (voff)[_i]), (PG8_LAS unsigned*)(lds + (bufoff) + ldsw + _i * 8192), 16, 0, 0); } while (0)
#define PG8_LDA(dst, b, h) do { _Pragma("unroll") for (int m = 0; m < 4; ++m) _Pragma("unroll") for (int k = 0; k < 2; ++k) dst[m][k] = *(const PG8_LAS bf16x8*)(lds + PG8_SA(b, h) + aoff + m * 2048 + k * 1024); } while (0)
#define PG8_LDB(dst, b, h) do { _Pragma("unroll") for (int n = 0; n < 2; ++n) _Pragma("unroll") for (int k = 0; k < 2; ++k) dst[n][k] = *(const PG8_LAS bf16x8*)(lds + PG8_SB(b, h) + boff + n * 2048 + k * 1024); } while (0)
#define PG8_MMA(ai, bj, At, Bt) do { __builtin_amdgcn_s_setprio(1); _Pragma("unroll") for (int m = 0; m < 4; ++m) _Pragma("unroll") for (int n = 0; n < 2; ++n) _Pragma("unroll") for (int k = 0; k < 2; ++k) \
        acc[ai][bj][m][n] = __builtin_amdgcn_mfma_f32_16x16x32_bf16(Bt[n][k], At[m][k], acc[ai][bj][m][n], 0, 0, 0); __builtin_amdgcn_s_setprio(0); } while (0)
#define PG8_WAIT_V(n) asm volatile("s_waitcnt vmcnt(" #n ")" ::: "memory")
#define PG8_WAIT_L(n) asm volatile("s_waitcnt lgkmcnt(" #n ")" ::: "memory")
#define PG8_BAR __builtin_amdgcn_s_barrier()
#define PG8_SCHED __builtin_amdgcn_sched_barrier(0)
    Unit cur, nxt; int ui = 0;
    if (!S.next(0, cur, g)) return;
    f32x4 acc[2][2][4][2];
    E.init(acc, cur, wr, wc);
    bf16x8 At[4][2], B0[2][2], B1[2][2];
    const char* cA = (const char*)g.A + cur.offA; const char* cB = (const char*)g.Bt + cur.offB;
    PG8_STAGE(PG8_SB(0, 0), cB, voffB); PG8_STAGE(PG8_SB(0, 1), cB + hstepB, voffB); PG8_STAGE(PG8_SA(0, 0), cA, voffA); PG8_STAGE(PG8_SA(0, 1), cA + hstepA, voffA);
    if (wr == 1) PG8_BAR;
    PG8_WAIT_V(2); PG8_BAR;
    PG8_STAGE(PG8_SB(1, 0), cB + kstep, voffB); PG8_STAGE(PG8_SA(1, 0), cA + kstep, voffA); PG8_STAGE(PG8_SB(1, 1), cB + hstepB + kstep, voffB);
    PG8_WAIT_V(6); PG8_BAR;
    for (;;) {
        const bool has_next = S.next(ui + 1, nxt, g);
        const char* nA = has_next ? (const char*)g.A + nxt.offA : cA; const char* nB = has_next ? (const char*)g.Bt + nxt.offB : cB;
        const int nt = cur.nt, TSEG = Epi::MIDK ? 8 : nt;
        for (int t0 = 0; t0 < nt; t0 += TSEG) {
        if constexpr (Epi::MIDK) { if (t0 != 0) { PG8_SCHED; E.midk(acc, cur, t0 / TSEG - 1, wr, wc, 0, 0); PG8_SCHED; } }
#pragma unroll 1
        for (int t = t0; t < t0 + TSEG; t += 2) {
            const bool last = (t == nt - 2);
            const char* a1 = cA + (size_t)(t + 1) * kstep;
            const char* a2 = last ? nA : cA + (size_t)(t + 2) * kstep; const char* b2 = last ? nB : cB + (size_t)(t + 2) * kstep;
            const char* a3 = a2 + kstep; const char* b3 = b2 + kstep;
            PG8_LDB(B0, 0, 0); PG8_LDB(B1, 0, 1); PG8_SCHED; PG8_LDA(At, 0, 0); PG8_STAGE(PG8_SA(1, 1), a1 + hstepA, voffA);
            PG8_WAIT_V(8); PG8_WAIT_L(0); PG8_BAR; PG8_MMA(0, 0, At, B0); PG8_MMA(0, 1, At, B1); PG8_BAR; PG8_SCHED;
            PG8_LDA(At, 0, 1); PG8_STAGE(PG8_SB(0, 0), b2, voffB); PG8_STAGE(PG8_SB(0, 1), b2 + hstepB, voffB); PG8_STAGE(PG8_SA(0, 0), a2, voffA);
            PG8_WAIT_V(8); PG8_WAIT_L(0); PG8_BAR; PG8_MMA(1, 0, At, B0); PG8_MMA(1, 1, At, B1); PG8_BAR; PG8_SCHED;
            PG8_LDB(B0, 1, 0); PG8_LDB(B1, 1, 1); PG8_SCHED; PG8_LDA(At, 1, 0); PG8_STAGE(PG8_SA(0, 1), a2 + hstepA, voffA);
            PG8_WAIT_V(8); PG8_WAIT_L(0); PG8_BAR; PG8_MMA(0, 0, At, B0); PG8_MMA(0, 1, At, B1); PG8_BAR; PG8_SCHED;
            PG8_LDA(At, 1, 1); PG8_STAGE(PG8_SB(1, 0), b3, voffB); PG8_STAGE(PG8_SB(1, 1), b3 + hstepB, voffB); PG8_STAGE(PG8_SA(1, 0), a3, voffA);
            PG8_WAIT_V(8); PG8_WAIT_L(0); PG8_BAR; PG8_MMA(1, 0, At, B0); PG8_MMA(1, 1, At, B1); PG8_BAR; PG8_SCHED;
        }
        }
        if constexpr (ALIGN_EPI) { if (wr == 0) PG8_BAR; }
        E(acc, cur, wr, wc, 0, 0);
        if (!has_next) break;
        cur = nxt; cA = nA; cB = nB; ++ui;
        E.init(acc, cur, wr, wc);
        if constexpr (ALIGN_EPI) { if (wr == 1) PG8_BAR; }
    }
    PG8_WAIT_V(0);
    if constexpr (!ALIGN_EPI) { if (wr == 0) PG8_BAR; }
    PG8_BAR;
#undef PG8_SA
#undef PG8_SB
#undef PG8_STAGE
#undef PG8_LDA
#undef PG8_LDB
#undef PG8_MMA
#undef PG8_WAIT_V
#undef PG8_WAIT_L
#undef PG8_BAR
#undef PG8_SCHED
}
}

constexpr int NWAVES = 8;
constexpr int NPHASE = 19;
constexpr size_t MiB = 1u << 20;
constexpr size_t WS_CTL = 0, CTL_ZERO_BYTES = 1 * MiB;
constexpr size_t WS_WA = 1 * MiB;
constexpr size_t WS_XB = 18 * MiB;
constexpr size_t WS_Y = 51 * MiB;
constexpr size_t WS_ZG = 117 * MiB;
constexpr size_t WS_BT3 = 249 * MiB, WS_BT4 = 253 * MiB, WS_BT5 = WS_WA, WS_BT6 = WS_ZG + 108 * MiB;
constexpr size_t WS_MB4S = WS_WA + 13 * MiB;
constexpr size_t WS_SLAB = WS_Y;
constexpr size_t WS_END = 255 * MiB;
static_assert(WS_XB + (size_t)M * DM * 2 <= WS_Y && WS_Y + (size_t)M * YC * 2 <= WS_ZG && WS_ZG + (size_t)M * GC * 2 <= WS_BT3 && WS_SLAB + (size_t)16 * 512 * DM * 4 <= WS_Y + 40 * MiB && WS_Y + 40 * MiB + 4 * 512 * 1024 <= WS_ZG, "ws map");
static_assert((size_t)M * FF * 2 <= 108 * MiB && WS_BT5 + (size_t)2 * FF * DM * 2 <= WS_MB4S && WS_MB4S + 4 * MiB <= WS_XB && WS_BT6 + (size_t)DM * FF * 2 <= WS_BT3, "ws map 2");
constexpr int CW_TMO = 0, CW_CODE = 1, CW_BAR = 4096, CW_SEAM = 16384, SEAM_BANK = 8192;
constexpr size_t WS_XCH = WS_Y + 40 * MiB;
constexpr int XLDS_OFF = 131072 + 1024;
constexpr int RING_OFF = 0, RING_BYTES = 131072;
constexpr int LDSCTL_OFF = RING_BYTES, MISC_OFF = LDSCTL_OFF + 320;
constexpr int LDS_BYTES = 147456;

#define GAS __attribute__((address_space(1)))
#define LAS __attribute__((address_space(3)))
typedef unsigned short bf16;
typedef unsigned v4u __attribute__((ext_vector_type(4)));
typedef unsigned v2u __attribute__((ext_vector_type(2)));
typedef float f32x4 __attribute__((ext_vector_type(4)));
typedef float f32x2 __attribute__((ext_vector_type(2)));
typedef short bf16x8 __attribute__((ext_vector_type(8)));
typedef GAS unsigned gu32;
#define RLX_AGENT __ATOMIC_RELAXED, __HIP_MEMORY_SCOPE_AGENT
#define LDS_WAIT() asm volatile("s_waitcnt lgkmcnt(0)" ::: "memory")
#define VM_WAIT() asm volatile("s_waitcnt vmcnt(0)" ::: "memory")
__device__ __forceinline__ unsigned pk2(float lo, float hi) { return pg8::cvt_pk_bf16(lo, hi); }
__device__ __forceinline__ float bflo(unsigned v) { return __uint_as_float(v << 16); }
__device__ __forceinline__ float bfhi(unsigned v) { return __uint_as_float(v & 0xffff0000u); }
__device__ __forceinline__ float bf1(unsigned short h) { return __uint_as_float((unsigned)h << 16); }
__device__ __forceinline__ unsigned short f2bf(float f) { return (unsigned short)(pg8::cvt_pk_bf16(f, 0.f) & 0xffffu); }

#define XB_TMO      128
#define XB_XCNT(j)  (256  + 64 * (j))
#define XB_XSUB(j)  (1280 + 64 * (j))
#define XB_XGEN(j)  (2304 + 64 * (j))
#define XB_TOP      3328
#define XB_TOPGEN   3392
#define XCD_BAR_WORDS 3456
#define XB_SPIN_CAP (1u << 18)
__device__ __forceinline__ unsigned xb_ld(unsigned* p)              { return __hip_atomic_load(p, __ATOMIC_RELAXED, __HIP_MEMORY_SCOPE_AGENT); }
__device__ __forceinline__ unsigned xb_add(unsigned* p, unsigned v) { return __hip_atomic_fetch_add(p, v, __ATOMIC_RELAXED, __HIP_MEMORY_SCOPE_AGENT); }
__device__ __forceinline__ unsigned xb_xcc_id() { return (unsigned)__builtin_amdgcn_s_getreg((3 << 11) | 20) & 0xFu; }
#define XB_SPIN(cond, bar) do { unsigned _sp = 0; while (cond) { __builtin_amdgcn_s_sleep(1); \
    if ((++_sp & 255u) == 0u) { if (xb_ld(&(bar)[XB_TMO])) break; if (_sp > XB_SPIN_CAP) { atomicAdd(&(bar)[XB_TMO], 1u); break; } } } } while (0)
struct XcdBarrier { unsigned* bar; unsigned x; volatile LAS unsigned* st; };
__device__ __forceinline__ XcdBarrier xcd_barrier_post(unsigned* bar, volatile LAS unsigned* st) {
    XcdBarrier b; b.bar = bar; b.x = xb_xcc_id(); b.st = st;
    if (threadIdx.x == 0) (void)xb_add(&bar[XB_XCNT(b.x)], 1u);
    return b;
}
__device__ __forceinline__ void xcd_barrier_complete(unsigned* bar, unsigned x, unsigned& nloc, unsigned& nx) {
    const unsigned G = gridDim.x * gridDim.y * gridDim.z;
    unsigned sum, cnt, mine, sp = 0u;
    for (;;) {
        sum = 0u; cnt = 0u; mine = 0u;
#pragma unroll
        for (unsigned j = 0; j < 16; ++j) { const unsigned c = xb_ld(&bar[XB_XCNT(j)]); sum += c; cnt += (c > 0u) ? 1u : 0u; mine = (j == x) ? c : mine; }
        if (sum == G) break;
        __builtin_amdgcn_s_sleep(1);
        if ((++sp & 255u) == 0u) { if (xb_ld(&bar[XB_TMO])) break; if (sp > XB_SPIN_CAP) { atomicAdd(&bar[XB_TMO], 1u); break; } }
    }
    nloc = mine > 0u ? mine : 1u; nx = cnt > 0u ? cnt : 1u;
}
__device__ __forceinline__ void xcd_barrier(const XcdBarrier& b) {
    asm volatile("s_waitcnt vmcnt(0)" ::: "memory");
    __syncthreads();
    if (threadIdx.x == 0) {
        unsigned* bar = b.bar;
        __builtin_amdgcn_s_waitcnt(0);
        unsigned nloc = b.st[0], nx = b.st[1];
        if (nloc == 0u) { xcd_barrier_complete(bar, b.x, nloc, nx); b.st[0] = nloc; b.st[1] = nx; }
        const unsigned old = xb_add(&bar[XB_XSUB(b.x)], 1u);
        const unsigned gen = old / nloc;
        if (old + 1u == (gen + 1u) * nloc) {
            __builtin_amdgcn_fence(__ATOMIC_RELEASE, "agent");
            asm volatile("s_waitcnt vmcnt(0)" ::: "memory");
            const unsigned og = xb_add(&bar[XB_TOP], 1u);
            const unsigned tg = og / nx;
            if (og + 1u == (tg + 1u) * nx) xb_add(&bar[XB_TOPGEN], 1u);
            else XB_SPIN(xb_ld(&bar[XB_TOPGEN]) == tg, bar);
            __builtin_amdgcn_fence(__ATOMIC_ACQUIRE, "agent");
            xb_add(&bar[XB_XGEN(b.x)], 1u);
            asm volatile("s_waitcnt vmcnt(0)" ::: "memory");
        } else {
            XB_SPIN(xb_ld(&bar[XB_XGEN(b.x)]) == gen, bar);
            __builtin_amdgcn_fence(__ATOMIC_ACQUIRE, "agent");
            asm volatile("s_waitcnt vmcnt(0)" ::: "memory");
        }
    }
    __syncthreads();
}

struct Frame {
    LAS unsigned char* lds;
    volatile LAS unsigned* MISC;
    gu32* ctl;
    int tid, lane, wave, G, bid;
    const float* const* in;
    float* out;
    unsigned char* ws;
};
enum { I_XP = 0, I_XS, I_SH, I_SRGC, I_SCF, I_SPOOL, I_SSC, I_WIN, I_RGCW, I_RGCB, I_RGWA, I_RGBA, I_RGWX, I_RGBX, I_LAM, I_CFW, I_CFB, I_CFG, I_CFBB, I_POOLW, I_POOLS, I_SCW,
       I_WBR, I_WOUT, I_LN1G, I_LN1B, I_WG, I_WU, I_WD, I_LN2G, I_LN2B };

__device__ __forceinline__ float shfl_idx(float v, int src_lane) { return __builtin_bit_cast(float, __builtin_amdgcn_ds_bpermute(src_lane << 2, __builtin_bit_cast(int, v))); }
__device__ __forceinline__ float wave_sum(float v, int lane) {
#pragma unroll
    for (int o = 1; o < 64; o <<= 1) v += shfl_idx(v, lane ^ o);
    return v;
}

enum { RM_ID = 0, RM_WIN = 1, RM_GU = 2 };
template <int MODE> __device__ __forceinline__ int rowmap(int s, int extra) {
    if (MODE == RM_ID) return s;
    if (MODE == RM_GU) return 256 * (s >> 7) + (s & 127) + extra;
    if (s < 1024) return s;
    if (s < 2048) { const int j = ((s - 1024) >> 7) & 3; return 1024 + 256 * j + (s >= 1536 ? 128 : 0) + (s & 127); }
    if (s < 3072) return s;
    if (s < 4096) { const int j = ((s - 3072) >> 7) & 3; return 3072 + 256 * j + (s >= 3584 ? 128 : 0) + (s & 127); }
    const int g = (s - 4096) >> 10, ch = s & 1023, pn = ch >> 6, chl = ch & 63, wc = chl >> 4, fq = (chl >> 2) & 3, i = chl & 3;
    return 4096 + 256 * pn + 128 * (g >> 1) + 32 * wc + 8 * fq + 4 * (g & 1) + i;
}
template <int MODE>
__device__ __forceinline__ void transpose_item(const float* W, int K, int N, bf16* WT, int dst_ld, int dst_koff, int extra, LAS float* scr, int item, int lane, int nb0, int nnb) {
    const int kb = item / nnb, nb = nb0 + item % nnb, k0 = 64 * kb, n0 = 32 * nb;
#pragma unroll 8
    for (int i = 0; i < 32; ++i) { const int kk = 2 * i + (lane >> 5); scr[kk * 33 + (lane & 31)] = W[(size_t)(k0 + kk) * N + n0 + (lane & 31)]; }
    LDS_WAIT(); asm volatile("" ::: "memory");
    const int c = lane & 7; const float sc = (MODE == RM_WIN && n0 >= 4096) ? -1.44269504089f : 1.0f;
#pragma unroll
    for (int j = 0; j < 4; ++j) { const int n = (lane >> 3) + 8 * j; const LAS float* s = scr + (8 * c) * 33 + n;
        v4u o; o.x = pk2(s[0 * 33] * sc, s[1 * 33] * sc); o.y = pk2(s[2 * 33] * sc, s[3 * 33] * sc); o.z = pk2(s[4 * 33] * sc, s[5 * 33] * sc); o.w = pk2(s[6 * 33] * sc, s[7 * 33] * sc);
        *(GAS v4u*)(WT + (size_t)rowmap<MODE>(n0 + n, extra) * dst_ld + dst_koff + k0 + 8 * c) = o; }
    LDS_WAIT(); asm volatile("" ::: "memory");
}
template <int MODE>
__device__ __forceinline__ void convert_matrix(Frame& F, const float* W, int K, int N, bf16* WT, int dst_ld, int dst_koff, int extra, int gw, int NGW, int first = 0, int nb0 = 0, int nnb = 0) {
    LAS float* scr = (LAS float*)(F.lds + RING_OFF + F.wave * 16384);
    if (nnb == 0) nnb = N / 32;
    const int nitems = (K / 64) * nnb;
    int it0 = gw - first; if (it0 < 0) it0 += ((-it0 + NGW - 1) / NGW) * NGW;
    for (int it = it0; it < nitems; it += NGW) transpose_item<MODE>(W, K, N, WT, dst_ld, dst_koff, extra, scr, it, F.lane, nb0, nnb);
}
__device__ __forceinline__ void compose_pool(Frame& F, int layer, bf16* Bt3, int gw, int NGW, int first = 0) {
    const float* pw = F.in[I_POOLW] + (size_t)layer * 4 * 128 * 128; const float* ps = F.in[I_POOLS] + layer * 512; const float* Wb2 = F.in[I_WBR] + ((size_t)layer * 4 + 2) * 512 * 1024;
    const int lane = F.lane;
    LAS float* Pl = (LAS float*)(F.lds + RING_OFF + F.wave * 16384);
    int id0 = gw - first; if (id0 < 0) id0 += ((-id0 + NGW - 1) / NGW) * NGW;
    for (int id = id0; id < 512; id += NGW) {
        const int g = __builtin_amdgcn_readfirstlane(id >> 7), c0 = __builtin_amdgcn_readfirstlane(8 * ((id >> 3) & 15)), d0 = 128 * (id & 7) + 2 * lane;
#pragma unroll
        for (int k = 0; k < 4; ++k) { const int idx4 = lane + 64 * k, i = idx4 >> 5, e4 = (idx4 & 31) * 4;
            const f32x4 pv = *(const GAS f32x4*)(pw + ((size_t)g * 128 + c0 + i) * 128 + e4), sv = *(const GAS f32x4*)(ps + 128 * g + e4);
            Pl[(e4 + 0) * 8 + i] = pv.x * sv.x; Pl[(e4 + 1) * 8 + i] = pv.y * sv.y; Pl[(e4 + 2) * 8 + i] = pv.z * sv.z; Pl[(e4 + 3) * 8 + i] = pv.w * sv.w; }
        LDS_WAIT(); asm volatile("" ::: "memory");
        f32x2 acc[8];
#pragma unroll
        for (int i = 0; i < 8; ++i) acc[i] = (f32x2){0.f, 0.f};
        const float* wrow = Wb2 + (size_t)(128 * g) * 1024 + d0;
#pragma unroll 1
        for (int e0 = 0; e0 < 128; e0 += 8) {
            f32x2 wv[8];
#pragma unroll
            for (int k = 0; k < 8; ++k) wv[k] = *(const GAS f32x2*)(wrow + (size_t)(e0 + k) * 1024);
#pragma unroll
            for (int k = 0; k < 8; ++k) { const f32x4 p0 = *(const LAS f32x4*)(Pl + (e0 + k) * 8), p1 = *(const LAS f32x4*)(Pl + (e0 + k) * 8 + 4);
#pragma unroll
                for (int i = 0; i < 4; ++i) { acc[i] += wv[k] * p0[i]; acc[4 + i] += wv[k] * p1[i]; } }
        }
        v4u o0, o1;
        o0.x = pk2(acc[0].x, acc[1].x); o0.y = pk2(acc[2].x, acc[3].x); o0.z = pk2(acc[4].x, acc[5].x); o0.w = pk2(acc[6].x, acc[7].x);
        o1.x = pk2(acc[0].y, acc[1].y); o1.y = pk2(acc[2].y, acc[3].y); o1.z = pk2(acc[4].y, acc[5].y); o1.w = pk2(acc[6].y, acc[7].y);
        *(GAS v4u*)(Bt3 + (size_t)d0 * 2048 + 1024 + 128 * g + c0) = o0; *(GAS v4u*)(Bt3 + (size_t)(d0 + 1) * 2048 + 1024 + 128 * g + c0) = o1;
        LDS_WAIT(); asm volatile("" ::: "memory");
    }
}

__device__ __forceinline__ const float* xrow_in(Frame& F, int m) { return m < MP ? F.in[I_XP] + (size_t)m * DM : F.in[I_XS] + (size_t)(m - MP) * DM; }
__device__ __forceinline__ void x_to_bf16(Frame& F, bf16* XB) {
    const int gw = F.bid * NWAVES + F.wave, NGW = F.G * NWAVES;
    for (int m0 = 4 * gw; m0 < M; m0 += 4 * NGW) {
        f32x4 v[4][4];
#pragma unroll
        for (int k = 0; k < 4; ++k) { const GAS f32x4* xr = (const GAS f32x4*)xrow_in(F, m0 + k) + F.lane;
#pragma unroll
            for (int j = 0; j < 4; ++j) v[k][j] = xr[64 * j]; }
#pragma unroll
        for (int k = 0; k < 4; ++k) { GAS v2u* o = (GAS v2u*)(XB + (size_t)(m0 + k) * DM) + F.lane;
#pragma unroll
            for (int j = 0; j < 4; ++j) o[64 * j] = (v2u){pk2(v[k][j].x, v[k][j].y), pk2(v[k][j].z, v[k][j].w)}; } }
}
__device__ __forceinline__ void ln_rows(Frame& F, const float* V, float* O, const float* g, const float* b, bf16* XB, const float* sbase, const float* slab, int nslab) {
    const int gw = F.bid * NWAVES + F.wave, NGW = F.G * NWAVES;
    f32x4 gv[4], bv[4];
#pragma unroll
    for (int j = 0; j < 4; ++j) { gv[j] = ((const GAS f32x4*)g)[F.lane + 64 * j]; bv[j] = ((const GAS f32x4*)b)[F.lane + 64 * j]; }
    for (int m = MP + gw; m < M; m += NGW) {
        const GAS f32x4* xr = (const GAS f32x4*)(V + (size_t)m * DM) + F.lane; GAS f32x4* orow = (GAS f32x4*)(O + (size_t)m * DM) + F.lane;
        f32x4 v[4]; float s = 0.f;
#pragma unroll
        for (int j = 0; j < 4; ++j) v[j] = xr[64 * j];
        if (m >= MP) { const GAS f32x4* br = (const GAS f32x4*)(sbase + (size_t)(m - MP) * DM) + F.lane;
#pragma unroll
            for (int j = 0; j < 4; ++j) v[j] = br[64 * j] * ALPHA;
            for (int sl = 0; sl < nslab; ++sl) { const GAS f32x4* sr = (const GAS f32x4*)(slab + ((size_t)sl * 512 + (m - MP)) * DM) + F.lane;
#pragma unroll
                for (int j = 0; j < 4; ++j) v[j] += sr[64 * j]; } }
#pragma unroll
        for (int j = 0; j < 4; ++j) s += (v[j].x + v[j].y) + (v[j].z + v[j].w);
        const float mean = wave_sum(s, F.lane) * (1.f / DM); float s2 = 0.f;
#pragma unroll
        for (int j = 0; j < 4; ++j) { v[j] = v[j] - mean; s2 += (v[j].x * v[j].x + v[j].y * v[j].y) + (v[j].z * v[j].z + v[j].w * v[j].w); }
        const float rstd = __builtin_amdgcn_rsqf(wave_sum(s2, F.lane) * (1.f / DM) + LN_EPS);
#pragma unroll
        for (int j = 0; j < 4; ++j) { v[j] = v[j] * rstd * gv[j] + bv[j]; orow[64 * j] = v[j]; }
        if (XB) { GAS v2u* o = (GAS v2u*)(XB + (size_t)m * DM) + F.lane;
#pragma unroll
            for (int j = 0; j < 4; ++j) o[64 * j] = (v2u){pk2(v[j].x, v[j].y), pk2(v[j].z, v[j].w)}; }
    }
}

__device__ __forceinline__ float softplusf_acc(float x) { return fmaxf(x, 0.f) + log1pf(__expf(-fabsf(x))); }
__device__ __forceinline__ float expm1_neg(float x) {
    const float p = x * (1.f + x * (0.5f + x * (1.f / 6.f + x * (1.f / 24.f + x * (1.f / 120.f + x * (1.f / 720.f + x * (1.f / 5040.f)))))));
    return x > -0.25f ? p : __expf(x) - 1.f;
}
constexpr int PATCH_STRIDE = 144;

struct ALane {
    float cwD[4], cbD, ba, bx, ck;
    bf16x8 Ba[4][2], Bx[4][2];
};
constexpr int PATCH_BYTES = 5120, ASLOT_OFF = 8 * PATCH_BYTES;
__device__ __forceinline__ void a_setup(Frame& F, int layer, int n, int q, ALane& L) {
    const int c = F.lane & 15, kg = F.lane >> 4, och = 64 * n + 16 * q + c;
    const float* cw = F.in[I_RGCW] + (size_t)layer * 4 * 512 + 64 * n; const float* cb = F.in[I_RGCB] + layer * 512 + 64 * n;
#pragma unroll
    for (int j = 0; j < 4; ++j) L.cwD[j] = cw[j * 512 + 16 * q + c];
    L.cbD = cb[16 * q + c];
    L.ck = 8.0f * softplusf_acc(-F.in[I_LAM][layer * 512 + och]);
    const float* wa = F.in[I_RGWA] + ((size_t)layer * 8 + n) * 4096 + 16 * q + c; const float* wx = F.in[I_RGWX] + ((size_t)layer * 8 + n) * 4096 + 16 * q + c;
    float wav[16], wxv[16], cbv[16];
#pragma unroll
    for (int e = 0; e < 16; ++e) { const int k = (e < 8 ? 8 * kg + e : 32 + 8 * kg + (e - 8)); wav[e] = wa[k * 64]; wxv[e] = wx[k * 64]; cbv[e] = cb[k]; }
#pragma unroll
    for (int j = 0; j < 4; ++j) { float t[16];
#pragma unroll
        for (int e = 0; e < 16; ++e) t[e] = cw[j * 512 + (e < 8 ? 8 * kg + e : 32 + 8 * kg + (e - 8))];
        L.Ba[j][0] = __builtin_bit_cast(bf16x8, (v4u){pk2(wav[0] * t[0], wav[1] * t[1]), pk2(wav[2] * t[2], wav[3] * t[3]), pk2(wav[4] * t[4], wav[5] * t[5]), pk2(wav[6] * t[6], wav[7] * t[7])});
        L.Ba[j][1] = __builtin_bit_cast(bf16x8, (v4u){pk2(wav[8] * t[8], wav[9] * t[9]), pk2(wav[10] * t[10], wav[11] * t[11]), pk2(wav[12] * t[12], wav[13] * t[13]), pk2(wav[14] * t[14], wav[15] * t[15])});
        L.Bx[j][0] = __builtin_bit_cast(bf16x8, (v4u){pk2(wxv[0] * t[0], wxv[1] * t[1]), pk2(wxv[2] * t[2], wxv[3] * t[3]), pk2(wxv[4] * t[4], wxv[5] * t[5]), pk2(wxv[6] * t[6], wxv[7] * t[7])});
        L.Bx[j][1] = __builtin_bit_cast(bf16x8, (v4u){pk2(wxv[8] * t[8], wxv[9] * t[9]), pk2(wxv[10] * t[10], wxv[11] * t[11]), pk2(wxv[12] * t[12], wxv[13] * t[13]), pk2(wxv[14] * t[14], wxv[15] * t[15])}); }
    float sa = 0.f, sx = 0.f;
#pragma unroll
    for (int e = 0; e < 16; ++e) { sa = fmaf(cbv[e], wav[e], sa); sx = fmaf(cbv[e], wxv[e], sx); }
    sa += shfl_idx(sa, F.lane ^ 16); sa += shfl_idx(sa, F.lane ^ 32); sx += shfl_idx(sx, F.lane ^ 16); sx += shfl_idx(sx, F.lane ^ 32);
    L.ba = F.in[I_RGBA][layer * 512 + och] + sa; L.bx = F.in[I_RGBX][layer * 512 + och] + sx;
}
__device__ __forceinline__ void a_block(const ALane& L, const LAS unsigned char* patch, int rowA0, int baseD, int q, int lane, float (&a)[4], float (&bb)[4]) {
    const int c = lane & 15, kg = lane >> 4;
    f32x4 accR = (f32x4){0.f, 0.f, 0.f, 0.f}, accI = (f32x4){0.f, 0.f, 0.f, 0.f};
#pragma unroll
    for (int j = 0; j < 4; ++j) { const LAS unsigned char* rp = patch + (rowA0 + j) * PATCH_STRIDE + 16 * kg;
        const bf16x8 A0 = *(const LAS bf16x8*)rp, A1 = *(const LAS bf16x8*)(rp + 64);
        accR = __builtin_amdgcn_mfma_f32_16x16x32_bf16(A0, L.Ba[j][0], accR, 0, 0, 0); accR = __builtin_amdgcn_mfma_f32_16x16x32_bf16(A1, L.Ba[j][1], accR, 0, 0, 0);
        accI = __builtin_amdgcn_mfma_f32_16x16x32_bf16(A0, L.Bx[j][0], accI, 0, 0, 0); accI = __builtin_amdgcn_mfma_f32_16x16x32_bf16(A1, L.Bx[j][1], accI, 0, 0, 0); }
    float pv[7];
#pragma unroll
    for (int k = 0; k < 7; ++k) pv[k] = bf1(*(const LAS unsigned short*)(patch + (baseD + k) * PATCH_STRIDE + 2 * (16 * q + c)));
#pragma unroll
    for (int r = 0; r < 4; ++r) {
        const float xd = L.cbD + L.cwD[0] * pv[r] + L.cwD[1] * pv[r + 1] + L.cwD[2] * pv[r + 2] + L.cwD[3] * pv[r + 3];
        const float rr = pg8::sigmoidf_fast(accR[r] + L.ba), ii = pg8::sigmoidf_fast(accI[r] + L.bx);
        const float la = -L.ck * rr;
        const float av = __builtin_amdgcn_exp2f(1.44269504089f * la);
        a[r] = av; bb[r] = __builtin_amdgcn_sqrtf(fmaxf(1.f - av * av, 0.f)) * (ii * xd);
    }
}
struct BlkScan { float Ac[4], Bc[4], EA, EB, WA, WB; };
__device__ __forceinline__ void blk_scan(const float (&a)[4], const float (&bb)[4], int lane, BlkScan& S) {
    const int c = lane & 15, g = lane >> 4;
    S.Ac[0] = a[0]; S.Bc[0] = bb[0];
#pragma unroll
    for (int r = 1; r < 4; ++r) { S.Ac[r] = a[r] * S.Ac[r - 1]; S.Bc[r] = a[r] * S.Bc[r - 1] + bb[r]; }
    float IA = S.Ac[3], IB = S.Bc[3];
    { const float pa = shfl_idx(IA, lane - 16), pb = shfl_idx(IB, lane - 16); if (g >= 1) { IB = IA * pb + IB; IA = IA * pa; } }
    { const float pa = shfl_idx(IA, lane - 32), pb = shfl_idx(IB, lane - 32); if (g >= 2) { IB = IA * pb + IB; IA = IA * pa; } }
    S.EA = shfl_idx(IA, lane - 16); S.EB = shfl_idx(IB, lane - 16); if (g == 0) { S.EA = 1.f; S.EB = 0.f; }
    S.WA = shfl_idx(IA, 48 + c); S.WB = shfl_idx(IB, 48 + c);
}
__device__ __forceinline__ void a_prompt_item(Frame& F, int layer, int item, const bf16* Z, bf16* Y) {
    const int b = item >> 5, n = (item >> 2) & 7, q = item & 3, lane = opqv(F.lane), w = F.wave, c = lane & 15, g = lane >> 4, och = 64 * n + 16 * q + c;
    ALane L; a_setup(F, layer, n, q, L);
    LAS unsigned char* patch = F.lds + RING_OFF + w * PATCH_BYTES;
    LAS f32x2* slots = (LAS f32x2*)(F.lds + RING_OFF + ASLOT_OFF);
    const bf16* Zb = Z + (size_t)b * SEQ * ZC;
    float hrun = 0.f;
    v4u pf[5];
    auto load_patch = [&](int tb) {
#pragma unroll
        for (int k = 0; k < 5; ++k) { const int ci = lane + 64 * k, pr = ci >> 3, cc = ci & 7, t = tb - 3 + pr;
            pf[k] = (ci < 280 && t >= 0) ? *(const GAS v4u*)(Zb + (size_t)t * ZC + 64 * n + 8 * cc) : (v4u){0u, 0u, 0u, 0u}; }
    };
    load_patch(32 * w);
    for (int it = 0; it < 8; ++it) {
        const int tb = 256 * it + 32 * w;
#pragma unroll
        for (int k = 0; k < 5; ++k) { const int ci = lane + 64 * k, pr = ci >> 3, cc = ci & 7; if (ci < 280) *(LAS v4u*)(patch + pr * PATCH_STRIDE + 16 * cc) = pf[k]; }
        if (it < 7) load_patch(tb + 256);
        unsigned short gav[8];
#pragma unroll
        for (int r = 0; r < 8; ++r) gav[r] = *(const GAS unsigned short*)(Zb + (size_t)(tb + 16 * (r >> 2) + 4 * g + (r & 3)) * ZC + 512 + och);
        asm volatile("" ::: "memory");
        float a0[4], b0[4], a1[4], b1[4];
        a_block(L, patch, lane & 15, 4 * g, q, lane, a0, b0);
        a_block(L, patch, 16 + (lane & 15), 16 + 4 * g, q, lane, a1, b1);
        BlkScan S0, S1; blk_scan(a0, b0, lane, S0); blk_scan(a1, b1, lane, S1);
        if (lane < 16) slots[((it & 1) * 8 + w) * 16 + c] = (f32x2){S0.WA * S1.WA, S1.WA * S0.WB + S1.WB};
        __syncthreads();
        float hin = hrun, hw = 0.f;
#pragma unroll
        for (int ww = 0; ww < 8; ++ww) { const f32x2 s = slots[((it & 1) * 8 + ww) * 16 + c]; if (ww == w) hw = hin; hin = s.x * hin + s.y; }
        hrun = hin;
        const float hg0 = S0.EA * hw + S0.EB, hw1 = S0.WA * hw + S0.WB, hg1 = S1.EA * hw1 + S1.EB;
#pragma unroll
        for (int r = 0; r < 4; ++r) { const float h = S0.Ac[r] * hg0 + S0.Bc[r];
            *(GAS unsigned short*)(Y + (size_t)(b * SEQ + tb + 4 * g + r) * YC + och) = f2bf(h * bf1(gav[r])); }
#pragma unroll
        for (int r = 0; r < 4; ++r) { const float h = S1.Ac[r] * hg1 + S1.Bc[r];
            *(GAS unsigned short*)(Y + (size_t)(b * SEQ + tb + 16 + 4 * g + r) * YC + och) = f2bf(h * bf1(gav[4 + r]));
            if (r == 3 && it == 7 && w == 7 && g == 3) F.out[O_PH + (size_t)(layer * 8 + b) * 512 + och] = h; }
    }
}
__device__ __forceinline__ void a_sample_task(Frame& F, int layer, int task, const bf16* Z, bf16* Y) {
    const int blk = task >> 5, n = (task >> 2) & 7, q = task & 3, lane = opqv(F.lane), c = lane & 15, g = lane >> 4, och = 64 * n + 16 * q + c, s0 = 4 * blk;
    ALane L; a_setup(F, layer, n, q, L);
    LAS unsigned char* patch = F.lds + RING_OFF + F.wave * PATCH_BYTES;
#pragma unroll
    for (int k = 0; k < 4; ++k) { const int ci = lane + 64 * k; if (ci < 224) { const int pr = ci >> 3, cc = ci & 7, sq = pr / 7, tau = pr - 7 * sq - 3, seq = s0 + sq; v4u v;
            if (tau < 0) { const GAS f32x4* sp = (const GAS f32x4*)(F.in[I_SRGC] + ((size_t)(layer * 128 + seq) * 3 + (tau + 3)) * 512 + 64 * n + 8 * cc); const f32x4 f0 = sp[0], f1 = sp[1];
                v = (v4u){pk2(f0.x, f0.y), pk2(f0.z, f0.w), pk2(f1.x, f1.y), pk2(f1.z, f1.w)}; }
            else v = *(const GAS v4u*)(Z + (size_t)(MP + 4 * seq + tau) * ZC + 64 * n + 8 * cc);
            *(LAS v4u*)(patch + pr * PATCH_STRIDE + 16 * cc) = v; } }
    asm volatile("" ::: "memory");
    float a[4], bb[4];
    a_block(L, patch, 7 * ((lane & 15) >> 2) + (lane & 3), 7 * g, q, lane, a, bb);
    const int seq = s0 + g;
    float h = F.in[I_SH][(size_t)(layer * 128 + seq) * 512 + och];
#pragma unroll
    for (int r = 0; r < 4; ++r) { h = a[r] * h + bb[r]; const size_t row = (size_t)(MP + 4 * seq + r);
        *(GAS unsigned short*)(Y + row * YC + och) = f2bf(h * bf1(*(const GAS unsigned short*)(Z + row * ZC + 512 + och))); }
    F.out[O_SH + (size_t)(layer * 128 + seq) * 512 + och] = h;
}

__device__ __forceinline__ void ln_silu_row(const LAS float* xr, const float* g, const float* b, bf16* dst, int lane) {
    const f32x4 v0 = *(const LAS f32x4*)(xr + 4 * lane), v1 = *(const LAS f32x4*)(xr + 256 + 4 * lane);
    const float s = (v0.x + v0.y) + (v0.z + v0.w) + (v1.x + v1.y) + (v1.z + v1.w);
    const float mean = wave_sum(s, lane) * (1.f / 512.f);
    const f32x4 d0 = v0 - mean, d1 = v1 - mean;
    const float s2 = (d0.x * d0.x + d0.y * d0.y) + (d0.z * d0.z + d0.w * d0.w) + (d1.x * d1.x + d1.y * d1.y) + (d1.z * d1.z + d1.w * d1.w);
    const float rstd = __builtin_amdgcn_rsqf(wave_sum(s2, lane) * (1.f / 512.f) + LN_EPS);
    const f32x4 g0 = *(const GAS f32x4*)(g + 4 * lane), g1 = *(const GAS f32x4*)(g + 256 + 4 * lane), b0 = *(const GAS f32x4*)(b + 4 * lane), b1 = *(const GAS f32x4*)(b + 256 + 4 * lane);
    f32x4 y0 = d0 * rstd * g0 + b0, y1 = d1 * rstd * g1 + b1;
#pragma unroll
    for (int i = 0; i < 4; ++i) { y0[i] = y0[i] * pg8::sigmoidf_fast(y0[i]); y1[i] = y1[i] * pg8::sigmoidf_fast(y1[i]); }
    *(GAS v2u*)(dst + 4 * lane) = (v2u){pk2(y0.x, y0.y), pk2(y0.z, y0.w)}; *(GAS v2u*)(dst + 256 + 4 * lane) = (v2u){pk2(y1.x, y1.y), pk2(y1.z, y1.w)};
}
__device__ __forceinline__ void ln_silu_rows4(const LAS float* xr, int rstride, const float* g, const float* b, bf16* dst, size_t dstride, int lane) {
    f32x4 v0[4], v1[4]; float s[4], s2[4];
#pragma unroll
    for (int k = 0; k < 4; ++k) { v0[k] = *(const LAS f32x4*)(xr + k * rstride + 4 * lane); v1[k] = *(const LAS f32x4*)(xr + k * rstride + 256 + 4 * lane);
        s[k] = (v0[k].x + v0[k].y) + (v0[k].z + v0[k].w) + (v1[k].x + v1[k].y) + (v1[k].z + v1[k].w); }
#pragma unroll
    for (int o = 1; o < 64; o <<= 1) {
#pragma unroll
        for (int k = 0; k < 4; ++k) s[k] += shfl_idx(s[k], lane ^ o); }
#pragma unroll
    for (int k = 0; k < 4; ++k) { const float mean = s[k] * (1.f / 512.f); v0[k] = v0[k] - mean; v1[k] = v1[k] - mean;
        s2[k] = (v0[k].x * v0[k].x + v0[k].y * v0[k].y) + (v0[k].z * v0[k].z + v0[k].w * v0[k].w) + (v1[k].x * v1[k].x + v1[k].y * v1[k].y) + (v1[k].z * v1[k].z + v1[k].w * v1[k].w); }
#pragma unroll
    for (int o = 1; o < 64; o <<= 1) {
#pragma unroll
        for (int k = 0; k < 4; ++k) s2[k] += shfl_idx(s2[k], lane ^ o); }
    const f32x4 g0 = *(const GAS f32x4*)(g + 4 * lane), g1 = *(const GAS f32x4*)(g + 256 + 4 * lane), b0 = *(const GAS f32x4*)(b + 4 * lane), b1 = *(const GAS f32x4*)(b + 256 + 4 * lane);
#pragma unroll
    for (int k = 0; k < 4; ++k) { const float rstd = __builtin_amdgcn_rsqf(s2[k] * (1.f / 512.f) + LN_EPS);
        f32x4 y0 = v0[k] * rstd * g0 + b0, y1 = v1[k] * rstd * g1 + b1;
#pragma unroll
        for (int i = 0; i < 4; ++i) { y0[i] = y0[i] * pg8::sigmoidf_fast(y0[i]); y1[i] = y1[i] * pg8::sigmoidf_fast(y1[i]); }
        bf16* d = dst + (size_t)k * dstride;
        *(GAS v2u*)(d + 4 * lane) = (v2u){pk2(y0.x, y0.y), pk2(y0.z, y0.w)}; *(GAS v2u*)(d + 256 + 4 * lane) = (v2u){pk2(y1.x, y1.y), pk2(y1.z, y1.w)}; }
}
__device__ __forceinline__ void b_prompt_item(Frame& F, int layer, int item, const bf16* Z, bf16* Y) {
    const int tidl = opqv(F.tid), b = item >> 5, t0 = 64 * (item & 31), p = tidl & 255, hh = tidl >> 8, ts = t0 + 32 * hh;
    const GAS unsigned* Zu = (const GAS unsigned*)(Z + (size_t)b * SEQ * ZC) + 512 + p;
    unsigned raw[62];
#pragma unroll
    for (int i = 0; i < 62; ++i) { const int t = ts - 30 + i; raw[i] = t >= 0 ? Zu[(size_t)t * (ZC / 2)] : 0u; }
    const float* cw = F.in[I_CFW] + (size_t)layer * 31 * 512 + 2 * p;
    f32x2 wj[31];
#pragma unroll
    for (int j = 0; j < 31; ++j) wj[j] = *(const GAS f32x2*)(cw + j * 512);
    const f32x2 bias = *(const GAS f32x2*)(F.in[I_CFB] + layer * 512 + 2 * p);
    f32x2 in[62];
#pragma unroll
    for (int i = 0; i < 62; ++i) in[i] = (f32x2){bflo(raw[i]), bfhi(raw[i])};
    LAS float* obuf = (LAS float*)(F.lds + RING_OFF);
#pragma unroll
    for (int i = 0; i < 32; ++i) { f32x2 o = bias;
#pragma unroll
        for (int j = 0; j < 31; ++j) o += wj[j] * in[i + j];
        *(LAS f32x2*)(obuf + (32 * hh + i) * 512 + 2 * p) = o; }
    __syncthreads();
    const float* lg = F.in[I_CFG] + layer * 512; const float* lb = F.in[I_CFBB] + layer * 512;
#pragma unroll 1
    for (int r = 8 * F.wave; r < 8 * F.wave + 8; r += 4) ln_silu_rows4(obuf + r * 512, 512, lg, lb, Y + (size_t)(b * SEQ + t0 + r) * YC + 512, YC, F.lane);
}
__device__ __forceinline__ void cd_prompt_item(Frame& F, int layer, int item, const bf16* Z, bf16* Y) {
    const int tidl = opqv(F.tid), b = item >> 5, t0 = 64 * (item & 31), p = tidl & 255, hh = tidl >> 8;
    const bf16* Zb = Z + (size_t)b * SEQ * ZC;
    LAS unsigned* cbuf = (LAS unsigned*)(F.lds + RING_OFF);
    { v4u tmp[10];
#pragma unroll
      for (int k = 0; k < 10; ++k) { const int ci = tidl + 512 * k, pr = ci >> 6, cc = ci & 63, t = t0 - 15 + pr;
          tmp[k] = (ci < 79 * 64 && t >= 0) ? *(const GAS v4u*)(Zb + (size_t)t * ZC + 1536 + 8 * cc) : (v4u){0u, 0u, 0u, 0u}; }
#pragma unroll
      for (int k = 0; k < 10; ++k) { const int ci = tidl + 512 * k, pr = ci >> 6, cc = ci & 63; if (ci < 79 * 64) *(LAS v4u*)(cbuf + pr * 256 + 4 * cc) = tmp[k]; } }
    const int ts = t0 + 32 * hh;
    unsigned uu[34], dd[32];
#pragma unroll
    for (int i = 0; i < 34; ++i) { const int t = ts - 2 + i; uu[i] = t >= 0 ? ((const GAS unsigned*)(Zb + (size_t)t * ZC))[1280 + p] : 0u; }
#pragma unroll
    for (int i = 0; i < 32; ++i) dd[i] = ((const GAS unsigned*)(Zb + (size_t)(ts + i) * ZC))[1024 + p];
    const f32x2 w0 = ((const GAS f32x2*)(F.in[I_SCW] + (size_t)(layer * 3 + 0) * 512))[p], w1 = ((const GAS f32x2*)(F.in[I_SCW] + (size_t)(layer * 3 + 1) * 512))[p],
                w2 = ((const GAS f32x2*)(F.in[I_SCW] + (size_t)(layer * 3 + 2) * 512))[p];
    __syncthreads();
    const int w = 2 << (p >> 6), rr0 = 15 + 32 * hh;
    f32x2 s = (f32x2){0.f, 0.f};
    for (int j = 0; j < w; ++j) { const unsigned v = cbuf[(rr0 - j) * 256 + p]; s += (f32x2){bflo(v), bfhi(v)}; }
    GAS unsigned* Yu = (GAS unsigned*)(Y + (size_t)(b * SEQ + ts) * YC) + p;
#pragma unroll
    for (int i = 0; i < 32; ++i) { const int t = ts + i, rr = rr0 + i;
        const unsigned cur = cbuf[rr * 256 + p]; const f32x2 cf = (f32x2){bflo(cur), bfhi(cur)};
        if (i > 0) { const unsigned old = cbuf[(rr - w) * 256 + p]; s += cf - (f32x2){bflo(old), bfhi(old)}; }
        const float ic = __builtin_amdgcn_rcpf((float)(t + 1 < w ? t + 1 : w));
        const f32x2 mm = s * ic - cf;
        Yu[(size_t)i * 1024 + 512] = pk2(mm.x, mm.y);
        const f32x2 cv = w0 * (f32x2){bflo(uu[i]), bfhi(uu[i])} + w1 * (f32x2){bflo(uu[i + 1]), bfhi(uu[i + 1])} + w2 * (f32x2){bflo(uu[i + 2]), bfhi(uu[i + 2])};
        const f32x2 yd = (f32x2){bflo(dd[i]), bfhi(dd[i])} * cv;
        Yu[(size_t)i * 1024 + 768] = pk2(yd.x, yd.y); }
}
__device__ __forceinline__ void s_sample_item(Frame& F, int layer, int s, const bf16* Z, bf16* Y) {
    const int ch = opqv(F.tid); const size_t ls = (size_t)layer * 128 + s;
    const bf16* Zr = Z + (size_t)(MP + 4 * s) * ZC; bf16* Yr = Y + (size_t)(MP + 4 * s) * YC;
    LAS float* obuf = (LAS float*)(F.lds + RING_OFF);
    float in[34], wv[31], pb[19], u[6], dbv[4];
#pragma unroll
    for (int j = 0; j < 30; ++j) in[j] = (F.in[I_SCF] + (ls * 30 + j) * 512)[ch];
#pragma unroll
    for (int j = 0; j < 15; ++j) pb[j] = (F.in[I_SPOOL] + (ls * 15 + j) * 512)[ch];
    u[0] = (F.in[I_SSC] + (ls * 2 + 0) * 512)[ch]; u[1] = (F.in[I_SSC] + (ls * 2 + 1) * 512)[ch];
#pragma unroll
    for (int r = 0; r < 4; ++r) { in[30 + r] = bf1((Zr + (size_t)r * ZC + 1024)[ch]); pb[15 + r] = bf1((Zr + (size_t)r * ZC + 1536)[ch]); u[2 + r] = bf1((Zr + (size_t)r * ZC + 2560)[ch]); dbv[r] = bf1((Zr + (size_t)r * ZC + 2048)[ch]); }
#pragma unroll
    for (int j = 0; j < 31; ++j) wv[j] = (F.in[I_CFW] + ((size_t)layer * 31 + j) * 512)[ch];
    const float bias = (F.in[I_CFB] + layer * 512)[ch];
    const float w0 = (F.in[I_SCW] + (size_t)(layer * 3 + 0) * 512)[ch], w1 = (F.in[I_SCW] + (size_t)(layer * 3 + 1) * 512)[ch], w2 = (F.in[I_SCW] + (size_t)(layer * 3 + 2) * 512)[ch];
    asm volatile("" ::: "memory");
#pragma unroll
    for (int j = 0; j < 26; ++j) (F.out + O_SCF + (ls * 30 + j) * 512)[ch] = in[j + 4];
#pragma unroll
    for (int r = 0; r < 4; ++r) { float o = bias;
#pragma unroll
        for (int j = 0; j < 31; ++j) o += wv[j] * in[r + j];
        obuf[r * 512 + ch] = o; }
#pragma unroll
    for (int j = 0; j < 11; ++j) (F.out + O_SPOOL + (ls * 15 + j) * 512)[ch] = pb[j + 4];
    const int gsel = ch >> 7;
#pragma unroll
    for (int r = 0; r < 4; ++r) { const int k = 15 + r;
        const float s2 = pb[k] + pb[k - 1], s4 = s2 + pb[k - 2] + pb[k - 3], s8 = s4 + (pb[k - 4] + pb[k - 5]) + (pb[k - 6] + pb[k - 7]);
        float s16 = s8;
#pragma unroll
        for (int j = 8; j < 16; ++j) s16 += pb[k - j];
        const float mv = (gsel == 0 ? s2 * 0.5f : gsel == 1 ? s4 * 0.25f : gsel == 2 ? s8 * 0.125f : s16 * 0.0625f) - pb[k];
        (Yr + (size_t)r * YC + 1024)[ch] = f2bf(mv); }
#pragma unroll
    for (int r = 0; r < 4; ++r) (Yr + (size_t)r * YC + 1536)[ch] = f2bf(dbv[r] * (w0 * u[r] + w1 * u[r + 1] + w2 * u[r + 2]));
    __syncthreads();
    if (F.wave < 4) ln_silu_row(obuf + F.wave * 512, F.in[I_CFG] + layer * 512, F.in[I_CFBB] + layer * 512, Yr + (size_t)F.wave * YC + 512, F.lane);
}

struct Args { const float* in[31]; float* out; unsigned char* ws; int ph_lo, ph_hi; };
__global__ void __launch_bounds__(NWAVES * 64, 2) hybrid_fwd(Args args) {
    extern __shared__ __attribute__((aligned(16))) unsigned char lds[];
    Frame F;
    F.lds = (LAS unsigned char*)lds;
    F.MISC = (volatile LAS unsigned*)(F.lds + MISC_OFF);
    const int wave0 = __builtin_amdgcn_readfirstlane((int)threadIdx.x >> 6);
    F.lane = lane_now(); F.wave = wave0; F.tid = F.wave * 64 + F.lane;
    F.G = gridDim.x; F.bid = blockIdx.x;
    F.ws = args.ws; F.out = args.out; F.ctl = (gu32*)(args.ws + WS_CTL);
    F.in = args.in;
    for (int u = F.tid; u < (LDS_BYTES - LDSCTL_OFF) / 4; u += NWAVES * 64) ((LAS unsigned*)(F.lds + LDSCTL_OFF))[u] = 0u;
    __syncthreads();
    XcdBarrier bar; bar.bar = (unsigned*)(F.ctl + CW_BAR); bar.x = 0; bar.st = nullptr;
    if (!MK_SPLIT) bar = xcd_barrier_post((unsigned*)(F.ctl + CW_BAR), F.MISC + 8);
    const int lo = args.ph_lo, hi = args.ph_hi;
#define IN(k) (lo <= (k) && (k) < hi)
#define REFRESH() do { F.lane = lane_now(); F.wave = opqs(wave0); F.tid = F.wave * 64 + F.lane; F.bid = opqs((int)blockIdx.x); } while (0)
#define SEAM(k) do { if (IN(k) && IN((k) + 1)) xcd_barrier(bar); } while (0)
    bf16* WA = (bf16*)(F.ws + WS_WA); bf16* XB = (bf16*)(F.ws + WS_XB); bf16* Y = (bf16*)(F.ws + WS_Y); bf16* Zm = (bf16*)(F.ws + WS_ZG); _Float16* Gb = (_Float16*)(F.ws + WS_ZG);
    bf16* Hb = (bf16*)(F.ws + WS_ZG); bf16* Bt3 = (bf16*)(F.ws + WS_BT3); bf16* Bt4 = (bf16*)(F.ws + WS_BT4); bf16* Bt5 = (bf16*)(F.ws + WS_BT5); bf16* Bt6 = (bf16*)(F.ws + WS_BT6);

    if (IN(0)) { REFRESH(); convert_matrix<RM_WIN>(F, F.in[I_WIN], DM, INC, WA, DM, 0, 0, F.bid * NWAVES + F.wave, F.G * NWAVES, 0, 0, F.G == 256 ? 128 : 0); REFRESH(); x_to_bf16(F, XB); }
    SEAM(0);

    for (int l = 0; l < 2; ++l) {
        const int pb = 1 + 9 * l;
        if (IN(pb + 0)) for (int rep = 0; rep < NREP(0); ++rep) { if (rep) xcd_barrier(bar); pg8::Gemm g{XB, WA, DM, DM}; pg8::UnitOrder S; S.init(pg8::SK_PLAIN, 4096, DM, F.G, F.bid, 0); pg8::EpiMix E{Zm, F.out, l};
            pg8::gemm_phase<pg8::EpiMix, pg8::UnitOrder, true>(F.lds + RING_OFF, g, S, E, wave0);
            if (F.G == 256 && F.bid >= 32) {
                REFRESH(); const int gw = (F.bid - 32) * NWAVES + F.wave, NGW = 224 * NWAVES; const float* wbr = F.in[I_WBR] + (size_t)l * 4 * 512 * 1024;
                convert_matrix<RM_ID>(F, wbr, 512, 1024, Bt3, 2048, 0, 0, gw, NGW, 0);
                convert_matrix<RM_ID>(F, wbr + (size_t)512 * 1024, 512, 1024, Bt3, 2048, 512, 0, gw, NGW, 256);
                convert_matrix<RM_ID>(F, wbr + (size_t)3 * 512 * 1024, 512, 1024, Bt3, 2048, 1536, 0, gw, NGW, 512);
                convert_matrix<RM_ID>(F, F.in[I_WOUT] + (size_t)l * DM * DM, DM, DM, Bt4, DM, 0, 0, gw, NGW, 768);
                REFRESH(); compose_pool(F, l, Bt3, gw, NGW, 1280);
                REFRESH(); convert_matrix<RM_WIN>(F, F.in[I_WIN] + (size_t)l * DM * INC, DM, INC, WA, DM, 0, 0, gw, NGW, 0, 128, 128); } }
        SEAM(pb + 0);
        if (IN(pb + 1)) for (int rep = 0; rep < NREP(1); ++rep) { if (rep) xcd_barrier(bar);
            __syncthreads(); REFRESH();
            for (int r2 = 0; r2 < NREP2(0); ++r2) for (int it = F.bid; it < 256; it += F.G) { a_prompt_item(F, l, it, Zm, Y); __syncthreads(); }
            REFRESH();
            for (int r2 = 0; r2 < NREP2(1); ++r2) for (int it = (F.bid + 128) % F.G; it < 128; it += F.G) a_sample_task(F, l, 8 * it + F.wave, Zm, Y);
            __syncthreads(); REFRESH();
            const bool rebal = F.G == 256, gemm_wg = rebal && F.bid >= 128 && F.bid < 160;
            for (int r2 = 0; r2 < NREP2(2); ++r2) { if (!gemm_wg) for (int it = F.bid; it < 256; it += F.G) { b_prompt_item(F, l, it, Zm, Y); __syncthreads(); }
                if (rebal && F.bid >= 160 && F.bid < 192) { b_prompt_item(F, l, F.bid - 32, Zm, Y); __syncthreads(); } }
            REFRESH();
            for (int r2 = 0; r2 < NREP2(3); ++r2) { if (!gemm_wg) for (int it = F.bid; it < 256; it += F.G) { cd_prompt_item(F, l, it, Zm, Y); __syncthreads(); }
                if (rebal && F.bid >= 192 && F.bid < 224) { cd_prompt_item(F, l, F.bid - 64, Zm, Y); __syncthreads(); } }
            REFRESH();
            for (int r2 = 0; r2 < NREP2(4); ++r2) for (int it = F.bid; it < 128; it += F.G) { s_sample_item(F, l, it, Zm, Y); __syncthreads(); }
            if (F.G == 256 && F.bid >= 128 && F.bid < 160) {
                pg8::Gemm g{XB, WA + (size_t)4096 * DM, DM, DM}; pg8::UnitOrder S; S.init(pg8::SK_PLAIN, 4096, DM, 32, F.bid - 128, 0, false, true); pg8::EpiGate E{Gb};
                pg8::gemm_phase<pg8::EpiGate, pg8::UnitOrder, true>(F.lds + RING_OFF, g, S, E, wave0); }
            REFRESH();
            const float* wbr = F.in[I_WBR] + (size_t)l * 4 * 512 * 1024;
            if (F.G != 256) { const int gw = F.bid * NWAVES + F.wave, NGW = F.G * NWAVES;
                convert_matrix<RM_ID>(F, wbr, 512, 1024, Bt3, 2048, 0, 0, gw, NGW); convert_matrix<RM_ID>(F, wbr + (size_t)512 * 1024, 512, 1024, Bt3, 2048, 512, 0, gw, NGW);
                convert_matrix<RM_ID>(F, wbr + (size_t)3 * 512 * 1024, 512, 1024, Bt3, 2048, 1536, 0, gw, NGW); convert_matrix<RM_ID>(F, F.in[I_WOUT] + (size_t)l * DM * DM, DM, DM, Bt4, DM, 0, 0, gw, NGW);
                REFRESH(); compose_pool(F, l, Bt3, gw, NGW); }
        }
        SEAM(pb + 1);
        if (IN(pb + 2)) for (int rep = 0; rep < NREP(2); ++rep) { if (rep) xcd_barrier(bar); pg8::Gemm g{XB, WA + (size_t)4096 * DM, DM, DM}; pg8::UnitOrder S; S.init(pg8::SK_PLAIN, 4096, DM, F.G, F.bid, 0, true, F.G != 256); pg8::EpiGate E{Gb};
            pg8::gemm_phase<pg8::EpiGate, pg8::UnitOrder, true>(F.lds + RING_OFF, g, S, E, wave0); }
        SEAM(pb + 2);
        if (IN(pb + 3)) for (int rep = 0; rep < NREP(3); ++rep) { if (rep) xcd_barrier(bar); pg8::Gemm g{Y, Bt3, 2048, 2048}; pg8::UnitOrder S; S.init(pg8::SK_P3, DM, 2048, F.G, F.bid, 0); pg8::EpiMerge E{Gb, XB, (bf16*)(F.ws + WS_MB4S)};
            pg8::gemm_phase<pg8::EpiMerge, pg8::UnitOrder, true>(F.lds + RING_OFF, g, S, E, wave0);
            if (F.G == 256 && F.bid >= 32 && rep + 1 == NREP(3)) {
                REFRESH(); const int gw = (F.bid - 32) * NWAVES + F.wave, NGW = 224 * NWAVES;
                convert_matrix<RM_GU>(F, F.in[I_WG] + (size_t)l * DM * FF, DM, FF, Bt5, DM, 0, 0, gw, NGW, 0);
                convert_matrix<RM_GU>(F, F.in[I_WU] + (size_t)l * DM * FF, DM, FF, Bt5, DM, 0, 128, gw, NGW, 1408); } }
        SEAM(pb + 3);
        if (IN(pb + 4)) for (int rep = 0; rep < 1; ++rep) { pg8::Gemm g{XB, Bt4, DM, DM}; pg8::UnitOrder S; S.init(pg8::SK_P4, DM, DM, F.G, F.bid, (long)(WS_MB4S - WS_XB));
            pg8::EpiRes E{l == 0 ? F.in[I_XP] : F.out, F.out, XB, F.in[I_LN1G] + l * DM, F.in[I_LN1B] + l * DM, (float*)(F.ws + WS_SLAB),
                          pg8::PanelStats{(unsigned*)(F.ws + WS_XCH + (size_t)(2 * l) * 512 * 1024), (unsigned*)(F.ctl + CW_SEAM + (2 * l) * SEAM_BANK)}, F.lds + XLDS_OFF, wave0};
            pg8::gemm_phase<pg8::EpiRes, pg8::UnitOrder, true>(F.lds + RING_OFF, g, S, E, wave0);
}
        SEAM(pb + 4);
        if (IN(pb + 5)) for (int rep = 0; rep < NREP(5); ++rep) { if (rep) xcd_barrier(bar);
            REFRESH();
            ln_rows(F, F.out, rep + 1 < NREP(5) ? (float*)(F.ws + WS_Y) : F.out, F.in[I_LN1G] + l * DM, F.in[I_LN1B] + l * DM, rep + 1 < NREP(5) ? nullptr : XB, l == 0 ? F.in[I_XS] : F.out + (size_t)MP * DM, (const float*)(F.ws + WS_SLAB), 16);
            REFRESH();
            if (F.G != 256) { const int gw = F.bid * NWAVES + F.wave, NGW = F.G * NWAVES;
                convert_matrix<RM_GU>(F, F.in[I_WG] + (size_t)l * DM * FF, DM, FF, Bt5, DM, 0, 0, gw, NGW); convert_matrix<RM_GU>(F, F.in[I_WU] + (size_t)l * DM * FF, DM, FF, Bt5, DM, 0, 128, gw, NGW);
                convert_matrix<RM_ID>(F, F.in[I_WD] + (size_t)l * FF * DM, FF, DM, Bt6, FF, 0, 0, gw, NGW); }
        }
        SEAM(pb + 5);
        if (IN(pb + 6)) for (int rep = 0; rep < NREP(6); ++rep) { if (rep) xcd_barrier(bar); pg8::Gemm g{XB, Bt5, DM, DM}; pg8::UnitOrder S; S.init(pg8::SK_PLAIN, 2 * FF, DM, F.G, F.bid, 0); pg8::EpiSwi E{Hb};
            pg8::gemm_phase<pg8::EpiSwi, pg8::UnitOrder, true>(F.lds + RING_OFF, g, S, E, wave0);
            if (F.G == 256 && F.bid >= 172 && rep + 1 == NREP(6)) {
                REFRESH(); const int gw = (F.bid - 172) * NWAVES + F.wave, NGW = 84 * NWAVES;
                convert_matrix<RM_ID>(F, F.in[I_WD] + (size_t)l * FF * DM, FF, DM, Bt6, FF, 0, 0, gw, NGW, 0);
            } }
        SEAM(pb + 6);
        if (IN(pb + 7)) for (int rep = 0; rep < 1; ++rep) { pg8::Gemm g{Hb, Bt6, FF, FF}; pg8::UnitOrder S; S.init(pg8::SK_P6, DM, FF, F.G, F.bid, 0); pg8::EpiRes E{F.out, F.out, l == 0 ? XB : nullptr, F.in[I_LN2G] + l * DM, F.in[I_LN2B] + l * DM, (float*)(F.ws + WS_SLAB),
                          pg8::PanelStats{(unsigned*)(F.ws + WS_XCH + (size_t)(2 * l + 1) * 512 * 1024), (unsigned*)(F.ctl + CW_SEAM + (2 * l + 1) * SEAM_BANK)}, F.lds + XLDS_OFF, wave0};
            pg8::gemm_phase<pg8::EpiRes, pg8::UnitOrder, true>(F.lds + RING_OFF, g, S, E, wave0);
            if (F.G == 256 && F.bid >= 88 && l == 0) {
                REFRESH(); convert_matrix<RM_WIN>(F, F.in[I_WIN] + (size_t)DM * INC, DM, INC, WA, DM, 0, 0, (F.bid - 88) * NWAVES + F.wave, 168 * NWAVES, 0, 0, 128); } }
        SEAM(pb + 7);
        if (IN(pb + 8)) for (int rep = 0; rep < NREP(8); ++rep) { if (rep) xcd_barrier(bar);
            REFRESH();
            ln_rows(F, F.out, rep + 1 < NREP(8) ? (float*)(F.ws + WS_Y) : F.out, F.in[I_LN2G] + l * DM, F.in[I_LN2B] + l * DM, (l == 0 && rep + 1 == NREP(8)) ? XB : nullptr, F.out + (size_t)MP * DM, (const float*)(F.ws + WS_SLAB), 11);
            REFRESH();
            if (l == 0 && F.G != 256) convert_matrix<RM_WIN>(F, F.in[I_WIN] + (size_t)DM * INC, DM, INC, WA, DM, 0, 0, F.bid * NWAVES + F.wave, F.G * NWAVES);
        }
        if (l == 0) SEAM(pb + 8);
    }
#undef IN
#undef SEAM
#undef REFRESH
}

extern "C" void kernel_launch(void* const* d_in, const int* in_sizes, int n_in, void* d_out, int out_size, void* d_ws, size_t ws_size, hipStream_t stream) {
    static int grid = 0;
    if (grid == 0) {
        if (n_in != 31 || out_size != (int)O_END || ws_size < WS_END) { fprintf(stderr, "kernel_launch: unexpected sizes n_in %d out %d ws %zu\n", n_in, out_size, ws_size); grid = -1; return; }
        int dev = 0, cus = 0, per_cu = 0;
        if (hipGetDevice(&dev) != hipSuccess || hipDeviceGetAttribute(&cus, hipDeviceAttributeMultiprocessorCount, dev) != hipSuccess) { grid = -1; return; }
        if (hipFuncSetAttribute((const void*)hybrid_fwd, hipFuncAttributeMaxDynamicSharedMemorySize, LDS_BYTES) != hipSuccess) { fprintf(stderr, "kernel_launch: hipFuncSetAttribute failed\n"); grid = -1; return; }
        if (hipOccupancyMaxActiveBlocksPerMultiprocessor(&per_cu, (const void*)hybrid_fwd, NWAVES * 64, LDS_BYTES) != hipSuccess || per_cu < 1)
            fprintf(stderr, "kernel_launch: occupancy query reports %d workgroups per CU\n", per_cu);
        (void)hipGetLastError();
        grid = cus;
    }
    if (grid < 0) return;
    if (hipMemsetAsync((char*)d_ws + WS_CTL, 0, CTL_ZERO_BYTES, stream) != hipSuccess) { fprintf(stderr, "kernel_launch: memset failed\n"); return; }
    Args a{};
    for (int i = 0; i < 31; ++i) a.in[i] = (const float*)d_in[i];
    a.out = (float*)d_out; a.ws = (unsigned char*)d_ws;
#if MK_SPLIT
    for (int ph = 0; ph < NPHASE; ++ph) { a.ph_lo = ph; a.ph_hi = ph + 1; hipLaunchKernelGGL(hybrid_fwd, dim3(grid), dim3(NWAVES * 64), LDS_BYTES, stream, a); }
#else
    a.ph_lo = 0; a.ph_hi = NPHASE;
    hipLaunchKernelGGL(hybrid_fwd, dim3(grid), dim3(NWAVES * 64), LDS_BYTES, stream, a);
#endif
}
```

```cpp
#include <hip/hip_runtime.h>
#include <cstdio>
#include <cstdint>

#ifndef PROBE_REP
#define PROBE_REP 0
#endif
#define NREP(k) (1 + ((PROBE_REP >> (k)) & 1))
#ifndef PROBE2
#define PROBE2 0
#endif
#define NREP2(j) (1 + ((PROBE2 >> (j)) & 1))
#ifndef MK_SPLIT
#define MK_SPLIT 0
#endif

constexpr int DM = 1024, WMIX = 512, NPB = 8, SEQ = 2048, NSB = 128, DSEQ = 4;
constexpr int MP = NPB * SEQ, MS = NSB * DSEQ, M = MP + MS;
constexpr int FF = 2816, INC = 8192, ZC = 3072, YC = 2048, GC = 4096;
constexpr float LN_EPS = 1e-5f, ALPHA = 1.41421356237f;
constexpr size_t O_Y = 0, O_PH = (size_t)M * DM, O_PRGC = O_PH + 8192, O_PCF = O_PRGC + 24576, O_PPOOL = O_PCF + 245760, O_PSC = O_PPOOL + 122880,
                 O_SH = O_PSC + 16384, O_SRGC = O_SH + 131072, O_SCF = O_SRGC + 393216, O_SPOOL = O_SCF + 3932160, O_SSC = O_SPOOL + 1966080, O_END = O_SSC + 262144;
static_assert(O_END == 24403968, "output map");

__device__ __forceinline__ int opqv(int v) { asm volatile("" : "+v"(v)); return v; }
__device__ __forceinline__ int lane_now() { int l; asm volatile("v_mbcnt_lo_u32_b32 %0, -1, 0\n\tv_mbcnt_hi_u32_b32 %0, -1, %0" : "=v"(l)); return l; }
__device__ __forceinline__ int opqs(int v) { asm volatile("" : "+s"(v)); return v; }
namespace pg8 {
#define PG8_LAS __attribute__((address_space(3)))
typedef unsigned short bf16_t;
typedef short bf16x8 __attribute__((ext_vector_type(8)));
typedef float f32x4 __attribute__((ext_vector_type(4)));
typedef float f32x2 __attribute__((ext_vector_type(2)));
typedef unsigned u32x4 __attribute__((ext_vector_type(4)));
typedef unsigned u32x2 __attribute__((ext_vector_type(2)));
typedef _Float16 f16x4 __attribute__((ext_vector_type(4)));
typedef _Float16 f16x8 __attribute__((ext_vector_type(8)));
constexpr int BM = 256, BK = 64, HALF = 128, HTB = HALF * BK * 2, STAGE_BYTES = 8 * HTB, NXCD = 8, WGM = 8;

__host__ __device__ __forceinline__ int lds_byte(int r, int c) { const int st = (r >> 4) * 2 + (c >> 5), rr = r & 15, cc = c & 31, ob = rr * 64 + cc * 2; return st * 1024 + (ob ^ (((ob >> 9) & 1) << 5)); }
__host__ __device__ __forceinline__ void stage_rc(int b, int& R, int& C) { const int st = b / 1024, sb = b % 1024, swz = sb ^ (((sb >> 9) & 1) << 5); R = (st >> 1) * 16 + swz / 64; C = (st & 1) * 32 + (swz % 64) / 2; }
__host__ __device__ __forceinline__ int perm32(int rho) { const int n = rho >> 4, i = rho & 15; return 8 * (i >> 2) + 4 * n + (i & 3); }

struct Unit { int pm, pn, nt, mode, aux; long offA, offB; };
struct Gemm { const bf16_t* A; const bf16_t* Bt; int lda, ldb; };

enum { SK_PLAIN = 0, SK_P3 = 1, SK_P4 = 2, SK_P6 = 3 };
struct UnitOrder {
    int kind, nN, nwgP, nS, ntP, G, c; long offA_s; const unsigned* ready = nullptr; unsigned need = 0;
    __device__ __forceinline__ void init(int kind_, int N_, int K_, int G_, int c_, long offA_s_, bool prompt = true, bool sample = true) { kind = kind_; nN = N_ / BM; nwgP = prompt ? 64 * nN : 0; ntP = K_ / BK; G = G_; c = c_; offA_s = offA_s_;
        nS = !sample ? 0 : kind_ == SK_PLAIN ? 2 * nN : kind_ == SK_P3 ? 32 : kind_ == SK_P4 ? 128 : 88; }
    __device__ __forceinline__ bool next(int i, Unit& u, const Gemm& g) const {
        const long L = (long)i * G + c; const long ra = (long)BM * g.lda * 2, rb = (long)BM * g.ldb * 2;
        if (L < nwgP) {
            int wgid = (int)L; { const int q = nwgP / NXCD, xcd = wgid % NXCD, off = wgid / NXCD; wgid = xcd * q + off; }
            const int nig = WGM * nN; u.pm = (wgid / nig) * WGM + ((wgid % nig) % WGM); u.pn = (wgid % nig) / WGM;
            u.nt = ntP; u.mode = 0; u.aux = 0; u.offA = u.pm * ra; u.offB = u.pn * rb; return true; }
        const int s = (int)(L - nwgP); if (s >= nS) return false;
        if (kind == SK_PLAIN) { u.pm = 64 + (s & 1); u.pn = s >> 1; u.nt = ntP; u.mode = 0; u.aux = 0; u.offA = u.pm * ra; u.offB = u.pn * rb; }
        else if (kind == SK_P3) { const int n = s & 3, tile = s >> 2; u.pm = 64 + (tile & 1); u.pn = tile >> 1; u.nt = 8; u.mode = 1; u.aux = n; u.offA = u.pm * ra + 1024 * n; u.offB = u.pn * rb + 1024 * n; }
        else if (kind == SK_P4) { const int ch = s & 15, tile = s >> 4, n = ch >> 2, kin = (ch & 3) * 256; u.pm = 64 + (tile & 1); u.pn = tile >> 1; u.nt = 4; u.mode = 1; u.aux = ch;
            u.offA = offA_s + ((long)(n * 512 + (u.pm - 64) * 256) * 1024 + kin) * 2; u.offB = u.pn * rb + kin * 2; }
        else { const int ch = s % 11, tile = s / 11; u.pm = 64 + (tile & 1); u.pn = tile >> 1; u.nt = 4; u.mode = 1; u.aux = ch; u.offA = u.pm * ra + 512 * ch; u.offB = u.pn * rb + 512 * ch; }
        return true;
    }
    __device__ __forceinline__ void a_ready(const Unit& u, int wid) const {
        if (ready == nullptr || u.pm < 64) return;
        if (wid == 0) { unsigned spins = 0;
            while ((unsigned)__builtin_amdgcn_readfirstlane(__hip_atomic_load(ready, __ATOMIC_RELAXED, __HIP_MEMORY_SCOPE_AGENT)) < need) { __builtin_amdgcn_s_sleep(2); if (++spins > (1u << 20)) break; }
            __builtin_amdgcn_fence(__ATOMIC_ACQUIRE, "agent");
            asm volatile("s_waitcnt vmcnt(0)" ::: "memory"); }
        asm volatile("" ::: "memory"); __builtin_amdgcn_s_barrier(); asm volatile("" ::: "memory");
    }
};

__device__ __forceinline__ unsigned cvt_pk_bf16(float lo, float hi) { unsigned r; asm volatile("v_cvt_pk_bf16_f32 %0, %1, %2" : "=v"(r) : "v"(lo), "v"(hi)); return r; }
__device__ __forceinline__ float sigmoidf_fast(float x) { return __builtin_amdgcn_rcpf(1.0f + __builtin_amdgcn_exp2f(-1.44269504089f * x)); }
__device__ __forceinline__ float gelu_tanh(float x) { const float t = x * x, y = x * fmaf(t, -0.10294324f, -2.3022082f); return x * __builtin_amdgcn_rcpf(1.0f + __builtin_amdgcn_exp2f(y)); }

__device__ __forceinline__ void acc_zero(f32x4 (&acc)[2][2][4][2]) {
#pragma unroll
    for (int a = 0; a < 2; ++a)
#pragma unroll
        for (int b = 0; b < 2; ++b)
#pragma unroll
            for (int m = 0; m < 4; ++m)
#pragma unroll
                for (int n = 0; n < 2; ++n) acc[a][b][m][n] = (f32x4){0.f, 0.f, 0.f, 0.f};
}
__device__ __forceinline__ float* state_ptr(float* out, int R, int keep, int layer, size_t p_off, size_t s_off) {
    if (R < MP) { const int b = R >> 11, j = (R & 2047) - (2048 - keep); return j < 0 ? nullptr : out + p_off + (size_t)((layer * 8 + b) * keep + j) * 512; }
    const int s = (R - MP) >> 2, j = (R & 3) + keep - 4; return j < 0 ? nullptr : out + s_off + (size_t)((layer * 128 + s) * keep + j) * 512;
}

struct EpiMix {
    static constexpr bool PERM = true, MIDK = false;
    __device__ __forceinline__ void init(f32x4 (&acc)[2][2][4][2], const Unit&, int, int) const { acc_zero(acc); }
    bf16_t* Z; float* out; int layer;
    __device__ __forceinline__ void midk(f32x4 (&)[2][2][4][2], const Unit&, int, int, int, int, int) const {}
    __device__ __forceinline__ void operator()(f32x4 (&acc)[2][2][4][2], const Unit& u, int wr, int wc, int fr_, int fq_) const {
        const int lane_ = lane_now(), fr = lane_ & 15, fq = lane_ >> 4; (void)fr_; (void)fq_;
        const int pn = u.pn; int type, zcol, keep = 0, scol = 0; size_t poff = 0, soff = 0;
        if (pn < 2) { type = 0; zcol = 256 * pn; keep = 3; scol = zcol; poff = O_PRGC; soff = O_SRGC; }
        else if (pn < 4) { type = 1; zcol = 512 + 256 * (pn - 2); }
        else if (pn < 8) { type = 2; zcol = 1024 + 128 * (pn - 4); keep = 30; scol = 128 * (pn - 4); poff = O_PCF; soff = O_SCF; }
        else if (pn < 10) { type = 0; zcol = 1536 + 256 * (pn - 8); keep = 15; scol = 256 * (pn - 8); poff = O_PPOOL; soff = O_SPOOL; }
        else if (pn < 12) { type = 0; zcol = 2048 + 256 * (pn - 10); }
        else { type = 3; zcol = 2560 + 128 * (pn - 12); keep = 2; scol = 128 * (pn - 12); poff = O_PSC; soff = O_SSC; }
        const bool tail = keep != 0 && (u.pm >= 64 || (u.pm & 7) == 7);
        const int row0 = u.pm * BM + wr * 64 + fr, cl = wc * 32 + 8 * fq;
        if (type < 2) {
#pragma unroll
            for (int ai = 0; ai < 2; ++ai)
#pragma unroll
                for (int m = 0; m < 4; ++m) { const int R = row0 + ai * HALF + m * 16; bf16_t* rowp = Z + (size_t)R * ZC + zcol + cl;
                    float* sp = tail ? state_ptr(out, R, keep, layer, poff, soff) : nullptr;
#pragma unroll
                    for (int bj = 0; bj < 2; ++bj) { f32x4 v0 = acc[ai][bj][m][0], v1 = acc[ai][bj][m][1];
                        if (type == 1) { v0 = (f32x4){gelu_tanh(v0[0]), gelu_tanh(v0[1]), gelu_tanh(v0[2]), gelu_tanh(v0[3])}; v1 = (f32x4){gelu_tanh(v1[0]), gelu_tanh(v1[1]), gelu_tanh(v1[2]), gelu_tanh(v1[3])}; }
                        u32x4 w; w.x = cvt_pk_bf16(v0[0], v0[1]); w.y = cvt_pk_bf16(v0[2], v0[3]); w.z = cvt_pk_bf16(v1[0], v1[1]); w.w = cvt_pk_bf16(v1[2], v1[3]);
                        *(u32x4*)(rowp + bj * HALF) = w;
                        if (sp) { *(f32x4*)(sp + scol + cl + bj * HALF) = v0; *(f32x4*)(sp + scol + cl + bj * HALF + 4) = v1; } } }
        } else {
#pragma unroll
            for (int ai = 0; ai < 2; ++ai)
#pragma unroll
                for (int m = 0; m < 4; ++m) { const int R = row0 + ai * HALF + m * 16; bf16_t* rowp = Z + (size_t)R * ZC + zcol + cl;
                    float* sp = tail ? state_ptr(out, R, keep, layer, poff, soff) : nullptr;
                    f32x4 v0, v1; const f32x4 a0 = acc[ai][0][m][0], a1 = acc[ai][0][m][1], b0 = acc[ai][1][m][0], b1 = acc[ai][1][m][1];
                    if (type == 2) {
#pragma unroll
                        for (int i = 0; i < 4; ++i) { v0[i] = a0[i] * sigmoidf_fast(b0[i]); v1[i] = a1[i] * sigmoidf_fast(b1[i]); }
                    } else { v0 = a0 * b0; v1 = a1 * b1; }
                    u32x4 w; w.x = cvt_pk_bf16(v0[0], v0[1]); w.y = cvt_pk_bf16(v0[2], v0[3]); w.z = cvt_pk_bf16(v1[0], v1[1]); w.w = cvt_pk_bf16(v1[2], v1[3]);
                    *(u32x4*)rowp = w;
                    if (sp) { *(f32x4*)(sp + scol + cl) = v0; *(f32x4*)(sp + scol + cl + 4) = v1; } }
        }
    }
};

struct EpiGate {
    static constexpr bool PERM = true, MIDK = false;
    __device__ __forceinline__ void init(f32x4 (&acc)[2][2][4][2], const Unit&, int, int) const { acc_zero(acc); }
    _Float16* G;
    __device__ __forceinline__ void midk(f32x4 (&)[2][2][4][2], const Unit&, int, int, int, int, int) const {}
    __device__ __forceinline__ void operator()(f32x4 (&acc)[2][2][4][2], const Unit& u, int wr, int wc, int fr_, int fq_) const {
        const int lane_ = lane_now(), fr = lane_ & 15, fq = lane_ >> 4; (void)fr_; (void)fq_;
        const int row0 = u.pm * BM + wr * 64 + fr, ch0 = 64 * u.pn + 16 * wc + 4 * fq; const bool plain = u.pm >= 64;
#pragma unroll
        for (int ai = 0; ai < 2; ++ai)
#pragma unroll
            for (int m = 0; m < 4; ++m) { const int R = row0 + ai * HALF + m * 16; _Float16* gp = G + (size_t)R * GC + ch0;
                f16x4 r0, r1, r2, g3;
#pragma unroll
                for (int i = 0; i < 4; ++i) {
                    const float d0 = 1.f + __builtin_amdgcn_exp2f(__builtin_amdgcn_fmed3f(acc[ai][0][m][0][i], -15.f, 15.f)), d1 = 1.f + __builtin_amdgcn_exp2f(__builtin_amdgcn_fmed3f(acc[ai][0][m][1][i], -15.f, 15.f));
                    const float d2 = 1.f + __builtin_amdgcn_exp2f(__builtin_amdgcn_fmed3f(acc[ai][1][m][0][i], -15.f, 15.f)), d3 = 1.f + __builtin_amdgcn_exp2f(__builtin_amdgcn_fmed3f(acc[ai][1][m][1][i], -15.f, 15.f));
                    const float i0 = __builtin_amdgcn_rcpf(d0), i1 = __builtin_amdgcn_rcpf(d1), i2 = __builtin_amdgcn_rcpf(d2), i3 = __builtin_amdgcn_rcpf(d3);
                    if (plain) { r0[i] = (_Float16)i0; r1[i] = (_Float16)i1; r2[i] = (_Float16)i2; }
                    else { r0[i] = (_Float16)(d1 * i0); r1[i] = (_Float16)(d2 * i1); r2[i] = (_Float16)(d3 * i2); }
                    g3[i] = (_Float16)i3; }
                *(f16x4*)(gp) = r0; *(f16x4*)(gp + 1024) = r1; *(f16x4*)(gp + 2048) = r2; *(f16x4*)(gp + 3072) = g3; }
    }
};

struct EpiMerge {
    static constexpr bool PERM = true, MIDK = true;
    __device__ __forceinline__ void init(f32x4 (&acc)[2][2][4][2], const Unit&, int, int) const { acc_zero(acc); }
    const _Float16* G; bf16_t* O; bf16_t* Os;
    __device__ __forceinline__ void scale(f32x4 (&acc)[2][2][4][2], const Unit& u, int seg, int wr, int wc) const {
        const int lane_ = lane_now(), fr = lane_ & 15, fq = lane_ >> 4;
        const int row0 = u.pm * BM + wr * 64 + fr, c0 = 1024 * seg + 256 * u.pn + wc * 32 + 8 * fq;
#pragma unroll
        for (int ai = 0; ai < 2; ++ai)
#pragma unroll
            for (int m = 0; m < 4; ++m) { const _Float16* gp = G + (size_t)(row0 + ai * HALF + m * 16) * GC + c0;
#pragma unroll
                for (int bj = 0; bj < 2; ++bj) { const f16x8 f = *(const f16x8*)(gp + bj * HALF);
                    acc[ai][bj][m][0] *= (f32x4){(float)f[0], (float)f[1], (float)f[2], (float)f[3]}; acc[ai][bj][m][1] *= (f32x4){(float)f[4], (float)f[5], (float)f[6], (float)f[7]}; } }
    }
    __device__ __forceinline__ void midk(f32x4 (&acc)[2][2][4][2], const Unit& u, int seg, int wr, int wc, int, int) const { scale(acc, u, seg, wr, wc); }
    __device__ __forceinline__ void operator()(f32x4 (&acc)[2][2][4][2], const Unit& u, int wr, int wc, int, int) const {
        scale(acc, u, u.mode ? u.aux : 3, wr, wc);
        const int lane_ = lane_now(), fr = lane_ & 15, fq = lane_ >> 4;
        const int row0 = (u.mode ? (u.pm - 64) * BM + 512 * u.aux : u.pm * BM) + wr * 64 + fr, c0 = 256 * u.pn + wc * 32 + 8 * fq;
        bf16_t* O = u.mode ? Os : this->O;
#pragma unroll
        for (int ai = 0; ai < 2; ++ai)
#pragma unroll
            for (int m = 0; m < 4; ++m) { bf16_t* rowp = O + (size_t)(row0 + ai * HALF + m * 16) * DM + c0;
#pragma unroll
                for (int bj = 0; bj < 2; ++bj) { const f32x4 v0 = acc[ai][bj][m][0], v1 = acc[ai][bj][m][1];
                    u32x4 w; w.x = cvt_pk_bf16(v0[0], v0[1]); w.y = cvt_pk_bf16(v0[2], v0[3]); w.z = cvt_pk_bf16(v1[0], v1[1]); w.w = cvt_pk_bf16(v1[2], v1[3]); *(u32x4*)(rowp + bj * HALF) = w; } }
    }
};

struct PanelStats {
    unsigned* xbuf;
    unsigned* cnt;
    __device__ __forceinline__ void run(const f32x4 (&v)[2][2][4][2], const Unit& u, int wr, int wc, PG8_LAS unsigned char* lds, int wid) const {
        const int lane = lane_now(), fr = lane & 15, fq = lane >> 4;
        PG8_LAS f32x2* P = (PG8_LAS f32x2*)lds;
        PG8_LAS f32x2* S = (PG8_LAS f32x2*)(lds + 8192);
#pragma unroll
        for (int ai = 0; ai < 2; ++ai)
#pragma unroll
            for (int m = 0; m < 4; ++m) {
                float s = 0.f;
#pragma unroll
                for (int bj = 0; bj < 2; ++bj)
#pragma unroll
                    for (int n = 0; n < 2; ++n) { const f32x4 x = v[ai][bj][m][n]; s += (x[0] + x[1]) + (x[2] + x[3]); }
                s += __builtin_bit_cast(float, __builtin_amdgcn_ds_bpermute((lane ^ 16) << 2, __builtin_bit_cast(int, s))); s += __builtin_bit_cast(float, __builtin_amdgcn_ds_bpermute((lane ^ 32) << 2, __builtin_bit_cast(int, s)));
                const float mw = s * (1.0f / 64.0f); float q = 0.f;
#pragma unroll
                for (int bj = 0; bj < 2; ++bj)
#pragma unroll
                    for (int n = 0; n < 2; ++n) { const f32x4 d = v[ai][bj][m][n] - mw; q += (d[0] * d[0] + d[1] * d[1]) + (d[2] * d[2] + d[3] * d[3]); }
                q += __builtin_bit_cast(float, __builtin_amdgcn_ds_bpermute((lane ^ 16) << 2, __builtin_bit_cast(int, q))); q += __builtin_bit_cast(float, __builtin_amdgcn_ds_bpermute((lane ^ 32) << 2, __builtin_bit_cast(int, q)));
                if (fq == 0) P[(ai * HALF + wr * 64 + m * 16 + fr) * 4 + wc] = (f32x2){mw, q};
            }
        asm volatile("s_waitcnt lgkmcnt(0)" ::: "memory"); __builtin_amdgcn_s_barrier(); asm volatile("" ::: "memory");
        const int row = wid * 32 + (lane & 31);
        if (lane < 32) {
            const f32x2 a = P[row * 4 + 0], b = P[row * 4 + 1], c = P[row * 4 + 2], d = P[row * 4 + 3];
            const float mt = (a.x + b.x + c.x + d.x) * 0.25f;
            const float da = a.x - mt, db = b.x - mt, dc = c.x - mt, dd = d.x - mt;
            const float m2 = (a.y + b.y) + (c.y + d.y) + 64.0f * ((da * da + db * db) + (dc * dc + dd * dd));
            unsigned long long* slot = (unsigned long long*)xbuf + ((size_t)(u.pm * BM + row) * 4 + u.pn);
            __hip_atomic_store(slot, ((unsigned long long)__float_as_uint(m2) << 32) | __float_as_uint(mt), __ATOMIC_RELAXED, __HIP_MEMORY_SCOPE_AGENT);
        }
        asm volatile("s_waitcnt vmcnt(0)" ::: "memory");
        if (lane == 0) __hip_atomic_fetch_add(cnt + 64 * u.pm, 1u, __ATOMIC_RELAXED, __HIP_MEMORY_SCOPE_AGENT);
        if (wid == 0) {
            unsigned spins = 0;
            while ((unsigned)__builtin_amdgcn_readfirstlane(__hip_atomic_load(cnt + 64 * u.pm, __ATOMIC_RELAXED, __HIP_MEMORY_SCOPE_AGENT)) < 32u) { __builtin_amdgcn_s_sleep(2); if (++spins > (1u << 20)) break; }
            __builtin_amdgcn_fence(__ATOMIC_ACQUIRE, "agent");
        }
        asm volatile("s_waitcnt vmcnt(0) lgkmcnt(0)" ::: "memory"); __builtin_amdgcn_s_barrier(); asm volatile("" ::: "memory");
        if (lane < 32) {
            const unsigned long long* slot = (const unsigned long long*)xbuf + (size_t)(u.pm * BM + row) * 4; float mt[4], m2[4]; float ms = 0.f;
#pragma unroll
            for (int t = 0; t < 4; ++t) { const unsigned long long w = __hip_atomic_load(slot + t, __ATOMIC_RELAXED, __HIP_MEMORY_SCOPE_AGENT); mt[t] = __uint_as_float((unsigned)w); m2[t] = __uint_as_float((unsigned)(w >> 32)); ms += mt[t]; }
            const float mean = ms * 0.25f; float q = 0.f;
#pragma unroll
            for (int t = 0; t < 4; ++t) { const float dm = mt[t] - mean; q += m2[t] + 256.0f * dm * dm; }
            S[row] = (f32x2){mean, __builtin_amdgcn_rsqf(q * (1.0f / 1024.0f) + LN_EPS)};
        }
        asm volatile("s_waitcnt lgkmcnt(0)" ::: "memory"); __builtin_amdgcn_s_barrier(); asm volatile("" ::: "memory");
    }
};
struct EpiRes {
    static constexpr bool PERM = false, MIDK = false;
    __device__ __forceinline__ void init(f32x4 (&acc)[2][2][4][2], const Unit& u, int wr, int wc) const {
        if (u.mode) { acc_zero(acc); return; }
        const int lane_ = lane_now(), fr = lane_ & 15, fq = lane_ >> 4;
        const float* bp0 = baseP + (size_t)(u.pm * BM + wr * 64 + fr) * DM + 256 * u.pn + wc * 32 + 4 * fq;
#pragma unroll
        for (int ai = 0; ai < 2; ++ai)
#pragma unroll
            for (int m = 0; m < 4; ++m)
#pragma unroll
                for (int bj = 0; bj < 2; ++bj)
#pragma unroll
                    for (int n = 0; n < 2; ++n) acc[ai][bj][m][n] = *(const f32x4*)(bp0 + (size_t)(ai * HALF + m * 16) * DM + bj * HALF + n * 16) * ALPHA;
    }
    const float* baseP; float* out; bf16_t* xb; const float* lng; const float* lnb; float* slab; PanelStats st; PG8_LAS unsigned char* xlds; int wid;
    __device__ __forceinline__ void midk(f32x4 (&)[2][2][4][2], const Unit&, int, int, int, int, int) const {}
    __device__ __forceinline__ void operator()(f32x4 (&acc)[2][2][4][2], const Unit& u, int wr, int wc, int fr_, int fq_) const {
        const int lane_ = lane_now(), fr = lane_ & 15, fq = lane_ >> 4; (void)fr_; (void)fq_;
        const int row0 = u.pm * BM + wr * 64 + fr, c0 = 256 * u.pn + wc * 32 + 4 * fq;
        if (u.mode) {
#pragma unroll
            for (int ai = 0; ai < 2; ++ai)
#pragma unroll
                for (int m = 0; m < 4; ++m) { float* op = slab + ((size_t)u.aux * 512 + (row0 - MP) + ai * HALF + m * 16) * DM + c0;
#pragma unroll
                    for (int bj = 0; bj < 2; ++bj)
#pragma unroll
                        for (int n = 0; n < 2; ++n) *(f32x4*)(op + bj * HALF + n * 16) = acc[ai][bj][m][n]; }
            return; }
        st.run(acc, u, wr, wc, xlds, wid);
        const PG8_LAS f32x2* S = (const PG8_LAS f32x2*)(xlds + 8192);
#pragma unroll
        for (int bj = 0; bj < 2; ++bj)
#pragma unroll
            for (int n = 0; n < 2; ++n) { const int cc = c0 + bj * HALF + n * 16; const f32x4 gv = *(const f32x4*)(lng + cc), bv = *(const f32x4*)(lnb + cc);
#pragma unroll
                for (int ai = 0; ai < 2; ++ai)
#pragma unroll
                    for (int m = 0; m < 4; ++m) { const int r = ai * HALF + wr * 64 + m * 16 + fr; const f32x2 sr = S[r]; const size_t off = (size_t)(u.pm * BM + r) * DM + cc;
                        const f32x4 o = (acc[ai][bj][m][n] - sr.x) * sr.y * gv + bv; *(f32x4*)(out + off) = o;
                        if (xb) { u32x2 w; w.x = cvt_pk_bf16(o[0], o[1]); w.y = cvt_pk_bf16(o[2], o[3]); *(u32x2*)(xb + off) = w; }
                        if (m & 1) asm volatile("" ::: "memory"); } }
    }
};

struct EpiSwi {
    static constexpr bool PERM = true, MIDK = false;
    __device__ __forceinline__ void init(f32x4 (&acc)[2][2][4][2], const Unit&, int, int) const { acc_zero(acc); }
    bf16_t* H;
    __device__ __forceinline__ void midk(f32x4 (&)[2][2][4][2], const Unit&, int, int, int, int, int) const {}
    __device__ __forceinline__ void operator()(f32x4 (&acc)[2][2][4][2], const Unit& u, int wr, int wc, int fr_, int fq_) const {
        const int lane_ = lane_now(), fr = lane_ & 15, fq = lane_ >> 4; (void)fr_; (void)fq_;
        const int row0 = u.pm * BM + wr * 64 + fr, c0 = 128 * u.pn + wc * 32 + 8 * fq;
#pragma unroll
        for (int ai = 0; ai < 2; ++ai)
#pragma unroll
            for (int m = 0; m < 4; ++m) { bf16_t* rowp = H + (size_t)(row0 + ai * HALF + m * 16) * FF + c0;
                const f32x4 g0 = acc[ai][0][m][0], g1 = acc[ai][0][m][1], u0 = acc[ai][1][m][0], u1 = acc[ai][1][m][1]; f32x4 v0, v1;
#pragma unroll
                for (int i = 0; i < 4; ++i) { v0[i] = g0[i] * sigmoidf_fast(g0[i]) * u0[i]; v1[i] = g1[i] * sigmoidf_fast(g1[i]) * u1[i]; }
                u32x4 w; w.x = cvt_pk_bf16(v0[0], v0[1]); w.y = cvt_pk_bf16(v0[2], v0[3]); w.z = cvt_pk_bf16(v1[0], v1[1]); w.w = cvt_pk_bf16(v1[2], v1[3]);
                *(u32x4*)rowp = w; }
    }
};

template <class Epi, class Sched, bool ALIGN_EPI>
__device__ __forceinline__ void gemm_phase(PG8_LAS unsigned char* lds, const Gemm g, const Sched& S, const Epi& E, int wave_id) {
    const int wid = opqs(wave_id), lane = lane_now(), tid = wid * 64 + lane, wr = wid >> 2, wc = wid & 3, fr = lane & 15, fq = lane >> 4;
    unsigned voffA[2], voffB[2];
#pragma unroll
    for (int i = 0; i < 2; ++i) { int R, C; stage_rc(tid * 16 + i * 8192, R, C); const int Rb = Epi::PERM ? ((R & ~31) + perm32(R & 31)) : R;
        voffA[i] = (unsigned)(R * g.lda + C) * 2u; voffB[i] = (unsigned)(Rb * g.ldb + C) * 2u; }
    const size_t kstep = (size_t)(BK * 2);
    const size_t hstepA = (size_t)HALF * g.lda * 2, hstepB = (size_t)HALF * g.ldb * 2;
    const unsigned ldsw = (unsigned)wid * 1024u;
    const int aoff = lds_byte(wr * 64 + fr, fq * 8), boff = lds_byte(wc * 32 + fr, fq * 8);
#define PG8_SA(b, h) (((b) * 2 + (h)) * HTB)
#define PG8_SB(b, h) ((4 + (b) * 2 + (h)) * HTB)
#define PG8_STAGE(bufoff, gbase, voff) do { _Pragma("unroll") for (int _i = 0; _i < 2; ++_i) \
        __builtin_amdgcn_global_load_lds((const unsigned*)((const char*)(gbase) + (voff)[_i]), (PG8_LAS unsigned*)(lds + (bufoff) + ldsw + _i * 8192), 16, 0, 0); } while (0)
#define PG8_LDA(dst, b, h) do { _Pragma("unroll") for (int m = 0; m < 4; ++m) _Pragma("unroll") for (int k = 0; k < 2; ++k) dst[m][k] = *(const PG8_LAS bf16x8*)(lds + PG8_SA(b, h) + aoff + m * 2048 + k * 1024); } while (0)
#define PG8_LDB(dst, b, h) do { _Pragma("unroll") for (int n = 0; n < 2; ++n) _Pragma("unroll") for (int k = 0; k < 2; ++k) dst[n][k] = *(const PG8_LAS bf16x8*)(lds + PG8_SB(b, h) + boff + n * 2048 + k * 1024); } while (0)
#define PG8_MMA(ai, bj, At, Bt) do { __builtin_amdgcn_s_setprio(1); _Pragma("unroll") for (int m = 0; m < 4; ++m) _Pragma("unroll") for (int n = 0; n < 2; ++n) _Pragma("unroll") for (int k = 0; k < 2; ++k) \
        acc[ai][bj][m][n] = __builtin_amdgcn_mfma_f32_16x16x32_bf16(Bt[n][k], At[m][k], acc[ai][bj][m][n], 0, 0, 0); __builtin_amdgcn_s_setprio(0); } while (0)
#define PG8_WAIT_V(n) asm volatile("s_waitcnt vmcnt(" #n ")" ::: "memory")
#define PG8_WAIT_L(n) asm volatile("s_waitcnt lgkmcnt(" #n ")" ::: "memory")
#define PG8_BAR __builtin_amdgcn_s_barrier()
#define PG8_SCHED __builtin_amdgcn_sched_barrier(0)
    Unit cur, nxt; int ui = 0;
    if (!S.next(0, cur, g)) return;
    f32x4 acc[2][2][4][2];
    E.init(acc, cur, wr, wc);
    bf16x8 At[4][2], B0[2][2], B1[2][2];
    const char* cA = (const char*)g.A + cur.offA; const char* cB = (const char*)g.Bt + cur.offB;
    PG8_STAGE(PG8_SB(0, 0), cB, voffB); PG8_STAGE(PG8_SB(0, 1), cB + hstepB, voffB); PG8_STAGE(PG8_SA(0, 0), cA, voffA); PG8_STAGE(PG8_SA(0, 1), cA + hstepA, voffA);
    if (wr == 1) PG8_BAR;
    PG8_WAIT_V(2); PG8_BAR;
    PG8_STAGE(PG8_SB(1, 0), cB + kstep, voffB); PG8_STAGE(PG8_SA(1, 0), cA + kstep, voffA); PG8_STAGE(PG8_SB(1, 1), cB + hstepB + kstep, voffB);
    PG8_WAIT_V(6); PG8_BAR;
    for (;;) {
        const bool has_next = S.next(ui + 1, nxt, g);
        const char* nA = has_next ? (const char*)g.A + nxt.offA : cA; const char* nB = has_next ? (const char*)g.Bt + nxt.offB : cB;
        const int nt = cur.nt, TSEG = Epi::MIDK ? 8 : nt;
        for (int t0 = 0; t0 < nt; t0 += TSEG) {
        if constexpr (Epi::MIDK) { if (t0 != 0) { PG8_SCHED; E.midk(acc, cur, t0 / TSEG - 1, wr, wc, 0, 0); PG8_SCHED; } }
#pragma unroll 1
        for (int t = t0; t < t0 + TSEG; t += 2) {
            const bool last = (t == nt - 2);
            if (last && has_next) S.a_ready(nxt, wid);
            const char* a1 = cA + (size_t)(t + 1) * kstep;
            const char* a2 = last ? nA : cA + (size_t)(t + 2) * kstep; const char* b2 = last ? nB : cB + (size_t)(t + 2) * kstep;
            const char* a3 = a2 + kstep; const char* b3 = b2 + kstep;
            PG8_LDB(B0, 0, 0); PG8_LDB(B1, 0, 1); PG8_SCHED; PG8_LDA(At, 0, 0); PG8_STAGE(PG8_SA(1, 1), a1 + hstepA, voffA);
            PG8_WAIT_V(8); PG8_WAIT_L(0); PG8_BAR; PG8_MMA(0, 0, At, B0); PG8_MMA(0, 1, At, B1); PG8_BAR; PG8_SCHED;
            PG8_LDA(At, 0, 1); PG8_STAGE(PG8_SB(0, 0), b2, voffB); PG8_STAGE(PG8_SB(0, 1), b2 + hstepB, voffB); PG8_STAGE(PG8_SA(0, 0), a2, voffA);
            PG8_WAIT_V(8); PG8_WAIT_L(0); PG8_BAR; PG8_MMA(1, 0, At, B0); PG8_MMA(1, 1, At, B1); PG8_BAR; PG8_SCHED;
            PG8_LDB(B0, 1, 0); PG8_LDB(B1, 1, 1); PG8_SCHED; PG8_LDA(At, 1, 0); PG8_STAGE(PG8_SA(0, 1), a2 + hstepA, voffA);
            PG8_WAIT_V(8); PG8_WAIT_L(0); PG8_BAR; PG8_MMA(0, 0, At, B0); PG8_MMA(0, 1, At, B1); PG8_BAR; PG8_SCHED;
            PG8_LDA(At, 1, 1); PG8_STAGE(PG8_SB(1, 0), b3, voffB); PG8_STAGE(PG8_SB(1, 1), b3 + hstepB, voffB); PG8_STAGE(PG8_SA(1, 0), a3, voffA);
            PG8_WAIT_V(8); PG8_WAIT_L(0); PG8_BAR; PG8_MMA(1, 0, At, B0); PG8_MMA(1, 1, At, B1); PG8_BAR; PG8_SCHED;
        }
        }
        if constexpr (ALIGN_EPI) { if (wr == 0) PG8_BAR; }
        E(acc, cur, wr, wc, 0, 0);
        if (!has_next) break;
        cur = nxt; cA = nA; cB = nB; ++ui;
        E.init(acc, cur, wr, wc);
        if constexpr (ALIGN_EPI) { if (wr == 1) PG8_BAR; }
    }
    PG8_WAIT_V(0);
    if constexpr (!ALIGN_EPI) { if (wr == 0) PG8_BAR; }
    PG8_BAR;
#undef PG8_SA
#undef PG8_SB
#undef PG8_STAGE
#undef PG8_LDA
#undef PG8_LDB
#undef PG8_MMA
#undef PG8_WAIT_V
#undef PG8_WAIT_L
#undef PG8_BAR
#undef PG8_SCHED
}
}

constexpr int NWAVES = 8;
constexpr int NPHASE = 19;
constexpr size_t MiB = 1u << 20;
constexpr size_t WS_CTL = 0, CTL_ZERO_BYTES = 1 * MiB;
constexpr size_t WS_WA = 1 * MiB;
constexpr size_t WS_XB = 18 * MiB;
constexpr size_t WS_Y = 51 * MiB;
constexpr size_t WS_ZG = 117 * MiB;
constexpr size_t WS_BT3 = 249 * MiB, WS_BT4 = 253 * MiB, WS_BT5 = WS_WA, WS_BT6 = WS_ZG + 108 * MiB;
constexpr size_t WS_MB4S = WS_WA + 13 * MiB;
constexpr size_t WS_SLAB = WS_Y;
constexpr size_t WS_END = 255 * MiB;
static_assert(WS_XB + (size_t)M * DM * 2 <= WS_Y && WS_Y + (size_t)M * YC * 2 <= WS_ZG && WS_ZG + (size_t)M * GC * 2 <= WS_BT3 && WS_SLAB + (size_t)16 * 512 * DM * 4 <= WS_Y + 40 * MiB && WS_Y + 40 * MiB + 4 * 512 * 1024 <= WS_ZG, "ws map");
static_assert((size_t)M * FF * 2 <= 108 * MiB && WS_BT5 + (size_t)2 * FF * DM * 2 <= WS_MB4S && WS_MB4S + 4 * MiB <= WS_XB && WS_BT6 + (size_t)DM * FF * 2 <= WS_BT3, "ws map 2");
constexpr int CW_RDY = 12288;
constexpr int CW_TMO = 0, CW_CODE = 1, CW_BAR = 4096, CW_SEAM = 16384, SEAM_BANK = 8192;
constexpr size_t WS_XCH = WS_Y + 40 * MiB;
constexpr int XLDS_OFF = 131072 + 1024;
constexpr int RING_OFF = 0, RING_BYTES = 131072;
constexpr int LDSCTL_OFF = RING_BYTES, MISC_OFF = LDSCTL_OFF + 320;
constexpr int LDS_BYTES = 147456;

#define GAS __attribute__((address_space(1)))
#define LAS __attribute__((address_space(3)))
typedef unsigned short bf16;
typedef unsigned v4u __attribute__((ext_vector_type(4)));
typedef unsigned v2u __attribute__((ext_vector_type(2)));
typedef float f32x4 __attribute__((ext_vector_type(4)));
typedef float f32x2 __attribute__((ext_vector_type(2)));
typedef short bf16x8 __attribute__((ext_vector_type(8)));
typedef GAS unsigned gu32;
#define RLX_AGENT __ATOMIC_RELAXED, __HIP_MEMORY_SCOPE_AGENT
#define LDS_WAIT() asm volatile("s_waitcnt lgkmcnt(0)" ::: "memory")
#define VM_WAIT() asm volatile("s_waitcnt vmcnt(0)" ::: "memory")
__device__ __forceinline__ unsigned pk2(float lo, float hi) { return pg8::cvt_pk_bf16(lo, hi); }
__device__ __forceinline__ float bflo(unsigned v) { return __uint_as_float(v << 16); }
__device__ __forceinline__ float bfhi(unsigned v) { return __uint_as_float(v & 0xffff0000u); }
__device__ __forceinline__ float bf1(unsigned short h) { return __uint_as_float((unsigned)h << 16); }
__device__ __forceinline__ unsigned short f2bf(float f) { return (unsigned short)(pg8::cvt_pk_bf16(f, 0.f) & 0xffffu); }

#define XB_TMO      128
#define XB_XCNT(j)  (256  + 64 * (j))
#define XB_XSUB(j)  (1280 + 64 * (j))
#define XB_XGEN(j)  (2304 + 64 * (j))
#define XB_TOP      3328
#define XB_TOPGEN   3392
#define XCD_BAR_WORDS 3456
#define XB_SPIN_CAP (1u << 18)
__device__ __forceinline__ unsigned xb_ld(unsigned* p)              { return __hip_atomic_load(p, __ATOMIC_RELAXED, __HIP_MEMORY_SCOPE_AGENT); }
__device__ __forceinline__ unsigned xb_add(unsigned* p, unsigned v) { return __hip_atomic_fetch_add(p, v, __ATOMIC_RELAXED, __HIP_MEMORY_SCOPE_AGENT); }
__device__ __forceinline__ unsigned xb_xcc_id() { return (unsigned)__builtin_amdgcn_s_getreg((3 << 11) | 20) & 0xFu; }
#define XB_SPIN(cond, bar) do { unsigned _sp = 0; while (cond) { __builtin_amdgcn_s_sleep(1); \
    if ((++_sp & 255u) == 0u) { if (xb_ld(&(bar)[XB_TMO])) break; if (_sp > XB_SPIN_CAP) { atomicAdd(&(bar)[XB_TMO], 1u); break; } } } } while (0)
struct XcdBarrier { unsigned* bar; unsigned x; volatile LAS unsigned* st; };
__device__ __forceinline__ XcdBarrier xcd_barrier_post(unsigned* bar, volatile LAS unsigned* st) {
    XcdBarrier b; b.bar = bar; b.x = xb_xcc_id(); b.st = st;
    if (threadIdx.x == 0) (void)xb_add(&bar[XB_XCNT(b.x)], 1u);
    return b;
}
__device__ __forceinline__ void xcd_barrier_complete(unsigned* bar, unsigned x, unsigned& nloc, unsigned& nx) {
    const unsigned G = gridDim.x * gridDim.y * gridDim.z;
    unsigned sum, cnt, mine, sp = 0u;
    for (;;) {
        sum = 0u; cnt = 0u; mine = 0u;
#pragma unroll
        for (unsigned j = 0; j < 16; ++j) { const unsigned c = xb_ld(&bar[XB_XCNT(j)]); sum += c; cnt += (c > 0u) ? 1u : 0u; mine = (j == x) ? c : mine; }
        if (sum == G) break;
        __builtin_amdgcn_s_sleep(1);
        if ((++sp & 255u) == 0u) { if (xb_ld(&bar[XB_TMO])) break; if (sp > XB_SPIN_CAP) { atomicAdd(&bar[XB_TMO], 1u); break; } }
    }
    nloc = mine > 0u ? mine : 1u; nx = cnt > 0u ? cnt : 1u;
}
__device__ __forceinline__ void xcd_barrier(const XcdBarrier& b) {
    asm volatile("s_waitcnt vmcnt(0)" ::: "memory");
    __syncthreads();
    if (threadIdx.x == 0) {
        unsigned* bar = b.bar;
        __builtin_amdgcn_s_waitcnt(0);
        unsigned nloc = b.st[0], nx = b.st[1];
        if (nloc == 0u) { xcd_barrier_complete(bar, b.x, nloc, nx); b.st[0] = nloc; b.st[1] = nx; }
        const unsigned old = xb_add(&bar[XB_XSUB(b.x)], 1u);
        const unsigned gen = old / nloc;
        if (old + 1u == (gen + 1u) * nloc) {
            __builtin_amdgcn_fence(__ATOMIC_RELEASE, "agent");
            asm volatile("s_waitcnt vmcnt(0)" ::: "memory");
            const unsigned og = xb_add(&bar[XB_TOP], 1u);
            const unsigned tg = og / nx;
            if (og + 1u == (tg + 1u) * nx) xb_add(&bar[XB_TOPGEN], 1u);
            else XB_SPIN(xb_ld(&bar[XB_TOPGEN]) == tg, bar);
            __builtin_amdgcn_fence(__ATOMIC_ACQUIRE, "agent");
            xb_add(&bar[XB_XGEN(b.x)], 1u);
            asm volatile("s_waitcnt vmcnt(0)" ::: "memory");
        } else {
            XB_SPIN(xb_ld(&bar[XB_XGEN(b.x)]) == gen, bar);
            __builtin_amdgcn_fence(__ATOMIC_ACQUIRE, "agent");
            asm volatile("s_waitcnt vmcnt(0)" ::: "memory");
        }
    }
    __syncthreads();
}

struct Frame {
    LAS unsigned char* lds;
    volatile LAS unsigned* MISC;
    gu32* ctl;
    int tid, lane, wave, G, bid;
    const float* const* in;
    float* out;
    unsigned char* ws;
};
enum { I_XP = 0, I_XS, I_SH, I_SRGC, I_SCF, I_SPOOL, I_SSC, I_WIN, I_RGCW, I_RGCB, I_RGWA, I_RGBA, I_RGWX, I_RGBX, I_LAM, I_CFW, I_CFB, I_CFG, I_CFBB, I_POOLW, I_POOLS, I_SCW,
       I_WBR, I_WOUT, I_LN1G, I_LN1B, I_WG, I_WU, I_WD, I_LN2G, I_LN2B };

__device__ __forceinline__ float shfl_idx(float v, int src_lane) { return __builtin_bit_cast(float, __builtin_amdgcn_ds_bpermute(src_lane << 2, __builtin_bit_cast(int, v))); }
__device__ __forceinline__ float wave_sum(float v, int lane) {
#pragma unroll
    for (int o = 1; o < 64; o <<= 1) v += shfl_idx(v, lane ^ o);
    return v;
}

enum { RM_ID = 0, RM_WIN = 1, RM_GU = 2 };
template <int MODE> __device__ __forceinline__ int rowmap(int s, int extra) {
    if (MODE == RM_ID) return s;
    if (MODE == RM_GU) return 256 * (s >> 7) + (s & 127) + extra;
    if (s < 1024) return s;
    if (s < 2048) { const int j = ((s - 1024) >> 7) & 3; return 1024 + 256 * j + (s >= 1536 ? 128 : 0) + (s & 127); }
    if (s < 3072) return s;
    if (s < 4096) { const int j = ((s - 3072) >> 7) & 3; return 3072 + 256 * j + (s >= 3584 ? 128 : 0) + (s & 127); }
    const int g = (s - 4096) >> 10, ch = s & 1023, pn = ch >> 6, chl = ch & 63, wc = chl >> 4, fq = (chl >> 2) & 3, i = chl & 3;
    return 4096 + 256 * pn + 128 * (g >> 1) + 32 * wc + 8 * fq + 4 * (g & 1) + i;
}
template <int MODE>
__device__ __forceinline__ void transpose_item(const float* W, int K, int N, bf16* WT, int dst_ld, int dst_koff, int extra, LAS float* scr, int item, int lane, int nb0, int nnb) {
    const int kb = item / nnb, nb = nb0 + item % nnb, k0 = 64 * kb, n0 = 32 * nb;
#pragma unroll 8
    for (int i = 0; i < 32; ++i) { const int kk = 2 * i + (lane >> 5); scr[kk * 33 + (lane & 31)] = W[(size_t)(k0 + kk) * N + n0 + (lane & 31)]; }
    LDS_WAIT(); asm volatile("" ::: "memory");
    const int c = lane & 7; const float sc = (MODE == RM_WIN && n0 >= 4096) ? -1.44269504089f : 1.0f;
#pragma unroll
    for (int j = 0; j < 4; ++j) { const int n = (lane >> 3) + 8 * j; const LAS float* s = scr + (8 * c) * 33 + n;
        v4u o; o.x = pk2(s[0 * 33] * sc, s[1 * 33] * sc); o.y = pk2(s[2 * 33] * sc, s[3 * 33] * sc); o.z = pk2(s[4 * 33] * sc, s[5 * 33] * sc); o.w = pk2(s[6 * 33] * sc, s[7 * 33] * sc);
        *(GAS v4u*)(WT + (size_t)rowmap<MODE>(n0 + n, extra) * dst_ld + dst_koff + k0 + 8 * c) = o; }
    LDS_WAIT(); asm volatile("" ::: "memory");
}
template <int MODE>
__device__ __forceinline__ void convert_matrix(Frame& F, const float* W, int K, int N, bf16* WT, int dst_ld, int dst_koff, int extra, int gw, int NGW, int first = 0, int nb0 = 0, int nnb = 0) {
    LAS float* scr = (LAS float*)(F.lds + RING_OFF + F.wave * 16384);
    if (nnb == 0) nnb = N / 32;
    const int nitems = (K / 64) * nnb;
    int it0 = gw - first; if (it0 < 0) it0 += ((-it0 + NGW - 1) / NGW) * NGW;
    for (int it = it0; it < nitems; it += NGW) transpose_item<MODE>(W, K, N, WT, dst_ld, dst_koff, extra, scr, it, F.lane, nb0, nnb);
}
__device__ __forceinline__ void compose_pool(Frame& F, int layer, bf16* Bt3, int gw, int NGW, int first = 0) {
    const float* pw = F.in[I_POOLW] + (size_t)layer * 4 * 128 * 128; const float* ps = F.in[I_POOLS] + layer * 512; const float* Wb2 = F.in[I_WBR] + ((size_t)layer * 4 + 2) * 512 * 1024;
    const int lane = F.lane;
    LAS float* Pl = (LAS float*)(F.lds + RING_OFF + F.wave * 16384);
    int id0 = gw - first; if (id0 < 0) id0 += ((-id0 + NGW - 1) / NGW) * NGW;
    for (int id = id0; id < 512; id += NGW) {
        const int g = __builtin_amdgcn_readfirstlane(id >> 7), c0 = __builtin_amdgcn_readfirstlane(8 * ((id >> 3) & 15)), d0 = 128 * (id & 7) + 2 * lane;
#pragma unroll
        for (int k = 0; k < 4; ++k) { const int idx4 = lane + 64 * k, i = idx4 >> 5, e4 = (idx4 & 31) * 4;
            const f32x4 pv = *(const GAS f32x4*)(pw + ((size_t)g * 128 + c0 + i) * 128 + e4), sv = *(const GAS f32x4*)(ps + 128 * g + e4);
            Pl[(e4 + 0) * 8 + i] = pv.x * sv.x; Pl[(e4 + 1) * 8 + i] = pv.y * sv.y; Pl[(e4 + 2) * 8 + i] = pv.z * sv.z; Pl[(e4 + 3) * 8 + i] = pv.w * sv.w; }
        LDS_WAIT(); asm volatile("" ::: "memory");
        f32x2 acc[8];
#pragma unroll
        for (int i = 0; i < 8; ++i) acc[i] = (f32x2){0.f, 0.f};
        const float* wrow = Wb2 + (size_t)(128 * g) * 1024 + d0;
#pragma unroll 1
        for (int e0 = 0; e0 < 128; e0 += 8) {
            f32x2 wv[8];
#pragma unroll
            for (int k = 0; k < 8; ++k) wv[k] = *(const GAS f32x2*)(wrow + (size_t)(e0 + k) * 1024);
#pragma unroll
            for (int k = 0; k < 8; ++k) { const f32x4 p0 = *(const LAS f32x4*)(Pl + (e0 + k) * 8), p1 = *(const LAS f32x4*)(Pl + (e0 + k) * 8 + 4);
#pragma unroll
                for (int i = 0; i < 4; ++i) { acc[i] += wv[k] * p0[i]; acc[4 + i] += wv[k] * p1[i]; } }
        }
        v4u o0, o1;
        o0.x = pk2(acc[0].x, acc[1].x); o0.y = pk2(acc[2].x, acc[3].x); o0.z = pk2(acc[4].x, acc[5].x); o0.w = pk2(acc[6].x, acc[7].x);
        o1.x = pk2(acc[0].y, acc[1].y); o1.y = pk2(acc[2].y, acc[3].y); o1.z = pk2(acc[4].y, acc[5].y); o1.w = pk2(acc[6].y, acc[7].y);
        *(GAS v4u*)(Bt3 + (size_t)d0 * 2048 + 1024 + 128 * g + c0) = o0; *(GAS v4u*)(Bt3 + (size_t)(d0 + 1) * 2048 + 1024 + 128 * g + c0) = o1;
        LDS_WAIT(); asm volatile("" ::: "memory");
    }
}

__device__ __forceinline__ const float* xrow_in(Frame& F, int m) { return m < MP ? F.in[I_XP] + (size_t)m * DM : F.in[I_XS] + (size_t)(m - MP) * DM; }
__device__ __forceinline__ void x_to_bf16(Frame& F, bf16* XB) {
    const int gw = F.bid * NWAVES + F.wave, NGW = F.G * NWAVES;
    for (int m0 = 4 * gw; m0 < M; m0 += 4 * NGW) {
        f32x4 v[4][4];
#pragma unroll
        for (int k = 0; k < 4; ++k) { const GAS f32x4* xr = (const GAS f32x4*)xrow_in(F, m0 + k) + F.lane;
#pragma unroll
            for (int j = 0; j < 4; ++j) v[k][j] = xr[64 * j]; }
#pragma unroll
        for (int k = 0; k < 4; ++k) { GAS v2u* o = (GAS v2u*)(XB + (size_t)(m0 + k) * DM) + F.lane;
#pragma unroll
            for (int j = 0; j < 4; ++j) o[64 * j] = (v2u){pk2(v[k][j].x, v[k][j].y), pk2(v[k][j].z, v[k][j].w)}; } }
}
__device__ __forceinline__ void ln_rows(Frame& F, const float* V, float* O, const float* g, const float* b, bf16* XB, const float* sbase, const float* slab, int nslab) {
    const int gw = F.bid * NWAVES + F.wave, NGW = F.G * NWAVES;
    f32x4 gv[4], bv[4];
#pragma unroll
    for (int j = 0; j < 4; ++j) { gv[j] = ((const GAS f32x4*)g)[F.lane + 64 * j]; bv[j] = ((const GAS f32x4*)b)[F.lane + 64 * j]; }
    for (int m = MP + gw; m < M; m += NGW) {
        const GAS f32x4* xr = (const GAS f32x4*)(V + (size_t)m * DM) + F.lane; GAS f32x4* orow = (GAS f32x4*)(O + (size_t)m * DM) + F.lane;
        f32x4 v[4]; float s = 0.f;
#pragma unroll
        for (int j = 0; j < 4; ++j) v[j] = xr[64 * j];
        if (m >= MP) { const GAS f32x4* br = (const GAS f32x4*)(sbase + (size_t)(m - MP) * DM) + F.lane;
#pragma unroll
            for (int j = 0; j < 4; ++j) v[j] = br[64 * j] * ALPHA;
            for (int sl = 0; sl < nslab; ++sl) { const GAS f32x4* sr = (const GAS f32x4*)(slab + ((size_t)sl * 512 + (m - MP)) * DM) + F.lane;
#pragma unroll
                for (int j = 0; j < 4; ++j) v[j] += sr[64 * j]; } }
#pragma unroll
        for (int j = 0; j < 4; ++j) s += (v[j].x + v[j].y) + (v[j].z + v[j].w);
        const float mean = wave_sum(s, F.lane) * (1.f / DM); float s2 = 0.f;
#pragma unroll
        for (int j = 0; j < 4; ++j) { v[j] = v[j] - mean; s2 += (v[j].x * v[j].x + v[j].y * v[j].y) + (v[j].z * v[j].z + v[j].w * v[j].w); }
        const float rstd = __builtin_amdgcn_rsqf(wave_sum(s2, F.lane) * (1.f / DM) + LN_EPS);
#pragma unroll
        for (int j = 0; j < 4; ++j) { v[j] = v[j] * rstd * gv[j] + bv[j]; orow[64 * j] = v[j]; }
        if (XB) { GAS v2u* o = (GAS v2u*)(XB + (size_t)m * DM) + F.lane;
#pragma unroll
            for (int j = 0; j < 4; ++j) o[64 * j] = (v2u){pk2(v[j].x, v[j].y), pk2(v[j].z, v[j].w)}; }
    }
}

__device__ __forceinline__ void publish_ready(Frame& F, gu32* ctr) {
    VM_WAIT(); __syncthreads();
    if (F.tid == 0) { __builtin_amdgcn_fence(__ATOMIC_RELEASE, "agent"); asm volatile("s_waitcnt vmcnt(0)" ::: "memory"); __hip_atomic_fetch_add((unsigned*)ctr, 1u, __ATOMIC_RELAXED, __HIP_MEMORY_SCOPE_AGENT); }
}
__device__ __forceinline__ float softplusf_acc(float x) { return fmaxf(x, 0.f) + log1pf(__expf(-fabsf(x))); }
__device__ __forceinline__ float expm1_neg(float x) {
    const float p = x * (1.f + x * (0.5f + x * (1.f / 6.f + x * (1.f / 24.f + x * (1.f / 120.f + x * (1.f / 720.f + x * (1.f / 5040.f)))))));
    return x > -0.25f ? p : __expf(x) - 1.f;
}
constexpr int PATCH_STRIDE = 144;

struct ALane {
    float cwD[4], cbD, ba, bx, ck;
    bf16x8 Ba[4][2], Bx[4][2];
};
constexpr int PATCH_BYTES = 5120, ASLOT_OFF = 8 * PATCH_BYTES;
__device__ __forceinline__ void a_setup(Frame& F, int layer, int n, int q, ALane& L) {
    const int c = F.lane & 15, kg = F.lane >> 4, och = 64 * n + 16 * q + c;
    const float* cw = F.in[I_RGCW] + (size_t)layer * 4 * 512 + 64 * n; const float* cb = F.in[I_RGCB] + layer * 512 + 64 * n;
#pragma unroll
    for (int j = 0; j < 4; ++j) L.cwD[j] = cw[j * 512 + 16 * q + c];
    L.cbD = cb[16 * q + c];
    L.ck = 8.0f * softplusf_acc(-F.in[I_LAM][layer * 512 + och]);
    const float* wa = F.in[I_RGWA] + ((size_t)layer * 8 + n) * 4096 + 16 * q + c; const float* wx = F.in[I_RGWX] + ((size_t)layer * 8 + n) * 4096 + 16 * q + c;
    float wav[16], wxv[16], cbv[16];
#pragma unroll
    for (int e = 0; e < 16; ++e) { const int k = (e < 8 ? 8 * kg + e : 32 + 8 * kg + (e - 8)); wav[e] = wa[k * 64]; wxv[e] = wx[k * 64]; cbv[e] = cb[k]; }
#pragma unroll
    for (int j = 0; j < 4; ++j) { float t[16];
#pragma unroll
        for (int e = 0; e < 16; ++e) t[e] = cw[j * 512 + (e < 8 ? 8 * kg + e : 32 + 8 * kg + (e - 8))];
        L.Ba[j][0] = __builtin_bit_cast(bf16x8, (v4u){pk2(wav[0] * t[0], wav[1] * t[1]), pk2(wav[2] * t[2], wav[3] * t[3]), pk2(wav[4] * t[4], wav[5] * t[5]), pk2(wav[6] * t[6], wav[7] * t[7])});
        L.Ba[j][1] = __builtin_bit_cast(bf16x8, (v4u){pk2(wav[8] * t[8], wav[9] * t[9]), pk2(wav[10] * t[10], wav[11] * t[11]), pk2(wav[12] * t[12], wav[13] * t[13]), pk2(wav[14] * t[14], wav[15] * t[15])});
        L.Bx[j][0] = __builtin_bit_cast(bf16x8, (v4u){pk2(wxv[0] * t[0], wxv[1] * t[1]), pk2(wxv[2] * t[2], wxv[3] * t[3]), pk2(wxv[4] * t[4], wxv[5] * t[5]), pk2(wxv[6] * t[6], wxv[7] * t[7])});
        L.Bx[j][1] = __builtin_bit_cast(bf16x8, (v4u){pk2(wxv[8] * t[8], wxv[9] * t[9]), pk2(wxv[10] * t[10], wxv[11] * t[11]), pk2(wxv[12] * t[12], wxv[13] * t[13]), pk2(wxv[14] * t[14], wxv[15] * t[15])}); }
    float sa = 0.f, sx = 0.f;
#pragma unroll
    for (int e = 0; e < 16; ++e) { sa = fmaf(cbv[e], wav[e], sa); sx = fmaf(cbv[e], wxv[e], sx); }
    sa += shfl_idx(sa, F.lane ^ 16); sa += shfl_idx(sa, F.lane ^ 32); sx += shfl_idx(sx, F.lane ^ 16); sx += shfl_idx(sx, F.lane ^ 32);
    L.ba = F.in[I_RGBA][layer * 512 + och] + sa; L.bx = F.in[I_RGBX][layer * 512 + och] + sx;
}
__device__ __forceinline__ void a_block(const ALane& L, const LAS unsigned char* patch, int rowA0, int baseD, int q, int lane, float (&a)[4], float (&bb)[4]) {
    const int c = lane & 15, kg = lane >> 4;
    f32x4 accR = (f32x4){0.f, 0.f, 0.f, 0.f}, accI = (f32x4){0.f, 0.f, 0.f, 0.f};
#pragma unroll
    for (int j = 0; j < 4; ++j) { const LAS unsigned char* rp = patch + (rowA0 + j) * PATCH_STRIDE + 16 * kg;
        const bf16x8 A0 = *(const LAS bf16x8*)rp, A1 = *(const LAS bf16x8*)(rp + 64);
        accR = __builtin_amdgcn_mfma_f32_16x16x32_bf16(A0, L.Ba[j][0], accR, 0, 0, 0); accR = __builtin_amdgcn_mfma_f32_16x16x32_bf16(A1, L.Ba[j][1], accR, 0, 0, 0);
        accI = __builtin_amdgcn_mfma_f32_16x16x32_bf16(A0, L.Bx[j][0], accI, 0, 0, 0); accI = __builtin_amdgcn_mfma_f32_16x16x32_bf16(A1, L.Bx[j][1], accI, 0, 0, 0); }
    float pv[7];
#pragma unroll
    for (int k = 0; k < 7; ++k) pv[k] = bf1(*(const LAS unsigned short*)(patch + (baseD + k) * PATCH_STRIDE + 2 * (16 * q + c)));
#pragma unroll
    for (int r = 0; r < 4; ++r) {
        const float xd = L.cbD + L.cwD[0] * pv[r] + L.cwD[1] * pv[r + 1] + L.cwD[2] * pv[r + 2] + L.cwD[3] * pv[r + 3];
        const float rr = pg8::sigmoidf_fast(accR[r] + L.ba), ii = pg8::sigmoidf_fast(accI[r] + L.bx);
        const float la = -L.ck * rr;
        const float av = __builtin_amdgcn_exp2f(1.44269504089f * la);
        a[r] = av; bb[r] = __builtin_amdgcn_sqrtf(fmaxf(1.f - av * av, 0.f)) * (ii * xd);
    }
}
struct BlkScan { float Ac[4], Bc[4], EA, EB, WA, WB; };
__device__ __forceinline__ void blk_scan(const float (&a)[4], const float (&bb)[4], int lane, BlkScan& S) {
    const int c = lane & 15, g = lane >> 4;
    S.Ac[0] = a[0]; S.Bc[0] = bb[0];
#pragma unroll
    for (int r = 1; r < 4; ++r) { S.Ac[r] = a[r] * S.Ac[r - 1]; S.Bc[r] = a[r] * S.Bc[r - 1] + bb[r]; }
    float IA = S.Ac[3], IB = S.Bc[3];
    { const float pa = shfl_idx(IA, lane - 16), pb = shfl_idx(IB, lane - 16); if (g >= 1) { IB = IA * pb + IB; IA = IA * pa; } }
    { const float pa = shfl_idx(IA, lane - 32), pb = shfl_idx(IB, lane - 32); if (g >= 2) { IB = IA * pb + IB; IA = IA * pa; } }
    S.EA = shfl_idx(IA, lane - 16); S.EB = shfl_idx(IB, lane - 16); if (g == 0) { S.EA = 1.f; S.EB = 0.f; }
    S.WA = shfl_idx(IA, 48 + c); S.WB = shfl_idx(IB, 48 + c);
}
__device__ __forceinline__ void a_prompt_item(Frame& F, int layer, int item, const bf16* Z, bf16* Y) {
    const int b = item >> 5, n = (item >> 2) & 7, q = item & 3, lane = opqv(F.lane), w = F.wave, c = lane & 15, g = lane >> 4, och = 64 * n + 16 * q + c;
    ALane L; a_setup(F, layer, n, q, L);
    LAS unsigned char* patch = F.lds + RING_OFF + w * PATCH_BYTES;
    LAS f32x2* slots = (LAS f32x2*)(F.lds + RING_OFF + ASLOT_OFF);
    const bf16* Zb = Z + (size_t)b * SEQ * ZC;
    float hrun = 0.f;
    v4u pf[5];
    auto load_patch = [&](int tb) {
#pragma unroll
        for (int k = 0; k < 5; ++k) { const int ci = lane + 64 * k, pr = ci >> 3, cc = ci & 7, t = tb - 3 + pr;
            pf[k] = (ci < 280 && t >= 0) ? *(const GAS v4u*)(Zb + (size_t)t * ZC + 64 * n + 8 * cc) : (v4u){0u, 0u, 0u, 0u}; }
    };
    load_patch(32 * w);
    for (int it = 0; it < 8; ++it) {
        const int tb = 256 * it + 32 * w;
#pragma unroll
        for (int k = 0; k < 5; ++k) { const int ci = lane + 64 * k, pr = ci >> 3, cc = ci & 7; if (ci < 280) *(LAS v4u*)(patch + pr * PATCH_STRIDE + 16 * cc) = pf[k]; }
        if (it < 7) load_patch(tb + 256);
        unsigned short gav[8];
#pragma unroll
        for (int r = 0; r < 8; ++r) gav[r] = *(const GAS unsigned short*)(Zb + (size_t)(tb + 16 * (r >> 2) + 4 * g + (r & 3)) * ZC + 512 + och);
        asm volatile("" ::: "memory");
        float a0[4], b0[4], a1[4], b1[4];
        a_block(L, patch, lane & 15, 4 * g, q, lane, a0, b0);
        a_block(L, patch, 16 + (lane & 15), 16 + 4 * g, q, lane, a1, b1);
        BlkScan S0, S1; blk_scan(a0, b0, lane, S0); blk_scan(a1, b1, lane, S1);
        if (lane < 16) slots[((it & 1) * 8 + w) * 16 + c] = (f32x2){S0.WA * S1.WA, S1.WA * S0.WB + S1.WB};
        __syncthreads();
        float hin = hrun, hw = 0.f;
#pragma unroll
        for (int ww = 0; ww < 8; ++ww) { const f32x2 s = slots[((it & 1) * 8 + ww) * 16 + c]; if (ww == w) hw = hin; hin = s.x * hin + s.y; }
        hrun = hin;
        const float hg0 = S0.EA * hw + S0.EB, hw1 = S0.WA * hw + S0.WB, hg1 = S1.EA * hw1 + S1.EB;
#pragma unroll
        for (int r = 0; r < 4; ++r) { const float h = S0.Ac[r] * hg0 + S0.Bc[r];
            *(GAS unsigned short*)(Y + (size_t)(b * SEQ + tb + 4 * g + r) * YC + och) = f2bf(h * bf1(gav[r])); }
#pragma unroll
        for (int r = 0; r < 4; ++r) { const float h = S1.Ac[r] * hg1 + S1.Bc[r];
            *(GAS unsigned short*)(Y + (size_t)(b * SEQ + tb + 16 + 4 * g + r) * YC + och) = f2bf(h * bf1(gav[4 + r]));
            if (r == 3 && it == 7 && w == 7 && g == 3) F.out[O_PH + (size_t)(layer * 8 + b) * 512 + och] = h; }
    }
}
__device__ __forceinline__ void a_sample_task(Frame& F, int layer, int task, const bf16* Z, bf16* Y) {
    const int blk = task >> 5, n = (task >> 2) & 7, q = task & 3, lane = opqv(F.lane), c = lane & 15, g = lane >> 4, och = 64 * n + 16 * q + c, s0 = 4 * blk;
    ALane L; a_setup(F, layer, n, q, L);
    LAS unsigned char* patch = F.lds + RING_OFF + F.wave * PATCH_BYTES;
#pragma unroll
    for (int k = 0; k < 4; ++k) { const int ci = lane + 64 * k; if (ci < 224) { const int pr = ci >> 3, cc = ci & 7, sq = pr / 7, tau = pr - 7 * sq - 3, seq = s0 + sq; v4u v;
            if (tau < 0) { const GAS f32x4* sp = (const GAS f32x4*)(F.in[I_SRGC] + ((size_t)(layer * 128 + seq) * 3 + (tau + 3)) * 512 + 64 * n + 8 * cc); const f32x4 f0 = sp[0], f1 = sp[1];
                v = (v4u){pk2(f0.x, f0.y), pk2(f0.z, f0.w), pk2(f1.x, f1.y), pk2(f1.z, f1.w)}; }
            else v = *(const GAS v4u*)(Z + (size_t)(MP + 4 * seq + tau) * ZC + 64 * n + 8 * cc);
            *(LAS v4u*)(patch + pr * PATCH_STRIDE + 16 * cc) = v; } }
    asm volatile("" ::: "memory");
    float a[4], bb[4];
    a_block(L, patch, 7 * ((lane & 15) >> 2) + (lane & 3), 7 * g, q, lane, a, bb);
    const int seq = s0 + g;
    float h = F.in[I_SH][(size_t)(layer * 128 + seq) * 512 + och];
#pragma unroll
    for (int r = 0; r < 4; ++r) { h = a[r] * h + bb[r]; const size_t row = (size_t)(MP + 4 * seq + r);
        *(GAS unsigned short*)(Y + row * YC + och) = f2bf(h * bf1(*(const GAS unsigned short*)(Z + row * ZC + 512 + och))); }
    F.out[O_SH + (size_t)(layer * 128 + seq) * 512 + och] = h;
}

__device__ __forceinline__ void ln_silu_row(const LAS float* xr, const float* g, const float* b, bf16* dst, int lane) {
    const f32x4 v0 = *(const LAS f32x4*)(xr + 4 * lane), v1 = *(const LAS f32x4*)(xr + 256 + 4 * lane);
    const float s = (v0.x + v0.y) + (v0.z + v0.w) + (v1.x + v1.y) + (v1.z + v1.w);
    const float mean = wave_sum(s, lane) * (1.f / 512.f);
    const f32x4 d0 = v0 - mean, d1 = v1 - mean;
    const float s2 = (d0.x * d0.x + d0.y * d0.y) + (d0.z * d0.z + d0.w * d0.w) + (d1.x * d1.x + d1.y * d1.y) + (d1.z * d1.z + d1.w * d1.w);
    const float rstd = __builtin_amdgcn_rsqf(wave_sum(s2, lane) * (1.f / 512.f) + LN_EPS);
    const f32x4 g0 = *(const GAS f32x4*)(g + 4 * lane), g1 = *(const GAS f32x4*)(g + 256 + 4 * lane), b0 = *(const GAS f32x4*)(b + 4 * lane), b1 = *(const GAS f32x4*)(b + 256 + 4 * lane);
    f32x4 y0 = d0 * rstd * g0 + b0, y1 = d1 * rstd * g1 + b1;
#pragma unroll
    for (int i = 0; i < 4; ++i) { y0[i] = y0[i] * pg8::sigmoidf_fast(y0[i]); y1[i] = y1[i] * pg8::sigmoidf_fast(y1[i]); }
    *(GAS v2u*)(dst + 4 * lane) = (v2u){pk2(y0.x, y0.y), pk2(y0.z, y0.w)}; *(GAS v2u*)(dst + 256 + 4 * lane) = (v2u){pk2(y1.x, y1.y), pk2(y1.z, y1.w)};
}
__device__ __forceinline__ void ln_silu_rows4(const LAS float* xr, int rstride, const float* g, const float* b, bf16* dst, size_t dstride, int lane) {
    f32x4 v0[4], v1[4]; float s[4], s2[4];
#pragma unroll
    for (int k = 0; k < 4; ++k) { v0[k] = *(const LAS f32x4*)(xr + k * rstride + 4 * lane); v1[k] = *(const LAS f32x4*)(xr + k * rstride + 256 + 4 * lane);
        s[k] = (v0[k].x + v0[k].y) + (v0[k].z + v0[k].w) + (v1[k].x + v1[k].y) + (v1[k].z + v1[k].w); }
#pragma unroll
    for (int o = 1; o < 64; o <<= 1) {
#pragma unroll
        for (int k = 0; k < 4; ++k) s[k] += shfl_idx(s[k], lane ^ o); }
#pragma unroll
    for (int k = 0; k < 4; ++k) { const float mean = s[k] * (1.f / 512.f); v0[k] = v0[k] - mean; v1[k] = v1[k] - mean;
        s2[k] = (v0[k].x * v0[k].x + v0[k].y * v0[k].y) + (v0[k].z * v0[k].z + v0[k].w * v0[k].w) + (v1[k].x * v1[k].x + v1[k].y * v1[k].y) + (v1[k].z * v1[k].z + v1[k].w * v1[k].w); }
#pragma unroll
    for (int o = 1; o < 64; o <<= 1) {
#pragma unroll
        for (int k = 0; k < 4; ++k) s2[k] += shfl_idx(s2[k], lane ^ o); }
    const f32x4 g0 = *(const GAS f32x4*)(g + 4 * lane), g1 = *(const GAS f32x4*)(g + 256 + 4 * lane), b0 = *(const GAS f32x4*)(b + 4 * lane), b1 = *(const GAS f32x4*)(b + 256 + 4 * lane);
#pragma unroll
    for (int k = 0; k < 4; ++k) { const float rstd = __builtin_amdgcn_rsqf(s2[k] * (1.f / 512.f) + LN_EPS);
        f32x4 y0 = v0[k] * rstd * g0 + b0, y1 = v1[k] * rstd * g1 + b1;
#pragma unroll
        for (int i = 0; i < 4; ++i) { y0[i] = y0[i] * pg8::sigmoidf_fast(y0[i]); y1[i] = y1[i] * pg8::sigmoidf_fast(y1[i]); }
        bf16* d = dst + (size_t)k * dstride;
        *(GAS v2u*)(d + 4 * lane) = (v2u){pk2(y0.x, y0.y), pk2(y0.z, y0.w)}; *(GAS v2u*)(d + 256 + 4 * lane) = (v2u){pk2(y1.x, y1.y), pk2(y1.z, y1.w)}; }
}
__device__ __forceinline__ void b_prompt_item(Frame& F, int layer, int item, const bf16* Z, bf16* Y) {
    const int tidl = opqv(F.tid), b = item >> 5, t0 = 64 * (item & 31), p = tidl & 255, hh = tidl >> 8, ts = t0 + 32 * hh;
    const GAS unsigned* Zu = (const GAS unsigned*)(Z + (size_t)b * SEQ * ZC) + 512 + p;
    unsigned raw[62];
#pragma unroll
    for (int i = 0; i < 62; ++i) { const int t = ts - 30 + i; raw[i] = t >= 0 ? Zu[(size_t)t * (ZC / 2)] : 0u; }
    const float* cw = F.in[I_CFW] + (size_t)layer * 31 * 512 + 2 * p;
    f32x2 wj[31];
#pragma unroll
    for (int j = 0; j < 31; ++j) wj[j] = *(const GAS f32x2*)(cw + j * 512);
    const f32x2 bias = *(const GAS f32x2*)(F.in[I_CFB] + layer * 512 + 2 * p);
    f32x2 in[62];
#pragma unroll
    for (int i = 0; i < 62; ++i) in[i] = (f32x2){bflo(raw[i]), bfhi(raw[i])};
    LAS float* obuf = (LAS float*)(F.lds + RING_OFF);
#pragma unroll
    for (int i = 0; i < 32; ++i) { f32x2 o = bias;
#pragma unroll
        for (int j = 0; j < 31; ++j) o += wj[j] * in[i + j];
        *(LAS f32x2*)(obuf + (32 * hh + i) * 512 + 2 * p) = o; }
    __syncthreads();
    const float* lg = F.in[I_CFG] + layer * 512; const float* lb = F.in[I_CFBB] + layer * 512;
#pragma unroll 1
    for (int r = 8 * F.wave; r < 8 * F.wave + 8; r += 4) ln_silu_rows4(obuf + r * 512, 512, lg, lb, Y + (size_t)(b * SEQ + t0 + r) * YC + 512, YC, F.lane);
}
__device__ __forceinline__ void cd_prompt_item(Frame& F, int layer, int item, const bf16* Z, bf16* Y) {
    const int tidl = opqv(F.tid), b = item >> 5, t0 = 64 * (item & 31), p = tidl & 255, hh = tidl >> 8;
    const bf16* Zb = Z + (size_t)b * SEQ * ZC;
    LAS unsigned* cbuf = (LAS unsigned*)(F.lds + RING_OFF);
    { v4u tmp[10];
#pragma unroll
      for (int k = 0; k < 10; ++k) { const int ci = tidl + 512 * k, pr = ci >> 6, cc = ci & 63, t = t0 - 15 + pr;
          tmp[k] = (ci < 79 * 64 && t >= 0) ? *(const GAS v4u*)(Zb + (size_t)t * ZC + 1536 + 8 * cc) : (v4u){0u, 0u, 0u, 0u}; }
#pragma unroll
      for (int k = 0; k < 10; ++k) { const int ci = tidl + 512 * k, pr = ci >> 6, cc = ci & 63; if (ci < 79 * 64) *(LAS v4u*)(cbuf + pr * 256 + 4 * cc) = tmp[k]; } }
    const int ts = t0 + 32 * hh;
    unsigned uu[34], dd[32];
#pragma unroll
    for (int i = 0; i < 34; ++i) { const int t = ts - 2 + i; uu[i] = t >= 0 ? ((const GAS unsigned*)(Zb + (size_t)t * ZC))[1280 + p] : 0u; }
#pragma unroll
    for (int i = 0; i < 32; ++i) dd[i] = ((const GAS unsigned*)(Zb + (size_t)(ts + i) * ZC))[1024 + p];
    const f32x2 w0 = ((const GAS f32x2*)(F.in[I_SCW] + (size_t)(layer * 3 + 0) * 512))[p], w1 = ((const GAS f32x2*)(F.in[I_SCW] + (size_t)(layer * 3 + 1) * 512))[p],
                w2 = ((const GAS f32x2*)(F.in[I_SCW] + (size_t)(layer * 3 + 2) * 512))[p];
    __syncthreads();
    const int w = 2 << (p >> 6), rr0 = 15 + 32 * hh;
    f32x2 s = (f32x2){0.f, 0.f};
    for (int j = 0; j < w; ++j) { const unsigned v = cbuf[(rr0 - j) * 256 + p]; s += (f32x2){bflo(v), bfhi(v)}; }
    GAS unsigned* Yu = (GAS unsigned*)(Y + (size_t)(b * SEQ + ts) * YC) + p;
#pragma unroll
    for (int i = 0; i < 32; ++i) { const int t = ts + i, rr = rr0 + i;
        const unsigned cur = cbuf[rr * 256 + p]; const f32x2 cf = (f32x2){bflo(cur), bfhi(cur)};
        if (i > 0) { const unsigned old = cbuf[(rr - w) * 256 + p]; s += cf - (f32x2){bflo(old), bfhi(old)}; }
        const float ic = __builtin_amdgcn_rcpf((float)(t + 1 < w ? t + 1 : w));
        const f32x2 mm = s * ic - cf;
        Yu[(size_t)i * 1024 + 512] = pk2(mm.x, mm.y);
        const f32x2 cv = w0 * (f32x2){bflo(uu[i]), bfhi(uu[i])} + w1 * (f32x2){bflo(uu[i + 1]), bfhi(uu[i + 1])} + w2 * (f32x2){bflo(uu[i + 2]), bfhi(uu[i + 2])};
        const f32x2 yd = (f32x2){bflo(dd[i]), bfhi(dd[i])} * cv;
        Yu[(size_t)i * 1024 + 768] = pk2(yd.x, yd.y); }
}
__device__ __forceinline__ void s_sample_item(Frame& F, int layer, int s, const bf16* Z, bf16* Y) {
    const int ch = opqv(F.tid); const size_t ls = (size_t)layer * 128 + s;
    const bf16* Zr = Z + (size_t)(MP + 4 * s) * ZC; bf16* Yr = Y + (size_t)(MP + 4 * s) * YC;
    LAS float* obuf = (LAS float*)(F.lds + RING_OFF);
    float in[34], wv[31], pb[19], u[6], dbv[4];
#pragma unroll
    for (int j = 0; j < 30; ++j) in[j] = (F.in[I_SCF] + (ls * 30 + j) * 512)[ch];
#pragma unroll
    for (int j = 0; j < 15; ++j) pb[j] = (F.in[I_SPOOL] + (ls * 15 + j) * 512)[ch];
    u[0] = (F.in[I_SSC] + (ls * 2 + 0) * 512)[ch]; u[1] = (F.in[I_SSC] + (ls * 2 + 1) * 512)[ch];
#pragma unroll
    for (int r = 0; r < 4; ++r) { in[30 + r] = bf1((Zr + (size_t)r * ZC + 1024)[ch]); pb[15 + r] = bf1((Zr + (size_t)r * ZC + 1536)[ch]); u[2 + r] = bf1((Zr + (size_t)r * ZC + 2560)[ch]); dbv[r] = bf1((Zr + (size_t)r * ZC + 2048)[ch]); }
#pragma unroll
    for (int j = 0; j < 31; ++j) wv[j] = (F.in[I_CFW] + ((size_t)layer * 31 + j) * 512)[ch];
    const float bias = (F.in[I_CFB] + layer * 512)[ch];
    const float w0 = (F.in[I_SCW] + (size_t)(layer * 3 + 0) * 512)[ch], w1 = (F.in[I_SCW] + (size_t)(layer * 3 + 1) * 512)[ch], w2 = (F.in[I_SCW] + (size_t)(layer * 3 + 2) * 512)[ch];
    asm volatile("" ::: "memory");
#pragma unroll
    for (int j = 0; j < 26; ++j) (F.out + O_SCF + (ls * 30 + j) * 512)[ch] = in[j + 4];
#pragma unroll
    for (int r = 0; r < 4; ++r) { float o = bias;
#pragma unroll
        for (int j = 0; j < 31; ++j) o += wv[j] * in[r + j];
        obuf[r * 512 + ch] = o; }
#pragma unroll
    for (int j = 0; j < 11; ++j) (F.out + O_SPOOL + (ls * 15 + j) * 512)[ch] = pb[j + 4];
    const int gsel = ch >> 7;
#pragma unroll
    for (int r = 0; r < 4; ++r) { const int k = 15 + r;
        const float s2 = pb[k] + pb[k - 1], s4 = s2 + pb[k - 2] + pb[k - 3], s8 = s4 + (pb[k - 4] + pb[k - 5]) + (pb[k - 6] + pb[k - 7]);
        float s16 = s8;
#pragma unroll
        for (int j = 8; j < 16; ++j) s16 += pb[k - j];
        const float mv = (gsel == 0 ? s2 * 0.5f : gsel == 1 ? s4 * 0.25f : gsel == 2 ? s8 * 0.125f : s16 * 0.0625f) - pb[k];
        (Yr + (size_t)r * YC + 1024)[ch] = f2bf(mv); }
#pragma unroll
    for (int r = 0; r < 4; ++r) (Yr + (size_t)r * YC + 1536)[ch] = f2bf(dbv[r] * (w0 * u[r] + w1 * u[r + 1] + w2 * u[r + 2]));
    __syncthreads();
    if (F.wave < 4) ln_silu_row(obuf + F.wave * 512, F.in[I_CFG] + layer * 512, F.in[I_CFBB] + layer * 512, Yr + (size_t)F.wave * YC + 512, F.lane);
}

struct Args { const float* in[31]; float* out; unsigned char* ws; int ph_lo, ph_hi; };
__global__ void __launch_bounds__(NWAVES * 64, 2) hybrid_fwd(Args args) {
    extern __shared__ __attribute__((aligned(16))) unsigned char lds[];
    Frame F;
    F.lds = (LAS unsigned char*)lds;
    F.MISC = (volatile LAS unsigned*)(F.lds + MISC_OFF);
    const int wave0 = __builtin_amdgcn_readfirstlane((int)threadIdx.x >> 6);
    F.lane = lane_now(); F.wave = wave0; F.tid = F.wave * 64 + F.lane;
    F.G = gridDim.x; F.bid = blockIdx.x;
    F.ws = args.ws; F.out = args.out; F.ctl = (gu32*)(args.ws + WS_CTL);
    F.in = args.in;
    for (int u = F.tid; u < (LDS_BYTES - LDSCTL_OFF) / 4; u += NWAVES * 64) ((LAS unsigned*)(F.lds + LDSCTL_OFF))[u] = 0u;
    __syncthreads();
    XcdBarrier bar; bar.bar = (unsigned*)(F.ctl + CW_BAR); bar.x = 0; bar.st = nullptr;
    if (!MK_SPLIT) bar = xcd_barrier_post((unsigned*)(F.ctl + CW_BAR), F.MISC + 8);
    const int lo = args.ph_lo, hi = args.ph_hi;
#define IN(k) (lo <= (k) && (k) < hi)
#define REFRESH() do { F.lane = lane_now(); F.wave = opqs(wave0); F.tid = F.wave * 64 + F.lane; F.bid = opqs((int)blockIdx.x); } while (0)
#define SEAM(k) do { if (IN(k) && IN((k) + 1)) xcd_barrier(bar); } while (0)
    bf16* WA = (bf16*)(F.ws + WS_WA); bf16* XB = (bf16*)(F.ws + WS_XB); bf16* Y = (bf16*)(F.ws + WS_Y); bf16* Zm = (bf16*)(F.ws + WS_ZG); _Float16* Gb = (_Float16*)(F.ws + WS_ZG);
    bf16* Hb = (bf16*)(F.ws + WS_ZG); bf16* Bt3 = (bf16*)(F.ws + WS_BT3); bf16* Bt4 = (bf16*)(F.ws + WS_BT4); bf16* Bt5 = (bf16*)(F.ws + WS_BT5); bf16* Bt6 = (bf16*)(F.ws + WS_BT6);

    if (IN(0)) { REFRESH(); convert_matrix<RM_WIN>(F, F.in[I_WIN], DM, INC, WA, DM, 0, 0, F.bid * NWAVES + F.wave, F.G * NWAVES, 0, 0, F.G == 256 ? 128 : 0); REFRESH(); x_to_bf16(F, XB); }
    SEAM(0);

    const bool fast = F.G == 256;
    for (int l = 0; l < 2; ++l) {
        const int pb = 1 + 9 * l;
        if (IN(pb + 0)) for (int rep = 0; rep < NREP(0); ++rep) { if (rep) xcd_barrier(bar);
            if (fast && l == 1 && rep == 0) { REFRESH();
                ln_rows(F, F.out, F.out, F.in[I_LN2G], F.in[I_LN2B], XB, F.out + (size_t)MP * DM, (const float*)(F.ws + WS_SLAB), 11); publish_ready(F, F.ctl + CW_RDY + 64 * 1); }
            pg8::Gemm g{XB, WA, DM, DM}; pg8::UnitOrder S; S.init(pg8::SK_PLAIN, 4096, DM, F.G, F.bid, 0); pg8::EpiMix E{Zm, F.out, l};
            if (fast && l == 1) { S.ready = (const unsigned*)(F.ctl + CW_RDY + 64 * 1); S.need = (unsigned)F.G; }
            pg8::gemm_phase<pg8::EpiMix, pg8::UnitOrder, true>(F.lds + RING_OFF, g, S, E, wave0);
            if (F.G == 256 && F.bid >= 32) {
                REFRESH(); const int gw = (F.bid - 32) * NWAVES + F.wave, NGW = 224 * NWAVES; const float* wbr = F.in[I_WBR] + (size_t)l * 4 * 512 * 1024;
                convert_matrix<RM_ID>(F, wbr, 512, 1024, Bt3, 2048, 0, 0, gw, NGW, 0);
                convert_matrix<RM_ID>(F, wbr + (size_t)512 * 1024, 512, 1024, Bt3, 2048, 512, 0, gw, NGW, 256);
                convert_matrix<RM_ID>(F, wbr + (size_t)3 * 512 * 1024, 512, 1024, Bt3, 2048, 1536, 0, gw, NGW, 512);
                convert_matrix<RM_ID>(F, F.in[I_WOUT] + (size_t)l * DM * DM, DM, DM, Bt4, DM, 0, 0, gw, NGW, 768);
                REFRESH(); compose_pool(F, l, Bt3, gw, NGW, 1280);
                REFRESH(); convert_matrix<RM_WIN>(F, F.in[I_WIN] + (size_t)l * DM * INC, DM, INC, WA, DM, 0, 0, gw, NGW, 0, 128, 128); } }
        SEAM(pb + 0);
        if (IN(pb + 1)) for (int rep = 0; rep < NREP(1); ++rep) { if (rep) xcd_barrier(bar);
            __syncthreads(); REFRESH();
            for (int r2 = 0; r2 < NREP2(0); ++r2) for (int it = F.bid; it < 256; it += F.G) { a_prompt_item(F, l, it, Zm, Y); __syncthreads(); }
            REFRESH();
            for (int r2 = 0; r2 < NREP2(1); ++r2) for (int it = (F.bid + 128) % F.G; it < 128; it += F.G) a_sample_task(F, l, 8 * it + F.wave, Zm, Y);
            __syncthreads(); REFRESH();
            const bool rebal = F.G == 256, gemm_wg = rebal && F.bid >= 128 && F.bid < 160;
            for (int r2 = 0; r2 < NREP2(2); ++r2) { if (!gemm_wg) for (int it = F.bid; it < 256; it += F.G) { b_prompt_item(F, l, it, Zm, Y); __syncthreads(); }
                if (rebal && F.bid >= 160 && F.bid < 192) { b_prompt_item(F, l, F.bid - 32, Zm, Y); __syncthreads(); } }
            REFRESH();
            for (int r2 = 0; r2 < NREP2(3); ++r2) { if (!gemm_wg) for (int it = F.bid; it < 256; it += F.G) { cd_prompt_item(F, l, it, Zm, Y); __syncthreads(); }
                if (rebal && F.bid >= 192 && F.bid < 224) { cd_prompt_item(F, l, F.bid - 64, Zm, Y); __syncthreads(); } }
            REFRESH();
            for (int r2 = 0; r2 < NREP2(4); ++r2) for (int it = F.bid; it < 128; it += F.G) { s_sample_item(F, l, it, Zm, Y); __syncthreads(); }
            if (F.G == 256 && F.bid >= 128 && F.bid < 160) {
                pg8::Gemm g{XB, WA + (size_t)4096 * DM, DM, DM}; pg8::UnitOrder S; S.init(pg8::SK_PLAIN, 4096, DM, 32, F.bid - 128, 0, false, true); pg8::EpiGate E{Gb};
                pg8::gemm_phase<pg8::EpiGate, pg8::UnitOrder, true>(F.lds + RING_OFF, g, S, E, wave0); }
            REFRESH();
            const float* wbr = F.in[I_WBR] + (size_t)l * 4 * 512 * 1024;
            if (F.G != 256) { const int gw = F.bid * NWAVES + F.wave, NGW = F.G * NWAVES;
                convert_matrix<RM_ID>(F, wbr, 512, 1024, Bt3, 2048, 0, 0, gw, NGW); convert_matrix<RM_ID>(F, wbr + (size_t)512 * 1024, 512, 1024, Bt3, 2048, 512, 0, gw, NGW);
                convert_matrix<RM_ID>(F, wbr + (size_t)3 * 512 * 1024, 512, 1024, Bt3, 2048, 1536, 0, gw, NGW); convert_matrix<RM_ID>(F, F.in[I_WOUT] + (size_t)l * DM * DM, DM, DM, Bt4, DM, 0, 0, gw, NGW);
                REFRESH(); compose_pool(F, l, Bt3, gw, NGW); }
        }
        SEAM(pb + 1);
        if (IN(pb + 2)) for (int rep = 0; rep < NREP(2); ++rep) { if (rep) xcd_barrier(bar); pg8::Gemm g{XB, WA + (size_t)4096 * DM, DM, DM}; pg8::UnitOrder S; S.init(pg8::SK_PLAIN, 4096, DM, F.G, F.bid, 0, true, F.G != 256); pg8::EpiGate E{Gb};
            pg8::gemm_phase<pg8::EpiGate, pg8::UnitOrder, true>(F.lds + RING_OFF, g, S, E, wave0); }
        SEAM(pb + 2);
        if (IN(pb + 3)) for (int rep = 0; rep < NREP(3); ++rep) { if (rep) xcd_barrier(bar); pg8::Gemm g{Y, Bt3, 2048, 2048}; pg8::UnitOrder S; S.init(pg8::SK_P3, DM, 2048, F.G, F.bid, 0); pg8::EpiMerge E{Gb, XB, (bf16*)(F.ws + WS_MB4S)};
            pg8::gemm_phase<pg8::EpiMerge, pg8::UnitOrder, true>(F.lds + RING_OFF, g, S, E, wave0);
            if (F.G == 256 && F.bid >= 32 && rep + 1 == NREP(3)) {
                REFRESH(); const int gw = (F.bid - 32) * NWAVES + F.wave, NGW = 224 * NWAVES;
                convert_matrix<RM_GU>(F, F.in[I_WG] + (size_t)l * DM * FF, DM, FF, Bt5, DM, 0, 0, gw, NGW, 0);
                convert_matrix<RM_GU>(F, F.in[I_WU] + (size_t)l * DM * FF, DM, FF, Bt5, DM, 0, 128, gw, NGW, 1408); } }
        SEAM(pb + 3);
        if (IN(pb + 4)) for (int rep = 0; rep < 1; ++rep) { pg8::Gemm g{XB, Bt4, DM, DM}; pg8::UnitOrder S; S.init(pg8::SK_P4, DM, DM, F.G, F.bid, (long)(WS_MB4S - WS_XB));
            pg8::EpiRes E{l == 0 ? F.in[I_XP] : F.out, F.out, XB, F.in[I_LN1G] + l * DM, F.in[I_LN1B] + l * DM, (float*)(F.ws + WS_SLAB),
                          pg8::PanelStats{(unsigned*)(F.ws + WS_XCH + (size_t)(2 * l) * 512 * 1024), (unsigned*)(F.ctl + CW_SEAM + (2 * l) * SEAM_BANK)}, F.lds + XLDS_OFF, wave0};
            pg8::gemm_phase<pg8::EpiRes, pg8::UnitOrder, true>(F.lds + RING_OFF, g, S, E, wave0);
}
        SEAM(pb + 4);
        if (IN(pb + 5) && !fast) for (int rep = 0; rep < NREP(5); ++rep) { if (rep) xcd_barrier(bar);
            REFRESH();
            ln_rows(F, F.out, rep + 1 < NREP(5) ? (float*)(F.ws + WS_Y) : F.out, F.in[I_LN1G] + l * DM, F.in[I_LN1B] + l * DM, rep + 1 < NREP(5) ? nullptr : XB, l == 0 ? F.in[I_XS] : F.out + (size_t)MP * DM, (const float*)(F.ws + WS_SLAB), 16);
            REFRESH();
            if (F.G != 256) { const int gw = F.bid * NWAVES + F.wave, NGW = F.G * NWAVES;
                convert_matrix<RM_GU>(F, F.in[I_WG] + (size_t)l * DM * FF, DM, FF, Bt5, DM, 0, 0, gw, NGW); convert_matrix<RM_GU>(F, F.in[I_WU] + (size_t)l * DM * FF, DM, FF, Bt5, DM, 0, 128, gw, NGW);
                convert_matrix<RM_ID>(F, F.in[I_WD] + (size_t)l * FF * DM, FF, DM, Bt6, FF, 0, 0, gw, NGW); }
        }
        if (!fast) SEAM(pb + 5);
        if (IN(pb + 6)) for (int rep = 0; rep < NREP(6); ++rep) { if (rep) xcd_barrier(bar);
            if (fast && rep == 0) { REFRESH();
                ln_rows(F, F.out, F.out, F.in[I_LN1G] + l * DM, F.in[I_LN1B] + l * DM, XB, l == 0 ? F.in[I_XS] : F.out + (size_t)MP * DM, (const float*)(F.ws + WS_SLAB), 16); publish_ready(F, F.ctl + CW_RDY + 64 * (2 * l)); }
            pg8::Gemm g{XB, Bt5, DM, DM}; pg8::UnitOrder S; S.init(pg8::SK_PLAIN, 2 * FF, DM, F.G, F.bid, 0); pg8::EpiSwi E{Hb};
            if (fast) { S.ready = (const unsigned*)(F.ctl + CW_RDY + 64 * (2 * l)); S.need = (unsigned)F.G; }
            pg8::gemm_phase<pg8::EpiSwi, pg8::UnitOrder, true>(F.lds + RING_OFF, g, S, E, wave0);
            if (F.G == 256 && F.bid >= 172 && rep + 1 == NREP(6)) {
                REFRESH(); const int gw = (F.bid - 172) * NWAVES + F.wave, NGW = 84 * NWAVES;
                convert_matrix<RM_ID>(F, F.in[I_WD] + (size_t)l * FF * DM, FF, DM, Bt6, FF, 0, 0, gw, NGW, 0);
            } }
        SEAM(pb + 6);
        if (IN(pb + 7)) for (int rep = 0; rep < 1; ++rep) { pg8::Gemm g{Hb, Bt6, FF, FF}; pg8::UnitOrder S; S.init(pg8::SK_P6, DM, FF, F.G, F.bid, 0); pg8::EpiRes E{F.out, F.out, l == 0 ? XB : nullptr, F.in[I_LN2G] + l * DM, F.in[I_LN2B] + l * DM, (float*)(F.ws + WS_SLAB),
                          pg8::PanelStats{(unsigned*)(F.ws + WS_XCH + (size_t)(2 * l + 1) * 512 * 1024), (unsigned*)(F.ctl + CW_SEAM + (2 * l + 1) * SEAM_BANK)}, F.lds + XLDS_OFF, wave0};
            pg8::gemm_phase<pg8::EpiRes, pg8::UnitOrder, true>(F.lds + RING_OFF, g, S, E, wave0);
            if (F.G == 256 && F.bid >= 88 && l == 0) {
                REFRESH(); convert_matrix<RM_WIN>(F, F.in[I_WIN] + (size_t)DM * INC, DM, INC, WA, DM, 0, 0, (F.bid - 88) * NWAVES + F.wave, 168 * NWAVES, 0, 0, 128); } }
        SEAM(pb + 7);
        if (IN(pb + 8) && !(fast && l == 0)) for (int rep = 0; rep < NREP(8); ++rep) { if (rep) xcd_barrier(bar);
            REFRESH();
            ln_rows(F, F.out, rep + 1 < NREP(8) ? (float*)(F.ws + WS_Y) : F.out, F.in[I_LN2G] + l * DM, F.in[I_LN2B] + l * DM, (l == 0 && rep + 1 == NREP(8)) ? XB : nullptr, F.out + (size_t)MP * DM, (const float*)(F.ws + WS_SLAB), 11);
            REFRESH();
            if (l == 0 && F.G != 256) convert_matrix<RM_WIN>(F, F.in[I_WIN] + (size_t)DM * INC, DM, INC, WA, DM, 0, 0, F.bid * NWAVES + F.wave, F.G * NWAVES);
        }
        if (l == 0 && !fast) SEAM(pb + 8);
    }
#undef IN
#undef SEAM
#undef REFRESH
}

extern "C" void kernel_launch(void* const* d_in, const int* in_sizes, int n_in, void* d_out, int out_size, void* d_ws, size_t ws_size, hipStream_t stream) {
    static int grid = 0;
    if (grid == 0) {
        if (n_in != 31 || out_size != (int)O_END || ws_size < WS_END) { fprintf(stderr, "kernel_launch: unexpected sizes n_in %d out %d ws %zu\n", n_in, out_size, ws_size); grid = -1; return; }
        int dev = 0, cus = 0, per_cu = 0;
        if (hipGetDevice(&dev) != hipSuccess || hipDeviceGetAttribute(&cus, hipDeviceAttributeMultiprocessorCount, dev) != hipSuccess) { grid = -1; return; }
        if (hipFuncSetAttribute((const void*)hybrid_fwd, hipFuncAttributeMaxDynamicSharedMemorySize, LDS_BYTES) != hipSuccess) { fprintf(stderr, "kernel_launch: hipFuncSetAttribute failed\n"); grid = -1; return; }
        if (hipOccupancyMaxActiveBlocksPerMultiprocessor(&per_cu, (const void*)hybrid_fwd, NWAVES * 64, LDS_BYTES) != hipSuccess || per_cu < 1)
            fprintf(stderr, "kernel_launch: occupancy query reports %d workgroups per CU\n", per_cu);
        (void)hipGetLastError();
        grid = cus;
    }
    if (grid < 0) return;
    if (hipMemsetAsync((char*)d_ws + WS_CTL, 0, CTL_ZERO_BYTES, stream) != hipSuccess) { fprintf(stderr, "kernel_launch: memset failed\n"); return; }
    Args a{};
    for (int i = 0; i < 31; ++i) a.in[i] = (const float*)d_in[i];
    a.out = (float*)d_out; a.ws = (unsigned char*)d_ws;
#if MK_SPLIT
    for (int ph = 0; ph < NPHASE; ++ph) { a.ph_lo = ph; a.ph_hi = ph + 1; hipLaunchKernelGGL(hybrid_fwd, dim3(grid), dim3(NWAVES * 64), LDS_BYTES, stream, a); }
#else
    a.ph_lo = 0; a.ph_hi = NPHASE;
    hipLaunchKernelGGL(hybrid_fwd, dim3(grid), dim3(NWAVES * 64), LDS_BYTES, stream, a);
#endif
}
```

```cpp
#include <hip/hip_runtime.h>
#include <cstdio>
#include <cstdint>

#ifndef PROBE_REP
#define PROBE_REP 0
#endif
#define NREP(k) (1 + ((PROBE_REP >> (k)) & 1))
#ifndef PROBE2
#define PROBE2 0
#endif
#define NREP2(j) (1 + ((PROBE2 >> (j)) & 1))
#ifndef MK_SPLIT
#define MK_SPLIT 0
#endif

constexpr int DM = 1024, WMIX = 512, NPB = 8, SEQ = 2048, NSB = 128, DSEQ = 4;
constexpr int MP = NPB * SEQ, MS = NSB * DSEQ, M = MP + MS;
constexpr int FF = 2816, INC = 8192, ZC = 3072, YC = 2048, GC = 4096;
constexpr float LN_EPS = 1e-5f, ALPHA = 1.41421356237f;
constexpr size_t O_Y = 0, O_PH = (size_t)M * DM, O_PRGC = O_PH + 8192, O_PCF = O_PRGC + 24576, O_PPOOL = O_PCF + 245760, O_PSC = O_PPOOL + 122880,
                 O_SH = O_PSC + 16384, O_SRGC = O_SH + 131072, O_SCF = O_SRGC + 393216, O_SPOOL = O_SCF + 3932160, O_SSC = O_SPOOL + 1966080, O_END = O_SSC + 262144;
static_assert(O_END == 24403968, "output map");

__device__ __forceinline__ int opqv(int v) { asm volatile("" : "+v"(v)); return v; }
__device__ __forceinline__ int lane_now() { int l; asm volatile("v_mbcnt_lo_u32_b32 %0, -1, 0\n\tv_mbcnt_hi_u32_b32 %0, -1, %0" : "=v"(l)); return l; }
__device__ __forceinline__ int opqs(int v) { asm volatile("" : "+s"(v)); return v; }
namespace pg8 {
#define PG8_LAS __attribute__((address_space(3)))
typedef unsigned short bf16_t;
typedef short bf16x8 __attribute__((ext_vector_type(8)));
typedef float f32x4 __attribute__((ext_vector_type(4)));
typedef float f32x2 __attribute__((ext_vector_type(2)));
typedef unsigned u32x4 __attribute__((ext_vector_type(4)));
typedef unsigned u32x2 __attribute__((ext_vector_type(2)));
typedef _Float16 f16x4 __attribute__((ext_vector_type(4)));
typedef _Float16 f16x8 __attribute__((ext_vector_type(8)));
constexpr int BM = 256, BK = 64, HALF = 128, HTB = HALF * BK * 2, STAGE_BYTES = 8 * HTB, NXCD = 8, WGM = 8;

__host__ __device__ __forceinline__ int lds_byte(int r, int c) { const int st = (r >> 4) * 2 + (c >> 5), rr = r & 15, cc = c & 31, ob = rr * 64 + cc * 2; return st * 1024 + (ob ^ (((ob >> 9) & 1) << 5)); }
__host__ __device__ __forceinline__ void stage_rc(int b, int& R, int& C) { const int st = b / 1024, sb = b % 1024, swz = sb ^ (((sb >> 9) & 1) << 5); R = (st >> 1) * 16 + swz / 64; C = (st & 1) * 32 + (swz % 64) / 2; }
__host__ __device__ __forceinline__ int perm32(int rho) { const int n = rho >> 4, i = rho & 15; return 8 * (i >> 2) + 4 * n + (i & 3); }

struct Unit { int pm, pn, nt, mode, aux; long offA, offB; };
struct Gemm { const bf16_t* A; const bf16_t* Bt; int lda, ldb; };

enum { SK_PLAIN = 0, SK_P3 = 1, SK_P4 = 2, SK_P6 = 3 };
struct UnitOrder {
    int kind, nN, nwgP, nS, ntP, G, c; long offA_s; const unsigned* ready = nullptr; unsigned need = 0;
    __device__ __forceinline__ void init(int kind_, int N_, int K_, int G_, int c_, long offA_s_, bool prompt = true, bool sample = true) { kind = kind_; nN = N_ / BM; nwgP = prompt ? 64 * nN : 0; ntP = K_ / BK; G = G_; c = c_; offA_s = offA_s_;
        nS = !sample ? 0 : kind_ == SK_PLAIN ? 2 * nN : kind_ == SK_P3 ? 32 : kind_ == SK_P4 ? 128 : 88; }
    __device__ __forceinline__ bool next(int i, Unit& u, const Gemm& g) const {
        const long L = (long)i * G + c; const long ra = (long)BM * g.lda * 2, rb = (long)BM * g.ldb * 2;
        if (L < nwgP) {
            int wgid = (int)L; { const int q = nwgP / NXCD, xcd = wgid % NXCD, off = wgid / NXCD; wgid = xcd * q + off; }
            const int nig = WGM * nN; u.pm = (wgid / nig) * WGM + ((wgid % nig) % WGM); u.pn = (wgid % nig) / WGM;
            u.nt = ntP; u.mode = 0; u.aux = 0; u.offA = u.pm * ra; u.offB = u.pn * rb; return true; }
        const int s = (int)(L - nwgP); if (s >= nS) return false;
        if (kind == SK_PLAIN) { u.pm = 64 + (s & 1); u.pn = s >> 1; u.nt = ntP; u.mode = 0; u.aux = 0; u.offA = u.pm * ra; u.offB = u.pn * rb; }
        else if (kind == SK_P3) { const int n = s & 3, tile = s >> 2; u.pm = 64 + (tile & 1); u.pn = tile >> 1; u.nt = 8; u.mode = 1; u.aux = n; u.offA = u.pm * ra + 1024 * n; u.offB = u.pn * rb + 1024 * n; }
        else if (kind == SK_P4) { const int ch = s & 15, tile = s >> 4, n = ch >> 2, kin = (ch & 3) * 256; u.pm = 64 + (tile & 1); u.pn = tile >> 1; u.nt = 4; u.mode = 1; u.aux = ch;
            u.offA = offA_s + ((long)(n * 512 + (u.pm - 64) * 256) * 1024 + kin) * 2; u.offB = u.pn * rb + kin * 2; }
        else { const int ch = s % 11, tile = s / 11; u.pm = 64 + (tile & 1); u.pn = tile >> 1; u.nt = 4; u.mode = 1; u.aux = ch; u.offA = u.pm * ra + 512 * ch; u.offB = u.pn * rb + 512 * ch; }
        return true;
    }
    __device__ __forceinline__ void a_ready(const Unit& u, int wid) const {
        if (ready == nullptr || u.pm < 64) return;
        if (wid == 0) { unsigned spins = 0;
            while ((unsigned)__builtin_amdgcn_readfirstlane(__hip_atomic_load(ready, __ATOMIC_RELAXED, __HIP_MEMORY_SCOPE_AGENT)) < need) { __builtin_amdgcn_s_sleep(2); if (++spins > (1u << 20)) break; }
            __builtin_amdgcn_fence(__ATOMIC_ACQUIRE, "agent");
            asm volatile("s_waitcnt vmcnt(0)" ::: "memory"); }
        asm volatile("" ::: "memory"); __builtin_amdgcn_s_barrier(); asm volatile("" ::: "memory");
    }
};

__device__ __forceinline__ unsigned cvt_pk_bf16(float lo, float hi) { unsigned r; asm volatile("v_cvt_pk_bf16_f32 %0, %1, %2" : "=v"(r) : "v"(lo), "v"(hi)); return r; }
__device__ __forceinline__ float sigmoidf_fast(float x) { return __builtin_amdgcn_rcpf(1.0f + __builtin_amdgcn_exp2f(-1.44269504089f * x)); }
__device__ __forceinline__ float gelu_tanh(float x) { const float t = x * x, y = x * fmaf(t, -0.10294324f, -2.3022082f); return x * __builtin_amdgcn_rcpf(1.0f + __builtin_amdgcn_exp2f(y)); }

__device__ __forceinline__ void acc_zero(f32x4 (&acc)[2][2][4][2]) {
#pragma unroll
    for (int a = 0; a < 2; ++a)
#pragma unroll
        for (int b = 0; b < 2; ++b)
#pragma unroll
            for (int m = 0; m < 4; ++m)
#pragma unroll
                for (int n = 0; n < 2; ++n) acc[a][b][m][n] = (f32x4){0.f, 0.f, 0.f, 0.f};
}
__device__ __forceinline__ float* state_ptr(float* out, int R, int keep, int layer, size_t p_off, size_t s_off) {
    if (R < MP) { const int b = R >> 11, j = (R & 2047) - (2048 - keep); return j < 0 ? nullptr : out + p_off + (size_t)((layer * 8 + b) * keep + j) * 512; }
    const int s = (R - MP) >> 2, j = (R & 3) + keep - 4; return j < 0 ? nullptr : out + s_off + (size_t)((layer * 128 + s) * keep + j) * 512;
}

struct EpiMix {
    static constexpr bool PERM = true, MIDK = false;
    __device__ __forceinline__ void init(f32x4 (&acc)[2][2][4][2], const Unit&, int, int) const { acc_zero(acc); }
    bf16_t* Z; float* out; int layer;
    __device__ __forceinline__ void midk(f32x4 (&)[2][2][4][2], const Unit&, int, int, int, int, int) const {}
    __device__ __forceinline__ void operator()(f32x4 (&acc)[2][2][4][2], const Unit& u, int wr, int wc, int fr_, int fq_) const {
        const int lane_ = lane_now(), fr = lane_ & 15, fq = lane_ >> 4; (void)fr_; (void)fq_;
        const int pn = u.pn; int type, zcol, keep = 0, scol = 0; size_t poff = 0, soff = 0;
        if (pn < 2) { type = 0; zcol = 256 * pn; keep = 3; scol = zcol; poff = O_PRGC; soff = O_SRGC; }
        else if (pn < 4) { type = 1; zcol = 512 + 256 * (pn - 2); }
        else if (pn < 8) { type = 2; zcol = 1024 + 128 * (pn - 4); keep = 30; scol = 128 * (pn - 4); poff = O_PCF; soff = O_SCF; }
        else if (pn < 10) { type = 0; zcol = 1536 + 256 * (pn - 8); keep = 15; scol = 256 * (pn - 8); poff = O_PPOOL; soff = O_SPOOL; }
        else if (pn < 12) { type = 0; zcol = 2048 + 256 * (pn - 10); }
        else { type = 3; zcol = 2560 + 128 * (pn - 12); keep = 2; scol = 128 * (pn - 12); poff = O_PSC; soff = O_SSC; }
        const bool tail = keep != 0 && (u.pm >= 64 || (u.pm & 7) == 7);
        const int row0 = u.pm * BM + wr * 64 + fr, cl = wc * 32 + 8 * fq;
        if (type < 2) {
#pragma unroll
            for (int ai = 0; ai < 2; ++ai)
#pragma unroll
                for (int m = 0; m < 4; ++m) { const int R = row0 + ai * HALF + m * 16; bf16_t* rowp = Z + (size_t)R * ZC + zcol + cl;
                    float* sp = tail ? state_ptr(out, R, keep, layer, poff, soff) : nullptr;
#pragma unroll
                    for (int bj = 0; bj < 2; ++bj) { f32x4 v0 = acc[ai][bj][m][0], v1 = acc[ai][bj][m][1];
                        if (type == 1) { v0 = (f32x4){gelu_tanh(v0[0]), gelu_tanh(v0[1]), gelu_tanh(v0[2]), gelu_tanh(v0[3])}; v1 = (f32x4){gelu_tanh(v1[0]), gelu_tanh(v1[1]), gelu_tanh(v1[2]), gelu_tanh(v1[3])}; }
                        u32x4 w; w.x = cvt_pk_bf16(v0[0], v0[1]); w.y = cvt_pk_bf16(v0[2], v0[3]); w.z = cvt_pk_bf16(v1[0], v1[1]); w.w = cvt_pk_bf16(v1[2], v1[3]);
                        *(u32x4*)(rowp + bj * HALF) = w;
                        if (sp) { *(f32x4*)(sp + scol + cl + bj * HALF) = v0; *(f32x4*)(sp + scol + cl + bj * HALF + 4) = v1; } } }
        } else {
#pragma unroll
            for (int ai = 0; ai < 2; ++ai)
#pragma unroll
                for (int m = 0; m < 4; ++m) { const int R = row0 + ai * HALF + m * 16; bf16_t* rowp = Z + (size_t)R * ZC + zcol + cl;
                    float* sp = tail ? state_ptr(out, R, keep, layer, poff, soff) : nullptr;
                    f32x4 v0, v1; const f32x4 a0 = acc[ai][0][m][0], a1 = acc[ai][0][m][1], b0 = acc[ai][1][m][0], b1 = acc[ai][1][m][1];
                    if (type == 2) {
#pragma unroll
                        for (int i = 0; i < 4; ++i) { v0[i] = a0[i] * sigmoidf_fast(b0[i]); v1[i] = a1[i] * sigmoidf_fast(b1[i]); }
                    } else { v0 = a0 * b0; v1 = a1 * b1; }
                    u32x4 w; w.x = cvt_pk_bf16(v0[0], v0[1]); w.y = cvt_pk_bf16(v0[2], v0[3]); w.z = cvt_pk_bf16(v1[0], v1[1]); w.w = cvt_pk_bf16(v1[2], v1[3]);
                    *(u32x4*)rowp = w;
                    if (sp) { *(f32x4*)(sp + scol + cl) = v0; *(f32x4*)(sp + scol + cl + 4) = v1; } }
        }
    }
};

struct EpiGate {
    static constexpr bool PERM = true, MIDK = false;
    __device__ __forceinline__ void init(f32x4 (&acc)[2][2][4][2], const Unit&, int, int) const { acc_zero(acc); }
    _Float16* G;
    __device__ __forceinline__ void midk(f32x4 (&)[2][2][4][2], const Unit&, int, int, int, int, int) const {}
    __device__ __forceinline__ void operator()(f32x4 (&acc)[2][2][4][2], const Unit& u, int wr, int wc, int fr_, int fq_) const {
        const int lane_ = lane_now(), fr = lane_ & 15, fq = lane_ >> 4; (void)fr_; (void)fq_;
        const int row0 = u.pm * BM + wr * 64 + fr, ch0 = 64 * u.pn + 16 * wc + 4 * fq; const bool plain = u.pm >= 64;
#pragma unroll
        for (int ai = 0; ai < 2; ++ai)
#pragma unroll
            for (int m = 0; m < 4; ++m) { const int R = row0 + ai * HALF + m * 16; _Float16* gp = G + (size_t)R * GC + ch0;
                f16x4 r0, r1, r2, g3;
#pragma unroll
                for (int i = 0; i < 4; ++i) {
                    const float d0 = 1.f + __builtin_amdgcn_exp2f(__builtin_amdgcn_fmed3f(acc[ai][0][m][0][i], -15.f, 15.f)), d1 = 1.f + __builtin_amdgcn_exp2f(__builtin_amdgcn_fmed3f(acc[ai][0][m][1][i], -15.f, 15.f));
                    const float d2 = 1.f + __builtin_amdgcn_exp2f(__builtin_amdgcn_fmed3f(acc[ai][1][m][0][i], -15.f, 15.f)), d3 = 1.f + __builtin_amdgcn_exp2f(__builtin_amdgcn_fmed3f(acc[ai][1][m][1][i], -15.f, 15.f));
                    const float i0 = __builtin_amdgcn_rcpf(d0), i1 = __builtin_amdgcn_rcpf(d1), i2 = __builtin_amdgcn_rcpf(d2), i3 = __builtin_amdgcn_rcpf(d3);
                    if (plain) { r0[i] = (_Float16)i0; r1[i] = (_Float16)i1; r2[i] = (_Float16)i2; }
                    else { r0[i] = (_Float16)(d1 * i0); r1[i] = (_Float16)(d2 * i1); r2[i] = (_Float16)(d3 * i2); }
                    g3[i] = (_Float16)i3; }
                *(f16x4*)(gp) = r0; *(f16x4*)(gp + 1024) = r1; *(f16x4*)(gp + 2048) = r2; *(f16x4*)(gp + 3072) = g3; }
    }
};

struct EpiMerge {
    static constexpr bool PERM = true, MIDK = true;
    __device__ __forceinline__ void init(f32x4 (&acc)[2][2][4][2], const Unit&, int, int) const { acc_zero(acc); }
    const _Float16* G; bf16_t* O; bf16_t* Os;
    __device__ __forceinline__ void scale(f32x4 (&acc)[2][2][4][2], const Unit& u, int seg, int wr, int wc) const {
        const int lane_ = lane_now(), fr = lane_ & 15, fq = lane_ >> 4;
        const int row0 = u.pm * BM + wr * 64 + fr, c0 = 1024 * seg + 256 * u.pn + wc * 32 + 8 * fq;
#pragma unroll
        for (int ai = 0; ai < 2; ++ai)
#pragma unroll
            for (int m = 0; m < 4; ++m) { const _Float16* gp = G + (size_t)(row0 + ai * HALF + m * 16) * GC + c0;
#pragma unroll
                for (int bj = 0; bj < 2; ++bj) { const f16x8 f = *(const f16x8*)(gp + bj * HALF);
                    acc[ai][bj][m][0] *= (f32x4){(float)f[0], (float)f[1], (float)f[2], (float)f[3]}; acc[ai][bj][m][1] *= (f32x4){(float)f[4], (float)f[5], (float)f[6], (float)f[7]}; } }
    }
    __device__ __forceinline__ void midk(f32x4 (&acc)[2][2][4][2], const Unit& u, int seg, int wr, int wc, int, int) const { scale(acc, u, seg, wr, wc); }
    __device__ __forceinline__ void operator()(f32x4 (&acc)[2][2][4][2], const Unit& u, int wr, int wc, int, int) const {
        scale(acc, u, u.mode ? u.aux : 3, wr, wc);
        const int lane_ = lane_now(), fr = lane_ & 15, fq = lane_ >> 4;
        const int row0 = (u.mode ? (u.pm - 64) * BM + 512 * u.aux : u.pm * BM) + wr * 64 + fr, c0 = 256 * u.pn + wc * 32 + 8 * fq;
        bf16_t* O = u.mode ? Os : this->O;
#pragma unroll
        for (int ai = 0; ai < 2; ++ai)
#pragma unroll
            for (int m = 0; m < 4; ++m) { bf16_t* rowp = O + (size_t)(row0 + ai * HALF + m * 16) * DM + c0;
#pragma unroll
                for (int bj = 0; bj < 2; ++bj) { const f32x4 v0 = acc[ai][bj][m][0], v1 = acc[ai][bj][m][1];
                    u32x4 w; w.x = cvt_pk_bf16(v0[0], v0[1]); w.y = cvt_pk_bf16(v0[2], v0[3]); w.z = cvt_pk_bf16(v1[0], v1[1]); w.w = cvt_pk_bf16(v1[2], v1[3]); *(u32x4*)(rowp + bj * HALF) = w; } }
    }
};

struct PanelStats {
    unsigned* xbuf;
    unsigned* cnt;
    __device__ __forceinline__ void run(const f32x4 (&v)[2][2][4][2], const Unit& u, int wr, int wc, PG8_LAS unsigned char* lds, int wid) const {
        const int lane = lane_now(), fr = lane & 15, fq = lane >> 4;
        PG8_LAS f32x2* P = (PG8_LAS f32x2*)lds;
        PG8_LAS f32x2* S = (PG8_LAS f32x2*)(lds + 8192);
#pragma unroll
        for (int ai = 0; ai < 2; ++ai)
#pragma unroll
            for (int m = 0; m < 4; ++m) {
                float s = 0.f;
#pragma unroll
                for (int bj = 0; bj < 2; ++bj)
#pragma unroll
                    for (int n = 0; n < 2; ++n) { const f32x4 x = v[ai][bj][m][n]; s += (x[0] + x[1]) + (x[2] + x[3]); }
                s += __builtin_bit_cast(float, __builtin_amdgcn_ds_bpermute((lane ^ 16) << 2, __builtin_bit_cast(int, s))); s += __builtin_bit_cast(float, __builtin_amdgcn_ds_bpermute((lane ^ 32) << 2, __builtin_bit_cast(int, s)));
                const float mw = s * (1.0f / 64.0f); float q = 0.f;
#pragma unroll
                for (int bj = 0; bj < 2; ++bj)
#pragma unroll
                    for (int n = 0; n < 2; ++n) { const f32x4 d = v[ai][bj][m][n] - mw; q += (d[0] * d[0] + d[1] * d[1]) + (d[2] * d[2] + d[3] * d[3]); }
                q += __builtin_bit_cast(float, __builtin_amdgcn_ds_bpermute((lane ^ 16) << 2, __builtin_bit_cast(int, q))); q += __builtin_bit_cast(float, __builtin_amdgcn_ds_bpermute((lane ^ 32) << 2, __builtin_bit_cast(int, q)));
                if (fq == 0) P[(ai * HALF + wr * 64 + m * 16 + fr) * 4 + wc] = (f32x2){mw, q};
            }
        asm volatile("s_waitcnt lgkmcnt(0)" ::: "memory"); __builtin_amdgcn_s_barrier(); asm volatile("" ::: "memory");
        const int row = wid * 32 + (lane & 31);
        if (lane < 32) {
            const f32x2 a = P[row * 4 + 0], b = P[row * 4 + 1], c = P[row * 4 + 2], d = P[row * 4 + 3];
            const float mt = (a.x + b.x + c.x + d.x) * 0.25f;
            const float da = a.x - mt, db = b.x - mt, dc = c.x - mt, dd = d.x - mt;
            const float m2 = (a.y + b.y) + (c.y + d.y) + 64.0f * ((da * da + db * db) + (dc * dc + dd * dd));
            unsigned long long* slot = (unsigned long long*)xbuf + ((size_t)(u.pm * BM + row) * 4 + u.pn);
            __hip_atomic_store(slot, ((unsigned long long)__float_as_uint(m2) << 32) | __float_as_uint(mt), __ATOMIC_RELAXED, __HIP_MEMORY_SCOPE_AGENT);
        }
        asm volatile("s_waitcnt vmcnt(0)" ::: "memory");
        if (lane == 0) __hip_atomic_fetch_add(cnt + 64 * u.pm, 1u, __ATOMIC_RELAXED, __HIP_MEMORY_SCOPE_AGENT);
        if (wid == 0) {
            unsigned spins = 0;
            while ((unsigned)__builtin_amdgcn_readfirstlane(__hip_atomic_load(cnt + 64 * u.pm, __ATOMIC_RELAXED, __HIP_MEMORY_SCOPE_AGENT)) < 32u) { __builtin_amdgcn_s_sleep(2); if (++spins > (1u << 20)) break; }
            __builtin_amdgcn_fence(__ATOMIC_ACQUIRE, "agent");
        }
        asm volatile("s_waitcnt vmcnt(0) lgkmcnt(0)" ::: "memory"); __builtin_amdgcn_s_barrier(); asm volatile("" ::: "memory");
        if (lane < 32) {
            const unsigned long long* slot = (const unsigned long long*)xbuf + (size_t)(u.pm * BM + row) * 4; float mt[4], m2[4]; float ms = 0.f;
#pragma unroll
            for (int t = 0; t < 4; ++t) { const unsigned long long w = __hip_atomic_load(slot + t, __ATOMIC_RELAXED, __HIP_MEMORY_SCOPE_AGENT); mt[t] = __uint_as_float((unsigned)w); m2[t] = __uint_as_float((unsigned)(w >> 32)); ms += mt[t]; }
            const float mean = ms * 0.25f; float q = 0.f;
#pragma unroll
            for (int t = 0; t < 4; ++t) { const float dm = mt[t] - mean; q += m2[t] + 256.0f * dm * dm; }
            S[row] = (f32x2){mean, __builtin_amdgcn_rsqf(q * (1.0f / 1024.0f) + LN_EPS)};
        }
        asm volatile("s_waitcnt lgkmcnt(0)" ::: "memory"); __builtin_amdgcn_s_barrier(); asm volatile("" ::: "memory");
    }
};
struct EpiRes {
    static constexpr bool PERM = false, MIDK = false;
    __device__ __forceinline__ void init(f32x4 (&acc)[2][2][4][2], const Unit& u, int wr, int wc) const {
        if (u.mode) { acc_zero(acc); return; }
        const int lane_ = lane_now(), fr = lane_ & 15, fq = lane_ >> 4;
        const float* bp0 = baseP + (size_t)(u.pm * BM + wr * 64 + fr) * DM + 256 * u.pn + wc * 32 + 4 * fq;
#pragma unroll
        for (int ai = 0; ai < 2; ++ai)
#pragma unroll
            for (int m = 0; m < 4; ++m)
#pragma unroll
                for (int bj = 0; bj < 2; ++bj)
#pragma unroll
                    for (int n = 0; n < 2; ++n) acc[ai][bj][m][n] = *(const f32x4*)(bp0 + (size_t)(ai * HALF + m * 16) * DM + bj * HALF + n * 16) * ALPHA;
    }
    const float* baseP; float* out; bf16_t* xb; const float* lng; const float* lnb; float* slab; PanelStats st; PG8_LAS unsigned char* xlds; int wid;
    __device__ __forceinline__ void midk(f32x4 (&)[2][2][4][2], const Unit&, int, int, int, int, int) const {}
    __device__ __forceinline__ void operator()(f32x4 (&acc)[2][2][4][2], const Unit& u, int wr, int wc, int fr_, int fq_) const {
        const int lane_ = lane_now(), fr = lane_ & 15, fq = lane_ >> 4; (void)fr_; (void)fq_;
        const int row0 = u.pm * BM + wr * 64 + fr, c0 = 256 * u.pn + wc * 32 + 4 * fq;
        if (u.mode) {
#pragma unroll
            for (int ai = 0; ai < 2; ++ai)
#pragma unroll
                for (int m = 0; m < 4; ++m) { float* op = slab + ((size_t)u.aux * 512 + (row0 - MP) + ai * HALF + m * 16) * DM + c0;
#pragma unroll
                    for (int bj = 0; bj < 2; ++bj)
#pragma unroll
                        for (int n = 0; n < 2; ++n) *(f32x4*)(op + bj * HALF + n * 16) = acc[ai][bj][m][n]; }
            return; }
        st.run(acc, u, wr, wc, xlds, wid);
        const PG8_LAS f32x2* S = (const PG8_LAS f32x2*)(xlds + 8192);
#pragma unroll
        for (int bj = 0; bj < 2; ++bj)
#pragma unroll
            for (int n = 0; n < 2; ++n) { const int cc = c0 + bj * HALF + n * 16; const f32x4 gv = *(const f32x4*)(lng + cc), bv = *(const f32x4*)(lnb + cc);
#pragma unroll
                for (int ai = 0; ai < 2; ++ai)
#pragma unroll
                    for (int m = 0; m < 4; ++m) { const int r = ai * HALF + wr * 64 + m * 16 + fr; const f32x2 sr = S[r]; const size_t off = (size_t)(u.pm * BM + r) * DM + cc;
                        const f32x4 o = (acc[ai][bj][m][n] - sr.x) * sr.y * gv + bv; *(f32x4*)(out + off) = o;
                        if (xb) { u32x2 w; w.x = cvt_pk_bf16(o[0], o[1]); w.y = cvt_pk_bf16(o[2], o[3]); *(u32x2*)(xb + off) = w; }
                        if (m & 1) asm volatile("" ::: "memory"); } }
    }
};

struct EpiSwi {
    static constexpr bool PERM = true, MIDK = false;
    __device__ __forceinline__ void init(f32x4 (&acc)[2][2][4][2], const Unit&, int, int) const { acc_zero(acc); }
    bf16_t* H;
    __device__ __forceinline__ void midk(f32x4 (&)[2][2][4][2], const Unit&, int, int, int, int, int) const {}
    __device__ __forceinline__ void operator()(f32x4 (&acc)[2][2][4][2], const Unit& u, int wr, int wc, int fr_, int fq_) const {
        const int lane_ = lane_now(), fr = lane_ & 15, fq = lane_ >> 4; (void)fr_; (void)fq_;
        const int row0 = u.pm * BM + wr * 64 + fr, c0 = 128 * u.pn + wc * 32 + 8 * fq;
#pragma unroll
        for (int ai = 0; ai < 2; ++ai)
#pragma unroll
            for (int m = 0; m < 4; ++m) { bf16_t* rowp = H + (size_t)(row0 + ai * HALF + m * 16) * FF + c0;
                const f32x4 g0 = acc[ai][0][m][0], g1 = acc[ai][0][m][1], u0 = acc[ai][1][m][0], u1 = acc[ai][1][m][1]; f32x4 v0, v1;
#pragma unroll
                for (int i = 0; i < 4; ++i) { v0[i] = g0[i] * sigmoidf_fast(g0[i]) * u0[i]; v1[i] = g1[i] * sigmoidf_fast(g1[i]) * u1[i]; }
                u32x4 w; w.x = cvt_pk_bf16(v0[0], v0[1]); w.y = cvt_pk_bf16(v0[2], v0[3]); w.z = cvt_pk_bf16(v1[0], v1[1]); w.w = cvt_pk_bf16(v1[2], v1[3]);
                *(u32x4*)rowp = w; }
    }
};

template <class Epi, class Sched, bool ALIGN_EPI>
__device__ __forceinline__ void gemm_phase(PG8_LAS unsigned char* lds, const Gemm g, const Sched& S, const Epi& E, int wave_id) {
    const int wid = opqs(wave_id), lane = lane_now(), tid = wid * 64 + lane, wr = wid >> 2, wc = wid & 3, fr = lane & 15, fq = lane >> 4;
    unsigned voffA[2], voffB[2];
#pragma unroll
    for (int i = 0; i < 2; ++i) { int R, C; stage_rc(tid * 16 + i * 8192, R, C); const int Rb = Epi::PERM ? ((R & ~31) + perm32(R & 31)) : R;
        voffA[i] = (unsigned)(R * g.lda + C) * 2u; voffB[i] = (unsigned)(Rb * g.ldb + C) * 2u; }
    const size_t kstep = (size_t)(BK * 2);
    const size_t hstepA = (size_t)HALF * g.lda * 2, hstepB = (size_t)HALF * g.ldb * 2;
    const unsigned ldsw = (unsigned)wid * 1024u;
    const int aoff = lds_byte(wr * 64 + fr, fq * 8), boff = lds_byte(wc * 32 + fr, fq * 8);
#define PG8_SA(b, h) (((b) * 2 + (h)) * HTB)
#define PG8_SB(b, h) ((4 + (b) * 2 + (h)) * HTB)
#define PG8_STAGE(bufoff, gbase, voff) do { _Pragma("unroll") for (int _i = 0; _i < 2; ++_i) \
        __builtin_amdgcn_global_load_lds((const unsigned*)((const char*)(gbase) + (voff)[_i]), (PG8_LAS unsigned*)(lds + (bufoff) + ldsw + _i * 8192), 16, 0, 0); } while (0)
#define PG8_LDA(dst, b, h) do { _Pragma("unroll") for (int m = 0; m < 4; ++m) _Pragma("unroll") for (int k = 0; k < 2; ++k) dst[m][k] = *(const PG8_LAS bf16x8*)(lds + PG8_SA(b, h) + aoff + m * 2048 + k * 1024); } while (0)
#define PG8_LDB(dst, b, h) do { _Pragma("unroll") for (int n = 0; n < 2; ++n) _Pragma("unroll") for (int k = 0; k < 2; ++k) dst[n][k] = *(const PG8_LAS bf16x8*)(lds + PG8_SB(b, h) + boff + n * 2048 + k * 1024); } while (0)
#define PG8_MMA(ai, bj, At, Bt) do { __builtin_amdgcn_s_setprio(1); _Pragma("unroll") for (int m = 0; m < 4; ++m) _Pragma("unroll") for (int n = 0; n < 2; ++n) _Pragma("unroll") for (int k = 0; k < 2; ++k) \
        acc[ai][bj][m][n] = __builtin_amdgcn_mfma_f32_16x16x32_bf16(Bt[n][k], At[m][k], acc[ai][bj][m][n], 0, 0, 0); __builtin_amdgcn_s_setprio(0); } while (0)
#define PG8_WAIT_V(n) asm volatile("s_waitcnt vmcnt(" #n ")" ::: "memory")
#define PG8_WAIT_L(n) asm volatile("s_waitcnt lgkmcnt(" #n ")" ::: "memory")
#define PG8_BAR __builtin_amdgcn_s_barrier()
#define PG8_SCHED __builtin_amdgcn_sched_barrier(0)
    Unit cur, nxt; int ui = 0;
    if (!S.next(0, cur, g)) return;
    f32x4 acc[2][2][4][2];
    E.init(acc, cur, wr, wc);
    bf16x8 At[4][2], B0[2][2], B1[2][2];
    const char* cA = (const char*)g.A + cur.offA; const char* cB = (const char*)g.Bt + cur.offB;
    PG8_STAGE(PG8_SB(0, 0), cB, voffB); PG8_STAGE(PG8_SB(0, 1), cB + hstepB, voffB); PG8_STAGE(PG8_SA(0, 0), cA, voffA); PG8_STAGE(PG8_SA(0, 1), cA + hstepA, voffA);
    if (wr == 1) PG8_BAR;
    PG8_WAIT_V(2); PG8_BAR;
    PG8_STAGE(PG8_SB(1, 0), cB + kstep, voffB); PG8_STAGE(PG8_SA(1, 0), cA + kstep, voffA); PG8_STAGE(PG8_SB(1, 1), cB + hstepB + kstep, voffB);
    PG8_WAIT_V(6); PG8_BAR;
    for (;;) {
        const bool has_next = S.next(ui + 1, nxt, g);
        const char* nA = has_next ? (const char*)g.A + nxt.offA : cA; const char* nB = has_next ? (const char*)g.Bt + nxt.offB : cB;
        const int nt = cur.nt, TSEG = Epi::MIDK ? 8 : nt;
        for (int t0 = 0; t0 < nt; t0 += TSEG) {
        if constexpr (Epi::MIDK) { if (t0 != 0) { PG8_SCHED; E.midk(acc, cur, t0 / TSEG - 1, wr, wc, 0, 0); PG8_SCHED; } }
#pragma unroll 1
        for (int t = t0; t < t0 + TSEG; t += 2) {
            const bool last = (t == nt - 2);
            if (last && has_next) S.a_ready(nxt, wid);
            const char* a1 = cA + (size_t)(t + 1) * kstep;
            const char* a2 = last ? nA : cA + (size_t)(t + 2) * kstep; const char* b2 = last ? nB : cB + (size_t)(t + 2) * kstep;
            const char* a3 = a2 + kstep; const char* b3 = b2 + kstep;
            PG8_LDB(B0, 0, 0); PG8_LDB(B1, 0, 1); PG8_SCHED; PG8_LDA(At, 0, 0); PG8_STAGE(PG8_SA(1, 1), a1 + hstepA, voffA);
            PG8_WAIT_V(8); PG8_WAIT_L(0); PG8_BAR; PG8_MMA(0, 0, At, B0); PG8_MMA(0, 1, At, B1); PG8_BAR; PG8_SCHED;
            PG8_LDA(At, 0, 1); PG8_STAGE(PG8_SB(0, 0), b2, voffB); PG8_STAGE(PG8_SB(0, 1), b2 + hstepB, voffB); PG8_STAGE(PG8_SA(0, 0), a2, voffA);
            PG8_WAIT_V(8); PG8_WAIT_L(0); PG8_BAR; PG8_MMA(1, 0, At, B0); PG8_MMA(1, 1, At, B1); PG8_BAR; PG8_SCHED;
            PG8_LDB(B0, 1, 0); PG8_LDB(B1, 1, 1); PG8_SCHED; PG8_LDA(At, 1, 0); PG8_STAGE(PG8_SA(0, 1), a2 + hstepA, voffA);
            PG8_WAIT_V(8); PG8_WAIT_L(0); PG8_BAR; PG8_MMA(0, 0, At, B0); PG8_MMA(0, 1, At, B1); PG8_BAR; PG8_SCHED;
            PG8_LDA(At, 1, 1); PG8_STAGE(PG8_SB(1, 0), b3, voffB); PG8_STAGE(PG8_SB(1, 1), b3 + hstepB, voffB); PG8_STAGE(PG8_SA(1, 0), a3, voffA);
            PG8_WAIT_V(8); PG8_WAIT_L(0); PG8_BAR; PG8_MMA(1, 0, At, B0); PG8_MMA(1, 1, At, B1); PG8_BAR; PG8_SCHED;
        }
        }
        if constexpr (ALIGN_EPI) { if (wr == 0) PG8_BAR; }
        E(acc, cur, wr, wc, 0, 0);
        if (!has_next) break;
        cur = nxt; cA = nA; cB = nB; ++ui;
        E.init(acc, cur, wr, wc);
        if constexpr (ALIGN_EPI) { if (wr == 1) PG8_BAR; }
    }
    PG8_WAIT_V(0);
    if constexpr (!ALIGN_EPI) { if (wr == 0) PG8_BAR; }
    PG8_BAR;
#undef PG8_SA
#undef PG8_SB
#undef PG8_STAGE
#undef PG8_LDA
#undef PG8_LDB
#undef PG8_MMA
#undef PG8_WAIT_V
#undef PG8_WAIT_L
#undef PG8_BAR
#undef PG8_SCHED
}
}

constexpr int NWAVES = 8;
constexpr int NPHASE = 19;
constexpr size_t MiB = 1u << 20;
constexpr size_t WS_CTL = 0, CTL_ZERO_BYTES = 1 * MiB;
constexpr size_t WS_WA = 1 * MiB;
constexpr size_t WS_XB = 18 * MiB;
constexpr size_t WS_Y = 51 * MiB;
constexpr size_t WS_ZG = 117 * MiB;
constexpr size_t WS_BT3 = 249 * MiB, WS_BT4 = 253 * MiB, WS_BT5 = WS_WA, WS_BT6 = WS_ZG + 108 * MiB;
constexpr size_t WS_MB4S = WS_WA + 13 * MiB;
constexpr size_t WS_SLAB = WS_Y;
constexpr size_t WS_END = 255 * MiB;
static_assert(WS_XB + (size_t)M * DM * 2 <= WS_Y && WS_Y + (size_t)M * YC * 2 <= WS_ZG && WS_ZG + (size_t)M * GC * 2 <= WS_BT3 && WS_SLAB + (size_t)16 * 512 * DM * 4 <= WS_Y + 40 * MiB && WS_Y + 40 * MiB + 4 * 512 * 1024 <= WS_ZG, "ws map");
static_assert((size_t)M * FF * 2 <= 108 * MiB && WS_BT5 + (size_t)2 * FF * DM * 2 <= WS_MB4S && WS_MB4S + 4 * MiB <= WS_XB && WS_BT6 + (size_t)DM * FF * 2 <= WS_BT3, "ws map 2");
constexpr int CW_RDY = 12288;
constexpr int CW_TMO = 0, CW_CODE = 1, CW_BAR = 4096, CW_SEAM = 16384, SEAM_BANK = 8192;
constexpr size_t WS_XCH = WS_Y + 40 * MiB;
constexpr int XLDS_OFF = 131072 + 1024;
constexpr int RING_OFF = 0, RING_BYTES = 131072;
constexpr int LDSCTL_OFF = RING_BYTES, MISC_OFF = LDSCTL_OFF + 320;
constexpr int LDS_BYTES = 147456;

#define GAS __attribute__((address_space(1)))
#define LAS __attribute__((address_space(3)))
typedef unsigned short bf16;
typedef unsigned v4u __attribute__((ext_vector_type(4)));
typedef unsigned v2u __attribute__((ext_vector_type(2)));
typedef float f32x4 __attribute__((ext_vector_type(4)));
typedef float f32x2 __attribute__((ext_vector_type(2)));
typedef short bf16x8 __attribute__((ext_vector_type(8)));
typedef GAS unsigned gu32;
#define RLX_AGENT __ATOMIC_RELAXED, __HIP_MEMORY_SCOPE_AGENT
#define LDS_WAIT() asm volatile("s_waitcnt lgkmcnt(0)" ::: "memory")
#define VM_WAIT() asm volatile("s_waitcnt vmcnt(0)" ::: "memory")
__device__ __forceinline__ unsigned pk2(float lo, float hi) { return pg8::cvt_pk_bf16(lo, hi); }
__device__ __forceinline__ float bflo(unsigned v) { return __uint_as_float(v << 16); }
__device__ __forceinline__ float bfhi(unsigned v) { return __uint_as_float(v & 0xffff0000u); }
__device__ __forceinline__ float bf1(unsigned short h) { return __uint_as_float((unsigned)h << 16); }
__device__ __forceinline__ unsigned short f2bf(float f) { return (unsigned short)(pg8::cvt_pk_bf16(f, 0.f) & 0xffffu); }

#define XB_TMO      128
#define XB_XCNT(j)  (256  + 64 * (j))
#define XB_XSUB(j)  (1280 + 64 * (j))
#define XB_XGEN(j)  (2304 + 64 * (j))
#define XB_TOP      3328
#define XB_TOPGEN   3392
#define XCD_BAR_WORDS 3456
#define XB_SPIN_CAP (1u << 18)
__device__ __forceinline__ unsigned xb_ld(unsigned* p)              { return __hip_atomic_load(p, __ATOMIC_RELAXED, __HIP_MEMORY_SCOPE_AGENT); }
__device__ __forceinline__ unsigned xb_add(unsigned* p, unsigned v) { return __hip_atomic_fetch_add(p, v, __ATOMIC_RELAXED, __HIP_MEMORY_SCOPE_AGENT); }
__device__ __forceinline__ unsigned xb_xcc_id() { return (unsigned)__builtin_amdgcn_s_getreg((3 << 11) | 20) & 0xFu; }
#define XB_SPIN(cond, bar) do { unsigned _sp = 0; while (cond) { __builtin_amdgcn_s_sleep(1); \
    if ((++_sp & 255u) == 0u) { if (xb_ld(&(bar)[XB_TMO])) break; if (_sp > XB_SPIN_CAP) { atomicAdd(&(bar)[XB_TMO], 1u); break; } } } } while (0)
struct XcdBarrier { unsigned* bar; unsigned x; volatile LAS unsigned* st; };
__device__ __forceinline__ XcdBarrier xcd_barrier_post(unsigned* bar, volatile LAS unsigned* st) {
    XcdBarrier b; b.bar = bar; b.x = xb_xcc_id(); b.st = st;
    if (threadIdx.x == 0) (void)xb_add(&bar[XB_XCNT(b.x)], 1u);
    return b;
}
__device__ __forceinline__ void xcd_barrier_complete(unsigned* bar, unsigned x, unsigned& nloc, unsigned& nx) {
    const unsigned G = gridDim.x * gridDim.y * gridDim.z;
    unsigned sum, cnt, mine, sp = 0u;
    for (;;) {
        sum = 0u; cnt = 0u; mine = 0u;
#pragma unroll
        for (unsigned j = 0; j < 16; ++j) { const unsigned c = xb_ld(&bar[XB_XCNT(j)]); sum += c; cnt += (c > 0u) ? 1u : 0u; mine = (j == x) ? c : mine; }
        if (sum == G) break;
        __builtin_amdgcn_s_sleep(1);
        if ((++sp & 255u) == 0u) { if (xb_ld(&bar[XB_TMO])) break; if (sp > XB_SPIN_CAP) { atomicAdd(&bar[XB_TMO], 1u); break; } }
    }
    nloc = mine > 0u ? mine : 1u; nx = cnt > 0u ? cnt : 1u;
}
__device__ __forceinline__ void xcd_barrier(const XcdBarrier& b) {
    asm volatile("s_waitcnt vmcnt(0)" ::: "memory");
    __syncthreads();
    if (threadIdx.x == 0) {
        unsigned* bar = b.bar;
        __builtin_amdgcn_s_waitcnt(0);
        unsigned nloc = b.st[0], nx = b.st[1];
        if (nloc == 0u) { xcd_barrier_complete(bar, b.x, nloc, nx); b.st[0] = nloc; b.st[1] = nx; }
        const unsigned old = xb_add(&bar[XB_XSUB(b.x)], 1u);
        const unsigned gen = old / nloc;
        if (old + 1u == (gen + 1u) * nloc) {
            __builtin_amdgcn_fence(__ATOMIC_RELEASE, "agent");
            asm volatile("s_waitcnt vmcnt(0)" ::: "memory");
            const unsigned og = xb_add(&bar[XB_TOP], 1u);
            const unsigned tg = og / nx;
            if (og + 1u == (tg + 1u) * nx) xb_add(&bar[XB_TOPGEN], 1u);
            else XB_SPIN(xb_ld(&bar[XB_TOPGEN]) == tg, bar);
            __builtin_amdgcn_fence(__ATOMIC_ACQUIRE, "agent");
            xb_add(&bar[XB_XGEN(b.x)], 1u);
            asm volatile("s_waitcnt vmcnt(0)" ::: "memory");
        } else {
            XB_SPIN(xb_ld(&bar[XB_XGEN(b.x)]) == gen, bar);
            __builtin_amdgcn_fence(__ATOMIC_ACQUIRE, "agent");
            asm volatile("s_waitcnt vmcnt(0)" ::: "memory");
        }
    }
    __syncthreads();
}

struct Frame {
    LAS unsigned char* lds;
    volatile LAS unsigned* MISC;
    gu32* ctl;
    int tid, lane, wave, G, bid;
    const float* const* in;
    float* out;
    unsigned char* ws;
};
enum { I_XP = 0, I_XS, I_SH, I_SRGC, I_SCF, I_SPOOL, I_SSC, I_WIN, I_RGCW, I_RGCB, I_RGWA, I_RGBA, I_RGWX, I_RGBX, I_LAM, I_CFW, I_CFB, I_CFG, I_CFBB, I_POOLW, I_POOLS, I_SCW,
       I_WBR, I_WOUT, I_LN1G, I_LN1B, I_WG, I_WU, I_WD, I_LN2G, I_LN2B };

__device__ __forceinline__ float shfl_idx(float v, int src_lane) { return __builtin_bit_cast(float, __builtin_amdgcn_ds_bpermute(src_lane << 2, __builtin_bit_cast(int, v))); }
__device__ __forceinline__ float wave_sum(float v, int lane) {
#pragma unroll
    for (int o = 1; o < 64; o <<= 1) v += shfl_idx(v, lane ^ o);
    return v;
}

enum { RM_ID = 0, RM_WIN = 1, RM_GU = 2 };
template <int MODE> __device__ __forceinline__ int rowmap(int s, int extra) {
    if (MODE == RM_ID) return s;
    if (MODE == RM_GU) return 256 * (s >> 7) + (s & 127) + extra;
    if (s < 1024) return s;
    if (s < 2048) { const int j = ((s - 1024) >> 7) & 3; return 1024 + 256 * j + (s >= 1536 ? 128 : 0) + (s & 127); }
    if (s < 3072) return s;
    if (s < 4096) { const int j = ((s - 3072) >> 7) & 3; return 3072 + 256 * j + (s >= 3584 ? 128 : 0) + (s & 127); }
    const int g = (s - 4096) >> 10, ch = s & 1023, pn = ch >> 6, chl = ch & 63, wc = chl >> 4, fq = (chl >> 2) & 3, i = chl & 3;
    return 4096 + 256 * pn + 128 * (g >> 1) + 32 * wc + 8 * fq + 4 * (g & 1) + i;
}
template <int MODE>
__device__ __forceinline__ void transpose_item(const float* W, int K, int N, bf16* WT, int dst_ld, int dst_koff, int extra, LAS float* scr, int item, int lane, int nb0, int nnb) {
    const int kb = item / nnb, nb = nb0 + item % nnb, k0 = 64 * kb, n0 = 32 * nb;
#pragma unroll 8
    for (int i = 0; i < 32; ++i) { const int kk = 2 * i + (lane >> 5); scr[kk * 33 + (lane & 31)] = W[(size_t)(k0 + kk) * N + n0 + (lane & 31)]; }
    LDS_WAIT(); asm volatile("" ::: "memory");
    const int c = lane & 7; const float sc = (MODE == RM_WIN && n0 >= 4096) ? -1.44269504089f : 1.0f;
#pragma unroll
    for (int j = 0; j < 4; ++j) { const int n = (lane >> 3) + 8 * j; const LAS float* s = scr + (8 * c) * 33 + n;
        v4u o; o.x = pk2(s[0 * 33] * sc, s[1 * 33] * sc); o.y = pk2(s[2 * 33] * sc, s[3 * 33] * sc); o.z = pk2(s[4 * 33] * sc, s[5 * 33] * sc); o.w = pk2(s[6 * 33] * sc, s[7 * 33] * sc);
        *(GAS v4u*)(WT + (size_t)rowmap<MODE>(n0 + n, extra) * dst_ld + dst_koff + k0 + 8 * c) = o; }
    LDS_WAIT(); asm volatile("" ::: "memory");
}
template <int MODE>
__device__ __forceinline__ void convert_matrix(Frame& F, const float* W, int K, int N, bf16* WT, int dst_ld, int dst_koff, int extra, int gw, int NGW, int first = 0, int nb0 = 0, int nnb = 0) {
    LAS float* scr = (LAS float*)(F.lds + RING_OFF + F.wave * 16384);
    if (nnb == 0) nnb = N / 32;
    const int nitems = (K / 64) * nnb;
    int it0 = gw - first; if (it0 < 0) it0 += ((-it0 + NGW - 1) / NGW) * NGW;
    for (int it = it0; it < nitems; it += NGW) transpose_item<MODE>(W, K, N, WT, dst_ld, dst_koff, extra, scr, it, F.lane, nb0, nnb);
}
__device__ __forceinline__ void compose_pool(Frame& F, int layer, bf16* Bt3, int gw, int NGW, int first = 0) {
    const float* pw = F.in[I_POOLW] + (size_t)layer * 4 * 128 * 128; const float* ps = F.in[I_POOLS] + layer * 512; const float* Wb2 = F.in[I_WBR] + ((size_t)layer * 4 + 2) * 512 * 1024;
    const int lane = F.lane;
    LAS float* Pl = (LAS float*)(F.lds + RING_OFF + F.wave * 16384);
    int id0 = gw - first; if (id0 < 0) id0 += ((-id0 + NGW - 1) / NGW) * NGW;
    for (int id = id0; id < 512; id += NGW) {
        const int g = __builtin_amdgcn_readfirstlane(id >> 7), c0 = __builtin_amdgcn_readfirstlane(8 * ((id >> 3) & 15)), d0 = 128 * (id & 7) + 2 * lane;
#pragma unroll
        for (int k = 0; k < 4; ++k) { const int idx4 = lane + 64 * k, i = idx4 >> 5, e4 = (idx4 & 31) * 4;
            const f32x4 pv = *(const GAS f32x4*)(pw + ((size_t)g * 128 + c0 + i) * 128 + e4), sv = *(const GAS f32x4*)(ps + 128 * g + e4);
            Pl[(e4 + 0) * 8 + i] = pv.x * sv.x; Pl[(e4 + 1) * 8 + i] = pv.y * sv.y; Pl[(e4 + 2) * 8 + i] = pv.z * sv.z; Pl[(e4 + 3) * 8 + i] = pv.w * sv.w; }
        LDS_WAIT(); asm volatile("" ::: "memory");
        f32x2 acc[8];
#pragma unroll
        for (int i = 0; i < 8; ++i) acc[i] = (f32x2){0.f, 0.f};
        const float* wrow = Wb2 + (size_t)(128 * g) * 1024 + d0;
#pragma unroll 1
        for (int e0 = 0; e0 < 128; e0 += 8) {
            f32x2 wv[8];
#pragma unroll
            for (int k = 0; k < 8; ++k) wv[k] = *(const GAS f32x2*)(wrow + (size_t)(e0 + k) * 1024);
#pragma unroll
            for (int k = 0; k < 8; ++k) { const f32x4 p0 = *(const LAS f32x4*)(Pl + (e0 + k) * 8), p1 = *(const LAS f32x4*)(Pl + (e0 + k) * 8 + 4);
#pragma unroll
                for (int i = 0; i < 4; ++i) { acc[i] += wv[k] * p0[i]; acc[4 + i] += wv[k] * p1[i]; } }
        }
        v4u o0, o1;
        o0.x = pk2(acc[0].x, acc[1].x); o0.y = pk2(acc[2].x, acc[3].x); o0.z = pk2(acc[4].x, acc[5].x); o0.w = pk2(acc[6].x, acc[7].x);
        o1.x = pk2(acc[0].y, acc[1].y); o1.y = pk2(acc[2].y, acc[3].y); o1.z = pk2(acc[4].y, acc[5].y); o1.w = pk2(acc[6].y, acc[7].y);
        *(GAS v4u*)(Bt3 + (size_t)d0 * 2048 + 1024 + 128 * g + c0) = o0; *(GAS v4u*)(Bt3 + (size_t)(d0 + 1) * 2048 + 1024 + 128 * g + c0) = o1;
        LDS_WAIT(); asm volatile("" ::: "memory");
    }
}

__device__ __forceinline__ const float* xrow_in(Frame& F, int m) { return m < MP ? F.in[I_XP] + (size_t)m * DM : F.in[I_XS] + (size_t)(m - MP) * DM; }
__device__ __forceinline__ void x_to_bf16(Frame& F, bf16* XB) {
    const int gw = F.bid * NWAVES + F.wave, NGW = F.G * NWAVES;
    for (int m0 = 4 * gw; m0 < M; m0 += 4 * NGW) {
        f32x4 v[4][4];
#pragma unroll
        for (int k = 0; k < 4; ++k) { const GAS f32x4* xr = (const GAS f32x4*)xrow_in(F, m0 + k) + F.lane;
#pragma unroll
            for (int j = 0; j < 4; ++j) v[k][j] = xr[64 * j]; }
#pragma unroll
        for (int k = 0; k < 4; ++k) { GAS v2u* o = (GAS v2u*)(XB + (size_t)(m0 + k) * DM) + F.lane;
#pragma unroll
            for (int j = 0; j < 4; ++j) o[64 * j] = (v2u){pk2(v[k][j].x, v[k][j].y), pk2(v[k][j].z, v[k][j].w)}; } }
}
__device__ __forceinline__ void ln_rows(Frame& F, const float* V, float* O, const float* g, const float* b, bf16* XB, const float* sbase, const float* slab, int nslab) {
    const int gw = F.bid * NWAVES + F.wave, NGW = F.G * NWAVES;
    f32x4 gv[4], bv[4];
#pragma unroll
    for (int j = 0; j < 4; ++j) { gv[j] = ((const GAS f32x4*)g)[F.lane + 64 * j]; bv[j] = ((const GAS f32x4*)b)[F.lane + 64 * j]; }
    for (int m = MP + gw; m < M; m += NGW) {
        const GAS f32x4* xr = (const GAS f32x4*)(V + (size_t)m * DM) + F.lane; GAS f32x4* orow = (GAS f32x4*)(O + (size_t)m * DM) + F.lane;
        f32x4 v[4]; float s = 0.f;
#pragma unroll
        for (int j = 0; j < 4; ++j) v[j] = xr[64 * j];
        if (m >= MP) { const GAS f32x4* br = (const GAS f32x4*)(sbase + (size_t)(m - MP) * DM) + F.lane;
#pragma unroll
            for (int j = 0; j < 4; ++j) v[j] = br[64 * j] * ALPHA;
            for (int sl = 0; sl < nslab; ++sl) { const GAS f32x4* sr = (const GAS f32x4*)(slab + ((size_t)sl * 512 + (m - MP)) * DM) + F.lane;
#pragma unroll
                for (int j = 0; j < 4; ++j) v[j] += sr[64 * j]; } }
#pragma unroll
        for (int j = 0; j < 4; ++j) s += (v[j].x + v[j].y) + (v[j].z + v[j].w);
        const float mean = wave_sum(s, F.lane) * (1.f / DM); float s2 = 0.f;
#pragma unroll
        for (int j = 0; j < 4; ++j) { v[j] = v[j] - mean; s2 += (v[j].x * v[j].x + v[j].y * v[j].y) + (v[j].z * v[j].z + v[j].w * v[j].w); }
        const float rstd = __builtin_amdgcn_rsqf(wave_sum(s2, F.lane) * (1.f / DM) + LN_EPS);
#pragma unroll
        for (int j = 0; j < 4; ++j) { v[j] = v[j] * rstd * gv[j] + bv[j]; orow[64 * j] = v[j]; }
        if (XB) { GAS v2u* o = (GAS v2u*)(XB + (size_t)m * DM) + F.lane;
#pragma unroll
            for (int j = 0; j < 4; ++j) o[64 * j] = (v2u){pk2(v[j].x, v[j].y), pk2(v[j].z, v[j].w)}; }
    }
}

__device__ __forceinline__ void publish_ready(Frame& F, gu32* ctr) {
    VM_WAIT(); __syncthreads();
    if (F.tid == 0) { __builtin_amdgcn_fence(__ATOMIC_RELEASE, "agent"); asm volatile("s_waitcnt vmcnt(0)" ::: "memory"); __hip_atomic_fetch_add((unsigned*)ctr, 1u, __ATOMIC_RELAXED, __HIP_MEMORY_SCOPE_AGENT); }
}
__device__ __forceinline__ float softplusf_acc(float x) { return fmaxf(x, 0.f) + log1pf(__expf(-fabsf(x))); }
__device__ __forceinline__ float expm1_neg(float x) {
    const float p = x * (1.f + x * (0.5f + x * (1.f / 6.f + x * (1.f / 24.f + x * (1.f / 120.f + x * (1.f / 720.f + x * (1.f / 5040.f)))))));
    return x > -0.25f ? p : __expf(x) - 1.f;
}
constexpr int PATCH_STRIDE = 144;

struct ALane {
    float cwD[4], cbD, ba, bx, ck;
    bf16x8 Ba[4][2], Bx[4][2];
};
constexpr int PATCH_BYTES = 5120, ASLOT_OFF = 8 * PATCH_BYTES;
__device__ __forceinline__ void a_setup(Frame& F, int layer, int n, int q, ALane& L) {
    const int c = F.lane & 15, kg = F.lane >> 4, och = 64 * n + 16 * q + c;
    const float* cw = F.in[I_RGCW] + (size_t)layer * 4 * 512 + 64 * n; const float* cb = F.in[I_RGCB] + layer * 512 + 64 * n;
#pragma unroll
    for (int j = 0; j < 4; ++j) L.cwD[j] = cw[j * 512 + 16 * q + c];
    L.cbD = cb[16 * q + c];
    L.ck = 8.0f * softplusf_acc(-F.in[I_LAM][layer * 512 + och]);
    const float* wa = F.in[I_RGWA] + ((size_t)layer * 8 + n) * 4096 + 16 * q + c; const float* wx = F.in[I_RGWX] + ((size_t)layer * 8 + n) * 4096 + 16 * q + c;
    float wav[16], wxv[16], cbv[16];
#pragma unroll
    for (int e = 0; e < 16; ++e) { const int k = (e < 8 ? 8 * kg + e : 32 + 8 * kg + (e - 8)); wav[e] = wa[k * 64]; wxv[e] = wx[k * 64]; cbv[e] = cb[k]; }
#pragma unroll
    for (int j = 0; j < 4; ++j) { float t[16];
#pragma unroll
        for (int e = 0; e < 16; ++e) t[e] = cw[j * 512 + (e < 8 ? 8 * kg + e : 32 + 8 * kg + (e - 8))];
        L.Ba[j][0] = __builtin_bit_cast(bf16x8, (v4u){pk2(wav[0] * t[0], wav[1] * t[1]), pk2(wav[2] * t[2], wav[3] * t[3]), pk2(wav[4] * t[4], wav[5] * t[5]), pk2(wav[6] * t[6], wav[7] * t[7])});
        L.Ba[j][1] = __builtin_bit_cast(bf16x8, (v4u){pk2(wav[8] * t[8], wav[9] * t[9]), pk2(wav[10] * t[10], wav[11] * t[11]), pk2(wav[12] * t[12], wav[13] * t[13]), pk2(wav[14] * t[14], wav[15] * t[15])});
        L.Bx[j][0] = __builtin_bit_cast(bf16x8, (v4u){pk2(wxv[0] * t[0], wxv[1] * t[1]), pk2(wxv[2] * t[2], wxv[3] * t[3]), pk2(wxv[4] * t[4], wxv[5] * t[5]), pk2(wxv[6] * t[6], wxv[7] * t[7])});
        L.Bx[j][1] = __builtin_bit_cast(bf16x8, (v4u){pk2(wxv[8] * t[8], wxv[9] * t[9]), pk2(wxv[10] * t[10], wxv[11] * t[11]), pk2(wxv[12] * t[12], wxv[13] * t[13]), pk2(wxv[14] * t[14], wxv[15] * t[15])}); }
    float sa = 0.f, sx = 0.f;
#pragma unroll
    for (int e = 0; e < 16; ++e) { sa = fmaf(cbv[e], wav[e], sa); sx = fmaf(cbv[e], wxv[e], sx); }
    sa += shfl_idx(sa, F.lane ^ 16); sa += shfl_idx(sa, F.lane ^ 32); sx += shfl_idx(sx, F.lane ^ 16); sx += shfl_idx(sx, F.lane ^ 32);
    L.ba = F.in[I_RGBA][layer * 512 + och] + sa; L.bx = F.in[I_RGBX][layer * 512 + och] + sx;
}
__device__ __forceinline__ void a_block(const ALane& L, const LAS unsigned char* patch, int rowA0, int baseD, int q, int lane, float (&a)[4], float (&bb)[4]) {
    const int c = lane & 15, kg = lane >> 4;
    f32x4 accR = (f32x4){0.f, 0.f, 0.f, 0.f}, accI = (f32x4){0.f, 0.f, 0.f, 0.f};
#pragma unroll
    for (int j = 0; j < 4; ++j) { const LAS unsigned char* rp = patch + (rowA0 + j) * PATCH_STRIDE + 16 * kg;
        const bf16x8 A0 = *(const LAS bf16x8*)rp, A1 = *(const LAS bf16x8*)(rp + 64);
        accR = __builtin_amdgcn_mfma_f32_16x16x32_bf16(A0, L.Ba[j][0], accR, 0, 0, 0); accR = __builtin_amdgcn_mfma_f32_16x16x32_bf16(A1, L.Ba[j][1], accR, 0, 0, 0);
        accI = __builtin_amdgcn_mfma_f32_16x16x32_bf16(A0, L.Bx[j][0], accI, 0, 0, 0); accI = __builtin_amdgcn_mfma_f32_16x16x32_bf16(A1, L.Bx[j][1], accI, 0, 0, 0); }
    float pv[7];
#pragma unroll
    for (int k = 0; k < 7; ++k) pv[k] = bf1(*(const LAS unsigned short*)(patch + (baseD + k) * PATCH_STRIDE + 2 * (16 * q + c)));
#pragma unroll
    for (int r = 0; r < 4; ++r) {
        const float xd = L.cbD + L.cwD[0] * pv[r] + L.cwD[1] * pv[r + 1] + L.cwD[2] * pv[r + 2] + L.cwD[3] * pv[r + 3];
        const float rr = pg8::sigmoidf_fast(accR[r] + L.ba), ii = pg8::sigmoidf_fast(accI[r] + L.bx);
        const float la = -L.ck * rr;
        const float av = __builtin_amdgcn_exp2f(1.44269504089f * la);
        a[r] = av; bb[r] = __builtin_amdgcn_sqrtf(fmaxf(1.f - av * av, 0.f)) * (ii * xd);
    }
}
struct BlkScan { float Ac[4], Bc[4], EA, EB, WA, WB; };
__device__ __forceinline__ void blk_scan(const float (&a)[4], const float (&bb)[4], int lane, BlkScan& S) {
    const int c = lane & 15, g = lane >> 4;
    S.Ac[0] = a[0]; S.Bc[0] = bb[0];
#pragma unroll
    for (int r = 1; r < 4; ++r) { S.Ac[r] = a[r] * S.Ac[r - 1]; S.Bc[r] = a[r] * S.Bc[r - 1] + bb[r]; }
    float IA = S.Ac[3], IB = S.Bc[3];
    { const float pa = shfl_idx(IA, lane - 16), pb = shfl_idx(IB, lane - 16); if (g >= 1) { IB = IA * pb + IB; IA = IA * pa; } }
    { const float pa = shfl_idx(IA, lane - 32), pb = shfl_idx(IB, lane - 32); if (g >= 2) { IB = IA * pb + IB; IA = IA * pa; } }
    S.EA = shfl_idx(IA, lane - 16); S.EB = shfl_idx(IB, lane - 16); if (g == 0) { S.EA = 1.f; S.EB = 0.f; }
    S.WA = shfl_idx(IA, 48 + c); S.WB = shfl_idx(IB, 48 + c);
}
__device__ __forceinline__ void a_prompt_item(Frame& F, int layer, int item, const bf16* Z, bf16* Y) {
    const int b = item >> 5, n = (item >> 2) & 7, q = item & 3, lane = opqv(F.lane), w = F.wave, c = lane & 15, g = lane >> 4, och = 64 * n + 16 * q + c;
    ALane L; a_setup(F, layer, n, q, L);
    LAS unsigned char* patch = F.lds + RING_OFF + w * PATCH_BYTES;
    LAS f32x2* slots = (LAS f32x2*)(F.lds + RING_OFF + ASLOT_OFF);
    const bf16* Zb = Z + (size_t)b * SEQ * ZC; bf16* Yb = Y + (size_t)b * SEQ * YC;
    float hrun = 0.f;
    v4u pf[5];
    auto load_patch = [&](int tb) {
#pragma unroll
        for (int k = 0; k < 5; ++k) { const int ci = lane + 64 * k, pr = ci >> 3, cc = ci & 7, t = tb - 3 + pr;
            pf[k] = (ci < 280 && t >= 0) ? *(const GAS v4u*)(Zb + (size_t)t * ZC + 64 * n + 8 * cc) : (v4u){0u, 0u, 0u, 0u}; }
    };
    load_patch(32 * w);
    for (int it = 0; it < 8; ++it) {
        const int tb = 256 * it + 32 * w;
#pragma unroll
        for (int k = 0; k < 5; ++k) { const int ci = lane + 64 * k, pr = ci >> 3, cc = ci & 7; if (ci < 280) *(LAS v4u*)(patch + pr * PATCH_STRIDE + 16 * cc) = pf[k]; }
        if (it < 7) load_patch(tb + 256);
        unsigned short gav[8];
#pragma unroll
        for (int r = 0; r < 8; ++r) gav[r] = ((const GAS unsigned short*)Zb)[(unsigned)((tb + 16 * (r >> 2) + 4 * g + (r & 3)) * ZC + 512 + och)];
        asm volatile("" ::: "memory");
        float a0[4], b0[4], a1[4], b1[4];
        a_block(L, patch, lane & 15, 4 * g, q, lane, a0, b0);
        a_block(L, patch, 16 + (lane & 15), 16 + 4 * g, q, lane, a1, b1);
        BlkScan S0, S1; blk_scan(a0, b0, lane, S0); blk_scan(a1, b1, lane, S1);
        if (lane < 16) slots[((it & 1) * 8 + w) * 16 + c] = (f32x2){S0.WA * S1.WA, S1.WA * S0.WB + S1.WB};
        __syncthreads();
        float hin = hrun, hw = 0.f;
#pragma unroll
        for (int ww = 0; ww < 8; ++ww) { const f32x2 s = slots[((it & 1) * 8 + ww) * 16 + c]; if (ww == w) hw = hin; hin = s.x * hin + s.y; }
        hrun = hin;
        const float hg0 = S0.EA * hw + S0.EB, hw1 = S0.WA * hw + S0.WB, hg1 = S1.EA * hw1 + S1.EB;
#pragma unroll
        for (int r = 0; r < 4; ++r) { const float h = S0.Ac[r] * hg0 + S0.Bc[r];
            ((GAS unsigned short*)Yb)[(unsigned)((tb + 4 * g + r) * YC + och)] = f2bf(h * bf1(gav[r])); }
#pragma unroll
        for (int r = 0; r < 4; ++r) { const float h = S1.Ac[r] * hg1 + S1.Bc[r];
            ((GAS unsigned short*)Yb)[(unsigned)((tb + 16 + 4 * g + r) * YC + och)] = f2bf(h * bf1(gav[4 + r]));
            if (r == 3 && it == 7 && w == 7 && g == 3) F.out[O_PH + (size_t)(layer * 8 + b) * 512 + och] = h; }
    }
}
__device__ __forceinline__ void a_sample_task(Frame& F, int layer, int task, const bf16* Z, bf16* Y) {
    const int blk = task >> 5, n = (task >> 2) & 7, q = task & 3, lane = opqv(F.lane), c = lane & 15, g = lane >> 4, och = 64 * n + 16 * q + c, s0 = 4 * blk;
    ALane L; a_setup(F, layer, n, q, L);
    LAS unsigned char* patch = F.lds + RING_OFF + F.wave * PATCH_BYTES;
#pragma unroll
    for (int k = 0; k < 4; ++k) { const int ci = lane + 64 * k; if (ci < 224) { const int pr = ci >> 3, cc = ci & 7, sq = pr / 7, tau = pr - 7 * sq - 3, seq = s0 + sq; v4u v;
            if (tau < 0) { const GAS f32x4* sp = (const GAS f32x4*)(F.in[I_SRGC] + ((size_t)(layer * 128 + seq) * 3 + (tau + 3)) * 512 + 64 * n + 8 * cc); const f32x4 f0 = sp[0], f1 = sp[1];
                v = (v4u){pk2(f0.x, f0.y), pk2(f0.z, f0.w), pk2(f1.x, f1.y), pk2(f1.z, f1.w)}; }
            else v = *(const GAS v4u*)(Z + (size_t)(MP + 4 * seq + tau) * ZC + 64 * n + 8 * cc);
            *(LAS v4u*)(patch + pr * PATCH_STRIDE + 16 * cc) = v; } }
    asm volatile("" ::: "memory");
    float a[4], bb[4];
    a_block(L, patch, 7 * ((lane & 15) >> 2) + (lane & 3), 7 * g, q, lane, a, bb);
    const int seq = s0 + g;
    float h = F.in[I_SH][(size_t)(layer * 128 + seq) * 512 + och];
#pragma unroll
    for (int r = 0; r < 4; ++r) { h = a[r] * h + bb[r]; const size_t row = (size_t)(MP + 4 * seq + r);
        *(GAS unsigned short*)(Y + row * YC + och) = f2bf(h * bf1(*(const GAS unsigned short*)(Z + row * ZC + 512 + och))); }
    F.out[O_SH + (size_t)(layer * 128 + seq) * 512 + och] = h;
}

__device__ __forceinline__ void ln_silu_row(const LAS float* xr, const float* g, const float* b, bf16* dst, int lane) {
    const f32x4 v0 = *(const LAS f32x4*)(xr + 4 * lane), v1 = *(const LAS f32x4*)(xr + 256 + 4 * lane);
    const float s = (v0.x + v0.y) + (v0.z + v0.w) + (v1.x + v1.y) + (v1.z + v1.w);
    const float mean = wave_sum(s, lane) * (1.f / 512.f);
    const f32x4 d0 = v0 - mean, d1 = v1 - mean;
    const float s2 = (d0.x * d0.x + d0.y * d0.y) + (d0.z * d0.z + d0.w * d0.w) + (d1.x * d1.x + d1.y * d1.y) + (d1.z * d1.z + d1.w * d1.w);
    const float rstd = __builtin_amdgcn_rsqf(wave_sum(s2, lane) * (1.f / 512.f) + LN_EPS);
    const f32x4 g0 = *(const GAS f32x4*)(g + 4 * lane), g1 = *(const GAS f32x4*)(g + 256 + 4 * lane), b0 = *(const GAS f32x4*)(b + 4 * lane), b1 = *(const GAS f32x4*)(b + 256 + 4 * lane);
    f32x4 y0 = d0 * rstd * g0 + b0, y1 = d1 * rstd * g1 + b1;
#pragma unroll
    for (int i = 0; i < 4; ++i) { y0[i] = y0[i] * pg8::sigmoidf_fast(y0[i]); y1[i] = y1[i] * pg8::sigmoidf_fast(y1[i]); }
    *(GAS v2u*)(dst + 4 * lane) = (v2u){pk2(y0.x, y0.y), pk2(y0.z, y0.w)}; *(GAS v2u*)(dst + 256 + 4 * lane) = (v2u){pk2(y1.x, y1.y), pk2(y1.z, y1.w)};
}
__device__ __forceinline__ void ln_silu_rows4(const LAS float* xr, int rstride, const float* g, const float* b, bf16* dst, size_t dstride, int lane) {
    f32x4 v0[4], v1[4]; float s[4], s2[4];
#pragma unroll
    for (int k = 0; k < 4; ++k) { v0[k] = *(const LAS f32x4*)(xr + k * rstride + 4 * lane); v1[k] = *(const LAS f32x4*)(xr + k * rstride + 256 + 4 * lane);
        s[k] = (v0[k].x + v0[k].y) + (v0[k].z + v0[k].w) + (v1[k].x + v1[k].y) + (v1[k].z + v1[k].w); }
#pragma unroll
    for (int o = 1; o < 64; o <<= 1) {
#pragma unroll
        for (int k = 0; k < 4; ++k) s[k] += shfl_idx(s[k], lane ^ o); }
#pragma unroll
    for (int k = 0; k < 4; ++k) { const float mean = s[k] * (1.f / 512.f); v0[k] = v0[k] - mean; v1[k] = v1[k] - mean;
        s2[k] = (v0[k].x * v0[k].x + v0[k].y * v0[k].y) + (v0[k].z * v0[k].z + v0[k].w * v0[k].w) + (v1[k].x * v1[k].x + v1[k].y * v1[k].y) + (v1[k].z * v1[k].z + v1[k].w * v1[k].w); }
#pragma unroll
    for (int o = 1; o < 64; o <<= 1) {
#pragma unroll
        for (int k = 0; k < 4; ++k) s2[k] += shfl_idx(s2[k], lane ^ o); }
    const f32x4 g0 = *(const GAS f32x4*)(g + 4 * lane), g1 = *(const GAS f32x4*)(g + 256 + 4 * lane), b0 = *(const GAS f32x4*)(b + 4 * lane), b1 = *(const GAS f32x4*)(b + 256 + 4 * lane);
#pragma unroll
    for (int k = 0; k < 4; ++k) { const float rstd = __builtin_amdgcn_rsqf(s2[k] * (1.f / 512.f) + LN_EPS);
        f32x4 y0 = v0[k] * rstd * g0 + b0, y1 = v1[k] * rstd * g1 + b1;
#pragma unroll
        for (int i = 0; i < 4; ++i) { y0[i] = y0[i] * pg8::sigmoidf_fast(y0[i]); y1[i] = y1[i] * pg8::sigmoidf_fast(y1[i]); }
        bf16* d = dst + (size_t)k * dstride;
        *(GAS v2u*)(d + 4 * lane) = (v2u){pk2(y0.x, y0.y), pk2(y0.z, y0.w)}; *(GAS v2u*)(d + 256 + 4 * lane) = (v2u){pk2(y1.x, y1.y), pk2(y1.z, y1.w)}; }
}
__device__ __forceinline__ void b_prompt_item(Frame& F, int layer, int item, const bf16* Z, bf16* Y) {
    const int tidl = opqv(F.tid), b = item >> 5, t0 = 64 * (item & 31), p = tidl & 255, hh = tidl >> 8, ts = t0 + 32 * hh;
    const GAS unsigned* Zu = (const GAS unsigned*)(Z + (size_t)b * SEQ * ZC) + 512 + p;
    unsigned raw[62];
#pragma unroll
    for (int i = 0; i < 62; ++i) { const int t = ts - 30 + i; raw[i] = t >= 0 ? Zu[(size_t)t * (ZC / 2)] : 0u; }
    const float* cw = F.in[I_CFW] + (size_t)layer * 31 * 512 + 2 * p;
    f32x2 wj[31];
#pragma unroll
    for (int j = 0; j < 31; ++j) wj[j] = *(const GAS f32x2*)(cw + j * 512);
    const f32x2 bias = *(const GAS f32x2*)(F.in[I_CFB] + layer * 512 + 2 * p);
    f32x2 in[62];
#pragma unroll
    for (int i = 0; i < 62; ++i) in[i] = (f32x2){bflo(raw[i]), bfhi(raw[i])};
    LAS float* obuf = (LAS float*)(F.lds + RING_OFF);
#pragma unroll
    for (int i = 0; i < 32; ++i) { f32x2 o = bias;
#pragma unroll
        for (int j = 0; j < 31; ++j) o += wj[j] * in[i + j];
        *(LAS f32x2*)(obuf + (32 * hh + i) * 512 + 2 * p) = o; }
    __syncthreads();
    const float* lg = F.in[I_CFG] + layer * 512; const float* lb = F.in[I_CFBB] + layer * 512;
#pragma unroll 1
    for (int r = 8 * F.wave; r < 8 * F.wave + 8; r += 4) ln_silu_rows4(obuf + r * 512, 512, lg, lb, Y + (size_t)(b * SEQ + t0 + r) * YC + 512, YC, F.lane);
}
__device__ __forceinline__ void cd_prompt_item(Frame& F, int layer, int item, const bf16* Z, bf16* Y) {
    const int tidl = opqv(F.tid), b = item >> 5, t0 = 64 * (item & 31), p = tidl & 255, hh = tidl >> 8;
    const bf16* Zb = Z + (size_t)b * SEQ * ZC;
    LAS unsigned* cbuf = (LAS unsigned*)(F.lds + RING_OFF);
    { v4u tmp[10];
#pragma unroll
      for (int k = 0; k < 10; ++k) { const int ci = tidl + 512 * k, pr = ci >> 6, cc = ci & 63, t = t0 - 15 + pr;
          tmp[k] = (ci < 79 * 64 && t >= 0) ? *(const GAS v4u*)(Zb + (size_t)t * ZC + 1536 + 8 * cc) : (v4u){0u, 0u, 0u, 0u}; }
#pragma unroll
      for (int k = 0; k < 10; ++k) { const int ci = tidl + 512 * k, pr = ci >> 6, cc = ci & 63; if (ci < 79 * 64) *(LAS v4u*)(cbuf + pr * 256 + 4 * cc) = tmp[k]; } }
    const int ts = t0 + 32 * hh;
    unsigned uu[34], dd[32];
#pragma unroll
    for (int i = 0; i < 34; ++i) { const int t = ts - 2 + i; uu[i] = t >= 0 ? ((const GAS unsigned*)(Zb + (size_t)t * ZC))[1280 + p] : 0u; }
#pragma unroll
    for (int i = 0; i < 32; ++i) dd[i] = ((const GAS unsigned*)(Zb + (size_t)(ts + i) * ZC))[1024 + p];
    const f32x2 w0 = ((const GAS f32x2*)(F.in[I_SCW] + (size_t)(layer * 3 + 0) * 512))[p], w1 = ((const GAS f32x2*)(F.in[I_SCW] + (size_t)(layer * 3 + 1) * 512))[p],
                w2 = ((const GAS f32x2*)(F.in[I_SCW] + (size_t)(layer * 3 + 2) * 512))[p];
    __syncthreads();
    const int w = 2 << (p >> 6), rr0 = 15 + 32 * hh;
    f32x2 s = (f32x2){0.f, 0.f};
    for (int j = 0; j < w; ++j) { const unsigned v = cbuf[(rr0 - j) * 256 + p]; s += (f32x2){bflo(v), bfhi(v)}; }
    GAS unsigned* Yu = (GAS unsigned*)(Y + (size_t)(b * SEQ + ts) * YC) + p;
#pragma unroll
    for (int i = 0; i < 32; ++i) { const int t = ts + i, rr = rr0 + i;
        const unsigned cur = cbuf[rr * 256 + p]; const f32x2 cf = (f32x2){bflo(cur), bfhi(cur)};
        if (i > 0) { const unsigned old = cbuf[(rr - w) * 256 + p]; s += cf - (f32x2){bflo(old), bfhi(old)}; }
        const float ic = __builtin_amdgcn_rcpf((float)(t + 1 < w ? t + 1 : w));
        const f32x2 mm = s * ic - cf;
        Yu[(size_t)i * 1024 + 512] = pk2(mm.x, mm.y);
        const f32x2 cv = w0 * (f32x2){bflo(uu[i]), bfhi(uu[i])} + w1 * (f32x2){bflo(uu[i + 1]), bfhi(uu[i + 1])} + w2 * (f32x2){bflo(uu[i + 2]), bfhi(uu[i + 2])};
        const f32x2 yd = (f32x2){bflo(dd[i]), bfhi(dd[i])} * cv;
        Yu[(size_t)i * 1024 + 768] = pk2(yd.x, yd.y); }
}
__device__ __forceinline__ void s_sample_item(Frame& F, int layer, int s, const bf16* Z, bf16* Y) {
    const int ch = opqv(F.tid); const size_t ls = (size_t)layer * 128 + s;
    const bf16* Zr = Z + (size_t)(MP + 4 * s) * ZC; bf16* Yr = Y + (size_t)(MP + 4 * s) * YC;
    LAS float* obuf = (LAS float*)(F.lds + RING_OFF);
    float in[34], wv[31], pb[19], u[6], dbv[4];
#pragma unroll
    for (int j = 0; j < 30; ++j) in[j] = (F.in[I_SCF] + (ls * 30 + j) * 512)[ch];
#pragma unroll
    for (int j = 0; j < 15; ++j) pb[j] = (F.in[I_SPOOL] + (ls * 15 + j) * 512)[ch];
    u[0] = (F.in[I_SSC] + (ls * 2 + 0) * 512)[ch]; u[1] = (F.in[I_SSC] + (ls * 2 + 1) * 512)[ch];
#pragma unroll
    for (int r = 0; r < 4; ++r) { in[30 + r] = bf1((Zr + (size_t)r * ZC + 1024)[ch]); pb[15 + r] = bf1((Zr + (size_t)r * ZC + 1536)[ch]); u[2 + r] = bf1((Zr + (size_t)r * ZC + 2560)[ch]); dbv[r] = bf1((Zr + (size_t)r * ZC + 2048)[ch]); }
#pragma unroll
    for (int j = 0; j < 31; ++j) wv[j] = (F.in[I_CFW] + ((size_t)layer * 31 + j) * 512)[ch];
    const float bias = (F.in[I_CFB] + layer * 512)[ch];
    const float w0 = (F.in[I_SCW] + (size_t)(layer * 3 + 0) * 512)[ch], w1 = (F.in[I_SCW] + (size_t)(layer * 3 + 1) * 512)[ch], w2 = (F.in[I_SCW] + (size_t)(layer * 3 + 2) * 512)[ch];
    asm volatile("" ::: "memory");
#pragma unroll
    for (int j = 0; j < 26; ++j) (F.out + O_SCF + (ls * 30 + j) * 512)[ch] = in[j + 4];
#pragma unroll
    for (int r = 0; r < 4; ++r) { float o = bias;
#pragma unroll
        for (int j = 0; j < 31; ++j) o += wv[j] * in[r + j];
        obuf[r * 512 + ch] = o; }
#pragma unroll
    for (int j = 0; j < 11; ++j) (F.out + O_SPOOL + (ls * 15 + j) * 512)[ch] = pb[j + 4];
    const int gsel = ch >> 7;
#pragma unroll
    for (int r = 0; r < 4; ++r) { const int k = 15 + r;
        const float s2 = pb[k] + pb[k - 1], s4 = s2 + pb[k - 2] + pb[k - 3], s8 = s4 + (pb[k - 4] + pb[k - 5]) + (pb[k - 6] + pb[k - 7]);
        float s16 = s8;
#pragma unroll
        for (int j = 8; j < 16; ++j) s16 += pb[k - j];
        const float mv = (gsel == 0 ? s2 * 0.5f : gsel == 1 ? s4 * 0.25f : gsel == 2 ? s8 * 0.125f : s16 * 0.0625f) - pb[k];
        (Yr + (size_t)r * YC + 1024)[ch] = f2bf(mv); }
#pragma unroll
    for (int r = 0; r < 4; ++r) (Yr + (size_t)r * YC + 1536)[ch] = f2bf(dbv[r] * (w0 * u[r] + w1 * u[r + 1] + w2 * u[r + 2]));
    __syncthreads();
    if (F.wave < 4) ln_silu_row(obuf + F.wave * 512, F.in[I_CFG] + layer * 512, F.in[I_CFBB] + layer * 512, Yr + (size_t)F.wave * YC + 512, F.lane);
}

struct Args { const float* in[31]; float* out; unsigned char* ws; int ph_lo, ph_hi; };
__global__ void __launch_bounds__(NWAVES * 64, 2) hybrid_fwd(Args args) {
    extern __shared__ __attribute__((aligned(16))) unsigned char lds[];
    Frame F;
    F.lds = (LAS unsigned char*)lds;
    F.MISC = (volatile LAS unsigned*)(F.lds + MISC_OFF);
    const int wave0 = __builtin_amdgcn_readfirstlane((int)threadIdx.x >> 6);
    F.lane = lane_now(); F.wave = wave0; F.tid = F.wave * 64 + F.lane;
    F.G = gridDim.x; F.bid = blockIdx.x;
    F.ws = args.ws; F.out = args.out; F.ctl = (gu32*)(args.ws + WS_CTL);
    F.in = args.in;
    for (int u = F.tid; u < (LDS_BYTES - LDSCTL_OFF) / 4; u += NWAVES * 64) ((LAS unsigned*)(F.lds + LDSCTL_OFF))[u] = 0u;
    __syncthreads();
    XcdBarrier bar; bar.bar = (unsigned*)(F.ctl + CW_BAR); bar.x = 0; bar.st = nullptr;
    if (!MK_SPLIT) bar = xcd_barrier_post((unsigned*)(F.ctl + CW_BAR), F.MISC + 8);
    const int lo = args.ph_lo, hi = args.ph_hi;
#define IN(k) (lo <= (k) && (k) < hi)
#define REFRESH() do { F.lane = lane_now(); F.wave = opqs(wave0); F.tid = F.wave * 64 + F.lane; F.bid = opqs((int)blockIdx.x); } while (0)
#define SEAM(k) do { if (IN(k) && IN((k) + 1)) xcd_barrier(bar); } while (0)
    bf16* WA = (bf16*)(F.ws + WS_WA); bf16* XB = (bf16*)(F.ws + WS_XB); bf16* Y = (bf16*)(F.ws + WS_Y); bf16* Zm = (bf16*)(F.ws + WS_ZG); _Float16* Gb = (_Float16*)(F.ws + WS_ZG);
    bf16* Hb = (bf16*)(F.ws + WS_ZG); bf16* Bt3 = (bf16*)(F.ws + WS_BT3); bf16* Bt4 = (bf16*)(F.ws + WS_BT4); bf16* Bt5 = (bf16*)(F.ws + WS_BT5); bf16* Bt6 = (bf16*)(F.ws + WS_BT6);

    if (IN(0)) { REFRESH(); convert_matrix<RM_WIN>(F, F.in[I_WIN], DM, INC, WA, DM, 0, 0, F.bid * NWAVES + F.wave, F.G * NWAVES, 0, 0, F.G == 256 ? 128 : 0); REFRESH(); x_to_bf16(F, XB); }
    SEAM(0);

    const bool fast = F.G == 256;
    for (int l = 0; l < 2; ++l) {
        const int pb = 1 + 9 * l;
        if (IN(pb + 0)) for (int rep = 0; rep < NREP(0); ++rep) { if (rep) xcd_barrier(bar);
            if (fast && l == 1 && rep == 0) { REFRESH();
                ln_rows(F, F.out, F.out, F.in[I_LN2G], F.in[I_LN2B], XB, F.out + (size_t)MP * DM, (const float*)(F.ws + WS_SLAB), 11); publish_ready(F, F.ctl + CW_RDY + 64 * 1); }
            pg8::Gemm g{XB, WA, DM, DM}; pg8::UnitOrder S; S.init(pg8::SK_PLAIN, 4096, DM, F.G, F.bid, 0); pg8::EpiMix E{Zm, F.out, l};
            if (fast && l == 1) { S.ready = (const unsigned*)(F.ctl + CW_RDY + 64 * 1); S.need = (unsigned)F.G; }
            pg8::gemm_phase<pg8::EpiMix, pg8::UnitOrder, true>(F.lds + RING_OFF, g, S, E, wave0);
            if (F.G == 256 && F.bid >= 32) {
                REFRESH(); const int gw = (F.bid - 32) * NWAVES + F.wave, NGW = 224 * NWAVES; const float* wbr = F.in[I_WBR] + (size_t)l * 4 * 512 * 1024;
                convert_matrix<RM_ID>(F, wbr, 512, 1024, Bt3, 2048, 0, 0, gw, NGW, 0);
                convert_matrix<RM_ID>(F, wbr + (size_t)512 * 1024, 512, 1024, Bt3, 2048, 512, 0, gw, NGW, 256);
                convert_matrix<RM_ID>(F, wbr + (size_t)3 * 512 * 1024, 512, 1024, Bt3, 2048, 1536, 0, gw, NGW, 512);
                convert_matrix<RM_ID>(F, F.in[I_WOUT] + (size_t)l * DM * DM, DM, DM, Bt4, DM, 0, 0, gw, NGW, 768);
                REFRESH(); compose_pool(F, l, Bt3, gw, NGW, 1280);
                REFRESH(); convert_matrix<RM_WIN>(F, F.in[I_WIN] + (size_t)l * DM * INC, DM, INC, WA, DM, 0, 0, gw, NGW, 0, 128, 128); } }
        SEAM(pb + 0);
        if (IN(pb + 1)) for (int rep = 0; rep < NREP(1); ++rep) { if (rep) xcd_barrier(bar);
            __syncthreads(); REFRESH();
            for (int r2 = 0; r2 < NREP2(0); ++r2) for (int it = F.bid; it < 256; it += F.G) { a_prompt_item(F, l, it, Zm, Y); __syncthreads(); }
            REFRESH();
            for (int r2 = 0; r2 < NREP2(1); ++r2) for (int it = (F.bid + 128) % F.G; it < 128; it += F.G) a_sample_task(F, l, 8 * it + F.wave, Zm, Y);
            __syncthreads(); REFRESH();
            const bool rebal = F.G == 256, gemm_wg = rebal && F.bid >= 128 && F.bid < 160;
            for (int r2 = 0; r2 < NREP2(2); ++r2) { if (!gemm_wg) for (int it = F.bid; it < 256; it += F.G) { b_prompt_item(F, l, it, Zm, Y); __syncthreads(); }
                if (rebal && F.bid >= 160 && F.bid < 192) { b_prompt_item(F, l, F.bid - 32, Zm, Y); __syncthreads(); } }
            REFRESH();
            for (int r2 = 0; r2 < NREP2(3); ++r2) { if (!gemm_wg) for (int it = F.bid; it < 256; it += F.G) { cd_prompt_item(F, l, it, Zm, Y); __syncthreads(); }
                if (rebal && F.bid >= 192 && F.bid < 224) { cd_prompt_item(F, l, F.bid - 64, Zm, Y); __syncthreads(); } }
            REFRESH();
            for (int r2 = 0; r2 < NREP2(4); ++r2) for (int it = F.bid; it < 128; it += F.G) { s_sample_item(F, l, it, Zm, Y); __syncthreads(); }
            if (F.G == 256 && F.bid >= 128 && F.bid < 160) {
                pg8::Gemm g{XB, WA + (size_t)4096 * DM, DM, DM}; pg8::UnitOrder S; S.init(pg8::SK_PLAIN, 4096, DM, 32, F.bid - 128, 0, false, true); pg8::EpiGate E{Gb};
                pg8::gemm_phase<pg8::EpiGate, pg8::UnitOrder, true>(F.lds + RING_OFF, g, S, E, wave0); }
            REFRESH();
            const float* wbr = F.in[I_WBR] + (size_t)l * 4 * 512 * 1024;
            if (F.G != 256) { const int gw = F.bid * NWAVES + F.wave, NGW = F.G * NWAVES;
                convert_matrix<RM_ID>(F, wbr, 512, 1024, Bt3, 2048, 0, 0, gw, NGW); convert_matrix<RM_ID>(F, wbr + (size_t)512 * 1024, 512, 1024, Bt3, 2048, 512, 0, gw, NGW);
                convert_matrix<RM_ID>(F, wbr + (size_t)3 * 512 * 1024, 512, 1024, Bt3, 2048, 1536, 0, gw, NGW); convert_matrix<RM_ID>(F, F.in[I_WOUT] + (size_t)l * DM * DM, DM, DM, Bt4, DM, 0, 0, gw, NGW);
                REFRESH(); compose_pool(F, l, Bt3, gw, NGW); }
        }
        SEAM(pb + 1);
        if (IN(pb + 2)) for (int rep = 0; rep < NREP(2); ++rep) { if (rep) xcd_barrier(bar); pg8::Gemm g{XB, WA + (size_t)4096 * DM, DM, DM}; pg8::UnitOrder S; S.init(pg8::SK_PLAIN, 4096, DM, F.G, F.bid, 0, true, F.G != 256); pg8::EpiGate E{Gb};
            pg8::gemm_phase<pg8::EpiGate, pg8::UnitOrder, true>(F.lds + RING_OFF, g, S, E, wave0); }
        SEAM(pb + 2);
        if (IN(pb + 3)) for (int rep = 0; rep < NREP(3); ++rep) { if (rep) xcd_barrier(bar); pg8::Gemm g{Y, Bt3, 2048, 2048}; pg8::UnitOrder S; S.init(pg8::SK_P3, DM, 2048, F.G, F.bid, 0); pg8::EpiMerge E{Gb, XB, (bf16*)(F.ws + WS_MB4S)};
            pg8::gemm_phase<pg8::EpiMerge, pg8::UnitOrder, true>(F.lds + RING_OFF, g, S, E, wave0);
            if (F.G == 256 && F.bid >= 32 && rep + 1 == NREP(3)) {
                REFRESH(); const int gw = (F.bid - 32) * NWAVES + F.wave, NGW = 224 * NWAVES;
                convert_matrix<RM_GU>(F, F.in[I_WG] + (size_t)l * DM * FF, DM, FF, Bt5, DM, 0, 0, gw, NGW, 0);
                convert_matrix<RM_GU>(F, F.in[I_WU] + (size_t)l * DM * FF, DM, FF, Bt5, DM, 0, 128, gw, NGW, 1408); } }
        SEAM(pb + 3);
        if (IN(pb + 4)) for (int rep = 0; rep < 1; ++rep) { pg8::Gemm g{XB, Bt4, DM, DM}; pg8::UnitOrder S; S.init(pg8::SK_P4, DM, DM, F.G, F.bid, (long)(WS_MB4S - WS_XB));
            pg8::EpiRes E{l == 0 ? F.in[I_XP] : F.out, F.out, XB, F.in[I_LN1G] + l * DM, F.in[I_LN1B] + l * DM, (float*)(F.ws + WS_SLAB),
                          pg8::PanelStats{(unsigned*)(F.ws + WS_XCH + (size_t)(2 * l) * 512 * 1024), (unsigned*)(F.ctl + CW_SEAM + (2 * l) * SEAM_BANK)}, F.lds + XLDS_OFF, wave0};
            pg8::gemm_phase<pg8::EpiRes, pg8::UnitOrder, true>(F.lds + RING_OFF, g, S, E, wave0);
}
        SEAM(pb + 4);
        if (IN(pb + 5) && !fast) for (int rep = 0; rep < NREP(5); ++rep) { if (rep) xcd_barrier(bar);
            REFRESH();
            ln_rows(F, F.out, rep + 1 < NREP(5) ? (float*)(F.ws + WS_Y) : F.out, F.in[I_LN1G] + l * DM, F.in[I_LN1B] + l * DM, rep + 1 < NREP(5) ? nullptr : XB, l == 0 ? F.in[I_XS] : F.out + (size_t)MP * DM, (const float*)(F.ws + WS_SLAB), 16);
            REFRESH();
            if (F.G != 256) { const int gw = F.bid * NWAVES + F.wave, NGW = F.G * NWAVES;
                convert_matrix<RM_GU>(F, F.in[I_WG] + (size_t)l * DM * FF, DM, FF, Bt5, DM, 0, 0, gw, NGW); convert_matrix<RM_GU>(F, F.in[I_WU] + (size_t)l * DM * FF, DM, FF, Bt5, DM, 0, 128, gw, NGW);
                convert_matrix<RM_ID>(F, F.in[I_WD] + (size_t)l * FF * DM, FF, DM, Bt6, FF, 0, 0, gw, NGW); }
        }
        if (!fast) SEAM(pb + 5);
        if (IN(pb + 6)) for (int rep = 0; rep < NREP(6); ++rep) { if (rep) xcd_barrier(bar);
            if (fast && rep == 0) { REFRESH();
                ln_rows(F, F.out, F.out, F.in[I_LN1G] + l * DM, F.in[I_LN1B] + l * DM, XB, l == 0 ? F.in[I_XS] : F.out + (size_t)MP * DM, (const float*)(F.ws + WS_SLAB), 16); publish_ready(F, F.ctl + CW_RDY + 64 * (2 * l)); }
            pg8::Gemm g{XB, Bt5, DM, DM}; pg8::UnitOrder S; S.init(pg8::SK_PLAIN, 2 * FF, DM, F.G, F.bid, 0); pg8::EpiSwi E{Hb};
            if (fast) { S.ready = (const unsigned*)(F.ctl + CW_RDY + 64 * (2 * l)); S.need = (unsigned)F.G; }
            pg8::gemm_phase<pg8::EpiSwi, pg8::UnitOrder, true>(F.lds + RING_OFF, g, S, E, wave0);
            if (F.G == 256 && F.bid >= 172 && rep + 1 == NREP(6)) {
                REFRESH(); const int gw = (F.bid - 172) * NWAVES + F.wave, NGW = 84 * NWAVES;
                convert_matrix<RM_ID>(F, F.in[I_WD] + (size_t)l * FF * DM, FF, DM, Bt6, FF, 0, 0, gw, NGW, 0);
            } }
        SEAM(pb + 6);
        if (IN(pb + 7)) for (int rep = 0; rep < 1; ++rep) { pg8::Gemm g{Hb, Bt6, FF, FF}; pg8::UnitOrder S; S.init(pg8::SK_P6, DM, FF, F.G, F.bid, 0); pg8::EpiRes E{F.out, F.out, l == 0 ? XB : nullptr, F.in[I_LN2G] + l * DM, F.in[I_LN2B] + l * DM, (float*)(F.ws + WS_SLAB),
                          pg8::PanelStats{(unsigned*)(F.ws + WS_XCH + (size_t)(2 * l + 1) * 512 * 1024), (unsigned*)(F.ctl + CW_SEAM + (2 * l + 1) * SEAM_BANK)}, F.lds + XLDS_OFF, wave0};
            pg8::gemm_phase<pg8::EpiRes, pg8::UnitOrder, true>(F.lds + RING_OFF, g, S, E, wave0);
            if (F.G == 256 && F.bid >= 88 && l == 0) {
                REFRESH(); convert_matrix<RM_WIN>(F, F.in[I_WIN] + (size_t)DM * INC, DM, INC, WA, DM, 0, 0, (F.bid - 88) * NWAVES + F.wave, 168 * NWAVES, 0, 0, 128); } }
        SEAM(pb + 7);
        if (IN(pb + 8) && !(fast && l == 0)) for (int rep = 0; rep < NREP(8); ++rep) { if (rep) xcd_barrier(bar);
            REFRESH();
            ln_rows(F, F.out, rep + 1 < NREP(8) ? (float*)(F.ws + WS_Y) : F.out, F.in[I_LN2G] + l * DM, F.in[I_LN2B] + l * DM, (l == 0 && rep + 1 == NREP(8)) ? XB : nullptr, F.out + (size_t)MP * DM, (const float*)(F.ws + WS_SLAB), 11);
            REFRESH();
            if (l == 0 && F.G != 256) convert_matrix<RM_WIN>(F, F.in[I_WIN] + (size_t)DM * INC, DM, INC, WA, DM, 0, 0, F.bid * NWAVES + F.wave, F.G * NWAVES);
        }
        if (l == 0 && !fast) SEAM(pb + 8);
    }
#undef IN
#undef SEAM
#undef REFRESH
}

extern "C" void kernel_launch(void* const* d_in, const int* in_sizes, int n_in, void* d_out, int out_size, void* d_ws, size_t ws_size, hipStream_t stream) {
    static int grid = 0;
    if (grid == 0) {
        if (n_in != 31 || out_size != (int)O_END || ws_size < WS_END) { fprintf(stderr, "kernel_launch: unexpected sizes n_in %d out %d ws %zu\n", n_in, out_size, ws_size); grid = -1; return; }
        int dev = 0, cus = 0, per_cu = 0;
        if (hipGetDevice(&dev) != hipSuccess || hipDeviceGetAttribute(&cus, hipDeviceAttributeMultiprocessorCount, dev) != hipSuccess) { grid = -1; return; }
        if (hipFuncSetAttribute((const void*)hybrid_fwd, hipFuncAttributeMaxDynamicSharedMemorySize, LDS_BYTES) != hipSuccess) { fprintf(stderr, "kernel_launch: hipFuncSetAttribute failed\n"); grid = -1; return; }
        if (hipOccupancyMaxActiveBlocksPerMultiprocessor(&per_cu, (const void*)hybrid_fwd, NWAVES * 64, LDS_BYTES) != hipSuccess || per_cu < 1)
            fprintf(stderr, "kernel_launch: occupancy query reports %d workgroups per CU\n", per_cu);
        (void)hipGetLastError();
        grid = cus;
    }
    if (grid < 0) return;
    if (hipMemsetAsync((char*)d_ws + WS_CTL, 0, CTL_ZERO_BYTES, stream) != hipSuccess) { fprintf(stderr, "kernel_launch: memset failed\n"); return; }
    Args a{};
    for (int i = 0; i < 31; ++i) a.in[i] = (const float*)d_in[i];
    a.out = (float*)d_out; a.ws = (unsigned char*)d_ws;
#if MK_SPLIT
    for (int ph = 0; ph < NPHASE; ++ph) { a.ph_lo = ph; a.ph_hi = ph + 1; hipLaunchKernelGGL(hybrid_fwd, dim3(grid), dim3(NWAVES * 64), LDS_BYTES, stream, a); }
#else
    a.ph_lo = 0; a.ph_hi = NPHASE;
    hipLaunchKernelGGL(hybrid_fwd, dim3(grid), dim3(NWAVES * 64), LDS_BYTES, stream, a);
#endif
}
```

```cpp
#include <hip/hip_runtime.h>
#include <cstdio>
#include <cstdint>

#ifndef PROBE_REP
#define PROBE_REP 0
#endif
#define NREP(k) (1 + ((PROBE_REP >> (k)) & 1))
#ifndef PROBE2
#define PROBE2 0
#endif
#define NREP2(j) (1 + ((PROBE2 >> (j)) & 1))
#ifndef MK_SPLIT
#define MK_SPLIT 0
#endif

constexpr int DM = 1024, WMIX = 512, NPB = 8, SEQ = 2048, NSB = 128, DSEQ = 4;
constexpr int MP = NPB * SEQ, MS = NSB * DSEQ, M = MP + MS;
constexpr int FF = 2816, INC = 8192, ZC = 3072, YC = 2048, GC = 4096;
constexpr float LN_EPS = 1e-5f, ALPHA = 1.41421356237f;
constexpr size_t O_Y = 0, O_PH = (size_t)M * DM, O_PRGC = O_PH + 8192, O_PCF = O_PRGC + 24576, O_PPOOL = O_PCF + 245760, O_PSC = O_PPOOL + 122880,
                 O_SH = O_PSC + 16384, O_SRGC = O_SH + 131072, O_SCF = O_SRGC + 393216, O_SPOOL = O_SCF + 3932160, O_SSC = O_SPOOL + 1966080, O_END = O_SSC + 262144;
static_assert(O_END == 24403968, "output map");

__device__ __forceinline__ int opqv(int v) { asm volatile("" : "+v"(v)); return v; }
__device__ __forceinline__ int lane_now() { int l; asm volatile("v_mbcnt_lo_u32_b32 %0, -1, 0\n\tv_mbcnt_hi_u32_b32 %0, -1, %0" : "=v"(l)); return l; }
__device__ __forceinline__ int opqs(int v) { asm volatile("" : "+s"(v)); return v; }
namespace pg8 {
#define PG8_LAS __attribute__((address_space(3)))
typedef unsigned short bf16_t;
typedef short bf16x8 __attribute__((ext_vector_type(8)));
typedef float f32x4 __attribute__((ext_vector_type(4)));
typedef float f32x2 __attribute__((ext_vector_type(2)));
typedef unsigned u32x4 __attribute__((ext_vector_type(4)));
typedef unsigned u32x2 __attribute__((ext_vector_type(2)));
typedef _Float16 f16x4 __attribute__((ext_vector_type(4)));
typedef _Float16 f16x8 __attribute__((ext_vector_type(8)));
constexpr int BM = 256, BK = 64, HALF = 128, HTB = HALF * BK * 2, STAGE_BYTES = 8 * HTB, NXCD = 8, WGM = 8;

__host__ __device__ __forceinline__ int lds_byte(int r, int c) { const int st = (r >> 4) * 2 + (c >> 5), rr = r & 15, cc = c & 31, ob = rr * 64 + cc * 2; return st * 1024 + (ob ^ (((ob >> 9) & 1) << 5)); }
__host__ __device__ __forceinline__ void stage_rc(int b, int& R, int& C) { const int st = b / 1024, sb = b % 1024, swz = sb ^ (((sb >> 9) & 1) << 5); R = (st >> 1) * 16 + swz / 64; C = (st & 1) * 32 + (swz % 64) / 2; }
__host__ __device__ __forceinline__ int perm32(int rho) { const int n = rho >> 4, i = rho & 15; return 8 * (i >> 2) + 4 * n + (i & 3); }

struct Unit { int pm, pn, nt, mode, aux; long offA, offB; };
struct Gemm { const bf16_t* A; const bf16_t* Bt; int lda, ldb; };

enum { SK_PLAIN = 0, SK_P3 = 1, SK_P4 = 2, SK_P6 = 3 };
struct UnitOrder {
    int kind, nN, nwgP, nS, ntP, G, c; long offA_s; const unsigned* ready = nullptr; unsigned need = 0;
    __device__ __forceinline__ void init(int kind_, int N_, int K_, int G_, int c_, long offA_s_, bool prompt = true, bool sample = true) { kind = kind_; nN = N_ / BM; nwgP = prompt ? 64 * nN : 0; ntP = K_ / BK; G = G_; c = c_; offA_s = offA_s_;
        nS = !sample ? 0 : kind_ == SK_PLAIN ? 2 * nN : kind_ == SK_P3 ? 32 : kind_ == SK_P4 ? 128 : 88; }
    __device__ __forceinline__ bool next(int i, Unit& u, const Gemm& g) const {
        const long L = (long)i * G + c; const long ra = (long)BM * g.lda * 2, rb = (long)BM * g.ldb * 2;
        if (L < nwgP) {
            int wgid = (int)L; { const int q = nwgP / NXCD, xcd = wgid % NXCD, off = wgid / NXCD; wgid = xcd * q + off; }
            const int nig = WGM * nN; u.pm = (wgid / nig) * WGM + ((wgid % nig) % WGM); u.pn = (wgid % nig) / WGM;
            u.nt = ntP; u.mode = 0; u.aux = 0; u.offA = u.pm * ra; u.offB = u.pn * rb; return true; }
        const int s = (int)(L - nwgP); if (s >= nS) return false;
        if (kind == SK_PLAIN) { u.pm = 64 + (s & 1); u.pn = s >> 1; u.nt = ntP; u.mode = 0; u.aux = 0; u.offA = u.pm * ra; u.offB = u.pn * rb; }
        else if (kind == SK_P3) { const int n = s & 3, tile = s >> 2; u.pm = 64 + (tile & 1); u.pn = tile >> 1; u.nt = 8; u.mode = 1; u.aux = n; u.offA = u.pm * ra + 1024 * n; u.offB = u.pn * rb + 1024 * n; }
        else if (kind == SK_P4) { const int ch = s & 15, tile = s >> 4, n = ch >> 2, kin = (ch & 3) * 256; u.pm = 64 + (tile & 1); u.pn = tile >> 1; u.nt = 4; u.mode = 1; u.aux = ch;
            u.offA = offA_s + ((long)(n * 512 + (u.pm - 64) * 256) * 1024 + kin) * 2; u.offB = u.pn * rb + kin * 2; }
        else { const int ch = s % 11, tile = s / 11; u.pm = 64 + (tile & 1); u.pn = tile >> 1; u.nt = 4; u.mode = 1; u.aux = ch; u.offA = u.pm * ra + 512 * ch; u.offB = u.pn * rb + 512 * ch; }
        return true;
    }
    __device__ __forceinline__ void a_ready(const Unit& u, int wid) const {
        if (ready == nullptr || u.pm < 64) return;
        if (wid == 0) { unsigned spins = 0;
            while ((unsigned)__builtin_amdgcn_readfirstlane(__hip_atomic_load(ready, __ATOMIC_RELAXED, __HIP_MEMORY_SCOPE_AGENT)) < need) { __builtin_amdgcn_s_sleep(2); if (++spins > (1u << 20)) break; }
            __builtin_amdgcn_fence(__ATOMIC_ACQUIRE, "agent");
            asm volatile("s_waitcnt vmcnt(0)" ::: "memory"); }
        asm volatile("" ::: "memory"); __builtin_amdgcn_s_barrier(); asm volatile("" ::: "memory");
    }
};

__device__ __forceinline__ unsigned cvt_pk_bf16(float lo, float hi) { unsigned r; asm volatile("v_cvt_pk_bf16_f32 %0, %1, %2" : "=v"(r) : "v"(lo), "v"(hi)); return r; }
__device__ __forceinline__ float sigmoidf_fast(float x) { return __builtin_amdgcn_rcpf(1.0f + __builtin_amdgcn_exp2f(-1.44269504089f * x)); }
__device__ __forceinline__ float gelu_tanh(float x) { const float t = x * x, y = x * fmaf(t, -0.10294324f, -2.3022082f); return x * __builtin_amdgcn_rcpf(1.0f + __builtin_amdgcn_exp2f(y)); }

__device__ __forceinline__ void acc_zero(f32x4 (&acc)[2][2][4][2]) {
#pragma unroll
    for (int a = 0; a < 2; ++a)
#pragma unroll
        for (int b = 0; b < 2; ++b)
#pragma unroll
            for (int m = 0; m < 4; ++m)
#pragma unroll
                for (int n = 0; n < 2; ++n) acc[a][b][m][n] = (f32x4){0.f, 0.f, 0.f, 0.f};
}
__device__ __forceinline__ float* state_ptr(float* out, int R, int keep, int layer, size_t p_off, size_t s_off) {
    if (R < MP) { const int b = R >> 11, j = (R & 2047) - (2048 - keep); return j < 0 ? nullptr : out + p_off + (size_t)((layer * 8 + b) * keep + j) * 512; }
    const int s = (R - MP) >> 2, j = (R & 3) + keep - 4; return j < 0 ? nullptr : out + s_off + (size_t)((layer * 128 + s) * keep + j) * 512;
}

struct EpiMix {
    static constexpr bool PERM = true, MIDK = false;
    __device__ __forceinline__ void init(f32x4 (&acc)[2][2][4][2], const Unit&, int, int) const { acc_zero(acc); }
    bf16_t* Z; float* out; int layer;
    __device__ __forceinline__ void midk(f32x4 (&)[2][2][4][2], const Unit&, int, int, int, int, int) const {}
    __device__ __forceinline__ void operator()(f32x4 (&acc)[2][2][4][2], const Unit& u, int wr, int wc, int fr_, int fq_) const {
        const int lane_ = lane_now(), fr = lane_ & 15, fq = lane_ >> 4; (void)fr_; (void)fq_;
        const int pn = u.pn; int type, zcol, keep = 0, scol = 0; size_t poff = 0, soff = 0;
        if (pn < 2) { type = 0; zcol = 256 * pn; keep = 3; scol = zcol; poff = O_PRGC; soff = O_SRGC; }
        else if (pn < 4) { type = 1; zcol = 512 + 256 * (pn - 2); }
        else if (pn < 8) { type = 2; zcol = 1024 + 128 * (pn - 4); keep = 30; scol = 128 * (pn - 4); poff = O_PCF; soff = O_SCF; }
        else if (pn < 10) { type = 0; zcol = 1536 + 256 * (pn - 8); keep = 15; scol = 256 * (pn - 8); poff = O_PPOOL; soff = O_SPOOL; }
        else if (pn < 12) { type = 0; zcol = 2048 + 256 * (pn - 10); }
        else { type = 3; zcol = 2560 + 128 * (pn - 12); keep = 2; scol = 128 * (pn - 12); poff = O_PSC; soff = O_SSC; }
        const bool tail = keep != 0 && (u.pm >= 64 || (u.pm & 7) == 7);
        const int row0 = u.pm * BM + wr * 64 + fr, cl = wc * 32 + 8 * fq;
        if (type < 2) {
#pragma unroll
            for (int ai = 0; ai < 2; ++ai)
#pragma unroll
                for (int m = 0; m < 4; ++m) { const int R = row0 + ai * HALF + m * 16; bf16_t* rowp = Z + (size_t)R * ZC + zcol + cl;
                    float* sp = tail ? state_ptr(out, R, keep, layer, poff, soff) : nullptr;
#pragma unroll
                    for (int bj = 0; bj < 2; ++bj) { f32x4 v0 = acc[ai][bj][m][0], v1 = acc[ai][bj][m][1];
                        if (type == 1) { v0 = (f32x4){gelu_tanh(v0[0]), gelu_tanh(v0[1]), gelu_tanh(v0[2]), gelu_tanh(v0[3])}; v1 = (f32x4){gelu_tanh(v1[0]), gelu_tanh(v1[1]), gelu_tanh(v1[2]), gelu_tanh(v1[3])}; }
                        u32x4 w; w.x = cvt_pk_bf16(v0[0], v0[1]); w.y = cvt_pk_bf16(v0[2], v0[3]); w.z = cvt_pk_bf16(v1[0], v1[1]); w.w = cvt_pk_bf16(v1[2], v1[3]);
                        *(u32x4*)(rowp + bj * HALF) = w;
                        if (sp) { *(f32x4*)(sp + scol + cl + bj * HALF) = v0; *(f32x4*)(sp + scol + cl + bj * HALF + 4) = v1; } } }
        } else {
#pragma unroll
            for (int ai = 0; ai < 2; ++ai)
#pragma unroll
                for (int m = 0; m < 4; ++m) { const int R = row0 + ai * HALF + m * 16; bf16_t* rowp = Z + (size_t)R * ZC + zcol + cl;
                    float* sp = tail ? state_ptr(out, R, keep, layer, poff, soff) : nullptr;
                    f32x4 v0, v1; const f32x4 a0 = acc[ai][0][m][0], a1 = acc[ai][0][m][1], b0 = acc[ai][1][m][0], b1 = acc[ai][1][m][1];
                    if (type == 2) {
#pragma unroll
                        for (int i = 0; i < 4; ++i) { v0[i] = a0[i] * sigmoidf_fast(b0[i]); v1[i] = a1[i] * sigmoidf_fast(b1[i]); }
                    } else { v0 = a0 * b0; v1 = a1 * b1; }
                    u32x4 w; w.x = cvt_pk_bf16(v0[0], v0[1]); w.y = cvt_pk_bf16(v0[2], v0[3]); w.z = cvt_pk_bf16(v1[0], v1[1]); w.w = cvt_pk_bf16(v1[2], v1[3]);
                    *(u32x4*)rowp = w;
                    if (sp) { *(f32x4*)(sp + scol + cl) = v0; *(f32x4*)(sp + scol + cl + 4) = v1; } }
        }
    }
};

struct EpiGate {
    static constexpr bool PERM = true, MIDK = false;
    __device__ __forceinline__ void init(f32x4 (&acc)[2][2][4][2], const Unit&, int, int) const { acc_zero(acc); }
    _Float16* G;
    __device__ __forceinline__ void midk(f32x4 (&)[2][2][4][2], const Unit&, int, int, int, int, int) const {}
    __device__ __forceinline__ void operator()(f32x4 (&acc)[2][2][4][2], const Unit& u, int wr, int wc, int fr_, int fq_) const {
        const int lane_ = lane_now(), fr = lane_ & 15, fq = lane_ >> 4; (void)fr_; (void)fq_;
        const int row0 = u.pm * BM + wr * 64 + fr, ch0 = 64 * u.pn + 16 * wc + 4 * fq; const bool plain = u.pm >= 64;
#pragma unroll
        for (int ai = 0; ai < 2; ++ai)
#pragma unroll
            for (int m = 0; m < 4; ++m) { const int R = row0 + ai * HALF + m * 16; _Float16* gp = G + (size_t)R * GC + ch0;
                f16x4 r0, r1, r2, g3;
#pragma unroll
                for (int i = 0; i < 4; ++i) {
                    const float d0 = 1.f + __builtin_amdgcn_exp2f(__builtin_amdgcn_fmed3f(acc[ai][0][m][0][i], -15.f, 15.f)), d1 = 1.f + __builtin_amdgcn_exp2f(__builtin_amdgcn_fmed3f(acc[ai][0][m][1][i], -15.f, 15.f));
                    const float d2 = 1.f + __builtin_amdgcn_exp2f(__builtin_amdgcn_fmed3f(acc[ai][1][m][0][i], -15.f, 15.f)), d3 = 1.f + __builtin_amdgcn_exp2f(__builtin_amdgcn_fmed3f(acc[ai][1][m][1][i], -15.f, 15.f));
                    const float i0 = __builtin_amdgcn_rcpf(d0), i1 = __builtin_amdgcn_rcpf(d1), i2 = __builtin_amdgcn_rcpf(d2), i3 = __builtin_amdgcn_rcpf(d3);
                    if (plain) { r0[i] = (_Float16)i0; r1[i] = (_Float16)i1; r2[i] = (_Float16)i2; }
                    else { r0[i] = (_Float16)(d1 * i0); r1[i] = (_Float16)(d2 * i1); r2[i] = (_Float16)(d3 * i2); }
                    g3[i] = (_Float16)i3; }
                *(f16x4*)(gp) = r0; *(f16x4*)(gp + 1024) = r1; *(f16x4*)(gp + 2048) = r2; *(f16x4*)(gp + 3072) = g3; }
    }
};

struct EpiMerge {
    static constexpr bool PERM = true, MIDK = true;
    __device__ __forceinline__ void init(f32x4 (&acc)[2][2][4][2], const Unit&, int, int) const { acc_zero(acc); }
    const _Float16* G; bf16_t* O; bf16_t* Os;
    __device__ __forceinline__ void scale(f32x4 (&acc)[2][2][4][2], const Unit& u, int seg, int wr, int wc) const {
        const int lane_ = lane_now(), fr = lane_ & 15, fq = lane_ >> 4;
        const int row0 = u.pm * BM + wr * 64 + fr, c0 = 1024 * seg + 256 * u.pn + wc * 32 + 8 * fq;
#pragma unroll
        for (int ai = 0; ai < 2; ++ai)
#pragma unroll
            for (int m = 0; m < 4; ++m) { const _Float16* gp = G + (size_t)(row0 + ai * HALF + m * 16) * GC + c0;
#pragma unroll
                for (int bj = 0; bj < 2; ++bj) { const f16x8 f = *(const f16x8*)(gp + bj * HALF);
                    acc[ai][bj][m][0] *= (f32x4){(float)f[0], (float)f[1], (float)f[2], (float)f[3]}; acc[ai][bj][m][1] *= (f32x4){(float)f[4], (float)f[5], (float)f[6], (float)f[7]}; } }
    }
    __device__ __forceinline__ void midk(f32x4 (&acc)[2][2][4][2], const Unit& u, int seg, int wr, int wc, int, int) const { scale(acc, u, seg, wr, wc); }
    __device__ __forceinline__ void operator()(f32x4 (&acc)[2][2][4][2], const Unit& u, int wr, int wc, int, int) const {
        scale(acc, u, u.mode ? u.aux : 3, wr, wc);
        const int lane_ = lane_now(), fr = lane_ & 15, fq = lane_ >> 4;
        const int row0 = (u.mode ? (u.pm - 64) * BM + 512 * u.aux : u.pm * BM) + wr * 64 + fr, c0 = 256 * u.pn + wc * 32 + 8 * fq;
        bf16_t* O = u.mode ? Os : this->O;
#pragma unroll
        for (int ai = 0; ai < 2; ++ai)
#pragma unroll
            for (int m = 0; m < 4; ++m) { bf16_t* rowp = O + (size_t)(row0 + ai * HALF + m * 16) * DM + c0;
#pragma unroll
                for (int bj = 0; bj < 2; ++bj) { const f32x4 v0 = acc[ai][bj][m][0], v1 = acc[ai][bj][m][1];
                    u32x4 w; w.x = cvt_pk_bf16(v0[0], v0[1]); w.y = cvt_pk_bf16(v0[2], v0[3]); w.z = cvt_pk_bf16(v1[0], v1[1]); w.w = cvt_pk_bf16(v1[2], v1[3]); *(u32x4*)(rowp + bj * HALF) = w; } }
    }
};

struct PanelStats {
    unsigned* xbuf;
    unsigned* cnt;
    __device__ __forceinline__ void run(const f32x4 (&v)[2][2][4][2], const Unit& u, int wr, int wc, PG8_LAS unsigned char* lds, int wid) const {
        const int lane = lane_now(), fr = lane & 15, fq = lane >> 4;
        PG8_LAS f32x2* P = (PG8_LAS f32x2*)lds;
        PG8_LAS f32x2* S = (PG8_LAS f32x2*)(lds + 8192);
#pragma unroll
        for (int ai = 0; ai < 2; ++ai)
#pragma unroll
            for (int m = 0; m < 4; ++m) {
                float s = 0.f;
#pragma unroll
                for (int bj = 0; bj < 2; ++bj)
#pragma unroll
                    for (int n = 0; n < 2; ++n) { const f32x4 x = v[ai][bj][m][n]; s += (x[0] + x[1]) + (x[2] + x[3]); }
                s += __builtin_bit_cast(float, __builtin_amdgcn_ds_bpermute((lane ^ 16) << 2, __builtin_bit_cast(int, s))); s += __builtin_bit_cast(float, __builtin_amdgcn_ds_bpermute((lane ^ 32) << 2, __builtin_bit_cast(int, s)));
                const float mw = s * (1.0f / 64.0f); float q = 0.f;
#pragma unroll
                for (int bj = 0; bj < 2; ++bj)
#pragma unroll
                    for (int n = 0; n < 2; ++n) { const f32x4 d = v[ai][bj][m][n] - mw; q += (d[0] * d[0] + d[1] * d[1]) + (d[2] * d[2] + d[3] * d[3]); }
                q += __builtin_bit_cast(float, __builtin_amdgcn_ds_bpermute((lane ^ 16) << 2, __builtin_bit_cast(int, q))); q += __builtin_bit_cast(float, __builtin_amdgcn_ds_bpermute((lane ^ 32) << 2, __builtin_bit_cast(int, q)));
                if (fq == 0) P[(ai * HALF + wr * 64 + m * 16 + fr) * 4 + wc] = (f32x2){mw, q};
            }
        asm volatile("s_waitcnt lgkmcnt(0)" ::: "memory"); __builtin_amdgcn_s_barrier(); asm volatile("" ::: "memory");
        const int row = wid * 32 + (lane & 31);
        if (lane < 32) {
            const f32x2 a = P[row * 4 + 0], b = P[row * 4 + 1], c = P[row * 4 + 2], d = P[row * 4 + 3];
            const float mt = (a.x + b.x + c.x + d.x) * 0.25f;
            const float da = a.x - mt, db = b.x - mt, dc = c.x - mt, dd = d.x - mt;
            const float m2 = (a.y + b.y) + (c.y + d.y) + 64.0f * ((da * da + db * db) + (dc * dc + dd * dd));
            unsigned long long* slot = (unsigned long long*)xbuf + ((size_t)(u.pm * BM + row) * 4 + u.pn);
            __hip_atomic_store(slot, ((unsigned long long)__float_as_uint(m2) << 32) | __float_as_uint(mt), __ATOMIC_RELAXED, __HIP_MEMORY_SCOPE_AGENT);
        }
        asm volatile("s_waitcnt vmcnt(0)" ::: "memory");
        if (lane == 0) __hip_atomic_fetch_add(cnt + 64 * u.pm, 1u, __ATOMIC_RELAXED, __HIP_MEMORY_SCOPE_AGENT);
        if (wid == 0) {
            unsigned spins = 0;
            while ((unsigned)__builtin_amdgcn_readfirstlane(__hip_atomic_load(cnt + 64 * u.pm, __ATOMIC_RELAXED, __HIP_MEMORY_SCOPE_AGENT)) < 32u) { __builtin_amdgcn_s_sleep(2); if (++spins > (1u << 20)) break; }
            __builtin_amdgcn_fence(__ATOMIC_ACQUIRE, "agent");
        }
        asm volatile("s_waitcnt vmcnt(0) lgkmcnt(0)" ::: "memory"); __builtin_amdgcn_s_barrier(); asm volatile("" ::: "memory");
        if (lane < 32) {
            const unsigned long long* slot = (const unsigned long long*)xbuf + (size_t)(u.pm * BM + row) * 4; float mt[4], m2[4]; float ms = 0.f;
#pragma unroll
            for (int t = 0; t < 4; ++t) { const unsigned long long w = __hip_atomic_load(slot + t, __ATOMIC_RELAXED, __HIP_MEMORY_SCOPE_AGENT); mt[t] = __uint_as_float((unsigned)w); m2[t] = __uint_as_float((unsigned)(w >> 32)); ms += mt[t]; }
            const float mean = ms * 0.25f; float q = 0.f;
#pragma unroll
            for (int t = 0; t < 4; ++t) { const float dm = mt[t] - mean; q += m2[t] + 256.0f * dm * dm; }
            S[row] = (f32x2){mean, __builtin_amdgcn_rsqf(q * (1.0f / 1024.0f) + LN_EPS)};
        }
        asm volatile("s_waitcnt lgkmcnt(0)" ::: "memory"); __builtin_amdgcn_s_barrier(); asm volatile("" ::: "memory");
    }
};
struct EpiRes {
    static constexpr bool PERM = false, MIDK = false;
    __device__ __forceinline__ void init(f32x4 (&acc)[2][2][4][2], const Unit& u, int wr, int wc) const {
        if (u.mode) { acc_zero(acc); return; }
        const int lane_ = lane_now(), fr = lane_ & 15, fq = lane_ >> 4;
        const float* bp0 = baseP + (size_t)(u.pm * BM + wr * 64 + fr) * DM + 256 * u.pn + wc * 32 + 4 * fq;
#pragma unroll
        for (int ai = 0; ai < 2; ++ai)
#pragma unroll
            for (int m = 0; m < 4; ++m)
#pragma unroll
                for (int bj = 0; bj < 2; ++bj)
#pragma unroll
                    for (int n = 0; n < 2; ++n) acc[ai][bj][m][n] = *(const f32x4*)(bp0 + (size_t)(ai * HALF + m * 16) * DM + bj * HALF + n * 16) * ALPHA;
    }
    const float* baseP; float* out; bf16_t* xb; const float* lng; const float* lnb; float* slab; PanelStats st; PG8_LAS unsigned char* xlds; int wid;
    __device__ __forceinline__ void midk(f32x4 (&)[2][2][4][2], const Unit&, int, int, int, int, int) const {}
    __device__ __forceinline__ void operator()(f32x4 (&acc)[2][2][4][2], const Unit& u, int wr, int wc, int fr_, int fq_) const {
        const int lane_ = lane_now(), fr = lane_ & 15, fq = lane_ >> 4; (void)fr_; (void)fq_;
        const int row0 = u.pm * BM + wr * 64 + fr, c0 = 256 * u.pn + wc * 32 + 4 * fq;
        if (u.mode) {
#pragma unroll
            for (int ai = 0; ai < 2; ++ai)
#pragma unroll
                for (int m = 0; m < 4; ++m) { float* op = slab + ((size_t)u.aux * 512 + (row0 - MP) + ai * HALF + m * 16) * DM + c0;
#pragma unroll
                    for (int bj = 0; bj < 2; ++bj)
#pragma unroll
                        for (int n = 0; n < 2; ++n) *(f32x4*)(op + bj * HALF + n * 16) = acc[ai][bj][m][n]; }
            return; }
        st.run(acc, u, wr, wc, xlds, wid);
        const PG8_LAS f32x2* S = (const PG8_LAS f32x2*)(xlds + 8192);
#pragma unroll
        for (int bj = 0; bj < 2; ++bj)
#pragma unroll
            for (int n = 0; n < 2; ++n) { const int cc = c0 + bj * HALF + n * 16; const f32x4 gv = *(const f32x4*)(lng + cc), bv = *(const f32x4*)(lnb + cc);
#pragma unroll
                for (int ai = 0; ai < 2; ++ai)
#pragma unroll
                    for (int m = 0; m < 4; ++m) { const int r = ai * HALF + wr * 64 + m * 16 + fr; const f32x2 sr = S[r]; const size_t off = (size_t)(u.pm * BM + r) * DM + cc;
                        const f32x4 o = (acc[ai][bj][m][n] - sr.x) * sr.y * gv + bv; *(f32x4*)(out + off) = o;
                        if (xb) { u32x2 w; w.x = cvt_pk_bf16(o[0], o[1]); w.y = cvt_pk_bf16(o[2], o[3]); *(u32x2*)(xb + off) = w; }
                        if (m & 1) asm volatile("" ::: "memory"); } }
    }
};

struct EpiSwi {
    static constexpr bool PERM = true, MIDK = false;
    __device__ __forceinline__ void init(f32x4 (&acc)[2][2][4][2], const Unit&, int, int) const { acc_zero(acc); }
    bf16_t* H;
    __device__ __forceinline__ void midk(f32x4 (&)[2][2][4][2], const Unit&, int, int, int, int, int) const {}
    __device__ __forceinline__ void operator()(f32x4 (&acc)[2][2][4][2], const Unit& u, int wr, int wc, int fr_, int fq_) const {
        const int lane_ = lane_now(), fr = lane_ & 15, fq = lane_ >> 4; (void)fr_; (void)fq_;
        const int row0 = u.pm * BM + wr * 64 + fr, c0 = 128 * u.pn + wc * 32 + 8 * fq;
#pragma unroll
        for (int ai = 0; ai < 2; ++ai)
#pragma unroll
            for (int m = 0; m < 4; ++m) { bf16_t* rowp = H + (size_t)(row0 + ai * HALF + m * 16) * FF + c0;
                const f32x4 g0 = acc[ai][0][m][0], g1 = acc[ai][0][m][1], u0 = acc[ai][1][m][0], u1 = acc[ai][1][m][1]; f32x4 v0, v1;
#pragma unroll
                for (int i = 0; i < 4; ++i) { v0[i] = g0[i] * sigmoidf_fast(g0[i]) * u0[i]; v1[i] = g1[i] * sigmoidf_fast(g1[i]) * u1[i]; }
                u32x4 w; w.x = cvt_pk_bf16(v0[0], v0[1]); w.y = cvt_pk_bf16(v0[2], v0[3]); w.z = cvt_pk_bf16(v1[0], v1[1]); w.w = cvt_pk_bf16(v1[2], v1[3]);
                *(u32x4*)rowp = w; }
    }
};

template <class Epi, class Sched, bool ALIGN_EPI>
__device__ __forceinline__ void gemm_phase(PG8_LAS unsigned char* lds, const Gemm g, const Sched& S, const Epi& E, int wave_id) {
    const int wid = opqs(wave_id), lane = lane_now(), tid = wid * 64 + lane, wr = wid >> 2, wc = wid & 3, fr = lane & 15, fq = lane >> 4;
    unsigned voffA[2], voffB[2];
#pragma unroll
    for (int i = 0; i < 2; ++i) { int R, C; stage_rc(tid * 16 + i * 8192, R, C); const int Rb = Epi::PERM ? ((R & ~31) + perm32(R & 31)) : R;
        voffA[i] = (unsigned)(R * g.lda + C) * 2u; voffB[i] = (unsigned)(Rb * g.ldb + C) * 2u; }
    const size_t kstep = (size_t)(BK * 2);
    const size_t hstepA = (size_t)HALF * g.lda * 2, hstepB = (size_t)HALF * g.ldb * 2;
    const unsigned ldsw = (unsigned)wid * 1024u;
    const int aoff = lds_byte(wr * 64 + fr, fq * 8), boff = lds_byte(wc * 32 + fr, fq * 8);
#define PG8_SA(b, h) (((b) * 2 + (h)) * HTB)
#define PG8_SB(b, h) ((4 + (b) * 2 + (h)) * HTB)
#define PG8_STAGE(bufoff, gbase, voff) do { _Pragma("unroll") for (int _i = 0; _i < 2; ++_i) \
        __builtin_amdgcn_global_load_lds((const unsigned*)((const char*)(gbase) + (voff)[_i]), (PG8_LAS unsigned*)(lds + (bufoff) + ldsw + _i * 8192), 16, 0, 0); } while (0)
#define PG8_LDA(dst, b, h) do { _Pragma("unroll") for (int m = 0; m < 4; ++m) _Pragma("unroll") for (int k = 0; k < 2; ++k) dst[m][k] = *(const PG8_LAS bf16x8*)(lds + PG8_SA(b, h) + aoff + m * 2048 + k * 1024); } while (0)
#define PG8_LDB(dst, b, h) do { _Pragma("unroll") for (int n = 0; n < 2; ++n) _Pragma("unroll") for (int k = 0; k < 2; ++k) dst[n][k] = *(const PG8_LAS bf16x8*)(lds + PG8_SB(b, h) + boff + n * 2048 + k * 1024); } while (0)
#define PG8_MMA(ai, bj, At, Bt) do { __builtin_amdgcn_s_setprio(1); _Pragma("unroll") for (int m = 0; m < 4; ++m) _Pragma("unroll") for (int n = 0; n < 2; ++n) _Pragma("unroll") for (int k = 0; k < 2; ++k) \
        acc[ai][bj][m][n] = __builtin_amdgcn_mfma_f32_16x16x32_bf16(Bt[n][k], At[m][k], acc[ai][bj][m][n], 0, 0, 0); __builtin_amdgcn_s_setprio(0); } while (0)
#define PG8_WAIT_V(n) asm volatile("s_waitcnt vmcnt(" #n ")" ::: "memory")
#define PG8_WAIT_L(n) asm volatile("s_waitcnt lgkmcnt(" #n ")" ::: "memory")
#define PG8_BAR __builtin_amdgcn_s_barrier()
#define PG8_SCHED __builtin_amdgcn_sched_barrier(0)
    Unit cur, nxt; int ui = 0;
    if (!S.next(0, cur, g)) return;
    f32x4 acc[2][2][4][2];
    E.init(acc, cur, wr, wc);
    bf16x8 At[4][2], B0[2][2], B1[2][2];
    const char* cA = (const char*)g.A + cur.offA; const char* cB = (const char*)g.Bt + cur.offB;
    PG8_STAGE(PG8_SB(0, 0), cB, voffB); PG8_STAGE(PG8_SB(0, 1), cB + hstepB, voffB); PG8_STAGE(PG8_SA(0, 0), cA, voffA); PG8_STAGE(PG8_SA(0, 1), cA + hstepA, voffA);
    if (wr == 1) PG8_BAR;
    PG8_WAIT_V(2); PG8_BAR;
    PG8_STAGE(PG8_SB(1, 0), cB + kstep, voffB); PG8_STAGE(PG8_SA(1, 0), cA + kstep, voffA); PG8_STAGE(PG8_SB(1, 1), cB + hstepB + kstep, voffB);
    PG8_WAIT_V(6); PG8_BAR;
    for (;;) {
        const bool has_next = S.next(ui + 1, nxt, g);
        const char* nA = has_next ? (const char*)g.A + nxt.offA : cA; const char* nB = has_next ? (const char*)g.Bt + nxt.offB : cB;
        const int nt = cur.nt, TSEG = Epi::MIDK ? 8 : nt;
        for (int t0 = 0; t0 < nt; t0 += TSEG) {
        if constexpr (Epi::MIDK) { if (t0 != 0) { PG8_SCHED; E.midk(acc, cur, t0 / TSEG - 1, wr, wc, 0, 0); PG8_SCHED; } }
#pragma unroll 1
        for (int t = t0; t < t0 + TSEG; t += 2) {
            const bool last = (t == nt - 2);
            if (last && has_next) S.a_ready(nxt, wid);
            const char* a1 = cA + (size_t)(t + 1) * kstep;
            const char* a2 = last ? nA : cA + (size_t)(t + 2) * kstep; const char* b2 = last ? nB : cB + (size_t)(t + 2) * kstep;
            const char* a3 = a2 + kstep; const char* b3 = b2 + kstep;
            PG8_LDB(B0, 0, 0); PG8_LDB(B1, 0, 1); PG8_SCHED; PG8_LDA(At, 0, 0); PG8_STAGE(PG8_SA(1, 1), a1 + hstepA, voffA);
            PG8_WAIT_V(8); PG8_WAIT_L(0); PG8_BAR; PG8_MMA(0, 0, At, B0); PG8_MMA(0, 1, At, B1); PG8_BAR; PG8_SCHED;
            PG8_LDA(At, 0, 1); PG8_STAGE(PG8_SB(0, 0), b2, voffB); PG8_STAGE(PG8_SB(0, 1), b2 + hstepB, voffB); PG8_STAGE(PG8_SA(0, 0), a2, voffA);
            PG8_WAIT_V(8); PG8_WAIT_L(0); PG8_BAR; PG8_MMA(1, 0, At, B0); PG8_MMA(1, 1, At, B1); PG8_BAR; PG8_SCHED;
            PG8_LDB(B0, 1, 0); PG8_LDB(B1, 1, 1); PG8_SCHED; PG8_LDA(At, 1, 0); PG8_STAGE(PG8_SA(0, 1), a2 + hstepA, voffA);
            PG8_WAIT_V(8); PG8_WAIT_L(0); PG8_BAR; PG8_MMA(0, 0, At, B0); PG8_MMA(0, 1, At, B1); PG8_BAR; PG8_SCHED;
            PG8_LDA(At, 1, 1); PG8_STAGE(PG8_SB(1, 0), b3, voffB); PG8_STAGE(PG8_SB(1, 1), b3 + hstepB, voffB); PG8_STAGE(PG8_SA(1, 0), a3, voffA);
            PG8_WAIT_V(8); PG8_WAIT_L(0); PG8_BAR; PG8_MMA(1, 0, At, B0); PG8_MMA(1, 1, At, B1); PG8_BAR; PG8_SCHED;
        }
        }
        if constexpr (ALIGN_EPI) { if (wr == 0) PG8_BAR; }
        E(acc, cur, wr, wc, 0, 0);
        if (!has_next) break;
        cur = nxt; cA = nA; cB = nB; ++ui;
        E.init(acc, cur, wr, wc);
        if constexpr (ALIGN_EPI) { if (wr == 1) PG8_BAR; }
    }
    PG8_WAIT_V(0);
    if constexpr (!ALIGN_EPI) { if (wr == 0) PG8_BAR; }
    PG8_BAR;
#undef PG8_SA
#undef PG8_SB
#undef PG8_STAGE
#undef PG8_LDA
#undef PG8_LDB
#undef PG8_MMA
#undef PG8_WAIT_V
#undef PG8_WAIT_L
#undef PG8_BAR
#undef PG8_SCHED
}
}

constexpr int NWAVES = 8;
constexpr int NPHASE = 19;
constexpr size_t MiB = 1u << 20;
constexpr size_t WS_CTL = 0, CTL_ZERO_BYTES = 1 * MiB;
constexpr size_t WS_WA = 1 * MiB;
constexpr size_t WS_XB = 18 * MiB;
constexpr size_t WS_Y = 51 * MiB;
constexpr size_t WS_ZG = 117 * MiB;
constexpr size_t WS_BT3 = 249 * MiB, WS_BT4 = 253 * MiB, WS_BT5 = WS_WA, WS_BT6 = WS_ZG + 108 * MiB;
constexpr size_t WS_MB4S = WS_WA + 13 * MiB;
constexpr size_t WS_SLAB = WS_Y;
constexpr size_t WS_END = 255 * MiB;
static_assert(WS_XB + (size_t)M * DM * 2 <= WS_Y && WS_Y + (size_t)M * YC * 2 <= WS_ZG && WS_ZG + (size_t)M * GC * 2 <= WS_BT3 && WS_SLAB + (size_t)16 * 512 * DM * 4 <= WS_Y + 40 * MiB && WS_Y + 40 * MiB + 4 * 512 * 1024 <= WS_ZG, "ws map");
static_assert((size_t)M * FF * 2 <= 108 * MiB && WS_BT5 + (size_t)2 * FF * DM * 2 <= WS_MB4S && WS_MB4S + 4 * MiB <= WS_XB && WS_BT6 + (size_t)DM * FF * 2 <= WS_BT3, "ws map 2");
constexpr int CW_RDY = 12288;
constexpr int CW_TMO = 0, CW_CODE = 1, CW_BAR = 4096, CW_SEAM = 16384, SEAM_BANK = 8192;
constexpr size_t WS_XCH = WS_Y + 40 * MiB;
constexpr int XLDS_OFF = 131072 + 1024;
constexpr int RING_OFF = 0, RING_BYTES = 131072;
constexpr int LDSCTL_OFF = RING_BYTES, MISC_OFF = LDSCTL_OFF + 320;
constexpr int LDS_BYTES = 147456;

#define GAS __attribute__((address_space(1)))
#define LAS __attribute__((address_space(3)))
typedef unsigned short bf16;
typedef unsigned v4u __attribute__((ext_vector_type(4)));
typedef unsigned v2u __attribute__((ext_vector_type(2)));
typedef float f32x4 __attribute__((ext_vector_type(4)));
typedef float f32x2 __attribute__((ext_vector_type(2)));
typedef short bf16x8 __attribute__((ext_vector_type(8)));
typedef GAS unsigned gu32;
#define RLX_AGENT __ATOMIC_RELAXED, __HIP_MEMORY_SCOPE_AGENT
#define LDS_WAIT() asm volatile("s_waitcnt lgkmcnt(0)" ::: "memory")
#define VM_WAIT() asm volatile("s_waitcnt vmcnt(0)" ::: "memory")
__device__ __forceinline__ unsigned pk2(float lo, float hi) { return pg8::cvt_pk_bf16(lo, hi); }
__device__ __forceinline__ float bflo(unsigned v) { return __uint_as_float(v << 16); }
__device__ __forceinline__ float bfhi(unsigned v) { return __uint_as_float(v & 0xffff0000u); }
__device__ __forceinline__ float bf1(unsigned short h) { return __uint_as_float((unsigned)h << 16); }
__device__ __forceinline__ unsigned short f2bf(float f) { return (unsigned short)(pg8::cvt_pk_bf16(f, 0.f) & 0xffffu); }

#define XB_TMO      128
#define XB_XCNT(j)  (256  + 64 * (j))
#define XB_XSUB(j)  (1280 + 64 * (j))
#define XB_XGEN(j)  (2304 + 64 * (j))
#define XB_TOP      3328
#define XB_TOPGEN   3392
#define XCD_BAR_WORDS 3456
#define XB_SPIN_CAP (1u << 18)
__device__ __forceinline__ unsigned xb_ld(unsigned* p)              { return __hip_atomic_load(p, __ATOMIC_RELAXED, __HIP_MEMORY_SCOPE_AGENT); }
__device__ __forceinline__ unsigned xb_add(unsigned* p, unsigned v) { return __hip_atomic_fetch_add(p, v, __ATOMIC_RELAXED, __HIP_MEMORY_SCOPE_AGENT); }
__device__ __forceinline__ unsigned xb_xcc_id() { return (unsigned)__builtin_amdgcn_s_getreg((3 << 11) | 20) & 0xFu; }
#define XB_SPIN(cond, bar) do { unsigned _sp = 0; while (cond) { __builtin_amdgcn_s_sleep(1); \
    if ((++_sp & 255u) == 0u) { if (xb_ld(&(bar)[XB_TMO])) break; if (_sp > XB_SPIN_CAP) { atomicAdd(&(bar)[XB_TMO], 1u); break; } } } } while (0)
struct XcdBarrier { unsigned* bar; unsigned x; volatile LAS unsigned* st; };
__device__ __forceinline__ XcdBarrier xcd_barrier_post(unsigned* bar, volatile LAS unsigned* st) {
    XcdBarrier b; b.bar = bar; b.x = xb_xcc_id(); b.st = st;
    if (threadIdx.x == 0) (void)xb_add(&bar[XB_XCNT(b.x)], 1u);
    return b;
}
__device__ __forceinline__ void xcd_barrier_complete(unsigned* bar, unsigned x, unsigned& nloc, unsigned& nx) {
    const unsigned G = gridDim.x * gridDim.y * gridDim.z;
    unsigned sum, cnt, mine, sp = 0u;
    for (;;) {
        sum = 0u; cnt = 0u; mine = 0u;
#pragma unroll
        for (unsigned j = 0; j < 16; ++j) { const unsigned c = xb_ld(&bar[XB_XCNT(j)]); sum += c; cnt += (c > 0u) ? 1u : 0u; mine = (j == x) ? c : mine; }
        if (sum == G) break;
        __builtin_amdgcn_s_sleep(1);
        if ((++sp & 255u) == 0u) { if (xb_ld(&bar[XB_TMO])) break; if (sp > XB_SPIN_CAP) { atomicAdd(&bar[XB_TMO], 1u); break; } }
    }
    nloc = mine > 0u ? mine : 1u; nx = cnt > 0u ? cnt : 1u;
}
__device__ __forceinline__ void xcd_barrier(const XcdBarrier& b) {
    asm volatile("s_waitcnt vmcnt(0)" ::: "memory");
    __syncthreads();
    if (threadIdx.x == 0) {
        unsigned* bar = b.bar;
        __builtin_amdgcn_s_waitcnt(0);
        unsigned nloc = b.st[0], nx = b.st[1];
        if (nloc == 0u) { xcd_barrier_complete(bar, b.x, nloc, nx); b.st[0] = nloc; b.st[1] = nx; }
        const unsigned old = xb_add(&bar[XB_XSUB(b.x)], 1u);
        const unsigned gen = old / nloc;
        if (old + 1u == (gen + 1u) * nloc) {
            __builtin_amdgcn_fence(__ATOMIC_RELEASE, "agent");
            asm volatile("s_waitcnt vmcnt(0)" ::: "memory");
            const unsigned og = xb_add(&bar[XB_TOP], 1u);
            const unsigned tg = og / nx;
            if (og + 1u == (tg + 1u) * nx) xb_add(&bar[XB_TOPGEN], 1u);
            else XB_SPIN(xb_ld(&bar[XB_TOPGEN]) == tg, bar);
            __builtin_amdgcn_fence(__ATOMIC_ACQUIRE, "agent");
            xb_add(&bar[XB_XGEN(b.x)], 1u);
            asm volatile("s_waitcnt vmcnt(0)" ::: "memory");
        } else {
            XB_SPIN(xb_ld(&bar[XB_XGEN(b.x)]) == gen, bar);
            __builtin_amdgcn_fence(__ATOMIC_ACQUIRE, "agent");
            asm volatile("s_waitcnt vmcnt(0)" ::: "memory");
        }
    }
    __syncthreads();
}

struct Frame {
    LAS unsigned char* lds;
    volatile LAS unsigned* MISC;
    gu32* ctl;
    int tid, lane, wave, G, bid;
    const float* const* in;
    float* out;
    unsigned char* ws;
};
enum { I_XP = 0, I_XS, I_SH, I_SRGC, I_SCF, I_SPOOL, I_SSC, I_WIN, I_RGCW, I_RGCB, I_RGWA, I_RGBA, I_RGWX, I_RGBX, I_LAM, I_CFW, I_CFB, I_CFG, I_CFBB, I_POOLW, I_POOLS, I_SCW,
       I_WBR, I_WOUT, I_LN1G, I_LN1B, I_WG, I_WU, I_WD, I_LN2G, I_LN2B };

__device__ __forceinline__ float shfl_idx(float v, int src_lane) { return __builtin_bit_cast(float, __builtin_amdgcn_ds_bpermute(src_lane << 2, __builtin_bit_cast(int, v))); }
__device__ __forceinline__ float wave_sum(float v, int lane) {
#pragma unroll
    for (int o = 1; o < 64; o <<= 1) v += shfl_idx(v, lane ^ o);
    return v;
}

enum { RM_ID = 0, RM_WIN = 1, RM_GU = 2 };
template <int MODE> __device__ __forceinline__ int rowmap(int s, int extra) {
    if (MODE == RM_ID) return s;
    if (MODE == RM_GU) return 256 * (s >> 7) + (s & 127) + extra;
    if (s < 1024) return s;
    if (s < 2048) { const int j = ((s - 1024) >> 7) & 3; return 1024 + 256 * j + (s >= 1536 ? 128 : 0) + (s & 127); }
    if (s < 3072) return s;
    if (s < 4096) { const int j = ((s - 3072) >> 7) & 3; return 3072 + 256 * j + (s >= 3584 ? 128 : 0) + (s & 127); }
    const int g = (s - 4096) >> 10, ch = s & 1023, pn = ch >> 6, chl = ch & 63, wc = chl >> 4, fq = (chl >> 2) & 3, i = chl & 3;
    return 4096 + 256 * pn + 128 * (g >> 1) + 32 * wc + 8 * fq + 4 * (g & 1) + i;
}
template <int MODE>
__device__ __forceinline__ void transpose_item(const float* W, int K, int N, bf16* WT, int dst_ld, int dst_koff, int extra, LAS float* scr, int item, int lane, int nb0, int nnb) {
    const int kb = item / nnb, nb = nb0 + item % nnb, k0 = 64 * kb, n0 = 32 * nb;
#pragma unroll 8
    for (int i = 0; i < 32; ++i) { const int kk = 2 * i + (lane >> 5); scr[kk * 33 + (lane & 31)] = W[(size_t)(k0 + kk) * N + n0 + (lane & 31)]; }
    LDS_WAIT(); asm volatile("" ::: "memory");
    const int c = lane & 7; const float sc = (MODE == RM_WIN && n0 >= 4096) ? -1.44269504089f : 1.0f;
#pragma unroll
    for (int j = 0; j < 4; ++j) { const int n = (lane >> 3) + 8 * j; const LAS float* s = scr + (8 * c) * 33 + n;
        v4u o; o.x = pk2(s[0 * 33] * sc, s[1 * 33] * sc); o.y = pk2(s[2 * 33] * sc, s[3 * 33] * sc); o.z = pk2(s[4 * 33] * sc, s[5 * 33] * sc); o.w = pk2(s[6 * 33] * sc, s[7 * 33] * sc);
        *(GAS v4u*)(WT + (size_t)rowmap<MODE>(n0 + n, extra) * dst_ld + dst_koff + k0 + 8 * c) = o; }
    LDS_WAIT(); asm volatile("" ::: "memory");
}
template <int MODE>
__device__ __forceinline__ void convert_matrix(Frame& F, const float* W, int K, int N, bf16* WT, int dst_ld, int dst_koff, int extra, int gw, int NGW, int first = 0, int nb0 = 0, int nnb = 0) {
    LAS float* scr = (LAS float*)(F.lds + RING_OFF + F.wave * 16384);
    if (nnb == 0) nnb = N / 32;
    const int nitems = (K / 64) * nnb;
    int it0 = gw - first; if (it0 < 0) it0 += ((-it0 + NGW - 1) / NGW) * NGW;
    for (int it = it0; it < nitems; it += NGW) transpose_item<MODE>(W, K, N, WT, dst_ld, dst_koff, extra, scr, it, F.lane, nb0, nnb);
}
__device__ __forceinline__ void compose_pool(Frame& F, int layer, bf16* Bt3, int gw, int NGW, int first = 0) {
    const float* pw = F.in[I_POOLW] + (size_t)layer * 4 * 128 * 128; const float* ps = F.in[I_POOLS] + layer * 512; const float* Wb2 = F.in[I_WBR] + ((size_t)layer * 4 + 2) * 512 * 1024;
    const int lane = F.lane;
    LAS float* Pl = (LAS float*)(F.lds + RING_OFF + F.wave * 16384);
    int id0 = gw - first; if (id0 < 0) id0 += ((-id0 + NGW - 1) / NGW) * NGW;
    for (int id = id0; id < 512; id += NGW) {
        const int g = __builtin_amdgcn_readfirstlane(id >> 7), c0 = __builtin_amdgcn_readfirstlane(8 * ((id >> 3) & 15)), d0 = 128 * (id & 7) + 2 * lane;
#pragma unroll
        for (int k = 0; k < 4; ++k) { const int idx4 = lane + 64 * k, i = idx4 >> 5, e4 = (idx4 & 31) * 4;
            const f32x4 pv = *(const GAS f32x4*)(pw + ((size_t)g * 128 + c0 + i) * 128 + e4), sv = *(const GAS f32x4*)(ps + 128 * g + e4);
            Pl[(e4 + 0) * 8 + i] = pv.x * sv.x; Pl[(e4 + 1) * 8 + i] = pv.y * sv.y; Pl[(e4 + 2) * 8 + i] = pv.z * sv.z; Pl[(e4 + 3) * 8 + i] = pv.w * sv.w; }
        LDS_WAIT(); asm volatile("" ::: "memory");
        f32x2 acc[8];
#pragma unroll
        for (int i = 0; i < 8; ++i) acc[i] = (f32x2){0.f, 0.f};
        const float* wrow = Wb2 + (size_t)(128 * g) * 1024 + d0;
#pragma unroll 1
        for (int e0 = 0; e0 < 128; e0 += 8) {
            f32x2 wv[8];
#pragma unroll
            for (int k = 0; k < 8; ++k) wv[k] = *(const GAS f32x2*)(wrow + (size_t)(e0 + k) * 1024);
#pragma unroll
            for (int k = 0; k < 8; ++k) { const f32x4 p0 = *(const LAS f32x4*)(Pl + (e0 + k) * 8), p1 = *(const LAS f32x4*)(Pl + (e0 + k) * 8 + 4);
#pragma unroll
                for (int i = 0; i < 4; ++i) { acc[i] += wv[k] * p0[i]; acc[4 + i] += wv[k] * p1[i]; } }
        }
        v4u o0, o1;
        o0.x = pk2(acc[0].x, acc[1].x); o0.y = pk2(acc[2].x, acc[3].x); o0.z = pk2(acc[4].x, acc[5].x); o0.w = pk2(acc[6].x, acc[7].x);
        o1.x = pk2(acc[0].y, acc[1].y); o1.y = pk2(acc[2].y, acc[3].y); o1.z = pk2(acc[4].y, acc[5].y); o1.w = pk2(acc[6].y, acc[7].y);
        *(GAS v4u*)(Bt3 + (size_t)d0 * 2048 + 1024 + 128 * g + c0) = o0; *(GAS v4u*)(Bt3 + (size_t)(d0 + 1) * 2048 + 1024 + 128 * g + c0) = o1;
        LDS_WAIT(); asm volatile("" ::: "memory");
    }
}

__device__ __forceinline__ const float* xrow_in(Frame& F, int m) { return m < MP ? F.in[I_XP] + (size_t)m * DM : F.in[I_XS] + (size_t)(m - MP) * DM; }
__device__ __forceinline__ void x_to_bf16(Frame& F, bf16* XB) {
    const int gw = F.bid * NWAVES + F.wave, NGW = F.G * NWAVES;
    for (int m0 = 4 * gw; m0 < M; m0 += 4 * NGW) {
        f32x4 v[4][4];
#pragma unroll
        for (int k = 0; k < 4; ++k) { const GAS f32x4* xr = (const GAS f32x4*)xrow_in(F, m0 + k) + F.lane;
#pragma unroll
            for (int j = 0; j < 4; ++j) v[k][j] = xr[64 * j]; }
#pragma unroll
        for (int k = 0; k < 4; ++k) { GAS v2u* o = (GAS v2u*)(XB + (size_t)(m0 + k) * DM) + F.lane;
#pragma unroll
            for (int j = 0; j < 4; ++j) o[64 * j] = (v2u){pk2(v[k][j].x, v[k][j].y), pk2(v[k][j].z, v[k][j].w)}; } }
}
__device__ __forceinline__ void ln_rows(Frame& F, const float* V, float* O, const float* g, const float* b, bf16* XB, const float* sbase, const float* slab, int nslab) {
    const int gw = F.bid * NWAVES + F.wave, NGW = F.G * NWAVES;
    f32x4 gv[4], bv[4];
#pragma unroll
    for (int j = 0; j < 4; ++j) { gv[j] = ((const GAS f32x4*)g)[F.lane + 64 * j]; bv[j] = ((const GAS f32x4*)b)[F.lane + 64 * j]; }
    for (int m = MP + gw; m < M; m += NGW) {
        const GAS f32x4* xr = (const GAS f32x4*)(V + (size_t)m * DM) + F.lane; GAS f32x4* orow = (GAS f32x4*)(O + (size_t)m * DM) + F.lane;
        f32x4 v[4]; float s = 0.f;
#pragma unroll
        for (int j = 0; j < 4; ++j) v[j] = xr[64 * j];
        if (m >= MP) { const GAS f32x4* br = (const GAS f32x4*)(sbase + (size_t)(m - MP) * DM) + F.lane;
#pragma unroll
            for (int j = 0; j < 4; ++j) v[j] = br[64 * j] * ALPHA;
            for (int sl = 0; sl < nslab; sl += 4) {
                f32x4 t[4][4];
#pragma unroll
                for (int k = 0; k < 4; ++k) { const GAS f32x4* sr = (const GAS f32x4*)(slab + ((size_t)(sl + k < nslab ? sl + k : sl) * 512 + (m - MP)) * DM) + F.lane;
#pragma unroll
                    for (int j = 0; j < 4; ++j) t[k][j] = sr[64 * j]; }
#pragma unroll
                for (int k = 0; k < 4; ++k) if (sl + k < nslab) {
#pragma unroll
                    for (int j = 0; j < 4; ++j) v[j] += t[k][j]; } } }
#pragma unroll
        for (int j = 0; j < 4; ++j) s += (v[j].x + v[j].y) + (v[j].z + v[j].w);
        const float mean = wave_sum(s, F.lane) * (1.f / DM); float s2 = 0.f;
#pragma unroll
        for (int j = 0; j < 4; ++j) { v[j] = v[j] - mean; s2 += (v[j].x * v[j].x + v[j].y * v[j].y) + (v[j].z * v[j].z + v[j].w * v[j].w); }
        const float rstd = __builtin_amdgcn_rsqf(wave_sum(s2, F.lane) * (1.f / DM) + LN_EPS);
#pragma unroll
        for (int j = 0; j < 4; ++j) { v[j] = v[j] * rstd * gv[j] + bv[j]; orow[64 * j] = v[j]; }
        if (XB) { GAS v2u* o = (GAS v2u*)(XB + (size_t)m * DM) + F.lane;
#pragma unroll
            for (int j = 0; j < 4; ++j) o[64 * j] = (v2u){pk2(v[j].x, v[j].y), pk2(v[j].z, v[j].w)}; }
    }
}

__device__ __forceinline__ void publish_ready(Frame& F, gu32* ctr) {
    VM_WAIT(); __syncthreads();
    if (F.tid == 0) { __builtin_amdgcn_fence(__ATOMIC_RELEASE, "agent"); asm volatile("s_waitcnt vmcnt(0)" ::: "memory"); __hip_atomic_fetch_add((unsigned*)ctr, 1u, __ATOMIC_RELAXED, __HIP_MEMORY_SCOPE_AGENT); }
}
__device__ __forceinline__ float softplusf_acc(float x) { return fmaxf(x, 0.f) + log1pf(__expf(-fabsf(x))); }
__device__ __forceinline__ float expm1_neg(float x) {
    const float p = x * (1.f + x * (0.5f + x * (1.f / 6.f + x * (1.f / 24.f + x * (1.f / 120.f + x * (1.f / 720.f + x * (1.f / 5040.f)))))));
    return x > -0.25f ? p : __expf(x) - 1.f;
}
constexpr int PATCH_STRIDE = 144;

struct ALane {
    float cwD[4], cbD, ba, bx, ck;
    bf16x8 Ba[4][2], Bx[4][2];
};
constexpr int PATCH_BYTES = 5120, ASLOT_OFF = 8 * PATCH_BYTES;
__device__ __forceinline__ void a_setup(Frame& F, int layer, int n, int q, ALane& L) {
    const int c = F.lane & 15, kg = F.lane >> 4, och = 64 * n + 16 * q + c;
    const float* cw = F.in[I_RGCW] + (size_t)layer * 4 * 512 + 64 * n; const float* cb = F.in[I_RGCB] + layer * 512 + 64 * n;
#pragma unroll
    for (int j = 0; j < 4; ++j) L.cwD[j] = cw[j * 512 + 16 * q + c];
    L.cbD = cb[16 * q + c];
    L.ck = 8.0f * softplusf_acc(-F.in[I_LAM][layer * 512 + och]);
    const float* wa = F.in[I_RGWA] + ((size_t)layer * 8 + n) * 4096 + 16 * q + c; const float* wx = F.in[I_RGWX] + ((size_t)layer * 8 + n) * 4096 + 16 * q + c;
    float wav[16], wxv[16], cbv[16];
#pragma unroll
    for (int e = 0; e < 16; ++e) { const int k = (e < 8 ? 8 * kg + e : 32 + 8 * kg + (e - 8)); wav[e] = wa[k * 64]; wxv[e] = wx[k * 64]; cbv[e] = cb[k]; }
#pragma unroll
    for (int j = 0; j < 4; ++j) { float t[16];
#pragma unroll
        for (int e = 0; e < 16; ++e) t[e] = cw[j * 512 + (e < 8 ? 8 * kg + e : 32 + 8 * kg + (e - 8))];
        L.Ba[j][0] = __builtin_bit_cast(bf16x8, (v4u){pk2(wav[0] * t[0], wav[1] * t[1]), pk2(wav[2] * t[2], wav[3] * t[3]), pk2(wav[4] * t[4], wav[5] * t[5]), pk2(wav[6] * t[6], wav[7] * t[7])});
        L.Ba[j][1] = __builtin_bit_cast(bf16x8, (v4u){pk2(wav[8] * t[8], wav[9] * t[9]), pk2(wav[10] * t[10], wav[11] * t[11]), pk2(wav[12] * t[12], wav[13] * t[13]), pk2(wav[14] * t[14], wav[15] * t[15])});
        L.Bx[j][0] = __builtin_bit_cast(bf16x8, (v4u){pk2(wxv[0] * t[0], wxv[1] * t[1]), pk2(wxv[2] * t[2], wxv[3] * t[3]), pk2(wxv[4] * t[4], wxv[5] * t[5]), pk2(wxv[6] * t[6], wxv[7] * t[7])});
        L.Bx[j][1] = __builtin_bit_cast(bf16x8, (v4u){pk2(wxv[8] * t[8], wxv[9] * t[9]), pk2(wxv[10] * t[10], wxv[11] * t[11]), pk2(wxv[12] * t[12], wxv[13] * t[13]), pk2(wxv[14] * t[14], wxv[15] * t[15])}); }
    float sa = 0.f, sx = 0.f;
#pragma unroll
    for (int e = 0; e < 16; ++e) { sa = fmaf(cbv[e], wav[e], sa); sx = fmaf(cbv[e], wxv[e], sx); }
    sa += shfl_idx(sa, F.lane ^ 16); sa += shfl_idx(sa, F.lane ^ 32); sx += shfl_idx(sx, F.lane ^ 16); sx += shfl_idx(sx, F.lane ^ 32);
    L.ba = F.in[I_RGBA][layer * 512 + och] + sa; L.bx = F.in[I_RGBX][layer * 512 + och] + sx;
}
__device__ __forceinline__ void a_block(const ALane& L, const LAS unsigned char* patch, int rowA0, int baseD, int q, int lane, float (&a)[4], float (&bb)[4]) {
    const int c = lane & 15, kg = lane >> 4;
    f32x4 accR = (f32x4){0.f, 0.f, 0.f, 0.f}, accI = (f32x4){0.f, 0.f, 0.f, 0.f};
#pragma unroll
    for (int j = 0; j < 4; ++j) { const LAS unsigned char* rp = patch + (rowA0 + j) * PATCH_STRIDE + 16 * kg;
        const bf16x8 A0 = *(const LAS bf16x8*)rp, A1 = *(const LAS bf16x8*)(rp + 64);
        accR = __builtin_amdgcn_mfma_f32_16x16x32_bf16(A0, L.Ba[j][0], accR, 0, 0, 0); accR = __builtin_amdgcn_mfma_f32_16x16x32_bf16(A1, L.Ba[j][1], accR, 0, 0, 0);
        accI = __builtin_amdgcn_mfma_f32_16x16x32_bf16(A0, L.Bx[j][0], accI, 0, 0, 0); accI = __builtin_amdgcn_mfma_f32_16x16x32_bf16(A1, L.Bx[j][1], accI, 0, 0, 0); }
    float pv[7];
#pragma unroll
    for (int k = 0; k < 7; ++k) pv[k] = bf1(*(const LAS unsigned short*)(patch + (baseD + k) * PATCH_STRIDE + 2 * (16 * q + c)));
#pragma unroll
    for (int r = 0; r < 4; ++r) {
        const float xd = L.cbD + L.cwD[0] * pv[r] + L.cwD[1] * pv[r + 1] + L.cwD[2] * pv[r + 2] + L.cwD[3] * pv[r + 3];
        const float rr = pg8::sigmoidf_fast(accR[r] + L.ba), ii = pg8::sigmoidf_fast(accI[r] + L.bx);
        const float la = -L.ck * rr;
        const float av = __builtin_amdgcn_exp2f(1.44269504089f * la);
        a[r] = av; bb[r] = __builtin_amdgcn_sqrtf(fmaxf(1.f - av * av, 0.f)) * (ii * xd);
    }
}
struct BlkScan { float Ac[4], Bc[4], EA, EB, WA, WB; };
__device__ __forceinline__ void blk_scan(const float (&a)[4], const float (&bb)[4], int lane, BlkScan& S) {
    const int c = lane & 15, g = lane >> 4;
    S.Ac[0] = a[0]; S.Bc[0] = bb[0];
#pragma unroll
    for (int r = 1; r < 4; ++r) { S.Ac[r] = a[r] * S.Ac[r - 1]; S.Bc[r] = a[r] * S.Bc[r - 1] + bb[r]; }
    float IA = S.Ac[3], IB = S.Bc[3];
    { const float pa = shfl_idx(IA, lane - 16), pb = shfl_idx(IB, lane - 16); if (g >= 1) { IB = IA * pb + IB; IA = IA * pa; } }
    { const float pa = shfl_idx(IA, lane - 32), pb = shfl_idx(IB, lane - 32); if (g >= 2) { IB = IA * pb + IB; IA = IA * pa; } }
    S.EA = shfl_idx(IA, lane - 16); S.EB = shfl_idx(IB, lane - 16); if (g == 0) { S.EA = 1.f; S.EB = 0.f; }
    S.WA = shfl_idx(IA, 48 + c); S.WB = shfl_idx(IB, 48 + c);
}
__device__ __forceinline__ void a_prompt_item(Frame& F, int layer, int item, const bf16* Z, bf16* Y) {
    const int b = item >> 5, n = (item >> 2) & 7, q = item & 3, lane = opqv(F.lane), w = F.wave, c = lane & 15, g = lane >> 4, och = 64 * n + 16 * q + c;
    ALane L; a_setup(F, layer, n, q, L);
    LAS unsigned char* patch = F.lds + RING_OFF + w * PATCH_BYTES;
    LAS f32x2* slots = (LAS f32x2*)(F.lds + RING_OFF + ASLOT_OFF);
    const bf16* Zb = Z + (size_t)b * SEQ * ZC; bf16* Yb = Y + (size_t)b * SEQ * YC;
    float hrun = 0.f;
    v4u pf[5];
    auto load_patch = [&](int tb) {
#pragma unroll
        for (int k = 0; k < 5; ++k) { const int ci = lane + 64 * k, pr = ci >> 3, cc = ci & 7, t = tb - 3 + pr;
            pf[k] = (ci < 280 && t >= 0) ? *(const GAS v4u*)(Zb + (size_t)t * ZC + 64 * n + 8 * cc) : (v4u){0u, 0u, 0u, 0u}; }
    };
    load_patch(32 * w);
    for (int it = 0; it < 8; ++it) {
        const int tb = 256 * it + 32 * w;
#pragma unroll
        for (int k = 0; k < 5; ++k) { const int ci = lane + 64 * k, pr = ci >> 3, cc = ci & 7; if (ci < 280) *(LAS v4u*)(patch + pr * PATCH_STRIDE + 16 * cc) = pf[k]; }
        if (it < 7) load_patch(tb + 256);
        unsigned short gav[8];
#pragma unroll
        for (int r = 0; r < 8; ++r) gav[r] = ((const GAS unsigned short*)Zb)[(unsigned)((tb + 16 * (r >> 2) + 4 * g + (r & 3)) * ZC + 512 + och)];
        asm volatile("" ::: "memory");
        float a0[4], b0[4], a1[4], b1[4];
        a_block(L, patch, lane & 15, 4 * g, q, lane, a0, b0);
        a_block(L, patch, 16 + (lane & 15), 16 + 4 * g, q, lane, a1, b1);
        BlkScan S0, S1; blk_scan(a0, b0, lane, S0); blk_scan(a1, b1, lane, S1);
        if (lane < 16) slots[((it & 1) * 8 + w) * 16 + c] = (f32x2){S0.WA * S1.WA, S1.WA * S0.WB + S1.WB};
        __syncthreads();
        float hin = hrun, hw = 0.f;
#pragma unroll
        for (int ww = 0; ww < 8; ++ww) { const f32x2 s = slots[((it & 1) * 8 + ww) * 16 + c]; if (ww == w) hw = hin; hin = s.x * hin + s.y; }
        hrun = hin;
        const float hg0 = S0.EA * hw + S0.EB, hw1 = S0.WA * hw + S0.WB, hg1 = S1.EA * hw1 + S1.EB;
#pragma unroll
        for (int r = 0; r < 4; ++r) { const float h = S0.Ac[r] * hg0 + S0.Bc[r];
            ((GAS unsigned short*)Yb)[(unsigned)((tb + 4 * g + r) * YC + och)] = f2bf(h * bf1(gav[r])); }
#pragma unroll
        for (int r = 0; r < 4; ++r) { const float h = S1.Ac[r] * hg1 + S1.Bc[r];
            ((GAS unsigned short*)Yb)[(unsigned)((tb + 16 + 4 * g + r) * YC + och)] = f2bf(h * bf1(gav[4 + r]));
            if (r == 3 && it == 7 && w == 7 && g == 3) F.out[O_PH + (size_t)(layer * 8 + b) * 512 + och] = h; }
    }
}
__device__ __forceinline__ void a_sample_task(Frame& F, int layer, int task, const bf16* Z, bf16* Y) {
    const int blk = task >> 5, n = (task >> 2) & 7, q = task & 3, lane = opqv(F.lane), c = lane & 15, g = lane >> 4, och = 64 * n + 16 * q + c, s0 = 4 * blk;
    ALane L; a_setup(F, layer, n, q, L);
    LAS unsigned char* patch = F.lds + RING_OFF + F.wave * PATCH_BYTES;
#pragma unroll
    for (int k = 0; k < 4; ++k) { const int ci = lane + 64 * k; if (ci < 224) { const int pr = ci >> 3, cc = ci & 7, sq = pr / 7, tau = pr - 7 * sq - 3, seq = s0 + sq; v4u v;
            if (tau < 0) { const GAS f32x4* sp = (const GAS f32x4*)(F.in[I_SRGC] + ((size_t)(layer * 128 + seq) * 3 + (tau + 3)) * 512 + 64 * n + 8 * cc); const f32x4 f0 = sp[0], f1 = sp[1];
                v = (v4u){pk2(f0.x, f0.y), pk2(f0.z, f0.w), pk2(f1.x, f1.y), pk2(f1.z, f1.w)}; }
            else v = *(const GAS v4u*)(Z + (size_t)(MP + 4 * seq + tau) * ZC + 64 * n + 8 * cc);
            *(LAS v4u*)(patch + pr * PATCH_STRIDE + 16 * cc) = v; } }
    asm volatile("" ::: "memory");
    float a[4], bb[4];
    a_block(L, patch, 7 * ((lane & 15) >> 2) + (lane & 3), 7 * g, q, lane, a, bb);
    const int seq = s0 + g;
    float h = F.in[I_SH][(size_t)(layer * 128 + seq) * 512 + och];
#pragma unroll
    for (int r = 0; r < 4; ++r) { h = a[r] * h + bb[r]; const size_t row = (size_t)(MP + 4 * seq + r);
        *(GAS unsigned short*)(Y + row * YC + och) = f2bf(h * bf1(*(const GAS unsigned short*)(Z + row * ZC + 512 + och))); }
    F.out[O_SH + (size_t)(layer * 128 + seq) * 512 + och] = h;
}

__device__ __forceinline__ void ln_silu_row(const LAS float* xr, const float* g, const float* b, bf16* dst, int lane) {
    const f32x4 v0 = *(const LAS f32x4*)(xr + 4 * lane), v1 = *(const LAS f32x4*)(xr + 256 + 4 * lane);
    const float s = (v0.x + v0.y) + (v0.z + v0.w) + (v1.x + v1.y) + (v1.z + v1.w);
    const float mean = wave_sum(s, lane) * (1.f / 512.f);
    const f32x4 d0 = v0 - mean, d1 = v1 - mean;
    const float s2 = (d0.x * d0.x + d0.y * d0.y) + (d0.z * d0.z + d0.w * d0.w) + (d1.x * d1.x + d1.y * d1.y) + (d1.z * d1.z + d1.w * d1.w);
    const float rstd = __builtin_amdgcn_rsqf(wave_sum(s2, lane) * (1.f / 512.f) + LN_EPS);
    const f32x4 g0 = *(const GAS f32x4*)(g + 4 * lane), g1 = *(const GAS f32x4*)(g + 256 + 4 * lane), b0 = *(const GAS f32x4*)(b + 4 * lane), b1 = *(const GAS f32x4*)(b + 256 + 4 * lane);
    f32x4 y0 = d0 * rstd * g0 + b0, y1 = d1 * rstd * g1 + b1;
#pragma unroll
    for (int i = 0; i < 4; ++i) { y0[i] = y0[i] * pg8::sigmoidf_fast(y0[i]); y1[i] = y1[i] * pg8::sigmoidf_fast(y1[i]); }
    *(GAS v2u*)(dst + 4 * lane) = (v2u){pk2(y0.x, y0.y), pk2(y0.z, y0.w)}; *(GAS v2u*)(dst + 256 + 4 * lane) = (v2u){pk2(y1.x, y1.y), pk2(y1.z, y1.w)};
}
__device__ __forceinline__ void ln_silu_rows4(const LAS float* xr, int rstride, const float* g, const float* b, bf16* dst, size_t dstride, int lane) {
    f32x4 v0[4], v1[4]; float s[4], s2[4];
#pragma unroll
    for (int k = 0; k < 4; ++k) { v0[k] = *(const LAS f32x4*)(xr + k * rstride + 4 * lane); v1[k] = *(const LAS f32x4*)(xr + k * rstride + 256 + 4 * lane);
        s[k] = (v0[k].x + v0[k].y) + (v0[k].z + v0[k].w) + (v1[k].x + v1[k].y) + (v1[k].z + v1[k].w); }
#pragma unroll
    for (int o = 1; o < 64; o <<= 1) {
#pragma unroll
        for (int k = 0; k < 4; ++k) s[k] += shfl_idx(s[k], lane ^ o); }
#pragma unroll
    for (int k = 0; k < 4; ++k) { const float mean = s[k] * (1.f / 512.f); v0[k] = v0[k] - mean; v1[k] = v1[k] - mean;
        s2[k] = (v0[k].x * v0[k].x + v0[k].y * v0[k].y) + (v0[k].z * v0[k].z + v0[k].w * v0[k].w) + (v1[k].x * v1[k].x + v1[k].y * v1[k].y) + (v1[k].z * v1[k].z + v1[k].w * v1[k].w); }
#pragma unroll
    for (int o = 1; o < 64; o <<= 1) {
#pragma unroll
        for (int k = 0; k < 4; ++k) s2[k] += shfl_idx(s2[k], lane ^ o); }
    const f32x4 g0 = *(const GAS f32x4*)(g + 4 * lane), g1 = *(const GAS f32x4*)(g + 256 + 4 * lane), b0 = *(const GAS f32x4*)(b + 4 * lane), b1 = *(const GAS f32x4*)(b + 256 + 4 * lane);
#pragma unroll
    for (int k = 0; k < 4; ++k) { const float rstd = __builtin_amdgcn_rsqf(s2[k] * (1.f / 512.f) + LN_EPS);
        f32x4 y0 = v0[k] * rstd * g0 + b0, y1 = v1[k] * rstd * g1 + b1;
#pragma unroll
        for (int i = 0; i < 4; ++i) { y0[i] = y0[i] * pg8::sigmoidf_fast(y0[i]); y1[i] = y1[i] * pg8::sigmoidf_fast(y1[i]); }
        bf16* d = dst + (size_t)k * dstride;
        *(GAS v2u*)(d + 4 * lane) = (v2u){pk2(y0.x, y0.y), pk2(y0.z, y0.w)}; *(GAS v2u*)(d + 256 + 4 * lane) = (v2u){pk2(y1.x, y1.y), pk2(y1.z, y1.w)}; }
}
__device__ __forceinline__ void b_prompt_item(Frame& F, int layer, int item, const bf16* Z, bf16* Y) {
    const int tidl = opqv(F.tid), b = item >> 5, t0 = 64 * (item & 31), p = tidl & 255, hh = tidl >> 8, ts = t0 + 32 * hh;
    const GAS unsigned* Zu = (const GAS unsigned*)(Z + (size_t)b * SEQ * ZC) + 512 + p;
    unsigned raw[62];
#pragma unroll
    for (int i = 0; i < 62; ++i) { const int t = ts - 30 + i; raw[i] = t >= 0 ? Zu[(size_t)t * (ZC / 2)] : 0u; }
    const float* cw = F.in[I_CFW] + (size_t)layer * 31 * 512 + 2 * p;
    f32x2 wj[31];
#pragma unroll
    for (int j = 0; j < 31; ++j) wj[j] = *(const GAS f32x2*)(cw + j * 512);
    const f32x2 bias = *(const GAS f32x2*)(F.in[I_CFB] + layer * 512 + 2 * p);
    f32x2 in[62];
#pragma unroll
    for (int i = 0; i < 62; ++i) in[i] = (f32x2){bflo(raw[i]), bfhi(raw[i])};
    LAS float* obuf = (LAS float*)(F.lds + RING_OFF);
#pragma unroll
    for (int i = 0; i < 32; ++i) { f32x2 o = bias;
#pragma unroll
        for (int j = 0; j < 31; ++j) o += wj[j] * in[i + j];
        *(LAS f32x2*)(obuf + (32 * hh + i) * 512 + 2 * p) = o; }
    __syncthreads();
    const float* lg = F.in[I_CFG] + layer * 512; const float* lb = F.in[I_CFBB] + layer * 512;
#pragma unroll 1
    for (int r = 8 * F.wave; r < 8 * F.wave + 8; r += 4) ln_silu_rows4(obuf + r * 512, 512, lg, lb, Y + (size_t)(b * SEQ + t0 + r) * YC + 512, YC, F.lane);
}
__device__ __forceinline__ void cd_prompt_item(Frame& F, int layer, int item, const bf16* Z, bf16* Y) {
    const int tidl = opqv(F.tid), b = item >> 5, t0 = 64 * (item & 31), p = tidl & 255, hh = tidl >> 8;
    const bf16* Zb = Z + (size_t)b * SEQ * ZC;
    LAS unsigned* cbuf = (LAS unsigned*)(F.lds + RING_OFF);
    { v4u tmp[10];
#pragma unroll
      for (int k = 0; k < 10; ++k) { const int ci = tidl + 512 * k, pr = ci >> 6, cc = ci & 63, t = t0 - 15 + pr;
          tmp[k] = (ci < 79 * 64 && t >= 0) ? *(const GAS v4u*)(Zb + (size_t)t * ZC + 1536 + 8 * cc) : (v4u){0u, 0u, 0u, 0u}; }
#pragma unroll
      for (int k = 0; k < 10; ++k) { const int ci = tidl + 512 * k, pr = ci >> 6, cc = ci & 63; if (ci < 79 * 64) *(LAS v4u*)(cbuf + pr * 256 + 4 * cc) = tmp[k]; } }
    const int ts = t0 + 32 * hh;
    unsigned uu[34], dd[32];
#pragma unroll
    for (int i = 0; i < 34; ++i) { const int t = ts - 2 + i; uu[i] = t >= 0 ? ((const GAS unsigned*)(Zb + (size_t)t * ZC))[1280 + p] : 0u; }
#pragma unroll
    for (int i = 0; i < 32; ++i) dd[i] = ((const GAS unsigned*)(Zb + (size_t)(ts + i) * ZC))[1024 + p];
    const f32x2 w0 = ((const GAS f32x2*)(F.in[I_SCW] + (size_t)(layer * 3 + 0) * 512))[p], w1 = ((const GAS f32x2*)(F.in[I_SCW] + (size_t)(layer * 3 + 1) * 512))[p],
                w2 = ((const GAS f32x2*)(F.in[I_SCW] + (size_t)(layer * 3 + 2) * 512))[p];
    __syncthreads();
    const int w = 2 << (p >> 6), rr0 = 15 + 32 * hh;
    f32x2 s = (f32x2){0.f, 0.f};
    for (int j = 0; j < w; ++j) { const unsigned v = cbuf[(rr0 - j) * 256 + p]; s += (f32x2){bflo(v), bfhi(v)}; }
    GAS unsigned* Yu = (GAS unsigned*)(Y + (size_t)(b * SEQ + ts) * YC) + p;
#pragma unroll
    for (int i = 0; i < 32; ++i) { const int t = ts + i, rr = rr0 + i;
        const unsigned cur = cbuf[rr * 256 + p]; const f32x2 cf = (f32x2){bflo(cur), bfhi(cur)};
        if (i > 0) { const unsigned old = cbuf[(rr - w) * 256 + p]; s += cf - (f32x2){bflo(old), bfhi(old)}; }
        const float ic = __builtin_amdgcn_rcpf((float)(t + 1 < w ? t + 1 : w));
        const f32x2 mm = s * ic - cf;
        Yu[(size_t)i * 1024 + 512] = pk2(mm.x, mm.y);
        const f32x2 cv = w0 * (f32x2){bflo(uu[i]), bfhi(uu[i])} + w1 * (f32x2){bflo(uu[i + 1]), bfhi(uu[i + 1])} + w2 * (f32x2){bflo(uu[i + 2]), bfhi(uu[i + 2])};
        const f32x2 yd = (f32x2){bflo(dd[i]), bfhi(dd[i])} * cv;
        Yu[(size_t)i * 1024 + 768] = pk2(yd.x, yd.y); }
}
__device__ __forceinline__ void s_sample_item(Frame& F, int layer, int s, const bf16* Z, bf16* Y) {
    const int ch = opqv(F.tid); const size_t ls = (size_t)layer * 128 + s;
    const bf16* Zr = Z + (size_t)(MP + 4 * s) * ZC; bf16* Yr = Y + (size_t)(MP + 4 * s) * YC;
    LAS float* obuf = (LAS float*)(F.lds + RING_OFF);
    float in[34], wv[31], pb[19], u[6], dbv[4];
#pragma unroll
    for (int j = 0; j < 30; ++j) in[j] = (F.in[I_SCF] + (ls * 30 + j) * 512)[ch];
#pragma unroll
    for (int j = 0; j < 15; ++j) pb[j] = (F.in[I_SPOOL] + (ls * 15 + j) * 512)[ch];
    u[0] = (F.in[I_SSC] + (ls * 2 + 0) * 512)[ch]; u[1] = (F.in[I_SSC] + (ls * 2 + 1) * 512)[ch];
#pragma unroll
    for (int r = 0; r < 4; ++r) { in[30 + r] = bf1((Zr + (size_t)r * ZC + 1024)[ch]); pb[15 + r] = bf1((Zr + (size_t)r * ZC + 1536)[ch]); u[2 + r] = bf1((Zr + (size_t)r * ZC + 2560)[ch]); dbv[r] = bf1((Zr + (size_t)r * ZC + 2048)[ch]); }
#pragma unroll
    for (int j = 0; j < 31; ++j) wv[j] = (F.in[I_CFW] + ((size_t)layer * 31 + j) * 512)[ch];
    const float bias = (F.in[I_CFB] + layer * 512)[ch];
    const float w0 = (F.in[I_SCW] + (size_t)(layer * 3 + 0) * 512)[ch], w1 = (F.in[I_SCW] + (size_t)(layer * 3 + 1) * 512)[ch], w2 = (F.in[I_SCW] + (size_t)(layer * 3 + 2) * 512)[ch];
    asm volatile("" ::: "memory");
#pragma unroll
    for (int j = 0; j < 26; ++j) (F.out + O_SCF + (ls * 30 + j) * 512)[ch] = in[j + 4];
#pragma unroll
    for (int r = 0; r < 4; ++r) { float o = bias;
#pragma unroll
        for (int j = 0; j < 31; ++j) o += wv[j] * in[r + j];
        obuf[r * 512 + ch] = o; }
#pragma unroll
    for (int j = 0; j < 11; ++j) (F.out + O_SPOOL + (ls * 15 + j) * 512)[ch] = pb[j + 4];
    const int gsel = ch >> 7;
#pragma unroll
    for (int r = 0; r < 4; ++r) { const int k = 15 + r;
        const float s2 = pb[k] + pb[k - 1], s4 = s2 + pb[k - 2] + pb[k - 3], s8 = s4 + (pb[k - 4] + pb[k - 5]) + (pb[k - 6] + pb[k - 7]);
        float s16 = s8;
#pragma unroll
        for (int j = 8; j < 16; ++j) s16 += pb[k - j];
        const float mv = (gsel == 0 ? s2 * 0.5f : gsel == 1 ? s4 * 0.25f : gsel == 2 ? s8 * 0.125f : s16 * 0.0625f) - pb[k];
        (Yr + (size_t)r * YC + 1024)[ch] = f2bf(mv); }
#pragma unroll
    for (int r = 0; r < 4; ++r) (Yr + (size_t)r * YC + 1536)[ch] = f2bf(dbv[r] * (w0 * u[r] + w1 * u[r + 1] + w2 * u[r + 2]));
    __syncthreads();
    if (F.wave < 4) ln_silu_row(obuf + F.wave * 512, F.in[I_CFG] + layer * 512, F.in[I_CFBB] + layer * 512, Yr + (size_t)F.wave * YC + 512, F.lane);
}

struct Args { const float* in[31]; float* out; unsigned char* ws; int ph_lo, ph_hi; };
__global__ void __launch_bounds__(NWAVES * 64, 2) hybrid_fwd(Args args) {
    extern __shared__ __attribute__((aligned(16))) unsigned char lds[];
    Frame F;
    F.lds = (LAS unsigned char*)lds;
    F.MISC = (volatile LAS unsigned*)(F.lds + MISC_OFF);
    const int wave0 = __builtin_amdgcn_readfirstlane((int)threadIdx.x >> 6);
    F.lane = lane_now(); F.wave = wave0; F.tid = F.wave * 64 + F.lane;
    F.G = gridDim.x; F.bid = blockIdx.x;
    F.ws = args.ws; F.out = args.out; F.ctl = (gu32*)(args.ws + WS_CTL);
    F.in = args.in;
    for (int u = F.tid; u < (LDS_BYTES - LDSCTL_OFF) / 4; u += NWAVES * 64) ((LAS unsigned*)(F.lds + LDSCTL_OFF))[u] = 0u;
    __syncthreads();
    XcdBarrier bar; bar.bar = (unsigned*)(F.ctl + CW_BAR); bar.x = 0; bar.st = nullptr;
    if (!MK_SPLIT) bar = xcd_barrier_post((unsigned*)(F.ctl + CW_BAR), F.MISC + 8);
    const int lo = args.ph_lo, hi = args.ph_hi;
#define IN(k) (lo <= (k) && (k) < hi)
#define REFRESH() do { F.lane = lane_now(); F.wave = opqs(wave0); F.tid = F.wave * 64 + F.lane; F.bid = opqs((int)blockIdx.x); } while (0)
#define SEAM(k) do { if (IN(k) && IN((k) + 1)) xcd_barrier(bar); } while (0)
    bf16* WA = (bf16*)(F.ws + WS_WA); bf16* XB = (bf16*)(F.ws + WS_XB); bf16* Y = (bf16*)(F.ws + WS_Y); bf16* Zm = (bf16*)(F.ws + WS_ZG); _Float16* Gb = (_Float16*)(F.ws + WS_ZG);
    bf16* Hb = (bf16*)(F.ws + WS_ZG); bf16* Bt3 = (bf16*)(F.ws + WS_BT3); bf16* Bt4 = (bf16*)(F.ws + WS_BT4); bf16* Bt5 = (bf16*)(F.ws + WS_BT5); bf16* Bt6 = (bf16*)(F.ws + WS_BT6);

    if (IN(0)) { REFRESH(); convert_matrix<RM_WIN>(F, F.in[I_WIN], DM, INC, WA, DM, 0, 0, F.bid * NWAVES + F.wave, F.G * NWAVES, 0, 0, F.G == 256 ? 128 : 0); REFRESH(); x_to_bf16(F, XB); }
    SEAM(0);

    const bool fast = F.G == 256;
    for (int l = 0; l < 2; ++l) {
        const int pb = 1 + 9 * l;
        if (IN(pb + 0)) for (int rep = 0; rep < NREP(0); ++rep) { if (rep) xcd_barrier(bar);
            if (fast && l == 1 && rep == 0) { REFRESH();
                ln_rows(F, F.out, F.out, F.in[I_LN2G], F.in[I_LN2B], XB, F.out + (size_t)MP * DM, (const float*)(F.ws + WS_SLAB), 11); publish_ready(F, F.ctl + CW_RDY + 64 * 1); }
            pg8::Gemm g{XB, WA, DM, DM}; pg8::UnitOrder S; S.init(pg8::SK_PLAIN, 4096, DM, F.G, F.bid, 0); pg8::EpiMix E{Zm, F.out, l};
            if (fast && l == 1) { S.ready = (const unsigned*)(F.ctl + CW_RDY + 64 * 1); S.need = (unsigned)F.G; }
            pg8::gemm_phase<pg8::EpiMix, pg8::UnitOrder, true>(F.lds + RING_OFF, g, S, E, wave0);
            if (F.G == 256 && F.bid >= 32) {
                REFRESH(); const int gw = (F.bid - 32) * NWAVES + F.wave, NGW = 224 * NWAVES; const float* wbr = F.in[I_WBR] + (size_t)l * 4 * 512 * 1024;
                convert_matrix<RM_ID>(F, wbr, 512, 1024, Bt3, 2048, 0, 0, gw, NGW, 0);
                convert_matrix<RM_ID>(F, wbr + (size_t)512 * 1024, 512, 1024, Bt3, 2048, 512, 0, gw, NGW, 256);
                convert_matrix<RM_ID>(F, wbr + (size_t)3 * 512 * 1024, 512, 1024, Bt3, 2048, 1536, 0, gw, NGW, 512);
                convert_matrix<RM_ID>(F, F.in[I_WOUT] + (size_t)l * DM * DM, DM, DM, Bt4, DM, 0, 0, gw, NGW, 768);
                REFRESH(); compose_pool(F, l, Bt3, gw, NGW, 1280);
                REFRESH(); convert_matrix<RM_WIN>(F, F.in[I_WIN] + (size_t)l * DM * INC, DM, INC, WA, DM, 0, 0, gw, NGW, 0, 128, 128); } }
        SEAM(pb + 0);
        if (IN(pb + 1)) for (int rep = 0; rep < NREP(1); ++rep) { if (rep) xcd_barrier(bar);
            __syncthreads(); REFRESH();
            for (int r2 = 0; r2 < NREP2(0); ++r2) for (int it = F.bid; it < 256; it += F.G) { a_prompt_item(F, l, it, Zm, Y); __syncthreads(); }
            REFRESH();
            for (int r2 = 0; r2 < NREP2(1); ++r2) for (int it = (F.bid + 128) % F.G; it < 128; it += F.G) a_sample_task(F, l, 8 * it + F.wave, Zm, Y);
            __syncthreads(); REFRESH();
            const bool rebal = F.G == 256, gemm_wg = rebal && F.bid >= 128 && F.bid < 160;
            for (int r2 = 0; r2 < NREP2(2); ++r2) { if (!gemm_wg) for (int it = F.bid; it < 256; it += F.G) { b_prompt_item(F, l, it, Zm, Y); __syncthreads(); }
                if (rebal && F.bid >= 160 && F.bid < 192) { b_prompt_item(F, l, F.bid - 32, Zm, Y); __syncthreads(); } }
            REFRESH();
            for (int r2 = 0; r2 < NREP2(3); ++r2) { if (!gemm_wg) for (int it = F.bid; it < 256; it += F.G) { cd_prompt_item(F, l, it, Zm, Y); __syncthreads(); }
                if (rebal && F.bid >= 192 && F.bid < 224) { cd_prompt_item(F, l, F.bid - 64, Zm, Y); __syncthreads(); } }
            REFRESH();
            for (int r2 = 0; r2 < NREP2(4); ++r2) for (int it = F.bid; it < 128; it += F.G) { s_sample_item(F, l, it, Zm, Y); __syncthreads(); }
            if (F.G == 256 && F.bid >= 128 && F.bid < 160) {
                pg8::Gemm g{XB, WA + (size_t)4096 * DM, DM, DM}; pg8::UnitOrder S; S.init(pg8::SK_PLAIN, 4096, DM, 32, F.bid - 128, 0, false, true); pg8::EpiGate E{Gb};
                pg8::gemm_phase<pg8::EpiGate, pg8::UnitOrder, true>(F.lds + RING_OFF, g, S, E, wave0); }
            REFRESH();
            const float* wbr = F.in[I_WBR] + (size_t)l * 4 * 512 * 1024;
            if (F.G != 256) { const int gw = F.bid * NWAVES + F.wave, NGW = F.G * NWAVES;
                convert_matrix<RM_ID>(F, wbr, 512, 1024, Bt3, 2048, 0, 0, gw, NGW); convert_matrix<RM_ID>(F, wbr + (size_t)512 * 1024, 512, 1024, Bt3, 2048, 512, 0, gw, NGW);
                convert_matrix<RM_ID>(F, wbr + (size_t)3 * 512 * 1024, 512, 1024, Bt3, 2048, 1536, 0, gw, NGW); convert_matrix<RM_ID>(F, F.in[I_WOUT] + (size_t)l * DM * DM, DM, DM, Bt4, DM, 0, 0, gw, NGW);
                REFRESH(); compose_pool(F, l, Bt3, gw, NGW); }
        }
        SEAM(pb + 1);
        if (IN(pb + 2)) for (int rep = 0; rep < NREP(2); ++rep) { if (rep) xcd_barrier(bar); pg8::Gemm g{XB, WA + (size_t)4096 * DM, DM, DM}; pg8::UnitOrder S; S.init(pg8::SK_PLAIN, 4096, DM, F.G, F.bid, 0, true, F.G != 256); pg8::EpiGate E{Gb};
            pg8::gemm_phase<pg8::EpiGate, pg8::UnitOrder, true>(F.lds + RING_OFF, g, S, E, wave0); }
        SEAM(pb + 2);
        if (IN(pb + 3)) for (int rep = 0; rep < NREP(3); ++rep) { if (rep) xcd_barrier(bar); pg8::Gemm g{Y, Bt3, 2048, 2048}; pg8::UnitOrder S; S.init(pg8::SK_P3, DM, 2048, F.G, F.bid, 0); pg8::EpiMerge E{Gb, XB, (bf16*)(F.ws + WS_MB4S)};
            pg8::gemm_phase<pg8::EpiMerge, pg8::UnitOrder, true>(F.lds + RING_OFF, g, S, E, wave0);
            if (F.G == 256 && F.bid >= 32 && rep + 1 == NREP(3)) {
                REFRESH(); const int gw = (F.bid - 32) * NWAVES + F.wave, NGW = 224 * NWAVES;
                convert_matrix<RM_GU>(F, F.in[I_WG] + (size_t)l * DM * FF, DM, FF, Bt5, DM, 0, 0, gw, NGW, 0);
                convert_matrix<RM_GU>(F, F.in[I_WU] + (size_t)l * DM * FF, DM, FF, Bt5, DM, 0, 128, gw, NGW, 1408); } }
        SEAM(pb + 3);
        if (IN(pb + 4)) for (int rep = 0; rep < 1; ++rep) { pg8::Gemm g{XB, Bt4, DM, DM}; pg8::UnitOrder S; S.init(pg8::SK_P4, DM, DM, F.G, F.bid, (long)(WS_MB4S - WS_XB));
            pg8::EpiRes E{l == 0 ? F.in[I_XP] : F.out, F.out, XB, F.in[I_LN1G] + l * DM, F.in[I_LN1B] + l * DM, (float*)(F.ws + WS_SLAB),
                          pg8::PanelStats{(unsigned*)(F.ws + WS_XCH + (size_t)(2 * l) * 512 * 1024), (unsigned*)(F.ctl + CW_SEAM + (2 * l) * SEAM_BANK)}, F.lds + XLDS_OFF, wave0};
            pg8::gemm_phase<pg8::EpiRes, pg8::UnitOrder, true>(F.lds + RING_OFF, g, S, E, wave0);
}
        SEAM(pb + 4);
        if (IN(pb + 5) && !fast) for (int rep = 0; rep < NREP(5); ++rep) { if (rep) xcd_barrier(bar);
            REFRESH();
            ln_rows(F, F.out, rep + 1 < NREP(5) ? (float*)(F.ws + WS_Y) : F.out, F.in[I_LN1G] + l * DM, F.in[I_LN1B] + l * DM, rep + 1 < NREP(5) ? nullptr : XB, l == 0 ? F.in[I_XS] : F.out + (size_t)MP * DM, (const float*)(F.ws + WS_SLAB), 16);
            REFRESH();
            if (F.G != 256) { const int gw = F.bid * NWAVES + F.wave, NGW = F.G * NWAVES;
                convert_matrix<RM_GU>(F, F.in[I_WG] + (size_t)l * DM * FF, DM, FF, Bt5, DM, 0, 0, gw, NGW); convert_matrix<RM_GU>(F, F.in[I_WU] + (size_t)l * DM * FF, DM, FF, Bt5, DM, 0, 128, gw, NGW);
                convert_matrix<RM_ID>(F, F.in[I_WD] + (size_t)l * FF * DM, FF, DM, Bt6, FF, 0, 0, gw, NGW); }
        }
        if (!fast) SEAM(pb + 5);
        if (IN(pb + 6)) for (int rep = 0; rep < NREP(6); ++rep) { if (rep) xcd_barrier(bar);
            if (fast && rep == 0) { REFRESH();
                ln_rows(F, F.out, F.out, F.in[I_LN1G] + l * DM, F.in[I_LN1B] + l * DM, XB, l == 0 ? F.in[I_XS] : F.out + (size_t)MP * DM, (const float*)(F.ws + WS_SLAB), 16); publish_ready(F, F.ctl + CW_RDY + 64 * (2 * l)); }
            pg8::Gemm g{XB, Bt5, DM, DM}; pg8::UnitOrder S; S.init(pg8::SK_PLAIN, 2 * FF, DM, F.G, F.bid, 0); pg8::EpiSwi E{Hb};
            if (fast) { S.ready = (const unsigned*)(F.ctl + CW_RDY + 64 * (2 * l)); S.need = (unsigned)F.G; }
            pg8::gemm_phase<pg8::EpiSwi, pg8::UnitOrder, true>(F.lds + RING_OFF, g, S, E, wave0);
            if (F.G == 256 && F.bid >= 172 && rep + 1 == NREP(6)) {
                REFRESH(); const int gw = (F.bid - 172) * NWAVES + F.wave, NGW = 84 * NWAVES;
                convert_matrix<RM_ID>(F, F.in[I_WD] + (size_t)l * FF * DM, FF, DM, Bt6, FF, 0, 0, gw, NGW, 0);
            } }
        SEAM(pb + 6);
        if (IN(pb + 7)) for (int rep = 0; rep < 1; ++rep) { pg8::Gemm g{Hb, Bt6, FF, FF}; pg8::UnitOrder S; S.init(pg8::SK_P6, DM, FF, F.G, F.bid, 0); pg8::EpiRes E{F.out, F.out, l == 0 ? XB : nullptr, F.in[I_LN2G] + l * DM, F.in[I_LN2B] + l * DM, (float*)(F.ws + WS_SLAB),
                          pg8::PanelStats{(unsigned*)(F.ws + WS_XCH + (size_t)(2 * l + 1) * 512 * 1024), (unsigned*)(F.ctl + CW_SEAM + (2 * l + 1) * SEAM_BANK)}, F.lds + XLDS_OFF, wave0};
            pg8::gemm_phase<pg8::EpiRes, pg8::UnitOrder, true>(F.lds + RING_OFF, g, S, E, wave0);
            if (F.G == 256 && F.bid >= 88 && l == 0) {
                REFRESH(); convert_matrix<RM_WIN>(F, F.in[I_WIN] + (size_t)DM * INC, DM, INC, WA, DM, 0, 0, (F.bid - 88) * NWAVES + F.wave, 168 * NWAVES, 0, 0, 128); } }
        SEAM(pb + 7);
        if (IN(pb + 8) && !(fast && l == 0)) for (int rep = 0; rep < NREP(8); ++rep) { if (rep) xcd_barrier(bar);
            REFRESH();
            ln_rows(F, F.out, rep + 1 < NREP(8) ? (float*)(F.ws + WS_Y) : F.out, F.in[I_LN2G] + l * DM, F.in[I_LN2B] + l * DM, (l == 0 && rep + 1 == NREP(8)) ? XB : nullptr, F.out + (size_t)MP * DM, (const float*)(F.ws + WS_SLAB), 11);
            REFRESH();
            if (l == 0 && F.G != 256) convert_matrix<RM_WIN>(F, F.in[I_WIN] + (size_t)DM * INC, DM, INC, WA, DM, 0, 0, F.bid * NWAVES + F.wave, F.G * NWAVES);
        }
        if (l == 0 && !fast) SEAM(pb + 8);
    }
#undef IN
#undef SEAM
#undef REFRESH
}

extern "C" void kernel_launch(void* const* d_in, const int* in_sizes, int n_in, void* d_out, int out_size, void* d_ws, size_t ws_size, hipStream_t stream) {
    static int grid = 0;
    if (grid == 0) {
        if (n_in != 31 || out_size != (int)O_END || ws_size < WS_END) { fprintf(stderr, "kernel_launch: unexpected sizes n_in %d out %d ws %zu\n", n_in, out_size, ws_size); grid = -1; return; }
        int dev = 0, cus = 0, per_cu = 0;
        if (hipGetDevice(&dev) != hipSuccess || hipDeviceGetAttribute(&cus, hipDeviceAttributeMultiprocessorCount, dev) != hipSuccess) { grid = -1; return; }
        if (hipFuncSetAttribute((const void*)hybrid_fwd, hipFuncAttributeMaxDynamicSharedMemorySize, LDS_BYTES) != hipSuccess) { fprintf(stderr, "kernel_launch: hipFuncSetAttribute failed\n"); grid = -1; return; }
        if (hipOccupancyMaxActiveBlocksPerMultiprocessor(&per_cu, (const void*)hybrid_fwd, NWAVES * 64, LDS_BYTES) != hipSuccess || per_cu < 1)
            fprintf(stderr, "kernel_launch: occupancy query reports %d workgroups per CU\n", per_cu);
        (void)hipGetLastError();
        grid = cus;
    }
    if (grid < 0) return;
    if (hipMemsetAsync((char*)d_ws + WS_CTL, 0, CTL_ZERO_BYTES, stream) != hipSuccess) { fprintf(stderr, "kernel_launch: memset failed\n"); return; }
    Args a{};
    for (int i = 0; i < 31; ++i) a.in[i] = (const float*)d_in[i];
    a.out = (float*)d_out; a.ws = (unsigned char*)d_ws;
#if MK_SPLIT
    for (int ph = 0; ph < NPHASE; ++ph) { a.ph_lo = ph; a.ph_hi = ph + 1; hipLaunchKernelGGL(hybrid_fwd, dim3(grid), dim3(NWAVES * 64), LDS_BYTES, stream, a); }
#else
    a.ph_lo = 0; a.ph_hi = NPHASE;
    hipLaunchKernelGGL(hybrid_fwd, dim3(grid), dim3(NWAVES * 64), LDS_BYTES, stream, a);
#endif
}
```

```cpp
#include <hip/hip_runtime.h>
#include <cstdio>
#include <cstdint>

#ifndef PROBE_REP
#define PROBE_REP 0
#endif
#define NREP(k) (1 + ((PROBE_REP >> (k)) & 1))
#ifndef PROBE2
#define PROBE2 0
#endif
#define NREP2(j) (1 + ((PROBE2 >> (j)) & 1))
#ifndef MK_SPLIT
#define MK_SPLIT 0
#endif

constexpr int DM = 1024, WMIX = 512, NPB = 8, SEQ = 2048, NSB = 128, DSEQ = 4;
constexpr int MP = NPB * SEQ, MS = NSB * DSEQ, M = MP + MS;
constexpr int FF = 2816, INC = 8192, ZC = 3072, YC = 2048, GC = 4096;
constexpr float LN_EPS = 1e-5f, ALPHA = 1.41421356237f;
constexpr size_t O_Y = 0, O_PH = (size_t)M * DM, O_PRGC = O_PH + 8192, O_PCF = O_PRGC + 24576, O_PPOOL = O_PCF + 245760, O_PSC = O_PPOOL + 122880,
                 O_SH = O_PSC + 16384, O_SRGC = O_SH + 131072, O_SCF = O_SRGC + 393216, O_SPOOL = O_SCF + 3932160, O_SSC = O_SPOOL + 1966080, O_END = O_SSC + 262144;
static_assert(O_END == 24403968, "output map");

__device__ __forceinline__ int opqv(int v) { asm volatile("" : "+v"(v)); return v; }
__device__ __forceinline__ int lane_now() { int l; asm volatile("v_mbcnt_lo_u32_b32 %0, -1, 0\n\tv_mbcnt_hi_u32_b32 %0, -1, %0" : "=v"(l)); return l; }
__device__ __forceinline__ int opqs(int v) { asm volatile("" : "+s"(v)); return v; }
namespace pg8 {
#define PG8_LAS __attribute__((address_space(3)))
typedef unsigned short bf16_t;
typedef short bf16x8 __attribute__((ext_vector_type(8)));
typedef float f32x4 __attribute__((ext_vector_type(4)));
typedef float f32x2 __attribute__((ext_vector_type(2)));
typedef unsigned u32x4 __attribute__((ext_vector_type(4)));
typedef unsigned u32x2 __attribute__((ext_vector_type(2)));
typedef _Float16 f16x4 __attribute__((ext_vector_type(4)));
typedef _Float16 f16x8 __attribute__((ext_vector_type(8)));
constexpr int BM = 256, BK = 64, HALF = 128, HTB = HALF * BK * 2, STAGE_BYTES = 8 * HTB, NXCD = 8, WGM = 8;

__host__ __device__ __forceinline__ int lds_byte(int r, int c) { const int st = (r >> 4) * 2 + (c >> 5), rr = r & 15, cc = c & 31, ob = rr * 64 + cc * 2; return st * 1024 + (ob ^ (((ob >> 9) & 1) << 5)); }
__host__ __device__ __forceinline__ void stage_rc(int b, int& R, int& C) { const int st = b / 1024, sb = b % 1024, swz = sb ^ (((sb >> 9) & 1) << 5); R = (st >> 1) * 16 + swz / 64; C = (st & 1) * 32 + (swz % 64) / 2; }
__host__ __device__ __forceinline__ int perm32(int rho) { const int n = rho >> 4, i = rho & 15; return 8 * (i >> 2) + 4 * n + (i & 3); }

struct Unit { int pm, pn, nt, mode, aux; long offA, offB; };
struct Gemm { const bf16_t* A; const bf16_t* Bt; int lda, ldb; };

enum { SK_PLAIN = 0, SK_P3 = 1, SK_P4 = 2, SK_P6 = 3 };
struct UnitOrder {
    int kind, nN, nwgP, nS, ntP, G, c; long offA_s; const unsigned* ready = nullptr; unsigned need = 0;
    __device__ __forceinline__ void init(int kind_, int N_, int K_, int G_, int c_, long offA_s_, bool prompt = true, bool sample = true) { kind = kind_; nN = N_ / BM; nwgP = prompt ? 64 * nN : 0; ntP = K_ / BK; G = G_; c = c_; offA_s = offA_s_;
        nS = !sample ? 0 : kind_ == SK_PLAIN ? 2 * nN : kind_ == SK_P3 ? 32 : kind_ == SK_P4 ? 128 : 88; }
    __device__ __forceinline__ bool next(int i, Unit& u, const Gemm& g) const {
        const long L = (long)i * G + c; const long ra = (long)BM * g.lda * 2, rb = (long)BM * g.ldb * 2;
        if (L < nwgP) {
            int wgid = (int)L; { const int q = nwgP / NXCD, xcd = wgid % NXCD, off = wgid / NXCD; wgid = xcd * q + off; }
            const int nig = WGM * nN; u.pm = (wgid / nig) * WGM + ((wgid % nig) % WGM); u.pn = (wgid % nig) / WGM;
            u.nt = ntP; u.mode = 0; u.aux = 0; u.offA = u.pm * ra; u.offB = u.pn * rb; return true; }
        const int s = (int)(L - nwgP); if (s >= nS) return false;
        if (kind == SK_PLAIN) { u.pm = 64 + (s & 1); u.pn = s >> 1; u.nt = ntP; u.mode = 0; u.aux = 0; u.offA = u.pm * ra; u.offB = u.pn * rb; }
        else if (kind == SK_P3) { const int n = s & 3, tile = s >> 2; u.pm = 64 + (tile & 1); u.pn = tile >> 1; u.nt = 8; u.mode = 1; u.aux = n; u.offA = u.pm * ra + 1024 * n; u.offB = u.pn * rb + 1024 * n; }
        else if (kind == SK_P4) { const int ch = s & 15, tile = s >> 4, n = ch >> 2, kin = (ch & 3) * 256; u.pm = 64 + (tile & 1); u.pn = tile >> 1; u.nt = 4; u.mode = 1; u.aux = ch;
            u.offA = offA_s + ((long)(n * 512 + (u.pm - 64) * 256) * 1024 + kin) * 2; u.offB = u.pn * rb + kin * 2; }
        else { const int ch = s % 11, tile = s / 11; u.pm = 64 + (tile & 1); u.pn = tile >> 1; u.nt = 4; u.mode = 1; u.aux = ch; u.offA = u.pm * ra + 512 * ch; u.offB = u.pn * rb + 512 * ch; }
        return true;
    }
    __device__ __forceinline__ void a_ready(const Unit& u, int wid) const {
        if (ready == nullptr || u.pm < 64) return;
        if (wid == 0) { unsigned spins = 0;
            while ((unsigned)__builtin_amdgcn_readfirstlane(__hip_atomic_load(ready, __ATOMIC_RELAXED, __HIP_MEMORY_SCOPE_AGENT)) < need) { __builtin_amdgcn_s_sleep(2); if (++spins > (1u << 20)) break; }
            __builtin_amdgcn_fence(__ATOMIC_ACQUIRE, "agent");
            asm volatile("s_waitcnt vmcnt(0)" ::: "memory"); }
        asm volatile("" ::: "memory"); __builtin_amdgcn_s_barrier(); asm volatile("" ::: "memory");
    }
};

__device__ __forceinline__ unsigned cvt_pk_bf16(float lo, float hi) { unsigned r; asm volatile("v_cvt_pk_bf16_f32 %0, %1, %2" : "=v"(r) : "v"(lo), "v"(hi)); return r; }
__device__ __forceinline__ float sigmoidf_fast(float x) { return __builtin_amdgcn_rcpf(1.0f + __builtin_amdgcn_exp2f(-1.44269504089f * x)); }
__device__ __forceinline__ float gelu_tanh(float x) { const float t = x * x, y = x * fmaf(t, -0.10294324f, -2.3022082f); return x * __builtin_amdgcn_rcpf(1.0f + __builtin_amdgcn_exp2f(y)); }

__device__ __forceinline__ void acc_zero(f32x4 (&acc)[2][2][4][2]) {
#pragma unroll
    for (int a = 0; a < 2; ++a)
#pragma unroll
        for (int b = 0; b < 2; ++b)
#pragma unroll
            for (int m = 0; m < 4; ++m)
#pragma unroll
                for (int n = 0; n < 2; ++n) acc[a][b][m][n] = (f32x4){0.f, 0.f, 0.f, 0.f};
}
__device__ __forceinline__ float* state_ptr(float* out, int R, int keep, int layer, size_t p_off, size_t s_off) {
    if (R < MP) { const int b = R >> 11, j = (R & 2047) - (2048 - keep); return j < 0 ? nullptr : out + p_off + (size_t)((layer * 8 + b) * keep + j) * 512; }
    const int s = (R - MP) >> 2, j = (R & 3) + keep - 4; return j < 0 ? nullptr : out + s_off + (size_t)((layer * 128 + s) * keep + j) * 512;
}

struct EpiMix {
    static constexpr bool PERM = true, MIDK = false;
    __device__ __forceinline__ void init(f32x4 (&acc)[2][2][4][2], const Unit&, int, int) const { acc_zero(acc); }
    bf16_t* Z; float* out; int layer;
    __device__ __forceinline__ void midk(f32x4 (&)[2][2][4][2], const Unit&, int, int, int, int, int) const {}
    __device__ __forceinline__ void operator()(f32x4 (&acc)[2][2][4][2], const Unit& u, int wr, int wc, int fr_, int fq_) const {
        const int lane_ = lane_now(), fr = lane_ & 15, fq = lane_ >> 4; (void)fr_; (void)fq_;
        const int pn = u.pn; int type, zcol, keep = 0, scol = 0; size_t poff = 0, soff = 0;
        if (pn < 2) { type = 0; zcol = 256 * pn; keep = 3; scol = zcol; poff = O_PRGC; soff = O_SRGC; }
        else if (pn < 4) { type = 1; zcol = 512 + 256 * (pn - 2); }
        else if (pn < 8) { type = 2; zcol = 1024 + 128 * (pn - 4); keep = 30; scol = 128 * (pn - 4); poff = O_PCF; soff = O_SCF; }
        else if (pn < 10) { type = 0; zcol = 1536 + 256 * (pn - 8); keep = 15; scol = 256 * (pn - 8); poff = O_PPOOL; soff = O_SPOOL; }
        else if (pn < 12) { type = 0; zcol = 2048 + 256 * (pn - 10); }
        else { type = 3; zcol = 2560 + 128 * (pn - 12); keep = 2; scol = 128 * (pn - 12); poff = O_PSC; soff = O_SSC; }
        const bool tail = keep != 0 && (u.pm >= 64 || (u.pm & 7) == 7);
        const int row0 = u.pm * BM + wr * 64 + fr, cl = wc * 32 + 8 * fq;
        if (type < 2) {
#pragma unroll
            for (int ai = 0; ai < 2; ++ai)
#pragma unroll
                for (int m = 0; m < 4; ++m) { const int R = row0 + ai * HALF + m * 16; bf16_t* rowp = Z + (size_t)R * ZC + zcol + cl;
                    float* sp = tail ? state_ptr(out, R, keep, layer, poff, soff) : nullptr;
#pragma unroll
                    for (int bj = 0; bj < 2; ++bj) { f32x4 v0 = acc[ai][bj][m][0], v1 = acc[ai][bj][m][1];
                        if (type == 1) { v0 = (f32x4){gelu_tanh(v0[0]), gelu_tanh(v0[1]), gelu_tanh(v0[2]), gelu_tanh(v0[3])}; v1 = (f32x4){gelu_tanh(v1[0]), gelu_tanh(v1[1]), gelu_tanh(v1[2]), gelu_tanh(v1[3])}; }
                        u32x4 w; w.x = cvt_pk_bf16(v0[0], v0[1]); w.y = cvt_pk_bf16(v0[2], v0[3]); w.z = cvt_pk_bf16(v1[0], v1[1]); w.w = cvt_pk_bf16(v1[2], v1[3]);
                        *(u32x4*)(rowp + bj * HALF) = w;
                        if (sp) { *(f32x4*)(sp + scol + cl + bj * HALF) = v0; *(f32x4*)(sp + scol + cl + bj * HALF + 4) = v1; } } }
        } else {
#pragma unroll
            for (int ai = 0; ai < 2; ++ai)
#pragma unroll
                for (int m = 0; m < 4; ++m) { const int R = row0 + ai * HALF + m * 16; bf16_t* rowp = Z + (size_t)R * ZC + zcol + cl;
                    float* sp = tail ? state_ptr(out, R, keep, layer, poff, soff) : nullptr;
                    f32x4 v0, v1; const f32x4 a0 = acc[ai][0][m][0], a1 = acc[ai][0][m][1], b0 = acc[ai][1][m][0], b1 = acc[ai][1][m][1];
                    if (type == 2) {
#pragma unroll
                        for (int i = 0; i < 4; ++i) { v0[i] = a0[i] * sigmoidf_fast(b0[i]); v1[i] = a1[i] * sigmoidf_fast(b1[i]); }
                    } else { v0 = a0 * b0; v1 = a1 * b1; }
                    u32x4 w; w.x = cvt_pk_bf16(v0[0], v0[1]); w.y = cvt_pk_bf16(v0[2], v0[3]); w.z = cvt_pk_bf16(v1[0], v1[1]); w.w = cvt_pk_bf16(v1[2], v1[3]);
                    *(u32x4*)rowp = w;
                    if (sp) { *(f32x4*)(sp + scol + cl) = v0; *(f32x4*)(sp + scol + cl + 4) = v1; } }
        }
    }
};

struct EpiGate {
    static constexpr bool PERM = true, MIDK = false;
    __device__ __forceinline__ void init(f32x4 (&acc)[2][2][4][2], const Unit&, int, int) const { acc_zero(acc); }
    _Float16* G;
    __device__ __forceinline__ void midk(f32x4 (&)[2][2][4][2], const Unit&, int, int, int, int, int) const {}
    __device__ __forceinline__ void operator()(f32x4 (&acc)[2][2][4][2], const Unit& u, int wr, int wc, int fr_, int fq_) const {
        const int lane_ = lane_now(), fr = lane_ & 15, fq = lane_ >> 4; (void)fr_; (void)fq_;
        const int row0 = u.pm * BM + wr * 64 + fr, ch0 = 64 * u.pn + 16 * wc + 4 * fq; const bool plain = u.pm >= 64;
#pragma unroll
        for (int ai = 0; ai < 2; ++ai)
#pragma unroll
            for (int m = 0; m < 4; ++m) { const int R = row0 + ai * HALF + m * 16; _Float16* gp = G + (size_t)R * GC + ch0;
                f16x4 r0, r1, r2, g3;
#pragma unroll
                for (int i = 0; i < 4; ++i) {
                    const float d0 = 1.f + __builtin_amdgcn_exp2f(__builtin_amdgcn_fmed3f(acc[ai][0][m][0][i], -15.f, 15.f)), d1 = 1.f + __builtin_amdgcn_exp2f(__builtin_amdgcn_fmed3f(acc[ai][0][m][1][i], -15.f, 15.f));
                    const float d2 = 1.f + __builtin_amdgcn_exp2f(__builtin_amdgcn_fmed3f(acc[ai][1][m][0][i], -15.f, 15.f)), d3 = 1.f + __builtin_amdgcn_exp2f(__builtin_amdgcn_fmed3f(acc[ai][1][m][1][i], -15.f, 15.f));
                    const float i0 = __builtin_amdgcn_rcpf(d0), i1 = __builtin_amdgcn_rcpf(d1), i2 = __builtin_amdgcn_rcpf(d2), i3 = __builtin_amdgcn_rcpf(d3);
                    if (plain) { r0[i] = (_Float16)i0; r1[i] = (_Float16)i1; r2[i] = (_Float16)i2; }
                    else { r0[i] = (_Float16)(d1 * i0); r1[i] = (_Float16)(d2 * i1); r2[i] = (_Float16)(d3 * i2); }
                    g3[i] = (_Float16)i3; }
                *(f16x4*)(gp) = r0; *(f16x4*)(gp + 1024) = r1; *(f16x4*)(gp + 2048) = r2; *(f16x4*)(gp + 3072) = g3; }
    }
};

struct EpiMerge {
    static constexpr bool PERM = true, MIDK = true;
    __device__ __forceinline__ void init(f32x4 (&acc)[2][2][4][2], const Unit&, int, int) const { acc_zero(acc); }
    const _Float16* G; bf16_t* O; bf16_t* Os;
    __device__ __forceinline__ void scale(f32x4 (&acc)[2][2][4][2], const Unit& u, int seg, int wr, int wc) const {
        const int lane_ = lane_now(), fr = lane_ & 15, fq = lane_ >> 4;
        const int row0 = u.pm * BM + wr * 64 + fr, c0 = 1024 * seg + 256 * u.pn + wc * 32 + 8 * fq;
#pragma unroll
        for (int ai = 0; ai < 2; ++ai)
#pragma unroll
            for (int m = 0; m < 4; ++m) { const _Float16* gp = G + (size_t)(row0 + ai * HALF + m * 16) * GC + c0;
#pragma unroll
                for (int bj = 0; bj < 2; ++bj) { const f16x8 f = *(const f16x8*)(gp + bj * HALF);
                    acc[ai][bj][m][0] *= (f32x4){(float)f[0], (float)f[1], (float)f[2], (float)f[3]}; acc[ai][bj][m][1] *= (f32x4){(float)f[4], (float)f[5], (float)f[6], (float)f[7]}; } }
    }
    __device__ __forceinline__ void midk(f32x4 (&acc)[2][2][4][2], const Unit& u, int seg, int wr, int wc, int, int) const { scale(acc, u, seg, wr, wc); }
    __device__ __forceinline__ void operator()(f32x4 (&acc)[2][2][4][2], const Unit& u, int wr, int wc, int, int) const {
        scale(acc, u, u.mode ? u.aux : 3, wr, wc);
        const int lane_ = lane_now(), fr = lane_ & 15, fq = lane_ >> 4;
        const int row0 = (u.mode ? (u.pm - 64) * BM + 512 * u.aux : u.pm * BM) + wr * 64 + fr, c0 = 256 * u.pn + wc * 32 + 8 * fq;
        bf16_t* O = u.mode ? Os : this->O;
#pragma unroll
        for (int ai = 0; ai < 2; ++ai)
#pragma unroll
            for (int m = 0; m < 4; ++m) { bf16_t* rowp = O + (size_t)(row0 + ai * HALF + m * 16) * DM + c0;
#pragma unroll
                for (int bj = 0; bj < 2; ++bj) { const f32x4 v0 = acc[ai][bj][m][0], v1 = acc[ai][bj][m][1];
                    u32x4 w; w.x = cvt_pk_bf16(v0[0], v0[1]); w.y = cvt_pk_bf16(v0[2], v0[3]); w.z = cvt_pk_bf16(v1[0], v1[1]); w.w = cvt_pk_bf16(v1[2], v1[3]); *(u32x4*)(rowp + bj * HALF) = w; } }
    }
};

struct PanelStats {
    unsigned* xbuf;
    unsigned* cnt;
    __device__ __forceinline__ void run(const f32x4 (&v)[2][2][4][2], const Unit& u, int wr, int wc, PG8_LAS unsigned char* lds, int wid) const {
        const int lane = lane_now(), fr = lane & 15, fq = lane >> 4;
        PG8_LAS f32x2* P = (PG8_LAS f32x2*)lds;
        PG8_LAS f32x2* S = (PG8_LAS f32x2*)(lds + 8192);
#pragma unroll
        for (int ai = 0; ai < 2; ++ai)
#pragma unroll
            for (int m = 0; m < 4; ++m) {
                float s = 0.f;
#pragma unroll
                for (int bj = 0; bj < 2; ++bj)
#pragma unroll
                    for (int n = 0; n < 2; ++n) { const f32x4 x = v[ai][bj][m][n]; s += (x[0] + x[1]) + (x[2] + x[3]); }
                s += __builtin_bit_cast(float, __builtin_amdgcn_ds_bpermute((lane ^ 16) << 2, __builtin_bit_cast(int, s))); s += __builtin_bit_cast(float, __builtin_amdgcn_ds_bpermute((lane ^ 32) << 2, __builtin_bit_cast(int, s)));
                const float mw = s * (1.0f / 64.0f); float q = 0.f;
#pragma unroll
                for (int bj = 0; bj < 2; ++bj)
#pragma unroll
                    for (int n = 0; n < 2; ++n) { const f32x4 d = v[ai][bj][m][n] - mw; q += (d[0] * d[0] + d[1] * d[1]) + (d[2] * d[2] + d[3] * d[3]); }
                q += __builtin_bit_cast(float, __builtin_amdgcn_ds_bpermute((lane ^ 16) << 2, __builtin_bit_cast(int, q))); q += __builtin_bit_cast(float, __builtin_amdgcn_ds_bpermute((lane ^ 32) << 2, __builtin_bit_cast(int, q)));
                if (fq == 0) P[(ai * HALF + wr * 64 + m * 16 + fr) * 4 + wc] = (f32x2){mw, q};
            }
        asm volatile("s_waitcnt lgkmcnt(0)" ::: "memory"); __builtin_amdgcn_s_barrier(); asm volatile("" ::: "memory");
        const int row = wid * 32 + (lane & 31);
        if (lane < 32) {
            const f32x2 a = P[row * 4 + 0], b = P[row * 4 + 1], c = P[row * 4 + 2], d = P[row * 4 + 3];
            const float mt = (a.x + b.x + c.x + d.x) * 0.25f;
            const float da = a.x - mt, db = b.x - mt, dc = c.x - mt, dd = d.x - mt;
            const float m2 = (a.y + b.y) + (c.y + d.y) + 64.0f * ((da * da + db * db) + (dc * dc + dd * dd));
            unsigned long long* slot = (unsigned long long*)xbuf + ((size_t)(u.pm * BM + row) * 4 + u.pn);
            __hip_atomic_store(slot, ((unsigned long long)__float_as_uint(m2) << 32) | __float_as_uint(mt), __ATOMIC_RELAXED, __HIP_MEMORY_SCOPE_AGENT);
        }
        asm volatile("s_waitcnt vmcnt(0)" ::: "memory");
        if (lane == 0) __hip_atomic_fetch_add(cnt + 64 * u.pm, 1u, __ATOMIC_RELAXED, __HIP_MEMORY_SCOPE_AGENT);
        if (wid == 0) {
            unsigned spins = 0;
            while ((unsigned)__builtin_amdgcn_readfirstlane(__hip_atomic_load(cnt + 64 * u.pm, __ATOMIC_RELAXED, __HIP_MEMORY_SCOPE_AGENT)) < 32u) { __builtin_amdgcn_s_sleep(2); if (++spins > (1u << 20)) break; }
            __builtin_amdgcn_fence(__ATOMIC_ACQUIRE, "agent");
        }
        asm volatile("s_waitcnt vmcnt(0) lgkmcnt(0)" ::: "memory"); __builtin_amdgcn_s_barrier(); asm volatile("" ::: "memory");
        if (lane < 32) {
            const unsigned long long* slot = (const unsigned long long*)xbuf + (size_t)(u.pm * BM + row) * 4; float mt[4], m2[4]; float ms = 0.f;
#pragma unroll
            for (int t = 0; t < 4; ++t) { const unsigned long long w = __hip_atomic_load(slot + t, __ATOMIC_RELAXED, __HIP_MEMORY_SCOPE_AGENT); mt[t] = __uint_as_float((unsigned)w); m2[t] = __uint_as_float((unsigned)(w >> 32)); ms += mt[t]; }
            const float mean = ms * 0.25f; float q = 0.f;
#pragma unroll
            for (int t = 0; t < 4; ++t) { const float dm = mt[t] - mean; q += m2[t] + 256.0f * dm * dm; }
            S[row] = (f32x2){mean, __builtin_amdgcn_rsqf(q * (1.0f / 1024.0f) + LN_EPS)};
        }
        asm volatile("s_waitcnt lgkmcnt(0)" ::: "memory"); __builtin_amdgcn_s_barrier(); asm volatile("" ::: "memory");
    }
};
struct EpiRes {
    static constexpr bool PERM = false, MIDK = false;
    __device__ __forceinline__ void init(f32x4 (&acc)[2][2][4][2], const Unit& u, int wr, int wc) const {
        if (u.mode) { acc_zero(acc); return; }
        const int lane_ = lane_now(), fr = lane_ & 15, fq = lane_ >> 4;
        const float* bp0 = baseP + (size_t)(u.pm * BM + wr * 64 + fr) * DM + 256 * u.pn + wc * 32 + 4 * fq;
#pragma unroll
        for (int ai = 0; ai < 2; ++ai)
#pragma unroll
            for (int m = 0; m < 4; ++m)
#pragma unroll
                for (int bj = 0; bj < 2; ++bj)
#pragma unroll
                    for (int n = 0; n < 2; ++n) acc[ai][bj][m][n] = *(const f32x4*)(bp0 + (size_t)(ai * HALF + m * 16) * DM + bj * HALF + n * 16) * ALPHA;
    }
    const float* baseP; float* out; bf16_t* xb; const float* lng; const float* lnb; float* slab; PanelStats st; PG8_LAS unsigned char* xlds; int wid;
    __device__ __forceinline__ void midk(f32x4 (&)[2][2][4][2], const Unit&, int, int, int, int, int) const {}
    __device__ __forceinline__ void operator()(f32x4 (&acc)[2][2][4][2], const Unit& u, int wr, int wc, int fr_, int fq_) const {
        const int lane_ = lane_now(), fr = lane_ & 15, fq = lane_ >> 4; (void)fr_; (void)fq_;
        const int row0 = u.pm * BM + wr * 64 + fr, c0 = 256 * u.pn + wc * 32 + 4 * fq;
        if (u.mode) {
#pragma unroll
            for (int ai = 0; ai < 2; ++ai)
#pragma unroll
                for (int m = 0; m < 4; ++m) { float* op = slab + ((size_t)u.aux * 512 + (row0 - MP) + ai * HALF + m * 16) * DM + c0;
#pragma unroll
                    for (int bj = 0; bj < 2; ++bj)
#pragma unroll
                        for (int n = 0; n < 2; ++n) *(f32x4*)(op + bj * HALF + n * 16) = acc[ai][bj][m][n]; }
            return; }
        st.run(acc, u, wr, wc, xlds, wid);
        const PG8_LAS f32x2* S = (const PG8_LAS f32x2*)(xlds + 8192);
#pragma unroll
        for (int bj = 0; bj < 2; ++bj)
#pragma unroll
            for (int n = 0; n < 2; ++n) { const int cc = c0 + bj * HALF + n * 16; const f32x4 gv = *(const f32x4*)(lng + cc), bv = *(const f32x4*)(lnb + cc);
#pragma unroll
                for (int ai = 0; ai < 2; ++ai)
#pragma unroll
                    for (int m = 0; m < 4; ++m) { const int r = ai * HALF + wr * 64 + m * 16 + fr; const f32x2 sr = S[r]; const size_t off = (size_t)(u.pm * BM + r) * DM + cc;
                        const f32x4 o = (acc[ai][bj][m][n] - sr.x) * sr.y * gv + bv; *(f32x4*)(out + off) = o;
                        if (xb) { u32x2 w; w.x = cvt_pk_bf16(o[0], o[1]); w.y = cvt_pk_bf16(o[2], o[3]); *(u32x2*)(xb + off) = w; }
                        if (m & 1) asm volatile("" ::: "memory"); } }
    }
};

struct EpiSwi {
    static constexpr bool PERM = true, MIDK = false;
    __device__ __forceinline__ void init(f32x4 (&acc)[2][2][4][2], const Unit&, int, int) const { acc_zero(acc); }
    bf16_t* H;
    __device__ __forceinline__ void midk(f32x4 (&)[2][2][4][2], const Unit&, int, int, int, int, int) const {}
    __device__ __forceinline__ void operator()(f32x4 (&acc)[2][2][4][2], const Unit& u, int wr, int wc, int fr_, int fq_) const {
        const int lane_ = lane_now(), fr = lane_ & 15, fq = lane_ >> 4; (void)fr_; (void)fq_;
        const int row0 = u.pm * BM + wr * 64 + fr, c0 = 128 * u.pn + wc * 32 + 8 * fq;
#pragma unroll
        for (int ai = 0; ai < 2; ++ai)
#pragma unroll
            for (int m = 0; m < 4; ++m) { bf16_t* rowp = H + (size_t)(row0 + ai * HALF + m * 16) * FF + c0;
                const f32x4 g0 = acc[ai][0][m][0], g1 = acc[ai][0][m][1], u0 = acc[ai][1][m][0], u1 = acc[ai][1][m][1]; f32x4 v0, v1;
#pragma unroll
                for (int i = 0; i < 4; ++i) { v0[i] = g0[i] * sigmoidf_fast(g0[i]) * u0[i]; v1[i] = g1[i] * sigmoidf_fast(g1[i]) * u1[i]; }
                u32x4 w; w.x = cvt_pk_bf16(v0[0], v0[1]); w.y = cvt_pk_bf16(v0[2], v0[3]); w.z = cvt_pk_bf16(v1[0], v1[1]); w.w = cvt_pk_bf16(v1[2], v1[3]);
                *(u32x4*)rowp = w; }
    }
};

template <class Epi, class Sched, bool ALIGN_EPI>
__device__ __forceinline__ void gemm_phase(PG8_LAS unsigned char* lds, const Gemm g, const Sched& S, const Epi& E, int wave_id) {
    const int wid = opqs(wave_id), lane = lane_now(), tid = wid * 64 + lane, wr = wid >> 2, wc = wid & 3, fr = lane & 15, fq = lane >> 4;
    unsigned voffA[2], voffB[2];
#pragma unroll
    for (int i = 0; i < 2; ++i) { int R, C; stage_rc(tid * 16 + i * 8192, R, C); const int Rb = Epi::PERM ? ((R & ~31) + perm32(R & 31)) : R;
        voffA[i] = (unsigned)(R * g.lda + C) * 2u; voffB[i] = (unsigned)(Rb * g.ldb + C) * 2u; }
    const size_t kstep = (size_t)(BK * 2);
    const size_t hstepA = (size_t)HALF * g.lda * 2, hstepB = (size_t)HALF * g.ldb * 2;
    const unsigned ldsw = (unsigned)wid * 1024u;
    const int aoff = lds_byte(wr * 64 + fr, fq * 8), boff = lds_byte(wc * 32 + fr, fq * 8);
#define PG8_SA(b, h) (((b) * 2 + (h)) * HTB)
#define PG8_SB(b, h) ((4 + (b) * 2 + (h)) * HTB)
#define PG8_STAGE(bufoff, gbase, voff) do { _Pragma("unroll") for (int _i = 0; _i < 2; ++_i) \
        __builtin_amdgcn_global_load_lds((const unsigned*)((const char*)(gbase) + (voff)[_i]), (PG8_LAS unsigned*)(lds + (bufoff) + ldsw + _i * 8192), 16, 0, 0); } while (0)
#define PG8_LDA(dst, b, h) do { _Pragma("unroll") for (int m = 0; m < 4; ++m) _Pragma("unroll") for (int k = 0; k < 2; ++k) dst[m][k] = *(const PG8_LAS bf16x8*)(lds + PG8_SA(b, h) + aoff + m * 2048 + k * 1024); } while (0)
#define PG8_LDB(dst, b, h) do { _Pragma("unroll") for (int n = 0; n < 2; ++n) _Pragma("unroll") for (int k = 0; k < 2; ++k) dst[n][k] = *(const PG8_LAS bf16x8*)(lds + PG8_SB(b, h) + boff + n * 2048 + k * 1024); } while (0)
#define PG8_MMA(ai, bj, At, Bt) do { __builtin_amdgcn_s_setprio(1); _Pragma("unroll") for (int m = 0; m < 4; ++m) _Pragma("unroll") for (int n = 0; n < 2; ++n) _Pragma("unroll") for (int k = 0; k < 2; ++k) \
        acc[ai][bj][m][n] = __builtin_amdgcn_mfma_f32_16x16x32_bf16(Bt[n][k], At[m][k], acc[ai][bj][m][n], 0, 0, 0); __builtin_amdgcn_s_setprio(0); } while (0)
#define PG8_WAIT_V(n) asm volatile("s_waitcnt vmcnt(" #n ")" ::: "memory")
#define PG8_WAIT_L(n) asm volatile("s_waitcnt lgkmcnt(" #n ")" ::: "memory")
#define PG8_BAR __builtin_amdgcn_s_barrier()
#define PG8_SCHED __builtin_amdgcn_sched_barrier(0)
    Unit cur, nxt; int ui = 0;
    if (!S.next(0, cur, g)) return;
    f32x4 acc[2][2][4][2];
    E.init(acc, cur, wr, wc);
    bf16x8 At[4][2], B0[2][2], B1[2][2];
    const char* cA = (const char*)g.A + cur.offA; const char* cB = (const char*)g.Bt + cur.offB;
    PG8_STAGE(PG8_SB(0, 0), cB, voffB); PG8_STAGE(PG8_SB(0, 1), cB + hstepB, voffB); PG8_STAGE(PG8_SA(0, 0), cA, voffA); PG8_STAGE(PG8_SA(0, 1), cA + hstepA, voffA);
    if (wr == 1) PG8_BAR;
    PG8_WAIT_V(2); PG8_BAR;
    PG8_STAGE(PG8_SB(1, 0), cB + kstep, voffB); PG8_STAGE(PG8_SA(1, 0), cA + kstep, voffA); PG8_STAGE(PG8_SB(1, 1), cB + hstepB + kstep, voffB);
    PG8_WAIT_V(6); PG8_BAR;
    for (;;) {
        const bool has_next = S.next(ui + 1, nxt, g);
        const char* nA = has_next ? (const char*)g.A + nxt.offA : cA; const char* nB = has_next ? (const char*)g.Bt + nxt.offB : cB;
        const int nt = cur.nt, TSEG = Epi::MIDK ? 8 : nt;
        for (int t0 = 0; t0 < nt; t0 += TSEG) {
        if constexpr (Epi::MIDK) { if (t0 != 0) { PG8_SCHED; E.midk(acc, cur, t0 / TSEG - 1, wr, wc, 0, 0); PG8_SCHED; } }
#pragma unroll 1
        for (int t = t0; t < t0 + TSEG; t += 2) {
            const bool last = (t == nt - 2);
            if (last && has_next) S.a_ready(nxt, wid);
            const char* a1 = cA + (size_t)(t + 1) * kstep;
            const char* a2 = last ? nA : cA + (size_t)(t + 2) * kstep; const char* b2 = last ? nB : cB + (size_t)(t + 2) * kstep;
            const char* a3 = a2 + kstep; const char* b3 = b2 + kstep;
            PG8_LDB(B0, 0, 0); PG8_LDB(B1, 0, 1); PG8_SCHED; PG8_LDA(At, 0, 0); PG8_STAGE(PG8_SA(1, 1), a1 + hstepA, voffA);
            PG8_WAIT_V(8); PG8_WAIT_L(0); PG8_BAR; PG8_MMA(0, 0, At, B0); PG8_MMA(0, 1, At, B1); PG8_BAR; PG8_SCHED;
            PG8_LDA(At, 0, 1); PG8_STAGE(PG8_SB(0, 0), b2, voffB); PG8_STAGE(PG8_SB(0, 1), b2 + hstepB, voffB); PG8_STAGE(PG8_SA(0, 0), a2, voffA);
            PG8_WAIT_V(8); PG8_WAIT_L(0); PG8_BAR; PG8_MMA(1, 0, At, B0); PG8_MMA(1, 1, At, B1); PG8_BAR; PG8_SCHED;
            PG8_LDB(B0, 1, 0); PG8_LDB(B1, 1, 1); PG8_SCHED; PG8_LDA(At, 1, 0); PG8_STAGE(PG8_SA(0, 1), a2 + hstepA, voffA);
            PG8_WAIT_V(8); PG8_WAIT_L(0); PG8_BAR; PG8_MMA(0, 0, At, B0); PG8_MMA(0, 1, At, B1); PG8_BAR; PG8_SCHED;
            PG8_LDA(At, 1, 1); PG8_STAGE(PG8_SB(1, 0), b3, voffB); PG8_STAGE(PG8_SB(1, 1), b3 + hstepB, voffB); PG8_STAGE(PG8_SA(1, 0), a3, voffA);
            PG8_WAIT_V(8); PG8_WAIT_L(0); PG8_BAR; PG8_MMA(1, 0, At, B0); PG8_MMA(1, 1, At, B1); PG8_BAR; PG8_SCHED;
        }
        }
        if constexpr (ALIGN_EPI) { if (wr == 0) PG8_BAR; }
        E(acc, cur, wr, wc, 0, 0);
        if (!has_next) break;
        cur = nxt; cA = nA; cB = nB; ++ui;
        E.init(acc, cur, wr, wc);
        if constexpr (ALIGN_EPI) { if (wr == 1) PG8_BAR; }
    }
    PG8_WAIT_V(0);
    if constexpr (!ALIGN_EPI) { if (wr == 0) PG8_BAR; }
    PG8_BAR;
#undef PG8_SA
#undef PG8_SB
#undef PG8_STAGE
#undef PG8_LDA
#undef PG8_LDB
#undef PG8_MMA
#undef PG8_WAIT_V
#undef PG8_WAIT_L
#undef PG8_BAR
#undef PG8_SCHED
}
}

constexpr int NWAVES = 8;
constexpr int NPHASE = 19;
constexpr size_t MiB = 1u << 20;
constexpr size_t WS_CTL = 0, CTL_ZERO_BYTES = 1 * MiB;
constexpr size_t WS_WA = 1 * MiB;
constexpr size_t WS_XB = 18 * MiB;
constexpr size_t WS_Y = 51 * MiB;
constexpr size_t WS_ZG = 117 * MiB;
constexpr size_t WS_BT3 = 249 * MiB, WS_BT4 = 253 * MiB, WS_BT5 = WS_WA, WS_BT6 = WS_ZG + 108 * MiB;
constexpr size_t WS_MB4S = WS_WA + 13 * MiB;
constexpr size_t WS_SLAB = WS_Y;
constexpr size_t WS_END = 255 * MiB;
static_assert(WS_XB + (size_t)M * DM * 2 <= WS_Y && WS_Y + (size_t)M * YC * 2 <= WS_ZG && WS_ZG + (size_t)M * GC * 2 <= WS_BT3 && WS_SLAB + (size_t)16 * 512 * DM * 4 <= WS_Y + 40 * MiB && WS_Y + 40 * MiB + 4 * 512 * 1024 <= WS_ZG, "ws map");
static_assert((size_t)M * FF * 2 <= 108 * MiB && WS_BT5 + (size_t)2 * FF * DM * 2 <= WS_MB4S && WS_MB4S + 4 * MiB <= WS_XB && WS_BT6 + (size_t)DM * FF * 2 <= WS_BT3, "ws map 2");
constexpr int CW_RDY = 12288;
constexpr int CW_TMO = 0, CW_CODE = 1, CW_BAR = 4096, CW_SEAM = 16384, SEAM_BANK = 8192;
constexpr size_t WS_XCH = WS_Y + 40 * MiB;
constexpr int XLDS_OFF = 131072 + 1024;
constexpr int RING_OFF = 0, RING_BYTES = 131072;
constexpr int LDSCTL_OFF = RING_BYTES, MISC_OFF = LDSCTL_OFF + 320;
constexpr int LDS_BYTES = 147456;

#define GAS __attribute__((address_space(1)))
#define LAS __attribute__((address_space(3)))
typedef unsigned short bf16;
typedef unsigned v4u __attribute__((ext_vector_type(4)));
typedef unsigned v2u __attribute__((ext_vector_type(2)));
typedef float f32x4 __attribute__((ext_vector_type(4)));
typedef float f32x2 __attribute__((ext_vector_type(2)));
typedef short bf16x8 __attribute__((ext_vector_type(8)));
typedef GAS unsigned gu32;
#define RLX_AGENT __ATOMIC_RELAXED, __HIP_MEMORY_SCOPE_AGENT
#define LDS_WAIT() asm volatile("s_waitcnt lgkmcnt(0)" ::: "memory")
#define VM_WAIT() asm volatile("s_waitcnt vmcnt(0)" ::: "memory")
__device__ __forceinline__ unsigned pk2(float lo, float hi) { return pg8::cvt_pk_bf16(lo, hi); }
__device__ __forceinline__ float bflo(unsigned v) { return __uint_as_float(v << 16); }
__device__ __forceinline__ float bfhi(unsigned v) { return __uint_as_float(v & 0xffff0000u); }
__device__ __forceinline__ float bf1(unsigned short h) { return __uint_as_float((unsigned)h << 16); }
__device__ __forceinline__ unsigned short f2bf(float f) { return (unsigned short)(pg8::cvt_pk_bf16(f, 0.f) & 0xffffu); }

#define XB_TMO      128
#define XB_XCNT(j)  (256  + 64 * (j))
#define XB_XSUB(j)  (1280 + 64 * (j))
#define XB_XGEN(j)  (2304 + 64 * (j))
#define XB_TOP      3328
#define XB_TOPGEN   3392
#define XCD_BAR_WORDS 3456
#define XB_SPIN_CAP (1u << 18)
__device__ __forceinline__ unsigned xb_ld(unsigned* p)              { return __hip_atomic_load(p, __ATOMIC_RELAXED, __HIP_MEMORY_SCOPE_AGENT); }
__device__ __forceinline__ unsigned xb_add(unsigned* p, unsigned v) { return __hip_atomic_fetch_add(p, v, __ATOMIC_RELAXED, __HIP_MEMORY_SCOPE_AGENT); }
__device__ __forceinline__ unsigned xb_xcc_id() { return (unsigned)__builtin_amdgcn_s_getreg((3 << 11) | 20) & 0xFu; }
#define XB_SPIN(cond, bar) do { unsigned _sp = 0; while (cond) { __builtin_amdgcn_s_sleep(1); \
    if ((++_sp & 255u) == 0u) { if (xb_ld(&(bar)[XB_TMO])) break; if (_sp > XB_SPIN_CAP) { atomicAdd(&(bar)[XB_TMO], 1u); break; } } } } while (0)
struct XcdBarrier { unsigned* bar; unsigned x; volatile LAS unsigned* st; };
__device__ __forceinline__ XcdBarrier xcd_barrier_post(unsigned* bar, volatile LAS unsigned* st) {
    XcdBarrier b; b.bar = bar; b.x = xb_xcc_id(); b.st = st;
    if (threadIdx.x == 0) (void)xb_add(&bar[XB_XCNT(b.x)], 1u);
    return b;
}
__device__ __forceinline__ void xcd_barrier_complete(unsigned* bar, unsigned x, unsigned& nloc, unsigned& nx) {
    const unsigned G = gridDim.x * gridDim.y * gridDim.z;
    unsigned sum, cnt, mine, sp = 0u;
    for (;;) {
        sum = 0u; cnt = 0u; mine = 0u;
#pragma unroll
        for (unsigned j = 0; j < 16; ++j) { const unsigned c = xb_ld(&bar[XB_XCNT(j)]); sum += c; cnt += (c > 0u) ? 1u : 0u; mine = (j == x) ? c : mine; }
        if (sum == G) break;
        __builtin_amdgcn_s_sleep(1);
        if ((++sp & 255u) == 0u) { if (xb_ld(&bar[XB_TMO])) break; if (sp > XB_SPIN_CAP) { atomicAdd(&bar[XB_TMO], 1u); break; } }
    }
    nloc = mine > 0u ? mine : 1u; nx = cnt > 0u ? cnt : 1u;
}
__device__ __forceinline__ void xcd_barrier(const XcdBarrier& b) {
    asm volatile("s_waitcnt vmcnt(0)" ::: "memory");
    __syncthreads();
    if (threadIdx.x == 0) {
        unsigned* bar = b.bar;
        __builtin_amdgcn_s_waitcnt(0);
        unsigned nloc = b.st[0], nx = b.st[1];
        if (nloc == 0u) { xcd_barrier_complete(bar, b.x, nloc, nx); b.st[0] = nloc; b.st[1] = nx; }
        const unsigned old = xb_add(&bar[XB_XSUB(b.x)], 1u);
        const unsigned gen = old / nloc;
        if (old + 1u == (gen + 1u) * nloc) {
            __builtin_amdgcn_fence(__ATOMIC_RELEASE, "agent");
            asm volatile("s_waitcnt vmcnt(0)" ::: "memory");
            const unsigned og = xb_add(&bar[XB_TOP], 1u);
            const unsigned tg = og / nx;
            if (og + 1u == (tg + 1u) * nx) xb_add(&bar[XB_TOPGEN], 1u);
            else XB_SPIN(xb_ld(&bar[XB_TOPGEN]) == tg, bar);
            __builtin_amdgcn_fence(__ATOMIC_ACQUIRE, "agent");
            xb_add(&bar[XB_XGEN(b.x)], 1u);
            asm volatile("s_waitcnt vmcnt(0)" ::: "memory");
        } else {
            XB_SPIN(xb_ld(&bar[XB_XGEN(b.x)]) == gen, bar);
            __builtin_amdgcn_fence(__ATOMIC_ACQUIRE, "agent");
            asm volatile("s_waitcnt vmcnt(0)" ::: "memory");
        }
    }
    __syncthreads();
}

struct Frame {
    LAS unsigned char* lds;
    volatile LAS unsigned* MISC;
    gu32* ctl;
    int tid, lane, wave, G, bid;
    const float* const* in;
    float* out;
    unsigned char* ws;
};
enum { I_XP = 0, I_XS, I_SH, I_SRGC, I_SCF, I_SPOOL, I_SSC, I_WIN, I_RGCW, I_RGCB, I_RGWA, I_RGBA, I_RGWX, I_RGBX, I_LAM, I_CFW, I_CFB, I_CFG, I_CFBB, I_POOLW, I_POOLS, I_SCW,
       I_WBR, I_WOUT, I_LN1G, I_LN1B, I_WG, I_WU, I_WD, I_LN2G, I_LN2B };

__device__ __forceinline__ float shfl_idx(float v, int src_lane) { return __builtin_bit_cast(float, __builtin_amdgcn_ds_bpermute(src_lane << 2, __builtin_bit_cast(int, v))); }
__device__ __forceinline__ float wave_sum(float v, int lane) {
#pragma unroll
    for (int o = 1; o < 64; o <<= 1) v += shfl_idx(v, lane ^ o);
    return v;
}

enum { RM_ID = 0, RM_WIN = 1, RM_GU = 2 };
template <int MODE> __device__ __forceinline__ int rowmap(int s, int extra) {
    if (MODE == RM_ID) return s;
    if (MODE == RM_GU) return 256 * (s >> 7) + (s & 127) + extra;
    if (s < 1024) return s;
    if (s < 2048) { const int j = ((s - 1024) >> 7) & 3; return 1024 + 256 * j + (s >= 1536 ? 128 : 0) + (s & 127); }
    if (s < 3072) return s;
    if (s < 4096) { const int j = ((s - 3072) >> 7) & 3; return 3072 + 256 * j + (s >= 3584 ? 128 : 0) + (s & 127); }
    const int g = (s - 4096) >> 10, ch = s & 1023, pn = ch >> 6, chl = ch & 63, wc = chl >> 4, fq = (chl >> 2) & 3, i = chl & 3;
    return 4096 + 256 * pn + 128 * (g >> 1) + 32 * wc + 8 * fq + 4 * (g & 1) + i;
}
template <int MODE>
__device__ __forceinline__ void transpose_item(const float* W, int K, int N, bf16* WT, int dst_ld, int dst_koff, int extra, LAS float* scr, int item, int lane, int nb0, int nnb) {
    const int kb = item / nnb, nb = nb0 + item % nnb, k0 = 64 * kb, n0 = 32 * nb;
#pragma unroll 8
    for (int i = 0; i < 32; ++i) { const int kk = 2 * i + (lane >> 5); scr[kk * 33 + (lane & 31)] = W[(size_t)(k0 + kk) * N + n0 + (lane & 31)]; }
    LDS_WAIT(); asm volatile("" ::: "memory");
    const int c = lane & 7; const float sc = (MODE == RM_WIN && n0 >= 4096) ? -1.44269504089f : 1.0f;
#pragma unroll
    for (int j = 0; j < 4; ++j) { const int n = (lane >> 3) + 8 * j; const LAS float* s = scr + (8 * c) * 33 + n;
        v4u o; o.x = pk2(s[0 * 33] * sc, s[1 * 33] * sc); o.y = pk2(s[2 * 33] * sc, s[3 * 33] * sc); o.z = pk2(s[4 * 33] * sc, s[5 * 33] * sc); o.w = pk2(s[6 * 33] * sc, s[7 * 33] * sc);
        *(GAS v4u*)(WT + (size_t)rowmap<MODE>(n0 + n, extra) * dst_ld + dst_koff + k0 + 8 * c) = o; }
    LDS_WAIT(); asm volatile("" ::: "memory");
}
template <int MODE>
__device__ __forceinline__ void convert_matrix(Frame& F, const float* W, int K, int N, bf16* WT, int dst_ld, int dst_koff, int extra, int gw, int NGW, int first = 0, int nb0 = 0, int nnb = 0) {
    LAS float* scr = (LAS float*)(F.lds + RING_OFF + F.wave * 16384);
    if (nnb == 0) nnb = N / 32;
    const int nitems = (K / 64) * nnb;
    int it0 = gw - first; if (it0 < 0) it0 += ((-it0 + NGW - 1) / NGW) * NGW;
    for (int it = it0; it < nitems; it += NGW) transpose_item<MODE>(W, K, N, WT, dst_ld, dst_koff, extra, scr, it, F.lane, nb0, nnb);
}
__device__ __forceinline__ void compose_pool(Frame& F, int layer, bf16* Bt3, int gw, int NGW, int first = 0) {
    const float* pw = F.in[I_POOLW] + (size_t)layer * 4 * 128 * 128; const float* ps = F.in[I_POOLS] + layer * 512; const float* Wb2 = F.in[I_WBR] + ((size_t)layer * 4 + 2) * 512 * 1024;
    const int lane = F.lane;
    LAS float* Pl = (LAS float*)(F.lds + RING_OFF + F.wave * 16384);
    int id0 = gw - first; if (id0 < 0) id0 += ((-id0 + NGW - 1) / NGW) * NGW;
    for (int id = id0; id < 512; id += NGW) {
        const int g = __builtin_amdgcn_readfirstlane(id >> 7), c0 = __builtin_amdgcn_readfirstlane(8 * ((id >> 3) & 15)), d0 = 128 * (id & 7) + 2 * lane;
#pragma unroll
        for (int k = 0; k < 4; ++k) { const int idx4 = lane + 64 * k, i = idx4 >> 5, e4 = (idx4 & 31) * 4;
            const f32x4 pv = *(const GAS f32x4*)(pw + ((size_t)g * 128 + c0 + i) * 128 + e4), sv = *(const GAS f32x4*)(ps + 128 * g + e4);
            Pl[(e4 + 0) * 8 + i] = pv.x * sv.x; Pl[(e4 + 1) * 8 + i] = pv.y * sv.y; Pl[(e4 + 2) * 8 + i] = pv.z * sv.z; Pl[(e4 + 3) * 8 + i] = pv.w * sv.w; }
        LDS_WAIT(); asm volatile("" ::: "memory");
        f32x2 acc[8];
#pragma unroll
        for (int i = 0; i < 8; ++i) acc[i] = (f32x2){0.f, 0.f};
        const float* wrow = Wb2 + (size_t)(128 * g) * 1024 + d0;
#pragma unroll 1
        for (int e0 = 0; e0 < 128; e0 += 8) {
            f32x2 wv[8];
#pragma unroll
            for (int k = 0; k < 8; ++k) wv[k] = *(const GAS f32x2*)(wrow + (size_t)(e0 + k) * 1024);
#pragma unroll
            for (int k = 0; k < 8; ++k) { const f32x4 p0 = *(const LAS f32x4*)(Pl + (e0 + k) * 8), p1 = *(const LAS f32x4*)(Pl + (e0 + k) * 8 + 4);
#pragma unroll
                for (int i = 0; i < 4; ++i) { acc[i] += wv[k] * p0[i]; acc[4 + i] += wv[k] * p1[i]; } }
        }
        v4u o0, o1;
        o0.x = pk2(acc[0].x, acc[1].x); o0.y = pk2(acc[2].x, acc[3].x); o0.z = pk2(acc[4].x, acc[5].x); o0.w = pk2(acc[6].x, acc[7].x);
        o1.x = pk2(acc[0].y, acc[1].y); o1.y = pk2(acc[2].y, acc[3].y); o1.z = pk2(acc[4].y, acc[5].y); o1.w = pk2(acc[6].y, acc[7].y);
        *(GAS v4u*)(Bt3 + (size_t)d0 * 2048 + 1024 + 128 * g + c0) = o0; *(GAS v4u*)(Bt3 + (size_t)(d0 + 1) * 2048 + 1024 + 128 * g + c0) = o1;
        LDS_WAIT(); asm volatile("" ::: "memory");
    }
}

__device__ __forceinline__ const float* xrow_in(Frame& F, int m) { return m < MP ? F.in[I_XP] + (size_t)m * DM : F.in[I_XS] + (size_t)(m - MP) * DM; }
__device__ __forceinline__ void x_to_bf16(Frame& F, bf16* XB) {
    const int gw = F.bid * NWAVES + F.wave, NGW = F.G * NWAVES;
    for (int m0 = 4 * gw; m0 < M; m0 += 4 * NGW) {
        f32x4 v[4][4];
#pragma unroll
        for (int k = 0; k < 4; ++k) { const GAS f32x4* xr = (const GAS f32x4*)xrow_in(F, m0 + k) + F.lane;
#pragma unroll
            for (int j = 0; j < 4; ++j) v[k][j] = xr[64 * j]; }
#pragma unroll
        for (int k = 0; k < 4; ++k) { GAS v2u* o = (GAS v2u*)(XB + (size_t)(m0 + k) * DM) + F.lane;
#pragma unroll
            for (int j = 0; j < 4; ++j) o[64 * j] = (v2u){pk2(v[k][j].x, v[k][j].y), pk2(v[k][j].z, v[k][j].w)}; } }
}
__device__ __forceinline__ void ln_rows(Frame& F, const float* V, float* O, const float* g, const float* b, bf16* XB, const float* sbase, const float* slab, int nslab, int wg0 = 0) {
    const int gw = ((F.bid - wg0 + F.G) % F.G) * NWAVES + F.wave, NGW = F.G * NWAVES;
    f32x4 gv[4], bv[4];
#pragma unroll
    for (int j = 0; j < 4; ++j) { gv[j] = ((const GAS f32x4*)g)[F.lane + 64 * j]; bv[j] = ((const GAS f32x4*)b)[F.lane + 64 * j]; }
    for (int m = MP + gw; m < M; m += NGW) {
        const GAS f32x4* xr = (const GAS f32x4*)(V + (size_t)m * DM) + F.lane; GAS f32x4* orow = (GAS f32x4*)(O + (size_t)m * DM) + F.lane;
        f32x4 v[4]; float s = 0.f;
#pragma unroll
        for (int j = 0; j < 4; ++j) v[j] = xr[64 * j];
        if (m >= MP) { const GAS f32x4* br = (const GAS f32x4*)(sbase + (size_t)(m - MP) * DM) + F.lane;
#pragma unroll
            for (int j = 0; j < 4; ++j) v[j] = br[64 * j] * ALPHA;
            for (int sl = 0; sl < nslab; sl += 4) {
                f32x4 t[4][4];
#pragma unroll
                for (int k = 0; k < 4; ++k) { const GAS f32x4* sr = (const GAS f32x4*)(slab + ((size_t)(sl + k < nslab ? sl + k : sl) * 512 + (m - MP)) * DM) + F.lane;
#pragma unroll
                    for (int j = 0; j < 4; ++j) t[k][j] = sr[64 * j]; }
#pragma unroll
                for (int k = 0; k < 4; ++k) if (sl + k < nslab) {
#pragma unroll
                    for (int j = 0; j < 4; ++j) v[j] += t[k][j]; } } }
#pragma unroll
        for (int j = 0; j < 4; ++j) s += (v[j].x + v[j].y) + (v[j].z + v[j].w);
        const float mean = wave_sum(s, F.lane) * (1.f / DM); float s2 = 0.f;
#pragma unroll
        for (int j = 0; j < 4; ++j) { v[j] = v[j] - mean; s2 += (v[j].x * v[j].x + v[j].y * v[j].y) + (v[j].z * v[j].z + v[j].w * v[j].w); }
        const float rstd = __builtin_amdgcn_rsqf(wave_sum(s2, F.lane) * (1.f / DM) + LN_EPS);
#pragma unroll
        for (int j = 0; j < 4; ++j) { v[j] = v[j] * rstd * gv[j] + bv[j]; orow[64 * j] = v[j]; }
        if (XB) { GAS v2u* o = (GAS v2u*)(XB + (size_t)m * DM) + F.lane;
#pragma unroll
            for (int j = 0; j < 4; ++j) o[64 * j] = (v2u){pk2(v[j].x, v[j].y), pk2(v[j].z, v[j].w)}; }
    }
}

__device__ __forceinline__ void publish_ready(Frame& F, gu32* ctr) {
    VM_WAIT(); __syncthreads();
    if (F.tid == 0) { __builtin_amdgcn_fence(__ATOMIC_RELEASE, "agent"); asm volatile("s_waitcnt vmcnt(0)" ::: "memory"); __hip_atomic_fetch_add((unsigned*)ctr, 1u, __ATOMIC_RELAXED, __HIP_MEMORY_SCOPE_AGENT); }
}
__device__ __forceinline__ float softplusf_acc(float x) { return fmaxf(x, 0.f) + log1pf(__expf(-fabsf(x))); }
__device__ __forceinline__ float expm1_neg(float x) {
    const float p = x * (1.f + x * (0.5f + x * (1.f / 6.f + x * (1.f / 24.f + x * (1.f / 120.f + x * (1.f / 720.f + x * (1.f / 5040.f)))))));
    return x > -0.25f ? p : __expf(x) - 1.f;
}
constexpr int PATCH_STRIDE = 144;

struct ALane {
    float cwD[4], cbD, ba, bx, ck;
    bf16x8 Ba[4][2], Bx[4][2];
};
constexpr int PATCH_BYTES = 5120, ASLOT_OFF = 8 * PATCH_BYTES;
__device__ __forceinline__ void a_setup(Frame& F, int layer, int n, int q, ALane& L) {
    const int c = F.lane & 15, kg = F.lane >> 4, och = 64 * n + 16 * q + c;
    const float* cw = F.in[I_RGCW] + (size_t)layer * 4 * 512 + 64 * n; const float* cb = F.in[I_RGCB] + layer * 512 + 64 * n;
#pragma unroll
    for (int j = 0; j < 4; ++j) L.cwD[j] = cw[j * 512 + 16 * q + c];
    L.cbD = cb[16 * q + c];
    L.ck = 8.0f * softplusf_acc(-F.in[I_LAM][layer * 512 + och]);
    const float* wa = F.in[I_RGWA] + ((size_t)layer * 8 + n) * 4096 + 16 * q + c; const float* wx = F.in[I_RGWX] + ((size_t)layer * 8 + n) * 4096 + 16 * q + c;
    float wav[16], wxv[16], cbv[16];
#pragma unroll
    for (int e = 0; e < 16; ++e) { const int k = (e < 8 ? 8 * kg + e : 32 + 8 * kg + (e - 8)); wav[e] = wa[k * 64]; wxv[e] = wx[k * 64]; cbv[e] = cb[k]; }
#pragma unroll
    for (int j = 0; j < 4; ++j) { float t[16];
#pragma unroll
        for (int e = 0; e < 16; ++e) t[e] = cw[j * 512 + (e < 8 ? 8 * kg + e : 32 + 8 * kg + (e - 8))];
        L.Ba[j][0] = __builtin_bit_cast(bf16x8, (v4u){pk2(wav[0] * t[0], wav[1] * t[1]), pk2(wav[2] * t[2], wav[3] * t[3]), pk2(wav[4] * t[4], wav[5] * t[5]), pk2(wav[6] * t[6], wav[7] * t[7])});
        L.Ba[j][1] = __builtin_bit_cast(bf16x8, (v4u){pk2(wav[8] * t[8], wav[9] * t[9]), pk2(wav[10] * t[10], wav[11] * t[11]), pk2(wav[12] * t[12], wav[13] * t[13]), pk2(wav[14] * t[14], wav[15] * t[15])});
        L.Bx[j][0] = __builtin_bit_cast(bf16x8, (v4u){pk2(wxv[0] * t[0], wxv[1] * t[1]), pk2(wxv[2] * t[2], wxv[3] * t[3]), pk2(wxv[4] * t[4], wxv[5] * t[5]), pk2(wxv[6] * t[6], wxv[7] * t[7])});
        L.Bx[j][1] = __builtin_bit_cast(bf16x8, (v4u){pk2(wxv[8] * t[8], wxv[9] * t[9]), pk2(wxv[10] * t[10], wxv[11] * t[11]), pk2(wxv[12] * t[12], wxv[13] * t[13]), pk2(wxv[14] * t[14], wxv[15] * t[15])}); }
    float sa = 0.f, sx = 0.f;
#pragma unroll
    for (int e = 0; e < 16; ++e) { sa = fmaf(cbv[e], wav[e], sa); sx = fmaf(cbv[e], wxv[e], sx); }
    sa += shfl_idx(sa, F.lane ^ 16); sa += shfl_idx(sa, F.lane ^ 32); sx += shfl_idx(sx, F.lane ^ 16); sx += shfl_idx(sx, F.lane ^ 32);
    L.ba = F.in[I_RGBA][layer * 512 + och] + sa; L.bx = F.in[I_RGBX][layer * 512 + och] + sx;
}
__device__ __forceinline__ void a_block(const ALane& L, const LAS unsigned char* patch, int rowA0, int baseD, int q, int lane, float (&a)[4], float (&bb)[4]) {
    const int c = lane & 15, kg = lane >> 4;
    f32x4 accR = (f32x4){0.f, 0.f, 0.f, 0.f}, accI = (f32x4){0.f, 0.f, 0.f, 0.f};
#pragma unroll
    for (int j = 0; j < 4; ++j) { const LAS unsigned char* rp = patch + (rowA0 + j) * PATCH_STRIDE + 16 * kg;
        const bf16x8 A0 = *(const LAS bf16x8*)rp, A1 = *(const LAS bf16x8*)(rp + 64);
        accR = __builtin_amdgcn_mfma_f32_16x16x32_bf16(A0, L.Ba[j][0], accR, 0, 0, 0); accR = __builtin_amdgcn_mfma_f32_16x16x32_bf16(A1, L.Ba[j][1], accR, 0, 0, 0);
        accI = __builtin_amdgcn_mfma_f32_16x16x32_bf16(A0, L.Bx[j][0], accI, 0, 0, 0); accI = __builtin_amdgcn_mfma_f32_16x16x32_bf16(A1, L.Bx[j][1], accI, 0, 0, 0); }
    float pv[7];
#pragma unroll
    for (int k = 0; k < 7; ++k) pv[k] = bf1(*(const LAS unsigned short*)(patch + (baseD + k) * PATCH_STRIDE + 2 * (16 * q + c)));
#pragma unroll
    for (int r = 0; r < 4; ++r) {
        const float xd = L.cbD + L.cwD[0] * pv[r] + L.cwD[1] * pv[r + 1] + L.cwD[2] * pv[r + 2] + L.cwD[3] * pv[r + 3];
        const float rr = pg8::sigmoidf_fast(accR[r] + L.ba), ii = pg8::sigmoidf_fast(accI[r] + L.bx);
        const float la = -L.ck * rr;
        const float av = __builtin_amdgcn_exp2f(1.44269504089f * la);
        a[r] = av; bb[r] = __builtin_amdgcn_sqrtf(fmaxf(1.f - av * av, 0.f)) * (ii * xd);
    }
}
struct BlkScan { float Ac[4], Bc[4], EA, EB, WA, WB; };
__device__ __forceinline__ void blk_scan(const float (&a)[4], const float (&bb)[4], int lane, BlkScan& S) {
    const int c = lane & 15, g = lane >> 4;
    S.Ac[0] = a[0]; S.Bc[0] = bb[0];
#pragma unroll
    for (int r = 1; r < 4; ++r) { S.Ac[r] = a[r] * S.Ac[r - 1]; S.Bc[r] = a[r] * S.Bc[r - 1] + bb[r]; }
    float IA = S.Ac[3], IB = S.Bc[3];
    { const float pa = shfl_idx(IA, lane - 16), pb = shfl_idx(IB, lane - 16); if (g >= 1) { IB = IA * pb + IB; IA = IA * pa; } }
    { const float pa = shfl_idx(IA, lane - 32), pb = shfl_idx(IB, lane - 32); if (g >= 2) { IB = IA * pb + IB; IA = IA * pa; } }
    S.EA = shfl_idx(IA, lane - 16); S.EB = shfl_idx(IB, lane - 16); if (g == 0) { S.EA = 1.f; S.EB = 0.f; }
    S.WA = shfl_idx(IA, 48 + c); S.WB = shfl_idx(IB, 48 + c);
}
__device__ __forceinline__ void a_prompt_item(Frame& F, int layer, int item, const bf16* Z, bf16* Y) {
    const int b = item >> 5, n = (item >> 2) & 7, q = item & 3, lane = opqv(F.lane), w = F.wave, c = lane & 15, g = lane >> 4, och = 64 * n + 16 * q + c;
    ALane L; a_setup(F, layer, n, q, L);
    LAS unsigned char* patch = F.lds + RING_OFF + w * PATCH_BYTES;
    LAS f32x2* slots = (LAS f32x2*)(F.lds + RING_OFF + ASLOT_OFF);
    const bf16* Zb = Z + (size_t)b * SEQ * ZC; bf16* Yb = Y + (size_t)b * SEQ * YC;
    float hrun = 0.f;
    v4u pf[5];
    auto load_patch = [&](int tb) {
#pragma unroll
        for (int k = 0; k < 5; ++k) { const int ci = lane + 64 * k, pr = ci >> 3, cc = ci & 7, t = tb - 3 + pr;
            pf[k] = (ci < 280 && t >= 0) ? *(const GAS v4u*)(Zb + (size_t)t * ZC + 64 * n + 8 * cc) : (v4u){0u, 0u, 0u, 0u}; }
    };
    load_patch(32 * w);
    for (int it = 0; it < 8; ++it) {
        const int tb = 256 * it + 32 * w;
#pragma unroll
        for (int k = 0; k < 5; ++k) { const int ci = lane + 64 * k, pr = ci >> 3, cc = ci & 7; if (ci < 280) *(LAS v4u*)(patch + pr * PATCH_STRIDE + 16 * cc) = pf[k]; }
        if (it < 7) load_patch(tb + 256);
        unsigned short gav[8];
#pragma unroll
        for (int r = 0; r < 8; ++r) gav[r] = ((const GAS unsigned short*)Zb)[(unsigned)((tb + 16 * (r >> 2) + 4 * g + (r & 3)) * ZC + 512 + och)];
        asm volatile("" ::: "memory");
        float a0[4], b0[4], a1[4], b1[4];
        a_block(L, patch, lane & 15, 4 * g, q, lane, a0, b0);
        a_block(L, patch, 16 + (lane & 15), 16 + 4 * g, q, lane, a1, b1);
        BlkScan S0, S1; blk_scan(a0, b0, lane, S0); blk_scan(a1, b1, lane, S1);
        if (lane < 16) slots[((it & 1) * 8 + w) * 16 + c] = (f32x2){S0.WA * S1.WA, S1.WA * S0.WB + S1.WB};
        __syncthreads();
        float hin = hrun, hw = 0.f;
#pragma unroll
        for (int ww = 0; ww < 8; ++ww) { const f32x2 s = slots[((it & 1) * 8 + ww) * 16 + c]; if (ww == w) hw = hin; hin = s.x * hin + s.y; }
        hrun = hin;
        const float hg0 = S0.EA * hw + S0.EB, hw1 = S0.WA * hw + S0.WB, hg1 = S1.EA * hw1 + S1.EB;
#pragma unroll
        for (int r = 0; r < 4; ++r) { const float h = S0.Ac[r] * hg0 + S0.Bc[r];
            ((GAS unsigned short*)Yb)[(unsigned)((tb + 4 * g + r) * YC + och)] = f2bf(h * bf1(gav[r])); }
#pragma unroll
        for (int r = 0; r < 4; ++r) { const float h = S1.Ac[r] * hg1 + S1.Bc[r];
            ((GAS unsigned short*)Yb)[(unsigned)((tb + 16 + 4 * g + r) * YC + och)] = f2bf(h * bf1(gav[4 + r]));
            if (r == 3 && it == 7 && w == 7 && g == 3) F.out[O_PH + (size_t)(layer * 8 + b) * 512 + och] = h; }
    }
}
__device__ __forceinline__ void a_sample_task(Frame& F, int layer, int task, const bf16* Z, bf16* Y) {
    const int blk = task >> 5, n = (task >> 2) & 7, q = task & 3, lane = opqv(F.lane), c = lane & 15, g = lane >> 4, och = 64 * n + 16 * q + c, s0 = 4 * blk;
    ALane L; a_setup(F, layer, n, q, L);
    LAS unsigned char* patch = F.lds + RING_OFF + F.wave * PATCH_BYTES;
#pragma unroll
    for (int k = 0; k < 4; ++k) { const int ci = lane + 64 * k; if (ci < 224) { const int pr = ci >> 3, cc = ci & 7, sq = pr / 7, tau = pr - 7 * sq - 3, seq = s0 + sq; v4u v;
            if (tau < 0) { const GAS f32x4* sp = (const GAS f32x4*)(F.in[I_SRGC] + ((size_t)(layer * 128 + seq) * 3 + (tau + 3)) * 512 + 64 * n + 8 * cc); const f32x4 f0 = sp[0], f1 = sp[1];
                v = (v4u){pk2(f0.x, f0.y), pk2(f0.z, f0.w), pk2(f1.x, f1.y), pk2(f1.z, f1.w)}; }
            else v = *(const GAS v4u*)(Z + (size_t)(MP + 4 * seq + tau) * ZC + 64 * n + 8 * cc);
            *(LAS v4u*)(patch + pr * PATCH_STRIDE + 16 * cc) = v; } }
    asm volatile("" ::: "memory");
    float a[4], bb[4];
    a_block(L, patch, 7 * ((lane & 15) >> 2) + (lane & 3), 7 * g, q, lane, a, bb);
    const int seq = s0 + g;
    float h = F.in[I_SH][(size_t)(layer * 128 + seq) * 512 + och];
#pragma unroll
    for (int r = 0; r < 4; ++r) { h = a[r] * h + bb[r]; const size_t row = (size_t)(MP + 4 * seq + r);
        *(GAS unsigned short*)(Y + row * YC + och) = f2bf(h * bf1(*(const GAS unsigned short*)(Z + row * ZC + 512 + och))); }
    F.out[O_SH + (size_t)(layer * 128 + seq) * 512 + och] = h;
}

__device__ __forceinline__ void ln_silu_row(const LAS float* xr, const float* g, const float* b, bf16* dst, int lane) {
    const f32x4 v0 = *(const LAS f32x4*)(xr + 4 * lane), v1 = *(const LAS f32x4*)(xr + 256 + 4 * lane);
    const float s = (v0.x + v0.y) + (v0.z + v0.w) + (v1.x + v1.y) + (v1.z + v1.w);
    const float mean = wave_sum(s, lane) * (1.f / 512.f);
    const f32x4 d0 = v0 - mean, d1 = v1 - mean;
    const float s2 = (d0.x * d0.x + d0.y * d0.y) + (d0.z * d0.z + d0.w * d0.w) + (d1.x * d1.x + d1.y * d1.y) + (d1.z * d1.z + d1.w * d1.w);
    const float rstd = __builtin_amdgcn_rsqf(wave_sum(s2, lane) * (1.f / 512.f) + LN_EPS);
    const f32x4 g0 = *(const GAS f32x4*)(g + 4 * lane), g1 = *(const GAS f32x4*)(g + 256 + 4 * lane), b0 = *(const GAS f32x4*)(b + 4 * lane), b1 = *(const GAS f32x4*)(b + 256 + 4 * lane);
    f32x4 y0 = d0 * rstd * g0 + b0, y1 = d1 * rstd * g1 + b1;
#pragma unroll
    for (int i = 0; i < 4; ++i) { y0[i] = y0[i] * pg8::sigmoidf_fast(y0[i]); y1[i] = y1[i] * pg8::sigmoidf_fast(y1[i]); }
    *(GAS v2u*)(dst + 4 * lane) = (v2u){pk2(y0.x, y0.y), pk2(y0.z, y0.w)}; *(GAS v2u*)(dst + 256 + 4 * lane) = (v2u){pk2(y1.x, y1.y), pk2(y1.z, y1.w)};
}
__device__ __forceinline__ void ln_silu_rows4(const LAS float* xr, int rstride, const float* g, const float* b, bf16* dst, size_t dstride, int lane) {
    f32x4 v0[4], v1[4]; float s[4], s2[4];
#pragma unroll
    for (int k = 0; k < 4; ++k) { v0[k] = *(const LAS f32x4*)(xr + k * rstride + 4 * lane); v1[k] = *(const LAS f32x4*)(xr + k * rstride + 256 + 4 * lane);
        s[k] = (v0[k].x + v0[k].y) + (v0[k].z + v0[k].w) + (v1[k].x + v1[k].y) + (v1[k].z + v1[k].w); }
#pragma unroll
    for (int o = 1; o < 64; o <<= 1) {
#pragma unroll
        for (int k = 0; k < 4; ++k) s[k] += shfl_idx(s[k], lane ^ o); }
#pragma unroll
    for (int k = 0; k < 4; ++k) { const float mean = s[k] * (1.f / 512.f); v0[k] = v0[k] - mean; v1[k] = v1[k] - mean;
        s2[k] = (v0[k].x * v0[k].x + v0[k].y * v0[k].y) + (v0[k].z * v0[k].z + v0[k].w * v0[k].w) + (v1[k].x * v1[k].x + v1[k].y * v1[k].y) + (v1[k].z * v1[k].z + v1[k].w * v1[k].w); }
#pragma unroll
    for (int o = 1; o < 64; o <<= 1) {
#pragma unroll
        for (int k = 0; k < 4; ++k) s2[k] += shfl_idx(s2[k], lane ^ o); }
    const f32x4 g0 = *(const GAS f32x4*)(g + 4 * lane), g1 = *(const GAS f32x4*)(g + 256 + 4 * lane), b0 = *(const GAS f32x4*)(b + 4 * lane), b1 = *(const GAS f32x4*)(b + 256 + 4 * lane);
#pragma unroll
    for (int k = 0; k < 4; ++k) { const float rstd = __builtin_amdgcn_rsqf(s2[k] * (1.f / 512.f) + LN_EPS);
        f32x4 y0 = v0[k] * rstd * g0 + b0, y1 = v1[k] * rstd * g1 + b1;
#pragma unroll
        for (int i = 0; i < 4; ++i) { y0[i] = y0[i] * pg8::sigmoidf_fast(y0[i]); y1[i] = y1[i] * pg8::sigmoidf_fast(y1[i]); }
        bf16* d = dst + (size_t)k * dstride;
        *(GAS v2u*)(d + 4 * lane) = (v2u){pk2(y0.x, y0.y), pk2(y0.z, y0.w)}; *(GAS v2u*)(d + 256 + 4 * lane) = (v2u){pk2(y1.x, y1.y), pk2(y1.z, y1.w)}; }
}
__device__ __forceinline__ void b_prompt_item(Frame& F, int layer, int item, const bf16* Z, bf16* Y) {
    const int tidl = opqv(F.tid), b = item >> 5, t0 = 64 * (item & 31), p = tidl & 255, hh = tidl >> 8, ts = t0 + 32 * hh;
    const GAS unsigned* Zu = (const GAS unsigned*)(Z + (size_t)b * SEQ * ZC) + 512 + p;
    unsigned raw[62];
#pragma unroll
    for (int i = 0; i < 62; ++i) { const int t = ts - 30 + i; raw[i] = t >= 0 ? Zu[(size_t)t * (ZC / 2)] : 0u; }
    const float* cw = F.in[I_CFW] + (size_t)layer * 31 * 512 + 2 * p;
    f32x2 wj[31];
#pragma unroll
    for (int j = 0; j < 31; ++j) wj[j] = *(const GAS f32x2*)(cw + j * 512);
    const f32x2 bias = *(const GAS f32x2*)(F.in[I_CFB] + layer * 512 + 2 * p);
    f32x2 in[62];
#pragma unroll
    for (int i = 0; i < 62; ++i) in[i] = (f32x2){bflo(raw[i]), bfhi(raw[i])};
    LAS float* obuf = (LAS float*)(F.lds + RING_OFF);
#pragma unroll
    for (int i = 0; i < 32; ++i) { f32x2 o = bias;
#pragma unroll
        for (int j = 0; j < 31; ++j) o += wj[j] * in[i + j];
        *(LAS f32x2*)(obuf + (32 * hh + i) * 512 + 2 * p) = o; }
    __syncthreads();
    const float* lg = F.in[I_CFG] + layer * 512; const float* lb = F.in[I_CFBB] + layer * 512;
#pragma unroll 1
    for (int r = 8 * F.wave; r < 8 * F.wave + 8; r += 4) ln_silu_rows4(obuf + r * 512, 512, lg, lb, Y + (size_t)(b * SEQ + t0 + r) * YC + 512, YC, F.lane);
}
__device__ __forceinline__ void cd_prompt_item(Frame& F, int layer, int item, const bf16* Z, bf16* Y) {
    const int tidl = opqv(F.tid), b = item >> 5, t0 = 64 * (item & 31), p = tidl & 255, hh = tidl >> 8;
    const bf16* Zb = Z + (size_t)b * SEQ * ZC;
    LAS unsigned* cbuf = (LAS unsigned*)(F.lds + RING_OFF);
    { v4u tmp[10];
#pragma unroll
      for (int k = 0; k < 10; ++k) { const int ci = tidl + 512 * k, pr = ci >> 6, cc = ci & 63, t = t0 - 15 + pr;
          tmp[k] = (ci < 79 * 64 && t >= 0) ? *(const GAS v4u*)(Zb + (size_t)t * ZC + 1536 + 8 * cc) : (v4u){0u, 0u, 0u, 0u}; }
#pragma unroll
      for (int k = 0; k < 10; ++k) { const int ci = tidl + 512 * k, pr = ci >> 6, cc = ci & 63; if (ci < 79 * 64) *(LAS v4u*)(cbuf + pr * 256 + 4 * cc) = tmp[k]; } }
    const int ts = t0 + 32 * hh;
    unsigned uu[34], dd[32];
#pragma unroll
    for (int i = 0; i < 34; ++i) { const int t = ts - 2 + i; uu[i] = t >= 0 ? ((const GAS unsigned*)(Zb + (size_t)t * ZC))[1280 + p] : 0u; }
#pragma unroll
    for (int i = 0; i < 32; ++i) dd[i] = ((const GAS unsigned*)(Zb + (size_t)(ts + i) * ZC))[1024 + p];
    const f32x2 w0 = ((const GAS f32x2*)(F.in[I_SCW] + (size_t)(layer * 3 + 0) * 512))[p], w1 = ((const GAS f32x2*)(F.in[I_SCW] + (size_t)(layer * 3 + 1) * 512))[p],
                w2 = ((const GAS f32x2*)(F.in[I_SCW] + (size_t)(layer * 3 + 2) * 512))[p];
    __syncthreads();
    const int w = 2 << (p >> 6), rr0 = 15 + 32 * hh;
    f32x2 s = (f32x2){0.f, 0.f};
    for (int j = 0; j < w; ++j) { const unsigned v = cbuf[(rr0 - j) * 256 + p]; s += (f32x2){bflo(v), bfhi(v)}; }
    GAS unsigned* Yu = (GAS unsigned*)(Y + (size_t)(b * SEQ + ts) * YC) + p;
#pragma unroll
    for (int i = 0; i < 32; ++i) { const int t = ts + i, rr = rr0 + i;
        const unsigned cur = cbuf[rr * 256 + p]; const f32x2 cf = (f32x2){bflo(cur), bfhi(cur)};
        if (i > 0) { const unsigned old = cbuf[(rr - w) * 256 + p]; s += cf - (f32x2){bflo(old), bfhi(old)}; }
        const float ic = __builtin_amdgcn_rcpf((float)(t + 1 < w ? t + 1 : w));
        const f32x2 mm = s * ic - cf;
        Yu[(size_t)i * 1024 + 512] = pk2(mm.x, mm.y);
        const f32x2 cv = w0 * (f32x2){bflo(uu[i]), bfhi(uu[i])} + w1 * (f32x2){bflo(uu[i + 1]), bfhi(uu[i + 1])} + w2 * (f32x2){bflo(uu[i + 2]), bfhi(uu[i + 2])};
        const f32x2 yd = (f32x2){bflo(dd[i]), bfhi(dd[i])} * cv;
        Yu[(size_t)i * 1024 + 768] = pk2(yd.x, yd.y); }
}
__device__ __forceinline__ void s_sample_item(Frame& F, int layer, int s, const bf16* Z, bf16* Y) {
    const int ch = opqv(F.tid); const size_t ls = (size_t)layer * 128 + s;
    const bf16* Zr = Z + (size_t)(MP + 4 * s) * ZC; bf16* Yr = Y + (size_t)(MP + 4 * s) * YC;
    LAS float* obuf = (LAS float*)(F.lds + RING_OFF);
    float in[34], wv[31], pb[19], u[6], dbv[4];
#pragma unroll
    for (int j = 0; j < 30; ++j) in[j] = (F.in[I_SCF] + (ls * 30 + j) * 512)[ch];
#pragma unroll
    for (int j = 0; j < 15; ++j) pb[j] = (F.in[I_SPOOL] + (ls * 15 + j) * 512)[ch];
    u[0] = (F.in[I_SSC] + (ls * 2 + 0) * 512)[ch]; u[1] = (F.in[I_SSC] + (ls * 2 + 1) * 512)[ch];
#pragma unroll
    for (int r = 0; r < 4; ++r) { in[30 + r] = bf1((Zr + (size_t)r * ZC + 1024)[ch]); pb[15 + r] = bf1((Zr + (size_t)r * ZC + 1536)[ch]); u[2 + r] = bf1((Zr + (size_t)r * ZC + 2560)[ch]); dbv[r] = bf1((Zr + (size_t)r * ZC + 2048)[ch]); }
#pragma unroll
    for (int j = 0; j < 31; ++j) wv[j] = (F.in[I_CFW] + ((size_t)layer * 31 + j) * 512)[ch];
    const float bias = (F.in[I_CFB] + layer * 512)[ch];
    const float w0 = (F.in[I_SCW] + (size_t)(layer * 3 + 0) * 512)[ch], w1 = (F.in[I_SCW] + (size_t)(layer * 3 + 1) * 512)[ch], w2 = (F.in[I_SCW] + (size_t)(layer * 3 + 2) * 512)[ch];
    asm volatile("" ::: "memory");
#pragma unroll
    for (int j = 0; j < 26; ++j) (F.out + O_SCF + (ls * 30 + j) * 512)[ch] = in[j + 4];
#pragma unroll
    for (int r = 0; r < 4; ++r) { float o = bias;
#pragma unroll
        for (int j = 0; j < 31; ++j) o += wv[j] * in[r + j];
        obuf[r * 512 + ch] = o; }
#pragma unroll
    for (int j = 0; j < 11; ++j) (F.out + O_SPOOL + (ls * 15 + j) * 512)[ch] = pb[j + 4];
    const int gsel = ch >> 7;
#pragma unroll
    for (int r = 0; r < 4; ++r) { const int k = 15 + r;
        const float s2 = pb[k] + pb[k - 1], s4 = s2 + pb[k - 2] + pb[k - 3], s8 = s4 + (pb[k - 4] + pb[k - 5]) + (pb[k - 6] + pb[k - 7]);
        float s16 = s8;
#pragma unroll
        for (int j = 8; j < 16; ++j) s16 += pb[k - j];
        const float mv = (gsel == 0 ? s2 * 0.5f : gsel == 1 ? s4 * 0.25f : gsel == 2 ? s8 * 0.125f : s16 * 0.0625f) - pb[k];
        (Yr + (size_t)r * YC + 1024)[ch] = f2bf(mv); }
#pragma unroll
    for (int r = 0; r < 4; ++r) (Yr + (size_t)r * YC + 1536)[ch] = f2bf(dbv[r] * (w0 * u[r] + w1 * u[r + 1] + w2 * u[r + 2]));
    __syncthreads();
    if (F.wave < 4) ln_silu_row(obuf + F.wave * 512, F.in[I_CFG] + layer * 512, F.in[I_CFBB] + layer * 512, Yr + (size_t)F.wave * YC + 512, F.lane);
}

struct Args { const float* in[31]; float* out; unsigned char* ws; int ph_lo, ph_hi; };
__global__ void __launch_bounds__(NWAVES * 64, 2) hybrid_fwd(Args args) {
    extern __shared__ __attribute__((aligned(16))) unsigned char lds[];
    Frame F;
    F.lds = (LAS unsigned char*)lds;
    F.MISC = (volatile LAS unsigned*)(F.lds + MISC_OFF);
    const int wave0 = __builtin_amdgcn_readfirstlane((int)threadIdx.x >> 6);
    F.lane = lane_now(); F.wave = wave0; F.tid = F.wave * 64 + F.lane;
    F.G = gridDim.x; F.bid = blockIdx.x;
    F.ws = args.ws; F.out = args.out; F.ctl = (gu32*)(args.ws + WS_CTL);
    F.in = args.in;
    for (int u = F.tid; u < (LDS_BYTES - LDSCTL_OFF) / 4; u += NWAVES * 64) ((LAS unsigned*)(F.lds + LDSCTL_OFF))[u] = 0u;
    __syncthreads();
    XcdBarrier bar; bar.bar = (unsigned*)(F.ctl + CW_BAR); bar.x = 0; bar.st = nullptr;
    if (!MK_SPLIT) bar = xcd_barrier_post((unsigned*)(F.ctl + CW_BAR), F.MISC + 8);
    const int lo = args.ph_lo, hi = args.ph_hi;
#define IN(k) (lo <= (k) && (k) < hi)
#define REFRESH() do { F.lane = lane_now(); F.wave = opqs(wave0); F.tid = F.wave * 64 + F.lane; F.bid = opqs((int)blockIdx.x); } while (0)
#define SEAM(k) do { if (IN(k) && IN((k) + 1)) xcd_barrier(bar); } while (0)
    bf16* WA = (bf16*)(F.ws + WS_WA); bf16* XB = (bf16*)(F.ws + WS_XB); bf16* Y = (bf16*)(F.ws + WS_Y); bf16* Zm = (bf16*)(F.ws + WS_ZG); _Float16* Gb = (_Float16*)(F.ws + WS_ZG);
    bf16* Hb = (bf16*)(F.ws + WS_ZG); bf16* Bt3 = (bf16*)(F.ws + WS_BT3); bf16* Bt4 = (bf16*)(F.ws + WS_BT4); bf16* Bt5 = (bf16*)(F.ws + WS_BT5); bf16* Bt6 = (bf16*)(F.ws + WS_BT6);

    if (IN(0)) { REFRESH(); convert_matrix<RM_WIN>(F, F.in[I_WIN], DM, INC, WA, DM, 0, 0, F.bid * NWAVES + F.wave, F.G * NWAVES, 0, 0, F.G == 256 ? 128 : 0); REFRESH(); x_to_bf16(F, XB); }
    SEAM(0);

    const bool fast = F.G == 256;
    for (int l = 0; l < 2; ++l) {
        const int pb = 1 + 9 * l;
        if (IN(pb + 0)) for (int rep = 0; rep < NREP(0); ++rep) { if (rep) xcd_barrier(bar);
            if (fast && l == 1 && rep == 0) { REFRESH();
                ln_rows(F, F.out, F.out, F.in[I_LN2G], F.in[I_LN2B], XB, F.out + (size_t)MP * DM, (const float*)(F.ws + WS_SLAB), 11, 32); publish_ready(F, F.ctl + CW_RDY + 64 * 1); }
            pg8::Gemm g{XB, WA, DM, DM}; pg8::UnitOrder S; S.init(pg8::SK_PLAIN, 4096, DM, F.G, F.bid, 0); pg8::EpiMix E{Zm, F.out, l};
            if (fast && l == 1) { S.ready = (const unsigned*)(F.ctl + CW_RDY + 64 * 1); S.need = (unsigned)F.G; }
            pg8::gemm_phase<pg8::EpiMix, pg8::UnitOrder, true>(F.lds + RING_OFF, g, S, E, wave0);
            if (F.G == 256 && F.bid >= 32) {
                REFRESH(); const int gw = (F.bid - 32) * NWAVES + F.wave, NGW = 224 * NWAVES; const float* wbr = F.in[I_WBR] + (size_t)l * 4 * 512 * 1024;
                convert_matrix<RM_ID>(F, wbr, 512, 1024, Bt3, 2048, 0, 0, gw, NGW, 0);
                convert_matrix<RM_ID>(F, wbr + (size_t)512 * 1024, 512, 1024, Bt3, 2048, 512, 0, gw, NGW, 256);
                convert_matrix<RM_ID>(F, wbr + (size_t)3 * 512 * 1024, 512, 1024, Bt3, 2048, 1536, 0, gw, NGW, 512);
                convert_matrix<RM_ID>(F, F.in[I_WOUT] + (size_t)l * DM * DM, DM, DM, Bt4, DM, 0, 0, gw, NGW, 768);
                REFRESH(); compose_pool(F, l, Bt3, gw, NGW, 1280);
                REFRESH(); convert_matrix<RM_WIN>(F, F.in[I_WIN] + (size_t)l * DM * INC, DM, INC, WA, DM, 0, 0, gw, NGW, 0, 128, 128); } }
        SEAM(pb + 0);
        if (IN(pb + 1)) for (int rep = 0; rep < NREP(1); ++rep) { if (rep) xcd_barrier(bar);
            __syncthreads(); REFRESH();
            for (int r2 = 0; r2 < NREP2(0); ++r2) for (int it = F.bid; it < 256; it += F.G) { a_prompt_item(F, l, it, Zm, Y); __syncthreads(); }
            REFRESH();
            for (int r2 = 0; r2 < NREP2(1); ++r2) for (int it = (F.bid + 128) % F.G; it < 128; it += F.G) a_sample_task(F, l, 8 * it + F.wave, Zm, Y);
            __syncthreads(); REFRESH();
            const bool rebal = F.G == 256, gemm_wg = rebal && F.bid >= 128 && F.bid < 160;
            for (int r2 = 0; r2 < NREP2(2); ++r2) { if (!gemm_wg) for (int it = F.bid; it < 256; it += F.G) { b_prompt_item(F, l, it, Zm, Y); __syncthreads(); }
                if (rebal && F.bid >= 160 && F.bid < 192) { b_prompt_item(F, l, F.bid - 32, Zm, Y); __syncthreads(); } }
            REFRESH();
            for (int r2 = 0; r2 < NREP2(3); ++r2) { if (!gemm_wg) for (int it = F.bid; it < 256; it += F.G) { cd_prompt_item(F, l, it, Zm, Y); __syncthreads(); }
                if (rebal && F.bid >= 192 && F.bid < 224) { cd_prompt_item(F, l, F.bid - 64, Zm, Y); __syncthreads(); } }
            REFRESH();
            for (int r2 = 0; r2 < NREP2(4); ++r2) for (int it = F.bid; it < 128; it += F.G) { s_sample_item(F, l, it, Zm, Y); __syncthreads(); }
            if (F.G == 256 && F.bid >= 128 && F.bid < 160) {
                pg8::Gemm g{XB, WA + (size_t)4096 * DM, DM, DM}; pg8::UnitOrder S; S.init(pg8::SK_PLAIN, 4096, DM, 32, F.bid - 128, 0, false, true); pg8::EpiGate E{Gb};
                pg8::gemm_phase<pg8::EpiGate, pg8::UnitOrder, true>(F.lds + RING_OFF, g, S, E, wave0); }
            REFRESH();
            const float* wbr = F.in[I_WBR] + (size_t)l * 4 * 512 * 1024;
            if (F.G != 256) { const int gw = F.bid * NWAVES + F.wave, NGW = F.G * NWAVES;
                convert_matrix<RM_ID>(F, wbr, 512, 1024, Bt3, 2048, 0, 0, gw, NGW); convert_matrix<RM_ID>(F, wbr + (size_t)512 * 1024, 512, 1024, Bt3, 2048, 512, 0, gw, NGW);
                convert_matrix<RM_ID>(F, wbr + (size_t)3 * 512 * 1024, 512, 1024, Bt3, 2048, 1536, 0, gw, NGW); convert_matrix<RM_ID>(F, F.in[I_WOUT] + (size_t)l * DM * DM, DM, DM, Bt4, DM, 0, 0, gw, NGW);
                REFRESH(); compose_pool(F, l, Bt3, gw, NGW); }
        }
        SEAM(pb + 1);
        if (IN(pb + 2)) for (int rep = 0; rep < NREP(2); ++rep) { if (rep) xcd_barrier(bar); pg8::Gemm g{XB, WA + (size_t)4096 * DM, DM, DM}; pg8::UnitOrder S; S.init(pg8::SK_PLAIN, 4096, DM, F.G, F.bid, 0, true, F.G != 256); pg8::EpiGate E{Gb};
            pg8::gemm_phase<pg8::EpiGate, pg8::UnitOrder, true>(F.lds + RING_OFF, g, S, E, wave0); }
        SEAM(pb + 2);
        if (IN(pb + 3)) for (int rep = 0; rep < NREP(3); ++rep) { if (rep) xcd_barrier(bar); pg8::Gemm g{Y, Bt3, 2048, 2048}; pg8::UnitOrder S; S.init(pg8::SK_P3, DM, 2048, F.G, F.bid, 0); pg8::EpiMerge E{Gb, XB, (bf16*)(F.ws + WS_MB4S)};
            pg8::gemm_phase<pg8::EpiMerge, pg8::UnitOrder, true>(F.lds + RING_OFF, g, S, E, wave0);
            if (F.G == 256 && F.bid >= 32 && rep + 1 == NREP(3)) {
                REFRESH(); const int gw = (F.bid - 32) * NWAVES + F.wave, NGW = 224 * NWAVES;
                convert_matrix<RM_GU>(F, F.in[I_WG] + (size_t)l * DM * FF, DM, FF, Bt5, DM, 0, 0, gw, NGW, 0);
                convert_matrix<RM_GU>(F, F.in[I_WU] + (size_t)l * DM * FF, DM, FF, Bt5, DM, 0, 128, gw, NGW, 1408); } }
        SEAM(pb + 3);
        if (IN(pb + 4)) for (int rep = 0; rep < 1; ++rep) { pg8::Gemm g{XB, Bt4, DM, DM}; pg8::UnitOrder S; S.init(pg8::SK_P4, DM, DM, F.G, F.bid, (long)(WS_MB4S - WS_XB));
            pg8::EpiRes E{l == 0 ? F.in[I_XP] : F.out, F.out, XB, F.in[I_LN1G] + l * DM, F.in[I_LN1B] + l * DM, (float*)(F.ws + WS_SLAB),
                          pg8::PanelStats{(unsigned*)(F.ws + WS_XCH + (size_t)(2 * l) * 512 * 1024), (unsigned*)(F.ctl + CW_SEAM + (2 * l) * SEAM_BANK)}, F.lds + XLDS_OFF, wave0};
            pg8::gemm_phase<pg8::EpiRes, pg8::UnitOrder, true>(F.lds + RING_OFF, g, S, E, wave0);
}
        SEAM(pb + 4);
        if (IN(pb + 5) && !fast) for (int rep = 0; rep < NREP(5); ++rep) { if (rep) xcd_barrier(bar);
            REFRESH();
            ln_rows(F, F.out, rep + 1 < NREP(5) ? (float*)(F.ws + WS_Y) : F.out, F.in[I_LN1G] + l * DM, F.in[I_LN1B] + l * DM, rep + 1 < NREP(5) ? nullptr : XB, l == 0 ? F.in[I_XS] : F.out + (size_t)MP * DM, (const float*)(F.ws + WS_SLAB), 16);
            REFRESH();
            if (F.G != 256) { const int gw = F.bid * NWAVES + F.wave, NGW = F.G * NWAVES;
                convert_matrix<RM_GU>(F, F.in[I_WG] + (size_t)l * DM * FF, DM, FF, Bt5, DM, 0, 0, gw, NGW); convert_matrix<RM_GU>(F, F.in[I_WU] + (size_t)l * DM * FF, DM, FF, Bt5, DM, 0, 128, gw, NGW);
                convert_matrix<RM_ID>(F, F.in[I_WD] + (size_t)l * FF * DM, FF, DM, Bt6, FF, 0, 0, gw, NGW); }
        }
        if (!fast) SEAM(pb + 5);
        if (IN(pb + 6)) for (int rep = 0; rep < NREP(6); ++rep) { if (rep) xcd_barrier(bar);
            if (fast && rep == 0) { REFRESH();
                ln_rows(F, F.out, F.out, F.in[I_LN1G] + l * DM, F.in[I_LN1B] + l * DM, XB, l == 0 ? F.in[I_XS] : F.out + (size_t)MP * DM, (const float*)(F.ws + WS_SLAB), 16, 172); publish_ready(F, F.ctl + CW_RDY + 64 * (2 * l)); }
            pg8::Gemm g{XB, Bt5, DM, DM}; pg8::UnitOrder S; S.init(pg8::SK_PLAIN, 2 * FF, DM, F.G, F.bid, 0); pg8::EpiSwi E{Hb};
            if (fast) { S.ready = (const unsigned*)(F.ctl + CW_RDY + 64 * (2 * l)); S.need = (unsigned)F.G; }
            pg8::gemm_phase<pg8::EpiSwi, pg8::UnitOrder, true>(F.lds + RING_OFF, g, S, E, wave0);
            if (F.G == 256 && F.bid >= 172 && rep + 1 == NREP(6)) {
                REFRESH(); const int gw = (F.bid - 172) * NWAVES + F.wave, NGW = 84 * NWAVES;
                convert_matrix<RM_ID>(F, F.in[I_WD] + (size_t)l * FF * DM, FF, DM, Bt6, FF, 0, 0, gw, NGW, 0);
            } }
        SEAM(pb + 6);
        if (IN(pb + 7)) for (int rep = 0; rep < 1; ++rep) { pg8::Gemm g{Hb, Bt6, FF, FF}; pg8::UnitOrder S; S.init(pg8::SK_P6, DM, FF, F.G, F.bid, 0); pg8::EpiRes E{F.out, F.out, l == 0 ? XB : nullptr, F.in[I_LN2G] + l * DM, F.in[I_LN2B] + l * DM, (float*)(F.ws + WS_SLAB),
                          pg8::PanelStats{(unsigned*)(F.ws + WS_XCH + (size_t)(2 * l + 1) * 512 * 1024), (unsigned*)(F.ctl + CW_SEAM + (2 * l + 1) * SEAM_BANK)}, F.lds + XLDS_OFF, wave0};
            pg8::gemm_phase<pg8::EpiRes, pg8::UnitOrder, true>(F.lds + RING_OFF, g, S, E, wave0);
            if (F.G == 256 && F.bid >= 88 && l == 0) {
                REFRESH(); convert_matrix<RM_WIN>(F, F.in[I_WIN] + (size_t)DM * INC, DM, INC, WA, DM, 0, 0, (F.bid - 88) * NWAVES + F.wave, 168 * NWAVES, 0, 0, 128); } }
        SEAM(pb + 7);
        if (IN(pb + 8) && !(fast && l == 0)) for (int rep = 0; rep < NREP(8); ++rep) { if (rep) xcd_barrier(bar);
            REFRESH();
            ln_rows(F, F.out, rep + 1 < NREP(8) ? (float*)(F.ws + WS_Y) : F.out, F.in[I_LN2G] + l * DM, F.in[I_LN2B] + l * DM, (l == 0 && rep + 1 == NREP(8)) ? XB : nullptr, F.out + (size_t)MP * DM, (const float*)(F.ws + WS_SLAB), 11);
            REFRESH();
            if (l == 0 && F.G != 256) convert_matrix<RM_WIN>(F, F.in[I_WIN] + (size_t)DM * INC, DM, INC, WA, DM, 0, 0, F.bid * NWAVES + F.wave, F.G * NWAVES);
        }
        if (l == 0 && !fast) SEAM(pb + 8);
    }
#undef IN
#undef SEAM
#undef REFRESH
}

extern "C" void kernel_launch(void* const* d_in, const int* in_sizes, int n_in, void* d_out, int out_size, void* d_ws, size_t ws_size, hipStream_t stream) {
    static int grid = 0;
    if (grid == 0) {
        if (n_in != 31 || out_size != (int)O_END || ws_size < WS_END) { fprintf(stderr, "kernel_launch: unexpected sizes n_in %d out %d ws %zu\n", n_in, out_size, ws_size); grid = -1; return; }
        int dev = 0, cus = 0, per_cu = 0;
        if (hipGetDevice(&dev) != hipSuccess || hipDeviceGetAttribute(&cus, hipDeviceAttributeMultiprocessorCount, dev) != hipSuccess) { grid = -1; return; }
        if (hipFuncSetAttribute((const void*)hybrid_fwd, hipFuncAttributeMaxDynamicSharedMemorySize, LDS_BYTES) != hipSuccess) { fprintf(stderr, "kernel_launch: hipFuncSetAttribute failed\n"); grid = -1; return; }
        if (hipOccupancyMaxActiveBlocksPerMultiprocessor(&per_cu, (const void*)hybrid_fwd, NWAVES * 64, LDS_BYTES) != hipSuccess || per_cu < 1)
            fprintf(stderr, "kernel_launch: occupancy query reports %d workgroups per CU\n", per_cu);
        (void)hipGetLastError();
        grid = cus;
    }
    if (grid < 0) return;
    if (hipMemsetAsync((char*)d_ws + WS_CTL, 0, CTL_ZERO_BYTES, stream) != hipSuccess) { fprintf(stderr, "kernel_launch: memset failed\n"); return; }
    Args a{};
    for (int i = 0; i < 31; ++i) a.in[i] = (const float*)d_in[i];
    a.out = (float*)d_out; a.ws = (unsigned char*)d_ws;
#if MK_SPLIT
    for (int ph = 0; ph < NPHASE; ++ph) { a.ph_lo = ph; a.ph_hi = ph + 1; hipLaunchKernelGGL(hybrid_fwd, dim3(grid), dim3(NWAVES * 64), LDS_BYTES, stream, a); }
#else
    a.ph_lo = 0; a.ph_hi = NPHASE;
    hipLaunchKernelGGL(hybrid_fwd, dim3(grid), dim3(NWAVES * 64), LDS_BYTES, stream, a);
#endif
}
```

```cpp
#include <hip/hip_runtime.h>
#include <cstdio>
#include <cstdint>

#ifndef PROBE_REP
#define PROBE_REP 0
#endif
#define NREP(k) (1 + ((PROBE_REP >> (k)) & 1))
#ifndef PROBE2
#define PROBE2 0
#endif
#define NREP2(j) (1 + ((PROBE2 >> (j)) & 1))
#ifndef MK_SPLIT
#define MK_SPLIT 0
#endif

constexpr int DM = 1024, WMIX = 512, NPB = 8, SEQ = 2048, NSB = 128, DSEQ = 4;
constexpr int MP = NPB * SEQ, MS = NSB * DSEQ, M = MP + MS;
constexpr int FF = 2816, INC = 8192, ZC = 3072, YC = 2048, GC = 4096;
constexpr float LN_EPS = 1e-5f, ALPHA = 1.41421356237f;
constexpr size_t O_Y = 0, O_PH = (size_t)M * DM, O_PRGC = O_PH + 8192, O_PCF = O_PRGC + 24576, O_PPOOL = O_PCF + 245760, O_PSC = O_PPOOL + 122880,
                 O_SH = O_PSC + 16384, O_SRGC = O_SH + 131072, O_SCF = O_SRGC + 393216, O_SPOOL = O_SCF + 3932160, O_SSC = O_SPOOL + 1966080, O_END = O_SSC + 262144;
static_assert(O_END == 24403968, "output map");

__device__ __forceinline__ int opqv(int v) { asm volatile("" : "+v"(v)); return v; }
__device__ __forceinline__ int lane_now() { int l; asm volatile("v_mbcnt_lo_u32_b32 %0, -1, 0\n\tv_mbcnt_hi_u32_b32 %0, -1, %0" : "=v"(l)); return l; }
__device__ __forceinline__ int opqs(int v) { asm volatile("" : "+s"(v)); return v; }
namespace pg8 {
#define PG8_LAS __attribute__((address_space(3)))
typedef unsigned short bf16_t;
typedef short bf16x8 __attribute__((ext_vector_type(8)));
typedef float f32x4 __attribute__((ext_vector_type(4)));
typedef float f32x2 __attribute__((ext_vector_type(2)));
typedef unsigned u32x4 __attribute__((ext_vector_type(4)));
typedef unsigned u32x2 __attribute__((ext_vector_type(2)));
typedef _Float16 f16x4 __attribute__((ext_vector_type(4)));
typedef _Float16 f16x8 __attribute__((ext_vector_type(8)));
constexpr int BM = 256, BK = 64, HALF = 128, HTB = HALF * BK * 2, STAGE_BYTES = 8 * HTB, NXCD = 8, WGM = 8;

__host__ __device__ __forceinline__ int lds_byte(int r, int c) { const int st = (r >> 4) * 2 + (c >> 5), rr = r & 15, cc = c & 31, ob = rr * 64 + cc * 2; return st * 1024 + (ob ^ (((ob >> 9) & 1) << 5)); }
__host__ __device__ __forceinline__ void stage_rc(int b, int& R, int& C) { const int st = b / 1024, sb = b % 1024, swz = sb ^ (((sb >> 9) & 1) << 5); R = (st >> 1) * 16 + swz / 64; C = (st & 1) * 32 + (swz % 64) / 2; }
__host__ __device__ __forceinline__ int perm32(int rho) { const int n = rho >> 4, i = rho & 15; return 8 * (i >> 2) + 4 * n + (i & 3); }

struct Unit { int pm, pn, nt, mode, aux; long offA, offB; };
struct Gemm { const bf16_t* A; const bf16_t* Bt; int lda, ldb; const bf16_t* As; };

enum { SK_PLAIN = 0, SK_P3 = 1, SK_P4 = 2, SK_P6 = 3 };
struct UnitOrder {
    int kind, nN, nwgP, nS, ntP, G, c; long offA_s; const unsigned* ready = nullptr; unsigned need = 0;
    __device__ __forceinline__ void init(int kind_, int N_, int K_, int G_, int c_, long offA_s_, bool prompt = true, bool sample = true) { kind = kind_; nN = N_ / BM; nwgP = prompt ? 64 * nN : 0; ntP = K_ / BK; G = G_; c = c_; offA_s = offA_s_;
        nS = !sample ? 0 : kind_ == SK_PLAIN ? 2 * nN : kind_ == SK_P3 ? 32 : kind_ == SK_P4 ? 128 : 88; }
    __device__ __forceinline__ bool next(int i, Unit& u, const Gemm& g) const {
        const long L = (long)i * G + c; const long ra = (long)BM * g.lda * 2, rb = (long)BM * g.ldb * 2;
        if (L < nwgP) {
            int wgid = (int)L; { const int q = nwgP / NXCD, xcd = wgid % NXCD, off = wgid / NXCD; wgid = xcd * q + off; }
            const int nig = WGM * nN; u.pm = (wgid / nig) * WGM + ((wgid % nig) % WGM); u.pn = (wgid % nig) / WGM;
            u.nt = ntP; u.mode = 0; u.aux = 0; u.offA = u.pm * ra; u.offB = u.pn * rb; return true; }
        const int s = (int)(L - nwgP); if (s >= nS) return false;
        if (kind == SK_PLAIN) { u.pm = 64 + (s & 1); u.pn = s >> 1; u.nt = ntP; u.mode = 0; u.aux = 0; u.offA = u.pm * ra; u.offB = u.pn * rb; }
        else if (kind == SK_P3) { const int n = s & 3, tile = s >> 2; u.pm = 64 + (tile & 1); u.pn = tile >> 1; u.nt = 8; u.mode = 1; u.aux = n; u.offA = u.pm * ra + 1024 * n; u.offB = u.pn * rb + 1024 * n; }
        else if (kind == SK_P4) { const int ch = s & 15, tile = s >> 4, n = ch >> 2, kin = (ch & 3) * 256; u.pm = 64 + (tile & 1); u.pn = tile >> 1; u.nt = 4; u.mode = 1; u.aux = ch;
            u.offA = ((long)(n * 512 + (u.pm - 64) * 256) * 1024 + kin) * 2; u.offB = u.pn * rb + kin * 2; }
        else { const int ch = s % 11, tile = s / 11; u.pm = 64 + (tile & 1); u.pn = tile >> 1; u.nt = 4; u.mode = 1; u.aux = ch; u.offA = u.pm * ra + 512 * ch; u.offB = u.pn * rb + 512 * ch; }
        return true;
    }
    __device__ __forceinline__ void a_ready(const Unit& u, int wid) const {
        if (ready == nullptr || u.pm < 64) return;
        if (wid == 0) { unsigned spins = 0;
            while ((unsigned)__builtin_amdgcn_readfirstlane(__hip_atomic_load(ready, __ATOMIC_RELAXED, __HIP_MEMORY_SCOPE_AGENT)) < need) { __builtin_amdgcn_s_sleep(2); if (++spins > (1u << 20)) break; }
            __builtin_amdgcn_fence(__ATOMIC_ACQUIRE, "agent");
            asm volatile("s_waitcnt vmcnt(0)" ::: "memory"); }
        asm volatile("" ::: "memory"); __builtin_amdgcn_s_barrier(); asm volatile("" ::: "memory");
    }
};

__device__ __forceinline__ unsigned cvt_pk_bf16(float lo, float hi) { unsigned r; asm volatile("v_cvt_pk_bf16_f32 %0, %1, %2" : "=v"(r) : "v"(lo), "v"(hi)); return r; }
__device__ __forceinline__ float sigmoidf_fast(float x) { return __builtin_amdgcn_rcpf(1.0f + __builtin_amdgcn_exp2f(-1.44269504089f * x)); }
__device__ __forceinline__ float gelu_tanh(float x) { const float t = x * x, y = x * fmaf(t, -0.10294324f, -2.3022082f); return x * __builtin_amdgcn_rcpf(1.0f + __builtin_amdgcn_exp2f(y)); }

__device__ __forceinline__ void acc_zero(f32x4 (&acc)[2][2][4][2]) {
#pragma unroll
    for (int a = 0; a < 2; ++a)
#pragma unroll
        for (int b = 0; b < 2; ++b)
#pragma unroll
            for (int m = 0; m < 4; ++m)
#pragma unroll
                for (int n = 0; n < 2; ++n) acc[a][b][m][n] = (f32x4){0.f, 0.f, 0.f, 0.f};
}
__device__ __forceinline__ float* state_ptr(float* out, int R, int keep, int layer, size_t p_off, size_t s_off) {
    if (R < MP) { const int b = R >> 11, j = (R & 2047) - (2048 - keep); return j < 0 ? nullptr : out + p_off + (size_t)((layer * 8 + b) * keep + j) * 512; }
    const int s = (R - MP) >> 2, j = (R & 3) + keep - 4; return j < 0 ? nullptr : out + s_off + (size_t)((layer * 128 + s) * keep + j) * 512;
}

struct EpiMix {
    static constexpr bool PERM = true, MIDK = false;
    __device__ __forceinline__ void init(f32x4 (&acc)[2][2][4][2], const Unit&, int, int) const { acc_zero(acc); }
    bf16_t* Z; float* out; int layer;
    __device__ __forceinline__ void midk(f32x4 (&)[2][2][4][2], const Unit&, int, int, int, int, int) const {}
    __device__ __forceinline__ void operator()(f32x4 (&acc)[2][2][4][2], const Unit& u, int wr, int wc, int fr_, int fq_) const {
        const int lane_ = lane_now(), fr = lane_ & 15, fq = lane_ >> 4; (void)fr_; (void)fq_;
        const int pn = u.pn; int type, zcol, keep = 0, scol = 0; size_t poff = 0, soff = 0;
        if (pn < 2) { type = 0; zcol = 256 * pn; keep = 3; scol = zcol; poff = O_PRGC; soff = O_SRGC; }
        else if (pn < 4) { type = 1; zcol = 512 + 256 * (pn - 2); }
        else if (pn < 8) { type = 2; zcol = 1024 + 128 * (pn - 4); keep = 30; scol = 128 * (pn - 4); poff = O_PCF; soff = O_SCF; }
        else if (pn < 10) { type = 0; zcol = 1536 + 256 * (pn - 8); keep = 15; scol = 256 * (pn - 8); poff = O_PPOOL; soff = O_SPOOL; }
        else if (pn < 12) { type = 0; zcol = 2048 + 256 * (pn - 10); }
        else { type = 3; zcol = 2560 + 128 * (pn - 12); keep = 2; scol = 128 * (pn - 12); poff = O_PSC; soff = O_SSC; }
        const bool tail = keep != 0 && (u.pm >= 64 || (u.pm & 7) == 7);
        const int row0 = u.pm * BM + wr * 64 + fr, cl = wc * 32 + 8 * fq;
        if (type < 2) {
#pragma unroll
            for (int ai = 0; ai < 2; ++ai)
#pragma unroll
                for (int m = 0; m < 4; ++m) { const int R = row0 + ai * HALF + m * 16; bf16_t* rowp = Z + (size_t)R * ZC + zcol + cl;
                    float* sp = tail ? state_ptr(out, R, keep, layer, poff, soff) : nullptr;
#pragma unroll
                    for (int bj = 0; bj < 2; ++bj) { f32x4 v0 = acc[ai][bj][m][0], v1 = acc[ai][bj][m][1];
                        if (type == 1) { v0 = (f32x4){gelu_tanh(v0[0]), gelu_tanh(v0[1]), gelu_tanh(v0[2]), gelu_tanh(v0[3])}; v1 = (f32x4){gelu_tanh(v1[0]), gelu_tanh(v1[1]), gelu_tanh(v1[2]), gelu_tanh(v1[3])}; }
                        u32x4 w; w.x = cvt_pk_bf16(v0[0], v0[1]); w.y = cvt_pk_bf16(v0[2], v0[3]); w.z = cvt_pk_bf16(v1[0], v1[1]); w.w = cvt_pk_bf16(v1[2], v1[3]);
                        *(u32x4*)(rowp + bj * HALF) = w;
                        if (sp) { *(f32x4*)(sp + scol + cl + bj * HALF) = v0; *(f32x4*)(sp + scol + cl + bj * HALF + 4) = v1; } } }
        } else {
#pragma unroll
            for (int ai = 0; ai < 2; ++ai)
#pragma unroll
                for (int m = 0; m < 4; ++m) { const int R = row0 + ai * HALF + m * 16; bf16_t* rowp = Z + (size_t)R * ZC + zcol + cl;
                    float* sp = tail ? state_ptr(out, R, keep, layer, poff, soff) : nullptr;
                    f32x4 v0, v1; const f32x4 a0 = acc[ai][0][m][0], a1 = acc[ai][0][m][1], b0 = acc[ai][1][m][0], b1 = acc[ai][1][m][1];
                    if (type == 2) {
#pragma unroll
                        for (int i = 0; i < 4; ++i) { v0[i] = a0[i] * sigmoidf_fast(b0[i]); v1[i] = a1[i] * sigmoidf_fast(b1[i]); }
                    } else { v0 = a0 * b0; v1 = a1 * b1; }
                    u32x4 w; w.x = cvt_pk_bf16(v0[0], v0[1]); w.y = cvt_pk_bf16(v0[2], v0[3]); w.z = cvt_pk_bf16(v1[0], v1[1]); w.w = cvt_pk_bf16(v1[2], v1[3]);
                    *(u32x4*)rowp = w;
                    if (sp) { *(f32x4*)(sp + scol + cl) = v0; *(f32x4*)(sp + scol + cl + 4) = v1; } }
        }
    }
};

struct EpiGate {
    static constexpr bool PERM = true, MIDK = false;
    __device__ __forceinline__ void init(f32x4 (&acc)[2][2][4][2], const Unit&, int, int) const { acc_zero(acc); }
    _Float16* G;
    __device__ __forceinline__ void midk(f32x4 (&)[2][2][4][2], const Unit&, int, int, int, int, int) const {}
    __device__ __forceinline__ void operator()(f32x4 (&acc)[2][2][4][2], const Unit& u, int wr, int wc, int fr_, int fq_) const {
        const int lane_ = lane_now(), fr = lane_ & 15, fq = lane_ >> 4; (void)fr_; (void)fq_;
        const int row0 = u.pm * BM + wr * 64 + fr, ch0 = 64 * u.pn + 16 * wc + 4 * fq; const bool plain = u.pm >= 64;
#pragma unroll
        for (int ai = 0; ai < 2; ++ai)
#pragma unroll
            for (int m = 0; m < 4; ++m) { const int R = row0 + ai * HALF + m * 16; _Float16* gp = G + (size_t)R * GC + ch0;
                f16x4 r0, r1, r2, g3;
#pragma unroll
                for (int i = 0; i < 4; ++i) {
                    const float d0 = 1.f + __builtin_amdgcn_exp2f(__builtin_amdgcn_fmed3f(acc[ai][0][m][0][i], -15.f, 15.f)), d1 = 1.f + __builtin_amdgcn_exp2f(__builtin_amdgcn_fmed3f(acc[ai][0][m][1][i], -15.f, 15.f));
                    const float d2 = 1.f + __builtin_amdgcn_exp2f(__builtin_amdgcn_fmed3f(acc[ai][1][m][0][i], -15.f, 15.f)), d3 = 1.f + __builtin_amdgcn_exp2f(__builtin_amdgcn_fmed3f(acc[ai][1][m][1][i], -15.f, 15.f));
                    const float i0 = __builtin_amdgcn_rcpf(d0), i1 = __builtin_amdgcn_rcpf(d1), i2 = __builtin_amdgcn_rcpf(d2), i3 = __builtin_amdgcn_rcpf(d3);
                    if (plain) { r0[i] = (_Float16)i0; r1[i] = (_Float16)i1; r2[i] = (_Float16)i2; }
                    else { r0[i] = (_Float16)(d1 * i0); r1[i] = (_Float16)(d2 * i1); r2[i] = (_Float16)(d3 * i2); }
                    g3[i] = (_Float16)i3; }
                *(f16x4*)(gp) = r0; *(f16x4*)(gp + 1024) = r1; *(f16x4*)(gp + 2048) = r2; *(f16x4*)(gp + 3072) = g3; }
    }
};

struct EpiMerge {
    static constexpr bool PERM = true, MIDK = true;
    __device__ __forceinline__ void init(f32x4 (&acc)[2][2][4][2], const Unit&, int, int) const { acc_zero(acc); }
    const _Float16* G; bf16_t* O; bf16_t* Os;
    __device__ __forceinline__ void scale(f32x4 (&acc)[2][2][4][2], const Unit& u, int seg, int wr, int wc) const {
        const int lane_ = lane_now(), fr = lane_ & 15, fq = lane_ >> 4;
        const int row0 = u.pm * BM + wr * 64 + fr, c0 = 1024 * seg + 256 * u.pn + wc * 32 + 8 * fq;
#pragma unroll
        for (int ai = 0; ai < 2; ++ai)
#pragma unroll
            for (int m = 0; m < 4; ++m) { const _Float16* gp = G + (size_t)(row0 + ai * HALF + m * 16) * GC + c0;
#pragma unroll
                for (int bj = 0; bj < 2; ++bj) { const f16x8 f = *(const f16x8*)(gp + bj * HALF);
                    acc[ai][bj][m][0] *= (f32x4){(float)f[0], (float)f[1], (float)f[2], (float)f[3]}; acc[ai][bj][m][1] *= (f32x4){(float)f[4], (float)f[5], (float)f[6], (float)f[7]}; } }
    }
    __device__ __forceinline__ void midk(f32x4 (&acc)[2][2][4][2], const Unit& u, int seg, int wr, int wc, int, int) const { scale(acc, u, seg, wr, wc); }
    __device__ __forceinline__ void operator()(f32x4 (&acc)[2][2][4][2], const Unit& u, int wr, int wc, int, int) const {
        scale(acc, u, u.mode ? u.aux : 3, wr, wc);
        const int lane_ = lane_now(), fr = lane_ & 15, fq = lane_ >> 4;
        const int row0 = (u.mode ? (u.pm - 64) * BM + 512 * u.aux : u.pm * BM) + wr * 64 + fr, c0 = 256 * u.pn + wc * 32 + 8 * fq;
        bf16_t* O = u.mode ? Os : this->O;
#pragma unroll
        for (int ai = 0; ai < 2; ++ai)
#pragma unroll
            for (int m = 0; m < 4; ++m) { bf16_t* rowp = O + (size_t)(row0 + ai * HALF + m * 16) * DM + c0;
#pragma unroll
                for (int bj = 0; bj < 2; ++bj) { const f32x4 v0 = acc[ai][bj][m][0], v1 = acc[ai][bj][m][1];
                    u32x4 w; w.x = cvt_pk_bf16(v0[0], v0[1]); w.y = cvt_pk_bf16(v0[2], v0[3]); w.z = cvt_pk_bf16(v1[0], v1[1]); w.w = cvt_pk_bf16(v1[2], v1[3]); *(u32x4*)(rowp + bj * HALF) = w; } }
    }
};

struct PanelStats {
    unsigned* xbuf;
    unsigned* cnt;
    __device__ __forceinline__ void run(const f32x4 (&v)[2][2][4][2], const Unit& u, int wr, int wc, PG8_LAS unsigned char* lds, int wid) const {
        const int lane = lane_now(), fr = lane & 15, fq = lane >> 4;
        PG8_LAS f32x2* P = (PG8_LAS f32x2*)lds;
        PG8_LAS f32x2* S = (PG8_LAS f32x2*)(lds + 8192);
#pragma unroll
        for (int ai = 0; ai < 2; ++ai)
#pragma unroll
            for (int m = 0; m < 4; ++m) {
                float s = 0.f;
#pragma unroll
                for (int bj = 0; bj < 2; ++bj)
#pragma unroll
                    for (int n = 0; n < 2; ++n) { const f32x4 x = v[ai][bj][m][n]; s += (x[0] + x[1]) + (x[2] + x[3]); }
                s += __builtin_bit_cast(float, __builtin_amdgcn_ds_bpermute((lane ^ 16) << 2, __builtin_bit_cast(int, s))); s += __builtin_bit_cast(float, __builtin_amdgcn_ds_bpermute((lane ^ 32) << 2, __builtin_bit_cast(int, s)));
                const float mw = s * (1.0f / 64.0f); float q = 0.f;
#pragma unroll
                for (int bj = 0; bj < 2; ++bj)
#pragma unroll
                    for (int n = 0; n < 2; ++n) { const f32x4 d = v[ai][bj][m][n] - mw; q += (d[0] * d[0] + d[1] * d[1]) + (d[2] * d[2] + d[3] * d[3]); }
                q += __builtin_bit_cast(float, __builtin_amdgcn_ds_bpermute((lane ^ 16) << 2, __builtin_bit_cast(int, q))); q += __builtin_bit_cast(float, __builtin_amdgcn_ds_bpermute((lane ^ 32) << 2, __builtin_bit_cast(int, q)));
                if (fq == 0) P[(ai * HALF + wr * 64 + m * 16 + fr) * 4 + wc] = (f32x2){mw, q};
            }
        asm volatile("s_waitcnt lgkmcnt(0)" ::: "memory"); __builtin_amdgcn_s_barrier(); asm volatile("" ::: "memory");
        const int row = wid * 32 + (lane & 31);
        if (lane < 32) {
            const f32x2 a = P[row * 4 + 0], b = P[row * 4 + 1], c = P[row * 4 + 2], d = P[row * 4 + 3];
            const float mt = (a.x + b.x + c.x + d.x) * 0.25f;
            const float da = a.x - mt, db = b.x - mt, dc = c.x - mt, dd = d.x - mt;
            const float m2 = (a.y + b.y) + (c.y + d.y) + 64.0f * ((da * da + db * db) + (dc * dc + dd * dd));
            unsigned long long* slot = (unsigned long long*)xbuf + ((size_t)(u.pm * BM + row) * 4 + u.pn);
            __hip_atomic_store(slot, ((unsigned long long)__float_as_uint(m2) << 32) | __float_as_uint(mt), __ATOMIC_RELAXED, __HIP_MEMORY_SCOPE_AGENT);
        }
        asm volatile("s_waitcnt vmcnt(0)" ::: "memory");
        if (lane == 0) __hip_atomic_fetch_add(cnt + 64 * u.pm, 1u, __ATOMIC_RELAXED, __HIP_MEMORY_SCOPE_AGENT);
        if (wid == 0) {
            unsigned spins = 0;
            while ((unsigned)__builtin_amdgcn_readfirstlane(__hip_atomic_load(cnt + 64 * u.pm, __ATOMIC_RELAXED, __HIP_MEMORY_SCOPE_AGENT)) < 32u) { __builtin_amdgcn_s_sleep(2); if (++spins > (1u << 20)) break; }
            __builtin_amdgcn_fence(__ATOMIC_ACQUIRE, "agent");
        }
        asm volatile("s_waitcnt vmcnt(0) lgkmcnt(0)" ::: "memory"); __builtin_amdgcn_s_barrier(); asm volatile("" ::: "memory");
        if (lane < 32) {
            const unsigned long long* slot = (const unsigned long long*)xbuf + (size_t)(u.pm * BM + row) * 4; float mt[4], m2[4]; float ms = 0.f;
#pragma unroll
            for (int t = 0; t < 4; ++t) { const unsigned long long w = __hip_atomic_load(slot + t, __ATOMIC_RELAXED, __HIP_MEMORY_SCOPE_AGENT); mt[t] = __uint_as_float((unsigned)w); m2[t] = __uint_as_float((unsigned)(w >> 32)); ms += mt[t]; }
            const float mean = ms * 0.25f; float q = 0.f;
#pragma unroll
            for (int t = 0; t < 4; ++t) { const float dm = mt[t] - mean; q += m2[t] + 256.0f * dm * dm; }
            S[row] = (f32x2){mean, __builtin_amdgcn_rsqf(q * (1.0f / 1024.0f) + LN_EPS)};
        }
        asm volatile("s_waitcnt lgkmcnt(0)" ::: "memory"); __builtin_amdgcn_s_barrier(); asm volatile("" ::: "memory");
    }
};
struct EpiRes {
    static constexpr bool PERM = false, MIDK = false;
    __device__ __forceinline__ void init(f32x4 (&acc)[2][2][4][2], const Unit& u, int wr, int wc) const {
        if (u.mode) { acc_zero(acc); return; }
        const int lane_ = lane_now(), fr = lane_ & 15, fq = lane_ >> 4;
        const size_t e0 = (size_t)(u.pm * BM + wr * 64 + fr) * DM + 256 * u.pn + wc * 32 + 4 * fq;
        if (base16) {
#pragma unroll
            for (int ai = 0; ai < 2; ++ai)
#pragma unroll
                for (int m = 0; m < 4; ++m)
#pragma unroll
                    for (int bj = 0; bj < 2; ++bj)
#pragma unroll
                        for (int n = 0; n < 2; ++n) { const u32x2 w = *(const u32x2*)(base16 + e0 + (size_t)(ai * HALF + m * 16) * DM + bj * HALF + n * 16);
                            acc[ai][bj][m][n] = (f32x4){__uint_as_float(w.x << 16), __uint_as_float(w.x & 0xffff0000u), __uint_as_float(w.y << 16), __uint_as_float(w.y & 0xffff0000u)} * ALPHA; }
            return; }
#pragma unroll
        for (int ai = 0; ai < 2; ++ai)
#pragma unroll
            for (int m = 0; m < 4; ++m)
#pragma unroll
                for (int bj = 0; bj < 2; ++bj)
#pragma unroll
                    for (int n = 0; n < 2; ++n) acc[ai][bj][m][n] = *(const f32x4*)(baseP + e0 + (size_t)(ai * HALF + m * 16) * DM + bj * HALF + n * 16) * ALPHA;
    }
    const float* baseP; const bf16_t* base16; float* out; bf16_t* xb; const float* lng; const float* lnb; float* slab; PanelStats st; PG8_LAS unsigned char* xlds; int wid;
    __device__ __forceinline__ void midk(f32x4 (&)[2][2][4][2], const Unit&, int, int, int, int, int) const {}
    __device__ __forceinline__ void operator()(f32x4 (&acc)[2][2][4][2], const Unit& u, int wr, int wc, int fr_, int fq_) const {
        const int lane_ = lane_now(), fr = lane_ & 15, fq = lane_ >> 4; (void)fr_; (void)fq_;
        const int row0 = u.pm * BM + wr * 64 + fr, c0 = 256 * u.pn + wc * 32 + 4 * fq;
        if (u.mode) {
#pragma unroll
            for (int ai = 0; ai < 2; ++ai)
#pragma unroll
                for (int m = 0; m < 4; ++m) { float* op = slab + ((size_t)u.aux * 512 + (row0 - MP) + ai * HALF + m * 16) * DM + c0;
#pragma unroll
                    for (int bj = 0; bj < 2; ++bj)
#pragma unroll
                        for (int n = 0; n < 2; ++n) *(f32x4*)(op + bj * HALF + n * 16) = acc[ai][bj][m][n]; }
            return; }
        st.run(acc, u, wr, wc, xlds, wid);
        const PG8_LAS f32x2* S = (const PG8_LAS f32x2*)(xlds + 8192);
#pragma unroll
        for (int bj = 0; bj < 2; ++bj)
#pragma unroll
            for (int n = 0; n < 2; ++n) { const int cc = c0 + bj * HALF + n * 16; const f32x4 gv = *(const f32x4*)(lng + cc), bv = *(const f32x4*)(lnb + cc);
#pragma unroll
                for (int ai = 0; ai < 2; ++ai)
#pragma unroll
                    for (int m = 0; m < 4; ++m) { const int r = ai * HALF + wr * 64 + m * 16 + fr; const f32x2 sr = S[r]; const size_t off = (size_t)(u.pm * BM + r) * DM + cc;
                        const f32x4 o = (acc[ai][bj][m][n] - sr.x) * sr.y * gv + bv; if (out) *(f32x4*)(out + off) = o;
                        if (xb) { u32x2 w; w.x = cvt_pk_bf16(o[0], o[1]); w.y = cvt_pk_bf16(o[2], o[3]); *(u32x2*)(xb + off) = w; }
                        if (m & 1) asm volatile("" ::: "memory"); } }
    }
};

struct EpiSwi {
    static constexpr bool PERM = true, MIDK = false;
    __device__ __forceinline__ void init(f32x4 (&acc)[2][2][4][2], const Unit&, int, int) const { acc_zero(acc); }
    bf16_t* H;
    __device__ __forceinline__ void midk(f32x4 (&)[2][2][4][2], const Unit&, int, int, int, int, int) const {}
    __device__ __forceinline__ void operator()(f32x4 (&acc)[2][2][4][2], const Unit& u, int wr, int wc, int fr_, int fq_) const {
        const int lane_ = lane_now(), fr = lane_ & 15, fq = lane_ >> 4; (void)fr_; (void)fq_;
        const int row0 = u.pm * BM + wr * 64 + fr, c0 = 128 * u.pn + wc * 32 + 8 * fq;
#pragma unroll
        for (int ai = 0; ai < 2; ++ai)
#pragma unroll
            for (int m = 0; m < 4; ++m) { bf16_t* rowp = H + (size_t)(row0 + ai * HALF + m * 16) * FF + c0;
                const f32x4 g0 = acc[ai][0][m][0], g1 = acc[ai][0][m][1], u0 = acc[ai][1][m][0], u1 = acc[ai][1][m][1]; f32x4 v0, v1;
#pragma unroll
                for (int i = 0; i < 4; ++i) { v0[i] = g0[i] * sigmoidf_fast(g0[i]) * u0[i]; v1[i] = g1[i] * sigmoidf_fast(g1[i]) * u1[i]; }
                u32x4 w; w.x = cvt_pk_bf16(v0[0], v0[1]); w.y = cvt_pk_bf16(v0[2], v0[3]); w.z = cvt_pk_bf16(v1[0], v1[1]); w.w = cvt_pk_bf16(v1[2], v1[3]);
                *(u32x4*)rowp = w; }
    }
};

template <class Epi, class Sched, bool ALIGN_EPI>
__device__ __forceinline__ void gemm_phase(PG8_LAS unsigned char* lds, const Gemm g, const Sched& S, const Epi& E, int wave_id) {
    const int wid = opqs(wave_id), lane = lane_now(), tid = wid * 64 + lane, wr = wid >> 2, wc = wid & 3, fr = lane & 15, fq = lane >> 4;
    unsigned voffA[2], voffB[2];
#pragma unroll
    for (int i = 0; i < 2; ++i) { int R, C; stage_rc(tid * 16 + i * 8192, R, C); const int Rb = Epi::PERM ? ((R & ~31) + perm32(R & 31)) : R;
        voffA[i] = (unsigned)(R * g.lda + C) * 2u; voffB[i] = (unsigned)(Rb * g.ldb + C) * 2u; }
    const size_t kstep = (size_t)(BK * 2);
    const size_t hstepA = (size_t)HALF * g.lda * 2, hstepB = (size_t)HALF * g.ldb * 2;
    const unsigned ldsw = (unsigned)wid * 1024u;
    const int aoff = lds_byte(wr * 64 + fr, fq * 8), boff = lds_byte(wc * 32 + fr, fq * 8);
#define PG8_SA(b, h) (((b) * 2 + (h)) * HTB)
#define PG8_SB(b, h) ((4 + (b) * 2 + (h)) * HTB)
#define PG8_STAGE(bufoff, gbase, voff) do { _Pragma("unroll") for (int _i = 0; _i < 2; ++_i) \
        __builtin_amdgcn_global_load_lds((const unsigned*)((const char*)(gbase) + (voff)[_i]), (PG8_LAS unsigned*)(lds + (bufoff) + ldsw + _i * 8192), 16, 0, 0); } while (0)
#define PG8_LDA(dst, b, h) do { _Pragma("unroll") for (int m = 0; m < 4; ++m) _Pragma("unroll") for (int k = 0; k < 2; ++k) dst[m][k] = *(const PG8_LAS bf16x8*)(lds + PG8_SA(b, h) + aoff + m * 2048 + k * 1024); } while (0)
#define PG8_LDB(dst, b, h) do { _Pragma("unroll") for (int n = 0; n < 2; ++n) _Pragma("unroll") for (int k = 0; k < 2; ++k) dst[n][k] = *(const PG8_LAS bf16x8*)(lds + PG8_SB(b, h) + boff + n * 2048 + k * 1024); } while (0)
#define PG8_MMA(ai, bj, At, Bt) do { __builtin_amdgcn_s_setprio(1); _Pragma("unroll") for (int m = 0; m < 4; ++m) _Pragma("unroll") for (int n = 0; n < 2; ++n) _Pragma("unroll") for (int k = 0; k < 2; ++k) \
        acc[ai][bj][m][n] = __builtin_amdgcn_mfma_f32_16x16x32_bf16(Bt[n][k], At[m][k], acc[ai][bj][m][n], 0, 0, 0); __builtin_amdgcn_s_setprio(0); } while (0)
#define PG8_WAIT_V(n) asm volatile("s_waitcnt vmcnt(" #n ")" ::: "memory")
#define PG8_WAIT_L(n) asm volatile("s_waitcnt lgkmcnt(" #n ")" ::: "memory")
#define PG8_BAR __builtin_amdgcn_s_barrier()
#define PG8_SCHED __builtin_amdgcn_sched_barrier(0)
    Unit cur, nxt; int ui = 0;
    if (!S.next(0, cur, g)) return;
    f32x4 acc[2][2][4][2];
    E.init(acc, cur, wr, wc);
    bf16x8 At[4][2], B0[2][2], B1[2][2];
    const char* cA = (const char*)(cur.mode ? g.As : g.A) + cur.offA; const char* cB = (const char*)g.Bt + cur.offB;
    PG8_STAGE(PG8_SB(0, 0), cB, voffB); PG8_STAGE(PG8_SB(0, 1), cB + hstepB, voffB); PG8_STAGE(PG8_SA(0, 0), cA, voffA); PG8_STAGE(PG8_SA(0, 1), cA + hstepA, voffA);
    if (wr == 1) PG8_BAR;
    PG8_WAIT_V(2); PG8_BAR;
    PG8_STAGE(PG8_SB(1, 0), cB + kstep, voffB); PG8_STAGE(PG8_SA(1, 0), cA + kstep, voffA); PG8_STAGE(PG8_SB(1, 1), cB + hstepB + kstep, voffB);
    PG8_WAIT_V(6); PG8_BAR;
    for (;;) {
        const bool has_next = S.next(ui + 1, nxt, g);
        const char* nA = has_next ? (const char*)(nxt.mode ? g.As : g.A) + nxt.offA : cA; const char* nB = has_next ? (const char*)g.Bt + nxt.offB : cB;
        const int nt = cur.nt, TSEG = Epi::MIDK ? 8 : nt;
        for (int t0 = 0; t0 < nt; t0 += TSEG) {
        if constexpr (Epi::MIDK) { if (t0 != 0) { PG8_SCHED; E.midk(acc, cur, t0 / TSEG - 1, wr, wc, 0, 0); PG8_SCHED; } }
#pragma unroll 1
        for (int t = t0; t < t0 + TSEG; t += 2) {
            const bool last = (t == nt - 2);
            if (last && has_next) S.a_ready(nxt, wid);
            const char* a1 = cA + (size_t)(t + 1) * kstep;
            const char* a2 = last ? nA : cA + (size_t)(t + 2) * kstep; const char* b2 = last ? nB : cB + (size_t)(t + 2) * kstep;
            const char* a3 = a2 + kstep; const char* b3 = b2 + kstep;
            PG8_LDB(B0, 0, 0); PG8_LDB(B1, 0, 1); PG8_SCHED; PG8_LDA(At, 0, 0); PG8_STAGE(PG8_SA(1, 1), a1 + hstepA, voffA);
            PG8_WAIT_V(8); PG8_WAIT_L(0); PG8_BAR; PG8_MMA(0, 0, At, B0); PG8_MMA(0, 1, At, B1); PG8_BAR; PG8_SCHED;
            PG8_LDA(At, 0, 1); PG8_STAGE(PG8_SB(0, 0), b2, voffB); PG8_STAGE(PG8_SB(0, 1), b2 + hstepB, voffB); PG8_STAGE(PG8_SA(0, 0), a2, voffA);
            PG8_WAIT_V(8); PG8_WAIT_L(0); PG8_BAR; PG8_MMA(1, 0, At, B0); PG8_MMA(1, 1, At, B1); PG8_BAR; PG8_SCHED;
            PG8_LDB(B0, 1, 0); PG8_LDB(B1, 1, 1); PG8_SCHED; PG8_LDA(At, 1, 0); PG8_STAGE(PG8_SA(0, 1), a2 + hstepA, voffA);
            PG8_WAIT_V(8); PG8_WAIT_L(0); PG8_BAR; PG8_MMA(0, 0, At, B0); PG8_MMA(0, 1, At, B1); PG8_BAR; PG8_SCHED;
            PG8_LDA(At, 1, 1); PG8_STAGE(PG8_SB(1, 0), b3, voffB); PG8_STAGE(PG8_SB(1, 1), b3 + hstepB, voffB); PG8_STAGE(PG8_SA(1, 0), a3, voffA);
            PG8_WAIT_V(8); PG8_WAIT_L(0); PG8_BAR; PG8_MMA(1, 0, At, B0); PG8_MMA(1, 1, At, B1); PG8_BAR; PG8_SCHED;
        }
        }
        if constexpr (ALIGN_EPI) { if (wr == 0) PG8_BAR; }
        E(acc, cur, wr, wc, 0, 0);
        if (!has_next) break;
        cur = nxt; cA = nA; cB = nB; ++ui;
        E.init(acc, cur, wr, wc);
        if constexpr (ALIGN_EPI) { if (wr == 1) PG8_BAR; }
    }
    PG8_WAIT_V(0);
    if constexpr (!ALIGN_EPI) { if (wr == 0) PG8_BAR; }
    PG8_BAR;
#undef PG8_SA
#undef PG8_SB
#undef PG8_STAGE
#undef PG8_LDA
#undef PG8_LDB
#undef PG8_MMA
#undef PG8_WAIT_V
#undef PG8_WAIT_L
#undef PG8_BAR
#undef PG8_SCHED
}
}

constexpr int NWAVES = 8;
constexpr int NPHASE = 19;
constexpr size_t MiB = 1u << 20;
constexpr size_t WS_CTL = 0, CTL_ZERO_BYTES = 1 * MiB;
constexpr size_t WS_WA = 1 * MiB;
constexpr size_t WS_XB = 18 * MiB;
constexpr size_t WS_Y = 51 * MiB;
constexpr size_t WS_ZG = 117 * MiB;
constexpr size_t WS_BT3 = 249 * MiB, WS_BT4 = 253 * MiB, WS_BT5 = WS_WA, WS_BT6 = WS_ZG + 108 * MiB;
constexpr size_t WS_MB4S = WS_WA + 13 * MiB;
constexpr size_t WS_SLAB = WS_Y;
constexpr size_t WS_END = 255 * MiB;
static_assert(WS_XB + (size_t)M * DM * 2 <= WS_Y && WS_Y + (size_t)M * YC * 2 <= WS_ZG && WS_ZG + (size_t)M * GC * 2 <= WS_BT3 && WS_SLAB + (size_t)16 * 512 * DM * 4 <= WS_Y + 40 * MiB && WS_Y + 40 * MiB + 4 * 512 * 1024 <= WS_ZG, "ws map");
static_assert((size_t)M * FF * 2 <= 108 * MiB && WS_BT5 + (size_t)2 * FF * DM * 2 <= WS_MB4S && WS_MB4S + 4 * MiB <= WS_XB && WS_BT6 + (size_t)DM * FF * 2 <= WS_BT3, "ws map 2");
constexpr int CW_RDY = 12288;
constexpr int CW_TMO = 0, CW_CODE = 1, CW_BAR = 4096, CW_SEAM = 16384, SEAM_BANK = 8192;
constexpr size_t WS_XCH = WS_Y + 40 * MiB;
constexpr int XLDS_OFF = 131072 + 1024;
constexpr int RING_OFF = 0, RING_BYTES = 131072;
constexpr int LDSCTL_OFF = RING_BYTES, MISC_OFF = LDSCTL_OFF + 320;
constexpr int LDS_BYTES = 147456;

#define GAS __attribute__((address_space(1)))
#define LAS __attribute__((address_space(3)))
typedef unsigned short bf16;
typedef unsigned v4u __attribute__((ext_vector_type(4)));
typedef unsigned v2u __attribute__((ext_vector_type(2)));
typedef float f32x4 __attribute__((ext_vector_type(4)));
typedef float f32x2 __attribute__((ext_vector_type(2)));
typedef short bf16x8 __attribute__((ext_vector_type(8)));
typedef GAS unsigned gu32;
#define RLX_AGENT __ATOMIC_RELAXED, __HIP_MEMORY_SCOPE_AGENT
#define LDS_WAIT() asm volatile("s_waitcnt lgkmcnt(0)" ::: "memory")
#define VM_WAIT() asm volatile("s_waitcnt vmcnt(0)" ::: "memory")
__device__ __forceinline__ unsigned pk2(float lo, float hi) { return pg8::cvt_pk_bf16(lo, hi); }
__device__ __forceinline__ float bflo(unsigned v) { return __uint_as_float(v << 16); }
__device__ __forceinline__ float bfhi(unsigned v) { return __uint_as_float(v & 0xffff0000u); }
__device__ __forceinline__ float bf1(unsigned short h) { return __uint_as_float((unsigned)h << 16); }
__device__ __forceinline__ unsigned short f2bf(float f) { return (unsigned short)(pg8::cvt_pk_bf16(f, 0.f) & 0xffffu); }

#define XB_TMO      128
#define XB_XCNT(j)  (256  + 64 * (j))
#define XB_XSUB(j)  (1280 + 64 * (j))
#define XB_XGEN(j)  (2304 + 64 * (j))
#define XB_TOP      3328
#define XB_TOPGEN   3392
#define XCD_BAR_WORDS 3456
#define XB_SPIN_CAP (1u << 18)
__device__ __forceinline__ unsigned xb_ld(unsigned* p)              { return __hip_atomic_load(p, __ATOMIC_RELAXED, __HIP_MEMORY_SCOPE_AGENT); }
__device__ __forceinline__ unsigned xb_add(unsigned* p, unsigned v) { return __hip_atomic_fetch_add(p, v, __ATOMIC_RELAXED, __HIP_MEMORY_SCOPE_AGENT); }
__device__ __forceinline__ unsigned xb_xcc_id() { return (unsigned)__builtin_amdgcn_s_getreg((3 << 11) | 20) & 0xFu; }
#define XB_SPIN(cond, bar) do { unsigned _sp = 0; while (cond) { __builtin_amdgcn_s_sleep(1); \
    if ((++_sp & 255u) == 0u) { if (xb_ld(&(bar)[XB_TMO])) break; if (_sp > XB_SPIN_CAP) { atomicAdd(&(bar)[XB_TMO], 1u); break; } } } } while (0)
struct XcdBarrier { unsigned* bar; unsigned x; volatile LAS unsigned* st; };
__device__ __forceinline__ XcdBarrier xcd_barrier_post(unsigned* bar, volatile LAS unsigned* st) {
    XcdBarrier b; b.bar = bar; b.x = xb_xcc_id(); b.st = st;
    if (threadIdx.x == 0) (void)xb_add(&bar[XB_XCNT(b.x)], 1u);
    return b;
}
__device__ __forceinline__ void xcd_barrier_complete(unsigned* bar, unsigned x, unsigned& nloc, unsigned& nx) {
    const unsigned G = gridDim.x * gridDim.y * gridDim.z;
    unsigned sum, cnt, mine, sp = 0u;
    for (;;) {
        sum = 0u; cnt = 0u; mine = 0u;
#pragma unroll
        for (unsigned j = 0; j < 16; ++j) { const unsigned c = xb_ld(&bar[XB_XCNT(j)]); sum += c; cnt += (c > 0u) ? 1u : 0u; mine = (j == x) ? c : mine; }
        if (sum == G) break;
        __builtin_amdgcn_s_sleep(1);
        if ((++sp & 255u) == 0u) { if (xb_ld(&bar[XB_TMO])) break; if (sp > XB_SPIN_CAP) { atomicAdd(&bar[XB_TMO], 1u); break; } }
    }
    nloc = mine > 0u ? mine : 1u; nx = cnt > 0u ? cnt : 1u;
}
__device__ __forceinline__ void xcd_barrier(const XcdBarrier& b) {
    asm volatile("s_waitcnt vmcnt(0)" ::: "memory");
    __syncthreads();
    if (threadIdx.x == 0) {
        unsigned* bar = b.bar;
        __builtin_amdgcn_s_waitcnt(0);
        unsigned nloc = b.st[0], nx = b.st[1];
        if (nloc == 0u) { xcd_barrier_complete(bar, b.x, nloc, nx); b.st[0] = nloc; b.st[1] = nx; }
        const unsigned old = xb_add(&bar[XB_XSUB(b.x)], 1u);
        const unsigned gen = old / nloc;
        if (old + 1u == (gen + 1u) * nloc) {
            __builtin_amdgcn_fence(__ATOMIC_RELEASE, "agent");
            asm volatile("s_waitcnt vmcnt(0)" ::: "memory");
            const unsigned og = xb_add(&bar[XB_TOP], 1u);
            const unsigned tg = og / nx;
            if (og + 1u == (tg + 1u) * nx) xb_add(&bar[XB_TOPGEN], 1u);
            else XB_SPIN(xb_ld(&bar[XB_TOPGEN]) == tg, bar);
            __builtin_amdgcn_fence(__ATOMIC_ACQUIRE, "agent");
            xb_add(&bar[XB_XGEN(b.x)], 1u);
            asm volatile("s_waitcnt vmcnt(0)" ::: "memory");
        } else {
            XB_SPIN(xb_ld(&bar[XB_XGEN(b.x)]) == gen, bar);
            __builtin_amdgcn_fence(__ATOMIC_ACQUIRE, "agent");
            asm volatile("s_waitcnt vmcnt(0)" ::: "memory");
        }
    }
    __syncthreads();
}

struct Frame {
    LAS unsigned char* lds;
    volatile LAS unsigned* MISC;
    gu32* ctl;
    int tid, lane, wave, G, bid;
    const float* const* in;
    float* out;
    unsigned char* ws;
};
enum { I_XP = 0, I_XS, I_SH, I_SRGC, I_SCF, I_SPOOL, I_SSC, I_WIN, I_RGCW, I_RGCB, I_RGWA, I_RGBA, I_RGWX, I_RGBX, I_LAM, I_CFW, I_CFB, I_CFG, I_CFBB, I_POOLW, I_POOLS, I_SCW,
       I_WBR, I_WOUT, I_LN1G, I_LN1B, I_WG, I_WU, I_WD, I_LN2G, I_LN2B };

__device__ __forceinline__ float shfl_idx(float v, int src_lane) { return __builtin_bit_cast(float, __builtin_amdgcn_ds_bpermute(src_lane << 2, __builtin_bit_cast(int, v))); }
__device__ __forceinline__ float wave_sum(float v, int lane) {
#pragma unroll
    for (int o = 1; o < 64; o <<= 1) v += shfl_idx(v, lane ^ o);
    return v;
}

enum { RM_ID = 0, RM_WIN = 1, RM_GU = 2 };
template <int MODE> __device__ __forceinline__ int rowmap(int s, int extra) {
    if (MODE == RM_ID) return s;
    if (MODE == RM_GU) return 256 * (s >> 7) + (s & 127) + extra;
    if (s < 1024) return s;
    if (s < 2048) { const int j = ((s - 1024) >> 7) & 3; return 1024 + 256 * j + (s >= 1536 ? 128 : 0) + (s & 127); }
    if (s < 3072) return s;
    if (s < 4096) { const int j = ((s - 3072) >> 7) & 3; return 3072 + 256 * j + (s >= 3584 ? 128 : 0) + (s & 127); }
    const int g = (s - 4096) >> 10, ch = s & 1023, pn = ch >> 6, chl = ch & 63, wc = chl >> 4, fq = (chl >> 2) & 3, i = chl & 3;
    return 4096 + 256 * pn + 128 * (g >> 1) + 32 * wc + 8 * fq + 4 * (g & 1) + i;
}
template <int MODE>
__device__ __forceinline__ void transpose_item(const float* W, int K, int N, bf16* WT, int dst_ld, int dst_koff, int extra, LAS float* scr, int item, int lane, int nb0, int nnb) {
    const int kb = item / nnb, nb = nb0 + item % nnb, k0 = 64 * kb, n0 = 32 * nb;
#pragma unroll 8
    for (int i = 0; i < 32; ++i) { const int kk = 2 * i + (lane >> 5); scr[kk * 33 + (lane & 31)] = W[(size_t)(k0 + kk) * N + n0 + (lane & 31)]; }
    LDS_WAIT(); asm volatile("" ::: "memory");
    const int c = lane & 7; const float sc = (MODE == RM_WIN && n0 >= 4096) ? -1.44269504089f : 1.0f;
#pragma unroll
    for (int j = 0; j < 4; ++j) { const int n = (lane >> 3) + 8 * j; const LAS float* s = scr + (8 * c) * 33 + n;
        v4u o; o.x = pk2(s[0 * 33] * sc, s[1 * 33] * sc); o.y = pk2(s[2 * 33] * sc, s[3 * 33] * sc); o.z = pk2(s[4 * 33] * sc, s[5 * 33] * sc); o.w = pk2(s[6 * 33] * sc, s[7 * 33] * sc);
        *(GAS v4u*)(WT + (size_t)rowmap<MODE>(n0 + n, extra) * dst_ld + dst_koff + k0 + 8 * c) = o; }
    LDS_WAIT(); asm volatile("" ::: "memory");
}
template <int MODE>
__device__ __forceinline__ void convert_matrix(Frame& F, const float* W, int K, int N, bf16* WT, int dst_ld, int dst_koff, int extra, int gw, int NGW, int first = 0, int nb0 = 0, int nnb = 0) {
    LAS float* scr = (LAS float*)(F.lds + RING_OFF + F.wave * 16384);
    if (nnb == 0) nnb = N / 32;
    const int nitems = (K / 64) * nnb;
    int it0 = gw - first; if (it0 < 0) it0 += ((-it0 + NGW - 1) / NGW) * NGW;
    for (int it = it0; it < nitems; it += NGW) transpose_item<MODE>(W, K, N, WT, dst_ld, dst_koff, extra, scr, it, F.lane, nb0, nnb);
}
__device__ __forceinline__ void compose_pool(Frame& F, int layer, bf16* Bt3, int gw, int NGW, int first = 0) {
    const float* pw = F.in[I_POOLW] + (size_t)layer * 4 * 128 * 128; const float* ps = F.in[I_POOLS] + layer * 512; const float* Wb2 = F.in[I_WBR] + ((size_t)layer * 4 + 2) * 512 * 1024;
    const int lane = F.lane;
    LAS float* Pl = (LAS float*)(F.lds + RING_OFF + F.wave * 16384);
    int id0 = gw - first; if (id0 < 0) id0 += ((-id0 + NGW - 1) / NGW) * NGW;
    for (int id = id0; id < 512; id += NGW) {
        const int g = __builtin_amdgcn_readfirstlane(id >> 7), c0 = __builtin_amdgcn_readfirstlane(8 * ((id >> 3) & 15)), d0 = 128 * (id & 7) + 2 * lane;
#pragma unroll
        for (int k = 0; k < 4; ++k) { const int idx4 = lane + 64 * k, i = idx4 >> 5, e4 = (idx4 & 31) * 4;
            const f32x4 pv = *(const GAS f32x4*)(pw + ((size_t)g * 128 + c0 + i) * 128 + e4), sv = *(const GAS f32x4*)(ps + 128 * g + e4);
            Pl[(e4 + 0) * 8 + i] = pv.x * sv.x; Pl[(e4 + 1) * 8 + i] = pv.y * sv.y; Pl[(e4 + 2) * 8 + i] = pv.z * sv.z; Pl[(e4 + 3) * 8 + i] = pv.w * sv.w; }
        LDS_WAIT(); asm volatile("" ::: "memory");
        f32x2 acc[8];
#pragma unroll
        for (int i = 0; i < 8; ++i) acc[i] = (f32x2){0.f, 0.f};
        const float* wrow = Wb2 + (size_t)(128 * g) * 1024 + d0;
#pragma unroll 1
        for (int e0 = 0; e0 < 128; e0 += 8) {
            f32x2 wv[8];
#pragma unroll
            for (int k = 0; k < 8; ++k) wv[k] = *(const GAS f32x2*)(wrow + (size_t)(e0 + k) * 1024);
#pragma unroll
            for (int k = 0; k < 8; ++k) { const f32x4 p0 = *(const LAS f32x4*)(Pl + (e0 + k) * 8), p1 = *(const LAS f32x4*)(Pl + (e0 + k) * 8 + 4);
#pragma unroll
                for (int i = 0; i < 4; ++i) { acc[i] += wv[k] * p0[i]; acc[4 + i] += wv[k] * p1[i]; } }
        }
        v4u o0, o1;
        o0.x = pk2(acc[0].x, acc[1].x); o0.y = pk2(acc[2].x, acc[3].x); o0.z = pk2(acc[4].x, acc[5].x); o0.w = pk2(acc[6].x, acc[7].x);
        o1.x = pk2(acc[0].y, acc[1].y); o1.y = pk2(acc[2].y, acc[3].y); o1.z = pk2(acc[4].y, acc[5].y); o1.w = pk2(acc[6].y, acc[7].y);
        *(GAS v4u*)(Bt3 + (size_t)d0 * 2048 + 1024 + 128 * g + c0) = o0; *(GAS v4u*)(Bt3 + (size_t)(d0 + 1) * 2048 + 1024 + 128 * g + c0) = o1;
        LDS_WAIT(); asm volatile("" ::: "memory");
    }
}

__device__ __forceinline__ const float* xrow_in(Frame& F, int m) { return m < MP ? F.in[I_XP] + (size_t)m * DM : F.in[I_XS] + (size_t)(m - MP) * DM; }
__device__ __forceinline__ void x_to_bf16(Frame& F, bf16* XB) {
    const int gw = F.bid * NWAVES + F.wave, NGW = F.G * NWAVES;
    for (int m0 = 4 * gw; m0 < M; m0 += 4 * NGW) {
        f32x4 v[4][4];
#pragma unroll
        for (int k = 0; k < 4; ++k) { const GAS f32x4* xr = (const GAS f32x4*)xrow_in(F, m0 + k) + F.lane;
#pragma unroll
            for (int j = 0; j < 4; ++j) v[k][j] = xr[64 * j]; }
#pragma unroll
        for (int k = 0; k < 4; ++k) { GAS v2u* o = (GAS v2u*)(XB + (size_t)(m0 + k) * DM) + F.lane;
#pragma unroll
            for (int j = 0; j < 4; ++j) o[64 * j] = (v2u){pk2(v[k][j].x, v[k][j].y), pk2(v[k][j].z, v[k][j].w)}; } }
}
__device__ __forceinline__ void ln_rows(Frame& F, const float* V, float* O, const float* g, const float* b, bf16* XB, const float* sbase, const float* slab, int nslab, int wg0 = 0) {
    const int gw = ((F.bid - wg0 + F.G) % F.G) * NWAVES + F.wave, NGW = F.G * NWAVES;
    f32x4 gv[4], bv[4];
#pragma unroll
    for (int j = 0; j < 4; ++j) { gv[j] = ((const GAS f32x4*)g)[F.lane + 64 * j]; bv[j] = ((const GAS f32x4*)b)[F.lane + 64 * j]; }
    for (int m = MP + gw; m < M; m += NGW) {
        const GAS f32x4* xr = (const GAS f32x4*)(V + (size_t)m * DM) + F.lane; GAS f32x4* orow = (GAS f32x4*)(O + (size_t)m * DM) + F.lane;
        f32x4 v[4]; float s = 0.f;
#pragma unroll
        for (int j = 0; j < 4; ++j) v[j] = xr[64 * j];
        if (m >= MP) { const GAS f32x4* br = (const GAS f32x4*)(sbase + (size_t)(m - MP) * DM) + F.lane;
#pragma unroll
            for (int j = 0; j < 4; ++j) v[j] = br[64 * j] * ALPHA;
            for (int sl = 0; sl < nslab; sl += 4) {
                f32x4 t[4][4];
#pragma unroll
                for (int k = 0; k < 4; ++k) { const GAS f32x4* sr = (const GAS f32x4*)(slab + ((size_t)(sl + k < nslab ? sl + k : sl) * 512 + (m - MP)) * DM) + F.lane;
#pragma unroll
                    for (int j = 0; j < 4; ++j) t[k][j] = sr[64 * j]; }
#pragma unroll
                for (int k = 0; k < 4; ++k) if (sl + k < nslab) {
#pragma unroll
                    for (int j = 0; j < 4; ++j) v[j] += t[k][j]; } } }
#pragma unroll
        for (int j = 0; j < 4; ++j) s += (v[j].x + v[j].y) + (v[j].z + v[j].w);
        const float mean = wave_sum(s, F.lane) * (1.f / DM); float s2 = 0.f;
#pragma unroll
        for (int j = 0; j < 4; ++j) { v[j] = v[j] - mean; s2 += (v[j].x * v[j].x + v[j].y * v[j].y) + (v[j].z * v[j].z + v[j].w * v[j].w); }
        const float rstd = __builtin_amdgcn_rsqf(wave_sum(s2, F.lane) * (1.f / DM) + LN_EPS);
#pragma unroll
        for (int j = 0; j < 4; ++j) { v[j] = v[j] * rstd * gv[j] + bv[j]; orow[64 * j] = v[j]; }
        if (XB) { GAS v2u* o = (GAS v2u*)(XB + (size_t)m * DM) + F.lane;
#pragma unroll
            for (int j = 0; j < 4; ++j) o[64 * j] = (v2u){pk2(v[j].x, v[j].y), pk2(v[j].z, v[j].w)}; }
    }
}

__device__ __forceinline__ void publish_ready(Frame& F, gu32* ctr) {
    VM_WAIT(); __syncthreads();
    if (F.tid == 0) { __builtin_amdgcn_fence(__ATOMIC_RELEASE, "agent"); asm volatile("s_waitcnt vmcnt(0)" ::: "memory"); __hip_atomic_fetch_add((unsigned*)ctr, 1u, __ATOMIC_RELAXED, __HIP_MEMORY_SCOPE_AGENT); }
}
__device__ __forceinline__ float softplusf_acc(float x) { return fmaxf(x, 0.f) + log1pf(__expf(-fabsf(x))); }
__device__ __forceinline__ float expm1_neg(float x) {
    const float p = x * (1.f + x * (0.5f + x * (1.f / 6.f + x * (1.f / 24.f + x * (1.f / 120.f + x * (1.f / 720.f + x * (1.f / 5040.f)))))));
    return x > -0.25f ? p : __expf(x) - 1.f;
}
constexpr int PATCH_STRIDE = 144;

struct ALane {
    float cwD[4], cbD, ba, bx, ck;
    bf16x8 Ba[4][2], Bx[4][2];
};
constexpr int PATCH_BYTES = 5120, ASLOT_OFF = 8 * PATCH_BYTES;
__device__ __forceinline__ void a_setup(Frame& F, int layer, int n, int q, ALane& L) {
    const int c = F.lane & 15, kg = F.lane >> 4, och = 64 * n + 16 * q + c;
    const float* cw = F.in[I_RGCW] + (size_t)layer * 4 * 512 + 64 * n; const float* cb = F.in[I_RGCB] + layer * 512 + 64 * n;
#pragma unroll
    for (int j = 0; j < 4; ++j) L.cwD[j] = cw[j * 512 + 16 * q + c];
    L.cbD = cb[16 * q + c];
    L.ck = 8.0f * softplusf_acc(-F.in[I_LAM][layer * 512 + och]);
    const float* wa = F.in[I_RGWA] + ((size_t)layer * 8 + n) * 4096 + 16 * q + c; const float* wx = F.in[I_RGWX] + ((size_t)layer * 8 + n) * 4096 + 16 * q + c;
    float wav[16], wxv[16], cbv[16];
#pragma unroll
    for (int e = 0; e < 16; ++e) { const int k = (e < 8 ? 8 * kg + e : 32 + 8 * kg + (e - 8)); wav[e] = wa[k * 64]; wxv[e] = wx[k * 64]; cbv[e] = cb[k]; }
#pragma unroll
    for (int j = 0; j < 4; ++j) { float t[16];
#pragma unroll
        for (int e = 0; e < 16; ++e) t[e] = cw[j * 512 + (e < 8 ? 8 * kg + e : 32 + 8 * kg + (e - 8))];
        L.Ba[j][0] = __builtin_bit_cast(bf16x8, (v4u){pk2(wav[0] * t[0], wav[1] * t[1]), pk2(wav[2] * t[2], wav[3] * t[3]), pk2(wav[4] * t[4], wav[5] * t[5]), pk2(wav[6] * t[6], wav[7] * t[7])});
        L.Ba[j][1] = __builtin_bit_cast(bf16x8, (v4u){pk2(wav[8] * t[8], wav[9] * t[9]), pk2(wav[10] * t[10], wav[11] * t[11]), pk2(wav[12] * t[12], wav[13] * t[13]), pk2(wav[14] * t[14], wav[15] * t[15])});
        L.Bx[j][0] = __builtin_bit_cast(bf16x8, (v4u){pk2(wxv[0] * t[0], wxv[1] * t[1]), pk2(wxv[2] * t[2], wxv[3] * t[3]), pk2(wxv[4] * t[4], wxv[5] * t[5]), pk2(wxv[6] * t[6], wxv[7] * t[7])});
        L.Bx[j][1] = __builtin_bit_cast(bf16x8, (v4u){pk2(wxv[8] * t[8], wxv[9] * t[9]), pk2(wxv[10] * t[10], wxv[11] * t[11]), pk2(wxv[12] * t[12], wxv[13] * t[13]), pk2(wxv[14] * t[14], wxv[15] * t[15])}); }
    float sa = 0.f, sx = 0.f;
#pragma unroll
    for (int e = 0; e < 16; ++e) { sa = fmaf(cbv[e], wav[e], sa); sx = fmaf(cbv[e], wxv[e], sx); }
    sa += shfl_idx(sa, F.lane ^ 16); sa += shfl_idx(sa, F.lane ^ 32); sx += shfl_idx(sx, F.lane ^ 16); sx += shfl_idx(sx, F.lane ^ 32);
    L.ba = F.in[I_RGBA][layer * 512 + och] + sa; L.bx = F.in[I_RGBX][layer * 512 + och] + sx;
}
__device__ __forceinline__ void a_block(const ALane& L, const LAS unsigned char* patch, int rowA0, int baseD, int q, int lane, float (&a)[4], float (&bb)[4]) {
    const int c = lane & 15, kg = lane >> 4;
    f32x4 accR = (f32x4){0.f, 0.f, 0.f, 0.f}, accI = (f32x4){0.f, 0.f, 0.f, 0.f};
#pragma unroll
    for (int j = 0; j < 4; ++j) { const LAS unsigned char* rp = patch + (rowA0 + j) * PATCH_STRIDE + 16 * kg;
        const bf16x8 A0 = *(const LAS bf16x8*)rp, A1 = *(const LAS bf16x8*)(rp + 64);
        accR = __builtin_amdgcn_mfma_f32_16x16x32_bf16(A0, L.Ba[j][0], accR, 0, 0, 0); accR = __builtin_amdgcn_mfma_f32_16x16x32_bf16(A1, L.Ba[j][1], accR, 0, 0, 0);
        accI = __builtin_amdgcn_mfma_f32_16x16x32_bf16(A0, L.Bx[j][0], accI, 0, 0, 0); accI = __builtin_amdgcn_mfma_f32_16x16x32_bf16(A1, L.Bx[j][1], accI, 0, 0, 0); }
    float pv[7];
#pragma unroll
    for (int k = 0; k < 7; ++k) pv[k] = bf1(*(const LAS unsigned short*)(patch + (baseD + k) * PATCH_STRIDE + 2 * (16 * q + c)));
#pragma unroll
    for (int r = 0; r < 4; ++r) {
        const float xd = L.cbD + L.cwD[0] * pv[r] + L.cwD[1] * pv[r + 1] + L.cwD[2] * pv[r + 2] + L.cwD[3] * pv[r + 3];
        const float rr = pg8::sigmoidf_fast(accR[r] + L.ba), ii = pg8::sigmoidf_fast(accI[r] + L.bx);
        const float la = -L.ck * rr;
        const float av = __builtin_amdgcn_exp2f(1.44269504089f * la);
        a[r] = av; bb[r] = __builtin_amdgcn_sqrtf(fmaxf(1.f - av * av, 0.f)) * (ii * xd);
    }
}
struct BlkScan { float Ac[4], Bc[4], EA, EB, WA, WB; };
__device__ __forceinline__ void blk_scan(const float (&a)[4], const float (&bb)[4], int lane, BlkScan& S) {
    const int c = lane & 15, g = lane >> 4;
    S.Ac[0] = a[0]; S.Bc[0] = bb[0];
#pragma unroll
    for (int r = 1; r < 4; ++r) { S.Ac[r] = a[r] * S.Ac[r - 1]; S.Bc[r] = a[r] * S.Bc[r - 1] + bb[r]; }
    float IA = S.Ac[3], IB = S.Bc[3];
    { const float pa = shfl_idx(IA, lane - 16), pb = shfl_idx(IB, lane - 16); if (g >= 1) { IB = IA * pb + IB; IA = IA * pa; } }
    { const float pa = shfl_idx(IA, lane - 32), pb = shfl_idx(IB, lane - 32); if (g >= 2) { IB = IA * pb + IB; IA = IA * pa; } }
    S.EA = shfl_idx(IA, lane - 16); S.EB = shfl_idx(IB, lane - 16); if (g == 0) { S.EA = 1.f; S.EB = 0.f; }
    S.WA = shfl_idx(IA, 48 + c); S.WB = shfl_idx(IB, 48 + c);
}
__device__ __forceinline__ void a_prompt_item(Frame& F, int layer, int item, const bf16* Z, bf16* Y) {
    const int b = item >> 5, n = (item >> 2) & 7, q = item & 3, lane = opqv(F.lane), w = F.wave, c = lane & 15, g = lane >> 4, och = 64 * n + 16 * q + c;
    ALane L; a_setup(F, layer, n, q, L);
    LAS unsigned char* patch = F.lds + RING_OFF + w * PATCH_BYTES;
    LAS f32x2* slots = (LAS f32x2*)(F.lds + RING_OFF + ASLOT_OFF);
    const bf16* Zb = Z + (size_t)b * SEQ * ZC; bf16* Yb = Y + (size_t)b * SEQ * YC;
    float hrun = 0.f;
    v4u pf[5];
    auto load_patch = [&](int tb) {
#pragma unroll
        for (int k = 0; k < 5; ++k) { const int ci = lane + 64 * k, pr = ci >> 3, cc = ci & 7, t = tb - 3 + pr;
            pf[k] = (ci < 280 && t >= 0) ? *(const GAS v4u*)(Zb + (size_t)t * ZC + 64 * n + 8 * cc) : (v4u){0u, 0u, 0u, 0u}; }
    };
    load_patch(32 * w);
    for (int it = 0; it < 8; ++it) {
        const int tb = 256 * it + 32 * w;
#pragma unroll
        for (int k = 0; k < 5; ++k) { const int ci = lane + 64 * k, pr = ci >> 3, cc = ci & 7; if (ci < 280) *(LAS v4u*)(patch + pr * PATCH_STRIDE + 16 * cc) = pf[k]; }
        if (it < 7) load_patch(tb + 256);
        unsigned short gav[8];
#pragma unroll
        for (int r = 0; r < 8; ++r) gav[r] = ((const GAS unsigned short*)Zb)[(unsigned)((tb + 16 * (r >> 2) + 4 * g + (r & 3)) * ZC + 512 + och)];
        asm volatile("" ::: "memory");
        float a0[4], b0[4], a1[4], b1[4];
        a_block(L, patch, lane & 15, 4 * g, q, lane, a0, b0);
        a_block(L, patch, 16 + (lane & 15), 16 + 4 * g, q, lane, a1, b1);
        BlkScan S0, S1; blk_scan(a0, b0, lane, S0); blk_scan(a1, b1, lane, S1);
        if (lane < 16) slots[((it & 1) * 8 + w) * 16 + c] = (f32x2){S0.WA * S1.WA, S1.WA * S0.WB + S1.WB};
        __syncthreads();
        float hin = hrun, hw = 0.f;
#pragma unroll
        for (int ww = 0; ww < 8; ++ww) { const f32x2 s = slots[((it & 1) * 8 + ww) * 16 + c]; if (ww == w) hw = hin; hin = s.x * hin + s.y; }
        hrun = hin;
        const float hg0 = S0.EA * hw + S0.EB, hw1 = S0.WA * hw + S0.WB, hg1 = S1.EA * hw1 + S1.EB;
#pragma unroll
        for (int r = 0; r < 4; ++r) { const float h = S0.Ac[r] * hg0 + S0.Bc[r];
            ((GAS unsigned short*)Yb)[(unsigned)((tb + 4 * g + r) * YC + och)] = f2bf(h * bf1(gav[r])); }
#pragma unroll
        for (int r = 0; r < 4; ++r) { const float h = S1.Ac[r] * hg1 + S1.Bc[r];
            ((GAS unsigned short*)Yb)[(unsigned)((tb + 16 + 4 * g + r) * YC + och)] = f2bf(h * bf1(gav[4 + r]));
            if (r == 3 && it == 7 && w == 7 && g == 3) F.out[O_PH + (size_t)(layer * 8 + b) * 512 + och] = h; }
    }
}
__device__ __forceinline__ void a_sample_task(Frame& F, int layer, int task, const bf16* Z, bf16* Y) {
    const int blk = task >> 5, n = (task >> 2) & 7, q = task & 3, lane = opqv(F.lane), c = lane & 15, g = lane >> 4, och = 64 * n + 16 * q + c, s0 = 4 * blk;
    ALane L; a_setup(F, layer, n, q, L);
    LAS unsigned char* patch = F.lds + RING_OFF + F.wave * PATCH_BYTES;
#pragma unroll
    for (int k = 0; k < 4; ++k) { const int ci = lane + 64 * k; if (ci < 224) { const int pr = ci >> 3, cc = ci & 7, sq = pr / 7, tau = pr - 7 * sq - 3, seq = s0 + sq; v4u v;
            if (tau < 0) { const GAS f32x4* sp = (const GAS f32x4*)(F.in[I_SRGC] + ((size_t)(layer * 128 + seq) * 3 + (tau + 3)) * 512 + 64 * n + 8 * cc); const f32x4 f0 = sp[0], f1 = sp[1];
                v = (v4u){pk2(f0.x, f0.y), pk2(f0.z, f0.w), pk2(f1.x, f1.y), pk2(f1.z, f1.w)}; }
            else v = *(const GAS v4u*)(Z + (size_t)(MP + 4 * seq + tau) * ZC + 64 * n + 8 * cc);
            *(LAS v4u*)(patch + pr * PATCH_STRIDE + 16 * cc) = v; } }
    asm volatile("" ::: "memory");
    float a[4], bb[4];
    a_block(L, patch, 7 * ((lane & 15) >> 2) + (lane & 3), 7 * g, q, lane, a, bb);
    const int seq = s0 + g;
    float h = F.in[I_SH][(size_t)(layer * 128 + seq) * 512 + och];
#pragma unroll
    for (int r = 0; r < 4; ++r) { h = a[r] * h + bb[r]; const size_t row = (size_t)(MP + 4 * seq + r);
        *(GAS unsigned short*)(Y + row * YC + och) = f2bf(h * bf1(*(const GAS unsigned short*)(Z + row * ZC + 512 + och))); }
    F.out[O_SH + (size_t)(layer * 128 + seq) * 512 + och] = h;
}

__device__ __forceinline__ void ln_silu_row(const LAS float* xr, const float* g, const float* b, bf16* dst, int lane) {
    const f32x4 v0 = *(const LAS f32x4*)(xr + 4 * lane), v1 = *(const LAS f32x4*)(xr + 256 + 4 * lane);
    const float s = (v0.x + v0.y) + (v0.z + v0.w) + (v1.x + v1.y) + (v1.z + v1.w);
    const float mean = wave_sum(s, lane) * (1.f / 512.f);
    const f32x4 d0 = v0 - mean, d1 = v1 - mean;
    const float s2 = (d0.x * d0.x + d0.y * d0.y) + (d0.z * d0.z + d0.w * d0.w) + (d1.x * d1.x + d1.y * d1.y) + (d1.z * d1.z + d1.w * d1.w);
    const float rstd = __builtin_amdgcn_rsqf(wave_sum(s2, lane) * (1.f / 512.f) + LN_EPS);
    const f32x4 g0 = *(const GAS f32x4*)(g + 4 * lane), g1 = *(const GAS f32x4*)(g + 256 + 4 * lane), b0 = *(const GAS f32x4*)(b + 4 * lane), b1 = *(const GAS f32x4*)(b + 256 + 4 * lane);
    f32x4 y0 = d0 * rstd * g0 + b0, y1 = d1 * rstd * g1 + b1;
#pragma unroll
    for (int i = 0; i < 4; ++i) { y0[i] = y0[i] * pg8::sigmoidf_fast(y0[i]); y1[i] = y1[i] * pg8::sigmoidf_fast(y1[i]); }
    *(GAS v2u*)(dst + 4 * lane) = (v2u){pk2(y0.x, y0.y), pk2(y0.z, y0.w)}; *(GAS v2u*)(dst + 256 + 4 * lane) = (v2u){pk2(y1.x, y1.y), pk2(y1.z, y1.w)};
}
__device__ __forceinline__ void ln_silu_rows4(const LAS float* xr, int rstride, const float* g, const float* b, bf16* dst, size_t dstride, int lane) {
    f32x4 v0[4], v1[4]; float s[4], s2[4];
#pragma unroll
    for (int k = 0; k < 4; ++k) { v0[k] = *(const LAS f32x4*)(xr + k * rstride + 4 * lane); v1[k] = *(const LAS f32x4*)(xr + k * rstride + 256 + 4 * lane);
        s[k] = (v0[k].x + v0[k].y) + (v0[k].z + v0[k].w) + (v1[k].x + v1[k].y) + (v1[k].z + v1[k].w); }
#pragma unroll
    for (int o = 1; o < 64; o <<= 1) {
#pragma unroll
        for (int k = 0; k < 4; ++k) s[k] += shfl_idx(s[k], lane ^ o); }
#pragma unroll
    for (int k = 0; k < 4; ++k) { const float mean = s[k] * (1.f / 512.f); v0[k] = v0[k] - mean; v1[k] = v1[k] - mean;
        s2[k] = (v0[k].x * v0[k].x + v0[k].y * v0[k].y) + (v0[k].z * v0[k].z + v0[k].w * v0[k].w) + (v1[k].x * v1[k].x + v1[k].y * v1[k].y) + (v1[k].z * v1[k].z + v1[k].w * v1[k].w); }
#pragma unroll
    for (int o = 1; o < 64; o <<= 1) {
#pragma unroll
        for (int k = 0; k < 4; ++k) s2[k] += shfl_idx(s2[k], lane ^ o); }
    const f32x4 g0 = *(const GAS f32x4*)(g + 4 * lane), g1 = *(const GAS f32x4*)(g + 256 + 4 * lane), b0 = *(const GAS f32x4*)(b + 4 * lane), b1 = *(const GAS f32x4*)(b + 256 + 4 * lane);
#pragma unroll
    for (int k = 0; k < 4; ++k) { const float rstd = __builtin_amdgcn_rsqf(s2[k] * (1.f / 512.f) + LN_EPS);
        f32x4 y0 = v0[k] * rstd * g0 + b0, y1 = v1[k] * rstd * g1 + b1;
#pragma unroll
        for (int i = 0; i < 4; ++i) { y0[i] = y0[i] * pg8::sigmoidf_fast(y0[i]); y1[i] = y1[i] * pg8::sigmoidf_fast(y1[i]); }
        bf16* d = dst + (size_t)k * dstride;
        *(GAS v2u*)(d + 4 * lane) = (v2u){pk2(y0.x, y0.y), pk2(y0.z, y0.w)}; *(GAS v2u*)(d + 256 + 4 * lane) = (v2u){pk2(y1.x, y1.y), pk2(y1.z, y1.w)}; }
}
__device__ __forceinline__ void b_prompt_item(Frame& F, int layer, int item, const bf16* Z, bf16* Y) {
    const int tidl = opqv(F.tid), b = item >> 5, t0 = 64 * (item & 31), p = tidl & 255, hh = tidl >> 8, ts = t0 + 32 * hh;
    const GAS unsigned* Zu = (const GAS unsigned*)(Z + (size_t)b * SEQ * ZC) + 512 + p;
    unsigned raw[62];
#pragma unroll
    for (int i = 0; i < 62; ++i) { const int t = ts - 30 + i; raw[i] = t >= 0 ? Zu[(size_t)t * (ZC / 2)] : 0u; }
    const float* cw = F.in[I_CFW] + (size_t)layer * 31 * 512 + 2 * p;
    f32x2 wj[31];
#pragma unroll
    for (int j = 0; j < 31; ++j) wj[j] = *(const GAS f32x2*)(cw + j * 512);
    const f32x2 bias = *(const GAS f32x2*)(F.in[I_CFB] + layer * 512 + 2 * p);
    f32x2 in[62];
#pragma unroll
    for (int i = 0; i < 62; ++i) in[i] = (f32x2){bflo(raw[i]), bfhi(raw[i])};
    LAS float* obuf = (LAS float*)(F.lds + RING_OFF);
#pragma unroll
    for (int i = 0; i < 32; ++i) { f32x2 o = bias;
#pragma unroll
        for (int j = 0; j < 31; ++j) o += wj[j] * in[i + j];
        *(LAS f32x2*)(obuf + (32 * hh + i) * 512 + 2 * p) = o; }
    __syncthreads();
    const float* lg = F.in[I_CFG] + layer * 512; const float* lb = F.in[I_CFBB] + layer * 512;
#pragma unroll 1
    for (int r = 8 * F.wave; r < 8 * F.wave + 8; r += 4) ln_silu_rows4(obuf + r * 512, 512, lg, lb, Y + (size_t)(b * SEQ + t0 + r) * YC + 512, YC, F.lane);
}
__device__ __forceinline__ void cd_prompt_item(Frame& F, int layer, int item, const bf16* Z, bf16* Y) {
    const int tidl = opqv(F.tid), b = item >> 5, t0 = 64 * (item & 31), p = tidl & 255, hh = tidl >> 8;
    const bf16* Zb = Z + (size_t)b * SEQ * ZC;
    LAS unsigned* cbuf = (LAS unsigned*)(F.lds + RING_OFF);
    { v4u tmp[10];
#pragma unroll
      for (int k = 0; k < 10; ++k) { const int ci = tidl + 512 * k, pr = ci >> 6, cc = ci & 63, t = t0 - 15 + pr;
          tmp[k] = (ci < 79 * 64 && t >= 0) ? *(const GAS v4u*)(Zb + (size_t)t * ZC + 1536 + 8 * cc) : (v4u){0u, 0u, 0u, 0u}; }
#pragma unroll
      for (int k = 0; k < 10; ++k) { const int ci = tidl + 512 * k, pr = ci >> 6, cc = ci & 63; if (ci < 79 * 64) *(LAS v4u*)(cbuf + pr * 256 + 4 * cc) = tmp[k]; } }
    const int ts = t0 + 32 * hh;
    unsigned uu[34], dd[32];
#pragma unroll
    for (int i = 0; i < 34; ++i) { const int t = ts - 2 + i; uu[i] = t >= 0 ? ((const GAS unsigned*)(Zb + (size_t)t * ZC))[1280 + p] : 0u; }
#pragma unroll
    for (int i = 0; i < 32; ++i) dd[i] = ((const GAS unsigned*)(Zb + (size_t)(ts + i) * ZC))[1024 + p];
    const f32x2 w0 = ((const GAS f32x2*)(F.in[I_SCW] + (size_t)(layer * 3 + 0) * 512))[p], w1 = ((const GAS f32x2*)(F.in[I_SCW] + (size_t)(layer * 3 + 1) * 512))[p],
                w2 = ((const GAS f32x2*)(F.in[I_SCW] + (size_t)(layer * 3 + 2) * 512))[p];
    __syncthreads();
    const int w = 2 << (p >> 6), rr0 = 15 + 32 * hh;
    f32x2 s = (f32x2){0.f, 0.f};
    for (int j = 0; j < w; ++j) { const unsigned v = cbuf[(rr0 - j) * 256 + p]; s += (f32x2){bflo(v), bfhi(v)}; }
    GAS unsigned* Yu = (GAS unsigned*)(Y + (size_t)(b * SEQ + ts) * YC) + p;
#pragma unroll
    for (int i = 0; i < 32; ++i) { const int t = ts + i, rr = rr0 + i;
        const unsigned cur = cbuf[rr * 256 + p]; const f32x2 cf = (f32x2){bflo(cur), bfhi(cur)};
        if (i > 0) { const unsigned old = cbuf[(rr - w) * 256 + p]; s += cf - (f32x2){bflo(old), bfhi(old)}; }
        const float ic = __builtin_amdgcn_rcpf((float)(t + 1 < w ? t + 1 : w));
        const f32x2 mm = s * ic - cf;
        Yu[(size_t)i * 1024 + 512] = pk2(mm.x, mm.y);
        const f32x2 cv = w0 * (f32x2){bflo(uu[i]), bfhi(uu[i])} + w1 * (f32x2){bflo(uu[i + 1]), bfhi(uu[i + 1])} + w2 * (f32x2){bflo(uu[i + 2]), bfhi(uu[i + 2])};
        const f32x2 yd = (f32x2){bflo(dd[i]), bfhi(dd[i])} * cv;
        Yu[(size_t)i * 1024 + 768] = pk2(yd.x, yd.y); }
}
__device__ __forceinline__ void s_sample_item(Frame& F, int layer, int s, const bf16* Z, bf16* Y) {
    const int ch = opqv(F.tid); const size_t ls = (size_t)layer * 128 + s;
    const bf16* Zr = Z + (size_t)(MP + 4 * s) * ZC; bf16* Yr = Y + (size_t)(MP + 4 * s) * YC;
    LAS float* obuf = (LAS float*)(F.lds + RING_OFF);
    float in[34], wv[31], pb[19], u[6], dbv[4];
#pragma unroll
    for (int j = 0; j < 30; ++j) in[j] = (F.in[I_SCF] + (ls * 30 + j) * 512)[ch];
#pragma unroll
    for (int j = 0; j < 15; ++j) pb[j] = (F.in[I_SPOOL] + (ls * 15 + j) * 512)[ch];
    u[0] = (F.in[I_SSC] + (ls * 2 + 0) * 512)[ch]; u[1] = (F.in[I_SSC] + (ls * 2 + 1) * 512)[ch];
#pragma unroll
    for (int r = 0; r < 4; ++r) { in[30 + r] = bf1((Zr + (size_t)r * ZC + 1024)[ch]); pb[15 + r] = bf1((Zr + (size_t)r * ZC + 1536)[ch]); u[2 + r] = bf1((Zr + (size_t)r * ZC + 2560)[ch]); dbv[r] = bf1((Zr + (size_t)r * ZC + 2048)[ch]); }
#pragma unroll
    for (int j = 0; j < 31; ++j) wv[j] = (F.in[I_CFW] + ((size_t)layer * 31 + j) * 512)[ch];
    const float bias = (F.in[I_CFB] + layer * 512)[ch];
    const float w0 = (F.in[I_SCW] + (size_t)(layer * 3 + 0) * 512)[ch], w1 = (F.in[I_SCW] + (size_t)(layer * 3 + 1) * 512)[ch], w2 = (F.in[I_SCW] + (size_t)(layer * 3 + 2) * 512)[ch];
    asm volatile("" ::: "memory");
#pragma unroll
    for (int j = 0; j < 26; ++j) (F.out + O_SCF + (ls * 30 + j) * 512)[ch] = in[j + 4];
#pragma unroll
    for (int r = 0; r < 4; ++r) { float o = bias;
#pragma unroll
        for (int j = 0; j < 31; ++j) o += wv[j] * in[r + j];
        obuf[r * 512 + ch] = o; }
#pragma unroll
    for (int j = 0; j < 11; ++j) (F.out + O_SPOOL + (ls * 15 + j) * 512)[ch] = pb[j + 4];
    const int gsel = ch >> 7;
#pragma unroll
    for (int r = 0; r < 4; ++r) { const int k = 15 + r;
        const float s2 = pb[k] + pb[k - 1], s4 = s2 + pb[k - 2] + pb[k - 3], s8 = s4 + (pb[k - 4] + pb[k - 5]) + (pb[k - 6] + pb[k - 7]);
        float s16 = s8;
#pragma unroll
        for (int j = 8; j < 16; ++j) s16 += pb[k - j];
        const float mv = (gsel == 0 ? s2 * 0.5f : gsel == 1 ? s4 * 0.25f : gsel == 2 ? s8 * 0.125f : s16 * 0.0625f) - pb[k];
        (Yr + (size_t)r * YC + 1024)[ch] = f2bf(mv); }
#pragma unroll
    for (int r = 0; r < 4; ++r) (Yr + (size_t)r * YC + 1536)[ch] = f2bf(dbv[r] * (w0 * u[r] + w1 * u[r + 1] + w2 * u[r + 2]));
    __syncthreads();
    if (F.wave < 4) ln_silu_row(obuf + F.wave * 512, F.in[I_CFG] + layer * 512, F.in[I_CFBB] + layer * 512, Yr + (size_t)F.wave * YC + 512, F.lane);
}

struct Args { const float* in[31]; float* out; unsigned char* ws; int ph_lo, ph_hi; };
__global__ void __launch_bounds__(NWAVES * 64, 2) hybrid_fwd(Args args) {
    extern __shared__ __attribute__((aligned(16))) unsigned char lds[];
    Frame F;
    F.lds = (LAS unsigned char*)lds;
    F.MISC = (volatile LAS unsigned*)(F.lds + MISC_OFF);
    const int wave0 = __builtin_amdgcn_readfirstlane((int)threadIdx.x >> 6);
    F.lane = lane_now(); F.wave = wave0; F.tid = F.wave * 64 + F.lane;
    F.G = gridDim.x; F.bid = blockIdx.x;
    F.ws = args.ws; F.out = args.out; F.ctl = (gu32*)(args.ws + WS_CTL);
    F.in = args.in;
    for (int u = F.tid; u < (LDS_BYTES - LDSCTL_OFF) / 4; u += NWAVES * 64) ((LAS unsigned*)(F.lds + LDSCTL_OFF))[u] = 0u;
    __syncthreads();
    XcdBarrier bar; bar.bar = (unsigned*)(F.ctl + CW_BAR); bar.x = 0; bar.st = nullptr;
    if (!MK_SPLIT) bar = xcd_barrier_post((unsigned*)(F.ctl + CW_BAR), F.MISC + 8);
    const int lo = args.ph_lo, hi = args.ph_hi;
#define IN(k) (lo <= (k) && (k) < hi)
#define REFRESH() do { F.lane = lane_now(); F.wave = opqs(wave0); F.tid = F.wave * 64 + F.lane; F.bid = opqs((int)blockIdx.x); } while (0)
#define SEAM(k) do { if (IN(k) && IN((k) + 1)) xcd_barrier(bar); } while (0)
    bf16* WA = (bf16*)(F.ws + WS_WA); bf16* XB = (bf16*)(F.ws + WS_XB); bf16* Y = (bf16*)(F.ws + WS_Y); bf16* Zm = (bf16*)(F.ws + WS_ZG); _Float16* Gb = (_Float16*)(F.ws + WS_ZG);
    bf16* Hb = (bf16*)(F.ws + WS_ZG); bf16* MB = (bf16*)F.out;
 bf16* Bt3 = (bf16*)(F.ws + WS_BT3); bf16* Bt4 = (bf16*)(F.ws + WS_BT4); bf16* Bt5 = (bf16*)(F.ws + WS_BT5); bf16* Bt6 = (bf16*)(F.ws + WS_BT6);

    if (IN(0)) { REFRESH(); convert_matrix<RM_WIN>(F, F.in[I_WIN], DM, INC, WA, DM, 0, 0, F.bid * NWAVES + F.wave, F.G * NWAVES, 0, 0, F.G == 256 ? 128 : 0); REFRESH(); x_to_bf16(F, XB); }
    SEAM(0);

    const bool fast = F.G == 256;
    for (int l = 0; l < 2; ++l) {
        const int pb = 1 + 9 * l;
        if (IN(pb + 0)) for (int rep = 0; rep < NREP(0); ++rep) { if (rep) xcd_barrier(bar);
            if (fast && l == 1 && rep == 0) { REFRESH();
                ln_rows(F, F.out, F.out, F.in[I_LN2G], F.in[I_LN2B], XB, F.out + (size_t)MP * DM, (const float*)(F.ws + WS_SLAB), 11, 32); publish_ready(F, F.ctl + CW_RDY + 64 * 1); }
            pg8::Gemm g{XB, WA, DM, DM, XB}; pg8::UnitOrder S; S.init(pg8::SK_PLAIN, 4096, DM, F.G, F.bid, 0); pg8::EpiMix E{Zm, F.out, l};
            if (fast && l == 1) { S.ready = (const unsigned*)(F.ctl + CW_RDY + 64 * 1); S.need = (unsigned)F.G; }
            pg8::gemm_phase<pg8::EpiMix, pg8::UnitOrder, true>(F.lds + RING_OFF, g, S, E, wave0);
            if (F.G == 256 && F.bid >= 32) {
                REFRESH(); const int gw = (F.bid - 32) * NWAVES + F.wave, NGW = 224 * NWAVES; const float* wbr = F.in[I_WBR] + (size_t)l * 4 * 512 * 1024;
                convert_matrix<RM_ID>(F, wbr, 512, 1024, Bt3, 2048, 0, 0, gw, NGW, 0);
                convert_matrix<RM_ID>(F, wbr + (size_t)512 * 1024, 512, 1024, Bt3, 2048, 512, 0, gw, NGW, 256);
                convert_matrix<RM_ID>(F, wbr + (size_t)3 * 512 * 1024, 512, 1024, Bt3, 2048, 1536, 0, gw, NGW, 512);
                convert_matrix<RM_ID>(F, F.in[I_WOUT] + (size_t)l * DM * DM, DM, DM, Bt4, DM, 0, 0, gw, NGW, 768);
                REFRESH(); compose_pool(F, l, Bt3, gw, NGW, 1280);
                REFRESH(); convert_matrix<RM_WIN>(F, F.in[I_WIN] + (size_t)l * DM * INC, DM, INC, WA, DM, 0, 0, gw, NGW, 0, 128, 128); } }
        SEAM(pb + 0);
        if (IN(pb + 1)) for (int rep = 0; rep < NREP(1); ++rep) { if (rep) xcd_barrier(bar);
            __syncthreads(); REFRESH();
            for (int r2 = 0; r2 < NREP2(0); ++r2) for (int it = F.bid; it < 256; it += F.G) { a_prompt_item(F, l, it, Zm, Y); __syncthreads(); }
            REFRESH();
            for (int r2 = 0; r2 < NREP2(1); ++r2) for (int it = (F.bid + 128) % F.G; it < 128; it += F.G) a_sample_task(F, l, 8 * it + F.wave, Zm, Y);
            __syncthreads(); REFRESH();
            const bool rebal = F.G == 256, gemm_wg = rebal && F.bid >= 128 && F.bid < 160;
            for (int r2 = 0; r2 < NREP2(2); ++r2) { if (!gemm_wg) for (int it = F.bid; it < 256; it += F.G) { b_prompt_item(F, l, it, Zm, Y); __syncthreads(); }
                if (rebal && F.bid >= 160 && F.bid < 192) { b_prompt_item(F, l, F.bid - 32, Zm, Y); __syncthreads(); } }
            REFRESH();
            for (int r2 = 0; r2 < NREP2(3); ++r2) { if (!gemm_wg) for (int it = F.bid; it < 256; it += F.G) { cd_prompt_item(F, l, it, Zm, Y); __syncthreads(); }
                if (rebal && F.bid >= 192 && F.bid < 224) { cd_prompt_item(F, l, F.bid - 64, Zm, Y); __syncthreads(); } }
            REFRESH();
            for (int r2 = 0; r2 < NREP2(4); ++r2) for (int it = F.bid; it < 128; it += F.G) { s_sample_item(F, l, it, Zm, Y); __syncthreads(); }
            if (F.G == 256 && F.bid >= 128 && F.bid < 160) {
                pg8::Gemm g{XB, WA + (size_t)4096 * DM, DM, DM, XB}; pg8::UnitOrder S; S.init(pg8::SK_PLAIN, 4096, DM, 32, F.bid - 128, 0, false, true); pg8::EpiGate E{Gb};
                pg8::gemm_phase<pg8::EpiGate, pg8::UnitOrder, true>(F.lds + RING_OFF, g, S, E, wave0); }
            REFRESH();
            const float* wbr = F.in[I_WBR] + (size_t)l * 4 * 512 * 1024;
            if (F.G != 256) { const int gw = F.bid * NWAVES + F.wave, NGW = F.G * NWAVES;
                convert_matrix<RM_ID>(F, wbr, 512, 1024, Bt3, 2048, 0, 0, gw, NGW); convert_matrix<RM_ID>(F, wbr + (size_t)512 * 1024, 512, 1024, Bt3, 2048, 512, 0, gw, NGW);
                convert_matrix<RM_ID>(F, wbr + (size_t)3 * 512 * 1024, 512, 1024, Bt3, 2048, 1536, 0, gw, NGW); convert_matrix<RM_ID>(F, F.in[I_WOUT] + (size_t)l * DM * DM, DM, DM, Bt4, DM, 0, 0, gw, NGW);
                REFRESH(); compose_pool(F, l, Bt3, gw, NGW); }
        }
        SEAM(pb + 1);
        if (IN(pb + 2)) for (int rep = 0; rep < NREP(2); ++rep) { if (rep) xcd_barrier(bar); pg8::Gemm g{XB, WA + (size_t)4096 * DM, DM, DM, XB}; pg8::UnitOrder S; S.init(pg8::SK_PLAIN, 4096, DM, F.G, F.bid, 0, true, F.G != 256); pg8::EpiGate E{Gb};
            pg8::gemm_phase<pg8::EpiGate, pg8::UnitOrder, true>(F.lds + RING_OFF, g, S, E, wave0); }
        SEAM(pb + 2);
        if (IN(pb + 3)) for (int rep = 0; rep < NREP(3); ++rep) { if (rep) xcd_barrier(bar); pg8::Gemm g{Y, Bt3, 2048, 2048, Y}; pg8::UnitOrder S; S.init(pg8::SK_P3, DM, 2048, F.G, F.bid, 0); pg8::EpiMerge E{Gb, MB, (bf16*)(F.ws + WS_MB4S)};
            pg8::gemm_phase<pg8::EpiMerge, pg8::UnitOrder, true>(F.lds + RING_OFF, g, S, E, wave0);
            if (F.G == 256 && F.bid >= 32 && rep + 1 == NREP(3)) {
                REFRESH(); const int gw = (F.bid - 32) * NWAVES + F.wave, NGW = 224 * NWAVES;
                convert_matrix<RM_GU>(F, F.in[I_WG] + (size_t)l * DM * FF, DM, FF, Bt5, DM, 0, 0, gw, NGW, 0);
                convert_matrix<RM_GU>(F, F.in[I_WU] + (size_t)l * DM * FF, DM, FF, Bt5, DM, 0, 128, gw, NGW, 1408); } }
        SEAM(pb + 3);
        if (IN(pb + 4)) for (int rep = 0; rep < 1; ++rep) { pg8::Gemm g{MB, Bt4, DM, DM, (const bf16*)(F.ws + WS_MB4S)}; pg8::UnitOrder S; S.init(pg8::SK_P4, DM, DM, F.G, F.bid, 0);
            pg8::EpiRes E{l == 0 ? F.in[I_XP] : nullptr, l == 0 ? nullptr : XB, nullptr, XB, F.in[I_LN1G] + l * DM, F.in[I_LN1B] + l * DM, (float*)(F.ws + WS_SLAB),
                          pg8::PanelStats{(unsigned*)(F.ws + WS_XCH + (size_t)(2 * l) * 512 * 1024), (unsigned*)(F.ctl + CW_SEAM + (2 * l) * SEAM_BANK)}, F.lds + XLDS_OFF, wave0};
            pg8::gemm_phase<pg8::EpiRes, pg8::UnitOrder, true>(F.lds + RING_OFF, g, S, E, wave0);
}
        SEAM(pb + 4);
        if (IN(pb + 5) && !fast) for (int rep = 0; rep < NREP(5); ++rep) { if (rep) xcd_barrier(bar);
            REFRESH();
            ln_rows(F, F.out, rep + 1 < NREP(5) ? (float*)(F.ws + WS_Y) : F.out, F.in[I_LN1G] + l * DM, F.in[I_LN1B] + l * DM, rep + 1 < NREP(5) ? nullptr : XB, l == 0 ? F.in[I_XS] : F.out + (size_t)MP * DM, (const float*)(F.ws + WS_SLAB), 16);
            REFRESH();
            if (F.G != 256) { const int gw = F.bid * NWAVES + F.wave, NGW = F.G * NWAVES;
                convert_matrix<RM_GU>(F, F.in[I_WG] + (size_t)l * DM * FF, DM, FF, Bt5, DM, 0, 0, gw, NGW); convert_matrix<RM_GU>(F, F.in[I_WU] + (size_t)l * DM * FF, DM, FF, Bt5, DM, 0, 128, gw, NGW);
                convert_matrix<RM_ID>(F, F.in[I_WD] + (size_t)l * FF * DM, FF, DM, Bt6, FF, 0, 0, gw, NGW); }
        }
        if (!fast) SEAM(pb + 5);
        if (IN(pb + 6)) for (int rep = 0; rep < NREP(6); ++rep) { if (rep) xcd_barrier(bar);
            if (fast && rep == 0) { REFRESH();
                ln_rows(F, F.out, F.out, F.in[I_LN1G] + l * DM, F.in[I_LN1B] + l * DM, XB, l == 0 ? F.in[I_XS] : F.out + (size_t)MP * DM, (const float*)(F.ws + WS_SLAB), 16, 172); publish_ready(F, F.ctl + CW_RDY + 64 * (2 * l)); }
            pg8::Gemm g{XB, Bt5, DM, DM, XB}; pg8::UnitOrder S; S.init(pg8::SK_PLAIN, 2 * FF, DM, F.G, F.bid, 0); pg8::EpiSwi E{Hb};
            if (fast) { S.ready = (const unsigned*)(F.ctl + CW_RDY + 64 * (2 * l)); S.need = (unsigned)F.G; }
            pg8::gemm_phase<pg8::EpiSwi, pg8::UnitOrder, true>(F.lds + RING_OFF, g, S, E, wave0);
            if (F.G == 256 && F.bid >= 172 && rep + 1 == NREP(6)) {
                REFRESH(); const int gw = (F.bid - 172) * NWAVES + F.wave, NGW = 84 * NWAVES;
                convert_matrix<RM_ID>(F, F.in[I_WD] + (size_t)l * FF * DM, FF, DM, Bt6, FF, 0, 0, gw, NGW, 0);
            } }
        SEAM(pb + 6);
        if (IN(pb + 7)) for (int rep = 0; rep < 1; ++rep) { pg8::Gemm g{Hb, Bt6, FF, FF, Hb}; pg8::UnitOrder S; S.init(pg8::SK_P6, DM, FF, F.G, F.bid, 0); pg8::EpiRes E{nullptr, XB, l == 1 ? F.out : nullptr, l == 0 ? XB : nullptr, F.in[I_LN2G] + l * DM, F.in[I_LN2B] + l * DM, (float*)(F.ws + WS_SLAB),
                          pg8::PanelStats{(unsigned*)(F.ws + WS_XCH + (size_t)(2 * l + 1) * 512 * 1024), (unsigned*)(F.ctl + CW_SEAM + (2 * l + 1) * SEAM_BANK)}, F.lds + XLDS_OFF, wave0};
            pg8::gemm_phase<pg8::EpiRes, pg8::UnitOrder, true>(F.lds + RING_OFF, g, S, E, wave0);
            if (F.G == 256 && F.bid >= 88 && l == 0) {
                REFRESH(); convert_matrix<RM_WIN>(F, F.in[I_WIN] + (size_t)DM * INC, DM, INC, WA, DM, 0, 0, (F.bid - 88) * NWAVES + F.wave, 168 * NWAVES, 0, 0, 128); } }
        SEAM(pb + 7);
        if (IN(pb + 8) && !(fast && l == 0)) for (int rep = 0; rep < NREP(8); ++rep) { if (rep) xcd_barrier(bar);
            REFRESH();
            ln_rows(F, F.out, rep + 1 < NREP(8) ? (float*)(F.ws + WS_Y) : F.out, F.in[I_LN2G] + l * DM, F.in[I_LN2B] + l * DM, (l == 0 && rep + 1 == NREP(8)) ? XB : nullptr, F.out + (size_t)MP * DM, (const float*)(F.ws + WS_SLAB), 11);
            REFRESH();
            if (l == 0 && F.G != 256) convert_matrix<RM_WIN>(F, F.in[I_WIN] + (size_t)DM * INC, DM, INC, WA, DM, 0, 0, F.bid * NWAVES + F.wave, F.G * NWAVES);
        }
        if (l == 0 && !fast) SEAM(pb + 8);
    }
#undef IN
#undef SEAM
#undef REFRESH
}

extern "C" void kernel_launch(void* const* d_in, const int* in_sizes, int n_in, void* d_out, int out_size, void* d_ws, size_t ws_size, hipStream_t stream) {
    static int grid = 0;
    if (grid == 0) {
        if (n_in != 31 || out_size != (int)O_END || ws_size < WS_END) { fprintf(stderr, "kernel_launch: unexpected sizes n_in %d out %d ws %zu\n", n_in, out_size, ws_size); grid = -1; return; }
        int dev = 0, cus = 0, per_cu = 0;
        if (hipGetDevice(&dev) != hipSuccess || hipDeviceGetAttribute(&cus, hipDeviceAttributeMultiprocessorCount, dev) != hipSuccess) { grid = -1; return; }
        if (hipFuncSetAttribute((const void*)hybrid_fwd, hipFuncAttributeMaxDynamicSharedMemorySize, LDS_BYTES) != hipSuccess) { fprintf(stderr, "kernel_launch: hipFuncSetAttribute failed\n"); grid = -1; return; }
        if (hipOccupancyMaxActiveBlocksPerMultiprocessor(&per_cu, (const void*)hybrid_fwd, NWAVES * 64, LDS_BYTES) != hipSuccess || per_cu < 1)
            fprintf(stderr, "kernel_launch: occupancy query reports %d workgroups per CU\n", per_cu);
        (void)hipGetLastError();
        grid = cus;
    }
    if (grid < 0) return;
    if (hipMemsetAsync((char*)d_ws + WS_CTL, 0, CTL_ZERO_BYTES, stream) != hipSuccess) { fprintf(stderr, "kernel_launch: memset failed\n"); return; }
    Args a{};
    for (int i = 0; i < 31; ++i) a.in[i] = (const float*)d_in[i];
    a.out = (float*)d_out; a.ws = (unsigned char*)d_ws;
#if MK_SPLIT
    for (int ph = 0; ph < NPHASE; ++ph) { a.ph_lo = ph; a.ph_hi = ph + 1; hipLaunchKernelGGL(hybrid_fwd, dim3(grid), dim3(NWAVES * 64), LDS_BYTES, stream, a); }
#else
    a.ph_lo = 0; a.ph_hi = NPHASE;
    hipLaunchKernelGGL(hybrid_fwd, dim3(grid), dim3(NWAVES * 64), LDS_BYTES, stream, a);
#endif
}
```

```cpp
#include <hip/hip_runtime.h>
#include <cstdio>
#include <cstdint>

#ifndef PROBE_REP
#define PROBE_REP 0
#endif
#define NREP(k) (1 + ((PROBE_REP >> (k)) & 1))
#ifndef PROBE2
#define PROBE2 0
#endif
#define NREP2(j) (1 + ((PROBE2 >> (j)) & 1))
#ifndef MK_SPLIT
#define MK_SPLIT 0
#endif

constexpr int DM = 1024, WMIX = 512, NPB = 8, SEQ = 2048, NSB = 128, DSEQ = 4;
constexpr int MP = NPB * SEQ, MS = NSB * DSEQ, M = MP + MS;
constexpr int FF = 2816, INC = 8192, ZC = 3072, YC = 2048, GC = 4096;
constexpr float LN_EPS = 1e-5f, ALPHA = 1.41421356237f;
constexpr size_t O_Y = 0, O_PH = (size_t)M * DM, O_PRGC = O_PH + 8192, O_PCF = O_PRGC + 24576, O_PPOOL = O_PCF + 245760, O_PSC = O_PPOOL + 122880,
                 O_SH = O_PSC + 16384, O_SRGC = O_SH + 131072, O_SCF = O_SRGC + 393216, O_SPOOL = O_SCF + 3932160, O_SSC = O_SPOOL + 1966080, O_END = O_SSC + 262144;
static_assert(O_END == 24403968, "output map");

__device__ __forceinline__ int opqv(int v) { asm volatile("" : "+v"(v)); return v; }
__device__ __forceinline__ int lane_now() { int l; asm volatile("v_mbcnt_lo_u32_b32 %0, -1, 0\n\tv_mbcnt_hi_u32_b32 %0, -1, %0" : "=v"(l)); return l; }
__device__ __forceinline__ int opqs(int v) { asm volatile("" : "+s"(v)); return v; }
namespace pg8 {
#define PG8_LAS __attribute__((address_space(3)))
typedef unsigned short bf16_t;
typedef short bf16x8 __attribute__((ext_vector_type(8)));
typedef float f32x4 __attribute__((ext_vector_type(4)));
typedef float f32x2 __attribute__((ext_vector_type(2)));
typedef unsigned u32x4 __attribute__((ext_vector_type(4)));
typedef unsigned u32x2 __attribute__((ext_vector_type(2)));
typedef _Float16 f16x4 __attribute__((ext_vector_type(4)));
typedef _Float16 f16x8 __attribute__((ext_vector_type(8)));
constexpr int BM = 256, BK = 64, HALF = 128, HTB = HALF * BK * 2, STAGE_BYTES = 8 * HTB, NXCD = 8, WGM = 8;

__host__ __device__ __forceinline__ int lds_byte(int r, int c) { const int st = (r >> 4) * 2 + (c >> 5), rr = r & 15, cc = c & 31, ob = rr * 64 + cc * 2; return st * 1024 + (ob ^ (((ob >> 9) & 1) << 5)); }
__host__ __device__ __forceinline__ void stage_rc(int b, int& R, int& C) { const int st = b / 1024, sb = b % 1024, swz = sb ^ (((sb >> 9) & 1) << 5); R = (st >> 1) * 16 + swz / 64; C = (st & 1) * 32 + (swz % 64) / 2; }
__host__ __device__ __forceinline__ int perm32(int rho) { const int n = rho >> 4, i = rho & 15; return 8 * (i >> 2) + 4 * n + (i & 3); }

struct Unit { int pm, pn, nt, mode, aux; long offA, offB; };
struct Gemm { const bf16_t* A; const bf16_t* Bt; int lda, ldb; const bf16_t* As; };

enum { SK_PLAIN = 0, SK_P3 = 1, SK_P4 = 2, SK_P6 = 3 };
struct UnitOrder {
    int kind, nN, nwgP, nS, ntP, G, c; long offA_s; const unsigned* ready = nullptr; unsigned need = 0;
    __device__ __forceinline__ void init(int kind_, int N_, int K_, int G_, int c_, long offA_s_, bool prompt = true, bool sample = true) { kind = kind_; nN = N_ / BM; nwgP = prompt ? 64 * nN : 0; ntP = K_ / BK; G = G_; c = c_; offA_s = offA_s_;
        nS = !sample ? 0 : kind_ == SK_PLAIN ? 2 * nN : kind_ == SK_P3 ? 32 : kind_ == SK_P4 ? 128 : 88; }
    __device__ __forceinline__ bool next(int i, Unit& u, const Gemm& g) const {
        const long L = (long)i * G + c; const long ra = (long)BM * g.lda * 2, rb = (long)BM * g.ldb * 2;
        if (L < nwgP) {
            int wgid = (int)L; { const int q = nwgP / NXCD, xcd = wgid % NXCD, off = wgid / NXCD; wgid = xcd * q + off; }
            const int nig = WGM * nN; u.pm = (wgid / nig) * WGM + ((wgid % nig) % WGM); u.pn = (wgid % nig) / WGM;
            u.nt = ntP; u.mode = 0; u.aux = 0; u.offA = u.pm * ra; u.offB = u.pn * rb; return true; }
        const int s = (int)(L - nwgP); if (s >= nS) return false;
        if (kind == SK_PLAIN) { u.pm = 64 + (s & 1); u.pn = s >> 1; u.nt = ntP; u.mode = 0; u.aux = 0; u.offA = u.pm * ra; u.offB = u.pn * rb; }
        else if (kind == SK_P3) { const int n = s & 3, tile = s >> 2; u.pm = 64 + (tile & 1); u.pn = tile >> 1; u.nt = 8; u.mode = 1; u.aux = n; u.offA = u.pm * ra + 1024 * n; u.offB = u.pn * rb + 1024 * n; }
        else if (kind == SK_P4) { const int ch = s & 15, tile = s >> 4, n = ch >> 2, kin = (ch & 3) * 256; u.pm = 64 + (tile & 1); u.pn = tile >> 1; u.nt = 4; u.mode = 1; u.aux = ch;
            u.offA = ((long)(n * 512 + (u.pm - 64) * 256) * 1024 + kin) * 2; u.offB = u.pn * rb + kin * 2; }
        else { const int ch = s % 11, tile = s / 11; u.pm = 64 + (tile & 1); u.pn = tile >> 1; u.nt = 4; u.mode = 1; u.aux = ch; u.offA = u.pm * ra + 512 * ch; u.offB = u.pn * rb + 512 * ch; }
        return true;
    }
    __device__ __forceinline__ void a_ready(const Unit& u, int wid) const {
        if (ready == nullptr || u.pm < 64) return;
        if (wid == 0) { unsigned spins = 0;
            while ((unsigned)__builtin_amdgcn_readfirstlane(__hip_atomic_load(ready, __ATOMIC_RELAXED, __HIP_MEMORY_SCOPE_AGENT)) < need) { __builtin_amdgcn_s_sleep(2); if (++spins > (1u << 20)) break; }
            __builtin_amdgcn_fence(__ATOMIC_ACQUIRE, "agent");
            asm volatile("s_waitcnt vmcnt(0)" ::: "memory"); }
        asm volatile("" ::: "memory"); __builtin_amdgcn_s_barrier(); asm volatile("" ::: "memory");
    }
};

__device__ __forceinline__ unsigned cvt_pk_bf16(float lo, float hi) { unsigned r; asm volatile("v_cvt_pk_bf16_f32 %0, %1, %2" : "=v"(r) : "v"(lo), "v"(hi)); return r; }
__device__ __forceinline__ float sigmoidf_fast(float x) { return __builtin_amdgcn_rcpf(1.0f + __builtin_amdgcn_exp2f(-1.44269504089f * x)); }
__device__ __forceinline__ float gelu_tanh(float x) { const float t = x * x, y = x * fmaf(t, -0.10294324f, -2.3022082f); return x * __builtin_amdgcn_rcpf(1.0f + __builtin_amdgcn_exp2f(y)); }

__device__ __forceinline__ void acc_zero(f32x4 (&acc)[2][2][4][2]) {
#pragma unroll
    for (int a = 0; a < 2; ++a)
#pragma unroll
        for (int b = 0; b < 2; ++b)
#pragma unroll
            for (int m = 0; m < 4; ++m)
#pragma unroll
                for (int n = 0; n < 2; ++n) acc[a][b][m][n] = (f32x4){0.f, 0.f, 0.f, 0.f};
}
__device__ __forceinline__ float* state_ptr(float* out, int R, int keep, int layer, size_t p_off, size_t s_off) {
    if (R < MP) { const int b = R >> 11, j = (R & 2047) - (2048 - keep); return j < 0 ? nullptr : out + p_off + (size_t)((layer * 8 + b) * keep + j) * 512; }
    const int s = (R - MP) >> 2, j = (R & 3) + keep - 4; return j < 0 ? nullptr : out + s_off + (size_t)((layer * 128 + s) * keep + j) * 512;
}

struct EpiMix {
    static constexpr bool PERM = true, MIDK = false;
    __device__ __forceinline__ void init(f32x4 (&acc)[2][2][4][2], const Unit&, int, int) const { acc_zero(acc); }
    bf16_t* Z; float* out; int layer;
    __device__ __forceinline__ void midk(f32x4 (&)[2][2][4][2], const Unit&, int, int, int, int, int) const {}
    __device__ __forceinline__ void operator()(f32x4 (&acc)[2][2][4][2], const Unit& u, int wr, int wc, int fr_, int fq_) const {
        const int lane_ = lane_now(), fr = lane_ & 15, fq = lane_ >> 4; (void)fr_; (void)fq_;
        const int pn = u.pn; int type, zcol, keep = 0, scol = 0; size_t poff = 0, soff = 0;
        if (pn < 2) { type = 0; zcol = 256 * pn; keep = 3; scol = zcol; poff = O_PRGC; soff = O_SRGC; }
        else if (pn < 4) { type = 1; zcol = 512 + 256 * (pn - 2); }
        else if (pn < 8) { type = 2; zcol = 1024 + 128 * (pn - 4); keep = 30; scol = 128 * (pn - 4); poff = O_PCF; soff = O_SCF; }
        else if (pn < 10) { type = 0; zcol = 1536 + 256 * (pn - 8); keep = 15; scol = 256 * (pn - 8); poff = O_PPOOL; soff = O_SPOOL; }
        else if (pn < 12) { type = 0; zcol = 2048 + 256 * (pn - 10); }
        else { type = 3; zcol = 2560 + 128 * (pn - 12); keep = 2; scol = 128 * (pn - 12); poff = O_PSC; soff = O_SSC; }
        const bool tail = keep != 0 && (u.pm >= 64 || (u.pm & 7) == 7);
        const int row0 = u.pm * BM + wr * 64 + fr, cl = wc * 32 + 8 * fq;
        if (type < 2) {
#pragma unroll
            for (int ai = 0; ai < 2; ++ai)
#pragma unroll
                for (int m = 0; m < 4; ++m) { const int R = row0 + ai * HALF + m * 16; bf16_t* rowp = Z + (size_t)R * ZC + zcol + cl;
                    float* sp = tail ? state_ptr(out, R, keep, layer, poff, soff) : nullptr;
#pragma unroll
                    for (int bj = 0; bj < 2; ++bj) { f32x4 v0 = acc[ai][bj][m][0], v1 = acc[ai][bj][m][1];
                        if (type == 1) { v0 = (f32x4){gelu_tanh(v0[0]), gelu_tanh(v0[1]), gelu_tanh(v0[2]), gelu_tanh(v0[3])}; v1 = (f32x4){gelu_tanh(v1[0]), gelu_tanh(v1[1]), gelu_tanh(v1[2]), gelu_tanh(v1[3])}; }
                        u32x4 w; w.x = cvt_pk_bf16(v0[0], v0[1]); w.y = cvt_pk_bf16(v0[2], v0[3]); w.z = cvt_pk_bf16(v1[0], v1[1]); w.w = cvt_pk_bf16(v1[2], v1[3]);
                        *(u32x4*)(rowp + bj * HALF) = w;
                        if (sp) { *(f32x4*)(sp + scol + cl + bj * HALF) = v0; *(f32x4*)(sp + scol + cl + bj * HALF + 4) = v1; } } }
        } else {
#pragma unroll
            for (int ai = 0; ai < 2; ++ai)
#pragma unroll
                for (int m = 0; m < 4; ++m) { const int R = row0 + ai * HALF + m * 16; bf16_t* rowp = Z + (size_t)R * ZC + zcol + cl;
                    float* sp = tail ? state_ptr(out, R, keep, layer, poff, soff) : nullptr;
                    f32x4 v0, v1; const f32x4 a0 = acc[ai][0][m][0], a1 = acc[ai][0][m][1], b0 = acc[ai][1][m][0], b1 = acc[ai][1][m][1];
                    if (type == 2) {
#pragma unroll
                        for (int i = 0; i < 4; ++i) { v0[i] = a0[i] * sigmoidf_fast(b0[i]); v1[i] = a1[i] * sigmoidf_fast(b1[i]); }
                    } else { v0 = a0 * b0; v1 = a1 * b1; }
                    u32x4 w; w.x = cvt_pk_bf16(v0[0], v0[1]); w.y = cvt_pk_bf16(v0[2], v0[3]); w.z = cvt_pk_bf16(v1[0], v1[1]); w.w = cvt_pk_bf16(v1[2], v1[3]);
                    *(u32x4*)rowp = w;
                    if (sp) { *(f32x4*)(sp + scol + cl) = v0; *(f32x4*)(sp + scol + cl + 4) = v1; } }
        }
    }
};

struct EpiGate {
    static constexpr bool PERM = true, MIDK = false;
    __device__ __forceinline__ void init(f32x4 (&acc)[2][2][4][2], const Unit&, int, int) const { acc_zero(acc); }
    _Float16* G;
    __device__ __forceinline__ void midk(f32x4 (&)[2][2][4][2], const Unit&, int, int, int, int, int) const {}
    __device__ __forceinline__ void operator()(f32x4 (&acc)[2][2][4][2], const Unit& u, int wr, int wc, int fr_, int fq_) const {
        const int lane_ = lane_now(), fr = lane_ & 15, fq = lane_ >> 4; (void)fr_; (void)fq_;
        const int row0 = u.pm * BM + wr * 64 + fr, ch0 = 64 * u.pn + 16 * wc + 4 * fq; const bool plain = u.pm >= 64;
#pragma unroll
        for (int ai = 0; ai < 2; ++ai)
#pragma unroll
            for (int m = 0; m < 4; ++m) { const int R = row0 + ai * HALF + m * 16; _Float16* gp = G + (size_t)R * GC + ch0;
                f16x4 r0, r1, r2, g3;
#pragma unroll
                for (int i = 0; i < 4; ++i) {
                    const float d0 = 1.f + __builtin_amdgcn_exp2f(__builtin_amdgcn_fmed3f(acc[ai][0][m][0][i], -15.f, 15.f)), d1 = 1.f + __builtin_amdgcn_exp2f(__builtin_amdgcn_fmed3f(acc[ai][0][m][1][i], -15.f, 15.f));
                    const float d2 = 1.f + __builtin_amdgcn_exp2f(__builtin_amdgcn_fmed3f(acc[ai][1][m][0][i], -15.f, 15.f)), d3 = 1.f + __builtin_amdgcn_exp2f(__builtin_amdgcn_fmed3f(acc[ai][1][m][1][i], -15.f, 15.f));
                    const float i0 = __builtin_amdgcn_rcpf(d0), i1 = __builtin_amdgcn_rcpf(d1), i2 = __builtin_amdgcn_rcpf(d2), i3 = __builtin_amdgcn_rcpf(d3);
                    if (plain) { r0[i] = (_Float16)i0; r1[i] = (_Float16)i1; r2[i] = (_Float16)i2; }
                    else { r0[i] = (_Float16)(d1 * i0); r1[i] = (_Float16)(d2 * i1); r2[i] = (_Float16)(d3 * i2); }
                    g3[i] = (_Float16)i3; }
                *(f16x4*)(gp) = r0; *(f16x4*)(gp + 1024) = r1; *(f16x4*)(gp + 2048) = r2; *(f16x4*)(gp + 3072) = g3; }
    }
};

struct EpiMerge {
    static constexpr bool PERM = true, MIDK = true;
    __device__ __forceinline__ void init(f32x4 (&acc)[2][2][4][2], const Unit&, int, int) const { acc_zero(acc); }
    const _Float16* G; bf16_t* O; bf16_t* Os;
    __device__ __forceinline__ void scale(f32x4 (&acc)[2][2][4][2], const Unit& u, int seg, int wr, int wc) const {
        const int lane_ = lane_now(), fr = lane_ & 15, fq = lane_ >> 4;
        const int row0 = u.pm * BM + wr * 64 + fr, c0 = 1024 * seg + 256 * u.pn + wc * 32 + 8 * fq;
#pragma unroll
        for (int ai = 0; ai < 2; ++ai)
#pragma unroll
            for (int m = 0; m < 4; ++m) { const _Float16* gp = G + (size_t)(row0 + ai * HALF + m * 16) * GC + c0;
#pragma unroll
                for (int bj = 0; bj < 2; ++bj) { const f16x8 f = *(const f16x8*)(gp + bj * HALF);
                    acc[ai][bj][m][0] *= (f32x4){(float)f[0], (float)f[1], (float)f[2], (float)f[3]}; acc[ai][bj][m][1] *= (f32x4){(float)f[4], (float)f[5], (float)f[6], (float)f[7]}; } }
    }
    __device__ __forceinline__ void midk(f32x4 (&acc)[2][2][4][2], const Unit& u, int seg, int wr, int wc, int, int) const { scale(acc, u, seg, wr, wc); }
    __device__ __forceinline__ void operator()(f32x4 (&acc)[2][2][4][2], const Unit& u, int wr, int wc, int, int) const {
        scale(acc, u, u.mode ? u.aux : 3, wr, wc);
        const int lane_ = lane_now(), fr = lane_ & 15, fq = lane_ >> 4;
        const int row0 = (u.mode ? (u.pm - 64) * BM + 512 * u.aux : u.pm * BM) + wr * 64 + fr, c0 = 256 * u.pn + wc * 32 + 8 * fq;
        bf16_t* O = u.mode ? Os : this->O;
#pragma unroll
        for (int ai = 0; ai < 2; ++ai)
#pragma unroll
            for (int m = 0; m < 4; ++m) { bf16_t* rowp = O + (size_t)(row0 + ai * HALF + m * 16) * DM + c0;
#pragma unroll
                for (int bj = 0; bj < 2; ++bj) { const f32x4 v0 = acc[ai][bj][m][0], v1 = acc[ai][bj][m][1];
                    u32x4 w; w.x = cvt_pk_bf16(v0[0], v0[1]); w.y = cvt_pk_bf16(v0[2], v0[3]); w.z = cvt_pk_bf16(v1[0], v1[1]); w.w = cvt_pk_bf16(v1[2], v1[3]); *(u32x4*)(rowp + bj * HALF) = w; } }
    }
};

struct PanelStats {
    unsigned* xbuf;
    unsigned* cnt;
    __device__ __forceinline__ void run(const f32x4 (&v)[2][2][4][2], const Unit& u, int wr, int wc, PG8_LAS unsigned char* lds, int wid) const {
        const int lane = lane_now(), fr = lane & 15, fq = lane >> 4;
        PG8_LAS f32x2* P = (PG8_LAS f32x2*)lds;
        PG8_LAS f32x2* S = (PG8_LAS f32x2*)(lds + 8192);
#pragma unroll
        for (int ai = 0; ai < 2; ++ai)
#pragma unroll
            for (int m = 0; m < 4; ++m) {
                float s = 0.f;
#pragma unroll
                for (int bj = 0; bj < 2; ++bj)
#pragma unroll
                    for (int n = 0; n < 2; ++n) { const f32x4 x = v[ai][bj][m][n]; s += (x[0] + x[1]) + (x[2] + x[3]); }
                s += __builtin_bit_cast(float, __builtin_amdgcn_ds_bpermute((lane ^ 16) << 2, __builtin_bit_cast(int, s))); s += __builtin_bit_cast(float, __builtin_amdgcn_ds_bpermute((lane ^ 32) << 2, __builtin_bit_cast(int, s)));
                const float mw = s * (1.0f / 64.0f); float q = 0.f;
#pragma unroll
                for (int bj = 0; bj < 2; ++bj)
#pragma unroll
                    for (int n = 0; n < 2; ++n) { const f32x4 d = v[ai][bj][m][n] - mw; q += (d[0] * d[0] + d[1] * d[1]) + (d[2] * d[2] + d[3] * d[3]); }
                q += __builtin_bit_cast(float, __builtin_amdgcn_ds_bpermute((lane ^ 16) << 2, __builtin_bit_cast(int, q))); q += __builtin_bit_cast(float, __builtin_amdgcn_ds_bpermute((lane ^ 32) << 2, __builtin_bit_cast(int, q)));
                if (fq == 0) P[(ai * HALF + wr * 64 + m * 16 + fr) * 4 + wc] = (f32x2){mw, q};
            }
        asm volatile("s_waitcnt lgkmcnt(0)" ::: "memory"); __builtin_amdgcn_s_barrier(); asm volatile("" ::: "memory");
        const int row = wid * 32 + (lane & 31);
        if (lane < 32) {
            const f32x2 a = P[row * 4 + 0], b = P[row * 4 + 1], c = P[row * 4 + 2], d = P[row * 4 + 3];
            const float mt = (a.x + b.x + c.x + d.x) * 0.25f;
            const float da = a.x - mt, db = b.x - mt, dc = c.x - mt, dd = d.x - mt;
            const float m2 = (a.y + b.y) + (c.y + d.y) + 64.0f * ((da * da + db * db) + (dc * dc + dd * dd));
            unsigned long long* slot = (unsigned long long*)xbuf + ((size_t)(u.pm * BM + row) * 4 + u.pn);
            __hip_atomic_store(slot, ((unsigned long long)__float_as_uint(m2) << 32) | __float_as_uint(mt), __ATOMIC_RELAXED, __HIP_MEMORY_SCOPE_AGENT);
        }
        asm volatile("s_waitcnt vmcnt(0)" ::: "memory");
        if (lane == 0) __hip_atomic_fetch_add(cnt + 64 * u.pm, 1u, __ATOMIC_RELAXED, __HIP_MEMORY_SCOPE_AGENT);
        if (wid == 0) {
            unsigned spins = 0;
            while ((unsigned)__builtin_amdgcn_readfirstlane(__hip_atomic_load(cnt + 64 * u.pm, __ATOMIC_RELAXED, __HIP_MEMORY_SCOPE_AGENT)) < 32u) { __builtin_amdgcn_s_sleep(2); if (++spins > (1u << 20)) break; }
            __builtin_amdgcn_fence(__ATOMIC_ACQUIRE, "agent");
        }
        asm volatile("s_waitcnt vmcnt(0) lgkmcnt(0)" ::: "memory"); __builtin_amdgcn_s_barrier(); asm volatile("" ::: "memory");
        if (lane < 32) {
            const unsigned long long* slot = (const unsigned long long*)xbuf + (size_t)(u.pm * BM + row) * 4; float mt[4], m2[4]; float ms = 0.f;
#pragma unroll
            for (int t = 0; t < 4; ++t) { const unsigned long long w = __hip_atomic_load(slot + t, __ATOMIC_RELAXED, __HIP_MEMORY_SCOPE_AGENT); mt[t] = __uint_as_float((unsigned)w); m2[t] = __uint_as_float((unsigned)(w >> 32)); ms += mt[t]; }
            const float mean = ms * 0.25f; float q = 0.f;
#pragma unroll
            for (int t = 0; t < 4; ++t) { const float dm = mt[t] - mean; q += m2[t] + 256.0f * dm * dm; }
            S[row] = (f32x2){mean, __builtin_amdgcn_rsqf(q * (1.0f / 1024.0f) + LN_EPS)};
        }
        asm volatile("s_waitcnt lgkmcnt(0)" ::: "memory"); __builtin_amdgcn_s_barrier(); asm volatile("" ::: "memory");
    }
};
struct EpiRes {
    static constexpr bool PERM = false, MIDK = false;
    __device__ __forceinline__ void init(f32x4 (&acc)[2][2][4][2], const Unit& u, int wr, int wc) const {
        if (u.mode) { acc_zero(acc); return; }
        const int lane_ = lane_now(), fr = lane_ & 15, fq = lane_ >> 4;
        const size_t e0 = (size_t)(u.pm * BM + wr * 64 + fr) * DM + 256 * u.pn + wc * 32 + 4 * fq;
        if (base16) {
#pragma unroll
            for (int ai = 0; ai < 2; ++ai)
#pragma unroll
                for (int m = 0; m < 4; ++m)
#pragma unroll
                    for (int bj = 0; bj < 2; ++bj)
#pragma unroll
                        for (int n = 0; n < 2; ++n) { const u32x2 w = *(const u32x2*)(base16 + e0 + (size_t)(ai * HALF + m * 16) * DM + bj * HALF + n * 16);
                            acc[ai][bj][m][n] = (f32x4){__uint_as_float(w.x << 16), __uint_as_float(w.x & 0xffff0000u), __uint_as_float(w.y << 16), __uint_as_float(w.y & 0xffff0000u)} * ALPHA; }
            return; }
#pragma unroll
        for (int ai = 0; ai < 2; ++ai)
#pragma unroll
            for (int m = 0; m < 4; ++m)
#pragma unroll
                for (int bj = 0; bj < 2; ++bj)
#pragma unroll
                    for (int n = 0; n < 2; ++n) acc[ai][bj][m][n] = *(const f32x4*)(baseP + e0 + (size_t)(ai * HALF + m * 16) * DM + bj * HALF + n * 16) * ALPHA;
    }
    const float* baseP; const bf16_t* base16; float* out; bf16_t* xb; const float* lng; const float* lnb; float* slab; PanelStats st; PG8_LAS unsigned char* xlds; int wid;
    __device__ __forceinline__ void midk(f32x4 (&)[2][2][4][2], const Unit&, int, int, int, int, int) const {}
    __device__ __forceinline__ void operator()(f32x4 (&acc)[2][2][4][2], const Unit& u, int wr, int wc, int fr_, int fq_) const {
        const int lane_ = lane_now(), fr = lane_ & 15, fq = lane_ >> 4; (void)fr_; (void)fq_;
        const int row0 = u.pm * BM + wr * 64 + fr, c0 = 256 * u.pn + wc * 32 + 4 * fq;
        if (u.mode) {
#pragma unroll
            for (int ai = 0; ai < 2; ++ai)
#pragma unroll
                for (int m = 0; m < 4; ++m) { float* op = slab + ((size_t)u.aux * 512 + (row0 - MP) + ai * HALF + m * 16) * DM + c0;
#pragma unroll
                    for (int bj = 0; bj < 2; ++bj)
#pragma unroll
                        for (int n = 0; n < 2; ++n) *(f32x4*)(op + bj * HALF + n * 16) = acc[ai][bj][m][n]; }
            return; }
        st.run(acc, u, wr, wc, xlds, wid);
        const PG8_LAS f32x2* S = (const PG8_LAS f32x2*)(xlds + 8192);
#pragma unroll
        for (int bj = 0; bj < 2; ++bj)
#pragma unroll
            for (int n = 0; n < 2; ++n) { const int cc = c0 + bj * HALF + n * 16; const f32x4 gv = *(const f32x4*)(lng + cc), bv = *(const f32x4*)(lnb + cc);
#pragma unroll
                for (int ai = 0; ai < 2; ++ai)
#pragma unroll
                    for (int m = 0; m < 4; ++m) { const int r = ai * HALF + wr * 64 + m * 16 + fr; const f32x2 sr = S[r]; const size_t off = (size_t)(u.pm * BM + r) * DM + cc;
                        const f32x4 o = (acc[ai][bj][m][n] - sr.x) * sr.y * gv + bv; if (out) *(f32x4*)(out + off) = o;
                        if (xb) { u32x2 w; w.x = cvt_pk_bf16(o[0], o[1]); w.y = cvt_pk_bf16(o[2], o[3]); *(u32x2*)(xb + off) = w; }
                        if (m & 1) asm volatile("" ::: "memory"); } }
    }
};

struct EpiSwi {
    static constexpr bool PERM = true, MIDK = false;
    __device__ __forceinline__ void init(f32x4 (&acc)[2][2][4][2], const Unit&, int, int) const { acc_zero(acc); }
    bf16_t* H;
    __device__ __forceinline__ void midk(f32x4 (&)[2][2][4][2], const Unit&, int, int, int, int, int) const {}
    __device__ __forceinline__ void operator()(f32x4 (&acc)[2][2][4][2], const Unit& u, int wr, int wc, int fr_, int fq_) const {
        const int lane_ = lane_now(), fr = lane_ & 15, fq = lane_ >> 4; (void)fr_; (void)fq_;
        const int row0 = u.pm * BM + wr * 64 + fr, c0 = 128 * u.pn + wc * 32 + 8 * fq;
#pragma unroll
        for (int ai = 0; ai < 2; ++ai)
#pragma unroll
            for (int m = 0; m < 4; ++m) { bf16_t* rowp = H + (size_t)(row0 + ai * HALF + m * 16) * FF + c0;
                const f32x4 g0 = acc[ai][0][m][0], g1 = acc[ai][0][m][1], u0 = acc[ai][1][m][0], u1 = acc[ai][1][m][1]; f32x4 v0, v1;
#pragma unroll
                for (int i = 0; i < 4; ++i) { v0[i] = g0[i] * sigmoidf_fast(g0[i]) * u0[i]; v1[i] = g1[i] * sigmoidf_fast(g1[i]) * u1[i]; }
                u32x4 w; w.x = cvt_pk_bf16(v0[0], v0[1]); w.y = cvt_pk_bf16(v0[2], v0[3]); w.z = cvt_pk_bf16(v1[0], v1[1]); w.w = cvt_pk_bf16(v1[2], v1[3]);
                *(u32x4*)rowp = w; }
    }
};

template <class Epi, class Sched, bool ALIGN_EPI>
__device__ __forceinline__ void gemm_phase(PG8_LAS unsigned char* lds, const Gemm g, const Sched& S, const Epi& E, int wave_id) {
    const int wid = opqs(wave_id), lane = lane_now(), tid = wid * 64 + lane, wr = wid >> 2, wc = wid & 3, fr = lane & 15, fq = lane >> 4;
    unsigned voffA[2], voffB[2];
#pragma unroll
    for (int i = 0; i < 2; ++i) { int R, C; stage_rc(tid * 16 + i * 8192, R, C); const int Rb = Epi::PERM ? ((R & ~31) + perm32(R & 31)) : R;
        voffA[i] = (unsigned)(R * g.lda + C) * 2u; voffB[i] = (unsigned)(Rb * g.ldb + C) * 2u; }
    const size_t kstep = (size_t)(BK * 2);
    const size_t hstepA = (size_t)HALF * g.lda * 2, hstepB = (size_t)HALF * g.ldb * 2;
    const unsigned ldsw = (unsigned)wid * 1024u;
    const int aoff = lds_byte(wr * 64 + fr, fq * 8), boff = lds_byte(wc * 32 + fr, fq * 8);
#define PG8_SA(b, h) (((b) * 2 + (h)) * HTB)
#define PG8_SB(b, h) ((4 + (b) * 2 + (h)) * HTB)
#define PG8_STAGE(bufoff, gbase, voff) do { _Pragma("unroll") for (int _i = 0; _i < 2; ++_i) \
        __builtin_amdgcn_global_load_lds((const unsigned*)((const char*)(gbase) + (voff)[_i]), (PG8_LAS unsigned*)(lds + (bufoff) + ldsw + _i * 8192), 16, 0, 0); } while (0)
#define PG8_LDA(dst, b, h) do { _Pragma("unroll") for (int m = 0; m < 4; ++m) _Pragma("unroll") for (int k = 0; k < 2; ++k) dst[m][k] = *(const PG8_LAS bf16x8*)(lds + PG8_SA(b, h) + aoff + m * 2048 + k * 1024); } while (0)
#define PG8_LDB(dst, b, h) do { _Pragma("unroll") for (int n = 0; n < 2; ++n) _Pragma("unroll") for (int k = 0; k < 2; ++k) dst[n][k] = *(const PG8_LAS bf16x8*)(lds + PG8_SB(b, h) + boff + n * 2048 + k * 1024); } while (0)
#define PG8_MMA(ai, bj, At, Bt) do { __builtin_amdgcn_s_setprio(1); _Pragma("unroll") for (int m = 0; m < 4; ++m) _Pragma("unroll") for (int n = 0; n < 2; ++n) _Pragma("unroll") for (int k = 0; k < 2; ++k) \
        acc[ai][bj][m][n] = __builtin_amdgcn_mfma_f32_16x16x32_bf16(Bt[n][k], At[m][k], acc[ai][bj][m][n], 0, 0, 0); __builtin_amdgcn_s_setprio(0); } while (0)
#define PG8_WAIT_V(n) asm volatile("s_waitcnt vmcnt(" #n ")" ::: "memory")
#define PG8_WAIT_L(n) asm volatile("s_waitcnt lgkmcnt(" #n ")" ::: "memory")
#define PG8_BAR __builtin_amdgcn_s_barrier()
#define PG8_SCHED __builtin_amdgcn_sched_barrier(0)
    Unit cur, nxt; int ui = 0;
    if (!S.next(0, cur, g)) return;
    f32x4 acc[2][2][4][2];
    E.init(acc, cur, wr, wc);
    bf16x8 At[4][2], B0[2][2], B1[2][2];
    const char* cA = (const char*)(cur.mode ? g.As : g.A) + cur.offA; const char* cB = (const char*)g.Bt + cur.offB;
    PG8_STAGE(PG8_SB(0, 0), cB, voffB); PG8_STAGE(PG8_SB(0, 1), cB + hstepB, voffB); PG8_STAGE(PG8_SA(0, 0), cA, voffA); PG8_STAGE(PG8_SA(0, 1), cA + hstepA, voffA);
    if (wr == 1) PG8_BAR;
    PG8_WAIT_V(2); PG8_BAR;
    PG8_STAGE(PG8_SB(1, 0), cB + kstep, voffB); PG8_STAGE(PG8_SA(1, 0), cA + kstep, voffA); PG8_STAGE(PG8_SB(1, 1), cB + hstepB + kstep, voffB);
    PG8_WAIT_V(6); PG8_BAR;
    for (;;) {
        const bool has_next = S.next(ui + 1, nxt, g);
        const char* nA = has_next ? (const char*)(nxt.mode ? g.As : g.A) + nxt.offA : cA; const char* nB = has_next ? (const char*)g.Bt + nxt.offB : cB;
        const int nt = cur.nt, TSEG = Epi::MIDK ? 8 : nt;
        for (int t0 = 0; t0 < nt; t0 += TSEG) {
        if constexpr (Epi::MIDK) { if (t0 != 0) { PG8_SCHED; E.midk(acc, cur, t0 / TSEG - 1, wr, wc, 0, 0); PG8_SCHED; } }
#pragma unroll 1
        for (int t = t0; t < t0 + TSEG; t += 2) {
            const bool last = (t == nt - 2);
            if (last && has_next) S.a_ready(nxt, wid);
            const char* a1 = cA + (size_t)(t + 1) * kstep;
            const char* a2 = last ? nA : cA + (size_t)(t + 2) * kstep; const char* b2 = last ? nB : cB + (size_t)(t + 2) * kstep;
            const char* a3 = a2 + kstep; const char* b3 = b2 + kstep;
            PG8_LDB(B0, 0, 0); PG8_LDB(B1, 0, 1); PG8_SCHED; PG8_LDA(At, 0, 0); PG8_STAGE(PG8_SA(1, 1), a1 + hstepA, voffA);
            PG8_WAIT_V(8); PG8_WAIT_L(0); PG8_BAR; PG8_MMA(0, 0, At, B0); PG8_MMA(0, 1, At, B1); PG8_BAR; PG8_SCHED;
            PG8_LDA(At, 0, 1); PG8_STAGE(PG8_SB(0, 0), b2, voffB); PG8_STAGE(PG8_SB(0, 1), b2 + hstepB, voffB); PG8_STAGE(PG8_SA(0, 0), a2, voffA);
            PG8_WAIT_V(8); PG8_WAIT_L(0); PG8_BAR; PG8_MMA(1, 0, At, B0); PG8_MMA(1, 1, At, B1); PG8_BAR; PG8_SCHED;
            PG8_LDB(B0, 1, 0); PG8_LDB(B1, 1, 1); PG8_SCHED; PG8_LDA(At, 1, 0); PG8_STAGE(PG8_SA(0, 1), a2 + hstepA, voffA);
            PG8_WAIT_V(8); PG8_WAIT_L(0); PG8_BAR; PG8_MMA(0, 0, At, B0); PG8_MMA(0, 1, At, B1); PG8_BAR; PG8_SCHED;
            PG8_LDA(At, 1, 1); PG8_STAGE(PG8_SB(1, 0), b3, voffB); PG8_STAGE(PG8_SB(1, 1), b3 + hstepB, voffB); PG8_STAGE(PG8_SA(1, 0), a3, voffA);
            PG8_WAIT_V(8); PG8_WAIT_L(0); PG8_BAR; PG8_MMA(1, 0, At, B0); PG8_MMA(1, 1, At, B1); PG8_BAR; PG8_SCHED;
        }
        }
        if constexpr (ALIGN_EPI) { if (wr == 0) PG8_BAR; }
        E(acc, cur, wr, wc, 0, 0);
        if (!has_next) break;
        cur = nxt; cA = nA; cB = nB; ++ui;
        E.init(acc, cur, wr, wc);
        if constexpr (ALIGN_EPI) { if (wr == 1) PG8_BAR; }
    }
    PG8_WAIT_V(0);
    if constexpr (!ALIGN_EPI) { if (wr == 0) PG8_BAR; }
    PG8_BAR;
#undef PG8_SA
#undef PG8_SB
#undef PG8_STAGE
#undef PG8_LDA
#undef PG8_LDB
#undef PG8_MMA
#undef PG8_WAIT_V
#undef PG8_WAIT_L
#undef PG8_BAR
#undef PG8_SCHED
}
}

constexpr int NWAVES = 8;
constexpr int NPHASE = 19;
constexpr size_t MiB = 1u << 20;
constexpr size_t WS_CTL = 0, CTL_ZERO_BYTES = 1 * MiB;
constexpr size_t WS_WA = 1 * MiB;
constexpr size_t WS_XB = 18 * MiB;
constexpr size_t WS_Y = 51 * MiB;
constexpr size_t WS_ZG = 117 * MiB;
constexpr size_t WS_BT3 = 249 * MiB, WS_BT4 = 253 * MiB, WS_BT5 = WS_WA, WS_BT6 = WS_ZG + 108 * MiB;
constexpr size_t WS_MB4S = WS_WA + 13 * MiB;
constexpr size_t WS_SLAB = WS_Y;
constexpr size_t WS_END = 255 * MiB;
static_assert(WS_XB + (size_t)M * DM * 2 <= WS_Y && WS_Y + (size_t)M * YC * 2 <= WS_ZG && WS_ZG + (size_t)M * GC * 2 <= WS_BT3 && WS_SLAB + (size_t)16 * 512 * DM * 4 <= WS_Y + 40 * MiB && WS_Y + 40 * MiB + 4 * 512 * 1024 <= WS_ZG, "ws map");
static_assert((size_t)M * FF * 2 <= 108 * MiB && WS_BT5 + (size_t)2 * FF * DM * 2 <= WS_MB4S && WS_MB4S + 4 * MiB <= WS_XB && WS_BT6 + (size_t)DM * FF * 2 <= WS_BT3, "ws map 2");
constexpr int CW_RDY = 12288;
constexpr int CW_TMO = 0, CW_CODE = 1, CW_BAR = 4096, CW_SEAM = 16384, SEAM_BANK = 8192;
constexpr size_t WS_XCH = WS_Y + 40 * MiB;
constexpr int XLDS_OFF = 131072 + 1024;
constexpr int RING_OFF = 0, RING_BYTES = 131072;
constexpr int LDSCTL_OFF = RING_BYTES, MISC_OFF = LDSCTL_OFF + 320;
constexpr int LDS_BYTES = 147456;

#define GAS __attribute__((address_space(1)))
#define LAS __attribute__((address_space(3)))
typedef unsigned short bf16;
typedef unsigned v4u __attribute__((ext_vector_type(4)));
typedef unsigned v2u __attribute__((ext_vector_type(2)));
typedef float f32x4 __attribute__((ext_vector_type(4)));
typedef float f32x2 __attribute__((ext_vector_type(2)));
typedef short bf16x8 __attribute__((ext_vector_type(8)));
typedef GAS unsigned gu32;
#define RLX_AGENT __ATOMIC_RELAXED, __HIP_MEMORY_SCOPE_AGENT
#define LDS_WAIT() asm volatile("s_waitcnt lgkmcnt(0)" ::: "memory")
#define VM_WAIT() asm volatile("s_waitcnt vmcnt(0)" ::: "memory")
__device__ __forceinline__ unsigned pk2(float lo, float hi) { return pg8::cvt_pk_bf16(lo, hi); }
__device__ __forceinline__ float bflo(unsigned v) { return __uint_as_float(v << 16); }
__device__ __forceinline__ float bfhi(unsigned v) { return __uint_as_float(v & 0xffff0000u); }
__device__ __forceinline__ float bf1(unsigned short h) { return __uint_as_float((unsigned)h << 16); }
__device__ __forceinline__ unsigned short f2bf(float f) { return (unsigned short)(pg8::cvt_pk_bf16(f, 0.f) & 0xffffu); }

#define XB_TMO      128
#define XB_XCNT(j)  (256  + 64 * (j))
#define XB_XSUB(j)  (1280 + 64 * (j))
#define XB_XGEN(j)  (2304 + 64 * (j))
#define XB_TOP      3328
#define XB_TOPGEN   3392
#define XCD_BAR_WORDS 3456
#define XB_SPIN_CAP (1u << 18)
__device__ __forceinline__ unsigned xb_ld(unsigned* p)              { return __hip_atomic_load(p, __ATOMIC_RELAXED, __HIP_MEMORY_SCOPE_AGENT); }
__device__ __forceinline__ unsigned xb_add(unsigned* p, unsigned v) { return __hip_atomic_fetch_add(p, v, __ATOMIC_RELAXED, __HIP_MEMORY_SCOPE_AGENT); }
__device__ __forceinline__ unsigned xb_xcc_id() { return (unsigned)__builtin_amdgcn_s_getreg((3 << 11) | 20) & 0xFu; }
#define XB_SPIN(cond, bar) do { unsigned _sp = 0; while (cond) { __builtin_amdgcn_s_sleep(1); \
    if ((++_sp & 255u) == 0u) { if (xb_ld(&(bar)[XB_TMO])) break; if (_sp > XB_SPIN_CAP) { atomicAdd(&(bar)[XB_TMO], 1u); break; } } } } while (0)
struct XcdBarrier { unsigned* bar; unsigned x; volatile LAS unsigned* st; };
__device__ __forceinline__ XcdBarrier xcd_barrier_post(unsigned* bar, volatile LAS unsigned* st) {
    XcdBarrier b; b.bar = bar; b.x = xb_xcc_id(); b.st = st;
    if (threadIdx.x == 0) (void)xb_add(&bar[XB_XCNT(b.x)], 1u);
    return b;
}
__device__ __forceinline__ void xcd_barrier_complete(unsigned* bar, unsigned x, unsigned& nloc, unsigned& nx) {
    const unsigned G = gridDim.x * gridDim.y * gridDim.z;
    unsigned sum, cnt, mine, sp = 0u;
    for (;;) {
        sum = 0u; cnt = 0u; mine = 0u;
#pragma unroll
        for (unsigned j = 0; j < 16; ++j) { const unsigned c = xb_ld(&bar[XB_XCNT(j)]); sum += c; cnt += (c > 0u) ? 1u : 0u; mine = (j == x) ? c : mine; }
        if (sum == G) break;
        __builtin_amdgcn_s_sleep(1);
        if ((++sp & 255u) == 0u) { if (xb_ld(&bar[XB_TMO])) break; if (sp > XB_SPIN_CAP) { atomicAdd(&bar[XB_TMO], 1u); break; } }
    }
    nloc = mine > 0u ? mine : 1u; nx = cnt > 0u ? cnt : 1u;
}
__device__ __forceinline__ void xcd_barrier(const XcdBarrier& b) {
    asm volatile("s_waitcnt vmcnt(0)" ::: "memory");
    __syncthreads();
    if (threadIdx.x == 0) {
        unsigned* bar = b.bar;
        __builtin_amdgcn_s_waitcnt(0);
        unsigned nloc = b.st[0], nx = b.st[1];
        if (nloc == 0u) { xcd_barrier_complete(bar, b.x, nloc, nx); b.st[0] = nloc; b.st[1] = nx; }
        const unsigned old = xb_add(&bar[XB_XSUB(b.x)], 1u);
        const unsigned gen = old / nloc;
        if (old + 1u == (gen + 1u) * nloc) {
            __builtin_amdgcn_fence(__ATOMIC_RELEASE, "agent");
            asm volatile("s_waitcnt vmcnt(0)" ::: "memory");
            const unsigned og = xb_add(&bar[XB_TOP], 1u);
            const unsigned tg = og / nx;
            if (og + 1u == (tg + 1u) * nx) xb_add(&bar[XB_TOPGEN], 1u);
            else XB_SPIN(xb_ld(&bar[XB_TOPGEN]) == tg, bar);
            __builtin_amdgcn_fence(__ATOMIC_ACQUIRE, "agent");
            xb_add(&bar[XB_XGEN(b.x)], 1u);
            asm volatile("s_waitcnt vmcnt(0)" ::: "memory");
        } else {
            XB_SPIN(xb_ld(&bar[XB_XGEN(b.x)]) == gen, bar);
            __builtin_amdgcn_fence(__ATOMIC_ACQUIRE, "agent");
            asm volatile("s_waitcnt vmcnt(0)" ::: "memory");
        }
    }
    __syncthreads();
}

struct Frame {
    LAS unsigned char* lds;
    volatile LAS unsigned* MISC;
    gu32* ctl;
    int tid, lane, wave, G, bid;
    const float* const* in;
    float* out;
    unsigned char* ws;
};
enum { I_XP = 0, I_XS, I_SH, I_SRGC, I_SCF, I_SPOOL, I_SSC, I_WIN, I_RGCW, I_RGCB, I_RGWA, I_RGBA, I_RGWX, I_RGBX, I_LAM, I_CFW, I_CFB, I_CFG, I_CFBB, I_POOLW, I_POOLS, I_SCW,
       I_WBR, I_WOUT, I_LN1G, I_LN1B, I_WG, I_WU, I_WD, I_LN2G, I_LN2B };

__device__ __forceinline__ float shfl_idx(float v, int src_lane) { return __builtin_bit_cast(float, __builtin_amdgcn_ds_bpermute(src_lane << 2, __builtin_bit_cast(int, v))); }
__device__ __forceinline__ float wave_sum(float v, int lane) {
#pragma unroll
    for (int o = 1; o < 64; o <<= 1) v += shfl_idx(v, lane ^ o);
    return v;
}

enum { RM_ID = 0, RM_WIN = 1, RM_GU = 2 };
template <int MODE> __device__ __forceinline__ int rowmap(int s, int extra) {
    if (MODE == RM_ID) return s;
    if (MODE == RM_GU) return 256 * (s >> 7) + (s & 127) + extra;
    if (s < 1024) return s;
    if (s < 2048) { const int j = ((s - 1024) >> 7) & 3; return 1024 + 256 * j + (s >= 1536 ? 128 : 0) + (s & 127); }
    if (s < 3072) return s;
    if (s < 4096) { const int j = ((s - 3072) >> 7) & 3; return 3072 + 256 * j + (s >= 3584 ? 128 : 0) + (s & 127); }
    const int g = (s - 4096) >> 10, ch = s & 1023, pn = ch >> 6, chl = ch & 63, wc = chl >> 4, fq = (chl >> 2) & 3, i = chl & 3;
    return 4096 + 256 * pn + 128 * (g >> 1) + 32 * wc + 8 * fq + 4 * (g & 1) + i;
}
template <int MODE>
__device__ __forceinline__ void transpose_item(const float* W, int K, int N, bf16* WT, int dst_ld, int dst_koff, int extra, LAS float* scr, int item, int lane, int nb0, int nnb) {
    const int kb = item / nnb, nb = nb0 + item % nnb, k0 = 64 * kb, n0 = 32 * nb;
#pragma unroll 8
    for (int i = 0; i < 32; ++i) { const int kk = 2 * i + (lane >> 5); scr[kk * 33 + (lane & 31)] = W[(size_t)(k0 + kk) * N + n0 + (lane & 31)]; }
    LDS_WAIT(); asm volatile("" ::: "memory");
    const int c = lane & 7; const float sc = (MODE == RM_WIN && n0 >= 4096) ? -1.44269504089f : 1.0f;
#pragma unroll
    for (int j = 0; j < 4; ++j) { const int n = (lane >> 3) + 8 * j; const LAS float* s = scr + (8 * c) * 33 + n;
        v4u o; o.x = pk2(s[0 * 33] * sc, s[1 * 33] * sc); o.y = pk2(s[2 * 33] * sc, s[3 * 33] * sc); o.z = pk2(s[4 * 33] * sc, s[5 * 33] * sc); o.w = pk2(s[6 * 33] * sc, s[7 * 33] * sc);
        *(GAS v4u*)(WT + (size_t)rowmap<MODE>(n0 + n, extra) * dst_ld + dst_koff + k0 + 8 * c) = o; }
    LDS_WAIT(); asm volatile("" ::: "memory");
}
template <int MODE>
__device__ __forceinline__ void convert_matrix(Frame& F, const float* W, int K, int N, bf16* WT, int dst_ld, int dst_koff, int extra, int gw, int NGW, int first = 0, int nb0 = 0, int nnb = 0) {
    LAS float* scr = (LAS float*)(F.lds + RING_OFF + F.wave * 16384);
    if (nnb == 0) nnb = N / 32;
    const int nitems = (K / 64) * nnb;
    int it0 = gw - first; if (it0 < 0) it0 += ((-it0 + NGW - 1) / NGW) * NGW;
    for (int it = it0; it < nitems; it += NGW) transpose_item<MODE>(W, K, N, WT, dst_ld, dst_koff, extra, scr, it, F.lane, nb0, nnb);
}
__device__ __forceinline__ void compose_pool(Frame& F, int layer, bf16* Bt3, int gw, int NGW, int first = 0) {
    const float* pw = F.in[I_POOLW] + (size_t)layer * 4 * 128 * 128; const float* ps = F.in[I_POOLS] + layer * 512; const float* Wb2 = F.in[I_WBR] + ((size_t)layer * 4 + 2) * 512 * 1024;
    const int lane = F.lane;
    LAS float* Pl = (LAS float*)(F.lds + RING_OFF + F.wave * 16384);
    int id0 = gw - first; if (id0 < 0) id0 += ((-id0 + NGW - 1) / NGW) * NGW;
    for (int id = id0; id < 512; id += NGW) {
        const int g = __builtin_amdgcn_readfirstlane(id >> 7), c0 = __builtin_amdgcn_readfirstlane(8 * ((id >> 3) & 15)), d0 = 128 * (id & 7) + 2 * lane;
#pragma unroll
        for (int k = 0; k < 4; ++k) { const int idx4 = lane + 64 * k, i = idx4 >> 5, e4 = (idx4 & 31) * 4;
            const f32x4 pv = *(const GAS f32x4*)(pw + ((size_t)g * 128 + c0 + i) * 128 + e4), sv = *(const GAS f32x4*)(ps + 128 * g + e4);
            Pl[(e4 + 0) * 8 + i] = pv.x * sv.x; Pl[(e4 + 1) * 8 + i] = pv.y * sv.y; Pl[(e4 + 2) * 8 + i] = pv.z * sv.z; Pl[(e4 + 3) * 8 + i] = pv.w * sv.w; }
        LDS_WAIT(); asm volatile("" ::: "memory");
        f32x2 acc[8];
#pragma unroll
        for (int i = 0; i < 8; ++i) acc[i] = (f32x2){0.f, 0.f};
        const float* wrow = Wb2 + (size_t)(128 * g) * 1024 + d0;
#pragma unroll 1
        for (int e0 = 0; e0 < 128; e0 += 8) {
            f32x2 wv[8];
#pragma unroll
            for (int k = 0; k < 8; ++k) wv[k] = *(const GAS f32x2*)(wrow + (size_t)(e0 + k) * 1024);
#pragma unroll
            for (int k = 0; k < 8; ++k) { const f32x4 p0 = *(const LAS f32x4*)(Pl + (e0 + k) * 8), p1 = *(const LAS f32x4*)(Pl + (e0 + k) * 8 + 4);
#pragma unroll
                for (int i = 0; i < 4; ++i) { acc[i] += wv[k] * p0[i]; acc[4 + i] += wv[k] * p1[i]; } }
        }
        v4u o0, o1;
        o0.x = pk2(acc[0].x, acc[1].x); o0.y = pk2(acc[2].x, acc[3].x); o0.z = pk2(acc[4].x, acc[5].x); o0.w = pk2(acc[6].x, acc[7].x);
        o1.x = pk2(acc[0].y, acc[1].y); o1.y = pk2(acc[2].y, acc[3].y); o1.z = pk2(acc[4].y, acc[5].y); o1.w = pk2(acc[6].y, acc[7].y);
        *(GAS v4u*)(Bt3 + (size_t)d0 * 2048 + 1024 + 128 * g + c0) = o0; *(GAS v4u*)(Bt3 + (size_t)(d0 + 1) * 2048 + 1024 + 128 * g + c0) = o1;
        LDS_WAIT(); asm volatile("" ::: "memory");
    }
}

__device__ __forceinline__ const float* xrow_in(Frame& F, int m) { return m < MP ? F.in[I_XP] + (size_t)m * DM : F.in[I_XS] + (size_t)(m - MP) * DM; }
__device__ __forceinline__ void x_to_bf16(Frame& F, bf16* XB) {
    const int gw = F.bid * NWAVES + F.wave, NGW = F.G * NWAVES;
    for (int m0 = 4 * gw; m0 < M; m0 += 4 * NGW) {
        f32x4 v[4][4];
#pragma unroll
        for (int k = 0; k < 4; ++k) { const GAS f32x4* xr = (const GAS f32x4*)xrow_in(F, m0 + k) + F.lane;
#pragma unroll
            for (int j = 0; j < 4; ++j) v[k][j] = xr[64 * j]; }
#pragma unroll
        for (int k = 0; k < 4; ++k) { GAS v2u* o = (GAS v2u*)(XB + (size_t)(m0 + k) * DM) + F.lane;
#pragma unroll
            for (int j = 0; j < 4; ++j) o[64 * j] = (v2u){pk2(v[k][j].x, v[k][j].y), pk2(v[k][j].z, v[k][j].w)}; } }
}
__device__ __forceinline__ void ln_rows(Frame& F, const float* V, float* O, const float* g, const float* b, bf16* XB, const float* sbase, const float* slab, int nslab, int wg0 = 0) {
    const int gw = ((F.bid - wg0 + F.G) % F.G) * NWAVES + F.wave, NGW = F.G * NWAVES;
    f32x4 gv[4], bv[4];
#pragma unroll
    for (int j = 0; j < 4; ++j) { gv[j] = ((const GAS f32x4*)g)[F.lane + 64 * j]; bv[j] = ((const GAS f32x4*)b)[F.lane + 64 * j]; }
    for (int m = MP + gw; m < M; m += NGW) {
        const GAS f32x4* xr = (const GAS f32x4*)(V + (size_t)m * DM) + F.lane; GAS f32x4* orow = (GAS f32x4*)(O + (size_t)m * DM) + F.lane;
        f32x4 v[4]; float s = 0.f;
#pragma unroll
        for (int j = 0; j < 4; ++j) v[j] = xr[64 * j];
        if (m >= MP) { const GAS f32x4* br = (const GAS f32x4*)(sbase + (size_t)(m - MP) * DM) + F.lane;
#pragma unroll
            for (int j = 0; j < 4; ++j) v[j] = br[64 * j] * ALPHA;
            for (int sl = 0; sl < nslab; sl += 4) {
                f32x4 t[4][4];
#pragma unroll
                for (int k = 0; k < 4; ++k) { const GAS f32x4* sr = (const GAS f32x4*)(slab + ((size_t)(sl + k < nslab ? sl + k : sl) * 512 + (m - MP)) * DM) + F.lane;
#pragma unroll
                    for (int j = 0; j < 4; ++j) t[k][j] = sr[64 * j]; }
#pragma unroll
                for (int k = 0; k < 4; ++k) if (sl + k < nslab) {
#pragma unroll
                    for (int j = 0; j < 4; ++j) v[j] += t[k][j]; } } }
#pragma unroll
        for (int j = 0; j < 4; ++j) s += (v[j].x + v[j].y) + (v[j].z + v[j].w);
        const float mean = wave_sum(s, F.lane) * (1.f / DM); float s2 = 0.f;
#pragma unroll
        for (int j = 0; j < 4; ++j) { v[j] = v[j] - mean; s2 += (v[j].x * v[j].x + v[j].y * v[j].y) + (v[j].z * v[j].z + v[j].w * v[j].w); }
        const float rstd = __builtin_amdgcn_rsqf(wave_sum(s2, F.lane) * (1.f / DM) + LN_EPS);
#pragma unroll
        for (int j = 0; j < 4; ++j) { v[j] = v[j] * rstd * gv[j] + bv[j]; orow[64 * j] = v[j]; }
        if (XB) { GAS v2u* o = (GAS v2u*)(XB + (size_t)m * DM) + F.lane;
#pragma unroll
            for (int j = 0; j < 4; ++j) o[64 * j] = (v2u){pk2(v[j].x, v[j].y), pk2(v[j].z, v[j].w)}; }
    }
}

__device__ __forceinline__ void publish_ready(Frame& F, gu32* ctr) {
    VM_WAIT(); __syncthreads();
    if (F.tid == 0) { __builtin_amdgcn_fence(__ATOMIC_RELEASE, "agent"); asm volatile("s_waitcnt vmcnt(0)" ::: "memory"); __hip_atomic_fetch_add((unsigned*)ctr, 1u, __ATOMIC_RELAXED, __HIP_MEMORY_SCOPE_AGENT); }
}
__device__ __forceinline__ void wait_ready(Frame& F, gu32* ctr, unsigned need) {
    if (F.wave == 0) { unsigned spins = 0;
        while ((unsigned)__builtin_amdgcn_readfirstlane(__hip_atomic_load((unsigned*)ctr, __ATOMIC_RELAXED, __HIP_MEMORY_SCOPE_AGENT)) < need) { __builtin_amdgcn_s_sleep(2); if (++spins > (1u << 20)) break; }
        __builtin_amdgcn_fence(__ATOMIC_ACQUIRE, "agent"); asm volatile("s_waitcnt vmcnt(0)" ::: "memory"); }
    __syncthreads();
}
__device__ __forceinline__ float softplusf_acc(float x) { return fmaxf(x, 0.f) + log1pf(__expf(-fabsf(x))); }
__device__ __forceinline__ float expm1_neg(float x) {
    const float p = x * (1.f + x * (0.5f + x * (1.f / 6.f + x * (1.f / 24.f + x * (1.f / 120.f + x * (1.f / 720.f + x * (1.f / 5040.f)))))));
    return x > -0.25f ? p : __expf(x) - 1.f;
}
constexpr int PATCH_STRIDE = 144;

struct ALane {
    float cwD[4], cbD, ba, bx, ck;
    bf16x8 Ba[4][2], Bx[4][2];
};
constexpr int PATCH_BYTES = 5120, ASLOT_OFF = 8 * PATCH_BYTES;
__device__ __forceinline__ void a_setup(Frame& F, int layer, int n, int q, ALane& L) {
    const int c = F.lane & 15, kg = F.lane >> 4, och = 64 * n + 16 * q + c;
    const float* cw = F.in[I_RGCW] + (size_t)layer * 4 * 512 + 64 * n; const float* cb = F.in[I_RGCB] + layer * 512 + 64 * n;
#pragma unroll
    for (int j = 0; j < 4; ++j) L.cwD[j] = cw[j * 512 + 16 * q + c];
    L.cbD = cb[16 * q + c];
    L.ck = 8.0f * softplusf_acc(-F.in[I_LAM][layer * 512 + och]);
    const float* wa = F.in[I_RGWA] + ((size_t)layer * 8 + n) * 4096 + 16 * q + c; const float* wx = F.in[I_RGWX] + ((size_t)layer * 8 + n) * 4096 + 16 * q + c;
    float wav[16], wxv[16], cbv[16];
#pragma unroll
    for (int e = 0; e < 16; ++e) { const int k = (e < 8 ? 8 * kg + e : 32 + 8 * kg + (e - 8)); wav[e] = wa[k * 64]; wxv[e] = wx[k * 64]; cbv[e] = cb[k]; }
#pragma unroll
    for (int j = 0; j < 4; ++j) { float t[16];
#pragma unroll
        for (int e = 0; e < 16; ++e) t[e] = cw[j * 512 + (e < 8 ? 8 * kg + e : 32 + 8 * kg + (e - 8))];
        L.Ba[j][0] = __builtin_bit_cast(bf16x8, (v4u){pk2(wav[0] * t[0], wav[1] * t[1]), pk2(wav[2] * t[2], wav[3] * t[3]), pk2(wav[4] * t[4], wav[5] * t[5]), pk2(wav[6] * t[6], wav[7] * t[7])});
        L.Ba[j][1] = __builtin_bit_cast(bf16x8, (v4u){pk2(wav[8] * t[8], wav[9] * t[9]), pk2(wav[10] * t[10], wav[11] * t[11]), pk2(wav[12] * t[12], wav[13] * t[13]), pk2(wav[14] * t[14], wav[15] * t[15])});
        L.Bx[j][0] = __builtin_bit_cast(bf16x8, (v4u){pk2(wxv[0] * t[0], wxv[1] * t[1]), pk2(wxv[2] * t[2], wxv[3] * t[3]), pk2(wxv[4] * t[4], wxv[5] * t[5]), pk2(wxv[6] * t[6], wxv[7] * t[7])});
        L.Bx[j][1] = __builtin_bit_cast(bf16x8, (v4u){pk2(wxv[8] * t[8], wxv[9] * t[9]), pk2(wxv[10] * t[10], wxv[11] * t[11]), pk2(wxv[12] * t[12], wxv[13] * t[13]), pk2(wxv[14] * t[14], wxv[15] * t[15])}); }
    float sa = 0.f, sx = 0.f;
#pragma unroll
    for (int e = 0; e < 16; ++e) { sa = fmaf(cbv[e], wav[e], sa); sx = fmaf(cbv[e], wxv[e], sx); }
    sa += shfl_idx(sa, F.lane ^ 16); sa += shfl_idx(sa, F.lane ^ 32); sx += shfl_idx(sx, F.lane ^ 16); sx += shfl_idx(sx, F.lane ^ 32);
    L.ba = F.in[I_RGBA][layer * 512 + och] + sa; L.bx = F.in[I_RGBX][layer * 512 + och] + sx;
}
__device__ __forceinline__ void a_block(const ALane& L, const LAS unsigned char* patch, int rowA0, int baseD, int q, int lane, float (&a)[4], float (&bb)[4]) {
    const int c = lane & 15, kg = lane >> 4;
    f32x4 accR = (f32x4){0.f, 0.f, 0.f, 0.f}, accI = (f32x4){0.f, 0.f, 0.f, 0.f};
#pragma unroll
    for (int j = 0; j < 4; ++j) { const LAS unsigned char* rp = patch + (rowA0 + j) * PATCH_STRIDE + 16 * kg;
        const bf16x8 A0 = *(const LAS bf16x8*)rp, A1 = *(const LAS bf16x8*)(rp + 64);
        accR = __builtin_amdgcn_mfma_f32_16x16x32_bf16(A0, L.Ba[j][0], accR, 0, 0, 0); accR = __builtin_amdgcn_mfma_f32_16x16x32_bf16(A1, L.Ba[j][1], accR, 0, 0, 0);
        accI = __builtin_amdgcn_mfma_f32_16x16x32_bf16(A0, L.Bx[j][0], accI, 0, 0, 0); accI = __builtin_amdgcn_mfma_f32_16x16x32_bf16(A1, L.Bx[j][1], accI, 0, 0, 0); }
    float pv[7];
#pragma unroll
    for (int k = 0; k < 7; ++k) pv[k] = bf1(*(const LAS unsigned short*)(patch + (baseD + k) * PATCH_STRIDE + 2 * (16 * q + c)));
#pragma unroll
    for (int r = 0; r < 4; ++r) {
        const float xd = L.cbD + L.cwD[0] * pv[r] + L.cwD[1] * pv[r + 1] + L.cwD[2] * pv[r + 2] + L.cwD[3] * pv[r + 3];
        const float rr = pg8::sigmoidf_fast(accR[r] + L.ba), ii = pg8::sigmoidf_fast(accI[r] + L.bx);
        const float la = -L.ck * rr;
        const float av = __builtin_amdgcn_exp2f(1.44269504089f * la);
        a[r] = av; bb[r] = __builtin_amdgcn_sqrtf(fmaxf(1.f - av * av, 0.f)) * (ii * xd);
    }
}
struct BlkScan { float Ac[4], Bc[4], EA, EB, WA, WB; };
__device__ __forceinline__ void blk_scan(const float (&a)[4], const float (&bb)[4], int lane, BlkScan& S) {
    const int c = lane & 15, g = lane >> 4;
    S.Ac[0] = a[0]; S.Bc[0] = bb[0];
#pragma unroll
    for (int r = 1; r < 4; ++r) { S.Ac[r] = a[r] * S.Ac[r - 1]; S.Bc[r] = a[r] * S.Bc[r - 1] + bb[r]; }
    float IA = S.Ac[3], IB = S.Bc[3];
    { const float pa = shfl_idx(IA, lane - 16), pb = shfl_idx(IB, lane - 16); if (g >= 1) { IB = IA * pb + IB; IA = IA * pa; } }
    { const float pa = shfl_idx(IA, lane - 32), pb = shfl_idx(IB, lane - 32); if (g >= 2) { IB = IA * pb + IB; IA = IA * pa; } }
    S.EA = shfl_idx(IA, lane - 16); S.EB = shfl_idx(IB, lane - 16); if (g == 0) { S.EA = 1.f; S.EB = 0.f; }
    S.WA = shfl_idx(IA, 48 + c); S.WB = shfl_idx(IB, 48 + c);
}
__device__ __forceinline__ void a_prompt_item(Frame& F, int layer, int item, const bf16* Z, bf16* Y) {
    const int b = item >> 5, n = (item >> 2) & 7, q = item & 3, lane = opqv(F.lane), w = F.wave, c = lane & 15, g = lane >> 4, och = 64 * n + 16 * q + c;
    ALane L; a_setup(F, layer, n, q, L);
    LAS unsigned char* patch = F.lds + RING_OFF + w * PATCH_BYTES;
    LAS f32x2* slots = (LAS f32x2*)(F.lds + RING_OFF + ASLOT_OFF);
    const bf16* Zb = Z + (size_t)b * SEQ * ZC; bf16* Yb = Y + (size_t)b * SEQ * YC;
    float hrun = 0.f;
    v4u pf[5];
    auto load_patch = [&](int tb) {
#pragma unroll
        for (int k = 0; k < 5; ++k) { const int ci = lane + 64 * k, pr = ci >> 3, cc = ci & 7, t = tb - 3 + pr;
            pf[k] = (ci < 280 && t >= 0) ? *(const GAS v4u*)(Zb + (size_t)t * ZC + 64 * n + 8 * cc) : (v4u){0u, 0u, 0u, 0u}; }
    };
    load_patch(32 * w);
    for (int it = 0; it < 8; ++it) {
        const int tb = 256 * it + 32 * w;
#pragma unroll
        for (int k = 0; k < 5; ++k) { const int ci = lane + 64 * k, pr = ci >> 3, cc = ci & 7; if (ci < 280) *(LAS v4u*)(patch + pr * PATCH_STRIDE + 16 * cc) = pf[k]; }
        if (it < 7) load_patch(tb + 256);
        unsigned short gav[8];
#pragma unroll
        for (int r = 0; r < 8; ++r) gav[r] = ((const GAS unsigned short*)Zb)[(unsigned)((tb + 16 * (r >> 2) + 4 * g + (r & 3)) * ZC + 512 + och)];
        asm volatile("" ::: "memory");
        float a0[4], b0[4], a1[4], b1[4];
        a_block(L, patch, lane & 15, 4 * g, q, lane, a0, b0);
        a_block(L, patch, 16 + (lane & 15), 16 + 4 * g, q, lane, a1, b1);
        BlkScan S0, S1; blk_scan(a0, b0, lane, S0); blk_scan(a1, b1, lane, S1);
        if (lane < 16) slots[((it & 1) * 8 + w) * 16 + c] = (f32x2){S0.WA * S1.WA, S1.WA * S0.WB + S1.WB};
        __syncthreads();
        float hin = hrun, hw = 0.f;
#pragma unroll
        for (int ww = 0; ww < 8; ++ww) { const f32x2 s = slots[((it & 1) * 8 + ww) * 16 + c]; if (ww == w) hw = hin; hin = s.x * hin + s.y; }
        hrun = hin;
        const float hg0 = S0.EA * hw + S0.EB, hw1 = S0.WA * hw + S0.WB, hg1 = S1.EA * hw1 + S1.EB;
#pragma unroll
        for (int r = 0; r < 4; ++r) { const float h = S0.Ac[r] * hg0 + S0.Bc[r];
            ((GAS unsigned short*)Yb)[(unsigned)((tb + 4 * g + r) * YC + och)] = f2bf(h * bf1(gav[r])); }
#pragma unroll
        for (int r = 0; r < 4; ++r) { const float h = S1.Ac[r] * hg1 + S1.Bc[r];
            ((GAS unsigned short*)Yb)[(unsigned)((tb + 16 + 4 * g + r) * YC + och)] = f2bf(h * bf1(gav[4 + r]));
            if (r == 3 && it == 7 && w == 7 && g == 3) F.out[O_PH + (size_t)(layer * 8 + b) * 512 + och] = h; }
    }
}
__device__ __forceinline__ void a_sample_task(Frame& F, int layer, int task, const bf16* Z, bf16* Y) {
    const int blk = task >> 5, n = (task >> 2) & 7, q = task & 3, lane = opqv(F.lane), c = lane & 15, g = lane >> 4, och = 64 * n + 16 * q + c, s0 = 4 * blk;
    ALane L; a_setup(F, layer, n, q, L);
    LAS unsigned char* patch = F.lds + RING_OFF + F.wave * PATCH_BYTES;
#pragma unroll
    for (int k = 0; k < 4; ++k) { const int ci = lane + 64 * k; if (ci < 224) { const int pr = ci >> 3, cc = ci & 7, sq = pr / 7, tau = pr - 7 * sq - 3, seq = s0 + sq; v4u v;
            if (tau < 0) { const GAS f32x4* sp = (const GAS f32x4*)(F.in[I_SRGC] + ((size_t)(layer * 128 + seq) * 3 + (tau + 3)) * 512 + 64 * n + 8 * cc); const f32x4 f0 = sp[0], f1 = sp[1];
                v = (v4u){pk2(f0.x, f0.y), pk2(f0.z, f0.w), pk2(f1.x, f1.y), pk2(f1.z, f1.w)}; }
            else v = *(const GAS v4u*)(Z + (size_t)(MP + 4 * seq + tau) * ZC + 64 * n + 8 * cc);
            *(LAS v4u*)(patch + pr * PATCH_STRIDE + 16 * cc) = v; } }
    asm volatile("" ::: "memory");
    float a[4], bb[4];
    a_block(L, patch, 7 * ((lane & 15) >> 2) + (lane & 3), 7 * g, q, lane, a, bb);
    const int seq = s0 + g;
    float h = F.in[I_SH][(size_t)(layer * 128 + seq) * 512 + och];
#pragma unroll
    for (int r = 0; r < 4; ++r) { h = a[r] * h + bb[r]; const size_t row = (size_t)(MP + 4 * seq + r);
        *(GAS unsigned short*)(Y + row * YC + och) = f2bf(h * bf1(*(const GAS unsigned short*)(Z + row * ZC + 512 + och))); }
    F.out[O_SH + (size_t)(layer * 128 + seq) * 512 + och] = h;
}

__device__ __forceinline__ void ln_silu_row(const LAS float* xr, const float* g, const float* b, bf16* dst, int lane) {
    const f32x4 v0 = *(const LAS f32x4*)(xr + 4 * lane), v1 = *(const LAS f32x4*)(xr + 256 + 4 * lane);
    const float s = (v0.x + v0.y) + (v0.z + v0.w) + (v1.x + v1.y) + (v1.z + v1.w);
    const float mean = wave_sum(s, lane) * (1.f / 512.f);
    const f32x4 d0 = v0 - mean, d1 = v1 - mean;
    const float s2 = (d0.x * d0.x + d0.y * d0.y) + (d0.z * d0.z + d0.w * d0.w) + (d1.x * d1.x + d1.y * d1.y) + (d1.z * d1.z + d1.w * d1.w);
    const float rstd = __builtin_amdgcn_rsqf(wave_sum(s2, lane) * (1.f / 512.f) + LN_EPS);
    const f32x4 g0 = *(const GAS f32x4*)(g + 4 * lane), g1 = *(const GAS f32x4*)(g + 256 + 4 * lane), b0 = *(const GAS f32x4*)(b + 4 * lane), b1 = *(const GAS f32x4*)(b + 256 + 4 * lane);
    f32x4 y0 = d0 * rstd * g0 + b0, y1 = d1 * rstd * g1 + b1;
#pragma unroll
    for (int i = 0; i < 4; ++i) { y0[i] = y0[i] * pg8::sigmoidf_fast(y0[i]); y1[i] = y1[i] * pg8::sigmoidf_fast(y1[i]); }
    *(GAS v2u*)(dst + 4 * lane) = (v2u){pk2(y0.x, y0.y), pk2(y0.z, y0.w)}; *(GAS v2u*)(dst + 256 + 4 * lane) = (v2u){pk2(y1.x, y1.y), pk2(y1.z, y1.w)};
}
__device__ __forceinline__ void ln_silu_rows4(const LAS float* xr, int rstride, const float* g, const float* b, bf16* dst, size_t dstride, int lane) {
    f32x4 v0[4], v1[4]; float s[4], s2[4];
#pragma unroll
    for (int k = 0; k < 4; ++k) { v0[k] = *(const LAS f32x4*)(xr + k * rstride + 4 * lane); v1[k] = *(const LAS f32x4*)(xr + k * rstride + 256 + 4 * lane);
        s[k] = (v0[k].x + v0[k].y) + (v0[k].z + v0[k].w) + (v1[k].x + v1[k].y) + (v1[k].z + v1[k].w); }
#pragma unroll
    for (int o = 1; o < 64; o <<= 1) {
#pragma unroll
        for (int k = 0; k < 4; ++k) s[k] += shfl_idx(s[k], lane ^ o); }
#pragma unroll
    for (int k = 0; k < 4; ++k) { const float mean = s[k] * (1.f / 512.f); v0[k] = v0[k] - mean; v1[k] = v1[k] - mean;
        s2[k] = (v0[k].x * v0[k].x + v0[k].y * v0[k].y) + (v0[k].z * v0[k].z + v0[k].w * v0[k].w) + (v1[k].x * v1[k].x + v1[k].y * v1[k].y) + (v1[k].z * v1[k].z + v1[k].w * v1[k].w); }
#pragma unroll
    for (int o = 1; o < 64; o <<= 1) {
#pragma unroll
        for (int k = 0; k < 4; ++k) s2[k] += shfl_idx(s2[k], lane ^ o); }
    const f32x4 g0 = *(const GAS f32x4*)(g + 4 * lane), g1 = *(const GAS f32x4*)(g + 256 + 4 * lane), b0 = *(const GAS f32x4*)(b + 4 * lane), b1 = *(const GAS f32x4*)(b + 256 + 4 * lane);
#pragma unroll
    for (int k = 0; k < 4; ++k) { const float rstd = __builtin_amdgcn_rsqf(s2[k] * (1.f / 512.f) + LN_EPS);
        f32x4 y0 = v0[k] * rstd * g0 + b0, y1 = v1[k] * rstd * g1 + b1;
#pragma unroll
        for (int i = 0; i < 4; ++i) { y0[i] = y0[i] * pg8::sigmoidf_fast(y0[i]); y1[i] = y1[i] * pg8::sigmoidf_fast(y1[i]); }
        bf16* d = dst + (size_t)k * dstride;
        *(GAS v2u*)(d + 4 * lane) = (v2u){pk2(y0.x, y0.y), pk2(y0.z, y0.w)}; *(GAS v2u*)(d + 256 + 4 * lane) = (v2u){pk2(y1.x, y1.y), pk2(y1.z, y1.w)}; }
}
__device__ __forceinline__ void b_prompt_item(Frame& F, int layer, int item, const bf16* Z, bf16* Y) {
    const int tidl = opqv(F.tid), b = item >> 5, t0 = 64 * (item & 31), p = tidl & 255, hh = tidl >> 8, ts = t0 + 32 * hh;
    const GAS unsigned* Zu = (const GAS unsigned*)(Z + (size_t)b * SEQ * ZC) + 512 + p;
    unsigned raw[62];
#pragma unroll
    for (int i = 0; i < 62; ++i) { const int t = ts - 30 + i; raw[i] = t >= 0 ? Zu[(size_t)t * (ZC / 2)] : 0u; }
    const float* cw = F.in[I_CFW] + (size_t)layer * 31 * 512 + 2 * p;
    f32x2 wj[31];
#pragma unroll
    for (int j = 0; j < 31; ++j) wj[j] = *(const GAS f32x2*)(cw + j * 512);
    const f32x2 bias = *(const GAS f32x2*)(F.in[I_CFB] + layer * 512 + 2 * p);
    f32x2 in[62];
#pragma unroll
    for (int i = 0; i < 62; ++i) in[i] = (f32x2){bflo(raw[i]), bfhi(raw[i])};
    LAS float* obuf = (LAS float*)(F.lds + RING_OFF);
#pragma unroll
    for (int i = 0; i < 32; ++i) { f32x2 o = bias;
#pragma unroll
        for (int j = 0; j < 31; ++j) o += wj[j] * in[i + j];
        *(LAS f32x2*)(obuf + (32 * hh + i) * 512 + 2 * p) = o; }
    __syncthreads();
    const float* lg = F.in[I_CFG] + layer * 512; const float* lb = F.in[I_CFBB] + layer * 512;
#pragma unroll 1
    for (int r = 8 * F.wave; r < 8 * F.wave + 8; r += 4) ln_silu_rows4(obuf + r * 512, 512, lg, lb, Y + (size_t)(b * SEQ + t0 + r) * YC + 512, YC, F.lane);
}
__device__ __forceinline__ void cd_prompt_item(Frame& F, int layer, int item, const bf16* Z, bf16* Y) {
    const int tidl = opqv(F.tid), b = item >> 5, t0 = 64 * (item & 31), p = tidl & 255, hh = tidl >> 8;
    const bf16* Zb = Z + (size_t)b * SEQ * ZC;
    LAS unsigned* cbuf = (LAS unsigned*)(F.lds + RING_OFF);
    { v4u tmp[10];
#pragma unroll
      for (int k = 0; k < 10; ++k) { const int ci = tidl + 512 * k, pr = ci >> 6, cc = ci & 63, t = t0 - 15 + pr;
          tmp[k] = (ci < 79 * 64 && t >= 0) ? *(const GAS v4u*)(Zb + (size_t)t * ZC + 1536 + 8 * cc) : (v4u){0u, 0u, 0u, 0u}; }
#pragma unroll
      for (int k = 0; k < 10; ++k) { const int ci = tidl + 512 * k, pr = ci >> 6, cc = ci & 63; if (ci < 79 * 64) *(LAS v4u*)(cbuf + pr * 256 + 4 * cc) = tmp[k]; } }
    const int ts = t0 + 32 * hh;
    unsigned uu[34], dd[32];
#pragma unroll
    for (int i = 0; i < 34; ++i) { const int t = ts - 2 + i; uu[i] = t >= 0 ? ((const GAS unsigned*)(Zb + (size_t)t * ZC))[1280 + p] : 0u; }
#pragma unroll
    for (int i = 0; i < 32; ++i) dd[i] = ((const GAS unsigned*)(Zb + (size_t)(ts + i) * ZC))[1024 + p];
    const f32x2 w0 = ((const GAS f32x2*)(F.in[I_SCW] + (size_t)(layer * 3 + 0) * 512))[p], w1 = ((const GAS f32x2*)(F.in[I_SCW] + (size_t)(layer * 3 + 1) * 512))[p],
                w2 = ((const GAS f32x2*)(F.in[I_SCW] + (size_t)(layer * 3 + 2) * 512))[p];
    __syncthreads();
    const int w = 2 << (p >> 6), rr0 = 15 + 32 * hh;
    f32x2 s = (f32x2){0.f, 0.f};
    for (int j = 0; j < w; ++j) { const unsigned v = cbuf[(rr0 - j) * 256 + p]; s += (f32x2){bflo(v), bfhi(v)}; }
    GAS unsigned* Yu = (GAS unsigned*)(Y + (size_t)(b * SEQ + ts) * YC) + p;
#pragma unroll
    for (int i = 0; i < 32; ++i) { const int t = ts + i, rr = rr0 + i;
        const unsigned cur = cbuf[rr * 256 + p]; const f32x2 cf = (f32x2){bflo(cur), bfhi(cur)};
        if (i > 0) { const unsigned old = cbuf[(rr - w) * 256 + p]; s += cf - (f32x2){bflo(old), bfhi(old)}; }
        const float ic = __builtin_amdgcn_rcpf((float)(t + 1 < w ? t + 1 : w));
        const f32x2 mm = s * ic - cf;
        Yu[(size_t)i * 1024 + 512] = pk2(mm.x, mm.y);
        const f32x2 cv = w0 * (f32x2){bflo(uu[i]), bfhi(uu[i])} + w1 * (f32x2){bflo(uu[i + 1]), bfhi(uu[i + 1])} + w2 * (f32x2){bflo(uu[i + 2]), bfhi(uu[i + 2])};
        const f32x2 yd = (f32x2){bflo(dd[i]), bfhi(dd[i])} * cv;
        Yu[(size_t)i * 1024 + 768] = pk2(yd.x, yd.y); }
}
__device__ __forceinline__ void s_sample_item(Frame& F, int layer, int s, const bf16* Z, bf16* Y) {
    const int ch = opqv(F.tid); const size_t ls = (size_t)layer * 128 + s;
    const bf16* Zr = Z + (size_t)(MP + 4 * s) * ZC; bf16* Yr = Y + (size_t)(MP + 4 * s) * YC;
    LAS float* obuf = (LAS float*)(F.lds + RING_OFF);
    float in[34], wv[31], pb[19], u[6], dbv[4];
#pragma unroll
    for (int j = 0; j < 30; ++j) in[j] = (F.in[I_SCF] + (ls * 30 + j) * 512)[ch];
#pragma unroll
    for (int j = 0; j < 15; ++j) pb[j] = (F.in[I_SPOOL] + (ls * 15 + j) * 512)[ch];
    u[0] = (F.in[I_SSC] + (ls * 2 + 0) * 512)[ch]; u[1] = (F.in[I_SSC] + (ls * 2 + 1) * 512)[ch];
#pragma unroll
    for (int r = 0; r < 4; ++r) { in[30 + r] = bf1((Zr + (size_t)r * ZC + 1024)[ch]); pb[15 + r] = bf1((Zr + (size_t)r * ZC + 1536)[ch]); u[2 + r] = bf1((Zr + (size_t)r * ZC + 2560)[ch]); dbv[r] = bf1((Zr + (size_t)r * ZC + 2048)[ch]); }
#pragma unroll
    for (int j = 0; j < 31; ++j) wv[j] = (F.in[I_CFW] + ((size_t)layer * 31 + j) * 512)[ch];
    const float bias = (F.in[I_CFB] + layer * 512)[ch];
    const float w0 = (F.in[I_SCW] + (size_t)(layer * 3 + 0) * 512)[ch], w1 = (F.in[I_SCW] + (size_t)(layer * 3 + 1) * 512)[ch], w2 = (F.in[I_SCW] + (size_t)(layer * 3 + 2) * 512)[ch];
    asm volatile("" ::: "memory");
#pragma unroll
    for (int j = 0; j < 26; ++j) (F.out + O_SCF + (ls * 30 + j) * 512)[ch] = in[j + 4];
#pragma unroll
    for (int r = 0; r < 4; ++r) { float o = bias;
#pragma unroll
        for (int j = 0; j < 31; ++j) o += wv[j] * in[r + j];
        obuf[r * 512 + ch] = o; }
#pragma unroll
    for (int j = 0; j < 11; ++j) (F.out + O_SPOOL + (ls * 15 + j) * 512)[ch] = pb[j + 4];
    const int gsel = ch >> 7;
#pragma unroll
    for (int r = 0; r < 4; ++r) { const int k = 15 + r;
        const float s2 = pb[k] + pb[k - 1], s4 = s2 + pb[k - 2] + pb[k - 3], s8 = s4 + (pb[k - 4] + pb[k - 5]) + (pb[k - 6] + pb[k - 7]);
        float s16 = s8;
#pragma unroll
        for (int j = 8; j < 16; ++j) s16 += pb[k - j];
        const float mv = (gsel == 0 ? s2 * 0.5f : gsel == 1 ? s4 * 0.25f : gsel == 2 ? s8 * 0.125f : s16 * 0.0625f) - pb[k];
        (Yr + (size_t)r * YC + 1024)[ch] = f2bf(mv); }
#pragma unroll
    for (int r = 0; r < 4; ++r) (Yr + (size_t)r * YC + 1536)[ch] = f2bf(dbv[r] * (w0 * u[r] + w1 * u[r + 1] + w2 * u[r + 2]));
    __syncthreads();
    if (F.wave < 4) ln_silu_row(obuf + F.wave * 512, F.in[I_CFG] + layer * 512, F.in[I_CFBB] + layer * 512, Yr + (size_t)F.wave * YC + 512, F.lane);
}

struct Args { const float* in[31]; float* out; unsigned char* ws; int ph_lo, ph_hi; };
__global__ void __launch_bounds__(NWAVES * 64, 2) hybrid_fwd(Args args) {
    extern __shared__ __attribute__((aligned(16))) unsigned char lds[];
    Frame F;
    F.lds = (LAS unsigned char*)lds;
    F.MISC = (volatile LAS unsigned*)(F.lds + MISC_OFF);
    const int wave0 = __builtin_amdgcn_readfirstlane((int)threadIdx.x >> 6);
    F.lane = lane_now(); F.wave = wave0; F.tid = F.wave * 64 + F.lane;
    F.G = gridDim.x; F.bid = blockIdx.x;
    F.ws = args.ws; F.out = args.out; F.ctl = (gu32*)(args.ws + WS_CTL);
    F.in = args.in;
    for (int u = F.tid; u < (LDS_BYTES - LDSCTL_OFF) / 4; u += NWAVES * 64) ((LAS unsigned*)(F.lds + LDSCTL_OFF))[u] = 0u;
    __syncthreads();
    XcdBarrier bar; bar.bar = (unsigned*)(F.ctl + CW_BAR); bar.x = 0; bar.st = nullptr;
    if (!MK_SPLIT) bar = xcd_barrier_post((unsigned*)(F.ctl + CW_BAR), F.MISC + 8);
    const int lo = args.ph_lo, hi = args.ph_hi;
#define IN(k) (lo <= (k) && (k) < hi)
#define REFRESH() do { F.lane = lane_now(); F.wave = opqs(wave0); F.tid = F.wave * 64 + F.lane; F.bid = opqs((int)blockIdx.x); } while (0)
#define SEAM(k) do { if (IN(k) && IN((k) + 1)) xcd_barrier(bar); } while (0)
    bf16* WA = (bf16*)(F.ws + WS_WA); bf16* XB = (bf16*)(F.ws + WS_XB); bf16* Y = (bf16*)(F.ws + WS_Y); bf16* Zm = (bf16*)(F.ws + WS_ZG); _Float16* Gb = (_Float16*)(F.ws + WS_ZG);
    bf16* Hb = (bf16*)(F.ws + WS_ZG); bf16* MB = (bf16*)F.out;
 bf16* Bt3 = (bf16*)(F.ws + WS_BT3); bf16* Bt4 = (bf16*)(F.ws + WS_BT4); bf16* Bt5 = (bf16*)(F.ws + WS_BT5); bf16* Bt6 = (bf16*)(F.ws + WS_BT6);

    if (IN(0)) { REFRESH(); convert_matrix<RM_WIN>(F, F.in[I_WIN], DM, INC, WA, DM, 0, 0, F.bid * NWAVES + F.wave, F.G * NWAVES); REFRESH(); x_to_bf16(F, XB); }
    SEAM(0);

    const bool fast = F.G == 256;
    for (int l = 0; l < 2; ++l) {
        const int pb = 1 + 9 * l;
        if (IN(pb + 0)) for (int rep = 0; rep < NREP(0); ++rep) { if (rep) xcd_barrier(bar);
            if (fast && l == 1 && rep == 0) { REFRESH();
                ln_rows(F, F.out, F.out, F.in[I_LN2G], F.in[I_LN2B], XB, F.out + (size_t)MP * DM, (const float*)(F.ws + WS_SLAB), 11, 32); publish_ready(F, F.ctl + CW_RDY + 64 * 1); }
            pg8::Gemm g{XB, WA, DM, DM, XB}; pg8::UnitOrder S; S.init(pg8::SK_PLAIN, 4096, DM, F.G, F.bid, 0); pg8::EpiMix E{Zm, F.out, l};
            if (fast && l == 1) { S.ready = (const unsigned*)(F.ctl + CW_RDY + 64 * 1); S.need = (unsigned)F.G; }
            pg8::gemm_phase<pg8::EpiMix, pg8::UnitOrder, true>(F.lds + RING_OFF, g, S, E, wave0);
            if (F.G == 256 && F.bid >= 32 && F.bid < 64 && rep + 1 == NREP(0)) {
                pg8::Gemm g2{XB, WA + (size_t)4096 * DM, DM, DM, XB}; pg8::UnitOrder S2; S2.init(pg8::SK_PLAIN, 4096, DM, 32, F.bid - 32, 0, false, true); pg8::EpiGate E2{Gb};
                if (fast && l == 1) { REFRESH(); wait_ready(F, F.ctl + CW_RDY + 64 * 1, (unsigned)F.G); }
                pg8::gemm_phase<pg8::EpiGate, pg8::UnitOrder, true>(F.lds + RING_OFF, g2, S2, E2, wave0); }
            if (F.G == 256 && F.bid >= 64 && rep + 1 == NREP(0)) {
                REFRESH(); const int gw = (F.bid - 64) * NWAVES + F.wave, NGW = 192 * NWAVES; const float* wbr = F.in[I_WBR] + (size_t)l * 4 * 512 * 1024;
                convert_matrix<RM_ID>(F, wbr, 512, 1024, Bt3, 2048, 0, 0, gw, NGW, 0);
                convert_matrix<RM_ID>(F, wbr + (size_t)512 * 1024, 512, 1024, Bt3, 2048, 512, 0, gw, NGW, 256);
                convert_matrix<RM_ID>(F, wbr + (size_t)3 * 512 * 1024, 512, 1024, Bt3, 2048, 1536, 0, gw, NGW, 512);
                convert_matrix<RM_ID>(F, F.in[I_WOUT] + (size_t)l * DM * DM, DM, DM, Bt4, DM, 0, 0, gw, NGW, 768);
                REFRESH(); compose_pool(F, l, Bt3, gw, NGW, 1280); } }
        SEAM(pb + 0);
        if (IN(pb + 1)) for (int rep = 0; rep < NREP(1); ++rep) { if (rep) xcd_barrier(bar);
            __syncthreads(); REFRESH();
            for (int r2 = 0; r2 < NREP2(0); ++r2) for (int it = F.bid; it < 256; it += F.G) { a_prompt_item(F, l, it, Zm, Y); __syncthreads(); }
            REFRESH();
            for (int r2 = 0; r2 < NREP2(1); ++r2) for (int it = (F.bid + 128) % F.G; it < 128; it += F.G) a_sample_task(F, l, 8 * it + F.wave, Zm, Y);
            __syncthreads(); REFRESH();
            const bool rebal = false, gemm_wg = false;
            for (int r2 = 0; r2 < NREP2(2); ++r2) { if (!gemm_wg) for (int it = F.bid; it < 256; it += F.G) { b_prompt_item(F, l, it, Zm, Y); __syncthreads(); }
                if (rebal && F.bid >= 160 && F.bid < 192) { b_prompt_item(F, l, F.bid - 32, Zm, Y); __syncthreads(); } }
            REFRESH();
            for (int r2 = 0; r2 < NREP2(3); ++r2) { if (!gemm_wg) for (int it = F.bid; it < 256; it += F.G) { cd_prompt_item(F, l, it, Zm, Y); __syncthreads(); }
                if (rebal && F.bid >= 192 && F.bid < 224) { cd_prompt_item(F, l, F.bid - 64, Zm, Y); __syncthreads(); } }
            REFRESH();
            for (int r2 = 0; r2 < NREP2(4); ++r2) for (int it = F.bid; it < 128; it += F.G) { s_sample_item(F, l, it, Zm, Y); __syncthreads(); }
            REFRESH();
            const float* wbr = F.in[I_WBR] + (size_t)l * 4 * 512 * 1024;
            if (F.G != 256) { const int gw = F.bid * NWAVES + F.wave, NGW = F.G * NWAVES;
                convert_matrix<RM_ID>(F, wbr, 512, 1024, Bt3, 2048, 0, 0, gw, NGW); convert_matrix<RM_ID>(F, wbr + (size_t)512 * 1024, 512, 1024, Bt3, 2048, 512, 0, gw, NGW);
                convert_matrix<RM_ID>(F, wbr + (size_t)3 * 512 * 1024, 512, 1024, Bt3, 2048, 1536, 0, gw, NGW); convert_matrix<RM_ID>(F, F.in[I_WOUT] + (size_t)l * DM * DM, DM, DM, Bt4, DM, 0, 0, gw, NGW);
                REFRESH(); compose_pool(F, l, Bt3, gw, NGW); }
        }
        SEAM(pb + 1);
        if (IN(pb + 2)) for (int rep = 0; rep < NREP(2); ++rep) { if (rep) xcd_barrier(bar); pg8::Gemm g{XB, WA + (size_t)4096 * DM, DM, DM, XB}; pg8::UnitOrder S; S.init(pg8::SK_PLAIN, 4096, DM, F.G, F.bid, 0, true, F.G != 256); pg8::EpiGate E{Gb};
            pg8::gemm_phase<pg8::EpiGate, pg8::UnitOrder, true>(F.lds + RING_OFF, g, S, E, wave0); }
        SEAM(pb + 2);
        if (IN(pb + 3)) for (int rep = 0; rep < NREP(3); ++rep) { if (rep) xcd_barrier(bar); pg8::Gemm g{Y, Bt3, 2048, 2048, Y}; pg8::UnitOrder S; S.init(pg8::SK_P3, DM, 2048, F.G, F.bid, 0); pg8::EpiMerge E{Gb, MB, (bf16*)(F.ws + WS_MB4S)};
            pg8::gemm_phase<pg8::EpiMerge, pg8::UnitOrder, true>(F.lds + RING_OFF, g, S, E, wave0);
            if (F.G == 256 && F.bid >= 32 && rep + 1 == NREP(3)) {
                REFRESH(); const int gw = (F.bid - 32) * NWAVES + F.wave, NGW = 224 * NWAVES;
                convert_matrix<RM_GU>(F, F.in[I_WG] + (size_t)l * DM * FF, DM, FF, Bt5, DM, 0, 0, gw, NGW, 0);
                convert_matrix<RM_GU>(F, F.in[I_WU] + (size_t)l * DM * FF, DM, FF, Bt5, DM, 0, 128, gw, NGW, 1408); } }
        SEAM(pb + 3);
        if (IN(pb + 4)) for (int rep = 0; rep < 1; ++rep) { pg8::Gemm g{MB, Bt4, DM, DM, (const bf16*)(F.ws + WS_MB4S)}; pg8::UnitOrder S; S.init(pg8::SK_P4, DM, DM, F.G, F.bid, 0);
            pg8::EpiRes E{l == 0 ? F.in[I_XP] : nullptr, l == 0 ? nullptr : XB, nullptr, XB, F.in[I_LN1G] + l * DM, F.in[I_LN1B] + l * DM, (float*)(F.ws + WS_SLAB),
                          pg8::PanelStats{(unsigned*)(F.ws + WS_XCH + (size_t)(2 * l) * 512 * 1024), (unsigned*)(F.ctl + CW_SEAM + (2 * l) * SEAM_BANK)}, F.lds + XLDS_OFF, wave0};
            pg8::gemm_phase<pg8::EpiRes, pg8::UnitOrder, true>(F.lds + RING_OFF, g, S, E, wave0);
}
        SEAM(pb + 4);
        if (IN(pb + 5) && !fast) for (int rep = 0; rep < NREP(5); ++rep) { if (rep) xcd_barrier(bar);
            REFRESH();
            ln_rows(F, F.out, rep + 1 < NREP(5) ? (float*)(F.ws + WS_Y) : F.out, F.in[I_LN1G] + l * DM, F.in[I_LN1B] + l * DM, rep + 1 < NREP(5) ? nullptr : XB, l == 0 ? F.in[I_XS] : F.out + (size_t)MP * DM, (const float*)(F.ws + WS_SLAB), 16);
            REFRESH();
            if (F.G != 256) { const int gw = F.bid * NWAVES + F.wave, NGW = F.G * NWAVES;
                convert_matrix<RM_GU>(F, F.in[I_WG] + (size_t)l * DM * FF, DM, FF, Bt5, DM, 0, 0, gw, NGW); convert_matrix<RM_GU>(F, F.in[I_WU] + (size_t)l * DM * FF, DM, FF, Bt5, DM, 0, 128, gw, NGW);
                convert_matrix<RM_ID>(F, F.in[I_WD] + (size_t)l * FF * DM, FF, DM, Bt6, FF, 0, 0, gw, NGW); }
        }
        if (!fast) SEAM(pb + 5);
        if (IN(pb + 6)) for (int rep = 0; rep < NREP(6); ++rep) { if (rep) xcd_barrier(bar);
            if (fast && rep == 0) { REFRESH();
                ln_rows(F, F.out, F.out, F.in[I_LN1G] + l * DM, F.in[I_LN1B] + l * DM, XB, l == 0 ? F.in[I_XS] : F.out + (size_t)MP * DM, (const float*)(F.ws + WS_SLAB), 16, 172); publish_ready(F, F.ctl + CW_RDY + 64 * (2 * l)); }
            pg8::Gemm g{XB, Bt5, DM, DM, XB}; pg8::UnitOrder S; S.init(pg8::SK_PLAIN, 2 * FF, DM, F.G, F.bid, 0); pg8::EpiSwi E{Hb};
            if (fast) { S.ready = (const unsigned*)(F.ctl + CW_RDY + 64 * (2 * l)); S.need = (unsigned)F.G; }
            pg8::gemm_phase<pg8::EpiSwi, pg8::UnitOrder, true>(F.lds + RING_OFF, g, S, E, wave0);
            if (F.G == 256 && F.bid >= 172 && rep + 1 == NREP(6)) {
                REFRESH(); const int gw = (F.bid - 172) * NWAVES + F.wave, NGW = 84 * NWAVES;
                convert_matrix<RM_ID>(F, F.in[I_WD] + (size_t)l * FF * DM, FF, DM, Bt6, FF, 0, 0, gw, NGW, 0);
            } }
        SEAM(pb + 6);
        if (IN(pb + 7)) for (int rep = 0; rep < 1; ++rep) { pg8::Gemm g{Hb, Bt6, FF, FF, Hb}; pg8::UnitOrder S; S.init(pg8::SK_P6, DM, FF, F.G, F.bid, 0); pg8::EpiRes E{nullptr, XB, l == 1 ? F.out : nullptr, l == 0 ? XB : nullptr, F.in[I_LN2G] + l * DM, F.in[I_LN2B] + l * DM, (float*)(F.ws + WS_SLAB),
                          pg8::PanelStats{(unsigned*)(F.ws + WS_XCH + (size_t)(2 * l + 1) * 512 * 1024), (unsigned*)(F.ctl + CW_SEAM + (2 * l + 1) * SEAM_BANK)}, F.lds + XLDS_OFF, wave0};
            pg8::gemm_phase<pg8::EpiRes, pg8::UnitOrder, true>(F.lds + RING_OFF, g, S, E, wave0);
            if (F.G == 256 && F.bid >= 88 && l == 0) {
                REFRESH(); convert_matrix<RM_WIN>(F, F.in[I_WIN] + (size_t)DM * INC, DM, INC, WA, DM, 0, 0, (F.bid - 88) * NWAVES + F.wave, 168 * NWAVES); } }
        SEAM(pb + 7);
        if (IN(pb + 8) && !(fast && l == 0)) for (int rep = 0; rep < NREP(8); ++rep) { if (rep) xcd_barrier(bar);
            REFRESH();
            ln_rows(F, F.out, rep + 1 < NREP(8) ? (float*)(F.ws + WS_Y) : F.out, F.in[I_LN2G] + l * DM, F.in[I_LN2B] + l * DM, (l == 0 && rep + 1 == NREP(8)) ? XB : nullptr, F.out + (size_t)MP * DM, (const float*)(F.ws + WS_SLAB), 11);
            REFRESH();
            if (l == 0 && F.G != 256) convert_matrix<RM_WIN>(F, F.in[I_WIN] + (size_t)DM * INC, DM, INC, WA, DM, 0, 0, F.bid * NWAVES + F.wave, F.G * NWAVES);
        }
        if (l == 0 && !fast) SEAM(pb + 8);
    }
#undef IN
#undef SEAM
#undef REFRESH
}

extern "C" void kernel_launch(void* const* d_in, const int* in_sizes, int n_in, void* d_out, int out_size, void* d_ws, size_t ws_size, hipStream_t stream) {
    static int grid = 0;
    if (grid == 0) {
        if (n_in != 31 || out_size != (int)O_END || ws_size < WS_END) { fprintf(stderr, "kernel_launch: unexpected sizes n_in %d out %d ws %zu\n", n_in, out_size, ws_size); grid = -1; return; }
        int dev = 0, cus = 0, per_cu = 0;
        if (hipGetDevice(&dev) != hipSuccess || hipDeviceGetAttribute(&cus, hipDeviceAttributeMultiprocessorCount, dev) != hipSuccess) { grid = -1; return; }
        if (hipFuncSetAttribute((const void*)hybrid_fwd, hipFuncAttributeMaxDynamicSharedMemorySize, LDS_BYTES) != hipSuccess) { fprintf(stderr, "kernel_launch: hipFuncSetAttribute failed\n"); grid = -1; return; }
        if (hipOccupancyMaxActiveBlocksPerMultiprocessor(&per_cu, (const void*)hybrid_fwd, NWAVES * 64, LDS_BYTES) != hipSuccess || per_cu < 1)
            fprintf(stderr, "kernel_launch: occupancy query reports %d workgroups per CU\n", per_cu);
        (void)hipGetLastError();
        grid = cus;
    }
    if (grid < 0) return;
    if (hipMemsetAsync((char*)d_ws + WS_CTL, 0, CTL_ZERO_BYTES, stream) != hipSuccess) { fprintf(stderr, "kernel_launch: memset failed\n"); return; }
    Args a{};
    for (int i = 0; i < 31; ++i) a.in[i] = (const float*)d_in[i];
    a.out = (float*)d_out; a.ws = (unsigned char*)d_ws;
#if MK_SPLIT
    for (int ph = 0; ph < NPHASE; ++ph) { a.ph_lo = ph; a.ph_hi = ph + 1; hipLaunchKernelGGL(hybrid_fwd, dim3(grid), dim3(NWAVES * 64), LDS_BYTES, stream, a); }
#else
    a.ph_lo = 0; a.ph_hi = NPHASE;
    hipLaunchKernelGGL(hybrid_fwd, dim3(grid), dim3(NWAVES * 64), LDS_BYTES, stream, a);
#endif
}
```

```cpp
#include <hip/hip_runtime.h>
#include <cstdio>
#include <cstdint>

#ifndef PROBE_REP
#define PROBE_REP 0
#endif
#define NREP(k) (1 + ((PROBE_REP >> (k)) & 1))
#ifndef PROBE2
#define PROBE2 0
#endif
#define NREP2(j) (1 + ((PROBE2 >> (j)) & 1))
#ifndef MK_SPLIT
#define MK_SPLIT 0
#endif

constexpr int DM = 1024, WMIX = 512, NPB = 8, SEQ = 2048, NSB = 128, DSEQ = 4;
constexpr int MP = NPB * SEQ, MS = NSB * DSEQ, M = MP + MS;
constexpr int FF = 2816, INC = 8192, ZC = 3072, YC = 2048, GC = 4096;
constexpr float LN_EPS = 1e-5f, ALPHA = 1.41421356237f;
constexpr size_t O_Y = 0, O_PH = (size_t)M * DM, O_PRGC = O_PH + 8192, O_PCF = O_PRGC + 24576, O_PPOOL = O_PCF + 245760, O_PSC = O_PPOOL + 122880,
                 O_SH = O_PSC + 16384, O_SRGC = O_SH + 131072, O_SCF = O_SRGC + 393216, O_SPOOL = O_SCF + 3932160, O_SSC = O_SPOOL + 1966080, O_END = O_SSC + 262144;
static_assert(O_END == 24403968, "output map");

__device__ __forceinline__ int opqv(int v) { asm volatile("" : "+v"(v)); return v; }
__device__ __forceinline__ int lane_now() { int l; asm volatile("v_mbcnt_lo_u32_b32 %0, -1, 0\n\tv_mbcnt_hi_u32_b32 %0, -1, %0" : "=v"(l)); return l; }
__device__ __forceinline__ int opqs(int v) { asm volatile("" : "+s"(v)); return v; }
namespace pg8 {
#define PG8_LAS __attribute__((address_space(3)))
typedef unsigned short bf16_t;
typedef short bf16x8 __attribute__((ext_vector_type(8)));
typedef float f32x4 __attribute__((ext_vector_type(4)));
typedef float f32x2 __attribute__((ext_vector_type(2)));
typedef unsigned u32x4 __attribute__((ext_vector_type(4)));
typedef unsigned u32x2 __attribute__((ext_vector_type(2)));
typedef _Float16 f16x4 __attribute__((ext_vector_type(4)));
typedef _Float16 f16x8 __attribute__((ext_vector_type(8)));
constexpr int BM = 256, BK = 64, HALF = 128, HTB = HALF * BK * 2, STAGE_BYTES = 8 * HTB, NXCD = 8, WGM = 8;

__host__ __device__ __forceinline__ int lds_byte(int r, int c) { const int st = (r >> 4) * 2 + (c >> 5), rr = r & 15, cc = c & 31, ob = rr * 64 + cc * 2; return st * 1024 + (ob ^ (((ob >> 9) & 1) << 5)); }
__host__ __device__ __forceinline__ void stage_rc(int b, int& R, int& C) { const int st = b / 1024, sb = b % 1024, swz = sb ^ (((sb >> 9) & 1) << 5); R = (st >> 1) * 16 + swz / 64; C = (st & 1) * 32 + (swz % 64) / 2; }
__host__ __device__ __forceinline__ int perm32(int rho) { const int n = rho >> 4, i = rho & 15; return 8 * (i >> 2) + 4 * n + (i & 3); }

struct Unit { int pm, pn, nt, mode, aux; long offA, offB; };
struct Gemm { const bf16_t* A; const bf16_t* Bt; int lda, ldb; const bf16_t* As; };

enum { SK_PLAIN = 0, SK_P3 = 1, SK_P4 = 2, SK_P6 = 3 };
struct UnitOrder {
    int kind, nN, nwgP, nS, ntP, G, c; long offA_s; const unsigned* ready = nullptr; unsigned need = 0;
    __device__ __forceinline__ void init(int kind_, int N_, int K_, int G_, int c_, long offA_s_, bool prompt = true, bool sample = true) { kind = kind_; nN = N_ / BM; nwgP = prompt ? 64 * nN : 0; ntP = K_ / BK; G = G_; c = c_; offA_s = offA_s_;
        nS = !sample ? 0 : kind_ == SK_PLAIN ? 2 * nN : kind_ == SK_P3 ? 32 : kind_ == SK_P4 ? 128 : 88; }
    __device__ __forceinline__ bool next(int i, Unit& u, const Gemm& g) const {
        const long L = (long)i * G + c; const long ra = (long)BM * g.lda * 2, rb = (long)BM * g.ldb * 2;
        if (L < nwgP) {
            int wgid = (int)L; { const int q = nwgP / NXCD, xcd = wgid % NXCD, off = wgid / NXCD; wgid = xcd * q + off; }
            const int nig = WGM * nN; u.pm = (wgid / nig) * WGM + ((wgid % nig) % WGM); u.pn = (wgid % nig) / WGM;
            u.nt = ntP; u.mode = 0; u.aux = 0; u.offA = u.pm * ra; u.offB = u.pn * rb; return true; }
        const int s = (int)(L - nwgP); if (s >= nS) return false;
        if (kind == SK_PLAIN) { u.pm = 64 + (s & 1); u.pn = s >> 1; u.nt = ntP; u.mode = 0; u.aux = 0; u.offA = u.pm * ra; u.offB = u.pn * rb; }
        else if (kind == SK_P3) { const int n = s & 3, tile = s >> 2; u.pm = 64 + (tile & 1); u.pn = tile >> 1; u.nt = 8; u.mode = 1; u.aux = n; u.offA = u.pm * ra + 1024 * n; u.offB = u.pn * rb + 1024 * n; }
        else if (kind == SK_P4) { const int ch = s & 15, tile = s >> 4, n = ch >> 2, kin = (ch & 3) * 256; u.pm = 64 + (tile & 1); u.pn = tile >> 1; u.nt = 4; u.mode = 1; u.aux = ch;
            u.offA = ((long)(n * 512 + (u.pm - 64) * 256) * 1024 + kin) * 2; u.offB = u.pn * rb + kin * 2; }
        else { const int ch = s % 11, tile = s / 11; u.pm = 64 + (tile & 1); u.pn = tile >> 1; u.nt = 4; u.mode = 1; u.aux = ch; u.offA = u.pm * ra + 512 * ch; u.offB = u.pn * rb + 512 * ch; }
        return true;
    }
    __device__ __forceinline__ void a_ready(const Unit& u, int wid) const {
        if (ready == nullptr || u.pm < 64) return;
        if (wid == 0) { unsigned spins = 0;
            while ((unsigned)__builtin_amdgcn_readfirstlane(__hip_atomic_load(ready, __ATOMIC_RELAXED, __HIP_MEMORY_SCOPE_AGENT)) < need) { __builtin_amdgcn_s_sleep(2); if (++spins > (1u << 20)) break; }
            __builtin_amdgcn_fence(__ATOMIC_ACQUIRE, "agent");
            asm volatile("s_waitcnt vmcnt(0)" ::: "memory"); }
        asm volatile("" ::: "memory"); __builtin_amdgcn_s_barrier(); asm volatile("" ::: "memory");
    }
};

__device__ __forceinline__ unsigned cvt_pk_bf16(float lo, float hi) { unsigned r; asm volatile("v_cvt_pk_bf16_f32 %0, %1, %2" : "=v"(r) : "v"(lo), "v"(hi)); return r; }
__device__ __forceinline__ float sigmoidf_fast(float x) { return __builtin_amdgcn_rcpf(1.0f + __builtin_amdgcn_exp2f(-1.44269504089f * x)); }
__device__ __forceinline__ float gelu_tanh(float x) { const float t = x * x, y = x * fmaf(t, -0.10294324f, -2.3022082f); return x * __builtin_amdgcn_rcpf(1.0f + __builtin_amdgcn_exp2f(y)); }

__device__ __forceinline__ void acc_zero(f32x4 (&acc)[2][2][4][2]) {
#pragma unroll
    for (int a = 0; a < 2; ++a)
#pragma unroll
        for (int b = 0; b < 2; ++b)
#pragma unroll
            for (int m = 0; m < 4; ++m)
#pragma unroll
                for (int n = 0; n < 2; ++n) acc[a][b][m][n] = (f32x4){0.f, 0.f, 0.f, 0.f};
}
__device__ __forceinline__ float* state_ptr(float* out, int R, int keep, int layer, size_t p_off, size_t s_off) {
    if (R < MP) { const int b = R >> 11, j = (R & 2047) - (2048 - keep); return j < 0 ? nullptr : out + p_off + (size_t)((layer * 8 + b) * keep + j) * 512; }
    const int s = (R - MP) >> 2, j = (R & 3) + keep - 4; return j < 0 ? nullptr : out + s_off + (size_t)((layer * 128 + s) * keep + j) * 512;
}

struct EpiMix {
    static constexpr bool PERM = true, MIDK = false;
    __device__ __forceinline__ void init(f32x4 (&acc)[2][2][4][2], const Unit&, int, int) const { acc_zero(acc); }
    bf16_t* Z; float* out; int layer;
    __device__ __forceinline__ void midk(f32x4 (&)[2][2][4][2], const Unit&, int, int, int, int, int) const {}
    __device__ __forceinline__ void operator()(f32x4 (&acc)[2][2][4][2], const Unit& u, int wr, int wc, int fr_, int fq_) const {
        const int lane_ = lane_now(), fr = lane_ & 15, fq = lane_ >> 4; (void)fr_; (void)fq_;
        const int pn = u.pn; int type, zcol, keep = 0, scol = 0; size_t poff = 0, soff = 0;
        if (pn < 2) { type = 0; zcol = 256 * pn; keep = 3; scol = zcol; poff = O_PRGC; soff = O_SRGC; }
        else if (pn < 4) { type = 1; zcol = 512 + 256 * (pn - 2); }
        else if (pn < 8) { type = 2; zcol = 1024 + 128 * (pn - 4); keep = 30; scol = 128 * (pn - 4); poff = O_PCF; soff = O_SCF; }
        else if (pn < 10) { type = 0; zcol = 1536 + 256 * (pn - 8); keep = 15; scol = 256 * (pn - 8); poff = O_PPOOL; soff = O_SPOOL; }
        else if (pn < 12) { type = 0; zcol = 2048 + 256 * (pn - 10); }
        else { type = 3; zcol = 2560 + 128 * (pn - 12); keep = 2; scol = 128 * (pn - 12); poff = O_PSC; soff = O_SSC; }
        const bool tail = keep != 0 && (u.pm >= 64 || (u.pm & 7) == 7);
        const int row0 = u.pm * BM + wr * 64 + fr, cl = wc * 32 + 8 * fq;
        if (type < 2) {
#pragma unroll
            for (int ai = 0; ai < 2; ++ai)
#pragma unroll
                for (int m = 0; m < 4; ++m) { const int R = row0 + ai * HALF + m * 16; bf16_t* rowp = Z + (size_t)R * ZC + zcol + cl;
                    float* sp = tail ? state_ptr(out, R, keep, layer, poff, soff) : nullptr;
#pragma unroll
                    for (int bj = 0; bj < 2; ++bj) { f32x4 v0 = acc[ai][bj][m][0], v1 = acc[ai][bj][m][1];
                        if (type == 1) { v0 = (f32x4){gelu_tanh(v0[0]), gelu_tanh(v0[1]), gelu_tanh(v0[2]), gelu_tanh(v0[3])}; v1 = (f32x4){gelu_tanh(v1[0]), gelu_tanh(v1[1]), gelu_tanh(v1[2]), gelu_tanh(v1[3])}; }
                        u32x4 w; w.x = cvt_pk_bf16(v0[0], v0[1]); w.y = cvt_pk_bf16(v0[2], v0[3]); w.z = cvt_pk_bf16(v1[0], v1[1]); w.w = cvt_pk_bf16(v1[2], v1[3]);
                        *(u32x4*)(rowp + bj * HALF) = w;
                        if (sp) { *(f32x4*)(sp + scol + cl + bj * HALF) = v0; *(f32x4*)(sp + scol + cl + bj * HALF + 4) = v1; } } }
        } else {
#pragma unroll
            for (int ai = 0; ai < 2; ++ai)
#pragma unroll
                for (int m = 0; m < 4; ++m) { const int R = row0 + ai * HALF + m * 16; bf16_t* rowp = Z + (size_t)R * ZC + zcol + cl;
                    float* sp = tail ? state_ptr(out, R, keep, layer, poff, soff) : nullptr;
                    f32x4 v0, v1; const f32x4 a0 = acc[ai][0][m][0], a1 = acc[ai][0][m][1], b0 = acc[ai][1][m][0], b1 = acc[ai][1][m][1];
                    if (type == 2) {
#pragma unroll
                        for (int i = 0; i < 4; ++i) { v0[i] = a0[i] * sigmoidf_fast(b0[i]); v1[i] = a1[i] * sigmoidf_fast(b1[i]); }
                    } else { v0 = a0 * b0; v1 = a1 * b1; }
                    u32x4 w; w.x = cvt_pk_bf16(v0[0], v0[1]); w.y = cvt_pk_bf16(v0[2], v0[3]); w.z = cvt_pk_bf16(v1[0], v1[1]); w.w = cvt_pk_bf16(v1[2], v1[3]);
                    *(u32x4*)rowp = w;
                    if (sp) { *(f32x4*)(sp + scol + cl) = v0; *(f32x4*)(sp + scol + cl + 4) = v1; } }
        }
    }
};

struct EpiGate {
    static constexpr bool PERM = true, MIDK = false;
    __device__ __forceinline__ void init(f32x4 (&acc)[2][2][4][2], const Unit&, int, int) const { acc_zero(acc); }
    _Float16* G;
    __device__ __forceinline__ void midk(f32x4 (&)[2][2][4][2], const Unit&, int, int, int, int, int) const {}
    __device__ __forceinline__ void operator()(f32x4 (&acc)[2][2][4][2], const Unit& u, int wr, int wc, int fr_, int fq_) const {
        const int lane_ = lane_now(), fr = lane_ & 15, fq = lane_ >> 4; (void)fr_; (void)fq_;
        const int row0 = u.pm * BM + wr * 64 + fr, ch0 = 64 * u.pn + 16 * wc + 4 * fq; const bool plain = u.pm >= 64;
#pragma unroll
        for (int ai = 0; ai < 2; ++ai)
#pragma unroll
            for (int m = 0; m < 4; ++m) { const int R = row0 + ai * HALF + m * 16; _Float16* gp = G + (size_t)R * GC + ch0;
                f16x4 r0, r1, r2, g3;
#pragma unroll
                for (int i = 0; i < 4; ++i) {
                    const float d0 = 1.f + __builtin_amdgcn_exp2f(__builtin_amdgcn_fmed3f(acc[ai][0][m][0][i], -15.f, 15.f)), d1 = 1.f + __builtin_amdgcn_exp2f(__builtin_amdgcn_fmed3f(acc[ai][0][m][1][i], -15.f, 15.f));
                    const float d2 = 1.f + __builtin_amdgcn_exp2f(__builtin_amdgcn_fmed3f(acc[ai][1][m][0][i], -15.f, 15.f)), d3 = 1.f + __builtin_amdgcn_exp2f(__builtin_amdgcn_fmed3f(acc[ai][1][m][1][i], -15.f, 15.f));
                    const float i0 = __builtin_amdgcn_rcpf(d0), i1 = __builtin_amdgcn_rcpf(d1), i2 = __builtin_amdgcn_rcpf(d2), i3 = __builtin_amdgcn_rcpf(d3);
                    if (plain) { r0[i] = (_Float16)i0; r1[i] = (_Float16)i1; r2[i] = (_Float16)i2; }
                    else { r0[i] = (_Float16)(d1 * i0); r1[i] = (_Float16)(d2 * i1); r2[i] = (_Float16)(d3 * i2); }
                    g3[i] = (_Float16)i3; }
                *(f16x4*)(gp) = r0; *(f16x4*)(gp + 1024) = r1; *(f16x4*)(gp + 2048) = r2; *(f16x4*)(gp + 3072) = g3; }
    }
};

struct EpiMerge {
    static constexpr bool PERM = true, MIDK = true;
    __device__ __forceinline__ void init(f32x4 (&acc)[2][2][4][2], const Unit&, int, int) const { acc_zero(acc); }
    const _Float16* G; bf16_t* O; bf16_t* Os;
    __device__ __forceinline__ void scale(f32x4 (&acc)[2][2][4][2], const Unit& u, int seg, int wr, int wc) const {
        const int lane_ = lane_now(), fr = lane_ & 15, fq = lane_ >> 4;
        const int row0 = u.pm * BM + wr * 64 + fr, c0 = 1024 * seg + 256 * u.pn + wc * 32 + 8 * fq;
#pragma unroll
        for (int ai = 0; ai < 2; ++ai)
#pragma unroll
            for (int m = 0; m < 4; ++m) { const _Float16* gp = G + (size_t)(row0 + ai * HALF + m * 16) * GC + c0;
#pragma unroll
                for (int bj = 0; bj < 2; ++bj) { const f16x8 f = *(const f16x8*)(gp + bj * HALF);
                    acc[ai][bj][m][0] *= (f32x4){(float)f[0], (float)f[1], (float)f[2], (float)f[3]}; acc[ai][bj][m][1] *= (f32x4){(float)f[4], (float)f[5], (float)f[6], (float)f[7]}; } }
    }
    __device__ __forceinline__ void midk(f32x4 (&acc)[2][2][4][2], const Unit& u, int seg, int wr, int wc, int, int) const { scale(acc, u, seg, wr, wc); }
    __device__ __forceinline__ void operator()(f32x4 (&acc)[2][2][4][2], const Unit& u, int wr, int wc, int, int) const {
        scale(acc, u, u.mode ? u.aux : 3, wr, wc);
        const int lane_ = lane_now(), fr = lane_ & 15, fq = lane_ >> 4;
        const int row0 = (u.mode ? (u.pm - 64) * BM + 512 * u.aux : u.pm * BM) + wr * 64 + fr, c0 = 256 * u.pn + wc * 32 + 8 * fq;
        bf16_t* O = u.mode ? Os : this->O;
#pragma unroll
        for (int ai = 0; ai < 2; ++ai)
#pragma unroll
            for (int m = 0; m < 4; ++m) { bf16_t* rowp = O + (size_t)(row0 + ai * HALF + m * 16) * DM + c0;
#pragma unroll
                for (int bj = 0; bj < 2; ++bj) { const f32x4 v0 = acc[ai][bj][m][0], v1 = acc[ai][bj][m][1];
                    u32x4 w; w.x = cvt_pk_bf16(v0[0], v0[1]); w.y = cvt_pk_bf16(v0[2], v0[3]); w.z = cvt_pk_bf16(v1[0], v1[1]); w.w = cvt_pk_bf16(v1[2], v1[3]); *(u32x4*)(rowp + bj * HALF) = w; } }
    }
};

struct PanelStats {
    unsigned* xbuf;
    unsigned* cnt;
    __device__ __forceinline__ void run(const f32x4 (&v)[2][2][4][2], const Unit& u, int wr, int wc, PG8_LAS unsigned char* lds, int wid) const {
        const int lane = lane_now(), fr = lane & 15, fq = lane >> 4;
        PG8_LAS f32x2* P = (PG8_LAS f32x2*)lds;
        PG8_LAS f32x2* S = (PG8_LAS f32x2*)(lds + 8192);
#pragma unroll
        for (int ai = 0; ai < 2; ++ai)
#pragma unroll
            for (int m = 0; m < 4; ++m) {
                float s = 0.f;
#pragma unroll
                for (int bj = 0; bj < 2; ++bj)
#pragma unroll
                    for (int n = 0; n < 2; ++n) { const f32x4 x = v[ai][bj][m][n]; s += (x[0] + x[1]) + (x[2] + x[3]); }
                s += __builtin_bit_cast(float, __builtin_amdgcn_ds_bpermute((lane ^ 16) << 2, __builtin_bit_cast(int, s))); s += __builtin_bit_cast(float, __builtin_amdgcn_ds_bpermute((lane ^ 32) << 2, __builtin_bit_cast(int, s)));
                const float mw = s * (1.0f / 64.0f); float q = 0.f;
#pragma unroll
                for (int bj = 0; bj < 2; ++bj)
#pragma unroll
                    for (int n = 0; n < 2; ++n) { const f32x4 d = v[ai][bj][m][n] - mw; q += (d[0] * d[0] + d[1] * d[1]) + (d[2] * d[2] + d[3] * d[3]); }
                q += __builtin_bit_cast(float, __builtin_amdgcn_ds_bpermute((lane ^ 16) << 2, __builtin_bit_cast(int, q))); q += __builtin_bit_cast(float, __builtin_amdgcn_ds_bpermute((lane ^ 32) << 2, __builtin_bit_cast(int, q)));
                if (fq == 0) P[(ai * HALF + wr * 64 + m * 16 + fr) * 4 + wc] = (f32x2){mw, q};
            }
        asm volatile("s_waitcnt lgkmcnt(0)" ::: "memory"); __builtin_amdgcn_s_barrier(); asm volatile("" ::: "memory");
        const int row = wid * 32 + (lane & 31);
        if (lane < 32) {
            const f32x2 a = P[row * 4 + 0], b = P[row * 4 + 1], c = P[row * 4 + 2], d = P[row * 4 + 3];
            const float mt = (a.x + b.x + c.x + d.x) * 0.25f;
            const float da = a.x - mt, db = b.x - mt, dc = c.x - mt, dd = d.x - mt;
            const float m2 = (a.y + b.y) + (c.y + d.y) + 64.0f * ((da * da + db * db) + (dc * dc + dd * dd));
            unsigned long long* slot = (unsigned long long*)xbuf + ((size_t)(u.pm * BM + row) * 4 + u.pn);
            __hip_atomic_store(slot, ((unsigned long long)__float_as_uint(m2) << 32) | __float_as_uint(mt), __ATOMIC_RELAXED, __HIP_MEMORY_SCOPE_AGENT);
        }
        asm volatile("s_waitcnt vmcnt(0)" ::: "memory");
        if (lane == 0) __hip_atomic_fetch_add(cnt + 64 * u.pm, 1u, __ATOMIC_RELAXED, __HIP_MEMORY_SCOPE_AGENT);
        if (wid == 0) {
            unsigned spins = 0;
            while ((unsigned)__builtin_amdgcn_readfirstlane(__hip_atomic_load(cnt + 64 * u.pm, __ATOMIC_RELAXED, __HIP_MEMORY_SCOPE_AGENT)) < 32u) { __builtin_amdgcn_s_sleep(2); if (++spins > (1u << 20)) break; }
            __builtin_amdgcn_fence(__ATOMIC_ACQUIRE, "agent");
        }
        asm volatile("s_waitcnt vmcnt(0) lgkmcnt(0)" ::: "memory"); __builtin_amdgcn_s_barrier(); asm volatile("" ::: "memory");
        if (lane < 32) {
            const unsigned long long* slot = (const unsigned long long*)xbuf + (size_t)(u.pm * BM + row) * 4; float mt[4], m2[4]; float ms = 0.f;
#pragma unroll
            for (int t = 0; t < 4; ++t) { const unsigned long long w = __hip_atomic_load(slot + t, __ATOMIC_RELAXED, __HIP_MEMORY_SCOPE_AGENT); mt[t] = __uint_as_float((unsigned)w); m2[t] = __uint_as_float((unsigned)(w >> 32)); ms += mt[t]; }
            const float mean = ms * 0.25f; float q = 0.f;
#pragma unroll
            for (int t = 0; t < 4; ++t) { const float dm = mt[t] - mean; q += m2[t] + 256.0f * dm * dm; }
            S[row] = (f32x2){mean, __builtin_amdgcn_rsqf(q * (1.0f / 1024.0f) + LN_EPS)};
        }
        asm volatile("s_waitcnt lgkmcnt(0)" ::: "memory"); __builtin_amdgcn_s_barrier(); asm volatile("" ::: "memory");
    }
};
struct EpiRes {
    static constexpr bool PERM = false, MIDK = false;
    __device__ __forceinline__ void init(f32x4 (&acc)[2][2][4][2], const Unit& u, int wr, int wc) const {
        if (u.mode) { acc_zero(acc); return; }
        const int lane_ = lane_now(), fr = lane_ & 15, fq = lane_ >> 4;
        const size_t e0 = (size_t)(u.pm * BM + wr * 64 + fr) * DM + 256 * u.pn + wc * 32 + 4 * fq;
        if (base16) {
#pragma unroll
            for (int ai = 0; ai < 2; ++ai)
#pragma unroll
                for (int m = 0; m < 4; ++m)
#pragma unroll
                    for (int bj = 0; bj < 2; ++bj)
#pragma unroll
                        for (int n = 0; n < 2; ++n) { const u32x2 w = *(const u32x2*)(base16 + e0 + (size_t)(ai * HALF + m * 16) * DM + bj * HALF + n * 16);
                            acc[ai][bj][m][n] = (f32x4){__uint_as_float(w.x << 16), __uint_as_float(w.x & 0xffff0000u), __uint_as_float(w.y << 16), __uint_as_float(w.y & 0xffff0000u)} * ALPHA; }
            return; }
#pragma unroll
        for (int ai = 0; ai < 2; ++ai)
#pragma unroll
            for (int m = 0; m < 4; ++m)
#pragma unroll
                for (int bj = 0; bj < 2; ++bj)
#pragma unroll
                    for (int n = 0; n < 2; ++n) acc[ai][bj][m][n] = *(const f32x4*)(baseP + e0 + (size_t)(ai * HALF + m * 16) * DM + bj * HALF + n * 16) * ALPHA;
    }
    const float* baseP; const bf16_t* base16; float* out; bf16_t* xb; const float* lng; const float* lnb; float* slab; PanelStats st; PG8_LAS unsigned char* xlds; int wid;
    __device__ __forceinline__ void midk(f32x4 (&)[2][2][4][2], const Unit&, int, int, int, int, int) const {}
    __device__ __forceinline__ void operator()(f32x4 (&acc)[2][2][4][2], const Unit& u, int wr, int wc, int fr_, int fq_) const {
        const int lane_ = lane_now(), fr = lane_ & 15, fq = lane_ >> 4; (void)fr_; (void)fq_;
        const int row0 = u.pm * BM + wr * 64 + fr, c0 = 256 * u.pn + wc * 32 + 4 * fq;
        if (u.mode) {
#pragma unroll
            for (int ai = 0; ai < 2; ++ai)
#pragma unroll
                for (int m = 0; m < 4; ++m) { float* op = slab + ((size_t)u.aux * 512 + (row0 - MP) + ai * HALF + m * 16) * DM + c0;
#pragma unroll
                    for (int bj = 0; bj < 2; ++bj)
#pragma unroll
                        for (int n = 0; n < 2; ++n) *(f32x4*)(op + bj * HALF + n * 16) = acc[ai][bj][m][n]; }
            return; }
        st.run(acc, u, wr, wc, xlds, wid);
        const PG8_LAS f32x2* S = (const PG8_LAS f32x2*)(xlds + 8192);
#pragma unroll
        for (int bj = 0; bj < 2; ++bj)
#pragma unroll
            for (int n = 0; n < 2; ++n) { const int cc = c0 + bj * HALF + n * 16; const f32x4 gv = *(const f32x4*)(lng + cc), bv = *(const f32x4*)(lnb + cc);
#pragma unroll
                for (int ai = 0; ai < 2; ++ai)
#pragma unroll
                    for (int m = 0; m < 4; ++m) { const int r = ai * HALF + wr * 64 + m * 16 + fr; const f32x2 sr = S[r]; const size_t off = (size_t)(u.pm * BM + r) * DM + cc;
                        const f32x4 o = (acc[ai][bj][m][n] - sr.x) * sr.y * gv + bv; if (out) *(f32x4*)(out + off) = o;
                        if (xb) { u32x2 w; w.x = cvt_pk_bf16(o[0], o[1]); w.y = cvt_pk_bf16(o[2], o[3]); *(u32x2*)(xb + off) = w; }
                        if (m & 1) asm volatile("" ::: "memory"); } }
    }
};

struct EpiSwi {
    static constexpr bool PERM = true, MIDK = false;
    __device__ __forceinline__ void init(f32x4 (&acc)[2][2][4][2], const Unit&, int, int) const { acc_zero(acc); }
    bf16_t* H;
    __device__ __forceinline__ void midk(f32x4 (&)[2][2][4][2], const Unit&, int, int, int, int, int) const {}
    __device__ __forceinline__ void operator()(f32x4 (&acc)[2][2][4][2], const Unit& u, int wr, int wc, int fr_, int fq_) const {
        const int lane_ = lane_now(), fr = lane_ & 15, fq = lane_ >> 4; (void)fr_; (void)fq_;
        const int row0 = u.pm * BM + wr * 64 + fr, c0 = 128 * u.pn + wc * 32 + 8 * fq;
#pragma unroll
        for (int ai = 0; ai < 2; ++ai)
#pragma unroll
            for (int m = 0; m < 4; ++m) { bf16_t* rowp = H + (size_t)(row0 + ai * HALF + m * 16) * FF + c0;
                const f32x4 g0 = acc[ai][0][m][0], g1 = acc[ai][0][m][1], u0 = acc[ai][1][m][0], u1 = acc[ai][1][m][1]; f32x4 v0, v1;
#pragma unroll
                for (int i = 0; i < 4; ++i) { v0[i] = g0[i] * sigmoidf_fast(g0[i]) * u0[i]; v1[i] = g1[i] * sigmoidf_fast(g1[i]) * u1[i]; }
                u32x4 w; w.x = cvt_pk_bf16(v0[0], v0[1]); w.y = cvt_pk_bf16(v0[2], v0[3]); w.z = cvt_pk_bf16(v1[0], v1[1]); w.w = cvt_pk_bf16(v1[2], v1[3]);
                *(u32x4*)rowp = w; }
    }
};

template <class Epi, class Sched, bool ALIGN_EPI>
__device__ __forceinline__ void gemm_phase(PG8_LAS unsigned char* lds, const Gemm g, const Sched& S, const Epi& E, int wave_id) {
    const int wid = opqs(wave_id), lane = lane_now(), tid = wid * 64 + lane, wr = wid >> 2, wc = wid & 3, fr = lane & 15, fq = lane >> 4;
    unsigned voffA[2], voffB[2];
#pragma unroll
    for (int i = 0; i < 2; ++i) { int R, C; stage_rc(tid * 16 + i * 8192, R, C); const int Rb = Epi::PERM ? ((R & ~31) + perm32(R & 31)) : R;
        voffA[i] = (unsigned)(R * g.lda + C) * 2u; voffB[i] = (unsigned)(Rb * g.ldb + C) * 2u; }
    const size_t kstep = (size_t)(BK * 2);
    const size_t hstepA = (size_t)HALF * g.lda * 2, hstepB = (size_t)HALF * g.ldb * 2;
    const unsigned ldsw = (unsigned)wid * 1024u;
    const int aoff = lds_byte(wr * 64 + fr, fq * 8), boff = lds_byte(wc * 32 + fr, fq * 8);
#define PG8_SA(b, h) (((b) * 2 + (h)) * HTB)
#define PG8_SB(b, h) ((4 + (b) * 2 + (h)) * HTB)
#define PG8_STAGE(bufoff, gbase, voff) do { _Pragma("unroll") for (int _i = 0; _i < 2; ++_i) \
        __builtin_amdgcn_global_load_lds((const unsigned*)((const char*)(gbase) + (voff)[_i]), (PG8_LAS unsigned*)(lds + (bufoff) + ldsw + _i * 8192), 16, 0, 0); } while (0)
#define PG8_LDA(dst, b, h) do { _Pragma("unroll") for (int m = 0; m < 4; ++m) _Pragma("unroll") for (int k = 0; k < 2; ++k) dst[m][k] = *(const PG8_LAS bf16x8*)(lds + PG8_SA(b, h) + aoff + m * 2048 + k * 1024); } while (0)
#define PG8_LDB(dst, b, h) do { _Pragma("unroll") for (int n = 0; n < 2; ++n) _Pragma("unroll") for (int k = 0; k < 2; ++k) dst[n][k] = *(const PG8_LAS bf16x8*)(lds + PG8_SB(b, h) + boff + n * 2048 + k * 1024); } while (0)
#define PG8_MMA(ai, bj, At, Bt) do { __builtin_amdgcn_s_setprio(1); _Pragma("unroll") for (int m = 0; m < 4; ++m) _Pragma("unroll") for (int n = 0; n < 2; ++n) _Pragma("unroll") for (int k = 0; k < 2; ++k) \
        acc[ai][bj][m][n] = __builtin_amdgcn_mfma_f32_16x16x32_bf16(Bt[n][k], At[m][k], acc[ai][bj][m][n], 0, 0, 0); __builtin_amdgcn_s_setprio(0); } while (0)
#define PG8_WAIT_V(n) asm volatile("s_waitcnt vmcnt(" #n ")" ::: "memory")
#define PG8_WAIT_L(n) asm volatile("s_waitcnt lgkmcnt(" #n ")" ::: "memory")
#define PG8_BAR __builtin_amdgcn_s_barrier()
#define PG8_SCHED __builtin_amdgcn_sched_barrier(0)
    Unit cur, nxt; int ui = 0;
    if (!S.next(0, cur, g)) return;
    f32x4 acc[2][2][4][2];
    E.init(acc, cur, wr, wc);
    bf16x8 At[4][2], B0[2][2], B1[2][2];
    const char* cA = (const char*)(cur.mode ? g.As : g.A) + cur.offA; const char* cB = (const char*)g.Bt + cur.offB;
    PG8_STAGE(PG8_SB(0, 0), cB, voffB); PG8_STAGE(PG8_SB(0, 1), cB + hstepB, voffB); PG8_STAGE(PG8_SA(0, 0), cA, voffA); PG8_STAGE(PG8_SA(0, 1), cA + hstepA, voffA);
    if (wr == 1) PG8_BAR;
    PG8_WAIT_V(2); PG8_BAR;
    PG8_STAGE(PG8_SB(1, 0), cB + kstep, voffB); PG8_STAGE(PG8_SA(1, 0), cA + kstep, voffA); PG8_STAGE(PG8_SB(1, 1), cB + hstepB + kstep, voffB);
    PG8_WAIT_V(6); PG8_BAR;
    for (;;) {
        const bool has_next = S.next(ui + 1, nxt, g);
        const char* nA = has_next ? (const char*)(nxt.mode ? g.As : g.A) + nxt.offA : cA; const char* nB = has_next ? (const char*)g.Bt + nxt.offB : cB;
        const int nt = cur.nt, TSEG = Epi::MIDK ? 8 : nt;
        for (int t0 = 0; t0 < nt; t0 += TSEG) {
        if constexpr (Epi::MIDK) { if (t0 != 0) { PG8_SCHED; E.midk(acc, cur, t0 / TSEG - 1, wr, wc, 0, 0); PG8_SCHED; } }
#pragma unroll 1
        for (int t = t0; t < t0 + TSEG; t += 2) {
            const bool last = (t == nt - 2);
            if (last && has_next) S.a_ready(nxt, wid);
            const char* a1 = cA + (size_t)(t + 1) * kstep;
            const char* a2 = last ? nA : cA + (size_t)(t + 2) * kstep; const char* b2 = last ? nB : cB + (size_t)(t + 2) * kstep;
            const char* a3 = a2 + kstep; const char* b3 = b2 + kstep;
            PG8_LDB(B0, 0, 0); PG8_LDB(B1, 0, 1); PG8_SCHED; PG8_LDA(At, 0, 0); PG8_STAGE(PG8_SA(1, 1), a1 + hstepA, voffA);
            PG8_WAIT_V(8); PG8_WAIT_L(0); PG8_BAR; PG8_MMA(0, 0, At, B0); PG8_MMA(0, 1, At, B1); PG8_BAR; PG8_SCHED;
            PG8_LDA(At, 0, 1); PG8_STAGE(PG8_SB(0, 0), b2, voffB); PG8_STAGE(PG8_SB(0, 1), b2 + hstepB, voffB); PG8_STAGE(PG8_SA(0, 0), a2, voffA);
            PG8_WAIT_V(8); PG8_WAIT_L(0); PG8_BAR; PG8_MMA(1, 0, At, B0); PG8_MMA(1, 1, At, B1); PG8_BAR; PG8_SCHED;
            PG8_LDB(B0, 1, 0); PG8_LDB(B1, 1, 1); PG8_SCHED; PG8_LDA(At, 1, 0); PG8_STAGE(PG8_SA(0, 1), a2 + hstepA, voffA);
            PG8_WAIT_V(8); PG8_WAIT_L(0); PG8_BAR; PG8_MMA(0, 0, At, B0); PG8_MMA(0, 1, At, B1); PG8_BAR; PG8_SCHED;
            PG8_LDA(At, 1, 1); PG8_STAGE(PG8_SB(1, 0), b3, voffB); PG8_STAGE(PG8_SB(1, 1), b3 + hstepB, voffB); PG8_STAGE(PG8_SA(1, 0), a3, voffA);
            PG8_WAIT_V(8); PG8_WAIT_L(0); PG8_BAR; PG8_MMA(1, 0, At, B0); PG8_MMA(1, 1, At, B1); PG8_BAR; PG8_SCHED;
        }
        }
        if constexpr (ALIGN_EPI) { if (wr == 0) PG8_BAR; }
        E(acc, cur, wr, wc, 0, 0);
        if (!has_next) break;
        cur = nxt; cA = nA; cB = nB; ++ui;
        E.init(acc, cur, wr, wc);
        if constexpr (ALIGN_EPI) { if (wr == 1) PG8_BAR; }
    }
    PG8_WAIT_V(0);
    if constexpr (!ALIGN_EPI) { if (wr == 0) PG8_BAR; }
    PG8_BAR;
#undef PG8_SA
#undef PG8_SB
#undef PG8_STAGE
#undef PG8_LDA
#undef PG8_LDB
#undef PG8_MMA
#undef PG8_WAIT_V
#undef PG8_WAIT_L
#undef PG8_BAR
#undef PG8_SCHED
}
}

constexpr int NWAVES = 8;
constexpr int NPHASE = 19;
constexpr size_t MiB = 1u << 20;
constexpr size_t WS_CTL = 0, CTL_ZERO_BYTES = 1 * MiB;
constexpr size_t WS_WA = 1 * MiB;
constexpr size_t WS_XB = 18 * MiB;
constexpr size_t WS_Y = 51 * MiB;
constexpr size_t WS_ZG = 117 * MiB;
constexpr size_t WS_BT3 = 249 * MiB, WS_BT4 = 253 * MiB, WS_BT5 = WS_WA, WS_BT6 = WS_ZG + 108 * MiB;
constexpr size_t WS_MB4S = WS_WA + 13 * MiB;
constexpr size_t WS_SLAB = WS_Y;
constexpr size_t WS_END = 255 * MiB;
static_assert(WS_XB + (size_t)M * DM * 2 <= WS_Y && WS_Y + (size_t)M * YC * 2 <= WS_ZG && WS_ZG + (size_t)M * GC * 2 <= WS_BT3 && WS_SLAB + (size_t)16 * 512 * DM * 4 <= WS_Y + 40 * MiB && WS_Y + 40 * MiB + 4 * 512 * 1024 <= WS_ZG, "ws map");
static_assert((size_t)M * FF * 2 <= 108 * MiB && WS_BT5 + (size_t)2 * FF * DM * 2 <= WS_MB4S && WS_MB4S + 4 * MiB <= WS_XB && WS_BT6 + (size_t)DM * FF * 2 <= WS_BT3, "ws map 2");
constexpr int CW_RDY = 12288;
constexpr int CW_TMO = 0, CW_CODE = 1, CW_BAR = 4096, CW_SEAM = 16384, SEAM_BANK = 8192;
constexpr size_t WS_XCH = WS_Y + 40 * MiB;
constexpr int XLDS_OFF = 131072 + 1024;
constexpr int RING_OFF = 0, RING_BYTES = 131072;
constexpr int LDSCTL_OFF = RING_BYTES, MISC_OFF = LDSCTL_OFF + 320;
constexpr int LDS_BYTES = 147456;

#define GAS __attribute__((address_space(1)))
#define LAS __attribute__((address_space(3)))
typedef unsigned short bf16;
typedef unsigned v4u __attribute__((ext_vector_type(4)));
typedef unsigned v2u __attribute__((ext_vector_type(2)));
typedef float f32x4 __attribute__((ext_vector_type(4)));
typedef float f32x2 __attribute__((ext_vector_type(2)));
typedef short bf16x8 __attribute__((ext_vector_type(8)));
typedef GAS unsigned gu32;
#define RLX_AGENT __ATOMIC_RELAXED, __HIP_MEMORY_SCOPE_AGENT
#define LDS_WAIT() asm volatile("s_waitcnt lgkmcnt(0)" ::: "memory")
#define VM_WAIT() asm volatile("s_waitcnt vmcnt(0)" ::: "memory")
__device__ __forceinline__ unsigned pk2(float lo, float hi) { return pg8::cvt_pk_bf16(lo, hi); }
__device__ __forceinline__ float bflo(unsigned v) { return __uint_as_float(v << 16); }
__device__ __forceinline__ float bfhi(unsigned v) { return __uint_as_float(v & 0xffff0000u); }
__device__ __forceinline__ float bf1(unsigned short h) { return __uint_as_float((unsigned)h << 16); }
__device__ __forceinline__ unsigned short f2bf(float f) { return (unsigned short)(pg8::cvt_pk_bf16(f, 0.f) & 0xffffu); }

#define XB_TMO      128
#define XB_XCNT(j)  (256  + 64 * (j))
#define XB_XSUB(j)  (1280 + 64 * (j))
#define XB_XGEN(j)  (2304 + 64 * (j))
#define XB_TOP      3328
#define XB_TOPGEN   3392
#define XCD_BAR_WORDS 3456
#define XB_SPIN_CAP (1u << 18)
__device__ __forceinline__ unsigned xb_ld(unsigned* p)              { return __hip_atomic_load(p, __ATOMIC_RELAXED, __HIP_MEMORY_SCOPE_AGENT); }
__device__ __forceinline__ unsigned xb_add(unsigned* p, unsigned v) { return __hip_atomic_fetch_add(p, v, __ATOMIC_RELAXED, __HIP_MEMORY_SCOPE_AGENT); }
__device__ __forceinline__ unsigned xb_xcc_id() { return (unsigned)__builtin_amdgcn_s_getreg((3 << 11) | 20) & 0xFu; }
#define XB_SPIN(cond, bar) do { unsigned _sp = 0; while (cond) { __builtin_amdgcn_s_sleep(1); \
    if ((++_sp & 255u) == 0u) { if (xb_ld(&(bar)[XB_TMO])) break; if (_sp > XB_SPIN_CAP) { atomicAdd(&(bar)[XB_TMO], 1u); break; } } } } while (0)
struct XcdBarrier { unsigned* bar; unsigned x; volatile LAS unsigned* st; };
__device__ __forceinline__ XcdBarrier xcd_barrier_post(unsigned* bar, volatile LAS unsigned* st) {
    XcdBarrier b; b.bar = bar; b.x = xb_xcc_id(); b.st = st;
    if (threadIdx.x == 0) (void)xb_add(&bar[XB_XCNT(b.x)], 1u);
    return b;
}
__device__ __forceinline__ void xcd_barrier_complete(unsigned* bar, unsigned x, unsigned& nloc, unsigned& nx) {
    const unsigned G = gridDim.x * gridDim.y * gridDim.z;
    unsigned sum, cnt, mine, sp = 0u;
    for (;;) {
        sum = 0u; cnt = 0u; mine = 0u;
#pragma unroll
        for (unsigned j = 0; j < 16; ++j) { const unsigned c = xb_ld(&bar[XB_XCNT(j)]); sum += c; cnt += (c > 0u) ? 1u : 0u; mine = (j == x) ? c : mine; }
        if (sum == G) break;
        __builtin_amdgcn_s_sleep(1);
        if ((++sp & 255u) == 0u) { if (xb_ld(&bar[XB_TMO])) break; if (sp > XB_SPIN_CAP) { atomicAdd(&bar[XB_TMO], 1u); break; } }
    }
    nloc = mine > 0u ? mine : 1u; nx = cnt > 0u ? cnt : 1u;
}
__device__ __forceinline__ void xcd_barrier(const XcdBarrier& b) {
    asm volatile("s_waitcnt vmcnt(0)" ::: "memory");
    __syncthreads();
    if (threadIdx.x == 0) {
        unsigned* bar = b.bar;
        __builtin_amdgcn_s_waitcnt(0);
        unsigned nloc = b.st[0], nx = b.st[1];
        if (nloc == 0u) { xcd_barrier_complete(bar, b.x, nloc, nx); b.st[0] = nloc; b.st[1] = nx; }
        const unsigned old = xb_add(&bar[XB_XSUB(b.x)], 1u);
        const unsigned gen = old / nloc;
        if (old + 1u == (gen + 1u) * nloc) {
            __builtin_amdgcn_fence(__ATOMIC_RELEASE, "agent");
            asm volatile("s_waitcnt vmcnt(0)" ::: "memory");
            const unsigned og = xb_add(&bar[XB_TOP], 1u);
            const unsigned tg = og / nx;
            if (og + 1u == (tg + 1u) * nx) xb_add(&bar[XB_TOPGEN], 1u);
            else XB_SPIN(xb_ld(&bar[XB_TOPGEN]) == tg, bar);
            __builtin_amdgcn_fence(__ATOMIC_ACQUIRE, "agent");
            xb_add(&bar[XB_XGEN(b.x)], 1u);
            asm volatile("s_waitcnt vmcnt(0)" ::: "memory");
        } else {
            XB_SPIN(xb_ld(&bar[XB_XGEN(b.x)]) == gen, bar);
            __builtin_amdgcn_fence(__ATOMIC_ACQUIRE, "agent");
            asm volatile("s_waitcnt vmcnt(0)" ::: "memory");
        }
    }
    __syncthreads();
}

struct Frame {
    LAS unsigned char* lds;
    volatile LAS unsigned* MISC;
    gu32* ctl;
    int tid, lane, wave, G, bid;
    const float* const* in;
    float* out;
    unsigned char* ws;
};
enum { I_XP = 0, I_XS, I_SH, I_SRGC, I_SCF, I_SPOOL, I_SSC, I_WIN, I_RGCW, I_RGCB, I_RGWA, I_RGBA, I_RGWX, I_RGBX, I_LAM, I_CFW, I_CFB, I_CFG, I_CFBB, I_POOLW, I_POOLS, I_SCW,
       I_WBR, I_WOUT, I_LN1G, I_LN1B, I_WG, I_WU, I_WD, I_LN2G, I_LN2B };

__device__ __forceinline__ float shfl_idx(float v, int src_lane) { return __builtin_bit_cast(float, __builtin_amdgcn_ds_bpermute(src_lane << 2, __builtin_bit_cast(int, v))); }
__device__ __forceinline__ float wave_sum(float v, int lane) {
#pragma unroll
    for (int o = 1; o < 64; o <<= 1) v += shfl_idx(v, lane ^ o);
    return v;
}

enum { RM_ID = 0, RM_WIN = 1, RM_GU = 2 };
template <int MODE> __device__ __forceinline__ int rowmap(int s, int extra) {
    if (MODE == RM_ID) return s;
    if (MODE == RM_GU) return 256 * (s >> 7) + (s & 127) + extra;
    if (s < 1024) return s;
    if (s < 2048) { const int j = ((s - 1024) >> 7) & 3; return 1024 + 256 * j + (s >= 1536 ? 128 : 0) + (s & 127); }
    if (s < 3072) return s;
    if (s < 4096) { const int j = ((s - 3072) >> 7) & 3; return 3072 + 256 * j + (s >= 3584 ? 128 : 0) + (s & 127); }
    const int g = (s - 4096) >> 10, ch = s & 1023, pn = ch >> 6, chl = ch & 63, wc = chl >> 4, fq = (chl >> 2) & 3, i = chl & 3;
    return 4096 + 256 * pn + 128 * (g >> 1) + 32 * wc + 8 * fq + 4 * (g & 1) + i;
}
template <int MODE>
__device__ __forceinline__ void transpose_item(const float* W, int K, int N, bf16* WT, int dst_ld, int dst_koff, int extra, LAS float* scr, int item, int lane, int nb0, int nnb) {
    const int kb = item / nnb, nb = nb0 + item % nnb, k0 = 64 * kb, n0 = 32 * nb;
    { float tv[32];
      const float* wp = W + (size_t)(k0 + (lane >> 5)) * N + n0 + (lane & 31);
#pragma unroll
      for (int i = 0; i < 32; ++i) tv[i] = wp[(size_t)(2 * i) * N];
#pragma unroll
      for (int i = 0; i < 32; ++i) scr[(2 * i + (lane >> 5)) * 33 + (lane & 31)] = tv[i]; }
    LDS_WAIT(); asm volatile("" ::: "memory");
    const int c = lane & 7; const float sc = (MODE == RM_WIN && n0 >= 4096) ? -1.44269504089f : 1.0f;
#pragma unroll
    for (int j = 0; j < 4; ++j) { const int n = (lane >> 3) + 8 * j; const LAS float* s = scr + (8 * c) * 33 + n;
        v4u o; o.x = pk2(s[0 * 33] * sc, s[1 * 33] * sc); o.y = pk2(s[2 * 33] * sc, s[3 * 33] * sc); o.z = pk2(s[4 * 33] * sc, s[5 * 33] * sc); o.w = pk2(s[6 * 33] * sc, s[7 * 33] * sc);
        *(GAS v4u*)(WT + (size_t)rowmap<MODE>(n0 + n, extra) * dst_ld + dst_koff + k0 + 8 * c) = o; }
    LDS_WAIT(); asm volatile("" ::: "memory");
}
template <int MODE>
__device__ __forceinline__ void convert_matrix(Frame& F, const float* W, int K, int N, bf16* WT, int dst_ld, int dst_koff, int extra, int gw, int NGW, int first = 0, int nb0 = 0, int nnb = 0) {
    LAS float* scr = (LAS float*)(F.lds + RING_OFF + F.wave * 16384);
    if (nnb == 0) nnb = N / 32;
    const int nitems = (K / 64) * nnb;
    int it0 = gw - first; if (it0 < 0) it0 += ((-it0 + NGW - 1) / NGW) * NGW;
    for (int it = it0; it < nitems; it += NGW) transpose_item<MODE>(W, K, N, WT, dst_ld, dst_koff, extra, scr, it, F.lane, nb0, nnb);
}
__device__ __forceinline__ void compose_pool(Frame& F, int layer, bf16* Bt3, int gw, int NGW, int first = 0) {
    const float* pw = F.in[I_POOLW] + (size_t)layer * 4 * 128 * 128; const float* ps = F.in[I_POOLS] + layer * 512; const float* Wb2 = F.in[I_WBR] + ((size_t)layer * 4 + 2) * 512 * 1024;
    const int lane = F.lane;
    LAS float* Pl = (LAS float*)(F.lds + RING_OFF + F.wave * 16384);
    int id0 = gw - first; if (id0 < 0) id0 += ((-id0 + NGW - 1) / NGW) * NGW;
    for (int id = id0; id < 512; id += NGW) {
        const int g = __builtin_amdgcn_readfirstlane(id >> 7), c0 = __builtin_amdgcn_readfirstlane(8 * ((id >> 3) & 15)), d0 = 128 * (id & 7) + 2 * lane;
#pragma unroll
        for (int k = 0; k < 4; ++k) { const int idx4 = lane + 64 * k, i = idx4 >> 5, e4 = (idx4 & 31) * 4;
            const f32x4 pv = *(const GAS f32x4*)(pw + ((size_t)g * 128 + c0 + i) * 128 + e4), sv = *(const GAS f32x4*)(ps + 128 * g + e4);
            Pl[(e4 + 0) * 8 + i] = pv.x * sv.x; Pl[(e4 + 1) * 8 + i] = pv.y * sv.y; Pl[(e4 + 2) * 8 + i] = pv.z * sv.z; Pl[(e4 + 3) * 8 + i] = pv.w * sv.w; }
        LDS_WAIT(); asm volatile("" ::: "memory");
        f32x2 acc[8];
#pragma unroll
        for (int i = 0; i < 8; ++i) acc[i] = (f32x2){0.f, 0.f};
        const float* wrow = Wb2 + (size_t)(128 * g) * 1024 + d0;
#pragma unroll 1
        for (int e0 = 0; e0 < 128; e0 += 8) {
            f32x2 wv[8];
#pragma unroll
            for (int k = 0; k < 8; ++k) wv[k] = *(const GAS f32x2*)(wrow + (size_t)(e0 + k) * 1024);
#pragma unroll
            for (int k = 0; k < 8; ++k) { const f32x4 p0 = *(const LAS f32x4*)(Pl + (e0 + k) * 8), p1 = *(const LAS f32x4*)(Pl + (e0 + k) * 8 + 4);
#pragma unroll
                for (int i = 0; i < 4; ++i) { acc[i] += wv[k] * p0[i]; acc[4 + i] += wv[k] * p1[i]; } }
        }
        v4u o0, o1;
        o0.x = pk2(acc[0].x, acc[1].x); o0.y = pk2(acc[2].x, acc[3].x); o0.z = pk2(acc[4].x, acc[5].x); o0.w = pk2(acc[6].x, acc[7].x);
        o1.x = pk2(acc[0].y, acc[1].y); o1.y = pk2(acc[2].y, acc[3].y); o1.z = pk2(acc[4].y, acc[5].y); o1.w = pk2(acc[6].y, acc[7].y);
        *(GAS v4u*)(Bt3 + (size_t)d0 * 2048 + 1024 + 128 * g + c0) = o0; *(GAS v4u*)(Bt3 + (size_t)(d0 + 1) * 2048 + 1024 + 128 * g + c0) = o1;
        LDS_WAIT(); asm volatile("" ::: "memory");
    }
}

__device__ __forceinline__ const float* xrow_in(Frame& F, int m) { return m < MP ? F.in[I_XP] + (size_t)m * DM : F.in[I_XS] + (size_t)(m - MP) * DM; }
__device__ __forceinline__ void x_to_bf16(Frame& F, bf16* XB) {
    const int gw = F.bid * NWAVES + F.wave, NGW = F.G * NWAVES;
    for (int m0 = 4 * gw; m0 < M; m0 += 4 * NGW) {
        f32x4 v[4][4];
#pragma unroll
        for (int k = 0; k < 4; ++k) { const GAS f32x4* xr = (const GAS f32x4*)xrow_in(F, m0 + k) + F.lane;
#pragma unroll
            for (int j = 0; j < 4; ++j) v[k][j] = xr[64 * j]; }
#pragma unroll
        for (int k = 0; k < 4; ++k) { GAS v2u* o = (GAS v2u*)(XB + (size_t)(m0 + k) * DM) + F.lane;
#pragma unroll
            for (int j = 0; j < 4; ++j) o[64 * j] = (v2u){pk2(v[k][j].x, v[k][j].y), pk2(v[k][j].z, v[k][j].w)}; } }
}
__device__ __forceinline__ void ln_rows(Frame& F, const float* V, float* O, const float* g, const float* b, bf16* XB, const float* sbase, const float* slab, int nslab, int wg0 = 0) {
    const int gw = ((F.bid - wg0 + F.G) % F.G) * NWAVES + F.wave, NGW = F.G * NWAVES;
    f32x4 gv[4], bv[4];
#pragma unroll
    for (int j = 0; j < 4; ++j) { gv[j] = ((const GAS f32x4*)g)[F.lane + 64 * j]; bv[j] = ((const GAS f32x4*)b)[F.lane + 64 * j]; }
    for (int m = MP + gw; m < M; m += NGW) {
        const GAS f32x4* xr = (const GAS f32x4*)(V + (size_t)m * DM) + F.lane; GAS f32x4* orow = (GAS f32x4*)(O + (size_t)m * DM) + F.lane;
        f32x4 v[4]; float s = 0.f;
#pragma unroll
        for (int j = 0; j < 4; ++j) v[j] = xr[64 * j];
        if (m >= MP) { const GAS f32x4* br = (const GAS f32x4*)(sbase + (size_t)(m - MP) * DM) + F.lane;
#pragma unroll
            for (int j = 0; j < 4; ++j) v[j] = br[64 * j] * ALPHA;
            for (int sl = 0; sl < nslab; sl += 4) {
                f32x4 t[4][4];
#pragma unroll
                for (int k = 0; k < 4; ++k) { const GAS f32x4* sr = (const GAS f32x4*)(slab + ((size_t)(sl + k < nslab ? sl + k : sl) * 512 + (m - MP)) * DM) + F.lane;
#pragma unroll
                    for (int j = 0; j < 4; ++j) t[k][j] = sr[64 * j]; }
#pragma unroll
                for (int k = 0; k < 4; ++k) if (sl + k < nslab) {
#pragma unroll
                    for (int j = 0; j < 4; ++j) v[j] += t[k][j]; } } }
#pragma unroll
        for (int j = 0; j < 4; ++j) s += (v[j].x + v[j].y) + (v[j].z + v[j].w);
        const float mean = wave_sum(s, F.lane) * (1.f / DM); float s2 = 0.f;
#pragma unroll
        for (int j = 0; j < 4; ++j) { v[j] = v[j] - mean; s2 += (v[j].x * v[j].x + v[j].y * v[j].y) + (v[j].z * v[j].z + v[j].w * v[j].w); }
        const float rstd = __builtin_amdgcn_rsqf(wave_sum(s2, F.lane) * (1.f / DM) + LN_EPS);
#pragma unroll
        for (int j = 0; j < 4; ++j) { v[j] = v[j] * rstd * gv[j] + bv[j]; orow[64 * j] = v[j]; }
        if (XB) { GAS v2u* o = (GAS v2u*)(XB + (size_t)m * DM) + F.lane;
#pragma unroll
            for (int j = 0; j < 4; ++j) o[64 * j] = (v2u){pk2(v[j].x, v[j].y), pk2(v[j].z, v[j].w)}; }
    }
}

__device__ __forceinline__ void publish_ready(Frame& F, gu32* ctr) {
    VM_WAIT(); __syncthreads();
    if (F.tid == 0) { __builtin_amdgcn_fence(__ATOMIC_RELEASE, "agent"); asm volatile("s_waitcnt vmcnt(0)" ::: "memory"); __hip_atomic_fetch_add((unsigned*)ctr, 1u, __ATOMIC_RELAXED, __HIP_MEMORY_SCOPE_AGENT); }
}
__device__ __forceinline__ void wait_ready(Frame& F, gu32* ctr, unsigned need) {
    if (F.wave == 0) { unsigned spins = 0;
        while ((unsigned)__builtin_amdgcn_readfirstlane(__hip_atomic_load((unsigned*)ctr, __ATOMIC_RELAXED, __HIP_MEMORY_SCOPE_AGENT)) < need) { __builtin_amdgcn_s_sleep(2); if (++spins > (1u << 20)) break; }
        __builtin_amdgcn_fence(__ATOMIC_ACQUIRE, "agent"); asm volatile("s_waitcnt vmcnt(0)" ::: "memory"); }
    __syncthreads();
}
__device__ __forceinline__ float softplusf_acc(float x) { return fmaxf(x, 0.f) + log1pf(__expf(-fabsf(x))); }
__device__ __forceinline__ float expm1_neg(float x) {
    const float p = x * (1.f + x * (0.5f + x * (1.f / 6.f + x * (1.f / 24.f + x * (1.f / 120.f + x * (1.f / 720.f + x * (1.f / 5040.f)))))));
    return x > -0.25f ? p : __expf(x) - 1.f;
}
constexpr int PATCH_STRIDE = 144;

struct ALane {
    float cwD[4], cbD, ba, bx, ck;
    bf16x8 Ba[4][2], Bx[4][2];
};
constexpr int PATCH_BYTES = 5120, ASLOT_OFF = 8 * PATCH_BYTES;
__device__ __forceinline__ void a_setup(Frame& F, int layer, int n, int q, ALane& L) {
    const int c = F.lane & 15, kg = F.lane >> 4, och = 64 * n + 16 * q + c;
    const float* cw = F.in[I_RGCW] + (size_t)layer * 4 * 512 + 64 * n; const float* cb = F.in[I_RGCB] + layer * 512 + 64 * n;
#pragma unroll
    for (int j = 0; j < 4; ++j) L.cwD[j] = cw[j * 512 + 16 * q + c];
    L.cbD = cb[16 * q + c];
    L.ck = 8.0f * softplusf_acc(-F.in[I_LAM][layer * 512 + och]);
    const float* wa = F.in[I_RGWA] + ((size_t)layer * 8 + n) * 4096 + 16 * q + c; const float* wx = F.in[I_RGWX] + ((size_t)layer * 8 + n) * 4096 + 16 * q + c;
    float wav[16], wxv[16], cbv[16];
#pragma unroll
    for (int e = 0; e < 16; ++e) { const int k = (e < 8 ? 8 * kg + e : 32 + 8 * kg + (e - 8)); wav[e] = wa[k * 64]; wxv[e] = wx[k * 64]; cbv[e] = cb[k]; }
#pragma unroll
    for (int j = 0; j < 4; ++j) { float t[16];
#pragma unroll
        for (int e = 0; e < 16; ++e) t[e] = cw[j * 512 + (e < 8 ? 8 * kg + e : 32 + 8 * kg + (e - 8))];
        L.Ba[j][0] = __builtin_bit_cast(bf16x8, (v4u){pk2(wav[0] * t[0], wav[1] * t[1]), pk2(wav[2] * t[2], wav[3] * t[3]), pk2(wav[4] * t[4], wav[5] * t[5]), pk2(wav[6] * t[6], wav[7] * t[7])});
        L.Ba[j][1] = __builtin_bit_cast(bf16x8, (v4u){pk2(wav[8] * t[8], wav[9] * t[9]), pk2(wav[10] * t[10], wav[11] * t[11]), pk2(wav[12] * t[12], wav[13] * t[13]), pk2(wav[14] * t[14], wav[15] * t[15])});
        L.Bx[j][0] = __builtin_bit_cast(bf16x8, (v4u){pk2(wxv[0] * t[0], wxv[1] * t[1]), pk2(wxv[2] * t[2], wxv[3] * t[3]), pk2(wxv[4] * t[4], wxv[5] * t[5]), pk2(wxv[6] * t[6], wxv[7] * t[7])});
        L.Bx[j][1] = __builtin_bit_cast(bf16x8, (v4u){pk2(wxv[8] * t[8], wxv[9] * t[9]), pk2(wxv[10] * t[10], wxv[11] * t[11]), pk2(wxv[12] * t[12], wxv[13] * t[13]), pk2(wxv[14] * t[14], wxv[15] * t[15])}); }
    float sa = 0.f, sx = 0.f;
#pragma unroll
    for (int e = 0; e < 16; ++e) { sa = fmaf(cbv[e], wav[e], sa); sx = fmaf(cbv[e], wxv[e], sx); }
    sa += shfl_idx(sa, F.lane ^ 16); sa += shfl_idx(sa, F.lane ^ 32); sx += shfl_idx(sx, F.lane ^ 16); sx += shfl_idx(sx, F.lane ^ 32);
    L.ba = F.in[I_RGBA][layer * 512 + och] + sa; L.bx = F.in[I_RGBX][layer * 512 + och] + sx;
}
__device__ __forceinline__ void a_block(const ALane& L, const LAS unsigned char* patch, int rowA0, int baseD, int q, int lane, float (&a)[4], float (&bb)[4]) {
    const int c = lane & 15, kg = lane >> 4;
    f32x4 accR = (f32x4){0.f, 0.f, 0.f, 0.f}, accI = (f32x4){0.f, 0.f, 0.f, 0.f};
#pragma unroll
    for (int j = 0; j < 4; ++j) { const LAS unsigned char* rp = patch + (rowA0 + j) * PATCH_STRIDE + 16 * kg;
        const bf16x8 A0 = *(const LAS bf16x8*)rp, A1 = *(const LAS bf16x8*)(rp + 64);
        accR = __builtin_amdgcn_mfma_f32_16x16x32_bf16(A0, L.Ba[j][0], accR, 0, 0, 0); accR = __builtin_amdgcn_mfma_f32_16x16x32_bf16(A1, L.Ba[j][1], accR, 0, 0, 0);
        accI = __builtin_amdgcn_mfma_f32_16x16x32_bf16(A0, L.Bx[j][0], accI, 0, 0, 0); accI = __builtin_amdgcn_mfma_f32_16x16x32_bf16(A1, L.Bx[j][1], accI, 0, 0, 0); }
    float pv[7];
#pragma unroll
    for (int k = 0; k < 7; ++k) pv[k] = bf1(*(const LAS unsigned short*)(patch + (baseD + k) * PATCH_STRIDE + 2 * (16 * q + c)));
#pragma unroll
    for (int r = 0; r < 4; ++r) {
        const float xd = L.cbD + L.cwD[0] * pv[r] + L.cwD[1] * pv[r + 1] + L.cwD[2] * pv[r + 2] + L.cwD[3] * pv[r + 3];
        const float rr = pg8::sigmoidf_fast(accR[r] + L.ba), ii = pg8::sigmoidf_fast(accI[r] + L.bx);
        const float la = -L.ck * rr;
        const float av = __builtin_amdgcn_exp2f(1.44269504089f * la);
        a[r] = av; bb[r] = __builtin_amdgcn_sqrtf(fmaxf(1.f - av * av, 0.f)) * (ii * xd);
    }
}
struct BlkScan { float Ac[4], Bc[4], EA, EB, WA, WB; };
__device__ __forceinline__ void blk_scan(const float (&a)[4], const float (&bb)[4], int lane, BlkScan& S) {
    const int c = lane & 15, g = lane >> 4;
    S.Ac[0] = a[0]; S.Bc[0] = bb[0];
#pragma unroll
    for (int r = 1; r < 4; ++r) { S.Ac[r] = a[r] * S.Ac[r - 1]; S.Bc[r] = a[r] * S.Bc[r - 1] + bb[r]; }
    float IA = S.Ac[3], IB = S.Bc[3];
    { const float pa = shfl_idx(IA, lane - 16), pb = shfl_idx(IB, lane - 16); if (g >= 1) { IB = IA * pb + IB; IA = IA * pa; } }
    { const float pa = shfl_idx(IA, lane - 32), pb = shfl_idx(IB, lane - 32); if (g >= 2) { IB = IA * pb + IB; IA = IA * pa; } }
    S.EA = shfl_idx(IA, lane - 16); S.EB = shfl_idx(IB, lane - 16); if (g == 0) { S.EA = 1.f; S.EB = 0.f; }
    S.WA = shfl_idx(IA, 48 + c); S.WB = shfl_idx(IB, 48 + c);
}
__device__ __forceinline__ void a_prompt_item(Frame& F, int layer, int item, const bf16* Z, bf16* Y) {
    const int b = item >> 5, n = (item >> 2) & 7, q = item & 3, lane = opqv(F.lane), w = F.wave, c = lane & 15, g = lane >> 4, och = 64 * n + 16 * q + c;
    ALane L; a_setup(F, layer, n, q, L);
    LAS unsigned char* patch = F.lds + RING_OFF + w * PATCH_BYTES;
    LAS f32x2* slots = (LAS f32x2*)(F.lds + RING_OFF + ASLOT_OFF);
    const bf16* Zb = Z + (size_t)b * SEQ * ZC; bf16* Yb = Y + (size_t)b * SEQ * YC;
    float hrun = 0.f;
    v4u pf[5];
    auto load_patch = [&](int tb) {
#pragma unroll
        for (int k = 0; k < 5; ++k) { const int ci = lane + 64 * k, pr = ci >> 3, cc = ci & 7, t = tb - 3 + pr;
            pf[k] = (ci < 280 && t >= 0) ? *(const GAS v4u*)(Zb + (size_t)t * ZC + 64 * n + 8 * cc) : (v4u){0u, 0u, 0u, 0u}; }
    };
    load_patch(32 * w);
    for (int it = 0; it < 8; ++it) {
        const int tb = 256 * it + 32 * w;
#pragma unroll
        for (int k = 0; k < 5; ++k) { const int ci = lane + 64 * k, pr = ci >> 3, cc = ci & 7; if (ci < 280) *(LAS v4u*)(patch + pr * PATCH_STRIDE + 16 * cc) = pf[k]; }
        if (it < 7) load_patch(tb + 256);
        unsigned short gav[8];
#pragma unroll
        for (int r = 0; r < 8; ++r) gav[r] = ((const GAS unsigned short*)Zb)[(unsigned)((tb + 16 * (r >> 2) + 4 * g + (r & 3)) * ZC + 512 + och)];
        asm volatile("" ::: "memory");
        float a0[4], b0[4], a1[4], b1[4];
        a_block(L, patch, lane & 15, 4 * g, q, lane, a0, b0);
        a_block(L, patch, 16 + (lane & 15), 16 + 4 * g, q, lane, a1, b1);
        BlkScan S0, S1; blk_scan(a0, b0, lane, S0); blk_scan(a1, b1, lane, S1);
        if (lane < 16) slots[((it & 1) * 8 + w) * 16 + c] = (f32x2){S0.WA * S1.WA, S1.WA * S0.WB + S1.WB};
        __syncthreads();
        float hin = hrun, hw = 0.f;
#pragma unroll
        for (int ww = 0; ww < 8; ++ww) { const f32x2 s = slots[((it & 1) * 8 + ww) * 16 + c]; if (ww == w) hw = hin; hin = s.x * hin + s.y; }
        hrun = hin;
        const float hg0 = S0.EA * hw + S0.EB, hw1 = S0.WA * hw + S0.WB, hg1 = S1.EA * hw1 + S1.EB;
#pragma unroll
        for (int r = 0; r < 4; ++r) { const float h = S0.Ac[r] * hg0 + S0.Bc[r];
            ((GAS unsigned short*)Yb)[(unsigned)((tb + 4 * g + r) * YC + och)] = f2bf(h * bf1(gav[r])); }
#pragma unroll
        for (int r = 0; r < 4; ++r) { const float h = S1.Ac[r] * hg1 + S1.Bc[r];
            ((GAS unsigned short*)Yb)[(unsigned)((tb + 16 + 4 * g + r) * YC + och)] = f2bf(h * bf1(gav[4 + r]));
            if (r == 3 && it == 7 && w == 7 && g == 3) F.out[O_PH + (size_t)(layer * 8 + b) * 512 + och] = h; }
    }
}
__device__ __forceinline__ void a_sample_task(Frame& F, int layer, int task, const bf16* Z, bf16* Y) {
    const int blk = task >> 5, n = (task >> 2) & 7, q = task & 3, lane = opqv(F.lane), c = lane & 15, g = lane >> 4, och = 64 * n + 16 * q + c, s0 = 4 * blk;
    ALane L; a_setup(F, layer, n, q, L);
    LAS unsigned char* patch = F.lds + RING_OFF + F.wave * PATCH_BYTES;
#pragma unroll
    for (int k = 0; k < 4; ++k) { const int ci = lane + 64 * k; if (ci < 224) { const int pr = ci >> 3, cc = ci & 7, sq = pr / 7, tau = pr - 7 * sq - 3, seq = s0 + sq; v4u v;
            if (tau < 0) { const GAS f32x4* sp = (const GAS f32x4*)(F.in[I_SRGC] + ((size_t)(layer * 128 + seq) * 3 + (tau + 3)) * 512 + 64 * n + 8 * cc); const f32x4 f0 = sp[0], f1 = sp[1];
                v = (v4u){pk2(f0.x, f0.y), pk2(f0.z, f0.w), pk2(f1.x, f1.y), pk2(f1.z, f1.w)}; }
            else v = *(const GAS v4u*)(Z + (size_t)(MP + 4 * seq + tau) * ZC + 64 * n + 8 * cc);
            *(LAS v4u*)(patch + pr * PATCH_STRIDE + 16 * cc) = v; } }
    asm volatile("" ::: "memory");
    float a[4], bb[4];
    a_block(L, patch, 7 * ((lane & 15) >> 2) + (lane & 3), 7 * g, q, lane, a, bb);
    const int seq = s0 + g;
    float h = F.in[I_SH][(size_t)(layer * 128 + seq) * 512 + och];
#pragma unroll
    for (int r = 0; r < 4; ++r) { h = a[r] * h + bb[r]; const size_t row = (size_t)(MP + 4 * seq + r);
        *(GAS unsigned short*)(Y + row * YC + och) = f2bf(h * bf1(*(const GAS unsigned short*)(Z + row * ZC + 512 + och))); }
    F.out[O_SH + (size_t)(layer * 128 + seq) * 512 + och] = h;
}

__device__ __forceinline__ void ln_silu_row(const LAS float* xr, const float* g, const float* b, bf16* dst, int lane) {
    const f32x4 v0 = *(const LAS f32x4*)(xr + 4 * lane), v1 = *(const LAS f32x4*)(xr + 256 + 4 * lane);
    const float s = (v0.x + v0.y) + (v0.z + v0.w) + (v1.x + v1.y) + (v1.z + v1.w);
    const float mean = wave_sum(s, lane) * (1.f / 512.f);
    const f32x4 d0 = v0 - mean, d1 = v1 - mean;
    const float s2 = (d0.x * d0.x + d0.y * d0.y) + (d0.z * d0.z + d0.w * d0.w) + (d1.x * d1.x + d1.y * d1.y) + (d1.z * d1.z + d1.w * d1.w);
    const float rstd = __builtin_amdgcn_rsqf(wave_sum(s2, lane) * (1.f / 512.f) + LN_EPS);
    const f32x4 g0 = *(const GAS f32x4*)(g + 4 * lane), g1 = *(const GAS f32x4*)(g + 256 + 4 * lane), b0 = *(const GAS f32x4*)(b + 4 * lane), b1 = *(const GAS f32x4*)(b + 256 + 4 * lane);
    f32x4 y0 = d0 * rstd * g0 + b0, y1 = d1 * rstd * g1 + b1;
#pragma unroll
    for (int i = 0; i < 4; ++i) { y0[i] = y0[i] * pg8::sigmoidf_fast(y0[i]); y1[i] = y1[i] * pg8::sigmoidf_fast(y1[i]); }
    *(GAS v2u*)(dst + 4 * lane) = (v2u){pk2(y0.x, y0.y), pk2(y0.z, y0.w)}; *(GAS v2u*)(dst + 256 + 4 * lane) = (v2u){pk2(y1.x, y1.y), pk2(y1.z, y1.w)};
}
__device__ __forceinline__ void ln_silu_rows4(const LAS float* xr, int rstride, const float* g, const float* b, bf16* dst, size_t dstride, int lane) {
    f32x4 v0[4], v1[4]; float s[4], s2[4];
#pragma unroll
    for (int k = 0; k < 4; ++k) { v0[k] = *(const LAS f32x4*)(xr + k * rstride + 4 * lane); v1[k] = *(const LAS f32x4*)(xr + k * rstride + 256 + 4 * lane);
        s[k] = (v0[k].x + v0[k].y) + (v0[k].z + v0[k].w) + (v1[k].x + v1[k].y) + (v1[k].z + v1[k].w); }
#pragma unroll
    for (int o = 1; o < 64; o <<= 1) {
#pragma unroll
        for (int k = 0; k < 4; ++k) s[k] += shfl_idx(s[k], lane ^ o); }
#pragma unroll
    for (int k = 0; k < 4; ++k) { const float mean = s[k] * (1.f / 512.f); v0[k] = v0[k] - mean; v1[k] = v1[k] - mean;
        s2[k] = (v0[k].x * v0[k].x + v0[k].y * v0[k].y) + (v0[k].z * v0[k].z + v0[k].w * v0[k].w) + (v1[k].x * v1[k].x + v1[k].y * v1[k].y) + (v1[k].z * v1[k].z + v1[k].w * v1[k].w); }
#pragma unroll
    for (int o = 1; o < 64; o <<= 1) {
#pragma unroll
        for (int k = 0; k < 4; ++k) s2[k] += shfl_idx(s2[k], lane ^ o); }
    const f32x4 g0 = *(const GAS f32x4*)(g + 4 * lane), g1 = *(const GAS f32x4*)(g + 256 + 4 * lane), b0 = *(const GAS f32x4*)(b + 4 * lane), b1 = *(const GAS f32x4*)(b + 256 + 4 * lane);
#pragma unroll
    for (int k = 0; k < 4; ++k) { const float rstd = __builtin_amdgcn_rsqf(s2[k] * (1.f / 512.f) + LN_EPS);
        f32x4 y0 = v0[k] * rstd * g0 + b0, y1 = v1[k] * rstd * g1 + b1;
#pragma unroll
        for (int i = 0; i < 4; ++i) { y0[i] = y0[i] * pg8::sigmoidf_fast(y0[i]); y1[i] = y1[i] * pg8::sigmoidf_fast(y1[i]); }
        bf16* d = dst + (size_t)k * dstride;
        *(GAS v2u*)(d + 4 * lane) = (v2u){pk2(y0.x, y0.y), pk2(y0.z, y0.w)}; *(GAS v2u*)(d + 256 + 4 * lane) = (v2u){pk2(y1.x, y1.y), pk2(y1.z, y1.w)}; }
}
__device__ __forceinline__ void b_prompt_item(Frame& F, int layer, int item, const bf16* Z, bf16* Y) {
    const int tidl = opqv(F.tid), b = item >> 5, t0 = 64 * (item & 31), p = tidl & 255, hh = tidl >> 8, ts = t0 + 32 * hh;
    const GAS unsigned* Zu = (const GAS unsigned*)(Z + (size_t)b * SEQ * ZC) + 512 + p;
    unsigned raw[62];
#pragma unroll
    for (int i = 0; i < 62; ++i) { const int t = ts - 30 + i; raw[i] = t >= 0 ? Zu[(size_t)t * (ZC / 2)] : 0u; }
    const float* cw = F.in[I_CFW] + (size_t)layer * 31 * 512 + 2 * p;
    f32x2 wj[31];
#pragma unroll
    for (int j = 0; j < 31; ++j) wj[j] = *(const GAS f32x2*)(cw + j * 512);
    const f32x2 bias = *(const GAS f32x2*)(F.in[I_CFB] + layer * 512 + 2 * p);
    f32x2 in[62];
#pragma unroll
    for (int i = 0; i < 62; ++i) in[i] = (f32x2){bflo(raw[i]), bfhi(raw[i])};
    LAS float* obuf = (LAS float*)(F.lds + RING_OFF);
#pragma unroll
    for (int i = 0; i < 32; ++i) { f32x2 o = bias;
#pragma unroll
        for (int j = 0; j < 31; ++j) o += wj[j] * in[i + j];
        *(LAS f32x2*)(obuf + (32 * hh + i) * 512 + 2 * p) = o; }
    __syncthreads();
    const float* lg = F.in[I_CFG] + layer * 512; const float* lb = F.in[I_CFBB] + layer * 512;
#pragma unroll 1
    for (int r = 8 * F.wave; r < 8 * F.wave + 8; r += 4) ln_silu_rows4(obuf + r * 512, 512, lg, lb, Y + (size_t)(b * SEQ + t0 + r) * YC + 512, YC, F.lane);
}
__device__ __forceinline__ void cd_prompt_item(Frame& F, int layer, int item, const bf16* Z, bf16* Y) {
    const int tidl = opqv(F.tid), b = item >> 5, t0 = 64 * (item & 31), p = tidl & 255, hh = tidl >> 8;
    const bf16* Zb = Z + (size_t)b * SEQ * ZC;
    LAS unsigned* cbuf = (LAS unsigned*)(F.lds + RING_OFF);
    { v4u tmp[10];
#pragma unroll
      for (int k = 0; k < 10; ++k) { const int ci = tidl + 512 * k, pr = ci >> 6, cc = ci & 63, t = t0 - 15 + pr;
          tmp[k] = (ci < 79 * 64 && t >= 0) ? *(const GAS v4u*)(Zb + (size_t)t * ZC + 1536 + 8 * cc) : (v4u){0u, 0u, 0u, 0u}; }
#pragma unroll
      for (int k = 0; k < 10; ++k) { const int ci = tidl + 512 * k, pr = ci >> 6, cc = ci & 63; if (ci < 79 * 64) *(LAS v4u*)(cbuf + pr * 256 + 4 * cc) = tmp[k]; } }
    const int ts = t0 + 32 * hh;
    unsigned uu[34], dd[32];
#pragma unroll
    for (int i = 0; i < 34; ++i) { const int t = ts - 2 + i; uu[i] = t >= 0 ? ((const GAS unsigned*)(Zb + (size_t)t * ZC))[1280 + p] : 0u; }
#pragma unroll
    for (int i = 0; i < 32; ++i) dd[i] = ((const GAS unsigned*)(Zb + (size_t)(ts + i) * ZC))[1024 + p];
    const f32x2 w0 = ((const GAS f32x2*)(F.in[I_SCW] + (size_t)(layer * 3 + 0) * 512))[p], w1 = ((const GAS f32x2*)(F.in[I_SCW] + (size_t)(layer * 3 + 1) * 512))[p],
                w2 = ((const GAS f32x2*)(F.in[I_SCW] + (size_t)(layer * 3 + 2) * 512))[p];
    __syncthreads();
    const int w = 2 << (p >> 6), rr0 = 15 + 32 * hh;
    f32x2 s = (f32x2){0.f, 0.f};
    for (int j = 0; j < w; ++j) { const unsigned v = cbuf[(rr0 - j) * 256 + p]; s += (f32x2){bflo(v), bfhi(v)}; }
    GAS unsigned* Yu = (GAS unsigned*)(Y + (size_t)(b * SEQ + ts) * YC) + p;
#pragma unroll
    for (int i = 0; i < 32; ++i) { const int t = ts + i, rr = rr0 + i;
        const unsigned cur = cbuf[rr * 256 + p]; const f32x2 cf = (f32x2){bflo(cur), bfhi(cur)};
        if (i > 0) { const unsigned old = cbuf[(rr - w) * 256 + p]; s += cf - (f32x2){bflo(old), bfhi(old)}; }
        const float ic = __builtin_amdgcn_rcpf((float)(t + 1 < w ? t + 1 : w));
        const f32x2 mm = s * ic - cf;
        Yu[(size_t)i * 1024 + 512] = pk2(mm.x, mm.y);
        const f32x2 cv = w0 * (f32x2){bflo(uu[i]), bfhi(uu[i])} + w1 * (f32x2){bflo(uu[i + 1]), bfhi(uu[i + 1])} + w2 * (f32x2){bflo(uu[i + 2]), bfhi(uu[i + 2])};
        const f32x2 yd = (f32x2){bflo(dd[i]), bfhi(dd[i])} * cv;
        Yu[(size_t)i * 1024 + 768] = pk2(yd.x, yd.y); }
}
__device__ __forceinline__ void s_sample_item(Frame& F, int layer, int s, const bf16* Z, bf16* Y) {
    const int ch = opqv(F.tid); const size_t ls = (size_t)layer * 128 + s;
    const bf16* Zr = Z + (size_t)(MP + 4 * s) * ZC; bf16* Yr = Y + (size_t)(MP + 4 * s) * YC;
    LAS float* obuf = (LAS float*)(F.lds + RING_OFF);
    float in[34], wv[31], pb[19], u[6], dbv[4];
#pragma unroll
    for (int j = 0; j < 30; ++j) in[j] = (F.in[I_SCF] + (ls * 30 + j) * 512)[ch];
#pragma unroll
    for (int j = 0; j < 15; ++j) pb[j] = (F.in[I_SPOOL] + (ls * 15 + j) * 512)[ch];
    u[0] = (F.in[I_SSC] + (ls * 2 + 0) * 512)[ch]; u[1] = (F.in[I_SSC] + (ls * 2 + 1) * 512)[ch];
#pragma unroll
    for (int r = 0; r < 4; ++r) { in[30 + r] = bf1((Zr + (size_t)r * ZC + 1024)[ch]); pb[15 + r] = bf1((Zr + (size_t)r * ZC + 1536)[ch]); u[2 + r] = bf1((Zr + (size_t)r * ZC + 2560)[ch]); dbv[r] = bf1((Zr + (size_t)r * ZC + 2048)[ch]); }
#pragma unroll
    for (int j = 0; j < 31; ++j) wv[j] = (F.in[I_CFW] + ((size_t)layer * 31 + j) * 512)[ch];
    const float bias = (F.in[I_CFB] + layer * 512)[ch];
    const float w0 = (F.in[I_SCW] + (size_t)(layer * 3 + 0) * 512)[ch], w1 = (F.in[I_SCW] + (size_t)(layer * 3 + 1) * 512)[ch], w2 = (F.in[I_SCW] + (size_t)(layer * 3 + 2) * 512)[ch];
    asm volatile("" ::: "memory");
#pragma unroll
    for (int j = 0; j < 26; ++j) (F.out + O_SCF + (ls * 30 + j) * 512)[ch] = in[j + 4];
#pragma unroll
    for (int r = 0; r < 4; ++r) { float o = bias;
#pragma unroll
        for (int j = 0; j < 31; ++j) o += wv[j] * in[r + j];
        obuf[r * 512 + ch] = o; }
#pragma unroll
    for (int j = 0; j < 11; ++j) (F.out + O_SPOOL + (ls * 15 + j) * 512)[ch] = pb[j + 4];
    const int gsel = ch >> 7;
#pragma unroll
    for (int r = 0; r < 4; ++r) { const int k = 15 + r;
        const float s2 = pb[k] + pb[k - 1], s4 = s2 + pb[k - 2] + pb[k - 3], s8 = s4 + (pb[k - 4] + pb[k - 5]) + (pb[k - 6] + pb[k - 7]);
        float s16 = s8;
#pragma unroll
        for (int j = 8; j < 16; ++j) s16 += pb[k - j];
        const float mv = (gsel == 0 ? s2 * 0.5f : gsel == 1 ? s4 * 0.25f : gsel == 2 ? s8 * 0.125f : s16 * 0.0625f) - pb[k];
        (Yr + (size_t)r * YC + 1024)[ch] = f2bf(mv); }
#pragma unroll
    for (int r = 0; r < 4; ++r) (Yr + (size_t)r * YC + 1536)[ch] = f2bf(dbv[r] * (w0 * u[r] + w1 * u[r + 1] + w2 * u[r + 2]));
    __syncthreads();
    if (F.wave < 4) ln_silu_row(obuf + F.wave * 512, F.in[I_CFG] + layer * 512, F.in[I_CFBB] + layer * 512, Yr + (size_t)F.wave * YC + 512, F.lane);
}

struct Args { const float* in[31]; float* out; unsigned char* ws; int ph_lo, ph_hi; };
__global__ void __launch_bounds__(NWAVES * 64, 2) hybrid_fwd(Args args) {
    extern __shared__ __attribute__((aligned(16))) unsigned char lds[];
    Frame F;
    F.lds = (LAS unsigned char*)lds;
    F.MISC = (volatile LAS unsigned*)(F.lds + MISC_OFF);
    const int wave0 = __builtin_amdgcn_readfirstlane((int)threadIdx.x >> 6);
    F.lane = lane_now(); F.wave = wave0; F.tid = F.wave * 64 + F.lane;
    F.G = gridDim.x; F.bid = blockIdx.x;
    F.ws = args.ws; F.out = args.out; F.ctl = (gu32*)(args.ws + WS_CTL);
    F.in = args.in;
    for (int u = F.tid; u < (LDS_BYTES - LDSCTL_OFF) / 4; u += NWAVES * 64) ((LAS unsigned*)(F.lds + LDSCTL_OFF))[u] = 0u;
    __syncthreads();
    XcdBarrier bar; bar.bar = (unsigned*)(F.ctl + CW_BAR); bar.x = 0; bar.st = nullptr;
    if (!MK_SPLIT) bar = xcd_barrier_post((unsigned*)(F.ctl + CW_BAR), F.MISC + 8);
    const int lo = args.ph_lo, hi = args.ph_hi;
#define IN(k) (lo <= (k) && (k) < hi)
#define REFRESH() do { F.lane = lane_now(); F.wave = opqs(wave0); F.tid = F.wave * 64 + F.lane; F.bid = opqs((int)blockIdx.x); } while (0)
#define SEAM(k) do { if (IN(k) && IN((k) + 1)) xcd_barrier(bar); } while (0)
    bf16* WA = (bf16*)(F.ws + WS_WA); bf16* XB = (bf16*)(F.ws + WS_XB); bf16* Y = (bf16*)(F.ws + WS_Y); bf16* Zm = (bf16*)(F.ws + WS_ZG); _Float16* Gb = (_Float16*)(F.ws + WS_ZG);
    bf16* Hb = (bf16*)(F.ws + WS_ZG); bf16* MB = (bf16*)F.out;
 bf16* Bt3 = (bf16*)(F.ws + WS_BT3); bf16* Bt4 = (bf16*)(F.ws + WS_BT4); bf16* Bt5 = (bf16*)(F.ws + WS_BT5); bf16* Bt6 = (bf16*)(F.ws + WS_BT6);

    if (IN(0)) { REFRESH(); convert_matrix<RM_WIN>(F, F.in[I_WIN], DM, INC, WA, DM, 0, 0, F.bid * NWAVES + F.wave, F.G * NWAVES); REFRESH(); x_to_bf16(F, XB); }
    SEAM(0);

    const bool fast = F.G == 256;
    for (int l = 0; l < 2; ++l) {
        const int pb = 1 + 9 * l;
        if (IN(pb + 0)) for (int rep = 0; rep < NREP(0); ++rep) { if (rep) xcd_barrier(bar);
            if (fast && l == 1 && rep == 0) { REFRESH();
                ln_rows(F, F.out, F.out, F.in[I_LN2G], F.in[I_LN2B], XB, F.out + (size_t)MP * DM, (const float*)(F.ws + WS_SLAB), 11, 32); publish_ready(F, F.ctl + CW_RDY + 64 * 1); }
            pg8::Gemm g{XB, WA, DM, DM, XB}; pg8::UnitOrder S; S.init(pg8::SK_PLAIN, 4096, DM, F.G, F.bid, 0); pg8::EpiMix E{Zm, F.out, l};
            if (fast && l == 1) { S.ready = (const unsigned*)(F.ctl + CW_RDY + 64 * 1); S.need = (unsigned)F.G; }
            pg8::gemm_phase<pg8::EpiMix, pg8::UnitOrder, true>(F.lds + RING_OFF, g, S, E, wave0);
            if (F.G == 256 && F.bid >= 32 && F.bid < 64 && rep + 1 == NREP(0)) {
                pg8::Gemm g2{XB, WA + (size_t)4096 * DM, DM, DM, XB}; pg8::UnitOrder S2; S2.init(pg8::SK_PLAIN, 4096, DM, 32, F.bid - 32, 0, false, true); pg8::EpiGate E2{Gb};
                if (fast && l == 1) { REFRESH(); wait_ready(F, F.ctl + CW_RDY + 64 * 1, (unsigned)F.G); }
                pg8::gemm_phase<pg8::EpiGate, pg8::UnitOrder, true>(F.lds + RING_OFF, g2, S2, E2, wave0); }
            if (F.G == 256 && F.bid >= 64 && rep + 1 == NREP(0)) {
                REFRESH(); const int gw = (F.bid - 64) * NWAVES + F.wave, NGW = 192 * NWAVES; const float* wbr = F.in[I_WBR] + (size_t)l * 4 * 512 * 1024;
                convert_matrix<RM_ID>(F, wbr, 512, 1024, Bt3, 2048, 0, 0, gw, NGW, 0);
                convert_matrix<RM_ID>(F, wbr + (size_t)512 * 1024, 512, 1024, Bt3, 2048, 512, 0, gw, NGW, 256);
                convert_matrix<RM_ID>(F, wbr + (size_t)3 * 512 * 1024, 512, 1024, Bt3, 2048, 1536, 0, gw, NGW, 512);
                convert_matrix<RM_ID>(F, F.in[I_WOUT] + (size_t)l * DM * DM, DM, DM, Bt4, DM, 0, 0, gw, NGW, 768);
                REFRESH(); compose_pool(F, l, Bt3, gw, NGW, 1280); } }
        SEAM(pb + 0);
        if (IN(pb + 1)) for (int rep = 0; rep < NREP(1); ++rep) { if (rep) xcd_barrier(bar);
            __syncthreads(); REFRESH();
            for (int r2 = 0; r2 < NREP2(0); ++r2) for (int it = F.bid; it < 256; it += F.G) { a_prompt_item(F, l, it, Zm, Y); __syncthreads(); }
            REFRESH();
            for (int r2 = 0; r2 < NREP2(1); ++r2) for (int it = (F.bid + 128) % F.G; it < 128; it += F.G) a_sample_task(F, l, 8 * it + F.wave, Zm, Y);
            __syncthreads(); REFRESH();
            const bool rebal = false, gemm_wg = false;
            for (int r2 = 0; r2 < NREP2(2); ++r2) { if (!gemm_wg) for (int it = F.bid; it < 256; it += F.G) { b_prompt_item(F, l, it, Zm, Y); __syncthreads(); }
                if (rebal && F.bid >= 160 && F.bid < 192) { b_prompt_item(F, l, F.bid - 32, Zm, Y); __syncthreads(); } }
            REFRESH();
            for (int r2 = 0; r2 < NREP2(3); ++r2) { if (!gemm_wg) for (int it = F.bid; it < 256; it += F.G) { cd_prompt_item(F, l, it, Zm, Y); __syncthreads(); }
                if (rebal && F.bid >= 192 && F.bid < 224) { cd_prompt_item(F, l, F.bid - 64, Zm, Y); __syncthreads(); } }
            REFRESH();
            for (int r2 = 0; r2 < NREP2(4); ++r2) for (int it = F.bid; it < 128; it += F.G) { s_sample_item(F, l, it, Zm, Y); __syncthreads(); }
            REFRESH();
            const float* wbr = F.in[I_WBR] + (size_t)l * 4 * 512 * 1024;
            if (F.G != 256) { const int gw = F.bid * NWAVES + F.wave, NGW = F.G * NWAVES;
                convert_matrix<RM_ID>(F, wbr, 512, 1024, Bt3, 2048, 0, 0, gw, NGW); convert_matrix<RM_ID>(F, wbr + (size_t)512 * 1024, 512, 1024, Bt3, 2048, 512, 0, gw, NGW);
                convert_matrix<RM_ID>(F, wbr + (size_t)3 * 512 * 1024, 512, 1024, Bt3, 2048, 1536, 0, gw, NGW); convert_matrix<RM_ID>(F, F.in[I_WOUT] + (size_t)l * DM * DM, DM, DM, Bt4, DM, 0, 0, gw, NGW);
                REFRESH(); compose_pool(F, l, Bt3, gw, NGW); }
        }
        SEAM(pb + 1);
        if (IN(pb + 2)) for (int rep = 0; rep < NREP(2); ++rep) { if (rep) xcd_barrier(bar); pg8::Gemm g{XB, WA + (size_t)4096 * DM, DM, DM, XB}; pg8::UnitOrder S; S.init(pg8::SK_PLAIN, 4096, DM, F.G, F.bid, 0, true, F.G != 256); pg8::EpiGate E{Gb};
            pg8::gemm_phase<pg8::EpiGate, pg8::UnitOrder, true>(F.lds + RING_OFF, g, S, E, wave0); }
        SEAM(pb + 2);
        if (IN(pb + 3)) for (int rep = 0; rep < NREP(3); ++rep) { if (rep) xcd_barrier(bar); pg8::Gemm g{Y, Bt3, 2048, 2048, Y}; pg8::UnitOrder S; S.init(pg8::SK_P3, DM, 2048, F.G, F.bid, 0); pg8::EpiMerge E{Gb, MB, (bf16*)(F.ws + WS_MB4S)};
            pg8::gemm_phase<pg8::EpiMerge, pg8::UnitOrder, true>(F.lds + RING_OFF, g, S, E, wave0);
            if (F.G == 256 && F.bid >= 32 && rep + 1 == NREP(3)) {
                REFRESH(); const int gw = (F.bid - 32) * NWAVES + F.wave, NGW = 224 * NWAVES;
                convert_matrix<RM_GU>(F, F.in[I_WG] + (size_t)l * DM * FF, DM, FF, Bt5, DM, 0, 0, gw, NGW, 0);
                convert_matrix<RM_GU>(F, F.in[I_WU] + (size_t)l * DM * FF, DM, FF, Bt5, DM, 0, 128, gw, NGW, 1408); } }
        SEAM(pb + 3);
        if (IN(pb + 4)) for (int rep = 0; rep < 1; ++rep) { pg8::Gemm g{MB, Bt4, DM, DM, (const bf16*)(F.ws + WS_MB4S)}; pg8::UnitOrder S; S.init(pg8::SK_P4, DM, DM, F.G, F.bid, 0);
            pg8::EpiRes E{l == 0 ? F.in[I_XP] : nullptr, l == 0 ? nullptr : XB, nullptr, XB, F.in[I_LN1G] + l * DM, F.in[I_LN1B] + l * DM, (float*)(F.ws + WS_SLAB),
                          pg8::PanelStats{(unsigned*)(F.ws + WS_XCH + (size_t)(2 * l) * 512 * 1024), (unsigned*)(F.ctl + CW_SEAM + (2 * l) * SEAM_BANK)}, F.lds + XLDS_OFF, wave0};
            pg8::gemm_phase<pg8::EpiRes, pg8::UnitOrder, true>(F.lds + RING_OFF, g, S, E, wave0);
}
        SEAM(pb + 4);
        if (IN(pb + 5) && !fast) for (int rep = 0; rep < NREP(5); ++rep) { if (rep) xcd_barrier(bar);
            REFRESH();
            ln_rows(F, F.out, rep + 1 < NREP(5) ? (float*)(F.ws + WS_Y) : F.out, F.in[I_LN1G] + l * DM, F.in[I_LN1B] + l * DM, rep + 1 < NREP(5) ? nullptr : XB, l == 0 ? F.in[I_XS] : F.out + (size_t)MP * DM, (const float*)(F.ws + WS_SLAB), 16);
            REFRESH();
            if (F.G != 256) { const int gw = F.bid * NWAVES + F.wave, NGW = F.G * NWAVES;
                convert_matrix<RM_GU>(F, F.in[I_WG] + (size_t)l * DM * FF, DM, FF, Bt5, DM, 0, 0, gw, NGW); convert_matrix<RM_GU>(F, F.in[I_WU] + (size_t)l * DM * FF, DM, FF, Bt5, DM, 0, 128, gw, NGW);
                convert_matrix<RM_ID>(F, F.in[I_WD] + (size_t)l * FF * DM, FF, DM, Bt6, FF, 0, 0, gw, NGW); }
        }
        if (!fast) SEAM(pb + 5);
        if (IN(pb + 6)) for (int rep = 0; rep < NREP(6); ++rep) { if (rep) xcd_barrier(bar);
            if (fast && rep == 0) { REFRESH();
                ln_rows(F, F.out, F.out, F.in[I_LN1G] + l * DM, F.in[I_LN1B] + l * DM, XB, l == 0 ? F.in[I_XS] : F.out + (size_t)MP * DM, (const float*)(F.ws + WS_SLAB), 16, 172); publish_ready(F, F.ctl + CW_RDY + 64 * (2 * l)); }
            pg8::Gemm g{XB, Bt5, DM, DM, XB}; pg8::UnitOrder S; S.init(pg8::SK_PLAIN, 2 * FF, DM, F.G, F.bid, 0); pg8::EpiSwi E{Hb};
            if (fast) { S.ready = (const unsigned*)(F.ctl + CW_RDY + 64 * (2 * l)); S.need = (unsigned)F.G; }
            pg8::gemm_phase<pg8::EpiSwi, pg8::UnitOrder, true>(F.lds + RING_OFF, g, S, E, wave0);
            if (F.G == 256 && F.bid >= 172 && rep + 1 == NREP(6)) {
                REFRESH(); const int gw = (F.bid - 172) * NWAVES + F.wave, NGW = 84 * NWAVES;
                convert_matrix<RM_ID>(F, F.in[I_WD] + (size_t)l * FF * DM, FF, DM, Bt6, FF, 0, 0, gw, NGW, 0);
            } }
        SEAM(pb + 6);
        if (IN(pb + 7)) for (int rep = 0; rep < 1; ++rep) { pg8::Gemm g{Hb, Bt6, FF, FF, Hb}; pg8::UnitOrder S; S.init(pg8::SK_P6, DM, FF, F.G, F.bid, 0); pg8::EpiRes E{nullptr, XB, l == 1 ? F.out : nullptr, l == 0 ? XB : nullptr, F.in[I_LN2G] + l * DM, F.in[I_LN2B] + l * DM, (float*)(F.ws + WS_SLAB),
                          pg8::PanelStats{(unsigned*)(F.ws + WS_XCH + (size_t)(2 * l + 1) * 512 * 1024), (unsigned*)(F.ctl + CW_SEAM + (2 * l + 1) * SEAM_BANK)}, F.lds + XLDS_OFF, wave0};
            pg8::gemm_phase<pg8::EpiRes, pg8::UnitOrder, true>(F.lds + RING_OFF, g, S, E, wave0);
            if (F.G == 256 && F.bid >= 88 && l == 0) {
                REFRESH(); convert_matrix<RM_WIN>(F, F.in[I_WIN] + (size_t)DM * INC, DM, INC, WA, DM, 0, 0, (F.bid - 88) * NWAVES + F.wave, 168 * NWAVES); } }
        SEAM(pb + 7);
        if (IN(pb + 8) && !(fast && l == 0)) for (int rep = 0; rep < NREP(8); ++rep) { if (rep) xcd_barrier(bar);
            REFRESH();
            ln_rows(F, F.out, rep + 1 < NREP(8) ? (float*)(F.ws + WS_Y) : F.out, F.in[I_LN2G] + l * DM, F.in[I_LN2B] + l * DM, (l == 0 && rep + 1 == NREP(8)) ? XB : nullptr, F.out + (size_t)MP * DM, (const float*)(F.ws + WS_SLAB), 11);
            REFRESH();
            if (l == 0 && F.G != 256) convert_matrix<RM_WIN>(F, F.in[I_WIN] + (size_t)DM * INC, DM, INC, WA, DM, 0, 0, F.bid * NWAVES + F.wave, F.G * NWAVES);
        }
        if (l == 0 && !fast) SEAM(pb + 8);
    }
#undef IN
#undef SEAM
#undef REFRESH
}

extern "C" void kernel_launch(void* const* d_in, const int* in_sizes, int n_in, void* d_out, int out_size, void* d_ws, size_t ws_size, hipStream_t stream) {
    static int grid = 0;
    if (grid == 0) {
        if (n_in != 31 || out_size != (int)O_END || ws_size < WS_END) { fprintf(stderr, "kernel_launch: unexpected sizes n_in %d out %d ws %zu\n", n_in, out_size, ws_size); grid = -1; return; }
        int dev = 0, cus = 0, per_cu = 0;
        if (hipGetDevice(&dev) != hipSuccess || hipDeviceGetAttribute(&cus, hipDeviceAttributeMultiprocessorCount, dev) != hipSuccess) { grid = -1; return; }
        if (hipFuncSetAttribute((const void*)hybrid_fwd, hipFuncAttributeMaxDynamicSharedMemorySize, LDS_BYTES) != hipSuccess) { fprintf(stderr, "kernel_launch: hipFuncSetAttribute failed\n"); grid = -1; return; }
        if (hipOccupancyMaxActiveBlocksPerMultiprocessor(&per_cu, (const void*)hybrid_fwd, NWAVES * 64, LDS_BYTES) != hipSuccess || per_cu < 1)
            fprintf(stderr, "kernel_launch: occupancy query reports %d workgroups per CU\n", per_cu);
        (void)hipGetLastError();
        grid = cus;
    }
    if (grid < 0) return;
    if (hipMemsetAsync((char*)d_ws + WS_CTL, 0, CTL_ZERO_BYTES, stream) != hipSuccess) { fprintf(stderr, "kernel_launch: memset failed\n"); return; }
    Args a{};
    for (int i = 0; i < 31; ++i) a.in[i] = (const float*)d_in[i];
    a.out = (float*)d_out; a.ws = (unsigned char*)d_ws;
#if MK_SPLIT
    for (int ph = 0; ph < NPHASE; ++ph) { a.ph_lo = ph; a.ph_hi = ph + 1; hipLaunchKernelGGL(hybrid_fwd, dim3(grid), dim3(NWAVES * 64), LDS_BYTES, stream, a); }
#else
    a.ph_lo = 0; a.ph_hi = NPHASE;
    hipLaunchKernelGGL(hybrid_fwd, dim3(grid), dim3(NWAVES * 64), LDS_BYTES, stream, a);
#endif
}
```

```cpp
#include <hip/hip_runtime.h>
#include <cstdio>
#include <cstdint>

#ifndef PROBE_REP
#define PROBE_REP 0
#endif
#define NREP(k) (1 + ((PROBE_REP >> (k)) & 1))
#ifndef PROBE2
#define PROBE2 0
#endif
#define NREP2(j) (1 + ((PROBE2 >> (j)) & 1))
#ifndef MK_SPLIT
#define MK_SPLIT 0
#endif

constexpr int DM = 1024, WMIX = 512, NPB = 8, SEQ = 2048, NSB = 128, DSEQ = 4;
constexpr int MP = NPB * SEQ, MS = NSB * DSEQ, M = MP + MS;
constexpr int FF = 2816, INC = 8192, ZC = 3072, YC = 2048, GC = 4096;
constexpr float LN_EPS = 1e-5f, ALPHA = 1.41421356237f;
constexpr size_t O_Y = 0, O_PH = (size_t)M * DM, O_PRGC = O_PH + 8192, O_PCF = O_PRGC + 24576, O_PPOOL = O_PCF + 245760, O_PSC = O_PPOOL + 122880,
                 O_SH = O_PSC + 16384, O_SRGC = O_SH + 131072, O_SCF = O_SRGC + 393216, O_SPOOL = O_SCF + 3932160, O_SSC = O_SPOOL + 1966080, O_END = O_SSC + 262144;
static_assert(O_END == 24403968, "output map");

__device__ __forceinline__ int opqv(int v) { asm volatile("" : "+v"(v)); return v; }
__device__ __forceinline__ int lane_now() { int l; asm volatile("v_mbcnt_lo_u32_b32 %0, -1, 0\n\tv_mbcnt_hi_u32_b32 %0, -1, %0" : "=v"(l)); return l; }
__device__ __forceinline__ int opqs(int v) { asm volatile("" : "+s"(v)); return v; }
namespace pg8 {
#define PG8_LAS __attribute__((address_space(3)))
typedef unsigned short bf16_t;
typedef short bf16x8 __attribute__((ext_vector_type(8)));
typedef float f32x4 __attribute__((ext_vector_type(4)));
typedef float f32x2 __attribute__((ext_vector_type(2)));
typedef unsigned u32x4 __attribute__((ext_vector_type(4)));
typedef unsigned u32x2 __attribute__((ext_vector_type(2)));
typedef _Float16 f16x4 __attribute__((ext_vector_type(4)));
typedef _Float16 f16x8 __attribute__((ext_vector_type(8)));
constexpr int BM = 256, BK = 64, HALF = 128, HTB = HALF * BK * 2, STAGE_BYTES = 8 * HTB, NXCD = 8, WGM = 8;

__host__ __device__ __forceinline__ int lds_byte(int r, int c) { const int st = (r >> 4) * 2 + (c >> 5), rr = r & 15, cc = c & 31, ob = rr * 64 + cc * 2; return st * 1024 + (ob ^ (((ob >> 9) & 1) << 5)); }
__host__ __device__ __forceinline__ void stage_rc(int b, int& R, int& C) { const int st = b / 1024, sb = b % 1024, swz = sb ^ (((sb >> 9) & 1) << 5); R = (st >> 1) * 16 + swz / 64; C = (st & 1) * 32 + (swz % 64) / 2; }
__host__ __device__ __forceinline__ int perm32(int rho) { const int n = rho >> 4, i = rho & 15; return 8 * (i >> 2) + 4 * n + (i & 3); }

struct Unit { int pm, pn, nt, mode, aux; long offA, offB; };
struct Gemm { const bf16_t* A; const bf16_t* Bt; int lda, ldb; const bf16_t* As; };

enum { SK_PLAIN = 0, SK_P3 = 1, SK_P4 = 2, SK_P6 = 3 };
struct UnitOrder {
    int kind, nN, nwgP, nS, ntP, G, c; long offA_s; const unsigned* ready = nullptr; unsigned need = 0;
    __device__ __forceinline__ void init(int kind_, int N_, int K_, int G_, int c_, long offA_s_, bool prompt = true, bool sample = true) { kind = kind_; nN = N_ / BM; nwgP = prompt ? 64 * nN : 0; ntP = K_ / BK; G = G_; c = c_; offA_s = offA_s_;
        nS = !sample ? 0 : kind_ == SK_PLAIN ? 2 * nN : kind_ == SK_P3 ? 32 : kind_ == SK_P4 ? 128 : 88; }
    __device__ __forceinline__ bool next(int i, Unit& u, const Gemm& g) const {
        const long L = (long)i * G + c; const long ra = (long)BM * g.lda * 2, rb = (long)BM * g.ldb * 2;
        if (L < nwgP) {
            int wgid = (int)L; { const int q = nwgP / NXCD, xcd = wgid % NXCD, off = wgid / NXCD; wgid = xcd * q + off; }
            const int nig = WGM * nN; u.pm = (wgid / nig) * WGM + ((wgid % nig) % WGM); u.pn = (wgid % nig) / WGM;
            u.nt = ntP; u.mode = 0; u.aux = 0; u.offA = u.pm * ra; u.offB = u.pn * rb; return true; }
        const int s = (int)(L - nwgP); if (s >= nS) return false;
        if (kind == SK_PLAIN) { u.pm = 64 + (s & 1); u.pn = s >> 1; u.nt = ntP; u.mode = 0; u.aux = 0; u.offA = u.pm * ra; u.offB = u.pn * rb; }
        else if (kind == SK_P3) { const int n = s & 3, tile = s >> 2; u.pm = 64 + (tile & 1); u.pn = tile >> 1; u.nt = 8; u.mode = 1; u.aux = n; u.offA = u.pm * ra + 1024 * n; u.offB = u.pn * rb + 1024 * n; }
        else if (kind == SK_P4) { const int ch = s & 15, tile = s >> 4, n = ch >> 2, kin = (ch & 3) * 256; u.pm = 64 + (tile & 1); u.pn = tile >> 1; u.nt = 4; u.mode = 1; u.aux = ch;
            u.offA = ((long)(n * 512 + (u.pm - 64) * 256) * 1024 + kin) * 2; u.offB = u.pn * rb + kin * 2; }
        else { const int ch = s % 11, tile = s / 11; u.pm = 64 + (tile & 1); u.pn = tile >> 1; u.nt = 4; u.mode = 1; u.aux = ch; u.offA = u.pm * ra + 512 * ch; u.offB = u.pn * rb + 512 * ch; }
        return true;
    }
    __device__ __forceinline__ void a_ready(const Unit& u, int wid) const {
        if (ready == nullptr || u.pm < 64) return;
        if (wid == 0) { unsigned spins = 0;
            while ((unsigned)__builtin_amdgcn_readfirstlane(__hip_atomic_load(ready, __ATOMIC_RELAXED, __HIP_MEMORY_SCOPE_AGENT)) < need) { __builtin_amdgcn_s_sleep(2); if (++spins > (1u << 20)) break; }
            __builtin_amdgcn_fence(__ATOMIC_ACQUIRE, "agent");
            asm volatile("s_waitcnt vmcnt(0)" ::: "memory"); }
        asm volatile("" ::: "memory"); __builtin_amdgcn_s_barrier(); asm volatile("" ::: "memory");
    }
};

__device__ __forceinline__ unsigned cvt_pk_bf16(float lo, float hi) { unsigned r; asm volatile("v_cvt_pk_bf16_f32 %0, %1, %2" : "=v"(r) : "v"(lo), "v"(hi)); return r; }
__device__ __forceinline__ float sigmoidf_fast(float x) { return __builtin_amdgcn_rcpf(1.0f + __builtin_amdgcn_exp2f(-1.44269504089f * x)); }
__device__ __forceinline__ float gelu_tanh(float x) { const float t = x * x, y = x * fmaf(t, -0.10294324f, -2.3022082f); return x * __builtin_amdgcn_rcpf(1.0f + __builtin_amdgcn_exp2f(y)); }

__device__ __forceinline__ void acc_zero(f32x4 (&acc)[2][2][4][2]) {
#pragma unroll
    for (int a = 0; a < 2; ++a)
#pragma unroll
        for (int b = 0; b < 2; ++b)
#pragma unroll
            for (int m = 0; m < 4; ++m)
#pragma unroll
                for (int n = 0; n < 2; ++n) acc[a][b][m][n] = (f32x4){0.f, 0.f, 0.f, 0.f};
}
__device__ __forceinline__ float* state_ptr(float* out, int R, int keep, int layer, size_t p_off, size_t s_off) {
    if (R < MP) { const int b = R >> 11, j = (R & 2047) - (2048 - keep); return j < 0 ? nullptr : out + p_off + (size_t)((layer * 8 + b) * keep + j) * 512; }
    const int s = (R - MP) >> 2, j = (R & 3) + keep - 4; return j < 0 ? nullptr : out + s_off + (size_t)((layer * 128 + s) * keep + j) * 512;
}

struct EpiMix {
    static constexpr bool PERM = true, MIDK = false;
    __device__ __forceinline__ void init(f32x4 (&acc)[2][2][4][2], const Unit&, int, int) const { acc_zero(acc); }
    bf16_t* Z; float* out; int layer;
    __device__ __forceinline__ void midk(f32x4 (&)[2][2][4][2], const Unit&, int, int, int, int, int) const {}
    __device__ __forceinline__ void operator()(f32x4 (&acc)[2][2][4][2], const Unit& u, int wr, int wc, int fr_, int fq_) const {
        const int lane_ = lane_now(), fr = lane_ & 15, fq = lane_ >> 4; (void)fr_; (void)fq_;
        const int pn = u.pn; int type, zcol, keep = 0, scol = 0; size_t poff = 0, soff = 0;
        if (pn < 2) { type = 0; zcol = 256 * pn; keep = 3; scol = zcol; poff = O_PRGC; soff = O_SRGC; }
        else if (pn < 4) { type = 1; zcol = 512 + 256 * (pn - 2); }
        else if (pn < 8) { type = 2; zcol = 1024 + 128 * (pn - 4); keep = 30; scol = 128 * (pn - 4); poff = O_PCF; soff = O_SCF; }
        else if (pn < 10) { type = 0; zcol = 1536 + 256 * (pn - 8); keep = 15; scol = 256 * (pn - 8); poff = O_PPOOL; soff = O_SPOOL; }
        else if (pn < 12) { type = 0; zcol = 2048 + 256 * (pn - 10); }
        else { type = 3; zcol = 2560 + 128 * (pn - 12); keep = 2; scol = 128 * (pn - 12); poff = O_PSC; soff = O_SSC; }
        const bool tail = keep != 0 && (u.pm >= 64 || (u.pm & 7) == 7);
        const int row0 = u.pm * BM + wr * 64 + fr, cl = wc * 32 + 8 * fq;
        if (type < 2) {
#pragma unroll
            for (int ai = 0; ai < 2; ++ai)
#pragma unroll
                for (int m = 0; m < 4; ++m) { const int R = row0 + ai * HALF + m * 16; bf16_t* rowp = Z + (size_t)R * ZC + zcol + cl;
                    float* sp = tail ? state_ptr(out, R, keep, layer, poff, soff) : nullptr;
#pragma unroll
                    for (int bj = 0; bj < 2; ++bj) { f32x4 v0 = acc[ai][bj][m][0], v1 = acc[ai][bj][m][1];
                        if (type == 1) { v0 = (f32x4){gelu_tanh(v0[0]), gelu_tanh(v0[1]), gelu_tanh(v0[2]), gelu_tanh(v0[3])}; v1 = (f32x4){gelu_tanh(v1[0]), gelu_tanh(v1[1]), gelu_tanh(v1[2]), gelu_tanh(v1[3])}; }
                        u32x4 w; w.x = cvt_pk_bf16(v0[0], v0[1]); w.y = cvt_pk_bf16(v0[2], v0[3]); w.z = cvt_pk_bf16(v1[0], v1[1]); w.w = cvt_pk_bf16(v1[2], v1[3]);
                        *(u32x4*)(rowp + bj * HALF) = w;
                        if (sp) { *(f32x4*)(sp + scol + cl + bj * HALF) = v0; *(f32x4*)(sp + scol + cl + bj * HALF + 4) = v1; } } }
        } else {
#pragma unroll
            for (int ai = 0; ai < 2; ++ai)
#pragma unroll
                for (int m = 0; m < 4; ++m) { const int R = row0 + ai * HALF + m * 16; bf16_t* rowp = Z + (size_t)R * ZC + zcol + cl;
                    float* sp = tail ? state_ptr(out, R, keep, layer, poff, soff) : nullptr;
                    f32x4 v0, v1; const f32x4 a0 = acc[ai][0][m][0], a1 = acc[ai][0][m][1], b0 = acc[ai][1][m][0], b1 = acc[ai][1][m][1];
                    if (type == 2) {
#pragma unroll
                        for (int i = 0; i < 4; ++i) { v0[i] = a0[i] * sigmoidf_fast(b0[i]); v1[i] = a1[i] * sigmoidf_fast(b1[i]); }
                    } else { v0 = a0 * b0; v1 = a1 * b1; }
                    u32x4 w; w.x = cvt_pk_bf16(v0[0], v0[1]); w.y = cvt_pk_bf16(v0[2], v0[3]); w.z = cvt_pk_bf16(v1[0], v1[1]); w.w = cvt_pk_bf16(v1[2], v1[3]);
                    *(u32x4*)rowp = w;
                    if (sp) { *(f32x4*)(sp + scol + cl) = v0; *(f32x4*)(sp + scol + cl + 4) = v1; } }
        }
    }
};

struct EpiGate {
    static constexpr bool PERM = true, MIDK = false;
    __device__ __forceinline__ void init(f32x4 (&acc)[2][2][4][2], const Unit&, int, int) const { acc_zero(acc); }
    _Float16* G;
    __device__ __forceinline__ void midk(f32x4 (&)[2][2][4][2], const Unit&, int, int, int, int, int) const {}
    __device__ __forceinline__ void operator()(f32x4 (&acc)[2][2][4][2], const Unit& u, int wr, int wc, int fr_, int fq_) const {
        const int lane_ = lane_now(), fr = lane_ & 15, fq = lane_ >> 4; (void)fr_; (void)fq_;
        const int row0 = u.pm * BM + wr * 64 + fr, ch0 = 64 * u.pn + 16 * wc + 4 * fq; const bool plain = u.pm >= 64;
#pragma unroll
        for (int ai = 0; ai < 2; ++ai)
#pragma unroll
            for (int m = 0; m < 4; ++m) { const int R = row0 + ai * HALF + m * 16; _Float16* gp = G + (size_t)R * GC + ch0;
                f16x4 r0, r1, r2, g3;
#pragma unroll
                for (int i = 0; i < 4; ++i) {
                    const float d0 = 1.f + __builtin_amdgcn_exp2f(__builtin_amdgcn_fmed3f(acc[ai][0][m][0][i], -15.f, 15.f)), d1 = 1.f + __builtin_amdgcn_exp2f(__builtin_amdgcn_fmed3f(acc[ai][0][m][1][i], -15.f, 15.f));
                    const float d2 = 1.f + __builtin_amdgcn_exp2f(__builtin_amdgcn_fmed3f(acc[ai][1][m][0][i], -15.f, 15.f)), d3 = 1.f + __builtin_amdgcn_exp2f(__builtin_amdgcn_fmed3f(acc[ai][1][m][1][i], -15.f, 15.f));
                    const float i0 = __builtin_amdgcn_rcpf(d0), i1 = __builtin_amdgcn_rcpf(d1), i2 = __builtin_amdgcn_rcpf(d2), i3 = __builtin_amdgcn_rcpf(d3);
                    if (plain) { r0[i] = (_Float16)i0; r1[i] = (_Float16)i1; r2[i] = (_Float16)i2; }
                    else { r0[i] = (_Float16)(d1 * i0); r1[i] = (_Float16)(d2 * i1); r2[i] = (_Float16)(d3 * i2); }
                    g3[i] = (_Float16)i3; }
                *(f16x4*)(gp) = r0; *(f16x4*)(gp + 1024) = r1; *(f16x4*)(gp + 2048) = r2; *(f16x4*)(gp + 3072) = g3; }
    }
};

struct EpiMerge {
    static constexpr bool PERM = true, MIDK = true;
    __device__ __forceinline__ void init(f32x4 (&acc)[2][2][4][2], const Unit&, int, int) const { acc_zero(acc); }
    const _Float16* G; bf16_t* O; bf16_t* Os;
    __device__ __forceinline__ void scale(f32x4 (&acc)[2][2][4][2], const Unit& u, int seg, int wr, int wc) const {
        const int lane_ = lane_now(), fr = lane_ & 15, fq = lane_ >> 4;
        const int row0 = u.pm * BM + wr * 64 + fr, c0 = 1024 * seg + 256 * u.pn + wc * 32 + 8 * fq;
#pragma unroll
        for (int ai = 0; ai < 2; ++ai)
#pragma unroll
            for (int m = 0; m < 4; ++m) { const _Float16* gp = G + (size_t)(row0 + ai * HALF + m * 16) * GC + c0;
#pragma unroll
                for (int bj = 0; bj < 2; ++bj) { const f16x8 f = *(const f16x8*)(gp + bj * HALF);
                    acc[ai][bj][m][0] *= (f32x4){(float)f[0], (float)f[1], (float)f[2], (float)f[3]}; acc[ai][bj][m][1] *= (f32x4){(float)f[4], (float)f[5], (float)f[6], (float)f[7]}; } }
    }
    __device__ __forceinline__ void midk(f32x4 (&acc)[2][2][4][2], const Unit& u, int seg, int wr, int wc, int, int) const { scale(acc, u, seg, wr, wc); }
    __device__ __forceinline__ void operator()(f32x4 (&acc)[2][2][4][2], const Unit& u, int wr, int wc, int, int) const {
        scale(acc, u, u.mode ? u.aux : 3, wr, wc);
        const int lane_ = lane_now(), fr = lane_ & 15, fq = lane_ >> 4;
        const int row0 = (u.mode ? (u.pm - 64) * BM + 512 * u.aux : u.pm * BM) + wr * 64 + fr, c0 = 256 * u.pn + wc * 32 + 8 * fq;
        bf16_t* O = u.mode ? Os : this->O;
#pragma unroll
        for (int ai = 0; ai < 2; ++ai)
#pragma unroll
            for (int m = 0; m < 4; ++m) { bf16_t* rowp = O + (size_t)(row0 + ai * HALF + m * 16) * DM + c0;
#pragma unroll
                for (int bj = 0; bj < 2; ++bj) { const f32x4 v0 = acc[ai][bj][m][0], v1 = acc[ai][bj][m][1];
                    u32x4 w; w.x = cvt_pk_bf16(v0[0], v0[1]); w.y = cvt_pk_bf16(v0[2], v0[3]); w.z = cvt_pk_bf16(v1[0], v1[1]); w.w = cvt_pk_bf16(v1[2], v1[3]); *(u32x4*)(rowp + bj * HALF) = w; } }
    }
};

struct PanelStats {
    unsigned* xbuf;
    unsigned* cnt;
    __device__ __forceinline__ void run(const f32x4 (&v)[2][2][4][2], const Unit& u, int wr, int wc, PG8_LAS unsigned char* lds, int wid) const {
        const int lane = lane_now(), fr = lane & 15, fq = lane >> 4;
        PG8_LAS f32x2* P = (PG8_LAS f32x2*)lds;
        PG8_LAS f32x2* S = (PG8_LAS f32x2*)(lds + 8192);
#pragma unroll
        for (int ai = 0; ai < 2; ++ai)
#pragma unroll
            for (int m = 0; m < 4; ++m) {
                float s = 0.f;
#pragma unroll
                for (int bj = 0; bj < 2; ++bj)
#pragma unroll
                    for (int n = 0; n < 2; ++n) { const f32x4 x = v[ai][bj][m][n]; s += (x[0] + x[1]) + (x[2] + x[3]); }
                s += __builtin_bit_cast(float, __builtin_amdgcn_ds_bpermute((lane ^ 16) << 2, __builtin_bit_cast(int, s))); s += __builtin_bit_cast(float, __builtin_amdgcn_ds_bpermute((lane ^ 32) << 2, __builtin_bit_cast(int, s)));
                const float mw = s * (1.0f / 64.0f); float q = 0.f;
#pragma unroll
                for (int bj = 0; bj < 2; ++bj)
#pragma unroll
                    for (int n = 0; n < 2; ++n) { const f32x4 d = v[ai][bj][m][n] - mw; q += (d[0] * d[0] + d[1] * d[1]) + (d[2] * d[2] + d[3] * d[3]); }
                q += __builtin_bit_cast(float, __builtin_amdgcn_ds_bpermute((lane ^ 16) << 2, __builtin_bit_cast(int, q))); q += __builtin_bit_cast(float, __builtin_amdgcn_ds_bpermute((lane ^ 32) << 2, __builtin_bit_cast(int, q)));
                if (fq == 0) P[(ai * HALF + wr * 64 + m * 16 + fr) * 4 + wc] = (f32x2){mw, q};
            }
        asm volatile("s_waitcnt lgkmcnt(0)" ::: "memory"); __builtin_amdgcn_s_barrier(); asm volatile("" ::: "memory");
        const int row = wid * 32 + (lane & 31);
        if (lane < 32) {
            const f32x2 a = P[row * 4 + 0], b = P[row * 4 + 1], c = P[row * 4 + 2], d = P[row * 4 + 3];
            const float mt = (a.x + b.x + c.x + d.x) * 0.25f;
            const float da = a.x - mt, db = b.x - mt, dc = c.x - mt, dd = d.x - mt;
            const float m2 = (a.y + b.y) + (c.y + d.y) + 64.0f * ((da * da + db * db) + (dc * dc + dd * dd));
            unsigned long long* slot = (unsigned long long*)xbuf + ((size_t)(u.pm * BM + row) * 4 + u.pn);
            __hip_atomic_store(slot, ((unsigned long long)__float_as_uint(m2) << 32) | __float_as_uint(mt), __ATOMIC_RELAXED, __HIP_MEMORY_SCOPE_AGENT);
        }
        asm volatile("s_waitcnt vmcnt(0)" ::: "memory");
        if (lane == 0) __hip_atomic_fetch_add(cnt + 64 * u.pm, 1u, __ATOMIC_RELAXED, __HIP_MEMORY_SCOPE_AGENT);
        if (wid == 0) {
            unsigned spins = 0;
            while ((unsigned)__builtin_amdgcn_readfirstlane(__hip_atomic_load(cnt + 64 * u.pm, __ATOMIC_RELAXED, __HIP_MEMORY_SCOPE_AGENT)) < 32u) { __builtin_amdgcn_s_sleep(2); if (++spins > (1u << 20)) break; }
            __builtin_amdgcn_fence(__ATOMIC_ACQUIRE, "agent");
        }
        asm volatile("s_waitcnt vmcnt(0) lgkmcnt(0)" ::: "memory"); __builtin_amdgcn_s_barrier(); asm volatile("" ::: "memory");
        if (lane < 32) {
            const unsigned long long* slot = (const unsigned long long*)xbuf + (size_t)(u.pm * BM + row) * 4; float mt[4], m2[4]; float ms = 0.f;
#pragma unroll
            for (int t = 0; t < 4; ++t) { const unsigned long long w = __hip_atomic_load(slot + t, __ATOMIC_RELAXED, __HIP_MEMORY_SCOPE_AGENT); mt[t] = __uint_as_float((unsigned)w); m2[t] = __uint_as_float((unsigned)(w >> 32)); ms += mt[t]; }
            const float mean = ms * 0.25f; float q = 0.f;
#pragma unroll
            for (int t = 0; t < 4; ++t) { const float dm = mt[t] - mean; q += m2[t] + 256.0f * dm * dm; }
            S[row] = (f32x2){mean, __builtin_amdgcn_rsqf(q * (1.0f / 1024.0f) + LN_EPS)};
        }
        asm volatile("s_waitcnt lgkmcnt(0)" ::: "memory"); __builtin_amdgcn_s_barrier(); asm volatile("" ::: "memory");
    }
};
struct EpiRes {
    static constexpr bool PERM = false, MIDK = false;
    __device__ __forceinline__ void init(f32x4 (&acc)[2][2][4][2], const Unit& u, int wr, int wc) const {
        if (u.mode) { acc_zero(acc); return; }
        const int lane_ = lane_now(), fr = lane_ & 15, fq = lane_ >> 4;
        const size_t e0 = (size_t)(u.pm * BM + wr * 64 + fr) * DM + 256 * u.pn + wc * 32 + 4 * fq;
        if (base16) {
#pragma unroll
            for (int ai = 0; ai < 2; ++ai)
#pragma unroll
                for (int m = 0; m < 4; ++m)
#pragma unroll
                    for (int bj = 0; bj < 2; ++bj)
#pragma unroll
                        for (int n = 0; n < 2; ++n) { const u32x2 w = *(const u32x2*)(base16 + e0 + (size_t)(ai * HALF + m * 16) * DM + bj * HALF + n * 16);
                            acc[ai][bj][m][n] = (f32x4){__uint_as_float(w.x << 16), __uint_as_float(w.x & 0xffff0000u), __uint_as_float(w.y << 16), __uint_as_float(w.y & 0xffff0000u)} * ALPHA; }
            return; }
#pragma unroll
        for (int ai = 0; ai < 2; ++ai)
#pragma unroll
            for (int m = 0; m < 4; ++m)
#pragma unroll
                for (int bj = 0; bj < 2; ++bj)
#pragma unroll
                    for (int n = 0; n < 2; ++n) acc[ai][bj][m][n] = *(const f32x4*)(baseP + e0 + (size_t)(ai * HALF + m * 16) * DM + bj * HALF + n * 16) * ALPHA;
    }
    const float* baseP; const bf16_t* base16; float* out; bf16_t* xb; const float* lng; const float* lnb; float* slab; PanelStats st; PG8_LAS unsigned char* xlds; int wid;
    __device__ __forceinline__ void midk(f32x4 (&)[2][2][4][2], const Unit&, int, int, int, int, int) const {}
    __device__ __forceinline__ void operator()(f32x4 (&acc)[2][2][4][2], const Unit& u, int wr, int wc, int fr_, int fq_) const {
        const int lane_ = lane_now(), fr = lane_ & 15, fq = lane_ >> 4; (void)fr_; (void)fq_;
        const int row0 = u.pm * BM + wr * 64 + fr, c0 = 256 * u.pn + wc * 32 + 4 * fq;
        if (u.mode) {
#pragma unroll
            for (int ai = 0; ai < 2; ++ai)
#pragma unroll
                for (int m = 0; m < 4; ++m) { float* op = slab + ((size_t)u.aux * 512 + (row0 - MP) + ai * HALF + m * 16) * DM + c0;
#pragma unroll
                    for (int bj = 0; bj < 2; ++bj)
#pragma unroll
                        for (int n = 0; n < 2; ++n) *(f32x4*)(op + bj * HALF + n * 16) = acc[ai][bj][m][n]; }
            return; }
        st.run(acc, u, wr, wc, xlds, wid);
        const PG8_LAS f32x2* S = (const PG8_LAS f32x2*)(xlds + 8192);
#pragma unroll
        for (int bj = 0; bj < 2; ++bj)
#pragma unroll
            for (int n = 0; n < 2; ++n) { const int cc = c0 + bj * HALF + n * 16; const f32x4 gv = *(const f32x4*)(lng + cc), bv = *(const f32x4*)(lnb + cc);
#pragma unroll
                for (int ai = 0; ai < 2; ++ai)
#pragma unroll
                    for (int m = 0; m < 4; ++m) { const int r = ai * HALF + wr * 64 + m * 16 + fr; const f32x2 sr = S[r]; const size_t off = (size_t)(u.pm * BM + r) * DM + cc;
                        const f32x4 o = (acc[ai][bj][m][n] - sr.x) * sr.y * gv + bv; if (out) *(f32x4*)(out + off) = o;
                        if (xb) { u32x2 w; w.x = cvt_pk_bf16(o[0], o[1]); w.y = cvt_pk_bf16(o[2], o[3]); *(u32x2*)(xb + off) = w; }
                        if (m & 1) asm volatile("" ::: "memory"); } }
    }
};

struct EpiSwi {
    static constexpr bool PERM = true, MIDK = false;
    __device__ __forceinline__ void init(f32x4 (&acc)[2][2][4][2], const Unit&, int, int) const { acc_zero(acc); }
    bf16_t* H;
    __device__ __forceinline__ void midk(f32x4 (&)[2][2][4][2], const Unit&, int, int, int, int, int) const {}
    __device__ __forceinline__ void operator()(f32x4 (&acc)[2][2][4][2], const Unit& u, int wr, int wc, int fr_, int fq_) const {
        const int lane_ = lane_now(), fr = lane_ & 15, fq = lane_ >> 4; (void)fr_; (void)fq_;
        const int row0 = u.pm * BM + wr * 64 + fr, c0 = 128 * u.pn + wc * 32 + 8 * fq;
#pragma unroll
        for (int ai = 0; ai < 2; ++ai)
#pragma unroll
            for (int m = 0; m < 4; ++m) { bf16_t* rowp = H + (size_t)(row0 + ai * HALF + m * 16) * FF + c0;
                const f32x4 g0 = acc[ai][0][m][0], g1 = acc[ai][0][m][1], u0 = acc[ai][1][m][0], u1 = acc[ai][1][m][1]; f32x4 v0, v1;
#pragma unroll
                for (int i = 0; i < 4; ++i) { v0[i] = g0[i] * sigmoidf_fast(g0[i]) * u0[i]; v1[i] = g1[i] * sigmoidf_fast(g1[i]) * u1[i]; }
                u32x4 w; w.x = cvt_pk_bf16(v0[0], v0[1]); w.y = cvt_pk_bf16(v0[2], v0[3]); w.z = cvt_pk_bf16(v1[0], v1[1]); w.w = cvt_pk_bf16(v1[2], v1[3]);
                *(u32x4*)rowp = w; }
    }
};

template <class Epi, class Sched, bool ALIGN_EPI>
__device__ __forceinline__ void gemm_phase(PG8_LAS unsigned char* lds, const Gemm g, const Sched& S, const Epi& E, int wave_id) {
    const int wid = opqs(wave_id), lane = lane_now(), tid = wid * 64 + lane, wr = wid >> 2, wc = wid & 3, fr = lane & 15, fq = lane >> 4;
    unsigned voffA[2], voffB[2];
#pragma unroll
    for (int i = 0; i < 2; ++i) { int R, C; stage_rc(tid * 16 + i * 8192, R, C); const int Rb = Epi::PERM ? ((R & ~31) + perm32(R & 31)) : R;
        voffA[i] = (unsigned)(R * g.lda + C) * 2u; voffB[i] = (unsigned)(Rb * g.ldb + C) * 2u; }
    const size_t kstep = (size_t)(BK * 2);
    const size_t hstepA = (size_t)HALF * g.lda * 2, hstepB = (size_t)HALF * g.ldb * 2;
    const unsigned ldsw = (unsigned)wid * 1024u;
    const int aoff = lds_byte(wr * 64 + fr, fq * 8), boff = lds_byte(wc * 32 + fr, fq * 8);
#define PG8_SA(b, h) (((b) * 2 + (h)) * HTB)
#define PG8_SB(b, h) ((4 + (b) * 2 + (h)) * HTB)
#define PG8_STAGE(bufoff, gbase, voff) do { _Pragma("unroll") for (int _i = 0; _i < 2; ++_i) \
        __builtin_amdgcn_global_load_lds((const unsigned*)((const char*)(gbase) + (voff)[_i]), (PG8_LAS unsigned*)(lds + (bufoff) + ldsw + _i * 8192), 16, 0, 0); } while (0)
#define PG8_LDA(dst, b, h) do { _Pragma("unroll") for (int m = 0; m < 4; ++m) _Pragma("unroll") for (int k = 0; k < 2; ++k) dst[m][k] = *(const PG8_LAS bf16x8*)(lds + PG8_SA(b, h) + aoff + m * 2048 + k * 1024); } while (0)
#define PG8_LDB(dst, b, h) do { _Pragma("unroll") for (int n = 0; n < 2; ++n) _Pragma("unroll") for (int k = 0; k < 2; ++k) dst[n][k] = *(const PG8_LAS bf16x8*)(lds + PG8_SB(b, h) + boff + n * 2048 + k * 1024); } while (0)
#define PG8_MMA(ai, bj, At, Bt) do { __builtin_amdgcn_s_setprio(1); _Pragma("unroll") for (int m = 0; m < 4; ++m) _Pragma("unroll") for (int n = 0; n < 2; ++n) _Pragma("unroll") for (int k = 0; k < 2; ++k) \
        acc[ai][bj][m][n] = __builtin_amdgcn_mfma_f32_16x16x32_bf16(Bt[n][k], At[m][k], acc[ai][bj][m][n], 0, 0, 0); __builtin_amdgcn_s_setprio(0); } while (0)
#define PG8_WAIT_V(n) asm volatile("s_waitcnt vmcnt(" #n ")" ::: "memory")
#define PG8_WAIT_L(n) asm volatile("s_waitcnt lgkmcnt(" #n ")" ::: "memory")
#define PG8_BAR __builtin_amdgcn_s_barrier()
#define PG8_SCHED __builtin_amdgcn_sched_barrier(0)
    Unit cur, nxt; int ui = 0;
    if (!S.next(0, cur, g)) return;
    f32x4 acc[2][2][4][2];
    E.init(acc, cur, wr, wc);
    bf16x8 At[4][2], B0[2][2], B1[2][2];
    const char* cA = (const char*)(cur.mode ? g.As : g.A) + cur.offA; const char* cB = (const char*)g.Bt + cur.offB;
    PG8_STAGE(PG8_SB(0, 0), cB, voffB); PG8_STAGE(PG8_SB(0, 1), cB + hstepB, voffB); PG8_STAGE(PG8_SA(0, 0), cA, voffA); PG8_STAGE(PG8_SA(0, 1), cA + hstepA, voffA);
    if (wr == 1) PG8_BAR;
    PG8_WAIT_V(2); PG8_BAR;
    PG8_STAGE(PG8_SB(1, 0), cB + kstep, voffB); PG8_STAGE(PG8_SA(1, 0), cA + kstep, voffA); PG8_STAGE(PG8_SB(1, 1), cB + hstepB + kstep, voffB);
    PG8_WAIT_V(6); PG8_BAR;
    for (;;) {
        const bool has_next = S.next(ui + 1, nxt, g);
        const char* nA = has_next ? (const char*)(nxt.mode ? g.As : g.A) + nxt.offA : cA; const char* nB = has_next ? (const char*)g.Bt + nxt.offB : cB;
        const int nt = cur.nt, TSEG = Epi::MIDK ? 8 : nt;
        for (int t0 = 0; t0 < nt; t0 += TSEG) {
        if constexpr (Epi::MIDK) { if (t0 != 0) { PG8_SCHED; E.midk(acc, cur, t0 / TSEG - 1, wr, wc, 0, 0); PG8_SCHED; } }
#pragma unroll 1
        for (int t = t0; t < t0 + TSEG; t += 2) {
            const bool last = (t == nt - 2);
            if (last && has_next) S.a_ready(nxt, wid);
            const char* a1 = cA + (size_t)(t + 1) * kstep;
            const char* a2 = last ? nA : cA + (size_t)(t + 2) * kstep; const char* b2 = last ? nB : cB + (size_t)(t + 2) * kstep;
            const char* a3 = a2 + kstep; const char* b3 = b2 + kstep;
            PG8_LDB(B0, 0, 0); PG8_LDB(B1, 0, 1); PG8_SCHED; PG8_LDA(At, 0, 0); PG8_STAGE(PG8_SA(1, 1), a1 + hstepA, voffA);
            PG8_WAIT_V(8); PG8_WAIT_L(0); PG8_BAR; PG8_MMA(0, 0, At, B0); PG8_MMA(0, 1, At, B1); PG8_BAR; PG8_SCHED;
            PG8_LDA(At, 0, 1); PG8_STAGE(PG8_SB(0, 0), b2, voffB); PG8_STAGE(PG8_SB(0, 1), b2 + hstepB, voffB); PG8_STAGE(PG8_SA(0, 0), a2, voffA);
            PG8_WAIT_V(8); PG8_WAIT_L(0); PG8_BAR; PG8_MMA(1, 0, At, B0); PG8_MMA(1, 1, At, B1); PG8_BAR; PG8_SCHED;
            PG8_LDB(B0, 1, 0); PG8_LDB(B1, 1, 1); PG8_SCHED; PG8_LDA(At, 1, 0); PG8_STAGE(PG8_SA(0, 1), a2 + hstepA, voffA);
            PG8_WAIT_V(8); PG8_WAIT_L(0); PG8_BAR; PG8_MMA(0, 0, At, B0); PG8_MMA(0, 1, At, B1); PG8_BAR; PG8_SCHED;
            PG8_LDA(At, 1, 1); PG8_STAGE(PG8_SB(1, 0), b3, voffB); PG8_STAGE(PG8_SB(1, 1), b3 + hstepB, voffB); PG8_STAGE(PG8_SA(1, 0), a3, voffA);
            PG8_WAIT_V(8); PG8_WAIT_L(0); PG8_BAR; PG8_MMA(1, 0, At, B0); PG8_MMA(1, 1, At, B1); PG8_BAR; PG8_SCHED;
        }
        }
        if constexpr (ALIGN_EPI) { if (wr == 0) PG8_BAR; }
        E(acc, cur, wr, wc, 0, 0);
        if (!has_next) break;
        cur = nxt; cA = nA; cB = nB; ++ui;
        E.init(acc, cur, wr, wc);
        if constexpr (ALIGN_EPI) { if (wr == 1) PG8_BAR; }
    }
    PG8_WAIT_V(0);
    if constexpr (!ALIGN_EPI) { if (wr == 0) PG8_BAR; }
    PG8_BAR;
#undef PG8_SA
#undef PG8_SB
#undef PG8_STAGE
#undef PG8_LDA
#undef PG8_LDB
#undef PG8_MMA
#undef PG8_WAIT_V
#undef PG8_WAIT_L
#undef PG8_BAR
#undef PG8_SCHED
}
}

constexpr int NWAVES = 8;
constexpr int NPHASE = 19;
constexpr size_t MiB = 1u << 20;
constexpr size_t WS_CTL = 0, CTL_ZERO_BYTES = 1 * MiB;
constexpr size_t WS_WA = 1 * MiB;
constexpr size_t WS_XB = 18 * MiB;
constexpr size_t WS_Y = 51 * MiB;
constexpr size_t WS_ZG = 117 * MiB;
constexpr size_t WS_BT3 = 249 * MiB, WS_BT4 = 253 * MiB, WS_BT5 = WS_WA, WS_BT6 = WS_ZG + 108 * MiB;
constexpr size_t WS_MB4S = WS_WA + 13 * MiB;
constexpr size_t WS_SLAB = WS_Y;
constexpr size_t WS_END = 255 * MiB;
static_assert(WS_XB + (size_t)M * DM * 2 <= WS_Y && WS_Y + (size_t)M * YC * 2 <= WS_ZG && WS_ZG + (size_t)M * GC * 2 <= WS_BT3 && WS_SLAB + (size_t)16 * 512 * DM * 4 <= WS_Y + 40 * MiB && WS_Y + 40 * MiB + 4 * 512 * 1024 <= WS_ZG, "ws map");
static_assert((size_t)M * FF * 2 <= 108 * MiB && WS_BT5 + (size_t)2 * FF * DM * 2 <= WS_MB4S && WS_MB4S + 4 * MiB <= WS_XB && WS_BT6 + (size_t)DM * FF * 2 <= WS_BT3, "ws map 2");
constexpr int CW_P0 = 65536;
constexpr int CW_RDY = 12288;
constexpr int CW_TMO = 0, CW_CODE = 1, CW_BAR = 4096, CW_SEAM = 16384, SEAM_BANK = 8192;
constexpr size_t WS_XCH = WS_Y + 40 * MiB;
constexpr int XLDS_OFF = 131072 + 1024;
constexpr int RING_OFF = 0, RING_BYTES = 131072;
constexpr int LDSCTL_OFF = RING_BYTES, MISC_OFF = LDSCTL_OFF + 320;
constexpr int LDS_BYTES = 147456;

#define GAS __attribute__((address_space(1)))
#define LAS __attribute__((address_space(3)))
typedef unsigned short bf16;
typedef unsigned v4u __attribute__((ext_vector_type(4)));
typedef unsigned v2u __attribute__((ext_vector_type(2)));
typedef float f32x4 __attribute__((ext_vector_type(4)));
typedef float f32x2 __attribute__((ext_vector_type(2)));
typedef short bf16x8 __attribute__((ext_vector_type(8)));
typedef GAS unsigned gu32;
#define RLX_AGENT __ATOMIC_RELAXED, __HIP_MEMORY_SCOPE_AGENT
#define LDS_WAIT() asm volatile("s_waitcnt lgkmcnt(0)" ::: "memory")
#define VM_WAIT() asm volatile("s_waitcnt vmcnt(0)" ::: "memory")
__device__ __forceinline__ unsigned pk2(float lo, float hi) { return pg8::cvt_pk_bf16(lo, hi); }
__device__ __forceinline__ float bflo(unsigned v) { return __uint_as_float(v << 16); }
__device__ __forceinline__ float bfhi(unsigned v) { return __uint_as_float(v & 0xffff0000u); }
__device__ __forceinline__ float bf1(unsigned short h) { return __uint_as_float((unsigned)h << 16); }
__device__ __forceinline__ unsigned short f2bf(float f) { return (unsigned short)(pg8::cvt_pk_bf16(f, 0.f) & 0xffffu); }

#define XB_TMO      128
#define XB_XCNT(j)  (256  + 64 * (j))
#define XB_XSUB(j)  (1280 + 64 * (j))
#define XB_XGEN(j)  (2304 + 64 * (j))
#define XB_TOP      3328
#define XB_TOPGEN   3392
#define XCD_BAR_WORDS 3456
#define XB_SPIN_CAP (1u << 18)
__device__ __forceinline__ unsigned xb_ld(unsigned* p)              { return __hip_atomic_load(p, __ATOMIC_RELAXED, __HIP_MEMORY_SCOPE_AGENT); }
__device__ __forceinline__ unsigned xb_add(unsigned* p, unsigned v) { return __hip_atomic_fetch_add(p, v, __ATOMIC_RELAXED, __HIP_MEMORY_SCOPE_AGENT); }
__device__ __forceinline__ unsigned xb_xcc_id() { return (unsigned)__builtin_amdgcn_s_getreg((3 << 11) | 20) & 0xFu; }
#define XB_SPIN(cond, bar) do { unsigned _sp = 0; while (cond) { __builtin_amdgcn_s_sleep(1); \
    if ((++_sp & 255u) == 0u) { if (xb_ld(&(bar)[XB_TMO])) break; if (_sp > XB_SPIN_CAP) { atomicAdd(&(bar)[XB_TMO], 1u); break; } } } } while (0)
struct XcdBarrier { unsigned* bar; unsigned x; volatile LAS unsigned* st; };
__device__ __forceinline__ XcdBarrier xcd_barrier_post(unsigned* bar, volatile LAS unsigned* st) {
    XcdBarrier b; b.bar = bar; b.x = xb_xcc_id(); b.st = st;
    if (threadIdx.x == 0) (void)xb_add(&bar[XB_XCNT(b.x)], 1u);
    return b;
}
__device__ __forceinline__ void xcd_barrier_complete(unsigned* bar, unsigned x, unsigned& nloc, unsigned& nx) {
    const unsigned G = gridDim.x * gridDim.y * gridDim.z;
    unsigned sum, cnt, mine, sp = 0u;
    for (;;) {
        sum = 0u; cnt = 0u; mine = 0u;
#pragma unroll
        for (unsigned j = 0; j < 16; ++j) { const unsigned c = xb_ld(&bar[XB_XCNT(j)]); sum += c; cnt += (c > 0u) ? 1u : 0u; mine = (j == x) ? c : mine; }
        if (sum == G) break;
        __builtin_amdgcn_s_sleep(1);
        if ((++sp & 255u) == 0u) { if (xb_ld(&bar[XB_TMO])) break; if (sp > XB_SPIN_CAP) { atomicAdd(&bar[XB_TMO], 1u); break; } }
    }
    nloc = mine > 0u ? mine : 1u; nx = cnt > 0u ? cnt : 1u;
}
__device__ __forceinline__ void xcd_barrier(const XcdBarrier& b) {
    asm volatile("s_waitcnt vmcnt(0)" ::: "memory");
    __syncthreads();
    if (threadIdx.x == 0) {
        unsigned* bar = b.bar;
        __builtin_amdgcn_s_waitcnt(0);
        unsigned nloc = b.st[0], nx = b.st[1];
        if (nloc == 0u) { xcd_barrier_complete(bar, b.x, nloc, nx); b.st[0] = nloc; b.st[1] = nx; }
        const unsigned old = xb_add(&bar[XB_XSUB(b.x)], 1u);
        const unsigned gen = old / nloc;
        if (old + 1u == (gen + 1u) * nloc) {
            __builtin_amdgcn_fence(__ATOMIC_RELEASE, "agent");
            asm volatile("s_waitcnt vmcnt(0)" ::: "memory");
            const unsigned og = xb_add(&bar[XB_TOP], 1u);
            const unsigned tg = og / nx;
            if (og + 1u == (tg + 1u) * nx) xb_add(&bar[XB_TOPGEN], 1u);
            else XB_SPIN(xb_ld(&bar[XB_TOPGEN]) == tg, bar);
            __builtin_amdgcn_fence(__ATOMIC_ACQUIRE, "agent");
            xb_add(&bar[XB_XGEN(b.x)], 1u);
            asm volatile("s_waitcnt vmcnt(0)" ::: "memory");
        } else {
            XB_SPIN(xb_ld(&bar[XB_XGEN(b.x)]) == gen, bar);
            __builtin_amdgcn_fence(__ATOMIC_ACQUIRE, "agent");
            asm volatile("s_waitcnt vmcnt(0)" ::: "memory");
        }
    }
    __syncthreads();
}

struct Frame {
    LAS unsigned char* lds;
    volatile LAS unsigned* MISC;
    gu32* ctl;
    int tid, lane, wave, G, bid;
    const float* const* in;
    float* out;
    unsigned char* ws;
};
enum { I_XP = 0, I_XS, I_SH, I_SRGC, I_SCF, I_SPOOL, I_SSC, I_WIN, I_RGCW, I_RGCB, I_RGWA, I_RGBA, I_RGWX, I_RGBX, I_LAM, I_CFW, I_CFB, I_CFG, I_CFBB, I_POOLW, I_POOLS, I_SCW,
       I_WBR, I_WOUT, I_LN1G, I_LN1B, I_WG, I_WU, I_WD, I_LN2G, I_LN2B };

__device__ __forceinline__ float shfl_idx(float v, int src_lane) { return __builtin_bit_cast(float, __builtin_amdgcn_ds_bpermute(src_lane << 2, __builtin_bit_cast(int, v))); }
__device__ __forceinline__ float wave_sum(float v, int lane) {
#pragma unroll
    for (int o = 1; o < 64; o <<= 1) v += shfl_idx(v, lane ^ o);
    return v;
}

enum { RM_ID = 0, RM_WIN = 1, RM_GU = 2 };
template <int MODE> __device__ __forceinline__ int rowmap(int s, int extra) {
    if (MODE == RM_ID) return s;
    if (MODE == RM_GU) return 256 * (s >> 7) + (s & 127) + extra;
    if (s < 1024) return s;
    if (s < 2048) { const int j = ((s - 1024) >> 7) & 3; return 1024 + 256 * j + (s >= 1536 ? 128 : 0) + (s & 127); }
    if (s < 3072) return s;
    if (s < 4096) { const int j = ((s - 3072) >> 7) & 3; return 3072 + 256 * j + (s >= 3584 ? 128 : 0) + (s & 127); }
    const int g = (s - 4096) >> 10, ch = s & 1023, pn = ch >> 6, chl = ch & 63, wc = chl >> 4, fq = (chl >> 2) & 3, i = chl & 3;
    return 4096 + 256 * pn + 128 * (g >> 1) + 32 * wc + 8 * fq + 4 * (g & 1) + i;
}
template <int MODE>
__device__ __forceinline__ void transpose_item(const float* W, int K, int N, bf16* WT, int dst_ld, int dst_koff, int extra, LAS float* scr, int item, int lane, int nb0, int nnb) {
    const int kb = item / nnb, nb = nb0 + item % nnb, k0 = 64 * kb, n0 = 32 * nb;
    { float tv[32];
      const float* wp = W + (size_t)(k0 + (lane >> 5)) * N + n0 + (lane & 31);
#pragma unroll
      for (int i = 0; i < 32; ++i) tv[i] = wp[(size_t)(2 * i) * N];
#pragma unroll
      for (int i = 0; i < 32; ++i) scr[(2 * i + (lane >> 5)) * 33 + (lane & 31)] = tv[i]; }
    LDS_WAIT(); asm volatile("" ::: "memory");
    const int c = lane & 7; const float sc = (MODE == RM_WIN && n0 >= 4096) ? -1.44269504089f : 1.0f;
#pragma unroll
    for (int j = 0; j < 4; ++j) { const int n = (lane >> 3) + 8 * j; const LAS float* s = scr + (8 * c) * 33 + n;
        v4u o; o.x = pk2(s[0 * 33] * sc, s[1 * 33] * sc); o.y = pk2(s[2 * 33] * sc, s[3 * 33] * sc); o.z = pk2(s[4 * 33] * sc, s[5 * 33] * sc); o.w = pk2(s[6 * 33] * sc, s[7 * 33] * sc);
        *(GAS v4u*)(WT + (size_t)rowmap<MODE>(n0 + n, extra) * dst_ld + dst_koff + k0 + 8 * c) = o; }
    LDS_WAIT(); asm volatile("" ::: "memory");
}
template <int MODE>
__device__ __forceinline__ void convert_matrix(Frame& F, const float* W, int K, int N, bf16* WT, int dst_ld, int dst_koff, int extra, int gw, int NGW, int first = 0, int nb0 = 0, int nnb = 0) {
    LAS float* scr = (LAS float*)(F.lds + RING_OFF + F.wave * 16384);
    if (nnb == 0) nnb = N / 32;
    const int nitems = (K / 64) * nnb;
    int it0 = gw - first; if (it0 < 0) it0 += ((-it0 + NGW - 1) / NGW) * NGW;
    for (int it = it0; it < nitems; it += NGW) transpose_item<MODE>(W, K, N, WT, dst_ld, dst_koff, extra, scr, it, F.lane, nb0, nnb);
}
__device__ __forceinline__ void compose_pool(Frame& F, int layer, bf16* Bt3, int gw, int NGW, int first = 0) {
    const float* pw = F.in[I_POOLW] + (size_t)layer * 4 * 128 * 128; const float* ps = F.in[I_POOLS] + layer * 512; const float* Wb2 = F.in[I_WBR] + ((size_t)layer * 4 + 2) * 512 * 1024;
    const int lane = F.lane;
    LAS float* Pl = (LAS float*)(F.lds + RING_OFF + F.wave * 16384);
    int id0 = gw - first; if (id0 < 0) id0 += ((-id0 + NGW - 1) / NGW) * NGW;
    for (int id = id0; id < 512; id += NGW) {
        const int g = __builtin_amdgcn_readfirstlane(id >> 7), c0 = __builtin_amdgcn_readfirstlane(8 * ((id >> 3) & 15)), d0 = 128 * (id & 7) + 2 * lane;
#pragma unroll
        for (int k = 0; k < 4; ++k) { const int idx4 = lane + 64 * k, i = idx4 >> 5, e4 = (idx4 & 31) * 4;
            const f32x4 pv = *(const GAS f32x4*)(pw + ((size_t)g * 128 + c0 + i) * 128 + e4), sv = *(const GAS f32x4*)(ps + 128 * g + e4);
            Pl[(e4 + 0) * 8 + i] = pv.x * sv.x; Pl[(e4 + 1) * 8 + i] = pv.y * sv.y; Pl[(e4 + 2) * 8 + i] = pv.z * sv.z; Pl[(e4 + 3) * 8 + i] = pv.w * sv.w; }
        LDS_WAIT(); asm volatile("" ::: "memory");
        f32x2 acc[8];
#pragma unroll
        for (int i = 0; i < 8; ++i) acc[i] = (f32x2){0.f, 0.f};
        const float* wrow = Wb2 + (size_t)(128 * g) * 1024 + d0;
#pragma unroll 1
        for (int e0 = 0; e0 < 128; e0 += 8) {
            f32x2 wv[8];
#pragma unroll
            for (int k = 0; k < 8; ++k) wv[k] = *(const GAS f32x2*)(wrow + (size_t)(e0 + k) * 1024);
#pragma unroll
            for (int k = 0; k < 8; ++k) { const f32x4 p0 = *(const LAS f32x4*)(Pl + (e0 + k) * 8), p1 = *(const LAS f32x4*)(Pl + (e0 + k) * 8 + 4);
#pragma unroll
                for (int i = 0; i < 4; ++i) { acc[i] += wv[k] * p0[i]; acc[4 + i] += wv[k] * p1[i]; } }
        }
        v4u o0, o1;
        o0.x = pk2(acc[0].x, acc[1].x); o0.y = pk2(acc[2].x, acc[3].x); o0.z = pk2(acc[4].x, acc[5].x); o0.w = pk2(acc[6].x, acc[7].x);
        o1.x = pk2(acc[0].y, acc[1].y); o1.y = pk2(acc[2].y, acc[3].y); o1.z = pk2(acc[4].y, acc[5].y); o1.w = pk2(acc[6].y, acc[7].y);
        *(GAS v4u*)(Bt3 + (size_t)d0 * 2048 + 1024 + 128 * g + c0) = o0; *(GAS v4u*)(Bt3 + (size_t)(d0 + 1) * 2048 + 1024 + 128 * g + c0) = o1;
        LDS_WAIT(); asm volatile("" ::: "memory");
    }
}

__device__ __forceinline__ const float* xrow_in(Frame& F, int m) { return m < MP ? F.in[I_XP] + (size_t)m * DM : F.in[I_XS] + (size_t)(m - MP) * DM; }
template <int NR>
__device__ __forceinline__ void x_rows(Frame& F, bf16* XB, int m0) {
    f32x4 v[NR][4];
#pragma unroll
    for (int k = 0; k < NR; ++k) { const GAS f32x4* xr = (const GAS f32x4*)xrow_in(F, m0 + k) + F.lane;
#pragma unroll
        for (int j = 0; j < 4; ++j) v[k][j] = xr[64 * j]; }
#pragma unroll
    for (int k = 0; k < NR; ++k) { GAS v2u* o = (GAS v2u*)(XB + (size_t)(m0 + k) * DM) + F.lane;
#pragma unroll
        for (int j = 0; j < 4; ++j) o[64 * j] = (v2u){pk2(v[k][j].x, v[k][j].y), pk2(v[k][j].z, v[k][j].w)}; }
}
__device__ __forceinline__ void x_to_bf16(Frame& F, bf16* XB, gu32* ctr) {
    const int gw = F.bid * NWAVES + F.wave, NGW = F.G * NWAVES;
    if (F.G != 256) { for (int m0 = 4 * gw; m0 < M; m0 += 4 * NGW) x_rows<4>(F, XB, m0); return; }
    unsigned claim = 0;
    if (F.tid == 0) claim = __hip_atomic_fetch_add((unsigned*)ctr, 1u, __ATOMIC_RELAXED, __HIP_MEMORY_SCOPE_AGENT);
    x_rows<4>(F, XB, 4 * gw);
    for (int it = 0;; ++it) {
        volatile LAS unsigned* slot = F.MISC + 32 + (it & 1);
        if (F.tid == 0) *slot = claim;
        __syncthreads();
        const int c = __builtin_amdgcn_readfirstlane((int)*slot);
        if (c >= (M - 8192) / 16) break;
        if (F.tid == 0) claim = __hip_atomic_fetch_add((unsigned*)ctr, 1u, __ATOMIC_RELAXED, __HIP_MEMORY_SCOPE_AGENT);
        x_rows<2>(F, XB, 8192 + 16 * c + 2 * F.wave);
    }
}
__device__ __forceinline__ void ln_rows(Frame& F, const float* V, float* O, const float* g, const float* b, bf16* XB, const float* sbase, const float* slab, int nslab, int wg0 = 0) {
    const int gw = ((F.bid - wg0 + F.G) % F.G) * NWAVES + F.wave, NGW = F.G * NWAVES;
    f32x4 gv[4], bv[4];
#pragma unroll
    for (int j = 0; j < 4; ++j) { gv[j] = ((const GAS f32x4*)g)[F.lane + 64 * j]; bv[j] = ((const GAS f32x4*)b)[F.lane + 64 * j]; }
    for (int m = MP + gw; m < M; m += NGW) {
        const GAS f32x4* xr = (const GAS f32x4*)(V + (size_t)m * DM) + F.lane; GAS f32x4* orow = (GAS f32x4*)(O + (size_t)m * DM) + F.lane;
        f32x4 v[4]; float s = 0.f;
#pragma unroll
        for (int j = 0; j < 4; ++j) v[j] = xr[64 * j];
        if (m >= MP) { const GAS f32x4* br = (const GAS f32x4*)(sbase + (size_t)(m - MP) * DM) + F.lane;
#pragma unroll
            for (int j = 0; j < 4; ++j) v[j] = br[64 * j] * ALPHA;
            for (int sl = 0; sl < nslab; sl += 4) {
                f32x4 t[4][4];
#pragma unroll
                for (int k = 0; k < 4; ++k) { const GAS f32x4* sr = (const GAS f32x4*)(slab + ((size_t)(sl + k < nslab ? sl + k : sl) * 512 + (m - MP)) * DM) + F.lane;
#pragma unroll
                    for (int j = 0; j < 4; ++j) t[k][j] = sr[64 * j]; }
#pragma unroll
                for (int k = 0; k < 4; ++k) if (sl + k < nslab) {
#pragma unroll
                    for (int j = 0; j < 4; ++j) v[j] += t[k][j]; } } }
#pragma unroll
        for (int j = 0; j < 4; ++j) s += (v[j].x + v[j].y) + (v[j].z + v[j].w);
        const float mean = wave_sum(s, F.lane) * (1.f / DM); float s2 = 0.f;
#pragma unroll
        for (int j = 0; j < 4; ++j) { v[j] = v[j] - mean; s2 += (v[j].x * v[j].x + v[j].y * v[j].y) + (v[j].z * v[j].z + v[j].w * v[j].w); }
        const float rstd = __builtin_amdgcn_rsqf(wave_sum(s2, F.lane) * (1.f / DM) + LN_EPS);
#pragma unroll
        for (int j = 0; j < 4; ++j) { v[j] = v[j] * rstd * gv[j] + bv[j]; orow[64 * j] = v[j]; }
        if (XB) { GAS v2u* o = (GAS v2u*)(XB + (size_t)m * DM) + F.lane;
#pragma unroll
            for (int j = 0; j < 4; ++j) o[64 * j] = (v2u){pk2(v[j].x, v[j].y), pk2(v[j].z, v[j].w)}; }
    }
}

__device__ __forceinline__ void publish_ready(Frame& F, gu32* ctr) {
    VM_WAIT(); __syncthreads();
    if (F.tid == 0) { __builtin_amdgcn_fence(__ATOMIC_RELEASE, "agent"); asm volatile("s_waitcnt vmcnt(0)" ::: "memory"); __hip_atomic_fetch_add((unsigned*)ctr, 1u, __ATOMIC_RELAXED, __HIP_MEMORY_SCOPE_AGENT); }
}
__device__ __forceinline__ void wait_ready(Frame& F, gu32* ctr, unsigned need) {
    if (F.wave == 0) { unsigned spins = 0;
        while ((unsigned)__builtin_amdgcn_readfirstlane(__hip_atomic_load((unsigned*)ctr, __ATOMIC_RELAXED, __HIP_MEMORY_SCOPE_AGENT)) < need) { __builtin_amdgcn_s_sleep(2); if (++spins > (1u << 20)) break; }
        __builtin_amdgcn_fence(__ATOMIC_ACQUIRE, "agent"); asm volatile("s_waitcnt vmcnt(0)" ::: "memory"); }
    __syncthreads();
}
__device__ __forceinline__ float softplusf_acc(float x) { return fmaxf(x, 0.f) + log1pf(__expf(-fabsf(x))); }
__device__ __forceinline__ float expm1_neg(float x) {
    const float p = x * (1.f + x * (0.5f + x * (1.f / 6.f + x * (1.f / 24.f + x * (1.f / 120.f + x * (1.f / 720.f + x * (1.f / 5040.f)))))));
    return x > -0.25f ? p : __expf(x) - 1.f;
}
constexpr int PATCH_STRIDE = 144;

struct ALane {
    float cwD[4], cbD, ba, bx, ck;
    bf16x8 Ba[4][2], Bx[4][2];
};
constexpr int PATCH_BYTES = 5120, ASLOT_OFF = 8 * PATCH_BYTES;
__device__ __forceinline__ void a_setup(Frame& F, int layer, int n, int q, ALane& L) {
    const int c = F.lane & 15, kg = F.lane >> 4, och = 64 * n + 16 * q + c;
    const float* cw = F.in[I_RGCW] + (size_t)layer * 4 * 512 + 64 * n; const float* cb = F.in[I_RGCB] + layer * 512 + 64 * n;
#pragma unroll
    for (int j = 0; j < 4; ++j) L.cwD[j] = cw[j * 512 + 16 * q + c];
    L.cbD = cb[16 * q + c];
    L.ck = 8.0f * softplusf_acc(-F.in[I_LAM][layer * 512 + och]);
    const float* wa = F.in[I_RGWA] + ((size_t)layer * 8 + n) * 4096 + 16 * q + c; const float* wx = F.in[I_RGWX] + ((size_t)layer * 8 + n) * 4096 + 16 * q + c;
    float wav[16], wxv[16], cbv[16];
#pragma unroll
    for (int e = 0; e < 16; ++e) { const int k = (e < 8 ? 8 * kg + e : 32 + 8 * kg + (e - 8)); wav[e] = wa[k * 64]; wxv[e] = wx[k * 64]; cbv[e] = cb[k]; }
#pragma unroll
    for (int j = 0; j < 4; ++j) { float t[16];
#pragma unroll
        for (int e = 0; e < 16; ++e) t[e] = cw[j * 512 + (e < 8 ? 8 * kg + e : 32 + 8 * kg + (e - 8))];
        L.Ba[j][0] = __builtin_bit_cast(bf16x8, (v4u){pk2(wav[0] * t[0], wav[1] * t[1]), pk2(wav[2] * t[2], wav[3] * t[3]), pk2(wav[4] * t[4], wav[5] * t[5]), pk2(wav[6] * t[6], wav[7] * t[7])});
        L.Ba[j][1] = __builtin_bit_cast(bf16x8, (v4u){pk2(wav[8] * t[8], wav[9] * t[9]), pk2(wav[10] * t[10], wav[11] * t[11]), pk2(wav[12] * t[12], wav[13] * t[13]), pk2(wav[14] * t[14], wav[15] * t[15])});
        L.Bx[j][0] = __builtin_bit_cast(bf16x8, (v4u){pk2(wxv[0] * t[0], wxv[1] * t[1]), pk2(wxv[2] * t[2], wxv[3] * t[3]), pk2(wxv[4] * t[4], wxv[5] * t[5]), pk2(wxv[6] * t[6], wxv[7] * t[7])});
        L.Bx[j][1] = __builtin_bit_cast(bf16x8, (v4u){pk2(wxv[8] * t[8], wxv[9] * t[9]), pk2(wxv[10] * t[10], wxv[11] * t[11]), pk2(wxv[12] * t[12], wxv[13] * t[13]), pk2(wxv[14] * t[14], wxv[15] * t[15])}); }
    float sa = 0.f, sx = 0.f;
#pragma unroll
    for (int e = 0; e < 16; ++e) { sa = fmaf(cbv[e], wav[e], sa); sx = fmaf(cbv[e], wxv[e], sx); }
    sa += shfl_idx(sa, F.lane ^ 16); sa += shfl_idx(sa, F.lane ^ 32); sx += shfl_idx(sx, F.lane ^ 16); sx += shfl_idx(sx, F.lane ^ 32);
    L.ba = F.in[I_RGBA][layer * 512 + och] + sa; L.bx = F.in[I_RGBX][layer * 512 + och] + sx;
}
__device__ __forceinline__ void a_block(const ALane& L, const LAS unsigned char* patch, int rowA0, int baseD, int q, int lane, float (&a)[4], float (&bb)[4]) {
    const int c = lane & 15, kg = lane >> 4;
    f32x4 accR = (f32x4){0.f, 0.f, 0.f, 0.f}, accI = (f32x4){0.f, 0.f, 0.f, 0.f};
#pragma unroll
    for (int j = 0; j < 4; ++j) { const LAS unsigned char* rp = patch + (rowA0 + j) * PATCH_STRIDE + 16 * kg;
        const bf16x8 A0 = *(const LAS bf16x8*)rp, A1 = *(const LAS bf16x8*)(rp + 64);
        accR = __builtin_amdgcn_mfma_f32_16x16x32_bf16(A0, L.Ba[j][0], accR, 0, 0, 0); accR = __builtin_amdgcn_mfma_f32_16x16x32_bf16(A1, L.Ba[j][1], accR, 0, 0, 0);
        accI = __builtin_amdgcn_mfma_f32_16x16x32_bf16(A0, L.Bx[j][0], accI, 0, 0, 0); accI = __builtin_amdgcn_mfma_f32_16x16x32_bf16(A1, L.Bx[j][1], accI, 0, 0, 0); }
    float pv[7];
#pragma unroll
    for (int k = 0; k < 7; ++k) pv[k] = bf1(*(const LAS unsigned short*)(patch + (baseD + k) * PATCH_STRIDE + 2 * (16 * q + c)));
#pragma unroll
    for (int r = 0; r < 4; ++r) {
        const float xd = L.cbD + L.cwD[0] * pv[r] + L.cwD[1] * pv[r + 1] + L.cwD[2] * pv[r + 2] + L.cwD[3] * pv[r + 3];
        const float rr = pg8::sigmoidf_fast(accR[r] + L.ba), ii = pg8::sigmoidf_fast(accI[r] + L.bx);
        const float la = -L.ck * rr;
        const float av = __builtin_amdgcn_exp2f(1.44269504089f * la);
        a[r] = av; bb[r] = __builtin_amdgcn_sqrtf(fmaxf(1.f - av * av, 0.f)) * (ii * xd);
    }
}
struct BlkScan { float Ac[4], Bc[4], EA, EB, WA, WB; };
__device__ __forceinline__ void blk_scan(const float (&a)[4], const float (&bb)[4], int lane, BlkScan& S) {
    const int c = lane & 15, g = lane >> 4;
    S.Ac[0] = a[0]; S.Bc[0] = bb[0];
#pragma unroll
    for (int r = 1; r < 4; ++r) { S.Ac[r] = a[r] * S.Ac[r - 1]; S.Bc[r] = a[r] * S.Bc[r - 1] + bb[r]; }
    float IA = S.Ac[3], IB = S.Bc[3];
    { const float pa = shfl_idx(IA, lane - 16), pb = shfl_idx(IB, lane - 16); if (g >= 1) { IB = IA * pb + IB; IA = IA * pa; } }
    { const float pa = shfl_idx(IA, lane - 32), pb = shfl_idx(IB, lane - 32); if (g >= 2) { IB = IA * pb + IB; IA = IA * pa; } }
    S.EA = shfl_idx(IA, lane - 16); S.EB = shfl_idx(IB, lane - 16); if (g == 0) { S.EA = 1.f; S.EB = 0.f; }
    S.WA = shfl_idx(IA, 48 + c); S.WB = shfl_idx(IB, 48 + c);
}
__device__ __forceinline__ void a_prompt_item(Frame& F, int layer, int item, const bf16* Z, bf16* Y) {
    const int b = item >> 5, n = (item >> 2) & 7, q = item & 3, lane = opqv(F.lane), w = F.wave, c = lane & 15, g = lane >> 4, och = 64 * n + 16 * q + c;
    ALane L; a_setup(F, layer, n, q, L);
    LAS unsigned char* patch = F.lds + RING_OFF + w * PATCH_BYTES;
    LAS f32x2* slots = (LAS f32x2*)(F.lds + RING_OFF + ASLOT_OFF);
    const bf16* Zb = Z + (size_t)b * SEQ * ZC; bf16* Yb = Y + (size_t)b * SEQ * YC;
    float hrun = 0.f;
    v4u pf[5];
    auto load_patch = [&](int tb) {
#pragma unroll
        for (int k = 0; k < 5; ++k) { const int ci = lane + 64 * k, pr = ci >> 3, cc = ci & 7, t = tb - 3 + pr;
            pf[k] = (ci < 280 && t >= 0) ? *(const GAS v4u*)(Zb + (size_t)t * ZC + 64 * n + 8 * cc) : (v4u){0u, 0u, 0u, 0u}; }
    };
    load_patch(32 * w);
    for (int it = 0; it < 8; ++it) {
        const int tb = 256 * it + 32 * w;
#pragma unroll
        for (int k = 0; k < 5; ++k) { const int ci = lane + 64 * k, pr = ci >> 3, cc = ci & 7; if (ci < 280) *(LAS v4u*)(patch + pr * PATCH_STRIDE + 16 * cc) = pf[k]; }
        if (it < 7) load_patch(tb + 256);
        unsigned short gav[8];
#pragma unroll
        for (int r = 0; r < 8; ++r) gav[r] = ((const GAS unsigned short*)Zb)[(unsigned)((tb + 16 * (r >> 2) + 4 * g + (r & 3)) * ZC + 512 + och)];
        asm volatile("" ::: "memory");
        float a0[4], b0[4], a1[4], b1[4];
        a_block(L, patch, lane & 15, 4 * g, q, lane, a0, b0);
        a_block(L, patch, 16 + (lane & 15), 16 + 4 * g, q, lane, a1, b1);
        BlkScan S0, S1; blk_scan(a0, b0, lane, S0); blk_scan(a1, b1, lane, S1);
        if (lane < 16) slots[((it & 1) * 8 + w) * 16 + c] = (f32x2){S0.WA * S1.WA, S1.WA * S0.WB + S1.WB};
        __syncthreads();
        float hin = hrun, hw = 0.f;
#pragma unroll
        for (int ww = 0; ww < 8; ++ww) { const f32x2 s = slots[((it & 1) * 8 + ww) * 16 + c]; if (ww == w) hw = hin; hin = s.x * hin + s.y; }
        hrun = hin;
        const float hg0 = S0.EA * hw + S0.EB, hw1 = S0.WA * hw + S0.WB, hg1 = S1.EA * hw1 + S1.EB;
#pragma unroll
        for (int r = 0; r < 4; ++r) { const float h = S0.Ac[r] * hg0 + S0.Bc[r];
            ((GAS unsigned short*)Yb)[(unsigned)((tb + 4 * g + r) * YC + och)] = f2bf(h * bf1(gav[r])); }
#pragma unroll
        for (int r = 0; r < 4; ++r) { const float h = S1.Ac[r] * hg1 + S1.Bc[r];
            ((GAS unsigned short*)Yb)[(unsigned)((tb + 16 + 4 * g + r) * YC + och)] = f2bf(h * bf1(gav[4 + r]));
            if (r == 3 && it == 7 && w == 7 && g == 3) F.out[O_PH + (size_t)(layer * 8 + b) * 512 + och] = h; }
    }
}
__device__ __forceinline__ void a_sample_task(Frame& F, int layer, int task, const bf16* Z, bf16* Y) {
    const int blk = task >> 5, n = (task >> 2) & 7, q = task & 3, lane = opqv(F.lane), c = lane & 15, g = lane >> 4, och = 64 * n + 16 * q + c, s0 = 4 * blk;
    ALane L; a_setup(F, layer, n, q, L);
    LAS unsigned char* patch = F.lds + RING_OFF + F.wave * PATCH_BYTES;
#pragma unroll
    for (int k = 0; k < 4; ++k) { const int ci = lane + 64 * k; if (ci < 224) { const int pr = ci >> 3, cc = ci & 7, sq = pr / 7, tau = pr - 7 * sq - 3, seq = s0 + sq; v4u v;
            if (tau < 0) { const GAS f32x4* sp = (const GAS f32x4*)(F.in[I_SRGC] + ((size_t)(layer * 128 + seq) * 3 + (tau + 3)) * 512 + 64 * n + 8 * cc); const f32x4 f0 = sp[0], f1 = sp[1];
                v = (v4u){pk2(f0.x, f0.y), pk2(f0.z, f0.w), pk2(f1.x, f1.y), pk2(f1.z, f1.w)}; }
            else v = *(const GAS v4u*)(Z + (size_t)(MP + 4 * seq + tau) * ZC + 64 * n + 8 * cc);
            *(LAS v4u*)(patch + pr * PATCH_STRIDE + 16 * cc) = v; } }
    asm volatile("" ::: "memory");
    float a[4], bb[4];
    a_block(L, patch, 7 * ((lane & 15) >> 2) + (lane & 3), 7 * g, q, lane, a, bb);
    const int seq = s0 + g;
    float h = F.in[I_SH][(size_t)(layer * 128 + seq) * 512 + och];
#pragma unroll
    for (int r = 0; r < 4; ++r) { h = a[r] * h + bb[r]; const size_t row = (size_t)(MP + 4 * seq + r);
        *(GAS unsigned short*)(Y + row * YC + och) = f2bf(h * bf1(*(const GAS unsigned short*)(Z + row * ZC + 512 + och))); }
    F.out[O_SH + (size_t)(layer * 128 + seq) * 512 + och] = h;
}

__device__ __forceinline__ void ln_silu_row(const LAS float* xr, const float* g, const float* b, bf16* dst, int lane) {
    const f32x4 v0 = *(const LAS f32x4*)(xr + 4 * lane), v1 = *(const LAS f32x4*)(xr + 256 + 4 * lane);
    const float s = (v0.x + v0.y) + (v0.z + v0.w) + (v1.x + v1.y) + (v1.z + v1.w);
    const float mean = wave_sum(s, lane) * (1.f / 512.f);
    const f32x4 d0 = v0 - mean, d1 = v1 - mean;
    const float s2 = (d0.x * d0.x + d0.y * d0.y) + (d0.z * d0.z + d0.w * d0.w) + (d1.x * d1.x + d1.y * d1.y) + (d1.z * d1.z + d1.w * d1.w);
    const float rstd = __builtin_amdgcn_rsqf(wave_sum(s2, lane) * (1.f / 512.f) + LN_EPS);
    const f32x4 g0 = *(const GAS f32x4*)(g + 4 * lane), g1 = *(const GAS f32x4*)(g + 256 + 4 * lane), b0 = *(const GAS f32x4*)(b + 4 * lane), b1 = *(const GAS f32x4*)(b + 256 + 4 * lane);
    f32x4 y0 = d0 * rstd * g0 + b0, y1 = d1 * rstd * g1 + b1;
#pragma unroll
    for (int i = 0; i < 4; ++i) { y0[i] = y0[i] * pg8::sigmoidf_fast(y0[i]); y1[i] = y1[i] * pg8::sigmoidf_fast(y1[i]); }
    *(GAS v2u*)(dst + 4 * lane) = (v2u){pk2(y0.x, y0.y), pk2(y0.z, y0.w)}; *(GAS v2u*)(dst + 256 + 4 * lane) = (v2u){pk2(y1.x, y1.y), pk2(y1.z, y1.w)};
}
__device__ __forceinline__ void ln_silu_rows4(const LAS float* xr, int rstride, const float* g, const float* b, bf16* dst, size_t dstride, int lane) {
    f32x4 v0[4], v1[4]; float s[4], s2[4];
#pragma unroll
    for (int k = 0; k < 4; ++k) { v0[k] = *(const LAS f32x4*)(xr + k * rstride + 4 * lane); v1[k] = *(const LAS f32x4*)(xr + k * rstride + 256 + 4 * lane);
        s[k] = (v0[k].x + v0[k].y) + (v0[k].z + v0[k].w) + (v1[k].x + v1[k].y) + (v1[k].z + v1[k].w); }
#pragma unroll
    for (int o = 1; o < 64; o <<= 1) {
#pragma unroll
        for (int k = 0; k < 4; ++k) s[k] += shfl_idx(s[k], lane ^ o); }
#pragma unroll
    for (int k = 0; k < 4; ++k) { const float mean = s[k] * (1.f / 512.f); v0[k] = v0[k] - mean; v1[k] = v1[k] - mean;
        s2[k] = (v0[k].x * v0[k].x + v0[k].y * v0[k].y) + (v0[k].z * v0[k].z + v0[k].w * v0[k].w) + (v1[k].x * v1[k].x + v1[k].y * v1[k].y) + (v1[k].z * v1[k].z + v1[k].w * v1[k].w); }
#pragma unroll
    for (int o = 1; o < 64; o <<= 1) {
#pragma unroll
        for (int k = 0; k < 4; ++k) s2[k] += shfl_idx(s2[k], lane ^ o); }
    const f32x4 g0 = *(const GAS f32x4*)(g + 4 * lane), g1 = *(const GAS f32x4*)(g + 256 + 4 * lane), b0 = *(const GAS f32x4*)(b + 4 * lane), b1 = *(const GAS f32x4*)(b + 256 + 4 * lane);
#pragma unroll
    for (int k = 0; k < 4; ++k) { const float rstd = __builtin_amdgcn_rsqf(s2[k] * (1.f / 512.f) + LN_EPS);
        f32x4 y0 = v0[k] * rstd * g0 + b0, y1 = v1[k] * rstd * g1 + b1;
#pragma unroll
        for (int i = 0; i < 4; ++i) { y0[i] = y0[i] * pg8::sigmoidf_fast(y0[i]); y1[i] = y1[i] * pg8::sigmoidf_fast(y1[i]); }
        bf16* d = dst + (size_t)k * dstride;
        *(GAS v2u*)(d + 4 * lane) = (v2u){pk2(y0.x, y0.y), pk2(y0.z, y0.w)}; *(GAS v2u*)(d + 256 + 4 * lane) = (v2u){pk2(y1.x, y1.y), pk2(y1.z, y1.w)}; }
}
__device__ __forceinline__ void b_prompt_item(Frame& F, int layer, int item, const bf16* Z, bf16* Y) {
    const int tidl = opqv(F.tid), b = item >> 5, t0 = 64 * (item & 31), p = tidl & 255, hh = tidl >> 8, ts = t0 + 32 * hh;
    const GAS unsigned* Zu = (const GAS unsigned*)(Z + (size_t)b * SEQ * ZC) + 512 + p;
    unsigned raw[62];
#pragma unroll
    for (int i = 0; i < 62; ++i) { const int t = ts - 30 + i; raw[i] = t >= 0 ? Zu[(size_t)t * (ZC / 2)] : 0u; }
    const float* cw = F.in[I_CFW] + (size_t)layer * 31 * 512 + 2 * p;
    f32x2 wj[31];
#pragma unroll
    for (int j = 0; j < 31; ++j) wj[j] = *(const GAS f32x2*)(cw + j * 512);
    const f32x2 bias = *(const GAS f32x2*)(F.in[I_CFB] + layer * 512 + 2 * p);
    f32x2 in[62];
#pragma unroll
    for (int i = 0; i < 62; ++i) in[i] = (f32x2){bflo(raw[i]), bfhi(raw[i])};
    LAS float* obuf = (LAS float*)(F.lds + RING_OFF);
#pragma unroll
    for (int i = 0; i < 32; ++i) { f32x2 o = bias;
#pragma unroll
        for (int j = 0; j < 31; ++j) o += wj[j] * in[i + j];
        *(LAS f32x2*)(obuf + (32 * hh + i) * 512 + 2 * p) = o; }
    __syncthreads();
    const float* lg = F.in[I_CFG] + layer * 512; const float* lb = F.in[I_CFBB] + layer * 512;
#pragma unroll 1
    for (int r = 8 * F.wave; r < 8 * F.wave + 8; r += 4) ln_silu_rows4(obuf + r * 512, 512, lg, lb, Y + (size_t)(b * SEQ + t0 + r) * YC + 512, YC, F.lane);
}
__device__ __forceinline__ void cd_prompt_item(Frame& F, int layer, int item, const bf16* Z, bf16* Y) {
    const int tidl = opqv(F.tid), b = item >> 5, t0 = 64 * (item & 31), p = tidl & 255, hh = tidl >> 8;
    const bf16* Zb = Z + (size_t)b * SEQ * ZC;
    LAS unsigned* cbuf = (LAS unsigned*)(F.lds + RING_OFF);
    { v4u tmp[10];
#pragma unroll
      for (int k = 0; k < 10; ++k) { const int ci = tidl + 512 * k, pr = ci >> 6, cc = ci & 63, t = t0 - 15 + pr;
          tmp[k] = (ci < 79 * 64 && t >= 0) ? *(const GAS v4u*)(Zb + (size_t)t * ZC + 1536 + 8 * cc) : (v4u){0u, 0u, 0u, 0u}; }
#pragma unroll
      for (int k = 0; k < 10; ++k) { const int ci = tidl + 512 * k, pr = ci >> 6, cc = ci & 63; if (ci < 79 * 64) *(LAS v4u*)(cbuf + pr * 256 + 4 * cc) = tmp[k]; } }
    const int ts = t0 + 32 * hh;
    unsigned uu[34], dd[32];
#pragma unroll
    for (int i = 0; i < 34; ++i) { const int t = ts - 2 + i; uu[i] = t >= 0 ? ((const GAS unsigned*)(Zb + (size_t)t * ZC))[1280 + p] : 0u; }
#pragma unroll
    for (int i = 0; i < 32; ++i) dd[i] = ((const GAS unsigned*)(Zb + (size_t)(ts + i) * ZC))[1024 + p];
    const f32x2 w0 = ((const GAS f32x2*)(F.in[I_SCW] + (size_t)(layer * 3 + 0) * 512))[p], w1 = ((const GAS f32x2*)(F.in[I_SCW] + (size_t)(layer * 3 + 1) * 512))[p],
                w2 = ((const GAS f32x2*)(F.in[I_SCW] + (size_t)(layer * 3 + 2) * 512))[p];
    __syncthreads();
    const int w = 2 << (p >> 6), rr0 = 15 + 32 * hh;
    f32x2 s = (f32x2){0.f, 0.f};
    for (int j = 0; j < w; ++j) { const unsigned v = cbuf[(rr0 - j) * 256 + p]; s += (f32x2){bflo(v), bfhi(v)}; }
    GAS unsigned* Yu = (GAS unsigned*)(Y + (size_t)(b * SEQ + ts) * YC) + p;
#pragma unroll
    for (int i = 0; i < 32; ++i) { const int t = ts + i, rr = rr0 + i;
        const unsigned cur = cbuf[rr * 256 + p]; const f32x2 cf = (f32x2){bflo(cur), bfhi(cur)};
        if (i > 0) { const unsigned old = cbuf[(rr - w) * 256 + p]; s += cf - (f32x2){bflo(old), bfhi(old)}; }
        const float ic = __builtin_amdgcn_rcpf((float)(t + 1 < w ? t + 1 : w));
        const f32x2 mm = s * ic - cf;
        Yu[(size_t)i * 1024 + 512] = pk2(mm.x, mm.y);
        const f32x2 cv = w0 * (f32x2){bflo(uu[i]), bfhi(uu[i])} + w1 * (f32x2){bflo(uu[i + 1]), bfhi(uu[i + 1])} + w2 * (f32x2){bflo(uu[i + 2]), bfhi(uu[i + 2])};
        const f32x2 yd = (f32x2){bflo(dd[i]), bfhi(dd[i])} * cv;
        Yu[(size_t)i * 1024 + 768] = pk2(yd.x, yd.y); }
}
__device__ __forceinline__ void s_sample_item(Frame& F, int layer, int s, const bf16* Z, bf16* Y) {
    const int ch = opqv(F.tid); const size_t ls = (size_t)layer * 128 + s;
    const bf16* Zr = Z + (size_t)(MP + 4 * s) * ZC; bf16* Yr = Y + (size_t)(MP + 4 * s) * YC;
    LAS float* obuf = (LAS float*)(F.lds + RING_OFF);
    float in[34], wv[31], pb[19], u[6], dbv[4];
#pragma unroll
    for (int j = 0; j < 30; ++j) in[j] = (F.in[I_SCF] + (ls * 30 + j) * 512)[ch];
#pragma unroll
    for (int j = 0; j < 15; ++j) pb[j] = (F.in[I_SPOOL] + (ls * 15 + j) * 512)[ch];
    u[0] = (F.in[I_SSC] + (ls * 2 + 0) * 512)[ch]; u[1] = (F.in[I_SSC] + (ls * 2 + 1) * 512)[ch];
#pragma unroll
    for (int r = 0; r < 4; ++r) { in[30 + r] = bf1((Zr + (size_t)r * ZC + 1024)[ch]); pb[15 + r] = bf1((Zr + (size_t)r * ZC + 1536)[ch]); u[2 + r] = bf1((Zr + (size_t)r * ZC + 2560)[ch]); dbv[r] = bf1((Zr + (size_t)r * ZC + 2048)[ch]); }
#pragma unroll
    for (int j = 0; j < 31; ++j) wv[j] = (F.in[I_CFW] + ((size_t)layer * 31 + j) * 512)[ch];
    const float bias = (F.in[I_CFB] + layer * 512)[ch];
    const float w0 = (F.in[I_SCW] + (size_t)(layer * 3 + 0) * 512)[ch], w1 = (F.in[I_SCW] + (size_t)(layer * 3 + 1) * 512)[ch], w2 = (F.in[I_SCW] + (size_t)(layer * 3 + 2) * 512)[ch];
    asm volatile("" ::: "memory");
#pragma unroll
    for (int j = 0; j < 26; ++j) (F.out + O_SCF + (ls * 30 + j) * 512)[ch] = in[j + 4];
#pragma unroll
    for (int r = 0; r < 4; ++r) { float o = bias;
#pragma unroll
        for (int j = 0; j < 31; ++j) o += wv[j] * in[r + j];
        obuf[r * 512 + ch] = o; }
#pragma unroll
    for (int j = 0; j < 11; ++j) (F.out + O_SPOOL + (ls * 15 + j) * 512)[ch] = pb[j + 4];
    const int gsel = ch >> 7;
#pragma unroll
    for (int r = 0; r < 4; ++r) { const int k = 15 + r;
        const float s2 = pb[k] + pb[k - 1], s4 = s2 + pb[k - 2] + pb[k - 3], s8 = s4 + (pb[k - 4] + pb[k - 5]) + (pb[k - 6] + pb[k - 7]);
        float s16 = s8;
#pragma unroll
        for (int j = 8; j < 16; ++j) s16 += pb[k - j];
        const float mv = (gsel == 0 ? s2 * 0.5f : gsel == 1 ? s4 * 0.25f : gsel == 2 ? s8 * 0.125f : s16 * 0.0625f) - pb[k];
        (Yr + (size_t)r * YC + 1024)[ch] = f2bf(mv); }
#pragma unroll
    for (int r = 0; r < 4; ++r) (Yr + (size_t)r * YC + 1536)[ch] = f2bf(dbv[r] * (w0 * u[r] + w1 * u[r + 1] + w2 * u[r + 2]));
    __syncthreads();
    if (F.wave < 4) ln_silu_row(obuf + F.wave * 512, F.in[I_CFG] + layer * 512, F.in[I_CFBB] + layer * 512, Yr + (size_t)F.wave * YC + 512, F.lane);
}

struct Args { const float* in[31]; float* out; unsigned char* ws; int ph_lo, ph_hi; };
__global__ void __launch_bounds__(NWAVES * 64, 2) hybrid_fwd(Args args) {
    extern __shared__ __attribute__((aligned(16))) unsigned char lds[];
    Frame F;
    F.lds = (LAS unsigned char*)lds;
    F.MISC = (volatile LAS unsigned*)(F.lds + MISC_OFF);
    const int wave0 = __builtin_amdgcn_readfirstlane((int)threadIdx.x >> 6);
    F.lane = lane_now(); F.wave = wave0; F.tid = F.wave * 64 + F.lane;
    F.G = gridDim.x; F.bid = blockIdx.x;
    F.ws = args.ws; F.out = args.out; F.ctl = (gu32*)(args.ws + WS_CTL);
    F.in = args.in;
    for (int u = F.tid; u < (LDS_BYTES - LDSCTL_OFF) / 4; u += NWAVES * 64) ((LAS unsigned*)(F.lds + LDSCTL_OFF))[u] = 0u;
    __syncthreads();
    XcdBarrier bar; bar.bar = (unsigned*)(F.ctl + CW_BAR); bar.x = 0; bar.st = nullptr;
    if (!MK_SPLIT) bar = xcd_barrier_post((unsigned*)(F.ctl + CW_BAR), F.MISC + 8);
    const int lo = args.ph_lo, hi = args.ph_hi;
#define IN(k) (lo <= (k) && (k) < hi)
#define REFRESH() do { F.lane = lane_now(); F.wave = opqs(wave0); F.tid = F.wave * 64 + F.lane; F.bid = opqs((int)blockIdx.x); } while (0)
#define SEAM(k) do { if (IN(k) && IN((k) + 1)) xcd_barrier(bar); } while (0)
    bf16* WA = (bf16*)(F.ws + WS_WA); bf16* XB = (bf16*)(F.ws + WS_XB); bf16* Y = (bf16*)(F.ws + WS_Y); bf16* Zm = (bf16*)(F.ws + WS_ZG); _Float16* Gb = (_Float16*)(F.ws + WS_ZG);
    bf16* Hb = (bf16*)(F.ws + WS_ZG); bf16* MB = (bf16*)F.out;
 bf16* Bt3 = (bf16*)(F.ws + WS_BT3); bf16* Bt4 = (bf16*)(F.ws + WS_BT4); bf16* Bt5 = (bf16*)(F.ws + WS_BT5); bf16* Bt6 = (bf16*)(F.ws + WS_BT6);

    if (IN(0)) { REFRESH(); convert_matrix<RM_WIN>(F, F.in[I_WIN], DM, INC, WA, DM, 0, 0, F.bid * NWAVES + F.wave, F.G * NWAVES); REFRESH(); x_to_bf16(F, XB, F.ctl + CW_P0); }
    SEAM(0);

    const bool fast = F.G == 256;
    for (int l = 0; l < 2; ++l) {
        const int pb = 1 + 9 * l;
        if (IN(pb + 0)) for (int rep = 0; rep < NREP(0); ++rep) { if (rep) xcd_barrier(bar);
            if (fast && l == 1 && rep == 0) { REFRESH();
                ln_rows(F, F.out, F.out, F.in[I_LN2G], F.in[I_LN2B], XB, F.out + (size_t)MP * DM, (const float*)(F.ws + WS_SLAB), 11, 32); publish_ready(F, F.ctl + CW_RDY + 64 * 1); }
            pg8::Gemm g{XB, WA, DM, DM, XB}; pg8::UnitOrder S; S.init(pg8::SK_PLAIN, 4096, DM, F.G, F.bid, 0); pg8::EpiMix E{Zm, F.out, l};
            if (fast && l == 1) { S.ready = (const unsigned*)(F.ctl + CW_RDY + 64 * 1); S.need = (unsigned)F.G; }
            pg8::gemm_phase<pg8::EpiMix, pg8::UnitOrder, true>(F.lds + RING_OFF, g, S, E, wave0);
            if (F.G == 256 && F.bid >= 32 && F.bid < 64 && rep + 1 == NREP(0)) {
                pg8::Gemm g2{XB, WA + (size_t)4096 * DM, DM, DM, XB}; pg8::UnitOrder S2; S2.init(pg8::SK_PLAIN, 4096, DM, 32, F.bid - 32, 0, false, true); pg8::EpiGate E2{Gb};
                if (fast && l == 1) { REFRESH(); wait_ready(F, F.ctl + CW_RDY + 64 * 1, (unsigned)F.G); }
                pg8::gemm_phase<pg8::EpiGate, pg8::UnitOrder, true>(F.lds + RING_OFF, g2, S2, E2, wave0); }
            if (F.G == 256 && F.bid >= 64 && rep + 1 == NREP(0)) {
                REFRESH(); const int gw = (F.bid - 64) * NWAVES + F.wave, NGW = 192 * NWAVES; const float* wbr = F.in[I_WBR] + (size_t)l * 4 * 512 * 1024;
                convert_matrix<RM_ID>(F, wbr, 512, 1024, Bt3, 2048, 0, 0, gw, NGW, 0);
                convert_matrix<RM_ID>(F, wbr + (size_t)512 * 1024, 512, 1024, Bt3, 2048, 512, 0, gw, NGW, 256);
                convert_matrix<RM_ID>(F, wbr + (size_t)3 * 512 * 1024, 512, 1024, Bt3, 2048, 1536, 0, gw, NGW, 512);
                convert_matrix<RM_ID>(F, F.in[I_WOUT] + (size_t)l * DM * DM, DM, DM, Bt4, DM, 0, 0, gw, NGW, 768);
                REFRESH(); compose_pool(F, l, Bt3, gw, NGW, 1280); } }
        SEAM(pb + 0);
        if (IN(pb + 1)) for (int rep = 0; rep < NREP(1); ++rep) { if (rep) xcd_barrier(bar);
            __syncthreads(); REFRESH();
            for (int r2 = 0; r2 < NREP2(0); ++r2) for (int it = F.bid; it < 256; it += F.G) { a_prompt_item(F, l, it, Zm, Y); __syncthreads(); }
            REFRESH();
            for (int r2 = 0; r2 < NREP2(1); ++r2) for (int it = (F.bid + 128) % F.G; it < 128; it += F.G) a_sample_task(F, l, 8 * it + F.wave, Zm, Y);
            __syncthreads(); REFRESH();
            const bool rebal = false, gemm_wg = false;
            for (int r2 = 0; r2 < NREP2(2); ++r2) { if (!gemm_wg) for (int it = F.bid; it < 256; it += F.G) { b_prompt_item(F, l, it, Zm, Y); __syncthreads(); }
                if (rebal && F.bid >= 160 && F.bid < 192) { b_prompt_item(F, l, F.bid - 32, Zm, Y); __syncthreads(); } }
            REFRESH();
            for (int r2 = 0; r2 < NREP2(3); ++r2) { if (!gemm_wg) for (int it = F.bid; it < 256; it += F.G) { cd_prompt_item(F, l, it, Zm, Y); __syncthreads(); }
                if (rebal && F.bid >= 192 && F.bid < 224) { cd_prompt_item(F, l, F.bid - 64, Zm, Y); __syncthreads(); } }
            REFRESH();
            for (int r2 = 0; r2 < NREP2(4); ++r2) for (int it = F.bid; it < 128; it += F.G) { s_sample_item(F, l, it, Zm, Y); __syncthreads(); }
            REFRESH();
            const float* wbr = F.in[I_WBR] + (size_t)l * 4 * 512 * 1024;
            if (F.G != 256) { const int gw = F.bid * NWAVES + F.wave, NGW = F.G * NWAVES;
                convert_matrix<RM_ID>(F, wbr, 512, 1024, Bt3, 2048, 0, 0, gw, NGW); convert_matrix<RM_ID>(F, wbr + (size_t)512 * 1024, 512, 1024, Bt3, 2048, 512, 0, gw, NGW);
                convert_matrix<RM_ID>(F, wbr + (size_t)3 * 512 * 1024, 512, 1024, Bt3, 2048, 1536, 0, gw, NGW); convert_matrix<RM_ID>(F, F.in[I_WOUT] + (size_t)l * DM * DM, DM, DM, Bt4, DM, 0, 0, gw, NGW);
                REFRESH(); compose_pool(F, l, Bt3, gw, NGW); }
        }
        SEAM(pb + 1);
        if (IN(pb + 2)) for (int rep = 0; rep < NREP(2); ++rep) { if (rep) xcd_barrier(bar); pg8::Gemm g{XB, WA + (size_t)4096 * DM, DM, DM, XB}; pg8::UnitOrder S; S.init(pg8::SK_PLAIN, 4096, DM, F.G, F.bid, 0, true, F.G != 256); pg8::EpiGate E{Gb};
            pg8::gemm_phase<pg8::EpiGate, pg8::UnitOrder, true>(F.lds + RING_OFF, g, S, E, wave0); }
        SEAM(pb + 2);
        if (IN(pb + 3)) for (int rep = 0; rep < NREP(3); ++rep) { if (rep) xcd_barrier(bar); pg8::Gemm g{Y, Bt3, 2048, 2048, Y}; pg8::UnitOrder S; S.init(pg8::SK_P3, DM, 2048, F.G, F.bid, 0); pg8::EpiMerge E{Gb, MB, (bf16*)(F.ws + WS_MB4S)};
            pg8::gemm_phase<pg8::EpiMerge, pg8::UnitOrder, true>(F.lds + RING_OFF, g, S, E, wave0);
            if (F.G == 256 && F.bid >= 32 && rep + 1 == NREP(3)) {
                REFRESH(); const int gw = (F.bid - 32) * NWAVES + F.wave, NGW = 224 * NWAVES;
                convert_matrix<RM_GU>(F, F.in[I_WG] + (size_t)l * DM * FF, DM, FF, Bt5, DM, 0, 0, gw, NGW, 0);
                convert_matrix<RM_GU>(F, F.in[I_WU] + (size_t)l * DM * FF, DM, FF, Bt5, DM, 0, 128, gw, NGW, 1408); } }
        SEAM(pb + 3);
        if (IN(pb + 4)) for (int rep = 0; rep < 1; ++rep) { pg8::Gemm g{MB, Bt4, DM, DM, (const bf16*)(F.ws + WS_MB4S)}; pg8::UnitOrder S; S.init(pg8::SK_P4, DM, DM, F.G, F.bid, 0);
            pg8::EpiRes E{l == 0 ? F.in[I_XP] : nullptr, l == 0 ? nullptr : XB, nullptr, XB, F.in[I_LN1G] + l * DM, F.in[I_LN1B] + l * DM, (float*)(F.ws + WS_SLAB),
                          pg8::PanelStats{(unsigned*)(F.ws + WS_XCH + (size_t)(2 * l) * 512 * 1024), (unsigned*)(F.ctl + CW_SEAM + (2 * l) * SEAM_BANK)}, F.lds + XLDS_OFF, wave0};
            pg8::gemm_phase<pg8::EpiRes, pg8::UnitOrder, true>(F.lds + RING_OFF, g, S, E, wave0);
}
        SEAM(pb + 4);
        if (IN(pb + 5) && !fast) for (int rep = 0; rep < NREP(5); ++rep) { if (rep) xcd_barrier(bar);
            REFRESH();
            ln_rows(F, F.out, rep + 1 < NREP(5) ? (float*)(F.ws + WS_Y) : F.out, F.in[I_LN1G] + l * DM, F.in[I_LN1B] + l * DM, rep + 1 < NREP(5) ? nullptr : XB, l == 0 ? F.in[I_XS] : F.out + (size_t)MP * DM, (const float*)(F.ws + WS_SLAB), 16);
            REFRESH();
            if (F.G != 256) { const int gw = F.bid * NWAVES + F.wave, NGW = F.G * NWAVES;
                convert_matrix<RM_GU>(F, F.in[I_WG] + (size_t)l * DM * FF, DM, FF, Bt5, DM, 0, 0, gw, NGW); convert_matrix<RM_GU>(F, F.in[I_WU] + (size_t)l * DM * FF, DM, FF, Bt5, DM, 0, 128, gw, NGW);
                convert_matrix<RM_ID>(F, F.in[I_WD] + (size_t)l * FF * DM, FF, DM, Bt6, FF, 0, 0, gw, NGW); }
        }
        if (!fast) SEAM(pb + 5);
        if (IN(pb + 6)) for (int rep = 0; rep < NREP(6); ++rep) { if (rep) xcd_barrier(bar);
            if (fast && rep == 0) { REFRESH();
                ln_rows(F, F.out, F.out, F.in[I_LN1G] + l * DM, F.in[I_LN1B] + l * DM, XB, l == 0 ? F.in[I_XS] : F.out + (size_t)MP * DM, (const float*)(F.ws + WS_SLAB), 16, 172); publish_ready(F, F.ctl + CW_RDY + 64 * (2 * l)); }
            pg8::Gemm g{XB, Bt5, DM, DM, XB}; pg8::UnitOrder S; S.init(pg8::SK_PLAIN, 2 * FF, DM, F.G, F.bid, 0); pg8::EpiSwi E{Hb};
            if (fast) { S.ready = (const unsigned*)(F.ctl + CW_RDY + 64 * (2 * l)); S.need = (unsigned)F.G; }
            pg8::gemm_phase<pg8::EpiSwi, pg8::UnitOrder, true>(F.lds + RING_OFF, g, S, E, wave0);
            if (F.G == 256 && F.bid >= 172 && rep + 1 == NREP(6)) {
                REFRESH(); const int gw = (F.bid - 172) * NWAVES + F.wave, NGW = 84 * NWAVES;
                convert_matrix<RM_ID>(F, F.in[I_WD] + (size_t)l * FF * DM, FF, DM, Bt6, FF, 0, 0, gw, NGW, 0);
            } }
        SEAM(pb + 6);
        if (IN(pb + 7)) for (int rep = 0; rep < 1; ++rep) { pg8::Gemm g{Hb, Bt6, FF, FF, Hb}; pg8::UnitOrder S; S.init(pg8::SK_P6, DM, FF, F.G, F.bid, 0); pg8::EpiRes E{nullptr, XB, l == 1 ? F.out : nullptr, l == 0 ? XB : nullptr, F.in[I_LN2G] + l * DM, F.in[I_LN2B] + l * DM, (float*)(F.ws + WS_SLAB),
                          pg8::PanelStats{(unsigned*)(F.ws + WS_XCH + (size_t)(2 * l + 1) * 512 * 1024), (unsigned*)(F.ctl + CW_SEAM + (2 * l + 1) * SEAM_BANK)}, F.lds + XLDS_OFF, wave0};
            pg8::gemm_phase<pg8::EpiRes, pg8::UnitOrder, true>(F.lds + RING_OFF, g, S, E, wave0);
            if (F.G == 256 && F.bid >= 88 && l == 0) {
                REFRESH(); convert_matrix<RM_WIN>(F, F.in[I_WIN] + (size_t)DM * INC, DM, INC, WA, DM, 0, 0, (F.bid - 88) * NWAVES + F.wave, 168 * NWAVES); } }
        SEAM(pb + 7);
        if (IN(pb + 8) && !(fast && l == 0)) for (int rep = 0; rep < NREP(8); ++rep) { if (rep) xcd_barrier(bar);
            REFRESH();
            ln_rows(F, F.out, rep + 1 < NREP(8) ? (float*)(F.ws + WS_Y) : F.out, F.in[I_LN2G] + l * DM, F.in[I_LN2B] + l * DM, (l == 0 && rep + 1 == NREP(8)) ? XB : nullptr, F.out + (size_t)MP * DM, (const float*)(F.ws + WS_SLAB), 11);
            REFRESH();
            if (l == 0 && F.G != 256) convert_matrix<RM_WIN>(F, F.in[I_WIN] + (size_t)DM * INC, DM, INC, WA, DM, 0, 0, F.bid * NWAVES + F.wave, F.G * NWAVES);
        }
        if (l == 0 && !fast) SEAM(pb + 8);
    }
#undef IN
#undef SEAM
#undef REFRESH
}

extern "C" void kernel_launch(void* const* d_in, const int* in_sizes, int n_in, void* d_out, int out_size, void* d_ws, size_t ws_size, hipStream_t stream) {
    static int grid = 0;
    if (grid == 0) {
        if (n_in != 31 || out_size != (int)O_END || ws_size < WS_END) { fprintf(stderr, "kernel_launch: unexpected sizes n_in %d out %d ws %zu\n", n_in, out_size, ws_size); grid = -1; return; }
        int dev = 0, cus = 0, per_cu = 0;
        if (hipGetDevice(&dev) != hipSuccess || hipDeviceGetAttribute(&cus, hipDeviceAttributeMultiprocessorCount, dev) != hipSuccess) { grid = -1; return; }
        if (hipFuncSetAttribute((const void*)hybrid_fwd, hipFuncAttributeMaxDynamicSharedMemorySize, LDS_BYTES) != hipSuccess) { fprintf(stderr, "kernel_launch: hipFuncSetAttribute failed\n"); grid = -1; return; }
        if (hipOccupancyMaxActiveBlocksPerMultiprocessor(&per_cu, (const void*)hybrid_fwd, NWAVES * 64, LDS_BYTES) != hipSuccess || per_cu < 1)
            fprintf(stderr, "kernel_launch: occupancy query reports %d workgroups per CU\n", per_cu);
        (void)hipGetLastError();
        grid = cus;
    }
    if (grid < 0) return;
    if (hipMemsetAsync((char*)d_ws + WS_CTL, 0, CTL_ZERO_BYTES, stream) != hipSuccess) { fprintf(stderr, "kernel_launch: memset failed\n"); return; }
    Args a{};
    for (int i = 0; i < 31; ++i) a.in[i] = (const float*)d_in[i];
    a.out = (float*)d_out; a.ws = (unsigned char*)d_ws;
#if MK_SPLIT
    for (int ph = 0; ph < NPHASE; ++ph) { a.ph_lo = ph; a.ph_hi = ph + 1; hipLaunchKernelGGL(hybrid_fwd, dim3(grid), dim3(NWAVES * 64), LDS_BYTES, stream, a); }
#else
    a.ph_lo = 0; a.ph_hi = NPHASE;
    hipLaunchKernelGGL(hybrid_fwd, dim3(grid), dim3(NWAVES * 64), LDS_BYTES, stream, a);
#endif
}
```

```cpp
#include <hip/hip_runtime.h>
#include <cstdio>
#include <cstdint>

#ifndef PROBE_REP
#define PROBE_REP 0
#endif
#define NREP(k) (1 + ((PROBE_REP >> (k)) & 1))
#ifndef PROBE2
#define PROBE2 0
#endif
#define NREP2(j) (1 + ((PROBE2 >> (j)) & 1))
#ifndef MK_SPLIT
#define MK_SPLIT 0
#endif

constexpr int DM = 1024, WMIX = 512, NPB = 8, SEQ = 2048, NSB = 128, DSEQ = 4;
constexpr int MP = NPB * SEQ, MS = NSB * DSEQ, M = MP + MS;
constexpr int FF = 2816, INC = 8192, ZC = 3072, YC = 2048, GC = 4096;
constexpr float LN_EPS = 1e-5f, ALPHA = 1.41421356237f;
constexpr size_t O_Y = 0, O_PH = (size_t)M * DM, O_PRGC = O_PH + 8192, O_PCF = O_PRGC + 24576, O_PPOOL = O_PCF + 245760, O_PSC = O_PPOOL + 122880,
                 O_SH = O_PSC + 16384, O_SRGC = O_SH + 131072, O_SCF = O_SRGC + 393216, O_SPOOL = O_SCF + 3932160, O_SSC = O_SPOOL + 1966080, O_END = O_SSC + 262144;
static_assert(O_END == 24403968, "output map");

__device__ __forceinline__ int opqv(int v) { asm volatile("" : "+v"(v)); return v; }
__device__ __forceinline__ int lane_now() { int l; asm volatile("v_mbcnt_lo_u32_b32 %0, -1, 0\n\tv_mbcnt_hi_u32_b32 %0, -1, %0" : "=v"(l)); return l; }
__device__ __forceinline__ int opqs(int v) { asm volatile("" : "+s"(v)); return v; }
namespace pg8 {
#define PG8_LAS __attribute__((address_space(3)))
typedef unsigned short bf16_t;
typedef short bf16x8 __attribute__((ext_vector_type(8)));
typedef float f32x4 __attribute__((ext_vector_type(4)));
typedef float f32x2 __attribute__((ext_vector_type(2)));
typedef unsigned u32x4 __attribute__((ext_vector_type(4)));
typedef unsigned u32x2 __attribute__((ext_vector_type(2)));
typedef _Float16 f16x4 __attribute__((ext_vector_type(4)));
typedef _Float16 f16x8 __attribute__((ext_vector_type(8)));
constexpr int BM = 256, BK = 64, HALF = 128, HTB = HALF * BK * 2, STAGE_BYTES = 8 * HTB, NXCD = 8, WGM = 8;

__host__ __device__ __forceinline__ int lds_byte(int r, int c) { const int st = (r >> 4) * 2 + (c >> 5), rr = r & 15, cc = c & 31, ob = rr * 64 + cc * 2; return st * 1024 + (ob ^ (((ob >> 9) & 1) << 5)); }
__host__ __device__ __forceinline__ void stage_rc(int b, int& R, int& C) { const int st = b / 1024, sb = b % 1024, swz = sb ^ (((sb >> 9) & 1) << 5); R = (st >> 1) * 16 + swz / 64; C = (st & 1) * 32 + (swz % 64) / 2; }
__host__ __device__ __forceinline__ int perm32(int rho) { const int n = rho >> 4, i = rho & 15; return 8 * (i >> 2) + 4 * n + (i & 3); }

struct Unit { int pm, pn, nt, mode, aux; long offA, offB; };
struct Gemm { const bf16_t* A; const bf16_t* Bt; int lda, ldb; const bf16_t* As; };

enum { SK_PLAIN = 0, SK_P3 = 1, SK_P4 = 2, SK_P6 = 3 };
struct UnitOrder {
    int kind, nN, nwgP, nS, ntP, G, c; long offA_s; const unsigned* ready = nullptr; unsigned need = 0; unsigned* doneP = nullptr; unsigned* doneS = nullptr; bool remap = false;
    __device__ __forceinline__ void init(int kind_, int N_, int K_, int G_, int c_, long offA_s_, bool prompt = true, bool sample = true) { kind = kind_; nN = N_ / BM; nwgP = prompt ? 64 * nN : 0; ntP = K_ / BK; G = G_; c = c_; offA_s = offA_s_;
        nS = !sample ? 0 : kind_ == SK_PLAIN ? 2 * nN : kind_ == SK_P3 ? 32 : kind_ == SK_P4 ? 128 : 88; }
    __device__ __forceinline__ bool next(int i, Unit& u, const Gemm& g) const {
        const long L = (long)i * G + c; const long ra = (long)BM * g.lda * 2, rb = (long)BM * g.ldb * 2;
        if (L < nwgP) {
            int wgid = (int)L; { const int q = nwgP / NXCD, xcd = wgid % NXCD, off = wgid / NXCD; wgid = xcd * q + off; }
            const int nig = WGM * nN; u.pm = (wgid / nig) * WGM + ((wgid % nig) % WGM); u.pn = (wgid % nig) / WGM;
            u.nt = ntP; u.mode = 0; u.aux = 0; u.offA = u.pm * ra; u.offB = u.pn * rb; return true; }
        int s = (int)(L - nwgP);
        if (remap) { const int r = c & 63, h = c >> 6; if (i != 1) return false;
            if (kind == SK_P3) { if (r >= 8) return false; s = h * 8 + r; } else { if (r < 8 || r >= 40) return false; s = h * 32 + r - 8; } }
        if (s >= nS) return false;
        if (kind == SK_PLAIN) { u.pm = 64 + (s & 1); u.pn = s >> 1; u.nt = ntP; u.mode = 0; u.aux = 0; u.offA = u.pm * ra; u.offB = u.pn * rb; }
        else if (kind == SK_P3) { const int n = s & 3, tile = s >> 2; u.pm = 64 + (tile & 1); u.pn = tile >> 1; u.nt = 8; u.mode = 1; u.aux = n; u.offA = u.pm * ra + 1024 * n; u.offB = u.pn * rb + 1024 * n; }
        else if (kind == SK_P4) { const int ch = s & 15, tile = s >> 4, n = ch >> 2, kin = (ch & 3) * 256; u.pm = 64 + (tile & 1); u.pn = tile >> 1; u.nt = 4; u.mode = 1; u.aux = ch;
            u.offA = ((long)(n * 512 + (u.pm - 64) * 256) * 1024 + kin) * 2; u.offB = u.pn * rb + kin * 2; }
        else { const int ch = s % 11, tile = s / 11; u.pm = 64 + (tile & 1); u.pn = tile >> 1; u.nt = 4; u.mode = 1; u.aux = ch; u.offA = u.pm * ra + 512 * ch; u.offB = u.pn * rb + 512 * ch; }
        return true;
    }
    __device__ __forceinline__ void a_ready(const Unit& u, int wid) const {
        if (ready == nullptr || u.pm < 64) return;
        if (wid == 0) { unsigned spins = 0;
            while ((unsigned)__builtin_amdgcn_readfirstlane(__hip_atomic_load(ready, __ATOMIC_RELAXED, __HIP_MEMORY_SCOPE_AGENT)) < need) { __builtin_amdgcn_s_sleep(2); if (++spins > (1u << 20)) break; }
            __builtin_amdgcn_fence(__ATOMIC_ACQUIRE, "agent");
            asm volatile("s_waitcnt vmcnt(0)" ::: "memory"); }
        asm volatile("" ::: "memory"); __builtin_amdgcn_s_barrier(); asm volatile("" ::: "memory");
    }
    __device__ __forceinline__ void unit_done(const Unit& u, int wid) const {
        if (doneP == nullptr) return;
        asm volatile("s_waitcnt vmcnt(0)" ::: "memory"); __builtin_amdgcn_s_barrier(); asm volatile("" ::: "memory");
        if (wid == 0) { if (lane_now() == 0) { __builtin_amdgcn_fence(__ATOMIC_RELEASE, "agent"); asm volatile("s_waitcnt vmcnt(0)" ::: "memory");
            __hip_atomic_fetch_add(u.pm < 64 ? doneP : doneS, 1u, __ATOMIC_RELAXED, __HIP_MEMORY_SCOPE_AGENT); } }
    }
};

__device__ __forceinline__ unsigned cvt_pk_bf16(float lo, float hi) { unsigned r; asm volatile("v_cvt_pk_bf16_f32 %0, %1, %2" : "=v"(r) : "v"(lo), "v"(hi)); return r; }
__device__ __forceinline__ float sigmoidf_fast(float x) { return __builtin_amdgcn_rcpf(1.0f + __builtin_amdgcn_exp2f(-1.44269504089f * x)); }
__device__ __forceinline__ float gelu_tanh(float x) { const float t = x * x, y = x * fmaf(t, -0.10294324f, -2.3022082f); return x * __builtin_amdgcn_rcpf(1.0f + __builtin_amdgcn_exp2f(y)); }

__device__ __forceinline__ void acc_zero(f32x4 (&acc)[2][2][4][2]) {
#pragma unroll
    for (int a = 0; a < 2; ++a)
#pragma unroll
        for (int b = 0; b < 2; ++b)
#pragma unroll
            for (int m = 0; m < 4; ++m)
#pragma unroll
                for (int n = 0; n < 2; ++n) acc[a][b][m][n] = (f32x4){0.f, 0.f, 0.f, 0.f};
}
__device__ __forceinline__ float* state_ptr(float* out, int R, int keep, int layer, size_t p_off, size_t s_off) {
    if (R < MP) { const int b = R >> 11, j = (R & 2047) - (2048 - keep); return j < 0 ? nullptr : out + p_off + (size_t)((layer * 8 + b) * keep + j) * 512; }
    const int s = (R - MP) >> 2, j = (R & 3) + keep - 4; return j < 0 ? nullptr : out + s_off + (size_t)((layer * 128 + s) * keep + j) * 512;
}

struct EpiMix {
    static constexpr bool PERM = true, MIDK = false;
    __device__ __forceinline__ void init(f32x4 (&acc)[2][2][4][2], const Unit&, int, int) const { acc_zero(acc); }
    bf16_t* Z; float* out; int layer;
    __device__ __forceinline__ void midk(f32x4 (&)[2][2][4][2], const Unit&, int, int, int, int, int) const {}
    __device__ __forceinline__ void operator()(f32x4 (&acc)[2][2][4][2], const Unit& u, int wr, int wc, int fr_, int fq_) const {
        const int lane_ = lane_now(), fr = lane_ & 15, fq = lane_ >> 4; (void)fr_; (void)fq_;
        const int pn = u.pn; int type, zcol, keep = 0, scol = 0; size_t poff = 0, soff = 0;
        if (pn < 2) { type = 0; zcol = 256 * pn; keep = 3; scol = zcol; poff = O_PRGC; soff = O_SRGC; }
        else if (pn < 4) { type = 1; zcol = 512 + 256 * (pn - 2); }
        else if (pn < 8) { type = 2; zcol = 1024 + 128 * (pn - 4); keep = 30; scol = 128 * (pn - 4); poff = O_PCF; soff = O_SCF; }
        else if (pn < 10) { type = 0; zcol = 1536 + 256 * (pn - 8); keep = 15; scol = 256 * (pn - 8); poff = O_PPOOL; soff = O_SPOOL; }
        else if (pn < 12) { type = 0; zcol = 2048 + 256 * (pn - 10); }
        else { type = 3; zcol = 2560 + 128 * (pn - 12); keep = 2; scol = 128 * (pn - 12); poff = O_PSC; soff = O_SSC; }
        const bool tail = keep != 0 && (u.pm >= 64 || (u.pm & 7) == 7);
        const int row0 = u.pm * BM + wr * 64 + fr, cl = wc * 32 + 8 * fq;
        if (type < 2) {
#pragma unroll
            for (int ai = 0; ai < 2; ++ai)
#pragma unroll
                for (int m = 0; m < 4; ++m) { const int R = row0 + ai * HALF + m * 16; bf16_t* rowp = Z + (size_t)R * ZC + zcol + cl;
                    float* sp = tail ? state_ptr(out, R, keep, layer, poff, soff) : nullptr;
#pragma unroll
                    for (int bj = 0; bj < 2; ++bj) { f32x4 v0 = acc[ai][bj][m][0], v1 = acc[ai][bj][m][1];
                        if (type == 1) { v0 = (f32x4){gelu_tanh(v0[0]), gelu_tanh(v0[1]), gelu_tanh(v0[2]), gelu_tanh(v0[3])}; v1 = (f32x4){gelu_tanh(v1[0]), gelu_tanh(v1[1]), gelu_tanh(v1[2]), gelu_tanh(v1[3])}; }
                        u32x4 w; w.x = cvt_pk_bf16(v0[0], v0[1]); w.y = cvt_pk_bf16(v0[2], v0[3]); w.z = cvt_pk_bf16(v1[0], v1[1]); w.w = cvt_pk_bf16(v1[2], v1[3]);
                        *(u32x4*)(rowp + bj * HALF) = w;
                        if (sp) { *(f32x4*)(sp + scol + cl + bj * HALF) = v0; *(f32x4*)(sp + scol + cl + bj * HALF + 4) = v1; } } }
        } else {
#pragma unroll
            for (int ai = 0; ai < 2; ++ai)
#pragma unroll
                for (int m = 0; m < 4; ++m) { const int R = row0 + ai * HALF + m * 16; bf16_t* rowp = Z + (size_t)R * ZC + zcol + cl;
                    float* sp = tail ? state_ptr(out, R, keep, layer, poff, soff) : nullptr;
                    f32x4 v0, v1; const f32x4 a0 = acc[ai][0][m][0], a1 = acc[ai][0][m][1], b0 = acc[ai][1][m][0], b1 = acc[ai][1][m][1];
                    if (type == 2) {
#pragma unroll
                        for (int i = 0; i < 4; ++i) { v0[i] = a0[i] * sigmoidf_fast(b0[i]); v1[i] = a1[i] * sigmoidf_fast(b1[i]); }
                    } else { v0 = a0 * b0; v1 = a1 * b1; }
                    u32x4 w; w.x = cvt_pk_bf16(v0[0], v0[1]); w.y = cvt_pk_bf16(v0[2], v0[3]); w.z = cvt_pk_bf16(v1[0], v1[1]); w.w = cvt_pk_bf16(v1[2], v1[3]);
                    *(u32x4*)rowp = w;
                    if (sp) { *(f32x4*)(sp + scol + cl) = v0; *(f32x4*)(sp + scol + cl + 4) = v1; } }
        }
    }
};

struct EpiGate {
    static constexpr bool PERM = true, MIDK = false;
    __device__ __forceinline__ void init(f32x4 (&acc)[2][2][4][2], const Unit&, int, int) const { acc_zero(acc); }
    _Float16* G;
    __device__ __forceinline__ void midk(f32x4 (&)[2][2][4][2], const Unit&, int, int, int, int, int) const {}
    __device__ __forceinline__ void operator()(f32x4 (&acc)[2][2][4][2], const Unit& u, int wr, int wc, int fr_, int fq_) const {
        const int lane_ = lane_now(), fr = lane_ & 15, fq = lane_ >> 4; (void)fr_; (void)fq_;
        const int row0 = u.pm * BM + wr * 64 + fr, ch0 = 64 * u.pn + 16 * wc + 4 * fq; const bool plain = u.pm >= 64;
#pragma unroll
        for (int ai = 0; ai < 2; ++ai)
#pragma unroll
            for (int m = 0; m < 4; ++m) { const int R = row0 + ai * HALF + m * 16; _Float16* gp = G + (size_t)R * GC + ch0;
                f16x4 r0, r1, r2, g3;
#pragma unroll
                for (int i = 0; i < 4; ++i) {
                    const float d0 = 1.f + __builtin_amdgcn_exp2f(__builtin_amdgcn_fmed3f(acc[ai][0][m][0][i], -15.f, 15.f)), d1 = 1.f + __builtin_amdgcn_exp2f(__builtin_amdgcn_fmed3f(acc[ai][0][m][1][i], -15.f, 15.f));
                    const float d2 = 1.f + __builtin_amdgcn_exp2f(__builtin_amdgcn_fmed3f(acc[ai][1][m][0][i], -15.f, 15.f)), d3 = 1.f + __builtin_amdgcn_exp2f(__builtin_amdgcn_fmed3f(acc[ai][1][m][1][i], -15.f, 15.f));
                    const float i0 = __builtin_amdgcn_rcpf(d0), i1 = __builtin_amdgcn_rcpf(d1), i2 = __builtin_amdgcn_rcpf(d2), i3 = __builtin_amdgcn_rcpf(d3);
                    if (plain) { r0[i] = (_Float16)i0; r1[i] = (_Float16)i1; r2[i] = (_Float16)i2; }
                    else { r0[i] = (_Float16)(d1 * i0); r1[i] = (_Float16)(d2 * i1); r2[i] = (_Float16)(d3 * i2); }
                    g3[i] = (_Float16)i3; }
                *(f16x4*)(gp) = r0; *(f16x4*)(gp + 1024) = r1; *(f16x4*)(gp + 2048) = r2; *(f16x4*)(gp + 3072) = g3; }
    }
};

struct EpiMerge {
    static constexpr bool PERM = true, MIDK = true;
    __device__ __forceinline__ void init(f32x4 (&acc)[2][2][4][2], const Unit&, int, int) const { acc_zero(acc); }
    const _Float16* G; bf16_t* O; bf16_t* Os;
    __device__ __forceinline__ void scale(f32x4 (&acc)[2][2][4][2], const Unit& u, int seg, int wr, int wc) const {
        const int lane_ = lane_now(), fr = lane_ & 15, fq = lane_ >> 4;
        const int row0 = u.pm * BM + wr * 64 + fr, c0 = 1024 * seg + 256 * u.pn + wc * 32 + 8 * fq;
#pragma unroll
        for (int ai = 0; ai < 2; ++ai)
#pragma unroll
            for (int m = 0; m < 4; ++m) { const _Float16* gp = G + (size_t)(row0 + ai * HALF + m * 16) * GC + c0;
#pragma unroll
                for (int bj = 0; bj < 2; ++bj) { const f16x8 f = *(const f16x8*)(gp + bj * HALF);
                    acc[ai][bj][m][0] *= (f32x4){(float)f[0], (float)f[1], (float)f[2], (float)f[3]}; acc[ai][bj][m][1] *= (f32x4){(float)f[4], (float)f[5], (float)f[6], (float)f[7]}; } }
    }
    __device__ __forceinline__ void midk(f32x4 (&acc)[2][2][4][2], const Unit& u, int seg, int wr, int wc, int, int) const { scale(acc, u, seg, wr, wc); }
    __device__ __forceinline__ void operator()(f32x4 (&acc)[2][2][4][2], const Unit& u, int wr, int wc, int, int) const {
        scale(acc, u, u.mode ? u.aux : 3, wr, wc);
        const int lane_ = lane_now(), fr = lane_ & 15, fq = lane_ >> 4;
        const int row0 = (u.mode ? (u.pm - 64) * BM + 512 * u.aux : u.pm * BM) + wr * 64 + fr, c0 = 256 * u.pn + wc * 32 + 8 * fq;
        bf16_t* O = u.mode ? Os : this->O;
#pragma unroll
        for (int ai = 0; ai < 2; ++ai)
#pragma unroll
            for (int m = 0; m < 4; ++m) { bf16_t* rowp = O + (size_t)(row0 + ai * HALF + m * 16) * DM + c0;
#pragma unroll
                for (int bj = 0; bj < 2; ++bj) { const f32x4 v0 = acc[ai][bj][m][0], v1 = acc[ai][bj][m][1];
                    u32x4 w; w.x = cvt_pk_bf16(v0[0], v0[1]); w.y = cvt_pk_bf16(v0[2], v0[3]); w.z = cvt_pk_bf16(v1[0], v1[1]); w.w = cvt_pk_bf16(v1[2], v1[3]); *(u32x4*)(rowp + bj * HALF) = w; } }
    }
};

struct PanelStats {
    unsigned* xbuf;
    unsigned* cnt;
    __device__ __forceinline__ void run(const f32x4 (&v)[2][2][4][2], const Unit& u, int wr, int wc, PG8_LAS unsigned char* lds, int wid) const {
        const int lane = lane_now(), fr = lane & 15, fq = lane >> 4;
        PG8_LAS f32x2* P = (PG8_LAS f32x2*)lds;
        PG8_LAS f32x2* S = (PG8_LAS f32x2*)(lds + 8192);
#pragma unroll
        for (int ai = 0; ai < 2; ++ai)
#pragma unroll
            for (int m = 0; m < 4; ++m) {
                float s = 0.f;
#pragma unroll
                for (int bj = 0; bj < 2; ++bj)
#pragma unroll
                    for (int n = 0; n < 2; ++n) { const f32x4 x = v[ai][bj][m][n]; s += (x[0] + x[1]) + (x[2] + x[3]); }
                s += __builtin_bit_cast(float, __builtin_amdgcn_ds_bpermute((lane ^ 16) << 2, __builtin_bit_cast(int, s))); s += __builtin_bit_cast(float, __builtin_amdgcn_ds_bpermute((lane ^ 32) << 2, __builtin_bit_cast(int, s)));
                const float mw = s * (1.0f / 64.0f); float q = 0.f;
#pragma unroll
                for (int bj = 0; bj < 2; ++bj)
#pragma unroll
                    for (int n = 0; n < 2; ++n) { const f32x4 d = v[ai][bj][m][n] - mw; q += (d[0] * d[0] + d[1] * d[1]) + (d[2] * d[2] + d[3] * d[3]); }
                q += __builtin_bit_cast(float, __builtin_amdgcn_ds_bpermute((lane ^ 16) << 2, __builtin_bit_cast(int, q))); q += __builtin_bit_cast(float, __builtin_amdgcn_ds_bpermute((lane ^ 32) << 2, __builtin_bit_cast(int, q)));
                if (fq == 0) P[(ai * HALF + wr * 64 + m * 16 + fr) * 4 + wc] = (f32x2){mw, q};
            }
        asm volatile("s_waitcnt lgkmcnt(0)" ::: "memory"); __builtin_amdgcn_s_barrier(); asm volatile("" ::: "memory");
        const int row = wid * 32 + (lane & 31);
        if (lane < 32) {
            const f32x2 a = P[row * 4 + 0], b = P[row * 4 + 1], c = P[row * 4 + 2], d = P[row * 4 + 3];
            const float mt = (a.x + b.x + c.x + d.x) * 0.25f;
            const float da = a.x - mt, db = b.x - mt, dc = c.x - mt, dd = d.x - mt;
            const float m2 = (a.y + b.y) + (c.y + d.y) + 64.0f * ((da * da + db * db) + (dc * dc + dd * dd));
            unsigned long long* slot = (unsigned long long*)xbuf + ((size_t)(u.pm * BM + row) * 4 + u.pn);
            __hip_atomic_store(slot, ((unsigned long long)__float_as_uint(m2) << 32) | __float_as_uint(mt), __ATOMIC_RELAXED, __HIP_MEMORY_SCOPE_AGENT);
        }
        asm volatile("s_waitcnt vmcnt(0)" ::: "memory");
        if (lane == 0) __hip_atomic_fetch_add(cnt + 64 * u.pm, 1u, __ATOMIC_RELAXED, __HIP_MEMORY_SCOPE_AGENT);
        if (wid == 0) {
            unsigned spins = 0;
            while ((unsigned)__builtin_amdgcn_readfirstlane(__hip_atomic_load(cnt + 64 * u.pm, __ATOMIC_RELAXED, __HIP_MEMORY_SCOPE_AGENT)) < 32u) { __builtin_amdgcn_s_sleep(2); if (++spins > (1u << 20)) break; }
            __builtin_amdgcn_fence(__ATOMIC_ACQUIRE, "agent");
        }
        asm volatile("s_waitcnt vmcnt(0) lgkmcnt(0)" ::: "memory"); __builtin_amdgcn_s_barrier(); asm volatile("" ::: "memory");
        if (lane < 32) {
            const unsigned long long* slot = (const unsigned long long*)xbuf + (size_t)(u.pm * BM + row) * 4; float mt[4], m2[4]; float ms = 0.f;
#pragma unroll
            for (int t = 0; t < 4; ++t) { const unsigned long long w = __hip_atomic_load(slot + t, __ATOMIC_RELAXED, __HIP_MEMORY_SCOPE_AGENT); mt[t] = __uint_as_float((unsigned)w); m2[t] = __uint_as_float((unsigned)(w >> 32)); ms += mt[t]; }
            const float mean = ms * 0.25f; float q = 0.f;
#pragma unroll
            for (int t = 0; t < 4; ++t) { const float dm = mt[t] - mean; q += m2[t] + 256.0f * dm * dm; }
            S[row] = (f32x2){mean, __builtin_amdgcn_rsqf(q * (1.0f / 1024.0f) + LN_EPS)};
        }
        asm volatile("s_waitcnt lgkmcnt(0)" ::: "memory"); __builtin_amdgcn_s_barrier(); asm volatile("" ::: "memory");
    }
};
struct EpiRes {
    static constexpr bool PERM = false, MIDK = false;
    __device__ __forceinline__ void init(f32x4 (&acc)[2][2][4][2], const Unit& u, int wr, int wc) const {
        if (u.mode) { acc_zero(acc); return; }
        const int lane_ = lane_now(), fr = lane_ & 15, fq = lane_ >> 4;
        const size_t e0 = (size_t)(u.pm * BM + wr * 64 + fr) * DM + 256 * u.pn + wc * 32 + 4 * fq;
        if (base16) {
#pragma unroll
            for (int ai = 0; ai < 2; ++ai)
#pragma unroll
                for (int m = 0; m < 4; ++m)
#pragma unroll
                    for (int bj = 0; bj < 2; ++bj)
#pragma unroll
                        for (int n = 0; n < 2; ++n) { const u32x2 w = *(const u32x2*)(base16 + e0 + (size_t)(ai * HALF + m * 16) * DM + bj * HALF + n * 16);
                            acc[ai][bj][m][n] = (f32x4){__uint_as_float(w.x << 16), __uint_as_float(w.x & 0xffff0000u), __uint_as_float(w.y << 16), __uint_as_float(w.y & 0xffff0000u)} * ALPHA; }
            return; }
#pragma unroll
        for (int ai = 0; ai < 2; ++ai)
#pragma unroll
            for (int m = 0; m < 4; ++m)
#pragma unroll
                for (int bj = 0; bj < 2; ++bj)
#pragma unroll
                    for (int n = 0; n < 2; ++n) acc[ai][bj][m][n] = *(const f32x4*)(baseP + e0 + (size_t)(ai * HALF + m * 16) * DM + bj * HALF + n * 16) * ALPHA;
    }
    const float* baseP; const bf16_t* base16; float* out; bf16_t* xb; const float* lng; const float* lnb; float* slab; PanelStats st; PG8_LAS unsigned char* xlds; int wid;
    __device__ __forceinline__ void midk(f32x4 (&)[2][2][4][2], const Unit&, int, int, int, int, int) const {}
    __device__ __forceinline__ void operator()(f32x4 (&acc)[2][2][4][2], const Unit& u, int wr, int wc, int fr_, int fq_) const {
        const int lane_ = lane_now(), fr = lane_ & 15, fq = lane_ >> 4; (void)fr_; (void)fq_;
        const int row0 = u.pm * BM + wr * 64 + fr, c0 = 256 * u.pn + wc * 32 + 4 * fq;
        if (u.mode) {
#pragma unroll
            for (int ai = 0; ai < 2; ++ai)
#pragma unroll
                for (int m = 0; m < 4; ++m) { float* op = slab + ((size_t)u.aux * 512 + (row0 - MP) + ai * HALF + m * 16) * DM + c0;
#pragma unroll
                    for (int bj = 0; bj < 2; ++bj)
#pragma unroll
                        for (int n = 0; n < 2; ++n) *(f32x4*)(op + bj * HALF + n * 16) = acc[ai][bj][m][n]; }
            return; }
        st.run(acc, u, wr, wc, xlds, wid);
        const PG8_LAS f32x2* S = (const PG8_LAS f32x2*)(xlds + 8192);
#pragma unroll
        for (int bj = 0; bj < 2; ++bj)
#pragma unroll
            for (int n = 0; n < 2; ++n) { const int cc = c0 + bj * HALF + n * 16; const f32x4 gv = *(const f32x4*)(lng + cc), bv = *(const f32x4*)(lnb + cc);
#pragma unroll
                for (int ai = 0; ai < 2; ++ai)
#pragma unroll
                    for (int m = 0; m < 4; ++m) { const int r = ai * HALF + wr * 64 + m * 16 + fr; const f32x2 sr = S[r]; const size_t off = (size_t)(u.pm * BM + r) * DM + cc;
                        const f32x4 o = (acc[ai][bj][m][n] - sr.x) * sr.y * gv + bv; if (out) *(f32x4*)(out + off) = o;
                        if (xb) { u32x2 w; w.x = cvt_pk_bf16(o[0], o[1]); w.y = cvt_pk_bf16(o[2], o[3]); *(u32x2*)(xb + off) = w; }
                        if (m & 1) asm volatile("" ::: "memory"); } }
    }
};

struct EpiSwi {
    static constexpr bool PERM = true, MIDK = false;
    __device__ __forceinline__ void init(f32x4 (&acc)[2][2][4][2], const Unit&, int, int) const { acc_zero(acc); }
    bf16_t* H;
    __device__ __forceinline__ void midk(f32x4 (&)[2][2][4][2], const Unit&, int, int, int, int, int) const {}
    __device__ __forceinline__ void operator()(f32x4 (&acc)[2][2][4][2], const Unit& u, int wr, int wc, int fr_, int fq_) const {
        const int lane_ = lane_now(), fr = lane_ & 15, fq = lane_ >> 4; (void)fr_; (void)fq_;
        const int row0 = u.pm * BM + wr * 64 + fr, c0 = 128 * u.pn + wc * 32 + 8 * fq;
#pragma unroll
        for (int ai = 0; ai < 2; ++ai)
#pragma unroll
            for (int m = 0; m < 4; ++m) { bf16_t* rowp = H + (size_t)(row0 + ai * HALF + m * 16) * FF + c0;
                const f32x4 g0 = acc[ai][0][m][0], g1 = acc[ai][0][m][1], u0 = acc[ai][1][m][0], u1 = acc[ai][1][m][1]; f32x4 v0, v1;
#pragma unroll
                for (int i = 0; i < 4; ++i) { v0[i] = g0[i] * sigmoidf_fast(g0[i]) * u0[i]; v1[i] = g1[i] * sigmoidf_fast(g1[i]) * u1[i]; }
                u32x4 w; w.x = cvt_pk_bf16(v0[0], v0[1]); w.y = cvt_pk_bf16(v0[2], v0[3]); w.z = cvt_pk_bf16(v1[0], v1[1]); w.w = cvt_pk_bf16(v1[2], v1[3]);
                *(u32x4*)rowp = w; }
    }
};

template <class Epi, class Sched, bool ALIGN_EPI>
__device__ __forceinline__ void gemm_phase(PG8_LAS unsigned char* lds, const Gemm g, const Sched& S, const Epi& E, int wave_id) {
    const int wid = opqs(wave_id), lane = lane_now(), tid = wid * 64 + lane, wr = wid >> 2, wc = wid & 3, fr = lane & 15, fq = lane >> 4;
    unsigned voffA[2], voffB[2];
#pragma unroll
    for (int i = 0; i < 2; ++i) { int R, C; stage_rc(tid * 16 + i * 8192, R, C); const int Rb = Epi::PERM ? ((R & ~31) + perm32(R & 31)) : R;
        voffA[i] = (unsigned)(R * g.lda + C) * 2u; voffB[i] = (unsigned)(Rb * g.ldb + C) * 2u; }
    const size_t kstep = (size_t)(BK * 2);
    const size_t hstepA = (size_t)HALF * g.lda * 2, hstepB = (size_t)HALF * g.ldb * 2;
    const unsigned ldsw = (unsigned)wid * 1024u;
    const int aoff = lds_byte(wr * 64 + fr, fq * 8), boff = lds_byte(wc * 32 + fr, fq * 8);
#define PG8_SA(b, h) (((b) * 2 + (h)) * HTB)
#define PG8_SB(b, h) ((4 + (b) * 2 + (h)) * HTB)
#define PG8_STAGE(bufoff, gbase, voff) do { _Pragma("unroll") for (int _i = 0; _i < 2; ++_i) \
        __builtin_amdgcn_global_load_lds((const unsigned*)((const char*)(gbase) + (voff)[_i]), (PG8_LAS unsigned*)(lds + (bufoff) + ldsw + _i * 8192), 16, 0, 0); } while (0)
#define PG8_LDA(dst, b, h) do { _Pragma("unroll") for (int m = 0; m < 4; ++m) _Pragma("unroll") for (int k = 0; k < 2; ++k) dst[m][k] = *(const PG8_LAS bf16x8*)(lds + PG8_SA(b, h) + aoff + m * 2048 + k * 1024); } while (0)
#define PG8_LDB(dst, b, h) do { _Pragma("unroll") for (int n = 0; n < 2; ++n) _Pragma("unroll") for (int k = 0; k < 2; ++k) dst[n][k] = *(const PG8_LAS bf16x8*)(lds + PG8_SB(b, h) + boff + n * 2048 + k * 1024); } while (0)
#define PG8_MMA(ai, bj, At, Bt) do { __builtin_amdgcn_s_setprio(1); _Pragma("unroll") for (int m = 0; m < 4; ++m) _Pragma("unroll") for (int n = 0; n < 2; ++n) _Pragma("unroll") for (int k = 0; k < 2; ++k) \
        acc[ai][bj][m][n] = __builtin_amdgcn_mfma_f32_16x16x32_bf16(Bt[n][k], At[m][k], acc[ai][bj][m][n], 0, 0, 0); __builtin_amdgcn_s_setprio(0); } while (0)
#define PG8_WAIT_V(n) asm volatile("s_waitcnt vmcnt(" #n ")" ::: "memory")
#define PG8_WAIT_L(n) asm volatile("s_waitcnt lgkmcnt(" #n ")" ::: "memory")
#define PG8_BAR __builtin_amdgcn_s_barrier()
#define PG8_SCHED __builtin_amdgcn_sched_barrier(0)
    Unit cur, nxt; int ui = 0;
    if (!S.next(0, cur, g)) return;
    f32x4 acc[2][2][4][2];
    E.init(acc, cur, wr, wc);
    bf16x8 At[4][2], B0[2][2], B1[2][2];
    const char* cA = (const char*)(cur.mode ? g.As : g.A) + cur.offA; const char* cB = (const char*)g.Bt + cur.offB;
    PG8_STAGE(PG8_SB(0, 0), cB, voffB); PG8_STAGE(PG8_SB(0, 1), cB + hstepB, voffB); PG8_STAGE(PG8_SA(0, 0), cA, voffA); PG8_STAGE(PG8_SA(0, 1), cA + hstepA, voffA);
    if (wr == 1) PG8_BAR;
    PG8_WAIT_V(2); PG8_BAR;
    PG8_STAGE(PG8_SB(1, 0), cB + kstep, voffB); PG8_STAGE(PG8_SA(1, 0), cA + kstep, voffA); PG8_STAGE(PG8_SB(1, 1), cB + hstepB + kstep, voffB);
    PG8_WAIT_V(6); PG8_BAR;
    for (;;) {
        const bool has_next = S.next(ui + 1, nxt, g);
        const char* nA = has_next ? (const char*)(nxt.mode ? g.As : g.A) + nxt.offA : cA; const char* nB = has_next ? (const char*)g.Bt + nxt.offB : cB;
        const int nt = cur.nt, TSEG = Epi::MIDK ? 8 : nt;
        for (int t0 = 0; t0 < nt; t0 += TSEG) {
        if constexpr (Epi::MIDK) { if (t0 != 0) { PG8_SCHED; E.midk(acc, cur, t0 / TSEG - 1, wr, wc, 0, 0); PG8_SCHED; } }
#pragma unroll 1
        for (int t = t0; t < t0 + TSEG; t += 2) {
            const bool last = (t == nt - 2);
            if (last && has_next) S.a_ready(nxt, wid);
            const char* a1 = cA + (size_t)(t + 1) * kstep;
            const char* a2 = last ? nA : cA + (size_t)(t + 2) * kstep; const char* b2 = last ? nB : cB + (size_t)(t + 2) * kstep;
            const char* a3 = a2 + kstep; const char* b3 = b2 + kstep;
            PG8_LDB(B0, 0, 0); PG8_LDB(B1, 0, 1); PG8_SCHED; PG8_LDA(At, 0, 0); PG8_STAGE(PG8_SA(1, 1), a1 + hstepA, voffA);
            PG8_WAIT_V(8); PG8_WAIT_L(0); PG8_BAR; PG8_MMA(0, 0, At, B0); PG8_MMA(0, 1, At, B1); PG8_BAR; PG8_SCHED;
            PG8_LDA(At, 0, 1); PG8_STAGE(PG8_SB(0, 0), b2, voffB); PG8_STAGE(PG8_SB(0, 1), b2 + hstepB, voffB); PG8_STAGE(PG8_SA(0, 0), a2, voffA);
            PG8_WAIT_V(8); PG8_WAIT_L(0); PG8_BAR; PG8_MMA(1, 0, At, B0); PG8_MMA(1, 1, At, B1); PG8_BAR; PG8_SCHED;
            PG8_LDB(B0, 1, 0); PG8_LDB(B1, 1, 1); PG8_SCHED; PG8_LDA(At, 1, 0); PG8_STAGE(PG8_SA(0, 1), a2 + hstepA, voffA);
            PG8_WAIT_V(8); PG8_WAIT_L(0); PG8_BAR; PG8_MMA(0, 0, At, B0); PG8_MMA(0, 1, At, B1); PG8_BAR; PG8_SCHED;
            PG8_LDA(At, 1, 1); PG8_STAGE(PG8_SB(1, 0), b3, voffB); PG8_STAGE(PG8_SB(1, 1), b3 + hstepB, voffB); PG8_STAGE(PG8_SA(1, 0), a3, voffA);
            PG8_WAIT_V(8); PG8_WAIT_L(0); PG8_BAR; PG8_MMA(1, 0, At, B0); PG8_MMA(1, 1, At, B1); PG8_BAR; PG8_SCHED;
        }
        }
        if constexpr (ALIGN_EPI) { if (wr == 0) PG8_BAR; }
        E(acc, cur, wr, wc, 0, 0);
        S.unit_done(cur, wid);
        if (!has_next) break;
        cur = nxt; cA = nA; cB = nB; ++ui;
        E.init(acc, cur, wr, wc);
        if constexpr (ALIGN_EPI) { if (wr == 1) PG8_BAR; }
    }
    PG8_WAIT_V(0);
    if constexpr (!ALIGN_EPI) { if (wr == 0) PG8_BAR; }
    PG8_BAR;
#undef PG8_SA
#undef PG8_SB
#undef PG8_STAGE
#undef PG8_LDA
#undef PG8_LDB
#undef PG8_MMA
#undef PG8_WAIT_V
#undef PG8_WAIT_L
#undef PG8_BAR
#undef PG8_SCHED
}
}

constexpr int NWAVES = 8;
constexpr int NPHASE = 19;
constexpr size_t MiB = 1u << 20;
constexpr size_t WS_CTL = 0, CTL_ZERO_BYTES = 1 * MiB;
constexpr size_t WS_WA = 1 * MiB;
constexpr size_t WS_XB = 18 * MiB;
constexpr size_t WS_Y = 51 * MiB;
constexpr size_t WS_ZG = 117 * MiB;
constexpr size_t WS_BT3 = 249 * MiB, WS_BT4 = 253 * MiB, WS_BT5 = WS_WA, WS_BT6 = WS_ZG + 108 * MiB;
constexpr size_t WS_MB4S = WS_WA + 13 * MiB;
constexpr size_t WS_SLAB = WS_Y;
constexpr size_t WS_END = 255 * MiB;
static_assert(WS_XB + (size_t)M * DM * 2 <= WS_Y && WS_Y + (size_t)M * YC * 2 <= WS_ZG && WS_ZG + (size_t)M * GC * 2 <= WS_BT3 && WS_SLAB + (size_t)16 * 512 * DM * 4 <= WS_Y + 40 * MiB && WS_Y + 40 * MiB + 4 * 512 * 1024 <= WS_ZG, "ws map");
static_assert((size_t)M * FF * 2 <= 108 * MiB && WS_BT5 + (size_t)2 * FF * DM * 2 <= WS_MB4S && WS_MB4S + 4 * MiB <= WS_XB && WS_BT6 + (size_t)DM * FF * 2 <= WS_BT3, "ws map 2");
constexpr int CW_DN = 12288 + 64 * 8;
constexpr int CW_P0 = 65536;
constexpr int CW_RDY = 12288;
constexpr int CW_TMO = 0, CW_CODE = 1, CW_BAR = 4096, CW_SEAM = 16384, SEAM_BANK = 8192;
constexpr size_t WS_XCH = WS_Y + 40 * MiB;
constexpr int XLDS_OFF = 131072 + 1024;
constexpr int RING_OFF = 0, RING_BYTES = 131072;
constexpr int LDSCTL_OFF = RING_BYTES, MISC_OFF = LDSCTL_OFF + 320;
constexpr int LDS_BYTES = 147456;

#define GAS __attribute__((address_space(1)))
#define LAS __attribute__((address_space(3)))
typedef unsigned short bf16;
typedef unsigned v4u __attribute__((ext_vector_type(4)));
typedef unsigned v2u __attribute__((ext_vector_type(2)));
typedef float f32x4 __attribute__((ext_vector_type(4)));
typedef float f32x2 __attribute__((ext_vector_type(2)));
typedef short bf16x8 __attribute__((ext_vector_type(8)));
typedef GAS unsigned gu32;
#define RLX_AGENT __ATOMIC_RELAXED, __HIP_MEMORY_SCOPE_AGENT
#define LDS_WAIT() asm volatile("s_waitcnt lgkmcnt(0)" ::: "memory")
#define VM_WAIT() asm volatile("s_waitcnt vmcnt(0)" ::: "memory")
__device__ __forceinline__ unsigned pk2(float lo, float hi) { return pg8::cvt_pk_bf16(lo, hi); }
__device__ __forceinline__ float bflo(unsigned v) { return __uint_as_float(v << 16); }
__device__ __forceinline__ float bfhi(unsigned v) { return __uint_as_float(v & 0xffff0000u); }
__device__ __forceinline__ float bf1(unsigned short h) { return __uint_as_float((unsigned)h << 16); }
__device__ __forceinline__ unsigned short f2bf(float f) { return (unsigned short)(pg8::cvt_pk_bf16(f, 0.f) & 0xffffu); }

#define XB_TMO      128
#define XB_XCNT(j)  (256  + 64 * (j))
#define XB_XSUB(j)  (1280 + 64 * (j))
#define XB_XGEN(j)  (2304 + 64 * (j))
#define XB_TOP      3328
#define XB_TOPGEN   3392
#define XCD_BAR_WORDS 3456
#define XB_SPIN_CAP (1u << 18)
__device__ __forceinline__ unsigned xb_ld(unsigned* p)              { return __hip_atomic_load(p, __ATOMIC_RELAXED, __HIP_MEMORY_SCOPE_AGENT); }
__device__ __forceinline__ unsigned xb_add(unsigned* p, unsigned v) { return __hip_atomic_fetch_add(p, v, __ATOMIC_RELAXED, __HIP_MEMORY_SCOPE_AGENT); }
__device__ __forceinline__ unsigned xb_xcc_id() { return (unsigned)__builtin_amdgcn_s_getreg((3 << 11) | 20) & 0xFu; }
#define XB_SPIN(cond, bar) do { unsigned _sp = 0; while (cond) { __builtin_amdgcn_s_sleep(1); \
    if ((++_sp & 255u) == 0u) { if (xb_ld(&(bar)[XB_TMO])) break; if (_sp > XB_SPIN_CAP) { atomicAdd(&(bar)[XB_TMO], 1u); break; } } } } while (0)
struct XcdBarrier { unsigned* bar; unsigned x; volatile LAS unsigned* st; };
__device__ __forceinline__ XcdBarrier xcd_barrier_post(unsigned* bar, volatile LAS unsigned* st) {
    XcdBarrier b; b.bar = bar; b.x = xb_xcc_id(); b.st = st;
    if (threadIdx.x == 0) (void)xb_add(&bar[XB_XCNT(b.x)], 1u);
    return b;
}
__device__ __forceinline__ void xcd_barrier_complete(unsigned* bar, unsigned x, unsigned& nloc, unsigned& nx) {
    const unsigned G = gridDim.x * gridDim.y * gridDim.z;
    unsigned sum, cnt, mine, sp = 0u;
    for (;;) {
        sum = 0u; cnt = 0u; mine = 0u;
#pragma unroll
        for (unsigned j = 0; j < 16; ++j) { const unsigned c = xb_ld(&bar[XB_XCNT(j)]); sum += c; cnt += (c > 0u) ? 1u : 0u; mine = (j == x) ? c : mine; }
        if (sum == G) break;
        __builtin_amdgcn_s_sleep(1);
        if ((++sp & 255u) == 0u) { if (xb_ld(&bar[XB_TMO])) break; if (sp > XB_SPIN_CAP) { atomicAdd(&bar[XB_TMO], 1u); break; } }
    }
    nloc = mine > 0u ? mine : 1u; nx = cnt > 0u ? cnt : 1u;
}
__device__ __forceinline__ void xcd_barrier(const XcdBarrier& b) {
    asm volatile("s_waitcnt vmcnt(0)" ::: "memory");
    __syncthreads();
    if (threadIdx.x == 0) {
        unsigned* bar = b.bar;
        __builtin_amdgcn_s_waitcnt(0);
        unsigned nloc = b.st[0], nx = b.st[1];
        if (nloc == 0u) { xcd_barrier_complete(bar, b.x, nloc, nx); b.st[0] = nloc; b.st[1] = nx; }
        const unsigned old = xb_add(&bar[XB_XSUB(b.x)], 1u);
        const unsigned gen = old / nloc;
        if (old + 1u == (gen + 1u) * nloc) {
            __builtin_amdgcn_fence(__ATOMIC_RELEASE, "agent");
            asm volatile("s_waitcnt vmcnt(0)" ::: "memory");
            const unsigned og = xb_add(&bar[XB_TOP], 1u);
            const unsigned tg = og / nx;
            if (og + 1u == (tg + 1u) * nx) xb_add(&bar[XB_TOPGEN], 1u);
            else XB_SPIN(xb_ld(&bar[XB_TOPGEN]) == tg, bar);
            __builtin_amdgcn_fence(__ATOMIC_ACQUIRE, "agent");
            xb_add(&bar[XB_XGEN(b.x)], 1u);
            asm volatile("s_waitcnt vmcnt(0)" ::: "memory");
        } else {
            XB_SPIN(xb_ld(&bar[XB_XGEN(b.x)]) == gen, bar);
            __builtin_amdgcn_fence(__ATOMIC_ACQUIRE, "agent");
            asm volatile("s_waitcnt vmcnt(0)" ::: "memory");
        }
    }
    __syncthreads();
}

struct Frame {
    LAS unsigned char* lds;
    volatile LAS unsigned* MISC;
    gu32* ctl;
    int tid, lane, wave, G, bid;
    const float* const* in;
    float* out;
    unsigned char* ws;
};
enum { I_XP = 0, I_XS, I_SH, I_SRGC, I_SCF, I_SPOOL, I_SSC, I_WIN, I_RGCW, I_RGCB, I_RGWA, I_RGBA, I_RGWX, I_RGBX, I_LAM, I_CFW, I_CFB, I_CFG, I_CFBB, I_POOLW, I_POOLS, I_SCW,
       I_WBR, I_WOUT, I_LN1G, I_LN1B, I_WG, I_WU, I_WD, I_LN2G, I_LN2B };

__device__ __forceinline__ float shfl_idx(float v, int src_lane) { return __builtin_bit_cast(float, __builtin_amdgcn_ds_bpermute(src_lane << 2, __builtin_bit_cast(int, v))); }
__device__ __forceinline__ float wave_sum(float v, int lane) {
#pragma unroll
    for (int o = 1; o < 64; o <<= 1) v += shfl_idx(v, lane ^ o);
    return v;
}

enum { RM_ID = 0, RM_WIN = 1, RM_GU = 2 };
template <int MODE> __device__ __forceinline__ int rowmap(int s, int extra) {
    if (MODE == RM_ID) return s;
    if (MODE == RM_GU) return 256 * (s >> 7) + (s & 127) + extra;
    if (s < 1024) return s;
    if (s < 2048) { const int j = ((s - 1024) >> 7) & 3; return 1024 + 256 * j + (s >= 1536 ? 128 : 0) + (s & 127); }
    if (s < 3072) return s;
    if (s < 4096) { const int j = ((s - 3072) >> 7) & 3; return 3072 + 256 * j + (s >= 3584 ? 128 : 0) + (s & 127); }
    const int g = (s - 4096) >> 10, ch = s & 1023, pn = ch >> 6, chl = ch & 63, wc = chl >> 4, fq = (chl >> 2) & 3, i = chl & 3;
    return 4096 + 256 * pn + 128 * (g >> 1) + 32 * wc + 8 * fq + 4 * (g & 1) + i;
}
template <int MODE>
__device__ __forceinline__ void transpose_item(const float* W, int K, int N, bf16* WT, int dst_ld, int dst_koff, int extra, LAS float* scr, int item, int lane, int nb0, int nnb) {
    const int kb = item / nnb, nb = nb0 + item % nnb, k0 = 64 * kb, n0 = 32 * nb;
    { float tv[32];
      const float* wp = W + (size_t)(k0 + (lane >> 5)) * N + n0 + (lane & 31);
#pragma unroll
      for (int i = 0; i < 32; ++i) tv[i] = wp[(size_t)(2 * i) * N];
#pragma unroll
      for (int i = 0; i < 32; ++i) scr[(2 * i + (lane >> 5)) * 33 + (lane & 31)] = tv[i]; }
    LDS_WAIT(); asm volatile("" ::: "memory");
    const int c = lane & 7; const float sc = (MODE == RM_WIN && n0 >= 4096) ? -1.44269504089f : 1.0f;
#pragma unroll
    for (int j = 0; j < 4; ++j) { const int n = (lane >> 3) + 8 * j; const LAS float* s = scr + (8 * c) * 33 + n;
        v4u o; o.x = pk2(s[0 * 33] * sc, s[1 * 33] * sc); o.y = pk2(s[2 * 33] * sc, s[3 * 33] * sc); o.z = pk2(s[4 * 33] * sc, s[5 * 33] * sc); o.w = pk2(s[6 * 33] * sc, s[7 * 33] * sc);
        *(GAS v4u*)(WT + (size_t)rowmap<MODE>(n0 + n, extra) * dst_ld + dst_koff + k0 + 8 * c) = o; }
    LDS_WAIT(); asm volatile("" ::: "memory");
}
template <int MODE>
__device__ __forceinline__ void convert_matrix(Frame& F, const float* W, int K, int N, bf16* WT, int dst_ld, int dst_koff, int extra, int gw, int NGW, int first = 0, int nb0 = 0, int nnb = 0) {
    LAS float* scr = (LAS float*)(F.lds + RING_OFF + F.wave * 16384);
    if (nnb == 0) nnb = N / 32;
    const int nitems = (K / 64) * nnb;
    int it0 = gw - first; if (it0 < 0) it0 += ((-it0 + NGW - 1) / NGW) * NGW;
    for (int it = it0; it < nitems; it += NGW) transpose_item<MODE>(W, K, N, WT, dst_ld, dst_koff, extra, scr, it, F.lane, nb0, nnb);
}
__device__ __forceinline__ void compose_pool(Frame& F, int layer, bf16* Bt3, int gw, int NGW, int first = 0) {
    const float* pw = F.in[I_POOLW] + (size_t)layer * 4 * 128 * 128; const float* ps = F.in[I_POOLS] + layer * 512; const float* Wb2 = F.in[I_WBR] + ((size_t)layer * 4 + 2) * 512 * 1024;
    const int lane = F.lane;
    LAS float* Pl = (LAS float*)(F.lds + RING_OFF + F.wave * 16384);
    int id0 = gw - first; if (id0 < 0) id0 += ((-id0 + NGW - 1) / NGW) * NGW;
    for (int id = id0; id < 512; id += NGW) {
        const int g = __builtin_amdgcn_readfirstlane(id >> 7), c0 = __builtin_amdgcn_readfirstlane(8 * ((id >> 3) & 15)), d0 = 128 * (id & 7) + 2 * lane;
#pragma unroll
        for (int k = 0; k < 4; ++k) { const int idx4 = lane + 64 * k, i = idx4 >> 5, e4 = (idx4 & 31) * 4;
            const f32x4 pv = *(const GAS f32x4*)(pw + ((size_t)g * 128 + c0 + i) * 128 + e4), sv = *(const GAS f32x4*)(ps + 128 * g + e4);
            Pl[(e4 + 0) * 8 + i] = pv.x * sv.x; Pl[(e4 + 1) * 8 + i] = pv.y * sv.y; Pl[(e4 + 2) * 8 + i] = pv.z * sv.z; Pl[(e4 + 3) * 8 + i] = pv.w * sv.w; }
        LDS_WAIT(); asm volatile("" ::: "memory");
        f32x2 acc[8];
#pragma unroll
        for (int i = 0; i < 8; ++i) acc[i] = (f32x2){0.f, 0.f};
        const float* wrow = Wb2 + (size_t)(128 * g) * 1024 + d0;
#pragma unroll 1
        for (int e0 = 0; e0 < 128; e0 += 8) {
            f32x2 wv[8];
#pragma unroll
            for (int k = 0; k < 8; ++k) wv[k] = *(const GAS f32x2*)(wrow + (size_t)(e0 + k) * 1024);
#pragma unroll
            for (int k = 0; k < 8; ++k) { const f32x4 p0 = *(const LAS f32x4*)(Pl + (e0 + k) * 8), p1 = *(const LAS f32x4*)(Pl + (e0 + k) * 8 + 4);
#pragma unroll
                for (int i = 0; i < 4; ++i) { acc[i] += wv[k] * p0[i]; acc[4 + i] += wv[k] * p1[i]; } }
        }
        v4u o0, o1;
        o0.x = pk2(acc[0].x, acc[1].x); o0.y = pk2(acc[2].x, acc[3].x); o0.z = pk2(acc[4].x, acc[5].x); o0.w = pk2(acc[6].x, acc[7].x);
        o1.x = pk2(acc[0].y, acc[1].y); o1.y = pk2(acc[2].y, acc[3].y); o1.z = pk2(acc[4].y, acc[5].y); o1.w = pk2(acc[6].y, acc[7].y);
        *(GAS v4u*)(Bt3 + (size_t)d0 * 2048 + 1024 + 128 * g + c0) = o0; *(GAS v4u*)(Bt3 + (size_t)(d0 + 1) * 2048 + 1024 + 128 * g + c0) = o1;
        LDS_WAIT(); asm volatile("" ::: "memory");
    }
}

__device__ __forceinline__ const float* xrow_in(Frame& F, int m) { return m < MP ? F.in[I_XP] + (size_t)m * DM : F.in[I_XS] + (size_t)(m - MP) * DM; }
template <int NR>
__device__ __forceinline__ void x_rows(Frame& F, bf16* XB, int m0) {
    f32x4 v[NR][4];
#pragma unroll
    for (int k = 0; k < NR; ++k) { const GAS f32x4* xr = (const GAS f32x4*)xrow_in(F, m0 + k) + F.lane;
#pragma unroll
        for (int j = 0; j < 4; ++j) v[k][j] = xr[64 * j]; }
#pragma unroll
    for (int k = 0; k < NR; ++k) { GAS v2u* o = (GAS v2u*)(XB + (size_t)(m0 + k) * DM) + F.lane;
#pragma unroll
        for (int j = 0; j < 4; ++j) o[64 * j] = (v2u){pk2(v[k][j].x, v[k][j].y), pk2(v[k][j].z, v[k][j].w)}; }
}
__device__ __forceinline__ void x_to_bf16(Frame& F, bf16* XB, gu32* ctr) {
    const int gw = F.bid * NWAVES + F.wave, NGW = F.G * NWAVES;
    if (F.G != 256) { for (int m0 = 4 * gw; m0 < M; m0 += 4 * NGW) x_rows<4>(F, XB, m0); return; }
    unsigned claim = 0;
    if (F.tid == 0) claim = __hip_atomic_fetch_add((unsigned*)ctr, 1u, __ATOMIC_RELAXED, __HIP_MEMORY_SCOPE_AGENT);
    x_rows<4>(F, XB, 4 * gw);
    for (int it = 0;; ++it) {
        volatile LAS unsigned* slot = F.MISC + 32 + (it & 1);
        if (F.tid == 0) *slot = claim;
        __syncthreads();
        const int c = __builtin_amdgcn_readfirstlane((int)*slot);
        if (c >= (M - 8192) / 16) break;
        if (F.tid == 0) claim = __hip_atomic_fetch_add((unsigned*)ctr, 1u, __ATOMIC_RELAXED, __HIP_MEMORY_SCOPE_AGENT);
        x_rows<2>(F, XB, 8192 + 16 * c + 2 * F.wave);
    }
}
__device__ __forceinline__ void ln_rows(Frame& F, const float* V, float* O, const float* g, const float* b, bf16* XB, const float* sbase, const float* slab, int nslab, int wg0 = 0) {
    const int gw = ((F.bid - wg0 + F.G) % F.G) * NWAVES + F.wave, NGW = F.G * NWAVES;
    f32x4 gv[4], bv[4];
#pragma unroll
    for (int j = 0; j < 4; ++j) { gv[j] = ((const GAS f32x4*)g)[F.lane + 64 * j]; bv[j] = ((const GAS f32x4*)b)[F.lane + 64 * j]; }
    for (int m = MP + gw; m < M; m += NGW) {
        const GAS f32x4* xr = (const GAS f32x4*)(V + (size_t)m * DM) + F.lane; GAS f32x4* orow = (GAS f32x4*)(O + (size_t)m * DM) + F.lane;
        f32x4 v[4]; float s = 0.f;
#pragma unroll
        for (int j = 0; j < 4; ++j) v[j] = xr[64 * j];
        if (m >= MP) { const GAS f32x4* br = (const GAS f32x4*)(sbase + (size_t)(m - MP) * DM) + F.lane;
#pragma unroll
            for (int j = 0; j < 4; ++j) v[j] = br[64 * j] * ALPHA;
            for (int sl = 0; sl < nslab; sl += 4) {
                f32x4 t[4][4];
#pragma unroll
                for (int k = 0; k < 4; ++k) { const GAS f32x4* sr = (const GAS f32x4*)(slab + ((size_t)(sl + k < nslab ? sl + k : sl) * 512 + (m - MP)) * DM) + F.lane;
#pragma unroll
                    for (int j = 0; j < 4; ++j) t[k][j] = sr[64 * j]; }
#pragma unroll
                for (int k = 0; k < 4; ++k) if (sl + k < nslab) {
#pragma unroll
                    for (int j = 0; j < 4; ++j) v[j] += t[k][j]; } } }
#pragma unroll
        for (int j = 0; j < 4; ++j) s += (v[j].x + v[j].y) + (v[j].z + v[j].w);
        const float mean = wave_sum(s, F.lane) * (1.f / DM); float s2 = 0.f;
#pragma unroll
        for (int j = 0; j < 4; ++j) { v[j] = v[j] - mean; s2 += (v[j].x * v[j].x + v[j].y * v[j].y) + (v[j].z * v[j].z + v[j].w * v[j].w); }
        const float rstd = __builtin_amdgcn_rsqf(wave_sum(s2, F.lane) * (1.f / DM) + LN_EPS);
#pragma unroll
        for (int j = 0; j < 4; ++j) { v[j] = v[j] * rstd * gv[j] + bv[j]; orow[64 * j] = v[j]; }
        if (XB) { GAS v2u* o = (GAS v2u*)(XB + (size_t)m * DM) + F.lane;
#pragma unroll
            for (int j = 0; j < 4; ++j) o[64 * j] = (v2u){pk2(v[j].x, v[j].y), pk2(v[j].z, v[j].w)}; }
    }
}

__device__ __forceinline__ void publish_ready(Frame& F, gu32* ctr) {
    VM_WAIT(); __syncthreads();
    if (F.tid == 0) { __builtin_amdgcn_fence(__ATOMIC_RELEASE, "agent"); asm volatile("s_waitcnt vmcnt(0)" ::: "memory"); __hip_atomic_fetch_add((unsigned*)ctr, 1u, __ATOMIC_RELAXED, __HIP_MEMORY_SCOPE_AGENT); }
}
__device__ __forceinline__ void wait_ready(Frame& F, gu32* ctr, unsigned need) {
    if (F.wave == 0) { unsigned spins = 0;
        while ((unsigned)__builtin_amdgcn_readfirstlane(__hip_atomic_load((unsigned*)ctr, __ATOMIC_RELAXED, __HIP_MEMORY_SCOPE_AGENT)) < need) { __builtin_amdgcn_s_sleep(2); if (++spins > (1u << 20)) break; }
        __builtin_amdgcn_fence(__ATOMIC_ACQUIRE, "agent"); asm volatile("s_waitcnt vmcnt(0)" ::: "memory"); }
    __syncthreads();
}
__device__ __forceinline__ float softplusf_acc(float x) { return fmaxf(x, 0.f) + log1pf(__expf(-fabsf(x))); }
__device__ __forceinline__ float expm1_neg(float x) {
    const float p = x * (1.f + x * (0.5f + x * (1.f / 6.f + x * (1.f / 24.f + x * (1.f / 120.f + x * (1.f / 720.f + x * (1.f / 5040.f)))))));
    return x > -0.25f ? p : __expf(x) - 1.f;
}
constexpr int PATCH_STRIDE = 144;

struct ALane {
    float cwD[4], cbD, ba, bx, ck;
    bf16x8 Ba[4][2], Bx[4][2];
};
constexpr int PATCH_BYTES = 5120, ASLOT_OFF = 8 * PATCH_BYTES;
__device__ __forceinline__ void a_setup(Frame& F, int layer, int n, int q, ALane& L) {
    const int c = F.lane & 15, kg = F.lane >> 4, och = 64 * n + 16 * q + c;
    const float* cw = F.in[I_RGCW] + (size_t)layer * 4 * 512 + 64 * n; const float* cb = F.in[I_RGCB] + layer * 512 + 64 * n;
#pragma unroll
    for (int j = 0; j < 4; ++j) L.cwD[j] = cw[j * 512 + 16 * q + c];
    L.cbD = cb[16 * q + c];
    L.ck = 8.0f * softplusf_acc(-F.in[I_LAM][layer * 512 + och]);
    const float* wa = F.in[I_RGWA] + ((size_t)layer * 8 + n) * 4096 + 16 * q + c; const float* wx = F.in[I_RGWX] + ((size_t)layer * 8 + n) * 4096 + 16 * q + c;
    float wav[16], wxv[16], cbv[16];
#pragma unroll
    for (int e = 0; e < 16; ++e) { const int k = (e < 8 ? 8 * kg + e : 32 + 8 * kg + (e - 8)); wav[e] = wa[k * 64]; wxv[e] = wx[k * 64]; cbv[e] = cb[k]; }
#pragma unroll
    for (int j = 0; j < 4; ++j) { float t[16];
#pragma unroll
        for (int e = 0; e < 16; ++e) t[e] = cw[j * 512 + (e < 8 ? 8 * kg + e : 32 + 8 * kg + (e - 8))];
        L.Ba[j][0] = __builtin_bit_cast(bf16x8, (v4u){pk2(wav[0] * t[0], wav[1] * t[1]), pk2(wav[2] * t[2], wav[3] * t[3]), pk2(wav[4] * t[4], wav[5] * t[5]), pk2(wav[6] * t[6], wav[7] * t[7])});
        L.Ba[j][1] = __builtin_bit_cast(bf16x8, (v4u){pk2(wav[8] * t[8], wav[9] * t[9]), pk2(wav[10] * t[10], wav[11] * t[11]), pk2(wav[12] * t[12], wav[13] * t[13]), pk2(wav[14] * t[14], wav[15] * t[15])});
        L.Bx[j][0] = __builtin_bit_cast(bf16x8, (v4u){pk2(wxv[0] * t[0], wxv[1] * t[1]), pk2(wxv[2] * t[2], wxv[3] * t[3]), pk2(wxv[4] * t[4], wxv[5] * t[5]), pk2(wxv[6] * t[6], wxv[7] * t[7])});
        L.Bx[j][1] = __builtin_bit_cast(bf16x8, (v4u){pk2(wxv[8] * t[8], wxv[9] * t[9]), pk2(wxv[10] * t[10], wxv[11] * t[11]), pk2(wxv[12] * t[12], wxv[13] * t[13]), pk2(wxv[14] * t[14], wxv[15] * t[15])}); }
    float sa = 0.f, sx = 0.f;
#pragma unroll
    for (int e = 0; e < 16; ++e) { sa = fmaf(cbv[e], wav[e], sa); sx = fmaf(cbv[e], wxv[e], sx); }
    sa += shfl_idx(sa, F.lane ^ 16); sa += shfl_idx(sa, F.lane ^ 32); sx += shfl_idx(sx, F.lane ^ 16); sx += shfl_idx(sx, F.lane ^ 32);
    L.ba = F.in[I_RGBA][layer * 512 + och] + sa; L.bx = F.in[I_RGBX][layer * 512 + och] + sx;
}
__device__ __forceinline__ void a_block(const ALane& L, const LAS unsigned char* patch, int rowA0, int baseD, int q, int lane, float (&a)[4], float (&bb)[4]) {
    const int c = lane & 15, kg = lane >> 4;
    f32x4 accR = (f32x4){0.f, 0.f, 0.f, 0.f}, accI = (f32x4){0.f, 0.f, 0.f, 0.f};
#pragma unroll
    for (int j = 0; j < 4; ++j) { const LAS unsigned char* rp = patch + (rowA0 + j) * PATCH_STRIDE + 16 * kg;
        const bf16x8 A0 = *(const LAS bf16x8*)rp, A1 = *(const LAS bf16x8*)(rp + 64);
        accR = __builtin_amdgcn_mfma_f32_16x16x32_bf16(A0, L.Ba[j][0], accR, 0, 0, 0); accR = __builtin_amdgcn_mfma_f32_16x16x32_bf16(A1, L.Ba[j][1], accR, 0, 0, 0);
        accI = __builtin_amdgcn_mfma_f32_16x16x32_bf16(A0, L.Bx[j][0], accI, 0, 0, 0); accI = __builtin_amdgcn_mfma_f32_16x16x32_bf16(A1, L.Bx[j][1], accI, 0, 0, 0); }
    float pv[7];
#pragma unroll
    for (int k = 0; k < 7; ++k) pv[k] = bf1(*(const LAS unsigned short*)(patch + (baseD + k) * PATCH_STRIDE + 2 * (16 * q + c)));
#pragma unroll
    for (int r = 0; r < 4; ++r) {
        const float xd = L.cbD + L.cwD[0] * pv[r] + L.cwD[1] * pv[r + 1] + L.cwD[2] * pv[r + 2] + L.cwD[3] * pv[r + 3];
        const float rr = pg8::sigmoidf_fast(accR[r] + L.ba), ii = pg8::sigmoidf_fast(accI[r] + L.bx);
        const float la = -L.ck * rr;
        const float av = __builtin_amdgcn_exp2f(1.44269504089f * la);
        a[r] = av; bb[r] = __builtin_amdgcn_sqrtf(fmaxf(1.f - av * av, 0.f)) * (ii * xd);
    }
}
struct BlkScan { float Ac[4], Bc[4], EA, EB, WA, WB; };
__device__ __forceinline__ void blk_scan(const float (&a)[4], const float (&bb)[4], int lane, BlkScan& S) {
    const int c = lane & 15, g = lane >> 4;
    S.Ac[0] = a[0]; S.Bc[0] = bb[0];
#pragma unroll
    for (int r = 1; r < 4; ++r) { S.Ac[r] = a[r] * S.Ac[r - 1]; S.Bc[r] = a[r] * S.Bc[r - 1] + bb[r]; }
    float IA = S.Ac[3], IB = S.Bc[3];
    { const float pa = shfl_idx(IA, lane - 16), pb = shfl_idx(IB, lane - 16); if (g >= 1) { IB = IA * pb + IB; IA = IA * pa; } }
    { const float pa = shfl_idx(IA, lane - 32), pb = shfl_idx(IB, lane - 32); if (g >= 2) { IB = IA * pb + IB; IA = IA * pa; } }
    S.EA = shfl_idx(IA, lane - 16); S.EB = shfl_idx(IB, lane - 16); if (g == 0) { S.EA = 1.f; S.EB = 0.f; }
    S.WA = shfl_idx(IA, 48 + c); S.WB = shfl_idx(IB, 48 + c);
}
__device__ __forceinline__ void a_prompt_item(Frame& F, int layer, int item, const bf16* Z, bf16* Y) {
    const int b = item >> 5, n = (item >> 2) & 7, q = item & 3, lane = opqv(F.lane), w = F.wave, c = lane & 15, g = lane >> 4, och = 64 * n + 16 * q + c;
    ALane L; a_setup(F, layer, n, q, L);
    LAS unsigned char* patch = F.lds + RING_OFF + w * PATCH_BYTES;
    LAS f32x2* slots = (LAS f32x2*)(F.lds + RING_OFF + ASLOT_OFF);
    const bf16* Zb = Z + (size_t)b * SEQ * ZC; bf16* Yb = Y + (size_t)b * SEQ * YC;
    float hrun = 0.f;
    v4u pf[5];
    auto load_patch = [&](int tb) {
#pragma unroll
        for (int k = 0; k < 5; ++k) { const int ci = lane + 64 * k, pr = ci >> 3, cc = ci & 7, t = tb - 3 + pr;
            pf[k] = (ci < 280 && t >= 0) ? *(const GAS v4u*)(Zb + (size_t)t * ZC + 64 * n + 8 * cc) : (v4u){0u, 0u, 0u, 0u}; }
    };
    load_patch(32 * w);
    for (int it = 0; it < 8; ++it) {
        const int tb = 256 * it + 32 * w;
#pragma unroll
        for (int k = 0; k < 5; ++k) { const int ci = lane + 64 * k, pr = ci >> 3, cc = ci & 7; if (ci < 280) *(LAS v4u*)(patch + pr * PATCH_STRIDE + 16 * cc) = pf[k]; }
        if (it < 7) load_patch(tb + 256);
        unsigned short gav[8];
#pragma unroll
        for (int r = 0; r < 8; ++r) gav[r] = ((const GAS unsigned short*)Zb)[(unsigned)((tb + 16 * (r >> 2) + 4 * g + (r & 3)) * ZC + 512 + och)];
        asm volatile("" ::: "memory");
        float a0[4], b0[4], a1[4], b1[4];
        a_block(L, patch, lane & 15, 4 * g, q, lane, a0, b0);
        a_block(L, patch, 16 + (lane & 15), 16 + 4 * g, q, lane, a1, b1);
        BlkScan S0, S1; blk_scan(a0, b0, lane, S0); blk_scan(a1, b1, lane, S1);
        if (lane < 16) slots[((it & 1) * 8 + w) * 16 + c] = (f32x2){S0.WA * S1.WA, S1.WA * S0.WB + S1.WB};
        __syncthreads();
        float hin = hrun, hw = 0.f;
#pragma unroll
        for (int ww = 0; ww < 8; ++ww) { const f32x2 s = slots[((it & 1) * 8 + ww) * 16 + c]; if (ww == w) hw = hin; hin = s.x * hin + s.y; }
        hrun = hin;
        const float hg0 = S0.EA * hw + S0.EB, hw1 = S0.WA * hw + S0.WB, hg1 = S1.EA * hw1 + S1.EB;
#pragma unroll
        for (int r = 0; r < 4; ++r) { const float h = S0.Ac[r] * hg0 + S0.Bc[r];
            ((GAS unsigned short*)Yb)[(unsigned)((tb + 4 * g + r) * YC + och)] = f2bf(h * bf1(gav[r])); }
#pragma unroll
        for (int r = 0; r < 4; ++r) { const float h = S1.Ac[r] * hg1 + S1.Bc[r];
            ((GAS unsigned short*)Yb)[(unsigned)((tb + 16 + 4 * g + r) * YC + och)] = f2bf(h * bf1(gav[4 + r]));
            if (r == 3 && it == 7 && w == 7 && g == 3) F.out[O_PH + (size_t)(layer * 8 + b) * 512 + och] = h; }
    }
}
__device__ __forceinline__ void a_sample_task(Frame& F, int layer, int task, const bf16* Z, bf16* Y) {
    const int blk = task >> 5, n = (task >> 2) & 7, q = task & 3, lane = opqv(F.lane), c = lane & 15, g = lane >> 4, och = 64 * n + 16 * q + c, s0 = 4 * blk;
    ALane L; a_setup(F, layer, n, q, L);
    LAS unsigned char* patch = F.lds + RING_OFF + F.wave * PATCH_BYTES;
#pragma unroll
    for (int k = 0; k < 4; ++k) { const int ci = lane + 64 * k; if (ci < 224) { const int pr = ci >> 3, cc = ci & 7, sq = pr / 7, tau = pr - 7 * sq - 3, seq = s0 + sq; v4u v;
            if (tau < 0) { const GAS f32x4* sp = (const GAS f32x4*)(F.in[I_SRGC] + ((size_t)(layer * 128 + seq) * 3 + (tau + 3)) * 512 + 64 * n + 8 * cc); const f32x4 f0 = sp[0], f1 = sp[1];
                v = (v4u){pk2(f0.x, f0.y), pk2(f0.z, f0.w), pk2(f1.x, f1.y), pk2(f1.z, f1.w)}; }
            else v = *(const GAS v4u*)(Z + (size_t)(MP + 4 * seq + tau) * ZC + 64 * n + 8 * cc);
            *(LAS v4u*)(patch + pr * PATCH_STRIDE + 16 * cc) = v; } }
    asm volatile("" ::: "memory");
    float a[4], bb[4];
    a_block(L, patch, 7 * ((lane & 15) >> 2) + (lane & 3), 7 * g, q, lane, a, bb);
    const int seq = s0 + g;
    float h = F.in[I_SH][(size_t)(layer * 128 + seq) * 512 + och];
#pragma unroll
    for (int r = 0; r < 4; ++r) { h = a[r] * h + bb[r]; const size_t row = (size_t)(MP + 4 * seq + r);
        *(GAS unsigned short*)(Y + row * YC + och) = f2bf(h * bf1(*(const GAS unsigned short*)(Z + row * ZC + 512 + och))); }
    F.out[O_SH + (size_t)(layer * 128 + seq) * 512 + och] = h;
}

__device__ __forceinline__ void ln_silu_row(const LAS float* xr, const float* g, const float* b, bf16* dst, int lane) {
    const f32x4 v0 = *(const LAS f32x4*)(xr + 4 * lane), v1 = *(const LAS f32x4*)(xr + 256 + 4 * lane);
    const float s = (v0.x + v0.y) + (v0.z + v0.w) + (v1.x + v1.y) + (v1.z + v1.w);
    const float mean = wave_sum(s, lane) * (1.f / 512.f);
    const f32x4 d0 = v0 - mean, d1 = v1 - mean;
    const float s2 = (d0.x * d0.x + d0.y * d0.y) + (d0.z * d0.z + d0.w * d0.w) + (d1.x * d1.x + d1.y * d1.y) + (d1.z * d1.z + d1.w * d1.w);
    const float rstd = __builtin_amdgcn_rsqf(wave_sum(s2, lane) * (1.f / 512.f) + LN_EPS);
    const f32x4 g0 = *(const GAS f32x4*)(g + 4 * lane), g1 = *(const GAS f32x4*)(g + 256 + 4 * lane), b0 = *(const GAS f32x4*)(b + 4 * lane), b1 = *(const GAS f32x4*)(b + 256 + 4 * lane);
    f32x4 y0 = d0 * rstd * g0 + b0, y1 = d1 * rstd * g1 + b1;
#pragma unroll
    for (int i = 0; i < 4; ++i) { y0[i] = y0[i] * pg8::sigmoidf_fast(y0[i]); y1[i] = y1[i] * pg8::sigmoidf_fast(y1[i]); }
    *(GAS v2u*)(dst + 4 * lane) = (v2u){pk2(y0.x, y0.y), pk2(y0.z, y0.w)}; *(GAS v2u*)(dst + 256 + 4 * lane) = (v2u){pk2(y1.x, y1.y), pk2(y1.z, y1.w)};
}
__device__ __forceinline__ void ln_silu_rows4(const LAS float* xr, int rstride, const float* g, const float* b, bf16* dst, size_t dstride, int lane) {
    f32x4 v0[4], v1[4]; float s[4], s2[4];
#pragma unroll
    for (int k = 0; k < 4; ++k) { v0[k] = *(const LAS f32x4*)(xr + k * rstride + 4 * lane); v1[k] = *(const LAS f32x4*)(xr + k * rstride + 256 + 4 * lane);
        s[k] = (v0[k].x + v0[k].y) + (v0[k].z + v0[k].w) + (v1[k].x + v1[k].y) + (v1[k].z + v1[k].w); }
#pragma unroll
    for (int o = 1; o < 64; o <<= 1) {
#pragma unroll
        for (int k = 0; k < 4; ++k) s[k] += shfl_idx(s[k], lane ^ o); }
#pragma unroll
    for (int k = 0; k < 4; ++k) { const float mean = s[k] * (1.f / 512.f); v0[k] = v0[k] - mean; v1[k] = v1[k] - mean;
        s2[k] = (v0[k].x * v0[k].x + v0[k].y * v0[k].y) + (v0[k].z * v0[k].z + v0[k].w * v0[k].w) + (v1[k].x * v1[k].x + v1[k].y * v1[k].y) + (v1[k].z * v1[k].z + v1[k].w * v1[k].w); }
#pragma unroll
    for (int o = 1; o < 64; o <<= 1) {
#pragma unroll
        for (int k = 0; k < 4; ++k) s2[k] += shfl_idx(s2[k], lane ^ o); }
    const f32x4 g0 = *(const GAS f32x4*)(g + 4 * lane), g1 = *(const GAS f32x4*)(g + 256 + 4 * lane), b0 = *(const GAS f32x4*)(b + 4 * lane), b1 = *(const GAS f32x4*)(b + 256 + 4 * lane);
#pragma unroll
    for (int k = 0; k < 4; ++k) { const float rstd = __builtin_amdgcn_rsqf(s2[k] * (1.f / 512.f) + LN_EPS);
        f32x4 y0 = v0[k] * rstd * g0 + b0, y1 = v1[k] * rstd * g1 + b1;
#pragma unroll
        for (int i = 0; i < 4; ++i) { y0[i] = y0[i] * pg8::sigmoidf_fast(y0[i]); y1[i] = y1[i] * pg8::sigmoidf_fast(y1[i]); }
        bf16* d = dst + (size_t)k * dstride;
        *(GAS v2u*)(d + 4 * lane) = (v2u){pk2(y0.x, y0.y), pk2(y0.z, y0.w)}; *(GAS v2u*)(d + 256 + 4 * lane) = (v2u){pk2(y1.x, y1.y), pk2(y1.z, y1.w)}; }
}
__device__ __forceinline__ void b_prompt_item(Frame& F, int layer, int item, const bf16* Z, bf16* Y) {
    const int tidl = opqv(F.tid), b = item >> 5, t0 = 64 * (item & 31), p = tidl & 255, hh = tidl >> 8, ts = t0 + 32 * hh;
    const GAS unsigned* Zu = (const GAS unsigned*)(Z + (size_t)b * SEQ * ZC) + 512 + p;
    unsigned raw[62];
#pragma unroll
    for (int i = 0; i < 62; ++i) { const int t = ts - 30 + i; raw[i] = t >= 0 ? Zu[(size_t)t * (ZC / 2)] : 0u; }
    const float* cw = F.in[I_CFW] + (size_t)layer * 31 * 512 + 2 * p;
    f32x2 wj[31];
#pragma unroll
    for (int j = 0; j < 31; ++j) wj[j] = *(const GAS f32x2*)(cw + j * 512);
    const f32x2 bias = *(const GAS f32x2*)(F.in[I_CFB] + layer * 512 + 2 * p);
    f32x2 in[62];
#pragma unroll
    for (int i = 0; i < 62; ++i) in[i] = (f32x2){bflo(raw[i]), bfhi(raw[i])};
    LAS float* obuf = (LAS float*)(F.lds + RING_OFF);
#pragma unroll
    for (int i = 0; i < 32; ++i) { f32x2 o = bias;
#pragma unroll
        for (int j = 0; j < 31; ++j) o += wj[j] * in[i + j];
        *(LAS f32x2*)(obuf + (32 * hh + i) * 512 + 2 * p) = o; }
    __syncthreads();
    const float* lg = F.in[I_CFG] + layer * 512; const float* lb = F.in[I_CFBB] + layer * 512;
#pragma unroll 1
    for (int r = 8 * F.wave; r < 8 * F.wave + 8; r += 4) ln_silu_rows4(obuf + r * 512, 512, lg, lb, Y + (size_t)(b * SEQ + t0 + r) * YC + 512, YC, F.lane);
}
__device__ __forceinline__ void cd_prompt_item(Frame& F, int layer, int item, const bf16* Z, bf16* Y) {
    const int tidl = opqv(F.tid), b = item >> 5, t0 = 64 * (item & 31), p = tidl & 255, hh = tidl >> 8;
    const bf16* Zb = Z + (size_t)b * SEQ * ZC;
    LAS unsigned* cbuf = (LAS unsigned*)(F.lds + RING_OFF);
    { v4u tmp[10];
#pragma unroll
      for (int k = 0; k < 10; ++k) { const int ci = tidl + 512 * k, pr = ci >> 6, cc = ci & 63, t = t0 - 15 + pr;
          tmp[k] = (ci < 79 * 64 && t >= 0) ? *(const GAS v4u*)(Zb + (size_t)t * ZC + 1536 + 8 * cc) : (v4u){0u, 0u, 0u, 0u}; }
#pragma unroll
      for (int k = 0; k < 10; ++k) { const int ci = tidl + 512 * k, pr = ci >> 6, cc = ci & 63; if (ci < 79 * 64) *(LAS v4u*)(cbuf + pr * 256 + 4 * cc) = tmp[k]; } }
    const int ts = t0 + 32 * hh;
    unsigned uu[34], dd[32];
#pragma unroll
    for (int i = 0; i < 34; ++i) { const int t = ts - 2 + i; uu[i] = t >= 0 ? ((const GAS unsigned*)(Zb + (size_t)t * ZC))[1280 + p] : 0u; }
#pragma unroll
    for (int i = 0; i < 32; ++i) dd[i] = ((const GAS unsigned*)(Zb + (size_t)(ts + i) * ZC))[1024 + p];
    const f32x2 w0 = ((const GAS f32x2*)(F.in[I_SCW] + (size_t)(layer * 3 + 0) * 512))[p], w1 = ((const GAS f32x2*)(F.in[I_SCW] + (size_t)(layer * 3 + 1) * 512))[p],
                w2 = ((const GAS f32x2*)(F.in[I_SCW] + (size_t)(layer * 3 + 2) * 512))[p];
    __syncthreads();
    const int w = 2 << (p >> 6), rr0 = 15 + 32 * hh;
    f32x2 s = (f32x2){0.f, 0.f};
    for (int j = 0; j < w; ++j) { const unsigned v = cbuf[(rr0 - j) * 256 + p]; s += (f32x2){bflo(v), bfhi(v)}; }
    GAS unsigned* Yu = (GAS unsigned*)(Y + (size_t)(b * SEQ + ts) * YC) + p;
#pragma unroll
    for (int i = 0; i < 32; ++i) { const int t = ts + i, rr = rr0 + i;
        const unsigned cur = cbuf[rr * 256 + p]; const f32x2 cf = (f32x2){bflo(cur), bfhi(cur)};
        if (i > 0) { const unsigned old = cbuf[(rr - w) * 256 + p]; s += cf - (f32x2){bflo(old), bfhi(old)}; }
        const float ic = __builtin_amdgcn_rcpf((float)(t + 1 < w ? t + 1 : w));
        const f32x2 mm = s * ic - cf;
        Yu[(size_t)i * 1024 + 512] = pk2(mm.x, mm.y);
        const f32x2 cv = w0 * (f32x2){bflo(uu[i]), bfhi(uu[i])} + w1 * (f32x2){bflo(uu[i + 1]), bfhi(uu[i + 1])} + w2 * (f32x2){bflo(uu[i + 2]), bfhi(uu[i + 2])};
        const f32x2 yd = (f32x2){bflo(dd[i]), bfhi(dd[i])} * cv;
        Yu[(size_t)i * 1024 + 768] = pk2(yd.x, yd.y); }
}
__device__ __forceinline__ void s_sample_item(Frame& F, int layer, int s, const bf16* Z, bf16* Y) {
    const int ch = opqv(F.tid); const size_t ls = (size_t)layer * 128 + s;
    const bf16* Zr = Z + (size_t)(MP + 4 * s) * ZC; bf16* Yr = Y + (size_t)(MP + 4 * s) * YC;
    LAS float* obuf = (LAS float*)(F.lds + RING_OFF);
    float in[34], wv[31], pb[19], u[6], dbv[4];
#pragma unroll
    for (int j = 0; j < 30; ++j) in[j] = (F.in[I_SCF] + (ls * 30 + j) * 512)[ch];
#pragma unroll
    for (int j = 0; j < 15; ++j) pb[j] = (F.in[I_SPOOL] + (ls * 15 + j) * 512)[ch];
    u[0] = (F.in[I_SSC] + (ls * 2 + 0) * 512)[ch]; u[1] = (F.in[I_SSC] + (ls * 2 + 1) * 512)[ch];
#pragma unroll
    for (int r = 0; r < 4; ++r) { in[30 + r] = bf1((Zr + (size_t)r * ZC + 1024)[ch]); pb[15 + r] = bf1((Zr + (size_t)r * ZC + 1536)[ch]); u[2 + r] = bf1((Zr + (size_t)r * ZC + 2560)[ch]); dbv[r] = bf1((Zr + (size_t)r * ZC + 2048)[ch]); }
#pragma unroll
    for (int j = 0; j < 31; ++j) wv[j] = (F.in[I_CFW] + ((size_t)layer * 31 + j) * 512)[ch];
    const float bias = (F.in[I_CFB] + layer * 512)[ch];
    const float w0 = (F.in[I_SCW] + (size_t)(layer * 3 + 0) * 512)[ch], w1 = (F.in[I_SCW] + (size_t)(layer * 3 + 1) * 512)[ch], w2 = (F.in[I_SCW] + (size_t)(layer * 3 + 2) * 512)[ch];
    asm volatile("" ::: "memory");
#pragma unroll
    for (int j = 0; j < 26; ++j) (F.out + O_SCF + (ls * 30 + j) * 512)[ch] = in[j + 4];
#pragma unroll
    for (int r = 0; r < 4; ++r) { float o = bias;
#pragma unroll
        for (int j = 0; j < 31; ++j) o += wv[j] * in[r + j];
        obuf[r * 512 + ch] = o; }
#pragma unroll
    for (int j = 0; j < 11; ++j) (F.out + O_SPOOL + (ls * 15 + j) * 512)[ch] = pb[j + 4];
    const int gsel = ch >> 7;
#pragma unroll
    for (int r = 0; r < 4; ++r) { const int k = 15 + r;
        const float s2 = pb[k] + pb[k - 1], s4 = s2 + pb[k - 2] + pb[k - 3], s8 = s4 + (pb[k - 4] + pb[k - 5]) + (pb[k - 6] + pb[k - 7]);
        float s16 = s8;
#pragma unroll
        for (int j = 8; j < 16; ++j) s16 += pb[k - j];
        const float mv = (gsel == 0 ? s2 * 0.5f : gsel == 1 ? s4 * 0.25f : gsel == 2 ? s8 * 0.125f : s16 * 0.0625f) - pb[k];
        (Yr + (size_t)r * YC + 1024)[ch] = f2bf(mv); }
#pragma unroll
    for (int r = 0; r < 4; ++r) (Yr + (size_t)r * YC + 1536)[ch] = f2bf(dbv[r] * (w0 * u[r] + w1 * u[r + 1] + w2 * u[r + 2]));
    __syncthreads();
    if (F.wave < 4) ln_silu_row(obuf + F.wave * 512, F.in[I_CFG] + layer * 512, F.in[I_CFBB] + layer * 512, Yr + (size_t)F.wave * YC + 512, F.lane);
}

struct Args { const float* in[31]; float* out; unsigned char* ws; int ph_lo, ph_hi; };
__global__ void __launch_bounds__(NWAVES * 64, 2) hybrid_fwd(Args args) {
    extern __shared__ __attribute__((aligned(16))) unsigned char lds[];
    Frame F;
    F.lds = (LAS unsigned char*)lds;
    F.MISC = (volatile LAS unsigned*)(F.lds + MISC_OFF);
    const int wave0 = __builtin_amdgcn_readfirstlane((int)threadIdx.x >> 6);
    F.lane = lane_now(); F.wave = wave0; F.tid = F.wave * 64 + F.lane;
    F.G = gridDim.x; F.bid = blockIdx.x;
    F.ws = args.ws; F.out = args.out; F.ctl = (gu32*)(args.ws + WS_CTL);
    F.in = args.in;
    for (int u = F.tid; u < (LDS_BYTES - LDSCTL_OFF) / 4; u += NWAVES * 64) ((LAS unsigned*)(F.lds + LDSCTL_OFF))[u] = 0u;
    __syncthreads();
    XcdBarrier bar; bar.bar = (unsigned*)(F.ctl + CW_BAR); bar.x = 0; bar.st = nullptr;
    if (!MK_SPLIT) bar = xcd_barrier_post((unsigned*)(F.ctl + CW_BAR), F.MISC + 8);
    const int lo = args.ph_lo, hi = args.ph_hi;
#define IN(k) (lo <= (k) && (k) < hi)
#define REFRESH() do { F.lane = lane_now(); F.wave = opqs(wave0); F.tid = F.wave * 64 + F.lane; F.bid = opqs((int)blockIdx.x); } while (0)
#define SEAM(k) do { if (IN(k) && IN((k) + 1)) xcd_barrier(bar); } while (0)
    bf16* WA = (bf16*)(F.ws + WS_WA); bf16* XB = (bf16*)(F.ws + WS_XB); bf16* Y = (bf16*)(F.ws + WS_Y); bf16* Zm = (bf16*)(F.ws + WS_ZG); _Float16* Gb = (_Float16*)(F.ws + WS_ZG);
    bf16* Hb = (bf16*)(F.ws + WS_ZG); bf16* MB = (bf16*)F.out;
 bf16* Bt3 = (bf16*)(F.ws + WS_BT3); bf16* Bt4 = (bf16*)(F.ws + WS_BT4); bf16* Bt5 = (bf16*)(F.ws + WS_BT5); bf16* Bt6 = (bf16*)(F.ws + WS_BT6);

    if (IN(0)) { REFRESH(); convert_matrix<RM_WIN>(F, F.in[I_WIN], DM, INC, WA, DM, 0, 0, F.bid * NWAVES + F.wave, F.G * NWAVES); REFRESH(); x_to_bf16(F, XB, F.ctl + CW_P0); }
    SEAM(0);

    const bool fast = F.G == 256;
    for (int l = 0; l < 2; ++l) {
        const int pb = 1 + 9 * l;
        if (IN(pb + 0)) for (int rep = 0; rep < NREP(0); ++rep) { if (rep) xcd_barrier(bar);
            if (fast && l == 1 && rep == 0) { REFRESH();
                ln_rows(F, F.out, F.out, F.in[I_LN2G], F.in[I_LN2B], XB, F.out + (size_t)MP * DM, (const float*)(F.ws + WS_SLAB), 11, 32); publish_ready(F, F.ctl + CW_RDY + 64 * 1); }
            pg8::Gemm g{XB, WA, DM, DM, XB}; pg8::UnitOrder S; S.init(pg8::SK_PLAIN, 4096, DM, F.G, F.bid, 0); pg8::EpiMix E{Zm, F.out, l};
            if (fast && l == 1) { S.ready = (const unsigned*)(F.ctl + CW_RDY + 64 * 1); S.need = (unsigned)F.G; }
            pg8::gemm_phase<pg8::EpiMix, pg8::UnitOrder, true>(F.lds + RING_OFF, g, S, E, wave0);
            if (F.G == 256 && F.bid >= 32 && F.bid < 64 && rep + 1 == NREP(0)) {
                pg8::Gemm g2{XB, WA + (size_t)4096 * DM, DM, DM, XB}; pg8::UnitOrder S2; S2.init(pg8::SK_PLAIN, 4096, DM, 32, F.bid - 32, 0, false, true); pg8::EpiGate E2{Gb};
                if (fast && l == 1) { REFRESH(); wait_ready(F, F.ctl + CW_RDY + 64 * 1, (unsigned)F.G); }
                pg8::gemm_phase<pg8::EpiGate, pg8::UnitOrder, true>(F.lds + RING_OFF, g2, S2, E2, wave0); }
            if (F.G == 256 && F.bid >= 64 && rep + 1 == NREP(0)) {
                REFRESH(); const int gw = (F.bid - 64) * NWAVES + F.wave, NGW = 192 * NWAVES; const float* wbr = F.in[I_WBR] + (size_t)l * 4 * 512 * 1024;
                convert_matrix<RM_ID>(F, wbr, 512, 1024, Bt3, 2048, 0, 0, gw, NGW, 0);
                convert_matrix<RM_ID>(F, wbr + (size_t)512 * 1024, 512, 1024, Bt3, 2048, 512, 0, gw, NGW, 256);
                convert_matrix<RM_ID>(F, wbr + (size_t)3 * 512 * 1024, 512, 1024, Bt3, 2048, 1536, 0, gw, NGW, 512);
                convert_matrix<RM_ID>(F, F.in[I_WOUT] + (size_t)l * DM * DM, DM, DM, Bt4, DM, 0, 0, gw, NGW, 768);
                REFRESH(); compose_pool(F, l, Bt3, gw, NGW, 1280); } }
        SEAM(pb + 0);
        if (IN(pb + 1)) for (int rep = 0; rep < NREP(1); ++rep) { if (rep) xcd_barrier(bar);
            __syncthreads(); REFRESH();
            for (int r2 = 0; r2 < NREP2(0); ++r2) for (int it = F.bid; it < 256; it += F.G) { a_prompt_item(F, l, it, Zm, Y); __syncthreads(); }
            REFRESH();
            for (int r2 = 0; r2 < NREP2(1); ++r2) for (int it = (F.bid + 128) % F.G; it < 128; it += F.G) a_sample_task(F, l, 8 * it + F.wave, Zm, Y);
            __syncthreads(); REFRESH();
            const bool rebal = false, gemm_wg = false;
            for (int r2 = 0; r2 < NREP2(2); ++r2) { if (!gemm_wg) for (int it = F.bid; it < 256; it += F.G) { b_prompt_item(F, l, it, Zm, Y); __syncthreads(); }
                if (rebal && F.bid >= 160 && F.bid < 192) { b_prompt_item(F, l, F.bid - 32, Zm, Y); __syncthreads(); } }
            REFRESH();
            for (int r2 = 0; r2 < NREP2(3); ++r2) { if (!gemm_wg) for (int it = F.bid; it < 256; it += F.G) { cd_prompt_item(F, l, it, Zm, Y); __syncthreads(); }
                if (rebal && F.bid >= 192 && F.bid < 224) { cd_prompt_item(F, l, F.bid - 64, Zm, Y); __syncthreads(); } }
            REFRESH();
            for (int r2 = 0; r2 < NREP2(4); ++r2) for (int it = F.bid; it < 128; it += F.G) { s_sample_item(F, l, it, Zm, Y); __syncthreads(); }
            REFRESH();
            const float* wbr = F.in[I_WBR] + (size_t)l * 4 * 512 * 1024;
            if (F.G != 256) { const int gw = F.bid * NWAVES + F.wave, NGW = F.G * NWAVES;
                convert_matrix<RM_ID>(F, wbr, 512, 1024, Bt3, 2048, 0, 0, gw, NGW); convert_matrix<RM_ID>(F, wbr + (size_t)512 * 1024, 512, 1024, Bt3, 2048, 512, 0, gw, NGW);
                convert_matrix<RM_ID>(F, wbr + (size_t)3 * 512 * 1024, 512, 1024, Bt3, 2048, 1536, 0, gw, NGW); convert_matrix<RM_ID>(F, F.in[I_WOUT] + (size_t)l * DM * DM, DM, DM, Bt4, DM, 0, 0, gw, NGW);
                REFRESH(); compose_pool(F, l, Bt3, gw, NGW); }
        }
        SEAM(pb + 1);
        if (IN(pb + 2)) for (int rep = 0; rep < NREP(2); ++rep) { if (rep) xcd_barrier(bar); pg8::Gemm g{XB, WA + (size_t)4096 * DM, DM, DM, XB}; pg8::UnitOrder S; S.init(pg8::SK_PLAIN, 4096, DM, F.G, F.bid, 0, true, F.G != 256); pg8::EpiGate E{Gb};
            pg8::gemm_phase<pg8::EpiGate, pg8::UnitOrder, true>(F.lds + RING_OFF, g, S, E, wave0); }
        SEAM(pb + 2);
        if (IN(pb + 3)) for (int rep = 0; rep < NREP(3); ++rep) { if (rep) xcd_barrier(bar); pg8::Gemm g{Y, Bt3, 2048, 2048, Y}; pg8::UnitOrder S; S.init(pg8::SK_P3, DM, 2048, F.G, F.bid, 0); pg8::EpiMerge E{Gb, MB, (bf16*)(F.ws + WS_MB4S)};
            if (fast) { S.remap = true; S.doneP = (unsigned*)(F.ctl + CW_DN + 64 * (2 * l)); S.doneS = (unsigned*)(F.ctl + CW_DN + 64 * (2 * l + 1)); }
            pg8::gemm_phase<pg8::EpiMerge, pg8::UnitOrder, true>(F.lds + RING_OFF, g, S, E, wave0);
            if (F.G == 256 && (F.bid & 63) >= 8 && rep + 1 == NREP(3)) {
                REFRESH(); const int gw = ((F.bid >> 6) * 56 + (F.bid & 63) - 8) * NWAVES + F.wave, NGW = 224 * NWAVES;
                convert_matrix<RM_GU>(F, F.in[I_WG] + (size_t)l * DM * FF, DM, FF, Bt5, DM, 0, 0, gw, NGW, 0);
                convert_matrix<RM_GU>(F, F.in[I_WU] + (size_t)l * DM * FF, DM, FF, Bt5, DM, 0, 128, gw, NGW, 1408); } }
        if (!fast) SEAM(pb + 3);
        if (IN(pb + 4)) for (int rep = 0; rep < 1; ++rep) { pg8::Gemm g{MB, Bt4, DM, DM, (const bf16*)(F.ws + WS_MB4S)}; pg8::UnitOrder S; S.init(pg8::SK_P4, DM, DM, F.G, F.bid, 0);
            if (fast) { S.remap = true; S.ready = (const unsigned*)(F.ctl + CW_DN + 64 * (2 * l + 1)); S.need = 32u; REFRESH(); wait_ready(F, F.ctl + CW_DN + 64 * (2 * l), 256u); }
            pg8::EpiRes E{l == 0 ? F.in[I_XP] : nullptr, l == 0 ? nullptr : XB, nullptr, XB, F.in[I_LN1G] + l * DM, F.in[I_LN1B] + l * DM, (float*)(F.ws + WS_SLAB),
                          pg8::PanelStats{(unsigned*)(F.ws + WS_XCH + (size_t)(2 * l) * 512 * 1024), (unsigned*)(F.ctl + CW_SEAM + (2 * l) * SEAM_BANK)}, F.lds + XLDS_OFF, wave0};
            pg8::gemm_phase<pg8::EpiRes, pg8::UnitOrder, true>(F.lds + RING_OFF, g, S, E, wave0);
}
        SEAM(pb + 4);
        if (IN(pb + 5) && !fast) for (int rep = 0; rep < NREP(5); ++rep) { if (rep) xcd_barrier(bar);
            REFRESH();
            ln_rows(F, F.out, rep + 1 < NREP(5) ? (float*)(F.ws + WS_Y) : F.out, F.in[I_LN1G] + l * DM, F.in[I_LN1B] + l * DM, rep + 1 < NREP(5) ? nullptr : XB, l == 0 ? F.in[I_XS] : F.out + (size_t)MP * DM, (const float*)(F.ws + WS_SLAB), 16);
            REFRESH();
            if (F.G != 256) { const int gw = F.bid * NWAVES + F.wave, NGW = F.G * NWAVES;
                convert_matrix<RM_GU>(F, F.in[I_WG] + (size_t)l * DM * FF, DM, FF, Bt5, DM, 0, 0, gw, NGW); convert_matrix<RM_GU>(F, F.in[I_WU] + (size_t)l * DM * FF, DM, FF, Bt5, DM, 0, 128, gw, NGW);
                convert_matrix<RM_ID>(F, F.in[I_WD] + (size_t)l * FF * DM, FF, DM, Bt6, FF, 0, 0, gw, NGW); }
        }
        if (!fast) SEAM(pb + 5);
        if (IN(pb + 6)) for (int rep = 0; rep < NREP(6); ++rep) { if (rep) xcd_barrier(bar);
            if (fast && rep == 0) { REFRESH();
                ln_rows(F, F.out, F.out, F.in[I_LN1G] + l * DM, F.in[I_LN1B] + l * DM, XB, l == 0 ? F.in[I_XS] : F.out + (size_t)MP * DM, (const float*)(F.ws + WS_SLAB), 16, 172); publish_ready(F, F.ctl + CW_RDY + 64 * (2 * l)); }
            pg8::Gemm g{XB, Bt5, DM, DM, XB}; pg8::UnitOrder S; S.init(pg8::SK_PLAIN, 2 * FF, DM, F.G, F.bid, 0); pg8::EpiSwi E{Hb};
            if (fast) { S.ready = (const unsigned*)(F.ctl + CW_RDY + 64 * (2 * l)); S.need = (unsigned)F.G; }
            pg8::gemm_phase<pg8::EpiSwi, pg8::UnitOrder, true>(F.lds + RING_OFF, g, S, E, wave0);
            if (F.G == 256 && F.bid >= 172 && rep + 1 == NREP(6)) {
                REFRESH(); const int gw = (F.bid - 172) * NWAVES + F.wave, NGW = 84 * NWAVES;
                convert_matrix<RM_ID>(F, F.in[I_WD] + (size_t)l * FF * DM, FF, DM, Bt6, FF, 0, 0, gw, NGW, 0);
            } }
        SEAM(pb + 6);
        if (IN(pb + 7)) for (int rep = 0; rep < 1; ++rep) { pg8::Gemm g{Hb, Bt6, FF, FF, Hb}; pg8::UnitOrder S; S.init(pg8::SK_P6, DM, FF, F.G, F.bid, 0); pg8::EpiRes E{nullptr, XB, l == 1 ? F.out : nullptr, l == 0 ? XB : nullptr, F.in[I_LN2G] + l * DM, F.in[I_LN2B] + l * DM, (float*)(F.ws + WS_SLAB),
                          pg8::PanelStats{(unsigned*)(F.ws + WS_XCH + (size_t)(2 * l + 1) * 512 * 1024), (unsigned*)(F.ctl + CW_SEAM + (2 * l + 1) * SEAM_BANK)}, F.lds + XLDS_OFF, wave0};
            pg8::gemm_phase<pg8::EpiRes, pg8::UnitOrder, true>(F.lds + RING_OFF, g, S, E, wave0);
            if (F.G == 256 && F.bid >= 88 && l == 0) {
                REFRESH(); convert_matrix<RM_WIN>(F, F.in[I_WIN] + (size_t)DM * INC, DM, INC, WA, DM, 0, 0, (F.bid - 88) * NWAVES + F.wave, 168 * NWAVES); } }
        SEAM(pb + 7);
        if (IN(pb + 8) && !(fast && l == 0)) for (int rep = 0; rep < NREP(8); ++rep) { if (rep) xcd_barrier(bar);
            REFRESH();
            ln_rows(F, F.out, rep + 1 < NREP(8) ? (float*)(F.ws + WS_Y) : F.out, F.in[I_LN2G] + l * DM, F.in[I_LN2B] + l * DM, (l == 0 && rep + 1 == NREP(8)) ? XB : nullptr, F.out + (size_t)MP * DM, (const float*)(F.ws + WS_SLAB), 11);
            REFRESH();
            if (l == 0 && F.G != 256) convert_matrix<RM_WIN>(F, F.in[I_WIN] + (size_t)DM * INC, DM, INC, WA, DM, 0, 0, F.bid * NWAVES + F.wave, F.G * NWAVES);
        }
        if (l == 0 && !fast) SEAM(pb + 8);
    }
#undef IN
#undef SEAM
#undef REFRESH
}

extern "C" void kernel_launch(void* const* d_in, const int* in_sizes, int n_in, void* d_out, int out_size, void* d_ws, size_t ws_size, hipStream_t stream) {
    static int grid = 0;
    if (grid == 0) {
        if (n_in != 31 || out_size != (int)O_END || ws_size < WS_END) { fprintf(stderr, "kernel_launch: unexpected sizes n_in %d out %d ws %zu\n", n_in, out_size, ws_size); grid = -1; return; }
        int dev = 0, cus = 0, per_cu = 0;
        if (hipGetDevice(&dev) != hipSuccess || hipDeviceGetAttribute(&cus, hipDeviceAttributeMultiprocessorCount, dev) != hipSuccess) { grid = -1; return; }
        if (hipFuncSetAttribute((const void*)hybrid_fwd, hipFuncAttributeMaxDynamicSharedMemorySize, LDS_BYTES) != hipSuccess) { fprintf(stderr, "kernel_launch: hipFuncSetAttribute failed\n"); grid = -1; return; }
        if (hipOccupancyMaxActiveBlocksPerMultiprocessor(&per_cu, (const void*)hybrid_fwd, NWAVES * 64, LDS_BYTES) != hipSuccess || per_cu < 1)
            fprintf(stderr, "kernel_launch: occupancy query reports %d workgroups per CU\n", per_cu);
        (void)hipGetLastError();
        grid = cus;
    }
    if (grid < 0) return;
    if (hipMemsetAsync((char*)d_ws + WS_CTL, 0, CTL_ZERO_BYTES, stream) != hipSuccess) { fprintf(stderr, "kernel_launch: memset failed\n"); return; }
    Args a{};
    for (int i = 0; i < 31; ++i) a.in[i] = (const float*)d_in[i];
    a.out = (float*)d_out; a.ws = (unsigned char*)d_ws;
#if MK_SPLIT
    for (int ph = 0; ph < NPHASE; ++ph) { a.ph_lo = ph; a.ph_hi = ph + 1; hipLaunchKernelGGL(hybrid_fwd, dim3(grid), dim3(NWAVES * 64), LDS_BYTES, stream, a); }
#else
    a.ph_lo = 0; a.ph_hi = NPHASE;
    hipLaunchKernelGGL(hybrid_fwd, dim3(grid), dim3(NWAVES * 64), LDS_BYTES, stream, a);
#endif
}
```

```cpp
#include <hip/hip_runtime.h>
#include <cstdio>
#include <cstdint>

#ifndef PROBE_REP
#define PROBE_REP 0
#endif
#define NREP(k) (1 + ((PROBE_REP >> (k)) & 1))
#ifndef PROBE2
#define PROBE2 0
#endif
#define NREP2(j) (1 + ((PROBE2 >> (j)) & 1))
#ifndef MK_SPLIT
#define MK_SPLIT 0
#endif

constexpr int DM = 1024, WMIX = 512, NPB = 8, SEQ = 2048, NSB = 128, DSEQ = 4;
constexpr int MP = NPB * SEQ, MS = NSB * DSEQ, M = MP + MS;
constexpr int FF = 2816, INC = 8192, ZC = 3072, YC = 2048, GC = 4096;
constexpr float LN_EPS = 1e-5f, ALPHA = 1.41421356237f;
constexpr size_t O_Y = 0, O_PH = (size_t)M * DM, O_PRGC = O_PH + 8192, O_PCF = O_PRGC + 24576, O_PPOOL = O_PCF + 245760, O_PSC = O_PPOOL + 122880,
                 O_SH = O_PSC + 16384, O_SRGC = O_SH + 131072, O_SCF = O_SRGC + 393216, O_SPOOL = O_SCF + 3932160, O_SSC = O_SPOOL + 1966080, O_END = O_SSC + 262144;
static_assert(O_END == 24403968, "output map");

__device__ __forceinline__ int opqv(int v) { asm volatile("" : "+v"(v)); return v; }
__device__ __forceinline__ int lane_now() { int l; asm volatile("v_mbcnt_lo_u32_b32 %0, -1, 0\n\tv_mbcnt_hi_u32_b32 %0, -1, %0" : "=v"(l)); return l; }
__device__ __forceinline__ int opqs(int v) { asm volatile("" : "+s"(v)); return v; }
namespace pg8 {
#define PG8_LAS __attribute__((address_space(3)))
typedef unsigned short bf16_t;
typedef short bf16x8 __attribute__((ext_vector_type(8)));
typedef float f32x4 __attribute__((ext_vector_type(4)));
typedef float f32x2 __attribute__((ext_vector_type(2)));
typedef unsigned u32x4 __attribute__((ext_vector_type(4)));
typedef unsigned u32x2 __attribute__((ext_vector_type(2)));
typedef _Float16 f16x4 __attribute__((ext_vector_type(4)));
typedef _Float16 f16x8 __attribute__((ext_vector_type(8)));
constexpr int BM = 256, BK = 64, HALF = 128, HTB = HALF * BK * 2, STAGE_BYTES = 8 * HTB, NXCD = 8, WGM = 8;

__host__ __device__ __forceinline__ int lds_byte(int r, int c) { const int st = (r >> 4) * 2 + (c >> 5), rr = r & 15, cc = c & 31, ob = rr * 64 + cc * 2; return st * 1024 + (ob ^ (((ob >> 9) & 1) << 5)); }
__host__ __device__ __forceinline__ void stage_rc(int b, int& R, int& C) { const int st = b / 1024, sb = b % 1024, swz = sb ^ (((sb >> 9) & 1) << 5); R = (st >> 1) * 16 + swz / 64; C = (st & 1) * 32 + (swz % 64) / 2; }
__host__ __device__ __forceinline__ int perm32(int rho) { const int n = rho >> 4, i = rho & 15; return 8 * (i >> 2) + 4 * n + (i & 3); }

struct Unit { int pm, pn, nt, mode, aux; long offA, offB; };
struct Gemm { const bf16_t* A; const bf16_t* Bt; int lda, ldb; const bf16_t* As; };

enum { SK_PLAIN = 0, SK_P3 = 1, SK_P4 = 2, SK_P6 = 3 };
struct UnitOrder {
    int kind, nN, nwgP, nS, ntP, G, c; long offA_s; const unsigned* ready = nullptr; unsigned need = 0; unsigned* subP = nullptr; unsigned* topP = nullptr; unsigned* doneS = nullptr; unsigned nlocP = 0; int lastP = 0; bool fenceS = false; bool remap = false;
    __device__ __forceinline__ void init(int kind_, int N_, int K_, int G_, int c_, long offA_s_, bool prompt = true, bool sample = true) { kind = kind_; nN = N_ / BM; nwgP = prompt ? 64 * nN : 0; ntP = K_ / BK; G = G_; c = c_; offA_s = offA_s_;
        nS = !sample ? 0 : kind_ == SK_PLAIN ? 2 * nN : kind_ == SK_P3 ? 32 : kind_ == SK_P4 ? 128 : 88; }
    __device__ __forceinline__ bool next(int i, Unit& u, const Gemm& g) const {
        const long L = (long)i * G + c; const long ra = (long)BM * g.lda * 2, rb = (long)BM * g.ldb * 2;
        if (L < nwgP) {
            int wgid = (int)L; { const int q = nwgP / NXCD, xcd = wgid % NXCD, off = wgid / NXCD; wgid = xcd * q + off; }
            const int nig = WGM * nN; u.pm = (wgid / nig) * WGM + ((wgid % nig) % WGM); u.pn = (wgid % nig) / WGM;
            u.nt = ntP; u.mode = 0; u.aux = 0; u.offA = u.pm * ra; u.offB = u.pn * rb; return true; }
        int s = (int)(L - nwgP);
        if (remap) { const int r = c & 63, h = c >> 6; if (i != 1) return false;
            if (kind == SK_P3) { if (r >= 8) return false; s = h * 8 + r; } else { if (r < 8 || r >= 40) return false; s = h * 32 + r - 8; } }
        if (s >= nS) return false;
        if (kind == SK_PLAIN) { u.pm = 64 + (s & 1); u.pn = s >> 1; u.nt = ntP; u.mode = 0; u.aux = 0; u.offA = u.pm * ra; u.offB = u.pn * rb; }
        else if (kind == SK_P3) { const int n = s & 3, tile = s >> 2; u.pm = 64 + (tile & 1); u.pn = tile >> 1; u.nt = 8; u.mode = 1; u.aux = n; u.offA = u.pm * ra + 1024 * n; u.offB = u.pn * rb + 1024 * n; }
        else if (kind == SK_P4) { const int ch = s & 15, tile = s >> 4, n = ch >> 2, kin = (ch & 3) * 256; u.pm = 64 + (tile & 1); u.pn = tile >> 1; u.nt = 4; u.mode = 1; u.aux = ch;
            u.offA = ((long)(n * 512 + (u.pm - 64) * 256) * 1024 + kin) * 2; u.offB = u.pn * rb + kin * 2; }
        else { const int ch = s % 11, tile = s / 11; u.pm = 64 + (tile & 1); u.pn = tile >> 1; u.nt = 4; u.mode = 1; u.aux = ch; u.offA = u.pm * ra + 512 * ch; u.offB = u.pn * rb + 512 * ch; }
        return true;
    }
    __device__ __forceinline__ void a_ready(const Unit& u, int wid) const {
        if (ready == nullptr || u.pm < 64) return;
        if (wid == 0) { unsigned spins = 0;
            while ((unsigned)__builtin_amdgcn_readfirstlane(__hip_atomic_load(ready, __ATOMIC_RELAXED, __HIP_MEMORY_SCOPE_AGENT)) < need) { __builtin_amdgcn_s_sleep(2); if (++spins > (1u << 20)) break; }
            __builtin_amdgcn_fence(__ATOMIC_ACQUIRE, "agent");
            asm volatile("s_waitcnt vmcnt(0)" ::: "memory"); }
        asm volatile("" ::: "memory"); __builtin_amdgcn_s_barrier(); asm volatile("" ::: "memory");
    }
    __device__ __forceinline__ void unit_done(const Unit& u, int wid, int ui) const {
        if (topP == nullptr) return;
        if (u.pm < 64 && ui != lastP) return;
        asm volatile("s_waitcnt vmcnt(0)" ::: "memory"); __builtin_amdgcn_s_barrier(); asm volatile("" ::: "memory");
        if (wid == 0) { if (lane_now() == 0) {
            if (u.pm < 64) { const unsigned old = __hip_atomic_fetch_add(subP, 1u, __ATOMIC_RELAXED, __HIP_MEMORY_SCOPE_AGENT);
                if (old + 1u == nlocP) { __builtin_amdgcn_fence(__ATOMIC_RELEASE, "agent"); asm volatile("s_waitcnt vmcnt(0)" ::: "memory"); __hip_atomic_fetch_add(topP, 1u, __ATOMIC_RELAXED, __HIP_MEMORY_SCOPE_AGENT); } }
            else { if (fenceS) { __builtin_amdgcn_fence(__ATOMIC_RELEASE, "agent"); asm volatile("s_waitcnt vmcnt(0)" ::: "memory"); }
                __hip_atomic_fetch_add(doneS, 1u, __ATOMIC_RELAXED, __HIP_MEMORY_SCOPE_AGENT); } } }
    }
};

__device__ __forceinline__ unsigned cvt_pk_bf16(float lo, float hi) { unsigned r; asm volatile("v_cvt_pk_bf16_f32 %0, %1, %2" : "=v"(r) : "v"(lo), "v"(hi)); return r; }
template <int OFF> __device__ __forceinline__ void st_wt16(void* p, u32x4 v) { asm volatile("global_store_dwordx4 %0, %1, off offset:%2 sc0 sc1" :: "v"(p), "v"(v), "n"(OFF) : "memory"); }
__device__ __forceinline__ float sigmoidf_fast(float x) { return __builtin_amdgcn_rcpf(1.0f + __builtin_amdgcn_exp2f(-1.44269504089f * x)); }
__device__ __forceinline__ float gelu_tanh(float x) { const float t = x * x, y = x * fmaf(t, -0.10294324f, -2.3022082f); return x * __builtin_amdgcn_rcpf(1.0f + __builtin_amdgcn_exp2f(y)); }

__device__ __forceinline__ void acc_zero(f32x4 (&acc)[2][2][4][2]) {
#pragma unroll
    for (int a = 0; a < 2; ++a)
#pragma unroll
        for (int b = 0; b < 2; ++b)
#pragma unroll
            for (int m = 0; m < 4; ++m)
#pragma unroll
                for (int n = 0; n < 2; ++n) acc[a][b][m][n] = (f32x4){0.f, 0.f, 0.f, 0.f};
}
__device__ __forceinline__ float* state_ptr(float* out, int R, int keep, int layer, size_t p_off, size_t s_off) {
    if (R < MP) { const int b = R >> 11, j = (R & 2047) - (2048 - keep); return j < 0 ? nullptr : out + p_off + (size_t)((layer * 8 + b) * keep + j) * 512; }
    const int s = (R - MP) >> 2, j = (R & 3) + keep - 4; return j < 0 ? nullptr : out + s_off + (size_t)((layer * 128 + s) * keep + j) * 512;
}

struct EpiMix {
    static constexpr bool PERM = true, MIDK = false;
    __device__ __forceinline__ void init(f32x4 (&acc)[2][2][4][2], const Unit&, int, int) const { acc_zero(acc); }
    bf16_t* Z; float* out; int layer;
    __device__ __forceinline__ void midk(f32x4 (&)[2][2][4][2], const Unit&, int, int, int, int, int) const {}
    __device__ __forceinline__ void operator()(f32x4 (&acc)[2][2][4][2], const Unit& u, int wr, int wc, int fr_, int fq_) const {
        const int lane_ = lane_now(), fr = lane_ & 15, fq = lane_ >> 4; (void)fr_; (void)fq_;
        const int pn = u.pn; int type, zcol, keep = 0, scol = 0; size_t poff = 0, soff = 0;
        if (pn < 2) { type = 0; zcol = 256 * pn; keep = 3; scol = zcol; poff = O_PRGC; soff = O_SRGC; }
        else if (pn < 4) { type = 1; zcol = 512 + 256 * (pn - 2); }
        else if (pn < 8) { type = 2; zcol = 1024 + 128 * (pn - 4); keep = 30; scol = 128 * (pn - 4); poff = O_PCF; soff = O_SCF; }
        else if (pn < 10) { type = 0; zcol = 1536 + 256 * (pn - 8); keep = 15; scol = 256 * (pn - 8); poff = O_PPOOL; soff = O_SPOOL; }
        else if (pn < 12) { type = 0; zcol = 2048 + 256 * (pn - 10); }
        else { type = 3; zcol = 2560 + 128 * (pn - 12); keep = 2; scol = 128 * (pn - 12); poff = O_PSC; soff = O_SSC; }
        const bool tail = keep != 0 && (u.pm >= 64 || (u.pm & 7) == 7);
        const int row0 = u.pm * BM + wr * 64 + fr, cl = wc * 32 + 8 * fq;
        if (type < 2) {
#pragma unroll
            for (int ai = 0; ai < 2; ++ai)
#pragma unroll
                for (int m = 0; m < 4; ++m) { const int R = row0 + ai * HALF + m * 16; bf16_t* rowp = Z + (size_t)R * ZC + zcol + cl;
                    float* sp = tail ? state_ptr(out, R, keep, layer, poff, soff) : nullptr;
#pragma unroll
                    for (int bj = 0; bj < 2; ++bj) { f32x4 v0 = acc[ai][bj][m][0], v1 = acc[ai][bj][m][1];
                        if (type == 1) { v0 = (f32x4){gelu_tanh(v0[0]), gelu_tanh(v0[1]), gelu_tanh(v0[2]), gelu_tanh(v0[3])}; v1 = (f32x4){gelu_tanh(v1[0]), gelu_tanh(v1[1]), gelu_tanh(v1[2]), gelu_tanh(v1[3])}; }
                        u32x4 w; w.x = cvt_pk_bf16(v0[0], v0[1]); w.y = cvt_pk_bf16(v0[2], v0[3]); w.z = cvt_pk_bf16(v1[0], v1[1]); w.w = cvt_pk_bf16(v1[2], v1[3]);
                        *(u32x4*)(rowp + bj * HALF) = w;
                        if (sp) { *(f32x4*)(sp + scol + cl + bj * HALF) = v0; *(f32x4*)(sp + scol + cl + bj * HALF + 4) = v1; } } }
        } else {
#pragma unroll
            for (int ai = 0; ai < 2; ++ai)
#pragma unroll
                for (int m = 0; m < 4; ++m) { const int R = row0 + ai * HALF + m * 16; bf16_t* rowp = Z + (size_t)R * ZC + zcol + cl;
                    float* sp = tail ? state_ptr(out, R, keep, layer, poff, soff) : nullptr;
                    f32x4 v0, v1; const f32x4 a0 = acc[ai][0][m][0], a1 = acc[ai][0][m][1], b0 = acc[ai][1][m][0], b1 = acc[ai][1][m][1];
                    if (type == 2) {
#pragma unroll
                        for (int i = 0; i < 4; ++i) { v0[i] = a0[i] * sigmoidf_fast(b0[i]); v1[i] = a1[i] * sigmoidf_fast(b1[i]); }
                    } else { v0 = a0 * b0; v1 = a1 * b1; }
                    u32x4 w; w.x = cvt_pk_bf16(v0[0], v0[1]); w.y = cvt_pk_bf16(v0[2], v0[3]); w.z = cvt_pk_bf16(v1[0], v1[1]); w.w = cvt_pk_bf16(v1[2], v1[3]);
                    *(u32x4*)rowp = w;
                    if (sp) { *(f32x4*)(sp + scol + cl) = v0; *(f32x4*)(sp + scol + cl + 4) = v1; } }
        }
    }
};

struct EpiGate {
    static constexpr bool PERM = true, MIDK = false;
    __device__ __forceinline__ void init(f32x4 (&acc)[2][2][4][2], const Unit&, int, int) const { acc_zero(acc); }
    _Float16* G;
    __device__ __forceinline__ void midk(f32x4 (&)[2][2][4][2], const Unit&, int, int, int, int, int) const {}
    __device__ __forceinline__ void operator()(f32x4 (&acc)[2][2][4][2], const Unit& u, int wr, int wc, int fr_, int fq_) const {
        const int lane_ = lane_now(), fr = lane_ & 15, fq = lane_ >> 4; (void)fr_; (void)fq_;
        const int row0 = u.pm * BM + wr * 64 + fr, ch0 = 64 * u.pn + 16 * wc + 4 * fq; const bool plain = u.pm >= 64;
#pragma unroll
        for (int ai = 0; ai < 2; ++ai)
#pragma unroll
            for (int m = 0; m < 4; ++m) { const int R = row0 + ai * HALF + m * 16; _Float16* gp = G + (size_t)R * GC + ch0;
                f16x4 r0, r1, r2, g3;
#pragma unroll
                for (int i = 0; i < 4; ++i) {
                    const float d0 = 1.f + __builtin_amdgcn_exp2f(__builtin_amdgcn_fmed3f(acc[ai][0][m][0][i], -15.f, 15.f)), d1 = 1.f + __builtin_amdgcn_exp2f(__builtin_amdgcn_fmed3f(acc[ai][0][m][1][i], -15.f, 15.f));
                    const float d2 = 1.f + __builtin_amdgcn_exp2f(__builtin_amdgcn_fmed3f(acc[ai][1][m][0][i], -15.f, 15.f)), d3 = 1.f + __builtin_amdgcn_exp2f(__builtin_amdgcn_fmed3f(acc[ai][1][m][1][i], -15.f, 15.f));
                    const float i0 = __builtin_amdgcn_rcpf(d0), i1 = __builtin_amdgcn_rcpf(d1), i2 = __builtin_amdgcn_rcpf(d2), i3 = __builtin_amdgcn_rcpf(d3);
                    if (plain) { r0[i] = (_Float16)i0; r1[i] = (_Float16)i1; r2[i] = (_Float16)i2; }
                    else { r0[i] = (_Float16)(d1 * i0); r1[i] = (_Float16)(d2 * i1); r2[i] = (_Float16)(d3 * i2); }
                    g3[i] = (_Float16)i3; }
                u32x2 a0 = __builtin_bit_cast(u32x2, r0), a1 = __builtin_bit_cast(u32x2, r1), a2 = __builtin_bit_cast(u32x2, r2), a3 = __builtin_bit_cast(u32x2, g3);
                { auto s = __builtin_amdgcn_permlane16_swap(a0.x, a2.x, false, false); a0.x = s[0]; a2.x = s[1]; } { auto s = __builtin_amdgcn_permlane16_swap(a0.y, a2.y, false, false); a0.y = s[0]; a2.y = s[1]; }
                { auto s = __builtin_amdgcn_permlane16_swap(a1.x, a3.x, false, false); a1.x = s[0]; a3.x = s[1]; } { auto s = __builtin_amdgcn_permlane16_swap(a1.y, a3.y, false, false); a1.y = s[0]; a3.y = s[1]; }
                _Float16* gq = gp - 4 * (fq & 1) + 2048 * (fq & 1);
                *(u32x4*)(gq) = (u32x4){a0.x, a0.y, a2.x, a2.y}; *(u32x4*)(gq + 1024) = (u32x4){a1.x, a1.y, a3.x, a3.y}; }
    }
};

struct EpiMerge {
    static constexpr bool PERM = true, MIDK = true;
    __device__ __forceinline__ void init(f32x4 (&acc)[2][2][4][2], const Unit&, int, int) const { acc_zero(acc); }
    const _Float16* G; bf16_t* O; bf16_t* Os;
    __device__ __forceinline__ void scale(f32x4 (&acc)[2][2][4][2], const Unit& u, int seg, int wr, int wc) const {
        const int lane_ = lane_now(), fr = lane_ & 15, fq = lane_ >> 4;
        const int row0 = u.pm * BM + wr * 64 + fr, c0 = 1024 * seg + 256 * u.pn + wc * 32 + 8 * fq;
        f16x8 f[2][4][2];
#pragma unroll
        for (int ai = 0; ai < 2; ++ai)
#pragma unroll
            for (int m = 0; m < 4; ++m) { const _Float16* gp = G + (size_t)(row0 + ai * HALF + m * 16) * GC + c0;
#pragma unroll
                for (int bj = 0; bj < 2; ++bj) f[ai][m][bj] = *(const f16x8*)(gp + bj * HALF); }
        __builtin_amdgcn_sched_barrier(0);
#pragma unroll
        for (int ai = 0; ai < 2; ++ai)
#pragma unroll
            for (int m = 0; m < 4; ++m)
#pragma unroll
                for (int bj = 0; bj < 2; ++bj) { const f16x8 v = f[ai][m][bj];
                    acc[ai][bj][m][0] *= (f32x4){(float)v[0], (float)v[1], (float)v[2], (float)v[3]}; acc[ai][bj][m][1] *= (f32x4){(float)v[4], (float)v[5], (float)v[6], (float)v[7]}; }
    }
    __device__ __forceinline__ void midk(f32x4 (&acc)[2][2][4][2], const Unit& u, int seg, int wr, int wc, int, int) const { scale(acc, u, seg, wr, wc); }
    __device__ __forceinline__ void operator()(f32x4 (&acc)[2][2][4][2], const Unit& u, int wr, int wc, int, int) const {
        scale(acc, u, u.mode ? u.aux : 3, wr, wc);
        const int lane_ = lane_now(), fr = lane_ & 15, fq = lane_ >> 4;
        const int row0 = (u.mode ? (u.pm - 64) * BM + 512 * u.aux : u.pm * BM) + wr * 64 + fr, c0 = 256 * u.pn + wc * 32 + 8 * fq;
        bf16_t* O = u.mode ? Os : this->O;
#pragma unroll
        for (int ai = 0; ai < 2; ++ai)
#pragma unroll
            for (int m = 0; m < 4; ++m) { bf16_t* rowp = O + (size_t)(row0 + ai * HALF + m * 16) * DM + c0;
#pragma unroll
                for (int bj = 0; bj < 2; ++bj) { const f32x4 v0 = acc[ai][bj][m][0], v1 = acc[ai][bj][m][1];
                    u32x4 w; w.x = cvt_pk_bf16(v0[0], v0[1]); w.y = cvt_pk_bf16(v0[2], v0[3]); w.z = cvt_pk_bf16(v1[0], v1[1]); w.w = cvt_pk_bf16(v1[2], v1[3]);
                    if (!u.mode) *(u32x4*)(rowp + bj * HALF) = w; else if (bj == 0) st_wt16<0>(rowp, w); else st_wt16<HALF * 2>(rowp, w); } }
    }
};

struct PanelStats {
    unsigned* xbuf;
    unsigned* cnt;
    __device__ __forceinline__ void run(const f32x4 (&v)[2][2][4][2], const Unit& u, int wr, int wc, PG8_LAS unsigned char* lds, int wid) const {
        const int lane = lane_now(), fr = lane & 15, fq = lane >> 4;
        PG8_LAS f32x2* P = (PG8_LAS f32x2*)lds;
        PG8_LAS f32x2* S = (PG8_LAS f32x2*)(lds + 8192);
#pragma unroll
        for (int ai = 0; ai < 2; ++ai)
#pragma unroll
            for (int m = 0; m < 4; ++m) {
                float s = 0.f;
#pragma unroll
                for (int bj = 0; bj < 2; ++bj)
#pragma unroll
                    for (int n = 0; n < 2; ++n) { const f32x4 x = v[ai][bj][m][n]; s += (x[0] + x[1]) + (x[2] + x[3]); }
                s += __builtin_bit_cast(float, __builtin_amdgcn_ds_bpermute((lane ^ 16) << 2, __builtin_bit_cast(int, s))); s += __builtin_bit_cast(float, __builtin_amdgcn_ds_bpermute((lane ^ 32) << 2, __builtin_bit_cast(int, s)));
                const float mw = s * (1.0f / 64.0f); float q = 0.f;
#pragma unroll
                for (int bj = 0; bj < 2; ++bj)
#pragma unroll
                    for (int n = 0; n < 2; ++n) { const f32x4 d = v[ai][bj][m][n] - mw; q += (d[0] * d[0] + d[1] * d[1]) + (d[2] * d[2] + d[3] * d[3]); }
                q += __builtin_bit_cast(float, __builtin_amdgcn_ds_bpermute((lane ^ 16) << 2, __builtin_bit_cast(int, q))); q += __builtin_bit_cast(float, __builtin_amdgcn_ds_bpermute((lane ^ 32) << 2, __builtin_bit_cast(int, q)));
                if (fq == 0) P[(ai * HALF + wr * 64 + m * 16 + fr) * 4 + wc] = (f32x2){mw, q};
            }
        asm volatile("s_waitcnt lgkmcnt(0)" ::: "memory"); __builtin_amdgcn_s_barrier(); asm volatile("" ::: "memory");
        const int row = wid * 32 + (lane & 31);
        if (lane < 32) {
            const f32x2 a = P[row * 4 + 0], b = P[row * 4 + 1], c = P[row * 4 + 2], d = P[row * 4 + 3];
            const float mt = (a.x + b.x + c.x + d.x) * 0.25f;
            const float da = a.x - mt, db = b.x - mt, dc = c.x - mt, dd = d.x - mt;
            const float m2 = (a.y + b.y) + (c.y + d.y) + 64.0f * ((da * da + db * db) + (dc * dc + dd * dd));
            unsigned long long* slot = (unsigned long long*)xbuf + ((size_t)(u.pm * BM + row) * 4 + u.pn);
            __hip_atomic_store(slot, ((unsigned long long)__float_as_uint(m2) << 32) | __float_as_uint(mt), __ATOMIC_RELAXED, __HIP_MEMORY_SCOPE_AGENT);
        }
        asm volatile("s_waitcnt vmcnt(0)" ::: "memory");
        if (lane == 0) __hip_atomic_fetch_add(cnt + 64 * u.pm, 1u, __ATOMIC_RELAXED, __HIP_MEMORY_SCOPE_AGENT);
        if (wid == 0) {
            unsigned spins = 0;
            while ((unsigned)__builtin_amdgcn_readfirstlane(__hip_atomic_load(cnt + 64 * u.pm, __ATOMIC_RELAXED, __HIP_MEMORY_SCOPE_AGENT)) < 32u) { __builtin_amdgcn_s_sleep(2); if (++spins > (1u << 20)) break; }
        }
        asm volatile("s_waitcnt vmcnt(0) lgkmcnt(0)" ::: "memory"); __builtin_amdgcn_s_barrier(); asm volatile("" ::: "memory");
        if (lane < 32) {
            const unsigned long long* slot = (const unsigned long long*)xbuf + (size_t)(u.pm * BM + row) * 4; float mt[4], m2[4]; float ms = 0.f;
#pragma unroll
            for (int t = 0; t < 4; ++t) { const unsigned long long w = __hip_atomic_load(slot + t, __ATOMIC_RELAXED, __HIP_MEMORY_SCOPE_AGENT); mt[t] = __uint_as_float((unsigned)w); m2[t] = __uint_as_float((unsigned)(w >> 32)); ms += mt[t]; }
            const float mean = ms * 0.25f; float q = 0.f;
#pragma unroll
            for (int t = 0; t < 4; ++t) { const float dm = mt[t] - mean; q += m2[t] + 256.0f * dm * dm; }
            S[row] = (f32x2){mean, __builtin_amdgcn_rsqf(q * (1.0f / 1024.0f) + LN_EPS)};
        }
        asm volatile("s_waitcnt lgkmcnt(0)" ::: "memory"); __builtin_amdgcn_s_barrier(); asm volatile("" ::: "memory");
    }
};
struct EpiRes {
    static constexpr bool PERM = true, MIDK = false;
    __device__ __forceinline__ void init(f32x4 (&acc)[2][2][4][2], const Unit& u, int wr, int wc) const {
        if (u.mode) { acc_zero(acc); return; }
        const int lane_ = lane_now(), fr = lane_ & 15, fq = lane_ >> 4;
        const size_t e0 = (size_t)(u.pm * BM + wr * 64 + fr) * DM + 256 * u.pn + wc * 32 + 8 * fq;
        if (base16) {
#pragma unroll
            for (int ai = 0; ai < 2; ++ai)
#pragma unroll
                for (int m = 0; m < 4; ++m)
#pragma unroll
                    for (int bj = 0; bj < 2; ++bj) { const u32x4 w = *(const u32x4*)(base16 + e0 + (size_t)(ai * HALF + m * 16) * DM + bj * HALF);
                        acc[ai][bj][m][0] = (f32x4){__uint_as_float(w.x), __uint_as_float(w.y), 0.f, 0.f}; acc[ai][bj][m][1] = (f32x4){__uint_as_float(w.z), __uint_as_float(w.w), 0.f, 0.f}; }
            __builtin_amdgcn_sched_barrier(0);
#pragma unroll
            for (int ai = 0; ai < 2; ++ai)
#pragma unroll
                for (int m = 0; m < 4; ++m)
#pragma unroll
                    for (int bj = 0; bj < 2; ++bj)
#pragma unroll
                        for (int n = 0; n < 2; ++n) { const unsigned wx = __float_as_uint(acc[ai][bj][m][n][0]), wy = __float_as_uint(acc[ai][bj][m][n][1]);
                            acc[ai][bj][m][n] = (f32x4){__uint_as_float(wx << 16), __uint_as_float(wx & 0xffff0000u), __uint_as_float(wy << 16), __uint_as_float(wy & 0xffff0000u)} * ALPHA; }
            return; }
#pragma unroll
        for (int ai = 0; ai < 2; ++ai)
#pragma unroll
            for (int m = 0; m < 4; ++m)
#pragma unroll
                for (int bj = 0; bj < 2; ++bj)
#pragma unroll
                    for (int n = 0; n < 2; ++n) acc[ai][bj][m][n] = *(const f32x4*)(baseP + e0 + (size_t)(ai * HALF + m * 16) * DM + bj * HALF + n * 4) * ALPHA;
    }
    const float* baseP; const bf16_t* base16; float* out; bf16_t* xb; const float* lng; const float* lnb; float* slab; PanelStats st; PG8_LAS unsigned char* xlds; int wid;
    __device__ __forceinline__ void midk(f32x4 (&)[2][2][4][2], const Unit&, int, int, int, int, int) const {}
    __device__ __forceinline__ void operator()(f32x4 (&acc)[2][2][4][2], const Unit& u, int wr, int wc, int fr_, int fq_) const {
        const int lane_ = lane_now(), fr = lane_ & 15, fq = lane_ >> 4; (void)fr_; (void)fq_;
        const int row0 = u.pm * BM + wr * 64 + fr, c0 = 256 * u.pn + wc * 32 + 8 * fq;
        if (u.mode) {
#pragma unroll
            for (int ai = 0; ai < 2; ++ai)
#pragma unroll
                for (int m = 0; m < 4; ++m) { float* op = slab + ((size_t)u.aux * 512 + (row0 - MP) + ai * HALF + m * 16) * DM + c0;
#pragma unroll
                    for (int bj = 0; bj < 2; ++bj)
#pragma unroll
                        for (int n = 0; n < 2; ++n) *(f32x4*)(op + bj * HALF + n * 4) = acc[ai][bj][m][n]; }
            return; }
        st.run(acc, u, wr, wc, xlds, wid);
        const PG8_LAS f32x2* S = (const PG8_LAS f32x2*)(xlds + 8192);
#pragma unroll
        for (int bj = 0; bj < 2; ++bj) { const int cc = c0 + bj * HALF;
            const f32x4 gv0 = *(const f32x4*)(lng + cc), gv1 = *(const f32x4*)(lng + cc + 4), bv0 = *(const f32x4*)(lnb + cc), bv1 = *(const f32x4*)(lnb + cc + 4);
#pragma unroll
            for (int ai = 0; ai < 2; ++ai)
#pragma unroll
                for (int m = 0; m < 4; ++m) { const int r = ai * HALF + wr * 64 + m * 16 + fr; const f32x2 sr = S[r]; const size_t off = (size_t)(u.pm * BM + r) * DM + cc;
                    const f32x4 o0 = (acc[ai][bj][m][0] - sr.x) * sr.y * gv0 + bv0, o1 = (acc[ai][bj][m][1] - sr.x) * sr.y * gv1 + bv1;
                    if (out) { *(f32x4*)(out + off) = o0; *(f32x4*)(out + off + 4) = o1; }
                    if (xb) { u32x4 w; w.x = cvt_pk_bf16(o0[0], o0[1]); w.y = cvt_pk_bf16(o0[2], o0[3]); w.z = cvt_pk_bf16(o1[0], o1[1]); w.w = cvt_pk_bf16(o1[2], o1[3]); *(u32x4*)(xb + off) = w; }
                    if (m & 1) asm volatile("" ::: "memory"); } }
    }
};

struct EpiSwi {
    static constexpr bool PERM = true, MIDK = false;
    __device__ __forceinline__ void init(f32x4 (&acc)[2][2][4][2], const Unit&, int, int) const { acc_zero(acc); }
    bf16_t* H;
    __device__ __forceinline__ void midk(f32x4 (&)[2][2][4][2], const Unit&, int, int, int, int, int) const {}
    __device__ __forceinline__ void operator()(f32x4 (&acc)[2][2][4][2], const Unit& u, int wr, int wc, int fr_, int fq_) const {
        const int lane_ = lane_now(), fr = lane_ & 15, fq = lane_ >> 4; (void)fr_; (void)fq_;
        const int row0 = u.pm * BM + wr * 64 + fr, c0 = 128 * u.pn + wc * 32 + 8 * fq;
#pragma unroll
        for (int ai = 0; ai < 2; ++ai)
#pragma unroll
            for (int m = 0; m < 4; ++m) { bf16_t* rowp = H + (size_t)(row0 + ai * HALF + m * 16) * FF + c0;
                const f32x4 g0 = acc[ai][0][m][0], g1 = acc[ai][0][m][1], u0 = acc[ai][1][m][0], u1 = acc[ai][1][m][1]; f32x4 v0, v1;
#pragma unroll
                for (int i = 0; i < 4; ++i) { v0[i] = g0[i] * sigmoidf_fast(g0[i]) * u0[i]; v1[i] = g1[i] * sigmoidf_fast(g1[i]) * u1[i]; }
                u32x4 w; w.x = cvt_pk_bf16(v0[0], v0[1]); w.y = cvt_pk_bf16(v0[2], v0[3]); w.z = cvt_pk_bf16(v1[0], v1[1]); w.w = cvt_pk_bf16(v1[2], v1[3]);
                *(u32x4*)rowp = w; }
    }
};

template <class Epi, class Sched, bool ALIGN_EPI>
__device__ __forceinline__ void gemm_phase(PG8_LAS unsigned char* lds, const Gemm g, const Sched& S, const Epi& E, int wave_id) {
    const int wid = opqs(wave_id), lane = lane_now(), tid = wid * 64 + lane, wr = wid >> 2, wc = wid & 3, fr = lane & 15, fq = lane >> 4;
    unsigned voffA[2], voffB[2];
#pragma unroll
    for (int i = 0; i < 2; ++i) { int R, C; stage_rc(tid * 16 + i * 8192, R, C); const int Rb = Epi::PERM ? ((R & ~31) + perm32(R & 31)) : R;
        voffA[i] = (unsigned)(R * g.lda + C) * 2u; voffB[i] = (unsigned)(Rb * g.ldb + C) * 2u; }
    const size_t kstep = (size_t)(BK * 2);
    const size_t hstepA = (size_t)HALF * g.lda * 2, hstepB = (size_t)HALF * g.ldb * 2;
    const unsigned ldsw = (unsigned)wid * 1024u;
    const int aoff = lds_byte(wr * 64 + fr, fq * 8), boff = lds_byte(wc * 32 + fr, fq * 8);
#define PG8_SA(b, h) (((b) * 2 + (h)) * HTB)
#define PG8_SB(b, h) ((4 + (b) * 2 + (h)) * HTB)
#define PG8_STAGE(bufoff, gbase, voff) do { _Pragma("unroll") for (int _i = 0; _i < 2; ++_i) \
        __builtin_amdgcn_global_load_lds((const unsigned*)((const char*)(gbase) + (voff)[_i]), (PG8_LAS unsigned*)(lds + (bufoff) + ldsw + _i * 8192), 16, 0, 0); } while (0)
#define PG8_LDA(dst, b, h) do { _Pragma("unroll") for (int m = 0; m < 4; ++m) _Pragma("unroll") for (int k = 0; k < 2; ++k) dst[m][k] = *(const PG8_LAS bf16x8*)(lds + PG8_SA(b, h) + aoff + m * 2048 + k * 1024); } while (0)
#define PG8_LDB(dst, b, h) do { _Pragma("unroll") for (int n = 0; n < 2; ++n) _Pragma("unroll") for (int k = 0; k < 2; ++k) dst[n][k] = *(const PG8_LAS bf16x8*)(lds + PG8_SB(b, h) + boff + n * 2048 + k * 1024); } while (0)
#define PG8_MMA(ai, bj, At, Bt) do { __builtin_amdgcn_s_setprio(1); _Pragma("unroll") for (int m = 0; m < 4; ++m) _Pragma("unroll") for (int n = 0; n < 2; ++n) _Pragma("unroll") for (int k = 0; k < 2; ++k) \
        acc[ai][bj][m][n] = __builtin_amdgcn_mfma_f32_16x16x32_bf16(Bt[n][k], At[m][k], acc[ai][bj][m][n], 0, 0, 0); __builtin_amdgcn_s_setprio(0); } while (0)
#define PG8_WAIT_V(n) asm volatile("s_waitcnt vmcnt(" #n ")" ::: "memory")
#define PG8_WAIT_L(n) asm volatile("s_waitcnt lgkmcnt(" #n ")" ::: "memory")
#define PG8_BAR __builtin_amdgcn_s_barrier()
#define PG8_SCHED __builtin_amdgcn_sched_barrier(0)
    Unit cur, nxt; int ui = 0;
    if (!S.next(0, cur, g)) return;
    f32x4 acc[2][2][4][2];
    E.init(acc, cur, wr, wc);
    bf16x8 At[4][2], B0[2][2], B1[2][2];
    const char* cA = (const char*)(cur.mode ? g.As : g.A) + cur.offA; const char* cB = (const char*)g.Bt + cur.offB;
    PG8_STAGE(PG8_SB(0, 0), cB, voffB); PG8_STAGE(PG8_SB(0, 1), cB + hstepB, voffB); PG8_STAGE(PG8_SA(0, 0), cA, voffA); PG8_STAGE(PG8_SA(0, 1), cA + hstepA, voffA);
    if (wr == 1) PG8_BAR;
    PG8_WAIT_V(2); PG8_BAR;
    PG8_STAGE(PG8_SB(1, 0), cB + kstep, voffB); PG8_STAGE(PG8_SA(1, 0), cA + kstep, voffA); PG8_STAGE(PG8_SB(1, 1), cB + hstepB + kstep, voffB);
    PG8_WAIT_V(6); PG8_BAR;
    for (;;) {
        const bool has_next = S.next(ui + 1, nxt, g);
        const char* nA = has_next ? (const char*)(nxt.mode ? g.As : g.A) + nxt.offA : cA; const char* nB = has_next ? (const char*)g.Bt + nxt.offB : cB;
        const int nt = cur.nt, TSEG = Epi::MIDK ? 8 : nt;
        for (int t0 = 0; t0 < nt; t0 += TSEG) {
        if constexpr (Epi::MIDK) { if (t0 != 0) { PG8_SCHED; E.midk(acc, cur, t0 / TSEG - 1, wr, wc, 0, 0); PG8_SCHED; } }
#pragma unroll 1
        for (int t = t0; t < t0 + TSEG; t += 2) {
            const bool last = (t == nt - 2);
            if (last && has_next) S.a_ready(nxt, wid);
            const char* a1 = cA + (size_t)(t + 1) * kstep;
            const char* a2 = last ? nA : cA + (size_t)(t + 2) * kstep; const char* b2 = last ? nB : cB + (size_t)(t + 2) * kstep;
            const char* a3 = a2 + kstep; const char* b3 = b2 + kstep;
            PG8_LDB(B0, 0, 0); PG8_LDB(B1, 0, 1); PG8_SCHED; PG8_LDA(At, 0, 0); PG8_STAGE(PG8_SA(1, 1), a1 + hstepA, voffA);
            PG8_WAIT_V(8); PG8_WAIT_L(0); PG8_BAR; PG8_MMA(0, 0, At, B0); PG8_MMA(0, 1, At, B1); PG8_BAR; PG8_SCHED;
            PG8_LDA(At, 0, 1); PG8_STAGE(PG8_SB(0, 0), b2, voffB); PG8_STAGE(PG8_SB(0, 1), b2 + hstepB, voffB); PG8_STAGE(PG8_SA(0, 0), a2, voffA);
            PG8_WAIT_V(8); PG8_WAIT_L(0); PG8_BAR; PG8_MMA(1, 0, At, B0); PG8_MMA(1, 1, At, B1); PG8_BAR; PG8_SCHED;
            PG8_LDB(B0, 1, 0); PG8_LDB(B1, 1, 1); PG8_SCHED; PG8_LDA(At, 1, 0); PG8_STAGE(PG8_SA(0, 1), a2 + hstepA, voffA);
            PG8_WAIT_V(8); PG8_WAIT_L(0); PG8_BAR; PG8_MMA(0, 0, At, B0); PG8_MMA(0, 1, At, B1); PG8_BAR; PG8_SCHED;
            PG8_LDA(At, 1, 1); PG8_STAGE(PG8_SB(1, 0), b3, voffB); PG8_STAGE(PG8_SB(1, 1), b3 + hstepB, voffB); PG8_STAGE(PG8_SA(1, 0), a3, voffA);
            PG8_WAIT_V(8); PG8_WAIT_L(0); PG8_BAR; PG8_MMA(1, 0, At, B0); PG8_MMA(1, 1, At, B1); PG8_BAR; PG8_SCHED;
        }
        }
        if constexpr (ALIGN_EPI) { if (wr == 0) PG8_BAR; }
        E(acc, cur, wr, wc, 0, 0);
        S.unit_done(cur, wid, ui);
        if (!has_next) break;
        cur = nxt; cA = nA; cB = nB; ++ui;
        E.init(acc, cur, wr, wc);
        if constexpr (ALIGN_EPI) { if (wr == 1) PG8_BAR; }
    }
    PG8_WAIT_V(0);
    if constexpr (!ALIGN_EPI) { if (wr == 0) PG8_BAR; }
    PG8_BAR;
#undef PG8_SA
#undef PG8_SB
#undef PG8_STAGE
#undef PG8_LDA
#undef PG8_LDB
#undef PG8_MMA
#undef PG8_WAIT_V
#undef PG8_WAIT_L
#undef PG8_BAR
#undef PG8_SCHED
}
}

constexpr int NWAVES = 8;
constexpr int NPHASE = 19;
constexpr size_t MiB = 1u << 20;
constexpr size_t WS_CTL = 0, CTL_ZERO_BYTES = 1 * MiB;
constexpr size_t WS_WA = 1 * MiB;
constexpr size_t WS_XB = 18 * MiB;
constexpr size_t WS_Y = 51 * MiB;
constexpr size_t WS_ZG = 117 * MiB;
constexpr size_t WS_BT3 = 249 * MiB, WS_BT4 = 253 * MiB, WS_BT5 = WS_WA, WS_BT6 = WS_ZG + 108 * MiB;
constexpr size_t WS_MB4S = WS_WA + 13 * MiB;
constexpr size_t WS_SLAB = WS_Y;
constexpr size_t WS_END = 255 * MiB;
static_assert(WS_XB + (size_t)M * DM * 2 <= WS_Y && WS_Y + (size_t)M * YC * 2 <= WS_ZG && WS_ZG + (size_t)M * GC * 2 <= WS_BT3 && WS_SLAB + (size_t)16 * 512 * DM * 4 <= WS_Y + 40 * MiB && WS_Y + 40 * MiB + 4 * 512 * 1024 <= WS_ZG, "ws map");
static_assert((size_t)M * FF * 2 <= 108 * MiB && WS_BT5 + (size_t)2 * FF * DM * 2 <= WS_MB4S && WS_MB4S + 4 * MiB <= WS_XB && WS_BT6 + (size_t)DM * FF * 2 <= WS_BT3, "ws map 2");
constexpr int CW_DN = 12288 + 64 * 8;
constexpr int CW_XID = 57344;
constexpr int CW_GRP = 66560;
constexpr int CW_DA = 49152;
constexpr int CW_P0 = 65536;
constexpr int CW_RDY = 12288;
constexpr int CW_TMO = 0, CW_CODE = 1, CW_BAR = 4096, CW_SEAM = 16384, SEAM_BANK = 8192;
constexpr size_t WS_XCH = WS_Y + 40 * MiB;
constexpr int XLDS_OFF = 131072 + 1024;
constexpr int RING_OFF = 0, RING_BYTES = 131072;
constexpr int LDSCTL_OFF = RING_BYTES, MISC_OFF = LDSCTL_OFF + 320;
constexpr int LDS_BYTES = 147456;

#define GAS __attribute__((address_space(1)))
#define LAS __attribute__((address_space(3)))
typedef unsigned short bf16;
typedef unsigned v4u __attribute__((ext_vector_type(4)));
typedef unsigned v2u __attribute__((ext_vector_type(2)));
typedef float f32x4 __attribute__((ext_vector_type(4)));
typedef float f32x2 __attribute__((ext_vector_type(2)));
typedef short bf16x8 __attribute__((ext_vector_type(8)));
typedef GAS unsigned gu32;
#define RLX_AGENT __ATOMIC_RELAXED, __HIP_MEMORY_SCOPE_AGENT
#define LDS_WAIT() asm volatile("s_waitcnt lgkmcnt(0)" ::: "memory")
#define VM_WAIT() asm volatile("s_waitcnt vmcnt(0)" ::: "memory")
__device__ __forceinline__ unsigned pk2(float lo, float hi) { return pg8::cvt_pk_bf16(lo, hi); }
__device__ __forceinline__ float bflo(unsigned v) { return __uint_as_float(v << 16); }
__device__ __forceinline__ float bfhi(unsigned v) { return __uint_as_float(v & 0xffff0000u); }
__device__ __forceinline__ float bf1(unsigned short h) { return __uint_as_float((unsigned)h << 16); }
__device__ __forceinline__ unsigned short f2bf(float f) { return (unsigned short)(pg8::cvt_pk_bf16(f, 0.f) & 0xffffu); }

#define XB_TMO      128
#define XB_XCNT(j)  (256  + 64 * (j))
#define XB_XSUB(j)  (1280 + 64 * (j))
#define XB_XGEN(j)  (2304 + 64 * (j))
#define XB_TOP      3328
#define XB_TOPGEN   3392
#define XCD_BAR_WORDS 3456
#define XB_SPIN_CAP (1u << 18)
__device__ __forceinline__ unsigned xb_ld(unsigned* p)              { return __hip_atomic_load(p, __ATOMIC_RELAXED, __HIP_MEMORY_SCOPE_AGENT); }
__device__ __forceinline__ unsigned xb_add(unsigned* p, unsigned v) { return __hip_atomic_fetch_add(p, v, __ATOMIC_RELAXED, __HIP_MEMORY_SCOPE_AGENT); }
__device__ __forceinline__ unsigned xb_xcc_id() { return (unsigned)__builtin_amdgcn_s_getreg((3 << 11) | 20) & 0xFu; }
#define XB_SPIN(cond, bar) do { unsigned _sp = 0; while (cond) { __builtin_amdgcn_s_sleep(1); \
    if ((++_sp & 255u) == 0u) { if (xb_ld(&(bar)[XB_TMO])) break; if (_sp > XB_SPIN_CAP) { atomicAdd(&(bar)[XB_TMO], 1u); break; } } } } while (0)
struct XcdBarrier { unsigned* bar; unsigned x; volatile LAS unsigned* st; };
__device__ __forceinline__ XcdBarrier xcd_barrier_post(unsigned* bar, volatile LAS unsigned* st) {
    XcdBarrier b; b.bar = bar; b.x = xb_xcc_id(); b.st = st;
    if (threadIdx.x == 0) (void)xb_add(&bar[XB_XCNT(b.x)], 1u);
    return b;
}
__device__ __forceinline__ void xcd_barrier_complete(unsigned* bar, unsigned x, unsigned& nloc, unsigned& nx) {
    const unsigned G = gridDim.x * gridDim.y * gridDim.z;
    unsigned sum, cnt, mine, sp = 0u;
    for (;;) {
        sum = 0u; cnt = 0u; mine = 0u;
#pragma unroll
        for (unsigned j = 0; j < 16; ++j) { const unsigned c = xb_ld(&bar[XB_XCNT(j)]); sum += c; cnt += (c > 0u) ? 1u : 0u; mine = (j == x) ? c : mine; }
        if (sum == G) break;
        __builtin_amdgcn_s_sleep(1);
        if ((++sp & 255u) == 0u) { if (xb_ld(&bar[XB_TMO])) break; if (sp > XB_SPIN_CAP) { atomicAdd(&bar[XB_TMO], 1u); break; } }
    }
    nloc = mine > 0u ? mine : 1u; nx = cnt > 0u ? cnt : 1u;
}
__device__ __forceinline__ void xcd_barrier(const XcdBarrier& b) {
    asm volatile("s_waitcnt vmcnt(0)" ::: "memory");
    __syncthreads();
    if (threadIdx.x == 0) {
        unsigned* bar = b.bar;
        __builtin_amdgcn_s_waitcnt(0);
        unsigned nloc = b.st[0], nx = b.st[1];
        if (nloc == 0u) { xcd_barrier_complete(bar, b.x, nloc, nx); b.st[0] = nloc; b.st[1] = nx; }
        const unsigned old = xb_add(&bar[XB_XSUB(b.x)], 1u);
        const unsigned gen = old / nloc;
        if (old + 1u == (gen + 1u) * nloc) {
            __builtin_amdgcn_fence(__ATOMIC_RELEASE, "agent");
            asm volatile("s_waitcnt vmcnt(0)" ::: "memory");
            const unsigned og = xb_add(&bar[XB_TOP], 1u);
            const unsigned tg = og / nx;
            if (og + 1u == (tg + 1u) * nx) xb_add(&bar[XB_TOPGEN], 1u);
            else XB_SPIN(xb_ld(&bar[XB_TOPGEN]) == tg, bar);
            xb_add(&bar[XB_XGEN(b.x)], 1u);
            __builtin_amdgcn_fence(__ATOMIC_ACQUIRE, "agent");
            asm volatile("s_waitcnt vmcnt(0)" ::: "memory");
        } else {
            XB_SPIN(xb_ld(&bar[XB_XGEN(b.x)]) == gen, bar);
            __builtin_amdgcn_fence(__ATOMIC_ACQUIRE, "agent");
            asm volatile("s_waitcnt vmcnt(0)" ::: "memory");
        }
    }
    __syncthreads();
}

struct Frame {
    LAS unsigned char* lds;
    volatile LAS unsigned* MISC;
    gu32* ctl;
    int tid, lane, wave, G, bid;
    const float* const* in;
    float* out;
    unsigned char* ws;
};
enum { I_XP = 0, I_XS, I_SH, I_SRGC, I_SCF, I_SPOOL, I_SSC, I_WIN, I_RGCW, I_RGCB, I_RGWA, I_RGBA, I_RGWX, I_RGBX, I_LAM, I_CFW, I_CFB, I_CFG, I_CFBB, I_POOLW, I_POOLS, I_SCW,
       I_WBR, I_WOUT, I_LN1G, I_LN1B, I_WG, I_WU, I_WD, I_LN2G, I_LN2B };

__device__ __forceinline__ float shfl_idx(float v, int src_lane) { return __builtin_bit_cast(float, __builtin_amdgcn_ds_bpermute(src_lane << 2, __builtin_bit_cast(int, v))); }
__device__ __forceinline__ float wave_sum(float v, int lane) {
#pragma unroll
    for (int o = 1; o < 64; o <<= 1) v += shfl_idx(v, lane ^ o);
    return v;
}

enum { RM_ID = 0, RM_WIN = 1, RM_GU = 2 };
template <int MODE> __device__ __forceinline__ int rowmap(int s, int extra) {
    if (MODE == RM_ID) return s;
    if (MODE == RM_GU) return 256 * (s >> 7) + (s & 127) + extra;
    if (s < 1024) return s;
    if (s < 2048) { const int j = ((s - 1024) >> 7) & 3; return 1024 + 256 * j + (s >= 1536 ? 128 : 0) + (s & 127); }
    if (s < 3072) return s;
    if (s < 4096) { const int j = ((s - 3072) >> 7) & 3; return 3072 + 256 * j + (s >= 3584 ? 128 : 0) + (s & 127); }
    const int g = (s - 4096) >> 10, ch = s & 1023, pn = ch >> 6, chl = ch & 63, wc = chl >> 4, fq = (chl >> 2) & 3, i = chl & 3;
    return 4096 + 256 * pn + 128 * (g >> 1) + 32 * wc + 8 * fq + 4 * (g & 1) + i;
}
template <int MODE>
__device__ __forceinline__ void transpose_item(const float* W, int K, int N, bf16* WT, int dst_ld, int dst_koff, int extra, LAS float* scr, int item, int lane, int nb0, int nnb) {
    const int kb = item / nnb, nb = nb0 + item % nnb, k0 = 64 * kb, n0 = 32 * nb;
    { float tv[32];
      const float* wp = W + (size_t)(k0 + (lane >> 5)) * N + n0 + (lane & 31);
#pragma unroll
      for (int i = 0; i < 32; ++i) tv[i] = wp[(size_t)(2 * i) * N];
#pragma unroll
      for (int i = 0; i < 32; ++i) scr[(2 * i + (lane >> 5)) * 33 + (lane & 31)] = tv[i]; }
    LDS_WAIT(); asm volatile("" ::: "memory");
    const int c = lane & 7; const float sc = (MODE == RM_WIN && n0 >= 4096) ? -1.44269504089f : 1.0f;
#pragma unroll
    for (int j = 0; j < 4; ++j) { const int n = (lane >> 3) + 8 * j; const LAS float* s = scr + (8 * c) * 33 + n;
        v4u o; o.x = pk2(s[0 * 33] * sc, s[1 * 33] * sc); o.y = pk2(s[2 * 33] * sc, s[3 * 33] * sc); o.z = pk2(s[4 * 33] * sc, s[5 * 33] * sc); o.w = pk2(s[6 * 33] * sc, s[7 * 33] * sc);
        *(GAS v4u*)(WT + (size_t)rowmap<MODE>(n0 + n, extra) * dst_ld + dst_koff + k0 + 8 * c) = o; }
    LDS_WAIT(); asm volatile("" ::: "memory");
}
template <int MODE>
__device__ __forceinline__ void convert_matrix(Frame& F, const float* W, int K, int N, bf16* WT, int dst_ld, int dst_koff, int extra, int gw, int NGW, int first = 0, int nb0 = 0, int nnb = 0) {
    LAS float* scr = (LAS float*)(F.lds + RING_OFF + F.wave * 16384);
    if (nnb == 0) nnb = N / 32;
    const int nitems = (K / 64) * nnb;
    int it0 = gw - first; if (it0 < 0) it0 += ((-it0 + NGW - 1) / NGW) * NGW;
    for (int it = it0; it < nitems; it += NGW) transpose_item<MODE>(W, K, N, WT, dst_ld, dst_koff, extra, scr, it, F.lane, nb0, nnb);
}
__device__ __forceinline__ void compose_pool(Frame& F, int layer, bf16* Bt3, int gw, int NGW, int first = 0) {
    const float* pw = F.in[I_POOLW] + (size_t)layer * 4 * 128 * 128; const float* ps = F.in[I_POOLS] + layer * 512; const float* Wb2 = F.in[I_WBR] + ((size_t)layer * 4 + 2) * 512 * 1024;
    const int lane = F.lane;
    LAS float* Pl = (LAS float*)(F.lds + RING_OFF + F.wave * 16384);
    int id0 = gw - first; if (id0 < 0) id0 += ((-id0 + NGW - 1) / NGW) * NGW;
    for (int id = id0; id < 512; id += NGW) {
        const int g = __builtin_amdgcn_readfirstlane(id >> 7), c0 = __builtin_amdgcn_readfirstlane(8 * ((id >> 3) & 15)), d0 = 128 * (id & 7) + 2 * lane;
#pragma unroll
        for (int k = 0; k < 4; ++k) { const int idx4 = lane + 64 * k, i = idx4 >> 5, e4 = (idx4 & 31) * 4;
            const f32x4 pv = *(const GAS f32x4*)(pw + ((size_t)g * 128 + c0 + i) * 128 + e4), sv = *(const GAS f32x4*)(ps + 128 * g + e4);
            Pl[(e4 + 0) * 8 + i] = pv.x * sv.x; Pl[(e4 + 1) * 8 + i] = pv.y * sv.y; Pl[(e4 + 2) * 8 + i] = pv.z * sv.z; Pl[(e4 + 3) * 8 + i] = pv.w * sv.w; }
        LDS_WAIT(); asm volatile("" ::: "memory");
        f32x2 acc[8];
#pragma unroll
        for (int i = 0; i < 8; ++i) acc[i] = (f32x2){0.f, 0.f};
        const float* wrow = Wb2 + (size_t)(128 * g) * 1024 + d0;
#pragma unroll 1
        for (int e0 = 0; e0 < 128; e0 += 32) {
            f32x2 wv[32];
#pragma unroll
            for (int k = 0; k < 32; ++k) wv[k] = *(const GAS f32x2*)(wrow + (size_t)(e0 + k) * 1024);
#pragma unroll
            for (int k = 0; k < 32; ++k) { const f32x4 p0 = *(const LAS f32x4*)(Pl + (e0 + k) * 8), p1 = *(const LAS f32x4*)(Pl + (e0 + k) * 8 + 4);
#pragma unroll
                for (int i = 0; i < 4; ++i) { acc[i] += wv[k] * p0[i]; acc[4 + i] += wv[k] * p1[i]; } }
        }
        v4u o0, o1;
        o0.x = pk2(acc[0].x, acc[1].x); o0.y = pk2(acc[2].x, acc[3].x); o0.z = pk2(acc[4].x, acc[5].x); o0.w = pk2(acc[6].x, acc[7].x);
        o1.x = pk2(acc[0].y, acc[1].y); o1.y = pk2(acc[2].y, acc[3].y); o1.z = pk2(acc[4].y, acc[5].y); o1.w = pk2(acc[6].y, acc[7].y);
        *(GAS v4u*)(Bt3 + (size_t)d0 * 2048 + 1024 + 128 * g + c0) = o0; *(GAS v4u*)(Bt3 + (size_t)(d0 + 1) * 2048 + 1024 + 128 * g + c0) = o1;
        LDS_WAIT(); asm volatile("" ::: "memory");
    }
}

__device__ __forceinline__ const float* xrow_in(Frame& F, int m) { return m < MP ? F.in[I_XP] + (size_t)m * DM : F.in[I_XS] + (size_t)(m - MP) * DM; }
template <int NR>
__device__ __forceinline__ void x_rows(Frame& F, bf16* XB, int m0) {
    f32x4 v[NR][4];
#pragma unroll
    for (int k = 0; k < NR; ++k) { const GAS f32x4* xr = (const GAS f32x4*)xrow_in(F, m0 + k) + F.lane;
#pragma unroll
        for (int j = 0; j < 4; ++j) v[k][j] = xr[64 * j]; }
#pragma unroll
    for (int k = 0; k < NR; ++k) { GAS v2u* o = (GAS v2u*)(XB + (size_t)(m0 + k) * DM) + F.lane;
#pragma unroll
        for (int j = 0; j < 4; ++j) o[64 * j] = (v2u){pk2(v[k][j].x, v[k][j].y), pk2(v[k][j].z, v[k][j].w)}; }
}
__device__ __forceinline__ void x_to_bf16(Frame& F, bf16* XB, gu32* ctr) {
    const int gw = F.bid * NWAVES + F.wave, NGW = F.G * NWAVES;
    if (F.G != 256) { for (int m0 = 4 * gw; m0 < M; m0 += 4 * NGW) x_rows<4>(F, XB, m0); return; }
    unsigned claim = 0;
    if (F.tid == 0) claim = __hip_atomic_fetch_add((unsigned*)ctr, 1u, __ATOMIC_RELAXED, __HIP_MEMORY_SCOPE_AGENT);
    x_rows<4>(F, XB, 4 * gw);
    for (int it = 0;; ++it) {
        volatile LAS unsigned* slot = F.MISC + 32 + (it & 1);
        if (F.tid == 0) *slot = claim;
        __syncthreads();
        const int c = __builtin_amdgcn_readfirstlane((int)*slot);
        if (c >= (M - 8192) / 16) break;
        if (F.tid == 0) claim = __hip_atomic_fetch_add((unsigned*)ctr, 1u, __ATOMIC_RELAXED, __HIP_MEMORY_SCOPE_AGENT);
        x_rows<2>(F, XB, 8192 + 16 * c + 2 * F.wave);
    }
}
__device__ __forceinline__ void ln_rows(Frame& F, const float* V, float* O, const float* g, const float* b, bf16* XB, const float* sbase, const float* slab, int nslab, int wg0 = 0) {
    const int gw = ((F.bid - wg0 + F.G) % F.G) * NWAVES + F.wave, NGW = F.G * NWAVES;
    f32x4 gv[4], bv[4];
#pragma unroll
    for (int j = 0; j < 4; ++j) { gv[j] = ((const GAS f32x4*)g)[F.lane + 64 * j]; bv[j] = ((const GAS f32x4*)b)[F.lane + 64 * j]; }
    for (int m = MP + gw; m < M; m += NGW) {
        const GAS f32x4* xr = (const GAS f32x4*)(V + (size_t)m * DM) + F.lane; GAS f32x4* orow = (GAS f32x4*)(O + (size_t)m * DM) + F.lane;
        f32x4 v[4]; float s = 0.f;
#pragma unroll
        for (int j = 0; j < 4; ++j) v[j] = xr[64 * j];
        if (m >= MP) { const GAS f32x4* br = (const GAS f32x4*)(sbase + (size_t)(m - MP) * DM) + F.lane;
#pragma unroll
            for (int j = 0; j < 4; ++j) v[j] = br[64 * j] * ALPHA;
            for (int sl = 0; sl < nslab; sl += 4) {
                f32x4 t[4][4];
#pragma unroll
                for (int k = 0; k < 4; ++k) { const GAS f32x4* sr = (const GAS f32x4*)(slab + ((size_t)(sl + k < nslab ? sl + k : sl) * 512 + (m - MP)) * DM) + F.lane;
#pragma unroll
                    for (int j = 0; j < 4; ++j) t[k][j] = sr[64 * j]; }
#pragma unroll
                for (int k = 0; k < 4; ++k) if (sl + k < nslab) {
#pragma unroll
                    for (int j = 0; j < 4; ++j) v[j] += t[k][j]; } } }
#pragma unroll
        for (int j = 0; j < 4; ++j) s += (v[j].x + v[j].y) + (v[j].z + v[j].w);
        const float mean = wave_sum(s, F.lane) * (1.f / DM); float s2 = 0.f;
#pragma unroll
        for (int j = 0; j < 4; ++j) { v[j] = v[j] - mean; s2 += (v[j].x * v[j].x + v[j].y * v[j].y) + (v[j].z * v[j].z + v[j].w * v[j].w); }
        const float rstd = __builtin_amdgcn_rsqf(wave_sum(s2, F.lane) * (1.f / DM) + LN_EPS);
#pragma unroll
        for (int j = 0; j < 4; ++j) { v[j] = v[j] * rstd * gv[j] + bv[j]; orow[64 * j] = v[j]; }
        if (XB) { GAS v2u* o = (GAS v2u*)(XB + (size_t)m * DM) + F.lane;
#pragma unroll
            for (int j = 0; j < 4; ++j) o[64 * j] = (v2u){pk2(v[j].x, v[j].y), pk2(v[j].z, v[j].w)}; }
    }
}

__device__ __forceinline__ void publish_ready(Frame& F, gu32* ctr) {
    VM_WAIT(); __syncthreads();
    if (F.tid == 0) { __builtin_amdgcn_fence(__ATOMIC_RELEASE, "agent"); asm volatile("s_waitcnt vmcnt(0)" ::: "memory"); __hip_atomic_fetch_add((unsigned*)ctr, 1u, __ATOMIC_RELAXED, __HIP_MEMORY_SCOPE_AGENT); }
}
__device__ __forceinline__ void wait_ready(Frame& F, gu32* ctr, unsigned need) {
    if (F.wave == 0) { unsigned spins = 0;
        while ((unsigned)__builtin_amdgcn_readfirstlane(__hip_atomic_load((unsigned*)ctr, __ATOMIC_RELAXED, __HIP_MEMORY_SCOPE_AGENT)) < need) { __builtin_amdgcn_s_sleep(2); if (++spins > (1u << 20)) break; }
        __builtin_amdgcn_fence(__ATOMIC_ACQUIRE, "agent"); asm volatile("s_waitcnt vmcnt(0)" ::: "memory"); }
    __syncthreads();
}
__device__ __forceinline__ float softplusf_acc(float x) { return fmaxf(x, 0.f) + log1pf(__expf(-fabsf(x))); }
__device__ __forceinline__ float expm1_neg(float x) {
    const float p = x * (1.f + x * (0.5f + x * (1.f / 6.f + x * (1.f / 24.f + x * (1.f / 120.f + x * (1.f / 720.f + x * (1.f / 5040.f)))))));
    return x > -0.25f ? p : __expf(x) - 1.f;
}
constexpr int PATCH_STRIDE = 144;

struct ALane {
    float cwD[4], cbD, ba, bx, ck;
    bf16x8 Ba[4][2], Bx[4][2];
};
constexpr int PATCH_BYTES = 5120, ASLOT_OFF = 8 * PATCH_BYTES;
__device__ __forceinline__ void a_setup(Frame& F, int layer, int n, int q, ALane& L) {
    const int c = F.lane & 15, kg = F.lane >> 4, och = 64 * n + 16 * q + c;
    const float* cw = F.in[I_RGCW] + (size_t)layer * 4 * 512 + 64 * n; const float* cb = F.in[I_RGCB] + layer * 512 + 64 * n;
#pragma unroll
    for (int j = 0; j < 4; ++j) L.cwD[j] = cw[j * 512 + 16 * q + c];
    L.cbD = cb[16 * q + c];
    L.ck = 8.0f * softplusf_acc(-F.in[I_LAM][layer * 512 + och]);
    const float* wa = F.in[I_RGWA] + ((size_t)layer * 8 + n) * 4096 + 16 * q + c; const float* wx = F.in[I_RGWX] + ((size_t)layer * 8 + n) * 4096 + 16 * q + c;
    float wav[16], wxv[16], cbv[16];
#pragma unroll
    for (int e = 0; e < 16; ++e) { const int k = (e < 8 ? 8 * kg + e : 32 + 8 * kg + (e - 8)); wav[e] = wa[k * 64]; wxv[e] = wx[k * 64]; cbv[e] = cb[k]; }
#pragma unroll
    for (int j = 0; j < 4; ++j) { float t[16];
#pragma unroll
        for (int e = 0; e < 16; ++e) t[e] = cw[j * 512 + (e < 8 ? 8 * kg + e : 32 + 8 * kg + (e - 8))];
        L.Ba[j][0] = __builtin_bit_cast(bf16x8, (v4u){pk2(wav[0] * t[0], wav[1] * t[1]), pk2(wav[2] * t[2], wav[3] * t[3]), pk2(wav[4] * t[4], wav[5] * t[5]), pk2(wav[6] * t[6], wav[7] * t[7])});
        L.Ba[j][1] = __builtin_bit_cast(bf16x8, (v4u){pk2(wav[8] * t[8], wav[9] * t[9]), pk2(wav[10] * t[10], wav[11] * t[11]), pk2(wav[12] * t[12], wav[13] * t[13]), pk2(wav[14] * t[14], wav[15] * t[15])});
        L.Bx[j][0] = __builtin_bit_cast(bf16x8, (v4u){pk2(wxv[0] * t[0], wxv[1] * t[1]), pk2(wxv[2] * t[2], wxv[3] * t[3]), pk2(wxv[4] * t[4], wxv[5] * t[5]), pk2(wxv[6] * t[6], wxv[7] * t[7])});
        L.Bx[j][1] = __builtin_bit_cast(bf16x8, (v4u){pk2(wxv[8] * t[8], wxv[9] * t[9]), pk2(wxv[10] * t[10], wxv[11] * t[11]), pk2(wxv[12] * t[12], wxv[13] * t[13]), pk2(wxv[14] * t[14], wxv[15] * t[15])}); }
    float sa = 0.f, sx = 0.f;
#pragma unroll
    for (int e = 0; e < 16; ++e) { sa = fmaf(cbv[e], wav[e], sa); sx = fmaf(cbv[e], wxv[e], sx); }
    sa += shfl_idx(sa, F.lane ^ 16); sa += shfl_idx(sa, F.lane ^ 32); sx += shfl_idx(sx, F.lane ^ 16); sx += shfl_idx(sx, F.lane ^ 32);
    L.ba = F.in[I_RGBA][layer * 512 + och] + sa; L.bx = F.in[I_RGBX][layer * 512 + och] + sx;
}
__device__ __forceinline__ void a_block(const ALane& L, const LAS unsigned char* patch, int rowA0, int baseD, int q, int lane, float (&a)[4], float (&bb)[4]) {
    const int c = lane & 15, kg = lane >> 4;
    f32x4 accR = (f32x4){0.f, 0.f, 0.f, 0.f}, accI = (f32x4){0.f, 0.f, 0.f, 0.f};
#pragma unroll
    for (int j = 0; j < 4; ++j) { const LAS unsigned char* rp = patch + (rowA0 + j) * PATCH_STRIDE + 16 * kg;
        const bf16x8 A0 = *(const LAS bf16x8*)rp, A1 = *(const LAS bf16x8*)(rp + 64);
        accR = __builtin_amdgcn_mfma_f32_16x16x32_bf16(A0, L.Ba[j][0], accR, 0, 0, 0); accR = __builtin_amdgcn_mfma_f32_16x16x32_bf16(A1, L.Ba[j][1], accR, 0, 0, 0);
        accI = __builtin_amdgcn_mfma_f32_16x16x32_bf16(A0, L.Bx[j][0], accI, 0, 0, 0); accI = __builtin_amdgcn_mfma_f32_16x16x32_bf16(A1, L.Bx[j][1], accI, 0, 0, 0); }
    float pv[7];
#pragma unroll
    for (int k = 0; k < 7; ++k) pv[k] = bf1(*(const LAS unsigned short*)(patch + (baseD + k) * PATCH_STRIDE + 2 * (16 * q + c)));
#pragma unroll
    for (int r = 0; r < 4; ++r) {
        const float xd = L.cbD + L.cwD[0] * pv[r] + L.cwD[1] * pv[r + 1] + L.cwD[2] * pv[r + 2] + L.cwD[3] * pv[r + 3];
        const float rr = pg8::sigmoidf_fast(accR[r] + L.ba), ii = pg8::sigmoidf_fast(accI[r] + L.bx);
        const float la = -L.ck * rr;
        const float av = __builtin_amdgcn_exp2f(1.44269504089f * la);
        a[r] = av; bb[r] = __builtin_amdgcn_sqrtf(fmaxf(1.f - av * av, 0.f)) * (ii * xd);
    }
}
struct BlkScan { float Ac[4], Bc[4], EA, EB, WA, WB; };
__device__ __forceinline__ void blk_scan(const float (&a)[4], const float (&bb)[4], int lane, BlkScan& S) {
    const int c = lane & 15, g = lane >> 4;
    S.Ac[0] = a[0]; S.Bc[0] = bb[0];
#pragma unroll
    for (int r = 1; r < 4; ++r) { S.Ac[r] = a[r] * S.Ac[r - 1]; S.Bc[r] = a[r] * S.Bc[r - 1] + bb[r]; }
    float IA = S.Ac[3], IB = S.Bc[3];
    { const float pa = shfl_idx(IA, lane - 16), pb = shfl_idx(IB, lane - 16); if (g >= 1) { IB = IA * pb + IB; IA = IA * pa; } }
    { const float pa = shfl_idx(IA, lane - 32), pb = shfl_idx(IB, lane - 32); if (g >= 2) { IB = IA * pb + IB; IA = IA * pa; } }
    S.EA = shfl_idx(IA, lane - 16); S.EB = shfl_idx(IB, lane - 16); if (g == 0) { S.EA = 1.f; S.EB = 0.f; }
    S.WA = shfl_idx(IA, 48 + c); S.WB = shfl_idx(IB, 48 + c);
}
__device__ __forceinline__ void a_prompt_item(Frame& F, int layer, int item, const bf16* Z, bf16* Y) {
    const int b = item >> 5, n = (item >> 2) & 7, q = item & 3, lane = opqv(F.lane), w = F.wave, c = lane & 15, g = lane >> 4, och = 64 * n + 16 * q + c;
    ALane L; a_setup(F, layer, n, q, L);
    LAS unsigned char* patch = F.lds + RING_OFF + w * PATCH_BYTES;
    LAS f32x2* slots = (LAS f32x2*)(F.lds + RING_OFF + ASLOT_OFF);
    const bf16* Zb = Z + (size_t)b * SEQ * ZC; bf16* Yb = Y + (size_t)b * SEQ * YC;
    float hrun = 0.f;
    v4u pf[5];
    auto load_patch = [&](int tb) {
#pragma unroll
        for (int k = 0; k < 5; ++k) { const int ci = lane + 64 * k, pr = ci >> 3, cc = ci & 7, t = tb - 3 + pr;
            pf[k] = (ci < 280 && t >= 0) ? *(const GAS v4u*)(Zb + (size_t)t * ZC + 64 * n + 8 * cc) : (v4u){0u, 0u, 0u, 0u}; }
    };
    load_patch(32 * w);
    for (int it = 0; it < 8; ++it) {
        const int tb = 256 * it + 32 * w;
#pragma unroll
        for (int k = 0; k < 5; ++k) { const int ci = lane + 64 * k, pr = ci >> 3, cc = ci & 7; if (ci < 280) *(LAS v4u*)(patch + pr * PATCH_STRIDE + 16 * cc) = pf[k]; }
        if (it < 7) load_patch(tb + 256);
        unsigned short gav[8];
#pragma unroll
        for (int r = 0; r < 8; ++r) gav[r] = ((const GAS unsigned short*)Zb)[(unsigned)((tb + 16 * (r >> 2) + 4 * g + (r & 3)) * ZC + 512 + och)];
        asm volatile("" ::: "memory");
        float a0[4], b0[4], a1[4], b1[4];
        a_block(L, patch, lane & 15, 4 * g, q, lane, a0, b0);
        a_block(L, patch, 16 + (lane & 15), 16 + 4 * g, q, lane, a1, b1);
        BlkScan S0, S1; blk_scan(a0, b0, lane, S0); blk_scan(a1, b1, lane, S1);
        if (lane < 16) slots[((it & 1) * 8 + w) * 16 + c] = (f32x2){S0.WA * S1.WA, S1.WA * S0.WB + S1.WB};
        __syncthreads();
        float hin = hrun, hw = 0.f;
#pragma unroll
        for (int ww = 0; ww < 8; ++ww) { const f32x2 s = slots[((it & 1) * 8 + ww) * 16 + c]; if (ww == w) hw = hin; hin = s.x * hin + s.y; }
        hrun = hin;
        const float hg0 = S0.EA * hw + S0.EB, hw1 = S0.WA * hw + S0.WB, hg1 = S1.EA * hw1 + S1.EB;
#pragma unroll
        for (int r = 0; r < 4; ++r) { const float h = S0.Ac[r] * hg0 + S0.Bc[r];
            ((GAS unsigned short*)Yb)[(unsigned)((tb + 4 * g + r) * YC + och)] = f2bf(h * bf1(gav[r])); }
#pragma unroll
        for (int r = 0; r < 4; ++r) { const float h = S1.Ac[r] * hg1 + S1.Bc[r];
            ((GAS unsigned short*)Yb)[(unsigned)((tb + 16 + 4 * g + r) * YC + och)] = f2bf(h * bf1(gav[4 + r]));
            if (r == 3 && it == 7 && w == 7 && g == 3) F.out[O_PH + (size_t)(layer * 8 + b) * 512 + och] = h; }
    }
}
__device__ __forceinline__ void a_sample_task(Frame& F, int layer, int task, const bf16* Z, bf16* Y) {
    const int blk = task >> 5, n = (task >> 2) & 7, q = task & 3, lane = opqv(F.lane), c = lane & 15, g = lane >> 4, och = 64 * n + 16 * q + c, s0 = 4 * blk;
    ALane L; a_setup(F, layer, n, q, L);
    LAS unsigned char* patch = F.lds + RING_OFF + F.wave * PATCH_BYTES;
#pragma unroll
    for (int k = 0; k < 4; ++k) { const int ci = lane + 64 * k; if (ci < 224) { const int pr = ci >> 3, cc = ci & 7, sq = pr / 7, tau = pr - 7 * sq - 3, seq = s0 + sq; v4u v;
            if (tau < 0) { const GAS f32x4* sp = (const GAS f32x4*)(F.in[I_SRGC] + ((size_t)(layer * 128 + seq) * 3 + (tau + 3)) * 512 + 64 * n + 8 * cc); const f32x4 f0 = sp[0], f1 = sp[1];
                v = (v4u){pk2(f0.x, f0.y), pk2(f0.z, f0.w), pk2(f1.x, f1.y), pk2(f1.z, f1.w)}; }
            else v = *(const GAS v4u*)(Z + (size_t)(MP + 4 * seq + tau) * ZC + 64 * n + 8 * cc);
            *(LAS v4u*)(patch + pr * PATCH_STRIDE + 16 * cc) = v; } }
    asm volatile("" ::: "memory");
    float a[4], bb[4];
    a_block(L, patch, 7 * ((lane & 15) >> 2) + (lane & 3), 7 * g, q, lane, a, bb);
    const int seq = s0 + g;
    float h = F.in[I_SH][(size_t)(layer * 128 + seq) * 512 + och];
#pragma unroll
    for (int r = 0; r < 4; ++r) { h = a[r] * h + bb[r]; const size_t row = (size_t)(MP + 4 * seq + r);
        *(GAS unsigned short*)(Y + row * YC + och) = f2bf(h * bf1(*(const GAS unsigned short*)(Z + row * ZC + 512 + och))); }
    F.out[O_SH + (size_t)(layer * 128 + seq) * 512 + och] = h;
}

__device__ __forceinline__ void ln_silu_row(const LAS float* xr, const float* g, const float* b, bf16* dst, int lane) {
    const f32x4 v0 = *(const LAS f32x4*)(xr + 4 * lane), v1 = *(const LAS f32x4*)(xr + 256 + 4 * lane);
    const float s = (v0.x + v0.y) + (v0.z + v0.w) + (v1.x + v1.y) + (v1.z + v1.w);
    const float mean = wave_sum(s, lane) * (1.f / 512.f);
    const f32x4 d0 = v0 - mean, d1 = v1 - mean;
    const float s2 = (d0.x * d0.x + d0.y * d0.y) + (d0.z * d0.z + d0.w * d0.w) + (d1.x * d1.x + d1.y * d1.y) + (d1.z * d1.z + d1.w * d1.w);
    const float rstd = __builtin_amdgcn_rsqf(wave_sum(s2, lane) * (1.f / 512.f) + LN_EPS);
    const f32x4 g0 = *(const GAS f32x4*)(g + 4 * lane), g1 = *(const GAS f32x4*)(g + 256 + 4 * lane), b0 = *(const GAS f32x4*)(b + 4 * lane), b1 = *(const GAS f32x4*)(b + 256 + 4 * lane);
    f32x4 y0 = d0 * rstd * g0 + b0, y1 = d1 * rstd * g1 + b1;
#pragma unroll
    for (int i = 0; i < 4; ++i) { y0[i] = y0[i] * pg8::sigmoidf_fast(y0[i]); y1[i] = y1[i] * pg8::sigmoidf_fast(y1[i]); }
    *(GAS v2u*)(dst + 4 * lane) = (v2u){pk2(y0.x, y0.y), pk2(y0.z, y0.w)}; *(GAS v2u*)(dst + 256 + 4 * lane) = (v2u){pk2(y1.x, y1.y), pk2(y1.z, y1.w)};
}
__device__ __forceinline__ void ln_silu_rows4(const LAS float* xr, int rstride, const float* g, const float* b, bf16* dst, size_t dstride, int lane) {
    f32x4 v0[4], v1[4]; float s[4], s2[4];
#pragma unroll
    for (int k = 0; k < 4; ++k) { v0[k] = *(const LAS f32x4*)(xr + k * rstride + 4 * lane); v1[k] = *(const LAS f32x4*)(xr + k * rstride + 256 + 4 * lane);
        s[k] = (v0[k].x + v0[k].y) + (v0[k].z + v0[k].w) + (v1[k].x + v1[k].y) + (v1[k].z + v1[k].w); }
#pragma unroll
    for (int o = 1; o < 64; o <<= 1) {
#pragma unroll
        for (int k = 0; k < 4; ++k) s[k] += shfl_idx(s[k], lane ^ o); }
#pragma unroll
    for (int k = 0; k < 4; ++k) { const float mean = s[k] * (1.f / 512.f); v0[k] = v0[k] - mean; v1[k] = v1[k] - mean;
        s2[k] = (v0[k].x * v0[k].x + v0[k].y * v0[k].y) + (v0[k].z * v0[k].z + v0[k].w * v0[k].w) + (v1[k].x * v1[k].x + v1[k].y * v1[k].y) + (v1[k].z * v1[k].z + v1[k].w * v1[k].w); }
#pragma unroll
    for (int o = 1; o < 64; o <<= 1) {
#pragma unroll
        for (int k = 0; k < 4; ++k) s2[k] += shfl_idx(s2[k], lane ^ o); }
    const f32x4 g0 = *(const GAS f32x4*)(g + 4 * lane), g1 = *(const GAS f32x4*)(g + 256 + 4 * lane), b0 = *(const GAS f32x4*)(b + 4 * lane), b1 = *(const GAS f32x4*)(b + 256 + 4 * lane);
#pragma unroll
    for (int k = 0; k < 4; ++k) { const float rstd = __builtin_amdgcn_rsqf(s2[k] * (1.f / 512.f) + LN_EPS);
        f32x4 y0 = v0[k] * rstd * g0 + b0, y1 = v1[k] * rstd * g1 + b1;
#pragma unroll
        for (int i = 0; i < 4; ++i) { y0[i] = y0[i] * pg8::sigmoidf_fast(y0[i]); y1[i] = y1[i] * pg8::sigmoidf_fast(y1[i]); }
        bf16* d = dst + (size_t)k * dstride;
        *(GAS v2u*)(d + 4 * lane) = (v2u){pk2(y0.x, y0.y), pk2(y0.z, y0.w)}; *(GAS v2u*)(d + 256 + 4 * lane) = (v2u){pk2(y1.x, y1.y), pk2(y1.z, y1.w)}; }
}
__device__ __forceinline__ void b_prompt_item(Frame& F, int layer, int item, const bf16* Z, bf16* Y) {
    const int tidl = opqv(F.tid), b = item >> 5, t0 = 64 * (item & 31), p = tidl & 255, hh = tidl >> 8, ts = t0 + 32 * hh;
    const GAS unsigned* Zu = (const GAS unsigned*)(Z + (size_t)b * SEQ * ZC) + 512 + p;
    unsigned raw[62];
#pragma unroll
    for (int i = 0; i < 62; ++i) { const int t = ts - 30 + i; raw[i] = t >= 0 ? Zu[(size_t)t * (ZC / 2)] : 0u; }
    const float* cw = F.in[I_CFW] + (size_t)layer * 31 * 512 + 2 * p;
    f32x2 wj[31];
#pragma unroll
    for (int j = 0; j < 31; ++j) wj[j] = *(const GAS f32x2*)(cw + j * 512);
    const f32x2 bias = *(const GAS f32x2*)(F.in[I_CFB] + layer * 512 + 2 * p);
    f32x2 in[62];
#pragma unroll
    for (int i = 0; i < 62; ++i) in[i] = (f32x2){bflo(raw[i]), bfhi(raw[i])};
    LAS float* obuf = (LAS float*)(F.lds + RING_OFF);
#pragma unroll
    for (int i = 0; i < 32; ++i) { f32x2 o = bias;
#pragma unroll
        for (int j = 0; j < 31; ++j) o += wj[j] * in[i + j];
        *(LAS f32x2*)(obuf + (32 * hh + i) * 512 + 2 * p) = o; }
    __syncthreads();
    const float* lg = F.in[I_CFG] + layer * 512; const float* lb = F.in[I_CFBB] + layer * 512;
#pragma unroll 1
    for (int r = 8 * F.wave; r < 8 * F.wave + 8; r += 4) ln_silu_rows4(obuf + r * 512, 512, lg, lb, Y + (size_t)(b * SEQ + t0 + r) * YC + 512, YC, F.lane);
}
__device__ __forceinline__ void cd_prompt_item(Frame& F, int layer, int item, const bf16* Z, bf16* Y) {
    const int tidl = opqv(F.tid), b = item >> 5, t0 = 64 * (item & 31), p = tidl & 255, hh = tidl >> 8;
    const bf16* Zb = Z + (size_t)b * SEQ * ZC;
    LAS unsigned* cbuf = (LAS unsigned*)(F.lds + RING_OFF);
    { v4u tmp[10];
#pragma unroll
      for (int k = 0; k < 10; ++k) { const int ci = tidl + 512 * k, pr = ci >> 6, cc = ci & 63, t = t0 - 15 + pr;
          tmp[k] = (ci < 79 * 64 && t >= 0) ? *(const GAS v4u*)(Zb + (size_t)t * ZC + 1536 + 8 * cc) : (v4u){0u, 0u, 0u, 0u}; }
#pragma unroll
      for (int k = 0; k < 10; ++k) { const int ci = tidl + 512 * k, pr = ci >> 6, cc = ci & 63; if (ci < 79 * 64) *(LAS v4u*)(cbuf + pr * 256 + 4 * cc) = tmp[k]; } }
    const int ts = t0 + 32 * hh;
    unsigned uu[34], dd[32];
#pragma unroll
    for (int i = 0; i < 34; ++i) { const int t = ts - 2 + i; uu[i] = t >= 0 ? ((const GAS unsigned*)(Zb + (size_t)t * ZC))[1280 + p] : 0u; }
#pragma unroll
    for (int i = 0; i < 32; ++i) dd[i] = ((const GAS unsigned*)(Zb + (size_t)(ts + i) * ZC))[1024 + p];
    const f32x2 w0 = ((const GAS f32x2*)(F.in[I_SCW] + (size_t)(layer * 3 + 0) * 512))[p], w1 = ((const GAS f32x2*)(F.in[I_SCW] + (size_t)(layer * 3 + 1) * 512))[p],
                w2 = ((const GAS f32x2*)(F.in[I_SCW] + (size_t)(layer * 3 + 2) * 512))[p];
    __syncthreads();
    const int w = 2 << (p >> 6), rr0 = 15 + 32 * hh;
    f32x2 s = (f32x2){0.f, 0.f};
    for (int j = 0; j < w; ++j) { const unsigned v = cbuf[(rr0 - j) * 256 + p]; s += (f32x2){bflo(v), bfhi(v)}; }
    GAS unsigned* Yu = (GAS unsigned*)(Y + (size_t)(b * SEQ + ts) * YC) + p;
#pragma unroll
    for (int i = 0; i < 32; ++i) { const int t = ts + i, rr = rr0 + i;
        const unsigned cur = cbuf[rr * 256 + p]; const f32x2 cf = (f32x2){bflo(cur), bfhi(cur)};
        if (i > 0) { const unsigned old = cbuf[(rr - w) * 256 + p]; s += cf - (f32x2){bflo(old), bfhi(old)}; }
        const float ic = __builtin_amdgcn_rcpf((float)(t + 1 < w ? t + 1 : w));
        const f32x2 mm = s * ic - cf;
        Yu[(size_t)i * 1024 + 512] = pk2(mm.x, mm.y);
        const f32x2 cv = w0 * (f32x2){bflo(uu[i]), bfhi(uu[i])} + w1 * (f32x2){bflo(uu[i + 1]), bfhi(uu[i + 1])} + w2 * (f32x2){bflo(uu[i + 2]), bfhi(uu[i + 2])};
        const f32x2 yd = (f32x2){bflo(dd[i]), bfhi(dd[i])} * cv;
        Yu[(size_t)i * 1024 + 768] = pk2(yd.x, yd.y); }
}
__device__ __forceinline__ void s_sample_item(Frame& F, int layer, int s, const bf16* Z, bf16* Y) {
    const int ch = opqv(F.tid); const size_t ls = (size_t)layer * 128 + s;
    const bf16* Zr = Z + (size_t)(MP + 4 * s) * ZC; bf16* Yr = Y + (size_t)(MP + 4 * s) * YC;
    LAS float* obuf = (LAS float*)(F.lds + RING_OFF);
    float in[34], wv[31], pb[19], u[6], dbv[4];
#pragma unroll
    for (int j = 0; j < 30; ++j) in[j] = (F.in[I_SCF] + (ls * 30 + j) * 512)[ch];
#pragma unroll
    for (int j = 0; j < 15; ++j) pb[j] = (F.in[I_SPOOL] + (ls * 15 + j) * 512)[ch];
    u[0] = (F.in[I_SSC] + (ls * 2 + 0) * 512)[ch]; u[1] = (F.in[I_SSC] + (ls * 2 + 1) * 512)[ch];
#pragma unroll
    for (int r = 0; r < 4; ++r) { in[30 + r] = bf1((Zr + (size_t)r * ZC + 1024)[ch]); pb[15 + r] = bf1((Zr + (size_t)r * ZC + 1536)[ch]); u[2 + r] = bf1((Zr + (size_t)r * ZC + 2560)[ch]); dbv[r] = bf1((Zr + (size_t)r * ZC + 2048)[ch]); }
#pragma unroll
    for (int j = 0; j < 31; ++j) wv[j] = (F.in[I_CFW] + ((size_t)layer * 31 + j) * 512)[ch];
    const float bias = (F.in[I_CFB] + layer * 512)[ch];
    const float w0 = (F.in[I_SCW] + (size_t)(layer * 3 + 0) * 512)[ch], w1 = (F.in[I_SCW] + (size_t)(layer * 3 + 1) * 512)[ch], w2 = (F.in[I_SCW] + (size_t)(layer * 3 + 2) * 512)[ch];
    asm volatile("" ::: "memory");
#pragma unroll
    for (int j = 0; j < 26; ++j) (F.out + O_SCF + (ls * 30 + j) * 512)[ch] = in[j + 4];
#pragma unroll
    for (int r = 0; r < 4; ++r) { float o = bias;
#pragma unroll
        for (int j = 0; j < 31; ++j) o += wv[j] * in[r + j];
        obuf[r * 512 + ch] = o; }
#pragma unroll
    for (int j = 0; j < 11; ++j) (F.out + O_SPOOL + (ls * 15 + j) * 512)[ch] = pb[j + 4];
    const int gsel = ch >> 7;
#pragma unroll
    for (int r = 0; r < 4; ++r) { const int k = 15 + r;
        const float s2 = pb[k] + pb[k - 1], s4 = s2 + pb[k - 2] + pb[k - 3], s8 = s4 + (pb[k - 4] + pb[k - 5]) + (pb[k - 6] + pb[k - 7]);
        float s16 = s8;
#pragma unroll
        for (int j = 8; j < 16; ++j) s16 += pb[k - j];
        const float mv = (gsel == 0 ? s2 * 0.5f : gsel == 1 ? s4 * 0.25f : gsel == 2 ? s8 * 0.125f : s16 * 0.0625f) - pb[k];
        (Yr + (size_t)r * YC + 1024)[ch] = f2bf(mv); }
#pragma unroll
    for (int r = 0; r < 4; ++r) (Yr + (size_t)r * YC + 1536)[ch] = f2bf(dbv[r] * (w0 * u[r] + w1 * u[r + 1] + w2 * u[r + 2]));
    __syncthreads();
    if (F.wave < 4) ln_silu_row(obuf + F.wave * 512, F.in[I_CFG] + layer * 512, F.in[I_CFBB] + layer * 512, Yr + (size_t)F.wave * YC + 512, F.lane);
}

struct Args { const float* in[31]; float* out; unsigned char* ws; int ph_lo, ph_hi; };
__global__ void __launch_bounds__(NWAVES * 64, 2) hybrid_fwd(Args args) {
    extern __shared__ __attribute__((aligned(16))) unsigned char lds[];
    Frame F;
    F.lds = (LAS unsigned char*)lds;
    F.MISC = (volatile LAS unsigned*)(F.lds + MISC_OFF);
    const int wave0 = __builtin_amdgcn_readfirstlane((int)threadIdx.x >> 6);
    F.lane = lane_now(); F.wave = wave0; F.tid = F.wave * 64 + F.lane;
    F.G = gridDim.x; F.bid = blockIdx.x;
    F.ws = args.ws; F.out = args.out; F.ctl = (gu32*)(args.ws + WS_CTL);
    F.in = args.in;
    for (int u = F.tid; u < (LDS_BYTES - LDSCTL_OFF) / 4; u += NWAVES * 64) ((LAS unsigned*)(F.lds + LDSCTL_OFF))[u] = 0u;
    __syncthreads();
    XcdBarrier bar; bar.bar = (unsigned*)(F.ctl + CW_BAR); bar.x = 0; bar.st = nullptr;
    if (!MK_SPLIT) bar = xcd_barrier_post((unsigned*)(F.ctl + CW_BAR), F.MISC + 8);
    if (!MK_SPLIT && threadIdx.x == 0) __hip_atomic_store((unsigned*)(F.ctl + CW_XID + blockIdx.x), bar.x + 1u, __ATOMIC_RELAXED, __HIP_MEMORY_SCOPE_AGENT);
    const int lo = args.ph_lo, hi = args.ph_hi;
#define IN(k) (lo <= (k) && (k) < hi)
#define REFRESH() do { F.lane = lane_now(); F.wave = opqs(wave0); F.tid = F.wave * 64 + F.lane; F.bid = opqs((int)blockIdx.x); } while (0)
#define SEAM(k) do { if (IN(k) && IN((k) + 1)) xcd_barrier(bar); } while (0)
    bf16* WA = (bf16*)(F.ws + WS_WA); bf16* XB = (bf16*)(F.ws + WS_XB); bf16* Y = (bf16*)(F.ws + WS_Y); bf16* Zm = (bf16*)(F.ws + WS_ZG); _Float16* Gb = (_Float16*)(F.ws + WS_ZG);
    bf16* Hb = (bf16*)(F.ws + WS_ZG); bf16* MB = (bf16*)F.out;
 bf16* Bt3 = (bf16*)(F.ws + WS_BT3); bf16* Bt4 = (bf16*)(F.ws + WS_BT4); bf16* Bt5 = (bf16*)(F.ws + WS_BT5); bf16* Bt6 = (bf16*)(F.ws + WS_BT6);

    if (IN(0)) { REFRESH(); convert_matrix<RM_WIN>(F, F.in[I_WIN], DM, INC, WA, DM, 0, 0, F.bid * NWAVES + F.wave, F.G * NWAVES); REFRESH(); x_to_bf16(F, XB, F.ctl + CW_P0); }
    SEAM(0);

    if (F.G == 256 && !MK_SPLIT) { if (threadIdx.x < 256) { const unsigned a = xb_ld((unsigned*)(F.ctl + CW_XID + threadIdx.x)), b = xb_ld((unsigned*)(F.ctl + CW_XID + (threadIdx.x & 63))); if (a != b || a == 0u) F.MISC[40] = 1u; } __syncthreads(); }
    const bool sameX = F.G == 256 && !MK_SPLIT && F.MISC[40] == 0u;
    const bool fast = F.G == 256;
    for (int l = 0; l < 2; ++l) {
        const int pb = 1 + 9 * l;
        if (IN(pb + 0)) for (int rep = 0; rep < NREP(0); ++rep) { if (rep) xcd_barrier(bar);
            if (fast && l == 1 && rep == 0 && F.bid >= 32 && F.bid < 96) { REFRESH();
                ln_rows(F, F.out, F.out, F.in[I_LN2G], F.in[I_LN2B], XB, F.out + (size_t)MP * DM, (const float*)(F.ws + WS_SLAB), 11, 32); publish_ready(F, F.ctl + CW_RDY + 64 * 1); }
            pg8::Gemm g{XB, WA, DM, DM, XB}; pg8::UnitOrder S; S.init(pg8::SK_PLAIN, 4096, DM, F.G, F.bid, 0); pg8::EpiMix E{Zm, F.out, l};
            if (fast && l == 1) { S.ready = (const unsigned*)(F.ctl + CW_RDY + 64 * 1); S.need = 64u; }
            if (fast) { S.subP = (unsigned*)(F.ctl + CW_DA + 1280 * l + 64 * bar.x); S.topP = (unsigned*)(F.ctl + CW_DA + 1280 * l + 64 * 16); S.doneS = (unsigned*)(F.ctl + CW_DA + 1280 * l + 64 * 17); S.nlocP = bar.st[0]; S.lastP = 3; S.fenceS = true; }
            pg8::gemm_phase<pg8::EpiMix, pg8::UnitOrder, true>(F.lds + RING_OFF, g, S, E, wave0);
            if (F.G == 256 && F.bid >= 32 && F.bid < 64 && rep + 1 == NREP(0)) {
                pg8::Gemm g2{XB, WA + (size_t)4096 * DM, DM, DM, XB}; pg8::UnitOrder S2; S2.init(pg8::SK_PLAIN, 4096, DM, 32, F.bid - 32, 0, false, true); pg8::EpiGate E2{Gb};
                if (fast) { S2.topP = (unsigned*)(F.ctl + CW_DA + 1280 * l + 64 * 16); S2.doneS = (unsigned*)(F.ctl + CW_DA + 1280 * l + 64 * 17); S2.fenceS = true; }
                if (fast && l == 1) { REFRESH(); wait_ready(F, F.ctl + CW_RDY + 64 * 1, 64u); }
                pg8::gemm_phase<pg8::EpiGate, pg8::UnitOrder, true>(F.lds + RING_OFF, g2, S2, E2, wave0); }
            if (F.G == 256 && F.bid >= 64 && rep + 1 == NREP(0)) {
                REFRESH(); const int gw = (F.bid - 64) * NWAVES + F.wave, NGW = 192 * NWAVES; const float* wbr = F.in[I_WBR] + (size_t)l * 4 * 512 * 1024;
                convert_matrix<RM_ID>(F, wbr, 512, 1024, Bt3, 2048, 0, 0, gw, NGW, 0);
                convert_matrix<RM_ID>(F, wbr + (size_t)512 * 1024, 512, 1024, Bt3, 2048, 512, 0, gw, NGW, 256);
                convert_matrix<RM_ID>(F, wbr + (size_t)3 * 512 * 1024, 512, 1024, Bt3, 2048, 1536, 0, gw, NGW, 512);
                convert_matrix<RM_ID>(F, F.in[I_WOUT] + (size_t)l * DM * DM, DM, DM, Bt4, DM, 0, 0, gw, NGW, 768);
                REFRESH(); compose_pool(F, l, Bt3, gw, NGW, 1280); } }
        if (!fast) SEAM(pb + 0);
        if (IN(pb + 1)) for (int rep = 0; rep < NREP(1); ++rep) { if (rep) xcd_barrier(bar);
            __syncthreads(); REFRESH();
            if (fast) wait_ready(F, F.ctl + CW_DA + 1280 * l + 64 * 16, bar.st[1]);
            REFRESH();
            for (int r2 = 0; r2 < NREP2(0); ++r2) for (int it = F.bid; it < 256; it += F.G) { a_prompt_item(F, l, it, Zm, Y); __syncthreads(); }
            REFRESH();
            for (int r2 = 0; r2 < NREP2(2); ++r2) for (int it = F.bid; it < 256; it += F.G) { b_prompt_item(F, l, it, Zm, Y); __syncthreads(); }
            REFRESH();
            { const int cd0 = !fast ? F.bid : F.bid < 64 ? 256 : F.bid < 128 ? F.bid - 64 : F.bid, cd1 = (fast && F.bid >= 64 && F.bid < 128) ? F.bid + 1 : 256, cds = !fast ? F.G : F.bid < 128 ? 64 : 256;
              for (int r2 = 0; r2 < NREP2(3); ++r2) for (int it = cd0; it < cd1; it += cds) { cd_prompt_item(F, l, it, Zm, Y); __syncthreads(); } }
            REFRESH();
            if (fast && (F.bid < 64 || F.bid >= 128)) wait_ready(F, F.ctl + CW_DA + 1280 * l + 64 * 17, 64u);
            REFRESH();
            for (int r2 = 0; r2 < NREP2(1); ++r2) for (int it = (F.bid + 128) % F.G; it < 128; it += F.G) a_sample_task(F, l, 8 * it + F.wave, Zm, Y);
            __syncthreads(); REFRESH();
            { const int s0 = !fast ? F.bid : F.bid < 64 ? F.bid : (F.bid >= 128 && F.bid < 192) ? F.bid - 64 : 128;
              for (int r2 = 0; r2 < NREP2(4); ++r2) for (int it = s0; it < 128; it += F.G) { s_sample_item(F, l, it, Zm, Y); __syncthreads(); } }
            REFRESH();
            const float* wbr = F.in[I_WBR] + (size_t)l * 4 * 512 * 1024;
            if (F.G != 256) { const int gw = F.bid * NWAVES + F.wave, NGW = F.G * NWAVES;
                convert_matrix<RM_ID>(F, wbr, 512, 1024, Bt3, 2048, 0, 0, gw, NGW); convert_matrix<RM_ID>(F, wbr + (size_t)512 * 1024, 512, 1024, Bt3, 2048, 512, 0, gw, NGW);
                convert_matrix<RM_ID>(F, wbr + (size_t)3 * 512 * 1024, 512, 1024, Bt3, 2048, 1536, 0, gw, NGW); convert_matrix<RM_ID>(F, F.in[I_WOUT] + (size_t)l * DM * DM, DM, DM, Bt4, DM, 0, 0, gw, NGW);
                REFRESH(); compose_pool(F, l, Bt3, gw, NGW); }
        }
        SEAM(pb + 1);
        if (IN(pb + 2)) for (int rep = 0; rep < NREP(2); ++rep) { if (rep) xcd_barrier(bar); pg8::Gemm g{XB, WA + (size_t)4096 * DM, DM, DM, XB}; pg8::UnitOrder S; S.init(pg8::SK_PLAIN, 4096, DM, F.G, F.bid, 0, true, F.G != 256); pg8::EpiGate E{Gb};
            pg8::gemm_phase<pg8::EpiGate, pg8::UnitOrder, true>(F.lds + RING_OFF, g, S, E, wave0); }
        if (sameX && IN(pb + 2) && IN(pb + 3)) {
            VM_WAIT(); __syncthreads();
            if (threadIdx.x == 0) { (void)xb_add((unsigned*)(F.ctl + CW_GRP + 4224 * l + 64 * 64), 1u); (void)xb_add((unsigned*)(F.ctl + CW_GRP + 4224 * l + 64 * (blockIdx.x & 63)), 1u); }
            REFRESH(); wait_ready(F, F.ctl + CW_GRP + 4224 * l + 64 * (F.bid & 63), 4u); }
        else SEAM(pb + 2);
        if (IN(pb + 3)) for (int rep = 0; rep < NREP(3); ++rep) { if (rep) xcd_barrier(bar); pg8::Gemm g{Y, Bt3, 2048, 2048, Y}; pg8::UnitOrder S; S.init(pg8::SK_P3, DM, 2048, F.G, F.bid, 0); pg8::EpiMerge E{Gb, MB, (bf16*)(F.ws + WS_MB4S)};
            if (sameX) { S.ready = (const unsigned*)(F.ctl + CW_GRP + 4224 * l + 64 * 64); S.need = 256u; }
            if (fast) { S.remap = true; S.subP = (unsigned*)(F.ctl + CW_DN + 1280 * l + 64 * bar.x); S.topP = (unsigned*)(F.ctl + CW_DN + 1280 * l + 64 * 16); S.doneS = (unsigned*)(F.ctl + CW_DN + 1280 * l + 64 * 17); S.nlocP = bar.st[0]; }
            pg8::gemm_phase<pg8::EpiMerge, pg8::UnitOrder, true>(F.lds + RING_OFF, g, S, E, wave0);
            if (F.G == 256 && (F.bid & 63) >= 8 && rep + 1 == NREP(3)) {
                REFRESH(); if (sameX) { wait_ready(F, F.ctl + CW_GRP + 4224 * l + 64 * 64, 256u); REFRESH(); }
                const int gw = ((F.bid >> 6) * 56 + (F.bid & 63) - 8) * NWAVES + F.wave, NGW = 224 * NWAVES;
                convert_matrix<RM_GU>(F, F.in[I_WG] + (size_t)l * DM * FF, DM, FF, Bt5, DM, 0, 0, gw, NGW, 0);
                convert_matrix<RM_GU>(F, F.in[I_WU] + (size_t)l * DM * FF, DM, FF, Bt5, DM, 0, 128, gw, NGW, 1408); } }
        if (!fast) SEAM(pb + 3);
        if (IN(pb + 4)) for (int rep = 0; rep < 1; ++rep) { pg8::Gemm g{MB, Bt4, DM, DM, (const bf16*)(F.ws + WS_MB4S)}; pg8::UnitOrder S; S.init(pg8::SK_P4, DM, DM, F.G, F.bid, 0);
            if (fast) { S.remap = true; S.ready = (const unsigned*)(F.ctl + CW_DN + 1280 * l + 64 * 17); S.need = 32u; REFRESH(); wait_ready(F, F.ctl + CW_DN + 1280 * l + 64 * 16, bar.st[1]); }
            pg8::EpiRes E{l == 0 ? F.in[I_XP] : nullptr, l == 0 ? nullptr : XB, nullptr, XB, F.in[I_LN1G] + l * DM, F.in[I_LN1B] + l * DM, (float*)(F.ws + WS_SLAB),
                          pg8::PanelStats{(unsigned*)(F.ws + WS_XCH + (size_t)(2 * l) * 512 * 1024), (unsigned*)(F.ctl + CW_SEAM + (2 * l) * SEAM_BANK)}, F.lds + XLDS_OFF, wave0};
            pg8::gemm_phase<pg8::EpiRes, pg8::UnitOrder, true>(F.lds + RING_OFF, g, S, E, wave0);
}
        SEAM(pb + 4);
        if (IN(pb + 5) && !fast) for (int rep = 0; rep < NREP(5); ++rep) { if (rep) xcd_barrier(bar);
            REFRESH();
            ln_rows(F, F.out, rep + 1 < NREP(5) ? (float*)(F.ws + WS_Y) : F.out, F.in[I_LN1G] + l * DM, F.in[I_LN1B] + l * DM, rep + 1 < NREP(5) ? nullptr : XB, l == 0 ? F.in[I_XS] : F.out + (size_t)MP * DM, (const float*)(F.ws + WS_SLAB), 16);
            REFRESH();
            if (F.G != 256) { const int gw = F.bid * NWAVES + F.wave, NGW = F.G * NWAVES;
                convert_matrix<RM_GU>(F, F.in[I_WG] + (size_t)l * DM * FF, DM, FF, Bt5, DM, 0, 0, gw, NGW); convert_matrix<RM_GU>(F, F.in[I_WU] + (size_t)l * DM * FF, DM, FF, Bt5, DM, 0, 128, gw, NGW);
                convert_matrix<RM_ID>(F, F.in[I_WD] + (size_t)l * FF * DM, FF, DM, Bt6, FF, 0, 0, gw, NGW); }
        }
        if (!fast) SEAM(pb + 5);
        if (IN(pb + 6)) for (int rep = 0; rep < NREP(6); ++rep) { if (rep) xcd_barrier(bar);
            if (fast && rep == 0 && F.bid >= 172 && F.bid < 236) { REFRESH();
                ln_rows(F, F.out, F.out, F.in[I_LN1G] + l * DM, F.in[I_LN1B] + l * DM, XB, l == 0 ? F.in[I_XS] : F.out + (size_t)MP * DM, (const float*)(F.ws + WS_SLAB), 16, 172); publish_ready(F, F.ctl + CW_RDY + 64 * (2 * l)); }
            pg8::Gemm g{XB, Bt5, DM, DM, XB}; pg8::UnitOrder S; S.init(pg8::SK_PLAIN, 2 * FF, DM, F.G, F.bid, 0); pg8::EpiSwi E{Hb};
            if (fast) { S.ready = (const unsigned*)(F.ctl + CW_RDY + 64 * (2 * l)); S.need = 64u; }
            pg8::gemm_phase<pg8::EpiSwi, pg8::UnitOrder, true>(F.lds + RING_OFF, g, S, E, wave0);
            if (F.G == 256 && F.bid >= 172 && rep + 1 == NREP(6)) {
                REFRESH(); const int gw = (F.bid - 172) * NWAVES + F.wave, NGW = 84 * NWAVES;
                convert_matrix<RM_ID>(F, F.in[I_WD] + (size_t)l * FF * DM, FF, DM, Bt6, FF, 0, 0, gw, NGW, 0);
            } }
        SEAM(pb + 6);
        if (IN(pb + 7)) for (int rep = 0; rep < 1; ++rep) { pg8::Gemm g{Hb, Bt6, FF, FF, Hb}; pg8::UnitOrder S; S.init(pg8::SK_P6, DM, FF, F.G, F.bid, 0); pg8::EpiRes E{nullptr, XB, l == 1 ? F.out : nullptr, l == 0 ? XB : nullptr, F.in[I_LN2G] + l * DM, F.in[I_LN2B] + l * DM, (float*)(F.ws + WS_SLAB),
                          pg8::PanelStats{(unsigned*)(F.ws + WS_XCH + (size_t)(2 * l + 1) * 512 * 1024), (unsigned*)(F.ctl + CW_SEAM + (2 * l + 1) * SEAM_BANK)}, F.lds + XLDS_OFF, wave0};
            pg8::gemm_phase<pg8::EpiRes, pg8::UnitOrder, true>(F.lds + RING_OFF, g, S, E, wave0);
            if (F.G == 256 && F.bid >= 88 && l == 0) {
                REFRESH(); convert_matrix<RM_WIN>(F, F.in[I_WIN] + (size_t)DM * INC, DM, INC, WA, DM, 0, 0, (F.bid - 88) * NWAVES + F.wave, 168 * NWAVES); } }
        SEAM(pb + 7);
        if (IN(pb + 8) && !(fast && l == 0)) for (int rep = 0; rep < NREP(8); ++rep) { if (rep) xcd_barrier(bar);
            REFRESH();
            ln_rows(F, F.out, rep + 1 < NREP(8) ? (float*)(F.ws + WS_Y) : F.out, F.in[I_LN2G] + l * DM, F.in[I_LN2B] + l * DM, (l == 0 && rep + 1 == NREP(8)) ? XB : nullptr, F.out + (size_t)MP * DM, (const float*)(F.ws + WS_SLAB), 11);
            REFRESH();
            if (l == 0 && F.G != 256) convert_matrix<RM_WIN>(F, F.in[I_WIN] + (size_t)DM * INC, DM, INC, WA, DM, 0, 0, F.bid * NWAVES + F.wave, F.G * NWAVES);
        }
        if (l == 0 && !fast) SEAM(pb + 8);
    }
#undef IN
#undef SEAM
#undef REFRESH
}

extern "C" void kernel_launch(void* const* d_in, const int* in_sizes, int n_in, void* d_out, int out_size, void* d_ws, size_t ws_size, hipStream_t stream) {
    static int grid = 0;
    if (grid == 0) {
        if (n_in != 31 || out_size != (int)O_END || ws_size < WS_END) { fprintf(stderr, "kernel_launch: unexpected sizes n_in %d out %d ws %zu\n", n_in, out_size, ws_size); grid = -1; return; }
        int dev = 0, cus = 0, per_cu = 0;
        if (hipGetDevice(&dev) != hipSuccess || hipDeviceGetAttribute(&cus, hipDeviceAttributeMultiprocessorCount, dev) != hipSuccess) { grid = -1; return; }
        if (hipFuncSetAttribute((const void*)hybrid_fwd, hipFuncAttributeMaxDynamicSharedMemorySize, LDS_BYTES) != hipSuccess) { fprintf(stderr, "kernel_launch: hipFuncSetAttribute failed\n"); grid = -1; return; }
        if (hipOccupancyMaxActiveBlocksPerMultiprocessor(&per_cu, (const void*)hybrid_fwd, NWAVES * 64, LDS_BYTES) != hipSuccess || per_cu < 1)
            fprintf(stderr, "kernel_launch: occupancy query reports %d workgroups per CU\n", per_cu);
        (void)hipGetLastError();
        grid = cus;
    }
    if (grid < 0) return;
    if (hipMemsetAsync((char*)d_ws + WS_CTL, 0, CTL_ZERO_BYTES, stream) != hipSuccess) { fprintf(stderr, "kernel_launch: memset failed\n"); return; }
    Args a{};
    for (int i = 0; i < 31; ++i) a.in[i] = (const float*)d_in[i];
    a.out = (float*)d_out; a.ws = (unsigned char*)d_ws;
#if MK_SPLIT
    for (int ph = 0; ph < NPHASE; ++ph) { a.ph_lo = ph; a.ph_hi = ph + 1; hipLaunchKernelGGL(hybrid_fwd, dim3(grid), dim3(NWAVES * 64), LDS_BYTES, stream, a); }
#else
    a.ph_lo = 0; a.ph_hi = NPHASE;
    hipLaunchKernelGGL(hybrid_fwd, dim3(grid), dim3(NWAVES * 64), LDS_BYTES, stream, a);
#endif
}
```
